# Optimizing an MI355X kernel written in HIP

```python
import math
import jax, jax.numpy as jnp
from jax import lax
import numpy as np

D_MODEL = 1024
BATCH = 2
SEQ = 8192
DEPTH = 2

POOL_GROUPS = 4
POOL_GROUP_DIM = 128
POOL_WINDOWS = (2, 4, 8, 16)
POOL_DIM = POOL_GROUPS * POOL_GROUP_DIM
MLA_HEADS = 8
MLA_NOPE = 64
MLA_ROPE = 32
MLA_V = 64
MLA_Q_RANK = 384
MLA_KV_RANK = 256
ROPE_THETA = 10000.0
Q_BLOCK = 128
POS_OFFSET_MAX = 4096
GLA_HEADS = 4
GLA_DK = 64
GLA_DV = 128
GLA_GATE_RANK = 16
GLA_GATE_NORM = 16.0
GLA_CHUNK = 64
N_BRANCHES = 3
N_EXPERTS = 16
CAPACITY_FACTOR = 2
D_EXPERT = 2048
DN_ALPHA = (2 * DEPTH) ** 0.25
DN_BETA = (8 * DEPTH) ** (-0.25)
LN_EPS = 1e-5
RMS_EPS = 1e-6

IN_SPLITS = (
    POOL_DIM,
    MLA_Q_RANK,
    MLA_KV_RANK,
    MLA_ROPE,
    GLA_HEADS * GLA_DK,
    GLA_HEADS * GLA_DK,
    GLA_HEADS * GLA_DV,
    GLA_HEADS * GLA_DV,
    2 * GLA_GATE_RANK,
    N_BRANCHES * D_MODEL,
)
D_IN = sum(IN_SPLITS)

kernel_name = "hybrid_pool_mla_gla_ecmoe_deepnorm"


def layer_norm(x, g, b):
    xf = x.astype(jnp.float32)
    mu = jnp.mean(xf, axis=-1, keepdims=True)
    var = jnp.mean(jnp.square(xf - mu), axis=-1, keepdims=True)
    return ((xf - mu) * lax.rsqrt(var + LN_EPS) * g + b).astype(x.dtype)


def rms_norm(x, g):
    xf = x.astype(jnp.float32)
    ms = jnp.mean(jnp.square(xf), axis=-1, keepdims=True)
    return (xf * lax.rsqrt(ms + RMS_EPS) * g).astype(x.dtype)


def split_columns(proj):
    idx, acc = [], 0
    for s in IN_SPLITS[:-1]:
        acc += s
        idx.append(acc)
    return jnp.split(proj, idx, axis=-1)


def pool_mixer(u, w_group, scale):
    B, S, _ = u.shape
    uf = u.astype(jnp.float32).reshape(B, S, POOL_GROUPS, POOL_GROUP_DIM)
    csum = jnp.concatenate(
        [jnp.zeros((B, 1, POOL_GROUPS, POOL_GROUP_DIM), jnp.float32), jnp.cumsum(uf, axis=1)], axis=1)
    t = jnp.arange(S)
    outs = []
    for g, w in enumerate(POOL_WINDOWS):
        lo = jnp.clip(t - w // 2, 0, S)
        hi = jnp.clip(t + w // 2, 0, S)
        cg = csum[:, :, g]
        cnt = (hi - lo).astype(jnp.float32)[None, :, None]
        outs.append((cg[:, hi] - cg[:, lo]) / cnt - uf[:, :, g])
    pooled = jnp.stack(outs, axis=2)
    mixed = jnp.einsum('bsgc,gcd->bsgd', pooled, w_group.astype(jnp.float32)).reshape(B, S, POOL_DIM)
    return (mixed * scale).astype(u.dtype)


def rope_angles(positions, dim):
    half = dim // 2
    freqs = ROPE_THETA ** (-jnp.arange(half, dtype=jnp.float32) / half)
    ang = positions.astype(jnp.float32)[..., None] * freqs
    return jnp.cos(ang), jnp.sin(ang)


def apply_rope(x, cos, sin):
    half = x.shape[-1] // 2
    xf = x.astype(jnp.float32)
    x1, x2 = xf[..., :half], xf[..., half:]
    return jnp.concatenate([x1 * cos - x2 * sin, x1 * sin + x2 * cos], axis=-1).astype(x.dtype)


def mla(c_q, c_kv, k_r, positions, q_norm, w_uq, kv_norm, w_ukv):
    B, S, _ = c_q.shape
    q = jnp.einsum('bsr,rn->bsn', rms_norm(c_q, q_norm), w_uq).reshape(B, S, MLA_HEADS, MLA_NOPE + MLA_ROPE)
    kv = jnp.einsum('bsr,rn->bsn', rms_norm(c_kv, kv_norm), w_ukv).reshape(B, S, MLA_HEADS, MLA_NOPE + MLA_V)
    q_nope, q_rope = q[..., :MLA_NOPE], q[..., MLA_NOPE:]
    k_nope, v = kv[..., :MLA_NOPE], kv[..., MLA_NOPE:]
    cos, sin = rope_angles(positions, MLA_ROPE)
    q_rope = apply_rope(q_rope, cos[:, :, None, :], sin[:, :, None, :])
    k_rope = apply_rope(k_r, cos, sin)
    scale = (MLA_NOPE + MLA_ROPE) ** -0.5
    nb = S // Q_BLOCK
    qn_b = (q_nope * scale).reshape(B, nb, Q_BLOCK, MLA_HEADS, MLA_NOPE).transpose(1, 0, 2, 3, 4)
    qr_b = (q_rope * scale).reshape(B, nb, Q_BLOCK, MLA_HEADS, MLA_ROPE).transpose(1, 0, 2, 3, 4)

    def attend(blk):
        qn, qr = blk
        s = (jnp.einsum('bqhd,bkhd->bhqk', qn, k_nope).astype(jnp.float32)
             + jnp.einsum('bqhr,bkr->bhqk', qr, k_rope).astype(jnp.float32))
        p = jax.nn.softmax(s, axis=-1).astype(v.dtype)
        return jnp.einsum('bhqk,bkhd->bqhd', p, v)

    o = lax.map(attend, (qn_b, qr_b))
    return o.transpose(1, 0, 2, 3, 4).reshape(B, S, MLA_HEADS * MLA_V)


def gla_direction(q, k, v, g):
    B, S, H, DK = q.shape
    L = GLA_CHUNK
    N = S // L

    def resh(t):
        return t.reshape(B, N, L, H, t.shape[-1]).transpose(0, 3, 1, 2, 4)

    q, k, v, g = resh(q), resh(k), resh(v), resh(g)
    b = jnp.cumsum(g, axis=3)
    b_last = b[:, :, :, -1:, :]
    q_in = q * jnp.exp(b)
    k_in = k * jnp.exp(-b)
    k_st = k * jnp.exp(b_last - b)
    mask = jnp.tril(jnp.ones((L, L), dtype=bool))
    a = jnp.where(mask, jnp.einsum('bhnid,bhnjd->bhnij', q_in, k_in), 0.0)
    o_intra = jnp.einsum('bhnij,bhnjv->bhniv', a, v)
    dec = jnp.exp(b_last[:, :, :, 0, :])
    kv_chunk = jnp.einsum('bhnjd,bhnjv->bhndv', k_st, v)

    def step(state, inp):
        dec_n, kv_n = inp
        return dec_n[..., None] * state + kv_n, state

    init = jnp.zeros((B, H, DK, v.shape[-1]), jnp.float32)
    _, s_prev = lax.scan(step, init, (jnp.moveaxis(dec, 2, 0), jnp.moveaxis(kv_chunk, 2, 0)))
    s_prev = jnp.moveaxis(s_prev, 0, 2)
    o_inter = jnp.einsum('bhnid,bhndv->bhniv', q_in, s_prev)
    return (o_intra + o_inter).transpose(0, 2, 3, 1, 4).reshape(B, S, H, v.shape[-1])


def gla(q, k, v, r, dlow, w_dec2, b_dec, norm_g):
    B, S, _ = q.shape
    qf = q.astype(jnp.float32).reshape(B, S, GLA_HEADS, GLA_DK) * (GLA_DK ** -0.5)
    kf = k.astype(jnp.float32).reshape(B, S, GLA_HEADS, GLA_DK)
    vf = v.astype(jnp.float32).reshape(B, S, GLA_HEADS, GLA_DV)
    logits = jnp.einsum('bsir,irk->bsik', dlow.reshape(B, S, 2, GLA_GATE_RANK), w_dec2) + b_dec
    g = (jax.nn.log_sigmoid(logits.astype(jnp.float32)) / GLA_GATE_NORM).reshape(B, S, 2, GLA_HEADS, GLA_DK)
    o_f = gla_direction(qf, kf, vf, g[:, :, 0])
    flip = lambda t: jnp.flip(t, axis=1)
    o_b = flip(gla_direction(flip(qf), flip(kf), flip(vf), flip(g[:, :, 1])))
    o = rms_norm(o_f + o_b, norm_g).reshape(B, S, GLA_HEADS * GLA_DV)
    return (o * jax.nn.silu(r.astype(jnp.float32))).astype(q.dtype)


def hybrid_mixer(h, positions, w_in, b_gate, pool_w, pool_scale, w_up_a,
                 mla_q_norm, mla_w_uq, mla_kv_norm, mla_w_ukv, w_up_b,
                 gla_w_dec, gla_b_dec, gla_norm, w_up_c, w_out):
    B, S, D = h.shape
    proj = jnp.einsum('bsd,dn->bsn', h, w_in)
    u_pool, c_q, c_kv, k_r, g_q, g_k, g_v, g_r, g_dec, gate_logits = split_columns(proj)
    y_a = jnp.einsum('bsc,cd->bsd', pool_mixer(u_pool, pool_w, pool_scale), w_up_a)
    y_b = jnp.einsum('bsc,cd->bsd', mla(c_q, c_kv, k_r, positions, mla_q_norm, mla_w_uq, mla_kv_norm, mla_w_ukv), w_up_b)
    y_c = jnp.einsum('bsc,cd->bsd', gla(g_q, g_k, g_v, g_r, g_dec, gla_w_dec, gla_b_dec, gla_norm), w_up_c)
    gates = jax.nn.sigmoid((gate_logits + b_gate).astype(jnp.float32)).reshape(B, S, N_BRANCHES, D).astype(h.dtype)
    merged = gates[:, :, 0] * y_a + gates[:, :, 1] * y_b + gates[:, :, 2] * y_c
    return jnp.einsum('bsd,de->bse', merged, w_out)


def expert_choice_ffn(h, router_w, w_gate, w_up, w_down):
    B, S, D = h.shape
    cap = CAPACITY_FACTOR * S // N_EXPERTS
    affinity = jax.nn.softmax(jnp.einsum('bsd,de->bse', h, router_w).astype(jnp.float32), axis=-1)
    gate, idx = lax.top_k(jnp.transpose(affinity, (0, 2, 1)), cap)
    xe = jax.vmap(lambda hb, ib: hb[ib])(h, idx)
    hid = jax.nn.silu(jnp.einsum('becd,edf->becf', xe, w_gate)) * jnp.einsum('becd,edf->becf', xe, w_up)
    ye = jnp.einsum('becf,efd->becd', hid, w_down) * gate[..., None].astype(h.dtype)
    return jax.vmap(lambda ib, yb: jnp.zeros((S, D), yb.dtype).at[ib.reshape(-1)].add(yb.reshape(-1, D)))(idx, ye)


def setup_inputs(seed: int = 0) -> dict:
    key = jax.random.key(seed)
    ks = jax.random.split(key, 32)
    L = DEPTH
    f32 = jnp.float32

    def w(k, shape, fan_in, gain=1.0):
        return jax.random.normal(k, shape, f32) * (gain * fan_in ** -0.5)

    def gain(k, shape):
        return 1.0 + 0.02 * jax.random.normal(k, shape, f32)

    def bias(k, shape):
        return 0.02 * jax.random.normal(k, shape, f32)

    x = jax.random.normal(ks[0], (BATCH, SEQ, D_MODEL), f32)
    positions = (jnp.arange(SEQ, dtype=jnp.int32)[None, :]
                 + jax.random.randint(ks[1], (BATCH, 1), 0, POS_OFFSET_MAX, dtype=jnp.int32))
    return {
        "x": x,
        "positions": positions,
        "ln0_g": gain(ks[2], (D_MODEL,)),
        "ln0_b": bias(ks[3], (D_MODEL,)),
        "w_in": w(ks[4], (L, D_MODEL, D_IN), D_MODEL),
        "b_gate": bias(ks[5], (L, N_BRANCHES * D_MODEL)),
        "pool_w": w(ks[6], (L, POOL_GROUPS, POOL_GROUP_DIM, POOL_GROUP_DIM), POOL_GROUP_DIM),
        "pool_scale": gain(ks[7], (L, POOL_DIM)),
        "w_up_a": w(ks[8], (L, POOL_DIM, D_MODEL), POOL_DIM),
        "mla_q_norm": gain(ks[9], (L, MLA_Q_RANK)),
        "mla_w_uq": w(ks[10], (L, MLA_Q_RANK, MLA_HEADS * (MLA_NOPE + MLA_ROPE)), MLA_Q_RANK),
        "mla_kv_norm": gain(ks[11], (L, MLA_KV_RANK)),
        "mla_w_ukv": w(ks[12], (L, MLA_KV_RANK, MLA_HEADS * (MLA_NOPE + MLA_V)), MLA_KV_RANK),
        "w_up_b": w(ks[13], (L, MLA_HEADS * MLA_V, D_MODEL), MLA_HEADS * MLA_V),
        "gla_w_dec": w(ks[14], (L, 2, GLA_GATE_RANK, GLA_HEADS * GLA_DK), GLA_GATE_RANK),
        "gla_b_dec": bias(ks[15], (L, 2, GLA_HEADS * GLA_DK)),
        "gla_norm": gain(ks[16], (L, GLA_DV)),
        "w_up_c": w(ks[17], (L, GLA_HEADS * GLA_DV, D_MODEL), GLA_HEADS * GLA_DV),
        "w_out": w(ks[18], (L, D_MODEL, D_MODEL), D_MODEL, DN_BETA),
        "ln1_g": gain(ks[19], (L, D_MODEL)),
        "ln1_b": bias(ks[20], (L, D_MODEL)),
        "router_w": w(ks[21], (L, D_MODEL, N_EXPERTS), D_MODEL),
        "exp_w_gate": w(ks[22], (L, N_EXPERTS, D_MODEL, D_EXPERT), D_MODEL),
        "exp_w_up": w(ks[23], (L, N_EXPERTS, D_MODEL, D_EXPERT), D_MODEL),
        "exp_w_down": w(ks[24], (L, N_EXPERTS, D_EXPERT, D_MODEL), D_EXPERT, DN_BETA),
        "ln2_g": gain(ks[25], (L, D_MODEL)),
        "ln2_b": bias(ks[26], (L, D_MODEL)),
    }


def reference(x, positions, ln0_g, ln0_b, w_in, b_gate, pool_w, pool_scale, w_up_a,
              mla_q_norm, mla_w_uq, mla_kv_norm, mla_w_ukv, w_up_b,
              gla_w_dec, gla_b_dec, gla_norm, w_up_c, w_out, ln1_g, ln1_b,
              router_w, exp_w_gate, exp_w_up, exp_w_down, ln2_g, ln2_b):
    h = layer_norm(x, ln0_g, ln0_b)
    for l in range(DEPTH):
        mix = hybrid_mixer(h, positions, w_in[l], b_gate[l], pool_w[l], pool_scale[l], w_up_a[l],
                           mla_q_norm[l], mla_w_uq[l], mla_kv_norm[l], mla_w_ukv[l], w_up_b[l],
                           gla_w_dec[l], gla_b_dec[l], gla_norm[l], w_up_c[l], w_out[l])
        h = layer_norm(DN_ALPHA * h + mix, ln1_g[l], ln1_b[l])
        ffn = expert_choice_ffn(h, router_w[l], exp_w_gate[l], exp_w_up[l], exp_w_down[l])
        h = layer_norm(DN_ALPHA * h + ffn, ln2_g[l], ln2_b[l])
    return h
```

```cpp
#include <hip/hip_runtime.h>
#include <cstdio>
#include <cstdint>

#ifndef MEGA
#define MEGA 1
#endif

constexpr int NB = 2, SEQ = 8192, T = NB * SEQ, DM = 1024, DIN = 5824;
constexpr int OFF_POOL = 0, OFF_CQ = 512, OFF_CKV = 896, OFF_KR = 1152, OFF_GQ = 1184, OFF_GK = 1440, OFF_GV = 1696, OFF_GR = 2208, OFF_GDEC = 2720, OFF_GATE = 2752;
constexpr int NE = 16, CAP = 1024, DEXP = 2048, NZ = NB * NE;
constexpr float ALPHA = 1.4142135623730951f;
constexpr float LN_EPS = 1e-5f, RMS_EPS = 1e-6f;
constexpr int NTHR = 512, LDS_BYTES = 147456;

constexpr size_t MiB = 1u << 20;
constexpr size_t WS_CTL = 0, CTL_BYTES = 1 * MiB;
constexpr size_t WS_ROPE = 1 * MiB;
constexpr size_t WS_AFF = 3 * MiB;
constexpr size_t WS_SLOT = 4 * MiB;
constexpr size_t WS_IDX = 5 * MiB;
constexpr size_t WS_GATEV = 5 * MiB + 256 * 1024;
constexpr size_t WS_PROJ = 8 * MiB;
constexpr size_t WS_HID = WS_PROJ;
constexpr size_t WS_PMIX = 372 * MiB;
constexpr size_t WS_MIXED = 404 * MiB;
constexpr size_t WS_CQN = 436 * MiB;
constexpr size_t WS_CKVN = 460 * MiB;
constexpr size_t WS_Q = 476 * MiB;
constexpr size_t WS_KV = 524 * MiB;
constexpr size_t WS_KROPE = 588 * MiB;
constexpr size_t WS_ATTO = 590 * MiB;
constexpr size_t WS_EG = 622 * MiB;
constexpr size_t WS_OF = 654 * MiB;
constexpr size_t WS_OB = 686 * MiB;
constexpr size_t WS_GLAO = 718 * MiB;
constexpr size_t WS_MERGED = 750 * MiB;
constexpr size_t WS_TMP = 814 * MiB;
constexpr size_t WS_YE = 878 * MiB;
constexpr size_t WS_END = 1006 * MiB;

struct Params {
    const float* in[27];
    const int* pos;
    float* out;
    unsigned char* ws;
};

__device__ __forceinline__ float wave_sum(float v) {
#pragma unroll
    for (int o = 1; o < 64; o <<= 1) v += __shfl_xor(v, o);
    return v;
}
__device__ __forceinline__ float sigmoidf_(float x) { return 1.f / (1.f + expf(-x)); }
__device__ __forceinline__ float siluf_(float x) { return x / (1.f + expf(-x)); }
__device__ __forceinline__ float log_sigmoidf_(float x) { return fminf(x, 0.f) - log1pf(expf(-fabsf(x))); }

__device__ __forceinline__ void ln_row(const float* a, const float* add, float alpha, const float* g, const float* b, float* out, int lane, float4 (&v)[4]) {
    float s = 0.f;
#pragma unroll
    for (int j = 0; j < 4; ++j) {
        float4 x = ((const float4*)a)[lane + 64 * j];
        x.x *= alpha; x.y *= alpha; x.z *= alpha; x.w *= alpha;
        if (add) { const float4 y = ((const float4*)add)[lane + 64 * j]; x.x += y.x; x.y += y.y; x.z += y.z; x.w += y.w; }
        v[j] = x; s += (x.x + x.y) + (x.z + x.w);
    }
    const float mean = wave_sum(s) * (1.f / DM); float s2 = 0.f;
#pragma unroll
    for (int j = 0; j < 4; ++j) { v[j].x -= mean; v[j].y -= mean; v[j].z -= mean; v[j].w -= mean; s2 += (v[j].x * v[j].x + v[j].y * v[j].y) + (v[j].z * v[j].z + v[j].w * v[j].w); }
    const float rstd = 1.f / sqrtf(wave_sum(s2) * (1.f / DM) + LN_EPS);
#pragma unroll
    for (int j = 0; j < 4; ++j) {
        const float4 gg = ((const float4*)g)[lane + 64 * j], bb = ((const float4*)b)[lane + 64 * j];
        float4 o; o.x = v[j].x * rstd * gg.x + bb.x; o.y = v[j].y * rstd * gg.y + bb.y; o.z = v[j].z * rstd * gg.z + bb.z; o.w = v[j].w * rstd * gg.w + bb.w;
        ((float4*)out)[lane + 64 * j] = o; v[j] = o;
    }
}

struct GemmP {
    const float* A; const int* ridx; const float* Bm; float* C;
    int lda, ldb, ldc, M, N, K, nb, bshift;
    long sA, sB, sC; int sR;
    const float* aux; int ldaux; long sAux; const float* aux2; int accum;
};
template <int MODE>
__device__ __forceinline__ void gemm_naive(const GemmP g, float* lds) {
    float (*As)[132] = (float (*)[132])lds;
    float (*Bs)[128] = (float (*)[128])(lds + 16 * 132);
    int tid_ = threadIdx.x; asm volatile("" : "+v"(tid_));
    const int tid = tid_, ty = tid >> 4, tx = tid & 15;
    const int mt = g.M / 128, nt = (g.N + 127) / 128, per = mt * nt, total = per * g.nb;
    int bid_ = blockIdx.x; asm volatile("" : "+s"(bid_));
    for (int tile = bid_; tile < total; tile += gridDim.x) {
        const int z = tile / per, r = tile % per, tm = r / nt, tn = r % nt;
        const int m0 = tm * 128, n0 = tn * 128;
        const float* Bz = g.Bm + (long)(z >> g.bshift) * g.sB;
        float* Cz = g.C + (long)z * g.sC;
        const int arow = m0 + (tid >> 2);
        const long grow = g.ridx ? (long)g.ridx[z * g.sR + arow] : (long)arow;
        const float* Arow = g.A + (long)z * g.sA + grow * g.lda + (tid & 3) * 4;
        const int bk = tid >> 5, bn = n0 + (tid & 31) * 4;
        const bool bok = bn < g.N;
        const float* Bp = Bz + (long)bk * g.ldb + bn;
        float acc[4][8];
#pragma unroll
        for (int i = 0; i < 4; ++i)
#pragma unroll
            for (int j = 0; j < 8; ++j) acc[i][j] = 0.f;
        float4 ra = *(const float4*)(Arow);
        float4 rb = bok ? *(const float4*)(Bp) : make_float4(0.f, 0.f, 0.f, 0.f);
        for (int k0 = 0; k0 < g.K; k0 += 16) {
            __syncthreads();
            { const int rr = tid >> 2, k4 = (tid & 3) * 4; As[k4][rr] = ra.x; As[k4 + 1][rr] = ra.y; As[k4 + 2][rr] = ra.z; As[k4 + 3][rr] = ra.w; }
            *(float4*)&Bs[bk][(tid & 31) * 4] = rb;
            __syncthreads();
            if (k0 + 16 < g.K) {
                ra = *(const float4*)(Arow + k0 + 16);
                rb = bok ? *(const float4*)(Bp + (long)(k0 + 16) * g.ldb) : make_float4(0.f, 0.f, 0.f, 0.f);
            }
#pragma unroll
            for (int k = 0; k < 16; ++k) {
                const float4 a = *(const float4*)&As[k][ty * 4];
                const float4 b0 = *(const float4*)&Bs[k][tx * 8], b1 = *(const float4*)&Bs[k][tx * 8 + 4];
                const float av[4] = {a.x, a.y, a.z, a.w};
                const float bv[8] = {b0.x, b0.y, b0.z, b0.w, b1.x, b1.y, b1.z, b1.w};
#pragma unroll
                for (int i = 0; i < 4; ++i)
#pragma unroll
                    for (int j = 0; j < 8; ++j) acc[i][j] = fmaf(av[i], bv[j], acc[i][j]);
            }
        }
#pragma unroll
        for (int i = 0; i < 4; ++i) {
            const int row = m0 + ty * 4 + i;
#pragma unroll
            for (int jv = 0; jv < 2; ++jv) {
                const int col = n0 + tx * 8 + jv * 4;
                if (col < g.N) {
                    float v[4] = {acc[i][jv * 4], acc[i][jv * 4 + 1], acc[i][jv * 4 + 2], acc[i][jv * 4 + 3]};
                    float* cp = Cz + (long)row * g.ldc + col;
                    if (MODE == 1) {
#pragma unroll
                        for (int q = 0; q < 4; ++q) v[q] *= g.aux[(long)z * g.sAux + col + q];
                    } else if (MODE == 2) {
                        const float4 gl = *(const float4*)(g.aux + (long)row * g.ldaux + col), gb = *(const float4*)(g.aux2 + col);
                        const float gv[4] = {gl.x + gb.x, gl.y + gb.y, gl.z + gb.z, gl.w + gb.w};
                        float4 old = make_float4(0.f, 0.f, 0.f, 0.f);
                        if (g.accum) old = *(const float4*)cp;
                        const float ov[4] = {old.x, old.y, old.z, old.w};
#pragma unroll
                        for (int q = 0; q < 4; ++q) v[q] = ov[q] + sigmoidf_(gv[q]) * v[q];
                    } else if (MODE == 3) {
                        const float4 old = *(const float4*)cp; const float ov[4] = {old.x, old.y, old.z, old.w};
#pragma unroll
                        for (int q = 0; q < 4; ++q) v[q] = siluf_(ov[q]) * v[q];
                    } else if (MODE == 4) {
                        const float rs = g.aux[(long)z * g.sAux + row];
#pragma unroll
                        for (int q = 0; q < 4; ++q) v[q] *= rs;
                    }
                    *(float4*)cp = make_float4(v[0], v[1], v[2], v[3]);
                }
            }
        }
    }
    __syncthreads();
}

#define W_IN(l)    (p.in[4]  + (size_t)(l) * DM * DIN)
#define B_GATE(l)  (p.in[5]  + (size_t)(l) * 3 * DM)
#define POOL_W(l)  (p.in[6]  + (size_t)(l) * 4 * 128 * 128)
#define POOL_S(l)  (p.in[7]  + (size_t)(l) * 512)
#define W_UP_A(l)  (p.in[8]  + (size_t)(l) * 512 * DM)
#define Q_NORM(l)  (p.in[9]  + (size_t)(l) * 384)
#define W_UQ(l)    (p.in[10] + (size_t)(l) * 384 * 768)
#define KV_NORM(l) (p.in[11] + (size_t)(l) * 256)
#define W_UKV(l)   (p.in[12] + (size_t)(l) * 256 * 1024)
#define W_UP_B(l)  (p.in[13] + (size_t)(l) * 512 * DM)
#define W_DEC(l)   (p.in[14] + (size_t)(l) * 2 * 16 * 256)
#define B_DEC(l)   (p.in[15] + (size_t)(l) * 2 * 256)
#define GLA_NORM(l)(p.in[16] + (size_t)(l) * 128)
#define W_UP_C(l)  (p.in[17] + (size_t)(l) * 512 * DM)
#define W_OUT(l)   (p.in[18] + (size_t)(l) * DM * DM)
#define LN1_G(l)   (p.in[19] + (size_t)(l) * DM)
#define LN1_B(l)   (p.in[20] + (size_t)(l) * DM)
#define ROUTER(l)  (p.in[21] + (size_t)(l) * DM * NE)
#define EW_GATE(l) (p.in[22] + (size_t)(l) * NE * DM * DEXP)
#define EW_UP(l)   (p.in[23] + (size_t)(l) * NE * DM * DEXP)
#define EW_DOWN(l) (p.in[24] + (size_t)(l) * NE * DEXP * DM)
#define LN2_G(l)   (p.in[25] + (size_t)(l) * DM)
#define LN2_B(l)   (p.in[26] + (size_t)(l) * DM)
#define WSF(off) ((float*)(p.ws + (off)))
#define WSI(off) ((int*)(p.ws + (off)))

enum Stage {
    ST_INIT = 0,
    ST_PROJ,
    ST_PREP,
    ST_SMALLGEMM,
    ST_ROPE,
    ST_ATTN,
    ST_GLAREC,
    ST_GLAFIN,
    ST_MERGE_A, ST_MERGE_B, ST_MERGE_C,
    ST_OUTP,
    ST_LN1,
    ST_TOPK,
    ST_EXP_G, ST_EXP_U, ST_EXP_D,
    ST_LN2,
    ST_COUNT
};

template <int ST>
__device__ __forceinline__ void run_stage(const Params& p, int l, float* lds) {
    int tid_ = threadIdx.x; asm volatile("" : "+v"(tid_));
    int bid_ = blockIdx.x; asm volatile("" : "+s"(bid_));
    const int tid = tid_, lane = tid & 63, wid = tid >> 6;
    const int G = gridDim.x, bid = bid_;
    const int gw = bid * 8 + wid, NGW = G * 8;
    const long gt = (long)bid * NTHR + tid, NGT = (long)G * NTHR;
    float* h = p.out;

    if constexpr (ST == ST_INIT) {
        for (int m = gw; m < T; m += NGW) { float4 vv[4]; ln_row(p.in[0] + (size_t)m * DM, nullptr, 1.f, p.in[2], p.in[3], h + (size_t)m * DM, lane, vv); }
        float* rc = WSF(WS_ROPE); float* rs = rc + T * 16;
        for (long i = gt; i < (long)T * 16; i += NGT) {
            const int t = (int)(i >> 4), j = (int)(i & 15);
            const float freq = (float)pow(10000.0, -(double)j / 16.0);
            const float ang = (float)p.pos[t] * freq;
            rc[i] = (float)cos((double)ang); rs[i] = (float)sin((double)ang);
        }
    }
    if constexpr (ST == ST_PROJ) {
        GemmP g{}; g.A = h; g.lda = DM; g.Bm = W_IN(l); g.ldb = DIN; g.C = WSF(WS_PROJ); g.ldc = DIN; g.M = T; g.N = DIN; g.K = DM; g.nb = 1;
        gemm_naive<0>(g, lds);
    }
    if constexpr (ST == ST_PREP) {
        const float* proj = WSF(WS_PROJ);
        float* pm = WSF(WS_PMIX);
        for (long i = gt; i < (long)T * 512; i += NGT) {
            const int t = (int)(i >> 9), c = (int)(i & 511), grp = c >> 7, w = 2 << grp;
            const int b = t / SEQ, s = t % SEQ;
            int lo = s - w / 2; if (lo < 0) lo = 0; int hi = s + w / 2; if (hi > SEQ) hi = SEQ;
            float sum = 0.f;
            for (int u = lo; u < hi; ++u) sum += proj[(size_t)(b * SEQ + u) * DIN + OFF_POOL + c];
            pm[i] = sum / (float)(hi - lo) - proj[(size_t)t * DIN + OFF_POOL + c];
        }
        float* cqn = WSF(WS_CQN); float* ckvn = WSF(WS_CKVN);
        for (int m = gw; m < T; m += NGW) {
            const float* cq = proj + (size_t)m * DIN + OFF_CQ; float v[6]; float s = 0.f;
#pragma unroll
            for (int j = 0; j < 6; ++j) { v[j] = cq[lane + 64 * j]; s += v[j] * v[j]; }
            const float r = 1.f / sqrtf(wave_sum(s) * (1.f / 384.f) + RMS_EPS);
#pragma unroll
            for (int j = 0; j < 6; ++j) cqn[(size_t)m * 384 + lane + 64 * j] = v[j] * r * Q_NORM(l)[lane + 64 * j];
            const float* ck = proj + (size_t)m * DIN + OFF_CKV; float u[4]; float s2 = 0.f;
#pragma unroll
            for (int j = 0; j < 4; ++j) { u[j] = ck[lane + 64 * j]; s2 += u[j] * u[j]; }
            const float r2 = 1.f / sqrtf(wave_sum(s2) * (1.f / 256.f) + RMS_EPS);
#pragma unroll
            for (int j = 0; j < 4; ++j) ckvn[(size_t)m * 256 + lane + 64 * j] = u[j] * r2 * KV_NORM(l)[lane + 64 * j];
        }
        float* eg = WSF(WS_EG);
        for (long i = gt; i < (long)T * 512; i += NGT) {
            const int t = (int)(i >> 9), dir = (int)((i >> 8) & 1), hd = (int)(i & 255);
            const float* dl = proj + (size_t)t * DIN + OFF_GDEC + dir * 16;
            const float* w = W_DEC(l) + (size_t)dir * 16 * 256 + hd;
            float acc = 0.f;
#pragma unroll
            for (int r = 0; r < 16; ++r) acc = fmaf(dl[r], w[(size_t)r * 256], acc);
            acc += B_DEC(l)[dir * 256 + hd];
            eg[i] = expf(log_sigmoidf_(acc) * (1.f / 16.f));
        }
    }
    if constexpr (ST == ST_SMALLGEMM) {
        { GemmP g{}; g.A = WSF(WS_PMIX); g.lda = 512; g.sA = 128; g.Bm = POOL_W(l); g.ldb = 128; g.sB = 128 * 128; g.C = WSF(WS_MIXED); g.ldc = 512; g.sC = 128;
          g.M = T; g.N = 128; g.K = 128; g.nb = 4; g.aux = POOL_S(l); g.sAux = 128; gemm_naive<1>(g, lds); }
        { GemmP g{}; g.A = WSF(WS_CQN); g.lda = 384; g.Bm = W_UQ(l); g.ldb = 768; g.C = WSF(WS_Q); g.ldc = 768; g.M = T; g.N = 768; g.K = 384; g.nb = 1; gemm_naive<0>(g, lds); }
        { GemmP g{}; g.A = WSF(WS_CKVN); g.lda = 256; g.Bm = W_UKV(l); g.ldb = 1024; g.C = WSF(WS_KV); g.ldc = 1024; g.M = T; g.N = 1024; g.K = 256; g.nb = 1; gemm_naive<0>(g, lds); }
    }
    if constexpr (ST == ST_ROPE) {
        const float* rc = WSF(WS_ROPE); const float* rs = rc + T * 16;
        float* q = WSF(WS_Q); float* kr = WSF(WS_KROPE); const float* proj = WSF(WS_PROJ);
        const float scale = 0.10206207261596575f;
        for (long i = gt; i < (long)T * 8 * 16; i += NGT) {
            const int t = (int)(i >> 7), hh = (int)((i >> 4) & 7), j = (int)(i & 15);
            float* qh = q + (size_t)t * 768 + hh * 96;
            const float c = rc[t * 16 + j], s = rs[t * 16 + j];
            const float x1 = qh[64 + j], x2 = qh[80 + j];
            qh[64 + j] = (x1 * c - x2 * s) * scale; qh[80 + j] = (x1 * s + x2 * c) * scale;
#pragma unroll
            for (int d = 0; d < 4; ++d) qh[j * 4 + d] *= scale;
        }
        for (long i = gt; i < (long)T * 16; i += NGT) {
            const int t = (int)(i >> 4), j = (int)(i & 15);
            const float c = rc[i], s = rs[i];
            const float x1 = proj[(size_t)t * DIN + OFF_KR + j], x2 = proj[(size_t)t * DIN + OFF_KR + 16 + j];
            kr[t * 32 + j] = x1 * c - x2 * s; kr[t * 32 + 16 + j] = x1 * s + x2 * c;
        }
    }
    if constexpr (ST == ST_ATTN) {
        const float* Q = WSF(WS_Q); const float* KV = WSF(WS_KV); const float* KR = WSF(WS_KROPE); float* AO = WSF(WS_ATTO);
        float (*Kt)[96] = (float (*)[96])lds;
        float (*Vt)[64] = (float (*)[64])(lds + 64 * 96);
        const int qd = tid & 3;
        for (int unit = bid; unit < NB * 8 * 64; unit += G) {
            const int b = unit >> 9, hh = (unit >> 6) & 7, qb = unit & 63;
            const int trow = b * SEQ + qb * 128 + (tid >> 2);
            float q[24], o[16]; float m = -1e30f, lsum = 0.f;
#pragma unroll
            for (int d = 0; d < 24; d += 4) { const float4 x = *(const float4*)(Q + (size_t)trow * 768 + hh * 96 + qd * 24 + d); q[d] = x.x; q[d + 1] = x.y; q[d + 2] = x.z; q[d + 3] = x.w; }
#pragma unroll
            for (int d = 0; d < 16; ++d) o[d] = 0.f;
            for (int k0 = 0; k0 < SEQ; k0 += 64) {
                __syncthreads();
#pragma unroll
                for (int it = 0; it < 5; ++it) {
                    const int e = tid + it * 512, key = e / 40, c4 = e % 40;
                    const size_t kt = (size_t)(b * SEQ + k0 + key);
                    if (c4 < 16) *(float4*)&Kt[key][c4 * 4] = *(const float4*)(KV + kt * 1024 + hh * 128 + c4 * 4);
                    else if (c4 < 24) *(float4*)&Kt[key][64 + (c4 - 16) * 4] = *(const float4*)(KR + kt * 32 + (c4 - 16) * 4);
                    else *(float4*)&Vt[key][(c4 - 24) * 4] = *(const float4*)(KV + kt * 1024 + hh * 128 + 64 + (c4 - 24) * 4);
                }
                __syncthreads();
#pragma unroll 1
                for (int kk = 0; kk < 64; kk += 8) {
                    float s[8]; float tm = -1e30f;
#pragma unroll
                    for (int j = 0; j < 8; ++j) {
                        float a = 0.f;
#pragma unroll
                        for (int d = 0; d < 24; d += 4) { const float4 kx = *(const float4*)&Kt[kk + j][qd * 24 + d]; a = fmaf(q[d], kx.x, a); a = fmaf(q[d + 1], kx.y, a); a = fmaf(q[d + 2], kx.z, a); a = fmaf(q[d + 3], kx.w, a); }
                        a += __shfl_xor(a, 1); a += __shfl_xor(a, 2);
                        s[j] = a; tm = fmaxf(tm, a);
                    }
                    const float mn = fmaxf(m, tm), corr = expf(m - mn); m = mn; lsum *= corr;
#pragma unroll
                    for (int d = 0; d < 16; ++d) o[d] *= corr;
#pragma unroll
                    for (int j = 0; j < 8; ++j) {
                        const float pj = expf(s[j] - mn); lsum += pj;
#pragma unroll
                        for (int d = 0; d < 16; d += 4) { const float4 vx = *(const float4*)&Vt[kk + j][qd * 16 + d]; o[d] = fmaf(pj, vx.x, o[d]); o[d + 1] = fmaf(pj, vx.y, o[d + 1]); o[d + 2] = fmaf(pj, vx.z, o[d + 2]); o[d + 3] = fmaf(pj, vx.w, o[d + 3]); }
                    }
                }
            }
            const float inv = 1.f / lsum;
#pragma unroll
            for (int d = 0; d < 16; d += 4) *(float4*)(AO + (size_t)trow * 512 + hh * 64 + qd * 16 + d) = make_float4(o[d] * inv, o[d + 1] * inv, o[d + 2] * inv, o[d + 3] * inv);
        }
        __syncthreads();
    }
    if constexpr (ST == ST_GLAREC) {
        {
            const int chain = (G - 1) - bid;
            if (chain < 32 && wid == 0) {
                const int b = chain >> 4, hh = (chain >> 2) & 3, dir = (chain >> 1) & 1, vh = chain & 1;
                const float* proj = WSF(WS_PROJ); const float* eg = WSF(WS_EG);
                float* O = dir ? WSF(WS_OB) : WSF(WS_OF);
                float st[64];
#pragma unroll
                for (int d = 0; d < 64; ++d) st[d] = 0.f;
                for (int step = 0; step < SEQ; ++step) {
                    const int s = dir ? (SEQ - 1 - step) : step; const size_t t = (size_t)b * SEQ + s;
                    const float* qp = proj + t * DIN + OFF_GQ + hh * 64; const float* kp = proj + t * DIN + OFF_GK + hh * 64; const float* ep = eg + t * 512 + dir * 256 + hh * 64;
                    const float vv = proj[t * DIN + OFF_GV + hh * 128 + vh * 64 + lane];
                    float oo = 0.f;
#pragma unroll
                    for (int d = 0; d < 64; d += 4) {
                        const float4 e4 = *(const float4*)(ep + d), k4 = *(const float4*)(kp + d), q4 = *(const float4*)(qp + d);
                        st[d] = fmaf(e4.x, st[d], k4.x * vv); oo = fmaf(q4.x * 0.125f, st[d], oo);
                        st[d + 1] = fmaf(e4.y, st[d + 1], k4.y * vv); oo = fmaf(q4.y * 0.125f, st[d + 1], oo);
                        st[d + 2] = fmaf(e4.z, st[d + 2], k4.z * vv); oo = fmaf(q4.z * 0.125f, st[d + 2], oo);
                        st[d + 3] = fmaf(e4.w, st[d + 3], k4.w * vv); oo = fmaf(q4.w * 0.125f, st[d + 3], oo);
                    }
                    O[t * 512 + hh * 128 + vh * 64 + lane] = oo;
                }
            }
        }
    }
    if constexpr (ST == ST_GLAFIN) {
        const float* of = WSF(WS_OF); const float* ob = WSF(WS_OB); const float* proj = WSF(WS_PROJ); float* go = WSF(WS_GLAO);
        for (int i = gw; i < T * 4; i += NGW) {
            const int t = i >> 2, hh = i & 3;
            const size_t base = (size_t)t * 512 + hh * 128;
            const float a0 = of[base + lane] + ob[base + lane], a1 = of[base + 64 + lane] + ob[base + 64 + lane];
            const float r = 1.f / sqrtf(wave_sum(a0 * a0 + a1 * a1) * (1.f / 128.f) + RMS_EPS);
            const float r0 = proj[(size_t)t * DIN + OFF_GR + hh * 128 + lane], r1 = proj[(size_t)t * DIN + OFF_GR + hh * 128 + 64 + lane];
            go[base + lane] = a0 * r * GLA_NORM(l)[lane] * siluf_(r0);
            go[base + 64 + lane] = a1 * r * GLA_NORM(l)[64 + lane] * siluf_(r1);
        }
    }
    if constexpr (ST == ST_MERGE_A || ST == ST_MERGE_B || ST == ST_MERGE_C) {
        constexpr int br = (ST == ST_MERGE_A) ? 0 : (ST == ST_MERGE_B) ? 1 : 2;
        GemmP g{}; g.A = br == 0 ? WSF(WS_MIXED) : br == 1 ? WSF(WS_ATTO) : WSF(WS_GLAO); g.lda = 512;
        g.Bm = br == 0 ? W_UP_A(l) : br == 1 ? W_UP_B(l) : W_UP_C(l); g.ldb = DM; g.C = WSF(WS_MERGED); g.ldc = DM; g.M = T; g.N = DM; g.K = 512; g.nb = 1;
        g.aux = WSF(WS_PROJ) + OFF_GATE + br * DM; g.ldaux = DIN; g.aux2 = B_GATE(l) + br * DM; g.accum = br > 0;
        gemm_naive<2>(g, lds);
    }
    if constexpr (ST == ST_OUTP) {
        GemmP g{}; g.A = WSF(WS_MERGED); g.lda = DM; g.Bm = W_OUT(l); g.ldb = DM; g.C = WSF(WS_TMP); g.ldc = DM; g.M = T; g.N = DM; g.K = DM; g.nb = 1;
        gemm_naive<0>(g, lds);
    }
    if constexpr (ST == ST_LN1) {
        float* aff = WSF(WS_AFF); const float* rw = ROUTER(l);
        for (int m = gw; m < T; m += NGW) {
            float* hr = h + (size_t)m * DM;
            float4 hv[4];
            ln_row(hr, WSF(WS_TMP) + (size_t)m * DM, ALPHA, LN1_G(l), LN1_B(l), hr, lane, hv);
            float acc[16];
#pragma unroll
            for (int e = 0; e < 16; ++e) acc[e] = 0.f;
#pragma unroll
            for (int j = 0; j < 4; ++j) {
                const float xs[4] = {hv[j].x, hv[j].y, hv[j].z, hv[j].w};
#pragma unroll
                for (int c = 0; c < 4; ++c) {
                    const int k = 4 * (lane + 64 * j) + c; const float x = xs[c];
                    const float4 w0 = *(const float4*)(rw + (size_t)k * 16), w1 = *(const float4*)(rw + (size_t)k * 16 + 4), w2 = *(const float4*)(rw + (size_t)k * 16 + 8), w3 = *(const float4*)(rw + (size_t)k * 16 + 12);
                    acc[0] = fmaf(x, w0.x, acc[0]); acc[1] = fmaf(x, w0.y, acc[1]); acc[2] = fmaf(x, w0.z, acc[2]); acc[3] = fmaf(x, w0.w, acc[3]);
                    acc[4] = fmaf(x, w1.x, acc[4]); acc[5] = fmaf(x, w1.y, acc[5]); acc[6] = fmaf(x, w1.z, acc[6]); acc[7] = fmaf(x, w1.w, acc[7]);
                    acc[8] = fmaf(x, w2.x, acc[8]); acc[9] = fmaf(x, w2.y, acc[9]); acc[10] = fmaf(x, w2.z, acc[10]); acc[11] = fmaf(x, w2.w, acc[11]);
                    acc[12] = fmaf(x, w3.x, acc[12]); acc[13] = fmaf(x, w3.y, acc[13]); acc[14] = fmaf(x, w3.z, acc[14]); acc[15] = fmaf(x, w3.w, acc[15]);
                }
            }
            float mx = -1e30f;
#pragma unroll
            for (int e = 0; e < 16; ++e) { acc[e] = wave_sum(acc[e]); mx = fmaxf(mx, acc[e]); }
            float se = 0.f;
#pragma unroll
            for (int e = 0; e < 16; ++e) { acc[e] = expf(acc[e] - mx); se += acc[e]; }
            if (lane < 16) {
                float v = 0.f;
#pragma unroll
                for (int e = 0; e < 16; ++e) v = (lane == e) ? acc[e] : v;
                aff[(size_t)m * 16 + lane] = v / se;
            }
        }
    }
    if constexpr (ST == ST_TOPK) {
        const float* aff = WSF(WS_AFF); int* idx = WSI(WS_IDX); float* gv = WSF(WS_GATEV); int* slot = WSI(WS_SLOT);
        for (int item = bid; item < NZ * 16; item += G) {
            const int z = item >> 4, sl = item & 15, e = z >> 1, b = z & 1;
            __syncthreads();
            for (int i = tid; i < SEQ; i += NTHR) lds[i] = aff[(size_t)(b * SEQ + i) * 16 + e];
            __syncthreads();
            const int s = sl * 512 + tid; const float mine = lds[s]; int rank = 0;
            for (int u = 0; u < SEQ; ++u) { const float o = lds[u]; rank += (o > mine || (o == mine && u < s)) ? 1 : 0; }
            const int trow = b * SEQ + s;
            if (rank < CAP) { idx[z * CAP + rank] = trow; gv[z * CAP + rank] = mine; slot[(size_t)trow * 16 + e] = rank; }
            else slot[(size_t)trow * 16 + e] = -1;
        }
        __syncthreads();
    }
    if constexpr (ST == ST_EXP_G || ST == ST_EXP_U) {
        GemmP g{}; g.A = h; g.lda = DM; g.ridx = WSI(WS_IDX); g.sR = CAP; g.Bm = (ST == ST_EXP_G) ? EW_GATE(l) : EW_UP(l); g.ldb = DEXP; g.sB = (long)DM * DEXP; g.bshift = 1;
        g.C = WSF(WS_HID); g.ldc = DEXP; g.sC = (long)CAP * DEXP; g.M = CAP; g.N = DEXP; g.K = DM; g.nb = NZ;
        if (ST == ST_EXP_G) gemm_naive<0>(g, lds); else gemm_naive<3>(g, lds);
    }
    if constexpr (ST == ST_EXP_D) {
        GemmP g{}; g.A = WSF(WS_HID); g.lda = DEXP; g.sA = (long)CAP * DEXP; g.Bm = EW_DOWN(l); g.ldb = DM; g.sB = (long)DEXP * DM; g.bshift = 1;
        g.C = WSF(WS_YE); g.ldc = DM; g.sC = (long)CAP * DM; g.M = CAP; g.N = DM; g.K = DEXP; g.nb = NZ; g.aux = WSF(WS_GATEV); g.sAux = CAP;
        gemm_naive<4>(g, lds);
    }
    if constexpr (ST == ST_LN2) {
        const int* slot = WSI(WS_SLOT); const float* ye = WSF(WS_YE); float* tmp = WSF(WS_TMP);
        for (int m = gw; m < T; m += NGW) {
            const int b = m / SEQ;
            float4 a[4];
#pragma unroll
            for (int j = 0; j < 4; ++j) a[j] = make_float4(0.f, 0.f, 0.f, 0.f);
            for (int e = 0; e < NE; ++e) {
                const int sl = slot[(size_t)m * 16 + e];
                if (sl >= 0) {
                    const float4* yr = (const float4*)(ye + ((size_t)(e * 2 + b) * CAP + sl) * DM);
#pragma unroll
                    for (int j = 0; j < 4; ++j) { const float4 y = yr[lane + 64 * j]; a[j].x += y.x; a[j].y += y.y; a[j].z += y.z; a[j].w += y.w; }
                }
            }
            float4* tr = (float4*)(tmp + (size_t)m * DM);
#pragma unroll
            for (int j = 0; j < 4; ++j) tr[lane + 64 * j] = a[j];
            float* hr = h + (size_t)m * DM;
            float4 hv2[4]; ln_row(hr, tmp + (size_t)m * DM, ALPHA, LN2_G(l), LN2_B(l), hr, lane, hv2);
        }
    }
}


#define LAS __attribute__((address_space(3)))
#define XB_TMO      128
#define XB_XCNT(j)  (256  + 64 * (j))
#define XB_XSUB(j)  (1280 + 64 * (j))
#define XB_XGEN(j)  (2304 + 64 * (j))
#define XB_TOP      3328
#define XB_TOPGEN   3392
#define XCD_BAR_WORDS 3456
#define XB_SPIN_CAP (1u << 18)
__device__ __forceinline__ unsigned xb_ld(unsigned* p)              { return __hip_atomic_load(p, __ATOMIC_RELAXED, __HIP_MEMORY_SCOPE_AGENT); }
__device__ __forceinline__ unsigned xb_add(unsigned* p, unsigned v) { return __hip_atomic_fetch_add(p, v, __ATOMIC_RELAXED, __HIP_MEMORY_SCOPE_AGENT); }
__device__ __forceinline__ unsigned xb_xcc_id() { return (unsigned)__builtin_amdgcn_s_getreg((3 << 11) | 20) & 0xFu; }
#define XB_SPIN(cond, bar) do { unsigned _sp = 0; while (cond) { __builtin_amdgcn_s_sleep(1); \
    if ((++_sp & 255u) == 0u) { if (xb_ld(&(bar)[XB_TMO])) break; if (_sp > XB_SPIN_CAP) { atomicAdd(&(bar)[XB_TMO], 1u); break; } } } } while (0)
struct XcdBarrier { unsigned* bar; unsigned x; volatile LAS unsigned* st; };
__device__ __forceinline__ XcdBarrier xcd_barrier_post(unsigned* bar, volatile LAS unsigned* st) {
    XcdBarrier b; b.bar = bar; b.x = xb_xcc_id(); b.st = st;
    if (threadIdx.x == 0) (void)xb_add(&bar[XB_XCNT(b.x)], 1u);
    return b;
}
__device__ __forceinline__ void xcd_barrier_complete(unsigned* bar, unsigned x, unsigned& nloc, unsigned& nx) {
    const unsigned G = gridDim.x * gridDim.y * gridDim.z;
    unsigned sum, cnt, mine, sp = 0u;
    for (;;) {
        sum = 0u; cnt = 0u; mine = 0u;
#pragma unroll
        for (unsigned j = 0; j < 16; ++j) { const unsigned c = xb_ld(&bar[XB_XCNT(j)]); sum += c; cnt += (c > 0u) ? 1u : 0u; mine = (j == x) ? c : mine; }
        if (sum == G) break;
        __builtin_amdgcn_s_sleep(1);
        if ((++sp & 255u) == 0u) { if (xb_ld(&bar[XB_TMO])) break; if (sp > XB_SPIN_CAP) { atomicAdd(&bar[XB_TMO], 1u); break; } }
    }
    nloc = mine > 0u ? mine : 1u; nx = cnt > 0u ? cnt : 1u;
}
__device__ __forceinline__ void xcd_barrier(const XcdBarrier& b) {
    asm volatile("s_waitcnt vmcnt(0)" ::: "memory");
    __syncthreads();
    if (threadIdx.x == 0) {
        unsigned* bar = b.bar;
        __builtin_amdgcn_s_waitcnt(0);
        unsigned nloc = b.st[0], nx = b.st[1];
        if (nloc == 0u) { xcd_barrier_complete(bar, b.x, nloc, nx); b.st[0] = nloc; b.st[1] = nx; }
        const unsigned old = xb_add(&bar[XB_XSUB(b.x)], 1u);
        const unsigned gen = old / nloc;
        if (old + 1u == (gen + 1u) * nloc) {
            __builtin_amdgcn_fence(__ATOMIC_RELEASE, "agent");
            asm volatile("s_waitcnt vmcnt(0)" ::: "memory");
            const unsigned og = xb_add(&bar[XB_TOP], 1u);
            const unsigned tg = og / nx;
            if (og + 1u == (tg + 1u) * nx) xb_add(&bar[XB_TOPGEN], 1u);
            else XB_SPIN(xb_ld(&bar[XB_TOPGEN]) == tg, bar);
            __builtin_amdgcn_fence(__ATOMIC_ACQUIRE, "agent");
            xb_add(&bar[XB_XGEN(b.x)], 1u);
            asm volatile("s_waitcnt vmcnt(0)" ::: "memory");
        } else {
            XB_SPIN(xb_ld(&bar[XB_XGEN(b.x)]) == gen, bar);
            __builtin_amdgcn_fence(__ATOMIC_ACQUIRE, "agent");
            asm volatile("s_waitcnt vmcnt(0)" ::: "memory");
        }
    }
    __syncthreads();
}
constexpr int MISC_OFF = 131072 + 320;
constexpr int CW_BAR = 4096;

__global__ void __launch_bounds__(NTHR) mega_fwd(Params p) {
    extern __shared__ __attribute__((aligned(16))) unsigned char lds_raw[];
    float* lds = (float*)lds_raw;
    volatile LAS unsigned* MISC = (volatile LAS unsigned*)((LAS unsigned char*)lds_raw + MISC_OFF);
    if (threadIdx.x < 32) MISC[threadIdx.x] = 0u;
    __syncthreads();
    XcdBarrier bar = xcd_barrier_post((unsigned*)(p.ws + WS_CTL) + CW_BAR, MISC + 8);
#define GB() xcd_barrier(bar)
    for (int step = 0; step < 1 + 2 * 14; ++step) {
        const int l = step == 0 ? 0 : (step - 1) / 14, s = step == 0 ? -1 : (step - 1) % 14;
        switch (s) {
        case -1: run_stage<ST_INIT>(p, 0, lds); break;
        case 0: run_stage<ST_PROJ>(p, l, lds); break;
        case 1: run_stage<ST_PREP>(p, l, lds); break;
        case 2: run_stage<ST_SMALLGEMM>(p, l, lds); break;
        case 3: run_stage<ST_ROPE>(p, l, lds); break;
        case 4: run_stage<ST_ATTN>(p, l, lds); break;
        case 5: run_stage<ST_GLAREC>(p, l, lds); break;
        case 6: run_stage<ST_GLAFIN>(p, l, lds); break;
        case 7: run_stage<ST_MERGE_A>(p, l, lds); run_stage<ST_MERGE_B>(p, l, lds); run_stage<ST_MERGE_C>(p, l, lds); break;
        case 8: run_stage<ST_OUTP>(p, l, lds); break;
        case 9: run_stage<ST_LN1>(p, l, lds); break;
        case 10: run_stage<ST_TOPK>(p, l, lds); break;
        case 11: run_stage<ST_EXP_G>(p, l, lds); run_stage<ST_EXP_U>(p, l, lds); break;
        case 12: run_stage<ST_EXP_D>(p, l, lds); break;
        default: run_stage<ST_LN2>(p, l, lds); break;
        }
        GB();
    }
#undef GB
}

template <int ST>
__global__ void __launch_bounds__(NTHR) k_stage(Params p, int l) {
    extern __shared__ __attribute__((aligned(16))) unsigned char lds_raw[];
    run_stage<ST>(p, l, (float*)lds_raw);
}

template <int ST> static void launch_stage(const Params& p, int l, int grid, hipStream_t stream) {
    static bool attr = false;
    if (!attr) { (void)hipFuncSetAttribute((const void*)k_stage<ST>, hipFuncAttributeMaxDynamicSharedMemorySize, LDS_BYTES); attr = true; }
    hipLaunchKernelGGL(k_stage<ST>, dim3(grid), dim3(NTHR), LDS_BYTES, stream, p, l);
}

extern "C" void kernel_launch(void* const* d_in, const int* in_sizes, int n_in, void* d_out, int out_size, void* d_ws, size_t ws_size, hipStream_t stream) {
    if (n_in != 27 || out_size != T * DM || ws_size < WS_END) {
        fprintf(stderr, "kernel_launch: unexpected shapes: n_in %d out %d ws %zu (need >= %zu)\n", n_in, out_size, ws_size, (size_t)WS_END);
        return;
    }
    Params p{};
    for (int i = 0; i < 27; ++i) p.in[i] = (const float*)d_in[i];
    p.pos = (const int*)d_in[1]; p.out = (float*)d_out; p.ws = (unsigned char*)d_ws;
    const int grid = 256;
#if MEGA
    static bool attr = false;
    if (!attr) { (void)hipFuncSetAttribute((const void*)mega_fwd, hipFuncAttributeMaxDynamicSharedMemorySize, LDS_BYTES); attr = true; }
    (void)hipMemsetAsync((char*)d_ws + WS_CTL, 0, 65536, stream);
    hipLaunchKernelGGL(mega_fwd, dim3(grid), dim3(NTHR), LDS_BYTES, stream, p);
#else
    launch_stage<ST_INIT>(p, 0, grid, stream);
    for (int l = 0; l < 2; ++l) {
        launch_stage<ST_PROJ>(p, l, grid, stream);
        launch_stage<ST_PREP>(p, l, grid, stream);
        launch_stage<ST_SMALLGEMM>(p, l, grid, stream);
        launch_stage<ST_ROPE>(p, l, grid, stream);
        launch_stage<ST_ATTN>(p, l, grid, stream);
        launch_stage<ST_GLAREC>(p, l, grid, stream);
        launch_stage<ST_GLAFIN>(p, l, grid, stream);
        launch_stage<ST_MERGE_A>(p, l, grid, stream);
        launch_stage<ST_MERGE_B>(p, l, grid, stream);
        launch_stage<ST_MERGE_C>(p, l, grid, stream);
        launch_stage<ST_OUTP>(p, l, grid, stream);
        launch_stage<ST_LN1>(p, l, grid, stream);
        launch_stage<ST_TOPK>(p, l, grid, stream);
        launch_stage<ST_EXP_G>(p, l, grid, stream);
        launch_stage<ST_EXP_U>(p, l, grid, stream);
        launch_stage<ST_EXP_D>(p, l, grid, stream);
        launch_stage<ST_LN2>(p, l, grid, stream);
    }
#endif
}
```

```cpp
#include <hip/hip_runtime.h>
#include <cstdio>
#include <cstdint>

#ifndef MEGA
#define MEGA 1
#endif

constexpr int NB = 2, SEQ = 8192, T = NB * SEQ, DM = 1024, DIN = 5824, DINP = 5888;
constexpr int OFF_GATE = 0, OFF_POOL = 3072, OFF_CQ = 3072 + 512, OFF_CKV = 3072 + 896, OFF_KR = 3072 + 1152, OFF_GQ = 3072 + 1184, OFF_GK = 3072 + 1440, OFF_GV = 3072 + 1696, OFF_GR = 3072 + 2208, OFF_GDEC = 3072 + 2720;
constexpr int NE = 16, CAP = 1024, DEXP = 2048, NZ = NB * NE;
constexpr float ALPHA = 1.4142135623730951f;
constexpr float LN_EPS = 1e-5f, RMS_EPS = 1e-6f;
constexpr int NTHR = 512, LDS_BYTES = 147456;

constexpr size_t MiB = 1u << 20;
constexpr size_t WS_CTL = 0;
constexpr size_t WS_ROPE = 1 * MiB;
constexpr size_t WS_AFF = 3 * MiB;
constexpr size_t WS_SLOT = 4 * MiB;
constexpr size_t WS_IDX = 5 * MiB;
constexpr size_t WS_GATEV = 5 * MiB + 256 * 1024;
constexpr size_t WS_WIN_T = 8 * MiB;
constexpr size_t WS_WSMALL = 31 * MiB;
constexpr size_t WSM_UQ = 0, WSM_UKV = 1 * MiB, WSM_MRG = 2 * MiB, WSM_OUT = 5 * MiB, WSM_STRIDE = 7 * MiB;
constexpr size_t WS_RQ = 6 * MiB;
constexpr size_t WS_HB = 958 * MiB;
constexpr size_t WS_WGU_T = 76 * MiB;
constexpr size_t WS_WD_T = 204 * MiB;
constexpr size_t WS_PROJB = 268 * MiB;
constexpr size_t WS_XE = 268 * MiB;
constexpr size_t WS_HID = 332 * MiB;
constexpr size_t WS_YE = 460 * MiB;
constexpr size_t WS_BR = 452 * MiB;
constexpr size_t WS_HB8 = 500 * MiB;
constexpr size_t WS_QB = 556 * MiB;
constexpr size_t WS_KB = 580 * MiB;
constexpr size_t WS_VB = 604 * MiB;
constexpr size_t WS_KVT = 702 * MiB;
constexpr size_t WS_ST = 766 * MiB;
constexpr size_t WS_DEC = 798 * MiB;
constexpr size_t WS_MERGEDB = 830 * MiB;
constexpr size_t WS_TMP = 894 * MiB;
constexpr size_t WS_END = 990 * MiB;
static_assert(WS_YE + 64 * MiB <= WS_QB, "overlay map");

namespace pg8 {
#define PG8_LAS __attribute__((address_space(3)))
typedef unsigned short bf16_t;
typedef short bf16x8 __attribute__((ext_vector_type(8)));
typedef float f32x4 __attribute__((ext_vector_type(4)));
typedef unsigned u32x4 __attribute__((ext_vector_type(4)));
constexpr int BM = 256, BK = 64, HALF = 128, HTB = HALF * BK * 2  , STAGE_BYTES = 8 * HTB, NXCD = 8, WGM = 8;

__host__ __device__ __forceinline__ int lds_byte(int r, int c) { const int st = (r >> 4) * 2 + (c >> 5), rr = r & 15, cc = c & 31, ob = rr * 64 + cc * 2; return st * 1024 + (ob ^ (((ob >> 9) & 1) << 5)); }
__host__ __device__ __forceinline__ void stage_rc(int b, int& R, int& C) { const int st = b / 1024, sb = b % 1024, swz = sb ^ (((sb >> 9) & 1) << 5); R = (st >> 1) * 16 + swz / 64; C = (st & 1) * 32 + (swz % 64) / 2; }
__host__ __device__ __forceinline__ int perm32(int rho) { const int n = rho >> 4, i = rho & 15; return 8 * (i >> 2) + 4 * n + (i & 3); }

struct Unit { int pm, pn; };
struct Gemm { const bf16_t* A; const bf16_t* Bt; int M, N, K, lda; const int* ridx; };

struct StaticOrder {
    int nM, nN, nwg, G, c;
    __host__ __device__ void init(int M, int N, int G_, int c_) { nM = M / BM; nN = N / BM; nwg = nM * nN; G = G_; c = c_; }
    __host__ __device__ bool next(int i, Unit& u) const {
        const long L = (long)i * G + c; if (L >= nwg) return false;
        int wgid = (int)L; { const int q = nwg / NXCD, r = nwg % NXCD, xcd = wgid % NXCD, off = wgid / NXCD; wgid = (xcd < r ? xcd * (q + 1) : r * (q + 1) + (xcd - r) * q) + off; }
        const int nig = WGM * nN, gid = wgid / nig, fm = gid * WGM, gsz = (nM - fm) < WGM ? (nM - fm) : WGM;
        u.pm = fm + ((wgid % nig) % gsz); u.pn = (wgid % nig) / gsz; return true;
    }
    __device__ __forceinline__ void a_ready(const Unit&) const {}
    __device__ __forceinline__ void done(const Unit&) const {}
};

__device__ __forceinline__ unsigned cvt_pk_bf16(float lo, float hi) { unsigned r; asm volatile("v_cvt_pk_bf16_f32 %0, %1, %2" : "=v"(r) : "v"(lo), "v"(hi)); return r; }
typedef float f32x2 __attribute__((ext_vector_type(2)));
__device__ __forceinline__ f32x2 gelu_pk(f32x2 v) {
    const f32x2 av = __builtin_elementwise_abs(v), d = av * 0.2316418882f + 1.0f;
    f32x2 t; t.x = __builtin_amdgcn_rcpf(d.x); t.y = __builtin_amdgcn_rcpf(d.y);
    f32x2 q = t * 0.5307027145f + (-0.7265760135f); q = q * t + 0.7107068705f; q = q * t + (-0.142248368f); q = q * t + 0.127414796f; q = q * t;
    const f32x2 s = (v * v) * (-0.72134752044f);
    f32x2 e; e.x = __builtin_amdgcn_exp2f(s.x); e.y = __builtin_amdgcn_exp2f(s.y);
    const f32x2 m = v * (q * e), r = v - m;
    f32x2 o; o.x = v.x < 0.f ? m.x : r.x; o.y = v.y < 0.f ? m.y : r.y; return o;
}

template <int ACT  > struct EpiBf16 {
    static constexpr bool PERM = true, AFTER_DRAIN = false; static constexpr int SEG = 0; static_assert(ACT == 0 || ACT == 1, "EpiBf16: ACT is 0 (none) or 1 (gelu_pk)");
    bf16_t* O; int ldc; const float* bias; int split_cols; size_t split_stride; float scale0;
    __device__ __forceinline__ void operator()(const f32x4 (&acc)[2][2][4][2], const Unit& u, int wr, int wc, int fr, int fq) const {
        const int row0 = u.pm * BM + wr * 64 + fr; int colt = u.pn * BM; bf16_t* base = O;
        float sc = 1.f; if (split_cols) { const int t = colt / split_cols; base += (size_t)t * split_stride; colt -= t * split_cols; if (t == 0) sc = scale0; }
        const int col0 = colt + wc * 32 + 8 * fq, bcol0 = u.pn * BM + wc * 32 + 8 * fq;
        f32x4 bv[2][2];
#pragma unroll
        for (int bj = 0; bj < 2; ++bj)
#pragma unroll
            for (int n = 0; n < 2; ++n) bv[bj][n] = bias ? *(const f32x4*)(bias + bcol0 + bj * HALF + 4 * n) : (f32x4){0.f, 0.f, 0.f, 0.f};
#pragma unroll
        for (int ai = 0; ai < 2; ++ai)
#pragma unroll
            for (int m = 0; m < 4; ++m) { bf16_t* rowp = base + (size_t)(row0 + ai * HALF + m * 16) * ldc + col0;
#pragma unroll
                for (int bj = 0; bj < 2; ++bj) { f32x4 v0 = acc[ai][bj][m][0] + bv[bj][0], v1 = acc[ai][bj][m][1] + bv[bj][1];
                    if (ACT == 1) { f32x2 a = gelu_pk((f32x2){v0[0], v0[1]}), b = gelu_pk((f32x2){v0[2], v0[3]}), c = gelu_pk((f32x2){v1[0], v1[1]}), d = gelu_pk((f32x2){v1[2], v1[3]});
                        v0 = (f32x4){a.x, a.y, b.x, b.y}; v1 = (f32x4){c.x, c.y, d.x, d.y}; }
                    v0 = v0 * sc; v1 = v1 * sc; u32x4 w; w.x = cvt_pk_bf16(v0[0], v0[1]); w.y = cvt_pk_bf16(v0[2], v0[3]); w.z = cvt_pk_bf16(v1[0], v1[1]); w.w = cvt_pk_bf16(v1[2], v1[3]);
                    *(u32x4*)(rowp + bj * HALF) = w; } }
    }
};

struct PanelStats {
    unsigned* xbuf;
    unsigned* cnt;
    unsigned* tmo;
    int ntn; float eps;
    unsigned code;
    __device__ __forceinline__ bool run(const f32x4 (&v)[2][2][4][2], const Unit& u, int wr, int wc, int fr, int fq, PG8_LAS unsigned char* lds, int wid, int lane) const {
        typedef float f32x2v __attribute__((ext_vector_type(2)));
        PG8_LAS f32x2v* P = (PG8_LAS f32x2v*)lds;
        PG8_LAS f32x2v* S = (PG8_LAS f32x2v*)(lds + 8192);
        PG8_LAS unsigned* flag = (PG8_LAS unsigned*)(lds + 8192 + 2048);
#pragma unroll
        for (int ai = 0; ai < 2; ++ai)
#pragma unroll
            for (int m = 0; m < 4; ++m) {
                float s = 0.f;
#pragma unroll
                for (int bj = 0; bj < 2; ++bj)
#pragma unroll
                    for (int n = 0; n < 2; ++n) { const f32x4 x = v[ai][bj][m][n]; s += (x[0] + x[1]) + (x[2] + x[3]); }
                s += __shfl_xor(s, 16); s += __shfl_xor(s, 32);
                const float mw = s * (1.0f / 64.0f); float q = 0.f;
#pragma unroll
                for (int bj = 0; bj < 2; ++bj)
#pragma unroll
                    for (int n = 0; n < 2; ++n) { const f32x4 d = v[ai][bj][m][n] - mw; q += (d[0] * d[0] + d[1] * d[1]) + (d[2] * d[2] + d[3] * d[3]); }
                q += __shfl_xor(q, 16); q += __shfl_xor(q, 32);
                if (fq == 0) P[(ai * HALF + wr * 64 + m * 16 + fr) * 4 + wc] = (f32x2v){mw, q};
            }
        asm volatile("s_waitcnt lgkmcnt(0)" ::: "memory"); __builtin_amdgcn_s_barrier(); asm volatile("" ::: "memory");
#if defined(BROKEN_EXCHANGE_NO_WAIT)
#warning BROKEN CONTROL BUILD: the row-statistics exchange does not wait; results are wrong by design
        if (blockIdx.x >= 64) { const long long t0_ = clock64(); while (clock64() - t0_ < 60000) __builtin_amdgcn_s_sleep(8); }
#endif
        const int row = wid * 32 + (lane & 31);
        if (lane < 32) {
            const f32x2v a = P[row * 4 + 0], b = P[row * 4 + 1], c = P[row * 4 + 2], d = P[row * 4 + 3];
            const float mt = (a.x + b.x + c.x + d.x) * 0.25f;
            const float da = a.x - mt, db = b.x - mt, dc = c.x - mt, dd = d.x - mt;
            const float m2 = (a.y + b.y) + (c.y + d.y) + 64.0f * ((da * da + db * db) + (dc * dc + dd * dd));
            unsigned long long* slot = (unsigned long long*)xbuf + ((size_t)(u.pm * BM + row) * 4 + u.pn);
            __hip_atomic_store(slot, ((unsigned long long)__float_as_uint(m2) << 32) | __float_as_uint(mt), __ATOMIC_RELAXED, __HIP_MEMORY_SCOPE_AGENT);
        }
        asm volatile("s_waitcnt vmcnt(0)" ::: "memory");
        if (lane == 0) __hip_atomic_fetch_add(cnt + 64 * u.pm, 1u, __ATOMIC_RELAXED, __HIP_MEMORY_SCOPE_AGENT);
        if (wid == 0) {
            bool dead = false; const unsigned long long t0 = __builtin_amdgcn_s_memrealtime(); const unsigned want = 8u * (unsigned)ntn;
            for (;;) {
#if defined(BROKEN_EXCHANGE_NO_WAIT)
                break;
#endif
                if ((unsigned)__builtin_amdgcn_readfirstlane(__hip_atomic_load(cnt + 64 * u.pm, __ATOMIC_RELAXED, __HIP_MEMORY_SCOPE_AGENT)) >= want) break;
                if (__builtin_amdgcn_s_memrealtime() - t0 > 2000000ull) {
                    if (lane == 0) { unsigned expect = 0u; __hip_atomic_compare_exchange_strong(tmo + 1, &expect, code | (unsigned)(u.pm & 0xff), __ATOMIC_RELAXED, __ATOMIC_RELAXED, __HIP_MEMORY_SCOPE_AGENT);
                                     __hip_atomic_store(tmo, 1u, __ATOMIC_RELAXED, __HIP_MEMORY_SCOPE_AGENT); }
                    dead = true; break; }
                __builtin_amdgcn_s_sleep(2);
            }
            __builtin_amdgcn_fence(__ATOMIC_ACQUIRE, "agent");
            if (lane == 0) flag[0] = dead ? 1u : 0u;
        }
        asm volatile("s_waitcnt vmcnt(0) lgkmcnt(0)" ::: "memory"); __builtin_amdgcn_s_barrier(); asm volatile("" ::: "memory");
        const bool bad = flag[0] != 0u;
        if (lane < 32) {
            const unsigned long long* slot = (const unsigned long long*)xbuf + (size_t)(u.pm * BM + row) * 4; float mt[4], m2[4]; float ms = 0.f;
#pragma unroll
            for (int t = 0; t < 4; ++t) { if (t < ntn) { const unsigned long long w = __hip_atomic_load(slot + t, __ATOMIC_RELAXED, __HIP_MEMORY_SCOPE_AGENT); mt[t] = __uint_as_float((unsigned)w); m2[t] = __uint_as_float((unsigned)(w >> 32)); } else { mt[t] = 0.f; m2[t] = 0.f; } ms += mt[t]; }
            const float mean = ms / (float)ntn; float q = 0.f;
#pragma unroll
            for (int t = 0; t < 4; ++t) if (t < ntn) { const float dm = mt[t] - mean; q += m2[t] + 256.0f * dm * dm; }
            S[row] = (f32x2v){mean, 1.0f / sqrtf(q / (256.0f * (float)ntn) + eps)};
        }
        asm volatile("s_waitcnt lgkmcnt(0)" ::: "memory"); __builtin_amdgcn_s_barrier(); asm volatile("" ::: "memory");
        return bad;
    }
};
struct EpiLnRes {
    static constexpr bool PERM = false, AFTER_DRAIN = true; static constexpr int SEG = 0;
    const float* base; float* out; int ldc; const float* bias; PanelStats st; unsigned poison;
    __device__ __forceinline__ void fused(f32x4 (&acc)[2][2][4][2], const Unit& u, int wr, int wc, int fr, int fq, PG8_LAS unsigned char* lds, int wid, int lane) const {
        typedef float f32x2v __attribute__((ext_vector_type(2)));
        const PG8_LAS f32x2v* S = (const PG8_LAS f32x2v*)(lds + 8192);
        const int col0 = u.pn * BM + wc * 32 + 4 * fq;
#pragma unroll
        for (int bj = 0; bj < 2; ++bj)
#pragma unroll
            for (int n = 0; n < 2; ++n) { const f32x4 bv = bias ? *(const f32x4*)(bias + col0 + bj * HALF + n * 16) : (f32x4){0.f, 0.f, 0.f, 0.f};
#pragma unroll
                for (int ai = 0; ai < 2; ++ai)
#pragma unroll
                    for (int m = 0; m < 4; ++m) acc[ai][bj][m][n] += bv; }
        f32x4 pre[4][2][2];
#pragma unroll
        for (int m = 0; m < 4; ++m) { const size_t off = (size_t)(u.pm * BM + wr * 64 + m * 16 + fr) * ldc + col0;
#pragma unroll
            for (int bj = 0; bj < 2; ++bj)
#pragma unroll
                for (int n = 0; n < 2; ++n) pre[m][bj][n] = *(const f32x4*)(base + off + bj * HALF + n * 16); }
        const bool bad = st.run(acc, u, wr, wc, fr, fq, lds, wid, lane) || poison != 0u;
        const float qnan = __builtin_nanf("");
#pragma unroll
        for (int ai = 0; ai < 2; ++ai)
#pragma unroll
            for (int m = 0; m < 4; ++m) { const int r = ai * HALF + wr * 64 + m * 16 + fr; const f32x2v sr = S[r]; const size_t off = (size_t)(u.pm * BM + r) * ldc + col0;
#pragma unroll
                for (int bj = 0; bj < 2; ++bj)
#pragma unroll
                    for (int n = 0; n < 2; ++n) { const f32x4 bs = ai == 0 ? pre[m][bj][n] : *(const f32x4*)(base + off + bj * HALF + n * 16); f32x4 o = bs + (acc[ai][bj][m][n] - sr.x) * sr.y;
                        if (bad) o = (f32x4){qnan, qnan, qnan, qnan}; *(f32x4*)(out + off + bj * HALF + n * 16) = o; }
                if (m & 1) asm volatile("" ::: "memory"); }
    }
};
struct EpiLnResLn {
    static constexpr bool PERM = false, AFTER_DRAIN = true; static constexpr int SEG = 0;
    const float* base; float* out; bf16_t* xn; int ldc; const float* bias; PanelStats st1, st2; unsigned poison;
    __device__ __forceinline__ void fused(f32x4 (&acc)[2][2][4][2], const Unit& u, int wr, int wc, int fr, int fq, PG8_LAS unsigned char* lds, int wid, int lane) const {
        typedef float f32x2v __attribute__((ext_vector_type(2))); typedef unsigned u32x2v __attribute__((ext_vector_type(2)));
        const PG8_LAS f32x2v* S = (const PG8_LAS f32x2v*)(lds + 8192);
        const int col0 = u.pn * BM + wc * 32 + 4 * fq;
#pragma unroll
        for (int bj = 0; bj < 2; ++bj)
#pragma unroll
            for (int n = 0; n < 2; ++n) { const f32x4 bv = bias ? *(const f32x4*)(bias + col0 + bj * HALF + n * 16) : (f32x4){0.f, 0.f, 0.f, 0.f};
#pragma unroll
                for (int ai = 0; ai < 2; ++ai)
#pragma unroll
                    for (int m = 0; m < 4; ++m) acc[ai][bj][m][n] += bv; }
        bool bad = st1.run(acc, u, wr, wc, fr, fq, lds, wid, lane) || poison != 0u;
        const float qnan = __builtin_nanf("");
#pragma unroll
        for (int ai = 0; ai < 2; ++ai)
#pragma unroll
            for (int m = 0; m < 4; ++m) { const int r = ai * HALF + wr * 64 + m * 16 + fr; const f32x2v sr = S[r]; const size_t off = (size_t)(u.pm * BM + r) * ldc + col0;
#pragma unroll
                for (int bj = 0; bj < 2; ++bj)
#pragma unroll
                    for (int n = 0; n < 2; ++n) { const f32x4 bs = *(const f32x4*)(base + off + bj * HALF + n * 16); acc[ai][bj][m][n] = bs + (acc[ai][bj][m][n] - sr.x) * sr.y; }
                asm volatile("" : "+v"(acc[ai][0][m][0]), "+v"(acc[ai][0][m][1]), "+v"(acc[ai][1][m][0]), "+v"(acc[ai][1][m][1]));
                if (m & 1) asm volatile("" ::: "memory"); }
        const bool bad1 = bad;
        bad = st2.run(acc, u, wr, wc, fr, fq, lds, wid, lane) || bad;
#pragma unroll
        for (int ai = 0; ai < 2; ++ai)
#pragma unroll
            for (int m = 0; m < 4; ++m) { const int r = ai * HALF + wr * 64 + m * 16 + fr; const f32x2v sr = S[r]; const size_t off = (size_t)(u.pm * BM + r) * ldc + col0;
#pragma unroll
                for (int bj = 0; bj < 2; ++bj)
#pragma unroll
                    for (int n = 0; n < 2; ++n) { const f32x4 x1 = acc[ai][bj][m][n]; *(f32x4*)(out + off + bj * HALF + n * 16) = bad1 ? (f32x4){qnan, qnan, qnan, qnan} : x1;
                        const f32x4 o = (x1 - sr.x) * sr.y; u32x2v w; w.x = cvt_pk_bf16(o[0], o[1]); w.y = cvt_pk_bf16(o[2], o[3]);
                        if (bad) { w.x = 0x7fc07fc0u; w.y = 0x7fc07fc0u; } *(u32x2v*)(xn + off + bj * HALF + n * 16) = w; }
                asm volatile("" ::: "memory"); }
    }
};

template <class Epi, class Sched, bool ALIGN_EPI = false, bool SP2 = false, bool GATHER = false, bool FP8 = false>
__device__ __forceinline__ void gemm_phase(PG8_LAS unsigned char* lds, const Gemm g, const Sched& S, const Epi& E) {
    int tid_ = threadIdx.x; asm volatile("" : "+v"(tid_));
    const int tid = tid_, wid = __builtin_amdgcn_readfirstlane(tid >> 6), lane = tid & 63, wr = wid >> 2, wc = wid & 3, fr = lane & 15, fq = lane >> 4;
    int K_ = g.K; asm volatile("" : "+s"(K_));
    const int K = K_, nt = K / BK;
    unsigned voffA[2], voffB[2];
#pragma unroll
    for (int i = 0; i < 2; ++i) { int R, C; stage_rc(tid * 16 + i * 8192, R, C); const int Rb = Epi::PERM ? ((R & ~31) + perm32(R & 31)) : R;
        voffA[i] = (unsigned)(R * g.lda + C) * 2u; voffB[i] = (unsigned)(Rb * K + C) * 2u; }
    const size_t kstep = (size_t)(BK * 2);
    static_assert(!GATHER || SP2, "GATHER is implemented for the SP2 loop");
    const size_t hstepB = (size_t)HALF * K * 2, hstepA = GATHER ? 0 : (size_t)HALF * g.lda * 2;
    const size_t tstepB = 2 * hstepB, tstepA = GATHER ? 0 : 2 * hstepA;
    const unsigned ldsw = (unsigned)wid * 1024u;
    const int aoffk[2] = {lds_byte(wr * 64 + fr, FP8 ? 16 * fq : 8 * fq), lds_byte(wr * 64 + fr, FP8 ? 16 * fq + 8 : 8 * fq + 32)};
    const int boffk[2] = {lds_byte(wc * 32 + fr, FP8 ? 16 * fq : 8 * fq), lds_byte(wc * 32 + fr, FP8 ? 16 * fq + 8 : 8 * fq + 32)};
#define PG8_SA(b, h) (((b) * 2 + (h)) * HTB)
#define PG8_SB(b, h) ((4 + (b) * 2 + (h)) * HTB)
#define PG8_STAGE(bufoff, gbase, voff) do { _Pragma("unroll") for (int _i = 0; _i < 2; ++_i) \
        __builtin_amdgcn_global_load_lds((const unsigned*)((const char*)(gbase) + (voff)[_i]), (PG8_LAS unsigned*)(lds + (bufoff) + ldsw + _i * 8192), 16, 0, 0); } while (0)
    typedef int i32x4_ __attribute__((ext_vector_type(4))); typedef int i32x8_ __attribute__((ext_vector_type(8)));
#define PG8_LD16(off) (*(const PG8_LAS i32x4_*)(lds + (off)))
#define PG8_LDA(dst, b, h) do { _Pragma("unroll") for (int m = 0; m < 4; ++m) { \
        if constexpr (FP8) dst##8[m] = *(const PG8_LAS i32x8_*)(lds + PG8_SA(b, h) + aoffk[0] + m * 2048);     \
        else { _Pragma("unroll") for (int k = 0; k < 2; ++k) dst[m][k] = *(const PG8_LAS bf16x8*)(lds + PG8_SA(b, h) + aoffk[k] + m * 2048); } } } while (0)
#define PG8_LDB(dst, b, h) do { _Pragma("unroll") for (int n = 0; n < 2; ++n) { \
        if constexpr (FP8) dst##8[n] = *(const PG8_LAS i32x8_*)(lds + PG8_SB(b, h) + boffk[0] + n * 2048); \
        else { _Pragma("unroll") for (int k = 0; k < 2; ++k) dst[n][k] = *(const PG8_LAS bf16x8*)(lds + PG8_SB(b, h) + boffk[k] + n * 2048); } } } while (0)
#define PG8_MMA(ai, bj, At, Bt) do { __builtin_amdgcn_s_setprio(1); _Pragma("unroll") for (int m = 0; m < 4; ++m) _Pragma("unroll") for (int n = 0; n < 2; ++n) { \
        if constexpr (FP8) asm volatile("s_nop 1\n\tv_mfma_scale_f32_16x16x128_f8f6f4 %0, %1, %2, %0, %3, %3 op_sel_hi:[0,0,0]" : "+v"(acc[ai][bj][m][n]) : "v"(Bt##8[n]), "v"(At##8[m]), "v"(sc1_));     \
        else { _Pragma("unroll") for (int k = 0; k < 2; ++k) acc[ai][bj][m][n] = __builtin_amdgcn_mfma_f32_16x16x32_bf16(Bt[n][k], At[m][k], acc[ai][bj][m][n], 0, 0, 0); } } \
        __builtin_amdgcn_s_setprio(0); } while (0)
#define PG8_WAIT_V(n) asm volatile("s_waitcnt vmcnt(" #n ")" ::: "memory")
#define PG8_WAIT_L(n) asm volatile("s_waitcnt lgkmcnt(" #n ")" ::: "memory")
#define PG8_BAR __builtin_amdgcn_s_barrier()
#define PG8_SCHED __builtin_amdgcn_sched_barrier(0)
    Unit cur, nxt; int ui = 0;
    if (!S.next(0, cur)) return;
    unsigned vC0[2] = {voffA[0], voffA[1]}, vC1[2] = {voffA[0], voffA[1]}, vN0[2] = {voffA[0], voffA[1]}, vN1[2] = {voffA[0], voffA[1]};
    int gR[2], gC[2];
#pragma unroll
    for (int i = 0; i < 2; ++i) { stage_rc(tid * 16 + i * 8192, gR[i], gC[i]); }
    if constexpr (GATHER) {
#pragma unroll
        for (int i = 0; i < 2; ++i) { vC0[i] = (unsigned)(g.ridx[cur.pm * 256 + gR[i]] * g.lda + gC[i]) * 2u; vC1[i] = (unsigned)(g.ridx[cur.pm * 256 + 128 + gR[i]] * g.lda + gC[i]) * 2u; }
    }
    f32x4 acc[2][2][4][2];
#pragma unroll
    for (int a = 0; a < 2; ++a)
#pragma unroll
        for (int b = 0; b < 2; ++b)
#pragma unroll
            for (int m = 0; m < 4; ++m)
#pragma unroll
                for (int n = 0; n < 2; ++n) acc[a][b][m][n] = (f32x4){0.f, 0.f, 0.f, 0.f};
    const int sc1_ = 0x7f7f7f7f;
    bf16x8 At[4][2], B0[2][2], B1[2][2]; i32x8_ At8[4], B08[2], B18[2];
    const char* cA = (const char*)g.A + (size_t)cur.pm * tstepA; const char* cB = (const char*)g.Bt + (size_t)cur.pn * tstepB;
    S.a_ready(cur);
    if constexpr (SP2) {
        PG8_STAGE(PG8_SB(0, 0), cB, voffB); PG8_STAGE(PG8_SB(0, 1), cB + hstepB, voffB); PG8_STAGE(PG8_SA(0, 0), cA, vC0); PG8_STAGE(PG8_SA(0, 1), cA + hstepA, vC1);
        if (wr == 1) PG8_BAR;
        PG8_WAIT_V(2); PG8_BAR;
        PG8_STAGE(PG8_SB(1, 0), cB + kstep, voffB); PG8_STAGE(PG8_SA(1, 0), cA + kstep, vC0); PG8_STAGE(PG8_SB(1, 1), cB + hstepB + kstep, voffB);
        PG8_WAIT_V(6); PG8_BAR;
    } else {
        PG8_STAGE(PG8_SB(0, 0), cB, voffB); PG8_STAGE(PG8_SA(0, 0), cA, voffA); PG8_STAGE(PG8_SB(0, 1), cB + hstepB, voffB); PG8_STAGE(PG8_SA(0, 1), cA + hstepA, voffA);
        if (wr == 1) PG8_BAR;
        PG8_WAIT_V(4); PG8_BAR;
        PG8_STAGE(PG8_SB(1, 0), cB + kstep, voffB); PG8_STAGE(PG8_SA(1, 0), cA + kstep, voffA); PG8_STAGE(PG8_SB(1, 1), cB + hstepB + kstep, voffB);
        PG8_WAIT_V(6); PG8_BAR;
    }
    for (;;) {
        const bool has_next = S.next(ui + 1, nxt);
        int gi0[2] = {0, 0}, gi1[2] = {0, 0};
        if constexpr (GATHER) { if (has_next) {
#pragma unroll
            for (int i = 0; i < 2; ++i) { gi0[i] = g.ridx[nxt.pm * 256 + gR[i]]; gi1[i] = g.ridx[nxt.pm * 256 + 128 + gR[i]]; } } }
        const char* nA = has_next ? (const char*)g.A + (size_t)nxt.pm * tstepA : cA; const char* nB = has_next ? (const char*)g.Bt + (size_t)nxt.pn * tstepB : cB;
        for (int t = 0; t < nt; t += 2) {
            const bool last = (t == nt - 2);
            const char* a1 = cA + (size_t)(t + 1) * kstep;
            const char* a2 = last ? nA : cA + (size_t)(t + 2) * kstep; const char* b2 = last ? nB : cB + (size_t)(t + 2) * kstep;
            const char* a3 = a2 + kstep; const char* b3 = b2 + kstep;
            if (last && has_next) S.a_ready(nxt);
            unsigned v20[2] = {vC0[0], vC0[1]}, v21[2] = {vC1[0], vC1[1]};
            if constexpr (GATHER) { if (last && has_next) {
#pragma unroll
                for (int i = 0; i < 2; ++i) { vN0[i] = (unsigned)(gi0[i] * g.lda + gC[i]) * 2u; vN1[i] = (unsigned)(gi1[i] * g.lda + gC[i]) * 2u; v20[i] = vN0[i]; v21[i] = vN1[i]; } } }
            if constexpr (SP2) {
            PG8_LDB(B0, 0, 0); PG8_LDB(B1, 0, 1); PG8_SCHED; PG8_LDA(At, 0, 0); PG8_STAGE(PG8_SA(1, 1), a1 + hstepA, vC1);
            PG8_WAIT_V(8); PG8_WAIT_L(0); PG8_BAR; PG8_MMA(0, 0, At, B0); PG8_MMA(0, 1, At, B1); PG8_BAR; PG8_SCHED;
            PG8_LDA(At, 0, 1); PG8_STAGE(PG8_SB(0, 0), b2, voffB); PG8_STAGE(PG8_SB(0, 1), b2 + hstepB, voffB); PG8_STAGE(PG8_SA(0, 0), a2, v20);
            PG8_WAIT_V(8); PG8_WAIT_L(0); PG8_BAR; PG8_MMA(1, 0, At, B0); PG8_MMA(1, 1, At, B1); PG8_BAR; PG8_SCHED;
            PG8_LDB(B0, 1, 0); PG8_LDB(B1, 1, 1); PG8_SCHED; PG8_LDA(At, 1, 0); PG8_STAGE(PG8_SA(0, 1), a2 + hstepA, v21);
            PG8_WAIT_V(8); PG8_WAIT_L(0); PG8_BAR; PG8_MMA(0, 0, At, B0); PG8_MMA(0, 1, At, B1); PG8_BAR; PG8_SCHED;
            PG8_LDA(At, 1, 1); PG8_STAGE(PG8_SB(1, 0), b3, voffB); PG8_STAGE(PG8_SB(1, 1), b3 + hstepB, voffB); PG8_STAGE(PG8_SA(1, 0), a3, v20);
            PG8_WAIT_V(8); PG8_WAIT_L(0); PG8_BAR; PG8_MMA(1, 0, At, B0); PG8_MMA(1, 1, At, B1); PG8_BAR; PG8_SCHED;
            if constexpr (Epi::SEG > 0) { if ((t + 2) % Epi::SEG == 0 && t + 2 < nt) E.segment(acc, cur, (t + 2) / Epi::SEG, wr, wc, fr, fq); }
            } else {
            PG8_LDB(B0, 0, 0); PG8_SCHED; PG8_LDA(At, 0, 0); PG8_STAGE(PG8_SA(1, 1), a1 + hstepA, voffA);
            PG8_WAIT_L(8); PG8_BAR; PG8_WAIT_L(0); PG8_MMA(0, 0, At, B0); PG8_BAR; PG8_SCHED;
            PG8_LDB(B1, 0, 1); PG8_STAGE(PG8_SB(0, 0), b2, voffB);
            PG8_BAR; PG8_WAIT_L(0); PG8_MMA(0, 1, At, B1); PG8_BAR;
            PG8_LDA(At, 0, 1); PG8_STAGE(PG8_SA(0, 0), a2, voffA);
            PG8_BAR; PG8_WAIT_L(0); PG8_MMA(1, 0, At, B0); PG8_BAR; PG8_SCHED;
            PG8_STAGE(PG8_SB(0, 1), b2 + hstepB, voffB);
            PG8_WAIT_V(6); PG8_BAR; PG8_MMA(1, 1, At, B1); PG8_BAR;
            PG8_LDB(B0, 1, 0); PG8_SCHED; PG8_LDA(At, 1, 0); PG8_STAGE(PG8_SA(0, 1), a2 + hstepA, voffA);
            PG8_WAIT_L(8); PG8_BAR; PG8_WAIT_L(0); PG8_MMA(0, 0, At, B0); PG8_BAR; PG8_SCHED;
            PG8_LDB(B1, 1, 1); PG8_STAGE(PG8_SB(1, 0), b3, voffB);
            PG8_BAR; PG8_WAIT_L(0); PG8_MMA(0, 1, At, B1); PG8_BAR;
            PG8_LDA(At, 1, 1); PG8_STAGE(PG8_SA(1, 0), a3, voffA);
            PG8_BAR; PG8_WAIT_L(0); PG8_MMA(1, 0, At, B0); PG8_BAR; PG8_SCHED;
            PG8_STAGE(PG8_SB(1, 1), b3 + hstepB, voffB);
            PG8_WAIT_V(6); PG8_BAR; PG8_MMA(1, 1, At, B1); PG8_BAR;
            }
        }
        if constexpr (FP8) asm volatile("s_nop 15\n\ts_nop 3" ::: "memory");
        if constexpr (ALIGN_EPI) { if (wr == 0) PG8_BAR; }
        if constexpr (!Epi::AFTER_DRAIN) { E(acc, cur, wr, wc, fr, fq); S.done(cur); }
        if (!has_next) break;
#pragma unroll
        for (int a = 0; a < 2; ++a)
#pragma unroll
            for (int b = 0; b < 2; ++b)
#pragma unroll
                for (int m = 0; m < 4; ++m)
#pragma unroll
                    for (int n = 0; n < 2; ++n) acc[a][b][m][n] = (f32x4){0.f, 0.f, 0.f, 0.f};
        cur = nxt; cA = nA; cB = nB; ++ui;
        if constexpr (GATHER) { vC0[0] = vN0[0]; vC0[1] = vN0[1]; vC1[0] = vN1[0]; vC1[1] = vN1[1]; }
        if constexpr (ALIGN_EPI) { if (wr == 1) PG8_BAR; }
    }
    PG8_WAIT_V(0);
    if constexpr (!ALIGN_EPI) { if (wr == 0) PG8_BAR; }
    PG8_BAR;
    if constexpr (Epi::AFTER_DRAIN) { E.fused(acc, cur, wr, wc, fr, fq, lds, wid, lane); S.done(cur); }
#undef PG8_SA
#undef PG8_SB
#undef PG8_STAGE
#undef PG8_LDA
#undef PG8_LD16
#undef PG8_LDB
#undef PG8_MMA
#undef PG8_WAIT_V
#undef PG8_WAIT_L
#undef PG8_BAR
#undef PG8_SCHED
}
}

typedef unsigned short bf16_t;
__device__ __forceinline__ unsigned pk4_fp8(float a, float b, float c, float d) { unsigned w = 0u; w = __builtin_amdgcn_cvt_pk_fp8_f32(a, b, w, false); w = __builtin_amdgcn_cvt_pk_fp8_f32(c, d, w, true); return w; }
constexpr float F8_WGU = 64.f, F8_WD = 128.f, F8_HID = 4.f;
typedef unsigned u32x4_t __attribute__((ext_vector_type(4)));
__device__ __forceinline__ void ldg8_dw(float (&o)[8], const void* base, const unsigned (&off)[8]) {
    asm volatile("global_load_dword %0, %9, %8\n\tglobal_load_dword %1, %10, %8\n\tglobal_load_dword %2, %11, %8\n\tglobal_load_dword %3, %12, %8\n\t"
                 "global_load_dword %4, %13, %8\n\tglobal_load_dword %5, %14, %8\n\tglobal_load_dword %6, %15, %8\n\tglobal_load_dword %7, %16, %8\n\ts_waitcnt vmcnt(0)"
                 : "=&v"(o[0]), "=&v"(o[1]), "=&v"(o[2]), "=&v"(o[3]), "=&v"(o[4]), "=&v"(o[5]), "=&v"(o[6]), "=&v"(o[7])
                 : "s"(base), "v"(off[0]), "v"(off[1]), "v"(off[2]), "v"(off[3]), "v"(off[4]), "v"(off[5]), "v"(off[6]), "v"(off[7]) : "memory");
}
template <int I1, int I2, int I3>
__device__ __forceinline__ void ldg8_x4(u32x4_t (&a)[4], u32x4_t (&b)[4], const void* base, unsigned offA, unsigned offB) {
    asm volatile("global_load_dwordx4 %0, %9, %8\n\tglobal_load_dwordx4 %1, %9, %8 offset:%11\n\tglobal_load_dwordx4 %2, %9, %8 offset:%12\n\tglobal_load_dwordx4 %3, %9, %8 offset:%13\n\t"
                 "global_load_dwordx4 %4, %10, %8\n\tglobal_load_dwordx4 %5, %10, %8 offset:%11\n\tglobal_load_dwordx4 %6, %10, %8 offset:%12\n\tglobal_load_dwordx4 %7, %10, %8 offset:%13\n\ts_waitcnt vmcnt(0)"
                 : "=&v"(a[0]), "=&v"(a[1]), "=&v"(a[2]), "=&v"(a[3]), "=&v"(b[0]), "=&v"(b[1]), "=&v"(b[2]), "=&v"(b[3])
                 : "s"(base), "v"(offA), "v"(offB), "i"(I1), "i"(I2), "i"(I3) : "memory");
}
__device__ __forceinline__ void ldg8_x4v(u32x4_t (&o)[8], const void* base, const unsigned (&off)[8]) {
    asm volatile("global_load_dwordx4 %0, %9, %8\n\tglobal_load_dwordx4 %1, %10, %8\n\tglobal_load_dwordx4 %2, %11, %8\n\tglobal_load_dwordx4 %3, %12, %8\n\t"
                 "global_load_dwordx4 %4, %13, %8\n\tglobal_load_dwordx4 %5, %14, %8\n\tglobal_load_dwordx4 %6, %15, %8\n\tglobal_load_dwordx4 %7, %16, %8\n\ts_waitcnt vmcnt(0)"
                 : "=&v"(o[0]), "=&v"(o[1]), "=&v"(o[2]), "=&v"(o[3]), "=&v"(o[4]), "=&v"(o[5]), "=&v"(o[6]), "=&v"(o[7])
                 : "s"(base), "v"(off[0]), "v"(off[1]), "v"(off[2]), "v"(off[3]), "v"(off[4]), "v"(off[5]), "v"(off[6]), "v"(off[7]) : "memory");
}
template <int I1, int I2, int I3>
__device__ __forceinline__ void ldg4_x4(u32x4_t (&a)[4], const void* base, unsigned off) {
    asm volatile("global_load_dwordx4 %0, %5, %4\n\tglobal_load_dwordx4 %1, %5, %4 offset:%6\n\tglobal_load_dwordx4 %2, %5, %4 offset:%7\n\tglobal_load_dwordx4 %3, %5, %4 offset:%8\n\ts_waitcnt vmcnt(0)"
                 : "=&v"(a[0]), "=&v"(a[1]), "=&v"(a[2]), "=&v"(a[3]) : "s"(base), "v"(off), "i"(I1), "i"(I2), "i"(I3) : "memory");
}
__device__ __forceinline__ void bf8_to_f32(const u32x4_t w, float* o) {
    o[0] = __uint_as_float(w.x << 16); o[1] = __uint_as_float(w.x & 0xffff0000u); o[2] = __uint_as_float(w.y << 16); o[3] = __uint_as_float(w.y & 0xffff0000u);
    o[4] = __uint_as_float(w.z << 16); o[5] = __uint_as_float(w.z & 0xffff0000u); o[6] = __uint_as_float(w.w << 16); o[7] = __uint_as_float(w.w & 0xffff0000u);
}
struct ExpertOrder1 {
    int G, v;
    __device__ void init(int G_, int c) { G = G_; v = (G_ % 8 == 0) ? (c % 8) * (G_ / 8) + c / 8 : c; }
    __device__ bool next(int i, pg8::Unit& u) const { const int L = i * G + v; if (L >= 2048) return false; const int e = L >> 7, r = L & 127; u.pm = e * 8 + (r & 7); u.pn = e * 16 + (r >> 3); return true; }
    __device__ __forceinline__ void a_ready(const pg8::Unit&) const {}
    __device__ __forceinline__ void done(const pg8::Unit&) const {}
};
struct ExpertOrder2 {
    int G, v;
    __device__ void init(int G_, int c) { G = G_; v = (G_ % 8 == 0) ? (c % 8) * (G_ / 8) + c / 8 : c; }
    __device__ bool next(int i, pg8::Unit& u) const { const int L = i * G + v; if (L >= 512) return false; const int e = L >> 5, r = L & 31; u.pm = e * 8 + (r & 7); u.pn = e * 4 + (r >> 3); return true; }
    __device__ __forceinline__ void a_ready(const pg8::Unit&) const {}
    __device__ __forceinline__ void done(const pg8::Unit&) const {}
};
__device__ __forceinline__ float silu_fast(float x) { return x * __builtin_amdgcn_rcpf(1.f + __builtin_amdgcn_exp2f(-1.4426950408889634f * x)); }
struct EpiSwiGLU {
    static constexpr bool PERM = true, AFTER_DRAIN = false; static constexpr int SEG = 0;
    bf16_t* O; int ldc;
    __device__ __forceinline__ void operator()(const pg8::f32x4 (&acc)[2][2][4][2], const pg8::Unit& u, int wr, int wc, int fr, int fq) const {
        int row0 = u.pm * 256 + wr * 64 + fr; asm volatile("" : "+v"(row0)); const int col0 = (u.pn & 15) * 128 + wc * 32 + 8 * fq;
#pragma unroll
        for (int ai = 0; ai < 2; ++ai)
#pragma unroll
            for (int m = 0; m < 4; ++m) {
                const pg8::f32x4 g0 = acc[ai][0][m][0], g1 = acc[ai][0][m][1], u0 = acc[ai][1][m][0], u1 = acc[ai][1][m][1];
                constexpr float IG = 1.f / F8_WGU, HS = F8_HID / F8_WGU;
                const unsigned w0 = pk4_fp8(silu_fast(g0[0] * IG) * u0[0] * HS, silu_fast(g0[1] * IG) * u0[1] * HS, silu_fast(g0[2] * IG) * u0[2] * HS, silu_fast(g0[3] * IG) * u0[3] * HS);
                const unsigned w1 = pk4_fp8(silu_fast(g1[0] * IG) * u1[0] * HS, silu_fast(g1[1] * IG) * u1[1] * HS, silu_fast(g1[2] * IG) * u1[2] * HS, silu_fast(g1[3] * IG) * u1[3] * HS);
                *(uint2*)((unsigned char*)O + (size_t)(row0 + ai * 128 + m * 16) * ldc + col0) = make_uint2(w0, w1);
            }
    }
};
struct EpiProj {
    static constexpr bool PERM = true, AFTER_DRAIN = false; static constexpr int SEG = 0;
    bf16_t* O; const float* bias;
    __device__ __forceinline__ void operator()(const pg8::f32x4 (&acc)[2][2][4][2], const pg8::Unit& u, int wr, int wc, int fr, int fq) const {
        int row0 = u.pm * 256 + wr * 64 + fr; asm volatile("" : "+v"(row0)); const int col0 = u.pn * 256 + wc * 32 + 8 * fq; const bool gate = u.pn < 12; constexpr float L2E = 1.4426950408889634f;
        float bias8[2][8];
        if (gate) { u32x4_t t0[4], t1[4]; const unsigned o0 = (unsigned)col0 * 4u; ldg8_x4<16, 512, 528>(t0, t1, bias, o0, o0);
#pragma unroll
            for (int q = 0; q < 4; ++q) { bias8[0][q] = __uint_as_float(t0[0][q]); bias8[0][4 + q] = __uint_as_float(t0[1][q]); bias8[1][q] = __uint_as_float(t0[2][q]); bias8[1][4 + q] = __uint_as_float(t0[3][q]); } }
#pragma unroll
        for (int bj = 0; bj < 2; ++bj) {
            float b[8];
#pragma unroll
            for (int q = 0; q < 8; ++q) b[q] = gate ? bias8[bj][q] : 0.f;
#pragma unroll
            for (int ai = 0; ai < 2; ++ai)
#pragma unroll
                for (int m = 0; m < 4; ++m) { float v[8];
#pragma unroll
                    for (int q = 0; q < 8; ++q) { const float x = acc[ai][bj][m][q >> 2][q & 3]; v[q] = gate ? __builtin_amdgcn_rcpf(1.f + __builtin_amdgcn_exp2f(-(x + b[q]) * L2E)) : x; }
                    pg8::u32x4 w; w.x = pg8::cvt_pk_bf16(v[0], v[1]); w.y = pg8::cvt_pk_bf16(v[2], v[3]); w.z = pg8::cvt_pk_bf16(v[4], v[5]); w.w = pg8::cvt_pk_bf16(v[6], v[7]);
                    *(pg8::u32x4*)(O + (size_t)(row0 + ai * 128 + m * 16) * DINP + col0 + bj * 128) = w; } }
    }
};
struct EpiQ {
    static constexpr bool PERM = false, AFTER_DRAIN = false; static constexpr int SEG = 0;
    bf16_t* Q; const float* rq; const float* rc; const float* rs;
    __device__ __forceinline__ void operator()(const pg8::f32x4 (&acc)[2][2][4][2], const pg8::Unit& u, int wr, int wc, int fr, int fq) const {
        int row0 = u.pm * 256 + wr * 64 + fr; asm volatile("" : "+v"(row0)); constexpr float SC = 0.10206207261596575f * 1.4426950408889634f;
        float sc8[8]; { unsigned off[8];
#pragma unroll
            for (int i = 0; i < 8; ++i) off[i] = (unsigned)(row0 + (i >> 2) * 128 + (i & 3) * 16) * 4u;
            ldg8_dw(sc8, rq, off); }
#pragma unroll
        for (int bj = 0; bj < 2; ++bj) { const int g32 = u.pn * 8 + bj * 4 + wc, col0 = g32 * 32 + 4 * fq; const bool rope = (g32 % 3) == 2;
#pragma unroll
            for (int ai = 0; ai < 2; ++ai) {
                u32x4_t cs4[4], sn4[4];
                if (rope) { u32x4_t t0[4], t1[4];
                    const unsigned o0 = (unsigned)((row0 + ai * 128) * 16 + 4 * fq) * 4u;
                    ldg8_x4<16 * 16 * 4, 32 * 16 * 4, 48 * 16 * 4>(t0, t1, rc, o0, o0 + (unsigned)(T * 16 * 4));
#pragma unroll
                    for (int m = 0; m < 4; ++m) { cs4[m] = t0[m]; sn4[m] = t1[m]; } }
#pragma unroll
                for (int m = 0; m < 4; ++m) { const int row = row0 + ai * 128 + m * 16; const float s = sc8[ai * 4 + m] * SC;
                    pg8::f32x4 v0 = acc[ai][bj][m][0] * s, v1 = acc[ai][bj][m][1] * s;
                    if (rope) { const pg8::f32x4 c4 = __builtin_bit_cast(pg8::f32x4, cs4[m]), s4 = __builtin_bit_cast(pg8::f32x4, sn4[m]);
                        const pg8::f32x4 x1 = v0, x2 = v1; v0 = x1 * c4 - x2 * s4; v1 = x1 * s4 + x2 * c4; }
                    bf16_t* qp = Q + (size_t)row * 768 + col0;
                    *(uint2*)qp = make_uint2(pg8::cvt_pk_bf16(v0[0], v0[1]), pg8::cvt_pk_bf16(v0[2], v0[3]));
                    *(uint2*)(qp + 16) = make_uint2(pg8::cvt_pk_bf16(v1[0], v1[1]), pg8::cvt_pk_bf16(v1[2], v1[3])); } } }
    }
};
struct EpiKV {
    static constexpr bool PERM = true, AFTER_DRAIN = false; static constexpr int SEG = 0;
    bf16_t* K; bf16_t* V; const float* rkv;
    __device__ __forceinline__ void operator()(const pg8::f32x4 (&acc)[2][2][4][2], const pg8::Unit& u, int wr, int wc, int fr, int fq) const {
        int row0 = u.pm * 256 + wr * 64 + fr; asm volatile("" : "+v"(row0));
        float sc8[8]; { unsigned off[8];
#pragma unroll
            for (int i = 0; i < 8; ++i) off[i] = (unsigned)(row0 + (i >> 2) * 128 + (i & 3) * 16) * 4u;
            ldg8_dw(sc8, rkv, off); }
#pragma unroll
        for (int bj = 0; bj < 2; ++bj) { const int head = u.pn * 2 + bj;
#pragma unroll
            for (int ai = 0; ai < 2; ++ai)
#pragma unroll
                for (int m = 0; m < 4; ++m) { const int row = row0 + ai * 128 + m * 16; const float s = sc8[ai * 4 + m];
                    const pg8::f32x4 v0 = acc[ai][bj][m][0] * s, v1 = acc[ai][bj][m][1] * s; pg8::u32x4 w;
                    w.x = pg8::cvt_pk_bf16(v0[0], v0[1]); w.y = pg8::cvt_pk_bf16(v0[2], v0[3]); w.z = pg8::cvt_pk_bf16(v1[0], v1[1]); w.w = pg8::cvt_pk_bf16(v1[2], v1[3]);
                    bf16_t* dst = (wc < 2) ? K + (size_t)row * 768 + head * 96 + wc * 32 + 8 * fq : V + (size_t)row * 512 + head * 64 + (wc - 2) * 32 + 8 * fq;
                    *(pg8::u32x4*)dst = w; } }
    }
};
struct EpiF32 {
    static constexpr bool PERM = true, AFTER_DRAIN = false; static constexpr int SEG = 0;
    float* O; int ldc; const float* rs;
    __device__ __forceinline__ void operator()(const pg8::f32x4 (&acc)[2][2][4][2], const pg8::Unit& u, int wr, int wc, int fr, int fq) const {
        int row0 = u.pm * 256 + wr * 64 + fr; asm volatile("" : "+v"(row0)); const int col0 = u.pn * 256 + wc * 32 + 8 * fq;
#pragma unroll
        for (int ai = 0; ai < 2; ++ai)
#pragma unroll
            for (int m = 0; m < 4; ++m) { const int row = row0 + ai * 128 + m * 16; const float s = rs ? rs[row] : 1.f;
#pragma unroll
                for (int bj = 0; bj < 2; ++bj) { float* op = O + (size_t)row * ldc + col0 + bj * 128;
                    *(pg8::f32x4*)op = acc[ai][bj][m][0] * s; *(pg8::f32x4*)(op + 4) = acc[ai][bj][m][1] * s; } }
    }
};
struct EpiMerge {
    static constexpr bool PERM = true, AFTER_DRAIN = false; static constexpr int SEG = 8;
    bf16_t* O; const bf16_t* GL;
    static __device__ __forceinline__ void ld8(const bf16_t* p, float* o) { const uint4 w = *(const uint4*)p;
        o[0] = __uint_as_float(w.x << 16); o[1] = __uint_as_float(w.x & 0xffff0000u); o[2] = __uint_as_float(w.y << 16); o[3] = __uint_as_float(w.y & 0xffff0000u);
        o[4] = __uint_as_float(w.z << 16); o[5] = __uint_as_float(w.z & 0xffff0000u); o[6] = __uint_as_float(w.w << 16); o[7] = __uint_as_float(w.w & 0xffff0000u); }
    __device__ __forceinline__ void segment(pg8::f32x4 (&acc)[2][2][4][2], const pg8::Unit& u, int seg, int wr, int wc, int fr, int fq) const {
        int row0 = u.pm * 256 + wr * 64 + fr; asm volatile("" : "+v"(row0));
        const unsigned cb = (unsigned)((seg - 1) * 1024 + u.pn * 256 + wc * 32 + 8 * fq) * 2u;
#pragma unroll
        for (int ai = 0; ai < 2; ++ai)
#pragma unroll
            for (int m = 0; m < 4; ++m) {
                u32x4_t ga[4];
                ldg4_x4<2048, 256, 2304>(ga, GL, (unsigned)(row0 + ai * 128 + m * 16) * (unsigned)(DINP * 2) + cb);
#pragma unroll
                for (int bj = 0; bj < 2; ++bj) { float x0[8], x1[8]; bf8_to_f32(ga[bj * 2], x0); bf8_to_f32(ga[bj * 2 + 1], x1);
#pragma unroll
                    for (int q = 0; q < 8; ++q) acc[ai][bj][m][q >> 2][q & 3] *= x0[q] * __builtin_amdgcn_rcpf(x1[q]); } }
    }
    __device__ __forceinline__ void operator()(const pg8::f32x4 (&acc)[2][2][4][2], const pg8::Unit& u, int wr, int wc, int fr, int fq) const {
        int row0 = u.pm * 256 + wr * 64 + fr; asm volatile("" : "+v"(row0)); const int col0 = u.pn * 256 + wc * 32 + 8 * fq;
        const unsigned cb = (unsigned)(2048 + col0) * 2u;
#pragma unroll
        for (int ai = 0; ai < 2; ++ai) {
            u32x4_t g8[8];
            { unsigned off[8];
#pragma unroll
              for (int i = 0; i < 8; ++i) off[i] = (unsigned)(row0 + ai * 128 + (i & 3) * 16) * (unsigned)(DINP * 2) + cb + (i >> 2) * 256u;
              ldg8_x4v(g8, GL, off); }
#pragma unroll
            for (int m = 0; m < 4; ++m) { const int row = row0 + ai * 128 + m * 16;
#pragma unroll
                for (int bj = 0; bj < 2; ++bj) { float x2[8], v[8]; bf8_to_f32(g8[bj * 4 + m], x2);
#pragma unroll
                    for (int q = 0; q < 8; ++q) v[q] = acc[ai][bj][m][q >> 2][q & 3] * x2[q];
                    pg8::u32x4 w; w.x = pg8::cvt_pk_bf16(v[0], v[1]); w.y = pg8::cvt_pk_bf16(v[2], v[3]); w.z = pg8::cvt_pk_bf16(v[4], v[5]); w.w = pg8::cvt_pk_bf16(v[6], v[7]);
                    *(pg8::u32x4*)(O + (size_t)row * DM + col0 + bj * 128) = w; } } }
    }
};
struct EpiRowScale {
    static constexpr bool PERM = true, AFTER_DRAIN = false; static constexpr int SEG = 0;
    bf16_t* O; int ldc; const float* rs;
    __device__ __forceinline__ void operator()(const pg8::f32x4 (&acc)[2][2][4][2], const pg8::Unit& u, int wr, int wc, int fr, int fq) const {
        int row0 = u.pm * 256 + wr * 64 + fr; asm volatile("" : "+v"(row0)); const int col0 = (u.pn & 3) * 256 + wc * 32 + 8 * fq;
        float sc8[8]; { unsigned off[8];
#pragma unroll
            for (int i = 0; i < 8; ++i) off[i] = (unsigned)(row0 + (i >> 2) * 128 + (i & 3) * 16) * 4u;
            ldg8_dw(sc8, rs, off); }
#pragma unroll
        for (int ai = 0; ai < 2; ++ai)
#pragma unroll
            for (int m = 0; m < 4; ++m) { const int row = row0 + ai * 128 + m * 16; const float s = sc8[ai * 4 + m] * (1.f / (F8_WD * F8_HID));
#pragma unroll
                for (int bj = 0; bj < 2; ++bj) { const pg8::f32x4 v0 = acc[ai][bj][m][0] * s, v1 = acc[ai][bj][m][1] * s; pg8::u32x4 w;
                    w.x = pg8::cvt_pk_bf16(v0[0], v0[1]); w.y = pg8::cvt_pk_bf16(v0[2], v0[3]); w.z = pg8::cvt_pk_bf16(v1[0], v1[1]); w.w = pg8::cvt_pk_bf16(v1[2], v1[3]);
                    *(pg8::u32x4*)(O + (size_t)row * ldc + col0 + bj * 128) = w; } }
    }
};
struct Params {
    const float* in[27];
    const int* pos;
    float* out;
    unsigned char* ws;
};

__device__ __forceinline__ float wave_sum(float v) {
#pragma unroll
    for (int o = 1; o < 64; o <<= 1) v += __shfl_xor(v, o);
    return v;
}
__device__ __forceinline__ float sigmoidf_(float x) { return 1.f / (1.f + expf(-x)); }
__device__ __forceinline__ float siluf_(float x) { return x / (1.f + expf(-x)); }
__device__ __forceinline__ float log_sigmoidf_(float x) { return fminf(x, 0.f) - log1pf(expf(-fabsf(x))); }

__device__ __forceinline__ float bf2f(bf16_t u) { return __uint_as_float((unsigned)u << 16); }
__device__ __forceinline__ unsigned f2bf(float f) { unsigned u = __float_as_uint(f); return (u + 0x7fffu + ((u >> 16) & 1u)) >> 16; }
__device__ __forceinline__ unsigned pk2(float lo, float hi) { return f2bf(lo) | (f2bf(hi) << 16); }
__device__ __forceinline__ void ld4bf(const bf16_t* p, float* o) {
    const uint2 w = *(const uint2*)p; o[0] = __uint_as_float(w.x << 16); o[1] = __uint_as_float(w.x & 0xffff0000u); o[2] = __uint_as_float(w.y << 16); o[3] = __uint_as_float(w.y & 0xffff0000u);
}
__device__ __forceinline__ void transpose_block(const float* Wblk, int ldw, bf16_t* dst, int ldt, const float* ks, const float* ns, float* scr, int lane) {
#pragma unroll 8
    for (int i = 0; i < 32; ++i) { const int kk = 2 * i + (lane >> 5); float v = __builtin_nontemporal_load(&Wblk[(size_t)kk * ldw + (lane & 31)]);     if (ks) v *= ks[kk]; if (ns) v *= ns[lane & 31]; scr[kk * 33 + (lane & 31)] = v; }
    asm volatile("s_waitcnt lgkmcnt(0)" ::: "memory");
    const int c = lane & 7;
#pragma unroll
    for (int j = 0; j < 4; ++j) { const int n = (lane >> 3) + 8 * j; const float* s = scr + (8 * c) * 33 + n;
        uint4 o; o.x = pk2(s[0 * 33], s[1 * 33]); o.y = pk2(s[2 * 33], s[3 * 33]); o.z = pk2(s[4 * 33], s[5 * 33]); o.w = pk2(s[6 * 33], s[7 * 33]);
        *(uint4*)(dst + (size_t)n * ldt + 8 * c) = o; }
    asm volatile("s_waitcnt lgkmcnt(0)" ::: "memory");
}

namespace att {
using bf16x8 = __attribute__((ext_vector_type(8))) short;
using s16x4  = __attribute__((ext_vector_type(4))) short;
using f32x16 = __attribute__((ext_vector_type(16))) float;
using u32x4  = __attribute__((ext_vector_type(4))) unsigned;
constexpr int NW = 8, QBLK = 32, KVBLK = 64;
constexpr int LDQ = 768, LDK = 768, LDV = 512, LDO = 1536;
constexpr int KROWB = 208;
constexpr int SHM_K = KVBLK * KROWB, SHM_V = KVBLK * 64 * 2;
constexpr int NBUF = 3;
constexpr int SHM_ATTN = NBUF * SHM_V + NBUF * SHM_K + NW * 64 * 4;
constexpr float THR = 8.f;
#define ASBAR() __builtin_amdgcn_sched_barrier(0)
__device__ __forceinline__ int crow(int r, int hi) { return (r & 3) + 8 * (r >> 2) + 4 * hi; }
__device__ __forceinline__ unsigned cvtpk(float lo, float hi) { unsigned r; asm volatile("v_cvt_pk_bf16_f32 %0, %1, %2" : "=v"(r) : "v"(lo), "v"(hi)); return r; }
#define MX3(a, b, c) __builtin_fmaxf(__builtin_fmaxf((a), (b)), (c))
template <bool FIRST>
__device__ __forceinline__ void partialSM(f32x16& p0, f32x16& p1, float& m_ref, f32x16& negm, float& alpha) {
  constexpr float THRL = THR * 1.4426950408889634f;
  float a = MX3(p0[0], p0[1], p1[0]), b = MX3(p0[2], p0[3], p1[1]); a = MX3(a, p1[2], p1[3]);
#pragma unroll
  for (int r = 4; r < 16; r += 4) { a = MX3(a, p0[r], p0[r + 1]); b = MX3(b, p0[r + 2], p0[r + 3]); a = MX3(a, p1[r], p1[r + 1]); b = MX3(b, p1[r + 2], p1[r + 3]); }
  float pmax = fmaxf(a, b);
  { auto rr = __builtin_amdgcn_permlane32_swap(__float_as_uint(pmax), __float_as_uint(pmax), false, false);
    pmax = fmaxf(__uint_as_float(rr[0]), __uint_as_float(rr[1])); }
  alpha = 1.f;
  if (FIRST || !__builtin_expect(__all(pmax <= THRL), 1)) {
    const float dl = FIRST ? pmax : fmaxf(pmax, 0.f); m_ref += dl;
#pragma unroll
    for (int r = 0; r < 16; ++r) { p0[r] -= dl; p1[r] -= dl; }
#pragma unroll
    for (int r = 0; r < 16; ++r) negm[r] = -m_ref;
    asm volatile("" : "+v"(negm));
    if (!FIRST) alpha = __builtin_amdgcn_exp2f(-dl);
  }
#pragma unroll
  for (int r = 0; r < 16; ++r) p0[r] = __builtin_amdgcn_exp2f(p0[r]);
}
#undef MX3
__device__ __forceinline__ void finishSM(f32x16& p0, f32x16& p1, float alpha, float& l_reg, bf16x8& pa0, bf16x8& pa1, bf16x8& pa2, bf16x8& pa3) {
  for (int r = 0; r < 16; ++r) p1[r] = __builtin_amdgcn_exp2f(p1[r]);
  float ps = 0; for (int r = 0; r < 16; ++r) ps += p0[r]; for (int r = 0; r < 16; ++r) ps += p1[r];
  { auto rr = __builtin_amdgcn_permlane32_swap(__float_as_uint(ps), __float_as_uint(ps), false, false);
    ps = __uint_as_float(rr[0]) + __uint_as_float(rr[1]); }
  l_reg = l_reg * alpha + ps;
#define PK4(P, BASE, OUT) do { u32x4 w = {cvtpk(P[BASE + 0], P[BASE + 1]), cvtpk(P[BASE + 2], P[BASE + 3]), cvtpk(P[BASE + 4], P[BASE + 5]), cvtpk(P[BASE + 6], P[BASE + 7])}; \
    OUT = *reinterpret_cast<bf16x8*>(&w); } while (0)
  PK4(p0, 0, pa0); PK4(p0, 8, pa1); PK4(p1, 0, pa2); PK4(p1, 8, pa3);
#undef PK4
}
__device__ __forceinline__ void qkt(f32x16& p0, f32x16& p1, const char* Ks, const bf16x8* qr, const f32x16& negm, int r32, int hi) {
  p0 = negm; p1 = negm;
#pragma unroll
  for (int d0 = 0; d0 < 6; ++d0) { const int cb = d0 * 32 + hi * 16;
    bf16x8 b0 = *reinterpret_cast<const bf16x8*>(Ks + r32 * KROWB + cb);
    bf16x8 b1 = *reinterpret_cast<const bf16x8*>(Ks + (32 + r32) * KROWB + cb);
    p0 = __builtin_amdgcn_mfma_f32_32x32x16_bf16(b0, qr[d0], p0, 0, 0, 0);
    p1 = __builtin_amdgcn_mfma_f32_32x32x16_bf16(b1, qr[d0], p1, 0, 0, 0); }
}
__device__ __forceinline__ int v_st(int k, int c) { const int kk = k;   return ((kk >> 3) * 2 + (c >> 5)) * 512 + ((kk & 7) * 32 + (c & 31)) * 2; }
__device__ __forceinline__ int v_rd_base(int lane) { return ((lane & 3) << 3) | (((lane >> 2) & 3) << 6) | (((lane >> 4) & 1) << 5) | (((lane >> 5) & 1) << 8); }
constexpr int v_rd_off(int d0, int ks, int half) { return d0 * 512 + ks * 2048 + half * 1024; }
template <int OFF> __device__ __forceinline__ s16x4 tr_read(int vb) {
  s16x4 r; asm volatile("ds_read_b64_tr_b16 %0, %1 offset:%2" : "=&v"(r) : "v"(vb), "i"(OFF) : "memory"); return r;
}
template <int D0> __device__ __forceinline__ void pv_one(f32x16& od, int vb, bf16x8 pa0, bf16x8 pa1, bf16x8 pa2, bf16x8 pa3) {
  const s16x4 l0 = tr_read<v_rd_off(D0, 0, 0)>(vb), h0 = tr_read<v_rd_off(D0, 0, 1)>(vb), l1 = tr_read<v_rd_off(D0, 1, 0)>(vb), h1 = tr_read<v_rd_off(D0, 1, 1)>(vb);
  const s16x4 l2 = tr_read<v_rd_off(D0, 2, 0)>(vb), h2 = tr_read<v_rd_off(D0, 2, 1)>(vb), l3 = tr_read<v_rd_off(D0, 3, 0)>(vb), h3 = tr_read<v_rd_off(D0, 3, 1)>(vb);
  asm volatile("s_waitcnt lgkmcnt(0)" ::: "memory"); ASBAR();
#define PK(L, H) (bf16x8){L[0], L[1], L[2], L[3], H[0], H[1], H[2], H[3]}
  od = __builtin_amdgcn_mfma_f32_32x32x16_bf16(pa0, PK(l0, h0), od, 0, 0, 0);
  od = __builtin_amdgcn_mfma_f32_32x32x16_bf16(pa1, PK(l1, h1), od, 0, 0, 0);
  od = __builtin_amdgcn_mfma_f32_32x32x16_bf16(pa2, PK(l2, h2), od, 0, 0, 0);
  od = __builtin_amdgcn_mfma_f32_32x32x16_bf16(pa3, PK(l3, h3), od, 0, 0, 0);
#undef PK
}
__device__ __forceinline__ void pv_d0(f32x16* o, int vb, bf16x8 pa0, bf16x8 pa1, bf16x8 pa2, bf16x8 pa3) {
  pv_one<0>(o[0], vb, pa0, pa1, pa2, pa3); pv_one<1>(o[1], vb, pa0, pa1, pa2, pa3);
}
__device__ __forceinline__ void attn_unit(const bf16_t* Qb, const bf16_t* Kh, const bf16_t* Vh, bf16_t* Ob, int seq, char* lds) {
  int tid_ = threadIdx.x; asm volatile("" : "+v"(tid_));
  const int tid = tid_, wid = tid >> 6, lane = tid & 63, r32 = lane & 31, hi = lane >> 5;
  char* V_lds = lds; char* K_lds = lds + NBUF * SHM_V;
  float* ws = (float*)(lds + NBUF * SHM_V + NBUF * SHM_K) + wid * 64; float* li_l = ws; float* al_l = ws + 32;
  float m_ref = 0.f, l_reg = 0; f32x16 o[2] = {}; bf16x8 qr[6]; f32x16 negm = {}; asm volatile("" : "+v"(negm));
  const bf16_t* Qw = Qb + (long)(wid * QBLK + r32) * LDQ + hi * 8;
#pragma unroll
  for (int d0 = 0; d0 < 6; ++d0) qr[d0] = *reinterpret_cast<const bf16x8*>(Qw + d0 * 16);
  const bool kact = tid < 384; const int kr = tid / 12, kc = tid - kr * 12, vr = tid >> 3, vc = (tid & 7) * 8, vst0 = v_st(vr, vc);
  const int kst0 = kr * KROWB + kc * 16, kst1 = (kr + 32) * KROWB + kc * 16;
  const int vb0 = (int)(uintptr_t)V_lds + v_rd_base(lane);
  struct { bf16x8 vs, ks0, ks1; } sr_[2];
#define SLOAD(i, k0) do { sr_[i].vs = *reinterpret_cast<const bf16x8*>(&Vh[(long)((k0) + vr) * LDV + vc]); \
    if (kact) { sr_[i].ks0 = *reinterpret_cast<const bf16x8*>(&Kh[(long)((k0) + kr) * LDK + kc * 8]); sr_[i].ks1 = *reinterpret_cast<const bf16x8*>(&Kh[(long)((k0) + 32 + kr) * LDK + kc * 8]); } } while (0)
#define SWRITE(b, i) do { *(bf16x8*)(V_lds + (b) * SHM_V + vst0) = sr_[i].vs; \
    if (kact) { *(bf16x8*)(K_lds + (b) * SHM_K + kst0) = sr_[i].ks0; *(bf16x8*)(K_lds + (b) * SHM_K + kst1) = sr_[i].ks1; } } while (0)
#define SWAIT() asm volatile("s_waitcnt vmcnt(3)" ::: "memory")
#define RESC(a) do { if (__any((a) < 1.f)) { if (hi == 0) al_l[r32] = (a); asm volatile("s_waitcnt lgkmcnt(0)" ::: "memory"); \
    for (int d = 0; d < 2; ++d) for (int r = 0; r < 16; ++r) o[d][r] *= al_l[crow(r, hi)]; } } while (0)
  f32x16 pA0, pA1, pB0, pB1; float alA, alB; bf16x8 pa0, pa1, pa2, pa3; const int NT = seq / KVBLK;
  constexpr int SE = 0, SO = 1;
  int b_prev = 0, b_cur = 1, b_next = 2;
#define ROT() do { b_prev = b_cur; b_cur = b_next; b_next = (b_next == NBUF - 1) ? 0 : b_next + 1; } while (0)
  SLOAD(SE, 0); asm volatile("s_waitcnt vmcnt(0)" ::: "memory"); SWRITE(0, SE);
  SLOAD(SO, KVBLK); if (2 < NT) SLOAD(SE, 2 * KVBLK);
  __syncthreads();
  qkt(pA0, pA1, K_lds, qr, negm, r32, hi); partialSM<true>(pA0, pA1, m_ref, negm, alA);
  SWAIT(); SWRITE(1, SO); __syncthreads();
  for (int j = 1; j + 1 < NT; j += 2) {
    ASBAR(); qkt(pB0, pB1, K_lds + b_cur * SHM_K, qr, negm, r32, hi);
    finishSM(pA0, pA1, alA, l_reg, pa0, pa1, pa2, pa3); ASBAR();
    SLOAD(SO, (j + 2) * KVBLK); ASBAR();
    pv_d0(o, vb0 + b_prev * SHM_V, pa0, pa1, pa2, pa3); partialSM<false>(pB0, pB1, m_ref, negm, alB);
    SWAIT(); SWRITE(b_next, SE);
    RESC(alB); __syncthreads(); ROT();
    ASBAR(); qkt(pA0, pA1, K_lds + b_cur * SHM_K, qr, negm, r32, hi);
    finishSM(pB0, pB1, alB, l_reg, pa0, pa1, pa2, pa3); ASBAR();
    if (j + 3 < NT) SLOAD(SE, (j + 3) * KVBLK); ASBAR();
    pv_d0(o, vb0 + b_prev * SHM_V, pa0, pa1, pa2, pa3); partialSM<false>(pA0, pA1, m_ref, negm, alA);
    SWAIT(); SWRITE(b_next, SO);
    RESC(alA); __syncthreads(); ROT();
  }
  ASBAR(); qkt(pB0, pB1, K_lds + b_cur * SHM_K, qr, negm, r32, hi);
  finishSM(pA0, pA1, alA, l_reg, pa0, pa1, pa2, pa3); ASBAR();
  pv_d0(o, vb0 + b_prev * SHM_V, pa0, pa1, pa2, pa3); partialSM<false>(pB0, pB1, m_ref, negm, alB);
  RESC(alB);
  finishSM(pB0, pB1, alB, l_reg, pa0, pa1, pa2, pa3); ASBAR();
  pv_d0(o, vb0 + b_cur * SHM_V, pa0, pa1, pa2, pa3);
#undef ROT
  if (hi == 0) li_l[r32] = l_reg; asm volatile("s_waitcnt lgkmcnt(0)" ::: "memory");
  float rli[16];
#pragma unroll
  for (int r = 0; r < 16; ++r) rli[r] = __builtin_amdgcn_rcpf(li_l[crow(r, hi)]);
  bf16_t* Ow = Ob + (long)(wid * QBLK) * LDO;
#pragma unroll
  for (int r = 0; r < 16; ++r) { const int orow = crow(r, hi);
#pragma unroll
    for (int d0 = 0; d0 < 2; ++d0) Ow[(long)orow * LDO + d0 * 32 + r32] = (bf16_t)f2bf(o[d0][r] * rli[r]); }
  __syncthreads();
#undef SLOAD
#undef SWRITE
#undef SWAIT
#undef RESC
}
#undef ASBAR
}

namespace gla {
using bf16x8 = __attribute__((ext_vector_type(8))) short;
using s16x4  = __attribute__((ext_vector_type(4))) short;
using f32x16 = __attribute__((ext_vector_type(16))) float;
using u32x4  = __attribute__((ext_vector_type(4))) unsigned;
constexpr int L_DL = 0, L_TOT = 8192, L_RSUM = 10240, L_V = 12288, L_QF = 28672, L_KF = 37888, L_QB = 47104, L_KB = 56320, L_KSTF = 65536, L_KSTB = 74752, L_STF = 65536, L_STB = 83968, L_QR = 102400, L_KR = 110592, L_END = 118784;
constexpr int RB = 144;
__device__ __forceinline__ int crow(int r, int hi) { return (r & 3) + 8 * (r >> 2) + 4 * hi; }
__device__ __forceinline__ unsigned cvtpk(float lo, float hi) { unsigned r; asm volatile("v_cvt_pk_bf16_f32 %0, %1, %2" : "=v"(r) : "v"(lo), "v"(hi)); return r; }
__device__ __forceinline__ int v_st4(int k, int c) { const int kk = (k & ~0xC) | ((k & 4) << 1) | ((k & 8) >> 1); return ((kk >> 3) * 4 + (c >> 5)) * 512 + ((kk & 7) * 32 + (c & 31)) * 2; }
__device__ __forceinline__ int v_rd_base(int lane) { return ((lane & 3) << 3) | (((lane >> 2) & 3) << 6) | (((lane >> 4) & 1) << 5) | (((lane >> 5) & 1) << 8); }
template <int OFF> __device__ __forceinline__ s16x4 tr_read(int vb) { s16x4 r; asm volatile("ds_read_b64_tr_b16 %0, %1 offset:%2" : "=&v"(r) : "v"(vb), "i"(OFF) : "memory"); return r; }
__device__ __forceinline__ void v_frags(int vb, bf16x8 (&f)[4]) {
  const s16x4 l0 = tr_read<0>(vb), h0 = tr_read<2048>(vb), l1 = tr_read<4096>(vb), h1 = tr_read<4096 + 2048>(vb);
  const s16x4 l2 = tr_read<8192>(vb), h2 = tr_read<8192 + 2048>(vb), l3 = tr_read<12288>(vb), h3 = tr_read<12288 + 2048>(vb);
  asm volatile("s_waitcnt lgkmcnt(0)" ::: "memory"); __builtin_amdgcn_sched_barrier(0);
#define PK(L, H) (bf16x8){L[0], L[1], L[2], L[3], H[0], H[1], H[2], H[3]}
  f[0] = PK(l0, h0); f[1] = PK(l1, h1); f[2] = PK(l2, h2); f[3] = PK(l3, h3);
#undef PK
}
__device__ __forceinline__ bf16x8 frag(const char* base, int row, int ks, int hi) { return *reinterpret_cast<const bf16x8*>(base + row * RB + ks * 32 + hi * 16); }

template <bool IS_G1>
__device__ __forceinline__ void prep(char* lds, const bf16_t* projb, const float* wdec, const float* bdec, int t0, int hh, float* dec_out  , long dec_dir_stride) {
  int tid_ = threadIdx.x; asm volatile("" : "+v"(tid_)); const int tid = tid_;
  float* DL = (float*)(lds + L_DL); float* TOT = (float*)(lds + L_TOT);
  { const int i = tid >> 3, r4 = (tid & 7) * 4; float v[4]; ld4bf(projb + (size_t)(t0 + i) * DINP + OFF_GDEC + r4, v); *(float4*)(DL + i * 32 + r4) = make_float4(v[0], v[1], v[2], v[3]);
    const int c8 = (tid & 7) * 8;
    *(uint4*)(lds + L_KR + i * 128 + c8 * 2) = *(const uint4*)(projb + (size_t)(t0 + i) * DINP + OFF_GK + hh * 64 + c8);
    if constexpr (!IS_G1) *(uint4*)(lds + L_QR + i * 128 + c8 * 2) = *(const uint4*)(projb + (size_t)(t0 + i) * DINP + OFF_GQ + hh * 64 + c8); }
#pragma unroll
  for (int e2 = 0; e2 < 2; ++e2) { const int e = tid + e2 * 512, i = e >> 4, cc = (e & 15) * 8;
    *(uint4*)(lds + L_V + v_st4(i, cc)) = *(const uint4*)(projb + (size_t)(t0 + i) * DINP + OFF_GV + hh * 128 + cc); }
  __syncthreads();
  const int cidx = tid & 127, tg = tid >> 7, dir = cidx >> 6, d = cidx & 63;
  float W[16];
#pragma unroll
  for (int r = 0; r < 16; ++r) W[r] = wdec[(size_t)(dir * 16 + r) * 256 + hh * 64 + d];
  const float bias = bdec[dir * 256 + hh * 64 + d];
  constexpr float L2E = 1.4426950408889634f;
  float g[16], cs[16]; float run = 0.f;
#pragma unroll
  for (int ii = 0; ii < 16; ++ii) { const float* dl = DL + (16 * tg + ii) * 32 + dir * 16; float a = bias;
#pragma unroll
    for (int r = 0; r < 16; r += 4) { const float4 x = *(const float4*)(dl + r); a = fmaf(x.x, W[r], a); a = fmaf(x.y, W[r + 1], a); a = fmaf(x.z, W[r + 2], a); a = fmaf(x.w, W[r + 3], a); }
    g[ii] = (fminf(a, 0.f) * L2E - __builtin_amdgcn_logf(1.f + __builtin_amdgcn_exp2f(-fabsf(a) * L2E))) * (1.f / 16.f); run += g[ii]; cs[ii] = run; }
  TOT[tg * 128 + cidx] = run;
  __syncthreads();
  const float t0s = TOT[cidx], t1s = TOT[128 + cidx], t2s = TOT[256 + cidx], t3s = TOT[384 + cidx], tall = (t0s + t1s) + (t2s + t3s);
  const float off_lo = (tg > 0 ? t0s : 0.f) + (tg > 1 ? t1s : 0.f) + (tg > 2 ? t2s : 0.f);
  const float off_hi = (tg < 1 ? t1s : 0.f) + (tg < 2 ? t2s : 0.f) + (tg < 3 ? t3s : 0.f);
  const bf16_t* KR = (const bf16_t*)(lds + L_KR); const bf16_t* QR = (const bf16_t*)(lds + L_QR);
  if constexpr (IS_G1) {
    unsigned pk[8];
#pragma unroll
    for (int ii = 0; ii < 16; ii += 2) {
      float kv2[2];
#pragma unroll
      for (int u = 0; u < 2; ++u) { const int i = 16 * tg + ii + u; const float bi = dir == 0 ? off_lo + cs[ii + u] : off_hi + run - cs[ii + u] + g[ii + u];
        kv2[u] = bf2f(KR[i * 64 + d]) * __builtin_amdgcn_exp2f(tall - bi); }
      pk[ii >> 1] = cvtpk(kv2[0], kv2[1]); }
    char* dst = lds + (dir ? L_KSTB : L_KSTF) + d * RB + 32 * tg;
    *(uint4*)dst = make_uint4(pk[0], pk[1], pk[2], pk[3]); *(uint4*)(dst + 16) = make_uint4(pk[4], pk[5], pk[6], pk[7]);
    if (tg == 0) dec_out[dir * dec_dir_stride + d] = __builtin_amdgcn_exp2f(tall);
  } else {
    bf16_t* Qx = (bf16_t*)(lds + (dir ? L_QB : L_QF)); bf16_t* Kx = (bf16_t*)(lds + (dir ? L_KB : L_KF));
#pragma unroll
    for (int ii = 0; ii < 16; ++ii) { const int i = 16 * tg + ii; const float bi = dir == 0 ? off_lo + cs[ii] : off_hi + run - cs[ii] + g[ii];
      const float qv = bf2f(QR[i * 64 + d]) * 0.125f, kv = bf2f(KR[i * 64 + d]);
      Qx[i * (RB / 2) + d] = (bf16_t)f2bf(qv * __builtin_amdgcn_exp2f(bi)); Kx[i * (RB / 2) + d] = (bf16_t)f2bf(kv * __builtin_amdgcn_exp2f(-bi)); }
  }
  __syncthreads();
}

__device__ __forceinline__ void g1_item(char* lds, const bf16_t* projb, const float* wdec, const float* bdec, int b, int hh, int c, float* kvt, float* dec) {
  int tid_ = threadIdx.x; asm volatile("" : "+v"(tid_)); const int tid = tid_, wid = tid >> 6, lane = tid & 63, r32 = lane & 31, hi = lane >> 5;
  const int bh = b * 4 + hh; const long item = (long)bh * 128 + c, dstride = 8L * 128;
  prep<true>(lds, projb, wdec, bdec, b * SEQ + c * 64, hh, dec + item * 64, dstride * 64);
  const int vblk = wid >> 1, dblk = wid & 1;
  bf16x8 vf[4]; v_frags((int)(uintptr_t)(lds + L_V) + v_rd_base(lane) + vblk * 512, vf);
#pragma unroll
  for (int dir = 0; dir < 2; ++dir) { const char* kst = lds + (dir ? L_KSTB : L_KSTF); f32x16 acc = {};
#pragma unroll
    for (int ks = 0; ks < 4; ++ks) acc = __builtin_amdgcn_mfma_f32_32x32x16_bf16(vf[ks], frag(kst, dblk * 32 + r32, ks, hi), acc, 0, 0, 0);
    float* o = kvt + ((long)dir * dstride + item) * 8192 + (size_t)(vblk * 32) * 64 + dblk * 32 + r32;
#pragma unroll
    for (int r = 0; r < 16; ++r) o[crow(r, hi) * 64] = acc[r]; }
  __syncthreads();
}

__device__ __forceinline__ void g3_item(char* lds, const bf16_t* projb, const float* wdec, const float* bdec, const float* normg, int b, int hh, int c, const bf16_t* st, bf16_t* out, int ldo) {
  int tid_ = threadIdx.x; asm volatile("" : "+v"(tid_)); const int tid = tid_, wid = tid >> 6, lane = tid & 63, r32 = lane & 31, hi = lane >> 5;
  const int bh = b * 4 + hh, t0 = b * SEQ + c * 64; const long item = (long)bh * 128 + c, dstride = 8L * 128;
#pragma unroll
  for (int e4 = 0; e4 < 4; ++e4) { const int e = tid + e4 * 512, dir = e >> 10, v = (e >> 3) & 127, dc = (e & 7) * 8;
    *(uint4*)(lds + (dir ? L_STB : L_STF) + v * RB + dc * 2) = *(const uint4*)(st + ((long)dir * dstride + item) * 8192 + (size_t)v * 64 + dc); }
  prep<false>(lds, projb, wdec, bdec, t0, hh, nullptr, 0);
  const int ib = wid & 1, vblk = wid >> 1, iglob = ib * 32 + r32;
  bf16_t rgr[16];
#pragma unroll
  for (int r = 0; r < 16; ++r) rgr[r] = projb[(size_t)(t0 + ib * 32 + crow(r, hi)) * DINP + OFF_GR + hh * 128 + vblk * 32 + r32];
  f32x16 pF0 = {}, pF1 = {}, pB0 = {}, pB1 = {};
#pragma unroll
  for (int ks = 0; ks < 4; ++ks) {
    const bf16x8 qf = frag(lds + L_QF, iglob, ks, hi), qb = frag(lds + L_QB, iglob, ks, hi);
    pF0 = __builtin_amdgcn_mfma_f32_32x32x16_bf16(frag(lds + L_KF, r32, ks, hi), qf, pF0, 0, 0, 0);
    pF1 = __builtin_amdgcn_mfma_f32_32x32x16_bf16(frag(lds + L_KF, 32 + r32, ks, hi), qf, pF1, 0, 0, 0);
    pB0 = __builtin_amdgcn_mfma_f32_32x32x16_bf16(frag(lds + L_KB, r32, ks, hi), qb, pB0, 0, 0, 0);
    pB1 = __builtin_amdgcn_mfma_f32_32x32x16_bf16(frag(lds + L_KB, 32 + r32, ks, hi), qb, pB1, 0, 0, 0); }
#pragma unroll
  for (int r = 0; r < 16; ++r) { const int j0 = crow(r, hi), j1 = 32 + j0;
    pF0[r] = (j0 <= iglob ? pF0[r] : 0.f) + (j0 >= iglob ? pB0[r] : 0.f);
    pF1[r] = (j1 <= iglob ? pF1[r] : 0.f) + (j1 >= iglob ? pB1[r] : 0.f); }
  bf16x8 pa0, pa1, pa2, pa3;
#define PK4(P, BASE, OUT) do { unsigned a0 = cvtpk(P[BASE + 0], P[BASE + 1]), a1 = cvtpk(P[BASE + 2], P[BASE + 3]);   \
    unsigned b0 = cvtpk(P[BASE + 4], P[BASE + 5]), b1 = cvtpk(P[BASE + 6], P[BASE + 7]);                              \
    auto r0 = __builtin_amdgcn_permlane32_swap(a0, b0, false, false); auto r1 = __builtin_amdgcn_permlane32_swap(a1, b1, false, false); \
    u32x4 w = {r0[0], r1[0], r0[1], r1[1]}; OUT = *reinterpret_cast<bf16x8*>(&w); } while (0)
  PK4(pF0, 0, pa0); PK4(pF0, 8, pa1); PK4(pF1, 0, pa2); PK4(pF1, 8, pa3);
#undef PK4
  bf16x8 vf[4]; v_frags((int)(uintptr_t)(lds + L_V) + v_rd_base(lane) + vblk * 512, vf);
  f32x16 o = {};
  o = __builtin_amdgcn_mfma_f32_32x32x16_bf16(pa0, vf[0], o, 0, 0, 0); o = __builtin_amdgcn_mfma_f32_32x32x16_bf16(pa1, vf[1], o, 0, 0, 0);
  o = __builtin_amdgcn_mfma_f32_32x32x16_bf16(pa2, vf[2], o, 0, 0, 0); o = __builtin_amdgcn_mfma_f32_32x32x16_bf16(pa3, vf[3], o, 0, 0, 0);
#pragma unroll
  for (int ks = 0; ks < 4; ++ks) {
    o = __builtin_amdgcn_mfma_f32_32x32x16_bf16(frag(lds + L_QF, iglob, ks, hi), frag(lds + L_STF, vblk * 32 + r32, ks, hi), o, 0, 0, 0);
    o = __builtin_amdgcn_mfma_f32_32x32x16_bf16(frag(lds + L_QB, iglob, ks, hi), frag(lds + L_STB, vblk * 32 + r32, ks, hi), o, 0, 0, 0); }
  float* RS = (float*)(lds + L_RSUM);
  float ss[16];
#pragma unroll
  for (int r = 0; r < 16; ++r) { float s = o[r] * o[r]; s += __shfl_xor(s, 1); s += __shfl_xor(s, 2); s += __shfl_xor(s, 4); s += __shfl_xor(s, 8); s += __shfl_xor(s, 16); ss[r] = s; }
  if (r32 == 0) {
#pragma unroll
    for (int r = 0; r < 16; ++r) RS[(ib * 4 + vblk) * 32 + crow(r, hi)] = ss[r]; }
  __syncthreads();
  const int v = vblk * 32 + r32; const float ng = normg[v];
#pragma unroll
  for (int r = 0; r < 16; ++r) { const int il = crow(r, hi), i = ib * 32 + il;
    const float tot = (RS[(ib * 4 + 0) * 32 + il] + RS[(ib * 4 + 1) * 32 + il]) + (RS[(ib * 4 + 2) * 32 + il] + RS[(ib * 4 + 3) * 32 + il]);
    const float rstd = 1.f / sqrtf(tot * (1.f / 128.f) + RMS_EPS);
    const float rg = bf2f(rgr[r]);
    out[(size_t)(t0 + i) * ldo + hh * 128 + v] = (bf16_t)f2bf(o[r] * rstd * ng * (rg * __builtin_amdgcn_rcpf(1.f + __builtin_amdgcn_exp2f(-1.4426950408889634f * rg)))); }
  __syncthreads();
}
}

__device__ __forceinline__ void ln_core(float4 (&v)[4], const float* g, const float* b, float* out, bf16_t* outb, int lane) {
    float s = 0.f;
#pragma unroll
    for (int j = 0; j < 4; ++j) s += (v[j].x + v[j].y) + (v[j].z + v[j].w);
    const float mean = wave_sum(s) * (1.f / DM); float s2 = 0.f;
#pragma unroll
    for (int j = 0; j < 4; ++j) { v[j].x -= mean; v[j].y -= mean; v[j].z -= mean; v[j].w -= mean; s2 += (v[j].x * v[j].x + v[j].y * v[j].y) + (v[j].z * v[j].z + v[j].w * v[j].w); }
    const float rstd = 1.f / sqrtf(wave_sum(s2) * (1.f / DM) + LN_EPS);
#pragma unroll
    for (int j = 0; j < 4; ++j) {
        const float4 gg = ((const float4*)g)[lane + 64 * j], bb = ((const float4*)b)[lane + 64 * j];
        float4 o; o.x = v[j].x * rstd * gg.x + bb.x; o.y = v[j].y * rstd * gg.y + bb.y; o.z = v[j].z * rstd * gg.z + bb.z; o.w = v[j].w * rstd * gg.w + bb.w;
        ((float4*)out)[lane + 64 * j] = o; v[j] = o;
        if (outb) ((uint2*)outb)[lane + 64 * j] = make_uint2(pk2(o.x, o.y), pk2(o.z, o.w));
    }
}
__device__ __forceinline__ void wave_sum2(float& a, float& b) {
#pragma unroll
    for (int o = 1; o < 64; o <<= 1) { const float ta = __shfl_xor(a, o), tb = __shfl_xor(b, o); a += ta; b += tb; }
}
__device__ __forceinline__ void ln_core2(float4 (&v)[2][4], const float* g, const float* b, float* out0, float* out1, bf16_t* ob0, bf16_t* ob1, int lane, unsigned char* o8_0 = nullptr, unsigned char* o8_1 = nullptr) {
    float s[2] = {0.f, 0.f};
#pragma unroll
    for (int u = 0; u < 2; ++u)
#pragma unroll
        for (int j = 0; j < 4; ++j) s[u] += (v[u][j].x + v[u][j].y) + (v[u][j].z + v[u][j].w);
    wave_sum2(s[0], s[1]);
    float q[2] = {0.f, 0.f};
#pragma unroll
    for (int u = 0; u < 2; ++u) { const float mean = s[u] * (1.f / DM);
#pragma unroll
        for (int j = 0; j < 4; ++j) { v[u][j].x -= mean; v[u][j].y -= mean; v[u][j].z -= mean; v[u][j].w -= mean; q[u] += (v[u][j].x * v[u][j].x + v[u][j].y * v[u][j].y) + (v[u][j].z * v[u][j].z + v[u][j].w * v[u][j].w); } }
    wave_sum2(q[0], q[1]);
#pragma unroll
    for (int j = 0; j < 4; ++j) {
        const float4 gg = ((const float4*)g)[lane + 64 * j], bb = ((const float4*)b)[lane + 64 * j];
#pragma unroll
        for (int u = 0; u < 2; ++u) { const float rstd = 1.f / sqrtf(q[u] * (1.f / DM) + LN_EPS);
            float4 o; o.x = v[u][j].x * rstd * gg.x + bb.x; o.y = v[u][j].y * rstd * gg.y + bb.y; o.z = v[u][j].z * rstd * gg.z + bb.z; o.w = v[u][j].w * rstd * gg.w + bb.w;
            ((float4*)(u ? out1 : out0))[lane + 64 * j] = o; v[u][j] = o;
            ((uint2*)(u ? ob1 : ob0))[lane + 64 * j] = make_uint2(pk2(o.x, o.y), pk2(o.z, o.w));
            if (o8_0) ((unsigned*)(u ? o8_1 : o8_0))[lane + 64 * j] = pk4_fp8(o.x, o.y, o.z, o.w); }
    }
}
__device__ __forceinline__ int block_excl_scan(int x, int* scr, int tid, int& total) {
    const int lane = tid & 63, wid = tid >> 6; int inc = x;
#pragma unroll
    for (int o = 1; o < 64; o <<= 1) { const int y = __shfl_up(inc, o); if (lane >= o) inc += y; }
    __syncthreads();
    if (lane == 63) scr[wid] = inc;
    __syncthreads();
    int base = 0, tot = 0;
#pragma unroll
    for (int w = 0; w < 8; ++w) { const int c = scr[w]; base += (w < wid) ? c : 0; tot += c; }
    total = tot; return base + inc - x;
}

__device__ __forceinline__ void tb_load(float (&v)[32], const float* Wblk, int ldw, int lane) {
#pragma unroll
    for (int i = 0; i < 32; ++i) v[i] = __builtin_nontemporal_load(&Wblk[(size_t)(2 * i + (lane >> 5)) * ldw + (lane & 31)]);
}
__device__ __forceinline__ void tb_store(const float (&v)[32], bf16_t* dst, int ldt, float* scr, int lane) {
#pragma unroll
    for (int i = 0; i < 32; ++i) scr[(2 * i + (lane >> 5)) * 33 + (lane & 31)] = v[i];
    asm volatile("s_waitcnt lgkmcnt(0)" ::: "memory");
    const int c = lane & 7;
#pragma unroll
    for (int j = 0; j < 4; ++j) { const int n = (lane >> 3) + 8 * j; const float* s = scr + (8 * c) * 33 + n;
        uint4 o; o.x = pk2(s[0 * 33], s[1 * 33]); o.y = pk2(s[2 * 33], s[3 * 33]); o.z = pk2(s[4 * 33], s[5 * 33]); o.w = pk2(s[6 * 33], s[7 * 33]);
        *(uint4*)(dst + (size_t)n * ldt + 8 * c) = o; }
    asm volatile("s_waitcnt lgkmcnt(0)" ::: "memory");
}

__device__ __forceinline__ void tb_store8(const float (&v)[32], unsigned char* dst, int ldt, float sc, float* scr, int lane) {
#pragma unroll
    for (int i = 0; i < 32; ++i) scr[(2 * i + (lane >> 5)) * 33 + (lane & 31)] = v[i];
    asm volatile("s_waitcnt lgkmcnt(0)" ::: "memory");
    const int c = lane & 7;
#pragma unroll
    for (int j = 0; j < 4; ++j) { const int n = (lane >> 3) + 8 * j; const float* s = scr + (8 * c) * 33 + n;
        *(uint2*)(dst + (size_t)n * ldt + 8 * c) = make_uint2(pk4_fp8(s[0 * 33] * sc, s[1 * 33] * sc, s[2 * 33] * sc, s[3 * 33] * sc), pk4_fp8(s[4 * 33] * sc, s[5 * 33] * sc, s[6 * 33] * sc, s[7 * 33] * sc)); }
    asm volatile("s_waitcnt lgkmcnt(0)" ::: "memory");
}

__device__ __forceinline__ void ln_row(const float* a, const float* add, float alpha, const float* g, const float* b, float* out, int lane, float4 (&v)[4], bf16_t* outb = nullptr) {
    float s = 0.f;
#pragma unroll
    for (int j = 0; j < 4; ++j) {
        float4 x = ((const float4*)a)[lane + 64 * j];
        x.x *= alpha; x.y *= alpha; x.z *= alpha; x.w *= alpha;
        if (add) { const float4 y = ((const float4*)add)[lane + 64 * j]; x.x += y.x; x.y += y.y; x.z += y.z; x.w += y.w; }
        v[j] = x; s += (x.x + x.y) + (x.z + x.w);
    }
    const float mean = wave_sum(s) * (1.f / DM); float s2 = 0.f;
#pragma unroll
    for (int j = 0; j < 4; ++j) { v[j].x -= mean; v[j].y -= mean; v[j].z -= mean; v[j].w -= mean; s2 += (v[j].x * v[j].x + v[j].y * v[j].y) + (v[j].z * v[j].z + v[j].w * v[j].w); }
    const float rstd = 1.f / sqrtf(wave_sum(s2) * (1.f / DM) + LN_EPS);
#pragma unroll
    for (int j = 0; j < 4; ++j) {
        const float4 gg = ((const float4*)g)[lane + 64 * j], bb = ((const float4*)b)[lane + 64 * j];
        float4 o; o.x = v[j].x * rstd * gg.x + bb.x; o.y = v[j].y * rstd * gg.y + bb.y; o.z = v[j].z * rstd * gg.z + bb.z; o.w = v[j].w * rstd * gg.w + bb.w;
        ((float4*)out)[lane + 64 * j] = o; v[j] = o;
        if (outb) ((uint2*)outb)[lane + 64 * j] = make_uint2(pk2(o.x, o.y), pk2(o.z, o.w));
    }
}

struct GemmP {
    const float* A; const int* ridx; const float* Bm; float* C;
    int lda, ldb, ldc, M, N, K, nb, bshift;
    long sA, sB, sC; int sR;
    const float* aux; const bf16_t* auxb; int ldaux; long sAux; const float* aux2; int accum;
};
template <int MODE>
__device__ __forceinline__ void gemm_naive(const GemmP g, float* lds) {
    float (*As)[132] = (float (*)[132])lds;
    float (*Bs)[128] = (float (*)[128])(lds + 16 * 132);
    int tid_ = threadIdx.x; asm volatile("" : "+v"(tid_));
    const int tid = tid_, ty = tid >> 4, tx = tid & 15;
    const int mt = g.M / 128, nt = (g.N + 127) / 128, per = mt * nt, total = per * g.nb;
    int bid_ = blockIdx.x; asm volatile("" : "+s"(bid_));
    for (int tile = bid_; tile < total; tile += gridDim.x) {
        const int z = tile / per, r = tile % per, tm = r / nt, tn = r % nt;
        const int m0 = tm * 128, n0 = tn * 128;
        const float* Bz = g.Bm + (long)(z >> g.bshift) * g.sB;
        float* Cz = g.C + (long)z * g.sC;
        const int arow = m0 + (tid >> 2);
        const long grow = g.ridx ? (long)g.ridx[z * g.sR + arow] : (long)arow;
        const float* Arow = g.A + (long)z * g.sA + grow * g.lda + (tid & 3) * 4;
        const int bk = tid >> 5, bn = n0 + (tid & 31) * 4;
        const bool bok = bn < g.N;
        const float* Bp = Bz + (long)bk * g.ldb + bn;
        float acc[4][8];
#pragma unroll
        for (int i = 0; i < 4; ++i)
#pragma unroll
            for (int j = 0; j < 8; ++j) acc[i][j] = 0.f;
        float4 ra = *(const float4*)(Arow);
        float4 rb = bok ? *(const float4*)(Bp) : make_float4(0.f, 0.f, 0.f, 0.f);
        for (int k0 = 0; k0 < g.K; k0 += 16) {
            __syncthreads();
            { const int rr = tid >> 2, k4 = (tid & 3) * 4; As[k4][rr] = ra.x; As[k4 + 1][rr] = ra.y; As[k4 + 2][rr] = ra.z; As[k4 + 3][rr] = ra.w; }
            *(float4*)&Bs[bk][(tid & 31) * 4] = rb;
            __syncthreads();
            if (k0 + 16 < g.K) {
                ra = *(const float4*)(Arow + k0 + 16);
                rb = bok ? *(const float4*)(Bp + (long)(k0 + 16) * g.ldb) : make_float4(0.f, 0.f, 0.f, 0.f);
            }
#pragma unroll
            for (int k = 0; k < 16; ++k) {
                const float4 a = *(const float4*)&As[k][ty * 4];
                const float4 b0 = *(const float4*)&Bs[k][tx * 8], b1 = *(const float4*)&Bs[k][tx * 8 + 4];
                const float av[4] = {a.x, a.y, a.z, a.w};
                const float bv[8] = {b0.x, b0.y, b0.z, b0.w, b1.x, b1.y, b1.z, b1.w};
#pragma unroll
                for (int i = 0; i < 4; ++i)
#pragma unroll
                    for (int j = 0; j < 8; ++j) acc[i][j] = fmaf(av[i], bv[j], acc[i][j]);
            }
        }
#pragma unroll
        for (int i = 0; i < 4; ++i) {
            const int row = m0 + ty * 4 + i;
#pragma unroll
            for (int jv = 0; jv < 2; ++jv) {
                const int col = n0 + tx * 8 + jv * 4;
                if (col < g.N) {
                    float v[4] = {acc[i][jv * 4], acc[i][jv * 4 + 1], acc[i][jv * 4 + 2], acc[i][jv * 4 + 3]};
                    float* cp = Cz + (long)row * g.ldc + col;
                    if (MODE == 1) {
#pragma unroll
                        for (int q = 0; q < 4; ++q) v[q] *= g.aux[(long)z * g.sAux + col + q];
                    } else if (MODE == 2) {
                        float gl[4]; ld4bf(g.auxb + (long)row * g.ldaux + col, gl); const float4 gb = *(const float4*)(g.aux2 + col);
                        const float gv[4] = {gl[0] + gb.x, gl[1] + gb.y, gl[2] + gb.z, gl[3] + gb.w};
                        float4 old = make_float4(0.f, 0.f, 0.f, 0.f);
                        if (g.accum) old = *(const float4*)cp;
                        const float ov[4] = {old.x, old.y, old.z, old.w};
#pragma unroll
                        for (int q = 0; q < 4; ++q) v[q] = ov[q] + sigmoidf_(gv[q]) * v[q];
                    } else if (MODE == 3) {
                        const float4 old = *(const float4*)cp; const float ov[4] = {old.x, old.y, old.z, old.w};
#pragma unroll
                        for (int q = 0; q < 4; ++q) v[q] = siluf_(ov[q]) * v[q];
                    } else if (MODE == 4) {
                        const float rs = g.aux[(long)z * g.sAux + row];
#pragma unroll
                        for (int q = 0; q < 4; ++q) v[q] *= rs;
                    }
                    *(float4*)cp = make_float4(v[0], v[1], v[2], v[3]);
                }
            }
        }
    }
    __syncthreads();
}

#define W_IN(l)    (p.in[4]  + (size_t)(l) * DM * DIN)
#define B_GATE(l)  (p.in[5]  + (size_t)(l) * 3 * DM)
#define POOL_W(l)  (p.in[6]  + (size_t)(l) * 4 * 128 * 128)
#define POOL_S(l)  (p.in[7]  + (size_t)(l) * 512)
#define W_UP_A(l)  (p.in[8]  + (size_t)(l) * 512 * DM)
#define Q_NORM(l)  (p.in[9]  + (size_t)(l) * 384)
#define W_UQ(l)    (p.in[10] + (size_t)(l) * 384 * 768)
#define KV_NORM(l) (p.in[11] + (size_t)(l) * 256)
#define W_UKV(l)   (p.in[12] + (size_t)(l) * 256 * 1024)
#define W_UP_B(l)  (p.in[13] + (size_t)(l) * 512 * DM)
#define W_DEC(l)   (p.in[14] + (size_t)(l) * 2 * 16 * 256)
#define B_DEC(l)   (p.in[15] + (size_t)(l) * 2 * 256)
#define GLA_NORM(l)(p.in[16] + (size_t)(l) * 128)
#define W_UP_C(l)  (p.in[17] + (size_t)(l) * 512 * DM)
#define W_OUT(l)   (p.in[18] + (size_t)(l) * DM * DM)
#define LN1_G(l)   (p.in[19] + (size_t)(l) * DM)
#define LN1_B(l)   (p.in[20] + (size_t)(l) * DM)
#define ROUTER(l)  (p.in[21] + (size_t)(l) * DM * NE)
#define EW_GATE(l) (p.in[22] + (size_t)(l) * NE * DM * DEXP)
#define EW_UP(l)   (p.in[23] + (size_t)(l) * NE * DM * DEXP)
#define EW_DOWN(l) (p.in[24] + (size_t)(l) * NE * DEXP * DM)
#define LN2_G(l)   (p.in[25] + (size_t)(l) * DM)
#define LN2_B(l)   (p.in[26] + (size_t)(l) * DM)
#define WSF(off) ((float*)(p.ws + (off)))
#define WSI(off) ((int*)(p.ws + (off)))
#define WSB(off) ((bf16_t*)(p.ws + (off)))
#define PJ(t, c) bf2f(projb[(size_t)(t) * DINP + (c)])

enum Stage {
    ST_INIT = 0,
    ST_WCONV,
    ST_PROJ,
    ST_PREP,
    ST_SMALLGEMM,
    ST_ROPE,
    ST_ATTN,
    ST_GLA1, ST_GLA2, ST_GLA3,
    ST_GLAFIN,
    ST_MERGE_A, ST_MERGE_B, ST_MERGE_C,
    ST_OUTP,
    ST_LN1,
    ST_TOPK,
    ST_GATHER,
    ST_EXP_G, ST_EXP_U, ST_EXP_D,
    ST_LN2,
    ST_COUNT
};

#define KAS __attribute__((address_space(4)))
template <int ST>
__device__ __forceinline__ void run_stage(int l, float* lds) {
    const KAS Params* pk_ = (const KAS Params*)__builtin_amdgcn_kernarg_segment_ptr(); asm volatile("" : "+s"(pk_));
    const KAS Params& p = *pk_;
    int tid_ = threadIdx.x; asm volatile("" : "+v"(tid_));
    int bid_ = blockIdx.x; asm volatile("" : "+s"(bid_));
    const int tid = tid_, lane = tid & 63, wid = tid >> 6;
    const int G = gridDim.x, bid = bid_;
    const int gw = bid * 8 + wid, NGW = G * 8;
    const long gt = (long)bid * NTHR + tid, NGT = (long)G * NTHR;
    float* h = p.out;

    if constexpr (ST == ST_INIT) {
        for (int m = gw; m < T; m += NGW) { float4 vv[4]; ln_row(p.in[0] + (size_t)m * DM, nullptr, 1.f, p.in[2], p.in[3], h + (size_t)m * DM, lane, vv, WSB(WS_HB) + (size_t)m * DM); }
        {
            float* scr = lds + wid * 4096;
            constexpr int NBLK = DIN / 32, ITEMS_L = (DM / 64) * NBLK;
            for (int it = gw; it < 2 * ITEMS_L; it += NGW) {
                const int ll = it / ITEMS_L, r = it % ITEMS_L, kb = r / NBLK, nb = r % NBLK;
                const int n0 = 32 * nb, drow = n0 < 2752 ? n0 + 3072 : n0 - 2752;
                transpose_block(p.in[4] + (size_t)ll * DM * DIN + (size_t)(64 * kb) * DIN + n0, DIN, WSB(WS_WIN_T) + (size_t)ll * DINP * DM + (size_t)drow * DM + 64 * kb, DM, nullptr, nullptr, scr, lane);
            }
            {
                constexpr int I_UQ = 6 * 24, I_UKV = 4 * 32, I_B = 8 * 32, I_OUT = 16 * 32, I_L = I_UQ + I_UKV + 2 * I_B + I_OUT;
                for (int it = gw; it < 2 * I_L; it += NGW) {
                    const int ll = it / I_L; int r = it % I_L; bf16_t* wsm = WSB(WS_WSMALL + (size_t)ll * WSM_STRIDE);
                    if (r < I_UQ) { const int kb = r / 24, nb = r % 24; transpose_block(p.in[10] + (size_t)ll * 384 * 768 + (size_t)(64 * kb) * 768 + 32 * nb, 768, wsm + WSM_UQ / 2 + (size_t)(32 * nb) * 384 + 64 * kb, 384, p.in[9] + ll * 384 + 64 * kb, nullptr, scr, lane); continue; } r -= I_UQ;
                    if (r < I_UKV) { const int kb = r / 32, nb = r % 32; transpose_block(p.in[12] + (size_t)ll * 256 * 1024 + (size_t)(64 * kb) * 1024 + 32 * nb, 1024, wsm + WSM_UKV / 2 + (size_t)(32 * nb) * 256 + 64 * kb, 256, p.in[11] + ll * 256 + 64 * kb, nullptr, scr, lane); continue; } r -= I_UKV;
                    if (r < 2 * I_B) { const int c = r / I_B, rr = r % I_B, kb = rr / 32, nb = rr % 32; const float* W = (c ? p.in[17] : p.in[13]) + (size_t)ll * 512 * DM;
                        transpose_block(W + (size_t)(64 * kb) * DM + 32 * nb, DM, wsm + WSM_MRG / 2 + (size_t)(32 * nb) * 1536 + 512 * (1 + c) + 64 * kb, 1536, nullptr, nullptr, scr, lane); continue; } r -= 2 * I_B;
                    { const int kb = r / 32, nb = r % 32; transpose_block(p.in[18] + (size_t)ll * DM * DM + (size_t)(64 * kb) * DM + 32 * nb, DM, wsm + WSM_OUT / 2 + (size_t)(32 * nb) * DM + 64 * kb, DM, nullptr, nullptr, scr, lane); }
                }
                for (long i = gt; i < 2L * 512 * DM; i += NGT) {
                    const int ll = (int)(i / (512 * DM)), r = (int)(i % (512 * DM)), cin = r >> 10, d = r & 1023, g = cin >> 7, c = cin & 127;
                    const float* pw = p.in[6] + (size_t)ll * 4 * 128 * 128 + (size_t)(g * 128 + c) * 128; const float* ps = p.in[7] + ll * 512 + g * 128; const float* wa = p.in[8] + (size_t)ll * 512 * DM + (size_t)(g * 128) * DM + d;
                    float a = 0.f;
                    for (int cc = 0; cc < 128; ++cc) a = fmaf(pw[cc] * ps[cc], wa[(size_t)cc * DM], a);
                    WSB(WS_WSMALL + (size_t)ll * WSM_STRIDE + WSM_MRG)[(size_t)d * 1536 + cin] = (bf16_t)f2bf(a);
                }
            }
            for (long i = gt; i < 2L * 64 * DM / 8; i += NGT) { const int ll = (int)(i / (64 * DM / 8)); const long r = i % (64 * DM / 8);
                *(uint4*)(WSB(WS_WIN_T) + (size_t)ll * DINP * DM + (size_t)DIN * DM + r * 8) = make_uint4(0u, 0u, 0u, 0u); }
        }
        float* rc = WSF(WS_ROPE); float* rs = rc + T * 16;
        for (long i = gt; i < (long)T * 16; i += NGT) {
            const int t = (int)(i >> 4), j = (int)(i & 15);
            const float freq = powf(10000.0f, -(float)j / 16.0f);
            const float ang = (float)p.pos[t] * freq;
            rc[i] = cosf(ang); rs[i] = sinf(ang);
        }
    }
    if constexpr (ST == ST_WCONV) {
        float* scr = lds + wid * 4096;
        constexpr int I_G = 16 * 16 * 64, I_D = 16 * 32 * 32;
        constexpr int I_ALL = 2 * I_G + I_D;
#define WCONV_ITEM(it, W, ldw, dst, ldt, sc8) do { if ((it) < 2 * I_G) { const int up_ = (it) >= I_G, r_ = up_ ? (it) - I_G : (it), e_ = r_ >> 10, kb_ = (r_ >> 6) & 15, nb_ = r_ & 63, j0_ = nb_ * 32; \
            W = (up_ ? EW_UP(l) : EW_GATE(l)) + (size_t)e_ * DM * DEXP + (size_t)(64 * kb_) * DEXP + j0_; ldw = DEXP; \
            dst = (unsigned char*)(p.ws + WS_WGU_T) + (size_t)(e_ * 4096 + 256 * (j0_ >> 7) + (j0_ & 127) + (up_ ? 128 : 0)) * DM + 64 * kb_; ldt = DM; sc8 = F8_WGU; } \
          else { const int r_ = (it) - 2 * I_G, e_ = r_ >> 10, kb_ = (r_ >> 5) & 31, nb_ = r_ & 31; \
            W = EW_DOWN(l) + (size_t)e_ * DEXP * DM + (size_t)(64 * kb_) * DM + 32 * nb_; ldw = DM; dst = (unsigned char*)(p.ws + WS_WD_T) + (size_t)(e_ * 1024 + 32 * nb_) * DEXP + 64 * kb_; ldt = DEXP; sc8 = F8_WD; } } while (0)
        float va[32], vb[32]; const float* Wa = nullptr; const float* Wb = nullptr; unsigned char* da = nullptr; unsigned char* db = nullptr; int lwa = 0, lwb = 0, lta = 0, ltb = 0; float sa = 1.f, sb = 1.f;
        int itA = gw, itB = gw + NGW;
        if (itA < I_ALL) { WCONV_ITEM(itA, Wa, lwa, da, lta, sa); tb_load(va, Wa, lwa, lane); }
        while (itA < I_ALL) {
            if (itB < I_ALL) { WCONV_ITEM(itB, Wb, lwb, db, ltb, sb); tb_load(vb, Wb, lwb, lane); }
            tb_store8(va, da, lta, sa, scr, lane);
            itA = itB + NGW;
            if (itB >= I_ALL) break;
            if (itA < I_ALL) { WCONV_ITEM(itA, Wa, lwa, da, lta, sa); tb_load(va, Wa, lwa, lane); }
            tb_store8(vb, db, ltb, sb, scr, lane);
            itB = itA + NGW;
        }
#undef WCONV_ITEM
        __syncthreads();
    }
    if constexpr (ST == ST_PROJ) {
        pg8::Gemm g{WSB(WS_HB), WSB(WS_WIN_T) + (size_t)l * DINP * DM, T, DINP, DM, DM};
        pg8::StaticOrder S; S.init(T, DINP, G, bid);
        EpiProj E{WSB(WS_PROJB), B_GATE(l)};
        pg8::gemm_phase<EpiProj, pg8::StaticOrder, true, true>((PG8_LAS unsigned char*)lds, g, S, E);
    }
    if constexpr (ST == ST_PREP) {
        const bf16_t* projb = WSB(WS_PROJB); bf16_t* br = WSB(WS_BR); bf16_t* U = (bf16_t*)lds;
        float* rq = WSF(WS_RQ); float* rkv = rq + T; const float* rc = WSF(WS_ROPE); const float* rs = rc + T * 16; bf16_t* kb = WSB(WS_KB);
        for (int tile = bid; tile < T / 64; tile += G) {
            const int b = tile / (SEQ / 64), s0 = (tile % (SEQ / 64)) * 64, t0 = b * SEQ + s0;
            __syncthreads();
#pragma unroll
            for (int it = 0; it < 10; ++it) { const int e = tid + it * NTHR, r = e >> 6, ch = e & 63, s = s0 - 8 + r;
                uint4 v = make_uint4(0u, 0u, 0u, 0u);
                if (s >= 0 && s < SEQ) v = *(const uint4*)(projb + (size_t)(b * SEQ + s) * DINP + OFF_POOL + ch * 8);
                *(uint4*)(U + r * 512 + ch * 8) = v; }
            for (int r = wid; r < 64; r += 8) { const bf16_t* row = projb + (size_t)(t0 + r) * DINP;
                float s1 = 0.f, s2 = 0.f;
                if (lane < 48) { const uint4 w = *(const uint4*)(row + OFF_CQ + lane * 8); const unsigned ww[4] = {w.x, w.y, w.z, w.w};
#pragma unroll
                    for (int q = 0; q < 4; ++q) { const float a = __uint_as_float(ww[q] << 16), c = __uint_as_float(ww[q] & 0xffff0000u); s1 += a * a + c * c; } }
                if (lane < 32) { const uint4 w = *(const uint4*)(row + OFF_CKV + lane * 8); const unsigned ww[4] = {w.x, w.y, w.z, w.w};
#pragma unroll
                    for (int q = 0; q < 4; ++q) { const float a = __uint_as_float(ww[q] << 16), c = __uint_as_float(ww[q] & 0xffff0000u); s2 += a * a + c * c; } }
                s1 = wave_sum(s1); s2 = wave_sum(s2);
                if (lane == 0) { rq[t0 + r] = 1.f / sqrtf(s1 * (1.f / 384.f) + RMS_EPS); rkv[t0 + r] = 1.f / sqrtf(s2 * (1.f / 256.f) + RMS_EPS); } }
#pragma unroll
            for (int it = 0; it < 2; ++it) { const int e = tid + it * NTHR, r = e >> 4, j = e & 15, t = t0 + r;
                const float c = rc[(size_t)t * 16 + j], s = rs[(size_t)t * 16 + j], x1 = PJ(t, OFF_KR + j), x2 = PJ(t, OFF_KR + 16 + j);
                const bf16_t k1 = (bf16_t)f2bf(x1 * c - x2 * s), k2 = (bf16_t)f2bf(x1 * s + x2 * c);
#pragma unroll
                for (int hh = 0; hh < 8; ++hh) { kb[(size_t)t * 768 + hh * 96 + 64 + j] = k1; kb[(size_t)t * 768 + hh * 96 + 80 + j] = k2; } }
            __syncthreads();
            { const int c = tid, hw = 1 << (c >> 7); float sum = 0.f;
                for (int u = s0 - hw; u < s0 + hw; ++u) if (u >= 0 && u < SEQ) sum += bf2f(U[(u - s0 + 8) * 512 + c]);
                for (int s = s0; s < s0 + 64; ++s) {
                    int lo = s - hw; if (lo < 0) lo = 0; int hi = s + hw; if (hi > SEQ) hi = SEQ;
                    br[(size_t)(b * SEQ + s) * 1536 + c] = (bf16_t)f2bf(sum / (float)(hi - lo) - bf2f(U[(s - s0 + 8) * 512 + c]));
                    if (s + hw < SEQ) sum += bf2f(U[(s + hw - s0 + 8) * 512 + c]);
                    if (s - hw >= 0) sum -= bf2f(U[(s - hw - s0 + 8) * 512 + c]);
                } }
        }
        __syncthreads();
    }
    if constexpr (ST == ST_SMALLGEMM) {
        const bf16_t* wsm = WSB(WS_WSMALL + (size_t)l * WSM_STRIDE);
        { pg8::Gemm g{WSB(WS_PROJB) + OFF_CQ, wsm + WSM_UQ / 2, T, 768, 384, DINP}; pg8::StaticOrder S; S.init(T, 768, G, bid);
          EpiQ E{WSB(WS_QB), WSF(WS_RQ), WSF(WS_ROPE), WSF(WS_ROPE) + T * 16}; pg8::gemm_phase<EpiQ, pg8::StaticOrder, true, true>((PG8_LAS unsigned char*)lds, g, S, E); }
        { pg8::Gemm g{WSB(WS_PROJB) + OFF_CKV, wsm + WSM_UKV / 2, T, 1024, 256, DINP}; pg8::StaticOrder S; S.init(T, 1024, G, bid);
          EpiKV E{WSB(WS_KB), WSB(WS_VB), WSF(WS_RQ) + T}; pg8::gemm_phase<EpiKV, pg8::StaticOrder, true, true>((PG8_LAS unsigned char*)lds, g, S, E); }
    }
    if constexpr (ST == ST_ATTN) {
        const int vcu = (G % 8 == 0) ? (bid % 8) * (G / 8) + bid / 8 : bid;
        for (int L = vcu; L < NB * 8 * 32; L += G) {
            const int bh = L >> 5, qb = L & 31, b = bh >> 3, hh = bh & 7;
            att::attn_unit(WSB(WS_QB) + (size_t)(b * SEQ + qb * 256) * 768 + hh * 96, WSB(WS_KB) + (size_t)(b * SEQ) * 768 + hh * 96, WSB(WS_VB) + (size_t)(b * SEQ) * 512 + hh * 64,
                           WSB(WS_BR) + (size_t)(b * SEQ + qb * 256) * 1536 + 512 + hh * 64, SEQ, (char*)lds);
        }
    }
    if constexpr (ST == ST_GLA1) {
        for (int item = bid; item < NB * 4 * 128; item += G) {
            const int b = item >> 9, hh = (item >> 7) & 3, c = item & 127;
            gla::g1_item((char*)lds, WSB(WS_PROJB), W_DEC(l), B_DEC(l), b, hh, c, WSF(WS_KVT), WSF(WS_DEC));
        }
    }
    if constexpr (ST == ST_GLA2) {
        const float* kvt = WSF(WS_KVT); const float* dec = WSF(WS_DEC); bf16_t* stp = WSB(WS_ST);
        for (long e = gt; e < 2L * 8 * 8192; e += NGT) {
            const int dir = (int)(e >> 16), bh = (int)((e >> 13) & 7), vd = (int)(e & 8191), d = vd & 63;
            const long base = ((long)dir * 8 + bh) * 128;
            float s = 0.f;
#pragma unroll 1
            for (int k0 = 0; k0 < 128; k0 += 32) {
                float kv[32], dc[32];
#pragma unroll
                for (int k = 0; k < 32; ++k) { const int c = dir ? 127 - (k0 + k) : k0 + k; kv[k] = kvt[(base + c) * 8192 + vd]; dc[k] = dec[(base + c) * 64 + d]; }
#pragma unroll
                for (int k = 0; k < 32; ++k) { const int c = dir ? 127 - (k0 + k) : k0 + k; stp[(base + c) * 8192 + vd] = (bf16_t)f2bf(s); s = fmaf(dc[k], s, kv[k]); }
            }
        }
    }
    if constexpr (ST == ST_GLA3) {
        for (int item = bid; item < NB * 4 * 128; item += G) {
            const int b = item >> 9, hh = (item >> 7) & 3, c = item & 127;
            gla::g3_item((char*)lds, WSB(WS_PROJB), W_DEC(l), B_DEC(l), GLA_NORM(l), b, hh, c, WSB(WS_ST), WSB(WS_BR) + 1024, 1536);
        }
    }
    if constexpr (ST == ST_MERGE_A) {
        const bf16_t* wsm = WSB(WS_WSMALL + (size_t)l * WSM_STRIDE);
        pg8::Gemm g{WSB(WS_BR), wsm + WSM_MRG / 2, T, DM, 1536, 1536}; pg8::StaticOrder S; S.init(T, DM, G, bid);
        EpiMerge E{WSB(WS_MERGEDB), WSB(WS_PROJB) + OFF_GATE};
        pg8::gemm_phase<EpiMerge, pg8::StaticOrder, true, true>((PG8_LAS unsigned char*)lds, g, S, E);
    }
    if constexpr (ST == ST_OUTP) {
        const bf16_t* wsm = WSB(WS_WSMALL + (size_t)l * WSM_STRIDE);
        pg8::Gemm g{WSB(WS_MERGEDB), wsm + WSM_OUT / 2, T, DM, DM, DM}; pg8::StaticOrder S; S.init(T, DM, G, bid);
        EpiF32 E{WSF(WS_TMP), DM, nullptr};
        pg8::gemm_phase<EpiF32, pg8::StaticOrder, true, true>((PG8_LAS unsigned char*)lds, g, S, E);
    }
    if constexpr (ST == ST_LN1) {
        float* RWT = lds; const float* rw = ROUTER(l);
        for (int i = tid; i < DM * 4; i += NTHR) { const int k = i >> 2, e4 = (i & 3) * 4; const float4 w = *(const float4*)(rw + (size_t)k * 16 + e4);
            RWT[(e4 + 0) * DM + k] = w.x; RWT[(e4 + 1) * DM + k] = w.y; RWT[(e4 + 2) * DM + k] = w.z; RWT[(e4 + 3) * DM + k] = w.w; }
        __syncthreads();
        float* afft = WSF(WS_AFF);
        for (int m0 = gw; m0 < T; m0 += 2 * NGW) {
            const int mr[2] = {m0, m0 + NGW};
            float4 hv[2][4];
#pragma unroll
            for (int u = 0; u < 2; ++u) { const float* hr = h + (size_t)mr[u] * DM; const float* tr = WSF(WS_TMP) + (size_t)mr[u] * DM;
#pragma unroll
                for (int j = 0; j < 4; ++j) { const float4 a = ((const float4*)hr)[lane + 64 * j], t4 = ((const float4*)tr)[lane + 64 * j];
                    hv[u][j] = make_float4(fmaf(ALPHA, a.x, t4.x), fmaf(ALPHA, a.y, t4.y), fmaf(ALPHA, a.z, t4.z), fmaf(ALPHA, a.w, t4.w)); } }
            ln_core2(hv, LN1_G(l), LN1_B(l), h + (size_t)mr[0] * DM, h + (size_t)mr[1] * DM, WSB(WS_HB) + (size_t)mr[0] * DM, WSB(WS_HB) + (size_t)mr[1] * DM, lane,
                     p.ws + WS_HB8 + (size_t)mr[0] * DM, p.ws + WS_HB8 + (size_t)mr[1] * DM);
            float acc[2][16];
#pragma unroll
            for (int e = 0; e < 16; ++e) { float a0 = 0.f, a1 = 0.f;
#pragma unroll
                for (int j = 0; j < 4; ++j) { const float4 w = *(const float4*)(RWT + e * DM + 4 * (lane + 64 * j));
                    a0 = fmaf(hv[0][j].x, w.x, a0); a0 = fmaf(hv[0][j].y, w.y, a0); a0 = fmaf(hv[0][j].z, w.z, a0); a0 = fmaf(hv[0][j].w, w.w, a0);
                    a1 = fmaf(hv[1][j].x, w.x, a1); a1 = fmaf(hv[1][j].y, w.y, a1); a1 = fmaf(hv[1][j].z, w.z, a1); a1 = fmaf(hv[1][j].w, w.w, a1); }
                acc[0][e] = a0; acc[1][e] = a1; if (e & 1) __builtin_amdgcn_sched_barrier(0); }
#pragma unroll
            for (int i = 0; i < 8; ++i)
#pragma unroll
                for (int u = 0; u < 2; ++u) { const bool up = lane & 32; const float keep = up ? acc[u][i + 8] : acc[u][i], send = up ? acc[u][i] : acc[u][i + 8]; acc[u][i] = keep + __shfl_xor(send, 32); }
#pragma unroll
            for (int i = 0; i < 4; ++i)
#pragma unroll
                for (int u = 0; u < 2; ++u) { const bool up = lane & 16; const float keep = up ? acc[u][i + 4] : acc[u][i], send = up ? acc[u][i] : acc[u][i + 4]; acc[u][i] = keep + __shfl_xor(send, 16); }
#pragma unroll
            for (int i = 0; i < 2; ++i)
#pragma unroll
                for (int u = 0; u < 2; ++u) { const bool up = lane & 8; const float keep = up ? acc[u][i + 2] : acc[u][i], send = up ? acc[u][i] : acc[u][i + 2]; acc[u][i] = keep + __shfl_xor(send, 8); }
#pragma unroll
            for (int u = 0; u < 2; ++u) { const bool up = lane & 4; const float keep = up ? acc[u][1] : acc[u][0], send = up ? acc[u][0] : acc[u][1]; acc[u][0] = keep + __shfl_xor(send, 4); }
            float lg[2] = {acc[0][0], acc[1][0]};
#pragma unroll
            for (int o = 1; o <= 2; o <<= 1) { const float t0 = __shfl_xor(lg[0], o), t1 = __shfl_xor(lg[1], o); lg[0] += t0; lg[1] += t1; }
            float mx[2] = {lg[0], lg[1]};
#pragma unroll
            for (int o = 4; o <= 32; o <<= 1) { const float t0 = __shfl_xor(mx[0], o), t1 = __shfl_xor(mx[1], o); mx[0] = fmaxf(mx[0], t0); mx[1] = fmaxf(mx[1], t1); }
            const float ex[2] = {expf(lg[0] - mx[0]), expf(lg[1] - mx[1])}; float se[2] = {ex[0], ex[1]};
#pragma unroll
            for (int o = 4; o <= 32; o <<= 1) { const float t0 = __shfl_xor(se[0], o), t1 = __shfl_xor(se[1], o); se[0] += t0; se[1] += t1; }
            if ((lane & 3) == 0) { const int e = ((lane >> 5) & 1) * 8 + ((lane >> 4) & 1) * 4 + ((lane >> 3) & 1) * 2 + ((lane >> 2) & 1);
#pragma unroll
                for (int u = 0; u < 2; ++u) afft[(size_t)((mr[u] / SEQ) * 16 + e) * SEQ + (mr[u] % SEQ)] = ex[u] / se[u]; }
        }
        __syncthreads();
    }
    if constexpr (ST == ST_TOPK) {
        const float* afft = WSF(WS_AFF); int* idx = WSI(WS_IDX); float* gv = WSF(WS_GATEV); int* slot = WSI(WS_SLOT);
        int* hist = (int*)lds; int* ctl = hist + 256; int* scr = hist + 272;
        for (int z = bid; z < NZ; z += G) {
            const int e = z >> 1, b = z & 1; const float* list = afft + (size_t)(b * 16 + e) * SEQ;
            unsigned key[16];
#pragma unroll
            for (int j = 0; j < 16; j += 4) { const float4 x = *(const float4*)(list + tid * 16 + j); key[j] = __float_as_uint(x.x); key[j + 1] = __float_as_uint(x.y); key[j + 2] = __float_as_uint(x.z); key[j + 3] = __float_as_uint(x.w); }
            unsigned prefix = 0u; int need = CAP;
#pragma unroll 1
            for (int shift = 24; shift >= 0; shift -= 8) {
                __syncthreads();
                if (tid < 256) hist[tid] = 0;
                __syncthreads();
#pragma unroll
                for (int j = 0; j < 16; ++j) { const bool in = (shift == 24) || ((key[j] >> (shift + 8)) == (prefix >> (shift + 8))); if (in) atomicAdd(&hist[(key[j] >> shift) & 255u], 1); }
                __syncthreads();
                if (tid < 256) {
                    const int hc = hist[tid]; int inc = hc;
#pragma unroll
                    for (int o = 1; o < 64; o <<= 1) { const int y = __shfl_down(inc, o); if (lane + o < 64) inc += y; }
                    if (lane == 0) scr[wid] = inc;
                    __builtin_amdgcn_s_waitcnt(0xc07f); __builtin_amdgcn_wave_barrier();
                }
                __syncthreads();
                if (tid < 256) {
                    const int hc = hist[tid]; int inc = hc;
#pragma unroll
                    for (int o = 1; o < 64; o <<= 1) { const int y = __shfl_down(inc, o); if (lane + o < 64) inc += y; }
                    int ca = inc - hc;
#pragma unroll
                    for (int w = 1; w < 4; ++w) ca += (w > wid) ? scr[w] : 0;
                    if (ca < need && need <= ca + hc) { ctl[0] = tid; ctl[1] = need - ca; } }
                __syncthreads();
                prefix |= (unsigned)ctl[0] << shift; need = ctl[1];
            }
            int ceq = 0;
#pragma unroll
            for (int j = 0; j < 16; ++j) ceq += (key[j] == prefix) ? 1 : 0;
            int tot; const int beq = block_excl_scan(ceq, scr, tid, tot);
            int csel = 0, eqr = beq; unsigned selmask = 0u;
#pragma unroll
            for (int j = 0; j < 16; ++j) { bool sel = key[j] > prefix; if (key[j] == prefix) { sel = eqr < need; ++eqr; } if (sel) { selmask |= 1u << j; ++csel; } }
            int sl = block_excl_scan(csel, scr, tid, tot);
#pragma unroll
            for (int j = 0; j < 16; ++j) { const int trow = b * SEQ + tid * 16 + j;
                if ((selmask >> j) & 1u) { idx[z * CAP + sl] = trow; gv[z * CAP + sl] = __uint_as_float(key[j]); slot[(size_t)trow * 16 + e] = sl; ++sl; }
                else slot[(size_t)trow * 16 + e] = -1; }
        }
        __syncthreads();
    }
    if constexpr (ST == ST_GATHER) {
        const int* idx = WSI(WS_IDX); const bf16_t* hb = WSB(WS_HB); bf16_t* xe = WSB(WS_XE);
        const int nr = (NZ * CAP - gw + NGW - 1) / NGW; const int myi = (lane < nr) ? (idx[gw + lane * NGW] & (T - 1)) : 0;
        for (int k = 0; k < nr; k += 4) {
            const int k1 = (k + 1 < nr) ? k + 1 : k, k2 = (k + 2 < nr) ? k + 2 : k, k3 = (k + 3 < nr) ? k + 3 : k;
            const uint4* s0 = (const uint4*)(hb + (size_t)__shfl(myi, k) * DM); const uint4* s1 = (const uint4*)(hb + (size_t)__shfl(myi, k1) * DM);
            const uint4* s2 = (const uint4*)(hb + (size_t)__shfl(myi, k2) * DM); const uint4* s3 = (const uint4*)(hb + (size_t)__shfl(myi, k3) * DM);
            const uint4 x0 = s0[lane], y0 = s0[lane + 64], x1 = s1[lane], y1 = s1[lane + 64], x2 = s2[lane], y2 = s2[lane + 64], x3 = s3[lane], y3 = s3[lane + 64];
            { uint4* d = (uint4*)(xe + (size_t)(gw + k * NGW) * DM); d[lane] = x0; d[lane + 64] = y0; }
            if (k + 1 < nr) { uint4* d = (uint4*)(xe + (size_t)(gw + (k + 1) * NGW) * DM); d[lane] = x1; d[lane + 64] = y1; }
            if (k + 2 < nr) { uint4* d = (uint4*)(xe + (size_t)(gw + (k + 2) * NGW) * DM); d[lane] = x2; d[lane + 64] = y2; }
            if (k + 3 < nr) { uint4* d = (uint4*)(xe + (size_t)(gw + (k + 3) * NGW) * DM); d[lane] = x3; d[lane + 64] = y3; }
        }
    }
    if constexpr (ST == ST_EXP_G) {
        pg8::Gemm g{WSB(WS_HB8), WSB(WS_WGU_T), NZ * CAP, 16 * 4096, DM / 2, DM / 2, WSI(WS_IDX)};
        ExpertOrder1 S; S.init(G, bid);
        EpiSwiGLU E{WSB(WS_HID), DEXP};
        pg8::gemm_phase<EpiSwiGLU, ExpertOrder1, true, true, true, true>((PG8_LAS unsigned char*)lds, g, S, E);
    }
    if constexpr (ST == ST_EXP_D) {
        pg8::Gemm g{WSB(WS_HID), WSB(WS_WD_T), NZ * CAP, 16 * 1024, DEXP / 2, DEXP / 2};
        ExpertOrder2 S; S.init(G, bid);
        EpiRowScale E{WSB(WS_YE), DM, WSF(WS_GATEV)};
        pg8::gemm_phase<EpiRowScale, ExpertOrder2, true, true, false, true>((PG8_LAS unsigned char*)lds, g, S, E);
    }
    if constexpr (ST == ST_LN2) {
        const int* slot = WSI(WS_SLOT); const bf16_t* ye = WSB(WS_YE);
        for (int m0 = gw; m0 < T; m0 += 2 * NGW) {
            const int mr[2] = {m0, m0 + NGW};
            int sl[2]; unsigned long long mask[2]; float4 a[2][4];
#pragma unroll
            for (int u = 0; u < 2; ++u) { sl[u] = (lane < 16) ? slot[(size_t)mr[u] * 16 + lane] : -1; }
#pragma unroll
            for (int u = 0; u < 2; ++u) { const float* hr = h + (size_t)mr[u] * DM;
#pragma unroll
                for (int j = 0; j < 4; ++j) { const float4 x = ((const float4*)hr)[lane + 64 * j]; a[u][j] = make_float4(ALPHA * x.x, ALPHA * x.y, ALPHA * x.z, ALPHA * x.w); } }
            mask[0] = __ballot(sl[0] >= 0); mask[1] = __ballot(sl[1] >= 0);
            while (mask[0] | mask[1]) {
#pragma unroll
                for (int u = 0; u < 2; ++u) if (mask[u]) {
                    const int e = __builtin_ctzll(mask[u]); mask[u] &= mask[u] - 1;
                    const bf16_t* yr = ye + ((size_t)(e * 2 + mr[u] / SEQ) * CAP + __shfl(sl[u], e)) * DM;
#pragma unroll
                    for (int j = 0; j < 4; ++j) { float y[4]; ld4bf(yr + 4 * (lane + 64 * j), y); a[u][j].x += y[0]; a[u][j].y += y[1]; a[u][j].z += y[2]; a[u][j].w += y[3]; }
                }
            }
            ln_core2(a, LN2_G(l), LN2_B(l), h + (size_t)mr[0] * DM, h + (size_t)mr[1] * DM, WSB(WS_HB) + (size_t)mr[0] * DM, WSB(WS_HB) + (size_t)mr[1] * DM, lane);
        }
    }
}


#define LAS __attribute__((address_space(3)))
#define XB_TMO      128
#define XB_XCNT(j)  (256  + 64 * (j))
#define XB_XSUB(j)  (1280 + 64 * (j))
#define XB_XGEN(j)  (2304 + 64 * (j))
#define XB_TOP      3328
#define XB_TOPGEN   3392
#define XCD_BAR_WORDS 3456
#define XB_SPIN_CAP (1u << 18)
__device__ __forceinline__ unsigned xb_ld(unsigned* p)              { return __hip_atomic_load(p, __ATOMIC_RELAXED, __HIP_MEMORY_SCOPE_AGENT); }
__device__ __forceinline__ unsigned xb_add(unsigned* p, unsigned v) { return __hip_atomic_fetch_add(p, v, __ATOMIC_RELAXED, __HIP_MEMORY_SCOPE_AGENT); }
__device__ __forceinline__ unsigned xb_xcc_id() { return (unsigned)__builtin_amdgcn_s_getreg((3 << 11) | 20) & 0xFu; }
#define XB_SPIN(cond, bar) do { unsigned _sp = 0; while (cond) { __builtin_amdgcn_s_sleep(1); \
    if ((++_sp & 255u) == 0u) { if (xb_ld(&(bar)[XB_TMO])) break; if (_sp > XB_SPIN_CAP) { atomicAdd(&(bar)[XB_TMO], 1u); break; } } } } while (0)
struct XcdBarrier { unsigned* bar; unsigned x; volatile LAS unsigned* st; };
__device__ __forceinline__ XcdBarrier xcd_barrier_post(unsigned* bar, volatile LAS unsigned* st) {
    XcdBarrier b; b.bar = bar; b.x = xb_xcc_id(); b.st = st;
    if (threadIdx.x == 0) (void)xb_add(&bar[XB_XCNT(b.x)], 1u);
    return b;
}
__device__ __forceinline__ void xcd_barrier_complete(unsigned* bar, unsigned x, unsigned& nloc, unsigned& nx) {
    const unsigned G = gridDim.x * gridDim.y * gridDim.z;
    unsigned sum, cnt, mine, sp = 0u;
    for (;;) {
        sum = 0u; cnt = 0u; mine = 0u;
#pragma unroll
        for (unsigned j = 0; j < 16; ++j) { const unsigned c = xb_ld(&bar[XB_XCNT(j)]); sum += c; cnt += (c > 0u) ? 1u : 0u; mine = (j == x) ? c : mine; }
        if (sum == G) break;
        __builtin_amdgcn_s_sleep(1);
        if ((++sp & 255u) == 0u) { if (xb_ld(&bar[XB_TMO])) break; if (sp > XB_SPIN_CAP) { atomicAdd(&bar[XB_TMO], 1u); break; } }
    }
    nloc = mine > 0u ? mine : 1u; nx = cnt > 0u ? cnt : 1u;
}
__device__ __forceinline__ void xcd_barrier(const XcdBarrier& b) {
    asm volatile("s_waitcnt vmcnt(0)" ::: "memory");
    __syncthreads();
    if (threadIdx.x == 0) {
        unsigned* bar = b.bar; asm volatile("" : "+s"(bar));
        unsigned bx = b.x; asm volatile("" : "+s"(bx));
        __builtin_amdgcn_s_waitcnt(0);
        unsigned nloc = b.st[0], nx = b.st[1];
        if (nloc == 0u) { xcd_barrier_complete(bar, bx, nloc, nx); b.st[0] = nloc; b.st[1] = nx; }
        const unsigned old = xb_add(&bar[XB_XSUB(bx)], 1u);
        const unsigned gen = old / nloc;
        if (old + 1u == (gen + 1u) * nloc) {
            __builtin_amdgcn_fence(__ATOMIC_RELEASE, "agent");
            asm volatile("s_waitcnt vmcnt(0)" ::: "memory");
            const unsigned og = xb_add(&bar[XB_TOP], 1u);
            const unsigned tg = og / nx;
            if (og + 1u == (tg + 1u) * nx) xb_add(&bar[XB_TOPGEN], 1u);
            else XB_SPIN(xb_ld(&bar[XB_TOPGEN]) == tg, bar);
            __builtin_amdgcn_fence(__ATOMIC_ACQUIRE, "agent");
            xb_add(&bar[XB_XGEN(bx)], 1u);
            asm volatile("s_waitcnt vmcnt(0)" ::: "memory");
        } else {
            XB_SPIN(xb_ld(&bar[XB_XGEN(bx)]) == gen, bar);
            __builtin_amdgcn_fence(__ATOMIC_ACQUIRE, "agent");
            asm volatile("s_waitcnt vmcnt(0)" ::: "memory");
        }
    }
    __syncthreads();
}
constexpr int MISC_OFF = 131072 + 320;
constexpr int CW_BAR = 4096;

__global__ void __launch_bounds__(NTHR) mega_fwd(Params p) {
    extern __shared__ __attribute__((aligned(16))) unsigned char lds_raw[];
    float* lds = (float*)lds_raw;
    volatile LAS unsigned* MISC = (volatile LAS unsigned*)((LAS unsigned char*)lds_raw + MISC_OFF);
    if (threadIdx.x < 32) MISC[threadIdx.x] = 0u;
    __syncthreads();
    unsigned char* ws_ = ((const KAS Params*)__builtin_amdgcn_kernarg_segment_ptr())->ws;
    XcdBarrier bar = xcd_barrier_post((unsigned*)(ws_ + WS_CTL) + CW_BAR, MISC + 8);
#define GB() xcd_barrier(bar)
    run_stage<ST_INIT>(0, lds); GB();
    for (int step = 0; step < 2 * 11; ++step) {
        const int l = step / 11, s = step % 11;
        switch (s) {
        case 0: for (int sub = 0; sub < 2; ++sub) { if (((int)(blockIdx.x & 1) ^ sub) != 0) run_stage<ST_WCONV>(l, lds); else run_stage<ST_PROJ>(l, lds); } break;
        case 1: run_stage<ST_PREP>(l, lds); run_stage<ST_GLA1>(l, lds); break;
        case 2: run_stage<ST_SMALLGEMM>(l, lds); run_stage<ST_GLA2>(l, lds); break;
        case 3: run_stage<ST_ATTN>(l, lds); run_stage<ST_GLA3>(l, lds); break;
        case 4: run_stage<ST_MERGE_A>(l, lds); break;
        case 5: run_stage<ST_OUTP>(l, lds); break;
        case 6: run_stage<ST_LN1>(l, lds); break;
        case 7: run_stage<ST_TOPK>(l, lds); break;
        case 8: run_stage<ST_EXP_G>(l, lds); break;
        case 9: run_stage<ST_EXP_D>(l, lds); break;
        default: run_stage<ST_LN2>(l, lds); break;
        }
        if (step + 1 < 2 * 11) GB();
    }
#undef GB
}

template <int ST>
__global__ void __launch_bounds__(NTHR) k_stage(Params p, int l) {
    extern __shared__ __attribute__((aligned(16))) unsigned char lds_raw[];
    run_stage<ST>(l, (float*)lds_raw);
}

template <int ST> static void launch_stage(const Params& p, int l, int grid, hipStream_t stream) {
    static bool attr = false;
    if (!attr) { (void)hipFuncSetAttribute((const void*)k_stage<ST>, hipFuncAttributeMaxDynamicSharedMemorySize, LDS_BYTES); attr = true; }
    hipLaunchKernelGGL(k_stage<ST>, dim3(grid), dim3(NTHR), LDS_BYTES, stream, p, l);
}

extern "C" void kernel_launch(void* const* d_in, const int* in_sizes, int n_in, void* d_out, int out_size, void* d_ws, size_t ws_size, hipStream_t stream) {
    if (n_in != 27 || out_size != T * DM || ws_size < WS_END) {
        fprintf(stderr, "kernel_launch: unexpected shapes: n_in %d out %d ws %zu (need >= %zu)\n", n_in, out_size, ws_size, (size_t)WS_END);
        return;
    }
    Params p{};
    for (int i = 0; i < 27; ++i) p.in[i] = (const float*)d_in[i];
    p.pos = (const int*)d_in[1]; p.out = (float*)d_out; p.ws = (unsigned char*)d_ws;
    const int grid = 256;
#if MEGA
    static bool attr = false;
    if (!attr) { (void)hipFuncSetAttribute((const void*)mega_fwd, hipFuncAttributeMaxDynamicSharedMemorySize, LDS_BYTES); attr = true; }
    (void)hipMemsetAsync((char*)d_ws + WS_CTL, 0, 65536, stream);
    hipLaunchKernelGGL(mega_fwd, dim3(grid), dim3(NTHR), LDS_BYTES, stream, p);
#else
    launch_stage<ST_INIT>(p, 0, grid, stream);
    for (int l = 0; l < 2; ++l) {
        launch_stage<ST_PROJ>(p, l, grid, stream);
        launch_stage<ST_PREP>(p, l, grid, stream);
        launch_stage<ST_SMALLGEMM>(p, l, grid, stream);
        launch_stage<ST_ROPE>(p, l, grid, stream);
        launch_stage<ST_ATTN>(p, l, grid, stream);
        launch_stage<ST_GLAREC>(p, l, grid, stream);
        launch_stage<ST_GLAFIN>(p, l, grid, stream);
        launch_stage<ST_MERGE_A>(p, l, grid, stream);
        launch_stage<ST_MERGE_B>(p, l, grid, stream);
        launch_stage<ST_MERGE_C>(p, l, grid, stream);
        launch_stage<ST_OUTP>(p, l, grid, stream);
        launch_stage<ST_LN1>(p, l, grid, stream);
        launch_stage<ST_TOPK>(p, l, grid, stream);
        launch_stage<ST_EXP_G>(p, l, grid, stream);
        launch_stage<ST_EXP_U>(p, l, grid, stream);
        launch_stage<ST_EXP_D>(p, l, grid, stream);
        launch_stage<ST_LN2>(p, l, grid, stream);
    }
#endif
}
```

```cpp
#include <hip/hip_runtime.h>
#include <cstdio>
#include <cstdint>

#ifndef MEGA
#define MEGA 1
#endif

constexpr int NB = 2, SEQ = 8192, T = NB * SEQ, DM = 1024, DIN = 5824, DINP = 5888;
constexpr int OFF_GATE = 0, OFF_POOL = 3072, OFF_CQ = 3072 + 512, OFF_CKV = 3072 + 896, OFF_KR = 3072 + 1152, OFF_GQ = 3072 + 1184, OFF_GK = 3072 + 1440, OFF_GV = 3072 + 1696, OFF_GR = 3072 + 2208, OFF_GDEC = 3072 + 2720;
constexpr int NE = 16, CAP = 1024, DEXP = 2048, NZ = NB * NE;
constexpr float ALPHA = 1.4142135623730951f;
constexpr float LN_EPS = 1e-5f, RMS_EPS = 1e-6f;
constexpr int NTHR = 512, LDS_BYTES = 147456;

constexpr size_t MiB = 1u << 20;
constexpr size_t WS_CTL = 0;
constexpr size_t WS_ROPE = 1 * MiB;
constexpr size_t WS_AFF = 3 * MiB;
constexpr size_t WS_SLOT = 4 * MiB;
constexpr size_t WS_IDX = 5 * MiB;
constexpr size_t WS_GATEV = 5 * MiB + 256 * 1024;
constexpr size_t WS_WIN_T = 8 * MiB;
constexpr size_t WS_WSMALL = 31 * MiB;
constexpr size_t WSM_UQ = 0, WSM_UKV = 1 * MiB, WSM_MRG = 2 * MiB, WSM_OUT = 5 * MiB, WSM_STRIDE = 7 * MiB;
constexpr size_t WS_RQ = 6 * MiB;
constexpr size_t WS_HB = 958 * MiB;
constexpr size_t WS_WGU_T = 76 * MiB;
constexpr size_t WS_WD_T = 204 * MiB;
constexpr size_t WS_PROJB = 268 * MiB;
constexpr size_t WS_XE = 268 * MiB;
constexpr size_t WS_HID = 332 * MiB;
constexpr size_t WS_YE = 460 * MiB;
constexpr size_t WS_BR = 452 * MiB;
constexpr size_t WS_HB8 = 500 * MiB;
constexpr size_t WS_QB = 556 * MiB;
constexpr size_t WS_KB = 580 * MiB;
constexpr size_t WS_VB = 604 * MiB;
constexpr size_t WS_KVT = 702 * MiB;
constexpr size_t WS_ST = 766 * MiB;
constexpr size_t WS_DEC = 798 * MiB;
constexpr size_t WS_MERGEDB = 830 * MiB;
constexpr size_t WS_TMP = 894 * MiB;
constexpr size_t WS_END = 990 * MiB;
static_assert(WS_YE + 64 * MiB <= WS_QB, "overlay map");

namespace pg8 {
#define PG8_LAS __attribute__((address_space(3)))
typedef unsigned short bf16_t;
typedef short bf16x8 __attribute__((ext_vector_type(8)));
typedef float f32x4 __attribute__((ext_vector_type(4)));
typedef unsigned u32x4 __attribute__((ext_vector_type(4)));
constexpr int BM = 256, BK = 64, HALF = 128, HTB = HALF * BK * 2  , STAGE_BYTES = 8 * HTB, NXCD = 8, WGM = 8;

__host__ __device__ __forceinline__ int lds_byte(int r, int c) { const int st = (r >> 4) * 2 + (c >> 5), rr = r & 15, cc = c & 31, ob = rr * 64 + cc * 2; return st * 1024 + (ob ^ (((ob >> 9) & 1) << 5)); }
__host__ __device__ __forceinline__ void stage_rc(int b, int& R, int& C) { const int st = b / 1024, sb = b % 1024, swz = sb ^ (((sb >> 9) & 1) << 5); R = (st >> 1) * 16 + swz / 64; C = (st & 1) * 32 + (swz % 64) / 2; }
__host__ __device__ __forceinline__ int perm32(int rho) { const int n = rho >> 4, i = rho & 15; return 8 * (i >> 2) + 4 * n + (i & 3); }

struct Unit { int pm, pn; };
struct Gemm { const bf16_t* A; const bf16_t* Bt; int M, N, K, lda; const int* ridx; };

struct StaticOrder {
    int nM, nN, nwg, G, c;
    __host__ __device__ void init(int M, int N, int G_, int c_) { nM = M / BM; nN = N / BM; nwg = nM * nN; G = G_; c = c_; }
    __host__ __device__ bool next(int i, Unit& u) const {
        const long L = (long)i * G + c; if (L >= nwg) return false;
        int wgid = (int)L; { const int q = nwg / NXCD, r = nwg % NXCD, xcd = wgid % NXCD, off = wgid / NXCD; wgid = (xcd < r ? xcd * (q + 1) : r * (q + 1) + (xcd - r) * q) + off; }
        const int nig = WGM * nN, gid = wgid / nig, fm = gid * WGM, gsz = (nM - fm) < WGM ? (nM - fm) : WGM;
        u.pm = fm + ((wgid % nig) % gsz); u.pn = (wgid % nig) / gsz; return true;
    }
    __device__ __forceinline__ void a_ready(const Unit&) const {}
    __device__ __forceinline__ void done(const Unit&) const {}
};

__device__ __forceinline__ unsigned cvt_pk_bf16(float lo, float hi) { unsigned r; asm volatile("v_cvt_pk_bf16_f32 %0, %1, %2" : "=v"(r) : "v"(lo), "v"(hi)); return r; }
typedef float f32x2 __attribute__((ext_vector_type(2)));
__device__ __forceinline__ f32x2 gelu_pk(f32x2 v) {
    const f32x2 av = __builtin_elementwise_abs(v), d = av * 0.2316418882f + 1.0f;
    f32x2 t; t.x = __builtin_amdgcn_rcpf(d.x); t.y = __builtin_amdgcn_rcpf(d.y);
    f32x2 q = t * 0.5307027145f + (-0.7265760135f); q = q * t + 0.7107068705f; q = q * t + (-0.142248368f); q = q * t + 0.127414796f; q = q * t;
    const f32x2 s = (v * v) * (-0.72134752044f);
    f32x2 e; e.x = __builtin_amdgcn_exp2f(s.x); e.y = __builtin_amdgcn_exp2f(s.y);
    const f32x2 m = v * (q * e), r = v - m;
    f32x2 o; o.x = v.x < 0.f ? m.x : r.x; o.y = v.y < 0.f ? m.y : r.y; return o;
}

template <int ACT  > struct EpiBf16 {
    static constexpr bool PERM = true, AFTER_DRAIN = false; static constexpr int SEG = 0; static_assert(ACT == 0 || ACT == 1, "EpiBf16: ACT is 0 (none) or 1 (gelu_pk)");
    bf16_t* O; int ldc; const float* bias; int split_cols; size_t split_stride; float scale0;
    __device__ __forceinline__ void operator()(const f32x4 (&acc)[2][2][4][2], const Unit& u, int wr, int wc, int fr, int fq) const {
        const int row0 = u.pm * BM + wr * 64 + fr; int colt = u.pn * BM; bf16_t* base = O;
        float sc = 1.f; if (split_cols) { const int t = colt / split_cols; base += (size_t)t * split_stride; colt -= t * split_cols; if (t == 0) sc = scale0; }
        const int col0 = colt + wc * 32 + 8 * fq, bcol0 = u.pn * BM + wc * 32 + 8 * fq;
        f32x4 bv[2][2];
#pragma unroll
        for (int bj = 0; bj < 2; ++bj)
#pragma unroll
            for (int n = 0; n < 2; ++n) bv[bj][n] = bias ? *(const f32x4*)(bias + bcol0 + bj * HALF + 4 * n) : (f32x4){0.f, 0.f, 0.f, 0.f};
#pragma unroll
        for (int ai = 0; ai < 2; ++ai)
#pragma unroll
            for (int m = 0; m < 4; ++m) { bf16_t* rowp = base + (size_t)(row0 + ai * HALF + m * 16) * ldc + col0;
#pragma unroll
                for (int bj = 0; bj < 2; ++bj) { f32x4 v0 = acc[ai][bj][m][0] + bv[bj][0], v1 = acc[ai][bj][m][1] + bv[bj][1];
                    if (ACT == 1) { f32x2 a = gelu_pk((f32x2){v0[0], v0[1]}), b = gelu_pk((f32x2){v0[2], v0[3]}), c = gelu_pk((f32x2){v1[0], v1[1]}), d = gelu_pk((f32x2){v1[2], v1[3]});
                        v0 = (f32x4){a.x, a.y, b.x, b.y}; v1 = (f32x4){c.x, c.y, d.x, d.y}; }
                    v0 = v0 * sc; v1 = v1 * sc; u32x4 w; w.x = cvt_pk_bf16(v0[0], v0[1]); w.y = cvt_pk_bf16(v0[2], v0[3]); w.z = cvt_pk_bf16(v1[0], v1[1]); w.w = cvt_pk_bf16(v1[2], v1[3]);
                    *(u32x4*)(rowp + bj * HALF) = w; } }
    }
};

struct PanelStats {
    unsigned* xbuf;
    unsigned* cnt;
    unsigned* tmo;
    int ntn; float eps;
    unsigned code;
    __device__ __forceinline__ bool run(const f32x4 (&v)[2][2][4][2], const Unit& u, int wr, int wc, int fr, int fq, PG8_LAS unsigned char* lds, int wid, int lane) const {
        typedef float f32x2v __attribute__((ext_vector_type(2)));
        PG8_LAS f32x2v* P = (PG8_LAS f32x2v*)lds;
        PG8_LAS f32x2v* S = (PG8_LAS f32x2v*)(lds + 8192);
        PG8_LAS unsigned* flag = (PG8_LAS unsigned*)(lds + 8192 + 2048);
#pragma unroll
        for (int ai = 0; ai < 2; ++ai)
#pragma unroll
            for (int m = 0; m < 4; ++m) {
                float s = 0.f;
#pragma unroll
                for (int bj = 0; bj < 2; ++bj)
#pragma unroll
                    for (int n = 0; n < 2; ++n) { const f32x4 x = v[ai][bj][m][n]; s += (x[0] + x[1]) + (x[2] + x[3]); }
                s += __shfl_xor(s, 16); s += __shfl_xor(s, 32);
                const float mw = s * (1.0f / 64.0f); float q = 0.f;
#pragma unroll
                for (int bj = 0; bj < 2; ++bj)
#pragma unroll
                    for (int n = 0; n < 2; ++n) { const f32x4 d = v[ai][bj][m][n] - mw; q += (d[0] * d[0] + d[1] * d[1]) + (d[2] * d[2] + d[3] * d[3]); }
                q += __shfl_xor(q, 16); q += __shfl_xor(q, 32);
                if (fq == 0) P[(ai * HALF + wr * 64 + m * 16 + fr) * 4 + wc] = (f32x2v){mw, q};
            }
        asm volatile("s_waitcnt lgkmcnt(0)" ::: "memory"); __builtin_amdgcn_s_barrier(); asm volatile("" ::: "memory");
#if defined(BROKEN_EXCHANGE_NO_WAIT)
#warning BROKEN CONTROL BUILD: the row-statistics exchange does not wait; results are wrong by design
        if (blockIdx.x >= 64) { const long long t0_ = clock64(); while (clock64() - t0_ < 60000) __builtin_amdgcn_s_sleep(8); }
#endif
        const int row = wid * 32 + (lane & 31);
        if (lane < 32) {
            const f32x2v a = P[row * 4 + 0], b = P[row * 4 + 1], c = P[row * 4 + 2], d = P[row * 4 + 3];
            const float mt = (a.x + b.x + c.x + d.x) * 0.25f;
            const float da = a.x - mt, db = b.x - mt, dc = c.x - mt, dd = d.x - mt;
            const float m2 = (a.y + b.y) + (c.y + d.y) + 64.0f * ((da * da + db * db) + (dc * dc + dd * dd));
            unsigned long long* slot = (unsigned long long*)xbuf + ((size_t)(u.pm * BM + row) * 4 + u.pn);
            __hip_atomic_store(slot, ((unsigned long long)__float_as_uint(m2) << 32) | __float_as_uint(mt), __ATOMIC_RELAXED, __HIP_MEMORY_SCOPE_AGENT);
        }
        asm volatile("s_waitcnt vmcnt(0)" ::: "memory");
        if (lane == 0) __hip_atomic_fetch_add(cnt + 64 * u.pm, 1u, __ATOMIC_RELAXED, __HIP_MEMORY_SCOPE_AGENT);
        if (wid == 0) {
            bool dead = false; const unsigned long long t0 = __builtin_amdgcn_s_memrealtime(); const unsigned want = 8u * (unsigned)ntn;
            for (;;) {
#if defined(BROKEN_EXCHANGE_NO_WAIT)
                break;
#endif
                if ((unsigned)__builtin_amdgcn_readfirstlane(__hip_atomic_load(cnt + 64 * u.pm, __ATOMIC_RELAXED, __HIP_MEMORY_SCOPE_AGENT)) >= want) break;
                if (__builtin_amdgcn_s_memrealtime() - t0 > 2000000ull) {
                    if (lane == 0) { unsigned expect = 0u; __hip_atomic_compare_exchange_strong(tmo + 1, &expect, code | (unsigned)(u.pm & 0xff), __ATOMIC_RELAXED, __ATOMIC_RELAXED, __HIP_MEMORY_SCOPE_AGENT);
                                     __hip_atomic_store(tmo, 1u, __ATOMIC_RELAXED, __HIP_MEMORY_SCOPE_AGENT); }
                    dead = true; break; }
                __builtin_amdgcn_s_sleep(2);
            }
            __builtin_amdgcn_fence(__ATOMIC_ACQUIRE, "agent");
            if (lane == 0) flag[0] = dead ? 1u : 0u;
        }
        asm volatile("s_waitcnt vmcnt(0) lgkmcnt(0)" ::: "memory"); __builtin_amdgcn_s_barrier(); asm volatile("" ::: "memory");
        const bool bad = flag[0] != 0u;
        if (lane < 32) {
            const unsigned long long* slot = (const unsigned long long*)xbuf + (size_t)(u.pm * BM + row) * 4; float mt[4], m2[4]; float ms = 0.f;
#pragma unroll
            for (int t = 0; t < 4; ++t) { if (t < ntn) { const unsigned long long w = __hip_atomic_load(slot + t, __ATOMIC_RELAXED, __HIP_MEMORY_SCOPE_AGENT); mt[t] = __uint_as_float((unsigned)w); m2[t] = __uint_as_float((unsigned)(w >> 32)); } else { mt[t] = 0.f; m2[t] = 0.f; } ms += mt[t]; }
            const float mean = ms / (float)ntn; float q = 0.f;
#pragma unroll
            for (int t = 0; t < 4; ++t) if (t < ntn) { const float dm = mt[t] - mean; q += m2[t] + 256.0f * dm * dm; }
            S[row] = (f32x2v){mean, 1.0f / sqrtf(q / (256.0f * (float)ntn) + eps)};
        }
        asm volatile("s_waitcnt lgkmcnt(0)" ::: "memory"); __builtin_amdgcn_s_barrier(); asm volatile("" ::: "memory");
        return bad;
    }
};
struct EpiLnRes {
    static constexpr bool PERM = false, AFTER_DRAIN = true; static constexpr int SEG = 0;
    const float* base; float* out; int ldc; const float* bias; PanelStats st; unsigned poison;
    __device__ __forceinline__ void fused(f32x4 (&acc)[2][2][4][2], const Unit& u, int wr, int wc, int fr, int fq, PG8_LAS unsigned char* lds, int wid, int lane) const {
        typedef float f32x2v __attribute__((ext_vector_type(2)));
        const PG8_LAS f32x2v* S = (const PG8_LAS f32x2v*)(lds + 8192);
        const int col0 = u.pn * BM + wc * 32 + 4 * fq;
#pragma unroll
        for (int bj = 0; bj < 2; ++bj)
#pragma unroll
            for (int n = 0; n < 2; ++n) { const f32x4 bv = bias ? *(const f32x4*)(bias + col0 + bj * HALF + n * 16) : (f32x4){0.f, 0.f, 0.f, 0.f};
#pragma unroll
                for (int ai = 0; ai < 2; ++ai)
#pragma unroll
                    for (int m = 0; m < 4; ++m) acc[ai][bj][m][n] += bv; }
        f32x4 pre[4][2][2];
#pragma unroll
        for (int m = 0; m < 4; ++m) { const size_t off = (size_t)(u.pm * BM + wr * 64 + m * 16 + fr) * ldc + col0;
#pragma unroll
            for (int bj = 0; bj < 2; ++bj)
#pragma unroll
                for (int n = 0; n < 2; ++n) pre[m][bj][n] = *(const f32x4*)(base + off + bj * HALF + n * 16); }
        const bool bad = st.run(acc, u, wr, wc, fr, fq, lds, wid, lane) || poison != 0u;
        const float qnan = __builtin_nanf("");
#pragma unroll
        for (int ai = 0; ai < 2; ++ai)
#pragma unroll
            for (int m = 0; m < 4; ++m) { const int r = ai * HALF + wr * 64 + m * 16 + fr; const f32x2v sr = S[r]; const size_t off = (size_t)(u.pm * BM + r) * ldc + col0;
#pragma unroll
                for (int bj = 0; bj < 2; ++bj)
#pragma unroll
                    for (int n = 0; n < 2; ++n) { const f32x4 bs = ai == 0 ? pre[m][bj][n] : *(const f32x4*)(base + off + bj * HALF + n * 16); f32x4 o = bs + (acc[ai][bj][m][n] - sr.x) * sr.y;
                        if (bad) o = (f32x4){qnan, qnan, qnan, qnan}; *(f32x4*)(out + off + bj * HALF + n * 16) = o; }
                if (m & 1) asm volatile("" ::: "memory"); }
    }
};
struct EpiLnResLn {
    static constexpr bool PERM = false, AFTER_DRAIN = true; static constexpr int SEG = 0;
    const float* base; float* out; bf16_t* xn; int ldc; const float* bias; PanelStats st1, st2; unsigned poison;
    __device__ __forceinline__ void fused(f32x4 (&acc)[2][2][4][2], const Unit& u, int wr, int wc, int fr, int fq, PG8_LAS unsigned char* lds, int wid, int lane) const {
        typedef float f32x2v __attribute__((ext_vector_type(2))); typedef unsigned u32x2v __attribute__((ext_vector_type(2)));
        const PG8_LAS f32x2v* S = (const PG8_LAS f32x2v*)(lds + 8192);
        const int col0 = u.pn * BM + wc * 32 + 4 * fq;
#pragma unroll
        for (int bj = 0; bj < 2; ++bj)
#pragma unroll
            for (int n = 0; n < 2; ++n) { const f32x4 bv = bias ? *(const f32x4*)(bias + col0 + bj * HALF + n * 16) : (f32x4){0.f, 0.f, 0.f, 0.f};
#pragma unroll
                for (int ai = 0; ai < 2; ++ai)
#pragma unroll
                    for (int m = 0; m < 4; ++m) acc[ai][bj][m][n] += bv; }
        bool bad = st1.run(acc, u, wr, wc, fr, fq, lds, wid, lane) || poison != 0u;
        const float qnan = __builtin_nanf("");
#pragma unroll
        for (int ai = 0; ai < 2; ++ai)
#pragma unroll
            for (int m = 0; m < 4; ++m) { const int r = ai * HALF + wr * 64 + m * 16 + fr; const f32x2v sr = S[r]; const size_t off = (size_t)(u.pm * BM + r) * ldc + col0;
#pragma unroll
                for (int bj = 0; bj < 2; ++bj)
#pragma unroll
                    for (int n = 0; n < 2; ++n) { const f32x4 bs = *(const f32x4*)(base + off + bj * HALF + n * 16); acc[ai][bj][m][n] = bs + (acc[ai][bj][m][n] - sr.x) * sr.y; }
                asm volatile("" : "+v"(acc[ai][0][m][0]), "+v"(acc[ai][0][m][1]), "+v"(acc[ai][1][m][0]), "+v"(acc[ai][1][m][1]));
                if (m & 1) asm volatile("" ::: "memory"); }
        const bool bad1 = bad;
        bad = st2.run(acc, u, wr, wc, fr, fq, lds, wid, lane) || bad;
#pragma unroll
        for (int ai = 0; ai < 2; ++ai)
#pragma unroll
            for (int m = 0; m < 4; ++m) { const int r = ai * HALF + wr * 64 + m * 16 + fr; const f32x2v sr = S[r]; const size_t off = (size_t)(u.pm * BM + r) * ldc + col0;
#pragma unroll
                for (int bj = 0; bj < 2; ++bj)
#pragma unroll
                    for (int n = 0; n < 2; ++n) { const f32x4 x1 = acc[ai][bj][m][n]; *(f32x4*)(out + off + bj * HALF + n * 16) = bad1 ? (f32x4){qnan, qnan, qnan, qnan} : x1;
                        const f32x4 o = (x1 - sr.x) * sr.y; u32x2v w; w.x = cvt_pk_bf16(o[0], o[1]); w.y = cvt_pk_bf16(o[2], o[3]);
                        if (bad) { w.x = 0x7fc07fc0u; w.y = 0x7fc07fc0u; } *(u32x2v*)(xn + off + bj * HALF + n * 16) = w; }
                asm volatile("" ::: "memory"); }
    }
};

template <class Epi, class Sched, bool ALIGN_EPI = false, bool SP2 = false, bool GATHER = false, bool FP8 = false>
__device__ __forceinline__ void gemm_phase(PG8_LAS unsigned char* lds, const Gemm g, const Sched& S, const Epi& E) {
    int tid_ = threadIdx.x; asm volatile("" : "+v"(tid_));
    const int tid = tid_, wid = __builtin_amdgcn_readfirstlane(tid >> 6), lane = tid & 63, wr = wid >> 2, wc = wid & 3, fr = lane & 15, fq = lane >> 4;
    int K_ = g.K; asm volatile("" : "+s"(K_));
    const int K = K_, nt = K / BK;
    unsigned voffA[2], voffB[2];
#pragma unroll
    for (int i = 0; i < 2; ++i) { int R, C; stage_rc(tid * 16 + i * 8192, R, C); const int Rb = Epi::PERM ? ((R & ~31) + perm32(R & 31)) : R;
        voffA[i] = (unsigned)(R * g.lda + C) * 2u; voffB[i] = (unsigned)(Rb * K + C) * 2u; }
    const size_t kstep = (size_t)(BK * 2);
    static_assert(!GATHER || SP2, "GATHER is implemented for the SP2 loop");
    const size_t hstepB = (size_t)HALF * K * 2, hstepA = GATHER ? 0 : (size_t)HALF * g.lda * 2;
    const size_t tstepB = 2 * hstepB, tstepA = GATHER ? 0 : 2 * hstepA;
    const unsigned ldsw = (unsigned)wid * 1024u;
    const int aoffk[2] = {lds_byte(wr * 64 + fr, FP8 ? 16 * fq : 8 * fq), lds_byte(wr * 64 + fr, FP8 ? 16 * fq + 8 : 8 * fq + 32)};
    const int boffk[2] = {lds_byte(wc * 32 + fr, FP8 ? 16 * fq : 8 * fq), lds_byte(wc * 32 + fr, FP8 ? 16 * fq + 8 : 8 * fq + 32)};
#define PG8_SA(b, h) (((b) * 2 + (h)) * HTB)
#define PG8_SB(b, h) ((4 + (b) * 2 + (h)) * HTB)
#define PG8_STAGE(bufoff, gbase, voff) do { _Pragma("unroll") for (int _i = 0; _i < 2; ++_i) \
        __builtin_amdgcn_global_load_lds((const unsigned*)((const char*)(gbase) + (voff)[_i]), (PG8_LAS unsigned*)(lds + (bufoff) + ldsw + _i * 8192), 16, 0, 0); } while (0)
    typedef int i32x4_ __attribute__((ext_vector_type(4))); typedef int i32x8_ __attribute__((ext_vector_type(8)));
#define PG8_LD16(off) (*(const PG8_LAS i32x4_*)(lds + (off)))
#define PG8_LDA(dst, b, h) do { _Pragma("unroll") for (int m = 0; m < 4; ++m) { \
        if constexpr (FP8) dst##8[m] = *(const PG8_LAS i32x8_*)(lds + PG8_SA(b, h) + aoffk[0] + m * 2048);     \
        else { _Pragma("unroll") for (int k = 0; k < 2; ++k) dst[m][k] = *(const PG8_LAS bf16x8*)(lds + PG8_SA(b, h) + aoffk[k] + m * 2048); } } } while (0)
#define PG8_LDB(dst, b, h) do { _Pragma("unroll") for (int n = 0; n < 2; ++n) { \
        if constexpr (FP8) dst##8[n] = *(const PG8_LAS i32x8_*)(lds + PG8_SB(b, h) + boffk[0] + n * 2048); \
        else { _Pragma("unroll") for (int k = 0; k < 2; ++k) dst[n][k] = *(const PG8_LAS bf16x8*)(lds + PG8_SB(b, h) + boffk[k] + n * 2048); } } } while (0)
#define PG8_MMA(ai, bj, At, Bt) do { __builtin_amdgcn_s_setprio(1); _Pragma("unroll") for (int m = 0; m < 4; ++m) _Pragma("unroll") for (int n = 0; n < 2; ++n) { \
        if constexpr (FP8) asm volatile("s_nop 1\n\tv_mfma_scale_f32_16x16x128_f8f6f4 %0, %1, %2, %0, %3, %3 op_sel_hi:[0,0,0]" : "+v"(acc[ai][bj][m][n]) : "v"(Bt##8[n]), "v"(At##8[m]), "v"(sc1_));     \
        else { _Pragma("unroll") for (int k = 0; k < 2; ++k) acc[ai][bj][m][n] = __builtin_amdgcn_mfma_f32_16x16x32_bf16(Bt[n][k], At[m][k], acc[ai][bj][m][n], 0, 0, 0); } } \
        __builtin_amdgcn_s_setprio(0); } while (0)
#define PG8_WAIT_V(n) asm volatile("s_waitcnt vmcnt(" #n ")" ::: "memory")
#define PG8_WAIT_L(n) asm volatile("s_waitcnt lgkmcnt(" #n ")" ::: "memory")
#define PG8_BAR __builtin_amdgcn_s_barrier()
#define PG8_SCHED __builtin_amdgcn_sched_barrier(0)
    Unit cur, nxt; int ui = 0;
    if (!S.next(0, cur)) return;
    unsigned vC0[2] = {voffA[0], voffA[1]}, vC1[2] = {voffA[0], voffA[1]}, vN0[2] = {voffA[0], voffA[1]}, vN1[2] = {voffA[0], voffA[1]};
    int gR[2], gC[2];
#pragma unroll
    for (int i = 0; i < 2; ++i) { stage_rc(tid * 16 + i * 8192, gR[i], gC[i]); }
    if constexpr (GATHER) {
#pragma unroll
        for (int i = 0; i < 2; ++i) { vC0[i] = (unsigned)(g.ridx[cur.pm * 256 + gR[i]] * g.lda + gC[i]) * 2u; vC1[i] = (unsigned)(g.ridx[cur.pm * 256 + 128 + gR[i]] * g.lda + gC[i]) * 2u; }
    }
    f32x4 acc[2][2][4][2];
#pragma unroll
    for (int a = 0; a < 2; ++a)
#pragma unroll
        for (int b = 0; b < 2; ++b)
#pragma unroll
            for (int m = 0; m < 4; ++m)
#pragma unroll
                for (int n = 0; n < 2; ++n) acc[a][b][m][n] = (f32x4){0.f, 0.f, 0.f, 0.f};
    const int sc1_ = 0x7f7f7f7f;
    bf16x8 At[4][2], B0[2][2], B1[2][2]; i32x8_ At8[4], B08[2], B18[2];
    const char* cA = (const char*)g.A + (size_t)cur.pm * tstepA; const char* cB = (const char*)g.Bt + (size_t)cur.pn * tstepB;
    S.a_ready(cur);
    if constexpr (SP2) {
        PG8_STAGE(PG8_SB(0, 0), cB, voffB); PG8_STAGE(PG8_SB(0, 1), cB + hstepB, voffB); PG8_STAGE(PG8_SA(0, 0), cA, vC0); PG8_STAGE(PG8_SA(0, 1), cA + hstepA, vC1);
        if (wr == 1) PG8_BAR;
        PG8_WAIT_V(2); PG8_BAR;
        PG8_STAGE(PG8_SB(1, 0), cB + kstep, voffB); PG8_STAGE(PG8_SA(1, 0), cA + kstep, vC0); PG8_STAGE(PG8_SB(1, 1), cB + hstepB + kstep, voffB);
        PG8_WAIT_V(6); PG8_BAR;
    } else {
        PG8_STAGE(PG8_SB(0, 0), cB, voffB); PG8_STAGE(PG8_SA(0, 0), cA, voffA); PG8_STAGE(PG8_SB(0, 1), cB + hstepB, voffB); PG8_STAGE(PG8_SA(0, 1), cA + hstepA, voffA);
        if (wr == 1) PG8_BAR;
        PG8_WAIT_V(4); PG8_BAR;
        PG8_STAGE(PG8_SB(1, 0), cB + kstep, voffB); PG8_STAGE(PG8_SA(1, 0), cA + kstep, voffA); PG8_STAGE(PG8_SB(1, 1), cB + hstepB + kstep, voffB);
        PG8_WAIT_V(6); PG8_BAR;
    }
    for (;;) {
        const bool has_next = S.next(ui + 1, nxt);
        int gi0[2] = {0, 0}, gi1[2] = {0, 0};
        if constexpr (GATHER) { if (has_next) {
#pragma unroll
            for (int i = 0; i < 2; ++i) { gi0[i] = g.ridx[nxt.pm * 256 + gR[i]]; gi1[i] = g.ridx[nxt.pm * 256 + 128 + gR[i]]; } } }
        const char* nA = has_next ? (const char*)g.A + (size_t)nxt.pm * tstepA : cA; const char* nB = has_next ? (const char*)g.Bt + (size_t)nxt.pn * tstepB : cB;
        for (int t = 0; t < nt; t += 2) {
            const bool last = (t == nt - 2);
            const char* a1 = cA + (size_t)(t + 1) * kstep;
            const char* a2 = last ? nA : cA + (size_t)(t + 2) * kstep; const char* b2 = last ? nB : cB + (size_t)(t + 2) * kstep;
            const char* a3 = a2 + kstep; const char* b3 = b2 + kstep;
            if (last && has_next) S.a_ready(nxt);
            unsigned v20[2] = {vC0[0], vC0[1]}, v21[2] = {vC1[0], vC1[1]};
            if constexpr (GATHER) { if (last && has_next) {
#pragma unroll
                for (int i = 0; i < 2; ++i) { vN0[i] = (unsigned)(gi0[i] * g.lda + gC[i]) * 2u; vN1[i] = (unsigned)(gi1[i] * g.lda + gC[i]) * 2u; v20[i] = vN0[i]; v21[i] = vN1[i]; } } }
            if constexpr (SP2) {
            PG8_LDB(B0, 0, 0); PG8_LDB(B1, 0, 1); PG8_SCHED; PG8_LDA(At, 0, 0); PG8_STAGE(PG8_SA(1, 1), a1 + hstepA, vC1);
            PG8_WAIT_V(8); PG8_WAIT_L(0); PG8_BAR; PG8_MMA(0, 0, At, B0); PG8_MMA(0, 1, At, B1); PG8_BAR; PG8_SCHED;
            PG8_LDA(At, 0, 1); PG8_STAGE(PG8_SB(0, 0), b2, voffB); PG8_STAGE(PG8_SB(0, 1), b2 + hstepB, voffB); PG8_STAGE(PG8_SA(0, 0), a2, v20);
            PG8_WAIT_V(8); PG8_WAIT_L(0); PG8_BAR; PG8_MMA(1, 0, At, B0); PG8_MMA(1, 1, At, B1); PG8_BAR; PG8_SCHED;
            PG8_LDB(B0, 1, 0); PG8_LDB(B1, 1, 1); PG8_SCHED; PG8_LDA(At, 1, 0); PG8_STAGE(PG8_SA(0, 1), a2 + hstepA, v21);
            PG8_WAIT_V(8); PG8_WAIT_L(0); PG8_BAR; PG8_MMA(0, 0, At, B0); PG8_MMA(0, 1, At, B1); PG8_BAR; PG8_SCHED;
            PG8_LDA(At, 1, 1); PG8_STAGE(PG8_SB(1, 0), b3, voffB); PG8_STAGE(PG8_SB(1, 1), b3 + hstepB, voffB); PG8_STAGE(PG8_SA(1, 0), a3, v20);
            PG8_WAIT_V(8); PG8_WAIT_L(0); PG8_BAR; PG8_MMA(1, 0, At, B0); PG8_MMA(1, 1, At, B1); PG8_BAR; PG8_SCHED;
            if constexpr (Epi::SEG > 0) { if ((t + 2) % Epi::SEG == 0 && t + 2 < nt) E.segment(acc, cur, (t + 2) / Epi::SEG, wr, wc, fr, fq); }
            } else {
            PG8_LDB(B0, 0, 0); PG8_SCHED; PG8_LDA(At, 0, 0); PG8_STAGE(PG8_SA(1, 1), a1 + hstepA, voffA);
            PG8_WAIT_L(8); PG8_BAR; PG8_WAIT_L(0); PG8_MMA(0, 0, At, B0); PG8_BAR; PG8_SCHED;
            PG8_LDB(B1, 0, 1); PG8_STAGE(PG8_SB(0, 0), b2, voffB);
            PG8_BAR; PG8_WAIT_L(0); PG8_MMA(0, 1, At, B1); PG8_BAR;
            PG8_LDA(At, 0, 1); PG8_STAGE(PG8_SA(0, 0), a2, voffA);
            PG8_BAR; PG8_WAIT_L(0); PG8_MMA(1, 0, At, B0); PG8_BAR; PG8_SCHED;
            PG8_STAGE(PG8_SB(0, 1), b2 + hstepB, voffB);
            PG8_WAIT_V(6); PG8_BAR; PG8_MMA(1, 1, At, B1); PG8_BAR;
            PG8_LDB(B0, 1, 0); PG8_SCHED; PG8_LDA(At, 1, 0); PG8_STAGE(PG8_SA(0, 1), a2 + hstepA, voffA);
            PG8_WAIT_L(8); PG8_BAR; PG8_WAIT_L(0); PG8_MMA(0, 0, At, B0); PG8_BAR; PG8_SCHED;
            PG8_LDB(B1, 1, 1); PG8_STAGE(PG8_SB(1, 0), b3, voffB);
            PG8_BAR; PG8_WAIT_L(0); PG8_MMA(0, 1, At, B1); PG8_BAR;
            PG8_LDA(At, 1, 1); PG8_STAGE(PG8_SA(1, 0), a3, voffA);
            PG8_BAR; PG8_WAIT_L(0); PG8_MMA(1, 0, At, B0); PG8_BAR; PG8_SCHED;
            PG8_STAGE(PG8_SB(1, 1), b3 + hstepB, voffB);
            PG8_WAIT_V(6); PG8_BAR; PG8_MMA(1, 1, At, B1); PG8_BAR;
            }
        }
        if constexpr (FP8) asm volatile("s_nop 15\n\ts_nop 3" ::: "memory");
        if constexpr (ALIGN_EPI) { if (wr == 0) PG8_BAR; }
        if constexpr (!Epi::AFTER_DRAIN) { E(acc, cur, wr, wc, fr, fq); S.done(cur); }
        if (!has_next) break;
#pragma unroll
        for (int a = 0; a < 2; ++a)
#pragma unroll
            for (int b = 0; b < 2; ++b)
#pragma unroll
                for (int m = 0; m < 4; ++m)
#pragma unroll
                    for (int n = 0; n < 2; ++n) acc[a][b][m][n] = (f32x4){0.f, 0.f, 0.f, 0.f};
        cur = nxt; cA = nA; cB = nB; ++ui;
        if constexpr (GATHER) { vC0[0] = vN0[0]; vC0[1] = vN0[1]; vC1[0] = vN1[0]; vC1[1] = vN1[1]; }
        if constexpr (ALIGN_EPI) { if (wr == 1) PG8_BAR; }
    }
    PG8_WAIT_V(0);
    if constexpr (!ALIGN_EPI) { if (wr == 0) PG8_BAR; }
    PG8_BAR;
    if constexpr (Epi::AFTER_DRAIN) { E.fused(acc, cur, wr, wc, fr, fq, lds, wid, lane); S.done(cur); }
#undef PG8_SA
#undef PG8_SB
#undef PG8_STAGE
#undef PG8_LDA
#undef PG8_LD16
#undef PG8_LDB
#undef PG8_MMA
#undef PG8_WAIT_V
#undef PG8_WAIT_L
#undef PG8_BAR
#undef PG8_SCHED
}
}

typedef unsigned short bf16_t;
__device__ __forceinline__ unsigned pk4_fp8(float a, float b, float c, float d) { unsigned w = 0u; w = __builtin_amdgcn_cvt_pk_fp8_f32(a, b, w, false); w = __builtin_amdgcn_cvt_pk_fp8_f32(c, d, w, true); return w; }
constexpr float F8_WGU = 64.f, F8_WD = 128.f, F8_HID = 4.f;
typedef unsigned u32x4_t __attribute__((ext_vector_type(4)));
__device__ __forceinline__ void ldg8_dw(float (&o)[8], const void* base, const unsigned (&off)[8]) {
    asm volatile("global_load_dword %0, %9, %8\n\tglobal_load_dword %1, %10, %8\n\tglobal_load_dword %2, %11, %8\n\tglobal_load_dword %3, %12, %8\n\t"
                 "global_load_dword %4, %13, %8\n\tglobal_load_dword %5, %14, %8\n\tglobal_load_dword %6, %15, %8\n\tglobal_load_dword %7, %16, %8\n\ts_waitcnt vmcnt(0)"
                 : "=&v"(o[0]), "=&v"(o[1]), "=&v"(o[2]), "=&v"(o[3]), "=&v"(o[4]), "=&v"(o[5]), "=&v"(o[6]), "=&v"(o[7])
                 : "s"(base), "v"(off[0]), "v"(off[1]), "v"(off[2]), "v"(off[3]), "v"(off[4]), "v"(off[5]), "v"(off[6]), "v"(off[7]) : "memory");
}
template <int I1, int I2, int I3>
__device__ __forceinline__ void ldg8_x4(u32x4_t (&a)[4], u32x4_t (&b)[4], const void* base, unsigned offA, unsigned offB) {
    asm volatile("global_load_dwordx4 %0, %9, %8\n\tglobal_load_dwordx4 %1, %9, %8 offset:%11\n\tglobal_load_dwordx4 %2, %9, %8 offset:%12\n\tglobal_load_dwordx4 %3, %9, %8 offset:%13\n\t"
                 "global_load_dwordx4 %4, %10, %8\n\tglobal_load_dwordx4 %5, %10, %8 offset:%11\n\tglobal_load_dwordx4 %6, %10, %8 offset:%12\n\tglobal_load_dwordx4 %7, %10, %8 offset:%13\n\ts_waitcnt vmcnt(0)"
                 : "=&v"(a[0]), "=&v"(a[1]), "=&v"(a[2]), "=&v"(a[3]), "=&v"(b[0]), "=&v"(b[1]), "=&v"(b[2]), "=&v"(b[3])
                 : "s"(base), "v"(offA), "v"(offB), "i"(I1), "i"(I2), "i"(I3) : "memory");
}
__device__ __forceinline__ void ldg8_x4v(u32x4_t (&o)[8], const void* base, const unsigned (&off)[8]) {
    asm volatile("global_load_dwordx4 %0, %9, %8\n\tglobal_load_dwordx4 %1, %10, %8\n\tglobal_load_dwordx4 %2, %11, %8\n\tglobal_load_dwordx4 %3, %12, %8\n\t"
                 "global_load_dwordx4 %4, %13, %8\n\tglobal_load_dwordx4 %5, %14, %8\n\tglobal_load_dwordx4 %6, %15, %8\n\tglobal_load_dwordx4 %7, %16, %8\n\ts_waitcnt vmcnt(0)"
                 : "=&v"(o[0]), "=&v"(o[1]), "=&v"(o[2]), "=&v"(o[3]), "=&v"(o[4]), "=&v"(o[5]), "=&v"(o[6]), "=&v"(o[7])
                 : "s"(base), "v"(off[0]), "v"(off[1]), "v"(off[2]), "v"(off[3]), "v"(off[4]), "v"(off[5]), "v"(off[6]), "v"(off[7]) : "memory");
}
template <int I1, int I2, int I3>
__device__ __forceinline__ void ldg4_x4(u32x4_t (&a)[4], const void* base, unsigned off) {
    asm volatile("global_load_dwordx4 %0, %5, %4\n\tglobal_load_dwordx4 %1, %5, %4 offset:%6\n\tglobal_load_dwordx4 %2, %5, %4 offset:%7\n\tglobal_load_dwordx4 %3, %5, %4 offset:%8\n\ts_waitcnt vmcnt(0)"
                 : "=&v"(a[0]), "=&v"(a[1]), "=&v"(a[2]), "=&v"(a[3]) : "s"(base), "v"(off), "i"(I1), "i"(I2), "i"(I3) : "memory");
}
__device__ __forceinline__ void bf8_to_f32(const u32x4_t w, float* o) {
    o[0] = __uint_as_float(w.x << 16); o[1] = __uint_as_float(w.x & 0xffff0000u); o[2] = __uint_as_float(w.y << 16); o[3] = __uint_as_float(w.y & 0xffff0000u);
    o[4] = __uint_as_float(w.z << 16); o[5] = __uint_as_float(w.z & 0xffff0000u); o[6] = __uint_as_float(w.w << 16); o[7] = __uint_as_float(w.w & 0xffff0000u);
}
struct ExpertOrder1 {
    int G, v;
    __device__ void init(int G_, int c) { G = G_; v = (G_ % 8 == 0) ? (c % 8) * (G_ / 8) + c / 8 : c; }
    __device__ bool next(int i, pg8::Unit& u) const { const int L = i * G + v; if (L >= 2048) return false; const int e = L >> 7, r = L & 127; u.pm = e * 8 + (r & 7); u.pn = e * 16 + (r >> 3); return true; }
    __device__ __forceinline__ void a_ready(const pg8::Unit&) const {}
    __device__ __forceinline__ void done(const pg8::Unit&) const {}
};
struct ExpertOrder2 {
    int G, v;
    __device__ void init(int G_, int c) { G = G_; v = (G_ % 8 == 0) ? (c % 8) * (G_ / 8) + c / 8 : c; }
    __device__ bool next(int i, pg8::Unit& u) const { const int L = i * G + v; if (L >= 512) return false; const int e = L >> 5, r = L & 31; u.pm = e * 8 + (r & 7); u.pn = e * 4 + (r >> 3); return true; }
    __device__ __forceinline__ void a_ready(const pg8::Unit&) const {}
    __device__ __forceinline__ void done(const pg8::Unit&) const {}
};
__device__ __forceinline__ float silu_fast(float x) { return x * __builtin_amdgcn_rcpf(1.f + __builtin_amdgcn_exp2f(-1.4426950408889634f * x)); }
struct EpiSwiGLU {
    static constexpr bool PERM = true, AFTER_DRAIN = false; static constexpr int SEG = 0;
    bf16_t* O; int ldc;
    __device__ __forceinline__ void operator()(const pg8::f32x4 (&acc)[2][2][4][2], const pg8::Unit& u, int wr, int wc, int fr, int fq) const {
        int row0 = u.pm * 256 + wr * 64 + fr; asm volatile("" : "+v"(row0)); const int col0 = (u.pn & 15) * 128 + wc * 32 + 8 * fq;
#pragma unroll
        for (int ai = 0; ai < 2; ++ai)
#pragma unroll
            for (int m = 0; m < 4; ++m) {
                const pg8::f32x4 g0 = acc[ai][0][m][0], g1 = acc[ai][0][m][1], u0 = acc[ai][1][m][0], u1 = acc[ai][1][m][1];
                constexpr float IG = 1.f / F8_WGU, HS = F8_HID / F8_WGU;
                const unsigned w0 = pk4_fp8(silu_fast(g0[0] * IG) * u0[0] * HS, silu_fast(g0[1] * IG) * u0[1] * HS, silu_fast(g0[2] * IG) * u0[2] * HS, silu_fast(g0[3] * IG) * u0[3] * HS);
                const unsigned w1 = pk4_fp8(silu_fast(g1[0] * IG) * u1[0] * HS, silu_fast(g1[1] * IG) * u1[1] * HS, silu_fast(g1[2] * IG) * u1[2] * HS, silu_fast(g1[3] * IG) * u1[3] * HS);
                *(uint2*)((unsigned char*)O + (size_t)(row0 + ai * 128 + m * 16) * ldc + col0) = make_uint2(w0, w1);
            }
    }
};
struct EpiProj {
    static constexpr bool PERM = true, AFTER_DRAIN = false; static constexpr int SEG = 0;
    bf16_t* O; const float* bias;
    __device__ __forceinline__ void operator()(const pg8::f32x4 (&acc)[2][2][4][2], const pg8::Unit& u, int wr, int wc, int fr, int fq) const {
        int row0 = u.pm * 256 + wr * 64 + fr; asm volatile("" : "+v"(row0)); const int col0 = u.pn * 256 + wc * 32 + 8 * fq; const bool gate = u.pn < 12; constexpr float L2E = 1.4426950408889634f;
        float bias8[2][8];
        if (gate) { u32x4_t t0[4], t1[4]; const unsigned o0 = (unsigned)col0 * 4u; ldg8_x4<16, 512, 528>(t0, t1, bias, o0, o0);
#pragma unroll
            for (int q = 0; q < 4; ++q) { bias8[0][q] = __uint_as_float(t0[0][q]); bias8[0][4 + q] = __uint_as_float(t0[1][q]); bias8[1][q] = __uint_as_float(t0[2][q]); bias8[1][4 + q] = __uint_as_float(t0[3][q]); } }
#pragma unroll
        for (int bj = 0; bj < 2; ++bj) {
            float b[8];
#pragma unroll
            for (int q = 0; q < 8; ++q) b[q] = gate ? bias8[bj][q] : 0.f;
#pragma unroll
            for (int ai = 0; ai < 2; ++ai)
#pragma unroll
                for (int m = 0; m < 4; ++m) { float v[8];
#pragma unroll
                    for (int q = 0; q < 8; ++q) { const float x = acc[ai][bj][m][q >> 2][q & 3]; v[q] = gate ? __builtin_amdgcn_rcpf(1.f + __builtin_amdgcn_exp2f(-(x + b[q]) * L2E)) : x; }
                    pg8::u32x4 w; w.x = pg8::cvt_pk_bf16(v[0], v[1]); w.y = pg8::cvt_pk_bf16(v[2], v[3]); w.z = pg8::cvt_pk_bf16(v[4], v[5]); w.w = pg8::cvt_pk_bf16(v[6], v[7]);
                    *(pg8::u32x4*)(O + (size_t)(row0 + ai * 128 + m * 16) * DINP + col0 + bj * 128) = w; } }
    }
};
struct EpiQ {
    static constexpr bool PERM = false, AFTER_DRAIN = false; static constexpr int SEG = 0;
    bf16_t* Q; const float* rq; const float* rc; const float* rs;
    __device__ __forceinline__ void operator()(const pg8::f32x4 (&acc)[2][2][4][2], const pg8::Unit& u, int wr, int wc, int fr, int fq) const {
        int row0 = u.pm * 256 + wr * 64 + fr; asm volatile("" : "+v"(row0)); constexpr float SC = 0.10206207261596575f * 1.4426950408889634f;
        float sc8[8]; { unsigned off[8];
#pragma unroll
            for (int i = 0; i < 8; ++i) off[i] = (unsigned)(row0 + (i >> 2) * 128 + (i & 3) * 16) * 4u;
            ldg8_dw(sc8, rq, off); }
#pragma unroll
        for (int bj = 0; bj < 2; ++bj) { const int g32 = u.pn * 8 + bj * 4 + wc, col0 = g32 * 32 + 4 * fq; const bool rope = (g32 % 3) == 2;
#pragma unroll
            for (int ai = 0; ai < 2; ++ai) {
                u32x4_t cs4[4], sn4[4];
                if (rope) { u32x4_t t0[4], t1[4];
                    const unsigned o0 = (unsigned)((row0 + ai * 128) * 16 + 4 * fq) * 4u;
                    ldg8_x4<16 * 16 * 4, 32 * 16 * 4, 48 * 16 * 4>(t0, t1, rc, o0, o0 + (unsigned)(T * 16 * 4));
#pragma unroll
                    for (int m = 0; m < 4; ++m) { cs4[m] = t0[m]; sn4[m] = t1[m]; } }
#pragma unroll
                for (int m = 0; m < 4; ++m) { const int row = row0 + ai * 128 + m * 16; const float s = sc8[ai * 4 + m] * SC;
                    pg8::f32x4 v0 = acc[ai][bj][m][0] * s, v1 = acc[ai][bj][m][1] * s;
                    if (rope) { const pg8::f32x4 c4 = __builtin_bit_cast(pg8::f32x4, cs4[m]), s4 = __builtin_bit_cast(pg8::f32x4, sn4[m]);
                        const pg8::f32x4 x1 = v0, x2 = v1; v0 = x1 * c4 - x2 * s4; v1 = x1 * s4 + x2 * c4; }
                    bf16_t* qp = Q + (size_t)row * 768 + col0;
                    *(uint2*)qp = make_uint2(pg8::cvt_pk_bf16(v0[0], v0[1]), pg8::cvt_pk_bf16(v0[2], v0[3]));
                    *(uint2*)(qp + 16) = make_uint2(pg8::cvt_pk_bf16(v1[0], v1[1]), pg8::cvt_pk_bf16(v1[2], v1[3])); } } }
    }
};
struct EpiKV {
    static constexpr bool PERM = true, AFTER_DRAIN = false; static constexpr int SEG = 0;
    bf16_t* K; bf16_t* V; const float* rkv;
    __device__ __forceinline__ void operator()(const pg8::f32x4 (&acc)[2][2][4][2], const pg8::Unit& u, int wr, int wc, int fr, int fq) const {
        int row0 = u.pm * 256 + wr * 64 + fr; asm volatile("" : "+v"(row0));
        float sc8[8]; { unsigned off[8];
#pragma unroll
            for (int i = 0; i < 8; ++i) off[i] = (unsigned)(row0 + (i >> 2) * 128 + (i & 3) * 16) * 4u;
            ldg8_dw(sc8, rkv, off); }
#pragma unroll
        for (int bj = 0; bj < 2; ++bj) { const int head = u.pn * 2 + bj;
#pragma unroll
            for (int ai = 0; ai < 2; ++ai)
#pragma unroll
                for (int m = 0; m < 4; ++m) { const int row = row0 + ai * 128 + m * 16; const float s = sc8[ai * 4 + m];
                    const pg8::f32x4 v0 = acc[ai][bj][m][0] * s, v1 = acc[ai][bj][m][1] * s; pg8::u32x4 w;
                    w.x = pg8::cvt_pk_bf16(v0[0], v0[1]); w.y = pg8::cvt_pk_bf16(v0[2], v0[3]); w.z = pg8::cvt_pk_bf16(v1[0], v1[1]); w.w = pg8::cvt_pk_bf16(v1[2], v1[3]);
                    bf16_t* dst = (wc < 2) ? K + (size_t)row * 768 + head * 96 + wc * 32 + 8 * fq : V + (size_t)row * 512 + head * 64 + (wc - 2) * 32 + 8 * fq;
                    *(pg8::u32x4*)dst = w; } }
    }
};
struct EpiF32 {
    static constexpr bool PERM = true, AFTER_DRAIN = false; static constexpr int SEG = 0;
    float* O; int ldc; const float* rs;
    __device__ __forceinline__ void operator()(const pg8::f32x4 (&acc)[2][2][4][2], const pg8::Unit& u, int wr, int wc, int fr, int fq) const {
        int row0 = u.pm * 256 + wr * 64 + fr; asm volatile("" : "+v"(row0)); const int col0 = u.pn * 256 + wc * 32 + 8 * fq;
#pragma unroll
        for (int ai = 0; ai < 2; ++ai)
#pragma unroll
            for (int m = 0; m < 4; ++m) { const int row = row0 + ai * 128 + m * 16; const float s = rs ? rs[row] : 1.f;
#pragma unroll
                for (int bj = 0; bj < 2; ++bj) { float* op = O + (size_t)row * ldc + col0 + bj * 128;
                    *(pg8::f32x4*)op = acc[ai][bj][m][0] * s; *(pg8::f32x4*)(op + 4) = acc[ai][bj][m][1] * s; } }
    }
};
struct EpiMerge {
    static constexpr bool PERM = true, AFTER_DRAIN = false; static constexpr int SEG = 8;
    bf16_t* O; const bf16_t* GL;
    static __device__ __forceinline__ void ld8(const bf16_t* p, float* o) { const uint4 w = *(const uint4*)p;
        o[0] = __uint_as_float(w.x << 16); o[1] = __uint_as_float(w.x & 0xffff0000u); o[2] = __uint_as_float(w.y << 16); o[3] = __uint_as_float(w.y & 0xffff0000u);
        o[4] = __uint_as_float(w.z << 16); o[5] = __uint_as_float(w.z & 0xffff0000u); o[6] = __uint_as_float(w.w << 16); o[7] = __uint_as_float(w.w & 0xffff0000u); }
    __device__ __forceinline__ void segment(pg8::f32x4 (&acc)[2][2][4][2], const pg8::Unit& u, int seg, int wr, int wc, int fr, int fq) const {
        int row0 = u.pm * 256 + wr * 64 + fr; asm volatile("" : "+v"(row0));
        const unsigned cb = (unsigned)((seg - 1) * 1024 + u.pn * 256 + wc * 32 + 8 * fq) * 2u;
#pragma unroll
        for (int ai = 0; ai < 2; ++ai)
#pragma unroll
            for (int m = 0; m < 4; ++m) {
                u32x4_t ga[4];
                ldg4_x4<2048, 256, 2304>(ga, GL, (unsigned)(row0 + ai * 128 + m * 16) * (unsigned)(DINP * 2) + cb);
#pragma unroll
                for (int bj = 0; bj < 2; ++bj) { float x0[8], x1[8]; bf8_to_f32(ga[bj * 2], x0); bf8_to_f32(ga[bj * 2 + 1], x1);
#pragma unroll
                    for (int q = 0; q < 8; ++q) acc[ai][bj][m][q >> 2][q & 3] *= x0[q] * __builtin_amdgcn_rcpf(x1[q]); } }
    }
    __device__ __forceinline__ void operator()(const pg8::f32x4 (&acc)[2][2][4][2], const pg8::Unit& u, int wr, int wc, int fr, int fq) const {
        int row0 = u.pm * 256 + wr * 64 + fr; asm volatile("" : "+v"(row0)); const int col0 = u.pn * 256 + wc * 32 + 8 * fq;
        const unsigned cb = (unsigned)(2048 + col0) * 2u;
#pragma unroll
        for (int ai = 0; ai < 2; ++ai) {
            u32x4_t g8[8];
            { unsigned off[8];
#pragma unroll
              for (int i = 0; i < 8; ++i) off[i] = (unsigned)(row0 + ai * 128 + (i & 3) * 16) * (unsigned)(DINP * 2) + cb + (i >> 2) * 256u;
              ldg8_x4v(g8, GL, off); }
#pragma unroll
            for (int m = 0; m < 4; ++m) { const int row = row0 + ai * 128 + m * 16;
#pragma unroll
                for (int bj = 0; bj < 2; ++bj) { float x2[8], v[8]; bf8_to_f32(g8[bj * 4 + m], x2);
#pragma unroll
                    for (int q = 0; q < 8; ++q) v[q] = acc[ai][bj][m][q >> 2][q & 3] * x2[q];
                    pg8::u32x4 w; w.x = pg8::cvt_pk_bf16(v[0], v[1]); w.y = pg8::cvt_pk_bf16(v[2], v[3]); w.z = pg8::cvt_pk_bf16(v[4], v[5]); w.w = pg8::cvt_pk_bf16(v[6], v[7]);
                    *(pg8::u32x4*)(O + (size_t)row * DM + col0 + bj * 128) = w; } } }
    }
};
struct EpiRowScale {
    static constexpr bool PERM = true, AFTER_DRAIN = false; static constexpr int SEG = 0;
    bf16_t* O; int ldc; const float* rs;
    __device__ __forceinline__ void operator()(const pg8::f32x4 (&acc)[2][2][4][2], const pg8::Unit& u, int wr, int wc, int fr, int fq) const {
        int row0 = u.pm * 256 + wr * 64 + fr; asm volatile("" : "+v"(row0)); const int col0 = (u.pn & 3) * 256 + wc * 32 + 8 * fq;
        float sc8[8]; { unsigned off[8];
#pragma unroll
            for (int i = 0; i < 8; ++i) off[i] = (unsigned)(row0 + (i >> 2) * 128 + (i & 3) * 16) * 4u;
            ldg8_dw(sc8, rs, off); }
#pragma unroll
        for (int ai = 0; ai < 2; ++ai)
#pragma unroll
            for (int m = 0; m < 4; ++m) { const int row = row0 + ai * 128 + m * 16; const float s = sc8[ai * 4 + m] * (1.f / (F8_WD * F8_HID));
#pragma unroll
                for (int bj = 0; bj < 2; ++bj) { const pg8::f32x4 v0 = acc[ai][bj][m][0] * s, v1 = acc[ai][bj][m][1] * s; pg8::u32x4 w;
                    w.x = pg8::cvt_pk_bf16(v0[0], v0[1]); w.y = pg8::cvt_pk_bf16(v0[2], v0[3]); w.z = pg8::cvt_pk_bf16(v1[0], v1[1]); w.w = pg8::cvt_pk_bf16(v1[2], v1[3]);
                    *(pg8::u32x4*)(O + (size_t)row * ldc + col0 + bj * 128) = w; } }
    }
};
struct Params {
    const float* in[27];
    const int* pos;
    float* out;
    unsigned char* ws;
};

__device__ __forceinline__ float wave_sum(float v) {
#pragma unroll
    for (int o = 1; o < 64; o <<= 1) v += __shfl_xor(v, o);
    return v;
}
__device__ __forceinline__ float sigmoidf_(float x) { return 1.f / (1.f + expf(-x)); }
__device__ __forceinline__ float siluf_(float x) { return x / (1.f + expf(-x)); }
__device__ __forceinline__ float log_sigmoidf_(float x) { return fminf(x, 0.f) - log1pf(expf(-fabsf(x))); }

__device__ __forceinline__ float bf2f(bf16_t u) { return __uint_as_float((unsigned)u << 16); }
__device__ __forceinline__ unsigned f2bf(float f) { unsigned u = __float_as_uint(f); return (u + 0x7fffu + ((u >> 16) & 1u)) >> 16; }
__device__ __forceinline__ unsigned pk2(float lo, float hi) { return f2bf(lo) | (f2bf(hi) << 16); }
__device__ __forceinline__ void ld4bf(const bf16_t* p, float* o) {
    const uint2 w = *(const uint2*)p; o[0] = __uint_as_float(w.x << 16); o[1] = __uint_as_float(w.x & 0xffff0000u); o[2] = __uint_as_float(w.y << 16); o[3] = __uint_as_float(w.y & 0xffff0000u);
}
__device__ __forceinline__ void transpose_block(const float* Wblk, int ldw, bf16_t* dst, int ldt, const float* ks, const float* ns, float* scr, int lane) {
#pragma unroll 8
    for (int i = 0; i < 32; ++i) { const int kk = 2 * i + (lane >> 5); float v = __builtin_nontemporal_load(&Wblk[(size_t)kk * ldw + (lane & 31)]);     if (ks) v *= ks[kk]; if (ns) v *= ns[lane & 31]; scr[kk * 33 + (lane & 31)] = v; }
    asm volatile("s_waitcnt lgkmcnt(0)" ::: "memory");
    const int c = lane & 7;
#pragma unroll
    for (int j = 0; j < 4; ++j) { const int n = (lane >> 3) + 8 * j; const float* s = scr + (8 * c) * 33 + n;
        uint4 o; o.x = pk2(s[0 * 33], s[1 * 33]); o.y = pk2(s[2 * 33], s[3 * 33]); o.z = pk2(s[4 * 33], s[5 * 33]); o.w = pk2(s[6 * 33], s[7 * 33]);
        *(uint4*)(dst + (size_t)n * ldt + 8 * c) = o; }
    asm volatile("s_waitcnt lgkmcnt(0)" ::: "memory");
}

namespace att {
using bf16x8 = __attribute__((ext_vector_type(8))) short;
using s16x4  = __attribute__((ext_vector_type(4))) short;
using f32x16 = __attribute__((ext_vector_type(16))) float;
using u32x4  = __attribute__((ext_vector_type(4))) unsigned;
constexpr int NW = 8, QBLK = 32, KVBLK = 64;
constexpr int LDQ = 768, LDK = 768, LDV = 512, LDO = 1536;
constexpr int KROWB = 208;
constexpr int SHM_K = KVBLK * KROWB, SHM_V = KVBLK * 64 * 2;
constexpr int NBUF = 3;
constexpr int SHM_ATTN = NBUF * SHM_V + NBUF * SHM_K + NW * 64 * 4;
constexpr float THR = 8.f;
#define ASBAR() __builtin_amdgcn_sched_barrier(0)
__device__ __forceinline__ int crow(int r, int hi) { return (r & 3) + 8 * (r >> 2) + 4 * hi; }
__device__ __forceinline__ unsigned cvtpk(float lo, float hi) { unsigned r; asm volatile("v_cvt_pk_bf16_f32 %0, %1, %2" : "=v"(r) : "v"(lo), "v"(hi)); return r; }
#define MX3(a, b, c) __builtin_fmaxf(__builtin_fmaxf((a), (b)), (c))
template <bool FIRST>
__device__ __forceinline__ void partialSM(f32x16& p0, f32x16& p1, float& m_ref, f32x16& negm, float& alpha) {
  constexpr float THRL = THR * 1.4426950408889634f;
  float a = MX3(p0[0], p0[1], p1[0]), b = MX3(p0[2], p0[3], p1[1]); a = MX3(a, p1[2], p1[3]);
#pragma unroll
  for (int r = 4; r < 16; r += 4) { a = MX3(a, p0[r], p0[r + 1]); b = MX3(b, p0[r + 2], p0[r + 3]); a = MX3(a, p1[r], p1[r + 1]); b = MX3(b, p1[r + 2], p1[r + 3]); }
  float pmax = fmaxf(a, b);
  { auto rr = __builtin_amdgcn_permlane32_swap(__float_as_uint(pmax), __float_as_uint(pmax), false, false);
    pmax = fmaxf(__uint_as_float(rr[0]), __uint_as_float(rr[1])); }
  alpha = 1.f;
  if (FIRST || !__builtin_expect(__all(pmax <= THRL), 1)) {
    const float dl = FIRST ? pmax : fmaxf(pmax, 0.f); m_ref += dl;
#pragma unroll
    for (int r = 0; r < 16; ++r) { p0[r] -= dl; p1[r] -= dl; }
#pragma unroll
    for (int r = 0; r < 16; ++r) negm[r] = -m_ref;
    asm volatile("" : "+v"(negm));
    if (!FIRST) alpha = __builtin_amdgcn_exp2f(-dl);
  }
#pragma unroll
  for (int r = 0; r < 16; ++r) p0[r] = __builtin_amdgcn_exp2f(p0[r]);
}
#undef MX3
__device__ __forceinline__ void finishSM(f32x16& p0, f32x16& p1, float alpha, float& l_reg, bf16x8& pa0, bf16x8& pa1, bf16x8& pa2, bf16x8& pa3) {
  for (int r = 0; r < 16; ++r) p1[r] = __builtin_amdgcn_exp2f(p1[r]);
  float ps = 0; for (int r = 0; r < 16; ++r) ps += p0[r]; for (int r = 0; r < 16; ++r) ps += p1[r];
  { auto rr = __builtin_amdgcn_permlane32_swap(__float_as_uint(ps), __float_as_uint(ps), false, false);
    ps = __uint_as_float(rr[0]) + __uint_as_float(rr[1]); }
  l_reg = l_reg * alpha + ps;
#define PK4(P, BASE, OUT) do { u32x4 w = {cvtpk(P[BASE + 0], P[BASE + 1]), cvtpk(P[BASE + 2], P[BASE + 3]), cvtpk(P[BASE + 4], P[BASE + 5]), cvtpk(P[BASE + 6], P[BASE + 7])}; \
    OUT = *reinterpret_cast<bf16x8*>(&w); } while (0)
  PK4(p0, 0, pa0); PK4(p0, 8, pa1); PK4(p1, 0, pa2); PK4(p1, 8, pa3);
#undef PK4
}
__device__ __forceinline__ void qkt(f32x16& p0, f32x16& p1, const char* Ks, const bf16x8* qr, const f32x16& negm, int r32, int hi) {
  p0 = negm; p1 = negm;
#pragma unroll
  for (int d0 = 0; d0 < 6; ++d0) { const int cb = d0 * 32 + hi * 16;
    bf16x8 b0 = *reinterpret_cast<const bf16x8*>(Ks + r32 * KROWB + cb);
    bf16x8 b1 = *reinterpret_cast<const bf16x8*>(Ks + (32 + r32) * KROWB + cb);
    p0 = __builtin_amdgcn_mfma_f32_32x32x16_bf16(b0, qr[d0], p0, 0, 0, 0);
    p1 = __builtin_amdgcn_mfma_f32_32x32x16_bf16(b1, qr[d0], p1, 0, 0, 0); }
}
__device__ __forceinline__ int v_st(int k, int c) { const int kk = k;   return ((kk >> 3) * 2 + (c >> 5)) * 512 + ((kk & 7) * 32 + (c & 31)) * 2; }
__device__ __forceinline__ int v_rd_base(int lane) { return ((lane & 3) << 3) | (((lane >> 2) & 3) << 6) | (((lane >> 4) & 1) << 5) | (((lane >> 5) & 1) << 8); }
constexpr int v_rd_off(int d0, int ks, int half) { return d0 * 512 + ks * 2048 + half * 1024; }
template <int OFF> __device__ __forceinline__ s16x4 tr_read(int vb) {
  s16x4 r; asm volatile("ds_read_b64_tr_b16 %0, %1 offset:%2" : "=&v"(r) : "v"(vb), "i"(OFF) : "memory"); return r;
}
template <int D0> __device__ __forceinline__ void pv_one(f32x16& od, int vb, bf16x8 pa0, bf16x8 pa1, bf16x8 pa2, bf16x8 pa3) {
  const s16x4 l0 = tr_read<v_rd_off(D0, 0, 0)>(vb), h0 = tr_read<v_rd_off(D0, 0, 1)>(vb), l1 = tr_read<v_rd_off(D0, 1, 0)>(vb), h1 = tr_read<v_rd_off(D0, 1, 1)>(vb);
  const s16x4 l2 = tr_read<v_rd_off(D0, 2, 0)>(vb), h2 = tr_read<v_rd_off(D0, 2, 1)>(vb), l3 = tr_read<v_rd_off(D0, 3, 0)>(vb), h3 = tr_read<v_rd_off(D0, 3, 1)>(vb);
  asm volatile("s_waitcnt lgkmcnt(0)" ::: "memory"); ASBAR();
#define PK(L, H) (bf16x8){L[0], L[1], L[2], L[3], H[0], H[1], H[2], H[3]}
  od = __builtin_amdgcn_mfma_f32_32x32x16_bf16(pa0, PK(l0, h0), od, 0, 0, 0);
  od = __builtin_amdgcn_mfma_f32_32x32x16_bf16(pa1, PK(l1, h1), od, 0, 0, 0);
  od = __builtin_amdgcn_mfma_f32_32x32x16_bf16(pa2, PK(l2, h2), od, 0, 0, 0);
  od = __builtin_amdgcn_mfma_f32_32x32x16_bf16(pa3, PK(l3, h3), od, 0, 0, 0);
#undef PK
}
__device__ __forceinline__ void pv_d0(f32x16* o, int vb, bf16x8 pa0, bf16x8 pa1, bf16x8 pa2, bf16x8 pa3) {
  pv_one<0>(o[0], vb, pa0, pa1, pa2, pa3); pv_one<1>(o[1], vb, pa0, pa1, pa2, pa3);
}
__device__ __forceinline__ void attn_unit(const bf16_t* Qb, const bf16_t* Kh, const bf16_t* Vh, bf16_t* Ob, int seq, char* lds) {
  int tid_ = threadIdx.x; asm volatile("" : "+v"(tid_));
  const int tid = tid_, wid = tid >> 6, lane = tid & 63, r32 = lane & 31, hi = lane >> 5;
  char* V_lds = lds; char* K_lds = lds + NBUF * SHM_V;
  float* ws = (float*)(lds + NBUF * SHM_V + NBUF * SHM_K) + wid * 64; float* li_l = ws; float* al_l = ws + 32;
  float m_ref = 0.f, l_reg = 0; f32x16 o[2] = {}; bf16x8 qr[6]; f32x16 negm = {}; asm volatile("" : "+v"(negm));
  const bf16_t* Qw = Qb + (long)(wid * QBLK + r32) * LDQ + hi * 8;
#pragma unroll
  for (int d0 = 0; d0 < 6; ++d0) qr[d0] = *reinterpret_cast<const bf16x8*>(Qw + d0 * 16);
  const bool kact = tid < 384; const int kr = tid / 12, kc = tid - kr * 12, vr = tid >> 3, vc = (tid & 7) * 8, vst0 = v_st(vr, vc);
  const int kst0 = kr * KROWB + kc * 16, kst1 = (kr + 32) * KROWB + kc * 16;
  const int vb0 = (int)(uintptr_t)V_lds + v_rd_base(lane);
  struct { bf16x8 vs, ks0, ks1; } sr_[2];
#define SLOAD(i, k0) do { sr_[i].vs = *reinterpret_cast<const bf16x8*>(&Vh[(long)((k0) + vr) * LDV + vc]); \
    if (kact) { sr_[i].ks0 = *reinterpret_cast<const bf16x8*>(&Kh[(long)((k0) + kr) * LDK + kc * 8]); sr_[i].ks1 = *reinterpret_cast<const bf16x8*>(&Kh[(long)((k0) + 32 + kr) * LDK + kc * 8]); } } while (0)
#define SWRITE(b, i) do { *(bf16x8*)(V_lds + (b) * SHM_V + vst0) = sr_[i].vs; \
    if (kact) { *(bf16x8*)(K_lds + (b) * SHM_K + kst0) = sr_[i].ks0; *(bf16x8*)(K_lds + (b) * SHM_K + kst1) = sr_[i].ks1; } } while (0)
#define SWAIT() asm volatile("s_waitcnt vmcnt(3)" ::: "memory")
#define RESC(a) do { if (__any((a) < 1.f)) { if (hi == 0) al_l[r32] = (a); asm volatile("s_waitcnt lgkmcnt(0)" ::: "memory"); \
    for (int d = 0; d < 2; ++d) for (int r = 0; r < 16; ++r) o[d][r] *= al_l[crow(r, hi)]; } } while (0)
  f32x16 pA0, pA1, pB0, pB1; float alA, alB; bf16x8 pa0, pa1, pa2, pa3; const int NT = seq / KVBLK;
  constexpr int SE = 0, SO = 1;
  int b_prev = 0, b_cur = 1, b_next = 2;
#define ROT() do { b_prev = b_cur; b_cur = b_next; b_next = (b_next == NBUF - 1) ? 0 : b_next + 1; } while (0)
  SLOAD(SE, 0); asm volatile("s_waitcnt vmcnt(0)" ::: "memory"); SWRITE(0, SE);
  SLOAD(SO, KVBLK); if (2 < NT) SLOAD(SE, 2 * KVBLK);
  __syncthreads();
  qkt(pA0, pA1, K_lds, qr, negm, r32, hi); partialSM<true>(pA0, pA1, m_ref, negm, alA);
  SWAIT(); SWRITE(1, SO); __syncthreads();
  for (int j = 1; j + 1 < NT; j += 2) {
    ASBAR(); qkt(pB0, pB1, K_lds + b_cur * SHM_K, qr, negm, r32, hi);
    finishSM(pA0, pA1, alA, l_reg, pa0, pa1, pa2, pa3); ASBAR();
    SLOAD(SO, (j + 2) * KVBLK); ASBAR();
    pv_d0(o, vb0 + b_prev * SHM_V, pa0, pa1, pa2, pa3); partialSM<false>(pB0, pB1, m_ref, negm, alB);
    SWAIT(); SWRITE(b_next, SE);
    RESC(alB); __syncthreads(); ROT();
    ASBAR(); qkt(pA0, pA1, K_lds + b_cur * SHM_K, qr, negm, r32, hi);
    finishSM(pB0, pB1, alB, l_reg, pa0, pa1, pa2, pa3); ASBAR();
    if (j + 3 < NT) SLOAD(SE, (j + 3) * KVBLK); ASBAR();
    pv_d0(o, vb0 + b_prev * SHM_V, pa0, pa1, pa2, pa3); partialSM<false>(pA0, pA1, m_ref, negm, alA);
    SWAIT(); SWRITE(b_next, SO);
    RESC(alA); __syncthreads(); ROT();
  }
  ASBAR(); qkt(pB0, pB1, K_lds + b_cur * SHM_K, qr, negm, r32, hi);
  finishSM(pA0, pA1, alA, l_reg, pa0, pa1, pa2, pa3); ASBAR();
  pv_d0(o, vb0 + b_prev * SHM_V, pa0, pa1, pa2, pa3); partialSM<false>(pB0, pB1, m_ref, negm, alB);
  RESC(alB);
  finishSM(pB0, pB1, alB, l_reg, pa0, pa1, pa2, pa3); ASBAR();
  pv_d0(o, vb0 + b_cur * SHM_V, pa0, pa1, pa2, pa3);
#undef ROT
  if (hi == 0) li_l[r32] = l_reg; asm volatile("s_waitcnt lgkmcnt(0)" ::: "memory");
  float rli[16];
#pragma unroll
  for (int r = 0; r < 16; ++r) rli[r] = __builtin_amdgcn_rcpf(li_l[crow(r, hi)]);
  bf16_t* Ow = Ob + (long)(wid * QBLK) * LDO;
#pragma unroll
  for (int r = 0; r < 16; ++r) { const int orow = crow(r, hi);
#pragma unroll
    for (int d0 = 0; d0 < 2; ++d0) Ow[(long)orow * LDO + d0 * 32 + r32] = (bf16_t)f2bf(o[d0][r] * rli[r]); }
  __syncthreads();
#undef SLOAD
#undef SWRITE
#undef SWAIT
#undef RESC
}
#undef ASBAR
}

namespace gla {
using bf16x8 = __attribute__((ext_vector_type(8))) short;
using s16x4  = __attribute__((ext_vector_type(4))) short;
using f32x16 = __attribute__((ext_vector_type(16))) float;
using u32x4  = __attribute__((ext_vector_type(4))) unsigned;
constexpr int L_DL = 0, L_TOT = 8192, L_RSUM = 10240, L_V = 12288, L_QF = 28672, L_KF = 37888, L_QB = 47104, L_KB = 56320, L_KSTF = 65536, L_KSTB = 74752, L_STF = 65536, L_STB = 83968, L_QR = 102400, L_KR = 110592, L_END = 118784;
constexpr int RB = 144;
__device__ __forceinline__ int crow(int r, int hi) { return (r & 3) + 8 * (r >> 2) + 4 * hi; }
__device__ __forceinline__ unsigned cvtpk(float lo, float hi) { unsigned r; asm volatile("v_cvt_pk_bf16_f32 %0, %1, %2" : "=v"(r) : "v"(lo), "v"(hi)); return r; }
__device__ __forceinline__ int v_st4(int k, int c) { const int kk = (k & ~0xC) | ((k & 4) << 1) | ((k & 8) >> 1); return ((kk >> 3) * 4 + (c >> 5)) * 512 + ((kk & 7) * 32 + (c & 31)) * 2; }
__device__ __forceinline__ int v_rd_base(int lane) { return ((lane & 3) << 3) | (((lane >> 2) & 3) << 6) | (((lane >> 4) & 1) << 5) | (((lane >> 5) & 1) << 8); }
template <int OFF> __device__ __forceinline__ s16x4 tr_read(int vb) { s16x4 r; asm volatile("ds_read_b64_tr_b16 %0, %1 offset:%2" : "=&v"(r) : "v"(vb), "i"(OFF) : "memory"); return r; }
__device__ __forceinline__ void v_frags(int vb, bf16x8 (&f)[4]) {
  const s16x4 l0 = tr_read<0>(vb), h0 = tr_read<2048>(vb), l1 = tr_read<4096>(vb), h1 = tr_read<4096 + 2048>(vb);
  const s16x4 l2 = tr_read<8192>(vb), h2 = tr_read<8192 + 2048>(vb), l3 = tr_read<12288>(vb), h3 = tr_read<12288 + 2048>(vb);
  asm volatile("s_waitcnt lgkmcnt(0)" ::: "memory"); __builtin_amdgcn_sched_barrier(0);
#define PK(L, H) (bf16x8){L[0], L[1], L[2], L[3], H[0], H[1], H[2], H[3]}
  f[0] = PK(l0, h0); f[1] = PK(l1, h1); f[2] = PK(l2, h2); f[3] = PK(l3, h3);
#undef PK
}
__device__ __forceinline__ bf16x8 frag(const char* base, int row, int ks, int hi) { return *reinterpret_cast<const bf16x8*>(base + row * RB + ks * 32 + hi * 16); }

template <bool IS_G1>
__device__ __forceinline__ void prep(char* lds, const bf16_t* projb, const float* wdec, const float* bdec, int t0, int hh, float* dec_out  , long dec_dir_stride) {
  int tid_ = threadIdx.x; asm volatile("" : "+v"(tid_)); const int tid = tid_;
  float* DL = (float*)(lds + L_DL); float* TOT = (float*)(lds + L_TOT);
  { const int i = tid >> 3, r4 = (tid & 7) * 4; float v[4]; ld4bf(projb + (size_t)(t0 + i) * DINP + OFF_GDEC + r4, v); *(float4*)(DL + i * 32 + r4) = make_float4(v[0], v[1], v[2], v[3]);
    const int c8 = (tid & 7) * 8;
    *(uint4*)(lds + L_KR + i * 128 + c8 * 2) = *(const uint4*)(projb + (size_t)(t0 + i) * DINP + OFF_GK + hh * 64 + c8);
    if constexpr (!IS_G1) *(uint4*)(lds + L_QR + i * 128 + c8 * 2) = *(const uint4*)(projb + (size_t)(t0 + i) * DINP + OFF_GQ + hh * 64 + c8); }
#pragma unroll
  for (int e2 = 0; e2 < 2; ++e2) { const int e = tid + e2 * 512, i = e >> 4, cc = (e & 15) * 8;
    *(uint4*)(lds + L_V + v_st4(i, cc)) = *(const uint4*)(projb + (size_t)(t0 + i) * DINP + OFF_GV + hh * 128 + cc); }
  __syncthreads();
  const int cidx = tid & 127, tg = tid >> 7, dir = cidx >> 6, d = cidx & 63;
  float W[16];
#pragma unroll
  for (int r = 0; r < 16; ++r) W[r] = wdec[(size_t)(dir * 16 + r) * 256 + hh * 64 + d];
  const float bias = bdec[dir * 256 + hh * 64 + d];
  constexpr float L2E = 1.4426950408889634f;
  float g[16], cs[16]; float run = 0.f;
#pragma unroll
  for (int ii = 0; ii < 16; ++ii) { const float* dl = DL + (16 * tg + ii) * 32 + dir * 16; float a = bias;
#pragma unroll
    for (int r = 0; r < 16; r += 4) { const float4 x = *(const float4*)(dl + r); a = fmaf(x.x, W[r], a); a = fmaf(x.y, W[r + 1], a); a = fmaf(x.z, W[r + 2], a); a = fmaf(x.w, W[r + 3], a); }
    g[ii] = (fminf(a, 0.f) * L2E - __builtin_amdgcn_logf(1.f + __builtin_amdgcn_exp2f(-fabsf(a) * L2E))) * (1.f / 16.f); run += g[ii]; cs[ii] = run; }
  TOT[tg * 128 + cidx] = run;
  __syncthreads();
  const float t0s = TOT[cidx], t1s = TOT[128 + cidx], t2s = TOT[256 + cidx], t3s = TOT[384 + cidx], tall = (t0s + t1s) + (t2s + t3s);
  const float off_lo = (tg > 0 ? t0s : 0.f) + (tg > 1 ? t1s : 0.f) + (tg > 2 ? t2s : 0.f);
  const float off_hi = (tg < 1 ? t1s : 0.f) + (tg < 2 ? t2s : 0.f) + (tg < 3 ? t3s : 0.f);
  const bf16_t* KR = (const bf16_t*)(lds + L_KR); const bf16_t* QR = (const bf16_t*)(lds + L_QR);
  if constexpr (IS_G1) {
    unsigned pk[8];
#pragma unroll
    for (int ii = 0; ii < 16; ii += 2) {
      float kv2[2];
#pragma unroll
      for (int u = 0; u < 2; ++u) { const int i = 16 * tg + ii + u; const float bi = dir == 0 ? off_lo + cs[ii + u] : off_hi + run - cs[ii + u] + g[ii + u];
        kv2[u] = bf2f(KR[i * 64 + d]) * __builtin_amdgcn_exp2f(tall - bi); }
      pk[ii >> 1] = cvtpk(kv2[0], kv2[1]); }
    char* dst = lds + (dir ? L_KSTB : L_KSTF) + d * RB + 32 * tg;
    *(uint4*)dst = make_uint4(pk[0], pk[1], pk[2], pk[3]); *(uint4*)(dst + 16) = make_uint4(pk[4], pk[5], pk[6], pk[7]);
    if (tg == 0) dec_out[dir * dec_dir_stride + d] = __builtin_amdgcn_exp2f(tall);
  } else {
    bf16_t* Qx = (bf16_t*)(lds + (dir ? L_QB : L_QF)); bf16_t* Kx = (bf16_t*)(lds + (dir ? L_KB : L_KF));
#pragma unroll
    for (int ii = 0; ii < 16; ++ii) { const int i = 16 * tg + ii; const float bi = dir == 0 ? off_lo + cs[ii] : off_hi + run - cs[ii] + g[ii];
      const float qv = bf2f(QR[i * 64 + d]) * 0.125f, kv = bf2f(KR[i * 64 + d]);
      Qx[i * (RB / 2) + d] = (bf16_t)f2bf(qv * __builtin_amdgcn_exp2f(bi)); Kx[i * (RB / 2) + d] = (bf16_t)f2bf(kv * __builtin_amdgcn_exp2f(-bi)); }
  }
  __syncthreads();
}

__device__ __forceinline__ void g1_item(char* lds, const bf16_t* projb, const float* wdec, const float* bdec, int b, int hh, int c, float* kvt, float* dec) {
  int tid_ = threadIdx.x; asm volatile("" : "+v"(tid_)); const int tid = tid_, wid = tid >> 6, lane = tid & 63, r32 = lane & 31, hi = lane >> 5;
  const int bh = b * 4 + hh; const long item = (long)bh * 128 + c, dstride = 8L * 128;
  prep<true>(lds, projb, wdec, bdec, b * SEQ + c * 64, hh, dec + item * 64, dstride * 64);
  const int vblk = wid >> 1, dblk = wid & 1;
  bf16x8 vf[4]; v_frags((int)(uintptr_t)(lds + L_V) + v_rd_base(lane) + vblk * 512, vf);
#pragma unroll
  for (int dir = 0; dir < 2; ++dir) { const char* kst = lds + (dir ? L_KSTB : L_KSTF); f32x16 acc = {};
#pragma unroll
    for (int ks = 0; ks < 4; ++ks) acc = __builtin_amdgcn_mfma_f32_32x32x16_bf16(vf[ks], frag(kst, dblk * 32 + r32, ks, hi), acc, 0, 0, 0);
    float* o = kvt + ((long)dir * dstride + item) * 8192 + (size_t)(vblk * 32) * 64 + dblk * 32 + r32;
#pragma unroll
    for (int r = 0; r < 16; ++r) o[crow(r, hi) * 64] = acc[r]; }
  __syncthreads();
}

__device__ __forceinline__ void g3_item(char* lds, const bf16_t* projb, const float* wdec, const float* bdec, const float* normg, int b, int hh, int c, const bf16_t* st, bf16_t* out, int ldo) {
  int tid_ = threadIdx.x; asm volatile("" : "+v"(tid_)); const int tid = tid_, wid = tid >> 6, lane = tid & 63, r32 = lane & 31, hi = lane >> 5;
  const int bh = b * 4 + hh, t0 = b * SEQ + c * 64; const long item = (long)bh * 128 + c, dstride = 8L * 128;
#pragma unroll
  for (int e4 = 0; e4 < 4; ++e4) { const int e = tid + e4 * 512, dir = e >> 10, v = (e >> 3) & 127, dc = (e & 7) * 8;
    *(uint4*)(lds + (dir ? L_STB : L_STF) + v * RB + dc * 2) = *(const uint4*)(st + ((long)dir * dstride + item) * 8192 + (size_t)v * 64 + dc); }
  prep<false>(lds, projb, wdec, bdec, t0, hh, nullptr, 0);
  const int ib = wid & 1, vblk = wid >> 1, iglob = ib * 32 + r32;
  bf16_t rgr[16];
#pragma unroll
  for (int r = 0; r < 16; ++r) rgr[r] = projb[(size_t)(t0 + ib * 32 + crow(r, hi)) * DINP + OFF_GR + hh * 128 + vblk * 32 + r32];
  f32x16 pF0 = {}, pF1 = {}, pB0 = {}, pB1 = {};
#pragma unroll
  for (int ks = 0; ks < 4; ++ks) {
    const bf16x8 qf = frag(lds + L_QF, iglob, ks, hi), qb = frag(lds + L_QB, iglob, ks, hi);
    pF0 = __builtin_amdgcn_mfma_f32_32x32x16_bf16(frag(lds + L_KF, r32, ks, hi), qf, pF0, 0, 0, 0);
    pF1 = __builtin_amdgcn_mfma_f32_32x32x16_bf16(frag(lds + L_KF, 32 + r32, ks, hi), qf, pF1, 0, 0, 0);
    pB0 = __builtin_amdgcn_mfma_f32_32x32x16_bf16(frag(lds + L_KB, r32, ks, hi), qb, pB0, 0, 0, 0);
    pB1 = __builtin_amdgcn_mfma_f32_32x32x16_bf16(frag(lds + L_KB, 32 + r32, ks, hi), qb, pB1, 0, 0, 0); }
#pragma unroll
  for (int r = 0; r < 16; ++r) { const int j0 = crow(r, hi), j1 = 32 + j0;
    pF0[r] = (j0 <= iglob ? pF0[r] : 0.f) + (j0 >= iglob ? pB0[r] : 0.f);
    pF1[r] = (j1 <= iglob ? pF1[r] : 0.f) + (j1 >= iglob ? pB1[r] : 0.f); }
  bf16x8 pa0, pa1, pa2, pa3;
#define PK4(P, BASE, OUT) do { unsigned a0 = cvtpk(P[BASE + 0], P[BASE + 1]), a1 = cvtpk(P[BASE + 2], P[BASE + 3]);   \
    unsigned b0 = cvtpk(P[BASE + 4], P[BASE + 5]), b1 = cvtpk(P[BASE + 6], P[BASE + 7]);                              \
    auto r0 = __builtin_amdgcn_permlane32_swap(a0, b0, false, false); auto r1 = __builtin_amdgcn_permlane32_swap(a1, b1, false, false); \
    u32x4 w = {r0[0], r1[0], r0[1], r1[1]}; OUT = *reinterpret_cast<bf16x8*>(&w); } while (0)
  PK4(pF0, 0, pa0); PK4(pF0, 8, pa1); PK4(pF1, 0, pa2); PK4(pF1, 8, pa3);
#undef PK4
  bf16x8 vf[4]; v_frags((int)(uintptr_t)(lds + L_V) + v_rd_base(lane) + vblk * 512, vf);
  f32x16 o = {};
  o = __builtin_amdgcn_mfma_f32_32x32x16_bf16(pa0, vf[0], o, 0, 0, 0); o = __builtin_amdgcn_mfma_f32_32x32x16_bf16(pa1, vf[1], o, 0, 0, 0);
  o = __builtin_amdgcn_mfma_f32_32x32x16_bf16(pa2, vf[2], o, 0, 0, 0); o = __builtin_amdgcn_mfma_f32_32x32x16_bf16(pa3, vf[3], o, 0, 0, 0);
#pragma unroll
  for (int ks = 0; ks < 4; ++ks) {
    o = __builtin_amdgcn_mfma_f32_32x32x16_bf16(frag(lds + L_QF, iglob, ks, hi), frag(lds + L_STF, vblk * 32 + r32, ks, hi), o, 0, 0, 0);
    o = __builtin_amdgcn_mfma_f32_32x32x16_bf16(frag(lds + L_QB, iglob, ks, hi), frag(lds + L_STB, vblk * 32 + r32, ks, hi), o, 0, 0, 0); }
  float* RS = (float*)(lds + L_RSUM);
  float ss[16];
#pragma unroll
  for (int r = 0; r < 16; ++r) { float s = o[r] * o[r]; s += __shfl_xor(s, 1); s += __shfl_xor(s, 2); s += __shfl_xor(s, 4); s += __shfl_xor(s, 8); s += __shfl_xor(s, 16); ss[r] = s; }
  if (r32 == 0) {
#pragma unroll
    for (int r = 0; r < 16; ++r) RS[(ib * 4 + vblk) * 32 + crow(r, hi)] = ss[r]; }
  __syncthreads();
  const int v = vblk * 32 + r32; const float ng = normg[v];
#pragma unroll
  for (int r = 0; r < 16; ++r) { const int il = crow(r, hi), i = ib * 32 + il;
    const float tot = (RS[(ib * 4 + 0) * 32 + il] + RS[(ib * 4 + 1) * 32 + il]) + (RS[(ib * 4 + 2) * 32 + il] + RS[(ib * 4 + 3) * 32 + il]);
    const float rstd = 1.f / sqrtf(tot * (1.f / 128.f) + RMS_EPS);
    const float rg = bf2f(rgr[r]);
    out[(size_t)(t0 + i) * ldo + hh * 128 + v] = (bf16_t)f2bf(o[r] * rstd * ng * (rg * __builtin_amdgcn_rcpf(1.f + __builtin_amdgcn_exp2f(-1.4426950408889634f * rg)))); }
  __syncthreads();
}
}

__device__ __forceinline__ void ln_core(float4 (&v)[4], const float* g, const float* b, float* out, bf16_t* outb, int lane) {
    float s = 0.f;
#pragma unroll
    for (int j = 0; j < 4; ++j) s += (v[j].x + v[j].y) + (v[j].z + v[j].w);
    const float mean = wave_sum(s) * (1.f / DM); float s2 = 0.f;
#pragma unroll
    for (int j = 0; j < 4; ++j) { v[j].x -= mean; v[j].y -= mean; v[j].z -= mean; v[j].w -= mean; s2 += (v[j].x * v[j].x + v[j].y * v[j].y) + (v[j].z * v[j].z + v[j].w * v[j].w); }
    const float rstd = 1.f / sqrtf(wave_sum(s2) * (1.f / DM) + LN_EPS);
#pragma unroll
    for (int j = 0; j < 4; ++j) {
        const float4 gg = ((const float4*)g)[lane + 64 * j], bb = ((const float4*)b)[lane + 64 * j];
        float4 o; o.x = v[j].x * rstd * gg.x + bb.x; o.y = v[j].y * rstd * gg.y + bb.y; o.z = v[j].z * rstd * gg.z + bb.z; o.w = v[j].w * rstd * gg.w + bb.w;
        ((float4*)out)[lane + 64 * j] = o; v[j] = o;
        if (outb) ((uint2*)outb)[lane + 64 * j] = make_uint2(pk2(o.x, o.y), pk2(o.z, o.w));
    }
}
__device__ __forceinline__ void wave_sum2(float& a, float& b) {
#pragma unroll
    for (int o = 1; o < 64; o <<= 1) { const float ta = __shfl_xor(a, o), tb = __shfl_xor(b, o); a += ta; b += tb; }
}
template <int MODE>
__device__ __forceinline__ void ln_core2(float4 (&v)[2][4], const float* g, const float* b, float* out0, float* out1, bf16_t* ob0, bf16_t* ob1, int lane, unsigned char* o8_0 = nullptr, unsigned char* o8_1 = nullptr) {
    float s[2] = {0.f, 0.f};
#pragma unroll
    for (int u = 0; u < 2; ++u)
#pragma unroll
        for (int j = 0; j < 4; ++j) s[u] += (v[u][j].x + v[u][j].y) + (v[u][j].z + v[u][j].w);
    wave_sum2(s[0], s[1]);
    float q[2] = {0.f, 0.f};
#pragma unroll
    for (int u = 0; u < 2; ++u) { const float mean = s[u] * (1.f / DM);
#pragma unroll
        for (int j = 0; j < 4; ++j) { v[u][j].x -= mean; v[u][j].y -= mean; v[u][j].z -= mean; v[u][j].w -= mean; q[u] += (v[u][j].x * v[u][j].x + v[u][j].y * v[u][j].y) + (v[u][j].z * v[u][j].z + v[u][j].w * v[u][j].w); } }
    wave_sum2(q[0], q[1]);
#pragma unroll
    for (int j = 0; j < 4; ++j) {
        const float4 gg = ((const float4*)g)[lane + 64 * j], bb = ((const float4*)b)[lane + 64 * j];
#pragma unroll
        for (int u = 0; u < 2; ++u) { const float rstd = 1.f / sqrtf(q[u] * (1.f / DM) + LN_EPS);
            float4 o; o.x = v[u][j].x * rstd * gg.x + bb.x; o.y = v[u][j].y * rstd * gg.y + bb.y; o.z = v[u][j].z * rstd * gg.z + bb.z; o.w = v[u][j].w * rstd * gg.w + bb.w;
            v[u][j] = o;
            if constexpr (MODE == 2) ((float4*)(u ? out1 : out0))[lane + 64 * j] = o;
            else ((uint2*)(u ? ob1 : ob0))[lane + 64 * j] = make_uint2(pk2(o.x, o.y), pk2(o.z, o.w));
            if constexpr (MODE == 1) ((unsigned*)(u ? o8_1 : o8_0))[lane + 64 * j] = pk4_fp8(o.x, o.y, o.z, o.w); }
    }
}
__device__ __forceinline__ int block_excl_scan(int x, int* scr, int tid, int& total) {
    const int lane = tid & 63, wid = tid >> 6; int inc = x;
#pragma unroll
    for (int o = 1; o < 64; o <<= 1) { const int y = __shfl_up(inc, o); if (lane >= o) inc += y; }
    __syncthreads();
    if (lane == 63) scr[wid] = inc;
    __syncthreads();
    int base = 0, tot = 0;
#pragma unroll
    for (int w = 0; w < 8; ++w) { const int c = scr[w]; base += (w < wid) ? c : 0; tot += c; }
    total = tot; return base + inc - x;
}

__device__ __forceinline__ void tb_load(float (&v)[32], const float* Wblk, int ldw, int lane) {
#pragma unroll
    for (int i = 0; i < 32; ++i) v[i] = __builtin_nontemporal_load(&Wblk[(size_t)(2 * i + (lane >> 5)) * ldw + (lane & 31)]);
}
__device__ __forceinline__ void tb_store(const float (&v)[32], bf16_t* dst, int ldt, float* scr, int lane) {
#pragma unroll
    for (int i = 0; i < 32; ++i) scr[(2 * i + (lane >> 5)) * 33 + (lane & 31)] = v[i];
    asm volatile("s_waitcnt lgkmcnt(0)" ::: "memory");
    const int c = lane & 7;
#pragma unroll
    for (int j = 0; j < 4; ++j) { const int n = (lane >> 3) + 8 * j; const float* s = scr + (8 * c) * 33 + n;
        uint4 o; o.x = pk2(s[0 * 33], s[1 * 33]); o.y = pk2(s[2 * 33], s[3 * 33]); o.z = pk2(s[4 * 33], s[5 * 33]); o.w = pk2(s[6 * 33], s[7 * 33]);
        *(uint4*)(dst + (size_t)n * ldt + 8 * c) = o; }
    asm volatile("s_waitcnt lgkmcnt(0)" ::: "memory");
}

__device__ __forceinline__ void tb_store8(const float (&v)[32], unsigned char* dst, int ldt, float sc, float* scr, int lane) {
#pragma unroll
    for (int i = 0; i < 32; ++i) scr[(2 * i + (lane >> 5)) * 33 + (lane & 31)] = v[i];
    asm volatile("s_waitcnt lgkmcnt(0)" ::: "memory");
    const int c = lane & 7;
#pragma unroll
    for (int j = 0; j < 4; ++j) { const int n = (lane >> 3) + 8 * j; const float* s = scr + (8 * c) * 33 + n;
        *(uint2*)(dst + (size_t)n * ldt + 8 * c) = make_uint2(pk4_fp8(s[0 * 33] * sc, s[1 * 33] * sc, s[2 * 33] * sc, s[3 * 33] * sc), pk4_fp8(s[4 * 33] * sc, s[5 * 33] * sc, s[6 * 33] * sc, s[7 * 33] * sc)); }
    asm volatile("s_waitcnt lgkmcnt(0)" ::: "memory");
}

__device__ __forceinline__ void ln_row(const float* a, const float* add, float alpha, const float* g, const float* b, float* out, int lane, float4 (&v)[4], bf16_t* outb = nullptr) {
    float s = 0.f;
#pragma unroll
    for (int j = 0; j < 4; ++j) {
        float4 x = ((const float4*)a)[lane + 64 * j];
        x.x *= alpha; x.y *= alpha; x.z *= alpha; x.w *= alpha;
        if (add) { const float4 y = ((const float4*)add)[lane + 64 * j]; x.x += y.x; x.y += y.y; x.z += y.z; x.w += y.w; }
        v[j] = x; s += (x.x + x.y) + (x.z + x.w);
    }
    const float mean = wave_sum(s) * (1.f / DM); float s2 = 0.f;
#pragma unroll
    for (int j = 0; j < 4; ++j) { v[j].x -= mean; v[j].y -= mean; v[j].z -= mean; v[j].w -= mean; s2 += (v[j].x * v[j].x + v[j].y * v[j].y) + (v[j].z * v[j].z + v[j].w * v[j].w); }
    const float rstd = 1.f / sqrtf(wave_sum(s2) * (1.f / DM) + LN_EPS);
#pragma unroll
    for (int j = 0; j < 4; ++j) {
        const float4 gg = ((const float4*)g)[lane + 64 * j], bb = ((const float4*)b)[lane + 64 * j];
        float4 o; o.x = v[j].x * rstd * gg.x + bb.x; o.y = v[j].y * rstd * gg.y + bb.y; o.z = v[j].z * rstd * gg.z + bb.z; o.w = v[j].w * rstd * gg.w + bb.w;
        if (out) ((float4*)out)[lane + 64 * j] = o; v[j] = o;
        if (outb) ((uint2*)outb)[lane + 64 * j] = make_uint2(pk2(o.x, o.y), pk2(o.z, o.w));
    }
}

struct GemmP {
    const float* A; const int* ridx; const float* Bm; float* C;
    int lda, ldb, ldc, M, N, K, nb, bshift;
    long sA, sB, sC; int sR;
    const float* aux; const bf16_t* auxb; int ldaux; long sAux; const float* aux2; int accum;
};
template <int MODE>
__device__ __forceinline__ void gemm_naive(const GemmP g, float* lds) {
    float (*As)[132] = (float (*)[132])lds;
    float (*Bs)[128] = (float (*)[128])(lds + 16 * 132);
    int tid_ = threadIdx.x; asm volatile("" : "+v"(tid_));
    const int tid = tid_, ty = tid >> 4, tx = tid & 15;
    const int mt = g.M / 128, nt = (g.N + 127) / 128, per = mt * nt, total = per * g.nb;
    int bid_ = blockIdx.x; asm volatile("" : "+s"(bid_));
    for (int tile = bid_; tile < total; tile += gridDim.x) {
        const int z = tile / per, r = tile % per, tm = r / nt, tn = r % nt;
        const int m0 = tm * 128, n0 = tn * 128;
        const float* Bz = g.Bm + (long)(z >> g.bshift) * g.sB;
        float* Cz = g.C + (long)z * g.sC;
        const int arow = m0 + (tid >> 2);
        const long grow = g.ridx ? (long)g.ridx[z * g.sR + arow] : (long)arow;
        const float* Arow = g.A + (long)z * g.sA + grow * g.lda + (tid & 3) * 4;
        const int bk = tid >> 5, bn = n0 + (tid & 31) * 4;
        const bool bok = bn < g.N;
        const float* Bp = Bz + (long)bk * g.ldb + bn;
        float acc[4][8];
#pragma unroll
        for (int i = 0; i < 4; ++i)
#pragma unroll
            for (int j = 0; j < 8; ++j) acc[i][j] = 0.f;
        float4 ra = *(const float4*)(Arow);
        float4 rb = bok ? *(const float4*)(Bp) : make_float4(0.f, 0.f, 0.f, 0.f);
        for (int k0 = 0; k0 < g.K; k0 += 16) {
            __syncthreads();
            { const int rr = tid >> 2, k4 = (tid & 3) * 4; As[k4][rr] = ra.x; As[k4 + 1][rr] = ra.y; As[k4 + 2][rr] = ra.z; As[k4 + 3][rr] = ra.w; }
            *(float4*)&Bs[bk][(tid & 31) * 4] = rb;
            __syncthreads();
            if (k0 + 16 < g.K) {
                ra = *(const float4*)(Arow + k0 + 16);
                rb = bok ? *(const float4*)(Bp + (long)(k0 + 16) * g.ldb) : make_float4(0.f, 0.f, 0.f, 0.f);
            }
#pragma unroll
            for (int k = 0; k < 16; ++k) {
                const float4 a = *(const float4*)&As[k][ty * 4];
                const float4 b0 = *(const float4*)&Bs[k][tx * 8], b1 = *(const float4*)&Bs[k][tx * 8 + 4];
                const float av[4] = {a.x, a.y, a.z, a.w};
                const float bv[8] = {b0.x, b0.y, b0.z, b0.w, b1.x, b1.y, b1.z, b1.w};
#pragma unroll
                for (int i = 0; i < 4; ++i)
#pragma unroll
                    for (int j = 0; j < 8; ++j) acc[i][j] = fmaf(av[i], bv[j], acc[i][j]);
            }
        }
#pragma unroll
        for (int i = 0; i < 4; ++i) {
            const int row = m0 + ty * 4 + i;
#pragma unroll
            for (int jv = 0; jv < 2; ++jv) {
                const int col = n0 + tx * 8 + jv * 4;
                if (col < g.N) {
                    float v[4] = {acc[i][jv * 4], acc[i][jv * 4 + 1], acc[i][jv * 4 + 2], acc[i][jv * 4 + 3]};
                    float* cp = Cz + (long)row * g.ldc + col;
                    if (MODE == 1) {
#pragma unroll
                        for (int q = 0; q < 4; ++q) v[q] *= g.aux[(long)z * g.sAux + col + q];
                    } else if (MODE == 2) {
                        float gl[4]; ld4bf(g.auxb + (long)row * g.ldaux + col, gl); const float4 gb = *(const float4*)(g.aux2 + col);
                        const float gv[4] = {gl[0] + gb.x, gl[1] + gb.y, gl[2] + gb.z, gl[3] + gb.w};
                        float4 old = make_float4(0.f, 0.f, 0.f, 0.f);
                        if (g.accum) old = *(const float4*)cp;
                        const float ov[4] = {old.x, old.y, old.z, old.w};
#pragma unroll
                        for (int q = 0; q < 4; ++q) v[q] = ov[q] + sigmoidf_(gv[q]) * v[q];
                    } else if (MODE == 3) {
                        const float4 old = *(const float4*)cp; const float ov[4] = {old.x, old.y, old.z, old.w};
#pragma unroll
                        for (int q = 0; q < 4; ++q) v[q] = siluf_(ov[q]) * v[q];
                    } else if (MODE == 4) {
                        const float rs = g.aux[(long)z * g.sAux + row];
#pragma unroll
                        for (int q = 0; q < 4; ++q) v[q] *= rs;
                    }
                    *(float4*)cp = make_float4(v[0], v[1], v[2], v[3]);
                }
            }
        }
    }
    __syncthreads();
}

#define W_IN(l)    (p.in[4]  + (size_t)(l) * DM * DIN)
#define B_GATE(l)  (p.in[5]  + (size_t)(l) * 3 * DM)
#define POOL_W(l)  (p.in[6]  + (size_t)(l) * 4 * 128 * 128)
#define POOL_S(l)  (p.in[7]  + (size_t)(l) * 512)
#define W_UP_A(l)  (p.in[8]  + (size_t)(l) * 512 * DM)
#define Q_NORM(l)  (p.in[9]  + (size_t)(l) * 384)
#define W_UQ(l)    (p.in[10] + (size_t)(l) * 384 * 768)
#define KV_NORM(l) (p.in[11] + (size_t)(l) * 256)
#define W_UKV(l)   (p.in[12] + (size_t)(l) * 256 * 1024)
#define W_UP_B(l)  (p.in[13] + (size_t)(l) * 512 * DM)
#define W_DEC(l)   (p.in[14] + (size_t)(l) * 2 * 16 * 256)
#define B_DEC(l)   (p.in[15] + (size_t)(l) * 2 * 256)
#define GLA_NORM(l)(p.in[16] + (size_t)(l) * 128)
#define W_UP_C(l)  (p.in[17] + (size_t)(l) * 512 * DM)
#define W_OUT(l)   (p.in[18] + (size_t)(l) * DM * DM)
#define LN1_G(l)   (p.in[19] + (size_t)(l) * DM)
#define LN1_B(l)   (p.in[20] + (size_t)(l) * DM)
#define ROUTER(l)  (p.in[21] + (size_t)(l) * DM * NE)
#define EW_GATE(l) (p.in[22] + (size_t)(l) * NE * DM * DEXP)
#define EW_UP(l)   (p.in[23] + (size_t)(l) * NE * DM * DEXP)
#define EW_DOWN(l) (p.in[24] + (size_t)(l) * NE * DEXP * DM)
#define LN2_G(l)   (p.in[25] + (size_t)(l) * DM)
#define LN2_B(l)   (p.in[26] + (size_t)(l) * DM)
#define WSF(off) ((float*)(p.ws + (off)))
#define WSI(off) ((int*)(p.ws + (off)))
#define WSB(off) ((bf16_t*)(p.ws + (off)))
#define PJ(t, c) bf2f(projb[(size_t)(t) * DINP + (c)])

enum Stage {
    ST_INIT = 0,
    ST_WCONV,
    ST_PROJ,
    ST_PREP,
    ST_SMALLGEMM,
    ST_ROPE,
    ST_ATTN,
    ST_GLA1, ST_GLA2, ST_GLA3,
    ST_GLAFIN,
    ST_MERGE_A, ST_MERGE_B, ST_MERGE_C,
    ST_OUTP,
    ST_LN1,
    ST_TOPK,
    ST_GATHER,
    ST_EXP_G, ST_EXP_U, ST_EXP_D,
    ST_LN2,
    ST_COUNT
};

#define KAS __attribute__((address_space(4)))
template <int ST>
__device__ __forceinline__ void run_stage(int l, float* lds) {
    const KAS Params* pk_ = (const KAS Params*)__builtin_amdgcn_kernarg_segment_ptr(); asm volatile("" : "+s"(pk_));
    const KAS Params& p = *pk_;
    int tid_ = threadIdx.x; asm volatile("" : "+v"(tid_));
    int bid_ = blockIdx.x; asm volatile("" : "+s"(bid_));
    const int tid = tid_, lane = tid & 63, wid = tid >> 6;
    const int G = gridDim.x, bid = bid_;
    const int gw = bid * 8 + wid, NGW = G * 8;
    const long gt = (long)bid * NTHR + tid, NGT = (long)G * NTHR;
    float* h = p.out;

    if constexpr (ST == ST_INIT) {
        for (int m = gw; m < T; m += NGW) { float4 vv[4]; ln_row(p.in[0] + (size_t)m * DM, nullptr, 1.f, p.in[2], p.in[3], nullptr, lane, vv, WSB(WS_HB) + (size_t)m * DM); }
        {
            float* scr = lds + wid * 4096;
            constexpr int NBLK = DIN / 32, ITEMS_L = (DM / 64) * NBLK;
            for (int it = gw; it < 2 * ITEMS_L; it += NGW) {
                const int ll = it / ITEMS_L, r = it % ITEMS_L, kb = r / NBLK, nb = r % NBLK;
                const int n0 = 32 * nb, drow = n0 < 2752 ? n0 + 3072 : n0 - 2752;
                transpose_block(p.in[4] + (size_t)ll * DM * DIN + (size_t)(64 * kb) * DIN + n0, DIN, WSB(WS_WIN_T) + (size_t)ll * DINP * DM + (size_t)drow * DM + 64 * kb, DM, nullptr, nullptr, scr, lane);
            }
            {
                constexpr int I_UQ = 6 * 24, I_UKV = 4 * 32, I_B = 8 * 32, I_OUT = 16 * 32, I_L = I_UQ + I_UKV + 2 * I_B + I_OUT;
                for (int it = gw; it < 2 * I_L; it += NGW) {
                    const int ll = it / I_L; int r = it % I_L; bf16_t* wsm = WSB(WS_WSMALL + (size_t)ll * WSM_STRIDE);
                    if (r < I_UQ) { const int kb = r / 24, nb = r % 24; transpose_block(p.in[10] + (size_t)ll * 384 * 768 + (size_t)(64 * kb) * 768 + 32 * nb, 768, wsm + WSM_UQ / 2 + (size_t)(32 * nb) * 384 + 64 * kb, 384, p.in[9] + ll * 384 + 64 * kb, nullptr, scr, lane); continue; } r -= I_UQ;
                    if (r < I_UKV) { const int kb = r / 32, nb = r % 32; transpose_block(p.in[12] + (size_t)ll * 256 * 1024 + (size_t)(64 * kb) * 1024 + 32 * nb, 1024, wsm + WSM_UKV / 2 + (size_t)(32 * nb) * 256 + 64 * kb, 256, p.in[11] + ll * 256 + 64 * kb, nullptr, scr, lane); continue; } r -= I_UKV;
                    if (r < 2 * I_B) { const int c = r / I_B, rr = r % I_B, kb = rr / 32, nb = rr % 32; const float* W = (c ? p.in[17] : p.in[13]) + (size_t)ll * 512 * DM;
                        transpose_block(W + (size_t)(64 * kb) * DM + 32 * nb, DM, wsm + WSM_MRG / 2 + (size_t)(32 * nb) * 1536 + 512 * (1 + c) + 64 * kb, 1536, nullptr, nullptr, scr, lane); continue; } r -= 2 * I_B;
                    { const int kb = r / 32, nb = r % 32; transpose_block(p.in[18] + (size_t)ll * DM * DM + (size_t)(64 * kb) * DM + 32 * nb, DM, wsm + WSM_OUT / 2 + (size_t)(32 * nb) * DM + 64 * kb, DM, nullptr, nullptr, scr, lane); }
                }
                for (long i = gt; i < 2L * 512 * DM; i += NGT) {
                    const int ll = (int)(i / (512 * DM)), r = (int)(i % (512 * DM)), cin = r >> 10, d = r & 1023, g = cin >> 7, c = cin & 127;
                    const float* pw = p.in[6] + (size_t)ll * 4 * 128 * 128 + (size_t)(g * 128 + c) * 128; const float* ps = p.in[7] + ll * 512 + g * 128; const float* wa = p.in[8] + (size_t)ll * 512 * DM + (size_t)(g * 128) * DM + d;
                    float a = 0.f;
                    for (int cc = 0; cc < 128; ++cc) a = fmaf(pw[cc] * ps[cc], wa[(size_t)cc * DM], a);
                    WSB(WS_WSMALL + (size_t)ll * WSM_STRIDE + WSM_MRG)[(size_t)d * 1536 + cin] = (bf16_t)f2bf(a);
                }
            }
            for (long i = gt; i < 2L * 64 * DM / 8; i += NGT) { const int ll = (int)(i / (64 * DM / 8)); const long r = i % (64 * DM / 8);
                *(uint4*)(WSB(WS_WIN_T) + (size_t)ll * DINP * DM + (size_t)DIN * DM + r * 8) = make_uint4(0u, 0u, 0u, 0u); }
        }
        float* rc = WSF(WS_ROPE); float* rs = rc + T * 16;
        for (long i = gt; i < (long)T * 16; i += NGT) {
            const int t = (int)(i >> 4), j = (int)(i & 15);
            const float freq = powf(10000.0f, -(float)j / 16.0f);
            const float ang = (float)p.pos[t] * freq;
            rc[i] = cosf(ang); rs[i] = sinf(ang);
        }
    }
    if constexpr (ST == ST_WCONV) {
        float* scr = lds + wid * 4096;
        constexpr int I_G = 16 * 16 * 64, I_D = 16 * 32 * 32;
        constexpr int I_ALL = 2 * I_G + I_D;
#define WCONV_ITEM(it, W, ldw, dst, ldt, sc8) do { if ((it) < 2 * I_G) { const int up_ = (it) >= I_G, r_ = up_ ? (it) - I_G : (it), e_ = r_ >> 10, kb_ = (r_ >> 6) & 15, nb_ = r_ & 63, j0_ = nb_ * 32; \
            W = (up_ ? EW_UP(l) : EW_GATE(l)) + (size_t)e_ * DM * DEXP + (size_t)(64 * kb_) * DEXP + j0_; ldw = DEXP; \
            dst = (unsigned char*)(p.ws + WS_WGU_T) + (size_t)(e_ * 4096 + 256 * (j0_ >> 7) + (j0_ & 127) + (up_ ? 128 : 0)) * DM + 64 * kb_; ldt = DM; sc8 = F8_WGU; } \
          else { const int r_ = (it) - 2 * I_G, e_ = r_ >> 10, kb_ = (r_ >> 5) & 31, nb_ = r_ & 31; \
            W = EW_DOWN(l) + (size_t)e_ * DEXP * DM + (size_t)(64 * kb_) * DM + 32 * nb_; ldw = DM; dst = (unsigned char*)(p.ws + WS_WD_T) + (size_t)(e_ * 1024 + 32 * nb_) * DEXP + 64 * kb_; ldt = DEXP; sc8 = F8_WD; } } while (0)
        float va[32], vb[32]; const float* Wa = nullptr; const float* Wb = nullptr; unsigned char* da = nullptr; unsigned char* db = nullptr; int lwa = 0, lwb = 0, lta = 0, ltb = 0; float sa = 1.f, sb = 1.f;
        int itA = gw, itB = gw + NGW;
        if (itA < I_ALL) { WCONV_ITEM(itA, Wa, lwa, da, lta, sa); tb_load(va, Wa, lwa, lane); }
        while (itA < I_ALL) {
            if (itB < I_ALL) { WCONV_ITEM(itB, Wb, lwb, db, ltb, sb); tb_load(vb, Wb, lwb, lane); }
            tb_store8(va, da, lta, sa, scr, lane);
            itA = itB + NGW;
            if (itB >= I_ALL) break;
            if (itA < I_ALL) { WCONV_ITEM(itA, Wa, lwa, da, lta, sa); tb_load(va, Wa, lwa, lane); }
            tb_store8(vb, db, ltb, sb, scr, lane);
            itB = itA + NGW;
        }
#undef WCONV_ITEM
        __syncthreads();
    }
    if constexpr (ST == ST_PROJ) {
        pg8::Gemm g{WSB(WS_HB), WSB(WS_WIN_T) + (size_t)l * DINP * DM, T, DINP, DM, DM};
        pg8::StaticOrder S; S.init(T, DINP, G, bid);
        EpiProj E{WSB(WS_PROJB), B_GATE(l)};
        pg8::gemm_phase<EpiProj, pg8::StaticOrder, true, true>((PG8_LAS unsigned char*)lds, g, S, E);
    }
    if constexpr (ST == ST_PREP) {
        const bf16_t* projb = WSB(WS_PROJB); bf16_t* br = WSB(WS_BR); bf16_t* U = (bf16_t*)lds;
        float* rq = WSF(WS_RQ); float* rkv = rq + T; const float* rc = WSF(WS_ROPE); const float* rs = rc + T * 16; bf16_t* kb = WSB(WS_KB);
        for (int tile = bid; tile < T / 64; tile += G) {
            const int b = tile / (SEQ / 64), s0 = (tile % (SEQ / 64)) * 64, t0 = b * SEQ + s0;
            __syncthreads();
#pragma unroll
            for (int it = 0; it < 10; ++it) { const int e = tid + it * NTHR, r = e >> 6, ch = e & 63, s = s0 - 8 + r;
                uint4 v = make_uint4(0u, 0u, 0u, 0u);
                if (s >= 0 && s < SEQ) v = *(const uint4*)(projb + (size_t)(b * SEQ + s) * DINP + OFF_POOL + ch * 8);
                *(uint4*)(U + r * 512 + ch * 8) = v; }
            for (int r = wid; r < 64; r += 8) { const bf16_t* row = projb + (size_t)(t0 + r) * DINP;
                float s1 = 0.f, s2 = 0.f;
                if (lane < 48) { const uint4 w = *(const uint4*)(row + OFF_CQ + lane * 8); const unsigned ww[4] = {w.x, w.y, w.z, w.w};
#pragma unroll
                    for (int q = 0; q < 4; ++q) { const float a = __uint_as_float(ww[q] << 16), c = __uint_as_float(ww[q] & 0xffff0000u); s1 += a * a + c * c; } }
                if (lane < 32) { const uint4 w = *(const uint4*)(row + OFF_CKV + lane * 8); const unsigned ww[4] = {w.x, w.y, w.z, w.w};
#pragma unroll
                    for (int q = 0; q < 4; ++q) { const float a = __uint_as_float(ww[q] << 16), c = __uint_as_float(ww[q] & 0xffff0000u); s2 += a * a + c * c; } }
                s1 = wave_sum(s1); s2 = wave_sum(s2);
                if (lane == 0) { rq[t0 + r] = 1.f / sqrtf(s1 * (1.f / 384.f) + RMS_EPS); rkv[t0 + r] = 1.f / sqrtf(s2 * (1.f / 256.f) + RMS_EPS); } }
#pragma unroll
            for (int it = 0; it < 2; ++it) { const int e = tid + it * NTHR, r = e >> 4, j = e & 15, t = t0 + r;
                const float c = rc[(size_t)t * 16 + j], s = rs[(size_t)t * 16 + j], x1 = PJ(t, OFF_KR + j), x2 = PJ(t, OFF_KR + 16 + j);
                const bf16_t k1 = (bf16_t)f2bf(x1 * c - x2 * s), k2 = (bf16_t)f2bf(x1 * s + x2 * c);
#pragma unroll
                for (int hh = 0; hh < 8; ++hh) { kb[(size_t)t * 768 + hh * 96 + 64 + j] = k1; kb[(size_t)t * 768 + hh * 96 + 80 + j] = k2; } }
            __syncthreads();
            { const int c = tid, hw = 1 << (c >> 7); float sum = 0.f;
                for (int u = s0 - hw; u < s0 + hw; ++u) if (u >= 0 && u < SEQ) sum += bf2f(U[(u - s0 + 8) * 512 + c]);
                for (int s = s0; s < s0 + 64; ++s) {
                    int lo = s - hw; if (lo < 0) lo = 0; int hi = s + hw; if (hi > SEQ) hi = SEQ;
                    br[(size_t)(b * SEQ + s) * 1536 + c] = (bf16_t)f2bf(sum / (float)(hi - lo) - bf2f(U[(s - s0 + 8) * 512 + c]));
                    if (s + hw < SEQ) sum += bf2f(U[(s + hw - s0 + 8) * 512 + c]);
                    if (s - hw >= 0) sum -= bf2f(U[(s - hw - s0 + 8) * 512 + c]);
                } }
        }
        __syncthreads();
    }
    if constexpr (ST == ST_SMALLGEMM) {
        const bf16_t* wsm = WSB(WS_WSMALL + (size_t)l * WSM_STRIDE);
        { pg8::Gemm g{WSB(WS_PROJB) + OFF_CQ, wsm + WSM_UQ / 2, T, 768, 384, DINP}; pg8::StaticOrder S; S.init(T, 768, G, bid);
          EpiQ E{WSB(WS_QB), WSF(WS_RQ), WSF(WS_ROPE), WSF(WS_ROPE) + T * 16}; pg8::gemm_phase<EpiQ, pg8::StaticOrder, true, true>((PG8_LAS unsigned char*)lds, g, S, E); }
        { pg8::Gemm g{WSB(WS_PROJB) + OFF_CKV, wsm + WSM_UKV / 2, T, 1024, 256, DINP}; pg8::StaticOrder S; S.init(T, 1024, G, bid);
          EpiKV E{WSB(WS_KB), WSB(WS_VB), WSF(WS_RQ) + T}; pg8::gemm_phase<EpiKV, pg8::StaticOrder, true, true>((PG8_LAS unsigned char*)lds, g, S, E); }
    }
    if constexpr (ST == ST_ATTN) {
        const int vcu = (G % 8 == 0) ? (bid % 8) * (G / 8) + bid / 8 : bid;
        for (int L = vcu; L < NB * 8 * 32; L += G) {
            const int bh = L >> 5, qb = L & 31, b = bh >> 3, hh = bh & 7;
            att::attn_unit(WSB(WS_QB) + (size_t)(b * SEQ + qb * 256) * 768 + hh * 96, WSB(WS_KB) + (size_t)(b * SEQ) * 768 + hh * 96, WSB(WS_VB) + (size_t)(b * SEQ) * 512 + hh * 64,
                           WSB(WS_BR) + (size_t)(b * SEQ + qb * 256) * 1536 + 512 + hh * 64, SEQ, (char*)lds);
        }
    }
    if constexpr (ST == ST_GLA1) {
        for (int item = bid; item < NB * 4 * 128; item += G) {
            const int b = item >> 9, hh = (item >> 7) & 3, c = item & 127;
            gla::g1_item((char*)lds, WSB(WS_PROJB), W_DEC(l), B_DEC(l), b, hh, c, WSF(WS_KVT), WSF(WS_DEC));
        }
    }
    if constexpr (ST == ST_GLA2) {
        const float* kvt = WSF(WS_KVT); const float* dec = WSF(WS_DEC); bf16_t* stp = WSB(WS_ST);
        for (long e = gt; e < 2L * 8 * 8192; e += NGT) {
            const int dir = (int)(e >> 16), bh = (int)((e >> 13) & 7), vd = (int)(e & 8191), d = vd & 63;
            const long base = ((long)dir * 8 + bh) * 128;
            float s = 0.f;
#pragma unroll 1
            for (int k0 = 0; k0 < 128; k0 += 32) {
                float kv[32], dc[32];
#pragma unroll
                for (int k = 0; k < 32; ++k) { const int c = dir ? 127 - (k0 + k) : k0 + k; kv[k] = kvt[(base + c) * 8192 + vd]; dc[k] = dec[(base + c) * 64 + d]; }
#pragma unroll
                for (int k = 0; k < 32; ++k) { const int c = dir ? 127 - (k0 + k) : k0 + k; stp[(base + c) * 8192 + vd] = (bf16_t)f2bf(s); s = fmaf(dc[k], s, kv[k]); }
            }
        }
    }
    if constexpr (ST == ST_GLA3) {
        for (int item = bid; item < NB * 4 * 128; item += G) {
            const int b = item >> 9, hh = (item >> 7) & 3, c = item & 127;
            gla::g3_item((char*)lds, WSB(WS_PROJB), W_DEC(l), B_DEC(l), GLA_NORM(l), b, hh, c, WSB(WS_ST), WSB(WS_BR) + 1024, 1536);
        }
    }
    if constexpr (ST == ST_MERGE_A) {
        const bf16_t* wsm = WSB(WS_WSMALL + (size_t)l * WSM_STRIDE);
        pg8::Gemm g{WSB(WS_BR), wsm + WSM_MRG / 2, T, DM, 1536, 1536}; pg8::StaticOrder S; S.init(T, DM, G, bid);
        EpiMerge E{WSB(WS_MERGEDB), WSB(WS_PROJB) + OFF_GATE};
        pg8::gemm_phase<EpiMerge, pg8::StaticOrder, true, true>((PG8_LAS unsigned char*)lds, g, S, E);
    }
    if constexpr (ST == ST_OUTP) {
        const bf16_t* wsm = WSB(WS_WSMALL + (size_t)l * WSM_STRIDE);
        pg8::Gemm g{WSB(WS_MERGEDB), wsm + WSM_OUT / 2, T, DM, DM, DM}; pg8::StaticOrder S; S.init(T, DM, G, bid);
        pg8::EpiBf16<0> E{WSB(WS_TMP), DM, nullptr, 0, 0, 1.f};
        pg8::gemm_phase<pg8::EpiBf16<0>, pg8::StaticOrder, true, true>((PG8_LAS unsigned char*)lds, g, S, E);
    }
    if constexpr (ST == ST_LN1) {
        float* RWT = lds; const float* rw = ROUTER(l);
        for (int i = tid; i < DM * 4; i += NTHR) { const int k = i >> 2, e4 = (i & 3) * 4; const float4 w = *(const float4*)(rw + (size_t)k * 16 + e4);
            RWT[(e4 + 0) * DM + k] = w.x; RWT[(e4 + 1) * DM + k] = w.y; RWT[(e4 + 2) * DM + k] = w.z; RWT[(e4 + 3) * DM + k] = w.w; }
        __syncthreads();
        float* afft = WSF(WS_AFF);
        for (int m0 = gw; m0 < T; m0 += 2 * NGW) {
            const int mr[2] = {m0, m0 + NGW};
            float4 hv[2][4];
#pragma unroll
            for (int u = 0; u < 2; ++u) { const bf16_t* hr = WSB(WS_HB) + (size_t)mr[u] * DM; const bf16_t* tr = WSB(WS_TMP) + (size_t)mr[u] * DM;
#pragma unroll
                for (int j = 0; j < 4; ++j) { float a[4], t4[4]; ld4bf(hr + 4 * (lane + 64 * j), a); ld4bf(tr + 4 * (lane + 64 * j), t4);
                    hv[u][j] = make_float4(fmaf(ALPHA, a[0], t4[0]), fmaf(ALPHA, a[1], t4[1]), fmaf(ALPHA, a[2], t4[2]), fmaf(ALPHA, a[3], t4[3])); } }
            ln_core2<1>(hv, LN1_G(l), LN1_B(l), nullptr, nullptr, WSB(WS_HB) + (size_t)mr[0] * DM, WSB(WS_HB) + (size_t)mr[1] * DM, lane,
                     p.ws + WS_HB8 + (size_t)mr[0] * DM, p.ws + WS_HB8 + (size_t)mr[1] * DM);
            float acc[2][16];
#pragma unroll
            for (int e = 0; e < 16; ++e) { float a0 = 0.f, a1 = 0.f;
#pragma unroll
                for (int j = 0; j < 4; ++j) { const float4 w = *(const float4*)(RWT + e * DM + 4 * (lane + 64 * j));
                    a0 = fmaf(hv[0][j].x, w.x, a0); a0 = fmaf(hv[0][j].y, w.y, a0); a0 = fmaf(hv[0][j].z, w.z, a0); a0 = fmaf(hv[0][j].w, w.w, a0);
                    a1 = fmaf(hv[1][j].x, w.x, a1); a1 = fmaf(hv[1][j].y, w.y, a1); a1 = fmaf(hv[1][j].z, w.z, a1); a1 = fmaf(hv[1][j].w, w.w, a1); }
                acc[0][e] = a0; acc[1][e] = a1; if (e & 1) __builtin_amdgcn_sched_barrier(0); }
#pragma unroll
            for (int i = 0; i < 8; ++i)
#pragma unroll
                for (int u = 0; u < 2; ++u) { const bool up = lane & 32; const float keep = up ? acc[u][i + 8] : acc[u][i], send = up ? acc[u][i] : acc[u][i + 8]; acc[u][i] = keep + __shfl_xor(send, 32); }
#pragma unroll
            for (int i = 0; i < 4; ++i)
#pragma unroll
                for (int u = 0; u < 2; ++u) { const bool up = lane & 16; const float keep = up ? acc[u][i + 4] : acc[u][i], send = up ? acc[u][i] : acc[u][i + 4]; acc[u][i] = keep + __shfl_xor(send, 16); }
#pragma unroll
            for (int i = 0; i < 2; ++i)
#pragma unroll
                for (int u = 0; u < 2; ++u) { const bool up = lane & 8; const float keep = up ? acc[u][i + 2] : acc[u][i], send = up ? acc[u][i] : acc[u][i + 2]; acc[u][i] = keep + __shfl_xor(send, 8); }
#pragma unroll
            for (int u = 0; u < 2; ++u) { const bool up = lane & 4; const float keep = up ? acc[u][1] : acc[u][0], send = up ? acc[u][0] : acc[u][1]; acc[u][0] = keep + __shfl_xor(send, 4); }
            float lg[2] = {acc[0][0], acc[1][0]};
#pragma unroll
            for (int o = 1; o <= 2; o <<= 1) { const float t0 = __shfl_xor(lg[0], o), t1 = __shfl_xor(lg[1], o); lg[0] += t0; lg[1] += t1; }
            float mx[2] = {lg[0], lg[1]};
#pragma unroll
            for (int o = 4; o <= 32; o <<= 1) { const float t0 = __shfl_xor(mx[0], o), t1 = __shfl_xor(mx[1], o); mx[0] = fmaxf(mx[0], t0); mx[1] = fmaxf(mx[1], t1); }
            const float ex[2] = {expf(lg[0] - mx[0]), expf(lg[1] - mx[1])}; float se[2] = {ex[0], ex[1]};
#pragma unroll
            for (int o = 4; o <= 32; o <<= 1) { const float t0 = __shfl_xor(se[0], o), t1 = __shfl_xor(se[1], o); se[0] += t0; se[1] += t1; }
            if ((lane & 3) == 0) { const int e = ((lane >> 5) & 1) * 8 + ((lane >> 4) & 1) * 4 + ((lane >> 3) & 1) * 2 + ((lane >> 2) & 1);
#pragma unroll
                for (int u = 0; u < 2; ++u) afft[(size_t)((mr[u] / SEQ) * 16 + e) * SEQ + (mr[u] % SEQ)] = ex[u] / se[u]; }
        }
        __syncthreads();
    }
    if constexpr (ST == ST_TOPK) {
        const float* afft = WSF(WS_AFF); int* idx = WSI(WS_IDX); float* gv = WSF(WS_GATEV); int* slot = WSI(WS_SLOT);
        int* hist = (int*)lds; int* ctl = hist + 256; int* scr = hist + 272;
        for (int z = bid; z < NZ; z += G) {
            const int e = z >> 1, b = z & 1; const float* list = afft + (size_t)(b * 16 + e) * SEQ;
            unsigned key[16];
#pragma unroll
            for (int j = 0; j < 16; j += 4) { const float4 x = *(const float4*)(list + tid * 16 + j); key[j] = __float_as_uint(x.x); key[j + 1] = __float_as_uint(x.y); key[j + 2] = __float_as_uint(x.z); key[j + 3] = __float_as_uint(x.w); }
            unsigned prefix = 0u; int need = CAP;
#pragma unroll 1
            for (int shift = 24; shift >= 0; shift -= 8) {
                __syncthreads();
                if (tid < 256) hist[tid] = 0;
                __syncthreads();
#pragma unroll
                for (int j = 0; j < 16; ++j) { const bool in = (shift == 24) || ((key[j] >> (shift + 8)) == (prefix >> (shift + 8))); if (in) atomicAdd(&hist[(key[j] >> shift) & 255u], 1); }
                __syncthreads();
                if (tid < 256) {
                    const int hc = hist[tid]; int inc = hc;
#pragma unroll
                    for (int o = 1; o < 64; o <<= 1) { const int y = __shfl_down(inc, o); if (lane + o < 64) inc += y; }
                    if (lane == 0) scr[wid] = inc;
                    __builtin_amdgcn_s_waitcnt(0xc07f); __builtin_amdgcn_wave_barrier();
                }
                __syncthreads();
                if (tid < 256) {
                    const int hc = hist[tid]; int inc = hc;
#pragma unroll
                    for (int o = 1; o < 64; o <<= 1) { const int y = __shfl_down(inc, o); if (lane + o < 64) inc += y; }
                    int ca = inc - hc;
#pragma unroll
                    for (int w = 1; w < 4; ++w) ca += (w > wid) ? scr[w] : 0;
                    if (ca < need && need <= ca + hc) { ctl[0] = tid; ctl[1] = need - ca; } }
                __syncthreads();
                prefix |= (unsigned)ctl[0] << shift; need = ctl[1];
            }
            int ceq = 0;
#pragma unroll
            for (int j = 0; j < 16; ++j) ceq += (key[j] == prefix) ? 1 : 0;
            int tot; const int beq = block_excl_scan(ceq, scr, tid, tot);
            int csel = 0, eqr = beq; unsigned selmask = 0u;
#pragma unroll
            for (int j = 0; j < 16; ++j) { bool sel = key[j] > prefix; if (key[j] == prefix) { sel = eqr < need; ++eqr; } if (sel) { selmask |= 1u << j; ++csel; } }
            int sl = block_excl_scan(csel, scr, tid, tot);
#pragma unroll
            for (int j = 0; j < 16; ++j) { const int trow = b * SEQ + tid * 16 + j;
                if ((selmask >> j) & 1u) { idx[z * CAP + sl] = trow; gv[z * CAP + sl] = __uint_as_float(key[j]); slot[(size_t)trow * 16 + e] = sl; ++sl; }
                else slot[(size_t)trow * 16 + e] = -1; }
        }
        __syncthreads();
    }
    if constexpr (ST == ST_GATHER) {
        const int* idx = WSI(WS_IDX); const bf16_t* hb = WSB(WS_HB); bf16_t* xe = WSB(WS_XE);
        const int nr = (NZ * CAP - gw + NGW - 1) / NGW; const int myi = (lane < nr) ? (idx[gw + lane * NGW] & (T - 1)) : 0;
        for (int k = 0; k < nr; k += 4) {
            const int k1 = (k + 1 < nr) ? k + 1 : k, k2 = (k + 2 < nr) ? k + 2 : k, k3 = (k + 3 < nr) ? k + 3 : k;
            const uint4* s0 = (const uint4*)(hb + (size_t)__shfl(myi, k) * DM); const uint4* s1 = (const uint4*)(hb + (size_t)__shfl(myi, k1) * DM);
            const uint4* s2 = (const uint4*)(hb + (size_t)__shfl(myi, k2) * DM); const uint4* s3 = (const uint4*)(hb + (size_t)__shfl(myi, k3) * DM);
            const uint4 x0 = s0[lane], y0 = s0[lane + 64], x1 = s1[lane], y1 = s1[lane + 64], x2 = s2[lane], y2 = s2[lane + 64], x3 = s3[lane], y3 = s3[lane + 64];
            { uint4* d = (uint4*)(xe + (size_t)(gw + k * NGW) * DM); d[lane] = x0; d[lane + 64] = y0; }
            if (k + 1 < nr) { uint4* d = (uint4*)(xe + (size_t)(gw + (k + 1) * NGW) * DM); d[lane] = x1; d[lane + 64] = y1; }
            if (k + 2 < nr) { uint4* d = (uint4*)(xe + (size_t)(gw + (k + 2) * NGW) * DM); d[lane] = x2; d[lane + 64] = y2; }
            if (k + 3 < nr) { uint4* d = (uint4*)(xe + (size_t)(gw + (k + 3) * NGW) * DM); d[lane] = x3; d[lane + 64] = y3; }
        }
    }
    if constexpr (ST == ST_EXP_G) {
        pg8::Gemm g{WSB(WS_HB8), WSB(WS_WGU_T), NZ * CAP, 16 * 4096, DM / 2, DM / 2, WSI(WS_IDX)};
        ExpertOrder1 S; S.init(G, bid);
        EpiSwiGLU E{WSB(WS_HID), DEXP};
        pg8::gemm_phase<EpiSwiGLU, ExpertOrder1, true, true, true, true>((PG8_LAS unsigned char*)lds, g, S, E);
    }
    if constexpr (ST == ST_EXP_D) {
        pg8::Gemm g{WSB(WS_HID), WSB(WS_WD_T), NZ * CAP, 16 * 1024, DEXP / 2, DEXP / 2};
        ExpertOrder2 S; S.init(G, bid);
        EpiRowScale E{WSB(WS_YE), DM, WSF(WS_GATEV)};
        pg8::gemm_phase<EpiRowScale, ExpertOrder2, true, true, false, true>((PG8_LAS unsigned char*)lds, g, S, E);
    }
    if constexpr (ST == ST_LN2) {
        const int* slot = WSI(WS_SLOT); const bf16_t* ye = WSB(WS_YE);
        for (int m0 = gw; m0 < T; m0 += 2 * NGW) {
            const int mr[2] = {m0, m0 + NGW};
            int sl[2]; unsigned long long mask[2]; float4 a[2][4];
#pragma unroll
            for (int u = 0; u < 2; ++u) { sl[u] = (lane < 16) ? slot[(size_t)mr[u] * 16 + lane] : -1; }
#pragma unroll
            for (int u = 0; u < 2; ++u) { const bf16_t* hr = WSB(WS_HB) + (size_t)mr[u] * DM;
#pragma unroll
                for (int j = 0; j < 4; ++j) { float x[4]; ld4bf(hr + 4 * (lane + 64 * j), x); a[u][j] = make_float4(ALPHA * x[0], ALPHA * x[1], ALPHA * x[2], ALPHA * x[3]); } }
            mask[0] = __ballot(sl[0] >= 0); mask[1] = __ballot(sl[1] >= 0);
            while (mask[0] | mask[1]) {
#pragma unroll
                for (int u = 0; u < 2; ++u) if (mask[u]) {
                    const int e = __builtin_ctzll(mask[u]); mask[u] &= mask[u] - 1;
                    const bf16_t* yr = ye + ((size_t)(e * 2 + mr[u] / SEQ) * CAP + __shfl(sl[u], e)) * DM;
#pragma unroll
                    for (int j = 0; j < 4; ++j) { float y[4]; ld4bf(yr + 4 * (lane + 64 * j), y); a[u][j].x += y[0]; a[u][j].y += y[1]; a[u][j].z += y[2]; a[u][j].w += y[3]; }
                }
            }
            if (l == 0) ln_core2<0>(a, LN2_G(l), LN2_B(l), nullptr, nullptr, WSB(WS_HB) + (size_t)mr[0] * DM, WSB(WS_HB) + (size_t)mr[1] * DM, lane);
            else ln_core2<2>(a, LN2_G(l), LN2_B(l), h + (size_t)mr[0] * DM, h + (size_t)mr[1] * DM, nullptr, nullptr, lane);
        }
    }
}


#define LAS __attribute__((address_space(3)))
#define XB_TMO      128
#define XB_XCNT(j)  (256  + 64 * (j))
#define XB_XSUB(j)  (1280 + 64 * (j))
#define XB_XGEN(j)  (2304 + 64 * (j))
#define XB_TOP      3328
#define XB_TOPGEN   3392
#define XCD_BAR_WORDS 3456
#define XB_SPIN_CAP (1u << 18)
__device__ __forceinline__ unsigned xb_ld(unsigned* p)              { return __hip_atomic_load(p, __ATOMIC_RELAXED, __HIP_MEMORY_SCOPE_AGENT); }
__device__ __forceinline__ unsigned xb_add(unsigned* p, unsigned v) { return __hip_atomic_fetch_add(p, v, __ATOMIC_RELAXED, __HIP_MEMORY_SCOPE_AGENT); }
__device__ __forceinline__ unsigned xb_xcc_id() { return (unsigned)__builtin_amdgcn_s_getreg((3 << 11) | 20) & 0xFu; }
#define XB_SPIN(cond, bar) do { unsigned _sp = 0; while (cond) { __builtin_amdgcn_s_sleep(1); \
    if ((++_sp & 255u) == 0u) { if (xb_ld(&(bar)[XB_TMO])) break; if (_sp > XB_SPIN_CAP) { atomicAdd(&(bar)[XB_TMO], 1u); break; } } } } while (0)
struct XcdBarrier { unsigned* bar; unsigned x; volatile LAS unsigned* st; };
__device__ __forceinline__ XcdBarrier xcd_barrier_post(unsigned* bar, volatile LAS unsigned* st) {
    XcdBarrier b; b.bar = bar; b.x = xb_xcc_id(); b.st = st;
    if (threadIdx.x == 0) (void)xb_add(&bar[XB_XCNT(b.x)], 1u);
    return b;
}
__device__ __forceinline__ void xcd_barrier_complete(unsigned* bar, unsigned x, unsigned& nloc, unsigned& nx) {
    const unsigned G = gridDim.x * gridDim.y * gridDim.z;
    unsigned sum, cnt, mine, sp = 0u;
    for (;;) {
        sum = 0u; cnt = 0u; mine = 0u;
#pragma unroll
        for (unsigned j = 0; j < 16; ++j) { const unsigned c = xb_ld(&bar[XB_XCNT(j)]); sum += c; cnt += (c > 0u) ? 1u : 0u; mine = (j == x) ? c : mine; }
        if (sum == G) break;
        __builtin_amdgcn_s_sleep(1);
        if ((++sp & 255u) == 0u) { if (xb_ld(&bar[XB_TMO])) break; if (sp > XB_SPIN_CAP) { atomicAdd(&bar[XB_TMO], 1u); break; } }
    }
    nloc = mine > 0u ? mine : 1u; nx = cnt > 0u ? cnt : 1u;
}
__device__ __forceinline__ void xcd_barrier(const XcdBarrier& b) {
    asm volatile("s_waitcnt vmcnt(0)" ::: "memory");
    __syncthreads();
    if (threadIdx.x == 0) {
        unsigned* bar = b.bar; asm volatile("" : "+s"(bar));
        unsigned bx = b.x; asm volatile("" : "+s"(bx));
        __builtin_amdgcn_s_waitcnt(0);
        unsigned nloc = b.st[0], nx = b.st[1];
        if (nloc == 0u) { xcd_barrier_complete(bar, bx, nloc, nx); b.st[0] = nloc; b.st[1] = nx; }
        const unsigned old = xb_add(&bar[XB_XSUB(bx)], 1u);
        const unsigned gen = old / nloc;
        if (old + 1u == (gen + 1u) * nloc) {
            __builtin_amdgcn_fence(__ATOMIC_RELEASE, "agent");
            asm volatile("s_waitcnt vmcnt(0)" ::: "memory");
            const unsigned og = xb_add(&bar[XB_TOP], 1u);
            const unsigned tg = og / nx;
            if (og + 1u == (tg + 1u) * nx) xb_add(&bar[XB_TOPGEN], 1u);
            else XB_SPIN(xb_ld(&bar[XB_TOPGEN]) == tg, bar);
            __builtin_amdgcn_fence(__ATOMIC_ACQUIRE, "agent");
            xb_add(&bar[XB_XGEN(bx)], 1u);
            asm volatile("s_waitcnt vmcnt(0)" ::: "memory");
        } else {
            XB_SPIN(xb_ld(&bar[XB_XGEN(bx)]) == gen, bar);
            __builtin_amdgcn_fence(__ATOMIC_ACQUIRE, "agent");
            asm volatile("s_waitcnt vmcnt(0)" ::: "memory");
        }
    }
    __syncthreads();
}
constexpr int MISC_OFF = 131072 + 320;
constexpr int CW_BAR = 4096;

__global__ void __launch_bounds__(NTHR) mega_fwd(Params p) {
    extern __shared__ __attribute__((aligned(16))) unsigned char lds_raw[];
    float* lds = (float*)lds_raw;
    volatile LAS unsigned* MISC = (volatile LAS unsigned*)((LAS unsigned char*)lds_raw + MISC_OFF);
    if (threadIdx.x < 32) MISC[threadIdx.x] = 0u;
    __syncthreads();
    unsigned char* ws_ = ((const KAS Params*)__builtin_amdgcn_kernarg_segment_ptr())->ws;
    XcdBarrier bar = xcd_barrier_post((unsigned*)(ws_ + WS_CTL) + CW_BAR, MISC + 8);
#define GB() xcd_barrier(bar)
    run_stage<ST_INIT>(0, lds); GB();
    for (int step = 0; step < 2 * 11; ++step) {
        const int l = step / 11, s = step % 11;
        switch (s) {
        case 0: for (int sub = 0; sub < 2; ++sub) { if (((int)(blockIdx.x & 1) ^ sub) != 0) run_stage<ST_WCONV>(l, lds); else run_stage<ST_PROJ>(l, lds); } break;
        case 1: run_stage<ST_PREP>(l, lds); run_stage<ST_GLA1>(l, lds); break;
        case 2: run_stage<ST_SMALLGEMM>(l, lds); run_stage<ST_GLA2>(l, lds); break;
        case 3: run_stage<ST_ATTN>(l, lds); run_stage<ST_GLA3>(l, lds); break;
        case 4: run_stage<ST_MERGE_A>(l, lds); break;
        case 5: run_stage<ST_OUTP>(l, lds); break;
        case 6: run_stage<ST_LN1>(l, lds); break;
        case 7: run_stage<ST_TOPK>(l, lds); break;
        case 8: run_stage<ST_EXP_G>(l, lds); break;
        case 9: run_stage<ST_EXP_D>(l, lds); break;
        default: run_stage<ST_LN2>(l, lds); break;
        }
        if (step + 1 < 2 * 11) GB();
    }
#undef GB
}

template <int ST>
__global__ void __launch_bounds__(NTHR) k_stage(Params p, int l) {
    extern __shared__ __attribute__((aligned(16))) unsigned char lds_raw[];
    run_stage<ST>(l, (float*)lds_raw);
}

template <int ST> static void launch_stage(const Params& p, int l, int grid, hipStream_t stream) {
    static bool attr = false;
    if (!attr) { (void)hipFuncSetAttribute((const void*)k_stage<ST>, hipFuncAttributeMaxDynamicSharedMemorySize, LDS_BYTES); attr = true; }
    hipLaunchKernelGGL(k_stage<ST>, dim3(grid), dim3(NTHR), LDS_BYTES, stream, p, l);
}

extern "C" void kernel_launch(void* const* d_in, const int* in_sizes, int n_in, void* d_out, int out_size, void* d_ws, size_t ws_size, hipStream_t stream) {
    if (n_in != 27 || out_size != T * DM || ws_size < WS_END) {
        fprintf(stderr, "kernel_launch: unexpected shapes: n_in %d out %d ws %zu (need >= %zu)\n", n_in, out_size, ws_size, (size_t)WS_END);
        return;
    }
    Params p{};
    for (int i = 0; i < 27; ++i) p.in[i] = (const float*)d_in[i];
    p.pos = (const int*)d_in[1]; p.out = (float*)d_out; p.ws = (unsigned char*)d_ws;
    const int grid = 256;
#if MEGA
    static bool attr = false;
    if (!attr) { (void)hipFuncSetAttribute((const void*)mega_fwd, hipFuncAttributeMaxDynamicSharedMemorySize, LDS_BYTES); attr = true; }
    (void)hipMemsetAsync((char*)d_ws + WS_CTL, 0, 65536, stream);
    hipLaunchKernelGGL(mega_fwd, dim3(grid), dim3(NTHR), LDS_BYTES, stream, p);
#else
    launch_stage<ST_INIT>(p, 0, grid, stream);
    for (int l = 0; l < 2; ++l) {
        launch_stage<ST_PROJ>(p, l, grid, stream);
        launch_stage<ST_PREP>(p, l, grid, stream);
        launch_stage<ST_SMALLGEMM>(p, l, grid, stream);
        launch_stage<ST_ROPE>(p, l, grid, stream);
        launch_stage<ST_ATTN>(p, l, grid, stream);
        launch_stage<ST_GLAREC>(p, l, grid, stream);
        launch_stage<ST_GLAFIN>(p, l, grid, stream);
        launch_stage<ST_MERGE_A>(p, l, grid, stream);
        launch_stage<ST_MERGE_B>(p, l, grid, stream);
        launch_stage<ST_MERGE_C>(p, l, grid, stream);
        launch_stage<ST_OUTP>(p, l, grid, stream);
        launch_stage<ST_LN1>(p, l, grid, stream);
        launch_stage<ST_TOPK>(p, l, grid, stream);
        launch_stage<ST_EXP_G>(p, l, grid, stream);
        launch_stage<ST_EXP_U>(p, l, grid, stream);
        launch_stage<ST_EXP_D>(p, l, grid, stream);
        launch_stage<ST_LN2>(p, l, grid, stream);
    }
#endif
}
```

```cpp
#include <hip/hip_runtime.h>
#include <cstdio>
#include <cstdint>

#ifndef MEGA
#define MEGA 1
#endif

constexpr int NB = 2, SEQ = 8192, T = NB * SEQ, DM = 1024, DIN = 5824, DINP = 5888;
constexpr int OFF_GATE = 0, OFF_POOL = 3072, OFF_CQ = 3072 + 512, OFF_CKV = 3072 + 896, OFF_KR = 3072 + 1152, OFF_GQ = 3072 + 1184, OFF_GK = 3072 + 1440, OFF_GV = 3072 + 1696, OFF_GR = 3072 + 2208, OFF_GDEC = 3072 + 2720;
constexpr int NE = 16, CAP = 1024, DEXP = 2048, NZ = NB * NE;
constexpr float ALPHA = 1.4142135623730951f;
constexpr float LN_EPS = 1e-5f, RMS_EPS = 1e-6f;
constexpr int NTHR = 512, LDS_BYTES = 147456;

constexpr size_t MiB = 1u << 20;
constexpr size_t WS_CTL = 0;
constexpr size_t WS_ROPE = 1 * MiB;
constexpr size_t WS_AFF = 3 * MiB;
constexpr size_t WS_SLOT = 4 * MiB;
constexpr size_t WS_IDX = 5 * MiB;
constexpr size_t WS_GATEV = 5 * MiB + 256 * 1024;
constexpr size_t WS_WIN_T = 8 * MiB;
constexpr size_t WS_WSMALL = 31 * MiB;
constexpr size_t WSM_UQ = 0, WSM_UKV = 1 * MiB, WSM_MRG = 2 * MiB, WSM_OUT = 5 * MiB, WSM_STRIDE = 7 * MiB;
constexpr size_t WS_RQ = 6 * MiB;
constexpr size_t WS_HB = 958 * MiB;
constexpr size_t WS_WGU_T = 76 * MiB;
constexpr size_t WS_WD_T = 204 * MiB;
constexpr size_t WS_PROJB = 268 * MiB;
constexpr size_t WS_XE = 268 * MiB;
constexpr size_t WS_HID = 332 * MiB;
constexpr size_t WS_YE = 460 * MiB;
constexpr size_t WS_BR = 452 * MiB;
constexpr size_t WS_HB8 = 500 * MiB;
constexpr size_t WS_QB = 556 * MiB;
constexpr size_t WS_KB = 580 * MiB;
constexpr size_t WS_VB = 604 * MiB;
constexpr size_t WS_KVT = 702 * MiB;
constexpr size_t WS_ST = 766 * MiB;
constexpr size_t WS_DEC = 798 * MiB;
constexpr size_t WS_MERGEDB = 830 * MiB;
constexpr size_t WS_TMP = 894 * MiB;
constexpr size_t WS_END = 990 * MiB;
static_assert(WS_YE + 64 * MiB <= WS_QB, "overlay map");

namespace pg8 {
#define PG8_LAS __attribute__((address_space(3)))
typedef unsigned short bf16_t;
typedef short bf16x8 __attribute__((ext_vector_type(8)));
typedef float f32x4 __attribute__((ext_vector_type(4)));
typedef unsigned u32x4 __attribute__((ext_vector_type(4)));
constexpr int BM = 256, BK = 64, HALF = 128, HTB = HALF * BK * 2  , STAGE_BYTES = 8 * HTB, NXCD = 8, WGM = 8;

__host__ __device__ __forceinline__ int lds_byte(int r, int c) { const int st = (r >> 4) * 2 + (c >> 5), rr = r & 15, cc = c & 31, ob = rr * 64 + cc * 2; return st * 1024 + (ob ^ (((ob >> 9) & 1) << 5)); }
__host__ __device__ __forceinline__ void stage_rc(int b, int& R, int& C) { const int st = b / 1024, sb = b % 1024, swz = sb ^ (((sb >> 9) & 1) << 5); R = (st >> 1) * 16 + swz / 64; C = (st & 1) * 32 + (swz % 64) / 2; }
__host__ __device__ __forceinline__ int perm32(int rho) { const int n = rho >> 4, i = rho & 15; return 8 * (i >> 2) + 4 * n + (i & 3); }

struct Unit { int pm, pn; };
struct Gemm { const bf16_t* A; const bf16_t* Bt; int M, N, K, lda; const int* ridx; };

struct StaticOrder {
    int nM, nN, nwg, G, c;
    __host__ __device__ void init(int M, int N, int G_, int c_) { nM = M / BM; nN = N / BM; nwg = nM * nN; G = G_; c = c_; }
    __host__ __device__ bool next(int i, Unit& u) const {
        const long L = (long)i * G + c; if (L >= nwg) return false;
        int wgid = (int)L; { const int q = nwg / NXCD, r = nwg % NXCD, xcd = wgid % NXCD, off = wgid / NXCD; wgid = (xcd < r ? xcd * (q + 1) : r * (q + 1) + (xcd - r) * q) + off; }
        const int nig = WGM * nN, gid = wgid / nig, fm = gid * WGM, gsz = (nM - fm) < WGM ? (nM - fm) : WGM;
        u.pm = fm + ((wgid % nig) % gsz); u.pn = (wgid % nig) / gsz; return true;
    }
    __device__ __forceinline__ void a_ready(const Unit&) const {}
    __device__ __forceinline__ void done(const Unit&) const {}
};

__device__ __forceinline__ unsigned cvt_pk_bf16(float lo, float hi) { unsigned r; asm volatile("v_cvt_pk_bf16_f32 %0, %1, %2" : "=v"(r) : "v"(lo), "v"(hi)); return r; }
typedef float f32x2 __attribute__((ext_vector_type(2)));
__device__ __forceinline__ f32x2 gelu_pk(f32x2 v) {
    const f32x2 av = __builtin_elementwise_abs(v), d = av * 0.2316418882f + 1.0f;
    f32x2 t; t.x = __builtin_amdgcn_rcpf(d.x); t.y = __builtin_amdgcn_rcpf(d.y);
    f32x2 q = t * 0.5307027145f + (-0.7265760135f); q = q * t + 0.7107068705f; q = q * t + (-0.142248368f); q = q * t + 0.127414796f; q = q * t;
    const f32x2 s = (v * v) * (-0.72134752044f);
    f32x2 e; e.x = __builtin_amdgcn_exp2f(s.x); e.y = __builtin_amdgcn_exp2f(s.y);
    const f32x2 m = v * (q * e), r = v - m;
    f32x2 o; o.x = v.x < 0.f ? m.x : r.x; o.y = v.y < 0.f ? m.y : r.y; return o;
}

template <int ACT  > struct EpiBf16 {
    static constexpr bool PERM = true, AFTER_DRAIN = false; static constexpr int SEG = 0; static_assert(ACT == 0 || ACT == 1, "EpiBf16: ACT is 0 (none) or 1 (gelu_pk)");
    bf16_t* O; int ldc; const float* bias; int split_cols; size_t split_stride; float scale0;
    __device__ __forceinline__ void operator()(const f32x4 (&acc)[2][2][4][2], const Unit& u, int wr, int wc, int fr, int fq) const {
        const int row0 = u.pm * BM + wr * 64 + fr; int colt = u.pn * BM; bf16_t* base = O;
        float sc = 1.f; if (split_cols) { const int t = colt / split_cols; base += (size_t)t * split_stride; colt -= t * split_cols; if (t == 0) sc = scale0; }
        const int col0 = colt + wc * 32 + 8 * fq, bcol0 = u.pn * BM + wc * 32 + 8 * fq;
        f32x4 bv[2][2];
#pragma unroll
        for (int bj = 0; bj < 2; ++bj)
#pragma unroll
            for (int n = 0; n < 2; ++n) bv[bj][n] = bias ? *(const f32x4*)(bias + bcol0 + bj * HALF + 4 * n) : (f32x4){0.f, 0.f, 0.f, 0.f};
#pragma unroll
        for (int ai = 0; ai < 2; ++ai)
#pragma unroll
            for (int m = 0; m < 4; ++m) { bf16_t* rowp = base + (size_t)(row0 + ai * HALF + m * 16) * ldc + col0;
#pragma unroll
                for (int bj = 0; bj < 2; ++bj) { f32x4 v0 = acc[ai][bj][m][0] + bv[bj][0], v1 = acc[ai][bj][m][1] + bv[bj][1];
                    if (ACT == 1) { f32x2 a = gelu_pk((f32x2){v0[0], v0[1]}), b = gelu_pk((f32x2){v0[2], v0[3]}), c = gelu_pk((f32x2){v1[0], v1[1]}), d = gelu_pk((f32x2){v1[2], v1[3]});
                        v0 = (f32x4){a.x, a.y, b.x, b.y}; v1 = (f32x4){c.x, c.y, d.x, d.y}; }
                    v0 = v0 * sc; v1 = v1 * sc; u32x4 w; w.x = cvt_pk_bf16(v0[0], v0[1]); w.y = cvt_pk_bf16(v0[2], v0[3]); w.z = cvt_pk_bf16(v1[0], v1[1]); w.w = cvt_pk_bf16(v1[2], v1[3]);
                    *(u32x4*)(rowp + bj * HALF) = w; } }
    }
};

struct PanelStats {
    unsigned* xbuf;
    unsigned* cnt;
    unsigned* tmo;
    int ntn; float eps;
    unsigned code;
    __device__ __forceinline__ bool run(const f32x4 (&v)[2][2][4][2], const Unit& u, int wr, int wc, int fr, int fq, PG8_LAS unsigned char* lds, int wid, int lane) const {
        typedef float f32x2v __attribute__((ext_vector_type(2)));
        PG8_LAS f32x2v* P = (PG8_LAS f32x2v*)lds;
        PG8_LAS f32x2v* S = (PG8_LAS f32x2v*)(lds + 8192);
        PG8_LAS unsigned* flag = (PG8_LAS unsigned*)(lds + 8192 + 2048);
#pragma unroll
        for (int ai = 0; ai < 2; ++ai)
#pragma unroll
            for (int m = 0; m < 4; ++m) {
                float s = 0.f;
#pragma unroll
                for (int bj = 0; bj < 2; ++bj)
#pragma unroll
                    for (int n = 0; n < 2; ++n) { const f32x4 x = v[ai][bj][m][n]; s += (x[0] + x[1]) + (x[2] + x[3]); }
                s += __shfl_xor(s, 16); s += __shfl_xor(s, 32);
                const float mw = s * (1.0f / 64.0f); float q = 0.f;
#pragma unroll
                for (int bj = 0; bj < 2; ++bj)
#pragma unroll
                    for (int n = 0; n < 2; ++n) { const f32x4 d = v[ai][bj][m][n] - mw; q += (d[0] * d[0] + d[1] * d[1]) + (d[2] * d[2] + d[3] * d[3]); }
                q += __shfl_xor(q, 16); q += __shfl_xor(q, 32);
                if (fq == 0) P[(ai * HALF + wr * 64 + m * 16 + fr) * 4 + wc] = (f32x2v){mw, q};
            }
        asm volatile("s_waitcnt lgkmcnt(0)" ::: "memory"); __builtin_amdgcn_s_barrier(); asm volatile("" ::: "memory");
#if defined(BROKEN_EXCHANGE_NO_WAIT)
#warning BROKEN CONTROL BUILD: the row-statistics exchange does not wait; results are wrong by design
        if (blockIdx.x >= 64) { const long long t0_ = clock64(); while (clock64() - t0_ < 60000) __builtin_amdgcn_s_sleep(8); }
#endif
        const int row = wid * 32 + (lane & 31);
        if (lane < 32) {
            const f32x2v a = P[row * 4 + 0], b = P[row * 4 + 1], c = P[row * 4 + 2], d = P[row * 4 + 3];
            const float mt = (a.x + b.x + c.x + d.x) * 0.25f;
            const float da = a.x - mt, db = b.x - mt, dc = c.x - mt, dd = d.x - mt;
            const float m2 = (a.y + b.y) + (c.y + d.y) + 64.0f * ((da * da + db * db) + (dc * dc + dd * dd));
            unsigned long long* slot = (unsigned long long*)xbuf + ((size_t)(u.pm * BM + row) * 4 + u.pn);
            __hip_atomic_store(slot, ((unsigned long long)__float_as_uint(m2) << 32) | __float_as_uint(mt), __ATOMIC_RELAXED, __HIP_MEMORY_SCOPE_AGENT);
        }
        asm volatile("s_waitcnt vmcnt(0)" ::: "memory");
        if (lane == 0) __hip_atomic_fetch_add(cnt + 64 * u.pm, 1u, __ATOMIC_RELAXED, __HIP_MEMORY_SCOPE_AGENT);
        if (wid == 0) {
            bool dead = false; const unsigned long long t0 = __builtin_amdgcn_s_memrealtime(); const unsigned want = 8u * (unsigned)ntn;
            for (;;) {
#if defined(BROKEN_EXCHANGE_NO_WAIT)
                break;
#endif
                if ((unsigned)__builtin_amdgcn_readfirstlane(__hip_atomic_load(cnt + 64 * u.pm, __ATOMIC_RELAXED, __HIP_MEMORY_SCOPE_AGENT)) >= want) break;
                if (__builtin_amdgcn_s_memrealtime() - t0 > 2000000ull) {
                    if (lane == 0) { unsigned expect = 0u; __hip_atomic_compare_exchange_strong(tmo + 1, &expect, code | (unsigned)(u.pm & 0xff), __ATOMIC_RELAXED, __ATOMIC_RELAXED, __HIP_MEMORY_SCOPE_AGENT);
                                     __hip_atomic_store(tmo, 1u, __ATOMIC_RELAXED, __HIP_MEMORY_SCOPE_AGENT); }
                    dead = true; break; }
                __builtin_amdgcn_s_sleep(2);
            }
            __builtin_amdgcn_fence(__ATOMIC_ACQUIRE, "agent");
            if (lane == 0) flag[0] = dead ? 1u : 0u;
        }
        asm volatile("s_waitcnt vmcnt(0) lgkmcnt(0)" ::: "memory"); __builtin_amdgcn_s_barrier(); asm volatile("" ::: "memory");
        const bool bad = flag[0] != 0u;
        if (lane < 32) {
            const unsigned long long* slot = (const unsigned long long*)xbuf + (size_t)(u.pm * BM + row) * 4; float mt[4], m2[4]; float ms = 0.f;
#pragma unroll
            for (int t = 0; t < 4; ++t) { if (t < ntn) { const unsigned long long w = __hip_atomic_load(slot + t, __ATOMIC_RELAXED, __HIP_MEMORY_SCOPE_AGENT); mt[t] = __uint_as_float((unsigned)w); m2[t] = __uint_as_float((unsigned)(w >> 32)); } else { mt[t] = 0.f; m2[t] = 0.f; } ms += mt[t]; }
            const float mean = ms / (float)ntn; float q = 0.f;
#pragma unroll
            for (int t = 0; t < 4; ++t) if (t < ntn) { const float dm = mt[t] - mean; q += m2[t] + 256.0f * dm * dm; }
            S[row] = (f32x2v){mean, 1.0f / sqrtf(q / (256.0f * (float)ntn) + eps)};
        }
        asm volatile("s_waitcnt lgkmcnt(0)" ::: "memory"); __builtin_amdgcn_s_barrier(); asm volatile("" ::: "memory");
        return bad;
    }
};
struct EpiLnRes {
    static constexpr bool PERM = false, AFTER_DRAIN = true; static constexpr int SEG = 0;
    const float* base; float* out; int ldc; const float* bias; PanelStats st; unsigned poison;
    __device__ __forceinline__ void fused(f32x4 (&acc)[2][2][4][2], const Unit& u, int wr, int wc, int fr, int fq, PG8_LAS unsigned char* lds, int wid, int lane) const {
        typedef float f32x2v __attribute__((ext_vector_type(2)));
        const PG8_LAS f32x2v* S = (const PG8_LAS f32x2v*)(lds + 8192);
        const int col0 = u.pn * BM + wc * 32 + 4 * fq;
#pragma unroll
        for (int bj = 0; bj < 2; ++bj)
#pragma unroll
            for (int n = 0; n < 2; ++n) { const f32x4 bv = bias ? *(const f32x4*)(bias + col0 + bj * HALF + n * 16) : (f32x4){0.f, 0.f, 0.f, 0.f};
#pragma unroll
                for (int ai = 0; ai < 2; ++ai)
#pragma unroll
                    for (int m = 0; m < 4; ++m) acc[ai][bj][m][n] += bv; }
        f32x4 pre[4][2][2];
#pragma unroll
        for (int m = 0; m < 4; ++m) { const size_t off = (size_t)(u.pm * BM + wr * 64 + m * 16 + fr) * ldc + col0;
#pragma unroll
            for (int bj = 0; bj < 2; ++bj)
#pragma unroll
                for (int n = 0; n < 2; ++n) pre[m][bj][n] = *(const f32x4*)(base + off + bj * HALF + n * 16); }
        const bool bad = st.run(acc, u, wr, wc, fr, fq, lds, wid, lane) || poison != 0u;
        const float qnan = __builtin_nanf("");
#pragma unroll
        for (int ai = 0; ai < 2; ++ai)
#pragma unroll
            for (int m = 0; m < 4; ++m) { const int r = ai * HALF + wr * 64 + m * 16 + fr; const f32x2v sr = S[r]; const size_t off = (size_t)(u.pm * BM + r) * ldc + col0;
#pragma unroll
                for (int bj = 0; bj < 2; ++bj)
#pragma unroll
                    for (int n = 0; n < 2; ++n) { const f32x4 bs = ai == 0 ? pre[m][bj][n] : *(const f32x4*)(base + off + bj * HALF + n * 16); f32x4 o = bs + (acc[ai][bj][m][n] - sr.x) * sr.y;
                        if (bad) o = (f32x4){qnan, qnan, qnan, qnan}; *(f32x4*)(out + off + bj * HALF + n * 16) = o; }
                if (m & 1) asm volatile("" ::: "memory"); }
    }
};
struct EpiLnResLn {
    static constexpr bool PERM = false, AFTER_DRAIN = true; static constexpr int SEG = 0;
    const float* base; float* out; bf16_t* xn; int ldc; const float* bias; PanelStats st1, st2; unsigned poison;
    __device__ __forceinline__ void fused(f32x4 (&acc)[2][2][4][2], const Unit& u, int wr, int wc, int fr, int fq, PG8_LAS unsigned char* lds, int wid, int lane) const {
        typedef float f32x2v __attribute__((ext_vector_type(2))); typedef unsigned u32x2v __attribute__((ext_vector_type(2)));
        const PG8_LAS f32x2v* S = (const PG8_LAS f32x2v*)(lds + 8192);
        const int col0 = u.pn * BM + wc * 32 + 4 * fq;
#pragma unroll
        for (int bj = 0; bj < 2; ++bj)
#pragma unroll
            for (int n = 0; n < 2; ++n) { const f32x4 bv = bias ? *(const f32x4*)(bias + col0 + bj * HALF + n * 16) : (f32x4){0.f, 0.f, 0.f, 0.f};
#pragma unroll
                for (int ai = 0; ai < 2; ++ai)
#pragma unroll
                    for (int m = 0; m < 4; ++m) acc[ai][bj][m][n] += bv; }
        bool bad = st1.run(acc, u, wr, wc, fr, fq, lds, wid, lane) || poison != 0u;
        const float qnan = __builtin_nanf("");
#pragma unroll
        for (int ai = 0; ai < 2; ++ai)
#pragma unroll
            for (int m = 0; m < 4; ++m) { const int r = ai * HALF + wr * 64 + m * 16 + fr; const f32x2v sr = S[r]; const size_t off = (size_t)(u.pm * BM + r) * ldc + col0;
#pragma unroll
                for (int bj = 0; bj < 2; ++bj)
#pragma unroll
                    for (int n = 0; n < 2; ++n) { const f32x4 bs = *(const f32x4*)(base + off + bj * HALF + n * 16); acc[ai][bj][m][n] = bs + (acc[ai][bj][m][n] - sr.x) * sr.y; }
                asm volatile("" : "+v"(acc[ai][0][m][0]), "+v"(acc[ai][0][m][1]), "+v"(acc[ai][1][m][0]), "+v"(acc[ai][1][m][1]));
                if (m & 1) asm volatile("" ::: "memory"); }
        const bool bad1 = bad;
        bad = st2.run(acc, u, wr, wc, fr, fq, lds, wid, lane) || bad;
#pragma unroll
        for (int ai = 0; ai < 2; ++ai)
#pragma unroll
            for (int m = 0; m < 4; ++m) { const int r = ai * HALF + wr * 64 + m * 16 + fr; const f32x2v sr = S[r]; const size_t off = (size_t)(u.pm * BM + r) * ldc + col0;
#pragma unroll
                for (int bj = 0; bj < 2; ++bj)
#pragma unroll
                    for (int n = 0; n < 2; ++n) { const f32x4 x1 = acc[ai][bj][m][n]; *(f32x4*)(out + off + bj * HALF + n * 16) = bad1 ? (f32x4){qnan, qnan, qnan, qnan} : x1;
                        const f32x4 o = (x1 - sr.x) * sr.y; u32x2v w; w.x = cvt_pk_bf16(o[0], o[1]); w.y = cvt_pk_bf16(o[2], o[3]);
                        if (bad) { w.x = 0x7fc07fc0u; w.y = 0x7fc07fc0u; } *(u32x2v*)(xn + off + bj * HALF + n * 16) = w; }
                asm volatile("" ::: "memory"); }
    }
};

template <class Epi, class Sched, bool ALIGN_EPI = false, bool SP2 = false, bool GATHER = false, bool FP8 = false>
__device__ __forceinline__ void gemm_phase(PG8_LAS unsigned char* lds, const Gemm g, const Sched& S, const Epi& E) {
    int tid_ = threadIdx.x; asm volatile("" : "+v"(tid_));
    const int tid = tid_, wid = __builtin_amdgcn_readfirstlane(tid >> 6), lane = tid & 63, wr = wid >> 2, wc = wid & 3, fr = lane & 15, fq = lane >> 4;
    int K_ = g.K; asm volatile("" : "+s"(K_));
    const int K = K_, nt = K / BK;
    unsigned voffA[2], voffB[2];
#pragma unroll
    for (int i = 0; i < 2; ++i) { int R, C; stage_rc(tid * 16 + i * 8192, R, C); const int Rb = Epi::PERM ? ((R & ~31) + perm32(R & 31)) : R;
        voffA[i] = (unsigned)(R * g.lda + C) * 2u; voffB[i] = (unsigned)(Rb * K + C) * 2u; }
    const size_t kstep = (size_t)(BK * 2);
    static_assert(!GATHER || SP2, "GATHER is implemented for the SP2 loop");
    const size_t hstepB = (size_t)HALF * K * 2, hstepA = GATHER ? 0 : (size_t)HALF * g.lda * 2;
    const size_t tstepB = 2 * hstepB, tstepA = GATHER ? 0 : 2 * hstepA;
    const unsigned ldsw = (unsigned)wid * 1024u;
    const int aoffk[2] = {lds_byte(wr * 64 + fr, FP8 ? 16 * fq : 8 * fq), lds_byte(wr * 64 + fr, FP8 ? 16 * fq + 8 : 8 * fq + 32)};
    const int boffk[2] = {lds_byte(wc * 32 + fr, FP8 ? 16 * fq : 8 * fq), lds_byte(wc * 32 + fr, FP8 ? 16 * fq + 8 : 8 * fq + 32)};
#define PG8_SA(b, h) (((b) * 2 + (h)) * HTB)
#define PG8_SB(b, h) ((4 + (b) * 2 + (h)) * HTB)
#define PG8_STAGE(bufoff, gbase, voff) do { _Pragma("unroll") for (int _i = 0; _i < 2; ++_i) \
        __builtin_amdgcn_global_load_lds((const unsigned*)((const char*)(gbase) + (voff)[_i]), (PG8_LAS unsigned*)(lds + (bufoff) + ldsw + _i * 8192), 16, 0, 0); } while (0)
    typedef int i32x4_ __attribute__((ext_vector_type(4))); typedef int i32x8_ __attribute__((ext_vector_type(8)));
#define PG8_LD16(off) (*(const PG8_LAS i32x4_*)(lds + (off)))
#define PG8_LDA(dst, b, h) do { _Pragma("unroll") for (int m = 0; m < 4; ++m) { \
        if constexpr (FP8) dst##8[m] = *(const PG8_LAS i32x8_*)(lds + PG8_SA(b, h) + aoffk[0] + m * 2048);     \
        else { _Pragma("unroll") for (int k = 0; k < 2; ++k) dst[m][k] = *(const PG8_LAS bf16x8*)(lds + PG8_SA(b, h) + aoffk[k] + m * 2048); } } } while (0)
#define PG8_LDB(dst, b, h) do { _Pragma("unroll") for (int n = 0; n < 2; ++n) { \
        if constexpr (FP8) dst##8[n] = *(const PG8_LAS i32x8_*)(lds + PG8_SB(b, h) + boffk[0] + n * 2048); \
        else { _Pragma("unroll") for (int k = 0; k < 2; ++k) dst[n][k] = *(const PG8_LAS bf16x8*)(lds + PG8_SB(b, h) + boffk[k] + n * 2048); } } } while (0)
#define PG8_MMA(ai, bj, At, Bt) do { __builtin_amdgcn_s_setprio(1); _Pragma("unroll") for (int m = 0; m < 4; ++m) _Pragma("unroll") for (int n = 0; n < 2; ++n) { \
        if constexpr (FP8) asm volatile("s_nop 1\n\tv_mfma_scale_f32_16x16x128_f8f6f4 %0, %1, %2, %0, %3, %3 op_sel_hi:[0,0,0]" : "+v"(acc[ai][bj][m][n]) : "v"(Bt##8[n]), "v"(At##8[m]), "v"(sc1_));     \
        else { _Pragma("unroll") for (int k = 0; k < 2; ++k) acc[ai][bj][m][n] = __builtin_amdgcn_mfma_f32_16x16x32_bf16(Bt[n][k], At[m][k], acc[ai][bj][m][n], 0, 0, 0); } } \
        __builtin_amdgcn_s_setprio(0); } while (0)
#define PG8_WAIT_V(n) asm volatile("s_waitcnt vmcnt(" #n ")" ::: "memory")
#define PG8_WAIT_L(n) asm volatile("s_waitcnt lgkmcnt(" #n ")" ::: "memory")
#define PG8_BAR __builtin_amdgcn_s_barrier()
#define PG8_SCHED __builtin_amdgcn_sched_barrier(0)
    Unit cur, nxt; int ui = 0;
    if (!S.next(0, cur)) return;
    unsigned vC0[2] = {voffA[0], voffA[1]}, vC1[2] = {voffA[0], voffA[1]}, vN0[2] = {voffA[0], voffA[1]}, vN1[2] = {voffA[0], voffA[1]};
    int gR[2], gC[2];
#pragma unroll
    for (int i = 0; i < 2; ++i) { stage_rc(tid * 16 + i * 8192, gR[i], gC[i]); }
    if constexpr (GATHER) {
#pragma unroll
        for (int i = 0; i < 2; ++i) { vC0[i] = (unsigned)(g.ridx[cur.pm * 256 + gR[i]] * g.lda + gC[i]) * 2u; vC1[i] = (unsigned)(g.ridx[cur.pm * 256 + 128 + gR[i]] * g.lda + gC[i]) * 2u; }
    }
    f32x4 acc[2][2][4][2];
#pragma unroll
    for (int a = 0; a < 2; ++a)
#pragma unroll
        for (int b = 0; b < 2; ++b)
#pragma unroll
            for (int m = 0; m < 4; ++m)
#pragma unroll
                for (int n = 0; n < 2; ++n) acc[a][b][m][n] = (f32x4){0.f, 0.f, 0.f, 0.f};
    const int sc1_ = 0x7f7f7f7f;
    bf16x8 At[4][2], B0[2][2], B1[2][2]; i32x8_ At8[4], B08[2], B18[2];
    const char* cA = (const char*)g.A + (size_t)cur.pm * tstepA; const char* cB = (const char*)g.Bt + (size_t)cur.pn * tstepB;
    S.a_ready(cur);
    if constexpr (SP2) {
        PG8_STAGE(PG8_SB(0, 0), cB, voffB); PG8_STAGE(PG8_SB(0, 1), cB + hstepB, voffB); PG8_STAGE(PG8_SA(0, 0), cA, vC0); PG8_STAGE(PG8_SA(0, 1), cA + hstepA, vC1);
        if (wr == 1) PG8_BAR;
        PG8_WAIT_V(2); PG8_BAR;
        PG8_STAGE(PG8_SB(1, 0), cB + kstep, voffB); PG8_STAGE(PG8_SA(1, 0), cA + kstep, vC0); PG8_STAGE(PG8_SB(1, 1), cB + hstepB + kstep, voffB);
        PG8_WAIT_V(6); PG8_BAR;
    } else {
        PG8_STAGE(PG8_SB(0, 0), cB, voffB); PG8_STAGE(PG8_SA(0, 0), cA, voffA); PG8_STAGE(PG8_SB(0, 1), cB + hstepB, voffB); PG8_STAGE(PG8_SA(0, 1), cA + hstepA, voffA);
        if (wr == 1) PG8_BAR;
        PG8_WAIT_V(4); PG8_BAR;
        PG8_STAGE(PG8_SB(1, 0), cB + kstep, voffB); PG8_STAGE(PG8_SA(1, 0), cA + kstep, voffA); PG8_STAGE(PG8_SB(1, 1), cB + hstepB + kstep, voffB);
        PG8_WAIT_V(6); PG8_BAR;
    }
    for (;;) {
        const bool has_next = S.next(ui + 1, nxt);
        int gi0[2] = {0, 0}, gi1[2] = {0, 0};
        if constexpr (GATHER) { if (has_next) {
#pragma unroll
            for (int i = 0; i < 2; ++i) { gi0[i] = g.ridx[nxt.pm * 256 + gR[i]]; gi1[i] = g.ridx[nxt.pm * 256 + 128 + gR[i]]; } } }
        const char* nA = has_next ? (const char*)g.A + (size_t)nxt.pm * tstepA : cA; const char* nB = has_next ? (const char*)g.Bt + (size_t)nxt.pn * tstepB : cB;
        for (int t = 0; t < nt; t += 2) {
            const bool last = (t == nt - 2);
            const char* a1 = cA + (size_t)(t + 1) * kstep;
            const char* a2 = last ? nA : cA + (size_t)(t + 2) * kstep; const char* b2 = last ? nB : cB + (size_t)(t + 2) * kstep;
            const char* a3 = a2 + kstep; const char* b3 = b2 + kstep;
            if (last && has_next) S.a_ready(nxt);
            unsigned v20[2] = {vC0[0], vC0[1]}, v21[2] = {vC1[0], vC1[1]};
            if constexpr (GATHER) { if (last && has_next) {
#pragma unroll
                for (int i = 0; i < 2; ++i) { vN0[i] = (unsigned)(gi0[i] * g.lda + gC[i]) * 2u; vN1[i] = (unsigned)(gi1[i] * g.lda + gC[i]) * 2u; v20[i] = vN0[i]; v21[i] = vN1[i]; } } }
            if constexpr (SP2) {
            PG8_LDB(B0, 0, 0); PG8_LDB(B1, 0, 1); PG8_SCHED; PG8_LDA(At, 0, 0); PG8_STAGE(PG8_SA(1, 1), a1 + hstepA, vC1);
            PG8_WAIT_V(8); PG8_WAIT_L(0); PG8_BAR; PG8_MMA(0, 0, At, B0); PG8_MMA(0, 1, At, B1); PG8_BAR; PG8_SCHED;
            PG8_LDA(At, 0, 1); PG8_STAGE(PG8_SB(0, 0), b2, voffB); PG8_STAGE(PG8_SB(0, 1), b2 + hstepB, voffB); PG8_STAGE(PG8_SA(0, 0), a2, v20);
            PG8_WAIT_V(8); PG8_WAIT_L(0); PG8_BAR; PG8_MMA(1, 0, At, B0); PG8_MMA(1, 1, At, B1); PG8_BAR; PG8_SCHED;
            PG8_LDB(B0, 1, 0); PG8_LDB(B1, 1, 1); PG8_SCHED; PG8_LDA(At, 1, 0); PG8_STAGE(PG8_SA(0, 1), a2 + hstepA, v21);
            PG8_WAIT_V(8); PG8_WAIT_L(0); PG8_BAR; PG8_MMA(0, 0, At, B0); PG8_MMA(0, 1, At, B1); PG8_BAR; PG8_SCHED;
            PG8_LDA(At, 1, 1); PG8_STAGE(PG8_SB(1, 0), b3, voffB); PG8_STAGE(PG8_SB(1, 1), b3 + hstepB, voffB); PG8_STAGE(PG8_SA(1, 0), a3, v20);
            PG8_WAIT_V(8); PG8_WAIT_L(0); PG8_BAR; PG8_MMA(1, 0, At, B0); PG8_MMA(1, 1, At, B1); PG8_BAR; PG8_SCHED;
            if constexpr (Epi::SEG > 0) { if ((t + 2) % Epi::SEG == 0 && t + 2 < nt) E.segment(acc, cur, (t + 2) / Epi::SEG, wr, wc, fr, fq); }
            } else {
            PG8_LDB(B0, 0, 0); PG8_SCHED; PG8_LDA(At, 0, 0); PG8_STAGE(PG8_SA(1, 1), a1 + hstepA, voffA);
            PG8_WAIT_L(8); PG8_BAR; PG8_WAIT_L(0); PG8_MMA(0, 0, At, B0); PG8_BAR; PG8_SCHED;
            PG8_LDB(B1, 0, 1); PG8_STAGE(PG8_SB(0, 0), b2, voffB);
            PG8_BAR; PG8_WAIT_L(0); PG8_MMA(0, 1, At, B1); PG8_BAR;
            PG8_LDA(At, 0, 1); PG8_STAGE(PG8_SA(0, 0), a2, voffA);
            PG8_BAR; PG8_WAIT_L(0); PG8_MMA(1, 0, At, B0); PG8_BAR; PG8_SCHED;
            PG8_STAGE(PG8_SB(0, 1), b2 + hstepB, voffB);
            PG8_WAIT_V(6); PG8_BAR; PG8_MMA(1, 1, At, B1); PG8_BAR;
            PG8_LDB(B0, 1, 0); PG8_SCHED; PG8_LDA(At, 1, 0); PG8_STAGE(PG8_SA(0, 1), a2 + hstepA, voffA);
            PG8_WAIT_L(8); PG8_BAR; PG8_WAIT_L(0); PG8_MMA(0, 0, At, B0); PG8_BAR; PG8_SCHED;
            PG8_LDB(B1, 1, 1); PG8_STAGE(PG8_SB(1, 0), b3, voffB);
            PG8_BAR; PG8_WAIT_L(0); PG8_MMA(0, 1, At, B1); PG8_BAR;
            PG8_LDA(At, 1, 1); PG8_STAGE(PG8_SA(1, 0), a3, voffA);
            PG8_BAR; PG8_WAIT_L(0); PG8_MMA(1, 0, At, B0); PG8_BAR; PG8_SCHED;
            PG8_STAGE(PG8_SB(1, 1), b3 + hstepB, voffB);
            PG8_WAIT_V(6); PG8_BAR; PG8_MMA(1, 1, At, B1); PG8_BAR;
            }
        }
        if constexpr (FP8) asm volatile("s_nop 15\n\ts_nop 3" ::: "memory");
        if constexpr (ALIGN_EPI) { if (wr == 0) PG8_BAR; }
        if constexpr (!Epi::AFTER_DRAIN) { E(acc, cur, wr, wc, fr, fq); S.done(cur); }
        if (!has_next) break;
#pragma unroll
        for (int a = 0; a < 2; ++a)
#pragma unroll
            for (int b = 0; b < 2; ++b)
#pragma unroll
                for (int m = 0; m < 4; ++m)
#pragma unroll
                    for (int n = 0; n < 2; ++n) acc[a][b][m][n] = (f32x4){0.f, 0.f, 0.f, 0.f};
        cur = nxt; cA = nA; cB = nB; ++ui;
        if constexpr (GATHER) { vC0[0] = vN0[0]; vC0[1] = vN0[1]; vC1[0] = vN1[0]; vC1[1] = vN1[1]; }
        if constexpr (ALIGN_EPI) { if (wr == 1) PG8_BAR; }
    }
    PG8_WAIT_V(0);
    if constexpr (!ALIGN_EPI) { if (wr == 0) PG8_BAR; }
    PG8_BAR;
    if constexpr (Epi::AFTER_DRAIN) { E.fused(acc, cur, wr, wc, fr, fq, lds, wid, lane); S.done(cur); }
#undef PG8_SA
#undef PG8_SB
#undef PG8_STAGE
#undef PG8_LDA
#undef PG8_LD16
#undef PG8_LDB
#undef PG8_MMA
#undef PG8_WAIT_V
#undef PG8_WAIT_L
#undef PG8_BAR
#undef PG8_SCHED
}
}

typedef unsigned short bf16_t;
__device__ __forceinline__ unsigned pk4_fp8(float a, float b, float c, float d) { unsigned w = 0u; w = __builtin_amdgcn_cvt_pk_fp8_f32(a, b, w, false); w = __builtin_amdgcn_cvt_pk_fp8_f32(c, d, w, true); return w; }
constexpr float F8_WGU = 64.f, F8_WD = 128.f, F8_HID = 4.f;
typedef unsigned u32x4_t __attribute__((ext_vector_type(4)));
__device__ __forceinline__ void ldg8_dw(float (&o)[8], const void* base, const unsigned (&off)[8]) {
    asm volatile("global_load_dword %0, %9, %8\n\tglobal_load_dword %1, %10, %8\n\tglobal_load_dword %2, %11, %8\n\tglobal_load_dword %3, %12, %8\n\t"
                 "global_load_dword %4, %13, %8\n\tglobal_load_dword %5, %14, %8\n\tglobal_load_dword %6, %15, %8\n\tglobal_load_dword %7, %16, %8\n\ts_waitcnt vmcnt(0)"
                 : "=&v"(o[0]), "=&v"(o[1]), "=&v"(o[2]), "=&v"(o[3]), "=&v"(o[4]), "=&v"(o[5]), "=&v"(o[6]), "=&v"(o[7])
                 : "s"(base), "v"(off[0]), "v"(off[1]), "v"(off[2]), "v"(off[3]), "v"(off[4]), "v"(off[5]), "v"(off[6]), "v"(off[7]) : "memory");
}
template <int I1, int I2, int I3>
__device__ __forceinline__ void ldg8_x4(u32x4_t (&a)[4], u32x4_t (&b)[4], const void* base, unsigned offA, unsigned offB) {
    asm volatile("global_load_dwordx4 %0, %9, %8\n\tglobal_load_dwordx4 %1, %9, %8 offset:%11\n\tglobal_load_dwordx4 %2, %9, %8 offset:%12\n\tglobal_load_dwordx4 %3, %9, %8 offset:%13\n\t"
                 "global_load_dwordx4 %4, %10, %8\n\tglobal_load_dwordx4 %5, %10, %8 offset:%11\n\tglobal_load_dwordx4 %6, %10, %8 offset:%12\n\tglobal_load_dwordx4 %7, %10, %8 offset:%13\n\ts_waitcnt vmcnt(0)"
                 : "=&v"(a[0]), "=&v"(a[1]), "=&v"(a[2]), "=&v"(a[3]), "=&v"(b[0]), "=&v"(b[1]), "=&v"(b[2]), "=&v"(b[3])
                 : "s"(base), "v"(offA), "v"(offB), "i"(I1), "i"(I2), "i"(I3) : "memory");
}
__device__ __forceinline__ void ldg8_x4v(u32x4_t (&o)[8], const void* base, const unsigned (&off)[8]) {
    asm volatile("global_load_dwordx4 %0, %9, %8\n\tglobal_load_dwordx4 %1, %10, %8\n\tglobal_load_dwordx4 %2, %11, %8\n\tglobal_load_dwordx4 %3, %12, %8\n\t"
                 "global_load_dwordx4 %4, %13, %8\n\tglobal_load_dwordx4 %5, %14, %8\n\tglobal_load_dwordx4 %6, %15, %8\n\tglobal_load_dwordx4 %7, %16, %8\n\ts_waitcnt vmcnt(0)"
                 : "=&v"(o[0]), "=&v"(o[1]), "=&v"(o[2]), "=&v"(o[3]), "=&v"(o[4]), "=&v"(o[5]), "=&v"(o[6]), "=&v"(o[7])
                 : "s"(base), "v"(off[0]), "v"(off[1]), "v"(off[2]), "v"(off[3]), "v"(off[4]), "v"(off[5]), "v"(off[6]), "v"(off[7]) : "memory");
}
template <int I1, int I2, int I3>
__device__ __forceinline__ void ldg4_x4(u32x4_t (&a)[4], const void* base, unsigned off) {
    asm volatile("global_load_dwordx4 %0, %5, %4\n\tglobal_load_dwordx4 %1, %5, %4 offset:%6\n\tglobal_load_dwordx4 %2, %5, %4 offset:%7\n\tglobal_load_dwordx4 %3, %5, %4 offset:%8\n\ts_waitcnt vmcnt(0)"
                 : "=&v"(a[0]), "=&v"(a[1]), "=&v"(a[2]), "=&v"(a[3]) : "s"(base), "v"(off), "i"(I1), "i"(I2), "i"(I3) : "memory");
}
__device__ __forceinline__ void bf8_to_f32(const u32x4_t w, float* o) {
    o[0] = __uint_as_float(w.x << 16); o[1] = __uint_as_float(w.x & 0xffff0000u); o[2] = __uint_as_float(w.y << 16); o[3] = __uint_as_float(w.y & 0xffff0000u);
    o[4] = __uint_as_float(w.z << 16); o[5] = __uint_as_float(w.z & 0xffff0000u); o[6] = __uint_as_float(w.w << 16); o[7] = __uint_as_float(w.w & 0xffff0000u);
}
struct ExpertOrder1 {
    int G, v;
    __device__ void init(int G_, int c) { G = G_; v = (G_ % 8 == 0) ? (c % 8) * (G_ / 8) + c / 8 : c; }
    __device__ bool next(int i, pg8::Unit& u) const { const int L = i * G + v; if (L >= 2048) return false; const int e = L >> 7, r = L & 127; u.pm = e * 8 + (r & 7); u.pn = e * 16 + (r >> 3); return true; }
    __device__ __forceinline__ void a_ready(const pg8::Unit&) const {}
    __device__ __forceinline__ void done(const pg8::Unit&) const {}
};
struct ExpertOrder2 {
    int G, v;
    __device__ void init(int G_, int c) { G = G_; v = (G_ % 8 == 0) ? (c % 8) * (G_ / 8) + c / 8 : c; }
    __device__ bool next(int i, pg8::Unit& u) const { const int L = i * G + v; if (L >= 512) return false; const int e = L >> 5, r = L & 31; u.pm = e * 8 + (r & 7); u.pn = e * 4 + (r >> 3); return true; }
    __device__ __forceinline__ void a_ready(const pg8::Unit&) const {}
    __device__ __forceinline__ void done(const pg8::Unit&) const {}
};
__device__ __forceinline__ float silu_fast(float x) { return x * __builtin_amdgcn_rcpf(1.f + __builtin_amdgcn_exp2f(-1.4426950408889634f * x)); }
struct EpiSwiGLU {
    static constexpr bool PERM = true, AFTER_DRAIN = false; static constexpr int SEG = 0;
    bf16_t* O; int ldc;
    __device__ __forceinline__ void operator()(const pg8::f32x4 (&acc)[2][2][4][2], const pg8::Unit& u, int wr, int wc, int fr, int fq) const {
        int row0 = u.pm * 256 + wr * 64 + fr; asm volatile("" : "+v"(row0)); const int col0 = (u.pn & 15) * 128 + wc * 32 + 8 * fq;
#pragma unroll
        for (int ai = 0; ai < 2; ++ai)
#pragma unroll
            for (int m = 0; m < 4; ++m) {
                const pg8::f32x4 g0 = acc[ai][0][m][0], g1 = acc[ai][0][m][1], u0 = acc[ai][1][m][0], u1 = acc[ai][1][m][1];
                constexpr float IG = 1.f / F8_WGU, HS = F8_HID / F8_WGU;
                const unsigned w0 = pk4_fp8(silu_fast(g0[0] * IG) * u0[0] * HS, silu_fast(g0[1] * IG) * u0[1] * HS, silu_fast(g0[2] * IG) * u0[2] * HS, silu_fast(g0[3] * IG) * u0[3] * HS);
                const unsigned w1 = pk4_fp8(silu_fast(g1[0] * IG) * u1[0] * HS, silu_fast(g1[1] * IG) * u1[1] * HS, silu_fast(g1[2] * IG) * u1[2] * HS, silu_fast(g1[3] * IG) * u1[3] * HS);
                *(uint2*)((unsigned char*)O + (size_t)(row0 + ai * 128 + m * 16) * ldc + col0) = make_uint2(w0, w1);
            }
    }
};
struct EpiProj {
    static constexpr bool PERM = true, AFTER_DRAIN = false; static constexpr int SEG = 0;
    bf16_t* O; const float* bias;
    __device__ __forceinline__ void operator()(const pg8::f32x4 (&acc)[2][2][4][2], const pg8::Unit& u, int wr, int wc, int fr, int fq) const {
        int row0 = u.pm * 256 + wr * 64 + fr; asm volatile("" : "+v"(row0)); const int col0 = u.pn * 256 + wc * 32 + 8 * fq; const bool gate = u.pn < 12; constexpr float L2E = 1.4426950408889634f;
        float bias8[2][8];
        if (gate) { u32x4_t t0[4], t1[4]; const unsigned o0 = (unsigned)col0 * 4u; ldg8_x4<16, 512, 528>(t0, t1, bias, o0, o0);
#pragma unroll
            for (int q = 0; q < 4; ++q) { bias8[0][q] = __uint_as_float(t0[0][q]); bias8[0][4 + q] = __uint_as_float(t0[1][q]); bias8[1][q] = __uint_as_float(t0[2][q]); bias8[1][4 + q] = __uint_as_float(t0[3][q]); } }
#pragma unroll
        for (int bj = 0; bj < 2; ++bj) {
            float b[8];
#pragma unroll
            for (int q = 0; q < 8; ++q) b[q] = gate ? bias8[bj][q] : 0.f;
#pragma unroll
            for (int ai = 0; ai < 2; ++ai)
#pragma unroll
                for (int m = 0; m < 4; ++m) { float v[8];
#pragma unroll
                    for (int q = 0; q < 8; ++q) { const float x = acc[ai][bj][m][q >> 2][q & 3]; v[q] = gate ? __builtin_amdgcn_rcpf(1.f + __builtin_amdgcn_exp2f(-(x + b[q]) * L2E)) : x; }
                    pg8::u32x4 w; w.x = pg8::cvt_pk_bf16(v[0], v[1]); w.y = pg8::cvt_pk_bf16(v[2], v[3]); w.z = pg8::cvt_pk_bf16(v[4], v[5]); w.w = pg8::cvt_pk_bf16(v[6], v[7]);
                    *(pg8::u32x4*)(O + (size_t)(row0 + ai * 128 + m * 16) * DINP + col0 + bj * 128) = w; } }
    }
};
struct EpiQ {
    static constexpr bool PERM = false, AFTER_DRAIN = false; static constexpr int SEG = 0;
    bf16_t* Q; const float* rq; const float* rc; const float* rs;
    __device__ __forceinline__ void operator()(const pg8::f32x4 (&acc)[2][2][4][2], const pg8::Unit& u, int wr, int wc, int fr, int fq) const {
        int row0 = u.pm * 256 + wr * 64 + fr; asm volatile("" : "+v"(row0)); constexpr float SC = 0.10206207261596575f * 1.4426950408889634f;
        float sc8[8]; { unsigned off[8];
#pragma unroll
            for (int i = 0; i < 8; ++i) off[i] = (unsigned)(row0 + (i >> 2) * 128 + (i & 3) * 16) * 4u;
            ldg8_dw(sc8, rq, off); }
#pragma unroll
        for (int bj = 0; bj < 2; ++bj) { const int g32 = u.pn * 8 + bj * 4 + wc, col0 = g32 * 32 + 4 * fq; const bool rope = (g32 % 3) == 2;
#pragma unroll
            for (int ai = 0; ai < 2; ++ai) {
                u32x4_t cs4[4], sn4[4];
                if (rope) { u32x4_t t0[4], t1[4];
                    const unsigned o0 = (unsigned)((row0 + ai * 128) * 16 + 4 * fq) * 4u;
                    ldg8_x4<16 * 16 * 4, 32 * 16 * 4, 48 * 16 * 4>(t0, t1, rc, o0, o0 + (unsigned)(T * 16 * 4));
#pragma unroll
                    for (int m = 0; m < 4; ++m) { cs4[m] = t0[m]; sn4[m] = t1[m]; } }
#pragma unroll
                for (int m = 0; m < 4; ++m) { const int row = row0 + ai * 128 + m * 16; const float s = sc8[ai * 4 + m] * SC;
                    pg8::f32x4 v0 = acc[ai][bj][m][0] * s, v1 = acc[ai][bj][m][1] * s;
                    if (rope) { const pg8::f32x4 c4 = __builtin_bit_cast(pg8::f32x4, cs4[m]), s4 = __builtin_bit_cast(pg8::f32x4, sn4[m]);
                        const pg8::f32x4 x1 = v0, x2 = v1; v0 = x1 * c4 - x2 * s4; v1 = x1 * s4 + x2 * c4; }
                    bf16_t* qp = Q + (size_t)row * 768 + col0;
                    *(uint2*)qp = make_uint2(pg8::cvt_pk_bf16(v0[0], v0[1]), pg8::cvt_pk_bf16(v0[2], v0[3]));
                    *(uint2*)(qp + 16) = make_uint2(pg8::cvt_pk_bf16(v1[0], v1[1]), pg8::cvt_pk_bf16(v1[2], v1[3])); } } }
    }
};
struct EpiKV {
    static constexpr bool PERM = true, AFTER_DRAIN = false; static constexpr int SEG = 0;
    bf16_t* K; bf16_t* V; const float* rkv;
    __device__ __forceinline__ void operator()(const pg8::f32x4 (&acc)[2][2][4][2], const pg8::Unit& u, int wr, int wc, int fr, int fq) const {
        int row0 = u.pm * 256 + wr * 64 + fr; asm volatile("" : "+v"(row0));
        float sc8[8]; { unsigned off[8];
#pragma unroll
            for (int i = 0; i < 8; ++i) off[i] = (unsigned)(row0 + (i >> 2) * 128 + (i & 3) * 16) * 4u;
            ldg8_dw(sc8, rkv, off); }
#pragma unroll
        for (int bj = 0; bj < 2; ++bj) { const int head = u.pn * 2 + bj;
#pragma unroll
            for (int ai = 0; ai < 2; ++ai)
#pragma unroll
                for (int m = 0; m < 4; ++m) { const int row = row0 + ai * 128 + m * 16; const float s = sc8[ai * 4 + m];
                    const pg8::f32x4 v0 = acc[ai][bj][m][0] * s, v1 = acc[ai][bj][m][1] * s; pg8::u32x4 w;
                    w.x = pg8::cvt_pk_bf16(v0[0], v0[1]); w.y = pg8::cvt_pk_bf16(v0[2], v0[3]); w.z = pg8::cvt_pk_bf16(v1[0], v1[1]); w.w = pg8::cvt_pk_bf16(v1[2], v1[3]);
                    bf16_t* dst = (wc < 2) ? K + (size_t)row * 768 + head * 96 + wc * 32 + 8 * fq : V + (size_t)row * 512 + head * 64 + (wc - 2) * 32 + 8 * fq;
                    *(pg8::u32x4*)dst = w; } }
    }
};
struct EpiF32 {
    static constexpr bool PERM = true, AFTER_DRAIN = false; static constexpr int SEG = 0;
    float* O; int ldc; const float* rs;
    __device__ __forceinline__ void operator()(const pg8::f32x4 (&acc)[2][2][4][2], const pg8::Unit& u, int wr, int wc, int fr, int fq) const {
        int row0 = u.pm * 256 + wr * 64 + fr; asm volatile("" : "+v"(row0)); const int col0 = u.pn * 256 + wc * 32 + 8 * fq;
#pragma unroll
        for (int ai = 0; ai < 2; ++ai)
#pragma unroll
            for (int m = 0; m < 4; ++m) { const int row = row0 + ai * 128 + m * 16; const float s = rs ? rs[row] : 1.f;
#pragma unroll
                for (int bj = 0; bj < 2; ++bj) { float* op = O + (size_t)row * ldc + col0 + bj * 128;
                    *(pg8::f32x4*)op = acc[ai][bj][m][0] * s; *(pg8::f32x4*)(op + 4) = acc[ai][bj][m][1] * s; } }
    }
};
struct EpiMerge {
    static constexpr bool PERM = true, AFTER_DRAIN = false; static constexpr int SEG = 8;
    bf16_t* O; const bf16_t* GL;
    static __device__ __forceinline__ void ld8(const bf16_t* p, float* o) { const uint4 w = *(const uint4*)p;
        o[0] = __uint_as_float(w.x << 16); o[1] = __uint_as_float(w.x & 0xffff0000u); o[2] = __uint_as_float(w.y << 16); o[3] = __uint_as_float(w.y & 0xffff0000u);
        o[4] = __uint_as_float(w.z << 16); o[5] = __uint_as_float(w.z & 0xffff0000u); o[6] = __uint_as_float(w.w << 16); o[7] = __uint_as_float(w.w & 0xffff0000u); }
    __device__ __forceinline__ void segment(pg8::f32x4 (&acc)[2][2][4][2], const pg8::Unit& u, int seg, int wr, int wc, int fr, int fq) const {
        int row0 = u.pm * 256 + wr * 64 + fr; asm volatile("" : "+v"(row0));
        const unsigned cb = (unsigned)((seg - 1) * 1024 + u.pn * 256 + wc * 32 + 8 * fq) * 2u;
#pragma unroll
        for (int ai = 0; ai < 2; ++ai)
#pragma unroll
            for (int m = 0; m < 4; ++m) {
                u32x4_t ga[4];
                ldg4_x4<2048, 256, 2304>(ga, GL, (unsigned)(row0 + ai * 128 + m * 16) * (unsigned)(DINP * 2) + cb);
#pragma unroll
                for (int bj = 0; bj < 2; ++bj) { float x0[8], x1[8]; bf8_to_f32(ga[bj * 2], x0); bf8_to_f32(ga[bj * 2 + 1], x1);
#pragma unroll
                    for (int q = 0; q < 8; ++q) acc[ai][bj][m][q >> 2][q & 3] *= x0[q] * __builtin_amdgcn_rcpf(x1[q]); } }
    }
    __device__ __forceinline__ void operator()(const pg8::f32x4 (&acc)[2][2][4][2], const pg8::Unit& u, int wr, int wc, int fr, int fq) const {
        int row0 = u.pm * 256 + wr * 64 + fr; asm volatile("" : "+v"(row0)); const int col0 = u.pn * 256 + wc * 32 + 8 * fq;
        const unsigned cb = (unsigned)(2048 + col0) * 2u;
#pragma unroll
        for (int ai = 0; ai < 2; ++ai) {
            u32x4_t g8[8];
            { unsigned off[8];
#pragma unroll
              for (int i = 0; i < 8; ++i) off[i] = (unsigned)(row0 + ai * 128 + (i & 3) * 16) * (unsigned)(DINP * 2) + cb + (i >> 2) * 256u;
              ldg8_x4v(g8, GL, off); }
#pragma unroll
            for (int m = 0; m < 4; ++m) { const int row = row0 + ai * 128 + m * 16;
#pragma unroll
                for (int bj = 0; bj < 2; ++bj) { float x2[8], v[8]; bf8_to_f32(g8[bj * 4 + m], x2);
#pragma unroll
                    for (int q = 0; q < 8; ++q) v[q] = acc[ai][bj][m][q >> 2][q & 3] * x2[q];
                    pg8::u32x4 w; w.x = pg8::cvt_pk_bf16(v[0], v[1]); w.y = pg8::cvt_pk_bf16(v[2], v[3]); w.z = pg8::cvt_pk_bf16(v[4], v[5]); w.w = pg8::cvt_pk_bf16(v[6], v[7]);
                    *(pg8::u32x4*)(O + (size_t)row * DM + col0 + bj * 128) = w; } } }
    }
};
struct EpiRowScale {
    static constexpr bool PERM = true, AFTER_DRAIN = false; static constexpr int SEG = 0;
    bf16_t* O; int ldc; const float* rs;
    __device__ __forceinline__ void operator()(const pg8::f32x4 (&acc)[2][2][4][2], const pg8::Unit& u, int wr, int wc, int fr, int fq) const {
        int row0 = u.pm * 256 + wr * 64 + fr; asm volatile("" : "+v"(row0)); const int col0 = (u.pn & 3) * 256 + wc * 32 + 8 * fq;
        float sc8[8]; { unsigned off[8];
#pragma unroll
            for (int i = 0; i < 8; ++i) off[i] = (unsigned)(row0 + (i >> 2) * 128 + (i & 3) * 16) * 4u;
            ldg8_dw(sc8, rs, off); }
#pragma unroll
        for (int ai = 0; ai < 2; ++ai)
#pragma unroll
            for (int m = 0; m < 4; ++m) { const int row = row0 + ai * 128 + m * 16; const float s = sc8[ai * 4 + m] * (1.f / (F8_WD * F8_HID));
#pragma unroll
                for (int bj = 0; bj < 2; ++bj) { const pg8::f32x4 v0 = acc[ai][bj][m][0] * s, v1 = acc[ai][bj][m][1] * s; pg8::u32x4 w;
                    w.x = pg8::cvt_pk_bf16(v0[0], v0[1]); w.y = pg8::cvt_pk_bf16(v0[2], v0[3]); w.z = pg8::cvt_pk_bf16(v1[0], v1[1]); w.w = pg8::cvt_pk_bf16(v1[2], v1[3]);
                    *(pg8::u32x4*)(O + (size_t)row * ldc + col0 + bj * 128) = w; } }
    }
};
struct Params {
    const float* in[27];
    const int* pos;
    float* out;
    unsigned char* ws;
};

__device__ __forceinline__ float wave_sum(float v) {
#pragma unroll
    for (int o = 1; o < 64; o <<= 1) v += __shfl_xor(v, o);
    return v;
}
__device__ __forceinline__ float sigmoidf_(float x) { return 1.f / (1.f + expf(-x)); }
__device__ __forceinline__ float siluf_(float x) { return x / (1.f + expf(-x)); }
__device__ __forceinline__ float log_sigmoidf_(float x) { return fminf(x, 0.f) - log1pf(expf(-fabsf(x))); }

__device__ __forceinline__ float bf2f(bf16_t u) { return __uint_as_float((unsigned)u << 16); }
__device__ __forceinline__ unsigned f2bf(float f) { unsigned u = __float_as_uint(f); return (u + 0x7fffu + ((u >> 16) & 1u)) >> 16; }
__device__ __forceinline__ unsigned pk2(float lo, float hi) { return f2bf(lo) | (f2bf(hi) << 16); }
__device__ __forceinline__ void ld4bf(const bf16_t* p, float* o) {
    const uint2 w = *(const uint2*)p; o[0] = __uint_as_float(w.x << 16); o[1] = __uint_as_float(w.x & 0xffff0000u); o[2] = __uint_as_float(w.y << 16); o[3] = __uint_as_float(w.y & 0xffff0000u);
}
__device__ __forceinline__ void transpose_block(const float* Wblk, int ldw, bf16_t* dst, int ldt, const float* ks, const float* ns, float* scr, int lane) {
#pragma unroll 8
    for (int i = 0; i < 32; ++i) { const int kk = 2 * i + (lane >> 5); float v = __builtin_nontemporal_load(&Wblk[(size_t)kk * ldw + (lane & 31)]);     if (ks) v *= ks[kk]; if (ns) v *= ns[lane & 31]; scr[kk * 33 + (lane & 31)] = v; }
    asm volatile("s_waitcnt lgkmcnt(0)" ::: "memory");
    const int c = lane & 7;
#pragma unroll
    for (int j = 0; j < 4; ++j) { const int n = (lane >> 3) + 8 * j; const float* s = scr + (8 * c) * 33 + n;
        uint4 o; o.x = pk2(s[0 * 33], s[1 * 33]); o.y = pk2(s[2 * 33], s[3 * 33]); o.z = pk2(s[4 * 33], s[5 * 33]); o.w = pk2(s[6 * 33], s[7 * 33]);
        *(uint4*)(dst + (size_t)n * ldt + 8 * c) = o; }
    asm volatile("s_waitcnt lgkmcnt(0)" ::: "memory");
}

struct WStream {
    const float* gate; const float* up; const float* down;
    unsigned char* wgu_t; unsigned char* wd_t;
    const float* src; unsigned char* dst; int ldw, ldt; float sc;
    int it, it_stride, step, nsteps, nwg;
    float v0, v1, v2, v3;
    __device__ __forceinline__ int it_stride_wg() const { return nwg; }
    char* blk;
    __device__ __forceinline__ void init(int gw, int ngw, char* lds_blk) {
        constexpr int I_ALL = 2 * 16 * 16 * 64 + 16 * 32 * 32; nwg = ngw >> 3;
        if (I_ALL % ngw == 0) { const int per_wg = I_ALL / (ngw >> 3); gw = (gw >> 3) * per_wg + (gw & 7); ngw = 8; }
        it = gw; it_stride = ngw; step = 0; blk = lds_blk; src = nullptr; dst = nullptr; ldw = 0; ldt = 0; sc = 1.f; v0 = v1 = v2 = v3 = 0.f;
        nsteps = (ngw == 8) ? I_ALL / (it_stride_wg()) : ((gw < I_ALL) ? 8 * ((I_ALL - gw + ngw - 1) / ngw) : 0);
    }
    __device__ __forceinline__ void tick(int lane) {
        const int n = lane & 31, h = lane >> 5;
        if (step > 0 && step <= nsteps) {
            const int sp = (step - 1) & 7;
            *(unsigned*)(blk + n * 80 + sp * 8 + 4 * h) = pk4_fp8(v0 * sc, v1 * sc, v2 * sc, v3 * sc);
            if (sp == 7) {
                const int nr = lane >> 1, hf = lane & 1;
                const uint4 a = *(const uint4*)(blk + nr * 80 + hf * 32), b = *(const uint4*)(blk + nr * 80 + hf * 32 + 16);
                unsigned char* q = dst + (size_t)nr * ldt + hf * 32;
                *(uint4*)q = a; *(uint4*)(q + 16) = b;
            }
        }
        if (step < nsteps) {
            const int sub = step & 7;
            if (sub == 0) {
                constexpr int I_G = 16 * 16 * 64;
                if (it < 2 * I_G) { const int up_ = it >= I_G, r_ = up_ ? it - I_G : it, e_ = r_ >> 10, kb_ = (r_ >> 6) & 15, nb_ = r_ & 63, j0_ = nb_ * 32;
                    src = (up_ ? up : gate) + (size_t)e_ * DM * DEXP + (size_t)(64 * kb_) * DEXP + j0_; ldw = DEXP;
                    dst = wgu_t + (size_t)(e_ * 4096 + 256 * (j0_ >> 7) + (j0_ & 127) + (up_ ? 128 : 0)) * DM + 64 * kb_; ldt = DM; sc = F8_WGU; }
                else { const int r_ = it - 2 * I_G, e_ = r_ >> 10, kb_ = (r_ >> 5) & 31, nb_ = r_ & 31;
                    src = down + (size_t)e_ * DEXP * DM + (size_t)(64 * kb_) * DM + 32 * nb_; ldw = DM; dst = wd_t + (size_t)(e_ * 1024 + 32 * nb_) * DEXP + 64 * kb_; ldt = DEXP; sc = F8_WD; }
                it += it_stride;
            }
            const char* r0 = (const char*)(src + (size_t)(sub * 8) * ldw); const unsigned vo = (unsigned)((4 * h) * ldw + n) * 4u, rs = (unsigned)ldw * 4u;
            v0 = __builtin_nontemporal_load((const float*)(r0 + vo)); v1 = __builtin_nontemporal_load((const float*)(r0 + rs + vo));
            v2 = __builtin_nontemporal_load((const float*)(r0 + 2 * rs + vo)); v3 = __builtin_nontemporal_load((const float*)(r0 + 3 * rs + vo));
        }
        ++step;
    }
};

namespace att {
using bf16x8 = __attribute__((ext_vector_type(8))) short;
using s16x4  = __attribute__((ext_vector_type(4))) short;
using f32x16 = __attribute__((ext_vector_type(16))) float;
using u32x4  = __attribute__((ext_vector_type(4))) unsigned;
constexpr int NW = 8, QBLK = 32, KVBLK = 64;
constexpr int LDQ = 768, LDK = 768, LDV = 512, LDO = 1536;
constexpr int KROWB = 208;
constexpr int SHM_K = KVBLK * KROWB, SHM_V = KVBLK * 64 * 2;
constexpr int NBUF = 3;
constexpr int SHM_ATTN = NBUF * SHM_V + NBUF * SHM_K + NW * 64 * 4;
constexpr float THR = 8.f;
#define ASBAR() __builtin_amdgcn_sched_barrier(0)
__device__ __forceinline__ int crow(int r, int hi) { return (r & 3) + 8 * (r >> 2) + 4 * hi; }
__device__ __forceinline__ unsigned cvtpk(float lo, float hi) { unsigned r; asm volatile("v_cvt_pk_bf16_f32 %0, %1, %2" : "=v"(r) : "v"(lo), "v"(hi)); return r; }
#define MX3(a, b, c) __builtin_fmaxf(__builtin_fmaxf((a), (b)), (c))
template <bool FIRST>
__device__ __forceinline__ void partialSM(f32x16& p0, f32x16& p1, float& m_ref, f32x16& negm, float& alpha) {
  constexpr float THRL = THR * 1.4426950408889634f;
  float a = MX3(p0[0], p0[1], p1[0]), b = MX3(p0[2], p0[3], p1[1]); a = MX3(a, p1[2], p1[3]);
#pragma unroll
  for (int r = 4; r < 16; r += 4) { a = MX3(a, p0[r], p0[r + 1]); b = MX3(b, p0[r + 2], p0[r + 3]); a = MX3(a, p1[r], p1[r + 1]); b = MX3(b, p1[r + 2], p1[r + 3]); }
  float pmax = fmaxf(a, b);
  { auto rr = __builtin_amdgcn_permlane32_swap(__float_as_uint(pmax), __float_as_uint(pmax), false, false);
    pmax = fmaxf(__uint_as_float(rr[0]), __uint_as_float(rr[1])); }
  alpha = 1.f;
  if (FIRST || !__builtin_expect(__all(pmax <= THRL), 1)) {
    const float dl = FIRST ? pmax : fmaxf(pmax, 0.f); m_ref += dl;
#pragma unroll
    for (int r = 0; r < 16; ++r) { p0[r] -= dl; p1[r] -= dl; }
#pragma unroll
    for (int r = 0; r < 16; ++r) negm[r] = -m_ref;
    asm volatile("" : "+v"(negm));
    if (!FIRST) alpha = __builtin_amdgcn_exp2f(-dl);
  }
#pragma unroll
  for (int r = 0; r < 16; ++r) p0[r] = __builtin_amdgcn_exp2f(p0[r]);
}
#undef MX3
__device__ __forceinline__ void finishSM(f32x16& p0, f32x16& p1, float alpha, float& l_reg, bf16x8& pa0, bf16x8& pa1, bf16x8& pa2, bf16x8& pa3) {
  for (int r = 0; r < 16; ++r) p1[r] = __builtin_amdgcn_exp2f(p1[r]);
  float ps = 0; for (int r = 0; r < 16; ++r) ps += p0[r]; for (int r = 0; r < 16; ++r) ps += p1[r];
  { auto rr = __builtin_amdgcn_permlane32_swap(__float_as_uint(ps), __float_as_uint(ps), false, false);
    ps = __uint_as_float(rr[0]) + __uint_as_float(rr[1]); }
  l_reg = l_reg * alpha + ps;
#define PK4(P, BASE, OUT) do { u32x4 w = {cvtpk(P[BASE + 0], P[BASE + 1]), cvtpk(P[BASE + 2], P[BASE + 3]), cvtpk(P[BASE + 4], P[BASE + 5]), cvtpk(P[BASE + 6], P[BASE + 7])}; \
    OUT = *reinterpret_cast<bf16x8*>(&w); } while (0)
  PK4(p0, 0, pa0); PK4(p0, 8, pa1); PK4(p1, 0, pa2); PK4(p1, 8, pa3);
#undef PK4
}
__device__ __forceinline__ void qkt(f32x16& p0, f32x16& p1, const char* Ks, const bf16x8* qr, const f32x16& negm, int r32, int hi) {
  p0 = negm; p1 = negm;
#pragma unroll
  for (int d0 = 0; d0 < 6; ++d0) { const int cb = d0 * 32 + hi * 16;
    bf16x8 b0 = *reinterpret_cast<const bf16x8*>(Ks + r32 * KROWB + cb);
    bf16x8 b1 = *reinterpret_cast<const bf16x8*>(Ks + (32 + r32) * KROWB + cb);
    p0 = __builtin_amdgcn_mfma_f32_32x32x16_bf16(b0, qr[d0], p0, 0, 0, 0);
    p1 = __builtin_amdgcn_mfma_f32_32x32x16_bf16(b1, qr[d0], p1, 0, 0, 0); }
}
__device__ __forceinline__ int v_st(int k, int c) { const int kk = k;   return ((kk >> 3) * 2 + (c >> 5)) * 512 + ((kk & 7) * 32 + (c & 31)) * 2; }
__device__ __forceinline__ int v_rd_base(int lane) { return ((lane & 3) << 3) | (((lane >> 2) & 3) << 6) | (((lane >> 4) & 1) << 5) | (((lane >> 5) & 1) << 8); }
constexpr int v_rd_off(int d0, int ks, int half) { return d0 * 512 + ks * 2048 + half * 1024; }
template <int OFF> __device__ __forceinline__ s16x4 tr_read(int vb) {
  s16x4 r; asm volatile("ds_read_b64_tr_b16 %0, %1 offset:%2" : "=&v"(r) : "v"(vb), "i"(OFF) : "memory"); return r;
}
template <int D0> __device__ __forceinline__ void pv_one(f32x16& od, int vb, bf16x8 pa0, bf16x8 pa1, bf16x8 pa2, bf16x8 pa3) {
  const s16x4 l0 = tr_read<v_rd_off(D0, 0, 0)>(vb), h0 = tr_read<v_rd_off(D0, 0, 1)>(vb), l1 = tr_read<v_rd_off(D0, 1, 0)>(vb), h1 = tr_read<v_rd_off(D0, 1, 1)>(vb);
  const s16x4 l2 = tr_read<v_rd_off(D0, 2, 0)>(vb), h2 = tr_read<v_rd_off(D0, 2, 1)>(vb), l3 = tr_read<v_rd_off(D0, 3, 0)>(vb), h3 = tr_read<v_rd_off(D0, 3, 1)>(vb);
  asm volatile("s_waitcnt lgkmcnt(0)" ::: "memory"); ASBAR();
#define PK(L, H) (bf16x8){L[0], L[1], L[2], L[3], H[0], H[1], H[2], H[3]}
  od = __builtin_amdgcn_mfma_f32_32x32x16_bf16(pa0, PK(l0, h0), od, 0, 0, 0);
  od = __builtin_amdgcn_mfma_f32_32x32x16_bf16(pa1, PK(l1, h1), od, 0, 0, 0);
  od = __builtin_amdgcn_mfma_f32_32x32x16_bf16(pa2, PK(l2, h2), od, 0, 0, 0);
  od = __builtin_amdgcn_mfma_f32_32x32x16_bf16(pa3, PK(l3, h3), od, 0, 0, 0);
#undef PK
}
__device__ __forceinline__ void pv_d0(f32x16* o, int vb, bf16x8 pa0, bf16x8 pa1, bf16x8 pa2, bf16x8 pa3) {
  pv_one<0>(o[0], vb, pa0, pa1, pa2, pa3); pv_one<1>(o[1], vb, pa0, pa1, pa2, pa3);
}
__device__ __forceinline__ void attn_unit(const bf16_t* Qb, const bf16_t* Kh, const bf16_t* Vh, bf16_t* Ob, int seq, char* lds, WStream& wst) {
  int tid_ = threadIdx.x; asm volatile("" : "+v"(tid_));
  const int tid = tid_, wid = tid >> 6, lane = tid & 63, r32 = lane & 31, hi = lane >> 5;
  char* V_lds = lds; char* K_lds = lds + NBUF * SHM_V;
  float* ws = (float*)(lds + NBUF * SHM_V + NBUF * SHM_K) + wid * 64; float* li_l = ws; float* al_l = ws + 32;
  float m_ref = 0.f, l_reg = 0; f32x16 o[2] = {}; bf16x8 qr[6]; f32x16 negm = {}; asm volatile("" : "+v"(negm));
  const bf16_t* Qw = Qb + (long)(wid * QBLK + r32) * LDQ + hi * 8;
#pragma unroll
  for (int d0 = 0; d0 < 6; ++d0) qr[d0] = *reinterpret_cast<const bf16x8*>(Qw + d0 * 16);
  const bool kact = tid < 384; const int kr = tid / 12, kc = tid - kr * 12, vr = tid >> 3, vc = (tid & 7) * 8, vst0 = v_st(vr, vc);
  const int kst0 = kr * KROWB + kc * 16, kst1 = (kr + 32) * KROWB + kc * 16;
  const int vb0 = (int)(uintptr_t)V_lds + v_rd_base(lane);
  struct { bf16x8 vs, ks0, ks1; } sr_[2];
#define SLOAD(i, k0) do { sr_[i].vs = *reinterpret_cast<const bf16x8*>(&Vh[(long)((k0) + vr) * LDV + vc]); \
    if (kact) { sr_[i].ks0 = *reinterpret_cast<const bf16x8*>(&Kh[(long)((k0) + kr) * LDK + kc * 8]); sr_[i].ks1 = *reinterpret_cast<const bf16x8*>(&Kh[(long)((k0) + 32 + kr) * LDK + kc * 8]); } } while (0)
#define SWRITE(b, i) do { *(bf16x8*)(V_lds + (b) * SHM_V + vst0) = sr_[i].vs; \
    if (kact) { *(bf16x8*)(K_lds + (b) * SHM_K + kst0) = sr_[i].ks0; *(bf16x8*)(K_lds + (b) * SHM_K + kst1) = sr_[i].ks1; } } while (0)
#define SWAIT() asm volatile("s_waitcnt vmcnt(3)" ::: "memory")
#define RESC(a) do { if (__any((a) < 1.f)) { if (hi == 0) al_l[r32] = (a); asm volatile("s_waitcnt lgkmcnt(0)" ::: "memory"); \
    for (int d = 0; d < 2; ++d) for (int r = 0; r < 16; ++r) o[d][r] *= al_l[crow(r, hi)]; } } while (0)
  f32x16 pA0, pA1, pB0, pB1; float alA, alB; bf16x8 pa0, pa1, pa2, pa3; const int NT = seq / KVBLK;
  constexpr int SE = 0, SO = 1;
  int b_prev = 0, b_cur = 1, b_next = 2;
#define ROT() do { b_prev = b_cur; b_cur = b_next; b_next = (b_next == NBUF - 1) ? 0 : b_next + 1; } while (0)
  SLOAD(SE, 0); asm volatile("s_waitcnt vmcnt(0)" ::: "memory"); SWRITE(0, SE);
  SLOAD(SO, KVBLK); if (2 < NT) SLOAD(SE, 2 * KVBLK);
  __syncthreads();
  qkt(pA0, pA1, K_lds, qr, negm, r32, hi); partialSM<true>(pA0, pA1, m_ref, negm, alA);
  SWAIT(); SWRITE(1, SO); __syncthreads();
  for (int j = 1; j + 1 < NT; j += 2) {
    SLOAD(SO, (j + 2) * KVBLK);
    ASBAR(); qkt(pB0, pB1, K_lds + b_cur * SHM_K, qr, negm, r32, hi);
    finishSM(pA0, pA1, alA, l_reg, pa0, pa1, pa2, pa3); ASBAR();
    pv_d0(o, vb0 + b_prev * SHM_V, pa0, pa1, pa2, pa3); partialSM<false>(pB0, pB1, m_ref, negm, alB);
    SWAIT(); SWRITE(b_next, SE);
    RESC(alB); wst.tick(lane); __syncthreads(); ROT();
    if (j + 3 < NT) SLOAD(SE, (j + 3) * KVBLK);
    ASBAR(); qkt(pA0, pA1, K_lds + b_cur * SHM_K, qr, negm, r32, hi);
    finishSM(pB0, pB1, alB, l_reg, pa0, pa1, pa2, pa3); ASBAR();
    pv_d0(o, vb0 + b_prev * SHM_V, pa0, pa1, pa2, pa3); partialSM<false>(pA0, pA1, m_ref, negm, alA);
    SWAIT(); SWRITE(b_next, SO);
    RESC(alA); wst.tick(lane); __syncthreads(); ROT();
  }
  ASBAR(); qkt(pB0, pB1, K_lds + b_cur * SHM_K, qr, negm, r32, hi);
  finishSM(pA0, pA1, alA, l_reg, pa0, pa1, pa2, pa3); ASBAR();
  pv_d0(o, vb0 + b_prev * SHM_V, pa0, pa1, pa2, pa3); partialSM<false>(pB0, pB1, m_ref, negm, alB);
  RESC(alB);
  finishSM(pB0, pB1, alB, l_reg, pa0, pa1, pa2, pa3); ASBAR();
  pv_d0(o, vb0 + b_cur * SHM_V, pa0, pa1, pa2, pa3);
#undef ROT
  if (hi == 0) li_l[r32] = l_reg; asm volatile("s_waitcnt lgkmcnt(0)" ::: "memory");
  float rli[16];
#pragma unroll
  for (int r = 0; r < 16; ++r) rli[r] = __builtin_amdgcn_rcpf(li_l[crow(r, hi)]);
  bf16_t* Ow = Ob + (long)(wid * QBLK) * LDO;
#pragma unroll
  for (int r = 0; r < 16; ++r) { const int orow = crow(r, hi);
#pragma unroll
    for (int d0 = 0; d0 < 2; ++d0) Ow[(long)orow * LDO + d0 * 32 + r32] = (bf16_t)f2bf(o[d0][r] * rli[r]); }
  __syncthreads();
#undef SLOAD
#undef SWRITE
#undef SWAIT
#undef RESC
}
#undef ASBAR
}

namespace gla {
using bf16x8 = __attribute__((ext_vector_type(8))) short;
using s16x4  = __attribute__((ext_vector_type(4))) short;
using f32x16 = __attribute__((ext_vector_type(16))) float;
using u32x4  = __attribute__((ext_vector_type(4))) unsigned;
constexpr int L_DL = 0, L_TOT = 8192, L_RSUM = 10240, L_V = 12288, L_QF = 28672, L_KF = 37888, L_QB = 47104, L_KB = 56320, L_KSTF = 65536, L_KSTB = 74752, L_STF = 65536, L_STB = 83968, L_QR = 102400, L_KR = 110592, L_END = 118784;
constexpr int RB = 144;
__device__ __forceinline__ int crow(int r, int hi) { return (r & 3) + 8 * (r >> 2) + 4 * hi; }
__device__ __forceinline__ unsigned cvtpk(float lo, float hi) { unsigned r; asm volatile("v_cvt_pk_bf16_f32 %0, %1, %2" : "=v"(r) : "v"(lo), "v"(hi)); return r; }
__device__ __forceinline__ int v_st4(int k, int c) { const int kk = (k & ~0xC) | ((k & 4) << 1) | ((k & 8) >> 1); return ((kk >> 3) * 4 + (c >> 5)) * 512 + ((kk & 7) * 32 + (c & 31)) * 2; }
__device__ __forceinline__ int v_rd_base(int lane) { return ((lane & 3) << 3) | (((lane >> 2) & 3) << 6) | (((lane >> 4) & 1) << 5) | (((lane >> 5) & 1) << 8); }
template <int OFF> __device__ __forceinline__ s16x4 tr_read(int vb) { s16x4 r; asm volatile("ds_read_b64_tr_b16 %0, %1 offset:%2" : "=&v"(r) : "v"(vb), "i"(OFF) : "memory"); return r; }
__device__ __forceinline__ void v_frags(int vb, bf16x8 (&f)[4]) {
  const s16x4 l0 = tr_read<0>(vb), h0 = tr_read<2048>(vb), l1 = tr_read<4096>(vb), h1 = tr_read<4096 + 2048>(vb);
  const s16x4 l2 = tr_read<8192>(vb), h2 = tr_read<8192 + 2048>(vb), l3 = tr_read<12288>(vb), h3 = tr_read<12288 + 2048>(vb);
  asm volatile("s_waitcnt lgkmcnt(0)" ::: "memory"); __builtin_amdgcn_sched_barrier(0);
#define PK(L, H) (bf16x8){L[0], L[1], L[2], L[3], H[0], H[1], H[2], H[3]}
  f[0] = PK(l0, h0); f[1] = PK(l1, h1); f[2] = PK(l2, h2); f[3] = PK(l3, h3);
#undef PK
}
__device__ __forceinline__ bf16x8 frag(const char* base, int row, int ks, int hi) { return *reinterpret_cast<const bf16x8*>(base + row * RB + ks * 32 + hi * 16); }

template <bool IS_G1>
__device__ __forceinline__ void prep(char* lds, const bf16_t* projb, const float* wdec, const float* bdec, int t0, int hh, float* dec_out  , long dec_dir_stride) {
  int tid_ = threadIdx.x; asm volatile("" : "+v"(tid_)); const int tid = tid_;
  float* DL = (float*)(lds + L_DL); float* TOT = (float*)(lds + L_TOT);
  { const int i = tid >> 3, r4 = (tid & 7) * 4; float v[4]; ld4bf(projb + (size_t)(t0 + i) * DINP + OFF_GDEC + r4, v); *(float4*)(DL + i * 32 + r4) = make_float4(v[0], v[1], v[2], v[3]);
    const int c8 = (tid & 7) * 8;
    *(uint4*)(lds + L_KR + i * 128 + c8 * 2) = *(const uint4*)(projb + (size_t)(t0 + i) * DINP + OFF_GK + hh * 64 + c8);
    if constexpr (!IS_G1) *(uint4*)(lds + L_QR + i * 128 + c8 * 2) = *(const uint4*)(projb + (size_t)(t0 + i) * DINP + OFF_GQ + hh * 64 + c8); }
#pragma unroll
  for (int e2 = 0; e2 < 2; ++e2) { const int e = tid + e2 * 512, i = e >> 4, cc = (e & 15) * 8;
    *(uint4*)(lds + L_V + v_st4(i, cc)) = *(const uint4*)(projb + (size_t)(t0 + i) * DINP + OFF_GV + hh * 128 + cc); }
  __syncthreads();
  const int cidx = tid & 127, tg = tid >> 7, dir = cidx >> 6, d = cidx & 63;
  float W[16];
#pragma unroll
  for (int r = 0; r < 16; ++r) W[r] = wdec[(size_t)(dir * 16 + r) * 256 + hh * 64 + d];
  const float bias = bdec[dir * 256 + hh * 64 + d];
  constexpr float L2E = 1.4426950408889634f;
  float g[16], cs[16]; float run = 0.f;
#pragma unroll
  for (int ii = 0; ii < 16; ++ii) { const float* dl = DL + (16 * tg + ii) * 32 + dir * 16; float a = bias;
#pragma unroll
    for (int r = 0; r < 16; r += 4) { const float4 x = *(const float4*)(dl + r); a = fmaf(x.x, W[r], a); a = fmaf(x.y, W[r + 1], a); a = fmaf(x.z, W[r + 2], a); a = fmaf(x.w, W[r + 3], a); }
    g[ii] = (fminf(a, 0.f) * L2E - __builtin_amdgcn_logf(1.f + __builtin_amdgcn_exp2f(-fabsf(a) * L2E))) * (1.f / 16.f); run += g[ii]; cs[ii] = run; }
  TOT[tg * 128 + cidx] = run;
  __syncthreads();
  const float t0s = TOT[cidx], t1s = TOT[128 + cidx], t2s = TOT[256 + cidx], t3s = TOT[384 + cidx], tall = (t0s + t1s) + (t2s + t3s);
  const float off_lo = (tg > 0 ? t0s : 0.f) + (tg > 1 ? t1s : 0.f) + (tg > 2 ? t2s : 0.f);
  const float off_hi = (tg < 1 ? t1s : 0.f) + (tg < 2 ? t2s : 0.f) + (tg < 3 ? t3s : 0.f);
  const bf16_t* KR = (const bf16_t*)(lds + L_KR); const bf16_t* QR = (const bf16_t*)(lds + L_QR);
  if constexpr (IS_G1) {
    unsigned pk[8];
#pragma unroll
    for (int ii = 0; ii < 16; ii += 2) {
      float kv2[2];
#pragma unroll
      for (int u = 0; u < 2; ++u) { const int i = 16 * tg + ii + u; const float bi = dir == 0 ? off_lo + cs[ii + u] : off_hi + run - cs[ii + u] + g[ii + u];
        kv2[u] = bf2f(KR[i * 64 + d]) * __builtin_amdgcn_exp2f(tall - bi); }
      pk[ii >> 1] = cvtpk(kv2[0], kv2[1]); }
    char* dst = lds + (dir ? L_KSTB : L_KSTF) + d * RB + 32 * tg;
    *(uint4*)dst = make_uint4(pk[0], pk[1], pk[2], pk[3]); *(uint4*)(dst + 16) = make_uint4(pk[4], pk[5], pk[6], pk[7]);
    if (tg == 0) dec_out[dir * dec_dir_stride + d] = __builtin_amdgcn_exp2f(tall);
  } else {
    bf16_t* Qx = (bf16_t*)(lds + (dir ? L_QB : L_QF)); bf16_t* Kx = (bf16_t*)(lds + (dir ? L_KB : L_KF));
#pragma unroll
    for (int ii = 0; ii < 16; ++ii) { const int i = 16 * tg + ii; const float bi = dir == 0 ? off_lo + cs[ii] : off_hi + run - cs[ii] + g[ii];
      const float qv = bf2f(QR[i * 64 + d]) * 0.125f, kv = bf2f(KR[i * 64 + d]);
      Qx[i * (RB / 2) + d] = (bf16_t)f2bf(qv * __builtin_amdgcn_exp2f(bi)); Kx[i * (RB / 2) + d] = (bf16_t)f2bf(kv * __builtin_amdgcn_exp2f(-bi)); }
  }
  __syncthreads();
}

__device__ __forceinline__ void g1_item(char* lds, const bf16_t* projb, const float* wdec, const float* bdec, int b, int hh, int c, float* kvt, float* dec) {
  int tid_ = threadIdx.x; asm volatile("" : "+v"(tid_)); const int tid = tid_, wid = tid >> 6, lane = tid & 63, r32 = lane & 31, hi = lane >> 5;
  const int bh = b * 4 + hh; const long item = (long)bh * 128 + c, dstride = 8L * 128;
  prep<true>(lds, projb, wdec, bdec, b * SEQ + c * 64, hh, dec + item * 64, dstride * 64);
  const int vblk = wid >> 1, dblk = wid & 1;
  bf16x8 vf[4]; v_frags((int)(uintptr_t)(lds + L_V) + v_rd_base(lane) + vblk * 512, vf);
#pragma unroll
  for (int dir = 0; dir < 2; ++dir) { const char* kst = lds + (dir ? L_KSTB : L_KSTF); f32x16 acc = {};
#pragma unroll
    for (int ks = 0; ks < 4; ++ks) acc = __builtin_amdgcn_mfma_f32_32x32x16_bf16(vf[ks], frag(kst, dblk * 32 + r32, ks, hi), acc, 0, 0, 0);
    float* o = kvt + ((long)dir * dstride + item) * 8192 + (size_t)(vblk * 32) * 64 + dblk * 32 + r32;
#pragma unroll
    for (int r = 0; r < 16; ++r) o[crow(r, hi) * 64] = acc[r]; }
  __syncthreads();
}

__device__ __forceinline__ void g3_item(char* lds, const bf16_t* projb, const float* wdec, const float* bdec, const float* normg, int b, int hh, int c, const bf16_t* st, bf16_t* out, int ldo) {
  int tid_ = threadIdx.x; asm volatile("" : "+v"(tid_)); const int tid = tid_, wid = tid >> 6, lane = tid & 63, r32 = lane & 31, hi = lane >> 5;
  const int bh = b * 4 + hh, t0 = b * SEQ + c * 64; const long item = (long)bh * 128 + c, dstride = 8L * 128;
#pragma unroll
  for (int e4 = 0; e4 < 4; ++e4) { const int e = tid + e4 * 512, dir = e >> 10, v = (e >> 3) & 127, dc = (e & 7) * 8;
    *(uint4*)(lds + (dir ? L_STB : L_STF) + v * RB + dc * 2) = *(const uint4*)(st + ((long)dir * dstride + item) * 8192 + (size_t)v * 64 + dc); }
  prep<false>(lds, projb, wdec, bdec, t0, hh, nullptr, 0);
  const int ib = wid & 1, vblk = wid >> 1, iglob = ib * 32 + r32;
  bf16_t rgr[16];
#pragma unroll
  for (int r = 0; r < 16; ++r) rgr[r] = projb[(size_t)(t0 + ib * 32 + crow(r, hi)) * DINP + OFF_GR + hh * 128 + vblk * 32 + r32];
  f32x16 pF0 = {}, pF1 = {}, pB0 = {}, pB1 = {};
#pragma unroll
  for (int ks = 0; ks < 4; ++ks) {
    const bf16x8 qf = frag(lds + L_QF, iglob, ks, hi), qb = frag(lds + L_QB, iglob, ks, hi);
    pF0 = __builtin_amdgcn_mfma_f32_32x32x16_bf16(frag(lds + L_KF, r32, ks, hi), qf, pF0, 0, 0, 0);
    pF1 = __builtin_amdgcn_mfma_f32_32x32x16_bf16(frag(lds + L_KF, 32 + r32, ks, hi), qf, pF1, 0, 0, 0);
    pB0 = __builtin_amdgcn_mfma_f32_32x32x16_bf16(frag(lds + L_KB, r32, ks, hi), qb, pB0, 0, 0, 0);
    pB1 = __builtin_amdgcn_mfma_f32_32x32x16_bf16(frag(lds + L_KB, 32 + r32, ks, hi), qb, pB1, 0, 0, 0); }
#pragma unroll
  for (int r = 0; r < 16; ++r) { const int j0 = crow(r, hi), j1 = 32 + j0;
    pF0[r] = (j0 <= iglob ? pF0[r] : 0.f) + (j0 >= iglob ? pB0[r] : 0.f);
    pF1[r] = (j1 <= iglob ? pF1[r] : 0.f) + (j1 >= iglob ? pB1[r] : 0.f); }
  bf16x8 pa0, pa1, pa2, pa3;
#define PK4(P, BASE, OUT) do { unsigned a0 = cvtpk(P[BASE + 0], P[BASE + 1]), a1 = cvtpk(P[BASE + 2], P[BASE + 3]);   \
    unsigned b0 = cvtpk(P[BASE + 4], P[BASE + 5]), b1 = cvtpk(P[BASE + 6], P[BASE + 7]);                              \
    auto r0 = __builtin_amdgcn_permlane32_swap(a0, b0, false, false); auto r1 = __builtin_amdgcn_permlane32_swap(a1, b1, false, false); \
    u32x4 w = {r0[0], r1[0], r0[1], r1[1]}; OUT = *reinterpret_cast<bf16x8*>(&w); } while (0)
  PK4(pF0, 0, pa0); PK4(pF0, 8, pa1); PK4(pF1, 0, pa2); PK4(pF1, 8, pa3);
#undef PK4
  bf16x8 vf[4]; v_frags((int)(uintptr_t)(lds + L_V) + v_rd_base(lane) + vblk * 512, vf);
  f32x16 o = {};
  o = __builtin_amdgcn_mfma_f32_32x32x16_bf16(pa0, vf[0], o, 0, 0, 0); o = __builtin_amdgcn_mfma_f32_32x32x16_bf16(pa1, vf[1], o, 0, 0, 0);
  o = __builtin_amdgcn_mfma_f32_32x32x16_bf16(pa2, vf[2], o, 0, 0, 0); o = __builtin_amdgcn_mfma_f32_32x32x16_bf16(pa3, vf[3], o, 0, 0, 0);
#pragma unroll
  for (int ks = 0; ks < 4; ++ks) {
    o = __builtin_amdgcn_mfma_f32_32x32x16_bf16(frag(lds + L_QF, iglob, ks, hi), frag(lds + L_STF, vblk * 32 + r32, ks, hi), o, 0, 0, 0);
    o = __builtin_amdgcn_mfma_f32_32x32x16_bf16(frag(lds + L_QB, iglob, ks, hi), frag(lds + L_STB, vblk * 32 + r32, ks, hi), o, 0, 0, 0); }
  float* RS = (float*)(lds + L_RSUM);
  float ss[16];
#pragma unroll
  for (int r = 0; r < 16; ++r) { float s = o[r] * o[r]; s += __shfl_xor(s, 1); s += __shfl_xor(s, 2); s += __shfl_xor(s, 4); s += __shfl_xor(s, 8); s += __shfl_xor(s, 16); ss[r] = s; }
  if (r32 == 0) {
#pragma unroll
    for (int r = 0; r < 16; ++r) RS[(ib * 4 + vblk) * 32 + crow(r, hi)] = ss[r]; }
  __syncthreads();
  const int v = vblk * 32 + r32; const float ng = normg[v];
#pragma unroll
  for (int r = 0; r < 16; ++r) { const int il = crow(r, hi), i = ib * 32 + il;
    const float tot = (RS[(ib * 4 + 0) * 32 + il] + RS[(ib * 4 + 1) * 32 + il]) + (RS[(ib * 4 + 2) * 32 + il] + RS[(ib * 4 + 3) * 32 + il]);
    const float rstd = 1.f / sqrtf(tot * (1.f / 128.f) + RMS_EPS);
    const float rg = bf2f(rgr[r]);
    out[(size_t)(t0 + i) * ldo + hh * 128 + v] = (bf16_t)f2bf(o[r] * rstd * ng * (rg * __builtin_amdgcn_rcpf(1.f + __builtin_amdgcn_exp2f(-1.4426950408889634f * rg)))); }
  __syncthreads();
}
}

__device__ __forceinline__ void ln_core(float4 (&v)[4], const float* g, const float* b, float* out, bf16_t* outb, int lane) {
    float s = 0.f;
#pragma unroll
    for (int j = 0; j < 4; ++j) s += (v[j].x + v[j].y) + (v[j].z + v[j].w);
    const float mean = wave_sum(s) * (1.f / DM); float s2 = 0.f;
#pragma unroll
    for (int j = 0; j < 4; ++j) { v[j].x -= mean; v[j].y -= mean; v[j].z -= mean; v[j].w -= mean; s2 += (v[j].x * v[j].x + v[j].y * v[j].y) + (v[j].z * v[j].z + v[j].w * v[j].w); }
    const float rstd = 1.f / sqrtf(wave_sum(s2) * (1.f / DM) + LN_EPS);
#pragma unroll
    for (int j = 0; j < 4; ++j) {
        const float4 gg = ((const float4*)g)[lane + 64 * j], bb = ((const float4*)b)[lane + 64 * j];
        float4 o; o.x = v[j].x * rstd * gg.x + bb.x; o.y = v[j].y * rstd * gg.y + bb.y; o.z = v[j].z * rstd * gg.z + bb.z; o.w = v[j].w * rstd * gg.w + bb.w;
        ((float4*)out)[lane + 64 * j] = o; v[j] = o;
        if (outb) ((uint2*)outb)[lane + 64 * j] = make_uint2(pk2(o.x, o.y), pk2(o.z, o.w));
    }
}
__device__ __forceinline__ void wave_sum2(float& a, float& b) {
#pragma unroll
    for (int o = 1; o < 64; o <<= 1) { const float ta = __shfl_xor(a, o), tb = __shfl_xor(b, o); a += ta; b += tb; }
}
template <int MODE>
__device__ __forceinline__ void ln_core2(float4 (&v)[2][4], const float* g, const float* b, float* out0, float* out1, bf16_t* ob0, bf16_t* ob1, int lane, unsigned char* o8_0 = nullptr, unsigned char* o8_1 = nullptr) {
    float s[2] = {0.f, 0.f};
#pragma unroll
    for (int u = 0; u < 2; ++u)
#pragma unroll
        for (int j = 0; j < 4; ++j) s[u] += (v[u][j].x + v[u][j].y) + (v[u][j].z + v[u][j].w);
    wave_sum2(s[0], s[1]);
    float q[2] = {0.f, 0.f};
#pragma unroll
    for (int u = 0; u < 2; ++u) { const float mean = s[u] * (1.f / DM);
#pragma unroll
        for (int j = 0; j < 4; ++j) { v[u][j].x -= mean; v[u][j].y -= mean; v[u][j].z -= mean; v[u][j].w -= mean; q[u] += (v[u][j].x * v[u][j].x + v[u][j].y * v[u][j].y) + (v[u][j].z * v[u][j].z + v[u][j].w * v[u][j].w); } }
    wave_sum2(q[0], q[1]);
#pragma unroll
    for (int j = 0; j < 4; ++j) {
        const float4 gg = ((const float4*)g)[lane + 64 * j], bb = ((const float4*)b)[lane + 64 * j];
#pragma unroll
        for (int u = 0; u < 2; ++u) { const float rstd = 1.f / sqrtf(q[u] * (1.f / DM) + LN_EPS);
            float4 o; o.x = v[u][j].x * rstd * gg.x + bb.x; o.y = v[u][j].y * rstd * gg.y + bb.y; o.z = v[u][j].z * rstd * gg.z + bb.z; o.w = v[u][j].w * rstd * gg.w + bb.w;
            v[u][j] = o;
            if constexpr (MODE == 2) ((float4*)(u ? out1 : out0))[lane + 64 * j] = o;
            else ((uint2*)(u ? ob1 : ob0))[lane + 64 * j] = make_uint2(pk2(o.x, o.y), pk2(o.z, o.w));
            if constexpr (MODE == 1) ((unsigned*)(u ? o8_1 : o8_0))[lane + 64 * j] = pk4_fp8(o.x, o.y, o.z, o.w); }
    }
}
__device__ __forceinline__ int block_excl_scan(int x, int* scr, int tid, int& total) {
    const int lane = tid & 63, wid = tid >> 6; int inc = x;
#pragma unroll
    for (int o = 1; o < 64; o <<= 1) { const int y = __shfl_up(inc, o); if (lane >= o) inc += y; }
    __syncthreads();
    if (lane == 63) scr[wid] = inc;
    __syncthreads();
    int base = 0, tot = 0;
#pragma unroll
    for (int w = 0; w < 8; ++w) { const int c = scr[w]; base += (w < wid) ? c : 0; tot += c; }
    total = tot; return base + inc - x;
}

__device__ __forceinline__ void tb_load(float (&v)[32], const float* Wblk, int ldw, int lane) {
#pragma unroll
    for (int i = 0; i < 32; ++i) v[i] = __builtin_nontemporal_load(&Wblk[(size_t)(2 * i + (lane >> 5)) * ldw + (lane & 31)]);
}
__device__ __forceinline__ void tb_store(const float (&v)[32], bf16_t* dst, int ldt, float* scr, int lane) {
#pragma unroll
    for (int i = 0; i < 32; ++i) scr[(2 * i + (lane >> 5)) * 33 + (lane & 31)] = v[i];
    asm volatile("s_waitcnt lgkmcnt(0)" ::: "memory");
    const int c = lane & 7;
#pragma unroll
    for (int j = 0; j < 4; ++j) { const int n = (lane >> 3) + 8 * j; const float* s = scr + (8 * c) * 33 + n;
        uint4 o; o.x = pk2(s[0 * 33], s[1 * 33]); o.y = pk2(s[2 * 33], s[3 * 33]); o.z = pk2(s[4 * 33], s[5 * 33]); o.w = pk2(s[6 * 33], s[7 * 33]);
        *(uint4*)(dst + (size_t)n * ldt + 8 * c) = o; }
    asm volatile("s_waitcnt lgkmcnt(0)" ::: "memory");
}

__device__ __forceinline__ void tb_store8(const float (&v)[32], unsigned char* dst, int ldt, float sc, float* scr, int lane) {
#pragma unroll
    for (int i = 0; i < 32; ++i) scr[(2 * i + (lane >> 5)) * 33 + (lane & 31)] = v[i];
    asm volatile("s_waitcnt lgkmcnt(0)" ::: "memory");
    const int c = lane & 7;
#pragma unroll
    for (int j = 0; j < 4; ++j) { const int n = (lane >> 3) + 8 * j; const float* s = scr + (8 * c) * 33 + n;
        *(uint2*)(dst + (size_t)n * ldt + 8 * c) = make_uint2(pk4_fp8(s[0 * 33] * sc, s[1 * 33] * sc, s[2 * 33] * sc, s[3 * 33] * sc), pk4_fp8(s[4 * 33] * sc, s[5 * 33] * sc, s[6 * 33] * sc, s[7 * 33] * sc)); }
    asm volatile("s_waitcnt lgkmcnt(0)" ::: "memory");
}

__device__ __forceinline__ void ln_row(const float* a, const float* add, float alpha, const float* g, const float* b, float* out, int lane, float4 (&v)[4], bf16_t* outb = nullptr) {
    float s = 0.f;
#pragma unroll
    for (int j = 0; j < 4; ++j) {
        float4 x = ((const float4*)a)[lane + 64 * j];
        x.x *= alpha; x.y *= alpha; x.z *= alpha; x.w *= alpha;
        if (add) { const float4 y = ((const float4*)add)[lane + 64 * j]; x.x += y.x; x.y += y.y; x.z += y.z; x.w += y.w; }
        v[j] = x; s += (x.x + x.y) + (x.z + x.w);
    }
    const float mean = wave_sum(s) * (1.f / DM); float s2 = 0.f;
#pragma unroll
    for (int j = 0; j < 4; ++j) { v[j].x -= mean; v[j].y -= mean; v[j].z -= mean; v[j].w -= mean; s2 += (v[j].x * v[j].x + v[j].y * v[j].y) + (v[j].z * v[j].z + v[j].w * v[j].w); }
    const float rstd = 1.f / sqrtf(wave_sum(s2) * (1.f / DM) + LN_EPS);
#pragma unroll
    for (int j = 0; j < 4; ++j) {
        const float4 gg = ((const float4*)g)[lane + 64 * j], bb = ((const float4*)b)[lane + 64 * j];
        float4 o; o.x = v[j].x * rstd * gg.x + bb.x; o.y = v[j].y * rstd * gg.y + bb.y; o.z = v[j].z * rstd * gg.z + bb.z; o.w = v[j].w * rstd * gg.w + bb.w;
        if (out) ((float4*)out)[lane + 64 * j] = o; v[j] = o;
        if (outb) ((uint2*)outb)[lane + 64 * j] = make_uint2(pk2(o.x, o.y), pk2(o.z, o.w));
    }
}

struct GemmP {
    const float* A; const int* ridx; const float* Bm; float* C;
    int lda, ldb, ldc, M, N, K, nb, bshift;
    long sA, sB, sC; int sR;
    const float* aux; const bf16_t* auxb; int ldaux; long sAux; const float* aux2; int accum;
};
template <int MODE>
__device__ __forceinline__ void gemm_naive(const GemmP g, float* lds) {
    float (*As)[132] = (float (*)[132])lds;
    float (*Bs)[128] = (float (*)[128])(lds + 16 * 132);
    int tid_ = threadIdx.x; asm volatile("" : "+v"(tid_));
    const int tid = tid_, ty = tid >> 4, tx = tid & 15;
    const int mt = g.M / 128, nt = (g.N + 127) / 128, per = mt * nt, total = per * g.nb;
    int bid_ = blockIdx.x; asm volatile("" : "+s"(bid_));
    for (int tile = bid_; tile < total; tile += gridDim.x) {
        const int z = tile / per, r = tile % per, tm = r / nt, tn = r % nt;
        const int m0 = tm * 128, n0 = tn * 128;
        const float* Bz = g.Bm + (long)(z >> g.bshift) * g.sB;
        float* Cz = g.C + (long)z * g.sC;
        const int arow = m0 + (tid >> 2);
        const long grow = g.ridx ? (long)g.ridx[z * g.sR + arow] : (long)arow;
        const float* Arow = g.A + (long)z * g.sA + grow * g.lda + (tid & 3) * 4;
        const int bk = tid >> 5, bn = n0 + (tid & 31) * 4;
        const bool bok = bn < g.N;
        const float* Bp = Bz + (long)bk * g.ldb + bn;
        float acc[4][8];
#pragma unroll
        for (int i = 0; i < 4; ++i)
#pragma unroll
            for (int j = 0; j < 8; ++j) acc[i][j] = 0.f;
        float4 ra = *(const float4*)(Arow);
        float4 rb = bok ? *(const float4*)(Bp) : make_float4(0.f, 0.f, 0.f, 0.f);
        for (int k0 = 0; k0 < g.K; k0 += 16) {
            __syncthreads();
            { const int rr = tid >> 2, k4 = (tid & 3) * 4; As[k4][rr] = ra.x; As[k4 + 1][rr] = ra.y; As[k4 + 2][rr] = ra.z; As[k4 + 3][rr] = ra.w; }
            *(float4*)&Bs[bk][(tid & 31) * 4] = rb;
            __syncthreads();
            if (k0 + 16 < g.K) {
                ra = *(const float4*)(Arow + k0 + 16);
                rb = bok ? *(const float4*)(Bp + (long)(k0 + 16) * g.ldb) : make_float4(0.f, 0.f, 0.f, 0.f);
            }
#pragma unroll
            for (int k = 0; k < 16; ++k) {
                const float4 a = *(const float4*)&As[k][ty * 4];
                const float4 b0 = *(const float4*)&Bs[k][tx * 8], b1 = *(const float4*)&Bs[k][tx * 8 + 4];
                const float av[4] = {a.x, a.y, a.z, a.w};
                const float bv[8] = {b0.x, b0.y, b0.z, b0.w, b1.x, b1.y, b1.z, b1.w};
#pragma unroll
                for (int i = 0; i < 4; ++i)
#pragma unroll
                    for (int j = 0; j < 8; ++j) acc[i][j] = fmaf(av[i], bv[j], acc[i][j]);
            }
        }
#pragma unroll
        for (int i = 0; i < 4; ++i) {
            const int row = m0 + ty * 4 + i;
#pragma unroll
            for (int jv = 0; jv < 2; ++jv) {
                const int col = n0 + tx * 8 + jv * 4;
                if (col < g.N) {
                    float v[4] = {acc[i][jv * 4], acc[i][jv * 4 + 1], acc[i][jv * 4 + 2], acc[i][jv * 4 + 3]};
                    float* cp = Cz + (long)row * g.ldc + col;
                    if (MODE == 1) {
#pragma unroll
                        for (int q = 0; q < 4; ++q) v[q] *= g.aux[(long)z * g.sAux + col + q];
                    } else if (MODE == 2) {
                        float gl[4]; ld4bf(g.auxb + (long)row * g.ldaux + col, gl); const float4 gb = *(const float4*)(g.aux2 + col);
                        const float gv[4] = {gl[0] + gb.x, gl[1] + gb.y, gl[2] + gb.z, gl[3] + gb.w};
                        float4 old = make_float4(0.f, 0.f, 0.f, 0.f);
                        if (g.accum) old = *(const float4*)cp;
                        const float ov[4] = {old.x, old.y, old.z, old.w};
#pragma unroll
                        for (int q = 0; q < 4; ++q) v[q] = ov[q] + sigmoidf_(gv[q]) * v[q];
                    } else if (MODE == 3) {
                        const float4 old = *(const float4*)cp; const float ov[4] = {old.x, old.y, old.z, old.w};
#pragma unroll
                        for (int q = 0; q < 4; ++q) v[q] = siluf_(ov[q]) * v[q];
                    } else if (MODE == 4) {
                        const float rs = g.aux[(long)z * g.sAux + row];
#pragma unroll
                        for (int q = 0; q < 4; ++q) v[q] *= rs;
                    }
                    *(float4*)cp = make_float4(v[0], v[1], v[2], v[3]);
                }
            }
        }
    }
    __syncthreads();
}

#define W_IN(l)    (p.in[4]  + (size_t)(l) * DM * DIN)
#define B_GATE(l)  (p.in[5]  + (size_t)(l) * 3 * DM)
#define POOL_W(l)  (p.in[6]  + (size_t)(l) * 4 * 128 * 128)
#define POOL_S(l)  (p.in[7]  + (size_t)(l) * 512)
#define W_UP_A(l)  (p.in[8]  + (size_t)(l) * 512 * DM)
#define Q_NORM(l)  (p.in[9]  + (size_t)(l) * 384)
#define W_UQ(l)    (p.in[10] + (size_t)(l) * 384 * 768)
#define KV_NORM(l) (p.in[11] + (size_t)(l) * 256)
#define W_UKV(l)   (p.in[12] + (size_t)(l) * 256 * 1024)
#define W_UP_B(l)  (p.in[13] + (size_t)(l) * 512 * DM)
#define W_DEC(l)   (p.in[14] + (size_t)(l) * 2 * 16 * 256)
#define B_DEC(l)   (p.in[15] + (size_t)(l) * 2 * 256)
#define GLA_NORM(l)(p.in[16] + (size_t)(l) * 128)
#define W_UP_C(l)  (p.in[17] + (size_t)(l) * 512 * DM)
#define W_OUT(l)   (p.in[18] + (size_t)(l) * DM * DM)
#define LN1_G(l)   (p.in[19] + (size_t)(l) * DM)
#define LN1_B(l)   (p.in[20] + (size_t)(l) * DM)
#define ROUTER(l)  (p.in[21] + (size_t)(l) * DM * NE)
#define EW_GATE(l) (p.in[22] + (size_t)(l) * NE * DM * DEXP)
#define EW_UP(l)   (p.in[23] + (size_t)(l) * NE * DM * DEXP)
#define EW_DOWN(l) (p.in[24] + (size_t)(l) * NE * DEXP * DM)
#define LN2_G(l)   (p.in[25] + (size_t)(l) * DM)
#define LN2_B(l)   (p.in[26] + (size_t)(l) * DM)
#define WSF(off) ((float*)(p.ws + (off)))
#define WSI(off) ((int*)(p.ws + (off)))
#define WSB(off) ((bf16_t*)(p.ws + (off)))
#define PJ(t, c) bf2f(projb[(size_t)(t) * DINP + (c)])

enum Stage {
    ST_INIT = 0,
    ST_WCONV,
    ST_PROJ,
    ST_PREP,
    ST_SMALLGEMM,
    ST_ROPE,
    ST_ATTN,
    ST_GLA1, ST_GLA2, ST_GLA3,
    ST_GLAFIN,
    ST_MERGE_A, ST_MERGE_B, ST_MERGE_C,
    ST_OUTP,
    ST_LN1,
    ST_TOPK,
    ST_GATHER,
    ST_EXP_G, ST_EXP_U, ST_EXP_D,
    ST_LN2,
    ST_COUNT
};

#define KAS __attribute__((address_space(4)))
template <int ST>
__device__ __forceinline__ void run_stage(int l, float* lds) {
    const KAS Params* pk_ = (const KAS Params*)__builtin_amdgcn_kernarg_segment_ptr(); asm volatile("" : "+s"(pk_));
    const KAS Params& p = *pk_;
    int tid_ = threadIdx.x; asm volatile("" : "+v"(tid_));
    int bid_ = blockIdx.x; asm volatile("" : "+s"(bid_));
    const int tid = tid_, lane = tid & 63, wid = tid >> 6;
    const int G = gridDim.x, bid = bid_;
    const int gw = bid * 8 + wid, NGW = G * 8;
    const long gt = (long)bid * NTHR + tid, NGT = (long)G * NTHR;
    float* h = p.out;

    if constexpr (ST == ST_INIT) {
        for (int m = gw; m < T; m += NGW) { float4 vv[4]; ln_row(p.in[0] + (size_t)m * DM, nullptr, 1.f, p.in[2], p.in[3], nullptr, lane, vv, WSB(WS_HB) + (size_t)m * DM); }
        {
            float* scr = lds + wid * 4096;
            constexpr int NBLK = DIN / 32, ITEMS_L = (DM / 64) * NBLK;
            for (int it = gw; it < 2 * ITEMS_L; it += NGW) {
                const int ll = it / ITEMS_L, r = it % ITEMS_L, kb = r / NBLK, nb = r % NBLK;
                const int n0 = 32 * nb, drow = n0 < 2752 ? n0 + 3072 : n0 - 2752;
                transpose_block(p.in[4] + (size_t)ll * DM * DIN + (size_t)(64 * kb) * DIN + n0, DIN, WSB(WS_WIN_T) + (size_t)ll * DINP * DM + (size_t)drow * DM + 64 * kb, DM, nullptr, nullptr, scr, lane);
            }
            {
                constexpr int I_UQ = 6 * 24, I_UKV = 4 * 32, I_B = 8 * 32, I_OUT = 16 * 32, I_L = I_UQ + I_UKV + 2 * I_B + I_OUT;
                for (int it = gw; it < 2 * I_L; it += NGW) {
                    const int ll = it / I_L; int r = it % I_L; bf16_t* wsm = WSB(WS_WSMALL + (size_t)ll * WSM_STRIDE);
                    if (r < I_UQ) { const int kb = r / 24, nb = r % 24; transpose_block(p.in[10] + (size_t)ll * 384 * 768 + (size_t)(64 * kb) * 768 + 32 * nb, 768, wsm + WSM_UQ / 2 + (size_t)(32 * nb) * 384 + 64 * kb, 384, p.in[9] + ll * 384 + 64 * kb, nullptr, scr, lane); continue; } r -= I_UQ;
                    if (r < I_UKV) { const int kb = r / 32, nb = r % 32; transpose_block(p.in[12] + (size_t)ll * 256 * 1024 + (size_t)(64 * kb) * 1024 + 32 * nb, 1024, wsm + WSM_UKV / 2 + (size_t)(32 * nb) * 256 + 64 * kb, 256, p.in[11] + ll * 256 + 64 * kb, nullptr, scr, lane); continue; } r -= I_UKV;
                    if (r < 2 * I_B) { const int c = r / I_B, rr = r % I_B, kb = rr / 32, nb = rr % 32; const float* W = (c ? p.in[17] : p.in[13]) + (size_t)ll * 512 * DM;
                        transpose_block(W + (size_t)(64 * kb) * DM + 32 * nb, DM, wsm + WSM_MRG / 2 + (size_t)(32 * nb) * 1536 + 512 * (1 + c) + 64 * kb, 1536, nullptr, nullptr, scr, lane); continue; } r -= 2 * I_B;
                    { const int kb = r / 32, nb = r % 32; transpose_block(p.in[18] + (size_t)ll * DM * DM + (size_t)(64 * kb) * DM + 32 * nb, DM, wsm + WSM_OUT / 2 + (size_t)(32 * nb) * DM + 64 * kb, DM, nullptr, nullptr, scr, lane); }
                }
                for (long i = gt; i < 2L * 512 * DM; i += NGT) {
                    const int ll = (int)(i / (512 * DM)), r = (int)(i % (512 * DM)), cin = r >> 10, d = r & 1023, g = cin >> 7, c = cin & 127;
                    const float* pw = p.in[6] + (size_t)ll * 4 * 128 * 128 + (size_t)(g * 128 + c) * 128; const float* ps = p.in[7] + ll * 512 + g * 128; const float* wa = p.in[8] + (size_t)ll * 512 * DM + (size_t)(g * 128) * DM + d;
                    float a = 0.f;
                    for (int cc = 0; cc < 128; ++cc) a = fmaf(pw[cc] * ps[cc], wa[(size_t)cc * DM], a);
                    WSB(WS_WSMALL + (size_t)ll * WSM_STRIDE + WSM_MRG)[(size_t)d * 1536 + cin] = (bf16_t)f2bf(a);
                }
            }
            for (long i = gt; i < 2L * 64 * DM / 8; i += NGT) { const int ll = (int)(i / (64 * DM / 8)); const long r = i % (64 * DM / 8);
                *(uint4*)(WSB(WS_WIN_T) + (size_t)ll * DINP * DM + (size_t)DIN * DM + r * 8) = make_uint4(0u, 0u, 0u, 0u); }
        }
        float* rc = WSF(WS_ROPE); float* rs = rc + T * 16;
        for (long i = gt; i < (long)T * 16; i += NGT) {
            const int t = (int)(i >> 4), j = (int)(i & 15);
            const float freq = powf(10000.0f, -(float)j / 16.0f);
            const float ang = (float)p.pos[t] * freq;
            rc[i] = cosf(ang); rs[i] = sinf(ang);
        }
    }
    if constexpr (ST == ST_WCONV) {
        float* scr = lds + wid * 4096;
        constexpr int I_G = 16 * 16 * 64, I_D = 16 * 32 * 32;
        constexpr int I_ALL = 2 * I_G + I_D;
#define WCONV_ITEM(it, W, ldw, dst, ldt, sc8) do { if ((it) < 2 * I_G) { const int up_ = (it) >= I_G, r_ = up_ ? (it) - I_G : (it), e_ = r_ >> 10, kb_ = (r_ >> 6) & 15, nb_ = r_ & 63, j0_ = nb_ * 32; \
            W = (up_ ? EW_UP(l) : EW_GATE(l)) + (size_t)e_ * DM * DEXP + (size_t)(64 * kb_) * DEXP + j0_; ldw = DEXP; \
            dst = (unsigned char*)(p.ws + WS_WGU_T) + (size_t)(e_ * 4096 + 256 * (j0_ >> 7) + (j0_ & 127) + (up_ ? 128 : 0)) * DM + 64 * kb_; ldt = DM; sc8 = F8_WGU; } \
          else { const int r_ = (it) - 2 * I_G, e_ = r_ >> 10, kb_ = (r_ >> 5) & 31, nb_ = r_ & 31; \
            W = EW_DOWN(l) + (size_t)e_ * DEXP * DM + (size_t)(64 * kb_) * DM + 32 * nb_; ldw = DM; dst = (unsigned char*)(p.ws + WS_WD_T) + (size_t)(e_ * 1024 + 32 * nb_) * DEXP + 64 * kb_; ldt = DEXP; sc8 = F8_WD; } } while (0)
        float va[32], vb[32]; const float* Wa = nullptr; const float* Wb = nullptr; unsigned char* da = nullptr; unsigned char* db = nullptr; int lwa = 0, lwb = 0, lta = 0, ltb = 0; float sa = 1.f, sb = 1.f;
        int itA = gw, itB = gw + NGW;
        if (itA < I_ALL) { WCONV_ITEM(itA, Wa, lwa, da, lta, sa); tb_load(va, Wa, lwa, lane); }
        while (itA < I_ALL) {
            if (itB < I_ALL) { WCONV_ITEM(itB, Wb, lwb, db, ltb, sb); tb_load(vb, Wb, lwb, lane); }
            tb_store8(va, da, lta, sa, scr, lane);
            itA = itB + NGW;
            if (itB >= I_ALL) break;
            if (itA < I_ALL) { WCONV_ITEM(itA, Wa, lwa, da, lta, sa); tb_load(va, Wa, lwa, lane); }
            tb_store8(vb, db, ltb, sb, scr, lane);
            itB = itA + NGW;
        }
#undef WCONV_ITEM
        __syncthreads();
    }
    if constexpr (ST == ST_PROJ) {
        pg8::Gemm g{WSB(WS_HB), WSB(WS_WIN_T) + (size_t)l * DINP * DM, T, DINP, DM, DM};
        pg8::StaticOrder S; S.init(T, DINP, G, bid);
        EpiProj E{WSB(WS_PROJB), B_GATE(l)};
        pg8::gemm_phase<EpiProj, pg8::StaticOrder, true, true>((PG8_LAS unsigned char*)lds, g, S, E);
    }
    if constexpr (ST == ST_PREP) {
        const bf16_t* projb = WSB(WS_PROJB); bf16_t* br = WSB(WS_BR); bf16_t* U = (bf16_t*)lds;
        float* rq = WSF(WS_RQ); float* rkv = rq + T; const float* rc = WSF(WS_ROPE); const float* rs = rc + T * 16; bf16_t* kb = WSB(WS_KB);
        for (int tile = bid; tile < T / 64; tile += G) {
            const int b = tile / (SEQ / 64), s0 = (tile % (SEQ / 64)) * 64, t0 = b * SEQ + s0;
            __syncthreads();
#pragma unroll
            for (int it = 0; it < 10; ++it) { const int e = tid + it * NTHR, r = e >> 6, ch = e & 63, s = s0 - 8 + r;
                uint4 v = make_uint4(0u, 0u, 0u, 0u);
                if (s >= 0 && s < SEQ) v = *(const uint4*)(projb + (size_t)(b * SEQ + s) * DINP + OFF_POOL + ch * 8);
                *(uint4*)(U + r * 512 + ch * 8) = v; }
            for (int r = wid; r < 64; r += 8) { const bf16_t* row = projb + (size_t)(t0 + r) * DINP;
                float s1 = 0.f, s2 = 0.f;
                if (lane < 48) { const uint4 w = *(const uint4*)(row + OFF_CQ + lane * 8); const unsigned ww[4] = {w.x, w.y, w.z, w.w};
#pragma unroll
                    for (int q = 0; q < 4; ++q) { const float a = __uint_as_float(ww[q] << 16), c = __uint_as_float(ww[q] & 0xffff0000u); s1 += a * a + c * c; } }
                if (lane < 32) { const uint4 w = *(const uint4*)(row + OFF_CKV + lane * 8); const unsigned ww[4] = {w.x, w.y, w.z, w.w};
#pragma unroll
                    for (int q = 0; q < 4; ++q) { const float a = __uint_as_float(ww[q] << 16), c = __uint_as_float(ww[q] & 0xffff0000u); s2 += a * a + c * c; } }
                s1 = wave_sum(s1); s2 = wave_sum(s2);
                if (lane == 0) { rq[t0 + r] = 1.f / sqrtf(s1 * (1.f / 384.f) + RMS_EPS); rkv[t0 + r] = 1.f / sqrtf(s2 * (1.f / 256.f) + RMS_EPS); } }
#pragma unroll
            for (int it = 0; it < 2; ++it) { const int e = tid + it * NTHR, r = e >> 4, j = e & 15, t = t0 + r;
                const float c = rc[(size_t)t * 16 + j], s = rs[(size_t)t * 16 + j], x1 = PJ(t, OFF_KR + j), x2 = PJ(t, OFF_KR + 16 + j);
                const bf16_t k1 = (bf16_t)f2bf(x1 * c - x2 * s), k2 = (bf16_t)f2bf(x1 * s + x2 * c);
#pragma unroll
                for (int hh = 0; hh < 8; ++hh) { kb[(size_t)t * 768 + hh * 96 + 64 + j] = k1; kb[(size_t)t * 768 + hh * 96 + 80 + j] = k2; } }
            __syncthreads();
            { const int c = tid, hw = 1 << (c >> 7); float sum = 0.f;
                for (int u = s0 - hw; u < s0 + hw; ++u) if (u >= 0 && u < SEQ) sum += bf2f(U[(u - s0 + 8) * 512 + c]);
                for (int s = s0; s < s0 + 64; ++s) {
                    int lo = s - hw; if (lo < 0) lo = 0; int hi = s + hw; if (hi > SEQ) hi = SEQ;
                    br[(size_t)(b * SEQ + s) * 1536 + c] = (bf16_t)f2bf(sum / (float)(hi - lo) - bf2f(U[(s - s0 + 8) * 512 + c]));
                    if (s + hw < SEQ) sum += bf2f(U[(s + hw - s0 + 8) * 512 + c]);
                    if (s - hw >= 0) sum -= bf2f(U[(s - hw - s0 + 8) * 512 + c]);
                } }
        }
        __syncthreads();
    }
    if constexpr (ST == ST_SMALLGEMM) {
        const bf16_t* wsm = WSB(WS_WSMALL + (size_t)l * WSM_STRIDE);
        { pg8::Gemm g{WSB(WS_PROJB) + OFF_CQ, wsm + WSM_UQ / 2, T, 768, 384, DINP}; pg8::StaticOrder S; S.init(T, 768, G, bid);
          EpiQ E{WSB(WS_QB), WSF(WS_RQ), WSF(WS_ROPE), WSF(WS_ROPE) + T * 16}; pg8::gemm_phase<EpiQ, pg8::StaticOrder, true, true>((PG8_LAS unsigned char*)lds, g, S, E); }
        { pg8::Gemm g{WSB(WS_PROJB) + OFF_CKV, wsm + WSM_UKV / 2, T, 1024, 256, DINP}; pg8::StaticOrder S; S.init(T, 1024, G, bid);
          EpiKV E{WSB(WS_KB), WSB(WS_VB), WSF(WS_RQ) + T}; pg8::gemm_phase<EpiKV, pg8::StaticOrder, true, true>((PG8_LAS unsigned char*)lds, g, S, E); }
    }
    if constexpr (ST == ST_ATTN) {
        const int vcu = (G % 8 == 0) ? (bid % 8) * (G / 8) + bid / 8 : bid;
        WStream wst; wst.gate = EW_GATE(l); wst.up = EW_UP(l); wst.down = EW_DOWN(l); wst.wgu_t = p.ws + WS_WGU_T; wst.wd_t = p.ws + WS_WD_T;
        { const int wu = __builtin_amdgcn_readfirstlane(wid); wst.init(bid * 8 + wu, NGW, (char*)lds + att::SHM_ATTN + wu * 2560); }
        for (int L = vcu; L < NB * 8 * 32; L += G) {
            const int bh = L >> 5, qb = L & 31, b = bh >> 3, hh = bh & 7;
            att::attn_unit(WSB(WS_QB) + (size_t)(b * SEQ + qb * 256) * 768 + hh * 96, WSB(WS_KB) + (size_t)(b * SEQ) * 768 + hh * 96, WSB(WS_VB) + (size_t)(b * SEQ) * 512 + hh * 64,
                           WSB(WS_BR) + (size_t)(b * SEQ + qb * 256) * 1536 + 512 + hh * 64, SEQ, (char*)lds, wst);
        }
        while (wst.step <= wst.nsteps) wst.tick(lane);
    }
    if constexpr (ST == ST_GLA1) {
        for (int item = bid; item < NB * 4 * 128; item += G) {
            const int b = item >> 9, hh = (item >> 7) & 3, c = item & 127;
            gla::g1_item((char*)lds, WSB(WS_PROJB), W_DEC(l), B_DEC(l), b, hh, c, WSF(WS_KVT), WSF(WS_DEC));
        }
    }
    if constexpr (ST == ST_GLA2) {
        const float* kvt = WSF(WS_KVT); const float* dec = WSF(WS_DEC); bf16_t* stp = WSB(WS_ST);
        for (long e = gt; e < 2L * 8 * 8192; e += NGT) {
            const int dir = (int)(e >> 16), bh = (int)((e >> 13) & 7), vd = (int)(e & 8191), d = vd & 63;
            const long base = ((long)dir * 8 + bh) * 128;
            float s = 0.f;
#pragma unroll 1
            for (int k0 = 0; k0 < 128; k0 += 32) {
                float kv[32], dc[32];
#pragma unroll
                for (int k = 0; k < 32; ++k) { const int c = dir ? 127 - (k0 + k) : k0 + k; kv[k] = kvt[(base + c) * 8192 + vd]; dc[k] = dec[(base + c) * 64 + d]; }
#pragma unroll
                for (int k = 0; k < 32; ++k) { const int c = dir ? 127 - (k0 + k) : k0 + k; stp[(base + c) * 8192 + vd] = (bf16_t)f2bf(s); s = fmaf(dc[k], s, kv[k]); }
            }
        }
    }
    if constexpr (ST == ST_GLA3) {
        for (int item = bid; item < NB * 4 * 128; item += G) {
            const int b = item >> 9, hh = (item >> 7) & 3, c = item & 127;
            gla::g3_item((char*)lds, WSB(WS_PROJB), W_DEC(l), B_DEC(l), GLA_NORM(l), b, hh, c, WSB(WS_ST), WSB(WS_BR) + 1024, 1536);
        }
    }
    if constexpr (ST == ST_MERGE_A) {
        const bf16_t* wsm = WSB(WS_WSMALL + (size_t)l * WSM_STRIDE);
        pg8::Gemm g{WSB(WS_BR), wsm + WSM_MRG / 2, T, DM, 1536, 1536}; pg8::StaticOrder S; S.init(T, DM, G, bid);
        EpiMerge E{WSB(WS_MERGEDB), WSB(WS_PROJB) + OFF_GATE};
        pg8::gemm_phase<EpiMerge, pg8::StaticOrder, true, true>((PG8_LAS unsigned char*)lds, g, S, E);
    }
    if constexpr (ST == ST_OUTP) {
        const bf16_t* wsm = WSB(WS_WSMALL + (size_t)l * WSM_STRIDE);
        pg8::Gemm g{WSB(WS_MERGEDB), wsm + WSM_OUT / 2, T, DM, DM, DM}; pg8::StaticOrder S; S.init(T, DM, G, bid);
        pg8::EpiBf16<0> E{WSB(WS_TMP), DM, nullptr, 0, 0, 1.f};
        pg8::gemm_phase<pg8::EpiBf16<0>, pg8::StaticOrder, true, true>((PG8_LAS unsigned char*)lds, g, S, E);
    }
    if constexpr (ST == ST_LN1) {
        float* RWT = lds; const float* rw = ROUTER(l);
        for (int i = tid; i < DM * 4; i += NTHR) { const int k = i >> 2, e4 = (i & 3) * 4; const float4 w = *(const float4*)(rw + (size_t)k * 16 + e4);
            RWT[(e4 + 0) * DM + k] = w.x; RWT[(e4 + 1) * DM + k] = w.y; RWT[(e4 + 2) * DM + k] = w.z; RWT[(e4 + 3) * DM + k] = w.w; }
        __syncthreads();
        float* afft = WSF(WS_AFF);
        for (int m0 = gw; m0 < T; m0 += 2 * NGW) {
            const int mr[2] = {m0, m0 + NGW};
            float4 hv[2][4];
#pragma unroll
            for (int u = 0; u < 2; ++u) { const bf16_t* hr = WSB(WS_HB) + (size_t)mr[u] * DM; const bf16_t* tr = WSB(WS_TMP) + (size_t)mr[u] * DM;
#pragma unroll
                for (int j = 0; j < 4; ++j) { float a[4], t4[4]; ld4bf(hr + 4 * (lane + 64 * j), a); ld4bf(tr + 4 * (lane + 64 * j), t4);
                    hv[u][j] = make_float4(fmaf(ALPHA, a[0], t4[0]), fmaf(ALPHA, a[1], t4[1]), fmaf(ALPHA, a[2], t4[2]), fmaf(ALPHA, a[3], t4[3])); } }
            ln_core2<1>(hv, LN1_G(l), LN1_B(l), nullptr, nullptr, WSB(WS_HB) + (size_t)mr[0] * DM, WSB(WS_HB) + (size_t)mr[1] * DM, lane,
                     p.ws + WS_HB8 + (size_t)mr[0] * DM, p.ws + WS_HB8 + (size_t)mr[1] * DM);
            float acc[2][16];
#pragma unroll
            for (int e = 0; e < 16; ++e) { float a0 = 0.f, a1 = 0.f;
#pragma unroll
                for (int j = 0; j < 4; ++j) { const float4 w = *(const float4*)(RWT + e * DM + 4 * (lane + 64 * j));
                    a0 = fmaf(hv[0][j].x, w.x, a0); a0 = fmaf(hv[0][j].y, w.y, a0); a0 = fmaf(hv[0][j].z, w.z, a0); a0 = fmaf(hv[0][j].w, w.w, a0);
                    a1 = fmaf(hv[1][j].x, w.x, a1); a1 = fmaf(hv[1][j].y, w.y, a1); a1 = fmaf(hv[1][j].z, w.z, a1); a1 = fmaf(hv[1][j].w, w.w, a1); }
                acc[0][e] = a0; acc[1][e] = a1; if (e & 1) __builtin_amdgcn_sched_barrier(0); }
#pragma unroll
            for (int i = 0; i < 8; ++i)
#pragma unroll
                for (int u = 0; u < 2; ++u) { const bool up = lane & 32; const float keep = up ? acc[u][i + 8] : acc[u][i], send = up ? acc[u][i] : acc[u][i + 8]; acc[u][i] = keep + __shfl_xor(send, 32); }
#pragma unroll
            for (int i = 0; i < 4; ++i)
#pragma unroll
                for (int u = 0; u < 2; ++u) { const bool up = lane & 16; const float keep = up ? acc[u][i + 4] : acc[u][i], send = up ? acc[u][i] : acc[u][i + 4]; acc[u][i] = keep + __shfl_xor(send, 16); }
#pragma unroll
            for (int i = 0; i < 2; ++i)
#pragma unroll
                for (int u = 0; u < 2; ++u) { const bool up = lane & 8; const float keep = up ? acc[u][i + 2] : acc[u][i], send = up ? acc[u][i] : acc[u][i + 2]; acc[u][i] = keep + __shfl_xor(send, 8); }
#pragma unroll
            for (int u = 0; u < 2; ++u) { const bool up = lane & 4; const float keep = up ? acc[u][1] : acc[u][0], send = up ? acc[u][0] : acc[u][1]; acc[u][0] = keep + __shfl_xor(send, 4); }
            float lg[2] = {acc[0][0], acc[1][0]};
#pragma unroll
            for (int o = 1; o <= 2; o <<= 1) { const float t0 = __shfl_xor(lg[0], o), t1 = __shfl_xor(lg[1], o); lg[0] += t0; lg[1] += t1; }
            float mx[2] = {lg[0], lg[1]};
#pragma unroll
            for (int o = 4; o <= 32; o <<= 1) { const float t0 = __shfl_xor(mx[0], o), t1 = __shfl_xor(mx[1], o); mx[0] = fmaxf(mx[0], t0); mx[1] = fmaxf(mx[1], t1); }
            const float ex[2] = {expf(lg[0] - mx[0]), expf(lg[1] - mx[1])}; float se[2] = {ex[0], ex[1]};
#pragma unroll
            for (int o = 4; o <= 32; o <<= 1) { const float t0 = __shfl_xor(se[0], o), t1 = __shfl_xor(se[1], o); se[0] += t0; se[1] += t1; }
            if ((lane & 3) == 0) { const int e = ((lane >> 5) & 1) * 8 + ((lane >> 4) & 1) * 4 + ((lane >> 3) & 1) * 2 + ((lane >> 2) & 1);
#pragma unroll
                for (int u = 0; u < 2; ++u) afft[(size_t)((mr[u] / SEQ) * 16 + e) * SEQ + (mr[u] % SEQ)] = ex[u] / se[u]; }
        }
        __syncthreads();
    }
    if constexpr (ST == ST_TOPK) {
        const float* afft = WSF(WS_AFF); int* idx = WSI(WS_IDX); float* gv = WSF(WS_GATEV); int* slot = WSI(WS_SLOT);
        int* hist = (int*)lds; int* ctl = hist + 256; int* scr = hist + 272;
        for (int z = bid; z < NZ; z += G) {
            const int e = z >> 1, b = z & 1; const float* list = afft + (size_t)(b * 16 + e) * SEQ;
            unsigned key[16];
#pragma unroll
            for (int j = 0; j < 16; j += 4) { const float4 x = *(const float4*)(list + tid * 16 + j); key[j] = __float_as_uint(x.x); key[j + 1] = __float_as_uint(x.y); key[j + 2] = __float_as_uint(x.z); key[j + 3] = __float_as_uint(x.w); }
            unsigned prefix = 0u; int need = CAP;
#pragma unroll 1
            for (int shift = 24; shift >= 0; shift -= 8) {
                __syncthreads();
                if (tid < 256) hist[tid] = 0;
                __syncthreads();
#pragma unroll
                for (int j = 0; j < 16; ++j) { const bool in = (shift == 24) || ((key[j] >> (shift + 8)) == (prefix >> (shift + 8))); if (in) atomicAdd(&hist[(key[j] >> shift) & 255u], 1); }
                __syncthreads();
                if (tid < 256) {
                    const int hc = hist[tid]; int inc = hc;
#pragma unroll
                    for (int o = 1; o < 64; o <<= 1) { const int y = __shfl_down(inc, o); if (lane + o < 64) inc += y; }
                    if (lane == 0) scr[wid] = inc;
                    __builtin_amdgcn_s_waitcnt(0xc07f); __builtin_amdgcn_wave_barrier();
                }
                __syncthreads();
                if (tid < 256) {
                    const int hc = hist[tid]; int inc = hc;
#pragma unroll
                    for (int o = 1; o < 64; o <<= 1) { const int y = __shfl_down(inc, o); if (lane + o < 64) inc += y; }
                    int ca = inc - hc;
#pragma unroll
                    for (int w = 1; w < 4; ++w) ca += (w > wid) ? scr[w] : 0;
                    if (ca < need && need <= ca + hc) { ctl[0] = tid; ctl[1] = need - ca; } }
                __syncthreads();
                prefix |= (unsigned)ctl[0] << shift; need = ctl[1];
            }
            int ceq = 0;
#pragma unroll
            for (int j = 0; j < 16; ++j) ceq += (key[j] == prefix) ? 1 : 0;
            int tot; const int beq = block_excl_scan(ceq, scr, tid, tot);
            int csel = 0, eqr = beq; unsigned selmask = 0u;
#pragma unroll
            for (int j = 0; j < 16; ++j) { bool sel = key[j] > prefix; if (key[j] == prefix) { sel = eqr < need; ++eqr; } if (sel) { selmask |= 1u << j; ++csel; } }
            int sl = block_excl_scan(csel, scr, tid, tot);
#pragma unroll
            for (int j = 0; j < 16; ++j) { const int trow = b * SEQ + tid * 16 + j;
                if ((selmask >> j) & 1u) { idx[z * CAP + sl] = trow; gv[z * CAP + sl] = __uint_as_float(key[j]); slot[(size_t)trow * 16 + e] = sl; ++sl; }
                else slot[(size_t)trow * 16 + e] = -1; }
        }
        __syncthreads();
    }
    if constexpr (ST == ST_GATHER) {
        const int* idx = WSI(WS_IDX); const bf16_t* hb = WSB(WS_HB); bf16_t* xe = WSB(WS_XE);
        const int nr = (NZ * CAP - gw + NGW - 1) / NGW; const int myi = (lane < nr) ? (idx[gw + lane * NGW] & (T - 1)) : 0;
        for (int k = 0; k < nr; k += 4) {
            const int k1 = (k + 1 < nr) ? k + 1 : k, k2 = (k + 2 < nr) ? k + 2 : k, k3 = (k + 3 < nr) ? k + 3 : k;
            const uint4* s0 = (const uint4*)(hb + (size_t)__shfl(myi, k) * DM); const uint4* s1 = (const uint4*)(hb + (size_t)__shfl(myi, k1) * DM);
            const uint4* s2 = (const uint4*)(hb + (size_t)__shfl(myi, k2) * DM); const uint4* s3 = (const uint4*)(hb + (size_t)__shfl(myi, k3) * DM);
            const uint4 x0 = s0[lane], y0 = s0[lane + 64], x1 = s1[lane], y1 = s1[lane + 64], x2 = s2[lane], y2 = s2[lane + 64], x3 = s3[lane], y3 = s3[lane + 64];
            { uint4* d = (uint4*)(xe + (size_t)(gw + k * NGW) * DM); d[lane] = x0; d[lane + 64] = y0; }
            if (k + 1 < nr) { uint4* d = (uint4*)(xe + (size_t)(gw + (k + 1) * NGW) * DM); d[lane] = x1; d[lane + 64] = y1; }
            if (k + 2 < nr) { uint4* d = (uint4*)(xe + (size_t)(gw + (k + 2) * NGW) * DM); d[lane] = x2; d[lane + 64] = y2; }
            if (k + 3 < nr) { uint4* d = (uint4*)(xe + (size_t)(gw + (k + 3) * NGW) * DM); d[lane] = x3; d[lane + 64] = y3; }
        }
    }
    if constexpr (ST == ST_EXP_G) {
        pg8::Gemm g{WSB(WS_HB8), WSB(WS_WGU_T), NZ * CAP, 16 * 4096, DM / 2, DM / 2, WSI(WS_IDX)};
        ExpertOrder1 S; S.init(G, bid);
        EpiSwiGLU E{WSB(WS_HID), DEXP};
        pg8::gemm_phase<EpiSwiGLU, ExpertOrder1, true, true, true, true>((PG8_LAS unsigned char*)lds, g, S, E);
    }
    if constexpr (ST == ST_EXP_D) {
        pg8::Gemm g{WSB(WS_HID), WSB(WS_WD_T), NZ * CAP, 16 * 1024, DEXP / 2, DEXP / 2};
        ExpertOrder2 S; S.init(G, bid);
        EpiRowScale E{WSB(WS_YE), DM, WSF(WS_GATEV)};
        pg8::gemm_phase<EpiRowScale, ExpertOrder2, true, true, false, true>((PG8_LAS unsigned char*)lds, g, S, E);
    }
    if constexpr (ST == ST_LN2) {
        const int* slot = WSI(WS_SLOT); const bf16_t* ye = WSB(WS_YE);
        for (int m0 = gw; m0 < T; m0 += 2 * NGW) {
            const int mr[2] = {m0, m0 + NGW};
            int sl[2]; unsigned long long mask[2]; float4 a[2][4];
#pragma unroll
            for (int u = 0; u < 2; ++u) { sl[u] = (lane < 16) ? slot[(size_t)mr[u] * 16 + lane] : -1; }
#pragma unroll
            for (int u = 0; u < 2; ++u) { const bf16_t* hr = WSB(WS_HB) + (size_t)mr[u] * DM;
#pragma unroll
                for (int j = 0; j < 4; ++j) { float x[4]; ld4bf(hr + 4 * (lane + 64 * j), x); a[u][j] = make_float4(ALPHA * x[0], ALPHA * x[1], ALPHA * x[2], ALPHA * x[3]); } }
            mask[0] = __ballot(sl[0] >= 0); mask[1] = __ballot(sl[1] >= 0);
            while (mask[0] | mask[1]) {
#pragma unroll
                for (int u = 0; u < 2; ++u) if (mask[u]) {
                    const int e = __builtin_ctzll(mask[u]); mask[u] &= mask[u] - 1;
                    const bf16_t* yr = ye + ((size_t)(e * 2 + mr[u] / SEQ) * CAP + __shfl(sl[u], e)) * DM;
#pragma unroll
                    for (int j = 0; j < 4; ++j) { float y[4]; ld4bf(yr + 4 * (lane + 64 * j), y); a[u][j].x += y[0]; a[u][j].y += y[1]; a[u][j].z += y[2]; a[u][j].w += y[3]; }
                }
            }
            if (l == 0) ln_core2<0>(a, LN2_G(l), LN2_B(l), nullptr, nullptr, WSB(WS_HB) + (size_t)mr[0] * DM, WSB(WS_HB) + (size_t)mr[1] * DM, lane);
            else ln_core2<2>(a, LN2_G(l), LN2_B(l), h + (size_t)mr[0] * DM, h + (size_t)mr[1] * DM, nullptr, nullptr, lane);
        }
    }
}


#define LAS __attribute__((address_space(3)))
#define XB_TMO      128
#define XB_XCNT(j)  (256  + 64 * (j))
#define XB_XSUB(j)  (1280 + 64 * (j))
#define XB_XGEN(j)  (2304 + 64 * (j))
#define XB_TOP      3328
#define XB_TOPGEN   3392
#define XCD_BAR_WORDS 3456
#define XB_SPIN_CAP (1u << 18)
__device__ __forceinline__ unsigned xb_ld(unsigned* p)              { return __hip_atomic_load(p, __ATOMIC_RELAXED, __HIP_MEMORY_SCOPE_AGENT); }
__device__ __forceinline__ unsigned xb_add(unsigned* p, unsigned v) { return __hip_atomic_fetch_add(p, v, __ATOMIC_RELAXED, __HIP_MEMORY_SCOPE_AGENT); }
__device__ __forceinline__ unsigned xb_xcc_id() { return (unsigned)__builtin_amdgcn_s_getreg((3 << 11) | 20) & 0xFu; }
#define XB_SPIN(cond, bar) do { unsigned _sp = 0; while (cond) { __builtin_amdgcn_s_sleep(1); \
    if ((++_sp & 255u) == 0u) { if (xb_ld(&(bar)[XB_TMO])) break; if (_sp > XB_SPIN_CAP) { atomicAdd(&(bar)[XB_TMO], 1u); break; } } } } while (0)
struct XcdBarrier { unsigned* bar; unsigned x; volatile LAS unsigned* st; };
__device__ __forceinline__ XcdBarrier xcd_barrier_post(unsigned* bar, volatile LAS unsigned* st) {
    XcdBarrier b; b.bar = bar; b.x = xb_xcc_id(); b.st = st;
    if (threadIdx.x == 0) (void)xb_add(&bar[XB_XCNT(b.x)], 1u);
    return b;
}
__device__ __forceinline__ void xcd_barrier_complete(unsigned* bar, unsigned x, unsigned& nloc, unsigned& nx) {
    const unsigned G = gridDim.x * gridDim.y * gridDim.z;
    unsigned sum, cnt, mine, sp = 0u;
    for (;;) {
        sum = 0u; cnt = 0u; mine = 0u;
#pragma unroll
        for (unsigned j = 0; j < 16; ++j) { const unsigned c = xb_ld(&bar[XB_XCNT(j)]); sum += c; cnt += (c > 0u) ? 1u : 0u; mine = (j == x) ? c : mine; }
        if (sum == G) break;
        __builtin_amdgcn_s_sleep(1);
        if ((++sp & 255u) == 0u) { if (xb_ld(&bar[XB_TMO])) break; if (sp > XB_SPIN_CAP) { atomicAdd(&bar[XB_TMO], 1u); break; } }
    }
    nloc = mine > 0u ? mine : 1u; nx = cnt > 0u ? cnt : 1u;
}
__device__ __forceinline__ void xcd_barrier(const XcdBarrier& b) {
    asm volatile("s_waitcnt vmcnt(0)" ::: "memory");
    __syncthreads();
    if (threadIdx.x == 0) {
        unsigned* bar = b.bar; asm volatile("" : "+s"(bar));
        unsigned bx = b.x; asm volatile("" : "+s"(bx));
        __builtin_amdgcn_s_waitcnt(0);
        unsigned nloc = b.st[0], nx = b.st[1];
        if (nloc == 0u) { xcd_barrier_complete(bar, bx, nloc, nx); b.st[0] = nloc; b.st[1] = nx; }
        const unsigned old = xb_add(&bar[XB_XSUB(bx)], 1u);
        const unsigned gen = old / nloc;
        if (old + 1u == (gen + 1u) * nloc) {
            __builtin_amdgcn_fence(__ATOMIC_RELEASE, "agent");
            asm volatile("s_waitcnt vmcnt(0)" ::: "memory");
            const unsigned og = xb_add(&bar[XB_TOP], 1u);
            const unsigned tg = og / nx;
            if (og + 1u == (tg + 1u) * nx) xb_add(&bar[XB_TOPGEN], 1u);
            else XB_SPIN(xb_ld(&bar[XB_TOPGEN]) == tg, bar);
            __builtin_amdgcn_fence(__ATOMIC_ACQUIRE, "agent");
            xb_add(&bar[XB_XGEN(bx)], 1u);
            asm volatile("s_waitcnt vmcnt(0)" ::: "memory");
        } else {
            XB_SPIN(xb_ld(&bar[XB_XGEN(bx)]) == gen, bar);
            __builtin_amdgcn_fence(__ATOMIC_ACQUIRE, "agent");
            asm volatile("s_waitcnt vmcnt(0)" ::: "memory");
        }
    }
    __syncthreads();
}
constexpr int MISC_OFF = 131072 + 320;
constexpr int CW_BAR = 4096;

__global__ void __launch_bounds__(NTHR) mega_fwd(Params p) {
    extern __shared__ __attribute__((aligned(16))) unsigned char lds_raw[];
    float* lds = (float*)lds_raw;
    volatile LAS unsigned* MISC = (volatile LAS unsigned*)((LAS unsigned char*)lds_raw + MISC_OFF);
    if (threadIdx.x < 32) MISC[threadIdx.x] = 0u;
    __syncthreads();
    unsigned char* ws_ = ((const KAS Params*)__builtin_amdgcn_kernarg_segment_ptr())->ws;
    XcdBarrier bar = xcd_barrier_post((unsigned*)(ws_ + WS_CTL) + CW_BAR, MISC + 8);
#define GB() xcd_barrier(bar)
    run_stage<ST_INIT>(0, lds); GB();
    for (int step = 0; step < 2 * 11; ++step) {
        const int l = step / 11, s = step % 11;
        switch (s) {
        case 0: run_stage<ST_PROJ>(l, lds); break;
        case 1: run_stage<ST_PREP>(l, lds); run_stage<ST_GLA1>(l, lds); break;
        case 2: run_stage<ST_SMALLGEMM>(l, lds); run_stage<ST_GLA2>(l, lds); break;
        case 3: run_stage<ST_ATTN>(l, lds); run_stage<ST_GLA3>(l, lds); break;
        case 4: run_stage<ST_MERGE_A>(l, lds); break;
        case 5: run_stage<ST_OUTP>(l, lds); break;
        case 6: run_stage<ST_LN1>(l, lds); break;
        case 7: run_stage<ST_TOPK>(l, lds); break;
        case 8: run_stage<ST_EXP_G>(l, lds); break;
        case 9: run_stage<ST_EXP_D>(l, lds); break;
        default: run_stage<ST_LN2>(l, lds); break;
        }
        if (step + 1 < 2 * 11) GB();
    }
#undef GB
}

template <int ST>
__global__ void __launch_bounds__(NTHR) k_stage(Params p, int l) {
    extern __shared__ __attribute__((aligned(16))) unsigned char lds_raw[];
    run_stage<ST>(l, (float*)lds_raw);
}

template <int ST> static void launch_stage(const Params& p, int l, int grid, hipStream_t stream) {
    static bool attr = false;
    if (!attr) { (void)hipFuncSetAttribute((const void*)k_stage<ST>, hipFuncAttributeMaxDynamicSharedMemorySize, LDS_BYTES); attr = true; }
    hipLaunchKernelGGL(k_stage<ST>, dim3(grid), dim3(NTHR), LDS_BYTES, stream, p, l);
}

extern "C" void kernel_launch(void* const* d_in, const int* in_sizes, int n_in, void* d_out, int out_size, void* d_ws, size_t ws_size, hipStream_t stream) {
    if (n_in != 27 || out_size != T * DM || ws_size < WS_END) {
        fprintf(stderr, "kernel_launch: unexpected shapes: n_in %d out %d ws %zu (need >= %zu)\n", n_in, out_size, ws_size, (size_t)WS_END);
        return;
    }
    Params p{};
    for (int i = 0; i < 27; ++i) p.in[i] = (const float*)d_in[i];
    p.pos = (const int*)d_in[1]; p.out = (float*)d_out; p.ws = (unsigned char*)d_ws;
    const int grid = 256;
#if MEGA
    static bool attr = false;
    if (!attr) { (void)hipFuncSetAttribute((const void*)mega_fwd, hipFuncAttributeMaxDynamicSharedMemorySize, LDS_BYTES); attr = true; }
    (void)hipMemsetAsync((char*)d_ws + WS_CTL, 0, 65536, stream);
    hipLaunchKernelGGL(mega_fwd, dim3(grid), dim3(NTHR), LDS_BYTES, stream, p);
#else
    launch_stage<ST_INIT>(p, 0, grid, stream);
    for (int l = 0; l < 2; ++l) {
        launch_stage<ST_PROJ>(p, l, grid, stream);
        launch_stage<ST_PREP>(p, l, grid, stream);
        launch_stage<ST_SMALLGEMM>(p, l, grid, stream);
        launch_stage<ST_ROPE>(p, l, grid, stream);
        launch_stage<ST_ATTN>(p, l, grid, stream);
        launch_stage<ST_GLAREC>(p, l, grid, stream);
        launch_stage<ST_GLAFIN>(p, l, grid, stream);
        launch_stage<ST_MERGE_A>(p, l, grid, stream);
        launch_stage<ST_MERGE_B>(p, l, grid, stream);
        launch_stage<ST_MERGE_C>(p, l, grid, stream);
        launch_stage<ST_OUTP>(p, l, grid, stream);
        launch_stage<ST_LN1>(p, l, grid, stream);
        launch_stage<ST_TOPK>(p, l, grid, stream);
        launch_stage<ST_EXP_G>(p, l, grid, stream);
        launch_stage<ST_EXP_U>(p, l, grid, stream);
        launch_stage<ST_EXP_D>(p, l, grid, stream);
        launch_stage<ST_LN2>(p, l, grid, stream);
    }
#endif
}
```

```cpp
#include <hip/hip_runtime.h>
#include <cstdio>
#include <cstdint>

#ifndef MEGA
#define MEGA 1
#endif

constexpr int NB = 2, SEQ = 8192, T = NB * SEQ, DM = 1024, DIN = 5824, DINP = 5888;
constexpr int OFF_GATE = 0, OFF_POOL = 3072, OFF_CQ = 3072 + 512, OFF_CKV = 3072 + 896, OFF_KR = 3072 + 1152, OFF_GQ = 3072 + 1184, OFF_GK = 3072 + 1440, OFF_GV = 3072 + 1696, OFF_GR = 3072 + 2208, OFF_GDEC = 3072 + 2720;
constexpr int NE = 16, CAP = 1024, DEXP = 2048, NZ = NB * NE;
constexpr float ALPHA = 1.4142135623730951f;
constexpr float LN_EPS = 1e-5f, RMS_EPS = 1e-6f;
constexpr int NTHR = 512, LDS_BYTES = 147456;

constexpr size_t MiB = 1u << 20;
constexpr size_t WS_CTL = 0;
constexpr size_t WS_ROPE = 1 * MiB;
constexpr size_t WS_AFF = 3 * MiB;
constexpr size_t WS_SLOT = 4 * MiB;
constexpr size_t WS_IDX = 5 * MiB;
constexpr size_t WS_GATEV = 5 * MiB + 256 * 1024;
constexpr size_t WS_WIN_T = 8 * MiB;
constexpr size_t WS_WSMALL = 31 * MiB;
constexpr size_t WSM_UQ = 0, WSM_UKV = 1 * MiB, WSM_MRG = 2 * MiB, WSM_OUT = 5 * MiB, WSM_STRIDE = 7 * MiB;
constexpr size_t WS_RQ = 6 * MiB;
constexpr size_t WS_HB = 958 * MiB;
constexpr size_t WS_WGU_T = 76 * MiB;
constexpr size_t WS_WD_T = 204 * MiB;
constexpr size_t WS_PROJB = 268 * MiB;
constexpr size_t WS_XE = 268 * MiB;
constexpr size_t WS_HID = 332 * MiB;
constexpr size_t WS_YE = 460 * MiB;
constexpr size_t WS_BR = 452 * MiB;
constexpr size_t WS_HB8 = 500 * MiB;
constexpr size_t WS_QB = 556 * MiB;
constexpr size_t WS_KB = 580 * MiB;
constexpr size_t WS_VB = 604 * MiB;
constexpr size_t WS_KVT = 702 * MiB;
constexpr size_t WS_ST = 766 * MiB;
constexpr size_t WS_DEC = 798 * MiB;
constexpr size_t WS_MERGEDB = 830 * MiB;
constexpr size_t WS_TMP = 894 * MiB;
constexpr size_t WS_END = 990 * MiB;
static_assert(WS_YE + 64 * MiB <= WS_QB, "overlay map");

namespace pg8 {
#define PG8_LAS __attribute__((address_space(3)))
typedef unsigned short bf16_t;
typedef short bf16x8 __attribute__((ext_vector_type(8)));
typedef float f32x4 __attribute__((ext_vector_type(4)));
typedef unsigned u32x4 __attribute__((ext_vector_type(4)));
constexpr int BM = 256, BK = 64, HALF = 128, HTB = HALF * BK * 2  , STAGE_BYTES = 8 * HTB, NXCD = 8, WGM = 8;

__host__ __device__ __forceinline__ int lds_byte(int r, int c) { const int st = (r >> 4) * 2 + (c >> 5), rr = r & 15, cc = c & 31, ob = rr * 64 + cc * 2; return st * 1024 + (ob ^ (((ob >> 9) & 1) << 5)); }
__host__ __device__ __forceinline__ void stage_rc(int b, int& R, int& C) { const int st = b / 1024, sb = b % 1024, swz = sb ^ (((sb >> 9) & 1) << 5); R = (st >> 1) * 16 + swz / 64; C = (st & 1) * 32 + (swz % 64) / 2; }
__host__ __device__ __forceinline__ int perm32(int rho) { const int n = rho >> 4, i = rho & 15; return 8 * (i >> 2) + 4 * n + (i & 3); }

struct Unit { int pm, pn; };
struct Gemm { const bf16_t* A; const bf16_t* Bt; int M, N, K, lda; const int* ridx; };

struct StaticOrder {
    int nM, nN, nwg, G, c;
    __host__ __device__ void init(int M, int N, int G_, int c_) { nM = M / BM; nN = N / BM; nwg = nM * nN; G = G_; c = c_; }
    __host__ __device__ bool next(int i, Unit& u) const {
        const long L = (long)i * G + c; if (L >= nwg) return false;
        int wgid = (int)L; { const int q = nwg / NXCD, r = nwg % NXCD, xcd = wgid % NXCD, off = wgid / NXCD; wgid = (xcd < r ? xcd * (q + 1) : r * (q + 1) + (xcd - r) * q) + off; }
        const int nig = WGM * nN, gid = wgid / nig, fm = gid * WGM, gsz = (nM - fm) < WGM ? (nM - fm) : WGM;
        u.pm = fm + ((wgid % nig) % gsz); u.pn = (wgid % nig) / gsz; return true;
    }
    __device__ __forceinline__ void a_ready(const Unit&) const {}
    __device__ __forceinline__ void done(const Unit&) const {}
};

__device__ __forceinline__ unsigned cvt_pk_bf16(float lo, float hi) { unsigned r; asm volatile("v_cvt_pk_bf16_f32 %0, %1, %2" : "=v"(r) : "v"(lo), "v"(hi)); return r; }
typedef float f32x2 __attribute__((ext_vector_type(2)));
__device__ __forceinline__ f32x2 gelu_pk(f32x2 v) {
    const f32x2 av = __builtin_elementwise_abs(v), d = av * 0.2316418882f + 1.0f;
    f32x2 t; t.x = __builtin_amdgcn_rcpf(d.x); t.y = __builtin_amdgcn_rcpf(d.y);
    f32x2 q = t * 0.5307027145f + (-0.7265760135f); q = q * t + 0.7107068705f; q = q * t + (-0.142248368f); q = q * t + 0.127414796f; q = q * t;
    const f32x2 s = (v * v) * (-0.72134752044f);
    f32x2 e; e.x = __builtin_amdgcn_exp2f(s.x); e.y = __builtin_amdgcn_exp2f(s.y);
    const f32x2 m = v * (q * e), r = v - m;
    f32x2 o; o.x = v.x < 0.f ? m.x : r.x; o.y = v.y < 0.f ? m.y : r.y; return o;
}

template <int ACT  > struct EpiBf16 {
    static constexpr bool PERM = true, AFTER_DRAIN = false; static constexpr int SEG = 0; static_assert(ACT == 0 || ACT == 1, "EpiBf16: ACT is 0 (none) or 1 (gelu_pk)");
    bf16_t* O; int ldc; const float* bias; int split_cols; size_t split_stride; float scale0;
    __device__ __forceinline__ void operator()(const f32x4 (&acc)[2][2][4][2], const Unit& u, int wr, int wc, int fr, int fq) const {
        const int row0 = u.pm * BM + wr * 64 + fr; int colt = u.pn * BM; bf16_t* base = O;
        float sc = 1.f; if (split_cols) { const int t = colt / split_cols; base += (size_t)t * split_stride; colt -= t * split_cols; if (t == 0) sc = scale0; }
        const int col0 = colt + wc * 32 + 8 * fq, bcol0 = u.pn * BM + wc * 32 + 8 * fq;
        f32x4 bv[2][2];
#pragma unroll
        for (int bj = 0; bj < 2; ++bj)
#pragma unroll
            for (int n = 0; n < 2; ++n) bv[bj][n] = bias ? *(const f32x4*)(bias + bcol0 + bj * HALF + 4 * n) : (f32x4){0.f, 0.f, 0.f, 0.f};
#pragma unroll
        for (int ai = 0; ai < 2; ++ai)
#pragma unroll
            for (int m = 0; m < 4; ++m) { bf16_t* rowp = base + (size_t)(row0 + ai * HALF + m * 16) * ldc + col0;
#pragma unroll
                for (int bj = 0; bj < 2; ++bj) { f32x4 v0 = acc[ai][bj][m][0] + bv[bj][0], v1 = acc[ai][bj][m][1] + bv[bj][1];
                    if (ACT == 1) { f32x2 a = gelu_pk((f32x2){v0[0], v0[1]}), b = gelu_pk((f32x2){v0[2], v0[3]}), c = gelu_pk((f32x2){v1[0], v1[1]}), d = gelu_pk((f32x2){v1[2], v1[3]});
                        v0 = (f32x4){a.x, a.y, b.x, b.y}; v1 = (f32x4){c.x, c.y, d.x, d.y}; }
                    v0 = v0 * sc; v1 = v1 * sc; u32x4 w; w.x = cvt_pk_bf16(v0[0], v0[1]); w.y = cvt_pk_bf16(v0[2], v0[3]); w.z = cvt_pk_bf16(v1[0], v1[1]); w.w = cvt_pk_bf16(v1[2], v1[3]);
                    *(u32x4*)(rowp + bj * HALF) = w; } }
    }
};

struct PanelStats {
    unsigned* xbuf;
    unsigned* cnt;
    unsigned* tmo;
    int ntn; float eps;
    unsigned code;
    __device__ __forceinline__ bool run(const f32x4 (&v)[2][2][4][2], const Unit& u, int wr, int wc, int fr, int fq, PG8_LAS unsigned char* lds, int wid, int lane) const {
        typedef float f32x2v __attribute__((ext_vector_type(2)));
        PG8_LAS f32x2v* P = (PG8_LAS f32x2v*)lds;
        PG8_LAS f32x2v* S = (PG8_LAS f32x2v*)(lds + 8192);
        PG8_LAS unsigned* flag = (PG8_LAS unsigned*)(lds + 8192 + 2048);
#pragma unroll
        for (int ai = 0; ai < 2; ++ai)
#pragma unroll
            for (int m = 0; m < 4; ++m) {
                float s = 0.f;
#pragma unroll
                for (int bj = 0; bj < 2; ++bj)
#pragma unroll
                    for (int n = 0; n < 2; ++n) { const f32x4 x = v[ai][bj][m][n]; s += (x[0] + x[1]) + (x[2] + x[3]); }
                s += __shfl_xor(s, 16); s += __shfl_xor(s, 32);
                const float mw = s * (1.0f / 64.0f); float q = 0.f;
#pragma unroll
                for (int bj = 0; bj < 2; ++bj)
#pragma unroll
                    for (int n = 0; n < 2; ++n) { const f32x4 d = v[ai][bj][m][n] - mw; q += (d[0] * d[0] + d[1] * d[1]) + (d[2] * d[2] + d[3] * d[3]); }
                q += __shfl_xor(q, 16); q += __shfl_xor(q, 32);
                if (fq == 0) P[(ai * HALF + wr * 64 + m * 16 + fr) * 4 + wc] = (f32x2v){mw, q};
            }
        asm volatile("s_waitcnt lgkmcnt(0)" ::: "memory"); __builtin_amdgcn_s_barrier(); asm volatile("" ::: "memory");
#if defined(BROKEN_EXCHANGE_NO_WAIT)
#warning BROKEN CONTROL BUILD: the row-statistics exchange does not wait; results are wrong by design
        if (blockIdx.x >= 64) { const long long t0_ = clock64(); while (clock64() - t0_ < 60000) __builtin_amdgcn_s_sleep(8); }
#endif
        const int row = wid * 32 + (lane & 31);
        if (lane < 32) {
            const f32x2v a = P[row * 4 + 0], b = P[row * 4 + 1], c = P[row * 4 + 2], d = P[row * 4 + 3];
            const float mt = (a.x + b.x + c.x + d.x) * 0.25f;
            const float da = a.x - mt, db = b.x - mt, dc = c.x - mt, dd = d.x - mt;
            const float m2 = (a.y + b.y) + (c.y + d.y) + 64.0f * ((da * da + db * db) + (dc * dc + dd * dd));
            unsigned long long* slot = (unsigned long long*)xbuf + ((size_t)(u.pm * BM + row) * 4 + u.pn);
            __hip_atomic_store(slot, ((unsigned long long)__float_as_uint(m2) << 32) | __float_as_uint(mt), __ATOMIC_RELAXED, __HIP_MEMORY_SCOPE_AGENT);
        }
        asm volatile("s_waitcnt vmcnt(0)" ::: "memory");
        if (lane == 0) __hip_atomic_fetch_add(cnt + 64 * u.pm, 1u, __ATOMIC_RELAXED, __HIP_MEMORY_SCOPE_AGENT);
        if (wid == 0) {
            bool dead = false; const unsigned long long t0 = __builtin_amdgcn_s_memrealtime(); const unsigned want = 8u * (unsigned)ntn;
            for (;;) {
#if defined(BROKEN_EXCHANGE_NO_WAIT)
                break;
#endif
                if ((unsigned)__builtin_amdgcn_readfirstlane(__hip_atomic_load(cnt + 64 * u.pm, __ATOMIC_RELAXED, __HIP_MEMORY_SCOPE_AGENT)) >= want) break;
                if (__builtin_amdgcn_s_memrealtime() - t0 > 2000000ull) {
                    if (lane == 0) { unsigned expect = 0u; __hip_atomic_compare_exchange_strong(tmo + 1, &expect, code | (unsigned)(u.pm & 0xff), __ATOMIC_RELAXED, __ATOMIC_RELAXED, __HIP_MEMORY_SCOPE_AGENT);
                                     __hip_atomic_store(tmo, 1u, __ATOMIC_RELAXED, __HIP_MEMORY_SCOPE_AGENT); }
                    dead = true; break; }
                __builtin_amdgcn_s_sleep(2);
            }
            __builtin_amdgcn_fence(__ATOMIC_ACQUIRE, "agent");
            if (lane == 0) flag[0] = dead ? 1u : 0u;
        }
        asm volatile("s_waitcnt vmcnt(0) lgkmcnt(0)" ::: "memory"); __builtin_amdgcn_s_barrier(); asm volatile("" ::: "memory");
        const bool bad = flag[0] != 0u;
        if (lane < 32) {
            const unsigned long long* slot = (const unsigned long long*)xbuf + (size_t)(u.pm * BM + row) * 4; float mt[4], m2[4]; float ms = 0.f;
#pragma unroll
            for (int t = 0; t < 4; ++t) { if (t < ntn) { const unsigned long long w = __hip_atomic_load(slot + t, __ATOMIC_RELAXED, __HIP_MEMORY_SCOPE_AGENT); mt[t] = __uint_as_float((unsigned)w); m2[t] = __uint_as_float((unsigned)(w >> 32)); } else { mt[t] = 0.f; m2[t] = 0.f; } ms += mt[t]; }
            const float mean = ms / (float)ntn; float q = 0.f;
#pragma unroll
            for (int t = 0; t < 4; ++t) if (t < ntn) { const float dm = mt[t] - mean; q += m2[t] + 256.0f * dm * dm; }
            S[row] = (f32x2v){mean, 1.0f / sqrtf(q / (256.0f * (float)ntn) + eps)};
        }
        asm volatile("s_waitcnt lgkmcnt(0)" ::: "memory"); __builtin_amdgcn_s_barrier(); asm volatile("" ::: "memory");
        return bad;
    }
};
struct EpiLnRes {
    static constexpr bool PERM = false, AFTER_DRAIN = true; static constexpr int SEG = 0;
    const float* base; float* out; int ldc; const float* bias; PanelStats st; unsigned poison;
    __device__ __forceinline__ void fused(f32x4 (&acc)[2][2][4][2], const Unit& u, int wr, int wc, int fr, int fq, PG8_LAS unsigned char* lds, int wid, int lane) const {
        typedef float f32x2v __attribute__((ext_vector_type(2)));
        const PG8_LAS f32x2v* S = (const PG8_LAS f32x2v*)(lds + 8192);
        const int col0 = u.pn * BM + wc * 32 + 4 * fq;
#pragma unroll
        for (int bj = 0; bj < 2; ++bj)
#pragma unroll
            for (int n = 0; n < 2; ++n) { const f32x4 bv = bias ? *(const f32x4*)(bias + col0 + bj * HALF + n * 16) : (f32x4){0.f, 0.f, 0.f, 0.f};
#pragma unroll
                for (int ai = 0; ai < 2; ++ai)
#pragma unroll
                    for (int m = 0; m < 4; ++m) acc[ai][bj][m][n] += bv; }
        f32x4 pre[4][2][2];
#pragma unroll
        for (int m = 0; m < 4; ++m) { const size_t off = (size_t)(u.pm * BM + wr * 64 + m * 16 + fr) * ldc + col0;
#pragma unroll
            for (int bj = 0; bj < 2; ++bj)
#pragma unroll
                for (int n = 0; n < 2; ++n) pre[m][bj][n] = *(const f32x4*)(base + off + bj * HALF + n * 16); }
        const bool bad = st.run(acc, u, wr, wc, fr, fq, lds, wid, lane) || poison != 0u;
        const float qnan = __builtin_nanf("");
#pragma unroll
        for (int ai = 0; ai < 2; ++ai)
#pragma unroll
            for (int m = 0; m < 4; ++m) { const int r = ai * HALF + wr * 64 + m * 16 + fr; const f32x2v sr = S[r]; const size_t off = (size_t)(u.pm * BM + r) * ldc + col0;
#pragma unroll
                for (int bj = 0; bj < 2; ++bj)
#pragma unroll
                    for (int n = 0; n < 2; ++n) { const f32x4 bs = ai == 0 ? pre[m][bj][n] : *(const f32x4*)(base + off + bj * HALF + n * 16); f32x4 o = bs + (acc[ai][bj][m][n] - sr.x) * sr.y;
                        if (bad) o = (f32x4){qnan, qnan, qnan, qnan}; *(f32x4*)(out + off + bj * HALF + n * 16) = o; }
                if (m & 1) asm volatile("" ::: "memory"); }
    }
};
struct EpiLnResLn {
    static constexpr bool PERM = false, AFTER_DRAIN = true; static constexpr int SEG = 0;
    const float* base; float* out; bf16_t* xn; int ldc; const float* bias; PanelStats st1, st2; unsigned poison;
    __device__ __forceinline__ void fused(f32x4 (&acc)[2][2][4][2], const Unit& u, int wr, int wc, int fr, int fq, PG8_LAS unsigned char* lds, int wid, int lane) const {
        typedef float f32x2v __attribute__((ext_vector_type(2))); typedef unsigned u32x2v __attribute__((ext_vector_type(2)));
        const PG8_LAS f32x2v* S = (const PG8_LAS f32x2v*)(lds + 8192);
        const int col0 = u.pn * BM + wc * 32 + 4 * fq;
#pragma unroll
        for (int bj = 0; bj < 2; ++bj)
#pragma unroll
            for (int n = 0; n < 2; ++n) { const f32x4 bv = bias ? *(const f32x4*)(bias + col0 + bj * HALF + n * 16) : (f32x4){0.f, 0.f, 0.f, 0.f};
#pragma unroll
                for (int ai = 0; ai < 2; ++ai)
#pragma unroll
                    for (int m = 0; m < 4; ++m) acc[ai][bj][m][n] += bv; }
        bool bad = st1.run(acc, u, wr, wc, fr, fq, lds, wid, lane) || poison != 0u;
        const float qnan = __builtin_nanf("");
#pragma unroll
        for (int ai = 0; ai < 2; ++ai)
#pragma unroll
            for (int m = 0; m < 4; ++m) { const int r = ai * HALF + wr * 64 + m * 16 + fr; const f32x2v sr = S[r]; const size_t off = (size_t)(u.pm * BM + r) * ldc + col0;
#pragma unroll
                for (int bj = 0; bj < 2; ++bj)
#pragma unroll
                    for (int n = 0; n < 2; ++n) { const f32x4 bs = *(const f32x4*)(base + off + bj * HALF + n * 16); acc[ai][bj][m][n] = bs + (acc[ai][bj][m][n] - sr.x) * sr.y; }
                asm volatile("" : "+v"(acc[ai][0][m][0]), "+v"(acc[ai][0][m][1]), "+v"(acc[ai][1][m][0]), "+v"(acc[ai][1][m][1]));
                if (m & 1) asm volatile("" ::: "memory"); }
        const bool bad1 = bad;
        bad = st2.run(acc, u, wr, wc, fr, fq, lds, wid, lane) || bad;
#pragma unroll
        for (int ai = 0; ai < 2; ++ai)
#pragma unroll
            for (int m = 0; m < 4; ++m) { const int r = ai * HALF + wr * 64 + m * 16 + fr; const f32x2v sr = S[r]; const size_t off = (size_t)(u.pm * BM + r) * ldc + col0;
#pragma unroll
                for (int bj = 0; bj < 2; ++bj)
#pragma unroll
                    for (int n = 0; n < 2; ++n) { const f32x4 x1 = acc[ai][bj][m][n]; *(f32x4*)(out + off + bj * HALF + n * 16) = bad1 ? (f32x4){qnan, qnan, qnan, qnan} : x1;
                        const f32x4 o = (x1 - sr.x) * sr.y; u32x2v w; w.x = cvt_pk_bf16(o[0], o[1]); w.y = cvt_pk_bf16(o[2], o[3]);
                        if (bad) { w.x = 0x7fc07fc0u; w.y = 0x7fc07fc0u; } *(u32x2v*)(xn + off + bj * HALF + n * 16) = w; }
                asm volatile("" ::: "memory"); }
    }
};

template <class Epi, class Sched, bool ALIGN_EPI = false, bool SP2 = false, bool GATHER = false, bool FP8 = false>
__device__ __forceinline__ void gemm_phase(PG8_LAS unsigned char* lds, const Gemm g, const Sched& S, const Epi& E) {
    int tid_ = threadIdx.x; asm volatile("" : "+v"(tid_));
    const int tid = tid_, wid = __builtin_amdgcn_readfirstlane(tid >> 6), lane = tid & 63, wr = wid >> 2, wc = wid & 3, fr = lane & 15, fq = lane >> 4;
    int K_ = g.K; asm volatile("" : "+s"(K_));
    const int K = K_, nt = K / BK;
    unsigned voffA[2], voffB[2];
#pragma unroll
    for (int i = 0; i < 2; ++i) { int R, C; stage_rc(tid * 16 + i * 8192, R, C); const int Rb = Epi::PERM ? ((R & ~31) + perm32(R & 31)) : R;
        voffA[i] = (unsigned)(R * g.lda + C) * 2u; voffB[i] = (unsigned)(Rb * K + C) * 2u; }
    const size_t kstep = (size_t)(BK * 2);
    static_assert(!GATHER || SP2, "GATHER is implemented for the SP2 loop");
    const size_t hstepB = (size_t)HALF * K * 2, hstepA = GATHER ? 0 : (size_t)HALF * g.lda * 2;
    const size_t tstepB = 2 * hstepB, tstepA = GATHER ? 0 : 2 * hstepA;
    const unsigned ldsw = (unsigned)wid * 1024u;
    const int aoffk[2] = {lds_byte(wr * 64 + fr, FP8 ? 16 * fq : 8 * fq), lds_byte(wr * 64 + fr, FP8 ? 16 * fq + 8 : 8 * fq + 32)};
    const int boffk[2] = {lds_byte(wc * 32 + fr, FP8 ? 16 * fq : 8 * fq), lds_byte(wc * 32 + fr, FP8 ? 16 * fq + 8 : 8 * fq + 32)};
#define PG8_SA(b, h) (((b) * 2 + (h)) * HTB)
#define PG8_SB(b, h) ((4 + (b) * 2 + (h)) * HTB)
#define PG8_STAGE(bufoff, gbase, voff) do { _Pragma("unroll") for (int _i = 0; _i < 2; ++_i) \
        __builtin_amdgcn_global_load_lds((const unsigned*)((const char*)(gbase) + (voff)[_i]), (PG8_LAS unsigned*)(lds + (bufoff) + ldsw + _i * 8192), 16, 0, 0); } while (0)
    typedef int i32x4_ __attribute__((ext_vector_type(4))); typedef int i32x8_ __attribute__((ext_vector_type(8)));
#define PG8_LD16(off) (*(const PG8_LAS i32x4_*)(lds + (off)))
#define PG8_LDA(dst, b, h) do { _Pragma("unroll") for (int m = 0; m < 4; ++m) { \
        if constexpr (FP8) dst##8[m] = *(const PG8_LAS i32x8_*)(lds + PG8_SA(b, h) + aoffk[0] + m * 2048);     \
        else { _Pragma("unroll") for (int k = 0; k < 2; ++k) dst[m][k] = *(const PG8_LAS bf16x8*)(lds + PG8_SA(b, h) + aoffk[k] + m * 2048); } } } while (0)
#define PG8_LDB(dst, b, h) do { _Pragma("unroll") for (int n = 0; n < 2; ++n) { \
        if constexpr (FP8) dst##8[n] = *(const PG8_LAS i32x8_*)(lds + PG8_SB(b, h) + boffk[0] + n * 2048); \
        else { _Pragma("unroll") for (int k = 0; k < 2; ++k) dst[n][k] = *(const PG8_LAS bf16x8*)(lds + PG8_SB(b, h) + boffk[k] + n * 2048); } } } while (0)
#define PG8_MMA(ai, bj, At, Bt) do { __builtin_amdgcn_s_setprio(1); _Pragma("unroll") for (int m = 0; m < 4; ++m) _Pragma("unroll") for (int n = 0; n < 2; ++n) { \
        if constexpr (FP8) asm volatile("s_nop 1\n\tv_mfma_scale_f32_16x16x128_f8f6f4 %0, %1, %2, %0, %3, %3 op_sel_hi:[0,0,0]" : "+v"(acc[ai][bj][m][n]) : "v"(Bt##8[n]), "v"(At##8[m]), "v"(sc1_));     \
        else { _Pragma("unroll") for (int k = 0; k < 2; ++k) acc[ai][bj][m][n] = __builtin_amdgcn_mfma_f32_16x16x32_bf16(Bt[n][k], At[m][k], acc[ai][bj][m][n], 0, 0, 0); } } \
        __builtin_amdgcn_s_setprio(0); } while (0)
#define PG8_WAIT_V(n) asm volatile("s_waitcnt vmcnt(" #n ")" ::: "memory")
#define PG8_WAIT_L(n) asm volatile("s_waitcnt lgkmcnt(" #n ")" ::: "memory")
#define PG8_BAR __builtin_amdgcn_s_barrier()
#define PG8_SCHED __builtin_amdgcn_sched_barrier(0)
    Unit cur, nxt; int ui = 0;
    if (!S.next(0, cur)) return;
    unsigned vC0[2] = {voffA[0], voffA[1]}, vC1[2] = {voffA[0], voffA[1]}, vN0[2] = {voffA[0], voffA[1]}, vN1[2] = {voffA[0], voffA[1]};
    int gR[2], gC[2];
#pragma unroll
    for (int i = 0; i < 2; ++i) { stage_rc(tid * 16 + i * 8192, gR[i], gC[i]); }
    if constexpr (GATHER) {
#pragma unroll
        for (int i = 0; i < 2; ++i) { vC0[i] = (unsigned)(g.ridx[cur.pm * 256 + gR[i]] * g.lda + gC[i]) * 2u; vC1[i] = (unsigned)(g.ridx[cur.pm * 256 + 128 + gR[i]] * g.lda + gC[i]) * 2u; }
    }
    f32x4 acc[2][2][4][2];
#pragma unroll
    for (int a = 0; a < 2; ++a)
#pragma unroll
        for (int b = 0; b < 2; ++b)
#pragma unroll
            for (int m = 0; m < 4; ++m)
#pragma unroll
                for (int n = 0; n < 2; ++n) acc[a][b][m][n] = (f32x4){0.f, 0.f, 0.f, 0.f};
    const int sc1_ = 0x7f7f7f7f;
    bf16x8 At[4][2], B0[2][2], B1[2][2]; i32x8_ At8[4], B08[2], B18[2];
    const char* cA = (const char*)g.A + (size_t)cur.pm * tstepA; const char* cB = (const char*)g.Bt + (size_t)cur.pn * tstepB;
    S.a_ready(cur);
    if constexpr (SP2) {
        PG8_STAGE(PG8_SB(0, 0), cB, voffB); PG8_STAGE(PG8_SB(0, 1), cB + hstepB, voffB); PG8_STAGE(PG8_SA(0, 0), cA, vC0); PG8_STAGE(PG8_SA(0, 1), cA + hstepA, vC1);
        if (wr == 1) PG8_BAR;
        PG8_WAIT_V(2); PG8_BAR;
        PG8_STAGE(PG8_SB(1, 0), cB + kstep, voffB); PG8_STAGE(PG8_SA(1, 0), cA + kstep, vC0); PG8_STAGE(PG8_SB(1, 1), cB + hstepB + kstep, voffB);
        PG8_WAIT_V(6); PG8_BAR;
    } else {
        PG8_STAGE(PG8_SB(0, 0), cB, voffB); PG8_STAGE(PG8_SA(0, 0), cA, voffA); PG8_STAGE(PG8_SB(0, 1), cB + hstepB, voffB); PG8_STAGE(PG8_SA(0, 1), cA + hstepA, voffA);
        if (wr == 1) PG8_BAR;
        PG8_WAIT_V(4); PG8_BAR;
        PG8_STAGE(PG8_SB(1, 0), cB + kstep, voffB); PG8_STAGE(PG8_SA(1, 0), cA + kstep, voffA); PG8_STAGE(PG8_SB(1, 1), cB + hstepB + kstep, voffB);
        PG8_WAIT_V(6); PG8_BAR;
    }
    for (;;) {
        const bool has_next = S.next(ui + 1, nxt);
        int gi0[2] = {0, 0}, gi1[2] = {0, 0};
        if constexpr (GATHER) { if (has_next) {
#pragma unroll
            for (int i = 0; i < 2; ++i) { gi0[i] = g.ridx[nxt.pm * 256 + gR[i]]; gi1[i] = g.ridx[nxt.pm * 256 + 128 + gR[i]]; } } }
        const char* nA = has_next ? (const char*)g.A + (size_t)nxt.pm * tstepA : cA; const char* nB = has_next ? (const char*)g.Bt + (size_t)nxt.pn * tstepB : cB;
        for (int t = 0; t < nt; t += 2) {
            const bool last = (t == nt - 2);
            const char* a1 = cA + (size_t)(t + 1) * kstep;
            const char* a2 = last ? nA : cA + (size_t)(t + 2) * kstep; const char* b2 = last ? nB : cB + (size_t)(t + 2) * kstep;
            const char* a3 = a2 + kstep; const char* b3 = b2 + kstep;
            if (last && has_next) S.a_ready(nxt);
            unsigned v20[2] = {vC0[0], vC0[1]}, v21[2] = {vC1[0], vC1[1]};
            if constexpr (GATHER) { if (last && has_next) {
#pragma unroll
                for (int i = 0; i < 2; ++i) { vN0[i] = (unsigned)(gi0[i] * g.lda + gC[i]) * 2u; vN1[i] = (unsigned)(gi1[i] * g.lda + gC[i]) * 2u; v20[i] = vN0[i]; v21[i] = vN1[i]; } } }
            if constexpr (SP2) {
            PG8_LDB(B0, 0, 0); PG8_LDB(B1, 0, 1); PG8_SCHED; PG8_LDA(At, 0, 0); PG8_STAGE(PG8_SA(1, 1), a1 + hstepA, vC1);
            PG8_WAIT_V(8); PG8_WAIT_L(0); PG8_BAR; PG8_MMA(0, 0, At, B0); PG8_MMA(0, 1, At, B1); PG8_BAR; PG8_SCHED;
            PG8_LDA(At, 0, 1); PG8_STAGE(PG8_SB(0, 0), b2, voffB); PG8_STAGE(PG8_SB(0, 1), b2 + hstepB, voffB); PG8_STAGE(PG8_SA(0, 0), a2, v20);
            PG8_WAIT_V(8); PG8_WAIT_L(0); PG8_BAR; PG8_MMA(1, 0, At, B0); PG8_MMA(1, 1, At, B1); PG8_BAR; PG8_SCHED;
            PG8_LDB(B0, 1, 0); PG8_LDB(B1, 1, 1); PG8_SCHED; PG8_LDA(At, 1, 0); PG8_STAGE(PG8_SA(0, 1), a2 + hstepA, v21);
            PG8_WAIT_V(8); PG8_WAIT_L(0); PG8_BAR; PG8_MMA(0, 0, At, B0); PG8_MMA(0, 1, At, B1); PG8_BAR; PG8_SCHED;
            PG8_LDA(At, 1, 1); PG8_STAGE(PG8_SB(1, 0), b3, voffB); PG8_STAGE(PG8_SB(1, 1), b3 + hstepB, voffB); PG8_STAGE(PG8_SA(1, 0), a3, v20);
            PG8_WAIT_V(8); PG8_WAIT_L(0); PG8_BAR; PG8_MMA(1, 0, At, B0); PG8_MMA(1, 1, At, B1); PG8_BAR; PG8_SCHED;
            if constexpr (Epi::SEG > 0) { if ((t + 2) % Epi::SEG == 0 && t + 2 < nt) E.segment(acc, cur, (t + 2) / Epi::SEG, wr, wc, fr, fq); }
            } else {
            PG8_LDB(B0, 0, 0); PG8_SCHED; PG8_LDA(At, 0, 0); PG8_STAGE(PG8_SA(1, 1), a1 + hstepA, voffA);
            PG8_WAIT_L(8); PG8_BAR; PG8_WAIT_L(0); PG8_MMA(0, 0, At, B0); PG8_BAR; PG8_SCHED;
            PG8_LDB(B1, 0, 1); PG8_STAGE(PG8_SB(0, 0), b2, voffB);
            PG8_BAR; PG8_WAIT_L(0); PG8_MMA(0, 1, At, B1); PG8_BAR;
            PG8_LDA(At, 0, 1); PG8_STAGE(PG8_SA(0, 0), a2, voffA);
            PG8_BAR; PG8_WAIT_L(0); PG8_MMA(1, 0, At, B0); PG8_BAR; PG8_SCHED;
            PG8_STAGE(PG8_SB(0, 1), b2 + hstepB, voffB);
            PG8_WAIT_V(6); PG8_BAR; PG8_MMA(1, 1, At, B1); PG8_BAR;
            PG8_LDB(B0, 1, 0); PG8_SCHED; PG8_LDA(At, 1, 0); PG8_STAGE(PG8_SA(0, 1), a2 + hstepA, voffA);
            PG8_WAIT_L(8); PG8_BAR; PG8_WAIT_L(0); PG8_MMA(0, 0, At, B0); PG8_BAR; PG8_SCHED;
            PG8_LDB(B1, 1, 1); PG8_STAGE(PG8_SB(1, 0), b3, voffB);
            PG8_BAR; PG8_WAIT_L(0); PG8_MMA(0, 1, At, B1); PG8_BAR;
            PG8_LDA(At, 1, 1); PG8_STAGE(PG8_SA(1, 0), a3, voffA);
            PG8_BAR; PG8_WAIT_L(0); PG8_MMA(1, 0, At, B0); PG8_BAR; PG8_SCHED;
            PG8_STAGE(PG8_SB(1, 1), b3 + hstepB, voffB);
            PG8_WAIT_V(6); PG8_BAR; PG8_MMA(1, 1, At, B1); PG8_BAR;
            }
        }
        if constexpr (FP8) asm volatile("s_nop 15\n\ts_nop 3" ::: "memory");
        if constexpr (ALIGN_EPI) { if (wr == 0) PG8_BAR; }
        if constexpr (!Epi::AFTER_DRAIN) { E(acc, cur, wr, wc, fr, fq); S.done(cur); }
        if (!has_next) break;
#pragma unroll
        for (int a = 0; a < 2; ++a)
#pragma unroll
            for (int b = 0; b < 2; ++b)
#pragma unroll
                for (int m = 0; m < 4; ++m)
#pragma unroll
                    for (int n = 0; n < 2; ++n) acc[a][b][m][n] = (f32x4){0.f, 0.f, 0.f, 0.f};
        cur = nxt; cA = nA; cB = nB; ++ui;
        if constexpr (GATHER) { vC0[0] = vN0[0]; vC0[1] = vN0[1]; vC1[0] = vN1[0]; vC1[1] = vN1[1]; }
        if constexpr (ALIGN_EPI) { if (wr == 1) PG8_BAR; }
    }
    PG8_WAIT_V(0);
    if constexpr (!ALIGN_EPI) { if (wr == 0) PG8_BAR; }
    PG8_BAR;
    if constexpr (Epi::AFTER_DRAIN) { E.fused(acc, cur, wr, wc, fr, fq, lds, wid, lane); S.done(cur); }
#undef PG8_SA
#undef PG8_SB
#undef PG8_STAGE
#undef PG8_LDA
#undef PG8_LD16
#undef PG8_LDB
#undef PG8_MMA
#undef PG8_WAIT_V
#undef PG8_WAIT_L
#undef PG8_BAR
#undef PG8_SCHED
}
}

typedef unsigned short bf16_t;
__device__ __forceinline__ unsigned pk4_fp8(float a, float b, float c, float d) { unsigned w = 0u; w = __builtin_amdgcn_cvt_pk_fp8_f32(a, b, w, false); w = __builtin_amdgcn_cvt_pk_fp8_f32(c, d, w, true); return w; }
constexpr float F8_WGU = 64.f, F8_WD = 128.f, F8_HID = 4.f;
typedef unsigned u32x4_t __attribute__((ext_vector_type(4)));
__device__ __forceinline__ void ldg8_dw(float (&o)[8], const void* base, const unsigned (&off)[8]) {
    asm volatile("global_load_dword %0, %9, %8\n\tglobal_load_dword %1, %10, %8\n\tglobal_load_dword %2, %11, %8\n\tglobal_load_dword %3, %12, %8\n\t"
                 "global_load_dword %4, %13, %8\n\tglobal_load_dword %5, %14, %8\n\tglobal_load_dword %6, %15, %8\n\tglobal_load_dword %7, %16, %8\n\ts_waitcnt vmcnt(0)"
                 : "=&v"(o[0]), "=&v"(o[1]), "=&v"(o[2]), "=&v"(o[3]), "=&v"(o[4]), "=&v"(o[5]), "=&v"(o[6]), "=&v"(o[7])
                 : "s"(base), "v"(off[0]), "v"(off[1]), "v"(off[2]), "v"(off[3]), "v"(off[4]), "v"(off[5]), "v"(off[6]), "v"(off[7]) : "memory");
}
template <int I1, int I2, int I3>
__device__ __forceinline__ void ldg8_x4(u32x4_t (&a)[4], u32x4_t (&b)[4], const void* base, unsigned offA, unsigned offB) {
    asm volatile("global_load_dwordx4 %0, %9, %8\n\tglobal_load_dwordx4 %1, %9, %8 offset:%11\n\tglobal_load_dwordx4 %2, %9, %8 offset:%12\n\tglobal_load_dwordx4 %3, %9, %8 offset:%13\n\t"
                 "global_load_dwordx4 %4, %10, %8\n\tglobal_load_dwordx4 %5, %10, %8 offset:%11\n\tglobal_load_dwordx4 %6, %10, %8 offset:%12\n\tglobal_load_dwordx4 %7, %10, %8 offset:%13\n\ts_waitcnt vmcnt(0)"
                 : "=&v"(a[0]), "=&v"(a[1]), "=&v"(a[2]), "=&v"(a[3]), "=&v"(b[0]), "=&v"(b[1]), "=&v"(b[2]), "=&v"(b[3])
                 : "s"(base), "v"(offA), "v"(offB), "i"(I1), "i"(I2), "i"(I3) : "memory");
}
__device__ __forceinline__ void ldg8_x4v(u32x4_t (&o)[8], const void* base, const unsigned (&off)[8]) {
    asm volatile("global_load_dwordx4 %0, %9, %8\n\tglobal_load_dwordx4 %1, %10, %8\n\tglobal_load_dwordx4 %2, %11, %8\n\tglobal_load_dwordx4 %3, %12, %8\n\t"
                 "global_load_dwordx4 %4, %13, %8\n\tglobal_load_dwordx4 %5, %14, %8\n\tglobal_load_dwordx4 %6, %15, %8\n\tglobal_load_dwordx4 %7, %16, %8\n\ts_waitcnt vmcnt(0)"
                 : "=&v"(o[0]), "=&v"(o[1]), "=&v"(o[2]), "=&v"(o[3]), "=&v"(o[4]), "=&v"(o[5]), "=&v"(o[6]), "=&v"(o[7])
                 : "s"(base), "v"(off[0]), "v"(off[1]), "v"(off[2]), "v"(off[3]), "v"(off[4]), "v"(off[5]), "v"(off[6]), "v"(off[7]) : "memory");
}
template <int I1, int I2, int I3>
__device__ __forceinline__ void ldg4_x4(u32x4_t (&a)[4], const void* base, unsigned off) {
    asm volatile("global_load_dwordx4 %0, %5, %4\n\tglobal_load_dwordx4 %1, %5, %4 offset:%6\n\tglobal_load_dwordx4 %2, %5, %4 offset:%7\n\tglobal_load_dwordx4 %3, %5, %4 offset:%8\n\ts_waitcnt vmcnt(0)"
                 : "=&v"(a[0]), "=&v"(a[1]), "=&v"(a[2]), "=&v"(a[3]) : "s"(base), "v"(off), "i"(I1), "i"(I2), "i"(I3) : "memory");
}
__device__ __forceinline__ void bf8_to_f32(const u32x4_t w, float* o) {
    o[0] = __uint_as_float(w.x << 16); o[1] = __uint_as_float(w.x & 0xffff0000u); o[2] = __uint_as_float(w.y << 16); o[3] = __uint_as_float(w.y & 0xffff0000u);
    o[4] = __uint_as_float(w.z << 16); o[5] = __uint_as_float(w.z & 0xffff0000u); o[6] = __uint_as_float(w.w << 16); o[7] = __uint_as_float(w.w & 0xffff0000u);
}
struct ExpertOrder1 {
    int G, v;
    __device__ void init(int G_, int c) { G = G_; v = (G_ % 8 == 0) ? (c % 8) * (G_ / 8) + c / 8 : c; }
    __device__ bool next(int i, pg8::Unit& u) const { const int L = i * G + v; if (L >= 2048) return false; const int e = L >> 7, r = L & 127; u.pm = e * 8 + (r & 7); u.pn = e * 16 + (r >> 3); return true; }
    __device__ __forceinline__ void a_ready(const pg8::Unit&) const {}
    __device__ __forceinline__ void done(const pg8::Unit&) const {}
};
struct ExpertOrder2 {
    int G, v;
    __device__ void init(int G_, int c) { G = G_; v = (G_ % 8 == 0) ? (c % 8) * (G_ / 8) + c / 8 : c; }
    __device__ bool next(int i, pg8::Unit& u) const { const int L = i * G + v; if (L >= 512) return false; const int e = L >> 5, r = L & 31; u.pm = e * 8 + (r & 7); u.pn = e * 4 + (r >> 3); return true; }
    __device__ __forceinline__ void a_ready(const pg8::Unit&) const {}
    __device__ __forceinline__ void done(const pg8::Unit&) const {}
};
__device__ __forceinline__ float silu_fast(float x) { return x * __builtin_amdgcn_rcpf(1.f + __builtin_amdgcn_exp2f(-1.4426950408889634f * x)); }
struct EpiSwiGLU {
    static constexpr bool PERM = true, AFTER_DRAIN = false; static constexpr int SEG = 0;
    bf16_t* O; int ldc;
    __device__ __forceinline__ void operator()(const pg8::f32x4 (&acc)[2][2][4][2], const pg8::Unit& u, int wr, int wc, int fr, int fq) const {
        int row0 = u.pm * 256 + wr * 64 + fr; asm volatile("" : "+v"(row0)); const int col0 = (u.pn & 15) * 128 + wc * 32 + 8 * fq;
#pragma unroll
        for (int ai = 0; ai < 2; ++ai)
#pragma unroll
            for (int m = 0; m < 4; ++m) {
                const pg8::f32x4 g0 = acc[ai][0][m][0], g1 = acc[ai][0][m][1], u0 = acc[ai][1][m][0], u1 = acc[ai][1][m][1];
                constexpr float IG = 1.f / F8_WGU, HS = F8_HID / F8_WGU;
                const unsigned w0 = pk4_fp8(silu_fast(g0[0] * IG) * u0[0] * HS, silu_fast(g0[1] * IG) * u0[1] * HS, silu_fast(g0[2] * IG) * u0[2] * HS, silu_fast(g0[3] * IG) * u0[3] * HS);
                const unsigned w1 = pk4_fp8(silu_fast(g1[0] * IG) * u1[0] * HS, silu_fast(g1[1] * IG) * u1[1] * HS, silu_fast(g1[2] * IG) * u1[2] * HS, silu_fast(g1[3] * IG) * u1[3] * HS);
                *(uint2*)((unsigned char*)O + (size_t)(row0 + ai * 128 + m * 16) * ldc + col0) = make_uint2(w0, w1);
            }
    }
};
struct EpiProj {
    static constexpr bool PERM = true, AFTER_DRAIN = false; static constexpr int SEG = 0;
    bf16_t* O; const float* bias;
    __device__ __forceinline__ void operator()(const pg8::f32x4 (&acc)[2][2][4][2], const pg8::Unit& u, int wr, int wc, int fr, int fq) const {
        int row0 = u.pm * 256 + wr * 64 + fr; asm volatile("" : "+v"(row0)); const int col0 = u.pn * 256 + wc * 32 + 8 * fq; const bool gate = u.pn < 12; constexpr float L2E = 1.4426950408889634f;
        float bias8[2][8];
        if (gate) { u32x4_t t0[4], t1[4]; const unsigned o0 = (unsigned)col0 * 4u; ldg8_x4<16, 512, 528>(t0, t1, bias, o0, o0);
#pragma unroll
            for (int q = 0; q < 4; ++q) { bias8[0][q] = __uint_as_float(t0[0][q]); bias8[0][4 + q] = __uint_as_float(t0[1][q]); bias8[1][q] = __uint_as_float(t0[2][q]); bias8[1][4 + q] = __uint_as_float(t0[3][q]); } }
#pragma unroll
        for (int bj = 0; bj < 2; ++bj) {
            float b[8];
#pragma unroll
            for (int q = 0; q < 8; ++q) b[q] = gate ? bias8[bj][q] : 0.f;
#pragma unroll
            for (int ai = 0; ai < 2; ++ai)
#pragma unroll
                for (int m = 0; m < 4; ++m) { float v[8];
#pragma unroll
                    for (int q = 0; q < 8; ++q) { const float x = acc[ai][bj][m][q >> 2][q & 3]; v[q] = gate ? __builtin_amdgcn_rcpf(1.f + __builtin_amdgcn_exp2f(-(x + b[q]) * L2E)) : x; }
                    pg8::u32x4 w; w.x = pg8::cvt_pk_bf16(v[0], v[1]); w.y = pg8::cvt_pk_bf16(v[2], v[3]); w.z = pg8::cvt_pk_bf16(v[4], v[5]); w.w = pg8::cvt_pk_bf16(v[6], v[7]);
                    *(pg8::u32x4*)(O + (size_t)(row0 + ai * 128 + m * 16) * DINP + col0 + bj * 128) = w; } }
    }
};
struct EpiQ {
    static constexpr bool PERM = false, AFTER_DRAIN = false; static constexpr int SEG = 0;
    bf16_t* Q; const float* rq; const float* rc; const float* rs;
    __device__ __forceinline__ void operator()(const pg8::f32x4 (&acc)[2][2][4][2], const pg8::Unit& u, int wr, int wc, int fr, int fq) const {
        int row0 = u.pm * 256 + wr * 64 + fr; asm volatile("" : "+v"(row0)); constexpr float SC = 0.10206207261596575f * 1.4426950408889634f;
        float sc8[8]; { unsigned off[8];
#pragma unroll
            for (int i = 0; i < 8; ++i) off[i] = (unsigned)(row0 + (i >> 2) * 128 + (i & 3) * 16) * 4u;
            ldg8_dw(sc8, rq, off); }
#pragma unroll
        for (int bj = 0; bj < 2; ++bj) { const int g32 = u.pn * 8 + bj * 4 + wc, col0 = g32 * 32 + 4 * fq; const bool rope = (g32 % 3) == 2;
#pragma unroll
            for (int ai = 0; ai < 2; ++ai) {
                u32x4_t cs4[4], sn4[4];
                if (rope) { u32x4_t t0[4], t1[4];
                    const unsigned o0 = (unsigned)((row0 + ai * 128) * 16 + 4 * fq) * 4u;
                    ldg8_x4<16 * 16 * 4, 32 * 16 * 4, 48 * 16 * 4>(t0, t1, rc, o0, o0 + (unsigned)(T * 16 * 4));
#pragma unroll
                    for (int m = 0; m < 4; ++m) { cs4[m] = t0[m]; sn4[m] = t1[m]; } }
#pragma unroll
                for (int m = 0; m < 4; ++m) { const int row = row0 + ai * 128 + m * 16; const float s = sc8[ai * 4 + m] * SC;
                    pg8::f32x4 v0 = acc[ai][bj][m][0] * s, v1 = acc[ai][bj][m][1] * s;
                    if (rope) { const pg8::f32x4 c4 = __builtin_bit_cast(pg8::f32x4, cs4[m]), s4 = __builtin_bit_cast(pg8::f32x4, sn4[m]);
                        const pg8::f32x4 x1 = v0, x2 = v1; v0 = x1 * c4 - x2 * s4; v1 = x1 * s4 + x2 * c4; }
                    bf16_t* qp = Q + (size_t)row * 768 + col0;
                    *(uint2*)qp = make_uint2(pg8::cvt_pk_bf16(v0[0], v0[1]), pg8::cvt_pk_bf16(v0[2], v0[3]));
                    *(uint2*)(qp + 16) = make_uint2(pg8::cvt_pk_bf16(v1[0], v1[1]), pg8::cvt_pk_bf16(v1[2], v1[3])); } } }
    }
};
struct EpiKV {
    static constexpr bool PERM = true, AFTER_DRAIN = false; static constexpr int SEG = 0;
    bf16_t* K; bf16_t* V; const float* rkv;
    __device__ __forceinline__ void operator()(const pg8::f32x4 (&acc)[2][2][4][2], const pg8::Unit& u, int wr, int wc, int fr, int fq) const {
        int row0 = u.pm * 256 + wr * 64 + fr; asm volatile("" : "+v"(row0));
        float sc8[8]; { unsigned off[8];
#pragma unroll
            for (int i = 0; i < 8; ++i) off[i] = (unsigned)(row0 + (i >> 2) * 128 + (i & 3) * 16) * 4u;
            ldg8_dw(sc8, rkv, off); }
#pragma unroll
        for (int bj = 0; bj < 2; ++bj) { const int head = u.pn * 2 + bj;
#pragma unroll
            for (int ai = 0; ai < 2; ++ai)
#pragma unroll
                for (int m = 0; m < 4; ++m) { const int row = row0 + ai * 128 + m * 16; const float s = sc8[ai * 4 + m];
                    const pg8::f32x4 v0 = acc[ai][bj][m][0] * s, v1 = acc[ai][bj][m][1] * s; pg8::u32x4 w;
                    w.x = pg8::cvt_pk_bf16(v0[0], v0[1]); w.y = pg8::cvt_pk_bf16(v0[2], v0[3]); w.z = pg8::cvt_pk_bf16(v1[0], v1[1]); w.w = pg8::cvt_pk_bf16(v1[2], v1[3]);
                    bf16_t* dst = (wc < 2) ? K + (size_t)row * 768 + head * 96 + wc * 32 + 8 * fq : V + (size_t)row * 512 + head * 64 + (wc - 2) * 32 + 8 * fq;
                    *(pg8::u32x4*)dst = w; } }
    }
};
struct EpiF32 {
    static constexpr bool PERM = true, AFTER_DRAIN = false; static constexpr int SEG = 0;
    float* O; int ldc; const float* rs;
    __device__ __forceinline__ void operator()(const pg8::f32x4 (&acc)[2][2][4][2], const pg8::Unit& u, int wr, int wc, int fr, int fq) const {
        int row0 = u.pm * 256 + wr * 64 + fr; asm volatile("" : "+v"(row0)); const int col0 = u.pn * 256 + wc * 32 + 8 * fq;
#pragma unroll
        for (int ai = 0; ai < 2; ++ai)
#pragma unroll
            for (int m = 0; m < 4; ++m) { const int row = row0 + ai * 128 + m * 16; const float s = rs ? rs[row] : 1.f;
#pragma unroll
                for (int bj = 0; bj < 2; ++bj) { float* op = O + (size_t)row * ldc + col0 + bj * 128;
                    *(pg8::f32x4*)op = acc[ai][bj][m][0] * s; *(pg8::f32x4*)(op + 4) = acc[ai][bj][m][1] * s; } }
    }
};
struct EpiMerge {
    static constexpr bool PERM = true, AFTER_DRAIN = false; static constexpr int SEG = 8;
    bf16_t* O; const bf16_t* GL;
    static __device__ __forceinline__ void ld8(const bf16_t* p, float* o) { const uint4 w = *(const uint4*)p;
        o[0] = __uint_as_float(w.x << 16); o[1] = __uint_as_float(w.x & 0xffff0000u); o[2] = __uint_as_float(w.y << 16); o[3] = __uint_as_float(w.y & 0xffff0000u);
        o[4] = __uint_as_float(w.z << 16); o[5] = __uint_as_float(w.z & 0xffff0000u); o[6] = __uint_as_float(w.w << 16); o[7] = __uint_as_float(w.w & 0xffff0000u); }
    __device__ __forceinline__ void segment(pg8::f32x4 (&acc)[2][2][4][2], const pg8::Unit& u, int seg, int wr, int wc, int fr, int fq) const {
        int row0 = u.pm * 256 + wr * 64 + fr; asm volatile("" : "+v"(row0));
        const unsigned cb = (unsigned)((seg - 1) * 1024 + u.pn * 256 + wc * 32 + 8 * fq) * 2u;
#pragma unroll
        for (int ai = 0; ai < 2; ++ai)
#pragma unroll
            for (int m = 0; m < 4; ++m) {
                u32x4_t ga[4];
                ldg4_x4<2048, 256, 2304>(ga, GL, (unsigned)(row0 + ai * 128 + m * 16) * (unsigned)(DINP * 2) + cb);
#pragma unroll
                for (int bj = 0; bj < 2; ++bj) { float x0[8], x1[8]; bf8_to_f32(ga[bj * 2], x0); bf8_to_f32(ga[bj * 2 + 1], x1);
#pragma unroll
                    for (int q = 0; q < 8; ++q) acc[ai][bj][m][q >> 2][q & 3] *= x0[q] * __builtin_amdgcn_rcpf(x1[q]); } }
    }
    __device__ __forceinline__ void operator()(const pg8::f32x4 (&acc)[2][2][4][2], const pg8::Unit& u, int wr, int wc, int fr, int fq) const {
        int row0 = u.pm * 256 + wr * 64 + fr; asm volatile("" : "+v"(row0)); const int col0 = u.pn * 256 + wc * 32 + 8 * fq;
        const unsigned cb = (unsigned)(2048 + col0) * 2u;
#pragma unroll
        for (int ai = 0; ai < 2; ++ai) {
            u32x4_t g8[8];
            { unsigned off[8];
#pragma unroll
              for (int i = 0; i < 8; ++i) off[i] = (unsigned)(row0 + ai * 128 + (i & 3) * 16) * (unsigned)(DINP * 2) + cb + (i >> 2) * 256u;
              ldg8_x4v(g8, GL, off); }
#pragma unroll
            for (int m = 0; m < 4; ++m) { const int row = row0 + ai * 128 + m * 16;
#pragma unroll
                for (int bj = 0; bj < 2; ++bj) { float x2[8], v[8]; bf8_to_f32(g8[bj * 4 + m], x2);
#pragma unroll
                    for (int q = 0; q < 8; ++q) v[q] = acc[ai][bj][m][q >> 2][q & 3] * x2[q];
                    pg8::u32x4 w; w.x = pg8::cvt_pk_bf16(v[0], v[1]); w.y = pg8::cvt_pk_bf16(v[2], v[3]); w.z = pg8::cvt_pk_bf16(v[4], v[5]); w.w = pg8::cvt_pk_bf16(v[6], v[7]);
                    *(pg8::u32x4*)(O + (size_t)row * DM + col0 + bj * 128) = w; } } }
    }
};
struct EpiRowScale {
    static constexpr bool PERM = true, AFTER_DRAIN = false; static constexpr int SEG = 0;
    bf16_t* O; int ldc; const float* rs;
    __device__ __forceinline__ void operator()(const pg8::f32x4 (&acc)[2][2][4][2], const pg8::Unit& u, int wr, int wc, int fr, int fq) const {
        int row0 = u.pm * 256 + wr * 64 + fr; asm volatile("" : "+v"(row0)); const int col0 = (u.pn & 3) * 256 + wc * 32 + 8 * fq;
        float sc8[8]; { unsigned off[8];
#pragma unroll
            for (int i = 0; i < 8; ++i) off[i] = (unsigned)(row0 + (i >> 2) * 128 + (i & 3) * 16) * 4u;
            ldg8_dw(sc8, rs, off); }
#pragma unroll
        for (int ai = 0; ai < 2; ++ai)
#pragma unroll
            for (int m = 0; m < 4; ++m) { const int row = row0 + ai * 128 + m * 16; const float s = sc8[ai * 4 + m] * (1.f / (F8_WD * F8_HID));
#pragma unroll
                for (int bj = 0; bj < 2; ++bj) { const pg8::f32x4 v0 = acc[ai][bj][m][0] * s, v1 = acc[ai][bj][m][1] * s; pg8::u32x4 w;
                    w.x = pg8::cvt_pk_bf16(v0[0], v0[1]); w.y = pg8::cvt_pk_bf16(v0[2], v0[3]); w.z = pg8::cvt_pk_bf16(v1[0], v1[1]); w.w = pg8::cvt_pk_bf16(v1[2], v1[3]);
                    *(pg8::u32x4*)(O + (size_t)row * ldc + col0 + bj * 128) = w; } }
    }
};
struct Params {
    const float* in[27];
    const int* pos;
    float* out;
    unsigned char* ws;
};

__device__ __forceinline__ float wave_sum(float v) {
#pragma unroll
    for (int o = 1; o < 64; o <<= 1) v += __shfl_xor(v, o);
    return v;
}
__device__ __forceinline__ float sigmoidf_(float x) { return 1.f / (1.f + expf(-x)); }
__device__ __forceinline__ float siluf_(float x) { return x / (1.f + expf(-x)); }
__device__ __forceinline__ float log_sigmoidf_(float x) { return fminf(x, 0.f) - log1pf(expf(-fabsf(x))); }

__device__ __forceinline__ float bf2f(bf16_t u) { return __uint_as_float((unsigned)u << 16); }
__device__ __forceinline__ unsigned f2bf(float f) { unsigned u = __float_as_uint(f); return (u + 0x7fffu + ((u >> 16) & 1u)) >> 16; }
__device__ __forceinline__ unsigned pk2(float lo, float hi) { return f2bf(lo) | (f2bf(hi) << 16); }
__device__ __forceinline__ void ld4bf(const bf16_t* p, float* o) {
    const uint2 w = *(const uint2*)p; o[0] = __uint_as_float(w.x << 16); o[1] = __uint_as_float(w.x & 0xffff0000u); o[2] = __uint_as_float(w.y << 16); o[3] = __uint_as_float(w.y & 0xffff0000u);
}
__device__ __forceinline__ void transpose_block(const float* Wblk, int ldw, bf16_t* dst, int ldt, const float* ks, const float* ns, float* scr, int lane) {
#pragma unroll 8
    for (int i = 0; i < 32; ++i) { const int kk = 2 * i + (lane >> 5); float v = __builtin_nontemporal_load(&Wblk[(size_t)kk * ldw + (lane & 31)]);     if (ks) v *= ks[kk]; if (ns) v *= ns[lane & 31]; scr[kk * 33 + (lane & 31)] = v; }
    asm volatile("s_waitcnt lgkmcnt(0)" ::: "memory");
    const int c = lane & 7;
#pragma unroll
    for (int j = 0; j < 4; ++j) { const int n = (lane >> 3) + 8 * j; const float* s = scr + (8 * c) * 33 + n;
        uint4 o; o.x = pk2(s[0 * 33], s[1 * 33]); o.y = pk2(s[2 * 33], s[3 * 33]); o.z = pk2(s[4 * 33], s[5 * 33]); o.w = pk2(s[6 * 33], s[7 * 33]);
        *(uint4*)(dst + (size_t)n * ldt + 8 * c) = o; }
    asm volatile("s_waitcnt lgkmcnt(0)" ::: "memory");
}

struct WStream {
    const float* gate; const float* up; const float* down;
    unsigned char* wgu_t; unsigned char* wd_t;
    const char* rowp; unsigned rs8, rs1;
    unsigned vo0;
    const float* src; unsigned char* dst; int ldt; float sc;
    int it, it_stride, step, nsteps;
    float v0, v1, v2, v3;
    char* blk; char* blkw;
    __device__ __forceinline__ void init(int gw, int ngw, char* lds_blk, int lane) {
        constexpr int I_ALL = 2 * 16 * 16 * 64 + 16 * 32 * 32;
        nsteps = (gw < I_ALL) ? 8 * ((I_ALL - gw + ngw - 1) / ngw) : 0;
        if (I_ALL % ngw == 0) { const int per_wg = I_ALL / (ngw >> 3); gw = (gw >> 3) * per_wg + (gw & 7); ngw = 8; nsteps = per_wg; }
        it = gw; it_stride = ngw; step = 0; blk = lds_blk; blkw = lds_blk + (lane & 31) * 80 + 4 * (lane >> 5);
        src = gate; rowp = (const char*)gate; rs8 = 0u; rs1 = 0u; vo0 = 0u; dst = wgu_t; ldt = DM; sc = 1.f; v0 = v1 = v2 = v3 = 0.f;
    }
    __device__ __forceinline__ void rare(int lane) {
        if (step >= 8 && step <= nsteps) {
            const int nr = lane >> 1, hf = lane & 1;
            const uint4 a = *(const uint4*)(blk + nr * 80 + hf * 32), b = *(const uint4*)(blk + nr * 80 + hf * 32 + 16);
            unsigned char* q = dst + (size_t)nr * ldt + hf * 32;
            *(uint4*)q = a; *(uint4*)(q + 16) = b;
        }
        if (step < nsteps) {
            constexpr int I_G = 16 * 16 * 64; int ldw;
            if (it < 2 * I_G) { const int up_ = it >= I_G, r_ = up_ ? it - I_G : it, e_ = r_ >> 10, kb_ = (r_ >> 6) & 15, nb_ = r_ & 63, j0_ = nb_ * 32;
                src = (up_ ? up : gate) + (size_t)e_ * DM * DEXP + (size_t)(64 * kb_) * DEXP + j0_; ldw = DEXP;
                dst = wgu_t + (size_t)(e_ * 4096 + 256 * (j0_ >> 7) + (j0_ & 127) + (up_ ? 128 : 0)) * DM + 64 * kb_; ldt = DM; sc = F8_WGU; }
            else { const int r_ = it - 2 * I_G, e_ = r_ >> 10, kb_ = (r_ >> 5) & 31, nb_ = r_ & 31;
                src = down + (size_t)e_ * DEXP * DM + (size_t)(64 * kb_) * DM + 32 * nb_; ldw = DM; dst = wd_t + (size_t)(e_ * 1024 + 32 * nb_) * DEXP + 64 * kb_; ldt = DEXP; sc = F8_WD; }
            it += it_stride;
            rowp = (const char*)src; rs8 = (unsigned)ldw * 32u; rs1 = (unsigned)ldw * 4u;
            vo0 = (unsigned)((4 * (lane >> 5)) * ldw + (lane & 31)) * 4u;
        } else { rowp = (const char*)src; rs8 = 0u; rs1 = 0u; vo0 = (unsigned)(lane & 31) * 4u; }
    }
    __device__ __forceinline__ void tick(int lane) {
        *(unsigned*)(blkw + ((step - 1) & 7) * 8) = pk4_fp8(v0 * sc, v1 * sc, v2 * sc, v3 * sc);
        if ((step & 7) == 0) rare(lane);
        v0 = __builtin_nontemporal_load((const float*)(rowp + vo0)); v1 = __builtin_nontemporal_load((const float*)(rowp + rs1 + vo0));
        v2 = __builtin_nontemporal_load((const float*)(rowp + 2 * rs1 + vo0)); v3 = __builtin_nontemporal_load((const float*)(rowp + 3 * rs1 + vo0));
        rowp += rs8; ++step;
    }
};

namespace att {
using bf16x8 = __attribute__((ext_vector_type(8))) short;
using s16x4  = __attribute__((ext_vector_type(4))) short;
using f32x16 = __attribute__((ext_vector_type(16))) float;
using u32x4  = __attribute__((ext_vector_type(4))) unsigned;
constexpr int NW = 8, QBLK = 32, KVBLK = 64;
constexpr int LDQ = 768, LDK = 768, LDV = 512, LDO = 1536;
constexpr int KROWB = 208;
constexpr int SHM_K = KVBLK * KROWB, SHM_V = KVBLK * 64 * 2;
constexpr int NBUF = 3;
constexpr int SHM_ATTN = NBUF * SHM_V + NBUF * SHM_K + NW * 64 * 4;
constexpr float THR = 8.f;
#define ASBAR() __builtin_amdgcn_sched_barrier(0)
__device__ __forceinline__ int crow(int r, int hi) { return (r & 3) + 8 * (r >> 2) + 4 * hi; }
__device__ __forceinline__ unsigned cvtpk(float lo, float hi) { unsigned r; asm volatile("v_cvt_pk_bf16_f32 %0, %1, %2" : "=v"(r) : "v"(lo), "v"(hi)); return r; }
#define MX3(a, b, c) __builtin_fmaxf(__builtin_fmaxf((a), (b)), (c))
template <bool FIRST>
__device__ __forceinline__ void partialSM(f32x16& p0, f32x16& p1, float& m_ref, f32x16& negm, float& alpha) {
  constexpr float THRL = THR * 1.4426950408889634f;
  float a = MX3(p0[0], p0[1], p1[0]), b = MX3(p0[2], p0[3], p1[1]); a = MX3(a, p1[2], p1[3]);
#pragma unroll
  for (int r = 4; r < 16; r += 4) { a = MX3(a, p0[r], p0[r + 1]); b = MX3(b, p0[r + 2], p0[r + 3]); a = MX3(a, p1[r], p1[r + 1]); b = MX3(b, p1[r + 2], p1[r + 3]); }
  float pmax = fmaxf(a, b);
  { auto rr = __builtin_amdgcn_permlane32_swap(__float_as_uint(pmax), __float_as_uint(pmax), false, false);
    pmax = fmaxf(__uint_as_float(rr[0]), __uint_as_float(rr[1])); }
  alpha = 1.f;
  if (FIRST || !__builtin_expect(__all(pmax <= THRL), 1)) {
    const float dl = FIRST ? pmax : fmaxf(pmax, 0.f); m_ref += dl;
#pragma unroll
    for (int r = 0; r < 16; ++r) { p0[r] -= dl; p1[r] -= dl; }
#pragma unroll
    for (int r = 0; r < 16; ++r) negm[r] = -m_ref;
    asm volatile("" : "+v"(negm));
    if (!FIRST) alpha = __builtin_amdgcn_exp2f(-dl);
  }
#pragma unroll
  for (int r = 0; r < 16; ++r) p0[r] = __builtin_amdgcn_exp2f(p0[r]);
}
#undef MX3
__device__ __forceinline__ void finishSM(f32x16& p0, f32x16& p1, float alpha, float& l_reg, bf16x8& pa0, bf16x8& pa1, bf16x8& pa2, bf16x8& pa3) {
  for (int r = 0; r < 16; ++r) p1[r] = __builtin_amdgcn_exp2f(p1[r]);
  float ps = 0; for (int r = 0; r < 16; ++r) ps += p0[r]; for (int r = 0; r < 16; ++r) ps += p1[r];
  { auto rr = __builtin_amdgcn_permlane32_swap(__float_as_uint(ps), __float_as_uint(ps), false, false);
    ps = __uint_as_float(rr[0]) + __uint_as_float(rr[1]); }
  l_reg = l_reg * alpha + ps;
#define PK4(P, BASE, OUT) do { u32x4 w = {cvtpk(P[BASE + 0], P[BASE + 1]), cvtpk(P[BASE + 2], P[BASE + 3]), cvtpk(P[BASE + 4], P[BASE + 5]), cvtpk(P[BASE + 6], P[BASE + 7])}; \
    OUT = *reinterpret_cast<bf16x8*>(&w); } while (0)
  PK4(p0, 0, pa0); PK4(p0, 8, pa1); PK4(p1, 0, pa2); PK4(p1, 8, pa3);
#undef PK4
}
__device__ __forceinline__ void qkt(f32x16& p0, f32x16& p1, const char* Ks, const bf16x8* qr, const f32x16& negm, int r32, int hi) {
  p0 = negm; p1 = negm;
#pragma unroll
  for (int d0 = 0; d0 < 6; ++d0) { const int cb = d0 * 32 + hi * 16;
    bf16x8 b0 = *reinterpret_cast<const bf16x8*>(Ks + r32 * KROWB + cb);
    bf16x8 b1 = *reinterpret_cast<const bf16x8*>(Ks + (32 + r32) * KROWB + cb);
    p0 = __builtin_amdgcn_mfma_f32_32x32x16_bf16(b0, qr[d0], p0, 0, 0, 0);
    p1 = __builtin_amdgcn_mfma_f32_32x32x16_bf16(b1, qr[d0], p1, 0, 0, 0); }
}
__device__ __forceinline__ int v_st(int k, int c) { const int kk = k;   return ((kk >> 3) * 2 + (c >> 5)) * 512 + ((kk & 7) * 32 + (c & 31)) * 2; }
__device__ __forceinline__ int v_rd_base(int lane) { return ((lane & 3) << 3) | (((lane >> 2) & 3) << 6) | (((lane >> 4) & 1) << 5) | (((lane >> 5) & 1) << 8); }
constexpr int v_rd_off(int d0, int ks, int half) { return d0 * 512 + ks * 2048 + half * 1024; }
template <int OFF> __device__ __forceinline__ s16x4 tr_read(int vb) {
  s16x4 r; asm volatile("ds_read_b64_tr_b16 %0, %1 offset:%2" : "=&v"(r) : "v"(vb), "i"(OFF) : "memory"); return r;
}
template <int D0> __device__ __forceinline__ void pv_one(f32x16& od, int vb, bf16x8 pa0, bf16x8 pa1, bf16x8 pa2, bf16x8 pa3) {
  const s16x4 l0 = tr_read<v_rd_off(D0, 0, 0)>(vb), h0 = tr_read<v_rd_off(D0, 0, 1)>(vb), l1 = tr_read<v_rd_off(D0, 1, 0)>(vb), h1 = tr_read<v_rd_off(D0, 1, 1)>(vb);
  const s16x4 l2 = tr_read<v_rd_off(D0, 2, 0)>(vb), h2 = tr_read<v_rd_off(D0, 2, 1)>(vb), l3 = tr_read<v_rd_off(D0, 3, 0)>(vb), h3 = tr_read<v_rd_off(D0, 3, 1)>(vb);
  asm volatile("s_waitcnt lgkmcnt(0)" ::: "memory"); ASBAR();
#define PK(L, H) (bf16x8){L[0], L[1], L[2], L[3], H[0], H[1], H[2], H[3]}
  od = __builtin_amdgcn_mfma_f32_32x32x16_bf16(pa0, PK(l0, h0), od, 0, 0, 0);
  od = __builtin_amdgcn_mfma_f32_32x32x16_bf16(pa1, PK(l1, h1), od, 0, 0, 0);
  od = __builtin_amdgcn_mfma_f32_32x32x16_bf16(pa2, PK(l2, h2), od, 0, 0, 0);
  od = __builtin_amdgcn_mfma_f32_32x32x16_bf16(pa3, PK(l3, h3), od, 0, 0, 0);
#undef PK
}
__device__ __forceinline__ void pv_d0(f32x16* o, int vb, bf16x8 pa0, bf16x8 pa1, bf16x8 pa2, bf16x8 pa3) {
  pv_one<0>(o[0], vb, pa0, pa1, pa2, pa3); pv_one<1>(o[1], vb, pa0, pa1, pa2, pa3);
}
__device__ __forceinline__ void attn_unit(const bf16_t* Qb, const bf16_t* Kh, const bf16_t* Vh, bf16_t* Ob, int seq, char* lds, WStream& wst) {
  int tid_ = threadIdx.x; asm volatile("" : "+v"(tid_));
  const int tid = tid_, wid = tid >> 6, lane = tid & 63, r32 = lane & 31, hi = lane >> 5;
  char* V_lds = lds; char* K_lds = lds + NBUF * SHM_V;
  float* ws = (float*)(lds + NBUF * SHM_V + NBUF * SHM_K) + wid * 64; float* li_l = ws; float* al_l = ws + 32;
  float m_ref = 0.f, l_reg = 0; f32x16 o[2] = {}; bf16x8 qr[6]; f32x16 negm = {}; asm volatile("" : "+v"(negm));
  const bf16_t* Qw = Qb + (long)(wid * QBLK + r32) * LDQ + hi * 8;
#pragma unroll
  for (int d0 = 0; d0 < 6; ++d0) qr[d0] = *reinterpret_cast<const bf16x8*>(Qw + d0 * 16);
  const bool kact = tid < 384; const int kr = tid / 12, kc = tid - kr * 12, vr = tid >> 3, vc = (tid & 7) * 8, vst0 = v_st(vr, vc);
  const int kst0 = kr * KROWB + kc * 16, kst1 = (kr + 32) * KROWB + kc * 16;
  const int vb0 = (int)(uintptr_t)V_lds + v_rd_base(lane);
  struct { bf16x8 vs, ks0, ks1; } sr_[2];
#define SLOAD(i, k0) do { sr_[i].vs = *reinterpret_cast<const bf16x8*>(&Vh[(long)((k0) + vr) * LDV + vc]); \
    if (kact) { sr_[i].ks0 = *reinterpret_cast<const bf16x8*>(&Kh[(long)((k0) + kr) * LDK + kc * 8]); sr_[i].ks1 = *reinterpret_cast<const bf16x8*>(&Kh[(long)((k0) + 32 + kr) * LDK + kc * 8]); } } while (0)
#define SWRITE(b, i) do { *(bf16x8*)(V_lds + (b) * SHM_V + vst0) = sr_[i].vs; \
    if (kact) { *(bf16x8*)(K_lds + (b) * SHM_K + kst0) = sr_[i].ks0; *(bf16x8*)(K_lds + (b) * SHM_K + kst1) = sr_[i].ks1; } } while (0)
#define SWAIT() asm volatile("s_waitcnt vmcnt(3)" ::: "memory")
#define RESC(a) do { if (__any((a) < 1.f)) { if (hi == 0) al_l[r32] = (a); asm volatile("s_waitcnt lgkmcnt(0)" ::: "memory"); \
    for (int d = 0; d < 2; ++d) for (int r = 0; r < 16; ++r) o[d][r] *= al_l[crow(r, hi)]; } } while (0)
  f32x16 pA0, pA1, pB0, pB1; float alA, alB; bf16x8 pa0, pa1, pa2, pa3; const int NT = seq / KVBLK;
  constexpr int SE = 0, SO = 1;
  int b_prev = 0, b_cur = 1, b_next = 2;
#define ROT() do { b_prev = b_cur; b_cur = b_next; b_next = (b_next == NBUF - 1) ? 0 : b_next + 1; } while (0)
  SLOAD(SE, 0); asm volatile("s_waitcnt vmcnt(0)" ::: "memory"); SWRITE(0, SE);
  SLOAD(SO, KVBLK); if (2 < NT) SLOAD(SE, 2 * KVBLK);
  __syncthreads();
  qkt(pA0, pA1, K_lds, qr, negm, r32, hi); partialSM<true>(pA0, pA1, m_ref, negm, alA);
  SWAIT(); SWRITE(1, SO); __syncthreads();
  for (int j = 1; j + 1 < NT; j += 2) {
    SLOAD(SO, (j + 2) * KVBLK);
    ASBAR(); qkt(pB0, pB1, K_lds + b_cur * SHM_K, qr, negm, r32, hi);
    finishSM(pA0, pA1, alA, l_reg, pa0, pa1, pa2, pa3); ASBAR();
    pv_d0(o, vb0 + b_prev * SHM_V, pa0, pa1, pa2, pa3); partialSM<false>(pB0, pB1, m_ref, negm, alB);
    SWAIT(); SWRITE(b_next, SE);
    RESC(alB); wst.tick(lane); __syncthreads(); ROT();
    if (j + 3 < NT) SLOAD(SE, (j + 3) * KVBLK);
    ASBAR(); qkt(pA0, pA1, K_lds + b_cur * SHM_K, qr, negm, r32, hi);
    finishSM(pB0, pB1, alB, l_reg, pa0, pa1, pa2, pa3); ASBAR();
    pv_d0(o, vb0 + b_prev * SHM_V, pa0, pa1, pa2, pa3); partialSM<false>(pA0, pA1, m_ref, negm, alA);
    SWAIT(); SWRITE(b_next, SO);
    RESC(alA); wst.tick(lane); __syncthreads(); ROT();
  }
  ASBAR(); qkt(pB0, pB1, K_lds + b_cur * SHM_K, qr, negm, r32, hi);
  finishSM(pA0, pA1, alA, l_reg, pa0, pa1, pa2, pa3); ASBAR();
  pv_d0(o, vb0 + b_prev * SHM_V, pa0, pa1, pa2, pa3); partialSM<false>(pB0, pB1, m_ref, negm, alB);
  RESC(alB);
  finishSM(pB0, pB1, alB, l_reg, pa0, pa1, pa2, pa3); ASBAR();
  pv_d0(o, vb0 + b_cur * SHM_V, pa0, pa1, pa2, pa3);
#undef ROT
  if (hi == 0) li_l[r32] = l_reg; asm volatile("s_waitcnt lgkmcnt(0)" ::: "memory");
  float rli[16];
#pragma unroll
  for (int r = 0; r < 16; ++r) rli[r] = __builtin_amdgcn_rcpf(li_l[crow(r, hi)]);
  bf16_t* Ow = Ob + (long)(wid * QBLK) * LDO;
#pragma unroll
  for (int r = 0; r < 16; ++r) { const int orow = crow(r, hi);
#pragma unroll
    for (int d0 = 0; d0 < 2; ++d0) Ow[(long)orow * LDO + d0 * 32 + r32] = (bf16_t)f2bf(o[d0][r] * rli[r]); }
  __syncthreads();
#undef SLOAD
#undef SWRITE
#undef SWAIT
#undef RESC
}
#undef ASBAR
}

namespace gla {
using bf16x8 = __attribute__((ext_vector_type(8))) short;
using s16x4  = __attribute__((ext_vector_type(4))) short;
using f32x16 = __attribute__((ext_vector_type(16))) float;
using u32x4  = __attribute__((ext_vector_type(4))) unsigned;
constexpr int L_DL = 0, L_TOT = 8192, L_RSUM = 10240, L_V = 12288, L_QF = 28672, L_KF = 37888, L_QB = 47104, L_KB = 56320, L_KSTF = 65536, L_KSTB = 74752, L_STF = 65536, L_STB = 83968, L_QR = 102400, L_KR = 110592, L_END = 118784;
constexpr int RB = 144;
__device__ __forceinline__ int crow(int r, int hi) { return (r & 3) + 8 * (r >> 2) + 4 * hi; }
__device__ __forceinline__ unsigned cvtpk(float lo, float hi) { unsigned r; asm volatile("v_cvt_pk_bf16_f32 %0, %1, %2" : "=v"(r) : "v"(lo), "v"(hi)); return r; }
__device__ __forceinline__ int v_st4(int k, int c) { const int kk = (k & ~0xC) | ((k & 4) << 1) | ((k & 8) >> 1); return ((kk >> 3) * 4 + (c >> 5)) * 512 + ((kk & 7) * 32 + (c & 31)) * 2; }
__device__ __forceinline__ int v_rd_base(int lane) { return ((lane & 3) << 3) | (((lane >> 2) & 3) << 6) | (((lane >> 4) & 1) << 5) | (((lane >> 5) & 1) << 8); }
template <int OFF> __device__ __forceinline__ s16x4 tr_read(int vb) { s16x4 r; asm volatile("ds_read_b64_tr_b16 %0, %1 offset:%2" : "=&v"(r) : "v"(vb), "i"(OFF) : "memory"); return r; }
__device__ __forceinline__ void v_frags(int vb, bf16x8 (&f)[4]) {
  const s16x4 l0 = tr_read<0>(vb), h0 = tr_read<2048>(vb), l1 = tr_read<4096>(vb), h1 = tr_read<4096 + 2048>(vb);
  const s16x4 l2 = tr_read<8192>(vb), h2 = tr_read<8192 + 2048>(vb), l3 = tr_read<12288>(vb), h3 = tr_read<12288 + 2048>(vb);
  asm volatile("s_waitcnt lgkmcnt(0)" ::: "memory"); __builtin_amdgcn_sched_barrier(0);
#define PK(L, H) (bf16x8){L[0], L[1], L[2], L[3], H[0], H[1], H[2], H[3]}
  f[0] = PK(l0, h0); f[1] = PK(l1, h1); f[2] = PK(l2, h2); f[3] = PK(l3, h3);
#undef PK
}
__device__ __forceinline__ bf16x8 frag(const char* base, int row, int ks, int hi) { return *reinterpret_cast<const bf16x8*>(base + row * RB + ks * 32 + hi * 16); }

template <bool IS_G1>
__device__ __forceinline__ void prep(char* lds, const bf16_t* projb, const float* wdec, const float* bdec, int t0, int hh, float* dec_out  , long dec_dir_stride) {
  int tid_ = threadIdx.x; asm volatile("" : "+v"(tid_)); const int tid = tid_;
  float* DL = (float*)(lds + L_DL); float* TOT = (float*)(lds + L_TOT);
  { const int i = tid >> 3, r4 = (tid & 7) * 4; float v[4]; ld4bf(projb + (size_t)(t0 + i) * DINP + OFF_GDEC + r4, v); *(float4*)(DL + i * 32 + r4) = make_float4(v[0], v[1], v[2], v[3]);
    const int c8 = (tid & 7) * 8;
    *(uint4*)(lds + L_KR + i * 128 + c8 * 2) = *(const uint4*)(projb + (size_t)(t0 + i) * DINP + OFF_GK + hh * 64 + c8);
    if constexpr (!IS_G1) *(uint4*)(lds + L_QR + i * 128 + c8 * 2) = *(const uint4*)(projb + (size_t)(t0 + i) * DINP + OFF_GQ + hh * 64 + c8); }
#pragma unroll
  for (int e2 = 0; e2 < 2; ++e2) { const int e = tid + e2 * 512, i = e >> 4, cc = (e & 15) * 8;
    *(uint4*)(lds + L_V + v_st4(i, cc)) = *(const uint4*)(projb + (size_t)(t0 + i) * DINP + OFF_GV + hh * 128 + cc); }
  __syncthreads();
  const int cidx = tid & 127, tg = tid >> 7, dir = cidx >> 6, d = cidx & 63;
  float W[16];
#pragma unroll
  for (int r = 0; r < 16; ++r) W[r] = wdec[(size_t)(dir * 16 + r) * 256 + hh * 64 + d];
  const float bias = bdec[dir * 256 + hh * 64 + d];
  constexpr float L2E = 1.4426950408889634f;
  float g[16], cs[16]; float run = 0.f;
#pragma unroll
  for (int ii = 0; ii < 16; ++ii) { const float* dl = DL + (16 * tg + ii) * 32 + dir * 16; float a = bias;
#pragma unroll
    for (int r = 0; r < 16; r += 4) { const float4 x = *(const float4*)(dl + r); a = fmaf(x.x, W[r], a); a = fmaf(x.y, W[r + 1], a); a = fmaf(x.z, W[r + 2], a); a = fmaf(x.w, W[r + 3], a); }
    g[ii] = (fminf(a, 0.f) * L2E - __builtin_amdgcn_logf(1.f + __builtin_amdgcn_exp2f(-fabsf(a) * L2E))) * (1.f / 16.f); run += g[ii]; cs[ii] = run; }
  TOT[tg * 128 + cidx] = run;
  __syncthreads();
  const float t0s = TOT[cidx], t1s = TOT[128 + cidx], t2s = TOT[256 + cidx], t3s = TOT[384 + cidx], tall = (t0s + t1s) + (t2s + t3s);
  const float off_lo = (tg > 0 ? t0s : 0.f) + (tg > 1 ? t1s : 0.f) + (tg > 2 ? t2s : 0.f);
  const float off_hi = (tg < 1 ? t1s : 0.f) + (tg < 2 ? t2s : 0.f) + (tg < 3 ? t3s : 0.f);
  const bf16_t* KR = (const bf16_t*)(lds + L_KR); const bf16_t* QR = (const bf16_t*)(lds + L_QR);
  if constexpr (IS_G1) {
    unsigned pk[8];
#pragma unroll
    for (int ii = 0; ii < 16; ii += 2) {
      float kv2[2];
#pragma unroll
      for (int u = 0; u < 2; ++u) { const int i = 16 * tg + ii + u; const float bi = dir == 0 ? off_lo + cs[ii + u] : off_hi + run - cs[ii + u] + g[ii + u];
        kv2[u] = bf2f(KR[i * 64 + d]) * __builtin_amdgcn_exp2f(tall - bi); }
      pk[ii >> 1] = cvtpk(kv2[0], kv2[1]); }
    char* dst = lds + (dir ? L_KSTB : L_KSTF) + d * RB + 32 * tg;
    *(uint4*)dst = make_uint4(pk[0], pk[1], pk[2], pk[3]); *(uint4*)(dst + 16) = make_uint4(pk[4], pk[5], pk[6], pk[7]);
    if (tg == 0) dec_out[dir * dec_dir_stride + d] = __builtin_amdgcn_exp2f(tall);
  } else {
    bf16_t* Qx = (bf16_t*)(lds + (dir ? L_QB : L_QF)); bf16_t* Kx = (bf16_t*)(lds + (dir ? L_KB : L_KF));
#pragma unroll
    for (int ii = 0; ii < 16; ++ii) { const int i = 16 * tg + ii; const float bi = dir == 0 ? off_lo + cs[ii] : off_hi + run - cs[ii] + g[ii];
      const float qv = bf2f(QR[i * 64 + d]) * 0.125f, kv = bf2f(KR[i * 64 + d]);
      Qx[i * (RB / 2) + d] = (bf16_t)f2bf(qv * __builtin_amdgcn_exp2f(bi)); Kx[i * (RB / 2) + d] = (bf16_t)f2bf(kv * __builtin_amdgcn_exp2f(-bi)); }
  }
  __syncthreads();
}

__device__ __forceinline__ void g1_item(char* lds, const bf16_t* projb, const float* wdec, const float* bdec, int b, int hh, int c, float* kvt, float* dec) {
  int tid_ = threadIdx.x; asm volatile("" : "+v"(tid_)); const int tid = tid_, wid = tid >> 6, lane = tid & 63, r32 = lane & 31, hi = lane >> 5;
  const int bh = b * 4 + hh; const long item = (long)bh * 128 + c, dstride = 8L * 128;
  prep<true>(lds, projb, wdec, bdec, b * SEQ + c * 64, hh, dec + item * 64, dstride * 64);
  const int vblk = wid >> 1, dblk = wid & 1;
  bf16x8 vf[4]; v_frags((int)(uintptr_t)(lds + L_V) + v_rd_base(lane) + vblk * 512, vf);
#pragma unroll
  for (int dir = 0; dir < 2; ++dir) { const char* kst = lds + (dir ? L_KSTB : L_KSTF); f32x16 acc = {};
#pragma unroll
    for (int ks = 0; ks < 4; ++ks) acc = __builtin_amdgcn_mfma_f32_32x32x16_bf16(vf[ks], frag(kst, dblk * 32 + r32, ks, hi), acc, 0, 0, 0);
    float* o = kvt + ((long)dir * dstride + item) * 8192 + (size_t)(vblk * 32) * 64 + dblk * 32 + r32;
#pragma unroll
    for (int r = 0; r < 16; ++r) o[crow(r, hi) * 64] = acc[r]; }
  __syncthreads();
}

__device__ __forceinline__ void g3_item(char* lds, const bf16_t* projb, const float* wdec, const float* bdec, const float* normg, int b, int hh, int c, const bf16_t* st, bf16_t* out, int ldo) {
  int tid_ = threadIdx.x; asm volatile("" : "+v"(tid_)); const int tid = tid_, wid = tid >> 6, lane = tid & 63, r32 = lane & 31, hi = lane >> 5;
  const int bh = b * 4 + hh, t0 = b * SEQ + c * 64; const long item = (long)bh * 128 + c, dstride = 8L * 128;
#pragma unroll
  for (int e4 = 0; e4 < 4; ++e4) { const int e = tid + e4 * 512, dir = e >> 10, v = (e >> 3) & 127, dc = (e & 7) * 8;
    *(uint4*)(lds + (dir ? L_STB : L_STF) + v * RB + dc * 2) = *(const uint4*)(st + ((long)dir * dstride + item) * 8192 + (size_t)v * 64 + dc); }
  prep<false>(lds, projb, wdec, bdec, t0, hh, nullptr, 0);
  const int ib = wid & 1, vblk = wid >> 1, iglob = ib * 32 + r32;
  bf16_t rgr[16];
#pragma unroll
  for (int r = 0; r < 16; ++r) rgr[r] = projb[(size_t)(t0 + ib * 32 + crow(r, hi)) * DINP + OFF_GR + hh * 128 + vblk * 32 + r32];
  f32x16 pF0 = {}, pF1 = {}, pB0 = {}, pB1 = {};
#pragma unroll
  for (int ks = 0; ks < 4; ++ks) {
    const bf16x8 qf = frag(lds + L_QF, iglob, ks, hi), qb = frag(lds + L_QB, iglob, ks, hi);
    pF0 = __builtin_amdgcn_mfma_f32_32x32x16_bf16(frag(lds + L_KF, r32, ks, hi), qf, pF0, 0, 0, 0);
    pF1 = __builtin_amdgcn_mfma_f32_32x32x16_bf16(frag(lds + L_KF, 32 + r32, ks, hi), qf, pF1, 0, 0, 0);
    pB0 = __builtin_amdgcn_mfma_f32_32x32x16_bf16(frag(lds + L_KB, r32, ks, hi), qb, pB0, 0, 0, 0);
    pB1 = __builtin_amdgcn_mfma_f32_32x32x16_bf16(frag(lds + L_KB, 32 + r32, ks, hi), qb, pB1, 0, 0, 0); }
#pragma unroll
  for (int r = 0; r < 16; ++r) { const int j0 = crow(r, hi), j1 = 32 + j0;
    pF0[r] = (j0 <= iglob ? pF0[r] : 0.f) + (j0 >= iglob ? pB0[r] : 0.f);
    pF1[r] = (j1 <= iglob ? pF1[r] : 0.f) + (j1 >= iglob ? pB1[r] : 0.f); }
  bf16x8 pa0, pa1, pa2, pa3;
#define PK4(P, BASE, OUT) do { unsigned a0 = cvtpk(P[BASE + 0], P[BASE + 1]), a1 = cvtpk(P[BASE + 2], P[BASE + 3]);   \
    unsigned b0 = cvtpk(P[BASE + 4], P[BASE + 5]), b1 = cvtpk(P[BASE + 6], P[BASE + 7]);                              \
    auto r0 = __builtin_amdgcn_permlane32_swap(a0, b0, false, false); auto r1 = __builtin_amdgcn_permlane32_swap(a1, b1, false, false); \
    u32x4 w = {r0[0], r1[0], r0[1], r1[1]}; OUT = *reinterpret_cast<bf16x8*>(&w); } while (0)
  PK4(pF0, 0, pa0); PK4(pF0, 8, pa1); PK4(pF1, 0, pa2); PK4(pF1, 8, pa3);
#undef PK4
  bf16x8 vf[4]; v_frags((int)(uintptr_t)(lds + L_V) + v_rd_base(lane) + vblk * 512, vf);
  f32x16 o = {};
  o = __builtin_amdgcn_mfma_f32_32x32x16_bf16(pa0, vf[0], o, 0, 0, 0); o = __builtin_amdgcn_mfma_f32_32x32x16_bf16(pa1, vf[1], o, 0, 0, 0);
  o = __builtin_amdgcn_mfma_f32_32x32x16_bf16(pa2, vf[2], o, 0, 0, 0); o = __builtin_amdgcn_mfma_f32_32x32x16_bf16(pa3, vf[3], o, 0, 0, 0);
#pragma unroll
  for (int ks = 0; ks < 4; ++ks) {
    o = __builtin_amdgcn_mfma_f32_32x32x16_bf16(frag(lds + L_QF, iglob, ks, hi), frag(lds + L_STF, vblk * 32 + r32, ks, hi), o, 0, 0, 0);
    o = __builtin_amdgcn_mfma_f32_32x32x16_bf16(frag(lds + L_QB, iglob, ks, hi), frag(lds + L_STB, vblk * 32 + r32, ks, hi), o, 0, 0, 0); }
  float* RS = (float*)(lds + L_RSUM);
  float ss[16];
#pragma unroll
  for (int r = 0; r < 16; ++r) { float s = o[r] * o[r]; s += __shfl_xor(s, 1); s += __shfl_xor(s, 2); s += __shfl_xor(s, 4); s += __shfl_xor(s, 8); s += __shfl_xor(s, 16); ss[r] = s; }
  if (r32 == 0) {
#pragma unroll
    for (int r = 0; r < 16; ++r) RS[(ib * 4 + vblk) * 32 + crow(r, hi)] = ss[r]; }
  __syncthreads();
  const int v = vblk * 32 + r32; const float ng = normg[v];
#pragma unroll
  for (int r = 0; r < 16; ++r) { const int il = crow(r, hi), i = ib * 32 + il;
    const float tot = (RS[(ib * 4 + 0) * 32 + il] + RS[(ib * 4 + 1) * 32 + il]) + (RS[(ib * 4 + 2) * 32 + il] + RS[(ib * 4 + 3) * 32 + il]);
    const float rstd = 1.f / sqrtf(tot * (1.f / 128.f) + RMS_EPS);
    const float rg = bf2f(rgr[r]);
    out[(size_t)(t0 + i) * ldo + hh * 128 + v] = (bf16_t)f2bf(o[r] * rstd * ng * (rg * __builtin_amdgcn_rcpf(1.f + __builtin_amdgcn_exp2f(-1.4426950408889634f * rg)))); }
  __syncthreads();
}
}

__device__ __forceinline__ void ln_core(float4 (&v)[4], const float* g, const float* b, float* out, bf16_t* outb, int lane) {
    float s = 0.f;
#pragma unroll
    for (int j = 0; j < 4; ++j) s += (v[j].x + v[j].y) + (v[j].z + v[j].w);
    const float mean = wave_sum(s) * (1.f / DM); float s2 = 0.f;
#pragma unroll
    for (int j = 0; j < 4; ++j) { v[j].x -= mean; v[j].y -= mean; v[j].z -= mean; v[j].w -= mean; s2 += (v[j].x * v[j].x + v[j].y * v[j].y) + (v[j].z * v[j].z + v[j].w * v[j].w); }
    const float rstd = 1.f / sqrtf(wave_sum(s2) * (1.f / DM) + LN_EPS);
#pragma unroll
    for (int j = 0; j < 4; ++j) {
        const float4 gg = ((const float4*)g)[lane + 64 * j], bb = ((const float4*)b)[lane + 64 * j];
        float4 o; o.x = v[j].x * rstd * gg.x + bb.x; o.y = v[j].y * rstd * gg.y + bb.y; o.z = v[j].z * rstd * gg.z + bb.z; o.w = v[j].w * rstd * gg.w + bb.w;
        ((float4*)out)[lane + 64 * j] = o; v[j] = o;
        if (outb) ((uint2*)outb)[lane + 64 * j] = make_uint2(pk2(o.x, o.y), pk2(o.z, o.w));
    }
}
__device__ __forceinline__ void wave_sum2(float& a, float& b) {
#pragma unroll
    for (int o = 1; o < 64; o <<= 1) { const float ta = __shfl_xor(a, o), tb = __shfl_xor(b, o); a += ta; b += tb; }
}
template <int MODE>
__device__ __forceinline__ void ln_core2(float4 (&v)[2][4], const float* g, const float* b, float* out0, float* out1, bf16_t* ob0, bf16_t* ob1, int lane, unsigned char* o8_0 = nullptr, unsigned char* o8_1 = nullptr) {
    float s[2] = {0.f, 0.f};
#pragma unroll
    for (int u = 0; u < 2; ++u)
#pragma unroll
        for (int j = 0; j < 4; ++j) s[u] += (v[u][j].x + v[u][j].y) + (v[u][j].z + v[u][j].w);
    wave_sum2(s[0], s[1]);
    float q[2] = {0.f, 0.f};
#pragma unroll
    for (int u = 0; u < 2; ++u) { const float mean = s[u] * (1.f / DM);
#pragma unroll
        for (int j = 0; j < 4; ++j) { v[u][j].x -= mean; v[u][j].y -= mean; v[u][j].z -= mean; v[u][j].w -= mean; q[u] += (v[u][j].x * v[u][j].x + v[u][j].y * v[u][j].y) + (v[u][j].z * v[u][j].z + v[u][j].w * v[u][j].w); } }
    wave_sum2(q[0], q[1]);
#pragma unroll
    for (int j = 0; j < 4; ++j) {
        const float4 gg = ((const float4*)g)[lane + 64 * j], bb = ((const float4*)b)[lane + 64 * j];
#pragma unroll
        for (int u = 0; u < 2; ++u) { const float rstd = 1.f / sqrtf(q[u] * (1.f / DM) + LN_EPS);
            float4 o; o.x = v[u][j].x * rstd * gg.x + bb.x; o.y = v[u][j].y * rstd * gg.y + bb.y; o.z = v[u][j].z * rstd * gg.z + bb.z; o.w = v[u][j].w * rstd * gg.w + bb.w;
            v[u][j] = o;
            if constexpr (MODE == 2) ((float4*)(u ? out1 : out0))[lane + 64 * j] = o;
            else ((uint2*)(u ? ob1 : ob0))[lane + 64 * j] = make_uint2(pk2(o.x, o.y), pk2(o.z, o.w));
            if constexpr (MODE == 1) ((unsigned*)(u ? o8_1 : o8_0))[lane + 64 * j] = pk4_fp8(o.x, o.y, o.z, o.w); }
    }
}
__device__ __forceinline__ int block_excl_scan(int x, int* scr, int tid, int& total) {
    const int lane = tid & 63, wid = tid >> 6; int inc = x;
#pragma unroll
    for (int o = 1; o < 64; o <<= 1) { const int y = __shfl_up(inc, o); if (lane >= o) inc += y; }
    __syncthreads();
    if (lane == 63) scr[wid] = inc;
    __syncthreads();
    int base = 0, tot = 0;
#pragma unroll
    for (int w = 0; w < 8; ++w) { const int c = scr[w]; base += (w < wid) ? c : 0; tot += c; }
    total = tot; return base + inc - x;
}

__device__ __forceinline__ void tb_load(float (&v)[32], const float* Wblk, int ldw, int lane) {
#pragma unroll
    for (int i = 0; i < 32; ++i) v[i] = __builtin_nontemporal_load(&Wblk[(size_t)(2 * i + (lane >> 5)) * ldw + (lane & 31)]);
}
__device__ __forceinline__ void tb_store(const float (&v)[32], bf16_t* dst, int ldt, float* scr, int lane) {
#pragma unroll
    for (int i = 0; i < 32; ++i) scr[(2 * i + (lane >> 5)) * 33 + (lane & 31)] = v[i];
    asm volatile("s_waitcnt lgkmcnt(0)" ::: "memory");
    const int c = lane & 7;
#pragma unroll
    for (int j = 0; j < 4; ++j) { const int n = (lane >> 3) + 8 * j; const float* s = scr + (8 * c) * 33 + n;
        uint4 o; o.x = pk2(s[0 * 33], s[1 * 33]); o.y = pk2(s[2 * 33], s[3 * 33]); o.z = pk2(s[4 * 33], s[5 * 33]); o.w = pk2(s[6 * 33], s[7 * 33]);
        *(uint4*)(dst + (size_t)n * ldt + 8 * c) = o; }
    asm volatile("s_waitcnt lgkmcnt(0)" ::: "memory");
}

__device__ __forceinline__ void tb_store8(const float (&v)[32], unsigned char* dst, int ldt, float sc, float* scr, int lane) {
#pragma unroll
    for (int i = 0; i < 32; ++i) scr[(2 * i + (lane >> 5)) * 33 + (lane & 31)] = v[i];
    asm volatile("s_waitcnt lgkmcnt(0)" ::: "memory");
    const int c = lane & 7;
#pragma unroll
    for (int j = 0; j < 4; ++j) { const int n = (lane >> 3) + 8 * j; const float* s = scr + (8 * c) * 33 + n;
        *(uint2*)(dst + (size_t)n * ldt + 8 * c) = make_uint2(pk4_fp8(s[0 * 33] * sc, s[1 * 33] * sc, s[2 * 33] * sc, s[3 * 33] * sc), pk4_fp8(s[4 * 33] * sc, s[5 * 33] * sc, s[6 * 33] * sc, s[7 * 33] * sc)); }
    asm volatile("s_waitcnt lgkmcnt(0)" ::: "memory");
}

__device__ __forceinline__ void ln_row(const float* a, const float* add, float alpha, const float* g, const float* b, float* out, int lane, float4 (&v)[4], bf16_t* outb = nullptr) {
    float s = 0.f;
#pragma unroll
    for (int j = 0; j < 4; ++j) {
        float4 x = ((const float4*)a)[lane + 64 * j];
        x.x *= alpha; x.y *= alpha; x.z *= alpha; x.w *= alpha;
        if (add) { const float4 y = ((const float4*)add)[lane + 64 * j]; x.x += y.x; x.y += y.y; x.z += y.z; x.w += y.w; }
        v[j] = x; s += (x.x + x.y) + (x.z + x.w);
    }
    const float mean = wave_sum(s) * (1.f / DM); float s2 = 0.f;
#pragma unroll
    for (int j = 0; j < 4; ++j) { v[j].x -= mean; v[j].y -= mean; v[j].z -= mean; v[j].w -= mean; s2 += (v[j].x * v[j].x + v[j].y * v[j].y) + (v[j].z * v[j].z + v[j].w * v[j].w); }
    const float rstd = 1.f / sqrtf(wave_sum(s2) * (1.f / DM) + LN_EPS);
#pragma unroll
    for (int j = 0; j < 4; ++j) {
        const float4 gg = ((const float4*)g)[lane + 64 * j], bb = ((const float4*)b)[lane + 64 * j];
        float4 o; o.x = v[j].x * rstd * gg.x + bb.x; o.y = v[j].y * rstd * gg.y + bb.y; o.z = v[j].z * rstd * gg.z + bb.z; o.w = v[j].w * rstd * gg.w + bb.w;
        if (out) ((float4*)out)[lane + 64 * j] = o; v[j] = o;
        if (outb) ((uint2*)outb)[lane + 64 * j] = make_uint2(pk2(o.x, o.y), pk2(o.z, o.w));
    }
}

struct GemmP {
    const float* A; const int* ridx; const float* Bm; float* C;
    int lda, ldb, ldc, M, N, K, nb, bshift;
    long sA, sB, sC; int sR;
    const float* aux; const bf16_t* auxb; int ldaux; long sAux; const float* aux2; int accum;
};
template <int MODE>
__device__ __forceinline__ void gemm_naive(const GemmP g, float* lds) {
    float (*As)[132] = (float (*)[132])lds;
    float (*Bs)[128] = (float (*)[128])(lds + 16 * 132);
    int tid_ = threadIdx.x; asm volatile("" : "+v"(tid_));
    const int tid = tid_, ty = tid >> 4, tx = tid & 15;
    const int mt = g.M / 128, nt = (g.N + 127) / 128, per = mt * nt, total = per * g.nb;
    int bid_ = blockIdx.x; asm volatile("" : "+s"(bid_));
    for (int tile = bid_; tile < total; tile += gridDim.x) {
        const int z = tile / per, r = tile % per, tm = r / nt, tn = r % nt;
        const int m0 = tm * 128, n0 = tn * 128;
        const float* Bz = g.Bm + (long)(z >> g.bshift) * g.sB;
        float* Cz = g.C + (long)z * g.sC;
        const int arow = m0 + (tid >> 2);
        const long grow = g.ridx ? (long)g.ridx[z * g.sR + arow] : (long)arow;
        const float* Arow = g.A + (long)z * g.sA + grow * g.lda + (tid & 3) * 4;
        const int bk = tid >> 5, bn = n0 + (tid & 31) * 4;
        const bool bok = bn < g.N;
        const float* Bp = Bz + (long)bk * g.ldb + bn;
        float acc[4][8];
#pragma unroll
        for (int i = 0; i < 4; ++i)
#pragma unroll
            for (int j = 0; j < 8; ++j) acc[i][j] = 0.f;
        float4 ra = *(const float4*)(Arow);
        float4 rb = bok ? *(const float4*)(Bp) : make_float4(0.f, 0.f, 0.f, 0.f);
        for (int k0 = 0; k0 < g.K; k0 += 16) {
            __syncthreads();
            { const int rr = tid >> 2, k4 = (tid & 3) * 4; As[k4][rr] = ra.x; As[k4 + 1][rr] = ra.y; As[k4 + 2][rr] = ra.z; As[k4 + 3][rr] = ra.w; }
            *(float4*)&Bs[bk][(tid & 31) * 4] = rb;
            __syncthreads();
            if (k0 + 16 < g.K) {
                ra = *(const float4*)(Arow + k0 + 16);
                rb = bok ? *(const float4*)(Bp + (long)(k0 + 16) * g.ldb) : make_float4(0.f, 0.f, 0.f, 0.f);
            }
#pragma unroll
            for (int k = 0; k < 16; ++k) {
                const float4 a = *(const float4*)&As[k][ty * 4];
                const float4 b0 = *(const float4*)&Bs[k][tx * 8], b1 = *(const float4*)&Bs[k][tx * 8 + 4];
                const float av[4] = {a.x, a.y, a.z, a.w};
                const float bv[8] = {b0.x, b0.y, b0.z, b0.w, b1.x, b1.y, b1.z, b1.w};
#pragma unroll
                for (int i = 0; i < 4; ++i)
#pragma unroll
                    for (int j = 0; j < 8; ++j) acc[i][j] = fmaf(av[i], bv[j], acc[i][j]);
            }
        }
#pragma unroll
        for (int i = 0; i < 4; ++i) {
            const int row = m0 + ty * 4 + i;
#pragma unroll
            for (int jv = 0; jv < 2; ++jv) {
                const int col = n0 + tx * 8 + jv * 4;
                if (col < g.N) {
                    float v[4] = {acc[i][jv * 4], acc[i][jv * 4 + 1], acc[i][jv * 4 + 2], acc[i][jv * 4 + 3]};
                    float* cp = Cz + (long)row * g.ldc + col;
                    if (MODE == 1) {
#pragma unroll
                        for (int q = 0; q < 4; ++q) v[q] *= g.aux[(long)z * g.sAux + col + q];
                    } else if (MODE == 2) {
                        float gl[4]; ld4bf(g.auxb + (long)row * g.ldaux + col, gl); const float4 gb = *(const float4*)(g.aux2 + col);
                        const float gv[4] = {gl[0] + gb.x, gl[1] + gb.y, gl[2] + gb.z, gl[3] + gb.w};
                        float4 old = make_float4(0.f, 0.f, 0.f, 0.f);
                        if (g.accum) old = *(const float4*)cp;
                        const float ov[4] = {old.x, old.y, old.z, old.w};
#pragma unroll
                        for (int q = 0; q < 4; ++q) v[q] = ov[q] + sigmoidf_(gv[q]) * v[q];
                    } else if (MODE == 3) {
                        const float4 old = *(const float4*)cp; const float ov[4] = {old.x, old.y, old.z, old.w};
#pragma unroll
                        for (int q = 0; q < 4; ++q) v[q] = siluf_(ov[q]) * v[q];
                    } else if (MODE == 4) {
                        const float rs = g.aux[(long)z * g.sAux + row];
#pragma unroll
                        for (int q = 0; q < 4; ++q) v[q] *= rs;
                    }
                    *(float4*)cp = make_float4(v[0], v[1], v[2], v[3]);
                }
            }
        }
    }
    __syncthreads();
}

#define W_IN(l)    (p.in[4]  + (size_t)(l) * DM * DIN)
#define B_GATE(l)  (p.in[5]  + (size_t)(l) * 3 * DM)
#define POOL_W(l)  (p.in[6]  + (size_t)(l) * 4 * 128 * 128)
#define POOL_S(l)  (p.in[7]  + (size_t)(l) * 512)
#define W_UP_A(l)  (p.in[8]  + (size_t)(l) * 512 * DM)
#define Q_NORM(l)  (p.in[9]  + (size_t)(l) * 384)
#define W_UQ(l)    (p.in[10] + (size_t)(l) * 384 * 768)
#define KV_NORM(l) (p.in[11] + (size_t)(l) * 256)
#define W_UKV(l)   (p.in[12] + (size_t)(l) * 256 * 1024)
#define W_UP_B(l)  (p.in[13] + (size_t)(l) * 512 * DM)
#define W_DEC(l)   (p.in[14] + (size_t)(l) * 2 * 16 * 256)
#define B_DEC(l)   (p.in[15] + (size_t)(l) * 2 * 256)
#define GLA_NORM(l)(p.in[16] + (size_t)(l) * 128)
#define W_UP_C(l)  (p.in[17] + (size_t)(l) * 512 * DM)
#define W_OUT(l)   (p.in[18] + (size_t)(l) * DM * DM)
#define LN1_G(l)   (p.in[19] + (size_t)(l) * DM)
#define LN1_B(l)   (p.in[20] + (size_t)(l) * DM)
#define ROUTER(l)  (p.in[21] + (size_t)(l) * DM * NE)
#define EW_GATE(l) (p.in[22] + (size_t)(l) * NE * DM * DEXP)
#define EW_UP(l)   (p.in[23] + (size_t)(l) * NE * DM * DEXP)
#define EW_DOWN(l) (p.in[24] + (size_t)(l) * NE * DEXP * DM)
#define LN2_G(l)   (p.in[25] + (size_t)(l) * DM)
#define LN2_B(l)   (p.in[26] + (size_t)(l) * DM)
#define WSF(off) ((float*)(p.ws + (off)))
#define WSI(off) ((int*)(p.ws + (off)))
#define WSB(off) ((bf16_t*)(p.ws + (off)))
#define PJ(t, c) bf2f(projb[(size_t)(t) * DINP + (c)])

enum Stage {
    ST_INIT = 0,
    ST_WCONV,
    ST_PROJ,
    ST_PREP,
    ST_SMALLGEMM,
    ST_ROPE,
    ST_ATTN,
    ST_GLA1, ST_GLA2, ST_GLA3,
    ST_GLAFIN,
    ST_MERGE_A, ST_MERGE_B, ST_MERGE_C,
    ST_OUTP,
    ST_LN1,
    ST_TOPK,
    ST_GATHER,
    ST_EXP_G, ST_EXP_U, ST_EXP_D,
    ST_LN2,
    ST_COUNT
};

#define KAS __attribute__((address_space(4)))
template <int ST>
__device__ __forceinline__ void run_stage(int l, float* lds) {
    const KAS Params* pk_ = (const KAS Params*)__builtin_amdgcn_kernarg_segment_ptr(); asm volatile("" : "+s"(pk_));
    const KAS Params& p = *pk_;
    int tid_ = threadIdx.x; asm volatile("" : "+v"(tid_));
    int bid_ = blockIdx.x; asm volatile("" : "+s"(bid_));
    const int tid = tid_, lane = tid & 63, wid = tid >> 6;
    const int G = gridDim.x, bid = bid_;
    const int gw = bid * 8 + wid, NGW = G * 8;
    const long gt = (long)bid * NTHR + tid, NGT = (long)G * NTHR;
    float* h = p.out;

    if constexpr (ST == ST_INIT) {
        for (int m = gw; m < T; m += NGW) { float4 vv[4]; ln_row(p.in[0] + (size_t)m * DM, nullptr, 1.f, p.in[2], p.in[3], nullptr, lane, vv, WSB(WS_HB) + (size_t)m * DM); }
        {
            float* scr = lds + wid * 4096;
            constexpr int NBLK = DIN / 32, ITEMS_L = (DM / 64) * NBLK;
            for (int it = gw; it < 2 * ITEMS_L; it += NGW) {
                const int ll = it / ITEMS_L, r = it % ITEMS_L, kb = r / NBLK, nb = r % NBLK;
                const int n0 = 32 * nb, drow = n0 < 2752 ? n0 + 3072 : n0 - 2752;
                transpose_block(p.in[4] + (size_t)ll * DM * DIN + (size_t)(64 * kb) * DIN + n0, DIN, WSB(WS_WIN_T) + (size_t)ll * DINP * DM + (size_t)drow * DM + 64 * kb, DM, nullptr, nullptr, scr, lane);
            }
            {
                constexpr int I_UQ = 6 * 24, I_UKV = 4 * 32, I_B = 8 * 32, I_OUT = 16 * 32, I_L = I_UQ + I_UKV + 2 * I_B + I_OUT;
                for (int it = gw; it < 2 * I_L; it += NGW) {
                    const int ll = it / I_L; int r = it % I_L; bf16_t* wsm = WSB(WS_WSMALL + (size_t)ll * WSM_STRIDE);
                    if (r < I_UQ) { const int kb = r / 24, nb = r % 24; transpose_block(p.in[10] + (size_t)ll * 384 * 768 + (size_t)(64 * kb) * 768 + 32 * nb, 768, wsm + WSM_UQ / 2 + (size_t)(32 * nb) * 384 + 64 * kb, 384, p.in[9] + ll * 384 + 64 * kb, nullptr, scr, lane); continue; } r -= I_UQ;
                    if (r < I_UKV) { const int kb = r / 32, nb = r % 32; transpose_block(p.in[12] + (size_t)ll * 256 * 1024 + (size_t)(64 * kb) * 1024 + 32 * nb, 1024, wsm + WSM_UKV / 2 + (size_t)(32 * nb) * 256 + 64 * kb, 256, p.in[11] + ll * 256 + 64 * kb, nullptr, scr, lane); continue; } r -= I_UKV;
                    if (r < 2 * I_B) { const int c = r / I_B, rr = r % I_B, kb = rr / 32, nb = rr % 32; const float* W = (c ? p.in[17] : p.in[13]) + (size_t)ll * 512 * DM;
                        transpose_block(W + (size_t)(64 * kb) * DM + 32 * nb, DM, wsm + WSM_MRG / 2 + (size_t)(32 * nb) * 1536 + 512 * (1 + c) + 64 * kb, 1536, nullptr, nullptr, scr, lane); continue; } r -= 2 * I_B;
                    { const int kb = r / 32, nb = r % 32; transpose_block(p.in[18] + (size_t)ll * DM * DM + (size_t)(64 * kb) * DM + 32 * nb, DM, wsm + WSM_OUT / 2 + (size_t)(32 * nb) * DM + 64 * kb, DM, nullptr, nullptr, scr, lane); }
                }
                for (long i = gt; i < 2L * 512 * DM; i += NGT) {
                    const int ll = (int)(i / (512 * DM)), r = (int)(i % (512 * DM)), cin = r >> 10, d = r & 1023, g = cin >> 7, c = cin & 127;
                    const float* pw = p.in[6] + (size_t)ll * 4 * 128 * 128 + (size_t)(g * 128 + c) * 128; const float* ps = p.in[7] + ll * 512 + g * 128; const float* wa = p.in[8] + (size_t)ll * 512 * DM + (size_t)(g * 128) * DM + d;
                    float a = 0.f;
                    for (int cc = 0; cc < 128; ++cc) a = fmaf(pw[cc] * ps[cc], wa[(size_t)cc * DM], a);
                    WSB(WS_WSMALL + (size_t)ll * WSM_STRIDE + WSM_MRG)[(size_t)d * 1536 + cin] = (bf16_t)f2bf(a);
                }
            }
            for (long i = gt; i < 2L * 64 * DM / 8; i += NGT) { const int ll = (int)(i / (64 * DM / 8)); const long r = i % (64 * DM / 8);
                *(uint4*)(WSB(WS_WIN_T) + (size_t)ll * DINP * DM + (size_t)DIN * DM + r * 8) = make_uint4(0u, 0u, 0u, 0u); }
        }
        float* rc = WSF(WS_ROPE); float* rs = rc + T * 16;
        for (long i = gt; i < (long)T * 16; i += NGT) {
            const int t = (int)(i >> 4), j = (int)(i & 15);
            const float freq = powf(10000.0f, -(float)j / 16.0f);
            const float ang = (float)p.pos[t] * freq;
            rc[i] = cosf(ang); rs[i] = sinf(ang);
        }
    }
    if constexpr (ST == ST_WCONV) {
        float* scr = lds + wid * 4096;
        constexpr int I_G = 16 * 16 * 64, I_D = 16 * 32 * 32;
        constexpr int I_ALL = 2 * I_G + I_D;
#define WCONV_ITEM(it, W, ldw, dst, ldt, sc8) do { if ((it) < 2 * I_G) { const int up_ = (it) >= I_G, r_ = up_ ? (it) - I_G : (it), e_ = r_ >> 10, kb_ = (r_ >> 6) & 15, nb_ = r_ & 63, j0_ = nb_ * 32; \
            W = (up_ ? EW_UP(l) : EW_GATE(l)) + (size_t)e_ * DM * DEXP + (size_t)(64 * kb_) * DEXP + j0_; ldw = DEXP; \
            dst = (unsigned char*)(p.ws + WS_WGU_T) + (size_t)(e_ * 4096 + 256 * (j0_ >> 7) + (j0_ & 127) + (up_ ? 128 : 0)) * DM + 64 * kb_; ldt = DM; sc8 = F8_WGU; } \
          else { const int r_ = (it) - 2 * I_G, e_ = r_ >> 10, kb_ = (r_ >> 5) & 31, nb_ = r_ & 31; \
            W = EW_DOWN(l) + (size_t)e_ * DEXP * DM + (size_t)(64 * kb_) * DM + 32 * nb_; ldw = DM; dst = (unsigned char*)(p.ws + WS_WD_T) + (size_t)(e_ * 1024 + 32 * nb_) * DEXP + 64 * kb_; ldt = DEXP; sc8 = F8_WD; } } while (0)
        float va[32], vb[32]; const float* Wa = nullptr; const float* Wb = nullptr; unsigned char* da = nullptr; unsigned char* db = nullptr; int lwa = 0, lwb = 0, lta = 0, ltb = 0; float sa = 1.f, sb = 1.f;
        int itA = gw, itB = gw + NGW;
        if (itA < I_ALL) { WCONV_ITEM(itA, Wa, lwa, da, lta, sa); tb_load(va, Wa, lwa, lane); }
        while (itA < I_ALL) {
            if (itB < I_ALL) { WCONV_ITEM(itB, Wb, lwb, db, ltb, sb); tb_load(vb, Wb, lwb, lane); }
            tb_store8(va, da, lta, sa, scr, lane);
            itA = itB + NGW;
            if (itB >= I_ALL) break;
            if (itA < I_ALL) { WCONV_ITEM(itA, Wa, lwa, da, lta, sa); tb_load(va, Wa, lwa, lane); }
            tb_store8(vb, db, ltb, sb, scr, lane);
            itB = itA + NGW;
        }
#undef WCONV_ITEM
        __syncthreads();
    }
    if constexpr (ST == ST_PROJ) {
        pg8::Gemm g{WSB(WS_HB), WSB(WS_WIN_T) + (size_t)l * DINP * DM, T, DINP, DM, DM};
        pg8::StaticOrder S; S.init(T, DINP, G, bid);
        EpiProj E{WSB(WS_PROJB), B_GATE(l)};
        pg8::gemm_phase<EpiProj, pg8::StaticOrder, true, true>((PG8_LAS unsigned char*)lds, g, S, E);
    }
    if constexpr (ST == ST_PREP) {
        const bf16_t* projb = WSB(WS_PROJB); bf16_t* br = WSB(WS_BR); bf16_t* U = (bf16_t*)lds;
        float* rq = WSF(WS_RQ); float* rkv = rq + T; const float* rc = WSF(WS_ROPE); const float* rs = rc + T * 16; bf16_t* kb = WSB(WS_KB);
        for (int tile = bid; tile < T / 64; tile += G) {
            const int b = tile / (SEQ / 64), s0 = (tile % (SEQ / 64)) * 64, t0 = b * SEQ + s0;
            __syncthreads();
#pragma unroll
            for (int it = 0; it < 10; ++it) { const int e = tid + it * NTHR, r = e >> 6, ch = e & 63, s = s0 - 8 + r;
                uint4 v = make_uint4(0u, 0u, 0u, 0u);
                if (s >= 0 && s < SEQ) v = *(const uint4*)(projb + (size_t)(b * SEQ + s) * DINP + OFF_POOL + ch * 8);
                *(uint4*)(U + r * 512 + ch * 8) = v; }
            for (int r = wid; r < 64; r += 8) { const bf16_t* row = projb + (size_t)(t0 + r) * DINP;
                float s1 = 0.f, s2 = 0.f;
                if (lane < 48) { const uint4 w = *(const uint4*)(row + OFF_CQ + lane * 8); const unsigned ww[4] = {w.x, w.y, w.z, w.w};
#pragma unroll
                    for (int q = 0; q < 4; ++q) { const float a = __uint_as_float(ww[q] << 16), c = __uint_as_float(ww[q] & 0xffff0000u); s1 += a * a + c * c; } }
                if (lane < 32) { const uint4 w = *(const uint4*)(row + OFF_CKV + lane * 8); const unsigned ww[4] = {w.x, w.y, w.z, w.w};
#pragma unroll
                    for (int q = 0; q < 4; ++q) { const float a = __uint_as_float(ww[q] << 16), c = __uint_as_float(ww[q] & 0xffff0000u); s2 += a * a + c * c; } }
                s1 = wave_sum(s1); s2 = wave_sum(s2);
                if (lane == 0) { rq[t0 + r] = 1.f / sqrtf(s1 * (1.f / 384.f) + RMS_EPS); rkv[t0 + r] = 1.f / sqrtf(s2 * (1.f / 256.f) + RMS_EPS); } }
#pragma unroll
            for (int it = 0; it < 2; ++it) { const int e = tid + it * NTHR, r = e >> 4, j = e & 15, t = t0 + r;
                const float c = rc[(size_t)t * 16 + j], s = rs[(size_t)t * 16 + j], x1 = PJ(t, OFF_KR + j), x2 = PJ(t, OFF_KR + 16 + j);
                const bf16_t k1 = (bf16_t)f2bf(x1 * c - x2 * s), k2 = (bf16_t)f2bf(x1 * s + x2 * c);
#pragma unroll
                for (int hh = 0; hh < 8; ++hh) { kb[(size_t)t * 768 + hh * 96 + 64 + j] = k1; kb[(size_t)t * 768 + hh * 96 + 80 + j] = k2; } }
            __syncthreads();
            { const int c = tid, hw = 1 << (c >> 7); float sum = 0.f;
                for (int u = s0 - hw; u < s0 + hw; ++u) if (u >= 0 && u < SEQ) sum += bf2f(U[(u - s0 + 8) * 512 + c]);
                for (int s = s0; s < s0 + 64; ++s) {
                    int lo = s - hw; if (lo < 0) lo = 0; int hi = s + hw; if (hi > SEQ) hi = SEQ;
                    br[(size_t)(b * SEQ + s) * 1536 + c] = (bf16_t)f2bf(sum / (float)(hi - lo) - bf2f(U[(s - s0 + 8) * 512 + c]));
                    if (s + hw < SEQ) sum += bf2f(U[(s + hw - s0 + 8) * 512 + c]);
                    if (s - hw >= 0) sum -= bf2f(U[(s - hw - s0 + 8) * 512 + c]);
                } }
        }
        __syncthreads();
    }
    if constexpr (ST == ST_SMALLGEMM) {
        const bf16_t* wsm = WSB(WS_WSMALL + (size_t)l * WSM_STRIDE);
        { pg8::Gemm g{WSB(WS_PROJB) + OFF_CQ, wsm + WSM_UQ / 2, T, 768, 384, DINP}; pg8::StaticOrder S; S.init(T, 768, G, bid);
          EpiQ E{WSB(WS_QB), WSF(WS_RQ), WSF(WS_ROPE), WSF(WS_ROPE) + T * 16}; pg8::gemm_phase<EpiQ, pg8::StaticOrder, true, true>((PG8_LAS unsigned char*)lds, g, S, E); }
        { pg8::Gemm g{WSB(WS_PROJB) + OFF_CKV, wsm + WSM_UKV / 2, T, 1024, 256, DINP}; pg8::StaticOrder S; S.init(T, 1024, G, bid);
          EpiKV E{WSB(WS_KB), WSB(WS_VB), WSF(WS_RQ) + T}; pg8::gemm_phase<EpiKV, pg8::StaticOrder, true, true>((PG8_LAS unsigned char*)lds, g, S, E); }
    }
    if constexpr (ST == ST_ATTN) {
        const int vcu = (G % 8 == 0) ? (bid % 8) * (G / 8) + bid / 8 : bid;
        WStream wst; wst.gate = EW_GATE(l); wst.up = EW_UP(l); wst.down = EW_DOWN(l); wst.wgu_t = p.ws + WS_WGU_T; wst.wd_t = p.ws + WS_WD_T;
        { const int wu = __builtin_amdgcn_readfirstlane(wid); wst.init(bid * 8 + wu, NGW, (char*)lds + att::SHM_ATTN + wu * 2560, lane); }
        for (int L = vcu; L < NB * 8 * 32; L += G) {
            const int bh = L >> 5, qb = L & 31, b = bh >> 3, hh = bh & 7;
            att::attn_unit(WSB(WS_QB) + (size_t)(b * SEQ + qb * 256) * 768 + hh * 96, WSB(WS_KB) + (size_t)(b * SEQ) * 768 + hh * 96, WSB(WS_VB) + (size_t)(b * SEQ) * 512 + hh * 64,
                           WSB(WS_BR) + (size_t)(b * SEQ + qb * 256) * 1536 + 512 + hh * 64, SEQ, (char*)lds, wst);
        }
        while (wst.step <= wst.nsteps) wst.tick(lane);
    }
    if constexpr (ST == ST_GLA1) {
        for (int item = bid; item < NB * 4 * 128; item += G) {
            const int b = item >> 9, hh = (item >> 7) & 3, c = item & 127;
            gla::g1_item((char*)lds, WSB(WS_PROJB), W_DEC(l), B_DEC(l), b, hh, c, WSF(WS_KVT), WSF(WS_DEC));
        }
    }
    if constexpr (ST == ST_GLA2) {
        const float* kvt = WSF(WS_KVT); const float* dec = WSF(WS_DEC); bf16_t* stp = WSB(WS_ST);
        for (long e = gt; e < 2L * 8 * 8192; e += NGT) {
            const int dir = (int)(e >> 16), bh = (int)((e >> 13) & 7), vd = (int)(e & 8191), d = vd & 63;
            const long base = ((long)dir * 8 + bh) * 128;
            float s = 0.f;
#pragma unroll 1
            for (int k0 = 0; k0 < 128; k0 += 32) {
                float kv[32], dc[32];
#pragma unroll
                for (int k = 0; k < 32; ++k) { const int c = dir ? 127 - (k0 + k) : k0 + k; kv[k] = kvt[(base + c) * 8192 + vd]; dc[k] = dec[(base + c) * 64 + d]; }
#pragma unroll
                for (int k = 0; k < 32; ++k) { const int c = dir ? 127 - (k0 + k) : k0 + k; stp[(base + c) * 8192 + vd] = (bf16_t)f2bf(s); s = fmaf(dc[k], s, kv[k]); }
            }
        }
    }
    if constexpr (ST == ST_GLA3) {
        for (int item = bid; item < NB * 4 * 128; item += G) {
            const int b = item >> 9, hh = (item >> 7) & 3, c = item & 127;
            gla::g3_item((char*)lds, WSB(WS_PROJB), W_DEC(l), B_DEC(l), GLA_NORM(l), b, hh, c, WSB(WS_ST), WSB(WS_BR) + 1024, 1536);
        }
    }
    if constexpr (ST == ST_MERGE_A) {
        const bf16_t* wsm = WSB(WS_WSMALL + (size_t)l * WSM_STRIDE);
        pg8::Gemm g{WSB(WS_BR), wsm + WSM_MRG / 2, T, DM, 1536, 1536}; pg8::StaticOrder S; S.init(T, DM, G, bid);
        EpiMerge E{WSB(WS_MERGEDB), WSB(WS_PROJB) + OFF_GATE};
        pg8::gemm_phase<EpiMerge, pg8::StaticOrder, true, true>((PG8_LAS unsigned char*)lds, g, S, E);
    }
    if constexpr (ST == ST_OUTP) {
        const bf16_t* wsm = WSB(WS_WSMALL + (size_t)l * WSM_STRIDE);
        pg8::Gemm g{WSB(WS_MERGEDB), wsm + WSM_OUT / 2, T, DM, DM, DM}; pg8::StaticOrder S; S.init(T, DM, G, bid);
        pg8::EpiBf16<0> E{WSB(WS_TMP), DM, nullptr, 0, 0, 1.f};
        pg8::gemm_phase<pg8::EpiBf16<0>, pg8::StaticOrder, true, true>((PG8_LAS unsigned char*)lds, g, S, E);
    }
    if constexpr (ST == ST_LN1) {
        float* RWT = lds; const float* rw = ROUTER(l);
        for (int i = tid; i < DM * 4; i += NTHR) { const int k = i >> 2, e4 = (i & 3) * 4; const float4 w = *(const float4*)(rw + (size_t)k * 16 + e4);
            RWT[(e4 + 0) * DM + k] = w.x; RWT[(e4 + 1) * DM + k] = w.y; RWT[(e4 + 2) * DM + k] = w.z; RWT[(e4 + 3) * DM + k] = w.w; }
        __syncthreads();
        float* afft = WSF(WS_AFF);
        for (int m0 = gw; m0 < T; m0 += 2 * NGW) {
            const int mr[2] = {m0, m0 + NGW};
            float4 hv[2][4];
#pragma unroll
            for (int u = 0; u < 2; ++u) { const bf16_t* hr = WSB(WS_HB) + (size_t)mr[u] * DM; const bf16_t* tr = WSB(WS_TMP) + (size_t)mr[u] * DM;
#pragma unroll
                for (int j = 0; j < 4; ++j) { float a[4], t4[4]; ld4bf(hr + 4 * (lane + 64 * j), a); ld4bf(tr + 4 * (lane + 64 * j), t4);
                    hv[u][j] = make_float4(fmaf(ALPHA, a[0], t4[0]), fmaf(ALPHA, a[1], t4[1]), fmaf(ALPHA, a[2], t4[2]), fmaf(ALPHA, a[3], t4[3])); } }
            ln_core2<1>(hv, LN1_G(l), LN1_B(l), nullptr, nullptr, WSB(WS_HB) + (size_t)mr[0] * DM, WSB(WS_HB) + (size_t)mr[1] * DM, lane,
                     p.ws + WS_HB8 + (size_t)mr[0] * DM, p.ws + WS_HB8 + (size_t)mr[1] * DM);
            float acc[2][16];
#pragma unroll
            for (int e = 0; e < 16; ++e) { float a0 = 0.f, a1 = 0.f;
#pragma unroll
                for (int j = 0; j < 4; ++j) { const float4 w = *(const float4*)(RWT + e * DM + 4 * (lane + 64 * j));
                    a0 = fmaf(hv[0][j].x, w.x, a0); a0 = fmaf(hv[0][j].y, w.y, a0); a0 = fmaf(hv[0][j].z, w.z, a0); a0 = fmaf(hv[0][j].w, w.w, a0);
                    a1 = fmaf(hv[1][j].x, w.x, a1); a1 = fmaf(hv[1][j].y, w.y, a1); a1 = fmaf(hv[1][j].z, w.z, a1); a1 = fmaf(hv[1][j].w, w.w, a1); }
                acc[0][e] = a0; acc[1][e] = a1; if (e & 1) __builtin_amdgcn_sched_barrier(0); }
#pragma unroll
            for (int i = 0; i < 8; ++i)
#pragma unroll
                for (int u = 0; u < 2; ++u) { const bool up = lane & 32; const float keep = up ? acc[u][i + 8] : acc[u][i], send = up ? acc[u][i] : acc[u][i + 8]; acc[u][i] = keep + __shfl_xor(send, 32); }
#pragma unroll
            for (int i = 0; i < 4; ++i)
#pragma unroll
                for (int u = 0; u < 2; ++u) { const bool up = lane & 16; const float keep = up ? acc[u][i + 4] : acc[u][i], send = up ? acc[u][i] : acc[u][i + 4]; acc[u][i] = keep + __shfl_xor(send, 16); }
#pragma unroll
            for (int i = 0; i < 2; ++i)
#pragma unroll
                for (int u = 0; u < 2; ++u) { const bool up = lane & 8; const float keep = up ? acc[u][i + 2] : acc[u][i], send = up ? acc[u][i] : acc[u][i + 2]; acc[u][i] = keep + __shfl_xor(send, 8); }
#pragma unroll
            for (int u = 0; u < 2; ++u) { const bool up = lane & 4; const float keep = up ? acc[u][1] : acc[u][0], send = up ? acc[u][0] : acc[u][1]; acc[u][0] = keep + __shfl_xor(send, 4); }
            float lg[2] = {acc[0][0], acc[1][0]};
#pragma unroll
            for (int o = 1; o <= 2; o <<= 1) { const float t0 = __shfl_xor(lg[0], o), t1 = __shfl_xor(lg[1], o); lg[0] += t0; lg[1] += t1; }
            float mx[2] = {lg[0], lg[1]};
#pragma unroll
            for (int o = 4; o <= 32; o <<= 1) { const float t0 = __shfl_xor(mx[0], o), t1 = __shfl_xor(mx[1], o); mx[0] = fmaxf(mx[0], t0); mx[1] = fmaxf(mx[1], t1); }
            const float ex[2] = {expf(lg[0] - mx[0]), expf(lg[1] - mx[1])}; float se[2] = {ex[0], ex[1]};
#pragma unroll
            for (int o = 4; o <= 32; o <<= 1) { const float t0 = __shfl_xor(se[0], o), t1 = __shfl_xor(se[1], o); se[0] += t0; se[1] += t1; }
            if ((lane & 3) == 0) { const int e = ((lane >> 5) & 1) * 8 + ((lane >> 4) & 1) * 4 + ((lane >> 3) & 1) * 2 + ((lane >> 2) & 1);
#pragma unroll
                for (int u = 0; u < 2; ++u) afft[(size_t)((mr[u] / SEQ) * 16 + e) * SEQ + (mr[u] % SEQ)] = ex[u] / se[u]; }
        }
        __syncthreads();
    }
    if constexpr (ST == ST_TOPK) {
        const float* afft = WSF(WS_AFF); int* idx = WSI(WS_IDX); float* gv = WSF(WS_GATEV); int* slot = WSI(WS_SLOT);
        int* hist = (int*)lds; int* ctl = hist + 256; int* scr = hist + 272;
        for (int z = bid; z < NZ; z += G) {
            const int e = z >> 1, b = z & 1; const float* list = afft + (size_t)(b * 16 + e) * SEQ;
            unsigned key[16];
#pragma unroll
            for (int j = 0; j < 16; j += 4) { const float4 x = *(const float4*)(list + tid * 16 + j); key[j] = __float_as_uint(x.x); key[j + 1] = __float_as_uint(x.y); key[j + 2] = __float_as_uint(x.z); key[j + 3] = __float_as_uint(x.w); }
            unsigned prefix = 0u; int need = CAP;
#pragma unroll 1
            for (int shift = 24; shift >= 0; shift -= 8) {
                __syncthreads();
                if (tid < 256) hist[tid] = 0;
                __syncthreads();
#pragma unroll
                for (int j = 0; j < 16; ++j) { const bool in = (shift == 24) || ((key[j] >> (shift + 8)) == (prefix >> (shift + 8))); if (in) atomicAdd(&hist[(key[j] >> shift) & 255u], 1); }
                __syncthreads();
                if (tid < 256) {
                    const int hc = hist[tid]; int inc = hc;
#pragma unroll
                    for (int o = 1; o < 64; o <<= 1) { const int y = __shfl_down(inc, o); if (lane + o < 64) inc += y; }
                    if (lane == 0) scr[wid] = inc;
                    __builtin_amdgcn_s_waitcnt(0xc07f); __builtin_amdgcn_wave_barrier();
                }
                __syncthreads();
                if (tid < 256) {
                    const int hc = hist[tid]; int inc = hc;
#pragma unroll
                    for (int o = 1; o < 64; o <<= 1) { const int y = __shfl_down(inc, o); if (lane + o < 64) inc += y; }
                    int ca = inc - hc;
#pragma unroll
                    for (int w = 1; w < 4; ++w) ca += (w > wid) ? scr[w] : 0;
                    if (ca < need && need <= ca + hc) { ctl[0] = tid; ctl[1] = need - ca; } }
                __syncthreads();
                prefix |= (unsigned)ctl[0] << shift; need = ctl[1];
            }
            int ceq = 0;
#pragma unroll
            for (int j = 0; j < 16; ++j) ceq += (key[j] == prefix) ? 1 : 0;
            int tot; const int beq = block_excl_scan(ceq, scr, tid, tot);
            int csel = 0, eqr = beq; unsigned selmask = 0u;
#pragma unroll
            for (int j = 0; j < 16; ++j) { bool sel = key[j] > prefix; if (key[j] == prefix) { sel = eqr < need; ++eqr; } if (sel) { selmask |= 1u << j; ++csel; } }
            int sl = block_excl_scan(csel, scr, tid, tot);
#pragma unroll
            for (int j = 0; j < 16; ++j) { const int trow = b * SEQ + tid * 16 + j;
                if ((selmask >> j) & 1u) { idx[z * CAP + sl] = trow; gv[z * CAP + sl] = __uint_as_float(key[j]); slot[(size_t)trow * 16 + e] = sl; ++sl; }
                else slot[(size_t)trow * 16 + e] = -1; }
        }
        __syncthreads();
    }
    if constexpr (ST == ST_GATHER) {
        const int* idx = WSI(WS_IDX); const bf16_t* hb = WSB(WS_HB); bf16_t* xe = WSB(WS_XE);
        const int nr = (NZ * CAP - gw + NGW - 1) / NGW; const int myi = (lane < nr) ? (idx[gw + lane * NGW] & (T - 1)) : 0;
        for (int k = 0; k < nr; k += 4) {
            const int k1 = (k + 1 < nr) ? k + 1 : k, k2 = (k + 2 < nr) ? k + 2 : k, k3 = (k + 3 < nr) ? k + 3 : k;
            const uint4* s0 = (const uint4*)(hb + (size_t)__shfl(myi, k) * DM); const uint4* s1 = (const uint4*)(hb + (size_t)__shfl(myi, k1) * DM);
            const uint4* s2 = (const uint4*)(hb + (size_t)__shfl(myi, k2) * DM); const uint4* s3 = (const uint4*)(hb + (size_t)__shfl(myi, k3) * DM);
            const uint4 x0 = s0[lane], y0 = s0[lane + 64], x1 = s1[lane], y1 = s1[lane + 64], x2 = s2[lane], y2 = s2[lane + 64], x3 = s3[lane], y3 = s3[lane + 64];
            { uint4* d = (uint4*)(xe + (size_t)(gw + k * NGW) * DM); d[lane] = x0; d[lane + 64] = y0; }
            if (k + 1 < nr) { uint4* d = (uint4*)(xe + (size_t)(gw + (k + 1) * NGW) * DM); d[lane] = x1; d[lane + 64] = y1; }
            if (k + 2 < nr) { uint4* d = (uint4*)(xe + (size_t)(gw + (k + 2) * NGW) * DM); d[lane] = x2; d[lane + 64] = y2; }
            if (k + 3 < nr) { uint4* d = (uint4*)(xe + (size_t)(gw + (k + 3) * NGW) * DM); d[lane] = x3; d[lane + 64] = y3; }
        }
    }
    if constexpr (ST == ST_EXP_G) {
        pg8::Gemm g{WSB(WS_HB8), WSB(WS_WGU_T), NZ * CAP, 16 * 4096, DM / 2, DM / 2, WSI(WS_IDX)};
        ExpertOrder1 S; S.init(G, bid);
        EpiSwiGLU E{WSB(WS_HID), DEXP};
        pg8::gemm_phase<EpiSwiGLU, ExpertOrder1, true, true, true, true>((PG8_LAS unsigned char*)lds, g, S, E);
    }
    if constexpr (ST == ST_EXP_D) {
        pg8::Gemm g{WSB(WS_HID), WSB(WS_WD_T), NZ * CAP, 16 * 1024, DEXP / 2, DEXP / 2};
        ExpertOrder2 S; S.init(G, bid);
        EpiRowScale E{WSB(WS_YE), DM, WSF(WS_GATEV)};
        pg8::gemm_phase<EpiRowScale, ExpertOrder2, true, true, false, true>((PG8_LAS unsigned char*)lds, g, S, E);
    }
    if constexpr (ST == ST_LN2) {
        const int* slot = WSI(WS_SLOT); const bf16_t* ye = WSB(WS_YE);
        for (int m0 = gw; m0 < T; m0 += 2 * NGW) {
            const int mr[2] = {m0, m0 + NGW};
            int sl[2]; unsigned long long mask[2]; float4 a[2][4];
#pragma unroll
            for (int u = 0; u < 2; ++u) { sl[u] = (lane < 16) ? slot[(size_t)mr[u] * 16 + lane] : -1; }
#pragma unroll
            for (int u = 0; u < 2; ++u) { const bf16_t* hr = WSB(WS_HB) + (size_t)mr[u] * DM;
#pragma unroll
                for (int j = 0; j < 4; ++j) { float x[4]; ld4bf(hr + 4 * (lane + 64 * j), x); a[u][j] = make_float4(ALPHA * x[0], ALPHA * x[1], ALPHA * x[2], ALPHA * x[3]); } }
            mask[0] = __ballot(sl[0] >= 0); mask[1] = __ballot(sl[1] >= 0);
            while (mask[0] | mask[1]) {
#pragma unroll
                for (int u = 0; u < 2; ++u) if (mask[u]) {
                    const int e = __builtin_ctzll(mask[u]); mask[u] &= mask[u] - 1;
                    const bf16_t* yr = ye + ((size_t)(e * 2 + mr[u] / SEQ) * CAP + __shfl(sl[u], e)) * DM;
#pragma unroll
                    for (int j = 0; j < 4; ++j) { float y[4]; ld4bf(yr + 4 * (lane + 64 * j), y); a[u][j].x += y[0]; a[u][j].y += y[1]; a[u][j].z += y[2]; a[u][j].w += y[3]; }
                }
            }
            if (l == 0) ln_core2<0>(a, LN2_G(l), LN2_B(l), nullptr, nullptr, WSB(WS_HB) + (size_t)mr[0] * DM, WSB(WS_HB) + (size_t)mr[1] * DM, lane);
            else ln_core2<2>(a, LN2_G(l), LN2_B(l), h + (size_t)mr[0] * DM, h + (size_t)mr[1] * DM, nullptr, nullptr, lane);
        }
    }
}


#define LAS __attribute__((address_space(3)))
#define XB_TMO      128
#define XB_XCNT(j)  (256  + 64 * (j))
#define XB_XSUB(j)  (1280 + 64 * (j))
#define XB_XGEN(j)  (2304 + 64 * (j))
#define XB_TOP      3328
#define XB_TOPGEN   3392
#define XCD_BAR_WORDS 3456
#define XB_SPIN_CAP (1u << 18)
__device__ __forceinline__ unsigned xb_ld(unsigned* p)              { return __hip_atomic_load(p, __ATOMIC_RELAXED, __HIP_MEMORY_SCOPE_AGENT); }
__device__ __forceinline__ unsigned xb_add(unsigned* p, unsigned v) { return __hip_atomic_fetch_add(p, v, __ATOMIC_RELAXED, __HIP_MEMORY_SCOPE_AGENT); }
__device__ __forceinline__ unsigned xb_xcc_id() { return (unsigned)__builtin_amdgcn_s_getreg((3 << 11) | 20) & 0xFu; }
#define XB_SPIN(cond, bar) do { unsigned _sp = 0; while (cond) { __builtin_amdgcn_s_sleep(1); \
    if ((++_sp & 255u) == 0u) { if (xb_ld(&(bar)[XB_TMO])) break; if (_sp > XB_SPIN_CAP) { atomicAdd(&(bar)[XB_TMO], 1u); break; } } } } while (0)
struct XcdBarrier { unsigned* bar; unsigned x; volatile LAS unsigned* st; };
__device__ __forceinline__ XcdBarrier xcd_barrier_post(unsigned* bar, volatile LAS unsigned* st) {
    XcdBarrier b; b.bar = bar; b.x = xb_xcc_id(); b.st = st;
    if (threadIdx.x == 0) (void)xb_add(&bar[XB_XCNT(b.x)], 1u);
    return b;
}
__device__ __forceinline__ void xcd_barrier_complete(unsigned* bar, unsigned x, unsigned& nloc, unsigned& nx) {
    const unsigned G = gridDim.x * gridDim.y * gridDim.z;
    unsigned sum, cnt, mine, sp = 0u;
    for (;;) {
        sum = 0u; cnt = 0u; mine = 0u;
#pragma unroll
        for (unsigned j = 0; j < 16; ++j) { const unsigned c = xb_ld(&bar[XB_XCNT(j)]); sum += c; cnt += (c > 0u) ? 1u : 0u; mine = (j == x) ? c : mine; }
        if (sum == G) break;
        __builtin_amdgcn_s_sleep(1);
        if ((++sp & 255u) == 0u) { if (xb_ld(&bar[XB_TMO])) break; if (sp > XB_SPIN_CAP) { atomicAdd(&bar[XB_TMO], 1u); break; } }
    }
    nloc = mine > 0u ? mine : 1u; nx = cnt > 0u ? cnt : 1u;
}
__device__ __forceinline__ void xcd_barrier(const XcdBarrier& b) {
    asm volatile("s_waitcnt vmcnt(0)" ::: "memory");
    __syncthreads();
    if (threadIdx.x == 0) {
        unsigned* bar = b.bar; asm volatile("" : "+s"(bar));
        unsigned bx = b.x; asm volatile("" : "+s"(bx));
        __builtin_amdgcn_s_waitcnt(0);
        unsigned nloc = b.st[0], nx = b.st[1];
        if (nloc == 0u) { xcd_barrier_complete(bar, bx, nloc, nx); b.st[0] = nloc; b.st[1] = nx; }
        const unsigned old = xb_add(&bar[XB_XSUB(bx)], 1u);
        const unsigned gen = old / nloc;
        if (old + 1u == (gen + 1u) * nloc) {
            __builtin_amdgcn_fence(__ATOMIC_RELEASE, "agent");
            asm volatile("s_waitcnt vmcnt(0)" ::: "memory");
            const unsigned og = xb_add(&bar[XB_TOP], 1u);
            const unsigned tg = og / nx;
            if (og + 1u == (tg + 1u) * nx) xb_add(&bar[XB_TOPGEN], 1u);
            else XB_SPIN(xb_ld(&bar[XB_TOPGEN]) == tg, bar);
            __builtin_amdgcn_fence(__ATOMIC_ACQUIRE, "agent");
            xb_add(&bar[XB_XGEN(bx)], 1u);
            asm volatile("s_waitcnt vmcnt(0)" ::: "memory");
        } else {
            XB_SPIN(xb_ld(&bar[XB_XGEN(bx)]) == gen, bar);
            __builtin_amdgcn_fence(__ATOMIC_ACQUIRE, "agent");
            asm volatile("s_waitcnt vmcnt(0)" ::: "memory");
        }
    }
    __syncthreads();
}
constexpr int MISC_OFF = 131072 + 320;
constexpr int CW_BAR = 4096;

__global__ void __launch_bounds__(NTHR) mega_fwd(Params p) {
    extern __shared__ __attribute__((aligned(16))) unsigned char lds_raw[];
    float* lds = (float*)lds_raw;
    volatile LAS unsigned* MISC = (volatile LAS unsigned*)((LAS unsigned char*)lds_raw + MISC_OFF);
    if (threadIdx.x < 32) MISC[threadIdx.x] = 0u;
    __syncthreads();
    unsigned char* ws_ = ((const KAS Params*)__builtin_amdgcn_kernarg_segment_ptr())->ws;
    XcdBarrier bar = xcd_barrier_post((unsigned*)(ws_ + WS_CTL) + CW_BAR, MISC + 8);
#define GB() xcd_barrier(bar)
    run_stage<ST_INIT>(0, lds); GB();
    for (int step = 0; step < 2 * 11; ++step) {
        const int l = step / 11, s = step % 11;
        switch (s) {
        case 0: run_stage<ST_PROJ>(l, lds); break;
        case 1: run_stage<ST_PREP>(l, lds); run_stage<ST_GLA1>(l, lds); break;
        case 2: run_stage<ST_SMALLGEMM>(l, lds); run_stage<ST_GLA2>(l, lds); break;
        case 3: run_stage<ST_ATTN>(l, lds); run_stage<ST_GLA3>(l, lds); break;
        case 4: run_stage<ST_MERGE_A>(l, lds); break;
        case 5: run_stage<ST_OUTP>(l, lds); break;
        case 6: run_stage<ST_LN1>(l, lds); break;
        case 7: run_stage<ST_TOPK>(l, lds); break;
        case 8: run_stage<ST_EXP_G>(l, lds); break;
        case 9: run_stage<ST_EXP_D>(l, lds); break;
        default: run_stage<ST_LN2>(l, lds); break;
        }
        if (step + 1 < 2 * 11) GB();
    }
#undef GB
}

template <int ST>
__global__ void __launch_bounds__(NTHR) k_stage(Params p, int l) {
    extern __shared__ __attribute__((aligned(16))) unsigned char lds_raw[];
    run_stage<ST>(l, (float*)lds_raw);
}

template <int ST> static void launch_stage(const Params& p, int l, int grid, hipStream_t stream) {
    static bool attr = false;
    if (!attr) { (void)hipFuncSetAttribute((const void*)k_stage<ST>, hipFuncAttributeMaxDynamicSharedMemorySize, LDS_BYTES); attr = true; }
    hipLaunchKernelGGL(k_stage<ST>, dim3(grid), dim3(NTHR), LDS_BYTES, stream, p, l);
}

extern "C" void kernel_launch(void* const* d_in, const int* in_sizes, int n_in, void* d_out, int out_size, void* d_ws, size_t ws_size, hipStream_t stream) {
    if (n_in != 27 || out_size != T * DM || ws_size < WS_END) {
        fprintf(stderr, "kernel_launch: unexpected shapes: n_in %d out %d ws %zu (need >= %zu)\n", n_in, out_size, ws_size, (size_t)WS_END);
        return;
    }
    Params p{};
    for (int i = 0; i < 27; ++i) p.in[i] = (const float*)d_in[i];
    p.pos = (const int*)d_in[1]; p.out = (float*)d_out; p.ws = (unsigned char*)d_ws;
    const int grid = 256;
#if MEGA
    static bool attr = false;
    if (!attr) { (void)hipFuncSetAttribute((const void*)mega_fwd, hipFuncAttributeMaxDynamicSharedMemorySize, LDS_BYTES); attr = true; }
    (void)hipMemsetAsync((char*)d_ws + WS_CTL, 0, 65536, stream);
    hipLaunchKernelGGL(mega_fwd, dim3(grid), dim3(NTHR), LDS_BYTES, stream, p);
#else
    launch_stage<ST_INIT>(p, 0, grid, stream);
    for (int l = 0; l < 2; ++l) {
        launch_stage<ST_PROJ>(p, l, grid, stream);
        launch_stage<ST_PREP>(p, l, grid, stream);
        launch_stage<ST_SMALLGEMM>(p, l, grid, stream);
        launch_stage<ST_ROPE>(p, l, grid, stream);
        launch_stage<ST_ATTN>(p, l, grid, stream);
        launch_stage<ST_GLAREC>(p, l, grid, stream);
        launch_stage<ST_GLAFIN>(p, l, grid, stream);
        launch_stage<ST_MERGE_A>(p, l, grid, stream);
        launch_stage<ST_MERGE_B>(p, l, grid, stream);
        launch_stage<ST_MERGE_C>(p, l, grid, stream);
        launch_stage<ST_OUTP>(p, l, grid, stream);
        launch_stage<ST_LN1>(p, l, grid, stream);
        launch_stage<ST_TOPK>(p, l, grid, stream);
        launch_stage<ST_EXP_G>(p, l, grid, stream);
        launch_stage<ST_EXP_U>(p, l, grid, stream);
        launch_stage<ST_EXP_D>(p, l, grid, stream);
        launch_stage<ST_LN2>(p, l, grid, stream);
    }
#endif
}
```

```cpp
#include <hip/hip_runtime.h>
#include <cstdio>
#include <cstdint>

#ifndef MEGA
#define MEGA 1
#endif

constexpr int NB = 2, SEQ = 8192, T = NB * SEQ, DM = 1024, DIN = 5824, DINP = 5888;
constexpr int OFF_GATE = 0, OFF_POOL = 3072, OFF_CQ = 3072 + 512, OFF_CKV = 3072 + 896, OFF_KR = 3072 + 1152, OFF_GQ = 3072 + 1184, OFF_GK = 3072 + 1440, OFF_GV = 3072 + 1696, OFF_GR = 3072 + 2208, OFF_GDEC = 3072 + 2720;
constexpr int NE = 16, CAP = 1024, DEXP = 2048, NZ = NB * NE;
constexpr float ALPHA = 1.4142135623730951f;
constexpr float LN_EPS = 1e-5f, RMS_EPS = 1e-6f;
constexpr int NTHR = 512, LDS_BYTES = 147456;

constexpr size_t MiB = 1u << 20;
constexpr size_t WS_CTL = 0;
constexpr size_t WS_ROPE = 1 * MiB;
constexpr size_t WS_AFF = 3 * MiB;
constexpr size_t WS_SLOT = 4 * MiB;
constexpr size_t WS_IDX = 5 * MiB;
constexpr size_t WS_GATEV = 5 * MiB + 256 * 1024;
constexpr size_t WS_WIN_T = 8 * MiB;
constexpr size_t WS_WSMALL = 31 * MiB;
constexpr size_t WSM_UQ = 0, WSM_UKV = 1 * MiB, WSM_MRG = 2 * MiB, WSM_OUT = 5 * MiB, WSM_STRIDE = 7 * MiB;
constexpr size_t WS_RQ = 6 * MiB;
constexpr size_t WS_HB = 958 * MiB;
constexpr size_t WS_WGU_T = 76 * MiB;
constexpr size_t WS_WD_T = 204 * MiB;
constexpr size_t WS_PROJB = 268 * MiB;
constexpr size_t WS_XE = 268 * MiB;
constexpr size_t WS_HID = 332 * MiB;
constexpr size_t WS_YE = 460 * MiB;
constexpr size_t WS_BR = 452 * MiB;
constexpr size_t WS_HB8 = 500 * MiB;
constexpr size_t WS_QB = 556 * MiB;
constexpr size_t WS_KB = 580 * MiB;
constexpr size_t WS_VB = 604 * MiB;
constexpr size_t WS_KVT = 702 * MiB;
constexpr size_t WS_ST = 766 * MiB;
constexpr size_t WS_DEC = 798 * MiB;
constexpr size_t WS_MERGEDB = 830 * MiB;
constexpr size_t WS_TMP = 894 * MiB;
constexpr size_t WS_END = 990 * MiB;
static_assert(WS_YE + 64 * MiB <= WS_QB, "overlay map");

namespace pg8 {
#define PG8_LAS __attribute__((address_space(3)))
typedef unsigned short bf16_t;
typedef short bf16x8 __attribute__((ext_vector_type(8)));
typedef float f32x4 __attribute__((ext_vector_type(4)));
typedef unsigned u32x4 __attribute__((ext_vector_type(4)));
constexpr int BM = 256, BK = 64, HALF = 128, HTB = HALF * BK * 2  , STAGE_BYTES = 8 * HTB, NXCD = 8, WGM = 8;

__host__ __device__ __forceinline__ int lds_byte(int r, int c) { const int st = (r >> 4) * 2 + (c >> 5), rr = r & 15, cc = c & 31, ob = rr * 64 + cc * 2; return st * 1024 + (ob ^ (((ob >> 9) & 1) << 5)); }
__host__ __device__ __forceinline__ void stage_rc(int b, int& R, int& C) { const int st = b / 1024, sb = b % 1024, swz = sb ^ (((sb >> 9) & 1) << 5); R = (st >> 1) * 16 + swz / 64; C = (st & 1) * 32 + (swz % 64) / 2; }
__host__ __device__ __forceinline__ int perm32(int rho) { const int n = rho >> 4, i = rho & 15; return 8 * (i >> 2) + 4 * n + (i & 3); }

struct Unit { int pm, pn; };
struct Gemm { const bf16_t* A; const bf16_t* Bt; int M, N, K, lda; const int* ridx; };

struct StaticOrder {
    int nM, nN, nwg, G, c;
    __host__ __device__ void init(int M, int N, int G_, int c_) { nM = M / BM; nN = N / BM; nwg = nM * nN; G = G_; c = c_; }
    __host__ __device__ bool next(int i, Unit& u) const {
        const long L = (long)i * G + c; if (L >= nwg) return false;
        int wgid = (int)L; { const int q = nwg / NXCD, r = nwg % NXCD, xcd = wgid % NXCD, off = wgid / NXCD; wgid = (xcd < r ? xcd * (q + 1) : r * (q + 1) + (xcd - r) * q) + off; }
        const int nig = WGM * nN, gid = wgid / nig, fm = gid * WGM, gsz = (nM - fm) < WGM ? (nM - fm) : WGM;
        u.pm = fm + ((wgid % nig) % gsz); u.pn = (wgid % nig) / gsz; return true;
    }
    __device__ __forceinline__ void a_ready(const Unit&) const {}
    __device__ __forceinline__ void done(const Unit&) const {}
};

__device__ __forceinline__ unsigned cvt_pk_bf16(float lo, float hi) { unsigned r; asm volatile("v_cvt_pk_bf16_f32 %0, %1, %2" : "=v"(r) : "v"(lo), "v"(hi)); return r; }
typedef float f32x2 __attribute__((ext_vector_type(2)));
__device__ __forceinline__ f32x2 gelu_pk(f32x2 v) {
    const f32x2 av = __builtin_elementwise_abs(v), d = av * 0.2316418882f + 1.0f;
    f32x2 t; t.x = __builtin_amdgcn_rcpf(d.x); t.y = __builtin_amdgcn_rcpf(d.y);
    f32x2 q = t * 0.5307027145f + (-0.7265760135f); q = q * t + 0.7107068705f; q = q * t + (-0.142248368f); q = q * t + 0.127414796f; q = q * t;
    const f32x2 s = (v * v) * (-0.72134752044f);
    f32x2 e; e.x = __builtin_amdgcn_exp2f(s.x); e.y = __builtin_amdgcn_exp2f(s.y);
    const f32x2 m = v * (q * e), r = v - m;
    f32x2 o; o.x = v.x < 0.f ? m.x : r.x; o.y = v.y < 0.f ? m.y : r.y; return o;
}

template <int ACT  > struct EpiBf16 {
    static constexpr bool PERM = true, AFTER_DRAIN = false; static constexpr int SEG = 0; static_assert(ACT == 0 || ACT == 1, "EpiBf16: ACT is 0 (none) or 1 (gelu_pk)");
    bf16_t* O; int ldc; const float* bias; int split_cols; size_t split_stride; float scale0;
    __device__ __forceinline__ void operator()(const f32x4 (&acc)[2][2][4][2], const Unit& u, int wr, int wc, int fr, int fq) const {
        const int row0 = u.pm * BM + wr * 64 + fr; int colt = u.pn * BM; bf16_t* base = O;
        float sc = 1.f; if (split_cols) { const int t = colt / split_cols; base += (size_t)t * split_stride; colt -= t * split_cols; if (t == 0) sc = scale0; }
        const int col0 = colt + wc * 32 + 8 * fq, bcol0 = u.pn * BM + wc * 32 + 8 * fq;
        f32x4 bv[2][2];
#pragma unroll
        for (int bj = 0; bj < 2; ++bj)
#pragma unroll
            for (int n = 0; n < 2; ++n) bv[bj][n] = bias ? *(const f32x4*)(bias + bcol0 + bj * HALF + 4 * n) : (f32x4){0.f, 0.f, 0.f, 0.f};
#pragma unroll
        for (int ai = 0; ai < 2; ++ai)
#pragma unroll
            for (int m = 0; m < 4; ++m) { bf16_t* rowp = base + (size_t)(row0 + ai * HALF + m * 16) * ldc + col0;
#pragma unroll
                for (int bj = 0; bj < 2; ++bj) { f32x4 v0 = acc[ai][bj][m][0] + bv[bj][0], v1 = acc[ai][bj][m][1] + bv[bj][1];
                    if (ACT == 1) { f32x2 a = gelu_pk((f32x2){v0[0], v0[1]}), b = gelu_pk((f32x2){v0[2], v0[3]}), c = gelu_pk((f32x2){v1[0], v1[1]}), d = gelu_pk((f32x2){v1[2], v1[3]});
                        v0 = (f32x4){a.x, a.y, b.x, b.y}; v1 = (f32x4){c.x, c.y, d.x, d.y}; }
                    v0 = v0 * sc; v1 = v1 * sc; u32x4 w; w.x = cvt_pk_bf16(v0[0], v0[1]); w.y = cvt_pk_bf16(v0[2], v0[3]); w.z = cvt_pk_bf16(v1[0], v1[1]); w.w = cvt_pk_bf16(v1[2], v1[3]);
                    *(u32x4*)(rowp + bj * HALF) = w; } }
    }
};

struct PanelStats {
    unsigned* xbuf;
    unsigned* cnt;
    unsigned* tmo;
    int ntn; float eps;
    unsigned code;
    __device__ __forceinline__ bool run(const f32x4 (&v)[2][2][4][2], const Unit& u, int wr, int wc, int fr, int fq, PG8_LAS unsigned char* lds, int wid, int lane) const {
        typedef float f32x2v __attribute__((ext_vector_type(2)));
        PG8_LAS f32x2v* P = (PG8_LAS f32x2v*)lds;
        PG8_LAS f32x2v* S = (PG8_LAS f32x2v*)(lds + 8192);
        PG8_LAS unsigned* flag = (PG8_LAS unsigned*)(lds + 8192 + 2048);
#pragma unroll
        for (int ai = 0; ai < 2; ++ai)
#pragma unroll
            for (int m = 0; m < 4; ++m) {
                float s = 0.f;
#pragma unroll
                for (int bj = 0; bj < 2; ++bj)
#pragma unroll
                    for (int n = 0; n < 2; ++n) { const f32x4 x = v[ai][bj][m][n]; s += (x[0] + x[1]) + (x[2] + x[3]); }
                s += __shfl_xor(s, 16); s += __shfl_xor(s, 32);
                const float mw = s * (1.0f / 64.0f); float q = 0.f;
#pragma unroll
                for (int bj = 0; bj < 2; ++bj)
#pragma unroll
                    for (int n = 0; n < 2; ++n) { const f32x4 d = v[ai][bj][m][n] - mw; q += (d[0] * d[0] + d[1] * d[1]) + (d[2] * d[2] + d[3] * d[3]); }
                q += __shfl_xor(q, 16); q += __shfl_xor(q, 32);
                if (fq == 0) P[(ai * HALF + wr * 64 + m * 16 + fr) * 4 + wc] = (f32x2v){mw, q};
            }
        asm volatile("s_waitcnt lgkmcnt(0)" ::: "memory"); __builtin_amdgcn_s_barrier(); asm volatile("" ::: "memory");
#if defined(BROKEN_EXCHANGE_NO_WAIT)
#warning BROKEN CONTROL BUILD: the row-statistics exchange does not wait; results are wrong by design
        if (blockIdx.x >= 64) { const long long t0_ = clock64(); while (clock64() - t0_ < 60000) __builtin_amdgcn_s_sleep(8); }
#endif
        const int row = wid * 32 + (lane & 31);
        if (lane < 32) {
            const f32x2v a = P[row * 4 + 0], b = P[row * 4 + 1], c = P[row * 4 + 2], d = P[row * 4 + 3];
            const float mt = (a.x + b.x + c.x + d.x) * 0.25f;
            const float da = a.x - mt, db = b.x - mt, dc = c.x - mt, dd = d.x - mt;
            const float m2 = (a.y + b.y) + (c.y + d.y) + 64.0f * ((da * da + db * db) + (dc * dc + dd * dd));
            unsigned long long* slot = (unsigned long long*)xbuf + ((size_t)(u.pm * BM + row) * 4 + u.pn);
            __hip_atomic_store(slot, ((unsigned long long)__float_as_uint(m2) << 32) | __float_as_uint(mt), __ATOMIC_RELAXED, __HIP_MEMORY_SCOPE_AGENT);
        }
        asm volatile("s_waitcnt vmcnt(0)" ::: "memory");
        if (lane == 0) __hip_atomic_fetch_add(cnt + 64 * u.pm, 1u, __ATOMIC_RELAXED, __HIP_MEMORY_SCOPE_AGENT);
        if (wid == 0) {
            bool dead = false; const unsigned long long t0 = __builtin_amdgcn_s_memrealtime(); const unsigned want = 8u * (unsigned)ntn;
            for (;;) {
#if defined(BROKEN_EXCHANGE_NO_WAIT)
                break;
#endif
                if ((unsigned)__builtin_amdgcn_readfirstlane(__hip_atomic_load(cnt + 64 * u.pm, __ATOMIC_RELAXED, __HIP_MEMORY_SCOPE_AGENT)) >= want) break;
                if (__builtin_amdgcn_s_memrealtime() - t0 > 2000000ull) {
                    if (lane == 0) { unsigned expect = 0u; __hip_atomic_compare_exchange_strong(tmo + 1, &expect, code | (unsigned)(u.pm & 0xff), __ATOMIC_RELAXED, __ATOMIC_RELAXED, __HIP_MEMORY_SCOPE_AGENT);
                                     __hip_atomic_store(tmo, 1u, __ATOMIC_RELAXED, __HIP_MEMORY_SCOPE_AGENT); }
                    dead = true; break; }
                __builtin_amdgcn_s_sleep(2);
            }
            __builtin_amdgcn_fence(__ATOMIC_ACQUIRE, "agent");
            if (lane == 0) flag[0] = dead ? 1u : 0u;
        }
        asm volatile("s_waitcnt vmcnt(0) lgkmcnt(0)" ::: "memory"); __builtin_amdgcn_s_barrier(); asm volatile("" ::: "memory");
        const bool bad = flag[0] != 0u;
        if (lane < 32) {
            const unsigned long long* slot = (const unsigned long long*)xbuf + (size_t)(u.pm * BM + row) * 4; float mt[4], m2[4]; float ms = 0.f;
#pragma unroll
            for (int t = 0; t < 4; ++t) { if (t < ntn) { const unsigned long long w = __hip_atomic_load(slot + t, __ATOMIC_RELAXED, __HIP_MEMORY_SCOPE_AGENT); mt[t] = __uint_as_float((unsigned)w); m2[t] = __uint_as_float((unsigned)(w >> 32)); } else { mt[t] = 0.f; m2[t] = 0.f; } ms += mt[t]; }
            const float mean = ms / (float)ntn; float q = 0.f;
#pragma unroll
            for (int t = 0; t < 4; ++t) if (t < ntn) { const float dm = mt[t] - mean; q += m2[t] + 256.0f * dm * dm; }
            S[row] = (f32x2v){mean, 1.0f / sqrtf(q / (256.0f * (float)ntn) + eps)};
        }
        asm volatile("s_waitcnt lgkmcnt(0)" ::: "memory"); __builtin_amdgcn_s_barrier(); asm volatile("" ::: "memory");
        return bad;
    }
};
struct EpiLnRes {
    static constexpr bool PERM = false, AFTER_DRAIN = true; static constexpr int SEG = 0;
    const float* base; float* out; int ldc; const float* bias; PanelStats st; unsigned poison;
    __device__ __forceinline__ void fused(f32x4 (&acc)[2][2][4][2], const Unit& u, int wr, int wc, int fr, int fq, PG8_LAS unsigned char* lds, int wid, int lane) const {
        typedef float f32x2v __attribute__((ext_vector_type(2)));
        const PG8_LAS f32x2v* S = (const PG8_LAS f32x2v*)(lds + 8192);
        const int col0 = u.pn * BM + wc * 32 + 4 * fq;
#pragma unroll
        for (int bj = 0; bj < 2; ++bj)
#pragma unroll
            for (int n = 0; n < 2; ++n) { const f32x4 bv = bias ? *(const f32x4*)(bias + col0 + bj * HALF + n * 16) : (f32x4){0.f, 0.f, 0.f, 0.f};
#pragma unroll
                for (int ai = 0; ai < 2; ++ai)
#pragma unroll
                    for (int m = 0; m < 4; ++m) acc[ai][bj][m][n] += bv; }
        f32x4 pre[4][2][2];
#pragma unroll
        for (int m = 0; m < 4; ++m) { const size_t off = (size_t)(u.pm * BM + wr * 64 + m * 16 + fr) * ldc + col0;
#pragma unroll
            for (int bj = 0; bj < 2; ++bj)
#pragma unroll
                for (int n = 0; n < 2; ++n) pre[m][bj][n] = *(const f32x4*)(base + off + bj * HALF + n * 16); }
        const bool bad = st.run(acc, u, wr, wc, fr, fq, lds, wid, lane) || poison != 0u;
        const float qnan = __builtin_nanf("");
#pragma unroll
        for (int ai = 0; ai < 2; ++ai)
#pragma unroll
            for (int m = 0; m < 4; ++m) { const int r = ai * HALF + wr * 64 + m * 16 + fr; const f32x2v sr = S[r]; const size_t off = (size_t)(u.pm * BM + r) * ldc + col0;
#pragma unroll
                for (int bj = 0; bj < 2; ++bj)
#pragma unroll
                    for (int n = 0; n < 2; ++n) { const f32x4 bs = ai == 0 ? pre[m][bj][n] : *(const f32x4*)(base + off + bj * HALF + n * 16); f32x4 o = bs + (acc[ai][bj][m][n] - sr.x) * sr.y;
                        if (bad) o = (f32x4){qnan, qnan, qnan, qnan}; *(f32x4*)(out + off + bj * HALF + n * 16) = o; }
                if (m & 1) asm volatile("" ::: "memory"); }
    }
};
struct EpiLnResLn {
    static constexpr bool PERM = false, AFTER_DRAIN = true; static constexpr int SEG = 0;
    const float* base; float* out; bf16_t* xn; int ldc; const float* bias; PanelStats st1, st2; unsigned poison;
    __device__ __forceinline__ void fused(f32x4 (&acc)[2][2][4][2], const Unit& u, int wr, int wc, int fr, int fq, PG8_LAS unsigned char* lds, int wid, int lane) const {
        typedef float f32x2v __attribute__((ext_vector_type(2))); typedef unsigned u32x2v __attribute__((ext_vector_type(2)));
        const PG8_LAS f32x2v* S = (const PG8_LAS f32x2v*)(lds + 8192);
        const int col0 = u.pn * BM + wc * 32 + 4 * fq;
#pragma unroll
        for (int bj = 0; bj < 2; ++bj)
#pragma unroll
            for (int n = 0; n < 2; ++n) { const f32x4 bv = bias ? *(const f32x4*)(bias + col0 + bj * HALF + n * 16) : (f32x4){0.f, 0.f, 0.f, 0.f};
#pragma unroll
                for (int ai = 0; ai < 2; ++ai)
#pragma unroll
                    for (int m = 0; m < 4; ++m) acc[ai][bj][m][n] += bv; }
        bool bad = st1.run(acc, u, wr, wc, fr, fq, lds, wid, lane) || poison != 0u;
        const float qnan = __builtin_nanf("");
#pragma unroll
        for (int ai = 0; ai < 2; ++ai)
#pragma unroll
            for (int m = 0; m < 4; ++m) { const int r = ai * HALF + wr * 64 + m * 16 + fr; const f32x2v sr = S[r]; const size_t off = (size_t)(u.pm * BM + r) * ldc + col0;
#pragma unroll
                for (int bj = 0; bj < 2; ++bj)
#pragma unroll
                    for (int n = 0; n < 2; ++n) { const f32x4 bs = *(const f32x4*)(base + off + bj * HALF + n * 16); acc[ai][bj][m][n] = bs + (acc[ai][bj][m][n] - sr.x) * sr.y; }
                asm volatile("" : "+v"(acc[ai][0][m][0]), "+v"(acc[ai][0][m][1]), "+v"(acc[ai][1][m][0]), "+v"(acc[ai][1][m][1]));
                if (m & 1) asm volatile("" ::: "memory"); }
        const bool bad1 = bad;
        bad = st2.run(acc, u, wr, wc, fr, fq, lds, wid, lane) || bad;
#pragma unroll
        for (int ai = 0; ai < 2; ++ai)
#pragma unroll
            for (int m = 0; m < 4; ++m) { const int r = ai * HALF + wr * 64 + m * 16 + fr; const f32x2v sr = S[r]; const size_t off = (size_t)(u.pm * BM + r) * ldc + col0;
#pragma unroll
                for (int bj = 0; bj < 2; ++bj)
#pragma unroll
                    for (int n = 0; n < 2; ++n) { const f32x4 x1 = acc[ai][bj][m][n]; *(f32x4*)(out + off + bj * HALF + n * 16) = bad1 ? (f32x4){qnan, qnan, qnan, qnan} : x1;
                        const f32x4 o = (x1 - sr.x) * sr.y; u32x2v w; w.x = cvt_pk_bf16(o[0], o[1]); w.y = cvt_pk_bf16(o[2], o[3]);
                        if (bad) { w.x = 0x7fc07fc0u; w.y = 0x7fc07fc0u; } *(u32x2v*)(xn + off + bj * HALF + n * 16) = w; }
                asm volatile("" ::: "memory"); }
    }
};

template <class Epi, class Sched, bool ALIGN_EPI = false, bool SP2 = false, bool GATHER = false, bool FP8 = false>
__device__ __forceinline__ void gemm_phase(PG8_LAS unsigned char* lds, const Gemm g, const Sched& S, const Epi& E) {
    int tid_ = threadIdx.x; asm volatile("" : "+v"(tid_));
    const int tid = tid_, wid = __builtin_amdgcn_readfirstlane(tid >> 6), lane = tid & 63, wr = wid >> 2, wc = wid & 3, fr = lane & 15, fq = lane >> 4;
    int K_ = g.K; asm volatile("" : "+s"(K_));
    const int K = K_, nt = K / BK;
    unsigned voffA[2], voffB[2];
#pragma unroll
    for (int i = 0; i < 2; ++i) { int R, C; stage_rc(tid * 16 + i * 8192, R, C); const int Rb = Epi::PERM ? ((R & ~31) + perm32(R & 31)) : R;
        voffA[i] = (unsigned)(R * g.lda + C) * 2u; voffB[i] = (unsigned)(Rb * K + C) * 2u; }
    const size_t kstep = (size_t)(BK * 2);
    static_assert(!GATHER || SP2, "GATHER is implemented for the SP2 loop");
    const size_t hstepB = (size_t)HALF * K * 2, hstepA = GATHER ? 0 : (size_t)HALF * g.lda * 2;
    const size_t tstepB = 2 * hstepB, tstepA = GATHER ? 0 : 2 * hstepA;
    const unsigned ldsw = (unsigned)wid * 1024u;
    const int aoffk[2] = {lds_byte(wr * 64 + fr, FP8 ? 16 * fq : 8 * fq), lds_byte(wr * 64 + fr, FP8 ? 16 * fq + 8 : 8 * fq + 32)};
    const int boffk[2] = {lds_byte(wc * 32 + fr, FP8 ? 16 * fq : 8 * fq), lds_byte(wc * 32 + fr, FP8 ? 16 * fq + 8 : 8 * fq + 32)};
#define PG8_SA(b, h) (((b) * 2 + (h)) * HTB)
#define PG8_SB(b, h) ((4 + (b) * 2 + (h)) * HTB)
#define PG8_STAGE(bufoff, gbase, voff) do { _Pragma("unroll") for (int _i = 0; _i < 2; ++_i) \
        __builtin_amdgcn_global_load_lds((const unsigned*)((const char*)(gbase) + (voff)[_i]), (PG8_LAS unsigned*)(lds + (bufoff) + ldsw + _i * 8192), 16, 0, 0); } while (0)
    typedef int i32x4_ __attribute__((ext_vector_type(4))); typedef int i32x8_ __attribute__((ext_vector_type(8)));
#define PG8_LD16(off) (*(const PG8_LAS i32x4_*)(lds + (off)))
#define PG8_LDA(dst, b, h) do { _Pragma("unroll") for (int m = 0; m < 4; ++m) { \
        if constexpr (FP8) dst##8[m] = *(const PG8_LAS i32x8_*)(lds + PG8_SA(b, h) + aoffk[0] + m * 2048);     \
        else { _Pragma("unroll") for (int k = 0; k < 2; ++k) dst[m][k] = *(const PG8_LAS bf16x8*)(lds + PG8_SA(b, h) + aoffk[k] + m * 2048); } } } while (0)
#define PG8_LDB(dst, b, h) do { _Pragma("unroll") for (int n = 0; n < 2; ++n) { \
        if constexpr (FP8) dst##8[n] = *(const PG8_LAS i32x8_*)(lds + PG8_SB(b, h) + boffk[0] + n * 2048); \
        else { _Pragma("unroll") for (int k = 0; k < 2; ++k) dst[n][k] = *(const PG8_LAS bf16x8*)(lds + PG8_SB(b, h) + boffk[k] + n * 2048); } } } while (0)
#define PG8_MMA(ai, bj, At, Bt) do { __builtin_amdgcn_s_setprio(1); _Pragma("unroll") for (int m = 0; m < 4; ++m) _Pragma("unroll") for (int n = 0; n < 2; ++n) { \
        if constexpr (FP8) asm volatile("s_nop 1\n\tv_mfma_scale_f32_16x16x128_f8f6f4 %0, %1, %2, %0, %3, %3 op_sel_hi:[0,0,0]" : "+v"(acc[ai][bj][m][n]) : "v"(Bt##8[n]), "v"(At##8[m]), "v"(sc1_));     \
        else { _Pragma("unroll") for (int k = 0; k < 2; ++k) acc[ai][bj][m][n] = __builtin_amdgcn_mfma_f32_16x16x32_bf16(Bt[n][k], At[m][k], acc[ai][bj][m][n], 0, 0, 0); } } \
        __builtin_amdgcn_s_setprio(0); } while (0)
#define PG8_WAIT_V(n) asm volatile("s_waitcnt vmcnt(" #n ")" ::: "memory")
#define PG8_WAIT_L(n) asm volatile("s_waitcnt lgkmcnt(" #n ")" ::: "memory")
#define PG8_BAR __builtin_amdgcn_s_barrier()
#define PG8_SCHED __builtin_amdgcn_sched_barrier(0)
    Unit cur, nxt; int ui = 0;
    if (!S.next(0, cur)) return;
    unsigned vC0[2] = {voffA[0], voffA[1]}, vC1[2] = {voffA[0], voffA[1]}, vN0[2] = {voffA[0], voffA[1]}, vN1[2] = {voffA[0], voffA[1]};
    int gR[2], gC[2];
#pragma unroll
    for (int i = 0; i < 2; ++i) { stage_rc(tid * 16 + i * 8192, gR[i], gC[i]); }
    if constexpr (GATHER) {
#pragma unroll
        for (int i = 0; i < 2; ++i) { vC0[i] = (unsigned)(g.ridx[cur.pm * 256 + gR[i]] * g.lda + gC[i]) * 2u; vC1[i] = (unsigned)(g.ridx[cur.pm * 256 + 128 + gR[i]] * g.lda + gC[i]) * 2u; }
    }
    f32x4 acc[2][2][4][2];
#pragma unroll
    for (int a = 0; a < 2; ++a)
#pragma unroll
        for (int b = 0; b < 2; ++b)
#pragma unroll
            for (int m = 0; m < 4; ++m)
#pragma unroll
                for (int n = 0; n < 2; ++n) acc[a][b][m][n] = (f32x4){0.f, 0.f, 0.f, 0.f};
    const int sc1_ = 0x7f7f7f7f;
    bf16x8 At[4][2], B0[2][2], B1[2][2]; i32x8_ At8[4], B08[2], B18[2];
    const char* cA = (const char*)g.A + (size_t)cur.pm * tstepA; const char* cB = (const char*)g.Bt + (size_t)cur.pn * tstepB;
    S.a_ready(cur);
    if constexpr (SP2) {
        PG8_STAGE(PG8_SB(0, 0), cB, voffB); PG8_STAGE(PG8_SB(0, 1), cB + hstepB, voffB); PG8_STAGE(PG8_SA(0, 0), cA, vC0); PG8_STAGE(PG8_SA(0, 1), cA + hstepA, vC1);
        if (wr == 1) PG8_BAR;
        PG8_WAIT_V(2); PG8_BAR;
        PG8_STAGE(PG8_SB(1, 0), cB + kstep, voffB); PG8_STAGE(PG8_SA(1, 0), cA + kstep, vC0); PG8_STAGE(PG8_SB(1, 1), cB + hstepB + kstep, voffB);
        PG8_WAIT_V(6); PG8_BAR;
    } else {
        PG8_STAGE(PG8_SB(0, 0), cB, voffB); PG8_STAGE(PG8_SA(0, 0), cA, voffA); PG8_STAGE(PG8_SB(0, 1), cB + hstepB, voffB); PG8_STAGE(PG8_SA(0, 1), cA + hstepA, voffA);
        if (wr == 1) PG8_BAR;
        PG8_WAIT_V(4); PG8_BAR;
        PG8_STAGE(PG8_SB(1, 0), cB + kstep, voffB); PG8_STAGE(PG8_SA(1, 0), cA + kstep, voffA); PG8_STAGE(PG8_SB(1, 1), cB + hstepB + kstep, voffB);
        PG8_WAIT_V(6); PG8_BAR;
    }
    for (;;) {
        const bool has_next = S.next(ui + 1, nxt);
        int gi0[2] = {0, 0}, gi1[2] = {0, 0};
        if constexpr (GATHER) { if (has_next) {
#pragma unroll
            for (int i = 0; i < 2; ++i) { gi0[i] = g.ridx[nxt.pm * 256 + gR[i]]; gi1[i] = g.ridx[nxt.pm * 256 + 128 + gR[i]]; } } }
        const char* nA = has_next ? (const char*)g.A + (size_t)nxt.pm * tstepA : cA; const char* nB = has_next ? (const char*)g.Bt + (size_t)nxt.pn * tstepB : cB;
        for (int t = 0; t < nt; t += 2) {
            const bool last = (t == nt - 2);
            const char* a1 = cA + (size_t)(t + 1) * kstep;
            const char* a2 = last ? nA : cA + (size_t)(t + 2) * kstep; const char* b2 = last ? nB : cB + (size_t)(t + 2) * kstep;
            const char* a3 = a2 + kstep; const char* b3 = b2 + kstep;
            if (last && has_next) S.a_ready(nxt);
            unsigned v20[2] = {vC0[0], vC0[1]}, v21[2] = {vC1[0], vC1[1]};
            if constexpr (GATHER) { if (last && has_next) {
#pragma unroll
                for (int i = 0; i < 2; ++i) { vN0[i] = (unsigned)(gi0[i] * g.lda + gC[i]) * 2u; vN1[i] = (unsigned)(gi1[i] * g.lda + gC[i]) * 2u; v20[i] = vN0[i]; v21[i] = vN1[i]; } } }
            if constexpr (SP2) {
            PG8_LDB(B0, 0, 0); PG8_LDB(B1, 0, 1); PG8_SCHED; PG8_LDA(At, 0, 0); PG8_STAGE(PG8_SA(1, 1), a1 + hstepA, vC1);
            PG8_WAIT_V(8); PG8_WAIT_L(0); PG8_BAR; PG8_MMA(0, 0, At, B0); PG8_MMA(0, 1, At, B1); PG8_BAR; PG8_SCHED;
            PG8_LDA(At, 0, 1); PG8_STAGE(PG8_SB(0, 0), b2, voffB); PG8_STAGE(PG8_SB(0, 1), b2 + hstepB, voffB); PG8_STAGE(PG8_SA(0, 0), a2, v20);
            PG8_WAIT_V(8); PG8_WAIT_L(0); PG8_BAR; PG8_MMA(1, 0, At, B0); PG8_MMA(1, 1, At, B1); PG8_BAR; PG8_SCHED;
            PG8_LDB(B0, 1, 0); PG8_LDB(B1, 1, 1); PG8_SCHED; PG8_LDA(At, 1, 0); PG8_STAGE(PG8_SA(0, 1), a2 + hstepA, v21);
            PG8_WAIT_V(8); PG8_WAIT_L(0); PG8_BAR; PG8_MMA(0, 0, At, B0); PG8_MMA(0, 1, At, B1); PG8_BAR; PG8_SCHED;
            PG8_LDA(At, 1, 1); PG8_STAGE(PG8_SB(1, 0), b3, voffB); PG8_STAGE(PG8_SB(1, 1), b3 + hstepB, voffB); PG8_STAGE(PG8_SA(1, 0), a3, v20);
            PG8_WAIT_V(8); PG8_WAIT_L(0); PG8_BAR; PG8_MMA(1, 0, At, B0); PG8_MMA(1, 1, At, B1); PG8_BAR; PG8_SCHED;
            if constexpr (Epi::SEG > 0) { if ((t + 2) % Epi::SEG == 0 && t + 2 < nt) E.segment(acc, cur, (t + 2) / Epi::SEG, wr, wc, fr, fq); }
            } else {
            PG8_LDB(B0, 0, 0); PG8_SCHED; PG8_LDA(At, 0, 0); PG8_STAGE(PG8_SA(1, 1), a1 + hstepA, voffA);
            PG8_WAIT_L(8); PG8_BAR; PG8_WAIT_L(0); PG8_MMA(0, 0, At, B0); PG8_BAR; PG8_SCHED;
            PG8_LDB(B1, 0, 1); PG8_STAGE(PG8_SB(0, 0), b2, voffB);
            PG8_BAR; PG8_WAIT_L(0); PG8_MMA(0, 1, At, B1); PG8_BAR;
            PG8_LDA(At, 0, 1); PG8_STAGE(PG8_SA(0, 0), a2, voffA);
            PG8_BAR; PG8_WAIT_L(0); PG8_MMA(1, 0, At, B0); PG8_BAR; PG8_SCHED;
            PG8_STAGE(PG8_SB(0, 1), b2 + hstepB, voffB);
            PG8_WAIT_V(6); PG8_BAR; PG8_MMA(1, 1, At, B1); PG8_BAR;
            PG8_LDB(B0, 1, 0); PG8_SCHED; PG8_LDA(At, 1, 0); PG8_STAGE(PG8_SA(0, 1), a2 + hstepA, voffA);
            PG8_WAIT_L(8); PG8_BAR; PG8_WAIT_L(0); PG8_MMA(0, 0, At, B0); PG8_BAR; PG8_SCHED;
            PG8_LDB(B1, 1, 1); PG8_STAGE(PG8_SB(1, 0), b3, voffB);
            PG8_BAR; PG8_WAIT_L(0); PG8_MMA(0, 1, At, B1); PG8_BAR;
            PG8_LDA(At, 1, 1); PG8_STAGE(PG8_SA(1, 0), a3, voffA);
            PG8_BAR; PG8_WAIT_L(0); PG8_MMA(1, 0, At, B0); PG8_BAR; PG8_SCHED;
            PG8_STAGE(PG8_SB(1, 1), b3 + hstepB, voffB);
            PG8_WAIT_V(6); PG8_BAR; PG8_MMA(1, 1, At, B1); PG8_BAR;
            }
        }
        if constexpr (FP8) asm volatile("s_nop 15\n\ts_nop 3" ::: "memory");
        if constexpr (ALIGN_EPI) { if (wr == 0) PG8_BAR; }
        if constexpr (!Epi::AFTER_DRAIN) { E(acc, cur, wr, wc, fr, fq); S.done(cur); }
        if (!has_next) break;
#pragma unroll
        for (int a = 0; a < 2; ++a)
#pragma unroll
            for (int b = 0; b < 2; ++b)
#pragma unroll
                for (int m = 0; m < 4; ++m)
#pragma unroll
                    for (int n = 0; n < 2; ++n) acc[a][b][m][n] = (f32x4){0.f, 0.f, 0.f, 0.f};
        cur = nxt; cA = nA; cB = nB; ++ui;
        if constexpr (GATHER) { vC0[0] = vN0[0]; vC0[1] = vN0[1]; vC1[0] = vN1[0]; vC1[1] = vN1[1]; }
        if constexpr (ALIGN_EPI) { if (wr == 1) PG8_BAR; }
    }
    PG8_WAIT_V(0);
    if constexpr (!ALIGN_EPI) { if (wr == 0) PG8_BAR; }
    PG8_BAR;
    if constexpr (Epi::AFTER_DRAIN) { E.fused(acc, cur, wr, wc, fr, fq, lds, wid, lane); S.done(cur); }
#undef PG8_SA
#undef PG8_SB
#undef PG8_STAGE
#undef PG8_LDA
#undef PG8_LD16
#undef PG8_LDB
#undef PG8_MMA
#undef PG8_WAIT_V
#undef PG8_WAIT_L
#undef PG8_BAR
#undef PG8_SCHED
}
}

typedef unsigned short bf16_t;
__device__ __forceinline__ unsigned pk4_fp8(float a, float b, float c, float d) { unsigned w = 0u; w = __builtin_amdgcn_cvt_pk_fp8_f32(a, b, w, false); w = __builtin_amdgcn_cvt_pk_fp8_f32(c, d, w, true); return w; }
constexpr float F8_WGU = 64.f, F8_WD = 128.f, F8_HID = 4.f;
typedef unsigned u32x4_t __attribute__((ext_vector_type(4)));
__device__ __forceinline__ void ldg8_dw(float (&o)[8], const void* base, const unsigned (&off)[8]) {
    asm volatile("global_load_dword %0, %9, %8\n\tglobal_load_dword %1, %10, %8\n\tglobal_load_dword %2, %11, %8\n\tglobal_load_dword %3, %12, %8\n\t"
                 "global_load_dword %4, %13, %8\n\tglobal_load_dword %5, %14, %8\n\tglobal_load_dword %6, %15, %8\n\tglobal_load_dword %7, %16, %8\n\ts_waitcnt vmcnt(0)"
                 : "=&v"(o[0]), "=&v"(o[1]), "=&v"(o[2]), "=&v"(o[3]), "=&v"(o[4]), "=&v"(o[5]), "=&v"(o[6]), "=&v"(o[7])
                 : "s"(base), "v"(off[0]), "v"(off[1]), "v"(off[2]), "v"(off[3]), "v"(off[4]), "v"(off[5]), "v"(off[6]), "v"(off[7]) : "memory");
}
template <int I1, int I2, int I3>
__device__ __forceinline__ void ldg8_x4(u32x4_t (&a)[4], u32x4_t (&b)[4], const void* base, unsigned offA, unsigned offB) {
    asm volatile("global_load_dwordx4 %0, %9, %8\n\tglobal_load_dwordx4 %1, %9, %8 offset:%11\n\tglobal_load_dwordx4 %2, %9, %8 offset:%12\n\tglobal_load_dwordx4 %3, %9, %8 offset:%13\n\t"
                 "global_load_dwordx4 %4, %10, %8\n\tglobal_load_dwordx4 %5, %10, %8 offset:%11\n\tglobal_load_dwordx4 %6, %10, %8 offset:%12\n\tglobal_load_dwordx4 %7, %10, %8 offset:%13\n\ts_waitcnt vmcnt(0)"
                 : "=&v"(a[0]), "=&v"(a[1]), "=&v"(a[2]), "=&v"(a[3]), "=&v"(b[0]), "=&v"(b[1]), "=&v"(b[2]), "=&v"(b[3])
                 : "s"(base), "v"(offA), "v"(offB), "i"(I1), "i"(I2), "i"(I3) : "memory");
}
__device__ __forceinline__ void ldg8_x4v(u32x4_t (&o)[8], const void* base, const unsigned (&off)[8]) {
    asm volatile("global_load_dwordx4 %0, %9, %8\n\tglobal_load_dwordx4 %1, %10, %8\n\tglobal_load_dwordx4 %2, %11, %8\n\tglobal_load_dwordx4 %3, %12, %8\n\t"
                 "global_load_dwordx4 %4, %13, %8\n\tglobal_load_dwordx4 %5, %14, %8\n\tglobal_load_dwordx4 %6, %15, %8\n\tglobal_load_dwordx4 %7, %16, %8\n\ts_waitcnt vmcnt(0)"
                 : "=&v"(o[0]), "=&v"(o[1]), "=&v"(o[2]), "=&v"(o[3]), "=&v"(o[4]), "=&v"(o[5]), "=&v"(o[6]), "=&v"(o[7])
                 : "s"(base), "v"(off[0]), "v"(off[1]), "v"(off[2]), "v"(off[3]), "v"(off[4]), "v"(off[5]), "v"(off[6]), "v"(off[7]) : "memory");
}
template <int I1, int I2, int I3>
__device__ __forceinline__ void ldg4_x4(u32x4_t (&a)[4], const void* base, unsigned off) {
    asm volatile("global_load_dwordx4 %0, %5, %4\n\tglobal_load_dwordx4 %1, %5, %4 offset:%6\n\tglobal_load_dwordx4 %2, %5, %4 offset:%7\n\tglobal_load_dwordx4 %3, %5, %4 offset:%8\n\ts_waitcnt vmcnt(0)"
                 : "=&v"(a[0]), "=&v"(a[1]), "=&v"(a[2]), "=&v"(a[3]) : "s"(base), "v"(off), "i"(I1), "i"(I2), "i"(I3) : "memory");
}
__device__ __forceinline__ void bf8_to_f32(const u32x4_t w, float* o) {
    o[0] = __uint_as_float(w.x << 16); o[1] = __uint_as_float(w.x & 0xffff0000u); o[2] = __uint_as_float(w.y << 16); o[3] = __uint_as_float(w.y & 0xffff0000u);
    o[4] = __uint_as_float(w.z << 16); o[5] = __uint_as_float(w.z & 0xffff0000u); o[6] = __uint_as_float(w.w << 16); o[7] = __uint_as_float(w.w & 0xffff0000u);
}
struct ExpertOrder1 {
    int G, v;
    __device__ void init(int G_, int c) { G = G_; v = (G_ % 8 == 0) ? (c % 8) * (G_ / 8) + c / 8 : c; }
    __device__ bool next(int i, pg8::Unit& u) const { const int L = i * G + v; if (L >= 2048) return false; const int e = L >> 7, r = L & 127; u.pm = e * 8 + (r & 7); u.pn = e * 16 + (r >> 3); return true; }
    __device__ __forceinline__ void a_ready(const pg8::Unit&) const {}
    __device__ __forceinline__ void done(const pg8::Unit&) const {}
};
struct ExpertOrder2 {
    int G, v;
    __device__ void init(int G_, int c) { G = G_; v = (G_ % 8 == 0) ? (c % 8) * (G_ / 8) + c / 8 : c; }
    __device__ bool next(int i, pg8::Unit& u) const { const int L = i * G + v; if (L >= 512) return false; const int e = L >> 5, r = L & 31; u.pm = e * 8 + (r & 7); u.pn = e * 4 + (r >> 3); return true; }
    __device__ __forceinline__ void a_ready(const pg8::Unit&) const {}
    __device__ __forceinline__ void done(const pg8::Unit&) const {}
};
__device__ __forceinline__ float silu_fast(float x) { return x * __builtin_amdgcn_rcpf(1.f + __builtin_amdgcn_exp2f(-1.4426950408889634f * x)); }
struct EpiSwiGLU {
    static constexpr bool PERM = true, AFTER_DRAIN = false; static constexpr int SEG = 0;
    bf16_t* O; int ldc;
    __device__ __forceinline__ void operator()(const pg8::f32x4 (&acc)[2][2][4][2], const pg8::Unit& u, int wr, int wc, int fr, int fq) const {
        int row0 = u.pm * 256 + wr * 64 + fr; asm volatile("" : "+v"(row0)); const int col0 = (u.pn & 15) * 128 + wc * 32 + 8 * fq;
#pragma unroll
        for (int ai = 0; ai < 2; ++ai)
#pragma unroll
            for (int m = 0; m < 4; ++m) {
                const pg8::f32x4 g0 = acc[ai][0][m][0], g1 = acc[ai][0][m][1], u0 = acc[ai][1][m][0], u1 = acc[ai][1][m][1];
                constexpr float IG = 1.f / F8_WGU, HS = F8_HID / F8_WGU;
                const unsigned w0 = pk4_fp8(silu_fast(g0[0] * IG) * u0[0] * HS, silu_fast(g0[1] * IG) * u0[1] * HS, silu_fast(g0[2] * IG) * u0[2] * HS, silu_fast(g0[3] * IG) * u0[3] * HS);
                const unsigned w1 = pk4_fp8(silu_fast(g1[0] * IG) * u1[0] * HS, silu_fast(g1[1] * IG) * u1[1] * HS, silu_fast(g1[2] * IG) * u1[2] * HS, silu_fast(g1[3] * IG) * u1[3] * HS);
                *(uint2*)((unsigned char*)O + (size_t)(row0 + ai * 128 + m * 16) * ldc + col0) = make_uint2(w0, w1);
            }
    }
};
struct EpiProj {
    static constexpr bool PERM = true, AFTER_DRAIN = false; static constexpr int SEG = 0;
    bf16_t* O; const float* bias;
    __device__ __forceinline__ void operator()(const pg8::f32x4 (&acc)[2][2][4][2], const pg8::Unit& u, int wr, int wc, int fr, int fq) const {
        int row0 = u.pm * 256 + wr * 64 + fr; asm volatile("" : "+v"(row0)); const int col0 = u.pn * 256 + wc * 32 + 8 * fq; const bool gate = u.pn < 12; constexpr float L2E = 1.4426950408889634f;
        float bias8[2][8];
        if (gate) { u32x4_t t0[4], t1[4]; const unsigned o0 = (unsigned)col0 * 4u; ldg8_x4<16, 512, 528>(t0, t1, bias, o0, o0);
#pragma unroll
            for (int q = 0; q < 4; ++q) { bias8[0][q] = __uint_as_float(t0[0][q]); bias8[0][4 + q] = __uint_as_float(t0[1][q]); bias8[1][q] = __uint_as_float(t0[2][q]); bias8[1][4 + q] = __uint_as_float(t0[3][q]); } }
#pragma unroll
        for (int bj = 0; bj < 2; ++bj) {
            float b[8];
#pragma unroll
            for (int q = 0; q < 8; ++q) b[q] = gate ? bias8[bj][q] : 0.f;
#pragma unroll
            for (int ai = 0; ai < 2; ++ai)
#pragma unroll
                for (int m = 0; m < 4; ++m) { float v[8];
#pragma unroll
                    for (int q = 0; q < 8; ++q) { const float x = acc[ai][bj][m][q >> 2][q & 3]; v[q] = gate ? __builtin_amdgcn_rcpf(1.f + __builtin_amdgcn_exp2f(-(x + b[q]) * L2E)) : x; }
                    pg8::u32x4 w; w.x = pg8::cvt_pk_bf16(v[0], v[1]); w.y = pg8::cvt_pk_bf16(v[2], v[3]); w.z = pg8::cvt_pk_bf16(v[4], v[5]); w.w = pg8::cvt_pk_bf16(v[6], v[7]);
                    *(pg8::u32x4*)(O + (size_t)(row0 + ai * 128 + m * 16) * DINP + col0 + bj * 128) = w; } }
    }
};
struct EpiQ {
    static constexpr bool PERM = false, AFTER_DRAIN = false; static constexpr int SEG = 0;
    bf16_t* Q; const float* rq; const float* rc; const float* rs;
    __device__ __forceinline__ void operator()(const pg8::f32x4 (&acc)[2][2][4][2], const pg8::Unit& u, int wr, int wc, int fr, int fq) const {
        int row0 = u.pm * 256 + wr * 64 + fr; asm volatile("" : "+v"(row0)); constexpr float SC = 0.10206207261596575f * 1.4426950408889634f;
        float sc8[8]; { unsigned off[8];
#pragma unroll
            for (int i = 0; i < 8; ++i) off[i] = (unsigned)(row0 + (i >> 2) * 128 + (i & 3) * 16) * 4u;
            ldg8_dw(sc8, rq, off); }
#pragma unroll
        for (int bj = 0; bj < 2; ++bj) { const int g32 = u.pn * 8 + bj * 4 + wc, col0 = g32 * 32 + 4 * fq; const bool rope = (g32 % 3) == 2;
#pragma unroll
            for (int ai = 0; ai < 2; ++ai) {
                u32x4_t cs4[4], sn4[4];
                if (rope) { u32x4_t t0[4], t1[4];
                    const unsigned o0 = (unsigned)((row0 + ai * 128) * 16 + 4 * fq) * 4u;
                    ldg8_x4<16 * 16 * 4, 32 * 16 * 4, 48 * 16 * 4>(t0, t1, rc, o0, o0 + (unsigned)(T * 16 * 4));
#pragma unroll
                    for (int m = 0; m < 4; ++m) { cs4[m] = t0[m]; sn4[m] = t1[m]; } }
#pragma unroll
                for (int m = 0; m < 4; ++m) { const int row = row0 + ai * 128 + m * 16; const float s = sc8[ai * 4 + m] * SC;
                    pg8::f32x4 v0 = acc[ai][bj][m][0] * s, v1 = acc[ai][bj][m][1] * s;
                    if (rope) { const pg8::f32x4 c4 = __builtin_bit_cast(pg8::f32x4, cs4[m]), s4 = __builtin_bit_cast(pg8::f32x4, sn4[m]);
                        const pg8::f32x4 x1 = v0, x2 = v1; v0 = x1 * c4 - x2 * s4; v1 = x1 * s4 + x2 * c4; }
                    bf16_t* qp = Q + (size_t)row * 768 + col0;
                    *(uint2*)qp = make_uint2(pg8::cvt_pk_bf16(v0[0], v0[1]), pg8::cvt_pk_bf16(v0[2], v0[3]));
                    *(uint2*)(qp + 16) = make_uint2(pg8::cvt_pk_bf16(v1[0], v1[1]), pg8::cvt_pk_bf16(v1[2], v1[3])); } } }
    }
};
struct EpiKV {
    static constexpr bool PERM = true, AFTER_DRAIN = false; static constexpr int SEG = 0;
    bf16_t* K; bf16_t* V; const float* rkv;
    __device__ __forceinline__ void operator()(const pg8::f32x4 (&acc)[2][2][4][2], const pg8::Unit& u, int wr, int wc, int fr, int fq) const {
        int row0 = u.pm * 256 + wr * 64 + fr; asm volatile("" : "+v"(row0));
        float sc8[8]; { unsigned off[8];
#pragma unroll
            for (int i = 0; i < 8; ++i) off[i] = (unsigned)(row0 + (i >> 2) * 128 + (i & 3) * 16) * 4u;
            ldg8_dw(sc8, rkv, off); }
#pragma unroll
        for (int bj = 0; bj < 2; ++bj) { const int head = u.pn * 2 + bj;
#pragma unroll
            for (int ai = 0; ai < 2; ++ai)
#pragma unroll
                for (int m = 0; m < 4; ++m) { const int row = row0 + ai * 128 + m * 16; const float s = sc8[ai * 4 + m];
                    const pg8::f32x4 v0 = acc[ai][bj][m][0] * s, v1 = acc[ai][bj][m][1] * s; pg8::u32x4 w;
                    w.x = pg8::cvt_pk_bf16(v0[0], v0[1]); w.y = pg8::cvt_pk_bf16(v0[2], v0[3]); w.z = pg8::cvt_pk_bf16(v1[0], v1[1]); w.w = pg8::cvt_pk_bf16(v1[2], v1[3]);
                    bf16_t* dst = (wc < 2) ? K + (size_t)row * 768 + head * 96 + wc * 32 + 8 * fq : V + (size_t)row * 512 + head * 64 + (wc - 2) * 32 + 8 * fq;
                    *(pg8::u32x4*)dst = w; } }
    }
};
struct EpiF32 {
    static constexpr bool PERM = true, AFTER_DRAIN = false; static constexpr int SEG = 0;
    float* O; int ldc; const float* rs;
    __device__ __forceinline__ void operator()(const pg8::f32x4 (&acc)[2][2][4][2], const pg8::Unit& u, int wr, int wc, int fr, int fq) const {
        int row0 = u.pm * 256 + wr * 64 + fr; asm volatile("" : "+v"(row0)); const int col0 = u.pn * 256 + wc * 32 + 8 * fq;
#pragma unroll
        for (int ai = 0; ai < 2; ++ai)
#pragma unroll
            for (int m = 0; m < 4; ++m) { const int row = row0 + ai * 128 + m * 16; const float s = rs ? rs[row] : 1.f;
#pragma unroll
                for (int bj = 0; bj < 2; ++bj) { float* op = O + (size_t)row * ldc + col0 + bj * 128;
                    *(pg8::f32x4*)op = acc[ai][bj][m][0] * s; *(pg8::f32x4*)(op + 4) = acc[ai][bj][m][1] * s; } }
    }
};
struct EpiMerge {
    static constexpr bool PERM = true, AFTER_DRAIN = false; static constexpr int SEG = 8;
    bf16_t* O; const bf16_t* GL;
    static __device__ __forceinline__ void ld8(const bf16_t* p, float* o) { const uint4 w = *(const uint4*)p;
        o[0] = __uint_as_float(w.x << 16); o[1] = __uint_as_float(w.x & 0xffff0000u); o[2] = __uint_as_float(w.y << 16); o[3] = __uint_as_float(w.y & 0xffff0000u);
        o[4] = __uint_as_float(w.z << 16); o[5] = __uint_as_float(w.z & 0xffff0000u); o[6] = __uint_as_float(w.w << 16); o[7] = __uint_as_float(w.w & 0xffff0000u); }
    __device__ __forceinline__ void segment(pg8::f32x4 (&acc)[2][2][4][2], const pg8::Unit& u, int seg, int wr, int wc, int fr, int fq) const {
        int row0 = u.pm * 256 + wr * 64 + fr; asm volatile("" : "+v"(row0));
        const unsigned cb = (unsigned)((seg - 1) * 1024 + u.pn * 256 + wc * 32 + 8 * fq) * 2u;
#pragma unroll
        for (int ai = 0; ai < 2; ++ai)
#pragma unroll
            for (int m = 0; m < 4; ++m) {
                u32x4_t ga[4];
                ldg4_x4<2048, 256, 2304>(ga, GL, (unsigned)(row0 + ai * 128 + m * 16) * (unsigned)(DINP * 2) + cb);
#pragma unroll
                for (int bj = 0; bj < 2; ++bj) { float x0[8], x1[8]; bf8_to_f32(ga[bj * 2], x0); bf8_to_f32(ga[bj * 2 + 1], x1);
#pragma unroll
                    for (int q = 0; q < 8; ++q) acc[ai][bj][m][q >> 2][q & 3] *= x0[q] * __builtin_amdgcn_rcpf(x1[q]); } }
    }
    __device__ __forceinline__ void operator()(const pg8::f32x4 (&acc)[2][2][4][2], const pg8::Unit& u, int wr, int wc, int fr, int fq) const {
        int row0 = u.pm * 256 + wr * 64 + fr; asm volatile("" : "+v"(row0)); const int col0 = u.pn * 256 + wc * 32 + 8 * fq;
        const unsigned cb = (unsigned)(2048 + col0) * 2u;
#pragma unroll
        for (int ai = 0; ai < 2; ++ai) {
            u32x4_t g8[8];
            { unsigned off[8];
#pragma unroll
              for (int i = 0; i < 8; ++i) off[i] = (unsigned)(row0 + ai * 128 + (i & 3) * 16) * (unsigned)(DINP * 2) + cb + (i >> 2) * 256u;
              ldg8_x4v(g8, GL, off); }
#pragma unroll
            for (int m = 0; m < 4; ++m) { const int row = row0 + ai * 128 + m * 16;
#pragma unroll
                for (int bj = 0; bj < 2; ++bj) { float x2[8], v[8]; bf8_to_f32(g8[bj * 4 + m], x2);
#pragma unroll
                    for (int q = 0; q < 8; ++q) v[q] = acc[ai][bj][m][q >> 2][q & 3] * x2[q];
                    pg8::u32x4 w; w.x = pg8::cvt_pk_bf16(v[0], v[1]); w.y = pg8::cvt_pk_bf16(v[2], v[3]); w.z = pg8::cvt_pk_bf16(v[4], v[5]); w.w = pg8::cvt_pk_bf16(v[6], v[7]);
                    *(pg8::u32x4*)(O + (size_t)row * DM + col0 + bj * 128) = w; } } }
    }
};
struct EpiRowScale {
    static constexpr bool PERM = true, AFTER_DRAIN = false; static constexpr int SEG = 0;
    bf16_t* O; int ldc; const float* rs;
    __device__ __forceinline__ void operator()(const pg8::f32x4 (&acc)[2][2][4][2], const pg8::Unit& u, int wr, int wc, int fr, int fq) const {
        int row0 = u.pm * 256 + wr * 64 + fr; asm volatile("" : "+v"(row0)); const int col0 = (u.pn & 3) * 256 + wc * 32 + 8 * fq;
        float sc8[8]; { unsigned off[8];
#pragma unroll
            for (int i = 0; i < 8; ++i) off[i] = (unsigned)(row0 + (i >> 2) * 128 + (i & 3) * 16) * 4u;
            ldg8_dw(sc8, rs, off); }
#pragma unroll
        for (int ai = 0; ai < 2; ++ai)
#pragma unroll
            for (int m = 0; m < 4; ++m) { const int row = row0 + ai * 128 + m * 16; const float s = sc8[ai * 4 + m] * (1.f / (F8_WD * F8_HID));
#pragma unroll
                for (int bj = 0; bj < 2; ++bj) { const pg8::f32x4 v0 = acc[ai][bj][m][0] * s, v1 = acc[ai][bj][m][1] * s; pg8::u32x4 w;
                    w.x = pg8::cvt_pk_bf16(v0[0], v0[1]); w.y = pg8::cvt_pk_bf16(v0[2], v0[3]); w.z = pg8::cvt_pk_bf16(v1[0], v1[1]); w.w = pg8::cvt_pk_bf16(v1[2], v1[3]);
                    *(pg8::u32x4*)(O + (size_t)row * ldc + col0 + bj * 128) = w; } }
    }
};
struct Params {
    const float* in[27];
    const int* pos;
    float* out;
    unsigned char* ws;
};

__device__ __forceinline__ float wave_sum(float v) {
#pragma unroll
    for (int o = 1; o < 64; o <<= 1) v += __shfl_xor(v, o);
    return v;
}
__device__ __forceinline__ float sigmoidf_(float x) { return 1.f / (1.f + expf(-x)); }
__device__ __forceinline__ float siluf_(float x) { return x / (1.f + expf(-x)); }
__device__ __forceinline__ float log_sigmoidf_(float x) { return fminf(x, 0.f) - log1pf(expf(-fabsf(x))); }

__device__ __forceinline__ float bf2f(bf16_t u) { return __uint_as_float((unsigned)u << 16); }
__device__ __forceinline__ unsigned f2bf(float f) { unsigned u = __float_as_uint(f); return (u + 0x7fffu + ((u >> 16) & 1u)) >> 16; }
__device__ __forceinline__ unsigned pk2(float lo, float hi) { return f2bf(lo) | (f2bf(hi) << 16); }
__device__ __forceinline__ void ld4bf(const bf16_t* p, float* o) {
    const uint2 w = *(const uint2*)p; o[0] = __uint_as_float(w.x << 16); o[1] = __uint_as_float(w.x & 0xffff0000u); o[2] = __uint_as_float(w.y << 16); o[3] = __uint_as_float(w.y & 0xffff0000u);
}
__device__ __forceinline__ void transpose_block(const float* Wblk, int ldw, bf16_t* dst, int ldt, const float* ks, const float* ns, float* scr, int lane) {
#pragma unroll 8
    for (int i = 0; i < 32; ++i) { const int kk = 2 * i + (lane >> 5); float v = __builtin_nontemporal_load(&Wblk[(size_t)kk * ldw + (lane & 31)]);     if (ks) v *= ks[kk]; if (ns) v *= ns[lane & 31]; scr[kk * 33 + (lane & 31)] = v; }
    asm volatile("s_waitcnt lgkmcnt(0)" ::: "memory");
    const int c = lane & 7;
#pragma unroll
    for (int j = 0; j < 4; ++j) { const int n = (lane >> 3) + 8 * j; const float* s = scr + (8 * c) * 33 + n;
        uint4 o; o.x = pk2(s[0 * 33], s[1 * 33]); o.y = pk2(s[2 * 33], s[3 * 33]); o.z = pk2(s[4 * 33], s[5 * 33]); o.w = pk2(s[6 * 33], s[7 * 33]);
        *(uint4*)(dst + (size_t)n * ldt + 8 * c) = o; }
    asm volatile("s_waitcnt lgkmcnt(0)" ::: "memory");
}

struct WStream {
    const float* gate; const float* up; const float* down;
    unsigned char* wgu_t; unsigned char* wd_t;
    const char* rowp; unsigned rs8, rs1;
    unsigned vo0;
    const float* src; unsigned char* dst; int ldt; float sc;
    int it, it_stride, step, nsteps;
    float v0, v1, v2, v3;
    char* blk; char* blkw;
    __device__ __forceinline__ void init(int gw, int ngw, char* lds_blk, int lane) {
        constexpr int I_ALL = 2 * 16 * 16 * 64 + 16 * 32 * 32;
        nsteps = (gw < I_ALL) ? 8 * ((I_ALL - gw + ngw - 1) / ngw) : 0;
        if (I_ALL % ngw == 0) { const int per_wg = I_ALL / (ngw >> 3); gw = (gw >> 3) * per_wg + (gw & 7); ngw = 8; nsteps = per_wg; }
        it = gw; it_stride = ngw; step = 0; blk = lds_blk; blkw = lds_blk + (lane & 31) * 80 + 4 * (lane >> 5);
        src = gate; rowp = (const char*)gate; rs8 = 0u; rs1 = 0u; vo0 = 0u; dst = wgu_t; ldt = DM; sc = 1.f; v0 = v1 = v2 = v3 = 0.f;
    }
    __device__ __forceinline__ void rare(int lane) {
        if (step >= 8 && step <= nsteps) {
            const int nr = lane >> 1, hf = lane & 1;
            const uint4 a = *(const uint4*)(blk + nr * 80 + hf * 32), b = *(const uint4*)(blk + nr * 80 + hf * 32 + 16);
            unsigned char* q = dst + (size_t)nr * ldt + hf * 32;
            { typedef unsigned u32x4n __attribute__((ext_vector_type(4))); const u32x4n an = {a.x, a.y, a.z, a.w}, bn = {b.x, b.y, b.z, b.w};
              __builtin_nontemporal_store(an, (u32x4n*)q); __builtin_nontemporal_store(bn, (u32x4n*)(q + 16)); }
        }
        if (step < nsteps) {
            constexpr int I_G = 16 * 16 * 64; int ldw;
            if (it < 2 * I_G) { const int up_ = it >= I_G, r_ = up_ ? it - I_G : it, e_ = r_ >> 10, kb_ = (r_ >> 6) & 15, nb_ = r_ & 63, j0_ = nb_ * 32;
                src = (up_ ? up : gate) + (size_t)e_ * DM * DEXP + (size_t)(64 * kb_) * DEXP + j0_; ldw = DEXP;
                dst = wgu_t + (size_t)(e_ * 4096 + 256 * (j0_ >> 7) + (j0_ & 127) + (up_ ? 128 : 0)) * DM + 64 * kb_; ldt = DM; sc = F8_WGU; }
            else { const int r_ = it - 2 * I_G, e_ = r_ >> 10, kb_ = (r_ >> 5) & 31, nb_ = r_ & 31;
                src = down + (size_t)e_ * DEXP * DM + (size_t)(64 * kb_) * DM + 32 * nb_; ldw = DM; dst = wd_t + (size_t)(e_ * 1024 + 32 * nb_) * DEXP + 64 * kb_; ldt = DEXP; sc = F8_WD; }
            it += it_stride;
            rowp = (const char*)src; rs8 = (unsigned)ldw * 32u; rs1 = (unsigned)ldw * 4u;
            vo0 = (unsigned)((4 * (lane >> 5)) * ldw + (lane & 31)) * 4u;
        } else { rowp = (const char*)src; rs8 = 0u; rs1 = 0u; vo0 = (unsigned)(lane & 31) * 4u; }
    }
    __device__ __forceinline__ void tick(int lane) {
        *(unsigned*)(blkw + ((step - 1) & 7) * 8) = pk4_fp8(v0 * sc, v1 * sc, v2 * sc, v3 * sc);
        if ((step & 7) == 0) rare(lane);
        v0 = __builtin_nontemporal_load((const float*)(rowp + vo0)); v1 = __builtin_nontemporal_load((const float*)(rowp + rs1 + vo0));
        v2 = __builtin_nontemporal_load((const float*)(rowp + 2 * rs1 + vo0)); v3 = __builtin_nontemporal_load((const float*)(rowp + 3 * rs1 + vo0));
        rowp += rs8; ++step;
    }
};

namespace att {
using bf16x8 = __attribute__((ext_vector_type(8))) short;
using s16x4  = __attribute__((ext_vector_type(4))) short;
using f32x16 = __attribute__((ext_vector_type(16))) float;
using u32x4  = __attribute__((ext_vector_type(4))) unsigned;
constexpr int NW = 8, QBLK = 32, KVBLK = 64;
constexpr int LDQ = 768, LDK = 768, LDV = 512, LDO = 1536;
constexpr int KROWB = 208;
constexpr int SHM_K = KVBLK * KROWB, SHM_V = KVBLK * 64 * 2;
constexpr int NBUF = 3;
constexpr int SHM_ATTN = NBUF * SHM_V + NBUF * SHM_K + NW * 64 * 4;
constexpr float THR = 8.f;
#define ASBAR() __builtin_amdgcn_sched_barrier(0)
__device__ __forceinline__ int crow(int r, int hi) { return (r & 3) + 8 * (r >> 2) + 4 * hi; }
__device__ __forceinline__ unsigned cvtpk(float lo, float hi) { unsigned r; asm volatile("v_cvt_pk_bf16_f32 %0, %1, %2" : "=v"(r) : "v"(lo), "v"(hi)); return r; }
#define MX3(a, b, c) __builtin_fmaxf(__builtin_fmaxf((a), (b)), (c))
template <bool FIRST>
__device__ __forceinline__ void partialSM(f32x16& p0, f32x16& p1, float& m_ref, f32x16& negm, float& alpha) {
  constexpr float THRL = THR * 1.4426950408889634f;
  float a = MX3(p0[0], p0[1], p1[0]), b = MX3(p0[2], p0[3], p1[1]); a = MX3(a, p1[2], p1[3]);
#pragma unroll
  for (int r = 4; r < 16; r += 4) { a = MX3(a, p0[r], p0[r + 1]); b = MX3(b, p0[r + 2], p0[r + 3]); a = MX3(a, p1[r], p1[r + 1]); b = MX3(b, p1[r + 2], p1[r + 3]); }
  float pmax = fmaxf(a, b);
  { auto rr = __builtin_amdgcn_permlane32_swap(__float_as_uint(pmax), __float_as_uint(pmax), false, false);
    pmax = fmaxf(__uint_as_float(rr[0]), __uint_as_float(rr[1])); }
  alpha = 1.f;
  if (FIRST || !__builtin_expect(__all(pmax <= THRL), 1)) {
    const float dl = FIRST ? pmax : fmaxf(pmax, 0.f); m_ref += dl;
#pragma unroll
    for (int r = 0; r < 16; ++r) { p0[r] -= dl; p1[r] -= dl; }
#pragma unroll
    for (int r = 0; r < 16; ++r) negm[r] = -m_ref;
    asm volatile("" : "+v"(negm));
    if (!FIRST) alpha = __builtin_amdgcn_exp2f(-dl);
  }
#pragma unroll
  for (int r = 0; r < 16; ++r) p0[r] = __builtin_amdgcn_exp2f(p0[r]);
}
#undef MX3
__device__ __forceinline__ void finishSM(f32x16& p0, f32x16& p1, float alpha, float& l_reg, bf16x8& pa0, bf16x8& pa1, bf16x8& pa2, bf16x8& pa3) {
  for (int r = 0; r < 16; ++r) p1[r] = __builtin_amdgcn_exp2f(p1[r]);
  float ps = 0; for (int r = 0; r < 16; ++r) ps += p0[r]; for (int r = 0; r < 16; ++r) ps += p1[r];
  { auto rr = __builtin_amdgcn_permlane32_swap(__float_as_uint(ps), __float_as_uint(ps), false, false);
    ps = __uint_as_float(rr[0]) + __uint_as_float(rr[1]); }
  l_reg = l_reg * alpha + ps;
#define PK4(P, BASE, OUT) do { u32x4 w = {cvtpk(P[BASE + 0], P[BASE + 1]), cvtpk(P[BASE + 2], P[BASE + 3]), cvtpk(P[BASE + 4], P[BASE + 5]), cvtpk(P[BASE + 6], P[BASE + 7])}; \
    OUT = *reinterpret_cast<bf16x8*>(&w); } while (0)
  PK4(p0, 0, pa0); PK4(p0, 8, pa1); PK4(p1, 0, pa2); PK4(p1, 8, pa3);
#undef PK4
}
__device__ __forceinline__ void qkt(f32x16& p0, f32x16& p1, const char* Ks, const bf16x8* qr, const f32x16& negm, int r32, int hi) {
  p0 = negm; p1 = negm;
#pragma unroll
  for (int d0 = 0; d0 < 6; ++d0) { const int cb = d0 * 32 + hi * 16;
    bf16x8 b0 = *reinterpret_cast<const bf16x8*>(Ks + r32 * KROWB + cb);
    bf16x8 b1 = *reinterpret_cast<const bf16x8*>(Ks + (32 + r32) * KROWB + cb);
    p0 = __builtin_amdgcn_mfma_f32_32x32x16_bf16(b0, qr[d0], p0, 0, 0, 0);
    p1 = __builtin_amdgcn_mfma_f32_32x32x16_bf16(b1, qr[d0], p1, 0, 0, 0); }
}
__device__ __forceinline__ int v_st(int k, int c) { const int kk = k;   return ((kk >> 3) * 2 + (c >> 5)) * 512 + ((kk & 7) * 32 + (c & 31)) * 2; }
__device__ __forceinline__ int v_rd_base(int lane) { return ((lane & 3) << 3) | (((lane >> 2) & 3) << 6) | (((lane >> 4) & 1) << 5) | (((lane >> 5) & 1) << 8); }
constexpr int v_rd_off(int d0, int ks, int half) { return d0 * 512 + ks * 2048 + half * 1024; }
template <int OFF> __device__ __forceinline__ s16x4 tr_read(int vb) {
  s16x4 r; asm volatile("ds_read_b64_tr_b16 %0, %1 offset:%2" : "=&v"(r) : "v"(vb), "i"(OFF) : "memory"); return r;
}
template <int D0> __device__ __forceinline__ void pv_one(f32x16& od, int vb, bf16x8 pa0, bf16x8 pa1, bf16x8 pa2, bf16x8 pa3) {
  const s16x4 l0 = tr_read<v_rd_off(D0, 0, 0)>(vb), h0 = tr_read<v_rd_off(D0, 0, 1)>(vb), l1 = tr_read<v_rd_off(D0, 1, 0)>(vb), h1 = tr_read<v_rd_off(D0, 1, 1)>(vb);
  const s16x4 l2 = tr_read<v_rd_off(D0, 2, 0)>(vb), h2 = tr_read<v_rd_off(D0, 2, 1)>(vb), l3 = tr_read<v_rd_off(D0, 3, 0)>(vb), h3 = tr_read<v_rd_off(D0, 3, 1)>(vb);
  asm volatile("s_waitcnt lgkmcnt(0)" ::: "memory"); ASBAR();
#define PK(L, H) (bf16x8){L[0], L[1], L[2], L[3], H[0], H[1], H[2], H[3]}
  od = __builtin_amdgcn_mfma_f32_32x32x16_bf16(pa0, PK(l0, h0), od, 0, 0, 0);
  od = __builtin_amdgcn_mfma_f32_32x32x16_bf16(pa1, PK(l1, h1), od, 0, 0, 0);
  od = __builtin_amdgcn_mfma_f32_32x32x16_bf16(pa2, PK(l2, h2), od, 0, 0, 0);
  od = __builtin_amdgcn_mfma_f32_32x32x16_bf16(pa3, PK(l3, h3), od, 0, 0, 0);
#undef PK
}
__device__ __forceinline__ void pv_d0(f32x16* o, int vb, bf16x8 pa0, bf16x8 pa1, bf16x8 pa2, bf16x8 pa3) {
  pv_one<0>(o[0], vb, pa0, pa1, pa2, pa3); pv_one<1>(o[1], vb, pa0, pa1, pa2, pa3);
}
__device__ __forceinline__ void attn_unit(const bf16_t* Qb, const bf16_t* Kh, const bf16_t* Vh, bf16_t* Ob, int seq, char* lds, WStream& wst) {
  int tid_ = threadIdx.x; asm volatile("" : "+v"(tid_));
  const int tid = tid_, wid = tid >> 6, lane = tid & 63, r32 = lane & 31, hi = lane >> 5;
  char* V_lds = lds; char* K_lds = lds + NBUF * SHM_V;
  float* ws = (float*)(lds + NBUF * SHM_V + NBUF * SHM_K) + wid * 64; float* li_l = ws; float* al_l = ws + 32;
  float m_ref = 0.f, l_reg = 0; f32x16 o[2] = {}; bf16x8 qr[6]; f32x16 negm = {}; asm volatile("" : "+v"(negm));
  const bf16_t* Qw = Qb + (long)(wid * QBLK + r32) * LDQ + hi * 8;
#pragma unroll
  for (int d0 = 0; d0 < 6; ++d0) qr[d0] = *reinterpret_cast<const bf16x8*>(Qw + d0 * 16);
  const bool kact = tid < 384; const int kr = tid / 12, kc = tid - kr * 12, vr = tid >> 3, vc = (tid & 7) * 8, vst0 = v_st(vr, vc);
  const int kst0 = kr * KROWB + kc * 16, kst1 = (kr + 32) * KROWB + kc * 16;
  const int vb0 = (int)(uintptr_t)V_lds + v_rd_base(lane);
  struct { bf16x8 vs, ks0, ks1; } sr_[2];
#define SLOAD(i, k0) do { sr_[i].vs = *reinterpret_cast<const bf16x8*>(&Vh[(long)((k0) + vr) * LDV + vc]); \
    if (kact) { sr_[i].ks0 = *reinterpret_cast<const bf16x8*>(&Kh[(long)((k0) + kr) * LDK + kc * 8]); sr_[i].ks1 = *reinterpret_cast<const bf16x8*>(&Kh[(long)((k0) + 32 + kr) * LDK + kc * 8]); } } while (0)
#define SWRITE(b, i) do { *(bf16x8*)(V_lds + (b) * SHM_V + vst0) = sr_[i].vs; \
    if (kact) { *(bf16x8*)(K_lds + (b) * SHM_K + kst0) = sr_[i].ks0; *(bf16x8*)(K_lds + (b) * SHM_K + kst1) = sr_[i].ks1; } } while (0)
#define SWAIT() asm volatile("s_waitcnt vmcnt(3)" ::: "memory")
#define RESC(a) do { if (__any((a) < 1.f)) { if (hi == 0) al_l[r32] = (a); asm volatile("s_waitcnt lgkmcnt(0)" ::: "memory"); \
    for (int d = 0; d < 2; ++d) for (int r = 0; r < 16; ++r) o[d][r] *= al_l[crow(r, hi)]; } } while (0)
  f32x16 pA0, pA1, pB0, pB1; float alA, alB; bf16x8 pa0, pa1, pa2, pa3; const int NT = seq / KVBLK;
  constexpr int SE = 0, SO = 1;
  int b_prev = 0, b_cur = 1, b_next = 2;
#define ROT() do { b_prev = b_cur; b_cur = b_next; b_next = (b_next == NBUF - 1) ? 0 : b_next + 1; } while (0)
  SLOAD(SE, 0); asm volatile("s_waitcnt vmcnt(0)" ::: "memory"); SWRITE(0, SE);
  SLOAD(SO, KVBLK); if (2 < NT) SLOAD(SE, 2 * KVBLK);
  __syncthreads();
  qkt(pA0, pA1, K_lds, qr, negm, r32, hi); partialSM<true>(pA0, pA1, m_ref, negm, alA);
  SWAIT(); SWRITE(1, SO); __syncthreads();
  for (int j = 1; j + 1 < NT; j += 2) {
    SLOAD(SO, (j + 2) * KVBLK);
    ASBAR(); qkt(pB0, pB1, K_lds + b_cur * SHM_K, qr, negm, r32, hi);
    finishSM(pA0, pA1, alA, l_reg, pa0, pa1, pa2, pa3); ASBAR();
    pv_d0(o, vb0 + b_prev * SHM_V, pa0, pa1, pa2, pa3); partialSM<false>(pB0, pB1, m_ref, negm, alB);
    SWAIT(); SWRITE(b_next, SE);
    RESC(alB); wst.tick(lane); __syncthreads(); ROT();
    if (j + 3 < NT) SLOAD(SE, (j + 3) * KVBLK);
    ASBAR(); qkt(pA0, pA1, K_lds + b_cur * SHM_K, qr, negm, r32, hi);
    finishSM(pB0, pB1, alB, l_reg, pa0, pa1, pa2, pa3); ASBAR();
    pv_d0(o, vb0 + b_prev * SHM_V, pa0, pa1, pa2, pa3); partialSM<false>(pA0, pA1, m_ref, negm, alA);
    SWAIT(); SWRITE(b_next, SO);
    RESC(alA); wst.tick(lane); __syncthreads(); ROT();
  }
  ASBAR(); qkt(pB0, pB1, K_lds + b_cur * SHM_K, qr, negm, r32, hi);
  finishSM(pA0, pA1, alA, l_reg, pa0, pa1, pa2, pa3); ASBAR();
  pv_d0(o, vb0 + b_prev * SHM_V, pa0, pa1, pa2, pa3); partialSM<false>(pB0, pB1, m_ref, negm, alB);
  RESC(alB);
  finishSM(pB0, pB1, alB, l_reg, pa0, pa1, pa2, pa3); ASBAR();
  pv_d0(o, vb0 + b_cur * SHM_V, pa0, pa1, pa2, pa3);
#undef ROT
  if (hi == 0) li_l[r32] = l_reg; asm volatile("s_waitcnt lgkmcnt(0)" ::: "memory");
  float rli[16];
#pragma unroll
  for (int r = 0; r < 16; ++r) rli[r] = __builtin_amdgcn_rcpf(li_l[crow(r, hi)]);
  bf16_t* Ow = Ob + (long)(wid * QBLK) * LDO;
#pragma unroll
  for (int r = 0; r < 16; ++r) { const int orow = crow(r, hi);
#pragma unroll
    for (int d0 = 0; d0 < 2; ++d0) Ow[(long)orow * LDO + d0 * 32 + r32] = (bf16_t)f2bf(o[d0][r] * rli[r]); }
  __syncthreads();
#undef SLOAD
#undef SWRITE
#undef SWAIT
#undef RESC
}
#undef ASBAR
}

namespace gla {
using bf16x8 = __attribute__((ext_vector_type(8))) short;
using s16x4  = __attribute__((ext_vector_type(4))) short;
using f32x16 = __attribute__((ext_vector_type(16))) float;
using u32x4  = __attribute__((ext_vector_type(4))) unsigned;
constexpr int L_DL = 0, L_TOT = 8192, L_RSUM = 10240, L_V = 12288, L_QF = 28672, L_KF = 37888, L_QB = 47104, L_KB = 56320, L_KSTF = 65536, L_KSTB = 74752, L_STF = 65536, L_STB = 83968, L_QR = 102400, L_KR = 110592, L_END = 118784;
constexpr int RB = 144;
__device__ __forceinline__ int crow(int r, int hi) { return (r & 3) + 8 * (r >> 2) + 4 * hi; }
__device__ __forceinline__ unsigned cvtpk(float lo, float hi) { unsigned r; asm volatile("v_cvt_pk_bf16_f32 %0, %1, %2" : "=v"(r) : "v"(lo), "v"(hi)); return r; }
__device__ __forceinline__ int v_st4(int k, int c) { const int kk = (k & ~0xC) | ((k & 4) << 1) | ((k & 8) >> 1); return ((kk >> 3) * 4 + (c >> 5)) * 512 + ((kk & 7) * 32 + (c & 31)) * 2; }
__device__ __forceinline__ int v_rd_base(int lane) { return ((lane & 3) << 3) | (((lane >> 2) & 3) << 6) | (((lane >> 4) & 1) << 5) | (((lane >> 5) & 1) << 8); }
template <int OFF> __device__ __forceinline__ s16x4 tr_read(int vb) { s16x4 r; asm volatile("ds_read_b64_tr_b16 %0, %1 offset:%2" : "=&v"(r) : "v"(vb), "i"(OFF) : "memory"); return r; }
__device__ __forceinline__ void v_frags(int vb, bf16x8 (&f)[4]) {
  const s16x4 l0 = tr_read<0>(vb), h0 = tr_read<2048>(vb), l1 = tr_read<4096>(vb), h1 = tr_read<4096 + 2048>(vb);
  const s16x4 l2 = tr_read<8192>(vb), h2 = tr_read<8192 + 2048>(vb), l3 = tr_read<12288>(vb), h3 = tr_read<12288 + 2048>(vb);
  asm volatile("s_waitcnt lgkmcnt(0)" ::: "memory"); __builtin_amdgcn_sched_barrier(0);
#define PK(L, H) (bf16x8){L[0], L[1], L[2], L[3], H[0], H[1], H[2], H[3]}
  f[0] = PK(l0, h0); f[1] = PK(l1, h1); f[2] = PK(l2, h2); f[3] = PK(l3, h3);
#undef PK
}
__device__ __forceinline__ bf16x8 frag(const char* base, int row, int ks, int hi) { return *reinterpret_cast<const bf16x8*>(base + row * RB + ks * 32 + hi * 16); }

template <bool IS_G1>
__device__ __forceinline__ void prep(char* lds, const bf16_t* projb, const float* wdec, const float* bdec, int t0, int hh, float* dec_out  , long dec_dir_stride) {
  int tid_ = threadIdx.x; asm volatile("" : "+v"(tid_)); const int tid = tid_;
  float* DL = (float*)(lds + L_DL); float* TOT = (float*)(lds + L_TOT);
  { const int i = tid >> 3, r4 = (tid & 7) * 4; float v[4]; ld4bf(projb + (size_t)(t0 + i) * DINP + OFF_GDEC + r4, v); *(float4*)(DL + i * 32 + r4) = make_float4(v[0], v[1], v[2], v[3]);
    const int c8 = (tid & 7) * 8;
    *(uint4*)(lds + L_KR + i * 128 + c8 * 2) = *(const uint4*)(projb + (size_t)(t0 + i) * DINP + OFF_GK + hh * 64 + c8);
    if constexpr (!IS_G1) *(uint4*)(lds + L_QR + i * 128 + c8 * 2) = *(const uint4*)(projb + (size_t)(t0 + i) * DINP + OFF_GQ + hh * 64 + c8); }
#pragma unroll
  for (int e2 = 0; e2 < 2; ++e2) { const int e = tid + e2 * 512, i = e >> 4, cc = (e & 15) * 8;
    *(uint4*)(lds + L_V + v_st4(i, cc)) = *(const uint4*)(projb + (size_t)(t0 + i) * DINP + OFF_GV + hh * 128 + cc); }
  __syncthreads();
  const int cidx = tid & 127, tg = tid >> 7, dir = cidx >> 6, d = cidx & 63;
  float W[16];
#pragma unroll
  for (int r = 0; r < 16; ++r) W[r] = wdec[(size_t)(dir * 16 + r) * 256 + hh * 64 + d];
  const float bias = bdec[dir * 256 + hh * 64 + d];
  constexpr float L2E = 1.4426950408889634f;
  float g[16], cs[16]; float run = 0.f;
#pragma unroll
  for (int ii = 0; ii < 16; ++ii) { const float* dl = DL + (16 * tg + ii) * 32 + dir * 16; float a = bias;
#pragma unroll
    for (int r = 0; r < 16; r += 4) { const float4 x = *(const float4*)(dl + r); a = fmaf(x.x, W[r], a); a = fmaf(x.y, W[r + 1], a); a = fmaf(x.z, W[r + 2], a); a = fmaf(x.w, W[r + 3], a); }
    g[ii] = (fminf(a, 0.f) * L2E - __builtin_amdgcn_logf(1.f + __builtin_amdgcn_exp2f(-fabsf(a) * L2E))) * (1.f / 16.f); run += g[ii]; cs[ii] = run; }
  TOT[tg * 128 + cidx] = run;
  __syncthreads();
  const float t0s = TOT[cidx], t1s = TOT[128 + cidx], t2s = TOT[256 + cidx], t3s = TOT[384 + cidx], tall = (t0s + t1s) + (t2s + t3s);
  const float off_lo = (tg > 0 ? t0s : 0.f) + (tg > 1 ? t1s : 0.f) + (tg > 2 ? t2s : 0.f);
  const float off_hi = (tg < 1 ? t1s : 0.f) + (tg < 2 ? t2s : 0.f) + (tg < 3 ? t3s : 0.f);
  const bf16_t* KR = (const bf16_t*)(lds + L_KR); const bf16_t* QR = (const bf16_t*)(lds + L_QR);
  if constexpr (IS_G1) {
    unsigned pk[8];
#pragma unroll
    for (int ii = 0; ii < 16; ii += 2) {
      float kv2[2];
#pragma unroll
      for (int u = 0; u < 2; ++u) { const int i = 16 * tg + ii + u; const float bi = dir == 0 ? off_lo + cs[ii + u] : off_hi + run - cs[ii + u] + g[ii + u];
        kv2[u] = bf2f(KR[i * 64 + d]) * __builtin_amdgcn_exp2f(tall - bi); }
      pk[ii >> 1] = cvtpk(kv2[0], kv2[1]); }
    char* dst = lds + (dir ? L_KSTB : L_KSTF) + d * RB + 32 * tg;
    *(uint4*)dst = make_uint4(pk[0], pk[1], pk[2], pk[3]); *(uint4*)(dst + 16) = make_uint4(pk[4], pk[5], pk[6], pk[7]);
    if (tg == 0) dec_out[dir * dec_dir_stride + d] = __builtin_amdgcn_exp2f(tall);
  } else {
    bf16_t* Qx = (bf16_t*)(lds + (dir ? L_QB : L_QF)); bf16_t* Kx = (bf16_t*)(lds + (dir ? L_KB : L_KF));
#pragma unroll
    for (int ii = 0; ii < 16; ++ii) { const int i = 16 * tg + ii; const float bi = dir == 0 ? off_lo + cs[ii] : off_hi + run - cs[ii] + g[ii];
      const float qv = bf2f(QR[i * 64 + d]) * 0.125f, kv = bf2f(KR[i * 64 + d]);
      Qx[i * (RB / 2) + d] = (bf16_t)f2bf(qv * __builtin_amdgcn_exp2f(bi)); Kx[i * (RB / 2) + d] = (bf16_t)f2bf(kv * __builtin_amdgcn_exp2f(-bi)); }
  }
  __syncthreads();
}

__device__ __forceinline__ void g1_item(char* lds, const bf16_t* projb, const float* wdec, const float* bdec, int b, int hh, int c, float* kvt, float* dec) {
  int tid_ = threadIdx.x; asm volatile("" : "+v"(tid_)); const int tid = tid_, wid = tid >> 6, lane = tid & 63, r32 = lane & 31, hi = lane >> 5;
  const int bh = b * 4 + hh; const long item = (long)bh * 128 + c, dstride = 8L * 128;
  prep<true>(lds, projb, wdec, bdec, b * SEQ + c * 64, hh, dec + item * 64, dstride * 64);
  const int vblk = wid >> 1, dblk = wid & 1;
  bf16x8 vf[4]; v_frags((int)(uintptr_t)(lds + L_V) + v_rd_base(lane) + vblk * 512, vf);
#pragma unroll
  for (int dir = 0; dir < 2; ++dir) { const char* kst = lds + (dir ? L_KSTB : L_KSTF); f32x16 acc = {};
#pragma unroll
    for (int ks = 0; ks < 4; ++ks) acc = __builtin_amdgcn_mfma_f32_32x32x16_bf16(vf[ks], frag(kst, dblk * 32 + r32, ks, hi), acc, 0, 0, 0);
    float* o = kvt + ((long)dir * dstride + item) * 8192 + (size_t)(vblk * 32) * 64 + dblk * 32 + r32;
#pragma unroll
    for (int r = 0; r < 16; ++r) o[crow(r, hi) * 64] = acc[r]; }
  __syncthreads();
}

__device__ __forceinline__ void g3_item(char* lds, const bf16_t* projb, const float* wdec, const float* bdec, const float* normg, int b, int hh, int c, const bf16_t* st, bf16_t* out, int ldo) {
  int tid_ = threadIdx.x; asm volatile("" : "+v"(tid_)); const int tid = tid_, wid = tid >> 6, lane = tid & 63, r32 = lane & 31, hi = lane >> 5;
  const int bh = b * 4 + hh, t0 = b * SEQ + c * 64; const long item = (long)bh * 128 + c, dstride = 8L * 128;
#pragma unroll
  for (int e4 = 0; e4 < 4; ++e4) { const int e = tid + e4 * 512, dir = e >> 10, v = (e >> 3) & 127, dc = (e & 7) * 8;
    *(uint4*)(lds + (dir ? L_STB : L_STF) + v * RB + dc * 2) = *(const uint4*)(st + ((long)dir * dstride + item) * 8192 + (size_t)v * 64 + dc); }
  prep<false>(lds, projb, wdec, bdec, t0, hh, nullptr, 0);
  const int ib = wid & 1, vblk = wid >> 1, iglob = ib * 32 + r32;
  bf16_t rgr[16];
#pragma unroll
  for (int r = 0; r < 16; ++r) rgr[r] = projb[(size_t)(t0 + ib * 32 + crow(r, hi)) * DINP + OFF_GR + hh * 128 + vblk * 32 + r32];
  f32x16 pF0 = {}, pF1 = {}, pB0 = {}, pB1 = {};
#pragma unroll
  for (int ks = 0; ks < 4; ++ks) {
    const bf16x8 qf = frag(lds + L_QF, iglob, ks, hi), qb = frag(lds + L_QB, iglob, ks, hi);
    pF0 = __builtin_amdgcn_mfma_f32_32x32x16_bf16(frag(lds + L_KF, r32, ks, hi), qf, pF0, 0, 0, 0);
    pF1 = __builtin_amdgcn_mfma_f32_32x32x16_bf16(frag(lds + L_KF, 32 + r32, ks, hi), qf, pF1, 0, 0, 0);
    pB0 = __builtin_amdgcn_mfma_f32_32x32x16_bf16(frag(lds + L_KB, r32, ks, hi), qb, pB0, 0, 0, 0);
    pB1 = __builtin_amdgcn_mfma_f32_32x32x16_bf16(frag(lds + L_KB, 32 + r32, ks, hi), qb, pB1, 0, 0, 0); }
#pragma unroll
  for (int r = 0; r < 16; ++r) { const int j0 = crow(r, hi), j1 = 32 + j0;
    pF0[r] = (j0 <= iglob ? pF0[r] : 0.f) + (j0 >= iglob ? pB0[r] : 0.f);
    pF1[r] = (j1 <= iglob ? pF1[r] : 0.f) + (j1 >= iglob ? pB1[r] : 0.f); }
  bf16x8 pa0, pa1, pa2, pa3;
#define PK4(P, BASE, OUT) do { unsigned a0 = cvtpk(P[BASE + 0], P[BASE + 1]), a1 = cvtpk(P[BASE + 2], P[BASE + 3]);   \
    unsigned b0 = cvtpk(P[BASE + 4], P[BASE + 5]), b1 = cvtpk(P[BASE + 6], P[BASE + 7]);                              \
    auto r0 = __builtin_amdgcn_permlane32_swap(a0, b0, false, false); auto r1 = __builtin_amdgcn_permlane32_swap(a1, b1, false, false); \
    u32x4 w = {r0[0], r1[0], r0[1], r1[1]}; OUT = *reinterpret_cast<bf16x8*>(&w); } while (0)
  PK4(pF0, 0, pa0); PK4(pF0, 8, pa1); PK4(pF1, 0, pa2); PK4(pF1, 8, pa3);
#undef PK4
  bf16x8 vf[4]; v_frags((int)(uintptr_t)(lds + L_V) + v_rd_base(lane) + vblk * 512, vf);
  f32x16 o = {};
  o = __builtin_amdgcn_mfma_f32_32x32x16_bf16(pa0, vf[0], o, 0, 0, 0); o = __builtin_amdgcn_mfma_f32_32x32x16_bf16(pa1, vf[1], o, 0, 0, 0);
  o = __builtin_amdgcn_mfma_f32_32x32x16_bf16(pa2, vf[2], o, 0, 0, 0); o = __builtin_amdgcn_mfma_f32_32x32x16_bf16(pa3, vf[3], o, 0, 0, 0);
#pragma unroll
  for (int ks = 0; ks < 4; ++ks) {
    o = __builtin_amdgcn_mfma_f32_32x32x16_bf16(frag(lds + L_QF, iglob, ks, hi), frag(lds + L_STF, vblk * 32 + r32, ks, hi), o, 0, 0, 0);
    o = __builtin_amdgcn_mfma_f32_32x32x16_bf16(frag(lds + L_QB, iglob, ks, hi), frag(lds + L_STB, vblk * 32 + r32, ks, hi), o, 0, 0, 0); }
  float* RS = (float*)(lds + L_RSUM);
  float ss[16];
#pragma unroll
  for (int r = 0; r < 16; ++r) { float s = o[r] * o[r]; s += __shfl_xor(s, 1); s += __shfl_xor(s, 2); s += __shfl_xor(s, 4); s += __shfl_xor(s, 8); s += __shfl_xor(s, 16); ss[r] = s; }
  if (r32 == 0) {
#pragma unroll
    for (int r = 0; r < 16; ++r) RS[(ib * 4 + vblk) * 32 + crow(r, hi)] = ss[r]; }
  __syncthreads();
  const int v = vblk * 32 + r32; const float ng = normg[v];
#pragma unroll
  for (int r = 0; r < 16; ++r) { const int il = crow(r, hi), i = ib * 32 + il;
    const float tot = (RS[(ib * 4 + 0) * 32 + il] + RS[(ib * 4 + 1) * 32 + il]) + (RS[(ib * 4 + 2) * 32 + il] + RS[(ib * 4 + 3) * 32 + il]);
    const float rstd = 1.f / sqrtf(tot * (1.f / 128.f) + RMS_EPS);
    const float rg = bf2f(rgr[r]);
    out[(size_t)(t0 + i) * ldo + hh * 128 + v] = (bf16_t)f2bf(o[r] * rstd * ng * (rg * __builtin_amdgcn_rcpf(1.f + __builtin_amdgcn_exp2f(-1.4426950408889634f * rg)))); }
  __syncthreads();
}
}

__device__ __forceinline__ void ln_core(float4 (&v)[4], const float* g, const float* b, float* out, bf16_t* outb, int lane) {
    float s = 0.f;
#pragma unroll
    for (int j = 0; j < 4; ++j) s += (v[j].x + v[j].y) + (v[j].z + v[j].w);
    const float mean = wave_sum(s) * (1.f / DM); float s2 = 0.f;
#pragma unroll
    for (int j = 0; j < 4; ++j) { v[j].x -= mean; v[j].y -= mean; v[j].z -= mean; v[j].w -= mean; s2 += (v[j].x * v[j].x + v[j].y * v[j].y) + (v[j].z * v[j].z + v[j].w * v[j].w); }
    const float rstd = 1.f / sqrtf(wave_sum(s2) * (1.f / DM) + LN_EPS);
#pragma unroll
    for (int j = 0; j < 4; ++j) {
        const float4 gg = ((const float4*)g)[lane + 64 * j], bb = ((const float4*)b)[lane + 64 * j];
        float4 o; o.x = v[j].x * rstd * gg.x + bb.x; o.y = v[j].y * rstd * gg.y + bb.y; o.z = v[j].z * rstd * gg.z + bb.z; o.w = v[j].w * rstd * gg.w + bb.w;
        ((float4*)out)[lane + 64 * j] = o; v[j] = o;
        if (outb) ((uint2*)outb)[lane + 64 * j] = make_uint2(pk2(o.x, o.y), pk2(o.z, o.w));
    }
}
__device__ __forceinline__ void wave_sum2(float& a, float& b) {
#pragma unroll
    for (int o = 1; o < 64; o <<= 1) { const float ta = __shfl_xor(a, o), tb = __shfl_xor(b, o); a += ta; b += tb; }
}
template <int MODE>
__device__ __forceinline__ void ln_core2(float4 (&v)[2][4], const float* g, const float* b, float* out0, float* out1, bf16_t* ob0, bf16_t* ob1, int lane, unsigned char* o8_0 = nullptr, unsigned char* o8_1 = nullptr) {
    float s[2] = {0.f, 0.f};
#pragma unroll
    for (int u = 0; u < 2; ++u)
#pragma unroll
        for (int j = 0; j < 4; ++j) s[u] += (v[u][j].x + v[u][j].y) + (v[u][j].z + v[u][j].w);
    wave_sum2(s[0], s[1]);
    float q[2] = {0.f, 0.f};
#pragma unroll
    for (int u = 0; u < 2; ++u) { const float mean = s[u] * (1.f / DM);
#pragma unroll
        for (int j = 0; j < 4; ++j) { v[u][j].x -= mean; v[u][j].y -= mean; v[u][j].z -= mean; v[u][j].w -= mean; q[u] += (v[u][j].x * v[u][j].x + v[u][j].y * v[u][j].y) + (v[u][j].z * v[u][j].z + v[u][j].w * v[u][j].w); } }
    wave_sum2(q[0], q[1]);
#pragma unroll
    for (int j = 0; j < 4; ++j) {
        const float4 gg = ((const float4*)g)[lane + 64 * j], bb = ((const float4*)b)[lane + 64 * j];
#pragma unroll
        for (int u = 0; u < 2; ++u) { const float rstd = 1.f / sqrtf(q[u] * (1.f / DM) + LN_EPS);
            float4 o; o.x = v[u][j].x * rstd * gg.x + bb.x; o.y = v[u][j].y * rstd * gg.y + bb.y; o.z = v[u][j].z * rstd * gg.z + bb.z; o.w = v[u][j].w * rstd * gg.w + bb.w;
            v[u][j] = o;
            if constexpr (MODE == 2) ((float4*)(u ? out1 : out0))[lane + 64 * j] = o;
            else ((uint2*)(u ? ob1 : ob0))[lane + 64 * j] = make_uint2(pk2(o.x, o.y), pk2(o.z, o.w));
            if constexpr (MODE == 1) ((unsigned*)(u ? o8_1 : o8_0))[lane + 64 * j] = pk4_fp8(o.x, o.y, o.z, o.w); }
    }
}
__device__ __forceinline__ int block_excl_scan(int x, int* scr, int tid, int& total) {
    const int lane = tid & 63, wid = tid >> 6; int inc = x;
#pragma unroll
    for (int o = 1; o < 64; o <<= 1) { const int y = __shfl_up(inc, o); if (lane >= o) inc += y; }
    __syncthreads();
    if (lane == 63) scr[wid] = inc;
    __syncthreads();
    int base = 0, tot = 0;
#pragma unroll
    for (int w = 0; w < 8; ++w) { const int c = scr[w]; base += (w < wid) ? c : 0; tot += c; }
    total = tot; return base + inc - x;
}

__device__ __forceinline__ void tb_load(float (&v)[32], const float* Wblk, int ldw, int lane) {
#pragma unroll
    for (int i = 0; i < 32; ++i) v[i] = __builtin_nontemporal_load(&Wblk[(size_t)(2 * i + (lane >> 5)) * ldw + (lane & 31)]);
}
__device__ __forceinline__ void tb_store(const float (&v)[32], bf16_t* dst, int ldt, float* scr, int lane) {
#pragma unroll
    for (int i = 0; i < 32; ++i) scr[(2 * i + (lane >> 5)) * 33 + (lane & 31)] = v[i];
    asm volatile("s_waitcnt lgkmcnt(0)" ::: "memory");
    const int c = lane & 7;
#pragma unroll
    for (int j = 0; j < 4; ++j) { const int n = (lane >> 3) + 8 * j; const float* s = scr + (8 * c) * 33 + n;
        uint4 o; o.x = pk2(s[0 * 33], s[1 * 33]); o.y = pk2(s[2 * 33], s[3 * 33]); o.z = pk2(s[4 * 33], s[5 * 33]); o.w = pk2(s[6 * 33], s[7 * 33]);
        *(uint4*)(dst + (size_t)n * ldt + 8 * c) = o; }
    asm volatile("s_waitcnt lgkmcnt(0)" ::: "memory");
}

__device__ __forceinline__ void tb_store8(const float (&v)[32], unsigned char* dst, int ldt, float sc, float* scr, int lane) {
#pragma unroll
    for (int i = 0; i < 32; ++i) scr[(2 * i + (lane >> 5)) * 33 + (lane & 31)] = v[i];
    asm volatile("s_waitcnt lgkmcnt(0)" ::: "memory");
    const int c = lane & 7;
#pragma unroll
    for (int j = 0; j < 4; ++j) { const int n = (lane >> 3) + 8 * j; const float* s = scr + (8 * c) * 33 + n;
        *(uint2*)(dst + (size_t)n * ldt + 8 * c) = make_uint2(pk4_fp8(s[0 * 33] * sc, s[1 * 33] * sc, s[2 * 33] * sc, s[3 * 33] * sc), pk4_fp8(s[4 * 33] * sc, s[5 * 33] * sc, s[6 * 33] * sc, s[7 * 33] * sc)); }
    asm volatile("s_waitcnt lgkmcnt(0)" ::: "memory");
}

__device__ __forceinline__ void ln_row(const float* a, const float* add, float alpha, const float* g, const float* b, float* out, int lane, float4 (&v)[4], bf16_t* outb = nullptr) {
    float s = 0.f;
#pragma unroll
    for (int j = 0; j < 4; ++j) {
        float4 x = ((const float4*)a)[lane + 64 * j];
        x.x *= alpha; x.y *= alpha; x.z *= alpha; x.w *= alpha;
        if (add) { const float4 y = ((const float4*)add)[lane + 64 * j]; x.x += y.x; x.y += y.y; x.z += y.z; x.w += y.w; }
        v[j] = x; s += (x.x + x.y) + (x.z + x.w);
    }
    const float mean = wave_sum(s) * (1.f / DM); float s2 = 0.f;
#pragma unroll
    for (int j = 0; j < 4; ++j) { v[j].x -= mean; v[j].y -= mean; v[j].z -= mean; v[j].w -= mean; s2 += (v[j].x * v[j].x + v[j].y * v[j].y) + (v[j].z * v[j].z + v[j].w * v[j].w); }
    const float rstd = 1.f / sqrtf(wave_sum(s2) * (1.f / DM) + LN_EPS);
#pragma unroll
    for (int j = 0; j < 4; ++j) {
        const float4 gg = ((const float4*)g)[lane + 64 * j], bb = ((const float4*)b)[lane + 64 * j];
        float4 o; o.x = v[j].x * rstd * gg.x + bb.x; o.y = v[j].y * rstd * gg.y + bb.y; o.z = v[j].z * rstd * gg.z + bb.z; o.w = v[j].w * rstd * gg.w + bb.w;
        if (out) ((float4*)out)[lane + 64 * j] = o; v[j] = o;
        if (outb) ((uint2*)outb)[lane + 64 * j] = make_uint2(pk2(o.x, o.y), pk2(o.z, o.w));
    }
}

struct GemmP {
    const float* A; const int* ridx; const float* Bm; float* C;
    int lda, ldb, ldc, M, N, K, nb, bshift;
    long sA, sB, sC; int sR;
    const float* aux; const bf16_t* auxb; int ldaux; long sAux; const float* aux2; int accum;
};
template <int MODE>
__device__ __forceinline__ void gemm_naive(const GemmP g, float* lds) {
    float (*As)[132] = (float (*)[132])lds;
    float (*Bs)[128] = (float (*)[128])(lds + 16 * 132);
    int tid_ = threadIdx.x; asm volatile("" : "+v"(tid_));
    const int tid = tid_, ty = tid >> 4, tx = tid & 15;
    const int mt = g.M / 128, nt = (g.N + 127) / 128, per = mt * nt, total = per * g.nb;
    int bid_ = blockIdx.x; asm volatile("" : "+s"(bid_));
    for (int tile = bid_; tile < total; tile += gridDim.x) {
        const int z = tile / per, r = tile % per, tm = r / nt, tn = r % nt;
        const int m0 = tm * 128, n0 = tn * 128;
        const float* Bz = g.Bm + (long)(z >> g.bshift) * g.sB;
        float* Cz = g.C + (long)z * g.sC;
        const int arow = m0 + (tid >> 2);
        const long grow = g.ridx ? (long)g.ridx[z * g.sR + arow] : (long)arow;
        const float* Arow = g.A + (long)z * g.sA + grow * g.lda + (tid & 3) * 4;
        const int bk = tid >> 5, bn = n0 + (tid & 31) * 4;
        const bool bok = bn < g.N;
        const float* Bp = Bz + (long)bk * g.ldb + bn;
        float acc[4][8];
#pragma unroll
        for (int i = 0; i < 4; ++i)
#pragma unroll
            for (int j = 0; j < 8; ++j) acc[i][j] = 0.f;
        float4 ra = *(const float4*)(Arow);
        float4 rb = bok ? *(const float4*)(Bp) : make_float4(0.f, 0.f, 0.f, 0.f);
        for (int k0 = 0; k0 < g.K; k0 += 16) {
            __syncthreads();
            { const int rr = tid >> 2, k4 = (tid & 3) * 4; As[k4][rr] = ra.x; As[k4 + 1][rr] = ra.y; As[k4 + 2][rr] = ra.z; As[k4 + 3][rr] = ra.w; }
            *(float4*)&Bs[bk][(tid & 31) * 4] = rb;
            __syncthreads();
            if (k0 + 16 < g.K) {
                ra = *(const float4*)(Arow + k0 + 16);
                rb = bok ? *(const float4*)(Bp + (long)(k0 + 16) * g.ldb) : make_float4(0.f, 0.f, 0.f, 0.f);
            }
#pragma unroll
            for (int k = 0; k < 16; ++k) {
                const float4 a = *(const float4*)&As[k][ty * 4];
                const float4 b0 = *(const float4*)&Bs[k][tx * 8], b1 = *(const float4*)&Bs[k][tx * 8 + 4];
                const float av[4] = {a.x, a.y, a.z, a.w};
                const float bv[8] = {b0.x, b0.y, b0.z, b0.w, b1.x, b1.y, b1.z, b1.w};
#pragma unroll
                for (int i = 0; i < 4; ++i)
#pragma unroll
                    for (int j = 0; j < 8; ++j) acc[i][j] = fmaf(av[i], bv[j], acc[i][j]);
            }
        }
#pragma unroll
        for (int i = 0; i < 4; ++i) {
            const int row = m0 + ty * 4 + i;
#pragma unroll
            for (int jv = 0; jv < 2; ++jv) {
                const int col = n0 + tx * 8 + jv * 4;
                if (col < g.N) {
                    float v[4] = {acc[i][jv * 4], acc[i][jv * 4 + 1], acc[i][jv * 4 + 2], acc[i][jv * 4 + 3]};
                    float* cp = Cz + (long)row * g.ldc + col;
                    if (MODE == 1) {
#pragma unroll
                        for (int q = 0; q < 4; ++q) v[q] *= g.aux[(long)z * g.sAux + col + q];
                    } else if (MODE == 2) {
                        float gl[4]; ld4bf(g.auxb + (long)row * g.ldaux + col, gl); const float4 gb = *(const float4*)(g.aux2 + col);
                        const float gv[4] = {gl[0] + gb.x, gl[1] + gb.y, gl[2] + gb.z, gl[3] + gb.w};
                        float4 old = make_float4(0.f, 0.f, 0.f, 0.f);
                        if (g.accum) old = *(const float4*)cp;
                        const float ov[4] = {old.x, old.y, old.z, old.w};
#pragma unroll
                        for (int q = 0; q < 4; ++q) v[q] = ov[q] + sigmoidf_(gv[q]) * v[q];
                    } else if (MODE == 3) {
                        const float4 old = *(const float4*)cp; const float ov[4] = {old.x, old.y, old.z, old.w};
#pragma unroll
                        for (int q = 0; q < 4; ++q) v[q] = siluf_(ov[q]) * v[q];
                    } else if (MODE == 4) {
                        const float rs = g.aux[(long)z * g.sAux + row];
#pragma unroll
                        for (int q = 0; q < 4; ++q) v[q] *= rs;
                    }
                    *(float4*)cp = make_float4(v[0], v[1], v[2], v[3]);
                }
            }
        }
    }
    __syncthreads();
}

#define W_IN(l)    (p.in[4]  + (size_t)(l) * DM * DIN)
#define B_GATE(l)  (p.in[5]  + (size_t)(l) * 3 * DM)
#define POOL_W(l)  (p.in[6]  + (size_t)(l) * 4 * 128 * 128)
#define POOL_S(l)  (p.in[7]  + (size_t)(l) * 512)
#define W_UP_A(l)  (p.in[8]  + (size_t)(l) * 512 * DM)
#define Q_NORM(l)  (p.in[9]  + (size_t)(l) * 384)
#define W_UQ(l)    (p.in[10] + (size_t)(l) * 384 * 768)
#define KV_NORM(l) (p.in[11] + (size_t)(l) * 256)
#define W_UKV(l)   (p.in[12] + (size_t)(l) * 256 * 1024)
#define W_UP_B(l)  (p.in[13] + (size_t)(l) * 512 * DM)
#define W_DEC(l)   (p.in[14] + (size_t)(l) * 2 * 16 * 256)
#define B_DEC(l)   (p.in[15] + (size_t)(l) * 2 * 256)
#define GLA_NORM(l)(p.in[16] + (size_t)(l) * 128)
#define W_UP_C(l)  (p.in[17] + (size_t)(l) * 512 * DM)
#define W_OUT(l)   (p.in[18] + (size_t)(l) * DM * DM)
#define LN1_G(l)   (p.in[19] + (size_t)(l) * DM)
#define LN1_B(l)   (p.in[20] + (size_t)(l) * DM)
#define ROUTER(l)  (p.in[21] + (size_t)(l) * DM * NE)
#define EW_GATE(l) (p.in[22] + (size_t)(l) * NE * DM * DEXP)
#define EW_UP(l)   (p.in[23] + (size_t)(l) * NE * DM * DEXP)
#define EW_DOWN(l) (p.in[24] + (size_t)(l) * NE * DEXP * DM)
#define LN2_G(l)   (p.in[25] + (size_t)(l) * DM)
#define LN2_B(l)   (p.in[26] + (size_t)(l) * DM)
#define WSF(off) ((float*)(p.ws + (off)))
#define WSI(off) ((int*)(p.ws + (off)))
#define WSB(off) ((bf16_t*)(p.ws + (off)))
#define PJ(t, c) bf2f(projb[(size_t)(t) * DINP + (c)])

enum Stage {
    ST_INIT = 0,
    ST_WCONV,
    ST_PROJ,
    ST_PREP,
    ST_SMALLGEMM,
    ST_ROPE,
    ST_ATTN,
    ST_GLA1, ST_GLA2, ST_GLA3,
    ST_GLAFIN,
    ST_MERGE_A, ST_MERGE_B, ST_MERGE_C,
    ST_OUTP,
    ST_LN1,
    ST_TOPK,
    ST_GATHER,
    ST_EXP_G, ST_EXP_U, ST_EXP_D,
    ST_LN2,
    ST_COUNT
};

#define KAS __attribute__((address_space(4)))
template <int ST>
__device__ __forceinline__ void run_stage(int l, float* lds) {
    const KAS Params* pk_ = (const KAS Params*)__builtin_amdgcn_kernarg_segment_ptr(); asm volatile("" : "+s"(pk_));
    const KAS Params& p = *pk_;
    int tid_ = threadIdx.x; asm volatile("" : "+v"(tid_));
    int bid_ = blockIdx.x; asm volatile("" : "+s"(bid_));
    const int tid = tid_, lane = tid & 63, wid = tid >> 6;
    const int G = gridDim.x, bid = bid_;
    const int gw = bid * 8 + wid, NGW = G * 8;
    const long gt = (long)bid * NTHR + tid, NGT = (long)G * NTHR;
    float* h = p.out;

    if constexpr (ST == ST_INIT) {
        for (int m = gw; m < T; m += NGW) { float4 vv[4]; ln_row(p.in[0] + (size_t)m * DM, nullptr, 1.f, p.in[2], p.in[3], nullptr, lane, vv, WSB(WS_HB) + (size_t)m * DM); }
        {
            float* scr = lds + wid * 4096;
            constexpr int NBLK = DIN / 32, ITEMS_L = (DM / 64) * NBLK;
            for (int it = gw; it < 2 * ITEMS_L; it += NGW) {
                const int ll = it / ITEMS_L, r = it % ITEMS_L, kb = r / NBLK, nb = r % NBLK;
                const int n0 = 32 * nb, drow = n0 < 2752 ? n0 + 3072 : n0 - 2752;
                transpose_block(p.in[4] + (size_t)ll * DM * DIN + (size_t)(64 * kb) * DIN + n0, DIN, WSB(WS_WIN_T) + (size_t)ll * DINP * DM + (size_t)drow * DM + 64 * kb, DM, nullptr, nullptr, scr, lane);
            }
            {
                constexpr int I_UQ = 6 * 24, I_UKV = 4 * 32, I_B = 8 * 32, I_OUT = 16 * 32, I_L = I_UQ + I_UKV + 2 * I_B + I_OUT;
                for (int it = gw; it < 2 * I_L; it += NGW) {
                    const int ll = it / I_L; int r = it % I_L; bf16_t* wsm = WSB(WS_WSMALL + (size_t)ll * WSM_STRIDE);
                    if (r < I_UQ) { const int kb = r / 24, nb = r % 24; transpose_block(p.in[10] + (size_t)ll * 384 * 768 + (size_t)(64 * kb) * 768 + 32 * nb, 768, wsm + WSM_UQ / 2 + (size_t)(32 * nb) * 384 + 64 * kb, 384, p.in[9] + ll * 384 + 64 * kb, nullptr, scr, lane); continue; } r -= I_UQ;
                    if (r < I_UKV) { const int kb = r / 32, nb = r % 32; transpose_block(p.in[12] + (size_t)ll * 256 * 1024 + (size_t)(64 * kb) * 1024 + 32 * nb, 1024, wsm + WSM_UKV / 2 + (size_t)(32 * nb) * 256 + 64 * kb, 256, p.in[11] + ll * 256 + 64 * kb, nullptr, scr, lane); continue; } r -= I_UKV;
                    if (r < 2 * I_B) { const int c = r / I_B, rr = r % I_B, kb = rr / 32, nb = rr % 32; const float* W = (c ? p.in[17] : p.in[13]) + (size_t)ll * 512 * DM;
                        transpose_block(W + (size_t)(64 * kb) * DM + 32 * nb, DM, wsm + WSM_MRG / 2 + (size_t)(32 * nb) * 1536 + 512 * (1 + c) + 64 * kb, 1536, nullptr, nullptr, scr, lane); continue; } r -= 2 * I_B;
                    { const int kb = r / 32, nb = r % 32; transpose_block(p.in[18] + (size_t)ll * DM * DM + (size_t)(64 * kb) * DM + 32 * nb, DM, wsm + WSM_OUT / 2 + (size_t)(32 * nb) * DM + 64 * kb, DM, nullptr, nullptr, scr, lane); }
                }
                for (long i = gt; i < 2L * 512 * DM; i += NGT) {
                    const int ll = (int)(i / (512 * DM)), r = (int)(i % (512 * DM)), cin = r >> 10, d = r & 1023, g = cin >> 7, c = cin & 127;
                    const float* pw = p.in[6] + (size_t)ll * 4 * 128 * 128 + (size_t)(g * 128 + c) * 128; const float* ps = p.in[7] + ll * 512 + g * 128; const float* wa = p.in[8] + (size_t)ll * 512 * DM + (size_t)(g * 128) * DM + d;
                    float a = 0.f;
                    for (int cc = 0; cc < 128; ++cc) a = fmaf(pw[cc] * ps[cc], wa[(size_t)cc * DM], a);
                    WSB(WS_WSMALL + (size_t)ll * WSM_STRIDE + WSM_MRG)[(size_t)d * 1536 + cin] = (bf16_t)f2bf(a);
                }
            }
            for (long i = gt; i < 2L * 64 * DM / 8; i += NGT) { const int ll = (int)(i / (64 * DM / 8)); const long r = i % (64 * DM / 8);
                *(uint4*)(WSB(WS_WIN_T) + (size_t)ll * DINP * DM + (size_t)DIN * DM + r * 8) = make_uint4(0u, 0u, 0u, 0u); }
        }
        float* rc = WSF(WS_ROPE); float* rs = rc + T * 16;
        for (long i = gt; i < (long)T * 16; i += NGT) {
            const int t = (int)(i >> 4), j = (int)(i & 15);
            const float freq = powf(10000.0f, -(float)j / 16.0f);
            const float ang = (float)p.pos[t] * freq;
            rc[i] = cosf(ang); rs[i] = sinf(ang);
        }
    }
    if constexpr (ST == ST_WCONV) {
        float* scr = lds + wid * 4096;
        constexpr int I_G = 16 * 16 * 64, I_D = 16 * 32 * 32;
        constexpr int I_ALL = 2 * I_G + I_D;
#define WCONV_ITEM(it, W, ldw, dst, ldt, sc8) do { if ((it) < 2 * I_G) { const int up_ = (it) >= I_G, r_ = up_ ? (it) - I_G : (it), e_ = r_ >> 10, kb_ = (r_ >> 6) & 15, nb_ = r_ & 63, j0_ = nb_ * 32; \
            W = (up_ ? EW_UP(l) : EW_GATE(l)) + (size_t)e_ * DM * DEXP + (size_t)(64 * kb_) * DEXP + j0_; ldw = DEXP; \
            dst = (unsigned char*)(p.ws + WS_WGU_T) + (size_t)(e_ * 4096 + 256 * (j0_ >> 7) + (j0_ & 127) + (up_ ? 128 : 0)) * DM + 64 * kb_; ldt = DM; sc8 = F8_WGU; } \
          else { const int r_ = (it) - 2 * I_G, e_ = r_ >> 10, kb_ = (r_ >> 5) & 31, nb_ = r_ & 31; \
            W = EW_DOWN(l) + (size_t)e_ * DEXP * DM + (size_t)(64 * kb_) * DM + 32 * nb_; ldw = DM; dst = (unsigned char*)(p.ws + WS_WD_T) + (size_t)(e_ * 1024 + 32 * nb_) * DEXP + 64 * kb_; ldt = DEXP; sc8 = F8_WD; } } while (0)
        float va[32], vb[32]; const float* Wa = nullptr; const float* Wb = nullptr; unsigned char* da = nullptr; unsigned char* db = nullptr; int lwa = 0, lwb = 0, lta = 0, ltb = 0; float sa = 1.f, sb = 1.f;
        int itA = gw, itB = gw + NGW;
        if (itA < I_ALL) { WCONV_ITEM(itA, Wa, lwa, da, lta, sa); tb_load(va, Wa, lwa, lane); }
        while (itA < I_ALL) {
            if (itB < I_ALL) { WCONV_ITEM(itB, Wb, lwb, db, ltb, sb); tb_load(vb, Wb, lwb, lane); }
            tb_store8(va, da, lta, sa, scr, lane);
            itA = itB + NGW;
            if (itB >= I_ALL) break;
            if (itA < I_ALL) { WCONV_ITEM(itA, Wa, lwa, da, lta, sa); tb_load(va, Wa, lwa, lane); }
            tb_store8(vb, db, ltb, sb, scr, lane);
            itB = itA + NGW;
        }
#undef WCONV_ITEM
        __syncthreads();
    }
    if constexpr (ST == ST_PROJ) {
        pg8::Gemm g{WSB(WS_HB), WSB(WS_WIN_T) + (size_t)l * DINP * DM, T, DINP, DM, DM};
        pg8::StaticOrder S; S.init(T, DINP, G, bid);
        EpiProj E{WSB(WS_PROJB), B_GATE(l)};
        pg8::gemm_phase<EpiProj, pg8::StaticOrder, true, true>((PG8_LAS unsigned char*)lds, g, S, E);
    }
    if constexpr (ST == ST_PREP) {
        const bf16_t* projb = WSB(WS_PROJB); bf16_t* br = WSB(WS_BR); bf16_t* U = (bf16_t*)lds;
        float* rq = WSF(WS_RQ); float* rkv = rq + T; const float* rc = WSF(WS_ROPE); const float* rs = rc + T * 16; bf16_t* kb = WSB(WS_KB);
        for (int tile = bid; tile < T / 64; tile += G) {
            const int b = tile / (SEQ / 64), s0 = (tile % (SEQ / 64)) * 64, t0 = b * SEQ + s0;
            __syncthreads();
#pragma unroll
            for (int it = 0; it < 10; ++it) { const int e = tid + it * NTHR, r = e >> 6, ch = e & 63, s = s0 - 8 + r;
                uint4 v = make_uint4(0u, 0u, 0u, 0u);
                if (s >= 0 && s < SEQ) v = *(const uint4*)(projb + (size_t)(b * SEQ + s) * DINP + OFF_POOL + ch * 8);
                *(uint4*)(U + r * 512 + ch * 8) = v; }
            for (int r = wid; r < 64; r += 8) { const bf16_t* row = projb + (size_t)(t0 + r) * DINP;
                float s1 = 0.f, s2 = 0.f;
                if (lane < 48) { const uint4 w = *(const uint4*)(row + OFF_CQ + lane * 8); const unsigned ww[4] = {w.x, w.y, w.z, w.w};
#pragma unroll
                    for (int q = 0; q < 4; ++q) { const float a = __uint_as_float(ww[q] << 16), c = __uint_as_float(ww[q] & 0xffff0000u); s1 += a * a + c * c; } }
                if (lane < 32) { const uint4 w = *(const uint4*)(row + OFF_CKV + lane * 8); const unsigned ww[4] = {w.x, w.y, w.z, w.w};
#pragma unroll
                    for (int q = 0; q < 4; ++q) { const float a = __uint_as_float(ww[q] << 16), c = __uint_as_float(ww[q] & 0xffff0000u); s2 += a * a + c * c; } }
                s1 = wave_sum(s1); s2 = wave_sum(s2);
                if (lane == 0) { rq[t0 + r] = 1.f / sqrtf(s1 * (1.f / 384.f) + RMS_EPS); rkv[t0 + r] = 1.f / sqrtf(s2 * (1.f / 256.f) + RMS_EPS); } }
#pragma unroll
            for (int it = 0; it < 2; ++it) { const int e = tid + it * NTHR, r = e >> 4, j = e & 15, t = t0 + r;
                const float c = rc[(size_t)t * 16 + j], s = rs[(size_t)t * 16 + j], x1 = PJ(t, OFF_KR + j), x2 = PJ(t, OFF_KR + 16 + j);
                const bf16_t k1 = (bf16_t)f2bf(x1 * c - x2 * s), k2 = (bf16_t)f2bf(x1 * s + x2 * c);
#pragma unroll
                for (int hh = 0; hh < 8; ++hh) { kb[(size_t)t * 768 + hh * 96 + 64 + j] = k1; kb[(size_t)t * 768 + hh * 96 + 80 + j] = k2; } }
            __syncthreads();
            { const int c = tid, hw = 1 << (c >> 7); float sum = 0.f;
                for (int u = s0 - hw; u < s0 + hw; ++u) if (u >= 0 && u < SEQ) sum += bf2f(U[(u - s0 + 8) * 512 + c]);
                for (int s = s0; s < s0 + 64; ++s) {
                    int lo = s - hw; if (lo < 0) lo = 0; int hi = s + hw; if (hi > SEQ) hi = SEQ;
                    br[(size_t)(b * SEQ + s) * 1536 + c] = (bf16_t)f2bf(sum / (float)(hi - lo) - bf2f(U[(s - s0 + 8) * 512 + c]));
                    if (s + hw < SEQ) sum += bf2f(U[(s + hw - s0 + 8) * 512 + c]);
                    if (s - hw >= 0) sum -= bf2f(U[(s - hw - s0 + 8) * 512 + c]);
                } }
        }
        __syncthreads();
    }
    if constexpr (ST == ST_SMALLGEMM) {
        const bf16_t* wsm = WSB(WS_WSMALL + (size_t)l * WSM_STRIDE);
        { pg8::Gemm g{WSB(WS_PROJB) + OFF_CQ, wsm + WSM_UQ / 2, T, 768, 384, DINP}; pg8::StaticOrder S; S.init(T, 768, G, bid);
          EpiQ E{WSB(WS_QB), WSF(WS_RQ), WSF(WS_ROPE), WSF(WS_ROPE) + T * 16}; pg8::gemm_phase<EpiQ, pg8::StaticOrder, true, true>((PG8_LAS unsigned char*)lds, g, S, E); }
        { pg8::Gemm g{WSB(WS_PROJB) + OFF_CKV, wsm + WSM_UKV / 2, T, 1024, 256, DINP}; pg8::StaticOrder S; S.init(T, 1024, G, bid);
          EpiKV E{WSB(WS_KB), WSB(WS_VB), WSF(WS_RQ) + T}; pg8::gemm_phase<EpiKV, pg8::StaticOrder, true, true>((PG8_LAS unsigned char*)lds, g, S, E); }
    }
    if constexpr (ST == ST_ATTN) {
        const int vcu = (G % 8 == 0) ? (bid % 8) * (G / 8) + bid / 8 : bid;
        WStream wst; wst.gate = EW_GATE(l); wst.up = EW_UP(l); wst.down = EW_DOWN(l); wst.wgu_t = p.ws + WS_WGU_T; wst.wd_t = p.ws + WS_WD_T;
        { const int wu = __builtin_amdgcn_readfirstlane(wid); wst.init(bid * 8 + wu, NGW, (char*)lds + att::SHM_ATTN + wu * 2560, lane); }
        for (int L = vcu; L < NB * 8 * 32; L += G) {
            const int bh = L >> 5, qb = L & 31, b = bh >> 3, hh = bh & 7;
            att::attn_unit(WSB(WS_QB) + (size_t)(b * SEQ + qb * 256) * 768 + hh * 96, WSB(WS_KB) + (size_t)(b * SEQ) * 768 + hh * 96, WSB(WS_VB) + (size_t)(b * SEQ) * 512 + hh * 64,
                           WSB(WS_BR) + (size_t)(b * SEQ + qb * 256) * 1536 + 512 + hh * 64, SEQ, (char*)lds, wst);
        }
        while (wst.step <= wst.nsteps) wst.tick(lane);
        __syncthreads();
    }
    if constexpr (ST == ST_GLA1) {
        for (int item = bid; item < NB * 4 * 128; item += G) {
            const int b = item >> 9, hh = (item >> 7) & 3, c = item & 127;
            gla::g1_item((char*)lds, WSB(WS_PROJB), W_DEC(l), B_DEC(l), b, hh, c, WSF(WS_KVT), WSF(WS_DEC));
        }
    }
    if constexpr (ST == ST_GLA2) {
        const float* kvt = WSF(WS_KVT); const float* dec = WSF(WS_DEC); bf16_t* stp = WSB(WS_ST);
        for (long e = gt; e < 2L * 8 * 8192; e += NGT) {
            const int dir = (int)(e >> 16), bh = (int)((e >> 13) & 7), vd = (int)(e & 8191), d = vd & 63;
            const long base = ((long)dir * 8 + bh) * 128;
            float s = 0.f;
#pragma unroll 1
            for (int k0 = 0; k0 < 128; k0 += 32) {
                float kv[32], dc[32];
#pragma unroll
                for (int k = 0; k < 32; ++k) { const int c = dir ? 127 - (k0 + k) : k0 + k; kv[k] = kvt[(base + c) * 8192 + vd]; dc[k] = dec[(base + c) * 64 + d]; }
#pragma unroll
                for (int k = 0; k < 32; ++k) { const int c = dir ? 127 - (k0 + k) : k0 + k; stp[(base + c) * 8192 + vd] = (bf16_t)f2bf(s); s = fmaf(dc[k], s, kv[k]); }
            }
        }
    }
    if constexpr (ST == ST_GLA3) {
        for (int item = bid; item < NB * 4 * 128; item += G) {
            const int b = item >> 9, hh = (item >> 7) & 3, c = item & 127;
            gla::g3_item((char*)lds, WSB(WS_PROJB), W_DEC(l), B_DEC(l), GLA_NORM(l), b, hh, c, WSB(WS_ST), WSB(WS_BR) + 1024, 1536);
        }
    }
    if constexpr (ST == ST_MERGE_A) {
        const bf16_t* wsm = WSB(WS_WSMALL + (size_t)l * WSM_STRIDE);
        pg8::Gemm g{WSB(WS_BR), wsm + WSM_MRG / 2, T, DM, 1536, 1536}; pg8::StaticOrder S; S.init(T, DM, G, bid);
        EpiMerge E{WSB(WS_MERGEDB), WSB(WS_PROJB) + OFF_GATE};
        pg8::gemm_phase<EpiMerge, pg8::StaticOrder, true, true>((PG8_LAS unsigned char*)lds, g, S, E);
    }
    if constexpr (ST == ST_OUTP) {
        const bf16_t* wsm = WSB(WS_WSMALL + (size_t)l * WSM_STRIDE);
        pg8::Gemm g{WSB(WS_MERGEDB), wsm + WSM_OUT / 2, T, DM, DM, DM}; pg8::StaticOrder S; S.init(T, DM, G, bid);
        pg8::EpiBf16<0> E{WSB(WS_TMP), DM, nullptr, 0, 0, 1.f};
        pg8::gemm_phase<pg8::EpiBf16<0>, pg8::StaticOrder, true, true>((PG8_LAS unsigned char*)lds, g, S, E);
    }
    if constexpr (ST == ST_LN1) {
        float* RWT = lds; const float* rw = ROUTER(l);
        for (int i = tid; i < DM * 4; i += NTHR) { const int k = i >> 2, e4 = (i & 3) * 4; const float4 w = *(const float4*)(rw + (size_t)k * 16 + e4);
            RWT[(e4 + 0) * DM + k] = w.x; RWT[(e4 + 1) * DM + k] = w.y; RWT[(e4 + 2) * DM + k] = w.z; RWT[(e4 + 3) * DM + k] = w.w; }
        __syncthreads();
        float* afft = WSF(WS_AFF);
        for (int m0 = gw; m0 < T; m0 += 2 * NGW) {
            const int mr[2] = {m0, m0 + NGW};
            float4 hv[2][4];
#pragma unroll
            for (int u = 0; u < 2; ++u) { const bf16_t* hr = WSB(WS_HB) + (size_t)mr[u] * DM; const bf16_t* tr = WSB(WS_TMP) + (size_t)mr[u] * DM;
#pragma unroll
                for (int j = 0; j < 4; ++j) { float a[4], t4[4]; ld4bf(hr + 4 * (lane + 64 * j), a); ld4bf(tr + 4 * (lane + 64 * j), t4);
                    hv[u][j] = make_float4(fmaf(ALPHA, a[0], t4[0]), fmaf(ALPHA, a[1], t4[1]), fmaf(ALPHA, a[2], t4[2]), fmaf(ALPHA, a[3], t4[3])); } }
            ln_core2<1>(hv, LN1_G(l), LN1_B(l), nullptr, nullptr, WSB(WS_HB) + (size_t)mr[0] * DM, WSB(WS_HB) + (size_t)mr[1] * DM, lane,
                     p.ws + WS_HB8 + (size_t)mr[0] * DM, p.ws + WS_HB8 + (size_t)mr[1] * DM);
            float acc[2][16];
#pragma unroll
            for (int e = 0; e < 16; ++e) { float a0 = 0.f, a1 = 0.f;
#pragma unroll
                for (int j = 0; j < 4; ++j) { const float4 w = *(const float4*)(RWT + e * DM + 4 * (lane + 64 * j));
                    a0 = fmaf(hv[0][j].x, w.x, a0); a0 = fmaf(hv[0][j].y, w.y, a0); a0 = fmaf(hv[0][j].z, w.z, a0); a0 = fmaf(hv[0][j].w, w.w, a0);
                    a1 = fmaf(hv[1][j].x, w.x, a1); a1 = fmaf(hv[1][j].y, w.y, a1); a1 = fmaf(hv[1][j].z, w.z, a1); a1 = fmaf(hv[1][j].w, w.w, a1); }
                acc[0][e] = a0; acc[1][e] = a1; if (e & 1) __builtin_amdgcn_sched_barrier(0); }
#pragma unroll
            for (int i = 0; i < 8; ++i)
#pragma unroll
                for (int u = 0; u < 2; ++u) { const bool up = lane & 32; const float keep = up ? acc[u][i + 8] : acc[u][i], send = up ? acc[u][i] : acc[u][i + 8]; acc[u][i] = keep + __shfl_xor(send, 32); }
#pragma unroll
            for (int i = 0; i < 4; ++i)
#pragma unroll
                for (int u = 0; u < 2; ++u) { const bool up = lane & 16; const float keep = up ? acc[u][i + 4] : acc[u][i], send = up ? acc[u][i] : acc[u][i + 4]; acc[u][i] = keep + __shfl_xor(send, 16); }
#pragma unroll
            for (int i = 0; i < 2; ++i)
#pragma unroll
                for (int u = 0; u < 2; ++u) { const bool up = lane & 8; const float keep = up ? acc[u][i + 2] : acc[u][i], send = up ? acc[u][i] : acc[u][i + 2]; acc[u][i] = keep + __shfl_xor(send, 8); }
#pragma unroll
            for (int u = 0; u < 2; ++u) { const bool up = lane & 4; const float keep = up ? acc[u][1] : acc[u][0], send = up ? acc[u][0] : acc[u][1]; acc[u][0] = keep + __shfl_xor(send, 4); }
            float lg[2] = {acc[0][0], acc[1][0]};
#pragma unroll
            for (int o = 1; o <= 2; o <<= 1) { const float t0 = __shfl_xor(lg[0], o), t1 = __shfl_xor(lg[1], o); lg[0] += t0; lg[1] += t1; }
            float mx[2] = {lg[0], lg[1]};
#pragma unroll
            for (int o = 4; o <= 32; o <<= 1) { const float t0 = __shfl_xor(mx[0], o), t1 = __shfl_xor(mx[1], o); mx[0] = fmaxf(mx[0], t0); mx[1] = fmaxf(mx[1], t1); }
            const float ex[2] = {expf(lg[0] - mx[0]), expf(lg[1] - mx[1])}; float se[2] = {ex[0], ex[1]};
#pragma unroll
            for (int o = 4; o <= 32; o <<= 1) { const float t0 = __shfl_xor(se[0], o), t1 = __shfl_xor(se[1], o); se[0] += t0; se[1] += t1; }
            if ((lane & 3) == 0) { const int e = ((lane >> 5) & 1) * 8 + ((lane >> 4) & 1) * 4 + ((lane >> 3) & 1) * 2 + ((lane >> 2) & 1);
#pragma unroll
                for (int u = 0; u < 2; ++u) afft[(size_t)((mr[u] / SEQ) * 16 + e) * SEQ + (mr[u] % SEQ)] = ex[u] / se[u]; }
        }
        __syncthreads();
    }
    if constexpr (ST == ST_TOPK) {
        const float* afft = WSF(WS_AFF); int* idx = WSI(WS_IDX); float* gv = WSF(WS_GATEV); int* slot = WSI(WS_SLOT);
        int* hist = (int*)lds; int* ctl = hist + 256; int* scr = hist + 272;
        for (int z = bid; z < NZ; z += G) {
            const int e = z >> 1, b = z & 1; const float* list = afft + (size_t)(b * 16 + e) * SEQ;
            unsigned key[16];
#pragma unroll
            for (int j = 0; j < 16; j += 4) { const float4 x = *(const float4*)(list + tid * 16 + j); key[j] = __float_as_uint(x.x); key[j + 1] = __float_as_uint(x.y); key[j + 2] = __float_as_uint(x.z); key[j + 3] = __float_as_uint(x.w); }
            unsigned prefix = 0u; int need = CAP;
#pragma unroll 1
            for (int shift = 24; shift >= 0; shift -= 8) {
                __syncthreads();
                if (tid < 256) hist[tid] = 0;
                __syncthreads();
#pragma unroll
                for (int j = 0; j < 16; ++j) { const bool in = (shift == 24) || ((key[j] >> (shift + 8)) == (prefix >> (shift + 8))); if (in) atomicAdd(&hist[(key[j] >> shift) & 255u], 1); }
                __syncthreads();
                if (tid < 256) {
                    const int hc = hist[tid]; int inc = hc;
#pragma unroll
                    for (int o = 1; o < 64; o <<= 1) { const int y = __shfl_down(inc, o); if (lane + o < 64) inc += y; }
                    if (lane == 0) scr[wid] = inc;
                    __builtin_amdgcn_s_waitcnt(0xc07f); __builtin_amdgcn_wave_barrier();
                }
                __syncthreads();
                if (tid < 256) {
                    const int hc = hist[tid]; int inc = hc;
#pragma unroll
                    for (int o = 1; o < 64; o <<= 1) { const int y = __shfl_down(inc, o); if (lane + o < 64) inc += y; }
                    int ca = inc - hc;
#pragma unroll
                    for (int w = 1; w < 4; ++w) ca += (w > wid) ? scr[w] : 0;
                    if (ca < need && need <= ca + hc) { ctl[0] = tid; ctl[1] = need - ca; } }
                __syncthreads();
                prefix |= (unsigned)ctl[0] << shift; need = ctl[1];
            }
            int ceq = 0;
#pragma unroll
            for (int j = 0; j < 16; ++j) ceq += (key[j] == prefix) ? 1 : 0;
            int tot; const int beq = block_excl_scan(ceq, scr, tid, tot);
            int csel = 0, eqr = beq; unsigned selmask = 0u;
#pragma unroll
            for (int j = 0; j < 16; ++j) { bool sel = key[j] > prefix; if (key[j] == prefix) { sel = eqr < need; ++eqr; } if (sel) { selmask |= 1u << j; ++csel; } }
            int sl = block_excl_scan(csel, scr, tid, tot);
#pragma unroll
            for (int j = 0; j < 16; ++j) { const int trow = b * SEQ + tid * 16 + j;
                if ((selmask >> j) & 1u) { idx[z * CAP + sl] = trow; gv[z * CAP + sl] = __uint_as_float(key[j]); slot[(size_t)trow * 16 + e] = sl; ++sl; }
                else slot[(size_t)trow * 16 + e] = -1; }
        }
        __syncthreads();
    }
    if constexpr (ST == ST_GATHER) {
        const int* idx = WSI(WS_IDX); const bf16_t* hb = WSB(WS_HB); bf16_t* xe = WSB(WS_XE);
        const int nr = (NZ * CAP - gw + NGW - 1) / NGW; const int myi = (lane < nr) ? (idx[gw + lane * NGW] & (T - 1)) : 0;
        for (int k = 0; k < nr; k += 4) {
            const int k1 = (k + 1 < nr) ? k + 1 : k, k2 = (k + 2 < nr) ? k + 2 : k, k3 = (k + 3 < nr) ? k + 3 : k;
            const uint4* s0 = (const uint4*)(hb + (size_t)__shfl(myi, k) * DM); const uint4* s1 = (const uint4*)(hb + (size_t)__shfl(myi, k1) * DM);
            const uint4* s2 = (const uint4*)(hb + (size_t)__shfl(myi, k2) * DM); const uint4* s3 = (const uint4*)(hb + (size_t)__shfl(myi, k3) * DM);
            const uint4 x0 = s0[lane], y0 = s0[lane + 64], x1 = s1[lane], y1 = s1[lane + 64], x2 = s2[lane], y2 = s2[lane + 64], x3 = s3[lane], y3 = s3[lane + 64];
            { uint4* d = (uint4*)(xe + (size_t)(gw + k * NGW) * DM); d[lane] = x0; d[lane + 64] = y0; }
            if (k + 1 < nr) { uint4* d = (uint4*)(xe + (size_t)(gw + (k + 1) * NGW) * DM); d[lane] = x1; d[lane + 64] = y1; }
            if (k + 2 < nr) { uint4* d = (uint4*)(xe + (size_t)(gw + (k + 2) * NGW) * DM); d[lane] = x2; d[lane + 64] = y2; }
            if (k + 3 < nr) { uint4* d = (uint4*)(xe + (size_t)(gw + (k + 3) * NGW) * DM); d[lane] = x3; d[lane + 64] = y3; }
        }
    }
    if constexpr (ST == ST_EXP_G) {
        pg8::Gemm g{WSB(WS_HB8), WSB(WS_WGU_T), NZ * CAP, 16 * 4096, DM / 2, DM / 2, WSI(WS_IDX)};
        ExpertOrder1 S; S.init(G, bid);
        EpiSwiGLU E{WSB(WS_HID), DEXP};
        pg8::gemm_phase<EpiSwiGLU, ExpertOrder1, true, true, true, true>((PG8_LAS unsigned char*)lds, g, S, E);
    }
    if constexpr (ST == ST_EXP_D) {
        pg8::Gemm g{WSB(WS_HID), WSB(WS_WD_T), NZ * CAP, 16 * 1024, DEXP / 2, DEXP / 2};
        ExpertOrder2 S; S.init(G, bid);
        EpiRowScale E{WSB(WS_YE), DM, WSF(WS_GATEV)};
        pg8::gemm_phase<EpiRowScale, ExpertOrder2, true, true, false, true>((PG8_LAS unsigned char*)lds, g, S, E);
    }
    if constexpr (ST == ST_LN2) {
        const int* slot = WSI(WS_SLOT); const bf16_t* ye = WSB(WS_YE);
        for (int m0 = gw; m0 < T; m0 += 2 * NGW) {
            const int mr[2] = {m0, m0 + NGW};
            int sl[2]; unsigned long long mask[2]; float4 a[2][4];
#pragma unroll
            for (int u = 0; u < 2; ++u) { sl[u] = (lane < 16) ? slot[(size_t)mr[u] * 16 + lane] : -1; }
#pragma unroll
            for (int u = 0; u < 2; ++u) { const bf16_t* hr = WSB(WS_HB) + (size_t)mr[u] * DM;
#pragma unroll
                for (int j = 0; j < 4; ++j) { float x[4]; ld4bf(hr + 4 * (lane + 64 * j), x); a[u][j] = make_float4(ALPHA * x[0], ALPHA * x[1], ALPHA * x[2], ALPHA * x[3]); } }
            mask[0] = __ballot(sl[0] >= 0); mask[1] = __ballot(sl[1] >= 0);
            while (mask[0] | mask[1]) {
#pragma unroll
                for (int u = 0; u < 2; ++u) if (mask[u]) {
                    const int e = __builtin_ctzll(mask[u]); mask[u] &= mask[u] - 1;
                    const bf16_t* yr = ye + ((size_t)(e * 2 + mr[u] / SEQ) * CAP + __shfl(sl[u], e)) * DM;
#pragma unroll
                    for (int j = 0; j < 4; ++j) { float y[4]; ld4bf(yr + 4 * (lane + 64 * j), y); a[u][j].x += y[0]; a[u][j].y += y[1]; a[u][j].z += y[2]; a[u][j].w += y[3]; }
                }
            }
            if (l == 0) ln_core2<0>(a, LN2_G(l), LN2_B(l), nullptr, nullptr, WSB(WS_HB) + (size_t)mr[0] * DM, WSB(WS_HB) + (size_t)mr[1] * DM, lane);
            else ln_core2<2>(a, LN2_G(l), LN2_B(l), h + (size_t)mr[0] * DM, h + (size_t)mr[1] * DM, nullptr, nullptr, lane);
        }
    }
}


#define LAS __attribute__((address_space(3)))
#define XB_TMO      128
#define XB_XCNT(j)  (256  + 64 * (j))
#define XB_XSUB(j)  (1280 + 64 * (j))
#define XB_XGEN(j)  (2304 + 64 * (j))
#define XB_TOP      3328
#define XB_TOPGEN   3392
#define XCD_BAR_WORDS 3456
#define XB_SPIN_CAP (1u << 18)
__device__ __forceinline__ unsigned xb_ld(unsigned* p)              { return __hip_atomic_load(p, __ATOMIC_RELAXED, __HIP_MEMORY_SCOPE_AGENT); }
__device__ __forceinline__ unsigned xb_add(unsigned* p, unsigned v) { return __hip_atomic_fetch_add(p, v, __ATOMIC_RELAXED, __HIP_MEMORY_SCOPE_AGENT); }
__device__ __forceinline__ unsigned xb_xcc_id() { return (unsigned)__builtin_amdgcn_s_getreg((3 << 11) | 20) & 0xFu; }
#define XB_SPIN(cond, bar) do { unsigned _sp = 0; while (cond) { __builtin_amdgcn_s_sleep(1); \
    if ((++_sp & 255u) == 0u) { if (xb_ld(&(bar)[XB_TMO])) break; if (_sp > XB_SPIN_CAP) { atomicAdd(&(bar)[XB_TMO], 1u); break; } } } } while (0)
struct XcdBarrier { unsigned* bar; unsigned x; volatile LAS unsigned* st; };
__device__ __forceinline__ XcdBarrier xcd_barrier_post(unsigned* bar, volatile LAS unsigned* st) {
    XcdBarrier b; b.bar = bar; b.x = xb_xcc_id(); b.st = st;
    if (threadIdx.x == 0) (void)xb_add(&bar[XB_XCNT(b.x)], 1u);
    return b;
}
__device__ __forceinline__ void xcd_barrier_complete(unsigned* bar, unsigned x, unsigned& nloc, unsigned& nx) {
    const unsigned G = gridDim.x * gridDim.y * gridDim.z;
    unsigned sum, cnt, mine, sp = 0u;
    for (;;) {
        sum = 0u; cnt = 0u; mine = 0u;
#pragma unroll
        for (unsigned j = 0; j < 16; ++j) { const unsigned c = xb_ld(&bar[XB_XCNT(j)]); sum += c; cnt += (c > 0u) ? 1u : 0u; mine = (j == x) ? c : mine; }
        if (sum == G) break;
        __builtin_amdgcn_s_sleep(1);
        if ((++sp & 255u) == 0u) { if (xb_ld(&bar[XB_TMO])) break; if (sp > XB_SPIN_CAP) { atomicAdd(&bar[XB_TMO], 1u); break; } }
    }
    nloc = mine > 0u ? mine : 1u; nx = cnt > 0u ? cnt : 1u;
}
__device__ __forceinline__ void xcd_barrier(const XcdBarrier& b) {
    asm volatile("s_waitcnt vmcnt(0)" ::: "memory");
    __syncthreads();
    if (threadIdx.x == 0) {
        unsigned* bar = b.bar; asm volatile("" : "+s"(bar));
        unsigned bx = b.x; asm volatile("" : "+s"(bx));
        __builtin_amdgcn_s_waitcnt(0);
        unsigned nloc = b.st[0], nx = b.st[1];
        if (nloc == 0u) { xcd_barrier_complete(bar, bx, nloc, nx); b.st[0] = nloc; b.st[1] = nx; }
        const unsigned old = xb_add(&bar[XB_XSUB(bx)], 1u);
        const unsigned gen = old / nloc;
        if (old + 1u == (gen + 1u) * nloc) {
            __builtin_amdgcn_fence(__ATOMIC_RELEASE, "agent");
            asm volatile("s_waitcnt vmcnt(0)" ::: "memory");
            const unsigned og = xb_add(&bar[XB_TOP], 1u);
            const unsigned tg = og / nx;
            if (og + 1u == (tg + 1u) * nx) xb_add(&bar[XB_TOPGEN], 1u);
            else XB_SPIN(xb_ld(&bar[XB_TOPGEN]) == tg, bar);
            __builtin_amdgcn_fence(__ATOMIC_ACQUIRE, "agent");
            xb_add(&bar[XB_XGEN(bx)], 1u);
            asm volatile("s_waitcnt vmcnt(0)" ::: "memory");
        } else {
            XB_SPIN(xb_ld(&bar[XB_XGEN(bx)]) == gen, bar);
            __builtin_amdgcn_fence(__ATOMIC_ACQUIRE, "agent");
            asm volatile("s_waitcnt vmcnt(0)" ::: "memory");
        }
    }
    __syncthreads();
}
constexpr int MISC_OFF = 131072 + 320;
constexpr int CW_BAR = 4096;

__global__ void __launch_bounds__(NTHR) mega_fwd(Params p) {
    extern __shared__ __attribute__((aligned(16))) unsigned char lds_raw[];
    float* lds = (float*)lds_raw;
    volatile LAS unsigned* MISC = (volatile LAS unsigned*)((LAS unsigned char*)lds_raw + MISC_OFF);
    if (threadIdx.x < 32) MISC[threadIdx.x] = 0u;
    __syncthreads();
    unsigned char* ws_ = ((const KAS Params*)__builtin_amdgcn_kernarg_segment_ptr())->ws;
    XcdBarrier bar = xcd_barrier_post((unsigned*)(ws_ + WS_CTL) + CW_BAR, MISC + 8);
#define GB() xcd_barrier(bar)
    run_stage<ST_INIT>(0, lds); GB();
    for (int step = 0; step < 2 * 11; ++step) {
        const int l = step / 11, s = step % 11;
        switch (s) {
        case 0: run_stage<ST_PROJ>(l, lds); break;
        case 1: run_stage<ST_PREP>(l, lds); run_stage<ST_GLA1>(l, lds); break;
        case 2: run_stage<ST_SMALLGEMM>(l, lds); run_stage<ST_GLA2>(l, lds); break;
        case 3: run_stage<ST_ATTN>(l, lds); run_stage<ST_GLA3>(l, lds); break;
        case 4: run_stage<ST_MERGE_A>(l, lds); break;
        case 5: run_stage<ST_OUTP>(l, lds); break;
        case 6: run_stage<ST_LN1>(l, lds); break;
        case 7: run_stage<ST_TOPK>(l, lds); break;
        case 8: run_stage<ST_EXP_G>(l, lds); break;
        case 9: run_stage<ST_EXP_D>(l, lds); break;
        default: run_stage<ST_LN2>(l, lds); break;
        }
        if (step + 1 < 2 * 11) GB();
    }
#undef GB
}

template <int ST>
__global__ void __launch_bounds__(NTHR) k_stage(Params p, int l) {
    extern __shared__ __attribute__((aligned(16))) unsigned char lds_raw[];
    run_stage<ST>(l, (float*)lds_raw);
}

template <int ST> static void launch_stage(const Params& p, int l, int grid, hipStream_t stream) {
    static bool attr = false;
    if (!attr) { (void)hipFuncSetAttribute((const void*)k_stage<ST>, hipFuncAttributeMaxDynamicSharedMemorySize, LDS_BYTES); attr = true; }
    hipLaunchKernelGGL(k_stage<ST>, dim3(grid), dim3(NTHR), LDS_BYTES, stream, p, l);
}

extern "C" void kernel_launch(void* const* d_in, const int* in_sizes, int n_in, void* d_out, int out_size, void* d_ws, size_t ws_size, hipStream_t stream) {
    if (n_in != 27 || out_size != T * DM || ws_size < WS_END) {
        fprintf(stderr, "kernel_launch: unexpected shapes: n_in %d out %d ws %zu (need >= %zu)\n", n_in, out_size, ws_size, (size_t)WS_END);
        return;
    }
    Params p{};
    for (int i = 0; i < 27; ++i) p.in[i] = (const float*)d_in[i];
    p.pos = (const int*)d_in[1]; p.out = (float*)d_out; p.ws = (unsigned char*)d_ws;
    const int grid = 256;
#if MEGA
    static bool attr = false;
    if (!attr) { (void)hipFuncSetAttribute((const void*)mega_fwd, hipFuncAttributeMaxDynamicSharedMemorySize, LDS_BYTES); attr = true; }
    (void)hipMemsetAsync((char*)d_ws + WS_CTL, 0, 65536, stream);
    hipLaunchKernelGGL(mega_fwd, dim3(grid), dim3(NTHR), LDS_BYTES, stream, p);
#else
    launch_stage<ST_INIT>(p, 0, grid, stream);
    for (int l = 0; l < 2; ++l) {
        launch_stage<ST_PROJ>(p, l, grid, stream);
        launch_stage<ST_PREP>(p, l, grid, stream);
        launch_stage<ST_SMALLGEMM>(p, l, grid, stream);
        launch_stage<ST_ROPE>(p, l, grid, stream);
        launch_stage<ST_ATTN>(p, l, grid, stream);
        launch_stage<ST_GLAREC>(p, l, grid, stream);
        launch_stage<ST_GLAFIN>(p, l, grid, stream);
        launch_stage<ST_MERGE_A>(p, l, grid, stream);
        launch_stage<ST_MERGE_B>(p, l, grid, stream);
        launch_stage<ST_MERGE_C>(p, l, grid, stream);
        launch_stage<ST_OUTP>(p, l, grid, stream);
        launch_stage<ST_LN1>(p, l, grid, stream);
        launch_stage<ST_TOPK>(p, l, grid, stream);
        launch_stage<ST_EXP_G>(p, l, grid, stream);
        launch_stage<ST_EXP_U>(p, l, grid, stream);
        launch_stage<ST_EXP_D>(p, l, grid, stream);
        launch_stage<ST_LN2>(p, l, grid, stream);
    }
#endif
}
```

```cpp
#include <hip/hip_runtime.h>
#include <cstdio>
#include <cstdint>

#ifndef MEGA
#define MEGA 1
#endif

constexpr int NB = 2, SEQ = 8192, T = NB * SEQ, DM = 1024, DIN = 5824, DINP = 5888;
constexpr int OFF_GATE = 0, OFF_POOL = 3072, OFF_CQ = 3072 + 512, OFF_CKV = 3072 + 896, OFF_KR = 3072 + 1152, OFF_GQ = 3072 + 1184, OFF_GK = 3072 + 1440, OFF_GV = 3072 + 1696, OFF_GR = 3072 + 2208, OFF_GDEC = 3072 + 2720;
constexpr int NE = 16, CAP = 1024, DEXP = 2048, NZ = NB * NE;
constexpr float ALPHA = 1.4142135623730951f;
constexpr float LN_EPS = 1e-5f, RMS_EPS = 1e-6f;
constexpr int NTHR = 512, LDS_BYTES = 147456;

constexpr size_t MiB = 1u << 20;
constexpr size_t WS_CTL = 0;
constexpr size_t WS_ROPE = 1 * MiB;
constexpr size_t WS_AFF = 3 * MiB;
constexpr size_t WS_SLOT = 4 * MiB;
constexpr size_t WS_IDX = 5 * MiB;
constexpr size_t WS_GATEV = 5 * MiB + 256 * 1024;
constexpr size_t WS_WIN_T = 8 * MiB;
constexpr size_t WS_WSMALL = 31 * MiB;
constexpr size_t WSM_UQ = 0, WSM_UKV = 1 * MiB, WSM_MRG = 2 * MiB, WSM_OUT = 5 * MiB, WSM_STRIDE = 7 * MiB;
constexpr size_t WS_RQ = 6 * MiB;
constexpr size_t WS_HB = 958 * MiB;
constexpr size_t WS_WGU_T = 76 * MiB;
constexpr size_t WS_WD_T = 204 * MiB;
constexpr size_t WS_PROJB = 268 * MiB;
constexpr size_t WS_XE = 268 * MiB;
constexpr size_t WS_HID = 332 * MiB;
constexpr size_t WS_YE = 460 * MiB;
constexpr size_t WS_BR = 452 * MiB;
constexpr size_t WS_HB8 = 500 * MiB;
constexpr size_t WS_QB = 556 * MiB;
constexpr size_t WS_KB = 580 * MiB;
constexpr size_t WS_VB = 604 * MiB;
constexpr size_t WS_KVT = 702 * MiB;
constexpr size_t WS_ST = 766 * MiB;
constexpr size_t WS_DEC = 798 * MiB;
constexpr size_t WS_MERGEDB = 830 * MiB;
constexpr size_t WS_TMP = 894 * MiB;
constexpr size_t WS_END = 990 * MiB;
static_assert(WS_YE + 64 * MiB <= WS_QB, "overlay map");

namespace pg8 {
#define PG8_LAS __attribute__((address_space(3)))
typedef unsigned short bf16_t;
typedef short bf16x8 __attribute__((ext_vector_type(8)));
typedef float f32x4 __attribute__((ext_vector_type(4)));
typedef unsigned u32x4 __attribute__((ext_vector_type(4)));
constexpr int BM = 256, BK = 64, HALF = 128, HTB = HALF * BK * 2  , STAGE_BYTES = 8 * HTB, NXCD = 8, WGM = 8;

__host__ __device__ __forceinline__ int lds_byte(int r, int c) { const int st = (r >> 4) * 2 + (c >> 5), rr = r & 15, cc = c & 31, ob = rr * 64 + cc * 2; return st * 1024 + (ob ^ (((ob >> 9) & 1) << 5)); }
__host__ __device__ __forceinline__ void stage_rc(int b, int& R, int& C) { const int st = b / 1024, sb = b % 1024, swz = sb ^ (((sb >> 9) & 1) << 5); R = (st >> 1) * 16 + swz / 64; C = (st & 1) * 32 + (swz % 64) / 2; }
__host__ __device__ __forceinline__ int perm32(int rho) { const int n = rho >> 4, i = rho & 15; return 8 * (i >> 2) + 4 * n + (i & 3); }

struct Unit { int pm, pn; };
struct Gemm { const bf16_t* A; const bf16_t* Bt; int M, N, K, lda; const int* ridx; };

struct StaticOrder {
    int nM, nN, nwg, G, c;
    __host__ __device__ void init(int M, int N, int G_, int c_) { nM = M / BM; nN = N / BM; nwg = nM * nN; G = G_; c = c_; }
    __host__ __device__ bool next(int i, Unit& u) const {
        const long L = (long)i * G + c; if (L >= nwg) return false;
        int wgid = (int)L; { const int q = nwg / NXCD, r = nwg % NXCD, xcd = wgid % NXCD, off = wgid / NXCD; wgid = (xcd < r ? xcd * (q + 1) : r * (q + 1) + (xcd - r) * q) + off; }
        const int nig = WGM * nN, gid = wgid / nig, fm = gid * WGM, gsz = (nM - fm) < WGM ? (nM - fm) : WGM;
        u.pm = fm + ((wgid % nig) % gsz); u.pn = (wgid % nig) / gsz; return true;
    }
    __device__ __forceinline__ void a_ready(const Unit&) const {}
    __device__ __forceinline__ void done(const Unit&) const {}
};

__device__ __forceinline__ unsigned cvt_pk_bf16(float lo, float hi) { unsigned r; asm volatile("v_cvt_pk_bf16_f32 %0, %1, %2" : "=v"(r) : "v"(lo), "v"(hi)); return r; }
typedef float f32x2 __attribute__((ext_vector_type(2)));
__device__ __forceinline__ f32x2 gelu_pk(f32x2 v) {
    const f32x2 av = __builtin_elementwise_abs(v), d = av * 0.2316418882f + 1.0f;
    f32x2 t; t.x = __builtin_amdgcn_rcpf(d.x); t.y = __builtin_amdgcn_rcpf(d.y);
    f32x2 q = t * 0.5307027145f + (-0.7265760135f); q = q * t + 0.7107068705f; q = q * t + (-0.142248368f); q = q * t + 0.127414796f; q = q * t;
    const f32x2 s = (v * v) * (-0.72134752044f);
    f32x2 e; e.x = __builtin_amdgcn_exp2f(s.x); e.y = __builtin_amdgcn_exp2f(s.y);
    const f32x2 m = v * (q * e), r = v - m;
    f32x2 o; o.x = v.x < 0.f ? m.x : r.x; o.y = v.y < 0.f ? m.y : r.y; return o;
}

template <int ACT  > struct EpiBf16 {
    static constexpr bool PERM = true, AFTER_DRAIN = false; static constexpr int SEG = 0; static_assert(ACT == 0 || ACT == 1, "EpiBf16: ACT is 0 (none) or 1 (gelu_pk)");
    bf16_t* O; int ldc; const float* bias; int split_cols; size_t split_stride; float scale0;
    __device__ __forceinline__ void operator()(const f32x4 (&acc)[2][2][4][2], const Unit& u, int wr, int wc, int fr, int fq) const {
        const int row0 = u.pm * BM + wr * 64 + fr; int colt = u.pn * BM; bf16_t* base = O;
        float sc = 1.f; if (split_cols) { const int t = colt / split_cols; base += (size_t)t * split_stride; colt -= t * split_cols; if (t == 0) sc = scale0; }
        const int col0 = colt + wc * 32 + 8 * fq, bcol0 = u.pn * BM + wc * 32 + 8 * fq;
        f32x4 bv[2][2];
#pragma unroll
        for (int bj = 0; bj < 2; ++bj)
#pragma unroll
            for (int n = 0; n < 2; ++n) bv[bj][n] = bias ? *(const f32x4*)(bias + bcol0 + bj * HALF + 4 * n) : (f32x4){0.f, 0.f, 0.f, 0.f};
#pragma unroll
        for (int ai = 0; ai < 2; ++ai)
#pragma unroll
            for (int m = 0; m < 4; ++m) { bf16_t* rowp = base + (size_t)(row0 + ai * HALF + m * 16) * ldc + col0;
#pragma unroll
                for (int bj = 0; bj < 2; ++bj) { f32x4 v0 = acc[ai][bj][m][0] + bv[bj][0], v1 = acc[ai][bj][m][1] + bv[bj][1];
                    if (ACT == 1) { f32x2 a = gelu_pk((f32x2){v0[0], v0[1]}), b = gelu_pk((f32x2){v0[2], v0[3]}), c = gelu_pk((f32x2){v1[0], v1[1]}), d = gelu_pk((f32x2){v1[2], v1[3]});
                        v0 = (f32x4){a.x, a.y, b.x, b.y}; v1 = (f32x4){c.x, c.y, d.x, d.y}; }
                    v0 = v0 * sc; v1 = v1 * sc; u32x4 w; w.x = cvt_pk_bf16(v0[0], v0[1]); w.y = cvt_pk_bf16(v0[2], v0[3]); w.z = cvt_pk_bf16(v1[0], v1[1]); w.w = cvt_pk_bf16(v1[2], v1[3]);
                    *(u32x4*)(rowp + bj * HALF) = w; } }
    }
};

struct PanelStats {
    unsigned* xbuf;
    unsigned* cnt;
    unsigned* tmo;
    int ntn; float eps;
    unsigned code;
    __device__ __forceinline__ bool run(const f32x4 (&v)[2][2][4][2], const Unit& u, int wr, int wc, int fr, int fq, PG8_LAS unsigned char* lds, int wid, int lane) const {
        typedef float f32x2v __attribute__((ext_vector_type(2)));
        PG8_LAS f32x2v* P = (PG8_LAS f32x2v*)lds;
        PG8_LAS f32x2v* S = (PG8_LAS f32x2v*)(lds + 8192);
        PG8_LAS unsigned* flag = (PG8_LAS unsigned*)(lds + 8192 + 2048);
#pragma unroll
        for (int ai = 0; ai < 2; ++ai)
#pragma unroll
            for (int m = 0; m < 4; ++m) {
                float s = 0.f;
#pragma unroll
                for (int bj = 0; bj < 2; ++bj)
#pragma unroll
                    for (int n = 0; n < 2; ++n) { const f32x4 x = v[ai][bj][m][n]; s += (x[0] + x[1]) + (x[2] + x[3]); }
                s += __shfl_xor(s, 16); s += __shfl_xor(s, 32);
                const float mw = s * (1.0f / 64.0f); float q = 0.f;
#pragma unroll
                for (int bj = 0; bj < 2; ++bj)
#pragma unroll
                    for (int n = 0; n < 2; ++n) { const f32x4 d = v[ai][bj][m][n] - mw; q += (d[0] * d[0] + d[1] * d[1]) + (d[2] * d[2] + d[3] * d[3]); }
                q += __shfl_xor(q, 16); q += __shfl_xor(q, 32);
                if (fq == 0) P[(ai * HALF + wr * 64 + m * 16 + fr) * 4 + wc] = (f32x2v){mw, q};
            }
        asm volatile("s_waitcnt lgkmcnt(0)" ::: "memory"); __builtin_amdgcn_s_barrier(); asm volatile("" ::: "memory");
#if defined(BROKEN_EXCHANGE_NO_WAIT)
#warning BROKEN CONTROL BUILD: the row-statistics exchange does not wait; results are wrong by design
        if (blockIdx.x >= 64) { const long long t0_ = clock64(); while (clock64() - t0_ < 60000) __builtin_amdgcn_s_sleep(8); }
#endif
        const int row = wid * 32 + (lane & 31);
        if (lane < 32) {
            const f32x2v a = P[row * 4 + 0], b = P[row * 4 + 1], c = P[row * 4 + 2], d = P[row * 4 + 3];
            const float mt = (a.x + b.x + c.x + d.x) * 0.25f;
            const float da = a.x - mt, db = b.x - mt, dc = c.x - mt, dd = d.x - mt;
            const float m2 = (a.y + b.y) + (c.y + d.y) + 64.0f * ((da * da + db * db) + (dc * dc + dd * dd));
            unsigned long long* slot = (unsigned long long*)xbuf + ((size_t)(u.pm * BM + row) * 4 + u.pn);
            __hip_atomic_store(slot, ((unsigned long long)__float_as_uint(m2) << 32) | __float_as_uint(mt), __ATOMIC_RELAXED, __HIP_MEMORY_SCOPE_AGENT);
        }
        asm volatile("s_waitcnt vmcnt(0)" ::: "memory");
        if (lane == 0) __hip_atomic_fetch_add(cnt + 64 * u.pm, 1u, __ATOMIC_RELAXED, __HIP_MEMORY_SCOPE_AGENT);
        if (wid == 0) {
            bool dead = false; const unsigned long long t0 = __builtin_amdgcn_s_memrealtime(); const unsigned want = 8u * (unsigned)ntn;
            for (;;) {
#if defined(BROKEN_EXCHANGE_NO_WAIT)
                break;
#endif
                if ((unsigned)__builtin_amdgcn_readfirstlane(__hip_atomic_load(cnt + 64 * u.pm, __ATOMIC_RELAXED, __HIP_MEMORY_SCOPE_AGENT)) >= want) break;
                if (__builtin_amdgcn_s_memrealtime() - t0 > 2000000ull) {
                    if (lane == 0) { unsigned expect = 0u; __hip_atomic_compare_exchange_strong(tmo + 1, &expect, code | (unsigned)(u.pm & 0xff), __ATOMIC_RELAXED, __ATOMIC_RELAXED, __HIP_MEMORY_SCOPE_AGENT);
                                     __hip_atomic_store(tmo, 1u, __ATOMIC_RELAXED, __HIP_MEMORY_SCOPE_AGENT); }
                    dead = true; break; }
                __builtin_amdgcn_s_sleep(2);
            }
            __builtin_amdgcn_fence(__ATOMIC_ACQUIRE, "agent");
            if (lane == 0) flag[0] = dead ? 1u : 0u;
        }
        asm volatile("s_waitcnt vmcnt(0) lgkmcnt(0)" ::: "memory"); __builtin_amdgcn_s_barrier(); asm volatile("" ::: "memory");
        const bool bad = flag[0] != 0u;
        if (lane < 32) {
            const unsigned long long* slot = (const unsigned long long*)xbuf + (size_t)(u.pm * BM + row) * 4; float mt[4], m2[4]; float ms = 0.f;
#pragma unroll
            for (int t = 0; t < 4; ++t) { if (t < ntn) { const unsigned long long w = __hip_atomic_load(slot + t, __ATOMIC_RELAXED, __HIP_MEMORY_SCOPE_AGENT); mt[t] = __uint_as_float((unsigned)w); m2[t] = __uint_as_float((unsigned)(w >> 32)); } else { mt[t] = 0.f; m2[t] = 0.f; } ms += mt[t]; }
            const float mean = ms / (float)ntn; float q = 0.f;
#pragma unroll
            for (int t = 0; t < 4; ++t) if (t < ntn) { const float dm = mt[t] - mean; q += m2[t] + 256.0f * dm * dm; }
            S[row] = (f32x2v){mean, 1.0f / sqrtf(q / (256.0f * (float)ntn) + eps)};
        }
        asm volatile("s_waitcnt lgkmcnt(0)" ::: "memory"); __builtin_amdgcn_s_barrier(); asm volatile("" ::: "memory");
        return bad;
    }
};
struct EpiLnRes {
    static constexpr bool PERM = false, AFTER_DRAIN = true; static constexpr int SEG = 0;
    const float* base; float* out; int ldc; const float* bias; PanelStats st; unsigned poison;
    __device__ __forceinline__ void fused(f32x4 (&acc)[2][2][4][2], const Unit& u, int wr, int wc, int fr, int fq, PG8_LAS unsigned char* lds, int wid, int lane) const {
        typedef float f32x2v __attribute__((ext_vector_type(2)));
        const PG8_LAS f32x2v* S = (const PG8_LAS f32x2v*)(lds + 8192);
        const int col0 = u.pn * BM + wc * 32 + 4 * fq;
#pragma unroll
        for (int bj = 0; bj < 2; ++bj)
#pragma unroll
            for (int n = 0; n < 2; ++n) { const f32x4 bv = bias ? *(const f32x4*)(bias + col0 + bj * HALF + n * 16) : (f32x4){0.f, 0.f, 0.f, 0.f};
#pragma unroll
                for (int ai = 0; ai < 2; ++ai)
#pragma unroll
                    for (int m = 0; m < 4; ++m) acc[ai][bj][m][n] += bv; }
        f32x4 pre[4][2][2];
#pragma unroll
        for (int m = 0; m < 4; ++m) { const size_t off = (size_t)(u.pm * BM + wr * 64 + m * 16 + fr) * ldc + col0;
#pragma unroll
            for (int bj = 0; bj < 2; ++bj)
#pragma unroll
                for (int n = 0; n < 2; ++n) pre[m][bj][n] = *(const f32x4*)(base + off + bj * HALF + n * 16); }
        const bool bad = st.run(acc, u, wr, wc, fr, fq, lds, wid, lane) || poison != 0u;
        const float qnan = __builtin_nanf("");
#pragma unroll
        for (int ai = 0; ai < 2; ++ai)
#pragma unroll
            for (int m = 0; m < 4; ++m) { const int r = ai * HALF + wr * 64 + m * 16 + fr; const f32x2v sr = S[r]; const size_t off = (size_t)(u.pm * BM + r) * ldc + col0;
#pragma unroll
                for (int bj = 0; bj < 2; ++bj)
#pragma unroll
                    for (int n = 0; n < 2; ++n) { const f32x4 bs = ai == 0 ? pre[m][bj][n] : *(const f32x4*)(base + off + bj * HALF + n * 16); f32x4 o = bs + (acc[ai][bj][m][n] - sr.x) * sr.y;
                        if (bad) o = (f32x4){qnan, qnan, qnan, qnan}; *(f32x4*)(out + off + bj * HALF + n * 16) = o; }
                if (m & 1) asm volatile("" ::: "memory"); }
    }
};
struct EpiLnResLn {
    static constexpr bool PERM = false, AFTER_DRAIN = true; static constexpr int SEG = 0;
    const float* base; float* out; bf16_t* xn; int ldc; const float* bias; PanelStats st1, st2; unsigned poison;
    __device__ __forceinline__ void fused(f32x4 (&acc)[2][2][4][2], const Unit& u, int wr, int wc, int fr, int fq, PG8_LAS unsigned char* lds, int wid, int lane) const {
        typedef float f32x2v __attribute__((ext_vector_type(2))); typedef unsigned u32x2v __attribute__((ext_vector_type(2)));
        const PG8_LAS f32x2v* S = (const PG8_LAS f32x2v*)(lds + 8192);
        const int col0 = u.pn * BM + wc * 32 + 4 * fq;
#pragma unroll
        for (int bj = 0; bj < 2; ++bj)
#pragma unroll
            for (int n = 0; n < 2; ++n) { const f32x4 bv = bias ? *(const f32x4*)(bias + col0 + bj * HALF + n * 16) : (f32x4){0.f, 0.f, 0.f, 0.f};
#pragma unroll
                for (int ai = 0; ai < 2; ++ai)
#pragma unroll
                    for (int m = 0; m < 4; ++m) acc[ai][bj][m][n] += bv; }
        bool bad = st1.run(acc, u, wr, wc, fr, fq, lds, wid, lane) || poison != 0u;
        const float qnan = __builtin_nanf("");
#pragma unroll
        for (int ai = 0; ai < 2; ++ai)
#pragma unroll
            for (int m = 0; m < 4; ++m) { const int r = ai * HALF + wr * 64 + m * 16 + fr; const f32x2v sr = S[r]; const size_t off = (size_t)(u.pm * BM + r) * ldc + col0;
#pragma unroll
                for (int bj = 0; bj < 2; ++bj)
#pragma unroll
                    for (int n = 0; n < 2; ++n) { const f32x4 bs = *(const f32x4*)(base + off + bj * HALF + n * 16); acc[ai][bj][m][n] = bs + (acc[ai][bj][m][n] - sr.x) * sr.y; }
                asm volatile("" : "+v"(acc[ai][0][m][0]), "+v"(acc[ai][0][m][1]), "+v"(acc[ai][1][m][0]), "+v"(acc[ai][1][m][1]));
                if (m & 1) asm volatile("" ::: "memory"); }
        const bool bad1 = bad;
        bad = st2.run(acc, u, wr, wc, fr, fq, lds, wid, lane) || bad;
#pragma unroll
        for (int ai = 0; ai < 2; ++ai)
#pragma unroll
            for (int m = 0; m < 4; ++m) { const int r = ai * HALF + wr * 64 + m * 16 + fr; const f32x2v sr = S[r]; const size_t off = (size_t)(u.pm * BM + r) * ldc + col0;
#pragma unroll
                for (int bj = 0; bj < 2; ++bj)
#pragma unroll
                    for (int n = 0; n < 2; ++n) { const f32x4 x1 = acc[ai][bj][m][n]; *(f32x4*)(out + off + bj * HALF + n * 16) = bad1 ? (f32x4){qnan, qnan, qnan, qnan} : x1;
                        const f32x4 o = (x1 - sr.x) * sr.y; u32x2v w; w.x = cvt_pk_bf16(o[0], o[1]); w.y = cvt_pk_bf16(o[2], o[3]);
                        if (bad) { w.x = 0x7fc07fc0u; w.y = 0x7fc07fc0u; } *(u32x2v*)(xn + off + bj * HALF + n * 16) = w; }
                asm volatile("" ::: "memory"); }
    }
};

template <class Epi, class Sched, bool ALIGN_EPI = false, bool SP2 = false, bool GATHER = false, bool FP8 = false>
__device__ __forceinline__ void gemm_phase(PG8_LAS unsigned char* lds, const Gemm g, const Sched& S, const Epi& E) {
    int tid_ = threadIdx.x; asm volatile("" : "+v"(tid_));
    const int tid = tid_, wid = __builtin_amdgcn_readfirstlane(tid >> 6), lane = tid & 63, wr = wid >> 2, wc = wid & 3, fr = lane & 15, fq = lane >> 4;
    int K_ = g.K; asm volatile("" : "+s"(K_));
    const int K = K_, nt = K / BK;
    unsigned voffA[2], voffB[2];
#pragma unroll
    for (int i = 0; i < 2; ++i) { int R, C; stage_rc(tid * 16 + i * 8192, R, C); const int Rb = Epi::PERM ? ((R & ~31) + perm32(R & 31)) : R;
        voffA[i] = (unsigned)(R * g.lda + C) * 2u; voffB[i] = (unsigned)(Rb * K + C) * 2u; }
    const size_t kstep = (size_t)(BK * 2);
    static_assert(!GATHER || SP2, "GATHER is implemented for the SP2 loop");
    const size_t hstepB = (size_t)HALF * K * 2, hstepA = GATHER ? 0 : (size_t)HALF * g.lda * 2;
    const size_t tstepB = 2 * hstepB, tstepA = GATHER ? 0 : 2 * hstepA;
    const unsigned ldsw = (unsigned)wid * 1024u;
    const int aoffk[2] = {lds_byte(wr * 64 + fr, FP8 ? 16 * fq : 8 * fq), lds_byte(wr * 64 + fr, FP8 ? 16 * fq + 8 : 8 * fq + 32)};
    const int boffk[2] = {lds_byte(wc * 32 + fr, FP8 ? 16 * fq : 8 * fq), lds_byte(wc * 32 + fr, FP8 ? 16 * fq + 8 : 8 * fq + 32)};
#define PG8_SA(b, h) (((b) * 2 + (h)) * HTB)
#define PG8_SB(b, h) ((4 + (b) * 2 + (h)) * HTB)
#define PG8_STAGE(bufoff, gbase, voff) do { _Pragma("unroll") for (int _i = 0; _i < 2; ++_i) \
        __builtin_amdgcn_global_load_lds((const unsigned*)((const char*)(gbase) + (voff)[_i]), (PG8_LAS unsigned*)(lds + (bufoff) + ldsw + _i * 8192), 16, 0, 0); } while (0)
    typedef int i32x4_ __attribute__((ext_vector_type(4))); typedef int i32x8_ __attribute__((ext_vector_type(8)));
#define PG8_LD16(off) (*(const PG8_LAS i32x4_*)(lds + (off)))
#define PG8_LDA(dst, b, h) do { _Pragma("unroll") for (int m = 0; m < 4; ++m) { \
        if constexpr (FP8) dst##8[m] = *(const PG8_LAS i32x8_*)(lds + PG8_SA(b, h) + aoffk[0] + m * 2048);     \
        else { _Pragma("unroll") for (int k = 0; k < 2; ++k) dst[m][k] = *(const PG8_LAS bf16x8*)(lds + PG8_SA(b, h) + aoffk[k] + m * 2048); } } } while (0)
#define PG8_LDB(dst, b, h) do { _Pragma("unroll") for (int n = 0; n < 2; ++n) { \
        if constexpr (FP8) dst##8[n] = *(const PG8_LAS i32x8_*)(lds + PG8_SB(b, h) + boffk[0] + n * 2048); \
        else { _Pragma("unroll") for (int k = 0; k < 2; ++k) dst[n][k] = *(const PG8_LAS bf16x8*)(lds + PG8_SB(b, h) + boffk[k] + n * 2048); } } } while (0)
#define PG8_MMA(ai, bj, At, Bt) do { __builtin_amdgcn_s_setprio(1); _Pragma("unroll") for (int m = 0; m < 4; ++m) _Pragma("unroll") for (int n = 0; n < 2; ++n) { \
        if constexpr (FP8) asm volatile("s_nop 1\n\tv_mfma_scale_f32_16x16x128_f8f6f4 %0, %1, %2, %0, %3, %3 op_sel_hi:[0,0,0]" : "+v"(acc[ai][bj][m][n]) : "v"(Bt##8[n]), "v"(At##8[m]), "v"(sc1_));     \
        else { _Pragma("unroll") for (int k = 0; k < 2; ++k) acc[ai][bj][m][n] = __builtin_amdgcn_mfma_f32_16x16x32_bf16(Bt[n][k], At[m][k], acc[ai][bj][m][n], 0, 0, 0); } } \
        __builtin_amdgcn_s_setprio(0); } while (0)
#define PG8_WAIT_V(n) asm volatile("s_waitcnt vmcnt(" #n ")" ::: "memory")
#define PG8_WAIT_L(n) asm volatile("s_waitcnt lgkmcnt(" #n ")" ::: "memory")
#define PG8_BAR __builtin_amdgcn_s_barrier()
#define PG8_SCHED __builtin_amdgcn_sched_barrier(0)
    Unit cur, nxt; int ui = 0;
    if (!S.next(0, cur)) return;
    unsigned vC0[2] = {voffA[0], voffA[1]}, vC1[2] = {voffA[0], voffA[1]}, vN0[2] = {voffA[0], voffA[1]}, vN1[2] = {voffA[0], voffA[1]};
    int gR[2], gC[2];
#pragma unroll
    for (int i = 0; i < 2; ++i) { stage_rc(tid * 16 + i * 8192, gR[i], gC[i]); }
    if constexpr (GATHER) {
#pragma unroll
        for (int i = 0; i < 2; ++i) { vC0[i] = (unsigned)(g.ridx[cur.pm * 256 + gR[i]] * g.lda + gC[i]) * 2u; vC1[i] = (unsigned)(g.ridx[cur.pm * 256 + 128 + gR[i]] * g.lda + gC[i]) * 2u; }
    }
    f32x4 acc[2][2][4][2];
#pragma unroll
    for (int a = 0; a < 2; ++a)
#pragma unroll
        for (int b = 0; b < 2; ++b)
#pragma unroll
            for (int m = 0; m < 4; ++m)
#pragma unroll
                for (int n = 0; n < 2; ++n) acc[a][b][m][n] = (f32x4){0.f, 0.f, 0.f, 0.f};
    const int sc1_ = 0x7f7f7f7f;
    bf16x8 At[4][2], B0[2][2], B1[2][2]; i32x8_ At8[4], B08[2], B18[2];
    const char* cA = (const char*)g.A + (size_t)cur.pm * tstepA; const char* cB = (const char*)g.Bt + (size_t)cur.pn * tstepB;
    S.a_ready(cur);
    if constexpr (SP2) {
        PG8_STAGE(PG8_SB(0, 0), cB, voffB); PG8_STAGE(PG8_SB(0, 1), cB + hstepB, voffB); PG8_STAGE(PG8_SA(0, 0), cA, vC0); PG8_STAGE(PG8_SA(0, 1), cA + hstepA, vC1);
        if (wr == 1) PG8_BAR;
        PG8_WAIT_V(2); PG8_BAR;
        PG8_STAGE(PG8_SB(1, 0), cB + kstep, voffB); PG8_STAGE(PG8_SA(1, 0), cA + kstep, vC0); PG8_STAGE(PG8_SB(1, 1), cB + hstepB + kstep, voffB);
        PG8_WAIT_V(6); PG8_BAR;
    } else {
        PG8_STAGE(PG8_SB(0, 0), cB, voffB); PG8_STAGE(PG8_SA(0, 0), cA, voffA); PG8_STAGE(PG8_SB(0, 1), cB + hstepB, voffB); PG8_STAGE(PG8_SA(0, 1), cA + hstepA, voffA);
        if (wr == 1) PG8_BAR;
        PG8_WAIT_V(4); PG8_BAR;
        PG8_STAGE(PG8_SB(1, 0), cB + kstep, voffB); PG8_STAGE(PG8_SA(1, 0), cA + kstep, voffA); PG8_STAGE(PG8_SB(1, 1), cB + hstepB + kstep, voffB);
        PG8_WAIT_V(6); PG8_BAR;
    }
    for (;;) {
        const bool has_next = S.next(ui + 1, nxt);
        int gi0[2] = {0, 0}, gi1[2] = {0, 0};
        if constexpr (GATHER) { if (has_next) {
#pragma unroll
            for (int i = 0; i < 2; ++i) { gi0[i] = g.ridx[nxt.pm * 256 + gR[i]]; gi1[i] = g.ridx[nxt.pm * 256 + 128 + gR[i]]; } } }
        const char* nA = has_next ? (const char*)g.A + (size_t)nxt.pm * tstepA : cA; const char* nB = has_next ? (const char*)g.Bt + (size_t)nxt.pn * tstepB : cB;
        for (int t = 0; t < nt; t += 2) {
            const bool last = (t == nt - 2);
            const char* a1 = cA + (size_t)(t + 1) * kstep;
            const char* a2 = last ? nA : cA + (size_t)(t + 2) * kstep; const char* b2 = last ? nB : cB + (size_t)(t + 2) * kstep;
            const char* a3 = a2 + kstep; const char* b3 = b2 + kstep;
            if (last && has_next) S.a_ready(nxt);
            unsigned v20[2] = {vC0[0], vC0[1]}, v21[2] = {vC1[0], vC1[1]};
            if constexpr (GATHER) { if (last && has_next) {
#pragma unroll
                for (int i = 0; i < 2; ++i) { vN0[i] = (unsigned)(gi0[i] * g.lda + gC[i]) * 2u; vN1[i] = (unsigned)(gi1[i] * g.lda + gC[i]) * 2u; v20[i] = vN0[i]; v21[i] = vN1[i]; } } }
            if constexpr (SP2) {
            PG8_LDB(B0, 0, 0); PG8_LDB(B1, 0, 1); PG8_SCHED; PG8_LDA(At, 0, 0); PG8_STAGE(PG8_SA(1, 1), a1 + hstepA, vC1);
            PG8_WAIT_V(8); PG8_WAIT_L(0); PG8_BAR; PG8_MMA(0, 0, At, B0); PG8_MMA(0, 1, At, B1); PG8_BAR; PG8_SCHED;
            PG8_LDA(At, 0, 1); PG8_STAGE(PG8_SB(0, 0), b2, voffB); PG8_STAGE(PG8_SB(0, 1), b2 + hstepB, voffB); PG8_STAGE(PG8_SA(0, 0), a2, v20);
            PG8_WAIT_V(8); PG8_WAIT_L(0); PG8_BAR; PG8_MMA(1, 0, At, B0); PG8_MMA(1, 1, At, B1); PG8_BAR; PG8_SCHED;
            PG8_LDB(B0, 1, 0); PG8_LDB(B1, 1, 1); PG8_SCHED; PG8_LDA(At, 1, 0); PG8_STAGE(PG8_SA(0, 1), a2 + hstepA, v21);
            PG8_WAIT_V(8); PG8_WAIT_L(0); PG8_BAR; PG8_MMA(0, 0, At, B0); PG8_MMA(0, 1, At, B1); PG8_BAR; PG8_SCHED;
            PG8_LDA(At, 1, 1); PG8_STAGE(PG8_SB(1, 0), b3, voffB); PG8_STAGE(PG8_SB(1, 1), b3 + hstepB, voffB); PG8_STAGE(PG8_SA(1, 0), a3, v20);
            PG8_WAIT_V(8); PG8_WAIT_L(0); PG8_BAR; PG8_MMA(1, 0, At, B0); PG8_MMA(1, 1, At, B1); PG8_BAR; PG8_SCHED;
            if constexpr (Epi::SEG > 0) { if ((t + 2) % Epi::SEG == 0 && t + 2 < nt) E.segment(acc, cur, (t + 2) / Epi::SEG, wr, wc, fr, fq); }
            } else {
            PG8_LDB(B0, 0, 0); PG8_SCHED; PG8_LDA(At, 0, 0); PG8_STAGE(PG8_SA(1, 1), a1 + hstepA, voffA);
            PG8_WAIT_L(8); PG8_BAR; PG8_WAIT_L(0); PG8_MMA(0, 0, At, B0); PG8_BAR; PG8_SCHED;
            PG8_LDB(B1, 0, 1); PG8_STAGE(PG8_SB(0, 0), b2, voffB);
            PG8_BAR; PG8_WAIT_L(0); PG8_MMA(0, 1, At, B1); PG8_BAR;
            PG8_LDA(At, 0, 1); PG8_STAGE(PG8_SA(0, 0), a2, voffA);
            PG8_BAR; PG8_WAIT_L(0); PG8_MMA(1, 0, At, B0); PG8_BAR; PG8_SCHED;
            PG8_STAGE(PG8_SB(0, 1), b2 + hstepB, voffB);
            PG8_WAIT_V(6); PG8_BAR; PG8_MMA(1, 1, At, B1); PG8_BAR;
            PG8_LDB(B0, 1, 0); PG8_SCHED; PG8_LDA(At, 1, 0); PG8_STAGE(PG8_SA(0, 1), a2 + hstepA, voffA);
            PG8_WAIT_L(8); PG8_BAR; PG8_WAIT_L(0); PG8_MMA(0, 0, At, B0); PG8_BAR; PG8_SCHED;
            PG8_LDB(B1, 1, 1); PG8_STAGE(PG8_SB(1, 0), b3, voffB);
            PG8_BAR; PG8_WAIT_L(0); PG8_MMA(0, 1, At, B1); PG8_BAR;
            PG8_LDA(At, 1, 1); PG8_STAGE(PG8_SA(1, 0), a3, voffA);
            PG8_BAR; PG8_WAIT_L(0); PG8_MMA(1, 0, At, B0); PG8_BAR; PG8_SCHED;
            PG8_STAGE(PG8_SB(1, 1), b3 + hstepB, voffB);
            PG8_WAIT_V(6); PG8_BAR; PG8_MMA(1, 1, At, B1); PG8_BAR;
            }
        }
        if constexpr (FP8) asm volatile("s_nop 15\n\ts_nop 3" ::: "memory");
        if constexpr (ALIGN_EPI) { if (wr == 0) PG8_BAR; }
        if constexpr (!Epi::AFTER_DRAIN) { E(acc, cur, wr, wc, fr, fq); S.done(cur); }
        if (!has_next) break;
#pragma unroll
        for (int a = 0; a < 2; ++a)
#pragma unroll
            for (int b = 0; b < 2; ++b)
#pragma unroll
                for (int m = 0; m < 4; ++m)
#pragma unroll
                    for (int n = 0; n < 2; ++n) acc[a][b][m][n] = (f32x4){0.f, 0.f, 0.f, 0.f};
        cur = nxt; cA = nA; cB = nB; ++ui;
        if constexpr (GATHER) { vC0[0] = vN0[0]; vC0[1] = vN0[1]; vC1[0] = vN1[0]; vC1[1] = vN1[1]; }
        if constexpr (ALIGN_EPI) { if (wr == 1) PG8_BAR; }
    }
    PG8_WAIT_V(0);
    if constexpr (!ALIGN_EPI) { if (wr == 0) PG8_BAR; }
    PG8_BAR;
    if constexpr (Epi::AFTER_DRAIN) { E.fused(acc, cur, wr, wc, fr, fq, lds, wid, lane); S.done(cur); }
#undef PG8_SA
#undef PG8_SB
#undef PG8_STAGE
#undef PG8_LDA
#undef PG8_LD16
#undef PG8_LDB
#undef PG8_MMA
#undef PG8_WAIT_V
#undef PG8_WAIT_L
#undef PG8_BAR
#undef PG8_SCHED
}
}

typedef unsigned short bf16_t;
__device__ __forceinline__ unsigned pk4_fp8(float a, float b, float c, float d) { unsigned w = 0u; w = __builtin_amdgcn_cvt_pk_fp8_f32(a, b, w, false); w = __builtin_amdgcn_cvt_pk_fp8_f32(c, d, w, true); return w; }
constexpr float F8_WGU = 64.f, F8_WD = 128.f, F8_HID = 4.f;
typedef unsigned u32x4_t __attribute__((ext_vector_type(4)));
__device__ __forceinline__ void ldg8_dw(float (&o)[8], const void* base, const unsigned (&off)[8]) {
    asm volatile("global_load_dword %0, %9, %8\n\tglobal_load_dword %1, %10, %8\n\tglobal_load_dword %2, %11, %8\n\tglobal_load_dword %3, %12, %8\n\t"
                 "global_load_dword %4, %13, %8\n\tglobal_load_dword %5, %14, %8\n\tglobal_load_dword %6, %15, %8\n\tglobal_load_dword %7, %16, %8\n\ts_waitcnt vmcnt(0)"
                 : "=&v"(o[0]), "=&v"(o[1]), "=&v"(o[2]), "=&v"(o[3]), "=&v"(o[4]), "=&v"(o[5]), "=&v"(o[6]), "=&v"(o[7])
                 : "s"(base), "v"(off[0]), "v"(off[1]), "v"(off[2]), "v"(off[3]), "v"(off[4]), "v"(off[5]), "v"(off[6]), "v"(off[7]) : "memory");
}
template <int I1, int I2, int I3>
__device__ __forceinline__ void ldg8_x4(u32x4_t (&a)[4], u32x4_t (&b)[4], const void* base, unsigned offA, unsigned offB) {
    asm volatile("global_load_dwordx4 %0, %9, %8\n\tglobal_load_dwordx4 %1, %9, %8 offset:%11\n\tglobal_load_dwordx4 %2, %9, %8 offset:%12\n\tglobal_load_dwordx4 %3, %9, %8 offset:%13\n\t"
                 "global_load_dwordx4 %4, %10, %8\n\tglobal_load_dwordx4 %5, %10, %8 offset:%11\n\tglobal_load_dwordx4 %6, %10, %8 offset:%12\n\tglobal_load_dwordx4 %7, %10, %8 offset:%13\n\ts_waitcnt vmcnt(0)"
                 : "=&v"(a[0]), "=&v"(a[1]), "=&v"(a[2]), "=&v"(a[3]), "=&v"(b[0]), "=&v"(b[1]), "=&v"(b[2]), "=&v"(b[3])
                 : "s"(base), "v"(offA), "v"(offB), "i"(I1), "i"(I2), "i"(I3) : "memory");
}
__device__ __forceinline__ void ldg8_x4v(u32x4_t (&o)[8], const void* base, const unsigned (&off)[8]) {
    asm volatile("global_load_dwordx4 %0, %9, %8\n\tglobal_load_dwordx4 %1, %10, %8\n\tglobal_load_dwordx4 %2, %11, %8\n\tglobal_load_dwordx4 %3, %12, %8\n\t"
                 "global_load_dwordx4 %4, %13, %8\n\tglobal_load_dwordx4 %5, %14, %8\n\tglobal_load_dwordx4 %6, %15, %8\n\tglobal_load_dwordx4 %7, %16, %8\n\ts_waitcnt vmcnt(0)"
                 : "=&v"(o[0]), "=&v"(o[1]), "=&v"(o[2]), "=&v"(o[3]), "=&v"(o[4]), "=&v"(o[5]), "=&v"(o[6]), "=&v"(o[7])
                 : "s"(base), "v"(off[0]), "v"(off[1]), "v"(off[2]), "v"(off[3]), "v"(off[4]), "v"(off[5]), "v"(off[6]), "v"(off[7]) : "memory");
}
template <int I1, int I2, int I3>
__device__ __forceinline__ void ldg4_x4(u32x4_t (&a)[4], const void* base, unsigned off) {
    asm volatile("global_load_dwordx4 %0, %5, %4\n\tglobal_load_dwordx4 %1, %5, %4 offset:%6\n\tglobal_load_dwordx4 %2, %5, %4 offset:%7\n\tglobal_load_dwordx4 %3, %5, %4 offset:%8\n\ts_waitcnt vmcnt(0)"
                 : "=&v"(a[0]), "=&v"(a[1]), "=&v"(a[2]), "=&v"(a[3]) : "s"(base), "v"(off), "i"(I1), "i"(I2), "i"(I3) : "memory");
}
__device__ __forceinline__ void bf8_to_f32(const u32x4_t w, float* o) {
    o[0] = __uint_as_float(w.x << 16); o[1] = __uint_as_float(w.x & 0xffff0000u); o[2] = __uint_as_float(w.y << 16); o[3] = __uint_as_float(w.y & 0xffff0000u);
    o[4] = __uint_as_float(w.z << 16); o[5] = __uint_as_float(w.z & 0xffff0000u); o[6] = __uint_as_float(w.w << 16); o[7] = __uint_as_float(w.w & 0xffff0000u);
}
struct ExpertOrder1 {
    int G, v;
    __device__ void init(int G_, int c) { G = G_; v = (G_ % 8 == 0) ? (c % 8) * (G_ / 8) + c / 8 : c; }
    __device__ bool next(int i, pg8::Unit& u) const { const int L = i * G + v; if (L >= 2048) return false; const int e = L >> 7, r = L & 127; u.pm = e * 8 + (r & 7); u.pn = e * 16 + (r >> 3); return true; }
    __device__ __forceinline__ void a_ready(const pg8::Unit&) const {}
    __device__ __forceinline__ void done(const pg8::Unit&) const {}
};
struct ExpertOrder2 {
    int G, v;
    __device__ void init(int G_, int c) { G = G_; v = (G_ % 8 == 0) ? (c % 8) * (G_ / 8) + c / 8 : c; }
    __device__ bool next(int i, pg8::Unit& u) const { const int L = i * G + v; if (L >= 512) return false; const int e = L >> 5, r = L & 31; u.pm = e * 8 + (r & 7); u.pn = e * 4 + (r >> 3); return true; }
    __device__ __forceinline__ void a_ready(const pg8::Unit&) const {}
    __device__ __forceinline__ void done(const pg8::Unit&) const {}
};
__device__ __forceinline__ float silu_fast(float x) { return x * __builtin_amdgcn_rcpf(1.f + __builtin_amdgcn_exp2f(-1.4426950408889634f * x)); }
struct EpiSwiGLU {
    static constexpr bool PERM = true, AFTER_DRAIN = false; static constexpr int SEG = 0;
    bf16_t* O; int ldc;
    __device__ __forceinline__ void operator()(const pg8::f32x4 (&acc)[2][2][4][2], const pg8::Unit& u, int wr, int wc, int fr, int fq) const {
        int row0 = u.pm * 256 + wr * 64 + fr; asm volatile("" : "+v"(row0)); const int col0 = (u.pn & 15) * 128 + wc * 32 + 8 * fq;
#pragma unroll
        for (int ai = 0; ai < 2; ++ai)
#pragma unroll
            for (int m = 0; m < 4; ++m) {
                const pg8::f32x4 g0 = acc[ai][0][m][0], g1 = acc[ai][0][m][1], u0 = acc[ai][1][m][0], u1 = acc[ai][1][m][1];
                constexpr float IG = 1.f / F8_WGU, HS = F8_HID / F8_WGU;
                const unsigned w0 = pk4_fp8(silu_fast(g0[0] * IG) * u0[0] * HS, silu_fast(g0[1] * IG) * u0[1] * HS, silu_fast(g0[2] * IG) * u0[2] * HS, silu_fast(g0[3] * IG) * u0[3] * HS);
                const unsigned w1 = pk4_fp8(silu_fast(g1[0] * IG) * u1[0] * HS, silu_fast(g1[1] * IG) * u1[1] * HS, silu_fast(g1[2] * IG) * u1[2] * HS, silu_fast(g1[3] * IG) * u1[3] * HS);
                *(uint2*)((unsigned char*)O + (size_t)(row0 + ai * 128 + m * 16) * ldc + col0) = make_uint2(w0, w1);
            }
    }
};
struct EpiProj {
    static constexpr bool PERM = true, AFTER_DRAIN = false; static constexpr int SEG = 0;
    bf16_t* O; const float* bias;
    __device__ __forceinline__ void operator()(const pg8::f32x4 (&acc)[2][2][4][2], const pg8::Unit& u, int wr, int wc, int fr, int fq) const {
        int row0 = u.pm * 256 + wr * 64 + fr; asm volatile("" : "+v"(row0)); const int col0 = u.pn * 256 + wc * 32 + 8 * fq; const bool gate = u.pn < 12; constexpr float L2E = 1.4426950408889634f;
        float bias8[2][8];
        if (gate) { u32x4_t t0[4], t1[4]; const unsigned o0 = (unsigned)col0 * 4u; ldg8_x4<16, 512, 528>(t0, t1, bias, o0, o0);
#pragma unroll
            for (int q = 0; q < 4; ++q) { bias8[0][q] = __uint_as_float(t0[0][q]); bias8[0][4 + q] = __uint_as_float(t0[1][q]); bias8[1][q] = __uint_as_float(t0[2][q]); bias8[1][4 + q] = __uint_as_float(t0[3][q]); } }
#pragma unroll
        for (int bj = 0; bj < 2; ++bj) {
            float b[8];
#pragma unroll
            for (int q = 0; q < 8; ++q) b[q] = gate ? bias8[bj][q] : 0.f;
#pragma unroll
            for (int ai = 0; ai < 2; ++ai)
#pragma unroll
                for (int m = 0; m < 4; ++m) { float v[8];
#pragma unroll
                    for (int q = 0; q < 8; ++q) { const float x = acc[ai][bj][m][q >> 2][q & 3]; v[q] = gate ? __builtin_amdgcn_rcpf(1.f + __builtin_amdgcn_exp2f(-(x + b[q]) * L2E)) : x; }
                    pg8::u32x4 w; w.x = pg8::cvt_pk_bf16(v[0], v[1]); w.y = pg8::cvt_pk_bf16(v[2], v[3]); w.z = pg8::cvt_pk_bf16(v[4], v[5]); w.w = pg8::cvt_pk_bf16(v[6], v[7]);
                    *(pg8::u32x4*)(O + (size_t)(row0 + ai * 128 + m * 16) * DINP + col0 + bj * 128) = w; } }
    }
};
struct EpiQ {
    static constexpr bool PERM = false, AFTER_DRAIN = false; static constexpr int SEG = 0;
    bf16_t* Q; const float* rq; const float* rc; const float* rs;
    __device__ __forceinline__ void operator()(const pg8::f32x4 (&acc)[2][2][4][2], const pg8::Unit& u, int wr, int wc, int fr, int fq) const {
        int row0 = u.pm * 256 + wr * 64 + fr; asm volatile("" : "+v"(row0)); constexpr float SC = 0.10206207261596575f * 1.4426950408889634f;
        float sc8[8]; { unsigned off[8];
#pragma unroll
            for (int i = 0; i < 8; ++i) off[i] = (unsigned)(row0 + (i >> 2) * 128 + (i & 3) * 16) * 4u;
            ldg8_dw(sc8, rq, off); }
#pragma unroll
        for (int bj = 0; bj < 2; ++bj) { const int g32 = u.pn * 8 + bj * 4 + wc, col0 = g32 * 32 + 4 * fq; const bool rope = (g32 % 3) == 2;
#pragma unroll
            for (int ai = 0; ai < 2; ++ai) {
                u32x4_t cs4[4], sn4[4];
                if (rope) { u32x4_t t0[4], t1[4];
                    const unsigned o0 = (unsigned)((row0 + ai * 128) * 16 + 4 * fq) * 4u;
                    ldg8_x4<16 * 16 * 4, 32 * 16 * 4, 48 * 16 * 4>(t0, t1, rc, o0, o0 + (unsigned)(T * 16 * 4));
#pragma unroll
                    for (int m = 0; m < 4; ++m) { cs4[m] = t0[m]; sn4[m] = t1[m]; } }
#pragma unroll
                for (int m = 0; m < 4; ++m) { const int row = row0 + ai * 128 + m * 16; const float s = sc8[ai * 4 + m] * SC;
                    pg8::f32x4 v0 = acc[ai][bj][m][0] * s, v1 = acc[ai][bj][m][1] * s;
                    if (rope) { const pg8::f32x4 c4 = __builtin_bit_cast(pg8::f32x4, cs4[m]), s4 = __builtin_bit_cast(pg8::f32x4, sn4[m]);
                        const pg8::f32x4 x1 = v0, x2 = v1; v0 = x1 * c4 - x2 * s4; v1 = x1 * s4 + x2 * c4; }
                    bf16_t* qp = Q + (size_t)row * 768 + col0;
                    *(uint2*)qp = make_uint2(pg8::cvt_pk_bf16(v0[0], v0[1]), pg8::cvt_pk_bf16(v0[2], v0[3]));
                    *(uint2*)(qp + 16) = make_uint2(pg8::cvt_pk_bf16(v1[0], v1[1]), pg8::cvt_pk_bf16(v1[2], v1[3])); } } }
    }
};
struct EpiKV {
    static constexpr bool PERM = true, AFTER_DRAIN = false; static constexpr int SEG = 0;
    bf16_t* K; bf16_t* V; const float* rkv;
    __device__ __forceinline__ void operator()(const pg8::f32x4 (&acc)[2][2][4][2], const pg8::Unit& u, int wr, int wc, int fr, int fq) const {
        int row0 = u.pm * 256 + wr * 64 + fr; asm volatile("" : "+v"(row0));
        float sc8[8]; { unsigned off[8];
#pragma unroll
            for (int i = 0; i < 8; ++i) off[i] = (unsigned)(row0 + (i >> 2) * 128 + (i & 3) * 16) * 4u;
            ldg8_dw(sc8, rkv, off); }
#pragma unroll
        for (int bj = 0; bj < 2; ++bj) { const int head = u.pn * 2 + bj;
#pragma unroll
            for (int ai = 0; ai < 2; ++ai)
#pragma unroll
                for (int m = 0; m < 4; ++m) { const int row = row0 + ai * 128 + m * 16; const float s = sc8[ai * 4 + m];
                    const pg8::f32x4 v0 = acc[ai][bj][m][0] * s, v1 = acc[ai][bj][m][1] * s; pg8::u32x4 w;
                    w.x = pg8::cvt_pk_bf16(v0[0], v0[1]); w.y = pg8::cvt_pk_bf16(v0[2], v0[3]); w.z = pg8::cvt_pk_bf16(v1[0], v1[1]); w.w = pg8::cvt_pk_bf16(v1[2], v1[3]);
                    bf16_t* dst = (wc < 2) ? K + (size_t)row * 768 + head * 96 + wc * 32 + 8 * fq : V + (size_t)row * 512 + head * 64 + (wc - 2) * 32 + 8 * fq;
                    *(pg8::u32x4*)dst = w; } }
    }
};
struct EpiF32 {
    static constexpr bool PERM = true, AFTER_DRAIN = false; static constexpr int SEG = 0;
    float* O; int ldc; const float* rs;
    __device__ __forceinline__ void operator()(const pg8::f32x4 (&acc)[2][2][4][2], const pg8::Unit& u, int wr, int wc, int fr, int fq) const {
        int row0 = u.pm * 256 + wr * 64 + fr; asm volatile("" : "+v"(row0)); const int col0 = u.pn * 256 + wc * 32 + 8 * fq;
#pragma unroll
        for (int ai = 0; ai < 2; ++ai)
#pragma unroll
            for (int m = 0; m < 4; ++m) { const int row = row0 + ai * 128 + m * 16; const float s = rs ? rs[row] : 1.f;
#pragma unroll
                for (int bj = 0; bj < 2; ++bj) { float* op = O + (size_t)row * ldc + col0 + bj * 128;
                    *(pg8::f32x4*)op = acc[ai][bj][m][0] * s; *(pg8::f32x4*)(op + 4) = acc[ai][bj][m][1] * s; } }
    }
};
struct EpiMerge {
    static constexpr bool PERM = true, AFTER_DRAIN = false; static constexpr int SEG = 8;
    bf16_t* O; const bf16_t* GL;
    static __device__ __forceinline__ void ld8(const bf16_t* p, float* o) { const uint4 w = *(const uint4*)p;
        o[0] = __uint_as_float(w.x << 16); o[1] = __uint_as_float(w.x & 0xffff0000u); o[2] = __uint_as_float(w.y << 16); o[3] = __uint_as_float(w.y & 0xffff0000u);
        o[4] = __uint_as_float(w.z << 16); o[5] = __uint_as_float(w.z & 0xffff0000u); o[6] = __uint_as_float(w.w << 16); o[7] = __uint_as_float(w.w & 0xffff0000u); }
    __device__ __forceinline__ void segment(pg8::f32x4 (&acc)[2][2][4][2], const pg8::Unit& u, int seg, int wr, int wc, int fr, int fq) const {
        int row0 = u.pm * 256 + wr * 64 + fr; asm volatile("" : "+v"(row0));
        const unsigned cb = (unsigned)((seg - 1) * 1024 + u.pn * 256 + wc * 32 + 8 * fq) * 2u;
#pragma unroll
        for (int ai = 0; ai < 2; ++ai)
#pragma unroll
            for (int m = 0; m < 4; ++m) {
                u32x4_t ga[4];
                ldg4_x4<2048, 256, 2304>(ga, GL, (unsigned)(row0 + ai * 128 + m * 16) * (unsigned)(DINP * 2) + cb);
#pragma unroll
                for (int bj = 0; bj < 2; ++bj) { float x0[8], x1[8]; bf8_to_f32(ga[bj * 2], x0); bf8_to_f32(ga[bj * 2 + 1], x1);
#pragma unroll
                    for (int q = 0; q < 8; ++q) acc[ai][bj][m][q >> 2][q & 3] *= x0[q] * __builtin_amdgcn_rcpf(x1[q]); } }
    }
    __device__ __forceinline__ void operator()(const pg8::f32x4 (&acc)[2][2][4][2], const pg8::Unit& u, int wr, int wc, int fr, int fq) const {
        int row0 = u.pm * 256 + wr * 64 + fr; asm volatile("" : "+v"(row0)); const int col0 = u.pn * 256 + wc * 32 + 8 * fq;
        const unsigned cb = (unsigned)(2048 + col0) * 2u;
#pragma unroll
        for (int ai = 0; ai < 2; ++ai) {
            u32x4_t g8[8];
            { unsigned off[8];
#pragma unroll
              for (int i = 0; i < 8; ++i) off[i] = (unsigned)(row0 + ai * 128 + (i & 3) * 16) * (unsigned)(DINP * 2) + cb + (i >> 2) * 256u;
              ldg8_x4v(g8, GL, off); }
#pragma unroll
            for (int m = 0; m < 4; ++m) { const int row = row0 + ai * 128 + m * 16;
#pragma unroll
                for (int bj = 0; bj < 2; ++bj) { float x2[8], v[8]; bf8_to_f32(g8[bj * 4 + m], x2);
#pragma unroll
                    for (int q = 0; q < 8; ++q) v[q] = acc[ai][bj][m][q >> 2][q & 3] * x2[q];
                    pg8::u32x4 w; w.x = pg8::cvt_pk_bf16(v[0], v[1]); w.y = pg8::cvt_pk_bf16(v[2], v[3]); w.z = pg8::cvt_pk_bf16(v[4], v[5]); w.w = pg8::cvt_pk_bf16(v[6], v[7]);
                    *(pg8::u32x4*)(O + (size_t)row * DM + col0 + bj * 128) = w; } } }
    }
};
struct EpiRowScale {
    static constexpr bool PERM = true, AFTER_DRAIN = false; static constexpr int SEG = 0;
    bf16_t* O; int ldc; const float* rs;
    __device__ __forceinline__ void operator()(const pg8::f32x4 (&acc)[2][2][4][2], const pg8::Unit& u, int wr, int wc, int fr, int fq) const {
        int row0 = u.pm * 256 + wr * 64 + fr; asm volatile("" : "+v"(row0)); const int col0 = (u.pn & 3) * 256 + wc * 32 + 8 * fq;
        float sc8[8]; { unsigned off[8];
#pragma unroll
            for (int i = 0; i < 8; ++i) off[i] = (unsigned)(row0 + (i >> 2) * 128 + (i & 3) * 16) * 4u;
            ldg8_dw(sc8, rs, off); }
#pragma unroll
        for (int ai = 0; ai < 2; ++ai)
#pragma unroll
            for (int m = 0; m < 4; ++m) { const int row = row0 + ai * 128 + m * 16; const float s = sc8[ai * 4 + m] * (1.f / (F8_WD * F8_HID));
#pragma unroll
                for (int bj = 0; bj < 2; ++bj) { const pg8::f32x4 v0 = acc[ai][bj][m][0] * s, v1 = acc[ai][bj][m][1] * s; pg8::u32x4 w;
                    w.x = pg8::cvt_pk_bf16(v0[0], v0[1]); w.y = pg8::cvt_pk_bf16(v0[2], v0[3]); w.z = pg8::cvt_pk_bf16(v1[0], v1[1]); w.w = pg8::cvt_pk_bf16(v1[2], v1[3]);
                    *(pg8::u32x4*)(O + (size_t)row * ldc + col0 + bj * 128) = w; } }
    }
};
struct Params {
    const float* in[27];
    const int* pos;
    float* out;
    unsigned char* ws;
};

__device__ __forceinline__ float wave_sum(float v) {
#pragma unroll
    for (int o = 1; o < 64; o <<= 1) v += __shfl_xor(v, o);
    return v;
}
__device__ __forceinline__ float sigmoidf_(float x) { return 1.f / (1.f + expf(-x)); }
__device__ __forceinline__ float siluf_(float x) { return x / (1.f + expf(-x)); }
__device__ __forceinline__ float log_sigmoidf_(float x) { return fminf(x, 0.f) - log1pf(expf(-fabsf(x))); }

__device__ __forceinline__ float bf2f(bf16_t u) { return __uint_as_float((unsigned)u << 16); }
__device__ __forceinline__ unsigned f2bf(float f) { unsigned u = __float_as_uint(f); return (u + 0x7fffu + ((u >> 16) & 1u)) >> 16; }
__device__ __forceinline__ unsigned pk2(float lo, float hi) { return f2bf(lo) | (f2bf(hi) << 16); }
__device__ __forceinline__ void ld4bf(const bf16_t* p, float* o) {
    const uint2 w = *(const uint2*)p; o[0] = __uint_as_float(w.x << 16); o[1] = __uint_as_float(w.x & 0xffff0000u); o[2] = __uint_as_float(w.y << 16); o[3] = __uint_as_float(w.y & 0xffff0000u);
}
__device__ __forceinline__ void transpose_block(const float* Wblk, int ldw, bf16_t* dst, int ldt, const float* ks, const float* ns, float* scr, int lane) {
#pragma unroll 8
    for (int i = 0; i < 32; ++i) { const int kk = 2 * i + (lane >> 5); float v = __builtin_nontemporal_load(&Wblk[(size_t)kk * ldw + (lane & 31)]);     if (ks) v *= ks[kk]; if (ns) v *= ns[lane & 31]; scr[kk * 33 + (lane & 31)] = v; }
    asm volatile("s_waitcnt lgkmcnt(0)" ::: "memory");
    const int c = lane & 7;
#pragma unroll
    for (int j = 0; j < 4; ++j) { const int n = (lane >> 3) + 8 * j; const float* s = scr + (8 * c) * 33 + n;
        uint4 o; o.x = pk2(s[0 * 33], s[1 * 33]); o.y = pk2(s[2 * 33], s[3 * 33]); o.z = pk2(s[4 * 33], s[5 * 33]); o.w = pk2(s[6 * 33], s[7 * 33]);
        *(uint4*)(dst + (size_t)n * ldt + 8 * c) = o; }
    asm volatile("s_waitcnt lgkmcnt(0)" ::: "memory");
}

struct WStream {
    const float* gate; const float* up; const float* down;
    unsigned char* wgu_t; unsigned char* wd_t;
    const char* rowp; unsigned rs8, rs1;
    unsigned vo0;
    const float* src; unsigned char* dst; int ldt; float sc;
    int it, it_stride, step, nsteps;
    float v0, v1, v2, v3;
    char* blk; char* blkw;
    __device__ __forceinline__ void init(int gw, int ngw, char* lds_blk, int lane) {
        constexpr int I_ALL = 2 * 16 * 16 * 64 + 16 * 32 * 32;
        nsteps = (gw < I_ALL) ? 8 * ((I_ALL - gw + ngw - 1) / ngw) : 0;
        if (I_ALL % ngw == 0) { const int per_wg = I_ALL / (ngw >> 3); gw = (gw >> 3) * per_wg + (gw & 7); ngw = 8; nsteps = per_wg; }
        it = gw; it_stride = ngw; step = 0; blk = lds_blk; blkw = lds_blk + (lane & 31) * 80 + 4 * (lane >> 5);
        src = gate; rowp = (const char*)gate; rs8 = 0u; rs1 = 0u; vo0 = 0u; dst = wgu_t; ldt = DM; sc = 1.f; v0 = v1 = v2 = v3 = 0.f;
    }
    __device__ __forceinline__ void rare(int lane) {
        if (step >= 8 && step <= nsteps) {
            const int nr = lane >> 1, hf = lane & 1;
            const uint4 a = *(const uint4*)(blk + nr * 80 + hf * 32), b = *(const uint4*)(blk + nr * 80 + hf * 32 + 16);
            unsigned char* q = dst + (size_t)nr * ldt + hf * 32;
            { typedef unsigned u32x4n __attribute__((ext_vector_type(4))); const u32x4n an = {a.x, a.y, a.z, a.w}, bn = {b.x, b.y, b.z, b.w};
              __builtin_nontemporal_store(an, (u32x4n*)q); __builtin_nontemporal_store(bn, (u32x4n*)(q + 16)); }
        }
        if (step < nsteps) {
            constexpr int I_G = 16 * 16 * 64; int ldw;
            if (it < 2 * I_G) { const int up_ = it >= I_G, r_ = up_ ? it - I_G : it, e_ = r_ >> 10, kb_ = (r_ >> 6) & 15, nb_ = r_ & 63, j0_ = nb_ * 32;
                src = (up_ ? up : gate) + (size_t)e_ * DM * DEXP + (size_t)(64 * kb_) * DEXP + j0_; ldw = DEXP;
                dst = wgu_t + (size_t)(e_ * 4096 + 256 * (j0_ >> 7) + (j0_ & 127) + (up_ ? 128 : 0)) * DM + 64 * kb_; ldt = DM; sc = F8_WGU; }
            else { const int r_ = it - 2 * I_G, e_ = r_ >> 10, kb_ = (r_ >> 5) & 31, nb_ = r_ & 31;
                src = down + (size_t)e_ * DEXP * DM + (size_t)(64 * kb_) * DM + 32 * nb_; ldw = DM; dst = wd_t + (size_t)(e_ * 1024 + 32 * nb_) * DEXP + 64 * kb_; ldt = DEXP; sc = F8_WD; }
            it += it_stride;
            rowp = (const char*)src; rs8 = (unsigned)ldw * 32u; rs1 = (unsigned)ldw * 4u;
            vo0 = (unsigned)((4 * (lane >> 5)) * ldw + (lane & 31)) * 4u;
        } else { rowp = (const char*)src; rs8 = 0u; rs1 = 0u; vo0 = (unsigned)(lane & 31) * 4u; }
    }
    __device__ __forceinline__ void tick(int lane) {
        *(unsigned*)(blkw + ((step - 1) & 7) * 8) = pk4_fp8(v0 * sc, v1 * sc, v2 * sc, v3 * sc);
        if ((step & 7) == 0) rare(lane);
        v0 = __builtin_nontemporal_load((const float*)(rowp + vo0)); v1 = __builtin_nontemporal_load((const float*)(rowp + rs1 + vo0));
        v2 = __builtin_nontemporal_load((const float*)(rowp + 2 * rs1 + vo0)); v3 = __builtin_nontemporal_load((const float*)(rowp + 3 * rs1 + vo0));
        rowp += rs8; ++step;
    }
};

namespace att {
using bf16x8 = __attribute__((ext_vector_type(8))) short;
using s16x4  = __attribute__((ext_vector_type(4))) short;
using f32x16 = __attribute__((ext_vector_type(16))) float;
using u32x4  = __attribute__((ext_vector_type(4))) unsigned;
constexpr int NW = 8, QBLK = 32, KVBLK = 64;
constexpr int LDQ = 768, LDK = 768, LDV = 512, LDO = 1536;
constexpr int KROWB = 208;
constexpr int SHM_K = KVBLK * KROWB, SHM_V = KVBLK * 64 * 2;
constexpr int NBUF = 3;
constexpr int SHM_ATTN = NBUF * SHM_V + NBUF * SHM_K + NW * 64 * 4;
constexpr float THR = 8.f;
#define ASBAR() __builtin_amdgcn_sched_barrier(0)
__device__ __forceinline__ int crow(int r, int hi) { return (r & 3) + 8 * (r >> 2) + 4 * hi; }
__device__ __forceinline__ unsigned cvtpk(float lo, float hi) { unsigned r; asm volatile("v_cvt_pk_bf16_f32 %0, %1, %2" : "=v"(r) : "v"(lo), "v"(hi)); return r; }
#define MX3(a, b, c) __builtin_fmaxf(__builtin_fmaxf((a), (b)), (c))
template <bool FIRST>
__device__ __forceinline__ void partialSM(f32x16& p0, f32x16& p1, float& m_ref, f32x16& negm, float& alpha) {
  constexpr float THRL = THR * 1.4426950408889634f;
  float a = MX3(p0[0], p0[1], p1[0]), b = MX3(p0[2], p0[3], p1[1]); a = MX3(a, p1[2], p1[3]);
#pragma unroll
  for (int r = 4; r < 16; r += 4) { a = MX3(a, p0[r], p0[r + 1]); b = MX3(b, p0[r + 2], p0[r + 3]); a = MX3(a, p1[r], p1[r + 1]); b = MX3(b, p1[r + 2], p1[r + 3]); }
  float pmax = fmaxf(a, b);
  { auto rr = __builtin_amdgcn_permlane32_swap(__float_as_uint(pmax), __float_as_uint(pmax), false, false);
    pmax = fmaxf(__uint_as_float(rr[0]), __uint_as_float(rr[1])); }
  alpha = 1.f;
  if (FIRST || !__builtin_expect(__all(pmax <= THRL), 1)) {
    const float dl = FIRST ? pmax : fmaxf(pmax, 0.f); m_ref += dl;
#pragma unroll
    for (int r = 0; r < 16; ++r) { p0[r] -= dl; p1[r] -= dl; }
#pragma unroll
    for (int r = 0; r < 16; ++r) negm[r] = -m_ref;
    asm volatile("" : "+v"(negm));
    if (!FIRST) alpha = __builtin_amdgcn_exp2f(-dl);
  }
#pragma unroll
  for (int r = 0; r < 16; ++r) p0[r] = __builtin_amdgcn_exp2f(p0[r]);
}
#undef MX3
__device__ __forceinline__ void finishSM(f32x16& p0, f32x16& p1, float alpha, float& l_reg, bf16x8& pa0, bf16x8& pa1, bf16x8& pa2, bf16x8& pa3) {
  for (int r = 0; r < 16; ++r) p1[r] = __builtin_amdgcn_exp2f(p1[r]);
  float ps = 0; for (int r = 0; r < 16; ++r) ps += p0[r]; for (int r = 0; r < 16; ++r) ps += p1[r];
  { auto rr = __builtin_amdgcn_permlane32_swap(__float_as_uint(ps), __float_as_uint(ps), false, false);
    ps = __uint_as_float(rr[0]) + __uint_as_float(rr[1]); }
  l_reg = l_reg * alpha + ps;
#define PK4(P, BASE, OUT) do { u32x4 w = {cvtpk(P[BASE + 0], P[BASE + 1]), cvtpk(P[BASE + 2], P[BASE + 3]), cvtpk(P[BASE + 4], P[BASE + 5]), cvtpk(P[BASE + 6], P[BASE + 7])}; \
    OUT = *reinterpret_cast<bf16x8*>(&w); } while (0)
  PK4(p0, 0, pa0); PK4(p0, 8, pa1); PK4(p1, 0, pa2); PK4(p1, 8, pa3);
#undef PK4
}
__device__ __forceinline__ void qkt(f32x16& p0, f32x16& p1, const char* Ks, const bf16x8* qr, const f32x16& negm, int r32, int hi) {
  p0 = negm; p1 = negm;
#pragma unroll
  for (int d0 = 0; d0 < 6; ++d0) { const int cb = d0 * 32 + hi * 16;
    bf16x8 b0 = *reinterpret_cast<const bf16x8*>(Ks + r32 * KROWB + cb);
    bf16x8 b1 = *reinterpret_cast<const bf16x8*>(Ks + (32 + r32) * KROWB + cb);
    p0 = __builtin_amdgcn_mfma_f32_32x32x16_bf16(b0, qr[d0], p0, 0, 0, 0);
    p1 = __builtin_amdgcn_mfma_f32_32x32x16_bf16(b1, qr[d0], p1, 0, 0, 0); }
}
__device__ __forceinline__ int v_st(int k, int c) { const int kk = k;   return ((kk >> 3) * 2 + (c >> 5)) * 512 + ((kk & 7) * 32 + (c & 31)) * 2; }
__device__ __forceinline__ int v_rd_base(int lane) { return ((lane & 3) << 3) | (((lane >> 2) & 3) << 6) | (((lane >> 4) & 1) << 5) | (((lane >> 5) & 1) << 8); }
constexpr int v_rd_off(int d0, int ks, int half) { return d0 * 512 + ks * 2048 + half * 1024; }
template <int OFF> __device__ __forceinline__ s16x4 tr_read(int vb) {
  s16x4 r; asm volatile("ds_read_b64_tr_b16 %0, %1 offset:%2" : "=&v"(r) : "v"(vb), "i"(OFF) : "memory"); return r;
}
template <int D0> __device__ __forceinline__ void pv_one(f32x16& od, int vb, bf16x8 pa0, bf16x8 pa1, bf16x8 pa2, bf16x8 pa3) {
  const s16x4 l0 = tr_read<v_rd_off(D0, 0, 0)>(vb), h0 = tr_read<v_rd_off(D0, 0, 1)>(vb), l1 = tr_read<v_rd_off(D0, 1, 0)>(vb), h1 = tr_read<v_rd_off(D0, 1, 1)>(vb);
  const s16x4 l2 = tr_read<v_rd_off(D0, 2, 0)>(vb), h2 = tr_read<v_rd_off(D0, 2, 1)>(vb), l3 = tr_read<v_rd_off(D0, 3, 0)>(vb), h3 = tr_read<v_rd_off(D0, 3, 1)>(vb);
  asm volatile("s_waitcnt lgkmcnt(0)" ::: "memory"); ASBAR();
#define PK(L, H) (bf16x8){L[0], L[1], L[2], L[3], H[0], H[1], H[2], H[3]}
  od = __builtin_amdgcn_mfma_f32_32x32x16_bf16(pa0, PK(l0, h0), od, 0, 0, 0);
  od = __builtin_amdgcn_mfma_f32_32x32x16_bf16(pa1, PK(l1, h1), od, 0, 0, 0);
  od = __builtin_amdgcn_mfma_f32_32x32x16_bf16(pa2, PK(l2, h2), od, 0, 0, 0);
  od = __builtin_amdgcn_mfma_f32_32x32x16_bf16(pa3, PK(l3, h3), od, 0, 0, 0);
#undef PK
}
__device__ __forceinline__ void pv_d0(f32x16* o, int vb, bf16x8 pa0, bf16x8 pa1, bf16x8 pa2, bf16x8 pa3) {
  pv_one<0>(o[0], vb, pa0, pa1, pa2, pa3); pv_one<1>(o[1], vb, pa0, pa1, pa2, pa3);
}
__device__ __forceinline__ void attn_unit(const bf16_t* Qb, const bf16_t* Kh, const bf16_t* Vh, bf16_t* Ob, int seq, char* lds, WStream& wst) {
  int tid_ = threadIdx.x; asm volatile("" : "+v"(tid_));
  const int tid = tid_, wid = tid >> 6, lane = tid & 63, r32 = lane & 31, hi = lane >> 5;
  char* V_lds = lds; char* K_lds = lds + NBUF * SHM_V;
  float* ws = (float*)(lds + NBUF * SHM_V + NBUF * SHM_K) + wid * 64; float* li_l = ws; float* al_l = ws + 32;
  float m_ref = 0.f, l_reg = 0; f32x16 o[2] = {}; bf16x8 qr[6]; f32x16 negm = {}; asm volatile("" : "+v"(negm));
  const bf16_t* Qw = Qb + (long)(wid * QBLK + r32) * LDQ + hi * 8;
#pragma unroll
  for (int d0 = 0; d0 < 6; ++d0) qr[d0] = *reinterpret_cast<const bf16x8*>(Qw + d0 * 16);
  const bool kact = tid < 384; const int kr = tid / 12, kc = tid - kr * 12, vr = tid >> 3, vc = (tid & 7) * 8, vst0 = v_st(vr, vc);
  const int kst0 = kr * KROWB + kc * 16, kst1 = (kr + 32) * KROWB + kc * 16;
  const int vb0 = (int)(uintptr_t)V_lds + v_rd_base(lane);
  struct { bf16x8 vs, ks0, ks1; } sr_[2];
#define SLOAD(i, k0) do { sr_[i].vs = *reinterpret_cast<const bf16x8*>(&Vh[(long)((k0) + vr) * LDV + vc]); \
    if (kact) { sr_[i].ks0 = *reinterpret_cast<const bf16x8*>(&Kh[(long)((k0) + kr) * LDK + kc * 8]); sr_[i].ks1 = *reinterpret_cast<const bf16x8*>(&Kh[(long)((k0) + 32 + kr) * LDK + kc * 8]); } } while (0)
#define SWRITE(b, i) do { *(bf16x8*)(V_lds + (b) * SHM_V + vst0) = sr_[i].vs; \
    if (kact) { *(bf16x8*)(K_lds + (b) * SHM_K + kst0) = sr_[i].ks0; *(bf16x8*)(K_lds + (b) * SHM_K + kst1) = sr_[i].ks1; } } while (0)
#define SWAIT() asm volatile("s_waitcnt vmcnt(3)" ::: "memory")
#define RESC(a) do { if (__any((a) < 1.f)) { if (hi == 0) al_l[r32] = (a); asm volatile("s_waitcnt lgkmcnt(0)" ::: "memory"); \
    for (int d = 0; d < 2; ++d) for (int r = 0; r < 16; ++r) o[d][r] *= al_l[crow(r, hi)]; } } while (0)
  f32x16 pA0, pA1, pB0, pB1; float alA, alB; bf16x8 pa0, pa1, pa2, pa3; const int NT = seq / KVBLK;
  constexpr int SE = 0, SO = 1;
  int b_prev = 0, b_cur = 1, b_next = 2;
#define ROT() do { b_prev = b_cur; b_cur = b_next; b_next = (b_next == NBUF - 1) ? 0 : b_next + 1; } while (0)
  SLOAD(SE, 0); asm volatile("s_waitcnt vmcnt(0)" ::: "memory"); SWRITE(0, SE);
  SLOAD(SO, KVBLK); if (2 < NT) SLOAD(SE, 2 * KVBLK);
  __syncthreads();
  qkt(pA0, pA1, K_lds, qr, negm, r32, hi); partialSM<true>(pA0, pA1, m_ref, negm, alA);
  SWAIT(); SWRITE(1, SO); __syncthreads();
  for (int j = 1; j + 1 < NT; j += 2) {
    SLOAD(SO, (j + 2) * KVBLK);
    ASBAR(); qkt(pB0, pB1, K_lds + b_cur * SHM_K, qr, negm, r32, hi);
    finishSM(pA0, pA1, alA, l_reg, pa0, pa1, pa2, pa3); ASBAR();
    pv_d0(o, vb0 + b_prev * SHM_V, pa0, pa1, pa2, pa3); partialSM<false>(pB0, pB1, m_ref, negm, alB);
    SWAIT(); SWRITE(b_next, SE);
    RESC(alB); if (wst.step <= wst.nsteps) wst.tick(lane); __syncthreads(); ROT();
    if (j + 3 < NT) SLOAD(SE, (j + 3) * KVBLK);
    ASBAR(); qkt(pA0, pA1, K_lds + b_cur * SHM_K, qr, negm, r32, hi);
    finishSM(pB0, pB1, alB, l_reg, pa0, pa1, pa2, pa3); ASBAR();
    pv_d0(o, vb0 + b_prev * SHM_V, pa0, pa1, pa2, pa3); partialSM<false>(pA0, pA1, m_ref, negm, alA);
    SWAIT(); SWRITE(b_next, SO);
    RESC(alA); if (wst.step <= wst.nsteps) wst.tick(lane); __syncthreads(); ROT();
  }
  ASBAR(); qkt(pB0, pB1, K_lds + b_cur * SHM_K, qr, negm, r32, hi);
  finishSM(pA0, pA1, alA, l_reg, pa0, pa1, pa2, pa3); ASBAR();
  pv_d0(o, vb0 + b_prev * SHM_V, pa0, pa1, pa2, pa3); partialSM<false>(pB0, pB1, m_ref, negm, alB);
  RESC(alB);
  finishSM(pB0, pB1, alB, l_reg, pa0, pa1, pa2, pa3); ASBAR();
  pv_d0(o, vb0 + b_cur * SHM_V, pa0, pa1, pa2, pa3);
#undef ROT
  if (hi == 0) li_l[r32] = l_reg; asm volatile("s_waitcnt lgkmcnt(0)" ::: "memory");
  float rli[16];
#pragma unroll
  for (int r = 0; r < 16; ++r) rli[r] = __builtin_amdgcn_rcpf(li_l[crow(r, hi)]);
  bf16_t* Ow = Ob + (long)(wid * QBLK) * LDO;
#pragma unroll
  for (int r = 0; r < 16; ++r) { const int orow = crow(r, hi);
#pragma unroll
    for (int d0 = 0; d0 < 2; ++d0) Ow[(long)orow * LDO + d0 * 32 + r32] = (bf16_t)f2bf(o[d0][r] * rli[r]); }
  __syncthreads();
#undef SLOAD
#undef SWRITE
#undef SWAIT
#undef RESC
}
#undef ASBAR
}

namespace gla {
using bf16x8 = __attribute__((ext_vector_type(8))) short;
using s16x4  = __attribute__((ext_vector_type(4))) short;
using f32x16 = __attribute__((ext_vector_type(16))) float;
using u32x4  = __attribute__((ext_vector_type(4))) unsigned;
constexpr int L_DL = 0, L_TOT = 8192, L_RSUM = 10240, L_V = 12288, L_QF = 28672, L_KF = 37888, L_QB = 47104, L_KB = 56320, L_KSTF = 65536, L_KSTB = 74752, L_STF = 65536, L_STB = 83968, L_QR = 102400, L_KR = 110592, L_END = 118784;
constexpr int RB = 144;
__device__ __forceinline__ int crow(int r, int hi) { return (r & 3) + 8 * (r >> 2) + 4 * hi; }
__device__ __forceinline__ unsigned cvtpk(float lo, float hi) { unsigned r; asm volatile("v_cvt_pk_bf16_f32 %0, %1, %2" : "=v"(r) : "v"(lo), "v"(hi)); return r; }
__device__ __forceinline__ int v_st4(int k, int c) { const int kk = (k & ~0xC) | ((k & 4) << 1) | ((k & 8) >> 1); return ((kk >> 3) * 4 + (c >> 5)) * 512 + ((kk & 7) * 32 + (c & 31)) * 2; }
__device__ __forceinline__ int v_rd_base(int lane) { return ((lane & 3) << 3) | (((lane >> 2) & 3) << 6) | (((lane >> 4) & 1) << 5) | (((lane >> 5) & 1) << 8); }
template <int OFF> __device__ __forceinline__ s16x4 tr_read(int vb) { s16x4 r; asm volatile("ds_read_b64_tr_b16 %0, %1 offset:%2" : "=&v"(r) : "v"(vb), "i"(OFF) : "memory"); return r; }
__device__ __forceinline__ void v_frags(int vb, bf16x8 (&f)[4]) {
  const s16x4 l0 = tr_read<0>(vb), h0 = tr_read<2048>(vb), l1 = tr_read<4096>(vb), h1 = tr_read<4096 + 2048>(vb);
  const s16x4 l2 = tr_read<8192>(vb), h2 = tr_read<8192 + 2048>(vb), l3 = tr_read<12288>(vb), h3 = tr_read<12288 + 2048>(vb);
  asm volatile("s_waitcnt lgkmcnt(0)" ::: "memory"); __builtin_amdgcn_sched_barrier(0);
#define PK(L, H) (bf16x8){L[0], L[1], L[2], L[3], H[0], H[1], H[2], H[3]}
  f[0] = PK(l0, h0); f[1] = PK(l1, h1); f[2] = PK(l2, h2); f[3] = PK(l3, h3);
#undef PK
}
__device__ __forceinline__ bf16x8 frag(const char* base, int row, int ks, int hi) { return *reinterpret_cast<const bf16x8*>(base + row * RB + ks * 32 + hi * 16); }

template <bool IS_G1>
__device__ __forceinline__ void prep(char* lds, const bf16_t* projb, const float* wdec, const float* bdec, int t0, int hh, float* dec_out  , long dec_dir_stride) {
  int tid_ = threadIdx.x; asm volatile("" : "+v"(tid_)); const int tid = tid_;
  float* DL = (float*)(lds + L_DL); float* TOT = (float*)(lds + L_TOT);
  { const int i = tid >> 3, r4 = (tid & 7) * 4; float v[4]; ld4bf(projb + (size_t)(t0 + i) * DINP + OFF_GDEC + r4, v); *(float4*)(DL + i * 32 + r4) = make_float4(v[0], v[1], v[2], v[3]);
    const int c8 = (tid & 7) * 8;
    *(uint4*)(lds + L_KR + i * 128 + c8 * 2) = *(const uint4*)(projb + (size_t)(t0 + i) * DINP + OFF_GK + hh * 64 + c8);
    if constexpr (!IS_G1) *(uint4*)(lds + L_QR + i * 128 + c8 * 2) = *(const uint4*)(projb + (size_t)(t0 + i) * DINP + OFF_GQ + hh * 64 + c8); }
#pragma unroll
  for (int e2 = 0; e2 < 2; ++e2) { const int e = tid + e2 * 512, i = e >> 4, cc = (e & 15) * 8;
    *(uint4*)(lds + L_V + v_st4(i, cc)) = *(const uint4*)(projb + (size_t)(t0 + i) * DINP + OFF_GV + hh * 128 + cc); }
  __syncthreads();
  const int cidx = tid & 127, tg = tid >> 7, dir = cidx >> 6, d = cidx & 63;
  float W[16];
#pragma unroll
  for (int r = 0; r < 16; ++r) W[r] = wdec[(size_t)(dir * 16 + r) * 256 + hh * 64 + d];
  const float bias = bdec[dir * 256 + hh * 64 + d];
  constexpr float L2E = 1.4426950408889634f;
  float g[16], cs[16]; float run = 0.f;
#pragma unroll
  for (int ii = 0; ii < 16; ++ii) { const float* dl = DL + (16 * tg + ii) * 32 + dir * 16; float a = bias;
#pragma unroll
    for (int r = 0; r < 16; r += 4) { const float4 x = *(const float4*)(dl + r); a = fmaf(x.x, W[r], a); a = fmaf(x.y, W[r + 1], a); a = fmaf(x.z, W[r + 2], a); a = fmaf(x.w, W[r + 3], a); }
    g[ii] = (fminf(a, 0.f) * L2E - __builtin_amdgcn_logf(1.f + __builtin_amdgcn_exp2f(-fabsf(a) * L2E))) * (1.f / 16.f); run += g[ii]; cs[ii] = run; }
  TOT[tg * 128 + cidx] = run;
  __syncthreads();
  const float t0s = TOT[cidx], t1s = TOT[128 + cidx], t2s = TOT[256 + cidx], t3s = TOT[384 + cidx], tall = (t0s + t1s) + (t2s + t3s);
  const float off_lo = (tg > 0 ? t0s : 0.f) + (tg > 1 ? t1s : 0.f) + (tg > 2 ? t2s : 0.f);
  const float off_hi = (tg < 1 ? t1s : 0.f) + (tg < 2 ? t2s : 0.f) + (tg < 3 ? t3s : 0.f);
  const bf16_t* KR = (const bf16_t*)(lds + L_KR); const bf16_t* QR = (const bf16_t*)(lds + L_QR);
  if constexpr (IS_G1) {
    unsigned pk[8];
#pragma unroll
    for (int ii = 0; ii < 16; ii += 2) {
      float kv2[2];
#pragma unroll
      for (int u = 0; u < 2; ++u) { const int i = 16 * tg + ii + u; const float bi = dir == 0 ? off_lo + cs[ii + u] : off_hi + run - cs[ii + u] + g[ii + u];
        kv2[u] = bf2f(KR[i * 64 + d]) * __builtin_amdgcn_exp2f(tall - bi); }
      pk[ii >> 1] = cvtpk(kv2[0], kv2[1]); }
    char* dst = lds + (dir ? L_KSTB : L_KSTF) + d * RB + 32 * tg;
    *(uint4*)dst = make_uint4(pk[0], pk[1], pk[2], pk[3]); *(uint4*)(dst + 16) = make_uint4(pk[4], pk[5], pk[6], pk[7]);
    if (tg == 0) dec_out[dir * dec_dir_stride + d] = __builtin_amdgcn_exp2f(tall);
  } else {
    bf16_t* Qx = (bf16_t*)(lds + (dir ? L_QB : L_QF)); bf16_t* Kx = (bf16_t*)(lds + (dir ? L_KB : L_KF));
#pragma unroll
    for (int ii = 0; ii < 16; ++ii) { const int i = 16 * tg + ii; const float bi = dir == 0 ? off_lo + cs[ii] : off_hi + run - cs[ii] + g[ii];
      const float qv = bf2f(QR[i * 64 + d]) * 0.125f, kv = bf2f(KR[i * 64 + d]);
      Qx[i * (RB / 2) + d] = (bf16_t)f2bf(qv * __builtin_amdgcn_exp2f(bi)); Kx[i * (RB / 2) + d] = (bf16_t)f2bf(kv * __builtin_amdgcn_exp2f(-bi)); }
  }
  __syncthreads();
}

__device__ __forceinline__ void g1_item(char* lds, const bf16_t* projb, const float* wdec, const float* bdec, int b, int hh, int c, float* kvt, float* dec) {
  int tid_ = threadIdx.x; asm volatile("" : "+v"(tid_)); const int tid = tid_, wid = tid >> 6, lane = tid & 63, r32 = lane & 31, hi = lane >> 5;
  const int bh = b * 4 + hh; const long item = (long)bh * 128 + c, dstride = 8L * 128;
  prep<true>(lds, projb, wdec, bdec, b * SEQ + c * 64, hh, dec + item * 64, dstride * 64);
  const int vblk = wid >> 1, dblk = wid & 1;
  bf16x8 vf[4]; v_frags((int)(uintptr_t)(lds + L_V) + v_rd_base(lane) + vblk * 512, vf);
#pragma unroll
  for (int dir = 0; dir < 2; ++dir) { const char* kst = lds + (dir ? L_KSTB : L_KSTF); f32x16 acc = {};
#pragma unroll
    for (int ks = 0; ks < 4; ++ks) acc = __builtin_amdgcn_mfma_f32_32x32x16_bf16(vf[ks], frag(kst, dblk * 32 + r32, ks, hi), acc, 0, 0, 0);
    float* o = kvt + ((long)dir * dstride + item) * 8192 + (size_t)(vblk * 32) * 64 + dblk * 32 + r32;
#pragma unroll
    for (int r = 0; r < 16; ++r) o[crow(r, hi) * 64] = acc[r]; }
  __syncthreads();
}

__device__ __forceinline__ void g3_item(char* lds, const bf16_t* projb, const float* wdec, const float* bdec, const float* normg, int b, int hh, int c, const bf16_t* st, bf16_t* out, int ldo) {
  int tid_ = threadIdx.x; asm volatile("" : "+v"(tid_)); const int tid = tid_, wid = tid >> 6, lane = tid & 63, r32 = lane & 31, hi = lane >> 5;
  const int bh = b * 4 + hh, t0 = b * SEQ + c * 64; const long item = (long)bh * 128 + c, dstride = 8L * 128;
#pragma unroll
  for (int e4 = 0; e4 < 4; ++e4) { const int e = tid + e4 * 512, dir = e >> 10, v = (e >> 3) & 127, dc = (e & 7) * 8;
    *(uint4*)(lds + (dir ? L_STB : L_STF) + v * RB + dc * 2) = *(const uint4*)(st + ((long)dir * dstride + item) * 8192 + (size_t)v * 64 + dc); }
  prep<false>(lds, projb, wdec, bdec, t0, hh, nullptr, 0);
  const int ib = wid & 1, vblk = wid >> 1, iglob = ib * 32 + r32;
  bf16_t rgr[16];
#pragma unroll
  for (int r = 0; r < 16; ++r) rgr[r] = projb[(size_t)(t0 + ib * 32 + crow(r, hi)) * DINP + OFF_GR + hh * 128 + vblk * 32 + r32];
  f32x16 pF0 = {}, pF1 = {}, pB0 = {}, pB1 = {};
#pragma unroll
  for (int ks = 0; ks < 4; ++ks) {
    const bf16x8 qf = frag(lds + L_QF, iglob, ks, hi), qb = frag(lds + L_QB, iglob, ks, hi);
    pF0 = __builtin_amdgcn_mfma_f32_32x32x16_bf16(frag(lds + L_KF, r32, ks, hi), qf, pF0, 0, 0, 0);
    pF1 = __builtin_amdgcn_mfma_f32_32x32x16_bf16(frag(lds + L_KF, 32 + r32, ks, hi), qf, pF1, 0, 0, 0);
    pB0 = __builtin_amdgcn_mfma_f32_32x32x16_bf16(frag(lds + L_KB, r32, ks, hi), qb, pB0, 0, 0, 0);
    pB1 = __builtin_amdgcn_mfma_f32_32x32x16_bf16(frag(lds + L_KB, 32 + r32, ks, hi), qb, pB1, 0, 0, 0); }
#pragma unroll
  for (int r = 0; r < 16; ++r) { const int j0 = crow(r, hi), j1 = 32 + j0;
    pF0[r] = (j0 <= iglob ? pF0[r] : 0.f) + (j0 >= iglob ? pB0[r] : 0.f);
    pF1[r] = (j1 <= iglob ? pF1[r] : 0.f) + (j1 >= iglob ? pB1[r] : 0.f); }
  bf16x8 pa0, pa1, pa2, pa3;
#define PK4(P, BASE, OUT) do { unsigned a0 = cvtpk(P[BASE + 0], P[BASE + 1]), a1 = cvtpk(P[BASE + 2], P[BASE + 3]);   \
    unsigned b0 = cvtpk(P[BASE + 4], P[BASE + 5]), b1 = cvtpk(P[BASE + 6], P[BASE + 7]);                              \
    auto r0 = __builtin_amdgcn_permlane32_swap(a0, b0, false, false); auto r1 = __builtin_amdgcn_permlane32_swap(a1, b1, false, false); \
    u32x4 w = {r0[0], r1[0], r0[1], r1[1]}; OUT = *reinterpret_cast<bf16x8*>(&w); } while (0)
  PK4(pF0, 0, pa0); PK4(pF0, 8, pa1); PK4(pF1, 0, pa2); PK4(pF1, 8, pa3);
#undef PK4
  bf16x8 vf[4]; v_frags((int)(uintptr_t)(lds + L_V) + v_rd_base(lane) + vblk * 512, vf);
  f32x16 o = {};
  o = __builtin_amdgcn_mfma_f32_32x32x16_bf16(pa0, vf[0], o, 0, 0, 0); o = __builtin_amdgcn_mfma_f32_32x32x16_bf16(pa1, vf[1], o, 0, 0, 0);
  o = __builtin_amdgcn_mfma_f32_32x32x16_bf16(pa2, vf[2], o, 0, 0, 0); o = __builtin_amdgcn_mfma_f32_32x32x16_bf16(pa3, vf[3], o, 0, 0, 0);
#pragma unroll
  for (int ks = 0; ks < 4; ++ks) {
    o = __builtin_amdgcn_mfma_f32_32x32x16_bf16(frag(lds + L_QF, iglob, ks, hi), frag(lds + L_STF, vblk * 32 + r32, ks, hi), o, 0, 0, 0);
    o = __builtin_amdgcn_mfma_f32_32x32x16_bf16(frag(lds + L_QB, iglob, ks, hi), frag(lds + L_STB, vblk * 32 + r32, ks, hi), o, 0, 0, 0); }
  float* RS = (float*)(lds + L_RSUM);
  float ss[16];
#pragma unroll
  for (int r = 0; r < 16; ++r) { float s = o[r] * o[r]; s += __shfl_xor(s, 1); s += __shfl_xor(s, 2); s += __shfl_xor(s, 4); s += __shfl_xor(s, 8); s += __shfl_xor(s, 16); ss[r] = s; }
  if (r32 == 0) {
#pragma unroll
    for (int r = 0; r < 16; ++r) RS[(ib * 4 + vblk) * 32 + crow(r, hi)] = ss[r]; }
  __syncthreads();
  const int v = vblk * 32 + r32; const float ng = normg[v];
#pragma unroll
  for (int r = 0; r < 16; ++r) { const int il = crow(r, hi), i = ib * 32 + il;
    const float tot = (RS[(ib * 4 + 0) * 32 + il] + RS[(ib * 4 + 1) * 32 + il]) + (RS[(ib * 4 + 2) * 32 + il] + RS[(ib * 4 + 3) * 32 + il]);
    const float rstd = 1.f / sqrtf(tot * (1.f / 128.f) + RMS_EPS);
    const float rg = bf2f(rgr[r]);
    out[(size_t)(t0 + i) * ldo + hh * 128 + v] = (bf16_t)f2bf(o[r] * rstd * ng * (rg * __builtin_amdgcn_rcpf(1.f + __builtin_amdgcn_exp2f(-1.4426950408889634f * rg)))); }
  __syncthreads();
}
}

__device__ __forceinline__ void ln_core(float4 (&v)[4], const float* g, const float* b, float* out, bf16_t* outb, int lane) {
    float s = 0.f;
#pragma unroll
    for (int j = 0; j < 4; ++j) s += (v[j].x + v[j].y) + (v[j].z + v[j].w);
    const float mean = wave_sum(s) * (1.f / DM); float s2 = 0.f;
#pragma unroll
    for (int j = 0; j < 4; ++j) { v[j].x -= mean; v[j].y -= mean; v[j].z -= mean; v[j].w -= mean; s2 += (v[j].x * v[j].x + v[j].y * v[j].y) + (v[j].z * v[j].z + v[j].w * v[j].w); }
    const float rstd = 1.f / sqrtf(wave_sum(s2) * (1.f / DM) + LN_EPS);
#pragma unroll
    for (int j = 0; j < 4; ++j) {
        const float4 gg = ((const float4*)g)[lane + 64 * j], bb = ((const float4*)b)[lane + 64 * j];
        float4 o; o.x = v[j].x * rstd * gg.x + bb.x; o.y = v[j].y * rstd * gg.y + bb.y; o.z = v[j].z * rstd * gg.z + bb.z; o.w = v[j].w * rstd * gg.w + bb.w;
        ((float4*)out)[lane + 64 * j] = o; v[j] = o;
        if (outb) ((uint2*)outb)[lane + 64 * j] = make_uint2(pk2(o.x, o.y), pk2(o.z, o.w));
    }
}
__device__ __forceinline__ void wave_sum2(float& a, float& b) {
#pragma unroll
    for (int o = 1; o < 64; o <<= 1) { const float ta = __shfl_xor(a, o), tb = __shfl_xor(b, o); a += ta; b += tb; }
}
template <int MODE>
__device__ __forceinline__ void ln_core2(float4 (&v)[2][4], const float* g, const float* b, float* out0, float* out1, bf16_t* ob0, bf16_t* ob1, int lane, unsigned char* o8_0 = nullptr, unsigned char* o8_1 = nullptr) {
    float s[2] = {0.f, 0.f};
#pragma unroll
    for (int u = 0; u < 2; ++u)
#pragma unroll
        for (int j = 0; j < 4; ++j) s[u] += (v[u][j].x + v[u][j].y) + (v[u][j].z + v[u][j].w);
    wave_sum2(s[0], s[1]);
    float q[2] = {0.f, 0.f};
#pragma unroll
    for (int u = 0; u < 2; ++u) { const float mean = s[u] * (1.f / DM);
#pragma unroll
        for (int j = 0; j < 4; ++j) { v[u][j].x -= mean; v[u][j].y -= mean; v[u][j].z -= mean; v[u][j].w -= mean; q[u] += (v[u][j].x * v[u][j].x + v[u][j].y * v[u][j].y) + (v[u][j].z * v[u][j].z + v[u][j].w * v[u][j].w); } }
    wave_sum2(q[0], q[1]);
#pragma unroll
    for (int j = 0; j < 4; ++j) {
        const float4 gg = ((const float4*)g)[lane + 64 * j], bb = ((const float4*)b)[lane + 64 * j];
#pragma unroll
        for (int u = 0; u < 2; ++u) { const float rstd = 1.f / sqrtf(q[u] * (1.f / DM) + LN_EPS);
            float4 o; o.x = v[u][j].x * rstd * gg.x + bb.x; o.y = v[u][j].y * rstd * gg.y + bb.y; o.z = v[u][j].z * rstd * gg.z + bb.z; o.w = v[u][j].w * rstd * gg.w + bb.w;
            v[u][j] = o;
            if constexpr (MODE == 2) ((float4*)(u ? out1 : out0))[lane + 64 * j] = o;
            else ((uint2*)(u ? ob1 : ob0))[lane + 64 * j] = make_uint2(pk2(o.x, o.y), pk2(o.z, o.w));
            if constexpr (MODE == 1) ((unsigned*)(u ? o8_1 : o8_0))[lane + 64 * j] = pk4_fp8(o.x, o.y, o.z, o.w); }
    }
}
__device__ __forceinline__ int block_excl_scan(int x, int* scr, int tid, int& total) {
    const int lane = tid & 63, wid = tid >> 6; int inc = x;
#pragma unroll
    for (int o = 1; o < 64; o <<= 1) { const int y = __shfl_up(inc, o); if (lane >= o) inc += y; }
    __syncthreads();
    if (lane == 63) scr[wid] = inc;
    __syncthreads();
    int base = 0, tot = 0;
#pragma unroll
    for (int w = 0; w < 8; ++w) { const int c = scr[w]; base += (w < wid) ? c : 0; tot += c; }
    total = tot; return base + inc - x;
}

__device__ __forceinline__ void tb_load(float (&v)[32], const float* Wblk, int ldw, int lane) {
#pragma unroll
    for (int i = 0; i < 32; ++i) v[i] = __builtin_nontemporal_load(&Wblk[(size_t)(2 * i + (lane >> 5)) * ldw + (lane & 31)]);
}
__device__ __forceinline__ void tb_store(const float (&v)[32], bf16_t* dst, int ldt, float* scr, int lane) {
#pragma unroll
    for (int i = 0; i < 32; ++i) scr[(2 * i + (lane >> 5)) * 33 + (lane & 31)] = v[i];
    asm volatile("s_waitcnt lgkmcnt(0)" ::: "memory");
    const int c = lane & 7;
#pragma unroll
    for (int j = 0; j < 4; ++j) { const int n = (lane >> 3) + 8 * j; const float* s = scr + (8 * c) * 33 + n;
        uint4 o; o.x = pk2(s[0 * 33], s[1 * 33]); o.y = pk2(s[2 * 33], s[3 * 33]); o.z = pk2(s[4 * 33], s[5 * 33]); o.w = pk2(s[6 * 33], s[7 * 33]);
        *(uint4*)(dst + (size_t)n * ldt + 8 * c) = o; }
    asm volatile("s_waitcnt lgkmcnt(0)" ::: "memory");
}

__device__ __forceinline__ void tb_store8(const float (&v)[32], unsigned char* dst, int ldt, float sc, float* scr, int lane) {
#pragma unroll
    for (int i = 0; i < 32; ++i) scr[(2 * i + (lane >> 5)) * 33 + (lane & 31)] = v[i];
    asm volatile("s_waitcnt lgkmcnt(0)" ::: "memory");
    const int c = lane & 7;
#pragma unroll
    for (int j = 0; j < 4; ++j) { const int n = (lane >> 3) + 8 * j; const float* s = scr + (8 * c) * 33 + n;
        *(uint2*)(dst + (size_t)n * ldt + 8 * c) = make_uint2(pk4_fp8(s[0 * 33] * sc, s[1 * 33] * sc, s[2 * 33] * sc, s[3 * 33] * sc), pk4_fp8(s[4 * 33] * sc, s[5 * 33] * sc, s[6 * 33] * sc, s[7 * 33] * sc)); }
    asm volatile("s_waitcnt lgkmcnt(0)" ::: "memory");
}

__device__ __forceinline__ void ln_row(const float* a, const float* add, float alpha, const float* g, const float* b, float* out, int lane, float4 (&v)[4], bf16_t* outb = nullptr) {
    float s = 0.f;
#pragma unroll
    for (int j = 0; j < 4; ++j) {
        float4 x = ((const float4*)a)[lane + 64 * j];
        x.x *= alpha; x.y *= alpha; x.z *= alpha; x.w *= alpha;
        if (add) { const float4 y = ((const float4*)add)[lane + 64 * j]; x.x += y.x; x.y += y.y; x.z += y.z; x.w += y.w; }
        v[j] = x; s += (x.x + x.y) + (x.z + x.w);
    }
    const float mean = wave_sum(s) * (1.f / DM); float s2 = 0.f;
#pragma unroll
    for (int j = 0; j < 4; ++j) { v[j].x -= mean; v[j].y -= mean; v[j].z -= mean; v[j].w -= mean; s2 += (v[j].x * v[j].x + v[j].y * v[j].y) + (v[j].z * v[j].z + v[j].w * v[j].w); }
    const float rstd = 1.f / sqrtf(wave_sum(s2) * (1.f / DM) + LN_EPS);
#pragma unroll
    for (int j = 0; j < 4; ++j) {
        const float4 gg = ((const float4*)g)[lane + 64 * j], bb = ((const float4*)b)[lane + 64 * j];
        float4 o; o.x = v[j].x * rstd * gg.x + bb.x; o.y = v[j].y * rstd * gg.y + bb.y; o.z = v[j].z * rstd * gg.z + bb.z; o.w = v[j].w * rstd * gg.w + bb.w;
        if (out) ((float4*)out)[lane + 64 * j] = o; v[j] = o;
        if (outb) ((uint2*)outb)[lane + 64 * j] = make_uint2(pk2(o.x, o.y), pk2(o.z, o.w));
    }
}

struct GemmP {
    const float* A; const int* ridx; const float* Bm; float* C;
    int lda, ldb, ldc, M, N, K, nb, bshift;
    long sA, sB, sC; int sR;
    const float* aux; const bf16_t* auxb; int ldaux; long sAux; const float* aux2; int accum;
};
template <int MODE>
__device__ __forceinline__ void gemm_naive(const GemmP g, float* lds) {
    float (*As)[132] = (float (*)[132])lds;
    float (*Bs)[128] = (float (*)[128])(lds + 16 * 132);
    int tid_ = threadIdx.x; asm volatile("" : "+v"(tid_));
    const int tid = tid_, ty = tid >> 4, tx = tid & 15;
    const int mt = g.M / 128, nt = (g.N + 127) / 128, per = mt * nt, total = per * g.nb;
    int bid_ = blockIdx.x; asm volatile("" : "+s"(bid_));
    for (int tile = bid_; tile < total; tile += gridDim.x) {
        const int z = tile / per, r = tile % per, tm = r / nt, tn = r % nt;
        const int m0 = tm * 128, n0 = tn * 128;
        const float* Bz = g.Bm + (long)(z >> g.bshift) * g.sB;
        float* Cz = g.C + (long)z * g.sC;
        const int arow = m0 + (tid >> 2);
        const long grow = g.ridx ? (long)g.ridx[z * g.sR + arow] : (long)arow;
        const float* Arow = g.A + (long)z * g.sA + grow * g.lda + (tid & 3) * 4;
        const int bk = tid >> 5, bn = n0 + (tid & 31) * 4;
        const bool bok = bn < g.N;
        const float* Bp = Bz + (long)bk * g.ldb + bn;
        float acc[4][8];
#pragma unroll
        for (int i = 0; i < 4; ++i)
#pragma unroll
            for (int j = 0; j < 8; ++j) acc[i][j] = 0.f;
        float4 ra = *(const float4*)(Arow);
        float4 rb = bok ? *(const float4*)(Bp) : make_float4(0.f, 0.f, 0.f, 0.f);
        for (int k0 = 0; k0 < g.K; k0 += 16) {
            __syncthreads();
            { const int rr = tid >> 2, k4 = (tid & 3) * 4; As[k4][rr] = ra.x; As[k4 + 1][rr] = ra.y; As[k4 + 2][rr] = ra.z; As[k4 + 3][rr] = ra.w; }
            *(float4*)&Bs[bk][(tid & 31) * 4] = rb;
            __syncthreads();
            if (k0 + 16 < g.K) {
                ra = *(const float4*)(Arow + k0 + 16);
                rb = bok ? *(const float4*)(Bp + (long)(k0 + 16) * g.ldb) : make_float4(0.f, 0.f, 0.f, 0.f);
            }
#pragma unroll
            for (int k = 0; k < 16; ++k) {
                const float4 a = *(const float4*)&As[k][ty * 4];
                const float4 b0 = *(const float4*)&Bs[k][tx * 8], b1 = *(const float4*)&Bs[k][tx * 8 + 4];
                const float av[4] = {a.x, a.y, a.z, a.w};
                const float bv[8] = {b0.x, b0.y, b0.z, b0.w, b1.x, b1.y, b1.z, b1.w};
#pragma unroll
                for (int i = 0; i < 4; ++i)
#pragma unroll
                    for (int j = 0; j < 8; ++j) acc[i][j] = fmaf(av[i], bv[j], acc[i][j]);
            }
        }
#pragma unroll
        for (int i = 0; i < 4; ++i) {
            const int row = m0 + ty * 4 + i;
#pragma unroll
            for (int jv = 0; jv < 2; ++jv) {
                const int col = n0 + tx * 8 + jv * 4;
                if (col < g.N) {
                    float v[4] = {acc[i][jv * 4], acc[i][jv * 4 + 1], acc[i][jv * 4 + 2], acc[i][jv * 4 + 3]};
                    float* cp = Cz + (long)row * g.ldc + col;
                    if (MODE == 1) {
#pragma unroll
                        for (int q = 0; q < 4; ++q) v[q] *= g.aux[(long)z * g.sAux + col + q];
                    } else if (MODE == 2) {
                        float gl[4]; ld4bf(g.auxb + (long)row * g.ldaux + col, gl); const float4 gb = *(const float4*)(g.aux2 + col);
                        const float gv[4] = {gl[0] + gb.x, gl[1] + gb.y, gl[2] + gb.z, gl[3] + gb.w};
                        float4 old = make_float4(0.f, 0.f, 0.f, 0.f);
                        if (g.accum) old = *(const float4*)cp;
                        const float ov[4] = {old.x, old.y, old.z, old.w};
#pragma unroll
                        for (int q = 0; q < 4; ++q) v[q] = ov[q] + sigmoidf_(gv[q]) * v[q];
                    } else if (MODE == 3) {
                        const float4 old = *(const float4*)cp; const float ov[4] = {old.x, old.y, old.z, old.w};
#pragma unroll
                        for (int q = 0; q < 4; ++q) v[q] = siluf_(ov[q]) * v[q];
                    } else if (MODE == 4) {
                        const float rs = g.aux[(long)z * g.sAux + row];
#pragma unroll
                        for (int q = 0; q < 4; ++q) v[q] *= rs;
                    }
                    *(float4*)cp = make_float4(v[0], v[1], v[2], v[3]);
                }
            }
        }
    }
    __syncthreads();
}

#define W_IN(l)    (p.in[4]  + (size_t)(l) * DM * DIN)
#define B_GATE(l)  (p.in[5]  + (size_t)(l) * 3 * DM)
#define POOL_W(l)  (p.in[6]  + (size_t)(l) * 4 * 128 * 128)
#define POOL_S(l)  (p.in[7]  + (size_t)(l) * 512)
#define W_UP_A(l)  (p.in[8]  + (size_t)(l) * 512 * DM)
#define Q_NORM(l)  (p.in[9]  + (size_t)(l) * 384)
#define W_UQ(l)    (p.in[10] + (size_t)(l) * 384 * 768)
#define KV_NORM(l) (p.in[11] + (size_t)(l) * 256)
#define W_UKV(l)   (p.in[12] + (size_t)(l) * 256 * 1024)
#define W_UP_B(l)  (p.in[13] + (size_t)(l) * 512 * DM)
#define W_DEC(l)   (p.in[14] + (size_t)(l) * 2 * 16 * 256)
#define B_DEC(l)   (p.in[15] + (size_t)(l) * 2 * 256)
#define GLA_NORM(l)(p.in[16] + (size_t)(l) * 128)
#define W_UP_C(l)  (p.in[17] + (size_t)(l) * 512 * DM)
#define W_OUT(l)   (p.in[18] + (size_t)(l) * DM * DM)
#define LN1_G(l)   (p.in[19] + (size_t)(l) * DM)
#define LN1_B(l)   (p.in[20] + (size_t)(l) * DM)
#define ROUTER(l)  (p.in[21] + (size_t)(l) * DM * NE)
#define EW_GATE(l) (p.in[22] + (size_t)(l) * NE * DM * DEXP)
#define EW_UP(l)   (p.in[23] + (size_t)(l) * NE * DM * DEXP)
#define EW_DOWN(l) (p.in[24] + (size_t)(l) * NE * DEXP * DM)
#define LN2_G(l)   (p.in[25] + (size_t)(l) * DM)
#define LN2_B(l)   (p.in[26] + (size_t)(l) * DM)
#define WSF(off) ((float*)(p.ws + (off)))
#define WSI(off) ((int*)(p.ws + (off)))
#define WSB(off) ((bf16_t*)(p.ws + (off)))
#define PJ(t, c) bf2f(projb[(size_t)(t) * DINP + (c)])

enum Stage {
    ST_INIT = 0,
    ST_WCONV,
    ST_PROJ,
    ST_PREP,
    ST_SMALLGEMM,
    ST_ROPE,
    ST_ATTN,
    ST_GLA1, ST_GLA2, ST_GLA3,
    ST_GLAFIN,
    ST_MERGE_A, ST_MERGE_B, ST_MERGE_C,
    ST_OUTP,
    ST_LN1,
    ST_TOPK,
    ST_GATHER,
    ST_EXP_G, ST_EXP_U, ST_EXP_D,
    ST_LN2,
    ST_COUNT
};

#define KAS __attribute__((address_space(4)))
template <int ST>
__device__ __forceinline__ void run_stage(int l, float* lds) {
    const KAS Params* pk_ = (const KAS Params*)__builtin_amdgcn_kernarg_segment_ptr(); asm volatile("" : "+s"(pk_));
    const KAS Params& p = *pk_;
    int tid_ = threadIdx.x; asm volatile("" : "+v"(tid_));
    int bid_ = blockIdx.x; asm volatile("" : "+s"(bid_));
    const int tid = tid_, lane = tid & 63, wid = tid >> 6;
    const int G = gridDim.x, bid = bid_;
    const int gw = bid * 8 + wid, NGW = G * 8;
    const long gt = (long)bid * NTHR + tid, NGT = (long)G * NTHR;
    float* h = p.out;

    if constexpr (ST == ST_INIT) {
        for (int m = gw; m < T; m += NGW) { float4 vv[4]; ln_row(p.in[0] + (size_t)m * DM, nullptr, 1.f, p.in[2], p.in[3], nullptr, lane, vv, WSB(WS_HB) + (size_t)m * DM); }
        {
            float* scr = lds + wid * 4096;
            constexpr int NBLK = DIN / 32, ITEMS_L = (DM / 64) * NBLK;
            for (int it = gw; it < 2 * ITEMS_L; it += NGW) {
                const int ll = it / ITEMS_L, r = it % ITEMS_L, kb = r / NBLK, nb = r % NBLK;
                const int n0 = 32 * nb, drow = n0 < 2752 ? n0 + 3072 : n0 - 2752;
                transpose_block(p.in[4] + (size_t)ll * DM * DIN + (size_t)(64 * kb) * DIN + n0, DIN, WSB(WS_WIN_T) + (size_t)ll * DINP * DM + (size_t)drow * DM + 64 * kb, DM, nullptr, nullptr, scr, lane);
            }
            {
                constexpr int I_UQ = 6 * 24, I_UKV = 4 * 32, I_B = 8 * 32, I_OUT = 16 * 32, I_L = I_UQ + I_UKV + 2 * I_B + I_OUT;
                for (int it = gw; it < 2 * I_L; it += NGW) {
                    const int ll = it / I_L; int r = it % I_L; bf16_t* wsm = WSB(WS_WSMALL + (size_t)ll * WSM_STRIDE);
                    if (r < I_UQ) { const int kb = r / 24, nb = r % 24; transpose_block(p.in[10] + (size_t)ll * 384 * 768 + (size_t)(64 * kb) * 768 + 32 * nb, 768, wsm + WSM_UQ / 2 + (size_t)(32 * nb) * 384 + 64 * kb, 384, p.in[9] + ll * 384 + 64 * kb, nullptr, scr, lane); continue; } r -= I_UQ;
                    if (r < I_UKV) { const int kb = r / 32, nb = r % 32; transpose_block(p.in[12] + (size_t)ll * 256 * 1024 + (size_t)(64 * kb) * 1024 + 32 * nb, 1024, wsm + WSM_UKV / 2 + (size_t)(32 * nb) * 256 + 64 * kb, 256, p.in[11] + ll * 256 + 64 * kb, nullptr, scr, lane); continue; } r -= I_UKV;
                    if (r < 2 * I_B) { const int c = r / I_B, rr = r % I_B, kb = rr / 32, nb = rr % 32; const float* W = (c ? p.in[17] : p.in[13]) + (size_t)ll * 512 * DM;
                        transpose_block(W + (size_t)(64 * kb) * DM + 32 * nb, DM, wsm + WSM_MRG / 2 + (size_t)(32 * nb) * 1536 + 512 * (1 + c) + 64 * kb, 1536, nullptr, nullptr, scr, lane); continue; } r -= 2 * I_B;
                    { const int kb = r / 32, nb = r % 32; transpose_block(p.in[18] + (size_t)ll * DM * DM + (size_t)(64 * kb) * DM + 32 * nb, DM, wsm + WSM_OUT / 2 + (size_t)(32 * nb) * DM + 64 * kb, DM, nullptr, nullptr, scr, lane); }
                }
                for (long i = gt; i < 2L * 512 * DM; i += NGT) {
                    const int ll = (int)(i / (512 * DM)), r = (int)(i % (512 * DM)), cin = r >> 10, d = r & 1023, g = cin >> 7, c = cin & 127;
                    const float* pw = p.in[6] + (size_t)ll * 4 * 128 * 128 + (size_t)(g * 128 + c) * 128; const float* ps = p.in[7] + ll * 512 + g * 128; const float* wa = p.in[8] + (size_t)ll * 512 * DM + (size_t)(g * 128) * DM + d;
                    float a = 0.f;
                    for (int cc = 0; cc < 128; ++cc) a = fmaf(pw[cc] * ps[cc], wa[(size_t)cc * DM], a);
                    WSB(WS_WSMALL + (size_t)ll * WSM_STRIDE + WSM_MRG)[(size_t)d * 1536 + cin] = (bf16_t)f2bf(a);
                }
            }
            for (long i = gt; i < 2L * 64 * DM / 8; i += NGT) { const int ll = (int)(i / (64 * DM / 8)); const long r = i % (64 * DM / 8);
                *(uint4*)(WSB(WS_WIN_T) + (size_t)ll * DINP * DM + (size_t)DIN * DM + r * 8) = make_uint4(0u, 0u, 0u, 0u); }
        }
        float* rc = WSF(WS_ROPE); float* rs = rc + T * 16;
        for (long i = gt; i < (long)T * 16; i += NGT) {
            const int t = (int)(i >> 4), j = (int)(i & 15);
            const float freq = powf(10000.0f, -(float)j / 16.0f);
            const float ang = (float)p.pos[t] * freq;
            rc[i] = cosf(ang); rs[i] = sinf(ang);
        }
    }
    if constexpr (ST == ST_WCONV) {
        float* scr = lds + wid * 4096;
        constexpr int I_G = 16 * 16 * 64, I_D = 16 * 32 * 32;
        constexpr int I_ALL = 2 * I_G + I_D;
#define WCONV_ITEM(it, W, ldw, dst, ldt, sc8) do { if ((it) < 2 * I_G) { const int up_ = (it) >= I_G, r_ = up_ ? (it) - I_G : (it), e_ = r_ >> 10, kb_ = (r_ >> 6) & 15, nb_ = r_ & 63, j0_ = nb_ * 32; \
            W = (up_ ? EW_UP(l) : EW_GATE(l)) + (size_t)e_ * DM * DEXP + (size_t)(64 * kb_) * DEXP + j0_; ldw = DEXP; \
            dst = (unsigned char*)(p.ws + WS_WGU_T) + (size_t)(e_ * 4096 + 256 * (j0_ >> 7) + (j0_ & 127) + (up_ ? 128 : 0)) * DM + 64 * kb_; ldt = DM; sc8 = F8_WGU; } \
          else { const int r_ = (it) - 2 * I_G, e_ = r_ >> 10, kb_ = (r_ >> 5) & 31, nb_ = r_ & 31; \
            W = EW_DOWN(l) + (size_t)e_ * DEXP * DM + (size_t)(64 * kb_) * DM + 32 * nb_; ldw = DM; dst = (unsigned char*)(p.ws + WS_WD_T) + (size_t)(e_ * 1024 + 32 * nb_) * DEXP + 64 * kb_; ldt = DEXP; sc8 = F8_WD; } } while (0)
        float va[32], vb[32]; const float* Wa = nullptr; const float* Wb = nullptr; unsigned char* da = nullptr; unsigned char* db = nullptr; int lwa = 0, lwb = 0, lta = 0, ltb = 0; float sa = 1.f, sb = 1.f;
        int itA = gw, itB = gw + NGW;
        if (itA < I_ALL) { WCONV_ITEM(itA, Wa, lwa, da, lta, sa); tb_load(va, Wa, lwa, lane); }
        while (itA < I_ALL) {
            if (itB < I_ALL) { WCONV_ITEM(itB, Wb, lwb, db, ltb, sb); tb_load(vb, Wb, lwb, lane); }
            tb_store8(va, da, lta, sa, scr, lane);
            itA = itB + NGW;
            if (itB >= I_ALL) break;
            if (itA < I_ALL) { WCONV_ITEM(itA, Wa, lwa, da, lta, sa); tb_load(va, Wa, lwa, lane); }
            tb_store8(vb, db, ltb, sb, scr, lane);
            itB = itA + NGW;
        }
#undef WCONV_ITEM
        __syncthreads();
    }
    if constexpr (ST == ST_PROJ) {
        pg8::Gemm g{WSB(WS_HB), WSB(WS_WIN_T) + (size_t)l * DINP * DM, T, DINP, DM, DM};
        pg8::StaticOrder S; S.init(T, DINP, G, bid);
        EpiProj E{WSB(WS_PROJB), B_GATE(l)};
        pg8::gemm_phase<EpiProj, pg8::StaticOrder, true, true>((PG8_LAS unsigned char*)lds, g, S, E);
    }
    if constexpr (ST == ST_PREP) {
        const bf16_t* projb = WSB(WS_PROJB); bf16_t* br = WSB(WS_BR); bf16_t* U = (bf16_t*)lds;
        float* rq = WSF(WS_RQ); float* rkv = rq + T; const float* rc = WSF(WS_ROPE); const float* rs = rc + T * 16; bf16_t* kb = WSB(WS_KB);
        for (int tile = bid; tile < T / 64; tile += G) {
            const int b = tile / (SEQ / 64), s0 = (tile % (SEQ / 64)) * 64, t0 = b * SEQ + s0;
            __syncthreads();
#pragma unroll
            for (int it = 0; it < 10; ++it) { const int e = tid + it * NTHR, r = e >> 6, ch = e & 63, s = s0 - 8 + r;
                uint4 v = make_uint4(0u, 0u, 0u, 0u);
                if (s >= 0 && s < SEQ) v = *(const uint4*)(projb + (size_t)(b * SEQ + s) * DINP + OFF_POOL + ch * 8);
                *(uint4*)(U + r * 512 + ch * 8) = v; }
            for (int r = wid; r < 64; r += 8) { const bf16_t* row = projb + (size_t)(t0 + r) * DINP;
                float s1 = 0.f, s2 = 0.f;
                if (lane < 48) { const uint4 w = *(const uint4*)(row + OFF_CQ + lane * 8); const unsigned ww[4] = {w.x, w.y, w.z, w.w};
#pragma unroll
                    for (int q = 0; q < 4; ++q) { const float a = __uint_as_float(ww[q] << 16), c = __uint_as_float(ww[q] & 0xffff0000u); s1 += a * a + c * c; } }
                if (lane < 32) { const uint4 w = *(const uint4*)(row + OFF_CKV + lane * 8); const unsigned ww[4] = {w.x, w.y, w.z, w.w};
#pragma unroll
                    for (int q = 0; q < 4; ++q) { const float a = __uint_as_float(ww[q] << 16), c = __uint_as_float(ww[q] & 0xffff0000u); s2 += a * a + c * c; } }
                s1 = wave_sum(s1); s2 = wave_sum(s2);
                if (lane == 0) { rq[t0 + r] = 1.f / sqrtf(s1 * (1.f / 384.f) + RMS_EPS); rkv[t0 + r] = 1.f / sqrtf(s2 * (1.f / 256.f) + RMS_EPS); } }
#pragma unroll
            for (int it = 0; it < 2; ++it) { const int e = tid + it * NTHR, r = e >> 4, j = e & 15, t = t0 + r;
                const float c = rc[(size_t)t * 16 + j], s = rs[(size_t)t * 16 + j], x1 = PJ(t, OFF_KR + j), x2 = PJ(t, OFF_KR + 16 + j);
                const bf16_t k1 = (bf16_t)f2bf(x1 * c - x2 * s), k2 = (bf16_t)f2bf(x1 * s + x2 * c);
#pragma unroll
                for (int hh = 0; hh < 8; ++hh) { kb[(size_t)t * 768 + hh * 96 + 64 + j] = k1; kb[(size_t)t * 768 + hh * 96 + 80 + j] = k2; } }
            __syncthreads();
            { const int c = tid, hw = 1 << (c >> 7); float sum = 0.f;
                for (int u = s0 - hw; u < s0 + hw; ++u) if (u >= 0 && u < SEQ) sum += bf2f(U[(u - s0 + 8) * 512 + c]);
                for (int s = s0; s < s0 + 64; ++s) {
                    int lo = s - hw; if (lo < 0) lo = 0; int hi = s + hw; if (hi > SEQ) hi = SEQ;
                    br[(size_t)(b * SEQ + s) * 1536 + c] = (bf16_t)f2bf(sum / (float)(hi - lo) - bf2f(U[(s - s0 + 8) * 512 + c]));
                    if (s + hw < SEQ) sum += bf2f(U[(s + hw - s0 + 8) * 512 + c]);
                    if (s - hw >= 0) sum -= bf2f(U[(s - hw - s0 + 8) * 512 + c]);
                } }
        }
        __syncthreads();
    }
    if constexpr (ST == ST_SMALLGEMM) {
        const bf16_t* wsm = WSB(WS_WSMALL + (size_t)l * WSM_STRIDE);
        { pg8::Gemm g{WSB(WS_PROJB) + OFF_CQ, wsm + WSM_UQ / 2, T, 768, 384, DINP}; pg8::StaticOrder S; S.init(T, 768, G, bid);
          EpiQ E{WSB(WS_QB), WSF(WS_RQ), WSF(WS_ROPE), WSF(WS_ROPE) + T * 16}; pg8::gemm_phase<EpiQ, pg8::StaticOrder, true, true>((PG8_LAS unsigned char*)lds, g, S, E); }
        { pg8::Gemm g{WSB(WS_PROJB) + OFF_CKV, wsm + WSM_UKV / 2, T, 1024, 256, DINP}; pg8::StaticOrder S; S.init(T, 1024, G, bid);
          EpiKV E{WSB(WS_KB), WSB(WS_VB), WSF(WS_RQ) + T}; pg8::gemm_phase<EpiKV, pg8::StaticOrder, true, true>((PG8_LAS unsigned char*)lds, g, S, E); }
    }
    if constexpr (ST == ST_ATTN) {
        const int vcu = (G % 8 == 0) ? (bid % 8) * (G / 8) + bid / 8 : bid;
        WStream wst; wst.gate = EW_GATE(l); wst.up = EW_UP(l); wst.down = EW_DOWN(l); wst.wgu_t = p.ws + WS_WGU_T; wst.wd_t = p.ws + WS_WD_T;
        { const int wu = __builtin_amdgcn_readfirstlane(wid); wst.init(bid * 8 + wu, NGW, (char*)lds + att::SHM_ATTN + wu * 2560, lane); }
        for (int L = vcu; L < NB * 8 * 32; L += G) {
            const int bh = L >> 5, qb = L & 31, b = bh >> 3, hh = bh & 7;
            att::attn_unit(WSB(WS_QB) + (size_t)(b * SEQ + qb * 256) * 768 + hh * 96, WSB(WS_KB) + (size_t)(b * SEQ) * 768 + hh * 96, WSB(WS_VB) + (size_t)(b * SEQ) * 512 + hh * 64,
                           WSB(WS_BR) + (size_t)(b * SEQ + qb * 256) * 1536 + 512 + hh * 64, SEQ, (char*)lds, wst);
        }
        while (wst.step <= wst.nsteps) wst.tick(lane);
        __syncthreads();
    }
    if constexpr (ST == ST_GLA1) {
        for (int item = bid; item < NB * 4 * 128; item += G) {
            const int b = item >> 9, hh = (item >> 7) & 3, c = item & 127;
            gla::g1_item((char*)lds, WSB(WS_PROJB), W_DEC(l), B_DEC(l), b, hh, c, WSF(WS_KVT), WSF(WS_DEC));
        }
    }
    if constexpr (ST == ST_GLA2) {
        const float* kvt = WSF(WS_KVT); const float* dec = WSF(WS_DEC); bf16_t* stp = WSB(WS_ST);
        for (long e = gt; e < 2L * 8 * 8192; e += NGT) {
            const int dir = (int)(e >> 16), bh = (int)((e >> 13) & 7), vd = (int)(e & 8191), d = vd & 63;
            const long base = ((long)dir * 8 + bh) * 128;
            float s = 0.f;
#pragma unroll 1
            for (int k0 = 0; k0 < 128; k0 += 32) {
                float kv[32], dc[32];
#pragma unroll
                for (int k = 0; k < 32; ++k) { const int c = dir ? 127 - (k0 + k) : k0 + k; kv[k] = kvt[(base + c) * 8192 + vd]; dc[k] = dec[(base + c) * 64 + d]; }
#pragma unroll
                for (int k = 0; k < 32; ++k) { const int c = dir ? 127 - (k0 + k) : k0 + k; stp[(base + c) * 8192 + vd] = (bf16_t)f2bf(s); s = fmaf(dc[k], s, kv[k]); }
            }
        }
    }
    if constexpr (ST == ST_GLA3) {
        for (int item = bid; item < NB * 4 * 128; item += G) {
            const int b = item >> 9, hh = (item >> 7) & 3, c = item & 127;
            gla::g3_item((char*)lds, WSB(WS_PROJB), W_DEC(l), B_DEC(l), GLA_NORM(l), b, hh, c, WSB(WS_ST), WSB(WS_BR) + 1024, 1536);
        }
    }
    if constexpr (ST == ST_MERGE_A) {
        const bf16_t* wsm = WSB(WS_WSMALL + (size_t)l * WSM_STRIDE);
        pg8::Gemm g{WSB(WS_BR), wsm + WSM_MRG / 2, T, DM, 1536, 1536}; pg8::StaticOrder S; S.init(T, DM, G, bid);
        EpiMerge E{WSB(WS_MERGEDB), WSB(WS_PROJB) + OFF_GATE};
        pg8::gemm_phase<EpiMerge, pg8::StaticOrder, true, true>((PG8_LAS unsigned char*)lds, g, S, E);
    }
    if constexpr (ST == ST_OUTP) {
        const bf16_t* wsm = WSB(WS_WSMALL + (size_t)l * WSM_STRIDE);
        pg8::Gemm g{WSB(WS_MERGEDB), wsm + WSM_OUT / 2, T, DM, DM, DM}; pg8::StaticOrder S; S.init(T, DM, G, bid);
        pg8::EpiBf16<0> E{WSB(WS_TMP), DM, nullptr, 0, 0, 1.f};
        pg8::gemm_phase<pg8::EpiBf16<0>, pg8::StaticOrder, true, true>((PG8_LAS unsigned char*)lds, g, S, E);
    }
    if constexpr (ST == ST_LN1) {
        float* RWT = lds; const float* rw = ROUTER(l);
        for (int i = tid; i < DM * 4; i += NTHR) { const int k = i >> 2, e4 = (i & 3) * 4; const float4 w = *(const float4*)(rw + (size_t)k * 16 + e4);
            RWT[(e4 + 0) * DM + k] = w.x; RWT[(e4 + 1) * DM + k] = w.y; RWT[(e4 + 2) * DM + k] = w.z; RWT[(e4 + 3) * DM + k] = w.w; }
        __syncthreads();
        float* afft = WSF(WS_AFF);
        for (int m0 = gw; m0 < T; m0 += 2 * NGW) {
            const int mr[2] = {m0, m0 + NGW};
            float4 hv[2][4];
#pragma unroll
            for (int u = 0; u < 2; ++u) { const bf16_t* hr = WSB(WS_HB) + (size_t)mr[u] * DM; const bf16_t* tr = WSB(WS_TMP) + (size_t)mr[u] * DM;
#pragma unroll
                for (int j = 0; j < 4; ++j) { float a[4], t4[4]; ld4bf(hr + 4 * (lane + 64 * j), a); ld4bf(tr + 4 * (lane + 64 * j), t4);
                    hv[u][j] = make_float4(fmaf(ALPHA, a[0], t4[0]), fmaf(ALPHA, a[1], t4[1]), fmaf(ALPHA, a[2], t4[2]), fmaf(ALPHA, a[3], t4[3])); } }
            ln_core2<1>(hv, LN1_G(l), LN1_B(l), nullptr, nullptr, WSB(WS_HB) + (size_t)mr[0] * DM, WSB(WS_HB) + (size_t)mr[1] * DM, lane,
                     p.ws + WS_HB8 + (size_t)mr[0] * DM, p.ws + WS_HB8 + (size_t)mr[1] * DM);
            float acc[2][16];
#pragma unroll
            for (int e = 0; e < 16; ++e) { float a0 = 0.f, a1 = 0.f;
#pragma unroll
                for (int j = 0; j < 4; ++j) { const float4 w = *(const float4*)(RWT + e * DM + 4 * (lane + 64 * j));
                    a0 = fmaf(hv[0][j].x, w.x, a0); a0 = fmaf(hv[0][j].y, w.y, a0); a0 = fmaf(hv[0][j].z, w.z, a0); a0 = fmaf(hv[0][j].w, w.w, a0);
                    a1 = fmaf(hv[1][j].x, w.x, a1); a1 = fmaf(hv[1][j].y, w.y, a1); a1 = fmaf(hv[1][j].z, w.z, a1); a1 = fmaf(hv[1][j].w, w.w, a1); }
                acc[0][e] = a0; acc[1][e] = a1; if (e & 1) __builtin_amdgcn_sched_barrier(0); }
#pragma unroll
            for (int i = 0; i < 8; ++i)
#pragma unroll
                for (int u = 0; u < 2; ++u) { const bool up = lane & 32; const float keep = up ? acc[u][i + 8] : acc[u][i], send = up ? acc[u][i] : acc[u][i + 8]; acc[u][i] = keep + __shfl_xor(send, 32); }
#pragma unroll
            for (int i = 0; i < 4; ++i)
#pragma unroll
                for (int u = 0; u < 2; ++u) { const bool up = lane & 16; const float keep = up ? acc[u][i + 4] : acc[u][i], send = up ? acc[u][i] : acc[u][i + 4]; acc[u][i] = keep + __shfl_xor(send, 16); }
#pragma unroll
            for (int i = 0; i < 2; ++i)
#pragma unroll
                for (int u = 0; u < 2; ++u) { const bool up = lane & 8; const float keep = up ? acc[u][i + 2] : acc[u][i], send = up ? acc[u][i] : acc[u][i + 2]; acc[u][i] = keep + __shfl_xor(send, 8); }
#pragma unroll
            for (int u = 0; u < 2; ++u) { const bool up = lane & 4; const float keep = up ? acc[u][1] : acc[u][0], send = up ? acc[u][0] : acc[u][1]; acc[u][0] = keep + __shfl_xor(send, 4); }
            float lg[2] = {acc[0][0], acc[1][0]};
#pragma unroll
            for (int o = 1; o <= 2; o <<= 1) { const float t0 = __shfl_xor(lg[0], o), t1 = __shfl_xor(lg[1], o); lg[0] += t0; lg[1] += t1; }
            float mx[2] = {lg[0], lg[1]};
#pragma unroll
            for (int o = 4; o <= 32; o <<= 1) { const float t0 = __shfl_xor(mx[0], o), t1 = __shfl_xor(mx[1], o); mx[0] = fmaxf(mx[0], t0); mx[1] = fmaxf(mx[1], t1); }
            const float ex[2] = {expf(lg[0] - mx[0]), expf(lg[1] - mx[1])}; float se[2] = {ex[0], ex[1]};
#pragma unroll
            for (int o = 4; o <= 32; o <<= 1) { const float t0 = __shfl_xor(se[0], o), t1 = __shfl_xor(se[1], o); se[0] += t0; se[1] += t1; }
            if ((lane & 3) == 0) { const int e = ((lane >> 5) & 1) * 8 + ((lane >> 4) & 1) * 4 + ((lane >> 3) & 1) * 2 + ((lane >> 2) & 1);
#pragma unroll
                for (int u = 0; u < 2; ++u) afft[(size_t)((mr[u] / SEQ) * 16 + e) * SEQ + (mr[u] % SEQ)] = ex[u] / se[u]; }
        }
        __syncthreads();
    }
    if constexpr (ST == ST_TOPK) {
        const float* afft = WSF(WS_AFF); int* idx = WSI(WS_IDX); float* gv = WSF(WS_GATEV); int* slot = WSI(WS_SLOT);
        int* hist = (int*)lds; int* ctl = hist + 256; int* scr = hist + 272;
        for (int z = bid; z < NZ; z += G) {
            const int e = z >> 1, b = z & 1; const float* list = afft + (size_t)(b * 16 + e) * SEQ;
            unsigned key[16];
#pragma unroll
            for (int j = 0; j < 16; j += 4) { const float4 x = *(const float4*)(list + tid * 16 + j); key[j] = __float_as_uint(x.x); key[j + 1] = __float_as_uint(x.y); key[j + 2] = __float_as_uint(x.z); key[j + 3] = __float_as_uint(x.w); }
            unsigned prefix = 0u; int need = CAP;
#pragma unroll 1
            for (int shift = 24; shift >= 0; shift -= 8) {
                __syncthreads();
                if (tid < 256) hist[tid] = 0;
                __syncthreads();
#pragma unroll
                for (int j = 0; j < 16; ++j) { const bool in = (shift == 24) || ((key[j] >> (shift + 8)) == (prefix >> (shift + 8))); if (in) atomicAdd(&hist[(key[j] >> shift) & 255u], 1); }
                __syncthreads();
                if (tid < 256) {
                    const int hc = hist[tid]; int inc = hc;
#pragma unroll
                    for (int o = 1; o < 64; o <<= 1) { const int y = __shfl_down(inc, o); if (lane + o < 64) inc += y; }
                    if (lane == 0) scr[wid] = inc;
                    __builtin_amdgcn_s_waitcnt(0xc07f); __builtin_amdgcn_wave_barrier();
                }
                __syncthreads();
                if (tid < 256) {
                    const int hc = hist[tid]; int inc = hc;
#pragma unroll
                    for (int o = 1; o < 64; o <<= 1) { const int y = __shfl_down(inc, o); if (lane + o < 64) inc += y; }
                    int ca = inc - hc;
#pragma unroll
                    for (int w = 1; w < 4; ++w) ca += (w > wid) ? scr[w] : 0;
                    if (ca < need && need <= ca + hc) { ctl[0] = tid; ctl[1] = need - ca; } }
                __syncthreads();
                prefix |= (unsigned)ctl[0] << shift; need = ctl[1];
            }
            int ceq = 0;
#pragma unroll
            for (int j = 0; j < 16; ++j) ceq += (key[j] == prefix) ? 1 : 0;
            int tot; const int beq = block_excl_scan(ceq, scr, tid, tot);
            int csel = 0, eqr = beq; unsigned selmask = 0u;
#pragma unroll
            for (int j = 0; j < 16; ++j) { bool sel = key[j] > prefix; if (key[j] == prefix) { sel = eqr < need; ++eqr; } if (sel) { selmask |= 1u << j; ++csel; } }
            int sl = block_excl_scan(csel, scr, tid, tot);
#pragma unroll
            for (int j = 0; j < 16; ++j) { const int trow = b * SEQ + tid * 16 + j;
                if ((selmask >> j) & 1u) { idx[z * CAP + sl] = trow; gv[z * CAP + sl] = __uint_as_float(key[j]); slot[(size_t)trow * 16 + e] = sl; ++sl; }
                else slot[(size_t)trow * 16 + e] = -1; }
        }
        __syncthreads();
    }
    if constexpr (ST == ST_GATHER) {
        const int* idx = WSI(WS_IDX); const bf16_t* hb = WSB(WS_HB); bf16_t* xe = WSB(WS_XE);
        const int nr = (NZ * CAP - gw + NGW - 1) / NGW; const int myi = (lane < nr) ? (idx[gw + lane * NGW] & (T - 1)) : 0;
        for (int k = 0; k < nr; k += 4) {
            const int k1 = (k + 1 < nr) ? k + 1 : k, k2 = (k + 2 < nr) ? k + 2 : k, k3 = (k + 3 < nr) ? k + 3 : k;
            const uint4* s0 = (const uint4*)(hb + (size_t)__shfl(myi, k) * DM); const uint4* s1 = (const uint4*)(hb + (size_t)__shfl(myi, k1) * DM);
            const uint4* s2 = (const uint4*)(hb + (size_t)__shfl(myi, k2) * DM); const uint4* s3 = (const uint4*)(hb + (size_t)__shfl(myi, k3) * DM);
            const uint4 x0 = s0[lane], y0 = s0[lane + 64], x1 = s1[lane], y1 = s1[lane + 64], x2 = s2[lane], y2 = s2[lane + 64], x3 = s3[lane], y3 = s3[lane + 64];
            { uint4* d = (uint4*)(xe + (size_t)(gw + k * NGW) * DM); d[lane] = x0; d[lane + 64] = y0; }
            if (k + 1 < nr) { uint4* d = (uint4*)(xe + (size_t)(gw + (k + 1) * NGW) * DM); d[lane] = x1; d[lane + 64] = y1; }
            if (k + 2 < nr) { uint4* d = (uint4*)(xe + (size_t)(gw + (k + 2) * NGW) * DM); d[lane] = x2; d[lane + 64] = y2; }
            if (k + 3 < nr) { uint4* d = (uint4*)(xe + (size_t)(gw + (k + 3) * NGW) * DM); d[lane] = x3; d[lane + 64] = y3; }
        }
    }
    if constexpr (ST == ST_EXP_G) {
        pg8::Gemm g{WSB(WS_HB8), WSB(WS_WGU_T), NZ * CAP, 16 * 4096, DM / 2, DM / 2, WSI(WS_IDX)};
        ExpertOrder1 S; S.init(G, bid);
        EpiSwiGLU E{WSB(WS_HID), DEXP};
        pg8::gemm_phase<EpiSwiGLU, ExpertOrder1, true, true, true, true>((PG8_LAS unsigned char*)lds, g, S, E);
    }
    if constexpr (ST == ST_EXP_D) {
        pg8::Gemm g{WSB(WS_HID), WSB(WS_WD_T), NZ * CAP, 16 * 1024, DEXP / 2, DEXP / 2};
        ExpertOrder2 S; S.init(G, bid);
        EpiRowScale E{WSB(WS_YE), DM, WSF(WS_GATEV)};
        pg8::gemm_phase<EpiRowScale, ExpertOrder2, true, true, false, true>((PG8_LAS unsigned char*)lds, g, S, E);
    }
    if constexpr (ST == ST_LN2) {
        const int* slot = WSI(WS_SLOT); const bf16_t* ye = WSB(WS_YE);
        for (int m0 = gw; m0 < T; m0 += 2 * NGW) {
            const int mr[2] = {m0, m0 + NGW};
            int sl[2]; unsigned long long mask[2]; float4 a[2][4];
#pragma unroll
            for (int u = 0; u < 2; ++u) { sl[u] = (lane < 16) ? slot[(size_t)mr[u] * 16 + lane] : -1; }
#pragma unroll
            for (int u = 0; u < 2; ++u) { const bf16_t* hr = WSB(WS_HB) + (size_t)mr[u] * DM;
#pragma unroll
                for (int j = 0; j < 4; ++j) { float x[4]; ld4bf(hr + 4 * (lane + 64 * j), x); a[u][j] = make_float4(ALPHA * x[0], ALPHA * x[1], ALPHA * x[2], ALPHA * x[3]); } }
            mask[0] = __ballot(sl[0] >= 0); mask[1] = __ballot(sl[1] >= 0);
            while (mask[0] | mask[1]) {
#pragma unroll
                for (int u = 0; u < 2; ++u) if (mask[u]) {
                    const int e = __builtin_ctzll(mask[u]); mask[u] &= mask[u] - 1;
                    const bf16_t* yr = ye + ((size_t)(e * 2 + mr[u] / SEQ) * CAP + __shfl(sl[u], e)) * DM;
#pragma unroll
                    for (int j = 0; j < 4; ++j) { float y[4]; ld4bf(yr + 4 * (lane + 64 * j), y); a[u][j].x += y[0]; a[u][j].y += y[1]; a[u][j].z += y[2]; a[u][j].w += y[3]; }
                }
            }
            if (l == 0) ln_core2<0>(a, LN2_G(l), LN2_B(l), nullptr, nullptr, WSB(WS_HB) + (size_t)mr[0] * DM, WSB(WS_HB) + (size_t)mr[1] * DM, lane);
            else ln_core2<2>(a, LN2_G(l), LN2_B(l), h + (size_t)mr[0] * DM, h + (size_t)mr[1] * DM, nullptr, nullptr, lane);
        }
    }
}


#define LAS __attribute__((address_space(3)))
#define XB_TMO      128
#define XB_XCNT(j)  (256  + 64 * (j))
#define XB_XSUB(j)  (1280 + 64 * (j))
#define XB_XGEN(j)  (2304 + 64 * (j))
#define XB_TOP      3328
#define XB_TOPGEN   3392
#define XCD_BAR_WORDS 3456
#define XB_SPIN_CAP (1u << 18)
__device__ __forceinline__ unsigned xb_ld(unsigned* p)              { return __hip_atomic_load(p, __ATOMIC_RELAXED, __HIP_MEMORY_SCOPE_AGENT); }
__device__ __forceinline__ unsigned xb_add(unsigned* p, unsigned v) { return __hip_atomic_fetch_add(p, v, __ATOMIC_RELAXED, __HIP_MEMORY_SCOPE_AGENT); }
__device__ __forceinline__ unsigned xb_xcc_id() { return (unsigned)__builtin_amdgcn_s_getreg((3 << 11) | 20) & 0xFu; }
#define XB_SPIN(cond, bar) do { unsigned _sp = 0; while (cond) { __builtin_amdgcn_s_sleep(1); \
    if ((++_sp & 255u) == 0u) { if (xb_ld(&(bar)[XB_TMO])) break; if (_sp > XB_SPIN_CAP) { atomicAdd(&(bar)[XB_TMO], 1u); break; } } } } while (0)
struct XcdBarrier { unsigned* bar; unsigned x; volatile LAS unsigned* st; };
__device__ __forceinline__ XcdBarrier xcd_barrier_post(unsigned* bar, volatile LAS unsigned* st) {
    XcdBarrier b; b.bar = bar; b.x = xb_xcc_id(); b.st = st;
    if (threadIdx.x == 0) (void)xb_add(&bar[XB_XCNT(b.x)], 1u);
    return b;
}
__device__ __forceinline__ void xcd_barrier_complete(unsigned* bar, unsigned x, unsigned& nloc, unsigned& nx) {
    const unsigned G = gridDim.x * gridDim.y * gridDim.z;
    unsigned sum, cnt, mine, sp = 0u;
    for (;;) {
        sum = 0u; cnt = 0u; mine = 0u;
#pragma unroll
        for (unsigned j = 0; j < 16; ++j) { const unsigned c = xb_ld(&bar[XB_XCNT(j)]); sum += c; cnt += (c > 0u) ? 1u : 0u; mine = (j == x) ? c : mine; }
        if (sum == G) break;
        __builtin_amdgcn_s_sleep(1);
        if ((++sp & 255u) == 0u) { if (xb_ld(&bar[XB_TMO])) break; if (sp > XB_SPIN_CAP) { atomicAdd(&bar[XB_TMO], 1u); break; } }
    }
    nloc = mine > 0u ? mine : 1u; nx = cnt > 0u ? cnt : 1u;
}
__device__ __forceinline__ void xcd_barrier(const XcdBarrier& b) {
    asm volatile("s_waitcnt vmcnt(0)" ::: "memory");
    __syncthreads();
    if (threadIdx.x == 0) {
        unsigned* bar = b.bar; asm volatile("" : "+s"(bar));
        unsigned bx = b.x; asm volatile("" : "+s"(bx));
        __builtin_amdgcn_s_waitcnt(0);
        unsigned nloc = b.st[0], nx = b.st[1];
        if (nloc == 0u) { xcd_barrier_complete(bar, bx, nloc, nx); b.st[0] = nloc; b.st[1] = nx; }
        const unsigned old = xb_add(&bar[XB_XSUB(bx)], 1u);
        const unsigned gen = old / nloc;
        if (old + 1u == (gen + 1u) * nloc) {
            __builtin_amdgcn_fence(__ATOMIC_RELEASE, "agent");
            asm volatile("s_waitcnt vmcnt(0)" ::: "memory");
            const unsigned og = xb_add(&bar[XB_TOP], 1u);
            const unsigned tg = og / nx;
            if (og + 1u == (tg + 1u) * nx) xb_add(&bar[XB_TOPGEN], 1u);
            else XB_SPIN(xb_ld(&bar[XB_TOPGEN]) == tg, bar);
            __builtin_amdgcn_fence(__ATOMIC_ACQUIRE, "agent");
            xb_add(&bar[XB_XGEN(bx)], 1u);
            asm volatile("s_waitcnt vmcnt(0)" ::: "memory");
        } else {
            XB_SPIN(xb_ld(&bar[XB_XGEN(bx)]) == gen, bar);
            __builtin_amdgcn_fence(__ATOMIC_ACQUIRE, "agent");
            asm volatile("s_waitcnt vmcnt(0)" ::: "memory");
        }
    }
    __syncthreads();
}
constexpr int MISC_OFF = 131072 + 320;
constexpr int CW_BAR = 4096;

__global__ void __launch_bounds__(NTHR) mega_fwd(Params p) {
    extern __shared__ __attribute__((aligned(16))) unsigned char lds_raw[];
    float* lds = (float*)lds_raw;
    volatile LAS unsigned* MISC = (volatile LAS unsigned*)((LAS unsigned char*)lds_raw + MISC_OFF);
    if (threadIdx.x < 32) MISC[threadIdx.x] = 0u;
    __syncthreads();
    unsigned char* ws_ = ((const KAS Params*)__builtin_amdgcn_kernarg_segment_ptr())->ws;
    XcdBarrier bar = xcd_barrier_post((unsigned*)(ws_ + WS_CTL) + CW_BAR, MISC + 8);
#define GB() xcd_barrier(bar)
    run_stage<ST_INIT>(0, lds); GB();
    for (int step = 0; step < 2 * 11; ++step) {
        const int l = step / 11, s = step % 11;
        switch (s) {
        case 0: run_stage<ST_PROJ>(l, lds); break;
        case 1: run_stage<ST_PREP>(l, lds); run_stage<ST_GLA1>(l, lds); break;
        case 2: run_stage<ST_SMALLGEMM>(l, lds); run_stage<ST_GLA2>(l, lds); break;
        case 3: run_stage<ST_ATTN>(l, lds); run_stage<ST_GLA3>(l, lds); break;
        case 4: run_stage<ST_MERGE_A>(l, lds); break;
        case 5: run_stage<ST_OUTP>(l, lds); break;
        case 6: run_stage<ST_LN1>(l, lds); break;
        case 7: run_stage<ST_TOPK>(l, lds); break;
        case 8: run_stage<ST_EXP_G>(l, lds); break;
        case 9: run_stage<ST_EXP_D>(l, lds); break;
        default: run_stage<ST_LN2>(l, lds); break;
        }
        if (step + 1 < 2 * 11) GB();
    }
#undef GB
}

template <int ST>
__global__ void __launch_bounds__(NTHR) k_stage(Params p, int l) {
    extern __shared__ __attribute__((aligned(16))) unsigned char lds_raw[];
    run_stage<ST>(l, (float*)lds_raw);
}

template <int ST> static void launch_stage(const Params& p, int l, int grid, hipStream_t stream) {
    static bool attr = false;
    if (!attr) { (void)hipFuncSetAttribute((const void*)k_stage<ST>, hipFuncAttributeMaxDynamicSharedMemorySize, LDS_BYTES); attr = true; }
    hipLaunchKernelGGL(k_stage<ST>, dim3(grid), dim3(NTHR), LDS_BYTES, stream, p, l);
}

extern "C" void kernel_launch(void* const* d_in, const int* in_sizes, int n_in, void* d_out, int out_size, void* d_ws, size_t ws_size, hipStream_t stream) {
    if (n_in != 27 || out_size != T * DM || ws_size < WS_END) {
        fprintf(stderr, "kernel_launch: unexpected shapes: n_in %d out %d ws %zu (need >= %zu)\n", n_in, out_size, ws_size, (size_t)WS_END);
        return;
    }
    Params p{};
    for (int i = 0; i < 27; ++i) p.in[i] = (const float*)d_in[i];
    p.pos = (const int*)d_in[1]; p.out = (float*)d_out; p.ws = (unsigned char*)d_ws;
    const int grid = 256;
#if MEGA
    static bool attr = false;
    if (!attr) { (void)hipFuncSetAttribute((const void*)mega_fwd, hipFuncAttributeMaxDynamicSharedMemorySize, LDS_BYTES); attr = true; }
    (void)hipMemsetAsync((char*)d_ws + WS_CTL, 0, 65536, stream);
    hipLaunchKernelGGL(mega_fwd, dim3(grid), dim3(NTHR), LDS_BYTES, stream, p);
#else
    launch_stage<ST_INIT>(p, 0, grid, stream);
    for (int l = 0; l < 2; ++l) {
        launch_stage<ST_PROJ>(p, l, grid, stream);
        launch_stage<ST_PREP>(p, l, grid, stream);
        launch_stage<ST_SMALLGEMM>(p, l, grid, stream);
        launch_stage<ST_ROPE>(p, l, grid, stream);
        launch_stage<ST_ATTN>(p, l, grid, stream);
        launch_stage<ST_GLAREC>(p, l, grid, stream);
        launch_stage<ST_GLAFIN>(p, l, grid, stream);
        launch_stage<ST_MERGE_A>(p, l, grid, stream);
        launch_stage<ST_MERGE_B>(p, l, grid, stream);
        launch_stage<ST_MERGE_C>(p, l, grid, stream);
        launch_stage<ST_OUTP>(p, l, grid, stream);
        launch_stage<ST_LN1>(p, l, grid, stream);
        launch_stage<ST_TOPK>(p, l, grid, stream);
        launch_stage<ST_EXP_G>(p, l, grid, stream);
        launch_stage<ST_EXP_U>(p, l, grid, stream);
        launch_stage<ST_EXP_D>(p, l, grid, stream);
        launch_stage<ST_LN2>(p, l, grid, stream);
    }
#endif
}
```

```cpp
#include <hip/hip_runtime.h>
#include <cstdio>
#include <cstdint>

#ifndef MEGA
#define MEGA 1
#endif

constexpr int NB = 2, SEQ = 8192, T = NB * SEQ, DM = 1024, DIN = 5824, DINP = 5888;
constexpr int OFF_GATE = 0, OFF_POOL = 3072, OFF_CQ = 3072 + 512, OFF_CKV = 3072 + 896, OFF_KR = 3072 + 1152, OFF_GQ = 3072 + 1184, OFF_GK = 3072 + 1440, OFF_GV = 3072 + 1696, OFF_GR = 3072 + 2208, OFF_GDEC = 3072 + 2720;
constexpr int NE = 16, CAP = 1024, DEXP = 2048, NZ = NB * NE;
constexpr float ALPHA = 1.4142135623730951f;
constexpr float LN_EPS = 1e-5f, RMS_EPS = 1e-6f;
constexpr int NTHR = 512, LDS_BYTES = 147456;

constexpr size_t MiB = 1u << 20;
constexpr size_t WS_CTL = 0;
constexpr size_t WS_ROPE = 1 * MiB;
constexpr size_t WS_AFF = 3 * MiB;
constexpr size_t WS_SLOT = 4 * MiB;
constexpr size_t WS_IDX = 5 * MiB;
constexpr size_t WS_GATEV = 5 * MiB + 256 * 1024;
constexpr size_t WS_WIN_T = 8 * MiB;
constexpr size_t WS_WSMALL = 31 * MiB;
constexpr size_t WSM_UQ = 0, WSM_UKV = 1 * MiB, WSM_MRG = 2 * MiB, WSM_OUT = 5 * MiB, WSM_STRIDE = 7 * MiB;
constexpr size_t WS_RQ = 6 * MiB;
constexpr size_t WS_HB = 958 * MiB;
constexpr size_t WS_WGU_T = 76 * MiB;
constexpr size_t WS_WD_T = 204 * MiB;
constexpr size_t WS_PROJB = 268 * MiB;
constexpr size_t WS_XE = 268 * MiB;
constexpr size_t WS_HID = 332 * MiB;
constexpr size_t WS_YE = 460 * MiB;
constexpr size_t WS_BR = 452 * MiB;
constexpr size_t WS_HB8 = 500 * MiB;
constexpr size_t WS_QB = 556 * MiB;
constexpr size_t WS_KB = 580 * MiB;
constexpr size_t WS_VB = 604 * MiB;
constexpr size_t WS_KVT = 702 * MiB;
constexpr size_t WS_ST = 766 * MiB;
constexpr size_t WS_DEC = 798 * MiB;
constexpr size_t WS_MERGEDB = 830 * MiB;
constexpr size_t WS_TMP = 894 * MiB;
constexpr size_t WS_END = 990 * MiB;
static_assert(WS_YE + 64 * MiB <= WS_QB, "overlay map");

namespace pg8 {
#define PG8_LAS __attribute__((address_space(3)))
typedef unsigned short bf16_t;
typedef short bf16x8 __attribute__((ext_vector_type(8)));
typedef float f32x4 __attribute__((ext_vector_type(4)));
typedef unsigned u32x4 __attribute__((ext_vector_type(4)));
constexpr int BM = 256, BK = 64, HALF = 128, HTB = HALF * BK * 2  , STAGE_BYTES = 8 * HTB, NXCD = 8, WGM = 8;

__host__ __device__ __forceinline__ int lds_byte(int r, int c) { const int st = (r >> 4) * 2 + (c >> 5), rr = r & 15, cc = c & 31, ob = rr * 64 + cc * 2; return st * 1024 + (ob ^ (((ob >> 9) & 1) << 5)); }
__host__ __device__ __forceinline__ void stage_rc(int b, int& R, int& C) { const int st = b / 1024, sb = b % 1024, swz = sb ^ (((sb >> 9) & 1) << 5); R = (st >> 1) * 16 + swz / 64; C = (st & 1) * 32 + (swz % 64) / 2; }
__host__ __device__ __forceinline__ int perm32(int rho) { const int n = rho >> 4, i = rho & 15; return 8 * (i >> 2) + 4 * n + (i & 3); }

struct Unit { int pm, pn; };
struct Gemm { const bf16_t* A; const bf16_t* Bt; int M, N, K, lda; const int* ridx; };

struct StaticOrder {
    int nM, nN, nwg, G, c;
    __host__ __device__ void init(int M, int N, int G_, int c_) { nM = M / BM; nN = N / BM; nwg = nM * nN; G = G_; c = c_; }
    __host__ __device__ bool next(int i, Unit& u) const {
        const long L = (long)i * G + c; if (L >= nwg) return false;
        int wgid = (int)L; { const int q = nwg / NXCD, r = nwg % NXCD, xcd = wgid % NXCD, off = wgid / NXCD; wgid = (xcd < r ? xcd * (q + 1) : r * (q + 1) + (xcd - r) * q) + off; }
        const int nig = WGM * nN, gid = wgid / nig, fm = gid * WGM, gsz = (nM - fm) < WGM ? (nM - fm) : WGM;
        u.pm = fm + ((wgid % nig) % gsz); u.pn = (wgid % nig) / gsz; return true;
    }
    __device__ __forceinline__ void a_ready(const Unit&) const {}
    __device__ __forceinline__ void done(const Unit&) const {}
};

__device__ __forceinline__ unsigned cvt_pk_bf16(float lo, float hi) { unsigned r; asm volatile("v_cvt_pk_bf16_f32 %0, %1, %2" : "=v"(r) : "v"(lo), "v"(hi)); return r; }
typedef float f32x2 __attribute__((ext_vector_type(2)));
__device__ __forceinline__ f32x2 gelu_pk(f32x2 v) {
    const f32x2 av = __builtin_elementwise_abs(v), d = av * 0.2316418882f + 1.0f;
    f32x2 t; t.x = __builtin_amdgcn_rcpf(d.x); t.y = __builtin_amdgcn_rcpf(d.y);
    f32x2 q = t * 0.5307027145f + (-0.7265760135f); q = q * t + 0.7107068705f; q = q * t + (-0.142248368f); q = q * t + 0.127414796f; q = q * t;
    const f32x2 s = (v * v) * (-0.72134752044f);
    f32x2 e; e.x = __builtin_amdgcn_exp2f(s.x); e.y = __builtin_amdgcn_exp2f(s.y);
    const f32x2 m = v * (q * e), r = v - m;
    f32x2 o; o.x = v.x < 0.f ? m.x : r.x; o.y = v.y < 0.f ? m.y : r.y; return o;
}

template <int ACT  > struct EpiBf16 {
    static constexpr bool PERM = true, AFTER_DRAIN = false; static constexpr int SEG = 0; static_assert(ACT == 0 || ACT == 1, "EpiBf16: ACT is 0 (none) or 1 (gelu_pk)");
    bf16_t* O; int ldc; const float* bias; int split_cols; size_t split_stride; float scale0;
    __device__ __forceinline__ void operator()(const f32x4 (&acc)[2][2][4][2], const Unit& u, int wr, int wc, int fr, int fq) const {
        const int row0 = u.pm * BM + wr * 64 + fr; int colt = u.pn * BM; bf16_t* base = O;
        float sc = 1.f; if (split_cols) { const int t = colt / split_cols; base += (size_t)t * split_stride; colt -= t * split_cols; if (t == 0) sc = scale0; }
        const int col0 = colt + wc * 32 + 8 * fq, bcol0 = u.pn * BM + wc * 32 + 8 * fq;
        f32x4 bv[2][2];
#pragma unroll
        for (int bj = 0; bj < 2; ++bj)
#pragma unroll
            for (int n = 0; n < 2; ++n) bv[bj][n] = bias ? *(const f32x4*)(bias + bcol0 + bj * HALF + 4 * n) : (f32x4){0.f, 0.f, 0.f, 0.f};
#pragma unroll
        for (int ai = 0; ai < 2; ++ai)
#pragma unroll
            for (int m = 0; m < 4; ++m) { bf16_t* rowp = base + (size_t)(row0 + ai * HALF + m * 16) * ldc + col0;
#pragma unroll
                for (int bj = 0; bj < 2; ++bj) { f32x4 v0 = acc[ai][bj][m][0] + bv[bj][0], v1 = acc[ai][bj][m][1] + bv[bj][1];
                    if (ACT == 1) { f32x2 a = gelu_pk((f32x2){v0[0], v0[1]}), b = gelu_pk((f32x2){v0[2], v0[3]}), c = gelu_pk((f32x2){v1[0], v1[1]}), d = gelu_pk((f32x2){v1[2], v1[3]});
                        v0 = (f32x4){a.x, a.y, b.x, b.y}; v1 = (f32x4){c.x, c.y, d.x, d.y}; }
                    v0 = v0 * sc; v1 = v1 * sc; u32x4 w; w.x = cvt_pk_bf16(v0[0], v0[1]); w.y = cvt_pk_bf16(v0[2], v0[3]); w.z = cvt_pk_bf16(v1[0], v1[1]); w.w = cvt_pk_bf16(v1[2], v1[3]);
                    *(u32x4*)(rowp + bj * HALF) = w; } }
    }
};

struct PanelStats {
    unsigned* xbuf;
    unsigned* cnt;
    unsigned* tmo;
    int ntn; float eps;
    unsigned code;
    __device__ __forceinline__ bool run(const f32x4 (&v)[2][2][4][2], const Unit& u, int wr, int wc, int fr, int fq, PG8_LAS unsigned char* lds, int wid, int lane) const {
        typedef float f32x2v __attribute__((ext_vector_type(2)));
        PG8_LAS f32x2v* P = (PG8_LAS f32x2v*)lds;
        PG8_LAS f32x2v* S = (PG8_LAS f32x2v*)(lds + 8192);
        PG8_LAS unsigned* flag = (PG8_LAS unsigned*)(lds + 8192 + 2048);
#pragma unroll
        for (int ai = 0; ai < 2; ++ai)
#pragma unroll
            for (int m = 0; m < 4; ++m) {
                float s = 0.f;
#pragma unroll
                for (int bj = 0; bj < 2; ++bj)
#pragma unroll
                    for (int n = 0; n < 2; ++n) { const f32x4 x = v[ai][bj][m][n]; s += (x[0] + x[1]) + (x[2] + x[3]); }
                s += __shfl_xor(s, 16); s += __shfl_xor(s, 32);
                const float mw = s * (1.0f / 64.0f); float q = 0.f;
#pragma unroll
                for (int bj = 0; bj < 2; ++bj)
#pragma unroll
                    for (int n = 0; n < 2; ++n) { const f32x4 d = v[ai][bj][m][n] - mw; q += (d[0] * d[0] + d[1] * d[1]) + (d[2] * d[2] + d[3] * d[3]); }
                q += __shfl_xor(q, 16); q += __shfl_xor(q, 32);
                if (fq == 0) P[(ai * HALF + wr * 64 + m * 16 + fr) * 4 + wc] = (f32x2v){mw, q};
            }
        asm volatile("s_waitcnt lgkmcnt(0)" ::: "memory"); __builtin_amdgcn_s_barrier(); asm volatile("" ::: "memory");
#if defined(BROKEN_EXCHANGE_NO_WAIT)
#warning BROKEN CONTROL BUILD: the row-statistics exchange does not wait; results are wrong by design
        if (blockIdx.x >= 64) { const long long t0_ = clock64(); while (clock64() - t0_ < 60000) __builtin_amdgcn_s_sleep(8); }
#endif
        const int row = wid * 32 + (lane & 31);
        if (lane < 32) {
            const f32x2v a = P[row * 4 + 0], b = P[row * 4 + 1], c = P[row * 4 + 2], d = P[row * 4 + 3];
            const float mt = (a.x + b.x + c.x + d.x) * 0.25f;
            const float da = a.x - mt, db = b.x - mt, dc = c.x - mt, dd = d.x - mt;
            const float m2 = (a.y + b.y) + (c.y + d.y) + 64.0f * ((da * da + db * db) + (dc * dc + dd * dd));
            unsigned long long* slot = (unsigned long long*)xbuf + ((size_t)(u.pm * BM + row) * 4 + u.pn);
            __hip_atomic_store(slot, ((unsigned long long)__float_as_uint(m2) << 32) | __float_as_uint(mt), __ATOMIC_RELAXED, __HIP_MEMORY_SCOPE_AGENT);
        }
        asm volatile("s_waitcnt vmcnt(0)" ::: "memory");
        if (lane == 0) __hip_atomic_fetch_add(cnt + 64 * u.pm, 1u, __ATOMIC_RELAXED, __HIP_MEMORY_SCOPE_AGENT);
        if (wid == 0) {
            bool dead = false; const unsigned long long t0 = __builtin_amdgcn_s_memrealtime(); const unsigned want = 8u * (unsigned)ntn;
            for (;;) {
#if defined(BROKEN_EXCHANGE_NO_WAIT)
                break;
#endif
                if ((unsigned)__builtin_amdgcn_readfirstlane(__hip_atomic_load(cnt + 64 * u.pm, __ATOMIC_RELAXED, __HIP_MEMORY_SCOPE_AGENT)) >= want) break;
                if (__builtin_amdgcn_s_memrealtime() - t0 > 2000000ull) {
                    if (lane == 0) { unsigned expect = 0u; __hip_atomic_compare_exchange_strong(tmo + 1, &expect, code | (unsigned)(u.pm & 0xff), __ATOMIC_RELAXED, __ATOMIC_RELAXED, __HIP_MEMORY_SCOPE_AGENT);
                                     __hip_atomic_store(tmo, 1u, __ATOMIC_RELAXED, __HIP_MEMORY_SCOPE_AGENT); }
                    dead = true; break; }
                __builtin_amdgcn_s_sleep(2);
            }
            __builtin_amdgcn_fence(__ATOMIC_ACQUIRE, "agent");
            if (lane == 0) flag[0] = dead ? 1u : 0u;
        }
        asm volatile("s_waitcnt vmcnt(0) lgkmcnt(0)" ::: "memory"); __builtin_amdgcn_s_barrier(); asm volatile("" ::: "memory");
        const bool bad = flag[0] != 0u;
        if (lane < 32) {
            const unsigned long long* slot = (const unsigned long long*)xbuf + (size_t)(u.pm * BM + row) * 4; float mt[4], m2[4]; float ms = 0.f;
#pragma unroll
            for (int t = 0; t < 4; ++t) { if (t < ntn) { const unsigned long long w = __hip_atomic_load(slot + t, __ATOMIC_RELAXED, __HIP_MEMORY_SCOPE_AGENT); mt[t] = __uint_as_float((unsigned)w); m2[t] = __uint_as_float((unsigned)(w >> 32)); } else { mt[t] = 0.f; m2[t] = 0.f; } ms += mt[t]; }
            const float mean = ms / (float)ntn; float q = 0.f;
#pragma unroll
            for (int t = 0; t < 4; ++t) if (t < ntn) { const float dm = mt[t] - mean; q += m2[t] + 256.0f * dm * dm; }
            S[row] = (f32x2v){mean, 1.0f / sqrtf(q / (256.0f * (float)ntn) + eps)};
        }
        asm volatile("s_waitcnt lgkmcnt(0)" ::: "memory"); __builtin_amdgcn_s_barrier(); asm volatile("" ::: "memory");
        return bad;
    }
};
struct EpiLnRes {
    static constexpr bool PERM = false, AFTER_DRAIN = true; static constexpr int SEG = 0;
    const float* base; float* out; int ldc; const float* bias; PanelStats st; unsigned poison;
    __device__ __forceinline__ void fused(f32x4 (&acc)[2][2][4][2], const Unit& u, int wr, int wc, int fr, int fq, PG8_LAS unsigned char* lds, int wid, int lane) const {
        typedef float f32x2v __attribute__((ext_vector_type(2)));
        const PG8_LAS f32x2v* S = (const PG8_LAS f32x2v*)(lds + 8192);
        const int col0 = u.pn * BM + wc * 32 + 4 * fq;
#pragma unroll
        for (int bj = 0; bj < 2; ++bj)
#pragma unroll
            for (int n = 0; n < 2; ++n) { const f32x4 bv = bias ? *(const f32x4*)(bias + col0 + bj * HALF + n * 16) : (f32x4){0.f, 0.f, 0.f, 0.f};
#pragma unroll
                for (int ai = 0; ai < 2; ++ai)
#pragma unroll
                    for (int m = 0; m < 4; ++m) acc[ai][bj][m][n] += bv; }
        f32x4 pre[4][2][2];
#pragma unroll
        for (int m = 0; m < 4; ++m) { const size_t off = (size_t)(u.pm * BM + wr * 64 + m * 16 + fr) * ldc + col0;
#pragma unroll
            for (int bj = 0; bj < 2; ++bj)
#pragma unroll
                for (int n = 0; n < 2; ++n) pre[m][bj][n] = *(const f32x4*)(base + off + bj * HALF + n * 16); }
        const bool bad = st.run(acc, u, wr, wc, fr, fq, lds, wid, lane) || poison != 0u;
        const float qnan = __builtin_nanf("");
#pragma unroll
        for (int ai = 0; ai < 2; ++ai)
#pragma unroll
            for (int m = 0; m < 4; ++m) { const int r = ai * HALF + wr * 64 + m * 16 + fr; const f32x2v sr = S[r]; const size_t off = (size_t)(u.pm * BM + r) * ldc + col0;
#pragma unroll
                for (int bj = 0; bj < 2; ++bj)
#pragma unroll
                    for (int n = 0; n < 2; ++n) { const f32x4 bs = ai == 0 ? pre[m][bj][n] : *(const f32x4*)(base + off + bj * HALF + n * 16); f32x4 o = bs + (acc[ai][bj][m][n] - sr.x) * sr.y;
                        if (bad) o = (f32x4){qnan, qnan, qnan, qnan}; *(f32x4*)(out + off + bj * HALF + n * 16) = o; }
                if (m & 1) asm volatile("" ::: "memory"); }
    }
};
struct EpiLnResLn {
    static constexpr bool PERM = false, AFTER_DRAIN = true; static constexpr int SEG = 0;
    const float* base; float* out; bf16_t* xn; int ldc; const float* bias; PanelStats st1, st2; unsigned poison;
    __device__ __forceinline__ void fused(f32x4 (&acc)[2][2][4][2], const Unit& u, int wr, int wc, int fr, int fq, PG8_LAS unsigned char* lds, int wid, int lane) const {
        typedef float f32x2v __attribute__((ext_vector_type(2))); typedef unsigned u32x2v __attribute__((ext_vector_type(2)));
        const PG8_LAS f32x2v* S = (const PG8_LAS f32x2v*)(lds + 8192);
        const int col0 = u.pn * BM + wc * 32 + 4 * fq;
#pragma unroll
        for (int bj = 0; bj < 2; ++bj)
#pragma unroll
            for (int n = 0; n < 2; ++n) { const f32x4 bv = bias ? *(const f32x4*)(bias + col0 + bj * HALF + n * 16) : (f32x4){0.f, 0.f, 0.f, 0.f};
#pragma unroll
                for (int ai = 0; ai < 2; ++ai)
#pragma unroll
                    for (int m = 0; m < 4; ++m) acc[ai][bj][m][n] += bv; }
        bool bad = st1.run(acc, u, wr, wc, fr, fq, lds, wid, lane) || poison != 0u;
        const float qnan = __builtin_nanf("");
#pragma unroll
        for (int ai = 0; ai < 2; ++ai)
#pragma unroll
            for (int m = 0; m < 4; ++m) { const int r = ai * HALF + wr * 64 + m * 16 + fr; const f32x2v sr = S[r]; const size_t off = (size_t)(u.pm * BM + r) * ldc + col0;
#pragma unroll
                for (int bj = 0; bj < 2; ++bj)
#pragma unroll
                    for (int n = 0; n < 2; ++n) { const f32x4 bs = *(const f32x4*)(base + off + bj * HALF + n * 16); acc[ai][bj][m][n] = bs + (acc[ai][bj][m][n] - sr.x) * sr.y; }
                asm volatile("" : "+v"(acc[ai][0][m][0]), "+v"(acc[ai][0][m][1]), "+v"(acc[ai][1][m][0]), "+v"(acc[ai][1][m][1]));
                if (m & 1) asm volatile("" ::: "memory"); }
        const bool bad1 = bad;
        bad = st2.run(acc, u, wr, wc, fr, fq, lds, wid, lane) || bad;
#pragma unroll
        for (int ai = 0; ai < 2; ++ai)
#pragma unroll
            for (int m = 0; m < 4; ++m) { const int r = ai * HALF + wr * 64 + m * 16 + fr; const f32x2v sr = S[r]; const size_t off = (size_t)(u.pm * BM + r) * ldc + col0;
#pragma unroll
                for (int bj = 0; bj < 2; ++bj)
#pragma unroll
                    for (int n = 0; n < 2; ++n) { const f32x4 x1 = acc[ai][bj][m][n]; *(f32x4*)(out + off + bj * HALF + n * 16) = bad1 ? (f32x4){qnan, qnan, qnan, qnan} : x1;
                        const f32x4 o = (x1 - sr.x) * sr.y; u32x2v w; w.x = cvt_pk_bf16(o[0], o[1]); w.y = cvt_pk_bf16(o[2], o[3]);
                        if (bad) { w.x = 0x7fc07fc0u; w.y = 0x7fc07fc0u; } *(u32x2v*)(xn + off + bj * HALF + n * 16) = w; }
                asm volatile("" ::: "memory"); }
    }
};

template <class Epi, class Sched, bool ALIGN_EPI = false, bool SP2 = false, bool GATHER = false, bool FP8 = false>
__device__ __forceinline__ void gemm_phase(PG8_LAS unsigned char* lds, const Gemm g, const Sched& S, const Epi& E) {
    int tid_ = threadIdx.x; asm volatile("" : "+v"(tid_));
    const int tid = tid_, wid = __builtin_amdgcn_readfirstlane(tid >> 6), lane = tid & 63, wr = wid >> 2, wc = wid & 3, fr = lane & 15, fq = lane >> 4;
    int K_ = g.K; asm volatile("" : "+s"(K_));
    const int K = K_, nt = K / BK;
    unsigned voffA[2], voffB[2];
#pragma unroll
    for (int i = 0; i < 2; ++i) { int R, C; stage_rc(tid * 16 + i * 8192, R, C); const int Rb = Epi::PERM ? ((R & ~31) + perm32(R & 31)) : R;
        voffA[i] = (unsigned)(R * g.lda + C) * 2u; voffB[i] = (unsigned)(Rb * K + C) * 2u; }
    const size_t kstep = (size_t)(BK * 2);
    static_assert(!GATHER || SP2, "GATHER is implemented for the SP2 loop");
    const size_t hstepB = (size_t)HALF * K * 2, hstepA = GATHER ? 0 : (size_t)HALF * g.lda * 2;
    const size_t tstepB = 2 * hstepB, tstepA = GATHER ? 0 : 2 * hstepA;
    const unsigned ldsw = (unsigned)wid * 1024u;
    const int aoffk[2] = {lds_byte(wr * 64 + fr, FP8 ? 16 * fq : 8 * fq), lds_byte(wr * 64 + fr, FP8 ? 16 * fq + 8 : 8 * fq + 32)};
    const int boffk[2] = {lds_byte(wc * 32 + fr, FP8 ? 16 * fq : 8 * fq), lds_byte(wc * 32 + fr, FP8 ? 16 * fq + 8 : 8 * fq + 32)};
#define PG8_SA(b, h) (((b) * 2 + (h)) * HTB)
#define PG8_SB(b, h) ((4 + (b) * 2 + (h)) * HTB)
#define PG8_STAGE(bufoff, gbase, voff) do { _Pragma("unroll") for (int _i = 0; _i < 2; ++_i) \
        __builtin_amdgcn_global_load_lds((const unsigned*)((const char*)(gbase) + (voff)[_i]), (PG8_LAS unsigned*)(lds + (bufoff) + ldsw + _i * 8192), 16, 0, 0); } while (0)
    typedef int i32x4_ __attribute__((ext_vector_type(4))); typedef int i32x8_ __attribute__((ext_vector_type(8)));
#define PG8_LD16(off) (*(const PG8_LAS i32x4_*)(lds + (off)))
#define PG8_LDA(dst, b, h) do { _Pragma("unroll") for (int m = 0; m < 4; ++m) { \
        if constexpr (FP8) dst##8[m] = *(const PG8_LAS i32x8_*)(lds + PG8_SA(b, h) + aoffk[0] + m * 2048);     \
        else { _Pragma("unroll") for (int k = 0; k < 2; ++k) dst[m][k] = *(const PG8_LAS bf16x8*)(lds + PG8_SA(b, h) + aoffk[k] + m * 2048); } } } while (0)
#define PG8_LDB(dst, b, h) do { _Pragma("unroll") for (int n = 0; n < 2; ++n) { \
        if constexpr (FP8) dst##8[n] = *(const PG8_LAS i32x8_*)(lds + PG8_SB(b, h) + boffk[0] + n * 2048); \
        else { _Pragma("unroll") for (int k = 0; k < 2; ++k) dst[n][k] = *(const PG8_LAS bf16x8*)(lds + PG8_SB(b, h) + boffk[k] + n * 2048); } } } while (0)
#define PG8_MMA(ai, bj, At, Bt) do { __builtin_amdgcn_s_setprio(1); _Pragma("unroll") for (int m = 0; m < 4; ++m) _Pragma("unroll") for (int n = 0; n < 2; ++n) { \
        if constexpr (FP8) asm volatile("s_nop 1\n\tv_mfma_scale_f32_16x16x128_f8f6f4 %0, %1, %2, %0, %3, %3 op_sel_hi:[0,0,0]" : "+v"(acc[ai][bj][m][n]) : "v"(Bt##8[n]), "v"(At##8[m]), "v"(sc1_));     \
        else { _Pragma("unroll") for (int k = 0; k < 2; ++k) acc[ai][bj][m][n] = __builtin_amdgcn_mfma_f32_16x16x32_bf16(Bt[n][k], At[m][k], acc[ai][bj][m][n], 0, 0, 0); } } \
        __builtin_amdgcn_s_setprio(0); } while (0)
#define PG8_WAIT_V(n) asm volatile("s_waitcnt vmcnt(" #n ")" ::: "memory")
#define PG8_WAIT_L(n) asm volatile("s_waitcnt lgkmcnt(" #n ")" ::: "memory")
#define PG8_BAR __builtin_amdgcn_s_barrier()
#define PG8_SCHED __builtin_amdgcn_sched_barrier(0)
    Unit cur, nxt; int ui = 0;
    if (!S.next(0, cur)) return;
    unsigned vC0[2] = {voffA[0], voffA[1]}, vC1[2] = {voffA[0], voffA[1]}, vN0[2] = {voffA[0], voffA[1]}, vN1[2] = {voffA[0], voffA[1]};
    int gR[2], gC[2];
#pragma unroll
    for (int i = 0; i < 2; ++i) { stage_rc(tid * 16 + i * 8192, gR[i], gC[i]); }
    if constexpr (GATHER) {
#pragma unroll
        for (int i = 0; i < 2; ++i) { vC0[i] = (unsigned)(g.ridx[cur.pm * 256 + gR[i]] * g.lda + gC[i]) * 2u; vC1[i] = (unsigned)(g.ridx[cur.pm * 256 + 128 + gR[i]] * g.lda + gC[i]) * 2u; }
    }
    f32x4 acc[2][2][4][2];
#pragma unroll
    for (int a = 0; a < 2; ++a)
#pragma unroll
        for (int b = 0; b < 2; ++b)
#pragma unroll
            for (int m = 0; m < 4; ++m)
#pragma unroll
                for (int n = 0; n < 2; ++n) acc[a][b][m][n] = (f32x4){0.f, 0.f, 0.f, 0.f};
    const int sc1_ = 0x7f7f7f7f;
    bf16x8 At[4][2], B0[2][2], B1[2][2]; i32x8_ At8[4], B08[2], B18[2];
    const char* cA = (const char*)g.A + (size_t)cur.pm * tstepA; const char* cB = (const char*)g.Bt + (size_t)cur.pn * tstepB;
    S.a_ready(cur);
    if constexpr (SP2) {
        PG8_STAGE(PG8_SB(0, 0), cB, voffB); PG8_STAGE(PG8_SB(0, 1), cB + hstepB, voffB); PG8_STAGE(PG8_SA(0, 0), cA, vC0); PG8_STAGE(PG8_SA(0, 1), cA + hstepA, vC1);
        if (wr == 1) PG8_BAR;
        PG8_WAIT_V(2); PG8_BAR;
        PG8_STAGE(PG8_SB(1, 0), cB + kstep, voffB); PG8_STAGE(PG8_SA(1, 0), cA + kstep, vC0); PG8_STAGE(PG8_SB(1, 1), cB + hstepB + kstep, voffB);
        PG8_WAIT_V(6); PG8_BAR;
    } else {
        PG8_STAGE(PG8_SB(0, 0), cB, voffB); PG8_STAGE(PG8_SA(0, 0), cA, voffA); PG8_STAGE(PG8_SB(0, 1), cB + hstepB, voffB); PG8_STAGE(PG8_SA(0, 1), cA + hstepA, voffA);
        if (wr == 1) PG8_BAR;
        PG8_WAIT_V(4); PG8_BAR;
        PG8_STAGE(PG8_SB(1, 0), cB + kstep, voffB); PG8_STAGE(PG8_SA(1, 0), cA + kstep, voffA); PG8_STAGE(PG8_SB(1, 1), cB + hstepB + kstep, voffB);
        PG8_WAIT_V(6); PG8_BAR;
    }
    for (;;) {
        const bool has_next = S.next(ui + 1, nxt);
        int gi0[2] = {0, 0}, gi1[2] = {0, 0};
        if constexpr (GATHER) { if (has_next) {
#pragma unroll
            for (int i = 0; i < 2; ++i) { gi0[i] = g.ridx[nxt.pm * 256 + gR[i]]; gi1[i] = g.ridx[nxt.pm * 256 + 128 + gR[i]]; } } }
        const char* nA = has_next ? (const char*)g.A + (size_t)nxt.pm * tstepA : cA; const char* nB = has_next ? (const char*)g.Bt + (size_t)nxt.pn * tstepB : cB;
        for (int t = 0; t < nt; t += 2) {
            const bool last = (t == nt - 2);
            const char* a1 = cA + (size_t)(t + 1) * kstep;
            const char* a2 = last ? nA : cA + (size_t)(t + 2) * kstep; const char* b2 = last ? nB : cB + (size_t)(t + 2) * kstep;
            const char* a3 = a2 + kstep; const char* b3 = b2 + kstep;
            if (last && has_next) S.a_ready(nxt);
            unsigned v20[2] = {vC0[0], vC0[1]}, v21[2] = {vC1[0], vC1[1]};
            if constexpr (GATHER) { if (last && has_next) {
#pragma unroll
                for (int i = 0; i < 2; ++i) { vN0[i] = (unsigned)(gi0[i] * g.lda + gC[i]) * 2u; vN1[i] = (unsigned)(gi1[i] * g.lda + gC[i]) * 2u; v20[i] = vN0[i]; v21[i] = vN1[i]; } } }
            if constexpr (SP2) {
            PG8_LDB(B0, 0, 0); PG8_LDB(B1, 0, 1); PG8_SCHED; PG8_LDA(At, 0, 0); PG8_STAGE(PG8_SA(1, 1), a1 + hstepA, vC1);
            PG8_WAIT_V(8); PG8_WAIT_L(0); PG8_BAR; PG8_MMA(0, 0, At, B0); PG8_MMA(0, 1, At, B1); PG8_BAR; PG8_SCHED;
            PG8_LDA(At, 0, 1); PG8_STAGE(PG8_SB(0, 0), b2, voffB); PG8_STAGE(PG8_SB(0, 1), b2 + hstepB, voffB); PG8_STAGE(PG8_SA(0, 0), a2, v20);
            PG8_WAIT_V(8); PG8_WAIT_L(0); PG8_BAR; PG8_MMA(1, 0, At, B0); PG8_MMA(1, 1, At, B1); PG8_BAR; PG8_SCHED;
            PG8_LDB(B0, 1, 0); PG8_LDB(B1, 1, 1); PG8_SCHED; PG8_LDA(At, 1, 0); PG8_STAGE(PG8_SA(0, 1), a2 + hstepA, v21);
            PG8_WAIT_V(8); PG8_WAIT_L(0); PG8_BAR; PG8_MMA(0, 0, At, B0); PG8_MMA(0, 1, At, B1); PG8_BAR; PG8_SCHED;
            PG8_LDA(At, 1, 1); PG8_STAGE(PG8_SB(1, 0), b3, voffB); PG8_STAGE(PG8_SB(1, 1), b3 + hstepB, voffB); PG8_STAGE(PG8_SA(1, 0), a3, v20);
            PG8_WAIT_V(8); PG8_WAIT_L(0); PG8_BAR; PG8_MMA(1, 0, At, B0); PG8_MMA(1, 1, At, B1); PG8_BAR; PG8_SCHED;
            if constexpr (Epi::SEG > 0) { if ((t + 2) % Epi::SEG == 0 && t + 2 < nt) E.segment(acc, cur, (t + 2) / Epi::SEG, wr, wc, fr, fq); }
            } else {
            PG8_LDB(B0, 0, 0); PG8_SCHED; PG8_LDA(At, 0, 0); PG8_STAGE(PG8_SA(1, 1), a1 + hstepA, voffA);
            PG8_WAIT_L(8); PG8_BAR; PG8_WAIT_L(0); PG8_MMA(0, 0, At, B0); PG8_BAR; PG8_SCHED;
            PG8_LDB(B1, 0, 1); PG8_STAGE(PG8_SB(0, 0), b2, voffB);
            PG8_BAR; PG8_WAIT_L(0); PG8_MMA(0, 1, At, B1); PG8_BAR;
            PG8_LDA(At, 0, 1); PG8_STAGE(PG8_SA(0, 0), a2, voffA);
            PG8_BAR; PG8_WAIT_L(0); PG8_MMA(1, 0, At, B0); PG8_BAR; PG8_SCHED;
            PG8_STAGE(PG8_SB(0, 1), b2 + hstepB, voffB);
            PG8_WAIT_V(6); PG8_BAR; PG8_MMA(1, 1, At, B1); PG8_BAR;
            PG8_LDB(B0, 1, 0); PG8_SCHED; PG8_LDA(At, 1, 0); PG8_STAGE(PG8_SA(0, 1), a2 + hstepA, voffA);
            PG8_WAIT_L(8); PG8_BAR; PG8_WAIT_L(0); PG8_MMA(0, 0, At, B0); PG8_BAR; PG8_SCHED;
            PG8_LDB(B1, 1, 1); PG8_STAGE(PG8_SB(1, 0), b3, voffB);
            PG8_BAR; PG8_WAIT_L(0); PG8_MMA(0, 1, At, B1); PG8_BAR;
            PG8_LDA(At, 1, 1); PG8_STAGE(PG8_SA(1, 0), a3, voffA);
            PG8_BAR; PG8_WAIT_L(0); PG8_MMA(1, 0, At, B0); PG8_BAR; PG8_SCHED;
            PG8_STAGE(PG8_SB(1, 1), b3 + hstepB, voffB);
            PG8_WAIT_V(6); PG8_BAR; PG8_MMA(1, 1, At, B1); PG8_BAR;
            }
        }
        if constexpr (FP8) asm volatile("s_nop 15\n\ts_nop 3" ::: "memory");
        if constexpr (ALIGN_EPI) { if (wr == 0) PG8_BAR; }
        if constexpr (!Epi::AFTER_DRAIN) { E(acc, cur, wr, wc, fr, fq); S.done(cur); }
        if (!has_next) break;
#pragma unroll
        for (int a = 0; a < 2; ++a)
#pragma unroll
            for (int b = 0; b < 2; ++b)
#pragma unroll
                for (int m = 0; m < 4; ++m)
#pragma unroll
                    for (int n = 0; n < 2; ++n) acc[a][b][m][n] = (f32x4){0.f, 0.f, 0.f, 0.f};
        cur = nxt; cA = nA; cB = nB; ++ui;
        if constexpr (GATHER) { vC0[0] = vN0[0]; vC0[1] = vN0[1]; vC1[0] = vN1[0]; vC1[1] = vN1[1]; }
        if constexpr (ALIGN_EPI) { if (wr == 1) PG8_BAR; }
    }
    PG8_WAIT_V(0);
    if constexpr (!ALIGN_EPI) { if (wr == 0) PG8_BAR; }
    PG8_BAR;
    if constexpr (Epi::AFTER_DRAIN) { E.fused(acc, cur, wr, wc, fr, fq, lds, wid, lane); S.done(cur); }
#undef PG8_SA
#undef PG8_SB
#undef PG8_STAGE
#undef PG8_LDA
#undef PG8_LD16
#undef PG8_LDB
#undef PG8_MMA
#undef PG8_WAIT_V
#undef PG8_WAIT_L
#undef PG8_BAR
#undef PG8_SCHED
}
}

typedef unsigned short bf16_t;
__device__ __forceinline__ unsigned pk4_fp8(float a, float b, float c, float d) { unsigned w = 0u; w = __builtin_amdgcn_cvt_pk_fp8_f32(a, b, w, false); w = __builtin_amdgcn_cvt_pk_fp8_f32(c, d, w, true); return w; }
constexpr float F8_WGU = 64.f, F8_WD = 128.f, F8_HID = 4.f;
typedef unsigned u32x4_t __attribute__((ext_vector_type(4)));
__device__ __forceinline__ void ldg8_dw(float (&o)[8], const void* base, const unsigned (&off)[8]) {
    asm volatile("global_load_dword %0, %9, %8\n\tglobal_load_dword %1, %10, %8\n\tglobal_load_dword %2, %11, %8\n\tglobal_load_dword %3, %12, %8\n\t"
                 "global_load_dword %4, %13, %8\n\tglobal_load_dword %5, %14, %8\n\tglobal_load_dword %6, %15, %8\n\tglobal_load_dword %7, %16, %8\n\ts_waitcnt vmcnt(0)"
                 : "=&v"(o[0]), "=&v"(o[1]), "=&v"(o[2]), "=&v"(o[3]), "=&v"(o[4]), "=&v"(o[5]), "=&v"(o[6]), "=&v"(o[7])
                 : "s"(base), "v"(off[0]), "v"(off[1]), "v"(off[2]), "v"(off[3]), "v"(off[4]), "v"(off[5]), "v"(off[6]), "v"(off[7]) : "memory");
}
template <int I1, int I2, int I3>
__device__ __forceinline__ void ldg8_x4(u32x4_t (&a)[4], u32x4_t (&b)[4], const void* base, unsigned offA, unsigned offB) {
    asm volatile("global_load_dwordx4 %0, %9, %8\n\tglobal_load_dwordx4 %1, %9, %8 offset:%11\n\tglobal_load_dwordx4 %2, %9, %8 offset:%12\n\tglobal_load_dwordx4 %3, %9, %8 offset:%13\n\t"
                 "global_load_dwordx4 %4, %10, %8\n\tglobal_load_dwordx4 %5, %10, %8 offset:%11\n\tglobal_load_dwordx4 %6, %10, %8 offset:%12\n\tglobal_load_dwordx4 %7, %10, %8 offset:%13\n\ts_waitcnt vmcnt(0)"
                 : "=&v"(a[0]), "=&v"(a[1]), "=&v"(a[2]), "=&v"(a[3]), "=&v"(b[0]), "=&v"(b[1]), "=&v"(b[2]), "=&v"(b[3])
                 : "s"(base), "v"(offA), "v"(offB), "i"(I1), "i"(I2), "i"(I3) : "memory");
}
__device__ __forceinline__ void ldg8_x4v(u32x4_t (&o)[8], const void* base, const unsigned (&off)[8]) {
    asm volatile("global_load_dwordx4 %0, %9, %8\n\tglobal_load_dwordx4 %1, %10, %8\n\tglobal_load_dwordx4 %2, %11, %8\n\tglobal_load_dwordx4 %3, %12, %8\n\t"
                 "global_load_dwordx4 %4, %13, %8\n\tglobal_load_dwordx4 %5, %14, %8\n\tglobal_load_dwordx4 %6, %15, %8\n\tglobal_load_dwordx4 %7, %16, %8\n\ts_waitcnt vmcnt(0)"
                 : "=&v"(o[0]), "=&v"(o[1]), "=&v"(o[2]), "=&v"(o[3]), "=&v"(o[4]), "=&v"(o[5]), "=&v"(o[6]), "=&v"(o[7])
                 : "s"(base), "v"(off[0]), "v"(off[1]), "v"(off[2]), "v"(off[3]), "v"(off[4]), "v"(off[5]), "v"(off[6]), "v"(off[7]) : "memory");
}
template <int I1, int I2, int I3>
__device__ __forceinline__ void ldg4_x4(u32x4_t (&a)[4], const void* base, unsigned off) {
    asm volatile("global_load_dwordx4 %0, %5, %4\n\tglobal_load_dwordx4 %1, %5, %4 offset:%6\n\tglobal_load_dwordx4 %2, %5, %4 offset:%7\n\tglobal_load_dwordx4 %3, %5, %4 offset:%8\n\ts_waitcnt vmcnt(0)"
                 : "=&v"(a[0]), "=&v"(a[1]), "=&v"(a[2]), "=&v"(a[3]) : "s"(base), "v"(off), "i"(I1), "i"(I2), "i"(I3) : "memory");
}
__device__ __forceinline__ void bf8_to_f32(const u32x4_t w, float* o) {
    o[0] = __uint_as_float(w.x << 16); o[1] = __uint_as_float(w.x & 0xffff0000u); o[2] = __uint_as_float(w.y << 16); o[3] = __uint_as_float(w.y & 0xffff0000u);
    o[4] = __uint_as_float(w.z << 16); o[5] = __uint_as_float(w.z & 0xffff0000u); o[6] = __uint_as_float(w.w << 16); o[7] = __uint_as_float(w.w & 0xffff0000u);
}
struct ExpertOrder1 {
    int G, v;
    __device__ void init(int G_, int c) { G = G_; v = (G_ % 8 == 0) ? (c % 8) * (G_ / 8) + c / 8 : c; }
    __device__ bool next(int i, pg8::Unit& u) const { const int L = i * G + v; if (L >= 2048) return false; const int e = L >> 7, r = L & 127; u.pm = e * 8 + (r & 7); u.pn = e * 16 + (r >> 3); return true; }
    __device__ __forceinline__ void a_ready(const pg8::Unit&) const {}
    __device__ __forceinline__ void done(const pg8::Unit&) const {}
};
struct ExpertOrder2 {
    int G, v;
    __device__ void init(int G_, int c) { G = G_; v = (G_ % 8 == 0) ? (c % 8) * (G_ / 8) + c / 8 : c; }
    __device__ bool next(int i, pg8::Unit& u) const { const int L = i * G + v; if (L >= 512) return false; const int e = L >> 5, r = L & 31; u.pm = e * 8 + (r & 7); u.pn = e * 4 + (r >> 3); return true; }
    __device__ __forceinline__ void a_ready(const pg8::Unit&) const {}
    __device__ __forceinline__ void done(const pg8::Unit&) const {}
};
__device__ __forceinline__ float silu_fast(float x) { return x * __builtin_amdgcn_rcpf(1.f + __builtin_amdgcn_exp2f(-1.4426950408889634f * x)); }
struct EpiSwiGLU {
    static constexpr bool PERM = true, AFTER_DRAIN = false; static constexpr int SEG = 0;
    bf16_t* O; int ldc;
    __device__ __forceinline__ void operator()(const pg8::f32x4 (&acc)[2][2][4][2], const pg8::Unit& u, int wr, int wc, int fr, int fq) const {
        int row0 = u.pm * 256 + wr * 64 + fr; asm volatile("" : "+v"(row0)); const int col0 = (u.pn & 15) * 128 + wc * 32 + 8 * fq;
#pragma unroll
        for (int ai = 0; ai < 2; ++ai)
#pragma unroll
            for (int m = 0; m < 4; ++m) {
                const pg8::f32x4 g0 = acc[ai][0][m][0], g1 = acc[ai][0][m][1], u0 = acc[ai][1][m][0], u1 = acc[ai][1][m][1];
                constexpr float IG = 1.f / F8_WGU, HS = F8_HID / F8_WGU;
                const unsigned w0 = pk4_fp8(silu_fast(g0[0] * IG) * u0[0] * HS, silu_fast(g0[1] * IG) * u0[1] * HS, silu_fast(g0[2] * IG) * u0[2] * HS, silu_fast(g0[3] * IG) * u0[3] * HS);
                const unsigned w1 = pk4_fp8(silu_fast(g1[0] * IG) * u1[0] * HS, silu_fast(g1[1] * IG) * u1[1] * HS, silu_fast(g1[2] * IG) * u1[2] * HS, silu_fast(g1[3] * IG) * u1[3] * HS);
                *(uint2*)((unsigned char*)O + (size_t)(row0 + ai * 128 + m * 16) * ldc + col0) = make_uint2(w0, w1);
            }
    }
};
struct EpiProj {
    static constexpr bool PERM = true, AFTER_DRAIN = false; static constexpr int SEG = 0;
    bf16_t* O; const float* bias;
    __device__ __forceinline__ void operator()(const pg8::f32x4 (&acc)[2][2][4][2], const pg8::Unit& u, int wr, int wc, int fr, int fq) const {
        int row0 = u.pm * 256 + wr * 64 + fr; asm volatile("" : "+v"(row0)); const int col0 = u.pn * 256 + wc * 32 + 8 * fq; const bool gate = u.pn < 12; constexpr float L2E = 1.4426950408889634f;
        float bias8[2][8];
        if (gate) { u32x4_t t0[4], t1[4]; const unsigned o0 = (unsigned)col0 * 4u; ldg8_x4<16, 512, 528>(t0, t1, bias, o0, o0);
#pragma unroll
            for (int q = 0; q < 4; ++q) { bias8[0][q] = __uint_as_float(t0[0][q]); bias8[0][4 + q] = __uint_as_float(t0[1][q]); bias8[1][q] = __uint_as_float(t0[2][q]); bias8[1][4 + q] = __uint_as_float(t0[3][q]); } }
#pragma unroll
        for (int bj = 0; bj < 2; ++bj) {
            float b[8];
#pragma unroll
            for (int q = 0; q < 8; ++q) b[q] = gate ? bias8[bj][q] : 0.f;
#pragma unroll
            for (int ai = 0; ai < 2; ++ai)
#pragma unroll
                for (int m = 0; m < 4; ++m) { float v[8];
#pragma unroll
                    for (int q = 0; q < 8; ++q) { const float x = acc[ai][bj][m][q >> 2][q & 3]; v[q] = gate ? __builtin_amdgcn_rcpf(1.f + __builtin_amdgcn_exp2f(-(x + b[q]) * L2E)) : x; }
                    pg8::u32x4 w; w.x = pg8::cvt_pk_bf16(v[0], v[1]); w.y = pg8::cvt_pk_bf16(v[2], v[3]); w.z = pg8::cvt_pk_bf16(v[4], v[5]); w.w = pg8::cvt_pk_bf16(v[6], v[7]);
                    *(pg8::u32x4*)(O + (size_t)(row0 + ai * 128 + m * 16) * DINP + col0 + bj * 128) = w; } }
    }
};
struct EpiQ {
    static constexpr bool PERM = false, AFTER_DRAIN = false; static constexpr int SEG = 0;
    bf16_t* Q; const float* rq; const float* rc; const float* rs;
    __device__ __forceinline__ void operator()(const pg8::f32x4 (&acc)[2][2][4][2], const pg8::Unit& u, int wr, int wc, int fr, int fq) const {
        int row0 = u.pm * 256 + wr * 64 + fr; asm volatile("" : "+v"(row0)); constexpr float SC = 0.10206207261596575f * 1.4426950408889634f;
        float sc8[8]; { unsigned off[8];
#pragma unroll
            for (int i = 0; i < 8; ++i) off[i] = (unsigned)(row0 + (i >> 2) * 128 + (i & 3) * 16) * 4u;
            ldg8_dw(sc8, rq, off); }
#pragma unroll
        for (int bj = 0; bj < 2; ++bj) { const int g32 = u.pn * 8 + bj * 4 + wc, col0 = g32 * 32 + 4 * fq; const bool rope = (g32 % 3) == 2;
#pragma unroll
            for (int ai = 0; ai < 2; ++ai) {
                u32x4_t cs4[4], sn4[4];
                if (rope) { u32x4_t t0[4], t1[4];
                    const unsigned o0 = (unsigned)((row0 + ai * 128) * 16 + 4 * fq) * 4u;
                    ldg8_x4<16 * 16 * 4, 32 * 16 * 4, 48 * 16 * 4>(t0, t1, rc, o0, o0 + (unsigned)(T * 16 * 4));
#pragma unroll
                    for (int m = 0; m < 4; ++m) { cs4[m] = t0[m]; sn4[m] = t1[m]; } }
#pragma unroll
                for (int m = 0; m < 4; ++m) { const int row = row0 + ai * 128 + m * 16; const float s = sc8[ai * 4 + m] * SC;
                    pg8::f32x4 v0 = acc[ai][bj][m][0] * s, v1 = acc[ai][bj][m][1] * s;
                    if (rope) { const pg8::f32x4 c4 = __builtin_bit_cast(pg8::f32x4, cs4[m]), s4 = __builtin_bit_cast(pg8::f32x4, sn4[m]);
                        const pg8::f32x4 x1 = v0, x2 = v1; v0 = x1 * c4 - x2 * s4; v1 = x1 * s4 + x2 * c4; }
                    bf16_t* qp = Q + (size_t)row * 768 + col0;
                    *(uint2*)qp = make_uint2(pg8::cvt_pk_bf16(v0[0], v0[1]), pg8::cvt_pk_bf16(v0[2], v0[3]));
                    *(uint2*)(qp + 16) = make_uint2(pg8::cvt_pk_bf16(v1[0], v1[1]), pg8::cvt_pk_bf16(v1[2], v1[3])); } } }
    }
};
struct EpiKV {
    static constexpr bool PERM = true, AFTER_DRAIN = false; static constexpr int SEG = 0;
    bf16_t* K; bf16_t* V; const float* rkv;
    __device__ __forceinline__ void operator()(const pg8::f32x4 (&acc)[2][2][4][2], const pg8::Unit& u, int wr, int wc, int fr, int fq) const {
        int row0 = u.pm * 256 + wr * 64 + fr; asm volatile("" : "+v"(row0));
        float sc8[8]; { unsigned off[8];
#pragma unroll
            for (int i = 0; i < 8; ++i) off[i] = (unsigned)(row0 + (i >> 2) * 128 + (i & 3) * 16) * 4u;
            ldg8_dw(sc8, rkv, off); }
#pragma unroll
        for (int bj = 0; bj < 2; ++bj) { const int head = u.pn * 2 + bj;
#pragma unroll
            for (int ai = 0; ai < 2; ++ai)
#pragma unroll
                for (int m = 0; m < 4; ++m) { const int row = row0 + ai * 128 + m * 16; const float s = sc8[ai * 4 + m];
                    const pg8::f32x4 v0 = acc[ai][bj][m][0] * s, v1 = acc[ai][bj][m][1] * s; pg8::u32x4 w;
                    w.x = pg8::cvt_pk_bf16(v0[0], v0[1]); w.y = pg8::cvt_pk_bf16(v0[2], v0[3]); w.z = pg8::cvt_pk_bf16(v1[0], v1[1]); w.w = pg8::cvt_pk_bf16(v1[2], v1[3]);
                    bf16_t* dst = (wc < 2) ? K + (size_t)row * 768 + head * 96 + wc * 32 + 8 * fq : V + (size_t)row * 512 + head * 64 + (wc - 2) * 32 + 8 * fq;
                    *(pg8::u32x4*)dst = w; } }
    }
};
struct EpiF32 {
    static constexpr bool PERM = true, AFTER_DRAIN = false; static constexpr int SEG = 0;
    float* O; int ldc; const float* rs;
    __device__ __forceinline__ void operator()(const pg8::f32x4 (&acc)[2][2][4][2], const pg8::Unit& u, int wr, int wc, int fr, int fq) const {
        int row0 = u.pm * 256 + wr * 64 + fr; asm volatile("" : "+v"(row0)); const int col0 = u.pn * 256 + wc * 32 + 8 * fq;
#pragma unroll
        for (int ai = 0; ai < 2; ++ai)
#pragma unroll
            for (int m = 0; m < 4; ++m) { const int row = row0 + ai * 128 + m * 16; const float s = rs ? rs[row] : 1.f;
#pragma unroll
                for (int bj = 0; bj < 2; ++bj) { float* op = O + (size_t)row * ldc + col0 + bj * 128;
                    *(pg8::f32x4*)op = acc[ai][bj][m][0] * s; *(pg8::f32x4*)(op + 4) = acc[ai][bj][m][1] * s; } }
    }
};
struct EpiMerge {
    static constexpr bool PERM = true, AFTER_DRAIN = false; static constexpr int SEG = 8;
    bf16_t* O; const bf16_t* GL;
    static __device__ __forceinline__ void ld8(const bf16_t* p, float* o) { const uint4 w = *(const uint4*)p;
        o[0] = __uint_as_float(w.x << 16); o[1] = __uint_as_float(w.x & 0xffff0000u); o[2] = __uint_as_float(w.y << 16); o[3] = __uint_as_float(w.y & 0xffff0000u);
        o[4] = __uint_as_float(w.z << 16); o[5] = __uint_as_float(w.z & 0xffff0000u); o[6] = __uint_as_float(w.w << 16); o[7] = __uint_as_float(w.w & 0xffff0000u); }
    __device__ __forceinline__ void segment(pg8::f32x4 (&acc)[2][2][4][2], const pg8::Unit& u, int seg, int wr, int wc, int fr, int fq) const {
        int row0 = u.pm * 256 + wr * 64 + fr; asm volatile("" : "+v"(row0));
        const unsigned cb = (unsigned)((seg - 1) * 1024 + u.pn * 256 + wc * 32 + 8 * fq) * 2u;
#pragma unroll
        for (int ai = 0; ai < 2; ++ai)
#pragma unroll
            for (int m = 0; m < 4; ++m) {
                u32x4_t ga[4];
                ldg4_x4<2048, 256, 2304>(ga, GL, (unsigned)(row0 + ai * 128 + m * 16) * (unsigned)(DINP * 2) + cb);
#pragma unroll
                for (int bj = 0; bj < 2; ++bj) { float x0[8], x1[8]; bf8_to_f32(ga[bj * 2], x0); bf8_to_f32(ga[bj * 2 + 1], x1);
#pragma unroll
                    for (int q = 0; q < 8; ++q) acc[ai][bj][m][q >> 2][q & 3] *= x0[q] * __builtin_amdgcn_rcpf(x1[q]); } }
    }
    __device__ __forceinline__ void operator()(const pg8::f32x4 (&acc)[2][2][4][2], const pg8::Unit& u, int wr, int wc, int fr, int fq) const {
        int row0 = u.pm * 256 + wr * 64 + fr; asm volatile("" : "+v"(row0)); const int col0 = u.pn * 256 + wc * 32 + 8 * fq;
        const unsigned cb = (unsigned)(2048 + col0) * 2u;
#pragma unroll
        for (int ai = 0; ai < 2; ++ai) {
            u32x4_t g8[8];
            { unsigned off[8];
#pragma unroll
              for (int i = 0; i < 8; ++i) off[i] = (unsigned)(row0 + ai * 128 + (i & 3) * 16) * (unsigned)(DINP * 2) + cb + (i >> 2) * 256u;
              ldg8_x4v(g8, GL, off); }
#pragma unroll
            for (int m = 0; m < 4; ++m) { const int row = row0 + ai * 128 + m * 16;
#pragma unroll
                for (int bj = 0; bj < 2; ++bj) { float x2[8], v[8]; bf8_to_f32(g8[bj * 4 + m], x2);
#pragma unroll
                    for (int q = 0; q < 8; ++q) v[q] = acc[ai][bj][m][q >> 2][q & 3] * x2[q];
                    pg8::u32x4 w; w.x = pg8::cvt_pk_bf16(v[0], v[1]); w.y = pg8::cvt_pk_bf16(v[2], v[3]); w.z = pg8::cvt_pk_bf16(v[4], v[5]); w.w = pg8::cvt_pk_bf16(v[6], v[7]);
                    *(pg8::u32x4*)(O + (size_t)row * DM + col0 + bj * 128) = w; } } }
    }
};
struct EpiRowScale {
    static constexpr bool PERM = true, AFTER_DRAIN = false; static constexpr int SEG = 0;
    bf16_t* O; int ldc; const float* rs;
    __device__ __forceinline__ void operator()(const pg8::f32x4 (&acc)[2][2][4][2], const pg8::Unit& u, int wr, int wc, int fr, int fq) const {
        int row0 = u.pm * 256 + wr * 64 + fr; asm volatile("" : "+v"(row0)); const int col0 = (u.pn & 3) * 256 + wc * 32 + 8 * fq;
        float sc8[8]; { unsigned off[8];
#pragma unroll
            for (int i = 0; i < 8; ++i) off[i] = (unsigned)(row0 + (i >> 2) * 128 + (i & 3) * 16) * 4u;
            ldg8_dw(sc8, rs, off); }
#pragma unroll
        for (int ai = 0; ai < 2; ++ai)
#pragma unroll
            for (int m = 0; m < 4; ++m) { const int row = row0 + ai * 128 + m * 16; const float s = sc8[ai * 4 + m] * (1.f / (F8_WD * F8_HID));
#pragma unroll
                for (int bj = 0; bj < 2; ++bj) { const pg8::f32x4 v0 = acc[ai][bj][m][0] * s, v1 = acc[ai][bj][m][1] * s; pg8::u32x4 w;
                    w.x = pg8::cvt_pk_bf16(v0[0], v0[1]); w.y = pg8::cvt_pk_bf16(v0[2], v0[3]); w.z = pg8::cvt_pk_bf16(v1[0], v1[1]); w.w = pg8::cvt_pk_bf16(v1[2], v1[3]);
                    *(pg8::u32x4*)(O + (size_t)row * ldc + col0 + bj * 128) = w; } }
    }
};
struct Params {
    const float* in[27];
    const int* pos;
    float* out;
    unsigned char* ws;
};

__device__ __forceinline__ float wave_sum(float v) {
#pragma unroll
    for (int o = 1; o < 64; o <<= 1) v += __shfl_xor(v, o);
    return v;
}
__device__ __forceinline__ float sigmoidf_(float x) { return 1.f / (1.f + expf(-x)); }
__device__ __forceinline__ float siluf_(float x) { return x / (1.f + expf(-x)); }
__device__ __forceinline__ float log_sigmoidf_(float x) { return fminf(x, 0.f) - log1pf(expf(-fabsf(x))); }

__device__ __forceinline__ float bf2f(bf16_t u) { return __uint_as_float((unsigned)u << 16); }
__device__ __forceinline__ unsigned f2bf(float f) { unsigned u = __float_as_uint(f); return (u + 0x7fffu + ((u >> 16) & 1u)) >> 16; }
__device__ __forceinline__ unsigned pk2(float lo, float hi) { return f2bf(lo) | (f2bf(hi) << 16); }
__device__ __forceinline__ void ld4bf(const bf16_t* p, float* o) {
    const uint2 w = *(const uint2*)p; o[0] = __uint_as_float(w.x << 16); o[1] = __uint_as_float(w.x & 0xffff0000u); o[2] = __uint_as_float(w.y << 16); o[3] = __uint_as_float(w.y & 0xffff0000u);
}
__device__ __forceinline__ void transpose_block(const float* Wblk, int ldw, bf16_t* dst, int ldt, const float* ks, const float* ns, float* scr, int lane) {
#pragma unroll 8
    for (int i = 0; i < 32; ++i) { const int kk = 2 * i + (lane >> 5); float v = __builtin_nontemporal_load(&Wblk[(size_t)kk * ldw + (lane & 31)]);     if (ks) v *= ks[kk]; if (ns) v *= ns[lane & 31]; scr[kk * 33 + (lane & 31)] = v; }
    asm volatile("s_waitcnt lgkmcnt(0)" ::: "memory");
    const int c = lane & 7;
#pragma unroll
    for (int j = 0; j < 4; ++j) { const int n = (lane >> 3) + 8 * j; const float* s = scr + (8 * c) * 33 + n;
        uint4 o; o.x = pk2(s[0 * 33], s[1 * 33]); o.y = pk2(s[2 * 33], s[3 * 33]); o.z = pk2(s[4 * 33], s[5 * 33]); o.w = pk2(s[6 * 33], s[7 * 33]);
        *(uint4*)(dst + (size_t)n * ldt + 8 * c) = o; }
    asm volatile("s_waitcnt lgkmcnt(0)" ::: "memory");
}

struct WStream {
    const float* gate; const float* up; const float* down;
    unsigned char* wgu_t; unsigned char* wd_t;
    const char* rowp; unsigned rs8, rs1;
    unsigned vo0;
    const float* src; unsigned char* dst; int ldt; float sc;
    int it, it_stride, step, nsteps;
    float v0, v1, v2, v3;
    char* blk; char* blkw;
    __device__ __forceinline__ void init(int gw, int ngw, char* lds_blk, int lane) {
        constexpr int I_ALL = 2 * 16 * 16 * 64 + 16 * 32 * 32;
        nsteps = (gw < I_ALL) ? 8 * ((I_ALL - gw + ngw - 1) / ngw) : 0;
        if (I_ALL % ngw == 0) { const int per_wg = I_ALL / (ngw >> 3); gw = (gw >> 3) * per_wg + (gw & 7); ngw = 8; nsteps = per_wg; }
        it = gw; it_stride = ngw; step = 0; blk = lds_blk; blkw = lds_blk + (lane & 31) * 80 + 4 * (lane >> 5);
        src = gate; rowp = (const char*)gate; rs8 = 0u; rs1 = 0u; vo0 = 0u; dst = wgu_t; ldt = DM; sc = 1.f; v0 = v1 = v2 = v3 = 0.f;
    }
    __device__ __forceinline__ void rare(int lane) {
        if (step >= 8 && step <= nsteps) {
            const int nr = lane >> 1, hf = lane & 1;
            const uint4 a = *(const uint4*)(blk + nr * 80 + hf * 32), b = *(const uint4*)(blk + nr * 80 + hf * 32 + 16);
            unsigned char* q = dst + (size_t)nr * ldt + hf * 32;
            { typedef unsigned u32x4n __attribute__((ext_vector_type(4))); const u32x4n an = {a.x, a.y, a.z, a.w}, bn = {b.x, b.y, b.z, b.w};
              __builtin_nontemporal_store(an, (u32x4n*)q); __builtin_nontemporal_store(bn, (u32x4n*)(q + 16)); }
        }
        if (step < nsteps) {
            constexpr int I_G = 16 * 16 * 64; int ldw;
            if (it < 2 * I_G) { const int up_ = it >= I_G, r_ = up_ ? it - I_G : it, e_ = r_ >> 10, kb_ = (r_ >> 6) & 15, nb_ = r_ & 63, j0_ = nb_ * 32;
                src = (up_ ? up : gate) + (size_t)e_ * DM * DEXP + (size_t)(64 * kb_) * DEXP + j0_; ldw = DEXP;
                dst = wgu_t + (size_t)(e_ * 4096 + 256 * (j0_ >> 7) + (j0_ & 127) + (up_ ? 128 : 0)) * DM + 64 * kb_; ldt = DM; sc = F8_WGU; }
            else { const int r_ = it - 2 * I_G, e_ = r_ >> 10, kb_ = (r_ >> 5) & 31, nb_ = r_ & 31;
                src = down + (size_t)e_ * DEXP * DM + (size_t)(64 * kb_) * DM + 32 * nb_; ldw = DM; dst = wd_t + (size_t)(e_ * 1024 + 32 * nb_) * DEXP + 64 * kb_; ldt = DEXP; sc = F8_WD; }
            it += it_stride;
            rowp = (const char*)src; rs8 = (unsigned)ldw * 32u; rs1 = (unsigned)ldw * 4u;
            vo0 = (unsigned)((4 * (lane >> 5)) * ldw + (lane & 31)) * 4u;
        } else { rowp = (const char*)src; rs8 = 0u; rs1 = 0u; vo0 = (unsigned)(lane & 31) * 4u; }
    }
    __device__ __forceinline__ void tick(int lane) {
        *(unsigned*)(blkw + ((step - 1) & 7) * 8) = pk4_fp8(v0 * sc, v1 * sc, v2 * sc, v3 * sc);
        if ((step & 7) == 0) rare(lane);
        v0 = __builtin_nontemporal_load((const float*)(rowp + vo0)); v1 = __builtin_nontemporal_load((const float*)(rowp + rs1 + vo0));
        v2 = __builtin_nontemporal_load((const float*)(rowp + 2 * rs1 + vo0)); v3 = __builtin_nontemporal_load((const float*)(rowp + 3 * rs1 + vo0));
        rowp += rs8; ++step;
    }
};

namespace att {
using bf16x8 = __attribute__((ext_vector_type(8))) short;
using s16x4  = __attribute__((ext_vector_type(4))) short;
using f32x16 = __attribute__((ext_vector_type(16))) float;
using u32x4  = __attribute__((ext_vector_type(4))) unsigned;
constexpr int NW = 8, QBLK = 32, KVBLK = 64;
constexpr int LDQ = 768, LDK = 768, LDV = 512, LDO = 1536;
constexpr int KROWB = 208;
constexpr int SHM_K = KVBLK * KROWB, SHM_V = KVBLK * 64 * 2;
constexpr int NBUF = 3;
constexpr int SHM_ATTN = NBUF * SHM_V + NBUF * SHM_K + NW * 64 * 4;
constexpr float THR = 8.f;
#define ASBAR() __builtin_amdgcn_sched_barrier(0)
__device__ __forceinline__ int crow(int r, int hi) { return (r & 3) + 8 * (r >> 2) + 4 * hi; }
__device__ __forceinline__ unsigned cvtpk(float lo, float hi) { unsigned r; asm volatile("v_cvt_pk_bf16_f32 %0, %1, %2" : "=v"(r) : "v"(lo), "v"(hi)); return r; }
#define MX3(a, b, c) __builtin_fmaxf(__builtin_fmaxf((a), (b)), (c))
template <bool FIRST>
__device__ __forceinline__ void partialSM(f32x16& p0, f32x16& p1, float& m_ref, f32x16& negm, float& alpha) {
  constexpr float THRL = THR * 1.4426950408889634f;
  float a = MX3(p0[0], p0[1], p1[0]), b = MX3(p0[2], p0[3], p1[1]); a = MX3(a, p1[2], p1[3]);
#pragma unroll
  for (int r = 4; r < 16; r += 4) { a = MX3(a, p0[r], p0[r + 1]); b = MX3(b, p0[r + 2], p0[r + 3]); a = MX3(a, p1[r], p1[r + 1]); b = MX3(b, p1[r + 2], p1[r + 3]); }
  float pmax = fmaxf(a, b);
  { auto rr = __builtin_amdgcn_permlane32_swap(__float_as_uint(pmax), __float_as_uint(pmax), false, false);
    pmax = fmaxf(__uint_as_float(rr[0]), __uint_as_float(rr[1])); }
  alpha = 1.f;
  if (FIRST || !__builtin_expect(__all(pmax <= THRL), 1)) {
    const float dl = FIRST ? pmax : fmaxf(pmax, 0.f); m_ref += dl;
#pragma unroll
    for (int r = 0; r < 16; ++r) { p0[r] -= dl; p1[r] -= dl; }
#pragma unroll
    for (int r = 0; r < 16; ++r) negm[r] = -m_ref;
    asm volatile("" : "+v"(negm));
    if (!FIRST) alpha = __builtin_amdgcn_exp2f(-dl);
  }
#pragma unroll
  for (int r = 0; r < 16; ++r) p0[r] = __builtin_amdgcn_exp2f(p0[r]);
}
#undef MX3
__device__ __forceinline__ void finishSM(f32x16& p0, f32x16& p1, float alpha, float& l_reg, bf16x8& pa0, bf16x8& pa1, bf16x8& pa2, bf16x8& pa3) {
  for (int r = 0; r < 16; ++r) p1[r] = __builtin_amdgcn_exp2f(p1[r]);
  float ps = 0; for (int r = 0; r < 16; ++r) ps += p0[r]; for (int r = 0; r < 16; ++r) ps += p1[r];
  { auto rr = __builtin_amdgcn_permlane32_swap(__float_as_uint(ps), __float_as_uint(ps), false, false);
    ps = __uint_as_float(rr[0]) + __uint_as_float(rr[1]); }
  l_reg = l_reg * alpha + ps;
#define PK4(P, BASE, OUT) do { u32x4 w = {cvtpk(P[BASE + 0], P[BASE + 1]), cvtpk(P[BASE + 2], P[BASE + 3]), cvtpk(P[BASE + 4], P[BASE + 5]), cvtpk(P[BASE + 6], P[BASE + 7])}; \
    OUT = *reinterpret_cast<bf16x8*>(&w); } while (0)
  PK4(p0, 0, pa0); PK4(p0, 8, pa1); PK4(p1, 0, pa2); PK4(p1, 8, pa3);
#undef PK4
}
__device__ __forceinline__ void qkt(f32x16& p0, f32x16& p1, const char* Ks, const bf16x8* qr, const f32x16& negm, int r32, int hi) {
  p0 = negm; p1 = negm;
#pragma unroll
  for (int d0 = 0; d0 < 6; ++d0) { const int cb = d0 * 32 + hi * 16;
    bf16x8 b0 = *reinterpret_cast<const bf16x8*>(Ks + r32 * KROWB + cb);
    bf16x8 b1 = *reinterpret_cast<const bf16x8*>(Ks + (32 + r32) * KROWB + cb);
    p0 = __builtin_amdgcn_mfma_f32_32x32x16_bf16(b0, qr[d0], p0, 0, 0, 0);
    p1 = __builtin_amdgcn_mfma_f32_32x32x16_bf16(b1, qr[d0], p1, 0, 0, 0); }
}
__device__ __forceinline__ int v_st(int k, int c) { const int kk = k;   return ((kk >> 3) * 2 + (c >> 5)) * 512 + ((kk & 7) * 32 + (c & 31)) * 2; }
__device__ __forceinline__ int v_rd_base(int lane) { return ((lane & 3) << 3) | (((lane >> 2) & 3) << 6) | (((lane >> 4) & 1) << 5) | (((lane >> 5) & 1) << 8); }
constexpr int v_rd_off(int d0, int ks, int half) { return d0 * 512 + ks * 2048 + half * 1024; }
template <int OFF> __device__ __forceinline__ s16x4 tr_read(int vb) {
  s16x4 r; asm volatile("ds_read_b64_tr_b16 %0, %1 offset:%2" : "=&v"(r) : "v"(vb), "i"(OFF) : "memory"); return r;
}
template <int D0> __device__ __forceinline__ void pv_one(f32x16& od, int vb, bf16x8 pa0, bf16x8 pa1, bf16x8 pa2, bf16x8 pa3) {
  const s16x4 l0 = tr_read<v_rd_off(D0, 0, 0)>(vb), h0 = tr_read<v_rd_off(D0, 0, 1)>(vb), l1 = tr_read<v_rd_off(D0, 1, 0)>(vb), h1 = tr_read<v_rd_off(D0, 1, 1)>(vb);
  const s16x4 l2 = tr_read<v_rd_off(D0, 2, 0)>(vb), h2 = tr_read<v_rd_off(D0, 2, 1)>(vb), l3 = tr_read<v_rd_off(D0, 3, 0)>(vb), h3 = tr_read<v_rd_off(D0, 3, 1)>(vb);
  asm volatile("s_waitcnt lgkmcnt(0)" ::: "memory"); ASBAR();
#define PK(L, H) (bf16x8){L[0], L[1], L[2], L[3], H[0], H[1], H[2], H[3]}
  od = __builtin_amdgcn_mfma_f32_32x32x16_bf16(pa0, PK(l0, h0), od, 0, 0, 0);
  od = __builtin_amdgcn_mfma_f32_32x32x16_bf16(pa1, PK(l1, h1), od, 0, 0, 0);
  od = __builtin_amdgcn_mfma_f32_32x32x16_bf16(pa2, PK(l2, h2), od, 0, 0, 0);
  od = __builtin_amdgcn_mfma_f32_32x32x16_bf16(pa3, PK(l3, h3), od, 0, 0, 0);
#undef PK
}
__device__ __forceinline__ void pv_d0(f32x16* o, int vb, bf16x8 pa0, bf16x8 pa1, bf16x8 pa2, bf16x8 pa3) {
  pv_one<0>(o[0], vb, pa0, pa1, pa2, pa3); pv_one<1>(o[1], vb, pa0, pa1, pa2, pa3);
}
__device__ __forceinline__ void attn_unit(const bf16_t* Qb, const bf16_t* Kh, const bf16_t* Vh, bf16_t* Ob, int seq, char* lds, WStream& wst) {
  int tid_ = threadIdx.x; asm volatile("" : "+v"(tid_));
  const int tid = tid_, wid = tid >> 6, lane = tid & 63, r32 = lane & 31, hi = lane >> 5;
  char* V_lds = lds; char* K_lds = lds + NBUF * SHM_V;
  float* ws = (float*)(lds + NBUF * SHM_V + NBUF * SHM_K) + wid * 64; float* li_l = ws; float* al_l = ws + 32;
  float m_ref = 0.f, l_reg = 0; f32x16 o[2] = {}; bf16x8 qr[6]; f32x16 negm = {}; asm volatile("" : "+v"(negm));
  const bf16_t* Qw = Qb + (long)(wid * QBLK + r32) * LDQ + hi * 8;
#pragma unroll
  for (int d0 = 0; d0 < 6; ++d0) qr[d0] = *reinterpret_cast<const bf16x8*>(Qw + d0 * 16);
  const bool kact = tid < 384; const int kr = tid / 12, kc = tid - kr * 12, vr = tid >> 3, vc = (tid & 7) * 8, vst0 = v_st(vr, vc);
  const int kst0 = kr * KROWB + kc * 16, kst1 = (kr + 32) * KROWB + kc * 16;
  const int vb0 = (int)(uintptr_t)V_lds + v_rd_base(lane);
  struct { bf16x8 vs, ks0, ks1; } sr_[2];
#define SLOAD(i, k0) do { sr_[i].vs = *reinterpret_cast<const bf16x8*>(&Vh[(long)((k0) + vr) * LDV + vc]); \
    if (kact) { sr_[i].ks0 = *reinterpret_cast<const bf16x8*>(&Kh[(long)((k0) + kr) * LDK + kc * 8]); sr_[i].ks1 = *reinterpret_cast<const bf16x8*>(&Kh[(long)((k0) + 32 + kr) * LDK + kc * 8]); } } while (0)
#define SWRITE(b, i) do { *(bf16x8*)(V_lds + (b) * SHM_V + vst0) = sr_[i].vs; \
    if (kact) { *(bf16x8*)(K_lds + (b) * SHM_K + kst0) = sr_[i].ks0; *(bf16x8*)(K_lds + (b) * SHM_K + kst1) = sr_[i].ks1; } } while (0)
#define SWAIT() asm volatile("s_waitcnt vmcnt(3)" ::: "memory")
#define RESC(a) do { if (__any((a) < 1.f)) { if (hi == 0) al_l[r32] = (a); asm volatile("s_waitcnt lgkmcnt(0)" ::: "memory"); \
    for (int d = 0; d < 2; ++d) for (int r = 0; r < 16; ++r) o[d][r] *= al_l[crow(r, hi)]; } } while (0)
  f32x16 pA0, pA1, pB0, pB1; float alA, alB; bf16x8 pa0, pa1, pa2, pa3; const int NT = seq / KVBLK;
  constexpr int SE = 0, SO = 1;
  int b_prev = 0, b_cur = 1, b_next = 2;
#define ROT() do { b_prev = b_cur; b_cur = b_next; b_next = (b_next == NBUF - 1) ? 0 : b_next + 1; } while (0)
  SLOAD(SE, 0); asm volatile("s_waitcnt vmcnt(0)" ::: "memory"); SWRITE(0, SE);
  SLOAD(SO, KVBLK); if (2 < NT) SLOAD(SE, 2 * KVBLK);
  __syncthreads();
  qkt(pA0, pA1, K_lds, qr, negm, r32, hi); partialSM<true>(pA0, pA1, m_ref, negm, alA);
  SWAIT(); SWRITE(1, SO); __syncthreads();
  for (int j = 1; j + 1 < NT; j += 2) {
    SLOAD(SO, (j + 2) * KVBLK);
    ASBAR(); qkt(pB0, pB1, K_lds + b_cur * SHM_K, qr, negm, r32, hi);
    finishSM(pA0, pA1, alA, l_reg, pa0, pa1, pa2, pa3); ASBAR();
    pv_d0(o, vb0 + b_prev * SHM_V, pa0, pa1, pa2, pa3); partialSM<false>(pB0, pB1, m_ref, negm, alB);
    SWAIT(); SWRITE(b_next, SE);
    RESC(alB); if (wst.step <= wst.nsteps) wst.tick(lane); __syncthreads(); ROT();
    if (j + 3 < NT) SLOAD(SE, (j + 3) * KVBLK);
    ASBAR(); qkt(pA0, pA1, K_lds + b_cur * SHM_K, qr, negm, r32, hi);
    finishSM(pB0, pB1, alB, l_reg, pa0, pa1, pa2, pa3); ASBAR();
    pv_d0(o, vb0 + b_prev * SHM_V, pa0, pa1, pa2, pa3); partialSM<false>(pA0, pA1, m_ref, negm, alA);
    SWAIT(); SWRITE(b_next, SO);
    RESC(alA); if (wst.step <= wst.nsteps) wst.tick(lane); __syncthreads(); ROT();
  }
  ASBAR(); qkt(pB0, pB1, K_lds + b_cur * SHM_K, qr, negm, r32, hi);
  finishSM(pA0, pA1, alA, l_reg, pa0, pa1, pa2, pa3); ASBAR();
  pv_d0(o, vb0 + b_prev * SHM_V, pa0, pa1, pa2, pa3); partialSM<false>(pB0, pB1, m_ref, negm, alB);
  RESC(alB);
  finishSM(pB0, pB1, alB, l_reg, pa0, pa1, pa2, pa3); ASBAR();
  pv_d0(o, vb0 + b_cur * SHM_V, pa0, pa1, pa2, pa3);
#undef ROT
  if (hi == 0) li_l[r32] = l_reg; asm volatile("s_waitcnt lgkmcnt(0)" ::: "memory");
  float rli[16];
#pragma unroll
  for (int r = 0; r < 16; ++r) rli[r] = __builtin_amdgcn_rcpf(li_l[crow(r, hi)]);
  bf16_t* Ow = Ob + (long)(wid * QBLK) * LDO;
#pragma unroll
  for (int r = 0; r < 16; ++r) { const int orow = crow(r, hi);
#pragma unroll
    for (int d0 = 0; d0 < 2; ++d0) Ow[(long)orow * LDO + d0 * 32 + r32] = (bf16_t)f2bf(o[d0][r] * rli[r]); }
  __syncthreads();
#undef SLOAD
#undef SWRITE
#undef SWAIT
#undef RESC
}
#undef ASBAR
}

namespace gla {
using bf16x8 = __attribute__((ext_vector_type(8))) short;
using s16x4  = __attribute__((ext_vector_type(4))) short;
using f32x16 = __attribute__((ext_vector_type(16))) float;
using u32x4  = __attribute__((ext_vector_type(4))) unsigned;
constexpr int L_DL = 0, L_TOT = 8192, L_RSUM = 10240, L_V = 12288, L_QF = 28672, L_KF = 37888, L_QB = 47104, L_KB = 56320, L_KSTF = 65536, L_KSTB = 74752, L_STF = 65536, L_STB = 83968, L_QR = 102400, L_KR = 110592, L_END = 118784;
constexpr int RB = 144;
__device__ __forceinline__ int crow(int r, int hi) { return (r & 3) + 8 * (r >> 2) + 4 * hi; }
__device__ __forceinline__ unsigned cvtpk(float lo, float hi) { unsigned r; asm volatile("v_cvt_pk_bf16_f32 %0, %1, %2" : "=v"(r) : "v"(lo), "v"(hi)); return r; }
__device__ __forceinline__ int v_st4(int k, int c) { const int kk = (k & ~0xC) | ((k & 4) << 1) | ((k & 8) >> 1); return ((kk >> 3) * 4 + (c >> 5)) * 512 + ((kk & 7) * 32 + (c & 31)) * 2; }
__device__ __forceinline__ int v_rd_base(int lane) { return ((lane & 3) << 3) | (((lane >> 2) & 3) << 6) | (((lane >> 4) & 1) << 5) | (((lane >> 5) & 1) << 8); }
template <int OFF> __device__ __forceinline__ s16x4 tr_read(int vb) { s16x4 r; asm volatile("ds_read_b64_tr_b16 %0, %1 offset:%2" : "=&v"(r) : "v"(vb), "i"(OFF) : "memory"); return r; }
__device__ __forceinline__ void v_frags(int vb, bf16x8 (&f)[4]) {
  const s16x4 l0 = tr_read<0>(vb), h0 = tr_read<2048>(vb), l1 = tr_read<4096>(vb), h1 = tr_read<4096 + 2048>(vb);
  const s16x4 l2 = tr_read<8192>(vb), h2 = tr_read<8192 + 2048>(vb), l3 = tr_read<12288>(vb), h3 = tr_read<12288 + 2048>(vb);
  asm volatile("s_waitcnt lgkmcnt(0)" ::: "memory"); __builtin_amdgcn_sched_barrier(0);
#define PK(L, H) (bf16x8){L[0], L[1], L[2], L[3], H[0], H[1], H[2], H[3]}
  f[0] = PK(l0, h0); f[1] = PK(l1, h1); f[2] = PK(l2, h2); f[3] = PK(l3, h3);
#undef PK
}
__device__ __forceinline__ bf16x8 frag(const char* base, int row, int ks, int hi) { return *reinterpret_cast<const bf16x8*>(base + row * RB + ks * 32 + hi * 16); }

template <bool IS_G1>
__device__ __forceinline__ void prep(char* lds, const bf16_t* projb, const float* wdec, const float* bdec, int t0, int hh, float* dec_out  , long dec_dir_stride) {
  int tid_ = threadIdx.x; asm volatile("" : "+v"(tid_)); const int tid = tid_;
  float* DL = (float*)(lds + L_DL); float* TOT = (float*)(lds + L_TOT);
  { const int i = tid >> 3, r4 = (tid & 7) * 4; float v[4]; ld4bf(projb + (size_t)(t0 + i) * DINP + OFF_GDEC + r4, v); *(float4*)(DL + i * 32 + r4) = make_float4(v[0], v[1], v[2], v[3]);
    const int c8 = (tid & 7) * 8;
    *(uint4*)(lds + L_KR + i * 128 + c8 * 2) = *(const uint4*)(projb + (size_t)(t0 + i) * DINP + OFF_GK + hh * 64 + c8);
    if constexpr (!IS_G1) *(uint4*)(lds + L_QR + i * 128 + c8 * 2) = *(const uint4*)(projb + (size_t)(t0 + i) * DINP + OFF_GQ + hh * 64 + c8); }
#pragma unroll
  for (int e2 = 0; e2 < 2; ++e2) { const int e = tid + e2 * 512, i = e >> 4, cc = (e & 15) * 8;
    *(uint4*)(lds + L_V + v_st4(i, cc)) = *(const uint4*)(projb + (size_t)(t0 + i) * DINP + OFF_GV + hh * 128 + cc); }
  __syncthreads();
  const int cidx = tid & 127, tg = tid >> 7, dir = cidx >> 6, d = cidx & 63;
  float W[16];
#pragma unroll
  for (int r = 0; r < 16; ++r) W[r] = wdec[(size_t)(dir * 16 + r) * 256 + hh * 64 + d];
  const float bias = bdec[dir * 256 + hh * 64 + d];
  constexpr float L2E = 1.4426950408889634f;
  float g[16], cs[16]; float run = 0.f;
#pragma unroll
  for (int ii = 0; ii < 16; ++ii) { const float* dl = DL + (16 * tg + ii) * 32 + dir * 16; float a = bias;
#pragma unroll
    for (int r = 0; r < 16; r += 4) { const float4 x = *(const float4*)(dl + r); a = fmaf(x.x, W[r], a); a = fmaf(x.y, W[r + 1], a); a = fmaf(x.z, W[r + 2], a); a = fmaf(x.w, W[r + 3], a); }
    g[ii] = (fminf(a, 0.f) * L2E - __builtin_amdgcn_logf(1.f + __builtin_amdgcn_exp2f(-fabsf(a) * L2E))) * (1.f / 16.f); run += g[ii]; cs[ii] = run; }
  TOT[tg * 128 + cidx] = run;
  __syncthreads();
  const float t0s = TOT[cidx], t1s = TOT[128 + cidx], t2s = TOT[256 + cidx], t3s = TOT[384 + cidx], tall = (t0s + t1s) + (t2s + t3s);
  const float off_lo = (tg > 0 ? t0s : 0.f) + (tg > 1 ? t1s : 0.f) + (tg > 2 ? t2s : 0.f);
  const float off_hi = (tg < 1 ? t1s : 0.f) + (tg < 2 ? t2s : 0.f) + (tg < 3 ? t3s : 0.f);
  const bf16_t* KR = (const bf16_t*)(lds + L_KR); const bf16_t* QR = (const bf16_t*)(lds + L_QR);
  if constexpr (IS_G1) {
    unsigned pk[8];
#pragma unroll
    for (int ii = 0; ii < 16; ii += 2) {
      float kv2[2];
#pragma unroll
      for (int u = 0; u < 2; ++u) { const int i = 16 * tg + ii + u; const float bi = dir == 0 ? off_lo + cs[ii + u] : off_hi + run - cs[ii + u] + g[ii + u];
        kv2[u] = bf2f(KR[i * 64 + d]) * __builtin_amdgcn_exp2f(tall - bi); }
      pk[ii >> 1] = cvtpk(kv2[0], kv2[1]); }
    char* dst = lds + (dir ? L_KSTB : L_KSTF) + d * RB + 32 * tg;
    *(uint4*)dst = make_uint4(pk[0], pk[1], pk[2], pk[3]); *(uint4*)(dst + 16) = make_uint4(pk[4], pk[5], pk[6], pk[7]);
    if (tg == 0) dec_out[dir * dec_dir_stride + d] = __builtin_amdgcn_exp2f(tall);
  } else {
    bf16_t* Qx = (bf16_t*)(lds + (dir ? L_QB : L_QF)); bf16_t* Kx = (bf16_t*)(lds + (dir ? L_KB : L_KF));
#pragma unroll
    for (int ii = 0; ii < 16; ++ii) { const int i = 16 * tg + ii; const float bi = dir == 0 ? off_lo + cs[ii] : off_hi + run - cs[ii] + g[ii];
      const float qv = bf2f(QR[i * 64 + d]) * 0.125f, kv = bf2f(KR[i * 64 + d]);
      Qx[i * (RB / 2) + d] = (bf16_t)f2bf(qv * __builtin_amdgcn_exp2f(bi)); Kx[i * (RB / 2) + d] = (bf16_t)f2bf(kv * __builtin_amdgcn_exp2f(-bi)); }
  }
  __syncthreads();
}

__device__ __forceinline__ void g1_item(char* lds, const bf16_t* projb, const float* wdec, const float* bdec, int b, int hh, int c, float* kvt, float* dec) {
  int tid_ = threadIdx.x; asm volatile("" : "+v"(tid_)); const int tid = tid_, wid = tid >> 6, lane = tid & 63, r32 = lane & 31, hi = lane >> 5;
  const int bh = b * 4 + hh; const long item = (long)bh * 128 + c, dstride = 8L * 128;
  prep<true>(lds, projb, wdec, bdec, b * SEQ + c * 64, hh, dec + item * 64, dstride * 64);
  const int vblk = wid >> 1, dblk = wid & 1;
  bf16x8 vf[4]; v_frags((int)(uintptr_t)(lds + L_V) + v_rd_base(lane) + vblk * 512, vf);
#pragma unroll
  for (int dir = 0; dir < 2; ++dir) { const char* kst = lds + (dir ? L_KSTB : L_KSTF); f32x16 acc = {};
#pragma unroll
    for (int ks = 0; ks < 4; ++ks) acc = __builtin_amdgcn_mfma_f32_32x32x16_bf16(vf[ks], frag(kst, dblk * 32 + r32, ks, hi), acc, 0, 0, 0);
    float* o = kvt + ((long)dir * dstride + item) * 8192 + (size_t)(vblk * 32) * 64 + dblk * 32 + r32;
#pragma unroll
    for (int r = 0; r < 16; ++r) o[crow(r, hi) * 64] = acc[r]; }
  __syncthreads();
}

__device__ __forceinline__ void g3_item(char* lds, const bf16_t* projb, const float* wdec, const float* bdec, const float* normg, int b, int hh, int c, const bf16_t* st, bf16_t* out, int ldo) {
  int tid_ = threadIdx.x; asm volatile("" : "+v"(tid_)); const int tid = tid_, wid = tid >> 6, lane = tid & 63, r32 = lane & 31, hi = lane >> 5;
  const int bh = b * 4 + hh, t0 = b * SEQ + c * 64; const long item = (long)bh * 128 + c, dstride = 8L * 128;
#pragma unroll
  for (int e4 = 0; e4 < 4; ++e4) { const int e = tid + e4 * 512, dir = e >> 10, v = (e >> 3) & 127, dc = (e & 7) * 8;
    *(uint4*)(lds + (dir ? L_STB : L_STF) + v * RB + dc * 2) = *(const uint4*)(st + ((long)dir * dstride + item) * 8192 + (size_t)v * 64 + dc); }
  prep<false>(lds, projb, wdec, bdec, t0, hh, nullptr, 0);
  const int ib = wid & 1, vblk = wid >> 1, iglob = ib * 32 + r32;
  bf16_t rgr[16];
#pragma unroll
  for (int r = 0; r < 16; ++r) rgr[r] = projb[(size_t)(t0 + ib * 32 + crow(r, hi)) * DINP + OFF_GR + hh * 128 + vblk * 32 + r32];
  f32x16 pF0 = {}, pF1 = {}, pB0 = {}, pB1 = {};
#pragma unroll
  for (int ks = 0; ks < 4; ++ks) {
    const bf16x8 qf = frag(lds + L_QF, iglob, ks, hi), qb = frag(lds + L_QB, iglob, ks, hi);
    pF0 = __builtin_amdgcn_mfma_f32_32x32x16_bf16(frag(lds + L_KF, r32, ks, hi), qf, pF0, 0, 0, 0);
    pF1 = __builtin_amdgcn_mfma_f32_32x32x16_bf16(frag(lds + L_KF, 32 + r32, ks, hi), qf, pF1, 0, 0, 0);
    pB0 = __builtin_amdgcn_mfma_f32_32x32x16_bf16(frag(lds + L_KB, r32, ks, hi), qb, pB0, 0, 0, 0);
    pB1 = __builtin_amdgcn_mfma_f32_32x32x16_bf16(frag(lds + L_KB, 32 + r32, ks, hi), qb, pB1, 0, 0, 0); }
#pragma unroll
  for (int r = 0; r < 16; ++r) { const int j0 = crow(r, hi), j1 = 32 + j0;
    pF0[r] = (j0 <= iglob ? pF0[r] : 0.f) + (j0 >= iglob ? pB0[r] : 0.f);
    pF1[r] = (j1 <= iglob ? pF1[r] : 0.f) + (j1 >= iglob ? pB1[r] : 0.f); }
  bf16x8 pa0, pa1, pa2, pa3;
#define PK4(P, BASE, OUT) do { unsigned a0 = cvtpk(P[BASE + 0], P[BASE + 1]), a1 = cvtpk(P[BASE + 2], P[BASE + 3]);   \
    unsigned b0 = cvtpk(P[BASE + 4], P[BASE + 5]), b1 = cvtpk(P[BASE + 6], P[BASE + 7]);                              \
    auto r0 = __builtin_amdgcn_permlane32_swap(a0, b0, false, false); auto r1 = __builtin_amdgcn_permlane32_swap(a1, b1, false, false); \
    u32x4 w = {r0[0], r1[0], r0[1], r1[1]}; OUT = *reinterpret_cast<bf16x8*>(&w); } while (0)
  PK4(pF0, 0, pa0); PK4(pF0, 8, pa1); PK4(pF1, 0, pa2); PK4(pF1, 8, pa3);
#undef PK4
  bf16x8 vf[4]; v_frags((int)(uintptr_t)(lds + L_V) + v_rd_base(lane) + vblk * 512, vf);
  f32x16 o = {};
  o = __builtin_amdgcn_mfma_f32_32x32x16_bf16(pa0, vf[0], o, 0, 0, 0); o = __builtin_amdgcn_mfma_f32_32x32x16_bf16(pa1, vf[1], o, 0, 0, 0);
  o = __builtin_amdgcn_mfma_f32_32x32x16_bf16(pa2, vf[2], o, 0, 0, 0); o = __builtin_amdgcn_mfma_f32_32x32x16_bf16(pa3, vf[3], o, 0, 0, 0);
#pragma unroll
  for (int ks = 0; ks < 4; ++ks) {
    o = __builtin_amdgcn_mfma_f32_32x32x16_bf16(frag(lds + L_QF, iglob, ks, hi), frag(lds + L_STF, vblk * 32 + r32, ks, hi), o, 0, 0, 0);
    o = __builtin_amdgcn_mfma_f32_32x32x16_bf16(frag(lds + L_QB, iglob, ks, hi), frag(lds + L_STB, vblk * 32 + r32, ks, hi), o, 0, 0, 0); }
  float* RS = (float*)(lds + L_RSUM);
  float ss[16];
#pragma unroll
  for (int r = 0; r < 16; ++r) { float s = o[r] * o[r]; s += __shfl_xor(s, 1); s += __shfl_xor(s, 2); s += __shfl_xor(s, 4); s += __shfl_xor(s, 8); s += __shfl_xor(s, 16); ss[r] = s; }
  if (r32 == 0) {
#pragma unroll
    for (int r = 0; r < 16; ++r) RS[(ib * 4 + vblk) * 32 + crow(r, hi)] = ss[r]; }
  __syncthreads();
  const int v = vblk * 32 + r32; const float ng = normg[v];
#pragma unroll
  for (int r = 0; r < 16; ++r) { const int il = crow(r, hi), i = ib * 32 + il;
    const float tot = (RS[(ib * 4 + 0) * 32 + il] + RS[(ib * 4 + 1) * 32 + il]) + (RS[(ib * 4 + 2) * 32 + il] + RS[(ib * 4 + 3) * 32 + il]);
    const float rstd = 1.f / sqrtf(tot * (1.f / 128.f) + RMS_EPS);
    const float rg = bf2f(rgr[r]);
    out[(size_t)(t0 + i) * ldo + hh * 128 + v] = (bf16_t)f2bf(o[r] * rstd * ng * (rg * __builtin_amdgcn_rcpf(1.f + __builtin_amdgcn_exp2f(-1.4426950408889634f * rg)))); }
  __syncthreads();
}
}

__device__ __forceinline__ void ln_core(float4 (&v)[4], const float* g, const float* b, float* out, bf16_t* outb, int lane) {
    float s = 0.f;
#pragma unroll
    for (int j = 0; j < 4; ++j) s += (v[j].x + v[j].y) + (v[j].z + v[j].w);
    const float mean = wave_sum(s) * (1.f / DM); float s2 = 0.f;
#pragma unroll
    for (int j = 0; j < 4; ++j) { v[j].x -= mean; v[j].y -= mean; v[j].z -= mean; v[j].w -= mean; s2 += (v[j].x * v[j].x + v[j].y * v[j].y) + (v[j].z * v[j].z + v[j].w * v[j].w); }
    const float rstd = 1.f / sqrtf(wave_sum(s2) * (1.f / DM) + LN_EPS);
#pragma unroll
    for (int j = 0; j < 4; ++j) {
        const float4 gg = ((const float4*)g)[lane + 64 * j], bb = ((const float4*)b)[lane + 64 * j];
        float4 o; o.x = v[j].x * rstd * gg.x + bb.x; o.y = v[j].y * rstd * gg.y + bb.y; o.z = v[j].z * rstd * gg.z + bb.z; o.w = v[j].w * rstd * gg.w + bb.w;
        ((float4*)out)[lane + 64 * j] = o; v[j] = o;
        if (outb) ((uint2*)outb)[lane + 64 * j] = make_uint2(pk2(o.x, o.y), pk2(o.z, o.w));
    }
}
__device__ __forceinline__ void wave_sum2(float& a, float& b) {
#pragma unroll
    for (int o = 1; o < 64; o <<= 1) { const float ta = __shfl_xor(a, o), tb = __shfl_xor(b, o); a += ta; b += tb; }
}
template <int MODE>
__device__ __forceinline__ void ln_core2(float4 (&v)[2][4], const float* g, const float* b, float* out0, float* out1, bf16_t* ob0, bf16_t* ob1, int lane, unsigned char* o8_0 = nullptr, unsigned char* o8_1 = nullptr) {
    float s[2] = {0.f, 0.f};
#pragma unroll
    for (int u = 0; u < 2; ++u)
#pragma unroll
        for (int j = 0; j < 4; ++j) s[u] += (v[u][j].x + v[u][j].y) + (v[u][j].z + v[u][j].w);
    wave_sum2(s[0], s[1]);
    float q[2] = {0.f, 0.f};
#pragma unroll
    for (int u = 0; u < 2; ++u) { const float mean = s[u] * (1.f / DM);
#pragma unroll
        for (int j = 0; j < 4; ++j) { v[u][j].x -= mean; v[u][j].y -= mean; v[u][j].z -= mean; v[u][j].w -= mean; q[u] += (v[u][j].x * v[u][j].x + v[u][j].y * v[u][j].y) + (v[u][j].z * v[u][j].z + v[u][j].w * v[u][j].w); } }
    wave_sum2(q[0], q[1]);
#pragma unroll
    for (int j = 0; j < 4; ++j) {
        const float4 gg = ((const float4*)g)[lane + 64 * j], bb = ((const float4*)b)[lane + 64 * j];
#pragma unroll
        for (int u = 0; u < 2; ++u) { const float rstd = 1.f / sqrtf(q[u] * (1.f / DM) + LN_EPS);
            float4 o; o.x = v[u][j].x * rstd * gg.x + bb.x; o.y = v[u][j].y * rstd * gg.y + bb.y; o.z = v[u][j].z * rstd * gg.z + bb.z; o.w = v[u][j].w * rstd * gg.w + bb.w;
            v[u][j] = o;
            if constexpr (MODE == 2) ((float4*)(u ? out1 : out0))[lane + 64 * j] = o;
            else ((uint2*)(u ? ob1 : ob0))[lane + 64 * j] = make_uint2(pk2(o.x, o.y), pk2(o.z, o.w));
            if constexpr (MODE == 1) ((unsigned*)(u ? o8_1 : o8_0))[lane + 64 * j] = pk4_fp8(o.x, o.y, o.z, o.w); }
    }
}
__device__ __forceinline__ int block_excl_scan(int x, int* scr, int tid, int& total) {
    const int lane = tid & 63, wid = tid >> 6; int inc = x;
#pragma unroll
    for (int o = 1; o < 64; o <<= 1) { const int y = __shfl_up(inc, o); if (lane >= o) inc += y; }
    __syncthreads();
    if (lane == 63) scr[wid] = inc;
    __syncthreads();
    int base = 0, tot = 0;
#pragma unroll
    for (int w = 0; w < 8; ++w) { const int c = scr[w]; base += (w < wid) ? c : 0; tot += c; }
    total = tot; return base + inc - x;
}

__device__ __forceinline__ void tb_load(float (&v)[32], const float* Wblk, int ldw, int lane) {
#pragma unroll
    for (int i = 0; i < 32; ++i) v[i] = __builtin_nontemporal_load(&Wblk[(size_t)(2 * i + (lane >> 5)) * ldw + (lane & 31)]);
}
__device__ __forceinline__ void tb_store(const float (&v)[32], bf16_t* dst, int ldt, float* scr, int lane) {
#pragma unroll
    for (int i = 0; i < 32; ++i) scr[(2 * i + (lane >> 5)) * 33 + (lane & 31)] = v[i];
    asm volatile("s_waitcnt lgkmcnt(0)" ::: "memory");
    const int c = lane & 7;
#pragma unroll
    for (int j = 0; j < 4; ++j) { const int n = (lane >> 3) + 8 * j; const float* s = scr + (8 * c) * 33 + n;
        uint4 o; o.x = pk2(s[0 * 33], s[1 * 33]); o.y = pk2(s[2 * 33], s[3 * 33]); o.z = pk2(s[4 * 33], s[5 * 33]); o.w = pk2(s[6 * 33], s[7 * 33]);
        *(uint4*)(dst + (size_t)n * ldt + 8 * c) = o; }
    asm volatile("s_waitcnt lgkmcnt(0)" ::: "memory");
}

__device__ __forceinline__ void tb_store8(const float (&v)[32], unsigned char* dst, int ldt, float sc, float* scr, int lane) {
#pragma unroll
    for (int i = 0; i < 32; ++i) scr[(2 * i + (lane >> 5)) * 33 + (lane & 31)] = v[i];
    asm volatile("s_waitcnt lgkmcnt(0)" ::: "memory");
    const int c = lane & 7;
#pragma unroll
    for (int j = 0; j < 4; ++j) { const int n = (lane >> 3) + 8 * j; const float* s = scr + (8 * c) * 33 + n;
        *(uint2*)(dst + (size_t)n * ldt + 8 * c) = make_uint2(pk4_fp8(s[0 * 33] * sc, s[1 * 33] * sc, s[2 * 33] * sc, s[3 * 33] * sc), pk4_fp8(s[4 * 33] * sc, s[5 * 33] * sc, s[6 * 33] * sc, s[7 * 33] * sc)); }
    asm volatile("s_waitcnt lgkmcnt(0)" ::: "memory");
}

__device__ __forceinline__ void ln_row(const float* a, const float* add, float alpha, const float* g, const float* b, float* out, int lane, float4 (&v)[4], bf16_t* outb = nullptr) {
    float s = 0.f;
#pragma unroll
    for (int j = 0; j < 4; ++j) {
        float4 x = ((const float4*)a)[lane + 64 * j];
        x.x *= alpha; x.y *= alpha; x.z *= alpha; x.w *= alpha;
        if (add) { const float4 y = ((const float4*)add)[lane + 64 * j]; x.x += y.x; x.y += y.y; x.z += y.z; x.w += y.w; }
        v[j] = x; s += (x.x + x.y) + (x.z + x.w);
    }
    const float mean = wave_sum(s) * (1.f / DM); float s2 = 0.f;
#pragma unroll
    for (int j = 0; j < 4; ++j) { v[j].x -= mean; v[j].y -= mean; v[j].z -= mean; v[j].w -= mean; s2 += (v[j].x * v[j].x + v[j].y * v[j].y) + (v[j].z * v[j].z + v[j].w * v[j].w); }
    const float rstd = 1.f / sqrtf(wave_sum(s2) * (1.f / DM) + LN_EPS);
#pragma unroll
    for (int j = 0; j < 4; ++j) {
        const float4 gg = ((const float4*)g)[lane + 64 * j], bb = ((const float4*)b)[lane + 64 * j];
        float4 o; o.x = v[j].x * rstd * gg.x + bb.x; o.y = v[j].y * rstd * gg.y + bb.y; o.z = v[j].z * rstd * gg.z + bb.z; o.w = v[j].w * rstd * gg.w + bb.w;
        if (out) ((float4*)out)[lane + 64 * j] = o; v[j] = o;
        if (outb) ((uint2*)outb)[lane + 64 * j] = make_uint2(pk2(o.x, o.y), pk2(o.z, o.w));
    }
}

struct GemmP {
    const float* A; const int* ridx; const float* Bm; float* C;
    int lda, ldb, ldc, M, N, K, nb, bshift;
    long sA, sB, sC; int sR;
    const float* aux; const bf16_t* auxb; int ldaux; long sAux; const float* aux2; int accum;
};
template <int MODE>
__device__ __forceinline__ void gemm_naive(const GemmP g, float* lds) {
    float (*As)[132] = (float (*)[132])lds;
    float (*Bs)[128] = (float (*)[128])(lds + 16 * 132);
    int tid_ = threadIdx.x; asm volatile("" : "+v"(tid_));
    const int tid = tid_, ty = tid >> 4, tx = tid & 15;
    const int mt = g.M / 128, nt = (g.N + 127) / 128, per = mt * nt, total = per * g.nb;
    int bid_ = blockIdx.x; asm volatile("" : "+s"(bid_));
    for (int tile = bid_; tile < total; tile += gridDim.x) {
        const int z = tile / per, r = tile % per, tm = r / nt, tn = r % nt;
        const int m0 = tm * 128, n0 = tn * 128;
        const float* Bz = g.Bm + (long)(z >> g.bshift) * g.sB;
        float* Cz = g.C + (long)z * g.sC;
        const int arow = m0 + (tid >> 2);
        const long grow = g.ridx ? (long)g.ridx[z * g.sR + arow] : (long)arow;
        const float* Arow = g.A + (long)z * g.sA + grow * g.lda + (tid & 3) * 4;
        const int bk = tid >> 5, bn = n0 + (tid & 31) * 4;
        const bool bok = bn < g.N;
        const float* Bp = Bz + (long)bk * g.ldb + bn;
        float acc[4][8];
#pragma unroll
        for (int i = 0; i < 4; ++i)
#pragma unroll
            for (int j = 0; j < 8; ++j) acc[i][j] = 0.f;
        float4 ra = *(const float4*)(Arow);
        float4 rb = bok ? *(const float4*)(Bp) : make_float4(0.f, 0.f, 0.f, 0.f);
        for (int k0 = 0; k0 < g.K; k0 += 16) {
            __syncthreads();
            { const int rr = tid >> 2, k4 = (tid & 3) * 4; As[k4][rr] = ra.x; As[k4 + 1][rr] = ra.y; As[k4 + 2][rr] = ra.z; As[k4 + 3][rr] = ra.w; }
            *(float4*)&Bs[bk][(tid & 31) * 4] = rb;
            __syncthreads();
            if (k0 + 16 < g.K) {
                ra = *(const float4*)(Arow + k0 + 16);
                rb = bok ? *(const float4*)(Bp + (long)(k0 + 16) * g.ldb) : make_float4(0.f, 0.f, 0.f, 0.f);
            }
#pragma unroll
            for (int k = 0; k < 16; ++k) {
                const float4 a = *(const float4*)&As[k][ty * 4];
                const float4 b0 = *(const float4*)&Bs[k][tx * 8], b1 = *(const float4*)&Bs[k][tx * 8 + 4];
                const float av[4] = {a.x, a.y, a.z, a.w};
                const float bv[8] = {b0.x, b0.y, b0.z, b0.w, b1.x, b1.y, b1.z, b1.w};
#pragma unroll
                for (int i = 0; i < 4; ++i)
#pragma unroll
                    for (int j = 0; j < 8; ++j) acc[i][j] = fmaf(av[i], bv[j], acc[i][j]);
            }
        }
#pragma unroll
        for (int i = 0; i < 4; ++i) {
            const int row = m0 + ty * 4 + i;
#pragma unroll
            for (int jv = 0; jv < 2; ++jv) {
                const int col = n0 + tx * 8 + jv * 4;
                if (col < g.N) {
                    float v[4] = {acc[i][jv * 4], acc[i][jv * 4 + 1], acc[i][jv * 4 + 2], acc[i][jv * 4 + 3]};
                    float* cp = Cz + (long)row * g.ldc + col;
                    if (MODE == 1) {
#pragma unroll
                        for (int q = 0; q < 4; ++q) v[q] *= g.aux[(long)z * g.sAux + col + q];
                    } else if (MODE == 2) {
                        float gl[4]; ld4bf(g.auxb + (long)row * g.ldaux + col, gl); const float4 gb = *(const float4*)(g.aux2 + col);
                        const float gv[4] = {gl[0] + gb.x, gl[1] + gb.y, gl[2] + gb.z, gl[3] + gb.w};
                        float4 old = make_float4(0.f, 0.f, 0.f, 0.f);
                        if (g.accum) old = *(const float4*)cp;
                        const float ov[4] = {old.x, old.y, old.z, old.w};
#pragma unroll
                        for (int q = 0; q < 4; ++q) v[q] = ov[q] + sigmoidf_(gv[q]) * v[q];
                    } else if (MODE == 3) {
                        const float4 old = *(const float4*)cp; const float ov[4] = {old.x, old.y, old.z, old.w};
#pragma unroll
                        for (int q = 0; q < 4; ++q) v[q] = siluf_(ov[q]) * v[q];
                    } else if (MODE == 4) {
                        const float rs = g.aux[(long)z * g.sAux + row];
#pragma unroll
                        for (int q = 0; q < 4; ++q) v[q] *= rs;
                    }
                    *(float4*)cp = make_float4(v[0], v[1], v[2], v[3]);
                }
            }
        }
    }
    __syncthreads();
}

#define W_IN(l)    (p.in[4]  + (size_t)(l) * DM * DIN)
#define B_GATE(l)  (p.in[5]  + (size_t)(l) * 3 * DM)
#define POOL_W(l)  (p.in[6]  + (size_t)(l) * 4 * 128 * 128)
#define POOL_S(l)  (p.in[7]  + (size_t)(l) * 512)
#define W_UP_A(l)  (p.in[8]  + (size_t)(l) * 512 * DM)
#define Q_NORM(l)  (p.in[9]  + (size_t)(l) * 384)
#define W_UQ(l)    (p.in[10] + (size_t)(l) * 384 * 768)
#define KV_NORM(l) (p.in[11] + (size_t)(l) * 256)
#define W_UKV(l)   (p.in[12] + (size_t)(l) * 256 * 1024)
#define W_UP_B(l)  (p.in[13] + (size_t)(l) * 512 * DM)
#define W_DEC(l)   (p.in[14] + (size_t)(l) * 2 * 16 * 256)
#define B_DEC(l)   (p.in[15] + (size_t)(l) * 2 * 256)
#define GLA_NORM(l)(p.in[16] + (size_t)(l) * 128)
#define W_UP_C(l)  (p.in[17] + (size_t)(l) * 512 * DM)
#define W_OUT(l)   (p.in[18] + (size_t)(l) * DM * DM)
#define LN1_G(l)   (p.in[19] + (size_t)(l) * DM)
#define LN1_B(l)   (p.in[20] + (size_t)(l) * DM)
#define ROUTER(l)  (p.in[21] + (size_t)(l) * DM * NE)
#define EW_GATE(l) (p.in[22] + (size_t)(l) * NE * DM * DEXP)
#define EW_UP(l)   (p.in[23] + (size_t)(l) * NE * DM * DEXP)
#define EW_DOWN(l) (p.in[24] + (size_t)(l) * NE * DEXP * DM)
#define LN2_G(l)   (p.in[25] + (size_t)(l) * DM)
#define LN2_B(l)   (p.in[26] + (size_t)(l) * DM)
#define WSF(off) ((float*)(p.ws + (off)))
#define WSI(off) ((int*)(p.ws + (off)))
#define WSB(off) ((bf16_t*)(p.ws + (off)))
#define PJ(t, c) bf2f(projb[(size_t)(t) * DINP + (c)])

enum Stage {
    ST_INIT = 0,
    ST_WCONV,
    ST_PROJ,
    ST_PREP,
    ST_SMALLGEMM,
    ST_ROPE,
    ST_ATTN,
    ST_GLA1, ST_GLA2, ST_GLA3,
    ST_GLAFIN,
    ST_MERGE_A, ST_MERGE_B, ST_MERGE_C,
    ST_OUTP,
    ST_LN1,
    ST_TOPK,
    ST_GATHER,
    ST_EXP_G, ST_EXP_U, ST_EXP_D,
    ST_LN2,
    ST_COUNT
};

#define KAS __attribute__((address_space(4)))
template <int ST>
__device__ __forceinline__ void run_stage(int l, float* lds) {
    const KAS Params* pk_ = (const KAS Params*)__builtin_amdgcn_kernarg_segment_ptr(); asm volatile("" : "+s"(pk_));
    const KAS Params& p = *pk_;
    int tid_ = threadIdx.x; asm volatile("" : "+v"(tid_));
    int bid_ = blockIdx.x; asm volatile("" : "+s"(bid_));
    const int tid = tid_, lane = tid & 63, wid = tid >> 6;
    const int G = gridDim.x, bid = bid_;
    const int gw = bid * 8 + wid, NGW = G * 8;
    const long gt = (long)bid * NTHR + tid, NGT = (long)G * NTHR;
    float* h = p.out;

    if constexpr (ST == ST_INIT) {
        for (int m = gw; m < T; m += NGW) { float4 vv[4]; ln_row(p.in[0] + (size_t)m * DM, nullptr, 1.f, p.in[2], p.in[3], nullptr, lane, vv, WSB(WS_HB) + (size_t)m * DM); }
        {
            float* scr = lds + wid * 4096;
            constexpr int NBLK = DIN / 32, ITEMS_L = (DM / 64) * NBLK;
            for (int it = gw; it < 2 * ITEMS_L; it += NGW) {
                const int ll = it / ITEMS_L, r = it % ITEMS_L, kb = r / NBLK, nb = r % NBLK;
                const int n0 = 32 * nb, drow = n0 < 2752 ? n0 + 3072 : n0 - 2752;
                transpose_block(p.in[4] + (size_t)ll * DM * DIN + (size_t)(64 * kb) * DIN + n0, DIN, WSB(WS_WIN_T) + (size_t)ll * DINP * DM + (size_t)drow * DM + 64 * kb, DM, nullptr, nullptr, scr, lane);
            }
            {
                constexpr int I_UQ = 6 * 24, I_UKV = 4 * 32, I_B = 8 * 32, I_OUT = 16 * 32, I_L = I_UQ + I_UKV + 2 * I_B + I_OUT;
                for (int it = gw; it < 2 * I_L; it += NGW) {
                    const int ll = it / I_L; int r = it % I_L; bf16_t* wsm = WSB(WS_WSMALL + (size_t)ll * WSM_STRIDE);
                    if (r < I_UQ) { const int kb = r / 24, nb = r % 24; transpose_block(p.in[10] + (size_t)ll * 384 * 768 + (size_t)(64 * kb) * 768 + 32 * nb, 768, wsm + WSM_UQ / 2 + (size_t)(32 * nb) * 384 + 64 * kb, 384, p.in[9] + ll * 384 + 64 * kb, nullptr, scr, lane); continue; } r -= I_UQ;
                    if (r < I_UKV) { const int kb = r / 32, nb = r % 32; transpose_block(p.in[12] + (size_t)ll * 256 * 1024 + (size_t)(64 * kb) * 1024 + 32 * nb, 1024, wsm + WSM_UKV / 2 + (size_t)(32 * nb) * 256 + 64 * kb, 256, p.in[11] + ll * 256 + 64 * kb, nullptr, scr, lane); continue; } r -= I_UKV;
                    if (r < 2 * I_B) { const int c = r / I_B, rr = r % I_B, kb = rr / 32, nb = rr % 32; const float* W = (c ? p.in[17] : p.in[13]) + (size_t)ll * 512 * DM;
                        transpose_block(W + (size_t)(64 * kb) * DM + 32 * nb, DM, wsm + WSM_MRG / 2 + (size_t)(32 * nb) * 1536 + 512 * (1 + c) + 64 * kb, 1536, nullptr, nullptr, scr, lane); continue; } r -= 2 * I_B;
                    { const int kb = r / 32, nb = r % 32; transpose_block(p.in[18] + (size_t)ll * DM * DM + (size_t)(64 * kb) * DM + 32 * nb, DM, wsm + WSM_OUT / 2 + (size_t)(32 * nb) * DM + 64 * kb, DM, nullptr, nullptr, scr, lane); }
                }
                {
                    float* At = lds; float* Bs = lds + 128 * 129;
                    for (int it = bid; it < 2 * 4 * 32; it += G) {
                        const int ll = it >> 7, g = (it >> 5) & 3, db = it & 31;
                        const float* pw = p.in[6] + (size_t)ll * 4 * 128 * 128 + (size_t)g * 128 * 128; const float* ps = p.in[7] + ll * 512 + g * 128;
                        const float* wa = p.in[8] + (size_t)ll * 512 * DM + (size_t)(g * 128) * DM + db * 32;
                        __syncthreads();
                        for (int e = tid; e < 128 * 128; e += NTHR) { const int c = e >> 7, cp = e & 127; At[cp * 129 + c] = pw[e] * ps[cp]; }
                        for (int e = tid; e < 128 * 32; e += NTHR) { const int cp = e >> 5, dd = e & 31; Bs[cp * 32 + dd] = wa[(size_t)cp * DM + dd]; }
                        __syncthreads();
                        const int c = tid >> 2, d0 = (tid & 3) * 8;
                        float a0 = 0.f, a1 = 0.f, a2 = 0.f, a3 = 0.f, a4 = 0.f, a5 = 0.f, a6 = 0.f, a7 = 0.f;
#pragma unroll 8
                        for (int cp = 0; cp < 128; ++cp) { const float a = At[cp * 129 + c]; const float4 b0 = *(const float4*)(Bs + cp * 32 + d0), b1 = *(const float4*)(Bs + cp * 32 + d0 + 4);
                            a0 = fmaf(a, b0.x, a0); a1 = fmaf(a, b0.y, a1); a2 = fmaf(a, b0.z, a2); a3 = fmaf(a, b0.w, a3); a4 = fmaf(a, b1.x, a4); a5 = fmaf(a, b1.y, a5); a6 = fmaf(a, b1.z, a6); a7 = fmaf(a, b1.w, a7); }
                        bf16_t* o = WSB(WS_WSMALL + (size_t)ll * WSM_STRIDE + WSM_MRG) + (size_t)(db * 32 + d0) * 1536 + g * 128 + c;
                        o[0] = (bf16_t)f2bf(a0); o[1536] = (bf16_t)f2bf(a1); o[2 * 1536] = (bf16_t)f2bf(a2); o[3 * 1536] = (bf16_t)f2bf(a3);
                        o[4 * 1536] = (bf16_t)f2bf(a4); o[5 * 1536] = (bf16_t)f2bf(a5); o[6 * 1536] = (bf16_t)f2bf(a6); o[7 * 1536] = (bf16_t)f2bf(a7);
                    }
                    __syncthreads();
                }
            }
            for (long i = gt; i < 2L * 64 * DM / 8; i += NGT) { const int ll = (int)(i / (64 * DM / 8)); const long r = i % (64 * DM / 8);
                *(uint4*)(WSB(WS_WIN_T) + (size_t)ll * DINP * DM + (size_t)DIN * DM + r * 8) = make_uint4(0u, 0u, 0u, 0u); }
        }
        float* rc = WSF(WS_ROPE); float* rs = rc + T * 16;
        for (long i = gt; i < (long)T * 16; i += NGT) {
            const int t = (int)(i >> 4), j = (int)(i & 15);
            const float freq = powf(10000.0f, -(float)j / 16.0f);
            const float ang = (float)p.pos[t] * freq;
            rc[i] = cosf(ang); rs[i] = sinf(ang);
        }
    }
    if constexpr (ST == ST_WCONV) {
        float* scr = lds + wid * 4096;
        constexpr int I_G = 16 * 16 * 64, I_D = 16 * 32 * 32;
        constexpr int I_ALL = 2 * I_G + I_D;
#define WCONV_ITEM(it, W, ldw, dst, ldt, sc8) do { if ((it) < 2 * I_G) { const int up_ = (it) >= I_G, r_ = up_ ? (it) - I_G : (it), e_ = r_ >> 10, kb_ = (r_ >> 6) & 15, nb_ = r_ & 63, j0_ = nb_ * 32; \
            W = (up_ ? EW_UP(l) : EW_GATE(l)) + (size_t)e_ * DM * DEXP + (size_t)(64 * kb_) * DEXP + j0_; ldw = DEXP; \
            dst = (unsigned char*)(p.ws + WS_WGU_T) + (size_t)(e_ * 4096 + 256 * (j0_ >> 7) + (j0_ & 127) + (up_ ? 128 : 0)) * DM + 64 * kb_; ldt = DM; sc8 = F8_WGU; } \
          else { const int r_ = (it) - 2 * I_G, e_ = r_ >> 10, kb_ = (r_ >> 5) & 31, nb_ = r_ & 31; \
            W = EW_DOWN(l) + (size_t)e_ * DEXP * DM + (size_t)(64 * kb_) * DM + 32 * nb_; ldw = DM; dst = (unsigned char*)(p.ws + WS_WD_T) + (size_t)(e_ * 1024 + 32 * nb_) * DEXP + 64 * kb_; ldt = DEXP; sc8 = F8_WD; } } while (0)
        float va[32], vb[32]; const float* Wa = nullptr; const float* Wb = nullptr; unsigned char* da = nullptr; unsigned char* db = nullptr; int lwa = 0, lwb = 0, lta = 0, ltb = 0; float sa = 1.f, sb = 1.f;
        int itA = gw, itB = gw + NGW;
        if (itA < I_ALL) { WCONV_ITEM(itA, Wa, lwa, da, lta, sa); tb_load(va, Wa, lwa, lane); }
        while (itA < I_ALL) {
            if (itB < I_ALL) { WCONV_ITEM(itB, Wb, lwb, db, ltb, sb); tb_load(vb, Wb, lwb, lane); }
            tb_store8(va, da, lta, sa, scr, lane);
            itA = itB + NGW;
            if (itB >= I_ALL) break;
            if (itA < I_ALL) { WCONV_ITEM(itA, Wa, lwa, da, lta, sa); tb_load(va, Wa, lwa, lane); }
            tb_store8(vb, db, ltb, sb, scr, lane);
            itB = itA + NGW;
        }
#undef WCONV_ITEM
        __syncthreads();
    }
    if constexpr (ST == ST_PROJ) {
        pg8::Gemm g{WSB(WS_HB), WSB(WS_WIN_T) + (size_t)l * DINP * DM, T, DINP, DM, DM};
        pg8::StaticOrder S; S.init(T, DINP, G, bid);
        EpiProj E{WSB(WS_PROJB), B_GATE(l)};
        pg8::gemm_phase<EpiProj, pg8::StaticOrder, true, true>((PG8_LAS unsigned char*)lds, g, S, E);
    }
    if constexpr (ST == ST_PREP) {
        const bf16_t* projb = WSB(WS_PROJB); bf16_t* br = WSB(WS_BR); bf16_t* U = (bf16_t*)lds;
        float* rq = WSF(WS_RQ); float* rkv = rq + T; const float* rc = WSF(WS_ROPE); const float* rs = rc + T * 16; bf16_t* kb = WSB(WS_KB);
        for (int tile = bid; tile < T / 64; tile += G) {
            const int b = tile / (SEQ / 64), s0 = (tile % (SEQ / 64)) * 64, t0 = b * SEQ + s0;
            __syncthreads();
#pragma unroll
            for (int it = 0; it < 10; ++it) { const int e = tid + it * NTHR, r = e >> 6, ch = e & 63, s = s0 - 8 + r;
                uint4 v = make_uint4(0u, 0u, 0u, 0u);
                if (s >= 0 && s < SEQ) v = *(const uint4*)(projb + (size_t)(b * SEQ + s) * DINP + OFF_POOL + ch * 8);
                *(uint4*)(U + r * 512 + ch * 8) = v; }
            for (int r = wid; r < 64; r += 8) { const bf16_t* row = projb + (size_t)(t0 + r) * DINP;
                float s1 = 0.f, s2 = 0.f;
                if (lane < 48) { const uint4 w = *(const uint4*)(row + OFF_CQ + lane * 8); const unsigned ww[4] = {w.x, w.y, w.z, w.w};
#pragma unroll
                    for (int q = 0; q < 4; ++q) { const float a = __uint_as_float(ww[q] << 16), c = __uint_as_float(ww[q] & 0xffff0000u); s1 += a * a + c * c; } }
                if (lane < 32) { const uint4 w = *(const uint4*)(row + OFF_CKV + lane * 8); const unsigned ww[4] = {w.x, w.y, w.z, w.w};
#pragma unroll
                    for (int q = 0; q < 4; ++q) { const float a = __uint_as_float(ww[q] << 16), c = __uint_as_float(ww[q] & 0xffff0000u); s2 += a * a + c * c; } }
                s1 = wave_sum(s1); s2 = wave_sum(s2);
                if (lane == 0) { rq[t0 + r] = 1.f / sqrtf(s1 * (1.f / 384.f) + RMS_EPS); rkv[t0 + r] = 1.f / sqrtf(s2 * (1.f / 256.f) + RMS_EPS); } }
#pragma unroll
            for (int it = 0; it < 2; ++it) { const int e = tid + it * NTHR, r = e >> 4, j = e & 15, t = t0 + r;
                const float c = rc[(size_t)t * 16 + j], s = rs[(size_t)t * 16 + j], x1 = PJ(t, OFF_KR + j), x2 = PJ(t, OFF_KR + 16 + j);
                const bf16_t k1 = (bf16_t)f2bf(x1 * c - x2 * s), k2 = (bf16_t)f2bf(x1 * s + x2 * c);
#pragma unroll
                for (int hh = 0; hh < 8; ++hh) { kb[(size_t)t * 768 + hh * 96 + 64 + j] = k1; kb[(size_t)t * 768 + hh * 96 + 80 + j] = k2; } }
            __syncthreads();
            { const int c = tid, hw = 1 << (c >> 7); float sum = 0.f;
                for (int u = s0 - hw; u < s0 + hw; ++u) if (u >= 0 && u < SEQ) sum += bf2f(U[(u - s0 + 8) * 512 + c]);
                for (int s = s0; s < s0 + 64; ++s) {
                    int lo = s - hw; if (lo < 0) lo = 0; int hi = s + hw; if (hi > SEQ) hi = SEQ;
                    br[(size_t)(b * SEQ + s) * 1536 + c] = (bf16_t)f2bf(sum / (float)(hi - lo) - bf2f(U[(s - s0 + 8) * 512 + c]));
                    if (s + hw < SEQ) sum += bf2f(U[(s + hw - s0 + 8) * 512 + c]);
                    if (s - hw >= 0) sum -= bf2f(U[(s - hw - s0 + 8) * 512 + c]);
                } }
        }
        __syncthreads();
    }
    if constexpr (ST == ST_SMALLGEMM) {
        const bf16_t* wsm = WSB(WS_WSMALL + (size_t)l * WSM_STRIDE);
        { pg8::Gemm g{WSB(WS_PROJB) + OFF_CQ, wsm + WSM_UQ / 2, T, 768, 384, DINP}; pg8::StaticOrder S; S.init(T, 768, G, bid);
          EpiQ E{WSB(WS_QB), WSF(WS_RQ), WSF(WS_ROPE), WSF(WS_ROPE) + T * 16}; pg8::gemm_phase<EpiQ, pg8::StaticOrder, true, true>((PG8_LAS unsigned char*)lds, g, S, E); }
        { pg8::Gemm g{WSB(WS_PROJB) + OFF_CKV, wsm + WSM_UKV / 2, T, 1024, 256, DINP}; pg8::StaticOrder S; S.init(T, 1024, G, bid);
          EpiKV E{WSB(WS_KB), WSB(WS_VB), WSF(WS_RQ) + T}; pg8::gemm_phase<EpiKV, pg8::StaticOrder, true, true>((PG8_LAS unsigned char*)lds, g, S, E); }
    }
    if constexpr (ST == ST_ATTN) {
        const int vcu = (G % 8 == 0) ? (bid % 8) * (G / 8) + bid / 8 : bid;
        WStream wst; wst.gate = EW_GATE(l); wst.up = EW_UP(l); wst.down = EW_DOWN(l); wst.wgu_t = p.ws + WS_WGU_T; wst.wd_t = p.ws + WS_WD_T;
        { const int wu = __builtin_amdgcn_readfirstlane(wid); wst.init(bid * 8 + wu, NGW, (char*)lds + att::SHM_ATTN + wu * 2560, lane); }
        for (int L = vcu; L < NB * 8 * 32; L += G) {
            const int bh = L >> 5, qb = L & 31, b = bh >> 3, hh = bh & 7;
            att::attn_unit(WSB(WS_QB) + (size_t)(b * SEQ + qb * 256) * 768 + hh * 96, WSB(WS_KB) + (size_t)(b * SEQ) * 768 + hh * 96, WSB(WS_VB) + (size_t)(b * SEQ) * 512 + hh * 64,
                           WSB(WS_BR) + (size_t)(b * SEQ + qb * 256) * 1536 + 512 + hh * 64, SEQ, (char*)lds, wst);
        }
        while (wst.step <= wst.nsteps) wst.tick(lane);
        __syncthreads();
    }
    if constexpr (ST == ST_GLA1) {
        for (int item = bid; item < NB * 4 * 128; item += G) {
            const int b = item >> 9, hh = (item >> 7) & 3, c = item & 127;
            gla::g1_item((char*)lds, WSB(WS_PROJB), W_DEC(l), B_DEC(l), b, hh, c, WSF(WS_KVT), WSF(WS_DEC));
        }
    }
    if constexpr (ST == ST_GLA2) {
        const float* kvt = WSF(WS_KVT); const float* dec = WSF(WS_DEC); bf16_t* stp = WSB(WS_ST);
        for (long e = gt; e < 2L * 8 * 8192; e += NGT) {
            const int dir = (int)(e >> 16), bh = (int)((e >> 13) & 7), vd = (int)(e & 8191), d = vd & 63;
            const long base = ((long)dir * 8 + bh) * 128;
            float s = 0.f;
#pragma unroll 1
            for (int k0 = 0; k0 < 128; k0 += 32) {
                float kv[32], dc[32];
#pragma unroll
                for (int k = 0; k < 32; ++k) { const int c = dir ? 127 - (k0 + k) : k0 + k; kv[k] = kvt[(base + c) * 8192 + vd]; dc[k] = dec[(base + c) * 64 + d]; }
#pragma unroll
                for (int k = 0; k < 32; ++k) { const int c = dir ? 127 - (k0 + k) : k0 + k; stp[(base + c) * 8192 + vd] = (bf16_t)f2bf(s); s = fmaf(dc[k], s, kv[k]); }
            }
        }
    }
    if constexpr (ST == ST_GLA3) {
        for (int item = bid; item < NB * 4 * 128; item += G) {
            const int b = item >> 9, hh = (item >> 7) & 3, c = item & 127;
            gla::g3_item((char*)lds, WSB(WS_PROJB), W_DEC(l), B_DEC(l), GLA_NORM(l), b, hh, c, WSB(WS_ST), WSB(WS_BR) + 1024, 1536);
        }
    }
    if constexpr (ST == ST_MERGE_A) {
        const bf16_t* wsm = WSB(WS_WSMALL + (size_t)l * WSM_STRIDE);
        pg8::Gemm g{WSB(WS_BR), wsm + WSM_MRG / 2, T, DM, 1536, 1536}; pg8::StaticOrder S; S.init(T, DM, G, bid);
        EpiMerge E{WSB(WS_MERGEDB), WSB(WS_PROJB) + OFF_GATE};
        pg8::gemm_phase<EpiMerge, pg8::StaticOrder, true, true>((PG8_LAS unsigned char*)lds, g, S, E);
    }
    if constexpr (ST == ST_OUTP) {
        const bf16_t* wsm = WSB(WS_WSMALL + (size_t)l * WSM_STRIDE);
        pg8::Gemm g{WSB(WS_MERGEDB), wsm + WSM_OUT / 2, T, DM, DM, DM}; pg8::StaticOrder S; S.init(T, DM, G, bid);
        pg8::EpiBf16<0> E{WSB(WS_TMP), DM, nullptr, 0, 0, 1.f};
        pg8::gemm_phase<pg8::EpiBf16<0>, pg8::StaticOrder, true, true>((PG8_LAS unsigned char*)lds, g, S, E);
    }
    if constexpr (ST == ST_LN1) {
        float* RWT = lds; const float* rw = ROUTER(l);
        for (int i = tid; i < DM * 4; i += NTHR) { const int k = i >> 2, e4 = (i & 3) * 4; const float4 w = *(const float4*)(rw + (size_t)k * 16 + e4);
            RWT[(e4 + 0) * DM + k] = w.x; RWT[(e4 + 1) * DM + k] = w.y; RWT[(e4 + 2) * DM + k] = w.z; RWT[(e4 + 3) * DM + k] = w.w; }
        __syncthreads();
        float* afft = WSF(WS_AFF);
        for (int m0 = gw; m0 < T; m0 += 2 * NGW) {
            const int mr[2] = {m0, m0 + NGW};
            float4 hv[2][4];
#pragma unroll
            for (int u = 0; u < 2; ++u) { const bf16_t* hr = WSB(WS_HB) + (size_t)mr[u] * DM; const bf16_t* tr = WSB(WS_TMP) + (size_t)mr[u] * DM;
#pragma unroll
                for (int j = 0; j < 4; ++j) { float a[4], t4[4]; ld4bf(hr + 4 * (lane + 64 * j), a); ld4bf(tr + 4 * (lane + 64 * j), t4);
                    hv[u][j] = make_float4(fmaf(ALPHA, a[0], t4[0]), fmaf(ALPHA, a[1], t4[1]), fmaf(ALPHA, a[2], t4[2]), fmaf(ALPHA, a[3], t4[3])); } }
            ln_core2<1>(hv, LN1_G(l), LN1_B(l), nullptr, nullptr, WSB(WS_HB) + (size_t)mr[0] * DM, WSB(WS_HB) + (size_t)mr[1] * DM, lane,
                     p.ws + WS_HB8 + (size_t)mr[0] * DM, p.ws + WS_HB8 + (size_t)mr[1] * DM);
            float acc[2][16];
#pragma unroll
            for (int e = 0; e < 16; ++e) { float a0 = 0.f, a1 = 0.f;
#pragma unroll
                for (int j = 0; j < 4; ++j) { const float4 w = *(const float4*)(RWT + e * DM + 4 * (lane + 64 * j));
                    a0 = fmaf(hv[0][j].x, w.x, a0); a0 = fmaf(hv[0][j].y, w.y, a0); a0 = fmaf(hv[0][j].z, w.z, a0); a0 = fmaf(hv[0][j].w, w.w, a0);
                    a1 = fmaf(hv[1][j].x, w.x, a1); a1 = fmaf(hv[1][j].y, w.y, a1); a1 = fmaf(hv[1][j].z, w.z, a1); a1 = fmaf(hv[1][j].w, w.w, a1); }
                acc[0][e] = a0; acc[1][e] = a1; if (e & 1) __builtin_amdgcn_sched_barrier(0); }
#pragma unroll
            for (int i = 0; i < 8; ++i)
#pragma unroll
                for (int u = 0; u < 2; ++u) { const bool up = lane & 32; const float keep = up ? acc[u][i + 8] : acc[u][i], send = up ? acc[u][i] : acc[u][i + 8]; acc[u][i] = keep + __shfl_xor(send, 32); }
#pragma unroll
            for (int i = 0; i < 4; ++i)
#pragma unroll
                for (int u = 0; u < 2; ++u) { const bool up = lane & 16; const float keep = up ? acc[u][i + 4] : acc[u][i], send = up ? acc[u][i] : acc[u][i + 4]; acc[u][i] = keep + __shfl_xor(send, 16); }
#pragma unroll
            for (int i = 0; i < 2; ++i)
#pragma unroll
                for (int u = 0; u < 2; ++u) { const bool up = lane & 8; const float keep = up ? acc[u][i + 2] : acc[u][i], send = up ? acc[u][i] : acc[u][i + 2]; acc[u][i] = keep + __shfl_xor(send, 8); }
#pragma unroll
            for (int u = 0; u < 2; ++u) { const bool up = lane & 4; const float keep = up ? acc[u][1] : acc[u][0], send = up ? acc[u][0] : acc[u][1]; acc[u][0] = keep + __shfl_xor(send, 4); }
            float lg[2] = {acc[0][0], acc[1][0]};
#pragma unroll
            for (int o = 1; o <= 2; o <<= 1) { const float t0 = __shfl_xor(lg[0], o), t1 = __shfl_xor(lg[1], o); lg[0] += t0; lg[1] += t1; }
            float mx[2] = {lg[0], lg[1]};
#pragma unroll
            for (int o = 4; o <= 32; o <<= 1) { const float t0 = __shfl_xor(mx[0], o), t1 = __shfl_xor(mx[1], o); mx[0] = fmaxf(mx[0], t0); mx[1] = fmaxf(mx[1], t1); }
            const float ex[2] = {expf(lg[0] - mx[0]), expf(lg[1] - mx[1])}; float se[2] = {ex[0], ex[1]};
#pragma unroll
            for (int o = 4; o <= 32; o <<= 1) { const float t0 = __shfl_xor(se[0], o), t1 = __shfl_xor(se[1], o); se[0] += t0; se[1] += t1; }
            if ((lane & 3) == 0) { const int e = ((lane >> 5) & 1) * 8 + ((lane >> 4) & 1) * 4 + ((lane >> 3) & 1) * 2 + ((lane >> 2) & 1);
#pragma unroll
                for (int u = 0; u < 2; ++u) afft[(size_t)((mr[u] / SEQ) * 16 + e) * SEQ + (mr[u] % SEQ)] = ex[u] / se[u]; }
        }
        __syncthreads();
    }
    if constexpr (ST == ST_TOPK) {
        const float* afft = WSF(WS_AFF); int* idx = WSI(WS_IDX); float* gv = WSF(WS_GATEV); int* slot = WSI(WS_SLOT);
        int* hist = (int*)lds; int* ctl = hist + 256; int* scr = hist + 272;
        for (int z = bid; z < NZ; z += G) {
            const int e = z >> 1, b = z & 1; const float* list = afft + (size_t)(b * 16 + e) * SEQ;
            unsigned key[16];
#pragma unroll
            for (int j = 0; j < 16; j += 4) { const float4 x = *(const float4*)(list + tid * 16 + j); key[j] = __float_as_uint(x.x); key[j + 1] = __float_as_uint(x.y); key[j + 2] = __float_as_uint(x.z); key[j + 3] = __float_as_uint(x.w); }
            unsigned prefix = 0u; int need = CAP;
#pragma unroll 1
            for (int shift = 24; shift >= 0; shift -= 8) {
                __syncthreads();
                if (tid < 256) hist[tid] = 0;
                __syncthreads();
#pragma unroll
                for (int j = 0; j < 16; ++j) { const bool in = (shift == 24) || ((key[j] >> (shift + 8)) == (prefix >> (shift + 8))); if (in) atomicAdd(&hist[(key[j] >> shift) & 255u], 1); }
                __syncthreads();
                if (tid < 256) {
                    const int hc = hist[tid]; int inc = hc;
#pragma unroll
                    for (int o = 1; o < 64; o <<= 1) { const int y = __shfl_down(inc, o); if (lane + o < 64) inc += y; }
                    if (lane == 0) scr[wid] = inc;
                    __builtin_amdgcn_s_waitcnt(0xc07f); __builtin_amdgcn_wave_barrier();
                }
                __syncthreads();
                if (tid < 256) {
                    const int hc = hist[tid]; int inc = hc;
#pragma unroll
                    for (int o = 1; o < 64; o <<= 1) { const int y = __shfl_down(inc, o); if (lane + o < 64) inc += y; }
                    int ca = inc - hc;
#pragma unroll
                    for (int w = 1; w < 4; ++w) ca += (w > wid) ? scr[w] : 0;
                    if (ca < need && need <= ca + hc) { ctl[0] = tid; ctl[1] = need - ca; } }
                __syncthreads();
                prefix |= (unsigned)ctl[0] << shift; need = ctl[1];
            }
            int ceq = 0;
#pragma unroll
            for (int j = 0; j < 16; ++j) ceq += (key[j] == prefix) ? 1 : 0;
            int tot; const int beq = block_excl_scan(ceq, scr, tid, tot);
            int csel = 0, eqr = beq; unsigned selmask = 0u;
#pragma unroll
            for (int j = 0; j < 16; ++j) { bool sel = key[j] > prefix; if (key[j] == prefix) { sel = eqr < need; ++eqr; } if (sel) { selmask |= 1u << j; ++csel; } }
            int sl = block_excl_scan(csel, scr, tid, tot);
#pragma unroll
            for (int j = 0; j < 16; ++j) { const int trow = b * SEQ + tid * 16 + j;
                if ((selmask >> j) & 1u) { idx[z * CAP + sl] = trow; gv[z * CAP + sl] = __uint_as_float(key[j]); slot[(size_t)trow * 16 + e] = sl; ++sl; }
                else slot[(size_t)trow * 16 + e] = -1; }
        }
        __syncthreads();
    }
    if constexpr (ST == ST_GATHER) {
        const int* idx = WSI(WS_IDX); const bf16_t* hb = WSB(WS_HB); bf16_t* xe = WSB(WS_XE);
        const int nr = (NZ * CAP - gw + NGW - 1) / NGW; const int myi = (lane < nr) ? (idx[gw + lane * NGW] & (T - 1)) : 0;
        for (int k = 0; k < nr; k += 4) {
            const int k1 = (k + 1 < nr) ? k + 1 : k, k2 = (k + 2 < nr) ? k + 2 : k, k3 = (k + 3 < nr) ? k + 3 : k;
            const uint4* s0 = (const uint4*)(hb + (size_t)__shfl(myi, k) * DM); const uint4* s1 = (const uint4*)(hb + (size_t)__shfl(myi, k1) * DM);
            const uint4* s2 = (const uint4*)(hb + (size_t)__shfl(myi, k2) * DM); const uint4* s3 = (const uint4*)(hb + (size_t)__shfl(myi, k3) * DM);
            const uint4 x0 = s0[lane], y0 = s0[lane + 64], x1 = s1[lane], y1 = s1[lane + 64], x2 = s2[lane], y2 = s2[lane + 64], x3 = s3[lane], y3 = s3[lane + 64];
            { uint4* d = (uint4*)(xe + (size_t)(gw + k * NGW) * DM); d[lane] = x0; d[lane + 64] = y0; }
            if (k + 1 < nr) { uint4* d = (uint4*)(xe + (size_t)(gw + (k + 1) * NGW) * DM); d[lane] = x1; d[lane + 64] = y1; }
            if (k + 2 < nr) { uint4* d = (uint4*)(xe + (size_t)(gw + (k + 2) * NGW) * DM); d[lane] = x2; d[lane + 64] = y2; }
            if (k + 3 < nr) { uint4* d = (uint4*)(xe + (size_t)(gw + (k + 3) * NGW) * DM); d[lane] = x3; d[lane + 64] = y3; }
        }
    }
    if constexpr (ST == ST_EXP_G) {
        pg8::Gemm g{WSB(WS_HB8), WSB(WS_WGU_T), NZ * CAP, 16 * 4096, DM / 2, DM / 2, WSI(WS_IDX)};
        ExpertOrder1 S; S.init(G, bid);
        EpiSwiGLU E{WSB(WS_HID), DEXP};
        pg8::gemm_phase<EpiSwiGLU, ExpertOrder1, true, true, true, true>((PG8_LAS unsigned char*)lds, g, S, E);
    }
    if constexpr (ST == ST_EXP_D) {
        pg8::Gemm g{WSB(WS_HID), WSB(WS_WD_T), NZ * CAP, 16 * 1024, DEXP / 2, DEXP / 2};
        ExpertOrder2 S; S.init(G, bid);
        EpiRowScale E{WSB(WS_YE), DM, WSF(WS_GATEV)};
        pg8::gemm_phase<EpiRowScale, ExpertOrder2, true, true, false, true>((PG8_LAS unsigned char*)lds, g, S, E);
    }
    if constexpr (ST == ST_LN2) {
        const int* slot = WSI(WS_SLOT); const bf16_t* ye = WSB(WS_YE);
        for (int m0 = gw; m0 < T; m0 += 2 * NGW) {
            const int mr[2] = {m0, m0 + NGW};
            int sl[2]; unsigned long long mask[2]; float4 a[2][4];
#pragma unroll
            for (int u = 0; u < 2; ++u) { sl[u] = (lane < 16) ? slot[(size_t)mr[u] * 16 + lane] : -1; }
#pragma unroll
            for (int u = 0; u < 2; ++u) { const bf16_t* hr = WSB(WS_HB) + (size_t)mr[u] * DM;
#pragma unroll
                for (int j = 0; j < 4; ++j) { float x[4]; ld4bf(hr + 4 * (lane + 64 * j), x); a[u][j] = make_float4(ALPHA * x[0], ALPHA * x[1], ALPHA * x[2], ALPHA * x[3]); } }
            mask[0] = __ballot(sl[0] >= 0); mask[1] = __ballot(sl[1] >= 0);
            while (mask[0] | mask[1]) {
#pragma unroll
                for (int u = 0; u < 2; ++u) if (mask[u]) {
                    const int e = __builtin_ctzll(mask[u]); mask[u] &= mask[u] - 1;
                    const bf16_t* yr = ye + ((size_t)(e * 2 + mr[u] / SEQ) * CAP + __shfl(sl[u], e)) * DM;
#pragma unroll
                    for (int j = 0; j < 4; ++j) { float y[4]; ld4bf(yr + 4 * (lane + 64 * j), y); a[u][j].x += y[0]; a[u][j].y += y[1]; a[u][j].z += y[2]; a[u][j].w += y[3]; }
                }
            }
            if (l == 0) ln_core2<0>(a, LN2_G(l), LN2_B(l), nullptr, nullptr, WSB(WS_HB) + (size_t)mr[0] * DM, WSB(WS_HB) + (size_t)mr[1] * DM, lane);
            else ln_core2<2>(a, LN2_G(l), LN2_B(l), h + (size_t)mr[0] * DM, h + (size_t)mr[1] * DM, nullptr, nullptr, lane);
        }
    }
}


#define LAS __attribute__((address_space(3)))
#define XB_TMO      128
#define XB_XCNT(j)  (256  + 64 * (j))
#define XB_XSUB(j)  (1280 + 64 * (j))
#define XB_XGEN(j)  (2304 + 64 * (j))
#define XB_TOP      3328
#define XB_TOPGEN   3392
#define XCD_BAR_WORDS 3456
#define XB_SPIN_CAP (1u << 18)
__device__ __forceinline__ unsigned xb_ld(unsigned* p)              { return __hip_atomic_load(p, __ATOMIC_RELAXED, __HIP_MEMORY_SCOPE_AGENT); }
__device__ __forceinline__ unsigned xb_add(unsigned* p, unsigned v) { return __hip_atomic_fetch_add(p, v, __ATOMIC_RELAXED, __HIP_MEMORY_SCOPE_AGENT); }
__device__ __forceinline__ unsigned xb_xcc_id() { return (unsigned)__builtin_amdgcn_s_getreg((3 << 11) | 20) & 0xFu; }
#define XB_SPIN(cond, bar) do { unsigned _sp = 0; while (cond) { __builtin_amdgcn_s_sleep(1); \
    if ((++_sp & 255u) == 0u) { if (xb_ld(&(bar)[XB_TMO])) break; if (_sp > XB_SPIN_CAP) { atomicAdd(&(bar)[XB_TMO], 1u); break; } } } } while (0)
struct XcdBarrier { unsigned* bar; unsigned x; volatile LAS unsigned* st; };
__device__ __forceinline__ XcdBarrier xcd_barrier_post(unsigned* bar, volatile LAS unsigned* st) {
    XcdBarrier b; b.bar = bar; b.x = xb_xcc_id(); b.st = st;
    if (threadIdx.x == 0) (void)xb_add(&bar[XB_XCNT(b.x)], 1u);
    return b;
}
__device__ __forceinline__ void xcd_barrier_complete(unsigned* bar, unsigned x, unsigned& nloc, unsigned& nx) {
    const unsigned G = gridDim.x * gridDim.y * gridDim.z;
    unsigned sum, cnt, mine, sp = 0u;
    for (;;) {
        sum = 0u; cnt = 0u; mine = 0u;
#pragma unroll
        for (unsigned j = 0; j < 16; ++j) { const unsigned c = xb_ld(&bar[XB_XCNT(j)]); sum += c; cnt += (c > 0u) ? 1u : 0u; mine = (j == x) ? c : mine; }
        if (sum == G) break;
        __builtin_amdgcn_s_sleep(1);
        if ((++sp & 255u) == 0u) { if (xb_ld(&bar[XB_TMO])) break; if (sp > XB_SPIN_CAP) { atomicAdd(&bar[XB_TMO], 1u); break; } }
    }
    nloc = mine > 0u ? mine : 1u; nx = cnt > 0u ? cnt : 1u;
}
__device__ __forceinline__ void xcd_barrier(const XcdBarrier& b) {
    asm volatile("s_waitcnt vmcnt(0)" ::: "memory");
    __syncthreads();
    if (threadIdx.x == 0) {
        unsigned* bar = b.bar; asm volatile("" : "+s"(bar));
        unsigned bx = b.x; asm volatile("" : "+s"(bx));
        __builtin_amdgcn_s_waitcnt(0);
        unsigned nloc = b.st[0], nx = b.st[1];
        if (nloc == 0u) { xcd_barrier_complete(bar, bx, nloc, nx); b.st[0] = nloc; b.st[1] = nx; }
        const unsigned old = xb_add(&bar[XB_XSUB(bx)], 1u);
        const unsigned gen = old / nloc;
        if (old + 1u == (gen + 1u) * nloc) {
            __builtin_amdgcn_fence(__ATOMIC_RELEASE, "agent");
            asm volatile("s_waitcnt vmcnt(0)" ::: "memory");
            const unsigned og = xb_add(&bar[XB_TOP], 1u);
            const unsigned tg = og / nx;
            if (og + 1u == (tg + 1u) * nx) xb_add(&bar[XB_TOPGEN], 1u);
            else XB_SPIN(xb_ld(&bar[XB_TOPGEN]) == tg, bar);
            __builtin_amdgcn_fence(__ATOMIC_ACQUIRE, "agent");
            xb_add(&bar[XB_XGEN(bx)], 1u);
            asm volatile("s_waitcnt vmcnt(0)" ::: "memory");
        } else {
            XB_SPIN(xb_ld(&bar[XB_XGEN(bx)]) == gen, bar);
            __builtin_amdgcn_fence(__ATOMIC_ACQUIRE, "agent");
            asm volatile("s_waitcnt vmcnt(0)" ::: "memory");
        }
    }
    __syncthreads();
}
constexpr int MISC_OFF = 131072 + 320;
constexpr int CW_BAR = 4096;

__global__ void __launch_bounds__(NTHR) mega_fwd(Params p) {
    extern __shared__ __attribute__((aligned(16))) unsigned char lds_raw[];
    float* lds = (float*)lds_raw;
    volatile LAS unsigned* MISC = (volatile LAS unsigned*)((LAS unsigned char*)lds_raw + MISC_OFF);
    if (threadIdx.x < 32) MISC[threadIdx.x] = 0u;
    __syncthreads();
    unsigned char* ws_ = ((const KAS Params*)__builtin_amdgcn_kernarg_segment_ptr())->ws;
    XcdBarrier bar = xcd_barrier_post((unsigned*)(ws_ + WS_CTL) + CW_BAR, MISC + 8);
#define GB() xcd_barrier(bar)
    run_stage<ST_INIT>(0, lds); GB();
    for (int step = 0; step < 2 * 11; ++step) {
        const int l = step / 11, s = step % 11;
        switch (s) {
        case 0: run_stage<ST_PROJ>(l, lds); break;
        case 1: run_stage<ST_PREP>(l, lds); run_stage<ST_GLA1>(l, lds); break;
        case 2: run_stage<ST_SMALLGEMM>(l, lds); run_stage<ST_GLA2>(l, lds); break;
        case 3: run_stage<ST_ATTN>(l, lds); run_stage<ST_GLA3>(l, lds); break;
        case 4: run_stage<ST_MERGE_A>(l, lds); break;
        case 5: run_stage<ST_OUTP>(l, lds); break;
        case 6: run_stage<ST_LN1>(l, lds); break;
        case 7: run_stage<ST_TOPK>(l, lds); break;
        case 8: run_stage<ST_EXP_G>(l, lds); break;
        case 9: run_stage<ST_EXP_D>(l, lds); break;
        default: run_stage<ST_LN2>(l, lds); break;
        }
        if (step + 1 < 2 * 11) GB();
    }
#undef GB
}

template <int ST>
__global__ void __launch_bounds__(NTHR) k_stage(Params p, int l) {
    extern __shared__ __attribute__((aligned(16))) unsigned char lds_raw[];
    run_stage<ST>(l, (float*)lds_raw);
}

template <int ST> static void launch_stage(const Params& p, int l, int grid, hipStream_t stream) {
    static bool attr = false;
    if (!attr) { (void)hipFuncSetAttribute((const void*)k_stage<ST>, hipFuncAttributeMaxDynamicSharedMemorySize, LDS_BYTES); attr = true; }
    hipLaunchKernelGGL(k_stage<ST>, dim3(grid), dim3(NTHR), LDS_BYTES, stream, p, l);
}

extern "C" void kernel_launch(void* const* d_in, const int* in_sizes, int n_in, void* d_out, int out_size, void* d_ws, size_t ws_size, hipStream_t stream) {
    if (n_in != 27 || out_size != T * DM || ws_size < WS_END) {
        fprintf(stderr, "kernel_launch: unexpected shapes: n_in %d out %d ws %zu (need >= %zu)\n", n_in, out_size, ws_size, (size_t)WS_END);
        return;
    }
    Params p{};
    for (int i = 0; i < 27; ++i) p.in[i] = (const float*)d_in[i];
    p.pos = (const int*)d_in[1]; p.out = (float*)d_out; p.ws = (unsigned char*)d_ws;
    const int grid = 256;
#if MEGA
    static bool attr = false;
    if (!attr) { (void)hipFuncSetAttribute((const void*)mega_fwd, hipFuncAttributeMaxDynamicSharedMemorySize, LDS_BYTES); attr = true; }
    (void)hipMemsetAsync((char*)d_ws + WS_CTL, 0, 65536, stream);
    hipLaunchKernelGGL(mega_fwd, dim3(grid), dim3(NTHR), LDS_BYTES, stream, p);
#else
    launch_stage<ST_INIT>(p, 0, grid, stream);
    for (int l = 0; l < 2; ++l) {
        launch_stage<ST_PROJ>(p, l, grid, stream);
        launch_stage<ST_PREP>(p, l, grid, stream);
        launch_stage<ST_SMALLGEMM>(p, l, grid, stream);
        launch_stage<ST_ROPE>(p, l, grid, stream);
        launch_stage<ST_ATTN>(p, l, grid, stream);
        launch_stage<ST_GLAREC>(p, l, grid, stream);
        launch_stage<ST_GLAFIN>(p, l, grid, stream);
        launch_stage<ST_MERGE_A>(p, l, grid, stream);
        launch_stage<ST_MERGE_B>(p, l, grid, stream);
        launch_stage<ST_MERGE_C>(p, l, grid, stream);
        launch_stage<ST_OUTP>(p, l, grid, stream);
        launch_stage<ST_LN1>(p, l, grid, stream);
        launch_stage<ST_TOPK>(p, l, grid, stream);
        launch_stage<ST_EXP_G>(p, l, grid, stream);
        launch_stage<ST_EXP_U>(p, l, grid, stream);
        launch_stage<ST_EXP_D>(p, l, grid, stream);
        launch_stage<ST_LN2>(p, l, grid, stream);
    }
#endif
}
```

```cpp
#include <hip/hip_runtime.h>
#include <cstdio>
#include <cstdint>

#ifndef MEGA
#define MEGA 1
#endif

constexpr int NB = 2, SEQ = 8192, T = NB * SEQ, DM = 1024, DIN = 5824, DINP = 5888;
constexpr int OFF_GATE = 0, OFF_POOL = 3072, OFF_CQ = 3072 + 512, OFF_CKV = 3072 + 896, OFF_KR = 3072 + 1152, OFF_GQ = 3072 + 1184, OFF_GK = 3072 + 1440, OFF_GV = 3072 + 1696, OFF_GR = 3072 + 2208, OFF_GDEC = 3072 + 2720;
constexpr int NE = 16, CAP = 1024, DEXP = 2048, NZ = NB * NE;
constexpr float ALPHA = 1.4142135623730951f;
constexpr float LN_EPS = 1e-5f, RMS_EPS = 1e-6f;
constexpr int NTHR = 512, LDS_BYTES = 147456;

constexpr size_t MiB = 1u << 20;
constexpr size_t WS_CTL = 0;
constexpr size_t WS_ROPE = 1 * MiB;
constexpr size_t WS_AFF = 3 * MiB;
constexpr size_t WS_SLOT = 4 * MiB;
constexpr size_t WS_IDX = 5 * MiB;
constexpr size_t WS_GATEV = 5 * MiB + 256 * 1024;
constexpr size_t WS_WIN_T = 8 * MiB;
constexpr size_t WS_WSMALL = 31 * MiB;
constexpr size_t WSM_UQ = 0, WSM_UKV = 1 * MiB, WSM_MRG = 2 * MiB, WSM_OUT = 5 * MiB, WSM_STRIDE = 7 * MiB;
constexpr size_t WS_RQ = 6 * MiB;
constexpr size_t WS_HB = 958 * MiB;
constexpr size_t WS_WGU_T = 76 * MiB;
constexpr size_t WS_WD_T = 204 * MiB;
constexpr size_t WS_PROJB = 268 * MiB;
constexpr size_t WS_XE = 268 * MiB;
constexpr size_t WS_HID = 332 * MiB;
constexpr size_t WS_YE = 460 * MiB;
constexpr size_t WS_BR = 452 * MiB;
constexpr size_t WS_HB8 = 500 * MiB;
constexpr size_t WS_QB = 556 * MiB;
constexpr size_t WS_KB = 580 * MiB;
constexpr size_t WS_VB = 604 * MiB;
constexpr size_t WS_KVT = 702 * MiB;
constexpr size_t WS_ST = 766 * MiB;
constexpr size_t WS_DEC = 798 * MiB;
constexpr size_t WS_MERGEDB = 830 * MiB;
constexpr size_t WS_TMP = 894 * MiB;
constexpr size_t WS_END = 990 * MiB;
static_assert(WS_YE + 64 * MiB <= WS_QB, "overlay map");

namespace pg8 {
#define PG8_LAS __attribute__((address_space(3)))
typedef unsigned short bf16_t;
typedef short bf16x8 __attribute__((ext_vector_type(8)));
typedef float f32x4 __attribute__((ext_vector_type(4)));
typedef unsigned u32x4 __attribute__((ext_vector_type(4)));
constexpr int BM = 256, BK = 64, HALF = 128, HTB = HALF * BK * 2  , STAGE_BYTES = 8 * HTB, NXCD = 8, WGM = 8;

__host__ __device__ __forceinline__ int lds_byte(int r, int c) { const int st = (r >> 4) * 2 + (c >> 5), rr = r & 15, cc = c & 31, ob = rr * 64 + cc * 2; return st * 1024 + (ob ^ (((ob >> 9) & 1) << 5)); }
__host__ __device__ __forceinline__ void stage_rc(int b, int& R, int& C) { const int st = b / 1024, sb = b % 1024, swz = sb ^ (((sb >> 9) & 1) << 5); R = (st >> 1) * 16 + swz / 64; C = (st & 1) * 32 + (swz % 64) / 2; }
__host__ __device__ __forceinline__ int perm32(int rho) { const int n = rho >> 4, i = rho & 15; return 8 * (i >> 2) + 4 * n + (i & 3); }

struct Unit { int pm, pn; };
struct Gemm { const bf16_t* A; const bf16_t* Bt; int M, N, K, lda; const int* ridx; };

struct StaticOrder {
    int nM, nN, nwg, G, c;
    __host__ __device__ void init(int M, int N, int G_, int c_) { nM = M / BM; nN = N / BM; nwg = nM * nN; G = G_; c = c_; }
    __host__ __device__ bool next(int i, Unit& u) const {
        const long L = (long)i * G + c; if (L >= nwg) return false;
        int wgid = (int)L; { const int q = nwg / NXCD, r = nwg % NXCD, xcd = wgid % NXCD, off = wgid / NXCD; wgid = (xcd < r ? xcd * (q + 1) : r * (q + 1) + (xcd - r) * q) + off; }
        const int nig = WGM * nN, gid = wgid / nig, fm = gid * WGM, gsz = (nM - fm) < WGM ? (nM - fm) : WGM;
        u.pm = fm + ((wgid % nig) % gsz); u.pn = (wgid % nig) / gsz; return true;
    }
    __device__ __forceinline__ void a_ready(const Unit&) const {}
    __device__ __forceinline__ void done(const Unit&) const {}
};

__device__ __forceinline__ unsigned cvt_pk_bf16(float lo, float hi) { unsigned r; asm volatile("v_cvt_pk_bf16_f32 %0, %1, %2" : "=v"(r) : "v"(lo), "v"(hi)); return r; }
typedef float f32x2 __attribute__((ext_vector_type(2)));
__device__ __forceinline__ f32x2 gelu_pk(f32x2 v) {
    const f32x2 av = __builtin_elementwise_abs(v), d = av * 0.2316418882f + 1.0f;
    f32x2 t; t.x = __builtin_amdgcn_rcpf(d.x); t.y = __builtin_amdgcn_rcpf(d.y);
    f32x2 q = t * 0.5307027145f + (-0.7265760135f); q = q * t + 0.7107068705f; q = q * t + (-0.142248368f); q = q * t + 0.127414796f; q = q * t;
    const f32x2 s = (v * v) * (-0.72134752044f);
    f32x2 e; e.x = __builtin_amdgcn_exp2f(s.x); e.y = __builtin_amdgcn_exp2f(s.y);
    const f32x2 m = v * (q * e), r = v - m;
    f32x2 o; o.x = v.x < 0.f ? m.x : r.x; o.y = v.y < 0.f ? m.y : r.y; return o;
}

template <int ACT  > struct EpiBf16 {
    static constexpr bool PERM = true, AFTER_DRAIN = false; static constexpr int SEG = 0; static_assert(ACT == 0 || ACT == 1, "EpiBf16: ACT is 0 (none) or 1 (gelu_pk)");
    bf16_t* O; int ldc; const float* bias; int split_cols; size_t split_stride; float scale0;
    __device__ __forceinline__ void operator()(const f32x4 (&acc)[2][2][4][2], const Unit& u, int wr, int wc, int fr, int fq) const {
        const int row0 = u.pm * BM + wr * 64 + fr; int colt = u.pn * BM; bf16_t* base = O;
        float sc = 1.f; if (split_cols) { const int t = colt / split_cols; base += (size_t)t * split_stride; colt -= t * split_cols; if (t == 0) sc = scale0; }
        const int col0 = colt + wc * 32 + 8 * fq, bcol0 = u.pn * BM + wc * 32 + 8 * fq;
        f32x4 bv[2][2];
#pragma unroll
        for (int bj = 0; bj < 2; ++bj)
#pragma unroll
            for (int n = 0; n < 2; ++n) bv[bj][n] = bias ? *(const f32x4*)(bias + bcol0 + bj * HALF + 4 * n) : (f32x4){0.f, 0.f, 0.f, 0.f};
#pragma unroll
        for (int ai = 0; ai < 2; ++ai)
#pragma unroll
            for (int m = 0; m < 4; ++m) { bf16_t* rowp = base + (size_t)(row0 + ai * HALF + m * 16) * ldc + col0;
#pragma unroll
                for (int bj = 0; bj < 2; ++bj) { f32x4 v0 = acc[ai][bj][m][0] + bv[bj][0], v1 = acc[ai][bj][m][1] + bv[bj][1];
                    if (ACT == 1) { f32x2 a = gelu_pk((f32x2){v0[0], v0[1]}), b = gelu_pk((f32x2){v0[2], v0[3]}), c = gelu_pk((f32x2){v1[0], v1[1]}), d = gelu_pk((f32x2){v1[2], v1[3]});
                        v0 = (f32x4){a.x, a.y, b.x, b.y}; v1 = (f32x4){c.x, c.y, d.x, d.y}; }
                    v0 = v0 * sc; v1 = v1 * sc; u32x4 w; w.x = cvt_pk_bf16(v0[0], v0[1]); w.y = cvt_pk_bf16(v0[2], v0[3]); w.z = cvt_pk_bf16(v1[0], v1[1]); w.w = cvt_pk_bf16(v1[2], v1[3]);
                    *(u32x4*)(rowp + bj * HALF) = w; } }
    }
};

struct PanelStats {
    unsigned* xbuf;
    unsigned* cnt;
    unsigned* tmo;
    int ntn; float eps;
    unsigned code;
    __device__ __forceinline__ bool run(const f32x4 (&v)[2][2][4][2], const Unit& u, int wr, int wc, int fr, int fq, PG8_LAS unsigned char* lds, int wid, int lane) const {
        typedef float f32x2v __attribute__((ext_vector_type(2)));
        PG8_LAS f32x2v* P = (PG8_LAS f32x2v*)lds;
        PG8_LAS f32x2v* S = (PG8_LAS f32x2v*)(lds + 8192);
        PG8_LAS unsigned* flag = (PG8_LAS unsigned*)(lds + 8192 + 2048);
#pragma unroll
        for (int ai = 0; ai < 2; ++ai)
#pragma unroll
            for (int m = 0; m < 4; ++m) {
                float s = 0.f;
#pragma unroll
                for (int bj = 0; bj < 2; ++bj)
#pragma unroll
                    for (int n = 0; n < 2; ++n) { const f32x4 x = v[ai][bj][m][n]; s += (x[0] + x[1]) + (x[2] + x[3]); }
                s += __shfl_xor(s, 16); s += __shfl_xor(s, 32);
                const float mw = s * (1.0f / 64.0f); float q = 0.f;
#pragma unroll
                for (int bj = 0; bj < 2; ++bj)
#pragma unroll
                    for (int n = 0; n < 2; ++n) { const f32x4 d = v[ai][bj][m][n] - mw; q += (d[0] * d[0] + d[1] * d[1]) + (d[2] * d[2] + d[3] * d[3]); }
                q += __shfl_xor(q, 16); q += __shfl_xor(q, 32);
                if (fq == 0) P[(ai * HALF + wr * 64 + m * 16 + fr) * 4 + wc] = (f32x2v){mw, q};
            }
        asm volatile("s_waitcnt lgkmcnt(0)" ::: "memory"); __builtin_amdgcn_s_barrier(); asm volatile("" ::: "memory");
#if defined(BROKEN_EXCHANGE_NO_WAIT)
#warning BROKEN CONTROL BUILD: the row-statistics exchange does not wait; results are wrong by design
        if (blockIdx.x >= 64) { const long long t0_ = clock64(); while (clock64() - t0_ < 60000) __builtin_amdgcn_s_sleep(8); }
#endif
        const int row = wid * 32 + (lane & 31);
        if (lane < 32) {
            const f32x2v a = P[row * 4 + 0], b = P[row * 4 + 1], c = P[row * 4 + 2], d = P[row * 4 + 3];
            const float mt = (a.x + b.x + c.x + d.x) * 0.25f;
            const float da = a.x - mt, db = b.x - mt, dc = c.x - mt, dd = d.x - mt;
            const float m2 = (a.y + b.y) + (c.y + d.y) + 64.0f * ((da * da + db * db) + (dc * dc + dd * dd));
            unsigned long long* slot = (unsigned long long*)xbuf + ((size_t)(u.pm * BM + row) * 4 + u.pn);
            __hip_atomic_store(slot, ((unsigned long long)__float_as_uint(m2) << 32) | __float_as_uint(mt), __ATOMIC_RELAXED, __HIP_MEMORY_SCOPE_AGENT);
        }
        asm volatile("s_waitcnt vmcnt(0)" ::: "memory");
        if (lane == 0) __hip_atomic_fetch_add(cnt + 64 * u.pm, 1u, __ATOMIC_RELAXED, __HIP_MEMORY_SCOPE_AGENT);
        if (wid == 0) {
            bool dead = false; const unsigned long long t0 = __builtin_amdgcn_s_memrealtime(); const unsigned want = 8u * (unsigned)ntn;
            for (;;) {
#if defined(BROKEN_EXCHANGE_NO_WAIT)
                break;
#endif
                if ((unsigned)__builtin_amdgcn_readfirstlane(__hip_atomic_load(cnt + 64 * u.pm, __ATOMIC_RELAXED, __HIP_MEMORY_SCOPE_AGENT)) >= want) break;
                if (__builtin_amdgcn_s_memrealtime() - t0 > 2000000ull) {
                    if (lane == 0) { unsigned expect = 0u; __hip_atomic_compare_exchange_strong(tmo + 1, &expect, code | (unsigned)(u.pm & 0xff), __ATOMIC_RELAXED, __ATOMIC_RELAXED, __HIP_MEMORY_SCOPE_AGENT);
                                     __hip_atomic_store(tmo, 1u, __ATOMIC_RELAXED, __HIP_MEMORY_SCOPE_AGENT); }
                    dead = true; break; }
                __builtin_amdgcn_s_sleep(2);
            }
            __builtin_amdgcn_fence(__ATOMIC_ACQUIRE, "agent");
            if (lane == 0) flag[0] = dead ? 1u : 0u;
        }
        asm volatile("s_waitcnt vmcnt(0) lgkmcnt(0)" ::: "memory"); __builtin_amdgcn_s_barrier(); asm volatile("" ::: "memory");
        const bool bad = flag[0] != 0u;
        if (lane < 32) {
            const unsigned long long* slot = (const unsigned long long*)xbuf + (size_t)(u.pm * BM + row) * 4; float mt[4], m2[4]; float ms = 0.f;
#pragma unroll
            for (int t = 0; t < 4; ++t) { if (t < ntn) { const unsigned long long w = __hip_atomic_load(slot + t, __ATOMIC_RELAXED, __HIP_MEMORY_SCOPE_AGENT); mt[t] = __uint_as_float((unsigned)w); m2[t] = __uint_as_float((unsigned)(w >> 32)); } else { mt[t] = 0.f; m2[t] = 0.f; } ms += mt[t]; }
            const float mean = ms / (float)ntn; float q = 0.f;
#pragma unroll
            for (int t = 0; t < 4; ++t) if (t < ntn) { const float dm = mt[t] - mean; q += m2[t] + 256.0f * dm * dm; }
            S[row] = (f32x2v){mean, 1.0f / sqrtf(q / (256.0f * (float)ntn) + eps)};
        }
        asm volatile("s_waitcnt lgkmcnt(0)" ::: "memory"); __builtin_amdgcn_s_barrier(); asm volatile("" ::: "memory");
        return bad;
    }
};
struct EpiLnRes {
    static constexpr bool PERM = false, AFTER_DRAIN = true; static constexpr int SEG = 0;
    const float* base; float* out; int ldc; const float* bias; PanelStats st; unsigned poison;
    __device__ __forceinline__ void fused(f32x4 (&acc)[2][2][4][2], const Unit& u, int wr, int wc, int fr, int fq, PG8_LAS unsigned char* lds, int wid, int lane) const {
        typedef float f32x2v __attribute__((ext_vector_type(2)));
        const PG8_LAS f32x2v* S = (const PG8_LAS f32x2v*)(lds + 8192);
        const int col0 = u.pn * BM + wc * 32 + 4 * fq;
#pragma unroll
        for (int bj = 0; bj < 2; ++bj)
#pragma unroll
            for (int n = 0; n < 2; ++n) { const f32x4 bv = bias ? *(const f32x4*)(bias + col0 + bj * HALF + n * 16) : (f32x4){0.f, 0.f, 0.f, 0.f};
#pragma unroll
                for (int ai = 0; ai < 2; ++ai)
#pragma unroll
                    for (int m = 0; m < 4; ++m) acc[ai][bj][m][n] += bv; }
        f32x4 pre[4][2][2];
#pragma unroll
        for (int m = 0; m < 4; ++m) { const size_t off = (size_t)(u.pm * BM + wr * 64 + m * 16 + fr) * ldc + col0;
#pragma unroll
            for (int bj = 0; bj < 2; ++bj)
#pragma unroll
                for (int n = 0; n < 2; ++n) pre[m][bj][n] = *(const f32x4*)(base + off + bj * HALF + n * 16); }
        const bool bad = st.run(acc, u, wr, wc, fr, fq, lds, wid, lane) || poison != 0u;
        const float qnan = __builtin_nanf("");
#pragma unroll
        for (int ai = 0; ai < 2; ++ai)
#pragma unroll
            for (int m = 0; m < 4; ++m) { const int r = ai * HALF + wr * 64 + m * 16 + fr; const f32x2v sr = S[r]; const size_t off = (size_t)(u.pm * BM + r) * ldc + col0;
#pragma unroll
                for (int bj = 0; bj < 2; ++bj)
#pragma unroll
                    for (int n = 0; n < 2; ++n) { const f32x4 bs = ai == 0 ? pre[m][bj][n] : *(const f32x4*)(base + off + bj * HALF + n * 16); f32x4 o = bs + (acc[ai][bj][m][n] - sr.x) * sr.y;
                        if (bad) o = (f32x4){qnan, qnan, qnan, qnan}; *(f32x4*)(out + off + bj * HALF + n * 16) = o; }
                if (m & 1) asm volatile("" ::: "memory"); }
    }
};
struct EpiLnResLn {
    static constexpr bool PERM = false, AFTER_DRAIN = true; static constexpr int SEG = 0;
    const float* base; float* out; bf16_t* xn; int ldc; const float* bias; PanelStats st1, st2; unsigned poison;
    __device__ __forceinline__ void fused(f32x4 (&acc)[2][2][4][2], const Unit& u, int wr, int wc, int fr, int fq, PG8_LAS unsigned char* lds, int wid, int lane) const {
        typedef float f32x2v __attribute__((ext_vector_type(2))); typedef unsigned u32x2v __attribute__((ext_vector_type(2)));
        const PG8_LAS f32x2v* S = (const PG8_LAS f32x2v*)(lds + 8192);
        const int col0 = u.pn * BM + wc * 32 + 4 * fq;
#pragma unroll
        for (int bj = 0; bj < 2; ++bj)
#pragma unroll
            for (int n = 0; n < 2; ++n) { const f32x4 bv = bias ? *(const f32x4*)(bias + col0 + bj * HALF + n * 16) : (f32x4){0.f, 0.f, 0.f, 0.f};
#pragma unroll
                for (int ai = 0; ai < 2; ++ai)
#pragma unroll
                    for (int m = 0; m < 4; ++m) acc[ai][bj][m][n] += bv; }
        bool bad = st1.run(acc, u, wr, wc, fr, fq, lds, wid, lane) || poison != 0u;
        const float qnan = __builtin_nanf("");
#pragma unroll
        for (int ai = 0; ai < 2; ++ai)
#pragma unroll
            for (int m = 0; m < 4; ++m) { const int r = ai * HALF + wr * 64 + m * 16 + fr; const f32x2v sr = S[r]; const size_t off = (size_t)(u.pm * BM + r) * ldc + col0;
#pragma unroll
                for (int bj = 0; bj < 2; ++bj)
#pragma unroll
                    for (int n = 0; n < 2; ++n) { const f32x4 bs = *(const f32x4*)(base + off + bj * HALF + n * 16); acc[ai][bj][m][n] = bs + (acc[ai][bj][m][n] - sr.x) * sr.y; }
                asm volatile("" : "+v"(acc[ai][0][m][0]), "+v"(acc[ai][0][m][1]), "+v"(acc[ai][1][m][0]), "+v"(acc[ai][1][m][1]));
                if (m & 1) asm volatile("" ::: "memory"); }
        const bool bad1 = bad;
        bad = st2.run(acc, u, wr, wc, fr, fq, lds, wid, lane) || bad;
#pragma unroll
        for (int ai = 0; ai < 2; ++ai)
#pragma unroll
            for (int m = 0; m < 4; ++m) { const int r = ai * HALF + wr * 64 + m * 16 + fr; const f32x2v sr = S[r]; const size_t off = (size_t)(u.pm * BM + r) * ldc + col0;
#pragma unroll
                for (int bj = 0; bj < 2; ++bj)
#pragma unroll
                    for (int n = 0; n < 2; ++n) { const f32x4 x1 = acc[ai][bj][m][n]; *(f32x4*)(out + off + bj * HALF + n * 16) = bad1 ? (f32x4){qnan, qnan, qnan, qnan} : x1;
                        const f32x4 o = (x1 - sr.x) * sr.y; u32x2v w; w.x = cvt_pk_bf16(o[0], o[1]); w.y = cvt_pk_bf16(o[2], o[3]);
                        if (bad) { w.x = 0x7fc07fc0u; w.y = 0x7fc07fc0u; } *(u32x2v*)(xn + off + bj * HALF + n * 16) = w; }
                asm volatile("" ::: "memory"); }
    }
};

template <class Epi, class Sched, bool ALIGN_EPI = false, bool SP2 = false, bool GATHER = false, bool FP8 = false>
__device__ __forceinline__ void gemm_phase(PG8_LAS unsigned char* lds, const Gemm g, const Sched& S, const Epi& E) {
    int tid_ = threadIdx.x; asm volatile("" : "+v"(tid_));
    const int tid = tid_, wid = __builtin_amdgcn_readfirstlane(tid >> 6), lane = tid & 63, wr = wid >> 2, wc = wid & 3, fr = lane & 15, fq = lane >> 4;
    int K_ = g.K; asm volatile("" : "+s"(K_));
    const int K = K_, nt = K / BK;
    unsigned voffA[2], voffB[2];
#pragma unroll
    for (int i = 0; i < 2; ++i) { int R, C; stage_rc(tid * 16 + i * 8192, R, C); const int Rb = Epi::PERM ? ((R & ~31) + perm32(R & 31)) : R;
        voffA[i] = (unsigned)(R * g.lda + C) * 2u; voffB[i] = (unsigned)(Rb * K + C) * 2u; }
    const size_t kstep = (size_t)(BK * 2);
    static_assert(!GATHER || SP2, "GATHER is implemented for the SP2 loop");
    const size_t hstepB = (size_t)HALF * K * 2, hstepA = GATHER ? 0 : (size_t)HALF * g.lda * 2;
    const size_t tstepB = 2 * hstepB, tstepA = GATHER ? 0 : 2 * hstepA;
    const unsigned ldsw = (unsigned)wid * 1024u;
    const int aoffk[2] = {lds_byte(wr * 64 + fr, FP8 ? 16 * fq : 8 * fq), lds_byte(wr * 64 + fr, FP8 ? 16 * fq + 8 : 8 * fq + 32)};
    const int boffk[2] = {lds_byte(wc * 32 + fr, FP8 ? 16 * fq : 8 * fq), lds_byte(wc * 32 + fr, FP8 ? 16 * fq + 8 : 8 * fq + 32)};
#define PG8_SA(b, h) (((b) * 2 + (h)) * HTB)
#define PG8_SB(b, h) ((4 + (b) * 2 + (h)) * HTB)
#define PG8_STAGE(bufoff, gbase, voff) do { _Pragma("unroll") for (int _i = 0; _i < 2; ++_i) \
        __builtin_amdgcn_global_load_lds((const unsigned*)((const char*)(gbase) + (voff)[_i]), (PG8_LAS unsigned*)(lds + (bufoff) + ldsw + _i * 8192), 16, 0, 0); } while (0)
    typedef int i32x4_ __attribute__((ext_vector_type(4))); typedef int i32x8_ __attribute__((ext_vector_type(8)));
#define PG8_LD16(off) (*(const PG8_LAS i32x4_*)(lds + (off)))
#define PG8_LDA(dst, b, h) do { _Pragma("unroll") for (int m = 0; m < 4; ++m) { \
        if constexpr (FP8) dst##8[m] = *(const PG8_LAS i32x8_*)(lds + PG8_SA(b, h) + aoffk[0] + m * 2048);     \
        else { _Pragma("unroll") for (int k = 0; k < 2; ++k) dst[m][k] = *(const PG8_LAS bf16x8*)(lds + PG8_SA(b, h) + aoffk[k] + m * 2048); } } } while (0)
#define PG8_LDB(dst, b, h) do { _Pragma("unroll") for (int n = 0; n < 2; ++n) { \
        if constexpr (FP8) dst##8[n] = *(const PG8_LAS i32x8_*)(lds + PG8_SB(b, h) + boffk[0] + n * 2048); \
        else { _Pragma("unroll") for (int k = 0; k < 2; ++k) dst[n][k] = *(const PG8_LAS bf16x8*)(lds + PG8_SB(b, h) + boffk[k] + n * 2048); } } } while (0)
#define PG8_MMA(ai, bj, At, Bt) do { __builtin_amdgcn_s_setprio(1); _Pragma("unroll") for (int m = 0; m < 4; ++m) _Pragma("unroll") for (int n = 0; n < 2; ++n) { \
        if constexpr (FP8) asm volatile("s_nop 1\n\tv_mfma_scale_f32_16x16x128_f8f6f4 %0, %1, %2, %0, %3, %3 op_sel_hi:[0,0,0]" : "+v"(acc[ai][bj][m][n]) : "v"(Bt##8[n]), "v"(At##8[m]), "v"(sc1_));     \
        else { _Pragma("unroll") for (int k = 0; k < 2; ++k) acc[ai][bj][m][n] = __builtin_amdgcn_mfma_f32_16x16x32_bf16(Bt[n][k], At[m][k], acc[ai][bj][m][n], 0, 0, 0); } } \
        __builtin_amdgcn_s_setprio(0); } while (0)
#define PG8_WAIT_V(n) asm volatile("s_waitcnt vmcnt(" #n ")" ::: "memory")
#define PG8_WAIT_L(n) asm volatile("s_waitcnt lgkmcnt(" #n ")" ::: "memory")
#define PG8_BAR __builtin_amdgcn_s_barrier()
#define PG8_SCHED __builtin_amdgcn_sched_barrier(0)
    Unit cur, nxt; int ui = 0;
    if (!S.next(0, cur)) return;
    unsigned vC0[2] = {voffA[0], voffA[1]}, vC1[2] = {voffA[0], voffA[1]}, vN0[2] = {voffA[0], voffA[1]}, vN1[2] = {voffA[0], voffA[1]};
    int gR[2], gC[2];
#pragma unroll
    for (int i = 0; i < 2; ++i) { stage_rc(tid * 16 + i * 8192, gR[i], gC[i]); }
    if constexpr (GATHER) {
#pragma unroll
        for (int i = 0; i < 2; ++i) { vC0[i] = (unsigned)(g.ridx[cur.pm * 256 + gR[i]] * g.lda + gC[i]) * 2u; vC1[i] = (unsigned)(g.ridx[cur.pm * 256 + 128 + gR[i]] * g.lda + gC[i]) * 2u; }
    }
    f32x4 acc[2][2][4][2];
#pragma unroll
    for (int a = 0; a < 2; ++a)
#pragma unroll
        for (int b = 0; b < 2; ++b)
#pragma unroll
            for (int m = 0; m < 4; ++m)
#pragma unroll
                for (int n = 0; n < 2; ++n) acc[a][b][m][n] = (f32x4){0.f, 0.f, 0.f, 0.f};
    const int sc1_ = 0x7f7f7f7f;
    bf16x8 At[4][2], B0[2][2], B1[2][2]; i32x8_ At8[4], B08[2], B18[2];
    const char* cA = (const char*)g.A + (size_t)cur.pm * tstepA; const char* cB = (const char*)g.Bt + (size_t)cur.pn * tstepB;
    S.a_ready(cur);
    if constexpr (SP2) {
        PG8_STAGE(PG8_SB(0, 0), cB, voffB); PG8_STAGE(PG8_SB(0, 1), cB + hstepB, voffB); PG8_STAGE(PG8_SA(0, 0), cA, vC0); PG8_STAGE(PG8_SA(0, 1), cA + hstepA, vC1);
        if (wr == 1) PG8_BAR;
        PG8_WAIT_V(2); PG8_BAR;
        PG8_STAGE(PG8_SB(1, 0), cB + kstep, voffB); PG8_STAGE(PG8_SA(1, 0), cA + kstep, vC0); PG8_STAGE(PG8_SB(1, 1), cB + hstepB + kstep, voffB);
        PG8_WAIT_V(6); PG8_BAR;
    } else {
        PG8_STAGE(PG8_SB(0, 0), cB, voffB); PG8_STAGE(PG8_SA(0, 0), cA, voffA); PG8_STAGE(PG8_SB(0, 1), cB + hstepB, voffB); PG8_STAGE(PG8_SA(0, 1), cA + hstepA, voffA);
        if (wr == 1) PG8_BAR;
        PG8_WAIT_V(4); PG8_BAR;
        PG8_STAGE(PG8_SB(1, 0), cB + kstep, voffB); PG8_STAGE(PG8_SA(1, 0), cA + kstep, voffA); PG8_STAGE(PG8_SB(1, 1), cB + hstepB + kstep, voffB);
        PG8_WAIT_V(6); PG8_BAR;
    }
    for (;;) {
        const bool has_next = S.next(ui + 1, nxt);
        int gi0[2] = {0, 0}, gi1[2] = {0, 0};
        if constexpr (GATHER) { if (has_next) {
#pragma unroll
            for (int i = 0; i < 2; ++i) { gi0[i] = g.ridx[nxt.pm * 256 + gR[i]]; gi1[i] = g.ridx[nxt.pm * 256 + 128 + gR[i]]; } } }
        const char* nA = has_next ? (const char*)g.A + (size_t)nxt.pm * tstepA : cA; const char* nB = has_next ? (const char*)g.Bt + (size_t)nxt.pn * tstepB : cB;
        for (int t = 0; t < nt; t += 2) {
            const bool last = (t == nt - 2);
            const char* a1 = cA + (size_t)(t + 1) * kstep;
            const char* a2 = last ? nA : cA + (size_t)(t + 2) * kstep; const char* b2 = last ? nB : cB + (size_t)(t + 2) * kstep;
            const char* a3 = a2 + kstep; const char* b3 = b2 + kstep;
            if (last && has_next) S.a_ready(nxt);
            unsigned v20[2] = {vC0[0], vC0[1]}, v21[2] = {vC1[0], vC1[1]};
            if constexpr (GATHER) { if (last && has_next) {
#pragma unroll
                for (int i = 0; i < 2; ++i) { vN0[i] = (unsigned)(gi0[i] * g.lda + gC[i]) * 2u; vN1[i] = (unsigned)(gi1[i] * g.lda + gC[i]) * 2u; v20[i] = vN0[i]; v21[i] = vN1[i]; } } }
            if constexpr (SP2) {
            PG8_LDB(B0, 0, 0); PG8_LDB(B1, 0, 1); PG8_SCHED; PG8_LDA(At, 0, 0); PG8_STAGE(PG8_SA(1, 1), a1 + hstepA, vC1);
            PG8_WAIT_V(8); PG8_WAIT_L(0); PG8_BAR; PG8_MMA(0, 0, At, B0); PG8_MMA(0, 1, At, B1); PG8_BAR; PG8_SCHED;
            PG8_LDA(At, 0, 1); PG8_STAGE(PG8_SB(0, 0), b2, voffB); PG8_STAGE(PG8_SB(0, 1), b2 + hstepB, voffB); PG8_STAGE(PG8_SA(0, 0), a2, v20);
            PG8_WAIT_V(8); PG8_WAIT_L(0); PG8_BAR; PG8_MMA(1, 0, At, B0); PG8_MMA(1, 1, At, B1); PG8_BAR; PG8_SCHED;
            PG8_LDB(B0, 1, 0); PG8_LDB(B1, 1, 1); PG8_SCHED; PG8_LDA(At, 1, 0); PG8_STAGE(PG8_SA(0, 1), a2 + hstepA, v21);
            PG8_WAIT_V(8); PG8_WAIT_L(0); PG8_BAR; PG8_MMA(0, 0, At, B0); PG8_MMA(0, 1, At, B1); PG8_BAR; PG8_SCHED;
            PG8_LDA(At, 1, 1); PG8_STAGE(PG8_SB(1, 0), b3, voffB); PG8_STAGE(PG8_SB(1, 1), b3 + hstepB, voffB); PG8_STAGE(PG8_SA(1, 0), a3, v20);
            PG8_WAIT_V(8); PG8_WAIT_L(0); PG8_BAR; PG8_MMA(1, 0, At, B0); PG8_MMA(1, 1, At, B1); PG8_BAR; PG8_SCHED;
            if constexpr (Epi::SEG > 0) { if ((t + 2) % Epi::SEG == 0 && t + 2 < nt) E.segment(acc, cur, (t + 2) / Epi::SEG, wr, wc, fr, fq); }
            } else {
            PG8_LDB(B0, 0, 0); PG8_SCHED; PG8_LDA(At, 0, 0); PG8_STAGE(PG8_SA(1, 1), a1 + hstepA, voffA);
            PG8_WAIT_L(8); PG8_BAR; PG8_WAIT_L(0); PG8_MMA(0, 0, At, B0); PG8_BAR; PG8_SCHED;
            PG8_LDB(B1, 0, 1); PG8_STAGE(PG8_SB(0, 0), b2, voffB);
            PG8_BAR; PG8_WAIT_L(0); PG8_MMA(0, 1, At, B1); PG8_BAR;
            PG8_LDA(At, 0, 1); PG8_STAGE(PG8_SA(0, 0), a2, voffA);
            PG8_BAR; PG8_WAIT_L(0); PG8_MMA(1, 0, At, B0); PG8_BAR; PG8_SCHED;
            PG8_STAGE(PG8_SB(0, 1), b2 + hstepB, voffB);
            PG8_WAIT_V(6); PG8_BAR; PG8_MMA(1, 1, At, B1); PG8_BAR;
            PG8_LDB(B0, 1, 0); PG8_SCHED; PG8_LDA(At, 1, 0); PG8_STAGE(PG8_SA(0, 1), a2 + hstepA, voffA);
            PG8_WAIT_L(8); PG8_BAR; PG8_WAIT_L(0); PG8_MMA(0, 0, At, B0); PG8_BAR; PG8_SCHED;
            PG8_LDB(B1, 1, 1); PG8_STAGE(PG8_SB(1, 0), b3, voffB);
            PG8_BAR; PG8_WAIT_L(0); PG8_MMA(0, 1, At, B1); PG8_BAR;
            PG8_LDA(At, 1, 1); PG8_STAGE(PG8_SA(1, 0), a3, voffA);
            PG8_BAR; PG8_WAIT_L(0); PG8_MMA(1, 0, At, B0); PG8_BAR; PG8_SCHED;
            PG8_STAGE(PG8_SB(1, 1), b3 + hstepB, voffB);
            PG8_WAIT_V(6); PG8_BAR; PG8_MMA(1, 1, At, B1); PG8_BAR;
            }
        }
        if constexpr (FP8) asm volatile("s_nop 15\n\ts_nop 3" ::: "memory");
        if constexpr (ALIGN_EPI) { if (wr == 0) PG8_BAR; }
        if constexpr (!Epi::AFTER_DRAIN) { E(acc, cur, wr, wc, fr, fq); S.done(cur); }
        if (!has_next) break;
#pragma unroll
        for (int a = 0; a < 2; ++a)
#pragma unroll
            for (int b = 0; b < 2; ++b)
#pragma unroll
                for (int m = 0; m < 4; ++m)
#pragma unroll
                    for (int n = 0; n < 2; ++n) acc[a][b][m][n] = (f32x4){0.f, 0.f, 0.f, 0.f};
        cur = nxt; cA = nA; cB = nB; ++ui;
        if constexpr (GATHER) { vC0[0] = vN0[0]; vC0[1] = vN0[1]; vC1[0] = vN1[0]; vC1[1] = vN1[1]; }
        if constexpr (ALIGN_EPI) { if (wr == 1) PG8_BAR; }
    }
    PG8_WAIT_V(0);
    if constexpr (!ALIGN_EPI) { if (wr == 0) PG8_BAR; }
    PG8_BAR;
    if constexpr (Epi::AFTER_DRAIN) { E.fused(acc, cur, wr, wc, fr, fq, lds, wid, lane); S.done(cur); }
#undef PG8_SA
#undef PG8_SB
#undef PG8_STAGE
#undef PG8_LDA
#undef PG8_LD16
#undef PG8_LDB
#undef PG8_MMA
#undef PG8_WAIT_V
#undef PG8_WAIT_L
#undef PG8_BAR
#undef PG8_SCHED
}
}

typedef unsigned short bf16_t;
__device__ __forceinline__ unsigned pk4_fp8(float a, float b, float c, float d) { unsigned w = 0u; w = __builtin_amdgcn_cvt_pk_fp8_f32(a, b, w, false); w = __builtin_amdgcn_cvt_pk_fp8_f32(c, d, w, true); return w; }
constexpr float F8_WGU = 64.f, F8_WD = 128.f, F8_HID = 4.f;
typedef unsigned u32x4_t __attribute__((ext_vector_type(4)));
__device__ __forceinline__ void ldg8_dw(float (&o)[8], const void* base, const unsigned (&off)[8]) {
    asm volatile("global_load_dword %0, %9, %8\n\tglobal_load_dword %1, %10, %8\n\tglobal_load_dword %2, %11, %8\n\tglobal_load_dword %3, %12, %8\n\t"
                 "global_load_dword %4, %13, %8\n\tglobal_load_dword %5, %14, %8\n\tglobal_load_dword %6, %15, %8\n\tglobal_load_dword %7, %16, %8\n\ts_waitcnt vmcnt(0)"
                 : "=&v"(o[0]), "=&v"(o[1]), "=&v"(o[2]), "=&v"(o[3]), "=&v"(o[4]), "=&v"(o[5]), "=&v"(o[6]), "=&v"(o[7])
                 : "s"(base), "v"(off[0]), "v"(off[1]), "v"(off[2]), "v"(off[3]), "v"(off[4]), "v"(off[5]), "v"(off[6]), "v"(off[7]) : "memory");
}
template <int I1, int I2, int I3>
__device__ __forceinline__ void ldg8_x4(u32x4_t (&a)[4], u32x4_t (&b)[4], const void* base, unsigned offA, unsigned offB) {
    asm volatile("global_load_dwordx4 %0, %9, %8\n\tglobal_load_dwordx4 %1, %9, %8 offset:%11\n\tglobal_load_dwordx4 %2, %9, %8 offset:%12\n\tglobal_load_dwordx4 %3, %9, %8 offset:%13\n\t"
                 "global_load_dwordx4 %4, %10, %8\n\tglobal_load_dwordx4 %5, %10, %8 offset:%11\n\tglobal_load_dwordx4 %6, %10, %8 offset:%12\n\tglobal_load_dwordx4 %7, %10, %8 offset:%13\n\ts_waitcnt vmcnt(0)"
                 : "=&v"(a[0]), "=&v"(a[1]), "=&v"(a[2]), "=&v"(a[3]), "=&v"(b[0]), "=&v"(b[1]), "=&v"(b[2]), "=&v"(b[3])
                 : "s"(base), "v"(offA), "v"(offB), "i"(I1), "i"(I2), "i"(I3) : "memory");
}
__device__ __forceinline__ void ldg8_x4v(u32x4_t (&o)[8], const void* base, const unsigned (&off)[8]) {
    asm volatile("global_load_dwordx4 %0, %9, %8\n\tglobal_load_dwordx4 %1, %10, %8\n\tglobal_load_dwordx4 %2, %11, %8\n\tglobal_load_dwordx4 %3, %12, %8\n\t"
                 "global_load_dwordx4 %4, %13, %8\n\tglobal_load_dwordx4 %5, %14, %8\n\tglobal_load_dwordx4 %6, %15, %8\n\tglobal_load_dwordx4 %7, %16, %8\n\ts_waitcnt vmcnt(0)"
                 : "=&v"(o[0]), "=&v"(o[1]), "=&v"(o[2]), "=&v"(o[3]), "=&v"(o[4]), "=&v"(o[5]), "=&v"(o[6]), "=&v"(o[7])
                 : "s"(base), "v"(off[0]), "v"(off[1]), "v"(off[2]), "v"(off[3]), "v"(off[4]), "v"(off[5]), "v"(off[6]), "v"(off[7]) : "memory");
}
template <int I1, int I2, int I3>
__device__ __forceinline__ void ldg4_x4(u32x4_t (&a)[4], const void* base, unsigned off) {
    asm volatile("global_load_dwordx4 %0, %5, %4\n\tglobal_load_dwordx4 %1, %5, %4 offset:%6\n\tglobal_load_dwordx4 %2, %5, %4 offset:%7\n\tglobal_load_dwordx4 %3, %5, %4 offset:%8\n\ts_waitcnt vmcnt(0)"
                 : "=&v"(a[0]), "=&v"(a[1]), "=&v"(a[2]), "=&v"(a[3]) : "s"(base), "v"(off), "i"(I1), "i"(I2), "i"(I3) : "memory");
}
__device__ __forceinline__ void bf8_to_f32(const u32x4_t w, float* o) {
    o[0] = __uint_as_float(w.x << 16); o[1] = __uint_as_float(w.x & 0xffff0000u); o[2] = __uint_as_float(w.y << 16); o[3] = __uint_as_float(w.y & 0xffff0000u);
    o[4] = __uint_as_float(w.z << 16); o[5] = __uint_as_float(w.z & 0xffff0000u); o[6] = __uint_as_float(w.w << 16); o[7] = __uint_as_float(w.w & 0xffff0000u);
}
struct ExpertOrder1 {
    int G, v;
    __device__ void init(int G_, int c) { G = G_; v = (G_ % 8 == 0) ? (c % 8) * (G_ / 8) + c / 8 : c; }
    __device__ bool next(int i, pg8::Unit& u) const { const int L = i * G + v; if (L >= 2048) return false; const int e = L >> 7, r = L & 127; u.pm = e * 8 + (r & 7); u.pn = e * 16 + (r >> 3); return true; }
    __device__ __forceinline__ void a_ready(const pg8::Unit&) const {}
    __device__ __forceinline__ void done(const pg8::Unit&) const {}
};
struct ExpertOrder2 {
    int G, v;
    __device__ void init(int G_, int c) { G = G_; v = (G_ % 8 == 0) ? (c % 8) * (G_ / 8) + c / 8 : c; }
    __device__ bool next(int i, pg8::Unit& u) const { const int L = i * G + v; if (L >= 512) return false; const int e = L >> 5, r = L & 31; u.pm = e * 8 + (r & 7); u.pn = e * 4 + (r >> 3); return true; }
    __device__ __forceinline__ void a_ready(const pg8::Unit&) const {}
    __device__ __forceinline__ void done(const pg8::Unit&) const {}
};
__device__ __forceinline__ float silu_fast(float x) { return x * __builtin_amdgcn_rcpf(1.f + __builtin_amdgcn_exp2f(-1.4426950408889634f * x)); }
struct EpiSwiGLU {
    static constexpr bool PERM = true, AFTER_DRAIN = false; static constexpr int SEG = 0;
    bf16_t* O; int ldc;
    __device__ __forceinline__ void operator()(const pg8::f32x4 (&acc)[2][2][4][2], const pg8::Unit& u, int wr, int wc, int fr, int fq) const {
        int row0 = u.pm * 256 + wr * 64 + fr; asm volatile("" : "+v"(row0)); const int col0 = (u.pn & 15) * 128 + wc * 32 + 8 * fq;
#pragma unroll
        for (int ai = 0; ai < 2; ++ai)
#pragma unroll
            for (int m = 0; m < 4; ++m) {
                const pg8::f32x4 g0 = acc[ai][0][m][0], g1 = acc[ai][0][m][1], u0 = acc[ai][1][m][0], u1 = acc[ai][1][m][1];
                constexpr float IG = 1.f / F8_WGU, HS = F8_HID / F8_WGU;
                const unsigned w0 = pk4_fp8(silu_fast(g0[0] * IG) * u0[0] * HS, silu_fast(g0[1] * IG) * u0[1] * HS, silu_fast(g0[2] * IG) * u0[2] * HS, silu_fast(g0[3] * IG) * u0[3] * HS);
                const unsigned w1 = pk4_fp8(silu_fast(g1[0] * IG) * u1[0] * HS, silu_fast(g1[1] * IG) * u1[1] * HS, silu_fast(g1[2] * IG) * u1[2] * HS, silu_fast(g1[3] * IG) * u1[3] * HS);
                *(uint2*)((unsigned char*)O + (size_t)(row0 + ai * 128 + m * 16) * ldc + col0) = make_uint2(w0, w1);
            }
    }
};
struct EpiProj {
    static constexpr bool PERM = true, AFTER_DRAIN = false; static constexpr int SEG = 0;
    bf16_t* O; const float* bias;
    __device__ __forceinline__ void operator()(const pg8::f32x4 (&acc)[2][2][4][2], const pg8::Unit& u, int wr, int wc, int fr, int fq) const {
        int row0 = u.pm * 256 + wr * 64 + fr; asm volatile("" : "+v"(row0)); const int col0 = u.pn * 256 + wc * 32 + 8 * fq; const bool gate = u.pn < 12; constexpr float L2E = 1.4426950408889634f;
        float bias8[2][8];
        if (gate) { u32x4_t t0[4], t1[4]; const unsigned o0 = (unsigned)col0 * 4u; ldg8_x4<16, 512, 528>(t0, t1, bias, o0, o0);
#pragma unroll
            for (int q = 0; q < 4; ++q) { bias8[0][q] = __uint_as_float(t0[0][q]); bias8[0][4 + q] = __uint_as_float(t0[1][q]); bias8[1][q] = __uint_as_float(t0[2][q]); bias8[1][4 + q] = __uint_as_float(t0[3][q]); } }
#pragma unroll
        for (int bj = 0; bj < 2; ++bj) {
            float b[8];
#pragma unroll
            for (int q = 0; q < 8; ++q) b[q] = gate ? bias8[bj][q] : 0.f;
#pragma unroll
            for (int ai = 0; ai < 2; ++ai)
#pragma unroll
                for (int m = 0; m < 4; ++m) { float v[8];
#pragma unroll
                    for (int q = 0; q < 8; ++q) { const float x = acc[ai][bj][m][q >> 2][q & 3]; v[q] = gate ? __builtin_amdgcn_rcpf(1.f + __builtin_amdgcn_exp2f(-(x + b[q]) * L2E)) : x; }
                    pg8::u32x4 w; w.x = pg8::cvt_pk_bf16(v[0], v[1]); w.y = pg8::cvt_pk_bf16(v[2], v[3]); w.z = pg8::cvt_pk_bf16(v[4], v[5]); w.w = pg8::cvt_pk_bf16(v[6], v[7]);
                    *(pg8::u32x4*)(O + (size_t)(row0 + ai * 128 + m * 16) * DINP + col0 + bj * 128) = w; } }
    }
};
struct EpiQ {
    static constexpr bool PERM = false, AFTER_DRAIN = false; static constexpr int SEG = 0;
    bf16_t* Q; const float* rq; const float* rc; const float* rs;
    __device__ __forceinline__ void operator()(const pg8::f32x4 (&acc)[2][2][4][2], const pg8::Unit& u, int wr, int wc, int fr, int fq) const {
        int row0 = u.pm * 256 + wr * 64 + fr; asm volatile("" : "+v"(row0)); constexpr float SC = 0.10206207261596575f * 1.4426950408889634f;
        float sc8[8]; { unsigned off[8];
#pragma unroll
            for (int i = 0; i < 8; ++i) off[i] = (unsigned)(row0 + (i >> 2) * 128 + (i & 3) * 16) * 4u;
            ldg8_dw(sc8, rq, off); }
#pragma unroll
        for (int bj = 0; bj < 2; ++bj) { const int g32 = u.pn * 8 + bj * 4 + wc, col0 = g32 * 32 + 4 * fq; const bool rope = (g32 % 3) == 2;
#pragma unroll
            for (int ai = 0; ai < 2; ++ai) {
                u32x4_t cs4[4], sn4[4];
                if (rope) { u32x4_t t0[4], t1[4];
                    const unsigned o0 = (unsigned)((row0 + ai * 128) * 16 + 4 * fq) * 4u;
                    ldg8_x4<16 * 16 * 4, 32 * 16 * 4, 48 * 16 * 4>(t0, t1, rc, o0, o0 + (unsigned)(T * 16 * 4));
#pragma unroll
                    for (int m = 0; m < 4; ++m) { cs4[m] = t0[m]; sn4[m] = t1[m]; } }
#pragma unroll
                for (int m = 0; m < 4; ++m) { const int row = row0 + ai * 128 + m * 16; const float s = sc8[ai * 4 + m] * SC;
                    pg8::f32x4 v0 = acc[ai][bj][m][0] * s, v1 = acc[ai][bj][m][1] * s;
                    if (rope) { const pg8::f32x4 c4 = __builtin_bit_cast(pg8::f32x4, cs4[m]), s4 = __builtin_bit_cast(pg8::f32x4, sn4[m]);
                        const pg8::f32x4 x1 = v0, x2 = v1; v0 = x1 * c4 - x2 * s4; v1 = x1 * s4 + x2 * c4; }
                    bf16_t* qp = Q + (size_t)row * 768 + col0;
                    *(uint2*)qp = make_uint2(pg8::cvt_pk_bf16(v0[0], v0[1]), pg8::cvt_pk_bf16(v0[2], v0[3]));
                    *(uint2*)(qp + 16) = make_uint2(pg8::cvt_pk_bf16(v1[0], v1[1]), pg8::cvt_pk_bf16(v1[2], v1[3])); } } }
    }
};
struct EpiKV {
    static constexpr bool PERM = true, AFTER_DRAIN = false; static constexpr int SEG = 0;
    bf16_t* K; bf16_t* V; const float* rkv;
    __device__ __forceinline__ void operator()(const pg8::f32x4 (&acc)[2][2][4][2], const pg8::Unit& u, int wr, int wc, int fr, int fq) const {
        int row0 = u.pm * 256 + wr * 64 + fr; asm volatile("" : "+v"(row0));
        float sc8[8]; { unsigned off[8];
#pragma unroll
            for (int i = 0; i < 8; ++i) off[i] = (unsigned)(row0 + (i >> 2) * 128 + (i & 3) * 16) * 4u;
            ldg8_dw(sc8, rkv, off); }
#pragma unroll
        for (int bj = 0; bj < 2; ++bj) { const int head = u.pn * 2 + bj;
#pragma unroll
            for (int ai = 0; ai < 2; ++ai)
#pragma unroll
                for (int m = 0; m < 4; ++m) { const int row = row0 + ai * 128 + m * 16; const float s = sc8[ai * 4 + m];
                    const pg8::f32x4 v0 = acc[ai][bj][m][0] * s, v1 = acc[ai][bj][m][1] * s; pg8::u32x4 w;
                    w.x = pg8::cvt_pk_bf16(v0[0], v0[1]); w.y = pg8::cvt_pk_bf16(v0[2], v0[3]); w.z = pg8::cvt_pk_bf16(v1[0], v1[1]); w.w = pg8::cvt_pk_bf16(v1[2], v1[3]);
                    bf16_t* dst = (wc < 2) ? K + (size_t)row * 768 + head * 96 + wc * 32 + 8 * fq : V + (size_t)row * 512 + head * 64 + (wc - 2) * 32 + 8 * fq;
                    *(pg8::u32x4*)dst = w; } }
    }
};
struct EpiF32 {
    static constexpr bool PERM = true, AFTER_DRAIN = false; static constexpr int SEG = 0;
    float* O; int ldc; const float* rs;
    __device__ __forceinline__ void operator()(const pg8::f32x4 (&acc)[2][2][4][2], const pg8::Unit& u, int wr, int wc, int fr, int fq) const {
        int row0 = u.pm * 256 + wr * 64 + fr; asm volatile("" : "+v"(row0)); const int col0 = u.pn * 256 + wc * 32 + 8 * fq;
#pragma unroll
        for (int ai = 0; ai < 2; ++ai)
#pragma unroll
            for (int m = 0; m < 4; ++m) { const int row = row0 + ai * 128 + m * 16; const float s = rs ? rs[row] : 1.f;
#pragma unroll
                for (int bj = 0; bj < 2; ++bj) { float* op = O + (size_t)row * ldc + col0 + bj * 128;
                    *(pg8::f32x4*)op = acc[ai][bj][m][0] * s; *(pg8::f32x4*)(op + 4) = acc[ai][bj][m][1] * s; } }
    }
};
struct EpiMerge {
    static constexpr bool PERM = true, AFTER_DRAIN = false; static constexpr int SEG = 8;
    bf16_t* O; const bf16_t* GL;
    static __device__ __forceinline__ void ld8(const bf16_t* p, float* o) { const uint4 w = *(const uint4*)p;
        o[0] = __uint_as_float(w.x << 16); o[1] = __uint_as_float(w.x & 0xffff0000u); o[2] = __uint_as_float(w.y << 16); o[3] = __uint_as_float(w.y & 0xffff0000u);
        o[4] = __uint_as_float(w.z << 16); o[5] = __uint_as_float(w.z & 0xffff0000u); o[6] = __uint_as_float(w.w << 16); o[7] = __uint_as_float(w.w & 0xffff0000u); }
    __device__ __forceinline__ void segment(pg8::f32x4 (&acc)[2][2][4][2], const pg8::Unit& u, int seg, int wr, int wc, int fr, int fq) const {
        int row0 = u.pm * 256 + wr * 64 + fr; asm volatile("" : "+v"(row0));
        const unsigned cb = (unsigned)((seg - 1) * 1024 + u.pn * 256 + wc * 32 + 8 * fq) * 2u;
#pragma unroll
        for (int ai = 0; ai < 2; ++ai)
#pragma unroll
            for (int m = 0; m < 4; ++m) {
                u32x4_t ga[4];
                ldg4_x4<2048, 256, 2304>(ga, GL, (unsigned)(row0 + ai * 128 + m * 16) * (unsigned)(DINP * 2) + cb);
#pragma unroll
                for (int bj = 0; bj < 2; ++bj) { float x0[8], x1[8]; bf8_to_f32(ga[bj * 2], x0); bf8_to_f32(ga[bj * 2 + 1], x1);
#pragma unroll
                    for (int q = 0; q < 8; ++q) acc[ai][bj][m][q >> 2][q & 3] *= x0[q] * __builtin_amdgcn_rcpf(x1[q]); } }
    }
    __device__ __forceinline__ void operator()(const pg8::f32x4 (&acc)[2][2][4][2], const pg8::Unit& u, int wr, int wc, int fr, int fq) const {
        int row0 = u.pm * 256 + wr * 64 + fr; asm volatile("" : "+v"(row0)); const int col0 = u.pn * 256 + wc * 32 + 8 * fq;
        const unsigned cb = (unsigned)(2048 + col0) * 2u;
#pragma unroll
        for (int ai = 0; ai < 2; ++ai) {
            u32x4_t g8[8];
            { unsigned off[8];
#pragma unroll
              for (int i = 0; i < 8; ++i) off[i] = (unsigned)(row0 + ai * 128 + (i & 3) * 16) * (unsigned)(DINP * 2) + cb + (i >> 2) * 256u;
              ldg8_x4v(g8, GL, off); }
#pragma unroll
            for (int m = 0; m < 4; ++m) { const int row = row0 + ai * 128 + m * 16;
#pragma unroll
                for (int bj = 0; bj < 2; ++bj) { float x2[8], v[8]; bf8_to_f32(g8[bj * 4 + m], x2);
#pragma unroll
                    for (int q = 0; q < 8; ++q) v[q] = acc[ai][bj][m][q >> 2][q & 3] * x2[q];
                    pg8::u32x4 w; w.x = pg8::cvt_pk_bf16(v[0], v[1]); w.y = pg8::cvt_pk_bf16(v[2], v[3]); w.z = pg8::cvt_pk_bf16(v[4], v[5]); w.w = pg8::cvt_pk_bf16(v[6], v[7]);
                    *(pg8::u32x4*)(O + (size_t)row * DM + col0 + bj * 128) = w; } } }
    }
};
struct EpiRowScale {
    static constexpr bool PERM = true, AFTER_DRAIN = false; static constexpr int SEG = 0;
    bf16_t* O; int ldc; const float* rs;
    __device__ __forceinline__ void operator()(const pg8::f32x4 (&acc)[2][2][4][2], const pg8::Unit& u, int wr, int wc, int fr, int fq) const {
        int row0 = u.pm * 256 + wr * 64 + fr; asm volatile("" : "+v"(row0)); const int col0 = (u.pn & 3) * 256 + wc * 32 + 8 * fq;
        float sc8[8]; { unsigned off[8];
#pragma unroll
            for (int i = 0; i < 8; ++i) off[i] = (unsigned)(row0 + (i >> 2) * 128 + (i & 3) * 16) * 4u;
            ldg8_dw(sc8, rs, off); }
#pragma unroll
        for (int ai = 0; ai < 2; ++ai)
#pragma unroll
            for (int m = 0; m < 4; ++m) { const int row = row0 + ai * 128 + m * 16; const float s = sc8[ai * 4 + m] * (1.f / (F8_WD * F8_HID));
#pragma unroll
                for (int bj = 0; bj < 2; ++bj) { const pg8::f32x4 v0 = acc[ai][bj][m][0] * s, v1 = acc[ai][bj][m][1] * s; pg8::u32x4 w;
                    w.x = pg8::cvt_pk_bf16(v0[0], v0[1]); w.y = pg8::cvt_pk_bf16(v0[2], v0[3]); w.z = pg8::cvt_pk_bf16(v1[0], v1[1]); w.w = pg8::cvt_pk_bf16(v1[2], v1[3]);
                    *(pg8::u32x4*)(O + (size_t)row * ldc + col0 + bj * 128) = w; } }
    }
};
struct Params {
    const float* in[27];
    const int* pos;
    float* out;
    unsigned char* ws;
};

__device__ __forceinline__ float wave_sum(float v) {
#pragma unroll
    for (int o = 1; o < 64; o <<= 1) v += __shfl_xor(v, o);
    return v;
}
__device__ __forceinline__ float sigmoidf_(float x) { return 1.f / (1.f + expf(-x)); }
__device__ __forceinline__ float siluf_(float x) { return x / (1.f + expf(-x)); }
__device__ __forceinline__ float log_sigmoidf_(float x) { return fminf(x, 0.f) - log1pf(expf(-fabsf(x))); }

__device__ __forceinline__ float bf2f(bf16_t u) { return __uint_as_float((unsigned)u << 16); }
__device__ __forceinline__ unsigned f2bf(float f) { unsigned u = __float_as_uint(f); return (u + 0x7fffu + ((u >> 16) & 1u)) >> 16; }
__device__ __forceinline__ unsigned pk2(float lo, float hi) { return f2bf(lo) | (f2bf(hi) << 16); }
__device__ __forceinline__ void ld4bf(const bf16_t* p, float* o) {
    const uint2 w = *(const uint2*)p; o[0] = __uint_as_float(w.x << 16); o[1] = __uint_as_float(w.x & 0xffff0000u); o[2] = __uint_as_float(w.y << 16); o[3] = __uint_as_float(w.y & 0xffff0000u);
}
__device__ __forceinline__ void transpose_block(const float* Wblk, int ldw, bf16_t* dst, int ldt, const float* ks, const float* ns, float* scr, int lane) {
#pragma unroll 8
    for (int i = 0; i < 32; ++i) { const int kk = 2 * i + (lane >> 5); float v = __builtin_nontemporal_load(&Wblk[(size_t)kk * ldw + (lane & 31)]);     if (ks) v *= ks[kk]; if (ns) v *= ns[lane & 31]; scr[kk * 33 + (lane & 31)] = v; }
    asm volatile("s_waitcnt lgkmcnt(0)" ::: "memory");
    const int c = lane & 7;
#pragma unroll
    for (int j = 0; j < 4; ++j) { const int n = (lane >> 3) + 8 * j; const float* s = scr + (8 * c) * 33 + n;
        uint4 o; o.x = pk2(s[0 * 33], s[1 * 33]); o.y = pk2(s[2 * 33], s[3 * 33]); o.z = pk2(s[4 * 33], s[5 * 33]); o.w = pk2(s[6 * 33], s[7 * 33]);
        *(uint4*)(dst + (size_t)n * ldt + 8 * c) = o; }
    asm volatile("s_waitcnt lgkmcnt(0)" ::: "memory");
}

struct WStream {
    const float* gate; const float* up; const float* down;
    unsigned char* wgu_t; unsigned char* wd_t;
    const char* rowp; unsigned rs8, rs1;
    unsigned vo0;
    const float* src; unsigned char* dst; int ldt; float sc;
    int it, it_stride, step, nsteps;
    float v0, v1, v2, v3;
    char* blk; char* blkw;
    __device__ __forceinline__ void init(int gw, int ngw, char* lds_blk, int lane) {
        constexpr int I_ALL = 2 * 16 * 16 * 64 + 16 * 32 * 32;
        nsteps = (gw < I_ALL) ? 8 * ((I_ALL - gw + ngw - 1) / ngw) : 0;
        if (I_ALL % ngw == 0) { const int per_wg = I_ALL / (ngw >> 3); gw = (gw >> 3) * per_wg + (gw & 7); ngw = 8; nsteps = per_wg; }
        it = gw; it_stride = ngw; step = 0; blk = lds_blk; blkw = lds_blk + (lane & 31) * 80 + 4 * (lane >> 5);
        src = gate; rowp = (const char*)gate; rs8 = 0u; rs1 = 0u; vo0 = 0u; dst = wgu_t; ldt = DM; sc = 1.f; v0 = v1 = v2 = v3 = 0.f;
    }
    __device__ __forceinline__ void rare(int lane) {
        if (step >= 8 && step <= nsteps) {
            const int nr = lane >> 1, hf = lane & 1;
            const uint4 a = *(const uint4*)(blk + nr * 80 + hf * 32), b = *(const uint4*)(blk + nr * 80 + hf * 32 + 16);
            unsigned char* q = dst + (size_t)nr * ldt + hf * 32;
            { typedef unsigned u32x4n __attribute__((ext_vector_type(4))); const u32x4n an = {a.x, a.y, a.z, a.w}, bn = {b.x, b.y, b.z, b.w};
              __builtin_nontemporal_store(an, (u32x4n*)q); __builtin_nontemporal_store(bn, (u32x4n*)(q + 16)); }
        }
        if (step < nsteps) {
            constexpr int I_G = 16 * 16 * 64; int ldw;
            if (it < 2 * I_G) { const int up_ = it >= I_G, r_ = up_ ? it - I_G : it, e_ = r_ >> 10, kb_ = (r_ >> 6) & 15, nb_ = r_ & 63, j0_ = nb_ * 32;
                src = (up_ ? up : gate) + (size_t)e_ * DM * DEXP + (size_t)(64 * kb_) * DEXP + j0_; ldw = DEXP;
                dst = wgu_t + (size_t)(e_ * 4096 + 256 * (j0_ >> 7) + (j0_ & 127) + (up_ ? 128 : 0)) * DM + 64 * kb_; ldt = DM; sc = F8_WGU; }
            else { const int r_ = it - 2 * I_G, e_ = r_ >> 10, kb_ = (r_ >> 5) & 31, nb_ = r_ & 31;
                src = down + (size_t)e_ * DEXP * DM + (size_t)(64 * kb_) * DM + 32 * nb_; ldw = DM; dst = wd_t + (size_t)(e_ * 1024 + 32 * nb_) * DEXP + 64 * kb_; ldt = DEXP; sc = F8_WD; }
            it += it_stride;
            rowp = (const char*)src; rs8 = (unsigned)ldw * 32u; rs1 = (unsigned)ldw * 4u;
            vo0 = (unsigned)((4 * (lane >> 5)) * ldw + (lane & 31)) * 4u;
        } else { rowp = (const char*)src; rs8 = 0u; rs1 = 0u; vo0 = (unsigned)(lane & 31) * 4u; }
    }
    __device__ __forceinline__ void tick(int lane) {
        *(unsigned*)(blkw + ((step - 1) & 7) * 8) = pk4_fp8(v0 * sc, v1 * sc, v2 * sc, v3 * sc);
        if ((step & 7) == 0) rare(lane);
        v0 = __builtin_nontemporal_load((const float*)(rowp + vo0)); v1 = __builtin_nontemporal_load((const float*)(rowp + rs1 + vo0));
        v2 = __builtin_nontemporal_load((const float*)(rowp + 2 * rs1 + vo0)); v3 = __builtin_nontemporal_load((const float*)(rowp + 3 * rs1 + vo0));
        rowp += rs8; ++step;
    }
};

namespace att {
using bf16x8 = __attribute__((ext_vector_type(8))) short;
using s16x4  = __attribute__((ext_vector_type(4))) short;
using f32x16 = __attribute__((ext_vector_type(16))) float;
using u32x4  = __attribute__((ext_vector_type(4))) unsigned;
constexpr int NW = 8, QBLK = 32, KVBLK = 64;
constexpr int LDQ = 768, LDK = 768, LDV = 512, LDO = 1536;
constexpr int KROWB = 208;
constexpr int SHM_K = KVBLK * KROWB, SHM_V = KVBLK * 64 * 2;
constexpr int NBUF = 3;
constexpr int SHM_ATTN = NBUF * SHM_V + NBUF * SHM_K + NW * 64 * 4;
constexpr float THR = 8.f;
#define ASBAR() __builtin_amdgcn_sched_barrier(0)
__device__ __forceinline__ int crow(int r, int hi) { return (r & 3) + 8 * (r >> 2) + 4 * hi; }
__device__ __forceinline__ unsigned cvtpk(float lo, float hi) { unsigned r; asm volatile("v_cvt_pk_bf16_f32 %0, %1, %2" : "=v"(r) : "v"(lo), "v"(hi)); return r; }
#define MX3(a, b, c) __builtin_fmaxf(__builtin_fmaxf((a), (b)), (c))
template <bool FIRST>
__device__ __forceinline__ void partialSM(f32x16& p0, f32x16& p1, float& m_ref, f32x16& negm, float& alpha) {
  constexpr float THRL = THR * 1.4426950408889634f;
  float a = MX3(p0[0], p0[1], p1[0]), b = MX3(p0[2], p0[3], p1[1]); a = MX3(a, p1[2], p1[3]);
#pragma unroll
  for (int r = 4; r < 16; r += 4) { a = MX3(a, p0[r], p0[r + 1]); b = MX3(b, p0[r + 2], p0[r + 3]); a = MX3(a, p1[r], p1[r + 1]); b = MX3(b, p1[r + 2], p1[r + 3]); }
  float pmax = fmaxf(a, b);
  { auto rr = __builtin_amdgcn_permlane32_swap(__float_as_uint(pmax), __float_as_uint(pmax), false, false);
    pmax = fmaxf(__uint_as_float(rr[0]), __uint_as_float(rr[1])); }
  alpha = 1.f;
  if (FIRST || !__builtin_expect(__all(pmax <= THRL), 1)) {
    const float dl = FIRST ? pmax : fmaxf(pmax, 0.f); m_ref += dl;
#pragma unroll
    for (int r = 0; r < 16; ++r) { p0[r] -= dl; p1[r] -= dl; }
#pragma unroll
    for (int r = 0; r < 16; ++r) negm[r] = -m_ref;
    asm volatile("" : "+v"(negm));
    if (!FIRST) alpha = __builtin_amdgcn_exp2f(-dl);
  }
#pragma unroll
  for (int r = 0; r < 16; ++r) p0[r] = __builtin_amdgcn_exp2f(p0[r]);
}
#undef MX3
__device__ __forceinline__ void finishSM(f32x16& p0, f32x16& p1, float alpha, float& l_reg, bf16x8& pa0, bf16x8& pa1, bf16x8& pa2, bf16x8& pa3) {
  for (int r = 0; r < 16; ++r) p1[r] = __builtin_amdgcn_exp2f(p1[r]);
  float ps = 0; for (int r = 0; r < 16; ++r) ps += p0[r]; for (int r = 0; r < 16; ++r) ps += p1[r];
  { auto rr = __builtin_amdgcn_permlane32_swap(__float_as_uint(ps), __float_as_uint(ps), false, false);
    ps = __uint_as_float(rr[0]) + __uint_as_float(rr[1]); }
  l_reg = l_reg * alpha + ps;
#define PK4(P, BASE, OUT) do { u32x4 w = {cvtpk(P[BASE + 0], P[BASE + 1]), cvtpk(P[BASE + 2], P[BASE + 3]), cvtpk(P[BASE + 4], P[BASE + 5]), cvtpk(P[BASE + 6], P[BASE + 7])}; \
    OUT = *reinterpret_cast<bf16x8*>(&w); } while (0)
  PK4(p0, 0, pa0); PK4(p0, 8, pa1); PK4(p1, 0, pa2); PK4(p1, 8, pa3);
#undef PK4
}
__device__ __forceinline__ void qkt(f32x16& p0, f32x16& p1, const char* Ks, const bf16x8* qr, const f32x16& negm, int r32, int hi) {
  p0 = negm; p1 = negm;
#pragma unroll
  for (int d0 = 0; d0 < 6; ++d0) { const int cb = d0 * 32 + hi * 16;
    bf16x8 b0 = *reinterpret_cast<const bf16x8*>(Ks + r32 * KROWB + cb);
    bf16x8 b1 = *reinterpret_cast<const bf16x8*>(Ks + (32 + r32) * KROWB + cb);
    p0 = __builtin_amdgcn_mfma_f32_32x32x16_bf16(b0, qr[d0], p0, 0, 0, 0);
    p1 = __builtin_amdgcn_mfma_f32_32x32x16_bf16(b1, qr[d0], p1, 0, 0, 0); }
}
__device__ __forceinline__ int v_st(int k, int c) { const int kk = k;   return ((kk >> 3) * 2 + (c >> 5)) * 512 + ((kk & 7) * 32 + (c & 31)) * 2; }
__device__ __forceinline__ int v_rd_base(int lane) { return ((lane & 3) << 3) | (((lane >> 2) & 3) << 6) | (((lane >> 4) & 1) << 5) | (((lane >> 5) & 1) << 8); }
constexpr int v_rd_off(int d0, int ks, int half) { return d0 * 512 + ks * 2048 + half * 1024; }
template <int OFF> __device__ __forceinline__ s16x4 tr_read(int vb) {
  s16x4 r; asm volatile("ds_read_b64_tr_b16 %0, %1 offset:%2" : "=&v"(r) : "v"(vb), "i"(OFF) : "memory"); return r;
}
template <int D0> __device__ __forceinline__ void pv_one(f32x16& od, int vb, bf16x8 pa0, bf16x8 pa1, bf16x8 pa2, bf16x8 pa3) {
  const s16x4 l0 = tr_read<v_rd_off(D0, 0, 0)>(vb), h0 = tr_read<v_rd_off(D0, 0, 1)>(vb), l1 = tr_read<v_rd_off(D0, 1, 0)>(vb), h1 = tr_read<v_rd_off(D0, 1, 1)>(vb);
  const s16x4 l2 = tr_read<v_rd_off(D0, 2, 0)>(vb), h2 = tr_read<v_rd_off(D0, 2, 1)>(vb), l3 = tr_read<v_rd_off(D0, 3, 0)>(vb), h3 = tr_read<v_rd_off(D0, 3, 1)>(vb);
  asm volatile("s_waitcnt lgkmcnt(0)" ::: "memory"); ASBAR();
#define PK(L, H) (bf16x8){L[0], L[1], L[2], L[3], H[0], H[1], H[2], H[3]}
  od = __builtin_amdgcn_mfma_f32_32x32x16_bf16(pa0, PK(l0, h0), od, 0, 0, 0);
  od = __builtin_amdgcn_mfma_f32_32x32x16_bf16(pa1, PK(l1, h1), od, 0, 0, 0);
  od = __builtin_amdgcn_mfma_f32_32x32x16_bf16(pa2, PK(l2, h2), od, 0, 0, 0);
  od = __builtin_amdgcn_mfma_f32_32x32x16_bf16(pa3, PK(l3, h3), od, 0, 0, 0);
#undef PK
}
__device__ __forceinline__ void pv_d0(f32x16* o, int vb, bf16x8 pa0, bf16x8 pa1, bf16x8 pa2, bf16x8 pa3) {
  pv_one<0>(o[0], vb, pa0, pa1, pa2, pa3); pv_one<1>(o[1], vb, pa0, pa1, pa2, pa3);
}
__device__ __forceinline__ void attn_unit(const bf16_t* Qb, const bf16_t* Kh, const bf16_t* Vh, bf16_t* Ob, int seq, char* lds, WStream& wst) {
  int tid_ = threadIdx.x; asm volatile("" : "+v"(tid_));
  const int tid = tid_, wid = tid >> 6, lane = tid & 63, r32 = lane & 31, hi = lane >> 5;
  char* V_lds = lds; char* K_lds = lds + NBUF * SHM_V;
  float* ws = (float*)(lds + NBUF * SHM_V + NBUF * SHM_K) + wid * 64; float* li_l = ws; float* al_l = ws + 32;
  float m_ref = 0.f, l_reg = 0; f32x16 o[2] = {}; bf16x8 qr[6]; f32x16 negm = {}; asm volatile("" : "+v"(negm));
  const bf16_t* Qw = Qb + (long)(wid * QBLK + r32) * LDQ + hi * 8;
#pragma unroll
  for (int d0 = 0; d0 < 6; ++d0) qr[d0] = *reinterpret_cast<const bf16x8*>(Qw + d0 * 16);
  const bool kact = tid < 384; const int kr = tid / 12, kc = tid - kr * 12, vr = tid >> 3, vc = (tid & 7) * 8, vst0 = v_st(vr, vc);
  const int kst0 = kr * KROWB + kc * 16, kst1 = (kr + 32) * KROWB + kc * 16;
  const int vb0 = (int)(uintptr_t)V_lds + v_rd_base(lane);
  struct { bf16x8 vs, ks0, ks1; } sr_[2];
#define SLOAD(i, k0) do { sr_[i].vs = *reinterpret_cast<const bf16x8*>(&Vh[(long)((k0) + vr) * LDV + vc]); \
    if (kact) { sr_[i].ks0 = *reinterpret_cast<const bf16x8*>(&Kh[(long)((k0) + kr) * LDK + kc * 8]); sr_[i].ks1 = *reinterpret_cast<const bf16x8*>(&Kh[(long)((k0) + 32 + kr) * LDK + kc * 8]); } } while (0)
#define SWRITE(b, i) do { *(bf16x8*)(V_lds + (b) * SHM_V + vst0) = sr_[i].vs; \
    if (kact) { *(bf16x8*)(K_lds + (b) * SHM_K + kst0) = sr_[i].ks0; *(bf16x8*)(K_lds + (b) * SHM_K + kst1) = sr_[i].ks1; } } while (0)
#define SWAIT() asm volatile("s_waitcnt vmcnt(3)" ::: "memory")
#define RESC(a) do { if (__any((a) < 1.f)) { if (hi == 0) al_l[r32] = (a); asm volatile("s_waitcnt lgkmcnt(0)" ::: "memory"); \
    for (int d = 0; d < 2; ++d) for (int r = 0; r < 16; ++r) o[d][r] *= al_l[crow(r, hi)]; } } while (0)
  f32x16 pA0, pA1, pB0, pB1; float alA, alB; bf16x8 pa0, pa1, pa2, pa3; const int NT = seq / KVBLK;
  constexpr int SE = 0, SO = 1;
  int b_prev = 0, b_cur = 1, b_next = 2;
#define ROT() do { b_prev = b_cur; b_cur = b_next; b_next = (b_next == NBUF - 1) ? 0 : b_next + 1; } while (0)
  SLOAD(SE, 0); asm volatile("s_waitcnt vmcnt(0)" ::: "memory"); SWRITE(0, SE);
  SLOAD(SO, KVBLK); if (2 < NT) SLOAD(SE, 2 * KVBLK);
  __syncthreads();
  qkt(pA0, pA1, K_lds, qr, negm, r32, hi); partialSM<true>(pA0, pA1, m_ref, negm, alA);
  SWAIT(); SWRITE(1, SO); __syncthreads();
  for (int j = 1; j + 1 < NT; j += 2) {
    SLOAD(SO, (j + 2) * KVBLK);
    ASBAR(); qkt(pB0, pB1, K_lds + b_cur * SHM_K, qr, negm, r32, hi);
    finishSM(pA0, pA1, alA, l_reg, pa0, pa1, pa2, pa3); ASBAR();
    pv_d0(o, vb0 + b_prev * SHM_V, pa0, pa1, pa2, pa3); partialSM<false>(pB0, pB1, m_ref, negm, alB);
    SWAIT(); SWRITE(b_next, SE);
    RESC(alB); if (wst.step <= wst.nsteps) wst.tick(lane); __syncthreads(); ROT();
    if (j + 3 < NT) SLOAD(SE, (j + 3) * KVBLK);
    ASBAR(); qkt(pA0, pA1, K_lds + b_cur * SHM_K, qr, negm, r32, hi);
    finishSM(pB0, pB1, alB, l_reg, pa0, pa1, pa2, pa3); ASBAR();
    pv_d0(o, vb0 + b_prev * SHM_V, pa0, pa1, pa2, pa3); partialSM<false>(pA0, pA1, m_ref, negm, alA);
    SWAIT(); SWRITE(b_next, SO);
    RESC(alA); if (wst.step <= wst.nsteps) wst.tick(lane); __syncthreads(); ROT();
  }
  ASBAR(); qkt(pB0, pB1, K_lds + b_cur * SHM_K, qr, negm, r32, hi);
  finishSM(pA0, pA1, alA, l_reg, pa0, pa1, pa2, pa3); ASBAR();
  pv_d0(o, vb0 + b_prev * SHM_V, pa0, pa1, pa2, pa3); partialSM<false>(pB0, pB1, m_ref, negm, alB);
  RESC(alB);
  finishSM(pB0, pB1, alB, l_reg, pa0, pa1, pa2, pa3); ASBAR();
  pv_d0(o, vb0 + b_cur * SHM_V, pa0, pa1, pa2, pa3);
#undef ROT
  if (hi == 0) li_l[r32] = l_reg; asm volatile("s_waitcnt lgkmcnt(0)" ::: "memory");
  float rli[16];
#pragma unroll
  for (int r = 0; r < 16; ++r) rli[r] = __builtin_amdgcn_rcpf(li_l[crow(r, hi)]);
  bf16_t* Ow = Ob + (long)(wid * QBLK) * LDO;
#pragma unroll
  for (int r = 0; r < 16; ++r) { const int orow = crow(r, hi);
#pragma unroll
    for (int d0 = 0; d0 < 2; ++d0) Ow[(long)orow * LDO + d0 * 32 + r32] = (bf16_t)f2bf(o[d0][r] * rli[r]); }
  __syncthreads();
#undef SLOAD
#undef SWRITE
#undef SWAIT
#undef RESC
}
#undef ASBAR
}

namespace gla {
using bf16x8 = __attribute__((ext_vector_type(8))) short;
using s16x4  = __attribute__((ext_vector_type(4))) short;
using f32x16 = __attribute__((ext_vector_type(16))) float;
using u32x4  = __attribute__((ext_vector_type(4))) unsigned;
constexpr int L_DL = 0, L_TOT = 8192, L_RSUM = 10240, L_V = 12288, L_QF = 28672, L_KF = 37888, L_QB = 47104, L_KB = 56320, L_KSTF = 65536, L_KSTB = 74752, L_STF = 65536, L_STB = 83968, L_QR = 102400, L_KR = 110592, L_END = 118784;
constexpr int RB = 144;
__device__ __forceinline__ int crow(int r, int hi) { return (r & 3) + 8 * (r >> 2) + 4 * hi; }
__device__ __forceinline__ unsigned cvtpk(float lo, float hi) { unsigned r; asm volatile("v_cvt_pk_bf16_f32 %0, %1, %2" : "=v"(r) : "v"(lo), "v"(hi)); return r; }
__device__ __forceinline__ int v_st4(int k, int c) { const int kk = (k & ~0xC) | ((k & 4) << 1) | ((k & 8) >> 1); return ((kk >> 3) * 4 + (c >> 5)) * 512 + ((kk & 7) * 32 + (c & 31)) * 2; }
__device__ __forceinline__ int v_rd_base(int lane) { return ((lane & 3) << 3) | (((lane >> 2) & 3) << 6) | (((lane >> 4) & 1) << 5) | (((lane >> 5) & 1) << 8); }
template <int OFF> __device__ __forceinline__ s16x4 tr_read(int vb) { s16x4 r; asm volatile("ds_read_b64_tr_b16 %0, %1 offset:%2" : "=&v"(r) : "v"(vb), "i"(OFF) : "memory"); return r; }
__device__ __forceinline__ void v_frags(int vb, bf16x8 (&f)[4]) {
  const s16x4 l0 = tr_read<0>(vb), h0 = tr_read<2048>(vb), l1 = tr_read<4096>(vb), h1 = tr_read<4096 + 2048>(vb);
  const s16x4 l2 = tr_read<8192>(vb), h2 = tr_read<8192 + 2048>(vb), l3 = tr_read<12288>(vb), h3 = tr_read<12288 + 2048>(vb);
  asm volatile("s_waitcnt lgkmcnt(0)" ::: "memory"); __builtin_amdgcn_sched_barrier(0);
#define PK(L, H) (bf16x8){L[0], L[1], L[2], L[3], H[0], H[1], H[2], H[3]}
  f[0] = PK(l0, h0); f[1] = PK(l1, h1); f[2] = PK(l2, h2); f[3] = PK(l3, h3);
#undef PK
}
__device__ __forceinline__ bf16x8 frag(const char* base, int row, int ks, int hi) { return *reinterpret_cast<const bf16x8*>(base + row * RB + ks * 32 + hi * 16); }

template <bool IS_G1>
__device__ __forceinline__ void prep(char* lds, const bf16_t* projb, const float* wdec, const float* bdec, int t0, int hh, float* dec_out  , long dec_dir_stride) {
  int tid_ = threadIdx.x; asm volatile("" : "+v"(tid_)); const int tid = tid_;
  float* DL = (float*)(lds + L_DL); float* TOT = (float*)(lds + L_TOT);
  { const int i = tid >> 3, r4 = (tid & 7) * 4; float v[4]; ld4bf(projb + (size_t)(t0 + i) * DINP + OFF_GDEC + r4, v); *(float4*)(DL + i * 32 + r4) = make_float4(v[0], v[1], v[2], v[3]);
    const int c8 = (tid & 7) * 8;
    *(uint4*)(lds + L_KR + i * 128 + c8 * 2) = *(const uint4*)(projb + (size_t)(t0 + i) * DINP + OFF_GK + hh * 64 + c8);
    if constexpr (!IS_G1) *(uint4*)(lds + L_QR + i * 128 + c8 * 2) = *(const uint4*)(projb + (size_t)(t0 + i) * DINP + OFF_GQ + hh * 64 + c8); }
#pragma unroll
  for (int e2 = 0; e2 < 2; ++e2) { const int e = tid + e2 * 512, i = e >> 4, cc = (e & 15) * 8;
    *(uint4*)(lds + L_V + v_st4(i, cc)) = *(const uint4*)(projb + (size_t)(t0 + i) * DINP + OFF_GV + hh * 128 + cc); }
  __syncthreads();
  const int cidx = tid & 127, tg = tid >> 7, dir = cidx >> 6, d = cidx & 63;
  float W[16];
#pragma unroll
  for (int r = 0; r < 16; ++r) W[r] = wdec[(size_t)(dir * 16 + r) * 256 + hh * 64 + d];
  const float bias = bdec[dir * 256 + hh * 64 + d];
  constexpr float L2E = 1.4426950408889634f;
  float g[16], cs[16]; float run = 0.f;
#pragma unroll
  for (int ii = 0; ii < 16; ++ii) { const float* dl = DL + (16 * tg + ii) * 32 + dir * 16; float a = bias;
#pragma unroll
    for (int r = 0; r < 16; r += 4) { const float4 x = *(const float4*)(dl + r); a = fmaf(x.x, W[r], a); a = fmaf(x.y, W[r + 1], a); a = fmaf(x.z, W[r + 2], a); a = fmaf(x.w, W[r + 3], a); }
    g[ii] = (fminf(a, 0.f) * L2E - __builtin_amdgcn_logf(1.f + __builtin_amdgcn_exp2f(-fabsf(a) * L2E))) * (1.f / 16.f); run += g[ii]; cs[ii] = run; }
  TOT[tg * 128 + cidx] = run;
  __syncthreads();
  const float t0s = TOT[cidx], t1s = TOT[128 + cidx], t2s = TOT[256 + cidx], t3s = TOT[384 + cidx], tall = (t0s + t1s) + (t2s + t3s);
  const float off_lo = (tg > 0 ? t0s : 0.f) + (tg > 1 ? t1s : 0.f) + (tg > 2 ? t2s : 0.f);
  const float off_hi = (tg < 1 ? t1s : 0.f) + (tg < 2 ? t2s : 0.f) + (tg < 3 ? t3s : 0.f);
  const bf16_t* KR = (const bf16_t*)(lds + L_KR); const bf16_t* QR = (const bf16_t*)(lds + L_QR);
  if constexpr (IS_G1) {
    unsigned pk[8];
#pragma unroll
    for (int ii = 0; ii < 16; ii += 2) {
      float kv2[2];
#pragma unroll
      for (int u = 0; u < 2; ++u) { const int i = 16 * tg + ii + u; const float bi = dir == 0 ? off_lo + cs[ii + u] : off_hi + run - cs[ii + u] + g[ii + u];
        kv2[u] = bf2f(KR[i * 64 + d]) * __builtin_amdgcn_exp2f(tall - bi); }
      pk[ii >> 1] = cvtpk(kv2[0], kv2[1]); }
    char* dst = lds + (dir ? L_KSTB : L_KSTF) + d * RB + 32 * tg;
    *(uint4*)dst = make_uint4(pk[0], pk[1], pk[2], pk[3]); *(uint4*)(dst + 16) = make_uint4(pk[4], pk[5], pk[6], pk[7]);
    if (tg == 0) dec_out[dir * dec_dir_stride + d] = __builtin_amdgcn_exp2f(tall);
  } else {
    bf16_t* Qx = (bf16_t*)(lds + (dir ? L_QB : L_QF)); bf16_t* Kx = (bf16_t*)(lds + (dir ? L_KB : L_KF));
#pragma unroll
    for (int ii = 0; ii < 16; ++ii) { const int i = 16 * tg + ii; const float bi = dir == 0 ? off_lo + cs[ii] : off_hi + run - cs[ii] + g[ii];
      const float qv = bf2f(QR[i * 64 + d]) * 0.125f, kv = bf2f(KR[i * 64 + d]);
      Qx[i * (RB / 2) + d] = (bf16_t)f2bf(qv * __builtin_amdgcn_exp2f(bi)); Kx[i * (RB / 2) + d] = (bf16_t)f2bf(kv * __builtin_amdgcn_exp2f(-bi)); }
  }
  __syncthreads();
}

__device__ __forceinline__ void g1_item(char* lds, const bf16_t* projb, const float* wdec, const float* bdec, int b, int hh, int c, float* kvt, float* dec) {
  int tid_ = threadIdx.x; asm volatile("" : "+v"(tid_)); const int tid = tid_, wid = tid >> 6, lane = tid & 63, r32 = lane & 31, hi = lane >> 5;
  const int bh = b * 4 + hh; const long item = (long)bh * 128 + c, dstride = 8L * 128;
  prep<true>(lds, projb, wdec, bdec, b * SEQ + c * 64, hh, dec + item * 64, dstride * 64);
  const int vblk = wid >> 1, dblk = wid & 1;
  bf16x8 vf[4]; v_frags((int)(uintptr_t)(lds + L_V) + v_rd_base(lane) + vblk * 512, vf);
#pragma unroll
  for (int dir = 0; dir < 2; ++dir) { const char* kst = lds + (dir ? L_KSTB : L_KSTF); f32x16 acc = {};
#pragma unroll
    for (int ks = 0; ks < 4; ++ks) acc = __builtin_amdgcn_mfma_f32_32x32x16_bf16(vf[ks], frag(kst, dblk * 32 + r32, ks, hi), acc, 0, 0, 0);
    float* o = kvt + ((long)dir * dstride + item) * 8192 + (size_t)(vblk * 32) * 64 + dblk * 32 + r32;
#pragma unroll
    for (int r = 0; r < 16; ++r) o[crow(r, hi) * 64] = acc[r]; }
  __syncthreads();
}

__device__ __forceinline__ void g3_item(char* lds, const bf16_t* projb, const float* wdec, const float* bdec, const float* normg, int b, int hh, int c, const bf16_t* st, bf16_t* out, int ldo) {
  int tid_ = threadIdx.x; asm volatile("" : "+v"(tid_)); const int tid = tid_, wid = tid >> 6, lane = tid & 63, r32 = lane & 31, hi = lane >> 5;
  const int bh = b * 4 + hh, t0 = b * SEQ + c * 64; const long item = (long)bh * 128 + c, dstride = 8L * 128;
#pragma unroll
  for (int e4 = 0; e4 < 4; ++e4) { const int e = tid + e4 * 512, dir = e >> 10, v = (e >> 3) & 127, dc = (e & 7) * 8;
    *(uint4*)(lds + (dir ? L_STB : L_STF) + v * RB + dc * 2) = *(const uint4*)(st + ((long)dir * dstride + item) * 8192 + (size_t)v * 64 + dc); }
  prep<false>(lds, projb, wdec, bdec, t0, hh, nullptr, 0);
  const int ib = wid & 1, vblk = wid >> 1, iglob = ib * 32 + r32;
  bf16_t rgr[16];
#pragma unroll
  for (int r = 0; r < 16; ++r) rgr[r] = projb[(size_t)(t0 + ib * 32 + crow(r, hi)) * DINP + OFF_GR + hh * 128 + vblk * 32 + r32];
  f32x16 pF0 = {}, pF1 = {}, pB0 = {}, pB1 = {};
#pragma unroll
  for (int ks = 0; ks < 4; ++ks) {
    const bf16x8 qf = frag(lds + L_QF, iglob, ks, hi), qb = frag(lds + L_QB, iglob, ks, hi);
    pF0 = __builtin_amdgcn_mfma_f32_32x32x16_bf16(frag(lds + L_KF, r32, ks, hi), qf, pF0, 0, 0, 0);
    pF1 = __builtin_amdgcn_mfma_f32_32x32x16_bf16(frag(lds + L_KF, 32 + r32, ks, hi), qf, pF1, 0, 0, 0);
    pB0 = __builtin_amdgcn_mfma_f32_32x32x16_bf16(frag(lds + L_KB, r32, ks, hi), qb, pB0, 0, 0, 0);
    pB1 = __builtin_amdgcn_mfma_f32_32x32x16_bf16(frag(lds + L_KB, 32 + r32, ks, hi), qb, pB1, 0, 0, 0); }
#pragma unroll
  for (int r = 0; r < 16; ++r) { const int j0 = crow(r, hi), j1 = 32 + j0;
    pF0[r] = (j0 <= iglob ? pF0[r] : 0.f) + (j0 >= iglob ? pB0[r] : 0.f);
    pF1[r] = (j1 <= iglob ? pF1[r] : 0.f) + (j1 >= iglob ? pB1[r] : 0.f); }
  bf16x8 pa0, pa1, pa2, pa3;
#define PK4(P, BASE, OUT) do { unsigned a0 = cvtpk(P[BASE + 0], P[BASE + 1]), a1 = cvtpk(P[BASE + 2], P[BASE + 3]);   \
    unsigned b0 = cvtpk(P[BASE + 4], P[BASE + 5]), b1 = cvtpk(P[BASE + 6], P[BASE + 7]);                              \
    auto r0 = __builtin_amdgcn_permlane32_swap(a0, b0, false, false); auto r1 = __builtin_amdgcn_permlane32_swap(a1, b1, false, false); \
    u32x4 w = {r0[0], r1[0], r0[1], r1[1]}; OUT = *reinterpret_cast<bf16x8*>(&w); } while (0)
  PK4(pF0, 0, pa0); PK4(pF0, 8, pa1); PK4(pF1, 0, pa2); PK4(pF1, 8, pa3);
#undef PK4
  bf16x8 vf[4]; v_frags((int)(uintptr_t)(lds + L_V) + v_rd_base(lane) + vblk * 512, vf);
  f32x16 o = {};
  o = __builtin_amdgcn_mfma_f32_32x32x16_bf16(pa0, vf[0], o, 0, 0, 0); o = __builtin_amdgcn_mfma_f32_32x32x16_bf16(pa1, vf[1], o, 0, 0, 0);
  o = __builtin_amdgcn_mfma_f32_32x32x16_bf16(pa2, vf[2], o, 0, 0, 0); o = __builtin_amdgcn_mfma_f32_32x32x16_bf16(pa3, vf[3], o, 0, 0, 0);
#pragma unroll
  for (int ks = 0; ks < 4; ++ks) {
    o = __builtin_amdgcn_mfma_f32_32x32x16_bf16(frag(lds + L_QF, iglob, ks, hi), frag(lds + L_STF, vblk * 32 + r32, ks, hi), o, 0, 0, 0);
    o = __builtin_amdgcn_mfma_f32_32x32x16_bf16(frag(lds + L_QB, iglob, ks, hi), frag(lds + L_STB, vblk * 32 + r32, ks, hi), o, 0, 0, 0); }
  float* RS = (float*)(lds + L_RSUM);
  float ss[16];
#pragma unroll
  for (int r = 0; r < 16; ++r) { float s = o[r] * o[r]; s += __shfl_xor(s, 1); s += __shfl_xor(s, 2); s += __shfl_xor(s, 4); s += __shfl_xor(s, 8); s += __shfl_xor(s, 16); ss[r] = s; }
  if (r32 == 0) {
#pragma unroll
    for (int r = 0; r < 16; ++r) RS[(ib * 4 + vblk) * 32 + crow(r, hi)] = ss[r]; }
  __syncthreads();
  const int v = vblk * 32 + r32; const float ng = normg[v];
#pragma unroll
  for (int r = 0; r < 16; ++r) { const int il = crow(r, hi), i = ib * 32 + il;
    const float tot = (RS[(ib * 4 + 0) * 32 + il] + RS[(ib * 4 + 1) * 32 + il]) + (RS[(ib * 4 + 2) * 32 + il] + RS[(ib * 4 + 3) * 32 + il]);
    const float rstd = 1.f / sqrtf(tot * (1.f / 128.f) + RMS_EPS);
    const float rg = bf2f(rgr[r]);
    out[(size_t)(t0 + i) * ldo + hh * 128 + v] = (bf16_t)f2bf(o[r] * rstd * ng * (rg * __builtin_amdgcn_rcpf(1.f + __builtin_amdgcn_exp2f(-1.4426950408889634f * rg)))); }
  __syncthreads();
}
}

__device__ __forceinline__ void ln_core(float4 (&v)[4], const float* g, const float* b, float* out, bf16_t* outb, int lane) {
    float s = 0.f;
#pragma unroll
    for (int j = 0; j < 4; ++j) s += (v[j].x + v[j].y) + (v[j].z + v[j].w);
    const float mean = wave_sum(s) * (1.f / DM); float s2 = 0.f;
#pragma unroll
    for (int j = 0; j < 4; ++j) { v[j].x -= mean; v[j].y -= mean; v[j].z -= mean; v[j].w -= mean; s2 += (v[j].x * v[j].x + v[j].y * v[j].y) + (v[j].z * v[j].z + v[j].w * v[j].w); }
    const float rstd = 1.f / sqrtf(wave_sum(s2) * (1.f / DM) + LN_EPS);
#pragma unroll
    for (int j = 0; j < 4; ++j) {
        const float4 gg = ((const float4*)g)[lane + 64 * j], bb = ((const float4*)b)[lane + 64 * j];
        float4 o; o.x = v[j].x * rstd * gg.x + bb.x; o.y = v[j].y * rstd * gg.y + bb.y; o.z = v[j].z * rstd * gg.z + bb.z; o.w = v[j].w * rstd * gg.w + bb.w;
        ((float4*)out)[lane + 64 * j] = o; v[j] = o;
        if (outb) ((uint2*)outb)[lane + 64 * j] = make_uint2(pk2(o.x, o.y), pk2(o.z, o.w));
    }
}
__device__ __forceinline__ void wave_sum2(float& a, float& b) {
#pragma unroll
    for (int o = 1; o < 64; o <<= 1) { const float ta = __shfl_xor(a, o), tb = __shfl_xor(b, o); a += ta; b += tb; }
}
template <int MODE>
__device__ __forceinline__ void ln_core2(float4 (&v)[2][4], const float* g, const float* b, float* out0, float* out1, bf16_t* ob0, bf16_t* ob1, int lane, unsigned char* o8_0 = nullptr, unsigned char* o8_1 = nullptr) {
    float s[2] = {0.f, 0.f};
#pragma unroll
    for (int u = 0; u < 2; ++u)
#pragma unroll
        for (int j = 0; j < 4; ++j) s[u] += (v[u][j].x + v[u][j].y) + (v[u][j].z + v[u][j].w);
    wave_sum2(s[0], s[1]);
    float q[2] = {0.f, 0.f};
#pragma unroll
    for (int u = 0; u < 2; ++u) { const float mean = s[u] * (1.f / DM);
#pragma unroll
        for (int j = 0; j < 4; ++j) { v[u][j].x -= mean; v[u][j].y -= mean; v[u][j].z -= mean; v[u][j].w -= mean; q[u] += (v[u][j].x * v[u][j].x + v[u][j].y * v[u][j].y) + (v[u][j].z * v[u][j].z + v[u][j].w * v[u][j].w); } }
    wave_sum2(q[0], q[1]);
#pragma unroll
    for (int j = 0; j < 4; ++j) {
        const float4 gg = ((const float4*)g)[lane + 64 * j], bb = ((const float4*)b)[lane + 64 * j];
#pragma unroll
        for (int u = 0; u < 2; ++u) { const float rstd = 1.f / sqrtf(q[u] * (1.f / DM) + LN_EPS);
            float4 o; o.x = v[u][j].x * rstd * gg.x + bb.x; o.y = v[u][j].y * rstd * gg.y + bb.y; o.z = v[u][j].z * rstd * gg.z + bb.z; o.w = v[u][j].w * rstd * gg.w + bb.w;
            v[u][j] = o;
            if constexpr (MODE == 2) ((float4*)(u ? out1 : out0))[lane + 64 * j] = o;
            else ((uint2*)(u ? ob1 : ob0))[lane + 64 * j] = make_uint2(pk2(o.x, o.y), pk2(o.z, o.w));
            if constexpr (MODE == 1) ((unsigned*)(u ? o8_1 : o8_0))[lane + 64 * j] = pk4_fp8(o.x, o.y, o.z, o.w); }
    }
}
__device__ __forceinline__ int block_excl_scan(int x, int* scr, int tid, int& total) {
    const int lane = tid & 63, wid = tid >> 6; int inc = x;
#pragma unroll
    for (int o = 1; o < 64; o <<= 1) { const int y = __shfl_up(inc, o); if (lane >= o) inc += y; }
    __syncthreads();
    if (lane == 63) scr[wid] = inc;
    __syncthreads();
    int base = 0, tot = 0;
#pragma unroll
    for (int w = 0; w < 8; ++w) { const int c = scr[w]; base += (w < wid) ? c : 0; tot += c; }
    total = tot; return base + inc - x;
}

__device__ __forceinline__ void tb_load(float (&v)[32], const float* Wblk, int ldw, int lane) {
#pragma unroll
    for (int i = 0; i < 32; ++i) v[i] = __builtin_nontemporal_load(&Wblk[(size_t)(2 * i + (lane >> 5)) * ldw + (lane & 31)]);
}
__device__ __forceinline__ void tb_store(const float (&v)[32], bf16_t* dst, int ldt, float* scr, int lane) {
#pragma unroll
    for (int i = 0; i < 32; ++i) scr[(2 * i + (lane >> 5)) * 33 + (lane & 31)] = v[i];
    asm volatile("s_waitcnt lgkmcnt(0)" ::: "memory");
    const int c = lane & 7;
#pragma unroll
    for (int j = 0; j < 4; ++j) { const int n = (lane >> 3) + 8 * j; const float* s = scr + (8 * c) * 33 + n;
        uint4 o; o.x = pk2(s[0 * 33], s[1 * 33]); o.y = pk2(s[2 * 33], s[3 * 33]); o.z = pk2(s[4 * 33], s[5 * 33]); o.w = pk2(s[6 * 33], s[7 * 33]);
        *(uint4*)(dst + (size_t)n * ldt + 8 * c) = o; }
    asm volatile("s_waitcnt lgkmcnt(0)" ::: "memory");
}

__device__ __forceinline__ void tb_store8(const float (&v)[32], unsigned char* dst, int ldt, float sc, float* scr, int lane) {
#pragma unroll
    for (int i = 0; i < 32; ++i) scr[(2 * i + (lane >> 5)) * 33 + (lane & 31)] = v[i];
    asm volatile("s_waitcnt lgkmcnt(0)" ::: "memory");
    const int c = lane & 7;
#pragma unroll
    for (int j = 0; j < 4; ++j) { const int n = (lane >> 3) + 8 * j; const float* s = scr + (8 * c) * 33 + n;
        *(uint2*)(dst + (size_t)n * ldt + 8 * c) = make_uint2(pk4_fp8(s[0 * 33] * sc, s[1 * 33] * sc, s[2 * 33] * sc, s[3 * 33] * sc), pk4_fp8(s[4 * 33] * sc, s[5 * 33] * sc, s[6 * 33] * sc, s[7 * 33] * sc)); }
    asm volatile("s_waitcnt lgkmcnt(0)" ::: "memory");
}

__device__ __forceinline__ void ln_row(const float* a, const float* add, float alpha, const float* g, const float* b, float* out, int lane, float4 (&v)[4], bf16_t* outb = nullptr) {
    float s = 0.f;
#pragma unroll
    for (int j = 0; j < 4; ++j) {
        float4 x = ((const float4*)a)[lane + 64 * j];
        x.x *= alpha; x.y *= alpha; x.z *= alpha; x.w *= alpha;
        if (add) { const float4 y = ((const float4*)add)[lane + 64 * j]; x.x += y.x; x.y += y.y; x.z += y.z; x.w += y.w; }
        v[j] = x; s += (x.x + x.y) + (x.z + x.w);
    }
    const float mean = wave_sum(s) * (1.f / DM); float s2 = 0.f;
#pragma unroll
    for (int j = 0; j < 4; ++j) { v[j].x -= mean; v[j].y -= mean; v[j].z -= mean; v[j].w -= mean; s2 += (v[j].x * v[j].x + v[j].y * v[j].y) + (v[j].z * v[j].z + v[j].w * v[j].w); }
    const float rstd = 1.f / sqrtf(wave_sum(s2) * (1.f / DM) + LN_EPS);
#pragma unroll
    for (int j = 0; j < 4; ++j) {
        const float4 gg = ((const float4*)g)[lane + 64 * j], bb = ((const float4*)b)[lane + 64 * j];
        float4 o; o.x = v[j].x * rstd * gg.x + bb.x; o.y = v[j].y * rstd * gg.y + bb.y; o.z = v[j].z * rstd * gg.z + bb.z; o.w = v[j].w * rstd * gg.w + bb.w;
        if (out) ((float4*)out)[lane + 64 * j] = o; v[j] = o;
        if (outb) ((uint2*)outb)[lane + 64 * j] = make_uint2(pk2(o.x, o.y), pk2(o.z, o.w));
    }
}

struct GemmP {
    const float* A; const int* ridx; const float* Bm; float* C;
    int lda, ldb, ldc, M, N, K, nb, bshift;
    long sA, sB, sC; int sR;
    const float* aux; const bf16_t* auxb; int ldaux; long sAux; const float* aux2; int accum;
};
template <int MODE>
__device__ __forceinline__ void gemm_naive(const GemmP g, float* lds) {
    float (*As)[132] = (float (*)[132])lds;
    float (*Bs)[128] = (float (*)[128])(lds + 16 * 132);
    int tid_ = threadIdx.x; asm volatile("" : "+v"(tid_));
    const int tid = tid_, ty = tid >> 4, tx = tid & 15;
    const int mt = g.M / 128, nt = (g.N + 127) / 128, per = mt * nt, total = per * g.nb;
    int bid_ = blockIdx.x; asm volatile("" : "+s"(bid_));
    for (int tile = bid_; tile < total; tile += gridDim.x) {
        const int z = tile / per, r = tile % per, tm = r / nt, tn = r % nt;
        const int m0 = tm * 128, n0 = tn * 128;
        const float* Bz = g.Bm + (long)(z >> g.bshift) * g.sB;
        float* Cz = g.C + (long)z * g.sC;
        const int arow = m0 + (tid >> 2);
        const long grow = g.ridx ? (long)g.ridx[z * g.sR + arow] : (long)arow;
        const float* Arow = g.A + (long)z * g.sA + grow * g.lda + (tid & 3) * 4;
        const int bk = tid >> 5, bn = n0 + (tid & 31) * 4;
        const bool bok = bn < g.N;
        const float* Bp = Bz + (long)bk * g.ldb + bn;
        float acc[4][8];
#pragma unroll
        for (int i = 0; i < 4; ++i)
#pragma unroll
            for (int j = 0; j < 8; ++j) acc[i][j] = 0.f;
        float4 ra = *(const float4*)(Arow);
        float4 rb = bok ? *(const float4*)(Bp) : make_float4(0.f, 0.f, 0.f, 0.f);
        for (int k0 = 0; k0 < g.K; k0 += 16) {
            __syncthreads();
            { const int rr = tid >> 2, k4 = (tid & 3) * 4; As[k4][rr] = ra.x; As[k4 + 1][rr] = ra.y; As[k4 + 2][rr] = ra.z; As[k4 + 3][rr] = ra.w; }
            *(float4*)&Bs[bk][(tid & 31) * 4] = rb;
            __syncthreads();
            if (k0 + 16 < g.K) {
                ra = *(const float4*)(Arow + k0 + 16);
                rb = bok ? *(const float4*)(Bp + (long)(k0 + 16) * g.ldb) : make_float4(0.f, 0.f, 0.f, 0.f);
            }
#pragma unroll
            for (int k = 0; k < 16; ++k) {
                const float4 a = *(const float4*)&As[k][ty * 4];
                const float4 b0 = *(const float4*)&Bs[k][tx * 8], b1 = *(const float4*)&Bs[k][tx * 8 + 4];
                const float av[4] = {a.x, a.y, a.z, a.w};
                const float bv[8] = {b0.x, b0.y, b0.z, b0.w, b1.x, b1.y, b1.z, b1.w};
#pragma unroll
                for (int i = 0; i < 4; ++i)
#pragma unroll
                    for (int j = 0; j < 8; ++j) acc[i][j] = fmaf(av[i], bv[j], acc[i][j]);
            }
        }
#pragma unroll
        for (int i = 0; i < 4; ++i) {
            const int row = m0 + ty * 4 + i;
#pragma unroll
            for (int jv = 0; jv < 2; ++jv) {
                const int col = n0 + tx * 8 + jv * 4;
                if (col < g.N) {
                    float v[4] = {acc[i][jv * 4], acc[i][jv * 4 + 1], acc[i][jv * 4 + 2], acc[i][jv * 4 + 3]};
                    float* cp = Cz + (long)row * g.ldc + col;
                    if (MODE == 1) {
#pragma unroll
                        for (int q = 0; q < 4; ++q) v[q] *= g.aux[(long)z * g.sAux + col + q];
                    } else if (MODE == 2) {
                        float gl[4]; ld4bf(g.auxb + (long)row * g.ldaux + col, gl); const float4 gb = *(const float4*)(g.aux2 + col);
                        const float gv[4] = {gl[0] + gb.x, gl[1] + gb.y, gl[2] + gb.z, gl[3] + gb.w};
                        float4 old = make_float4(0.f, 0.f, 0.f, 0.f);
                        if (g.accum) old = *(const float4*)cp;
                        const float ov[4] = {old.x, old.y, old.z, old.w};
#pragma unroll
                        for (int q = 0; q < 4; ++q) v[q] = ov[q] + sigmoidf_(gv[q]) * v[q];
                    } else if (MODE == 3) {
                        const float4 old = *(const float4*)cp; const float ov[4] = {old.x, old.y, old.z, old.w};
#pragma unroll
                        for (int q = 0; q < 4; ++q) v[q] = siluf_(ov[q]) * v[q];
                    } else if (MODE == 4) {
                        const float rs = g.aux[(long)z * g.sAux + row];
#pragma unroll
                        for (int q = 0; q < 4; ++q) v[q] *= rs;
                    }
                    *(float4*)cp = make_float4(v[0], v[1], v[2], v[3]);
                }
            }
        }
    }
    __syncthreads();
}

#define W_IN(l)    (p.in[4]  + (size_t)(l) * DM * DIN)
#define B_GATE(l)  (p.in[5]  + (size_t)(l) * 3 * DM)
#define POOL_W(l)  (p.in[6]  + (size_t)(l) * 4 * 128 * 128)
#define POOL_S(l)  (p.in[7]  + (size_t)(l) * 512)
#define W_UP_A(l)  (p.in[8]  + (size_t)(l) * 512 * DM)
#define Q_NORM(l)  (p.in[9]  + (size_t)(l) * 384)
#define W_UQ(l)    (p.in[10] + (size_t)(l) * 384 * 768)
#define KV_NORM(l) (p.in[11] + (size_t)(l) * 256)
#define W_UKV(l)   (p.in[12] + (size_t)(l) * 256 * 1024)
#define W_UP_B(l)  (p.in[13] + (size_t)(l) * 512 * DM)
#define W_DEC(l)   (p.in[14] + (size_t)(l) * 2 * 16 * 256)
#define B_DEC(l)   (p.in[15] + (size_t)(l) * 2 * 256)
#define GLA_NORM(l)(p.in[16] + (size_t)(l) * 128)
#define W_UP_C(l)  (p.in[17] + (size_t)(l) * 512 * DM)
#define W_OUT(l)   (p.in[18] + (size_t)(l) * DM * DM)
#define LN1_G(l)   (p.in[19] + (size_t)(l) * DM)
#define LN1_B(l)   (p.in[20] + (size_t)(l) * DM)
#define ROUTER(l)  (p.in[21] + (size_t)(l) * DM * NE)
#define EW_GATE(l) (p.in[22] + (size_t)(l) * NE * DM * DEXP)
#define EW_UP(l)   (p.in[23] + (size_t)(l) * NE * DM * DEXP)
#define EW_DOWN(l) (p.in[24] + (size_t)(l) * NE * DEXP * DM)
#define LN2_G(l)   (p.in[25] + (size_t)(l) * DM)
#define LN2_B(l)   (p.in[26] + (size_t)(l) * DM)
#define WSF(off) ((float*)(p.ws + (off)))
#define WSI(off) ((int*)(p.ws + (off)))
#define WSB(off) ((bf16_t*)(p.ws + (off)))
#define PJ(t, c) bf2f(projb[(size_t)(t) * DINP + (c)])

enum Stage {
    ST_INIT = 0,
    ST_WCONV,
    ST_PROJ,
    ST_PREP,
    ST_SMALLGEMM,
    ST_ROPE,
    ST_ATTN,
    ST_GLA1, ST_GLA2, ST_GLA3,
    ST_GLAFIN,
    ST_MERGE_A, ST_MERGE_B, ST_MERGE_C,
    ST_OUTP,
    ST_LN1,
    ST_TOPK,
    ST_GATHER,
    ST_EXP_G, ST_EXP_U, ST_EXP_D,
    ST_LN2,
    ST_COUNT
};

#define KAS __attribute__((address_space(4)))
template <int ST>
__device__ __forceinline__ void run_stage(int l, float* lds) {
    const KAS Params* pk_ = (const KAS Params*)__builtin_amdgcn_kernarg_segment_ptr(); asm volatile("" : "+s"(pk_));
    const KAS Params& p = *pk_;
    int tid_ = threadIdx.x; asm volatile("" : "+v"(tid_));
    int bid_ = blockIdx.x; asm volatile("" : "+s"(bid_));
    const int tid = tid_, lane = tid & 63, wid = tid >> 6;
    const int G = gridDim.x, bid = bid_;
    const int gw = bid * 8 + wid, NGW = G * 8;
    const long gt = (long)bid * NTHR + tid, NGT = (long)G * NTHR;
    float* h = p.out;

    if constexpr (ST == ST_INIT) {
        for (int m0 = gw; m0 < T; m0 += 2 * NGW) {
            const int mr[2] = {m0, m0 + NGW}; float4 a[2][4];
#pragma unroll
            for (int u = 0; u < 2; ++u)
#pragma unroll
                for (int j = 0; j < 4; ++j) a[u][j] = ((const float4*)(p.in[0] + (size_t)mr[u] * DM))[lane + 64 * j];
            ln_core2<0>(a, p.in[2], p.in[3], nullptr, nullptr, WSB(WS_HB) + (size_t)mr[0] * DM, WSB(WS_HB) + (size_t)mr[1] * DM, lane);
        }
        {
            float* scr = lds + wid * 4096;
            constexpr int NBLK = DIN / 32, ITEMS_L = (DM / 64) * NBLK;
            {
#define WIN_ITEM(it, W, dst) do { const int ll_ = (it) / ITEMS_L, r_ = (it) % ITEMS_L, kb_ = r_ / NBLK, nb_ = r_ % NBLK; const int n0_ = 32 * nb_, drow_ = n0_ < 2752 ? n0_ + 3072 : n0_ - 2752; \
                    W = p.in[4] + (size_t)ll_ * DM * DIN + (size_t)(64 * kb_) * DIN + n0_; dst = WSB(WS_WIN_T) + (size_t)ll_ * DINP * DM + (size_t)drow_ * DM + 64 * kb_; } while (0)
                float va[32], vb[32]; const float* Wa = nullptr; const float* Wb = nullptr; bf16_t* da = nullptr; bf16_t* db = nullptr;
                int itA = gw, itB = gw + NGW;
                if (itA < 2 * ITEMS_L) { WIN_ITEM(itA, Wa, da); tb_load(va, Wa, DIN, lane); }
                while (itA < 2 * ITEMS_L) {
                    if (itB < 2 * ITEMS_L) { WIN_ITEM(itB, Wb, db); tb_load(vb, Wb, DIN, lane); }
                    tb_store(va, da, DM, scr, lane);
                    itA = itB + NGW;
                    if (itB >= 2 * ITEMS_L) break;
                    if (itA < 2 * ITEMS_L) { WIN_ITEM(itA, Wa, da); tb_load(va, Wa, DIN, lane); }
                    tb_store(vb, db, DM, scr, lane);
                    itB = itA + NGW;
                }
#undef WIN_ITEM
            }
            {
                constexpr int I_UQ = 6 * 24, I_UKV = 4 * 32, I_B = 8 * 32, I_OUT = 16 * 32, I_L = I_UQ + I_UKV + 2 * I_B + I_OUT;
                for (int it = gw; it < 2 * I_L; it += NGW) {
                    const int ll = it / I_L; int r = it % I_L; bf16_t* wsm = WSB(WS_WSMALL + (size_t)ll * WSM_STRIDE);
                    if (r < I_UQ) { const int kb = r / 24, nb = r % 24; transpose_block(p.in[10] + (size_t)ll * 384 * 768 + (size_t)(64 * kb) * 768 + 32 * nb, 768, wsm + WSM_UQ / 2 + (size_t)(32 * nb) * 384 + 64 * kb, 384, p.in[9] + ll * 384 + 64 * kb, nullptr, scr, lane); continue; } r -= I_UQ;
                    if (r < I_UKV) { const int kb = r / 32, nb = r % 32; transpose_block(p.in[12] + (size_t)ll * 256 * 1024 + (size_t)(64 * kb) * 1024 + 32 * nb, 1024, wsm + WSM_UKV / 2 + (size_t)(32 * nb) * 256 + 64 * kb, 256, p.in[11] + ll * 256 + 64 * kb, nullptr, scr, lane); continue; } r -= I_UKV;
                    if (r < 2 * I_B) { const int c = r / I_B, rr = r % I_B, kb = rr / 32, nb = rr % 32; const float* W = (c ? p.in[17] : p.in[13]) + (size_t)ll * 512 * DM;
                        transpose_block(W + (size_t)(64 * kb) * DM + 32 * nb, DM, wsm + WSM_MRG / 2 + (size_t)(32 * nb) * 1536 + 512 * (1 + c) + 64 * kb, 1536, nullptr, nullptr, scr, lane); continue; } r -= 2 * I_B;
                    { const int kb = r / 32, nb = r % 32; transpose_block(p.in[18] + (size_t)ll * DM * DM + (size_t)(64 * kb) * DM + 32 * nb, DM, wsm + WSM_OUT / 2 + (size_t)(32 * nb) * DM + 64 * kb, DM, nullptr, nullptr, scr, lane); }
                }
                {
                    float* At = lds; float* Bs = lds + 128 * 129;
                    for (int it = bid; it < 2 * 4 * 32; it += G) {
                        const int ll = it >> 7, g = (it >> 5) & 3, db = it & 31;
                        const float* pw = p.in[6] + (size_t)ll * 4 * 128 * 128 + (size_t)g * 128 * 128; const float* ps = p.in[7] + ll * 512 + g * 128;
                        const float* wa = p.in[8] + (size_t)ll * 512 * DM + (size_t)(g * 128) * DM + db * 32;
                        __syncthreads();
                        for (int e = tid; e < 128 * 128; e += NTHR) { const int c = e >> 7, cp = e & 127; At[cp * 129 + c] = pw[e] * ps[cp]; }
                        for (int e = tid; e < 128 * 32; e += NTHR) { const int cp = e >> 5, dd = e & 31; Bs[cp * 32 + dd] = wa[(size_t)cp * DM + dd]; }
                        __syncthreads();
                        const int c = tid >> 2, d0 = (tid & 3) * 8;
                        float a0 = 0.f, a1 = 0.f, a2 = 0.f, a3 = 0.f, a4 = 0.f, a5 = 0.f, a6 = 0.f, a7 = 0.f;
#pragma unroll 8
                        for (int cp = 0; cp < 128; ++cp) { const float a = At[cp * 129 + c]; const float4 b0 = *(const float4*)(Bs + cp * 32 + d0), b1 = *(const float4*)(Bs + cp * 32 + d0 + 4);
                            a0 = fmaf(a, b0.x, a0); a1 = fmaf(a, b0.y, a1); a2 = fmaf(a, b0.z, a2); a3 = fmaf(a, b0.w, a3); a4 = fmaf(a, b1.x, a4); a5 = fmaf(a, b1.y, a5); a6 = fmaf(a, b1.z, a6); a7 = fmaf(a, b1.w, a7); }
                        bf16_t* o = WSB(WS_WSMALL + (size_t)ll * WSM_STRIDE + WSM_MRG) + (size_t)(db * 32 + d0) * 1536 + g * 128 + c;
                        o[0] = (bf16_t)f2bf(a0); o[1536] = (bf16_t)f2bf(a1); o[2 * 1536] = (bf16_t)f2bf(a2); o[3 * 1536] = (bf16_t)f2bf(a3);
                        o[4 * 1536] = (bf16_t)f2bf(a4); o[5 * 1536] = (bf16_t)f2bf(a5); o[6 * 1536] = (bf16_t)f2bf(a6); o[7 * 1536] = (bf16_t)f2bf(a7);
                    }
                    __syncthreads();
                }
            }
            for (long i = gt; i < 2L * 64 * DM / 8; i += NGT) { const int ll = (int)(i / (64 * DM / 8)); const long r = i % (64 * DM / 8);
                *(uint4*)(WSB(WS_WIN_T) + (size_t)ll * DINP * DM + (size_t)DIN * DM + r * 8) = make_uint4(0u, 0u, 0u, 0u); }
        }
        float* rc = WSF(WS_ROPE); float* rs = rc + T * 16;
        for (long i = gt; i < (long)T * 16; i += NGT) {
            const int t = (int)(i >> 4), j = (int)(i & 15);
            const float freq = powf(10000.0f, -(float)j / 16.0f);
            const float ang = (float)p.pos[t] * freq;
            rc[i] = cosf(ang); rs[i] = sinf(ang);
        }
    }
    if constexpr (ST == ST_WCONV) {
        float* scr = lds + wid * 4096;
        constexpr int I_G = 16 * 16 * 64, I_D = 16 * 32 * 32;
        constexpr int I_ALL = 2 * I_G + I_D;
#define WCONV_ITEM(it, W, ldw, dst, ldt, sc8) do { if ((it) < 2 * I_G) { const int up_ = (it) >= I_G, r_ = up_ ? (it) - I_G : (it), e_ = r_ >> 10, kb_ = (r_ >> 6) & 15, nb_ = r_ & 63, j0_ = nb_ * 32; \
            W = (up_ ? EW_UP(l) : EW_GATE(l)) + (size_t)e_ * DM * DEXP + (size_t)(64 * kb_) * DEXP + j0_; ldw = DEXP; \
            dst = (unsigned char*)(p.ws + WS_WGU_T) + (size_t)(e_ * 4096 + 256 * (j0_ >> 7) + (j0_ & 127) + (up_ ? 128 : 0)) * DM + 64 * kb_; ldt = DM; sc8 = F8_WGU; } \
          else { const int r_ = (it) - 2 * I_G, e_ = r_ >> 10, kb_ = (r_ >> 5) & 31, nb_ = r_ & 31; \
            W = EW_DOWN(l) + (size_t)e_ * DEXP * DM + (size_t)(64 * kb_) * DM + 32 * nb_; ldw = DM; dst = (unsigned char*)(p.ws + WS_WD_T) + (size_t)(e_ * 1024 + 32 * nb_) * DEXP + 64 * kb_; ldt = DEXP; sc8 = F8_WD; } } while (0)
        float va[32], vb[32]; const float* Wa = nullptr; const float* Wb = nullptr; unsigned char* da = nullptr; unsigned char* db = nullptr; int lwa = 0, lwb = 0, lta = 0, ltb = 0; float sa = 1.f, sb = 1.f;
        int itA = gw, itB = gw + NGW;
        if (itA < I_ALL) { WCONV_ITEM(itA, Wa, lwa, da, lta, sa); tb_load(va, Wa, lwa, lane); }
        while (itA < I_ALL) {
            if (itB < I_ALL) { WCONV_ITEM(itB, Wb, lwb, db, ltb, sb); tb_load(vb, Wb, lwb, lane); }
            tb_store8(va, da, lta, sa, scr, lane);
            itA = itB + NGW;
            if (itB >= I_ALL) break;
            if (itA < I_ALL) { WCONV_ITEM(itA, Wa, lwa, da, lta, sa); tb_load(va, Wa, lwa, lane); }
            tb_store8(vb, db, ltb, sb, scr, lane);
            itB = itA + NGW;
        }
#undef WCONV_ITEM
        __syncthreads();
    }
    if constexpr (ST == ST_PROJ) {
        pg8::Gemm g{WSB(WS_HB), WSB(WS_WIN_T) + (size_t)l * DINP * DM, T, DINP, DM, DM};
        pg8::StaticOrder S; S.init(T, DINP, G, bid);
        EpiProj E{WSB(WS_PROJB), B_GATE(l)};
        pg8::gemm_phase<EpiProj, pg8::StaticOrder, true, true>((PG8_LAS unsigned char*)lds, g, S, E);
    }
    if constexpr (ST == ST_PREP) {
        const bf16_t* projb = WSB(WS_PROJB); bf16_t* br = WSB(WS_BR); bf16_t* U = (bf16_t*)lds;
        float* rq = WSF(WS_RQ); float* rkv = rq + T; const float* rc = WSF(WS_ROPE); const float* rs = rc + T * 16; bf16_t* kb = WSB(WS_KB);
        for (int tile = bid; tile < T / 64; tile += G) {
            const int b = tile / (SEQ / 64), s0 = (tile % (SEQ / 64)) * 64, t0 = b * SEQ + s0;
            __syncthreads();
#pragma unroll
            for (int it = 0; it < 10; ++it) { const int e = tid + it * NTHR, r = e >> 6, ch = e & 63, s = s0 - 8 + r;
                uint4 v = make_uint4(0u, 0u, 0u, 0u);
                if (s >= 0 && s < SEQ) v = *(const uint4*)(projb + (size_t)(b * SEQ + s) * DINP + OFF_POOL + ch * 8);
                *(uint4*)(U + r * 512 + ch * 8) = v; }
            for (int r = wid; r < 64; r += 8) { const bf16_t* row = projb + (size_t)(t0 + r) * DINP;
                float s1 = 0.f, s2 = 0.f;
                if (lane < 48) { const uint4 w = *(const uint4*)(row + OFF_CQ + lane * 8); const unsigned ww[4] = {w.x, w.y, w.z, w.w};
#pragma unroll
                    for (int q = 0; q < 4; ++q) { const float a = __uint_as_float(ww[q] << 16), c = __uint_as_float(ww[q] & 0xffff0000u); s1 += a * a + c * c; } }
                if (lane < 32) { const uint4 w = *(const uint4*)(row + OFF_CKV + lane * 8); const unsigned ww[4] = {w.x, w.y, w.z, w.w};
#pragma unroll
                    for (int q = 0; q < 4; ++q) { const float a = __uint_as_float(ww[q] << 16), c = __uint_as_float(ww[q] & 0xffff0000u); s2 += a * a + c * c; } }
                s1 = wave_sum(s1); s2 = wave_sum(s2);
                if (lane == 0) { rq[t0 + r] = 1.f / sqrtf(s1 * (1.f / 384.f) + RMS_EPS); rkv[t0 + r] = 1.f / sqrtf(s2 * (1.f / 256.f) + RMS_EPS); } }
#pragma unroll
            for (int it = 0; it < 2; ++it) { const int e = tid + it * NTHR, r = e >> 4, j = e & 15, t = t0 + r;
                const float c = rc[(size_t)t * 16 + j], s = rs[(size_t)t * 16 + j], x1 = PJ(t, OFF_KR + j), x2 = PJ(t, OFF_KR + 16 + j);
                const bf16_t k1 = (bf16_t)f2bf(x1 * c - x2 * s), k2 = (bf16_t)f2bf(x1 * s + x2 * c);
#pragma unroll
                for (int hh = 0; hh < 8; ++hh) { kb[(size_t)t * 768 + hh * 96 + 64 + j] = k1; kb[(size_t)t * 768 + hh * 96 + 80 + j] = k2; } }
            __syncthreads();
            { const int c = tid, hw = 1 << (c >> 7); float sum = 0.f;
                for (int u = s0 - hw; u < s0 + hw; ++u) if (u >= 0 && u < SEQ) sum += bf2f(U[(u - s0 + 8) * 512 + c]);
                for (int s = s0; s < s0 + 64; ++s) {
                    int lo = s - hw; if (lo < 0) lo = 0; int hi = s + hw; if (hi > SEQ) hi = SEQ;
                    br[(size_t)(b * SEQ + s) * 1536 + c] = (bf16_t)f2bf(sum / (float)(hi - lo) - bf2f(U[(s - s0 + 8) * 512 + c]));
                    if (s + hw < SEQ) sum += bf2f(U[(s + hw - s0 + 8) * 512 + c]);
                    if (s - hw >= 0) sum -= bf2f(U[(s - hw - s0 + 8) * 512 + c]);
                } }
        }
        __syncthreads();
    }
    if constexpr (ST == ST_SMALLGEMM) {
        const bf16_t* wsm = WSB(WS_WSMALL + (size_t)l * WSM_STRIDE);
        { pg8::Gemm g{WSB(WS_PROJB) + OFF_CQ, wsm + WSM_UQ / 2, T, 768, 384, DINP}; pg8::StaticOrder S; S.init(T, 768, G, bid);
          EpiQ E{WSB(WS_QB), WSF(WS_RQ), WSF(WS_ROPE), WSF(WS_ROPE) + T * 16}; pg8::gemm_phase<EpiQ, pg8::StaticOrder, true, true>((PG8_LAS unsigned char*)lds, g, S, E); }
        { pg8::Gemm g{WSB(WS_PROJB) + OFF_CKV, wsm + WSM_UKV / 2, T, 1024, 256, DINP}; pg8::StaticOrder S; S.init(T, 1024, G, bid);
          EpiKV E{WSB(WS_KB), WSB(WS_VB), WSF(WS_RQ) + T}; pg8::gemm_phase<EpiKV, pg8::StaticOrder, true, true>((PG8_LAS unsigned char*)lds, g, S, E); }
    }
    if constexpr (ST == ST_ATTN) {
        const int vcu = (G % 8 == 0) ? (bid % 8) * (G / 8) + bid / 8 : bid;
        WStream wst; wst.gate = EW_GATE(l); wst.up = EW_UP(l); wst.down = EW_DOWN(l); wst.wgu_t = p.ws + WS_WGU_T; wst.wd_t = p.ws + WS_WD_T;
        { const int wu = __builtin_amdgcn_readfirstlane(wid); wst.init(bid * 8 + wu, NGW, (char*)lds + att::SHM_ATTN + wu * 2560, lane); }
        for (int L = vcu; L < NB * 8 * 32; L += G) {
            const int bh = L >> 5, qb = L & 31, b = bh >> 3, hh = bh & 7;
            att::attn_unit(WSB(WS_QB) + (size_t)(b * SEQ + qb * 256) * 768 + hh * 96, WSB(WS_KB) + (size_t)(b * SEQ) * 768 + hh * 96, WSB(WS_VB) + (size_t)(b * SEQ) * 512 + hh * 64,
                           WSB(WS_BR) + (size_t)(b * SEQ + qb * 256) * 1536 + 512 + hh * 64, SEQ, (char*)lds, wst);
        }
        while (wst.step <= wst.nsteps) wst.tick(lane);
        __syncthreads();
    }
    if constexpr (ST == ST_GLA1) {
        for (int item = bid; item < NB * 4 * 128; item += G) {
            const int b = item >> 9, hh = (item >> 7) & 3, c = item & 127;
            gla::g1_item((char*)lds, WSB(WS_PROJB), W_DEC(l), B_DEC(l), b, hh, c, WSF(WS_KVT), WSF(WS_DEC));
        }
    }
    if constexpr (ST == ST_GLA2) {
        const float* kvt = WSF(WS_KVT); const float* dec = WSF(WS_DEC); bf16_t* stp = WSB(WS_ST);
        for (long e = gt; e < 2L * 8 * 8192; e += NGT) {
            const int dir = (int)(e >> 16), bh = (int)((e >> 13) & 7), vd = (int)(e & 8191), d = vd & 63;
            const long base = ((long)dir * 8 + bh) * 128;
            float s = 0.f;
#pragma unroll 1
            for (int k0 = 0; k0 < 128; k0 += 32) {
                float kv[32], dc[32];
#pragma unroll
                for (int k = 0; k < 32; ++k) { const int c = dir ? 127 - (k0 + k) : k0 + k; kv[k] = kvt[(base + c) * 8192 + vd]; dc[k] = dec[(base + c) * 64 + d]; }
#pragma unroll
                for (int k = 0; k < 32; ++k) { const int c = dir ? 127 - (k0 + k) : k0 + k; stp[(base + c) * 8192 + vd] = (bf16_t)f2bf(s); s = fmaf(dc[k], s, kv[k]); }
            }
        }
    }
    if constexpr (ST == ST_GLA3) {
        for (int item = bid; item < NB * 4 * 128; item += G) {
            const int b = item >> 9, hh = (item >> 7) & 3, c = item & 127;
            gla::g3_item((char*)lds, WSB(WS_PROJB), W_DEC(l), B_DEC(l), GLA_NORM(l), b, hh, c, WSB(WS_ST), WSB(WS_BR) + 1024, 1536);
        }
    }
    if constexpr (ST == ST_MERGE_A) {
        const bf16_t* wsm = WSB(WS_WSMALL + (size_t)l * WSM_STRIDE);
        pg8::Gemm g{WSB(WS_BR), wsm + WSM_MRG / 2, T, DM, 1536, 1536}; pg8::StaticOrder S; S.init(T, DM, G, bid);
        EpiMerge E{WSB(WS_MERGEDB), WSB(WS_PROJB) + OFF_GATE};
        pg8::gemm_phase<EpiMerge, pg8::StaticOrder, true, true>((PG8_LAS unsigned char*)lds, g, S, E);
    }
    if constexpr (ST == ST_OUTP) {
        const bf16_t* wsm = WSB(WS_WSMALL + (size_t)l * WSM_STRIDE);
        pg8::Gemm g{WSB(WS_MERGEDB), wsm + WSM_OUT / 2, T, DM, DM, DM}; pg8::StaticOrder S; S.init(T, DM, G, bid);
        pg8::EpiBf16<0> E{WSB(WS_TMP), DM, nullptr, 0, 0, 1.f};
        pg8::gemm_phase<pg8::EpiBf16<0>, pg8::StaticOrder, true, true>((PG8_LAS unsigned char*)lds, g, S, E);
    }
    if constexpr (ST == ST_LN1) {
        float* RWT = lds; const float* rw = ROUTER(l);
        for (int i = tid; i < DM * 4; i += NTHR) { const int k = i >> 2, e4 = (i & 3) * 4; const float4 w = *(const float4*)(rw + (size_t)k * 16 + e4);
            RWT[(e4 + 0) * DM + k] = w.x; RWT[(e4 + 1) * DM + k] = w.y; RWT[(e4 + 2) * DM + k] = w.z; RWT[(e4 + 3) * DM + k] = w.w; }
        __syncthreads();
        float* afft = WSF(WS_AFF);
        for (int m0 = gw; m0 < T; m0 += 2 * NGW) {
            const int mr[2] = {m0, m0 + NGW};
            float4 hv[2][4];
#pragma unroll
            for (int u = 0; u < 2; ++u) { const bf16_t* hr = WSB(WS_HB) + (size_t)mr[u] * DM; const bf16_t* tr = WSB(WS_TMP) + (size_t)mr[u] * DM;
#pragma unroll
                for (int j = 0; j < 4; ++j) { float a[4], t4[4]; ld4bf(hr + 4 * (lane + 64 * j), a); ld4bf(tr + 4 * (lane + 64 * j), t4);
                    hv[u][j] = make_float4(fmaf(ALPHA, a[0], t4[0]), fmaf(ALPHA, a[1], t4[1]), fmaf(ALPHA, a[2], t4[2]), fmaf(ALPHA, a[3], t4[3])); } }
            ln_core2<1>(hv, LN1_G(l), LN1_B(l), nullptr, nullptr, WSB(WS_HB) + (size_t)mr[0] * DM, WSB(WS_HB) + (size_t)mr[1] * DM, lane,
                     p.ws + WS_HB8 + (size_t)mr[0] * DM, p.ws + WS_HB8 + (size_t)mr[1] * DM);
            float acc[2][16];
#pragma unroll
            for (int e = 0; e < 16; ++e) { float a0 = 0.f, a1 = 0.f;
#pragma unroll
                for (int j = 0; j < 4; ++j) { const float4 w = *(const float4*)(RWT + e * DM + 4 * (lane + 64 * j));
                    a0 = fmaf(hv[0][j].x, w.x, a0); a0 = fmaf(hv[0][j].y, w.y, a0); a0 = fmaf(hv[0][j].z, w.z, a0); a0 = fmaf(hv[0][j].w, w.w, a0);
                    a1 = fmaf(hv[1][j].x, w.x, a1); a1 = fmaf(hv[1][j].y, w.y, a1); a1 = fmaf(hv[1][j].z, w.z, a1); a1 = fmaf(hv[1][j].w, w.w, a1); }
                acc[0][e] = a0; acc[1][e] = a1; if (e & 1) __builtin_amdgcn_sched_barrier(0); }
#pragma unroll
            for (int i = 0; i < 8; ++i)
#pragma unroll
                for (int u = 0; u < 2; ++u) { const bool up = lane & 32; const float keep = up ? acc[u][i + 8] : acc[u][i], send = up ? acc[u][i] : acc[u][i + 8]; acc[u][i] = keep + __shfl_xor(send, 32); }
#pragma unroll
            for (int i = 0; i < 4; ++i)
#pragma unroll
                for (int u = 0; u < 2; ++u) { const bool up = lane & 16; const float keep = up ? acc[u][i + 4] : acc[u][i], send = up ? acc[u][i] : acc[u][i + 4]; acc[u][i] = keep + __shfl_xor(send, 16); }
#pragma unroll
            for (int i = 0; i < 2; ++i)
#pragma unroll
                for (int u = 0; u < 2; ++u) { const bool up = lane & 8; const float keep = up ? acc[u][i + 2] : acc[u][i], send = up ? acc[u][i] : acc[u][i + 2]; acc[u][i] = keep + __shfl_xor(send, 8); }
#pragma unroll
            for (int u = 0; u < 2; ++u) { const bool up = lane & 4; const float keep = up ? acc[u][1] : acc[u][0], send = up ? acc[u][0] : acc[u][1]; acc[u][0] = keep + __shfl_xor(send, 4); }
            float lg[2] = {acc[0][0], acc[1][0]};
#pragma unroll
            for (int o = 1; o <= 2; o <<= 1) { const float t0 = __shfl_xor(lg[0], o), t1 = __shfl_xor(lg[1], o); lg[0] += t0; lg[1] += t1; }
            float mx[2] = {lg[0], lg[1]};
#pragma unroll
            for (int o = 4; o <= 32; o <<= 1) { const float t0 = __shfl_xor(mx[0], o), t1 = __shfl_xor(mx[1], o); mx[0] = fmaxf(mx[0], t0); mx[1] = fmaxf(mx[1], t1); }
            const float ex[2] = {expf(lg[0] - mx[0]), expf(lg[1] - mx[1])}; float se[2] = {ex[0], ex[1]};
#pragma unroll
            for (int o = 4; o <= 32; o <<= 1) { const float t0 = __shfl_xor(se[0], o), t1 = __shfl_xor(se[1], o); se[0] += t0; se[1] += t1; }
            if ((lane & 3) == 0) { const int e = ((lane >> 5) & 1) * 8 + ((lane >> 4) & 1) * 4 + ((lane >> 3) & 1) * 2 + ((lane >> 2) & 1);
#pragma unroll
                for (int u = 0; u < 2; ++u) afft[(size_t)((mr[u] / SEQ) * 16 + e) * SEQ + (mr[u] % SEQ)] = ex[u] / se[u]; }
        }
        __syncthreads();
    }
    if constexpr (ST == ST_TOPK) {
        const float* afft = WSF(WS_AFF); int* idx = WSI(WS_IDX); float* gv = WSF(WS_GATEV); int* slot = WSI(WS_SLOT);
        int* hist = (int*)lds; int* ctl = hist + 256; int* scr = hist + 272;
        for (int z = bid; z < NZ; z += G) {
            const int e = z >> 1, b = z & 1; const float* list = afft + (size_t)(b * 16 + e) * SEQ;
            unsigned key[16];
#pragma unroll
            for (int j = 0; j < 16; j += 4) { const float4 x = *(const float4*)(list + tid * 16 + j); key[j] = __float_as_uint(x.x); key[j + 1] = __float_as_uint(x.y); key[j + 2] = __float_as_uint(x.z); key[j + 3] = __float_as_uint(x.w); }
            unsigned prefix = 0u; int need = CAP;
#pragma unroll 1
            for (int shift = 24; shift >= 0; shift -= 8) {
                __syncthreads();
                if (tid < 256) hist[tid] = 0;
                __syncthreads();
#pragma unroll
                for (int j = 0; j < 16; ++j) { const bool in = (shift == 24) || ((key[j] >> (shift + 8)) == (prefix >> (shift + 8))); if (in) atomicAdd(&hist[(key[j] >> shift) & 255u], 1); }
                __syncthreads();
                if (tid < 256) {
                    const int hc = hist[tid]; int inc = hc;
#pragma unroll
                    for (int o = 1; o < 64; o <<= 1) { const int y = __shfl_down(inc, o); if (lane + o < 64) inc += y; }
                    if (lane == 0) scr[wid] = inc;
                    __builtin_amdgcn_s_waitcnt(0xc07f); __builtin_amdgcn_wave_barrier();
                }
                __syncthreads();
                if (tid < 256) {
                    const int hc = hist[tid]; int inc = hc;
#pragma unroll
                    for (int o = 1; o < 64; o <<= 1) { const int y = __shfl_down(inc, o); if (lane + o < 64) inc += y; }
                    int ca = inc - hc;
#pragma unroll
                    for (int w = 1; w < 4; ++w) ca += (w > wid) ? scr[w] : 0;
                    if (ca < need && need <= ca + hc) { ctl[0] = tid; ctl[1] = need - ca; } }
                __syncthreads();
                prefix |= (unsigned)ctl[0] << shift; need = ctl[1];
            }
            int ceq = 0;
#pragma unroll
            for (int j = 0; j < 16; ++j) ceq += (key[j] == prefix) ? 1 : 0;
            int tot; const int beq = block_excl_scan(ceq, scr, tid, tot);
            int csel = 0, eqr = beq; unsigned selmask = 0u;
#pragma unroll
            for (int j = 0; j < 16; ++j) { bool sel = key[j] > prefix; if (key[j] == prefix) { sel = eqr < need; ++eqr; } if (sel) { selmask |= 1u << j; ++csel; } }
            int sl = block_excl_scan(csel, scr, tid, tot);
#pragma unroll
            for (int j = 0; j < 16; ++j) { const int trow = b * SEQ + tid * 16 + j;
                if ((selmask >> j) & 1u) { idx[z * CAP + sl] = trow; gv[z * CAP + sl] = __uint_as_float(key[j]); slot[(size_t)trow * 16 + e] = sl; ++sl; }
                else slot[(size_t)trow * 16 + e] = -1; }
        }
        __syncthreads();
    }
    if constexpr (ST == ST_GATHER) {
        const int* idx = WSI(WS_IDX); const bf16_t* hb = WSB(WS_HB); bf16_t* xe = WSB(WS_XE);
        const int nr = (NZ * CAP - gw + NGW - 1) / NGW; const int myi = (lane < nr) ? (idx[gw + lane * NGW] & (T - 1)) : 0;
        for (int k = 0; k < nr; k += 4) {
            const int k1 = (k + 1 < nr) ? k + 1 : k, k2 = (k + 2 < nr) ? k + 2 : k, k3 = (k + 3 < nr) ? k + 3 : k;
            const uint4* s0 = (const uint4*)(hb + (size_t)__shfl(myi, k) * DM); const uint4* s1 = (const uint4*)(hb + (size_t)__shfl(myi, k1) * DM);
            const uint4* s2 = (const uint4*)(hb + (size_t)__shfl(myi, k2) * DM); const uint4* s3 = (const uint4*)(hb + (size_t)__shfl(myi, k3) * DM);
            const uint4 x0 = s0[lane], y0 = s0[lane + 64], x1 = s1[lane], y1 = s1[lane + 64], x2 = s2[lane], y2 = s2[lane + 64], x3 = s3[lane], y3 = s3[lane + 64];
            { uint4* d = (uint4*)(xe + (size_t)(gw + k * NGW) * DM); d[lane] = x0; d[lane + 64] = y0; }
            if (k + 1 < nr) { uint4* d = (uint4*)(xe + (size_t)(gw + (k + 1) * NGW) * DM); d[lane] = x1; d[lane + 64] = y1; }
            if (k + 2 < nr) { uint4* d = (uint4*)(xe + (size_t)(gw + (k + 2) * NGW) * DM); d[lane] = x2; d[lane + 64] = y2; }
            if (k + 3 < nr) { uint4* d = (uint4*)(xe + (size_t)(gw + (k + 3) * NGW) * DM); d[lane] = x3; d[lane + 64] = y3; }
        }
    }
    if constexpr (ST == ST_EXP_G) {
        pg8::Gemm g{WSB(WS_HB8), WSB(WS_WGU_T), NZ * CAP, 16 * 4096, DM / 2, DM / 2, WSI(WS_IDX)};
        ExpertOrder1 S; S.init(G, bid);
        EpiSwiGLU E{WSB(WS_HID), DEXP};
        pg8::gemm_phase<EpiSwiGLU, ExpertOrder1, true, true, true, true>((PG8_LAS unsigned char*)lds, g, S, E);
    }
    if constexpr (ST == ST_EXP_D) {
        pg8::Gemm g{WSB(WS_HID), WSB(WS_WD_T), NZ * CAP, 16 * 1024, DEXP / 2, DEXP / 2};
        ExpertOrder2 S; S.init(G, bid);
        EpiRowScale E{WSB(WS_YE), DM, WSF(WS_GATEV)};
        pg8::gemm_phase<EpiRowScale, ExpertOrder2, true, true, false, true>((PG8_LAS unsigned char*)lds, g, S, E);
    }
    if constexpr (ST == ST_LN2) {
        const int* slot = WSI(WS_SLOT); const bf16_t* ye = WSB(WS_YE);
        for (int m0 = gw; m0 < T; m0 += 2 * NGW) {
            const int mr[2] = {m0, m0 + NGW};
            int sl[2]; unsigned long long mask[2]; float4 a[2][4];
#pragma unroll
            for (int u = 0; u < 2; ++u) { sl[u] = (lane < 16) ? slot[(size_t)mr[u] * 16 + lane] : -1; }
#pragma unroll
            for (int u = 0; u < 2; ++u) { const bf16_t* hr = WSB(WS_HB) + (size_t)mr[u] * DM;
#pragma unroll
                for (int j = 0; j < 4; ++j) { float x[4]; ld4bf(hr + 4 * (lane + 64 * j), x); a[u][j] = make_float4(ALPHA * x[0], ALPHA * x[1], ALPHA * x[2], ALPHA * x[3]); } }
            mask[0] = __ballot(sl[0] >= 0); mask[1] = __ballot(sl[1] >= 0);
            while (mask[0] | mask[1]) {
#pragma unroll
                for (int u = 0; u < 2; ++u) if (mask[u]) {
                    const int e = __builtin_ctzll(mask[u]); mask[u] &= mask[u] - 1;
                    const bf16_t* yr = ye + ((size_t)(e * 2 + mr[u] / SEQ) * CAP + __shfl(sl[u], e)) * DM;
#pragma unroll
                    for (int j = 0; j < 4; ++j) { float y[4]; ld4bf(yr + 4 * (lane + 64 * j), y); a[u][j].x += y[0]; a[u][j].y += y[1]; a[u][j].z += y[2]; a[u][j].w += y[3]; }
                }
            }
            if (l == 0) ln_core2<0>(a, LN2_G(l), LN2_B(l), nullptr, nullptr, WSB(WS_HB) + (size_t)mr[0] * DM, WSB(WS_HB) + (size_t)mr[1] * DM, lane);
            else ln_core2<2>(a, LN2_G(l), LN2_B(l), h + (size_t)mr[0] * DM, h + (size_t)mr[1] * DM, nullptr, nullptr, lane);
        }
    }
}


#define LAS __attribute__((address_space(3)))
#define XB_TMO      128
#define XB_XCNT(j)  (256  + 64 * (j))
#define XB_XSUB(j)  (1280 + 64 * (j))
#define XB_XGEN(j)  (2304 + 64 * (j))
#define XB_TOP      3328
#define XB_TOPGEN   3392
#define XCD_BAR_WORDS 3456
#define XB_SPIN_CAP (1u << 18)
__device__ __forceinline__ unsigned xb_ld(unsigned* p)              { return __hip_atomic_load(p, __ATOMIC_RELAXED, __HIP_MEMORY_SCOPE_AGENT); }
__device__ __forceinline__ unsigned xb_add(unsigned* p, unsigned v) { return __hip_atomic_fetch_add(p, v, __ATOMIC_RELAXED, __HIP_MEMORY_SCOPE_AGENT); }
__device__ __forceinline__ unsigned xb_xcc_id() { return (unsigned)__builtin_amdgcn_s_getreg((3 << 11) | 20) & 0xFu; }
#define XB_SPIN(cond, bar) do { unsigned _sp = 0; while (cond) { __builtin_amdgcn_s_sleep(1); \
    if ((++_sp & 255u) == 0u) { if (xb_ld(&(bar)[XB_TMO])) break; if (_sp > XB_SPIN_CAP) { atomicAdd(&(bar)[XB_TMO], 1u); break; } } } } while (0)
struct XcdBarrier { unsigned* bar; unsigned x; volatile LAS unsigned* st; };
__device__ __forceinline__ XcdBarrier xcd_barrier_post(unsigned* bar, volatile LAS unsigned* st) {
    XcdBarrier b; b.bar = bar; b.x = xb_xcc_id(); b.st = st;
    if (threadIdx.x == 0) (void)xb_add(&bar[XB_XCNT(b.x)], 1u);
    return b;
}
__device__ __forceinline__ void xcd_barrier_complete(unsigned* bar, unsigned x, unsigned& nloc, unsigned& nx) {
    const unsigned G = gridDim.x * gridDim.y * gridDim.z;
    unsigned sum, cnt, mine, sp = 0u;
    for (;;) {
        sum = 0u; cnt = 0u; mine = 0u;
#pragma unroll
        for (unsigned j = 0; j < 16; ++j) { const unsigned c = xb_ld(&bar[XB_XCNT(j)]); sum += c; cnt += (c > 0u) ? 1u : 0u; mine = (j == x) ? c : mine; }
        if (sum == G) break;
        __builtin_amdgcn_s_sleep(1);
        if ((++sp & 255u) == 0u) { if (xb_ld(&bar[XB_TMO])) break; if (sp > XB_SPIN_CAP) { atomicAdd(&bar[XB_TMO], 1u); break; } }
    }
    nloc = mine > 0u ? mine : 1u; nx = cnt > 0u ? cnt : 1u;
}
__device__ __forceinline__ void xcd_barrier(const XcdBarrier& b) {
    asm volatile("s_waitcnt vmcnt(0)" ::: "memory");
    __syncthreads();
    if (threadIdx.x == 0) {
        unsigned* bar = b.bar; asm volatile("" : "+s"(bar));
        unsigned bx = b.x; asm volatile("" : "+s"(bx));
        __builtin_amdgcn_s_waitcnt(0);
        unsigned nloc = b.st[0], nx = b.st[1];
        if (nloc == 0u) { xcd_barrier_complete(bar, bx, nloc, nx); b.st[0] = nloc; b.st[1] = nx; }
        const unsigned old = xb_add(&bar[XB_XSUB(bx)], 1u);
        const unsigned gen = old / nloc;
        if (old + 1u == (gen + 1u) * nloc) {
            __builtin_amdgcn_fence(__ATOMIC_RELEASE, "agent");
            asm volatile("s_waitcnt vmcnt(0)" ::: "memory");
            const unsigned og = xb_add(&bar[XB_TOP], 1u);
            const unsigned tg = og / nx;
            if (og + 1u == (tg + 1u) * nx) xb_add(&bar[XB_TOPGEN], 1u);
            else XB_SPIN(xb_ld(&bar[XB_TOPGEN]) == tg, bar);
            __builtin_amdgcn_fence(__ATOMIC_ACQUIRE, "agent");
            xb_add(&bar[XB_XGEN(bx)], 1u);
            asm volatile("s_waitcnt vmcnt(0)" ::: "memory");
        } else {
            XB_SPIN(xb_ld(&bar[XB_XGEN(bx)]) == gen, bar);
            __builtin_amdgcn_fence(__ATOMIC_ACQUIRE, "agent");
            asm volatile("s_waitcnt vmcnt(0)" ::: "memory");
        }
    }
    __syncthreads();
}
constexpr int MISC_OFF = 131072 + 320;
constexpr int CW_BAR = 4096;

__global__ void __launch_bounds__(NTHR) mega_fwd(Params p) {
    extern __shared__ __attribute__((aligned(16))) unsigned char lds_raw[];
    float* lds = (float*)lds_raw;
    volatile LAS unsigned* MISC = (volatile LAS unsigned*)((LAS unsigned char*)lds_raw + MISC_OFF);
    if (threadIdx.x < 32) MISC[threadIdx.x] = 0u;
    __syncthreads();
    unsigned char* ws_ = ((const KAS Params*)__builtin_amdgcn_kernarg_segment_ptr())->ws;
    XcdBarrier bar = xcd_barrier_post((unsigned*)(ws_ + WS_CTL) + CW_BAR, MISC + 8);
#define GB() xcd_barrier(bar)
    run_stage<ST_INIT>(0, lds); GB();
    for (int step = 0; step < 2 * 11; ++step) {
        const int l = step / 11, s = step % 11;
        switch (s) {
        case 0: run_stage<ST_PROJ>(l, lds); break;
        case 1: run_stage<ST_PREP>(l, lds); run_stage<ST_GLA1>(l, lds); break;
        case 2: run_stage<ST_SMALLGEMM>(l, lds); run_stage<ST_GLA2>(l, lds); break;
        case 3: run_stage<ST_ATTN>(l, lds); run_stage<ST_GLA3>(l, lds); break;
        case 4: run_stage<ST_MERGE_A>(l, lds); break;
        case 5: run_stage<ST_OUTP>(l, lds); break;
        case 6: run_stage<ST_LN1>(l, lds); break;
        case 7: run_stage<ST_TOPK>(l, lds); break;
        case 8: run_stage<ST_EXP_G>(l, lds); break;
        case 9: run_stage<ST_EXP_D>(l, lds); break;
        default: run_stage<ST_LN2>(l, lds); break;
        }
        if (step + 1 < 2 * 11) GB();
    }
#undef GB
}

template <int ST>
__global__ void __launch_bounds__(NTHR) k_stage(Params p, int l) {
    extern __shared__ __attribute__((aligned(16))) unsigned char lds_raw[];
    run_stage<ST>(l, (float*)lds_raw);
}

template <int ST> static void launch_stage(const Params& p, int l, int grid, hipStream_t stream) {
    static bool attr = false;
    if (!attr) { (void)hipFuncSetAttribute((const void*)k_stage<ST>, hipFuncAttributeMaxDynamicSharedMemorySize, LDS_BYTES); attr = true; }
    hipLaunchKernelGGL(k_stage<ST>, dim3(grid), dim3(NTHR), LDS_BYTES, stream, p, l);
}

extern "C" void kernel_launch(void* const* d_in, const int* in_sizes, int n_in, void* d_out, int out_size, void* d_ws, size_t ws_size, hipStream_t stream) {
    if (n_in != 27 || out_size != T * DM || ws_size < WS_END) {
        fprintf(stderr, "kernel_launch: unexpected shapes: n_in %d out %d ws %zu (need >= %zu)\n", n_in, out_size, ws_size, (size_t)WS_END);
        return;
    }
    Params p{};
    for (int i = 0; i < 27; ++i) p.in[i] = (const float*)d_in[i];
    p.pos = (const int*)d_in[1]; p.out = (float*)d_out; p.ws = (unsigned char*)d_ws;
    const int grid = 256;
#if MEGA
    static bool attr = false;
    if (!attr) { (void)hipFuncSetAttribute((const void*)mega_fwd, hipFuncAttributeMaxDynamicSharedMemorySize, LDS_BYTES); attr = true; }
    (void)hipMemsetAsync((char*)d_ws + WS_CTL, 0, 65536, stream);
    hipLaunchKernelGGL(mega_fwd, dim3(grid), dim3(NTHR), LDS_BYTES, stream, p);
#else
    launch_stage<ST_INIT>(p, 0, grid, stream);
    for (int l = 0; l < 2; ++l) {
        launch_stage<ST_PROJ>(p, l, grid, stream);
        launch_stage<ST_PREP>(p, l, grid, stream);
        launch_stage<ST_SMALLGEMM>(p, l, grid, stream);
        launch_stage<ST_ROPE>(p, l, grid, stream);
        launch_stage<ST_ATTN>(p, l, grid, stream);
        launch_stage<ST_GLAREC>(p, l, grid, stream);
        launch_stage<ST_GLAFIN>(p, l, grid, stream);
        launch_stage<ST_MERGE_A>(p, l, grid, stream);
        launch_stage<ST_MERGE_B>(p, l, grid, stream);
        launch_stage<ST_MERGE_C>(p, l, grid, stream);
        launch_stage<ST_OUTP>(p, l, grid, stream);
        launch_stage<ST_LN1>(p, l, grid, stream);
        launch_stage<ST_TOPK>(p, l, grid, stream);
        launch_stage<ST_EXP_G>(p, l, grid, stream);
        launch_stage<ST_EXP_U>(p, l, grid, stream);
        launch_stage<ST_EXP_D>(p, l, grid, stream);
        launch_stage<ST_LN2>(p, l, grid, stream);
    }
#endif
}
```

```cpp
#include <hip/hip_runtime.h>
#include <cstdio>
#include <cstdint>

#ifndef MEGA
#define MEGA 1
#endif

constexpr int NB = 2, SEQ = 8192, T = NB * SEQ, DM = 1024, DIN = 5824, DINP = 5888;
constexpr int OFF_GATE = 0, OFF_POOL = 3072, OFF_CQ = 3072 + 512, OFF_CKV = 3072 + 896, OFF_KR = 3072 + 1152, OFF_GQ = 3072 + 1184, OFF_GK = 3072 + 1440, OFF_GV = 3072 + 1696, OFF_GR = 3072 + 2208, OFF_GDEC = 3072 + 2720;
constexpr int NE = 16, CAP = 1024, DEXP = 2048, NZ = NB * NE;
constexpr float ALPHA = 1.4142135623730951f;
constexpr float LN_EPS = 1e-5f, RMS_EPS = 1e-6f;
constexpr int NTHR = 512, LDS_BYTES = 147456;

constexpr size_t MiB = 1u << 20;
constexpr size_t WS_CTL = 0;
constexpr size_t WS_ROPE = 1 * MiB;
constexpr size_t WS_AFF = 3 * MiB;
constexpr size_t WS_SLOT = 4 * MiB;
constexpr size_t WS_IDX = 5 * MiB;
constexpr size_t WS_GATEV = 5 * MiB + 256 * 1024;
constexpr size_t WS_WIN_T = 8 * MiB;
constexpr size_t WS_WSMALL = 31 * MiB;
constexpr size_t WSM_UQ = 0, WSM_UKV = 1 * MiB, WSM_MRG = 2 * MiB, WSM_OUT = 5 * MiB, WSM_STRIDE = 7 * MiB;
constexpr size_t WS_RQ = 6 * MiB;
constexpr size_t WS_HB = 958 * MiB;
constexpr size_t WS_WGU_T = 76 * MiB;
constexpr size_t WS_WD_T = 204 * MiB;
constexpr size_t WS_PROJB = 268 * MiB;
constexpr size_t WS_XE = 268 * MiB;
constexpr size_t WS_HID = 332 * MiB;
constexpr size_t WS_YE = 460 * MiB;
constexpr size_t WS_BR = 452 * MiB;
constexpr size_t WS_HB8 = 500 * MiB;
constexpr size_t WS_QB = 556 * MiB;
constexpr size_t WS_KB = 580 * MiB;
constexpr size_t WS_VB = 604 * MiB;
constexpr size_t WS_KVT = 702 * MiB;
constexpr size_t WS_ST = 766 * MiB;
constexpr size_t WS_DEC = 798 * MiB;
constexpr size_t WS_MERGEDB = 830 * MiB;
constexpr size_t WS_TMP = 894 * MiB;
constexpr size_t WS_END = 990 * MiB;
static_assert(WS_YE + 64 * MiB <= WS_QB, "overlay map");

namespace pg8 {
#define PG8_LAS __attribute__((address_space(3)))
typedef unsigned short bf16_t;
typedef short bf16x8 __attribute__((ext_vector_type(8)));
typedef float f32x4 __attribute__((ext_vector_type(4)));
typedef unsigned u32x4 __attribute__((ext_vector_type(4)));
constexpr int BM = 256, BK = 64, HALF = 128, HTB = HALF * BK * 2  , STAGE_BYTES = 8 * HTB, NXCD = 8, WGM = 8;

__host__ __device__ __forceinline__ int lds_byte(int r, int c) { const int st = (r >> 4) * 2 + (c >> 5), rr = r & 15, cc = c & 31, ob = rr * 64 + cc * 2; return st * 1024 + (ob ^ (((ob >> 9) & 1) << 5)); }
__host__ __device__ __forceinline__ void stage_rc(int b, int& R, int& C) { const int st = b / 1024, sb = b % 1024, swz = sb ^ (((sb >> 9) & 1) << 5); R = (st >> 1) * 16 + swz / 64; C = (st & 1) * 32 + (swz % 64) / 2; }
__host__ __device__ __forceinline__ int perm32(int rho) { const int n = rho >> 4, i = rho & 15; return 8 * (i >> 2) + 4 * n + (i & 3); }

struct Unit { int pm, pn; };
struct Gemm { const bf16_t* A; const bf16_t* Bt; int M, N, K, lda; const int* ridx; };

struct StaticOrder {
    int nM, nN, nwg, G, c;
    __host__ __device__ void init(int M, int N, int G_, int c_) { nM = M / BM; nN = N / BM; nwg = nM * nN; G = G_; c = c_; }
    __host__ __device__ bool next(int i, Unit& u) const {
        const long L = (long)i * G + c; if (L >= nwg) return false;
        int wgid = (int)L; { const int q = nwg / NXCD, r = nwg % NXCD, xcd = wgid % NXCD, off = wgid / NXCD; wgid = (xcd < r ? xcd * (q + 1) : r * (q + 1) + (xcd - r) * q) + off; }
        const int nig = WGM * nN, gid = wgid / nig, fm = gid * WGM, gsz = (nM - fm) < WGM ? (nM - fm) : WGM;
        u.pm = fm + ((wgid % nig) % gsz); u.pn = (wgid % nig) / gsz; return true;
    }
    __device__ __forceinline__ void a_ready(const Unit&) const {}
    __device__ __forceinline__ void done(const Unit&) const {}
};

__device__ __forceinline__ unsigned cvt_pk_bf16(float lo, float hi) { unsigned r; asm volatile("v_cvt_pk_bf16_f32 %0, %1, %2" : "=v"(r) : "v"(lo), "v"(hi)); return r; }
typedef float f32x2 __attribute__((ext_vector_type(2)));
__device__ __forceinline__ f32x2 gelu_pk(f32x2 v) {
    const f32x2 av = __builtin_elementwise_abs(v), d = av * 0.2316418882f + 1.0f;
    f32x2 t; t.x = __builtin_amdgcn_rcpf(d.x); t.y = __builtin_amdgcn_rcpf(d.y);
    f32x2 q = t * 0.5307027145f + (-0.7265760135f); q = q * t + 0.7107068705f; q = q * t + (-0.142248368f); q = q * t + 0.127414796f; q = q * t;
    const f32x2 s = (v * v) * (-0.72134752044f);
    f32x2 e; e.x = __builtin_amdgcn_exp2f(s.x); e.y = __builtin_amdgcn_exp2f(s.y);
    const f32x2 m = v * (q * e), r = v - m;
    f32x2 o; o.x = v.x < 0.f ? m.x : r.x; o.y = v.y < 0.f ? m.y : r.y; return o;
}

template <int ACT  > struct EpiBf16 {
    static constexpr bool PERM = true, AFTER_DRAIN = false; static constexpr int SEG = 0; static_assert(ACT == 0 || ACT == 1, "EpiBf16: ACT is 0 (none) or 1 (gelu_pk)");
    bf16_t* O; int ldc; const float* bias; int split_cols; size_t split_stride; float scale0;
    __device__ __forceinline__ void operator()(const f32x4 (&acc)[2][2][4][2], const Unit& u, int wr, int wc, int fr, int fq) const {
        const int row0 = u.pm * BM + wr * 64 + fr; int colt = u.pn * BM; bf16_t* base = O;
        float sc = 1.f; if (split_cols) { const int t = colt / split_cols; base += (size_t)t * split_stride; colt -= t * split_cols; if (t == 0) sc = scale0; }
        const int col0 = colt + wc * 32 + 8 * fq, bcol0 = u.pn * BM + wc * 32 + 8 * fq;
        f32x4 bv[2][2];
#pragma unroll
        for (int bj = 0; bj < 2; ++bj)
#pragma unroll
            for (int n = 0; n < 2; ++n) bv[bj][n] = bias ? *(const f32x4*)(bias + bcol0 + bj * HALF + 4 * n) : (f32x4){0.f, 0.f, 0.f, 0.f};
#pragma unroll
        for (int ai = 0; ai < 2; ++ai)
#pragma unroll
            for (int m = 0; m < 4; ++m) { bf16_t* rowp = base + (size_t)(row0 + ai * HALF + m * 16) * ldc + col0;
#pragma unroll
                for (int bj = 0; bj < 2; ++bj) { f32x4 v0 = acc[ai][bj][m][0] + bv[bj][0], v1 = acc[ai][bj][m][1] + bv[bj][1];
                    if (ACT == 1) { f32x2 a = gelu_pk((f32x2){v0[0], v0[1]}), b = gelu_pk((f32x2){v0[2], v0[3]}), c = gelu_pk((f32x2){v1[0], v1[1]}), d = gelu_pk((f32x2){v1[2], v1[3]});
                        v0 = (f32x4){a.x, a.y, b.x, b.y}; v1 = (f32x4){c.x, c.y, d.x, d.y}; }
                    v0 = v0 * sc; v1 = v1 * sc; u32x4 w; w.x = cvt_pk_bf16(v0[0], v0[1]); w.y = cvt_pk_bf16(v0[2], v0[3]); w.z = cvt_pk_bf16(v1[0], v1[1]); w.w = cvt_pk_bf16(v1[2], v1[3]);
                    *(u32x4*)(rowp + bj * HALF) = w; } }
    }
};

struct PanelStats {
    unsigned* xbuf;
    unsigned* cnt;
    unsigned* tmo;
    int ntn; float eps;
    unsigned code;
    __device__ __forceinline__ bool run(const f32x4 (&v)[2][2][4][2], const Unit& u, int wr, int wc, int fr, int fq, PG8_LAS unsigned char* lds, int wid, int lane) const {
        typedef float f32x2v __attribute__((ext_vector_type(2)));
        PG8_LAS f32x2v* P = (PG8_LAS f32x2v*)lds;
        PG8_LAS f32x2v* S = (PG8_LAS f32x2v*)(lds + 8192);
        PG8_LAS unsigned* flag = (PG8_LAS unsigned*)(lds + 8192 + 2048);
#pragma unroll
        for (int ai = 0; ai < 2; ++ai)
#pragma unroll
            for (int m = 0; m < 4; ++m) {
                float s = 0.f;
#pragma unroll
                for (int bj = 0; bj < 2; ++bj)
#pragma unroll
                    for (int n = 0; n < 2; ++n) { const f32x4 x = v[ai][bj][m][n]; s += (x[0] + x[1]) + (x[2] + x[3]); }
                s += __shfl_xor(s, 16); s += __shfl_xor(s, 32);
                const float mw = s * (1.0f / 64.0f); float q = 0.f;
#pragma unroll
                for (int bj = 0; bj < 2; ++bj)
#pragma unroll
                    for (int n = 0; n < 2; ++n) { const f32x4 d = v[ai][bj][m][n] - mw; q += (d[0] * d[0] + d[1] * d[1]) + (d[2] * d[2] + d[3] * d[3]); }
                q += __shfl_xor(q, 16); q += __shfl_xor(q, 32);
                if (fq == 0) P[(ai * HALF + wr * 64 + m * 16 + fr) * 4 + wc] = (f32x2v){mw, q};
            }
        asm volatile("s_waitcnt lgkmcnt(0)" ::: "memory"); __builtin_amdgcn_s_barrier(); asm volatile("" ::: "memory");
#if defined(BROKEN_EXCHANGE_NO_WAIT)
#warning BROKEN CONTROL BUILD: the row-statistics exchange does not wait; results are wrong by design
        if (blockIdx.x >= 64) { const long long t0_ = clock64(); while (clock64() - t0_ < 60000) __builtin_amdgcn_s_sleep(8); }
#endif
        const int row = wid * 32 + (lane & 31);
        if (lane < 32) {
            const f32x2v a = P[row * 4 + 0], b = P[row * 4 + 1], c = P[row * 4 + 2], d = P[row * 4 + 3];
            const float mt = (a.x + b.x + c.x + d.x) * 0.25f;
            const float da = a.x - mt, db = b.x - mt, dc = c.x - mt, dd = d.x - mt;
            const float m2 = (a.y + b.y) + (c.y + d.y) + 64.0f * ((da * da + db * db) + (dc * dc + dd * dd));
            unsigned long long* slot = (unsigned long long*)xbuf + ((size_t)(u.pm * BM + row) * 4 + u.pn);
            __hip_atomic_store(slot, ((unsigned long long)__float_as_uint(m2) << 32) | __float_as_uint(mt), __ATOMIC_RELAXED, __HIP_MEMORY_SCOPE_AGENT);
        }
        asm volatile("s_waitcnt vmcnt(0)" ::: "memory");
        if (lane == 0) __hip_atomic_fetch_add(cnt + 64 * u.pm, 1u, __ATOMIC_RELAXED, __HIP_MEMORY_SCOPE_AGENT);
        if (wid == 0) {
            bool dead = false; const unsigned long long t0 = __builtin_amdgcn_s_memrealtime(); const unsigned want = 8u * (unsigned)ntn;
            for (;;) {
#if defined(BROKEN_EXCHANGE_NO_WAIT)
                break;
#endif
                if ((unsigned)__builtin_amdgcn_readfirstlane(__hip_atomic_load(cnt + 64 * u.pm, __ATOMIC_RELAXED, __HIP_MEMORY_SCOPE_AGENT)) >= want) break;
                if (__builtin_amdgcn_s_memrealtime() - t0 > 2000000ull) {
                    if (lane == 0) { unsigned expect = 0u; __hip_atomic_compare_exchange_strong(tmo + 1, &expect, code | (unsigned)(u.pm & 0xff), __ATOMIC_RELAXED, __ATOMIC_RELAXED, __HIP_MEMORY_SCOPE_AGENT);
                                     __hip_atomic_store(tmo, 1u, __ATOMIC_RELAXED, __HIP_MEMORY_SCOPE_AGENT); }
                    dead = true; break; }
                __builtin_amdgcn_s_sleep(2);
            }
            __builtin_amdgcn_fence(__ATOMIC_ACQUIRE, "agent");
            if (lane == 0) flag[0] = dead ? 1u : 0u;
        }
        asm volatile("s_waitcnt vmcnt(0) lgkmcnt(0)" ::: "memory"); __builtin_amdgcn_s_barrier(); asm volatile("" ::: "memory");
        const bool bad = flag[0] != 0u;
        if (lane < 32) {
            const unsigned long long* slot = (const unsigned long long*)xbuf + (size_t)(u.pm * BM + row) * 4; float mt[4], m2[4]; float ms = 0.f;
#pragma unroll
            for (int t = 0; t < 4; ++t) { if (t < ntn) { const unsigned long long w = __hip_atomic_load(slot + t, __ATOMIC_RELAXED, __HIP_MEMORY_SCOPE_AGENT); mt[t] = __uint_as_float((unsigned)w); m2[t] = __uint_as_float((unsigned)(w >> 32)); } else { mt[t] = 0.f; m2[t] = 0.f; } ms += mt[t]; }
            const float mean = ms / (float)ntn; float q = 0.f;
#pragma unroll
            for (int t = 0; t < 4; ++t) if (t < ntn) { const float dm = mt[t] - mean; q += m2[t] + 256.0f * dm * dm; }
            S[row] = (f32x2v){mean, 1.0f / sqrtf(q / (256.0f * (float)ntn) + eps)};
        }
        asm volatile("s_waitcnt lgkmcnt(0)" ::: "memory"); __builtin_amdgcn_s_barrier(); asm volatile("" ::: "memory");
        return bad;
    }
};
struct EpiLnRes {
    static constexpr bool PERM = false, AFTER_DRAIN = true; static constexpr int SEG = 0;
    const float* base; float* out; int ldc; const float* bias; PanelStats st; unsigned poison;
    __device__ __forceinline__ void fused(f32x4 (&acc)[2][2][4][2], const Unit& u, int wr, int wc, int fr, int fq, PG8_LAS unsigned char* lds, int wid, int lane) const {
        typedef float f32x2v __attribute__((ext_vector_type(2)));
        const PG8_LAS f32x2v* S = (const PG8_LAS f32x2v*)(lds + 8192);
        const int col0 = u.pn * BM + wc * 32 + 4 * fq;
#pragma unroll
        for (int bj = 0; bj < 2; ++bj)
#pragma unroll
            for (int n = 0; n < 2; ++n) { const f32x4 bv = bias ? *(const f32x4*)(bias + col0 + bj * HALF + n * 16) : (f32x4){0.f, 0.f, 0.f, 0.f};
#pragma unroll
                for (int ai = 0; ai < 2; ++ai)
#pragma unroll
                    for (int m = 0; m < 4; ++m) acc[ai][bj][m][n] += bv; }
        f32x4 pre[4][2][2];
#pragma unroll
        for (int m = 0; m < 4; ++m) { const size_t off = (size_t)(u.pm * BM + wr * 64 + m * 16 + fr) * ldc + col0;
#pragma unroll
            for (int bj = 0; bj < 2; ++bj)
#pragma unroll
                for (int n = 0; n < 2; ++n) pre[m][bj][n] = *(const f32x4*)(base + off + bj * HALF + n * 16); }
        const bool bad = st.run(acc, u, wr, wc, fr, fq, lds, wid, lane) || poison != 0u;
        const float qnan = __builtin_nanf("");
#pragma unroll
        for (int ai = 0; ai < 2; ++ai)
#pragma unroll
            for (int m = 0; m < 4; ++m) { const int r = ai * HALF + wr * 64 + m * 16 + fr; const f32x2v sr = S[r]; const size_t off = (size_t)(u.pm * BM + r) * ldc + col0;
#pragma unroll
                for (int bj = 0; bj < 2; ++bj)
#pragma unroll
                    for (int n = 0; n < 2; ++n) { const f32x4 bs = ai == 0 ? pre[m][bj][n] : *(const f32x4*)(base + off + bj * HALF + n * 16); f32x4 o = bs + (acc[ai][bj][m][n] - sr.x) * sr.y;
                        if (bad) o = (f32x4){qnan, qnan, qnan, qnan}; *(f32x4*)(out + off + bj * HALF + n * 16) = o; }
                if (m & 1) asm volatile("" ::: "memory"); }
    }
};
struct EpiLnResLn {
    static constexpr bool PERM = false, AFTER_DRAIN = true; static constexpr int SEG = 0;
    const float* base; float* out; bf16_t* xn; int ldc; const float* bias; PanelStats st1, st2; unsigned poison;
    __device__ __forceinline__ void fused(f32x4 (&acc)[2][2][4][2], const Unit& u, int wr, int wc, int fr, int fq, PG8_LAS unsigned char* lds, int wid, int lane) const {
        typedef float f32x2v __attribute__((ext_vector_type(2))); typedef unsigned u32x2v __attribute__((ext_vector_type(2)));
        const PG8_LAS f32x2v* S = (const PG8_LAS f32x2v*)(lds + 8192);
        const int col0 = u.pn * BM + wc * 32 + 4 * fq;
#pragma unroll
        for (int bj = 0; bj < 2; ++bj)
#pragma unroll
            for (int n = 0; n < 2; ++n) { const f32x4 bv = bias ? *(const f32x4*)(bias + col0 + bj * HALF + n * 16) : (f32x4){0.f, 0.f, 0.f, 0.f};
#pragma unroll
                for (int ai = 0; ai < 2; ++ai)
#pragma unroll
                    for (int m = 0; m < 4; ++m) acc[ai][bj][m][n] += bv; }
        bool bad = st1.run(acc, u, wr, wc, fr, fq, lds, wid, lane) || poison != 0u;
        const float qnan = __builtin_nanf("");
#pragma unroll
        for (int ai = 0; ai < 2; ++ai)
#pragma unroll
            for (int m = 0; m < 4; ++m) { const int r = ai * HALF + wr * 64 + m * 16 + fr; const f32x2v sr = S[r]; const size_t off = (size_t)(u.pm * BM + r) * ldc + col0;
#pragma unroll
                for (int bj = 0; bj < 2; ++bj)
#pragma unroll
                    for (int n = 0; n < 2; ++n) { const f32x4 bs = *(const f32x4*)(base + off + bj * HALF + n * 16); acc[ai][bj][m][n] = bs + (acc[ai][bj][m][n] - sr.x) * sr.y; }
                asm volatile("" : "+v"(acc[ai][0][m][0]), "+v"(acc[ai][0][m][1]), "+v"(acc[ai][1][m][0]), "+v"(acc[ai][1][m][1]));
                if (m & 1) asm volatile("" ::: "memory"); }
        const bool bad1 = bad;
        bad = st2.run(acc, u, wr, wc, fr, fq, lds, wid, lane) || bad;
#pragma unroll
        for (int ai = 0; ai < 2; ++ai)
#pragma unroll
            for (int m = 0; m < 4; ++m) { const int r = ai * HALF + wr * 64 + m * 16 + fr; const f32x2v sr = S[r]; const size_t off = (size_t)(u.pm * BM + r) * ldc + col0;
#pragma unroll
                for (int bj = 0; bj < 2; ++bj)
#pragma unroll
                    for (int n = 0; n < 2; ++n) { const f32x4 x1 = acc[ai][bj][m][n]; *(f32x4*)(out + off + bj * HALF + n * 16) = bad1 ? (f32x4){qnan, qnan, qnan, qnan} : x1;
                        const f32x4 o = (x1 - sr.x) * sr.y; u32x2v w; w.x = cvt_pk_bf16(o[0], o[1]); w.y = cvt_pk_bf16(o[2], o[3]);
                        if (bad) { w.x = 0x7fc07fc0u; w.y = 0x7fc07fc0u; } *(u32x2v*)(xn + off + bj * HALF + n * 16) = w; }
                asm volatile("" ::: "memory"); }
    }
};

template <class Epi, class Sched, bool ALIGN_EPI = false, bool SP2 = false, bool GATHER = false, bool FP8 = false>
__device__ __forceinline__ void gemm_phase(PG8_LAS unsigned char* lds, const Gemm g, const Sched& S, const Epi& E) {
    int tid_ = threadIdx.x; asm volatile("" : "+v"(tid_));
    const int tid = tid_, wid = __builtin_amdgcn_readfirstlane(tid >> 6), lane = tid & 63, wr = wid >> 2, wc = wid & 3, fr = lane & 15, fq = lane >> 4;
    int K_ = g.K; asm volatile("" : "+s"(K_));
    const int K = K_, nt = K / BK;
    unsigned voffA[2], voffB[2];
#pragma unroll
    for (int i = 0; i < 2; ++i) { int R, C; stage_rc(tid * 16 + i * 8192, R, C); const int Rb = Epi::PERM ? ((R & ~31) + perm32(R & 31)) : R;
        voffA[i] = (unsigned)(R * g.lda + C) * 2u; voffB[i] = (unsigned)(Rb * K + C) * 2u; }
    const size_t kstep = (size_t)(BK * 2);
    static_assert(!GATHER || SP2, "GATHER is implemented for the SP2 loop");
    const size_t hstepB = (size_t)HALF * K * 2, hstepA = GATHER ? 0 : (size_t)HALF * g.lda * 2;
    const size_t tstepB = 2 * hstepB, tstepA = GATHER ? 0 : 2 * hstepA;
    const unsigned ldsw = (unsigned)wid * 1024u;
    const int aoffk[2] = {lds_byte(wr * 64 + fr, FP8 ? 16 * fq : 8 * fq), lds_byte(wr * 64 + fr, FP8 ? 16 * fq + 8 : 8 * fq + 32)};
    const int boffk[2] = {lds_byte(wc * 32 + fr, FP8 ? 16 * fq : 8 * fq), lds_byte(wc * 32 + fr, FP8 ? 16 * fq + 8 : 8 * fq + 32)};
#define PG8_SA(b, h) (((b) * 2 + (h)) * HTB)
#define PG8_SB(b, h) ((4 + (b) * 2 + (h)) * HTB)
#define PG8_STAGE(bufoff, gbase, voff) do { _Pragma("unroll") for (int _i = 0; _i < 2; ++_i) \
        __builtin_amdgcn_global_load_lds((const unsigned*)((const char*)(gbase) + (voff)[_i]), (PG8_LAS unsigned*)(lds + (bufoff) + ldsw + _i * 8192), 16, 0, 0); } while (0)
    typedef int i32x4_ __attribute__((ext_vector_type(4))); typedef int i32x8_ __attribute__((ext_vector_type(8)));
#define PG8_LD16(off) (*(const PG8_LAS i32x4_*)(lds + (off)))
#define PG8_LDA(dst, b, h) do { _Pragma("unroll") for (int m = 0; m < 4; ++m) { \
        if constexpr (FP8) dst##8[m] = *(const PG8_LAS i32x8_*)(lds + PG8_SA(b, h) + aoffk[0] + m * 2048);     \
        else { _Pragma("unroll") for (int k = 0; k < 2; ++k) dst[m][k] = *(const PG8_LAS bf16x8*)(lds + PG8_SA(b, h) + aoffk[k] + m * 2048); } } } while (0)
#define PG8_LDB(dst, b, h) do { _Pragma("unroll") for (int n = 0; n < 2; ++n) { \
        if constexpr (FP8) dst##8[n] = *(const PG8_LAS i32x8_*)(lds + PG8_SB(b, h) + boffk[0] + n * 2048); \
        else { _Pragma("unroll") for (int k = 0; k < 2; ++k) dst[n][k] = *(const PG8_LAS bf16x8*)(lds + PG8_SB(b, h) + boffk[k] + n * 2048); } } } while (0)
#define PG8_MMA(ai, bj, At, Bt) do { __builtin_amdgcn_s_setprio(1); _Pragma("unroll") for (int m = 0; m < 4; ++m) _Pragma("unroll") for (int n = 0; n < 2; ++n) { \
        if constexpr (FP8) asm volatile("s_nop 1\n\tv_mfma_scale_f32_16x16x128_f8f6f4 %0, %1, %2, %0, %3, %3 op_sel_hi:[0,0,0]" : "+v"(acc[ai][bj][m][n]) : "v"(Bt##8[n]), "v"(At##8[m]), "v"(sc1_));     \
        else { _Pragma("unroll") for (int k = 0; k < 2; ++k) acc[ai][bj][m][n] = __builtin_amdgcn_mfma_f32_16x16x32_bf16(Bt[n][k], At[m][k], acc[ai][bj][m][n], 0, 0, 0); } } \
        __builtin_amdgcn_s_setprio(0); } while (0)
#define PG8_WAIT_V(n) asm volatile("s_waitcnt vmcnt(" #n ")" ::: "memory")
#define PG8_WAIT_L(n) asm volatile("s_waitcnt lgkmcnt(" #n ")" ::: "memory")
#define PG8_BAR __builtin_amdgcn_s_barrier()
#define PG8_SCHED __builtin_amdgcn_sched_barrier(0)
    Unit cur, nxt; int ui = 0;
    if (!S.next(0, cur)) return;
    unsigned vC0[2] = {voffA[0], voffA[1]}, vC1[2] = {voffA[0], voffA[1]}, vN0[2] = {voffA[0], voffA[1]}, vN1[2] = {voffA[0], voffA[1]};
    int gR[2], gC[2];
#pragma unroll
    for (int i = 0; i < 2; ++i) { stage_rc(tid * 16 + i * 8192, gR[i], gC[i]); }
    if constexpr (GATHER) {
#pragma unroll
        for (int i = 0; i < 2; ++i) { vC0[i] = (unsigned)(g.ridx[cur.pm * 256 + gR[i]] * g.lda + gC[i]) * 2u; vC1[i] = (unsigned)(g.ridx[cur.pm * 256 + 128 + gR[i]] * g.lda + gC[i]) * 2u; }
    }
    f32x4 acc[2][2][4][2];
#pragma unroll
    for (int a = 0; a < 2; ++a)
#pragma unroll
        for (int b = 0; b < 2; ++b)
#pragma unroll
            for (int m = 0; m < 4; ++m)
#pragma unroll
                for (int n = 0; n < 2; ++n) acc[a][b][m][n] = (f32x4){0.f, 0.f, 0.f, 0.f};
    const int sc1_ = 0x7f7f7f7f;
    bf16x8 At[4][2], B0[2][2], B1[2][2]; i32x8_ At8[4], B08[2], B18[2];
    const char* cA = (const char*)g.A + (size_t)cur.pm * tstepA; const char* cB = (const char*)g.Bt + (size_t)cur.pn * tstepB;
    S.a_ready(cur);
    if constexpr (SP2) {
        PG8_STAGE(PG8_SB(0, 0), cB, voffB); PG8_STAGE(PG8_SB(0, 1), cB + hstepB, voffB); PG8_STAGE(PG8_SA(0, 0), cA, vC0); PG8_STAGE(PG8_SA(0, 1), cA + hstepA, vC1);
        if (wr == 1) PG8_BAR;
        PG8_WAIT_V(2); PG8_BAR;
        PG8_STAGE(PG8_SB(1, 0), cB + kstep, voffB); PG8_STAGE(PG8_SA(1, 0), cA + kstep, vC0); PG8_STAGE(PG8_SB(1, 1), cB + hstepB + kstep, voffB);
        PG8_WAIT_V(6); PG8_BAR;
    } else {
        PG8_STAGE(PG8_SB(0, 0), cB, voffB); PG8_STAGE(PG8_SA(0, 0), cA, voffA); PG8_STAGE(PG8_SB(0, 1), cB + hstepB, voffB); PG8_STAGE(PG8_SA(0, 1), cA + hstepA, voffA);
        if (wr == 1) PG8_BAR;
        PG8_WAIT_V(4); PG8_BAR;
        PG8_STAGE(PG8_SB(1, 0), cB + kstep, voffB); PG8_STAGE(PG8_SA(1, 0), cA + kstep, voffA); PG8_STAGE(PG8_SB(1, 1), cB + hstepB + kstep, voffB);
        PG8_WAIT_V(6); PG8_BAR;
    }
    for (;;) {
        const bool has_next = S.next(ui + 1, nxt);
        int gi0[2] = {0, 0}, gi1[2] = {0, 0};
        if constexpr (GATHER) { if (has_next) {
#pragma unroll
            for (int i = 0; i < 2; ++i) { gi0[i] = g.ridx[nxt.pm * 256 + gR[i]]; gi1[i] = g.ridx[nxt.pm * 256 + 128 + gR[i]]; } } }
        const char* nA = has_next ? (const char*)g.A + (size_t)nxt.pm * tstepA : cA; const char* nB = has_next ? (const char*)g.Bt + (size_t)nxt.pn * tstepB : cB;
        for (int t = 0; t < nt; t += 2) {
            const bool last = (t == nt - 2);
            const char* a1 = cA + (size_t)(t + 1) * kstep;
            const char* a2 = last ? nA : cA + (size_t)(t + 2) * kstep; const char* b2 = last ? nB : cB + (size_t)(t + 2) * kstep;
            const char* a3 = a2 + kstep; const char* b3 = b2 + kstep;
            if (last && has_next) S.a_ready(nxt);
            unsigned v20[2] = {vC0[0], vC0[1]}, v21[2] = {vC1[0], vC1[1]};
            if constexpr (GATHER) { if (last && has_next) {
#pragma unroll
                for (int i = 0; i < 2; ++i) { vN0[i] = (unsigned)(gi0[i] * g.lda + gC[i]) * 2u; vN1[i] = (unsigned)(gi1[i] * g.lda + gC[i]) * 2u; v20[i] = vN0[i]; v21[i] = vN1[i]; } } }
            if constexpr (SP2) {
            PG8_LDB(B0, 0, 0); PG8_LDB(B1, 0, 1); PG8_SCHED; PG8_LDA(At, 0, 0); PG8_STAGE(PG8_SA(1, 1), a1 + hstepA, vC1);
            PG8_WAIT_V(8); PG8_WAIT_L(0); PG8_BAR; PG8_MMA(0, 0, At, B0); PG8_MMA(0, 1, At, B1); PG8_BAR; PG8_SCHED;
            PG8_LDA(At, 0, 1); PG8_STAGE(PG8_SB(0, 0), b2, voffB); PG8_STAGE(PG8_SB(0, 1), b2 + hstepB, voffB); PG8_STAGE(PG8_SA(0, 0), a2, v20);
            PG8_WAIT_V(8); PG8_WAIT_L(0); PG8_BAR; PG8_MMA(1, 0, At, B0); PG8_MMA(1, 1, At, B1); PG8_BAR; PG8_SCHED;
            PG8_LDB(B0, 1, 0); PG8_LDB(B1, 1, 1); PG8_SCHED; PG8_LDA(At, 1, 0); PG8_STAGE(PG8_SA(0, 1), a2 + hstepA, v21);
            PG8_WAIT_V(8); PG8_WAIT_L(0); PG8_BAR; PG8_MMA(0, 0, At, B0); PG8_MMA(0, 1, At, B1); PG8_BAR; PG8_SCHED;
            PG8_LDA(At, 1, 1); PG8_STAGE(PG8_SB(1, 0), b3, voffB); PG8_STAGE(PG8_SB(1, 1), b3 + hstepB, voffB); PG8_STAGE(PG8_SA(1, 0), a3, v20);
            PG8_WAIT_V(8); PG8_WAIT_L(0); PG8_BAR; PG8_MMA(1, 0, At, B0); PG8_MMA(1, 1, At, B1); PG8_BAR; PG8_SCHED;
            if constexpr (Epi::SEG > 0) { if ((t + 2) % Epi::SEG == 0 && t + 2 < nt) E.segment(acc, cur, (t + 2) / Epi::SEG, wr, wc, fr, fq); }
            } else {
            PG8_LDB(B0, 0, 0); PG8_SCHED; PG8_LDA(At, 0, 0); PG8_STAGE(PG8_SA(1, 1), a1 + hstepA, voffA);
            PG8_WAIT_L(8); PG8_BAR; PG8_WAIT_L(0); PG8_MMA(0, 0, At, B0); PG8_BAR; PG8_SCHED;
            PG8_LDB(B1, 0, 1); PG8_STAGE(PG8_SB(0, 0), b2, voffB);
            PG8_BAR; PG8_WAIT_L(0); PG8_MMA(0, 1, At, B1); PG8_BAR;
            PG8_LDA(At, 0, 1); PG8_STAGE(PG8_SA(0, 0), a2, voffA);
            PG8_BAR; PG8_WAIT_L(0); PG8_MMA(1, 0, At, B0); PG8_BAR; PG8_SCHED;
            PG8_STAGE(PG8_SB(0, 1), b2 + hstepB, voffB);
            PG8_WAIT_V(6); PG8_BAR; PG8_MMA(1, 1, At, B1); PG8_BAR;
            PG8_LDB(B0, 1, 0); PG8_SCHED; PG8_LDA(At, 1, 0); PG8_STAGE(PG8_SA(0, 1), a2 + hstepA, voffA);
            PG8_WAIT_L(8); PG8_BAR; PG8_WAIT_L(0); PG8_MMA(0, 0, At, B0); PG8_BAR; PG8_SCHED;
            PG8_LDB(B1, 1, 1); PG8_STAGE(PG8_SB(1, 0), b3, voffB);
            PG8_BAR; PG8_WAIT_L(0); PG8_MMA(0, 1, At, B1); PG8_BAR;
            PG8_LDA(At, 1, 1); PG8_STAGE(PG8_SA(1, 0), a3, voffA);
            PG8_BAR; PG8_WAIT_L(0); PG8_MMA(1, 0, At, B0); PG8_BAR; PG8_SCHED;
            PG8_STAGE(PG8_SB(1, 1), b3 + hstepB, voffB);
            PG8_WAIT_V(6); PG8_BAR; PG8_MMA(1, 1, At, B1); PG8_BAR;
            }
        }
        if constexpr (FP8) asm volatile("s_nop 15\n\ts_nop 3" ::: "memory");
        if constexpr (ALIGN_EPI) { if (wr == 0) PG8_BAR; }
        if constexpr (!Epi::AFTER_DRAIN) { E(acc, cur, wr, wc, fr, fq); S.done(cur); }
        if (!has_next) break;
#pragma unroll
        for (int a = 0; a < 2; ++a)
#pragma unroll
            for (int b = 0; b < 2; ++b)
#pragma unroll
                for (int m = 0; m < 4; ++m)
#pragma unroll
                    for (int n = 0; n < 2; ++n) acc[a][b][m][n] = (f32x4){0.f, 0.f, 0.f, 0.f};
        cur = nxt; cA = nA; cB = nB; ++ui;
        if constexpr (GATHER) { vC0[0] = vN0[0]; vC0[1] = vN0[1]; vC1[0] = vN1[0]; vC1[1] = vN1[1]; }
        if constexpr (ALIGN_EPI) { if (wr == 1) PG8_BAR; }
    }
    PG8_WAIT_V(0);
    if constexpr (!ALIGN_EPI) { if (wr == 0) PG8_BAR; }
    PG8_BAR;
    if constexpr (Epi::AFTER_DRAIN) { E.fused(acc, cur, wr, wc, fr, fq, lds, wid, lane); S.done(cur); }
#undef PG8_SA
#undef PG8_SB
#undef PG8_STAGE
#undef PG8_LDA
#undef PG8_LD16
#undef PG8_LDB
#undef PG8_MMA
#undef PG8_WAIT_V
#undef PG8_WAIT_L
#undef PG8_BAR
#undef PG8_SCHED
}
}

typedef unsigned short bf16_t;
__device__ __forceinline__ unsigned pk4_fp8(float a, float b, float c, float d) { unsigned w = 0u; w = __builtin_amdgcn_cvt_pk_fp8_f32(a, b, w, false); w = __builtin_amdgcn_cvt_pk_fp8_f32(c, d, w, true); return w; }
constexpr float F8_WGU = 64.f, F8_WD = 128.f, F8_HID = 4.f;
typedef unsigned u32x4_t __attribute__((ext_vector_type(4)));
__device__ __forceinline__ void ldg8_dw(float (&o)[8], const void* base, const unsigned (&off)[8]) {
    asm volatile("global_load_dword %0, %9, %8\n\tglobal_load_dword %1, %10, %8\n\tglobal_load_dword %2, %11, %8\n\tglobal_load_dword %3, %12, %8\n\t"
                 "global_load_dword %4, %13, %8\n\tglobal_load_dword %5, %14, %8\n\tglobal_load_dword %6, %15, %8\n\tglobal_load_dword %7, %16, %8\n\ts_waitcnt vmcnt(0)"
                 : "=&v"(o[0]), "=&v"(o[1]), "=&v"(o[2]), "=&v"(o[3]), "=&v"(o[4]), "=&v"(o[5]), "=&v"(o[6]), "=&v"(o[7])
                 : "s"(base), "v"(off[0]), "v"(off[1]), "v"(off[2]), "v"(off[3]), "v"(off[4]), "v"(off[5]), "v"(off[6]), "v"(off[7]) : "memory");
}
template <int I1, int I2, int I3>
__device__ __forceinline__ void ldg8_x4(u32x4_t (&a)[4], u32x4_t (&b)[4], const void* base, unsigned offA, unsigned offB) {
    asm volatile("global_load_dwordx4 %0, %9, %8\n\tglobal_load_dwordx4 %1, %9, %8 offset:%11\n\tglobal_load_dwordx4 %2, %9, %8 offset:%12\n\tglobal_load_dwordx4 %3, %9, %8 offset:%13\n\t"
                 "global_load_dwordx4 %4, %10, %8\n\tglobal_load_dwordx4 %5, %10, %8 offset:%11\n\tglobal_load_dwordx4 %6, %10, %8 offset:%12\n\tglobal_load_dwordx4 %7, %10, %8 offset:%13\n\ts_waitcnt vmcnt(0)"
                 : "=&v"(a[0]), "=&v"(a[1]), "=&v"(a[2]), "=&v"(a[3]), "=&v"(b[0]), "=&v"(b[1]), "=&v"(b[2]), "=&v"(b[3])
                 : "s"(base), "v"(offA), "v"(offB), "i"(I1), "i"(I2), "i"(I3) : "memory");
}
__device__ __forceinline__ void ldg8_x4v(u32x4_t (&o)[8], const void* base, const unsigned (&off)[8]) {
    asm volatile("global_load_dwordx4 %0, %9, %8\n\tglobal_load_dwordx4 %1, %10, %8\n\tglobal_load_dwordx4 %2, %11, %8\n\tglobal_load_dwordx4 %3, %12, %8\n\t"
                 "global_load_dwordx4 %4, %13, %8\n\tglobal_load_dwordx4 %5, %14, %8\n\tglobal_load_dwordx4 %6, %15, %8\n\tglobal_load_dwordx4 %7, %16, %8\n\ts_waitcnt vmcnt(0)"
                 : "=&v"(o[0]), "=&v"(o[1]), "=&v"(o[2]), "=&v"(o[3]), "=&v"(o[4]), "=&v"(o[5]), "=&v"(o[6]), "=&v"(o[7])
                 : "s"(base), "v"(off[0]), "v"(off[1]), "v"(off[2]), "v"(off[3]), "v"(off[4]), "v"(off[5]), "v"(off[6]), "v"(off[7]) : "memory");
}
template <int I1, int I2, int I3>
__device__ __forceinline__ void ldg4_x4(u32x4_t (&a)[4], const void* base, unsigned off) {
    asm volatile("global_load_dwordx4 %0, %5, %4\n\tglobal_load_dwordx4 %1, %5, %4 offset:%6\n\tglobal_load_dwordx4 %2, %5, %4 offset:%7\n\tglobal_load_dwordx4 %3, %5, %4 offset:%8\n\ts_waitcnt vmcnt(0)"
                 : "=&v"(a[0]), "=&v"(a[1]), "=&v"(a[2]), "=&v"(a[3]) : "s"(base), "v"(off), "i"(I1), "i"(I2), "i"(I3) : "memory");
}
__device__ __forceinline__ void bf8_to_f32(const u32x4_t w, float* o) {
    o[0] = __uint_as_float(w.x << 16); o[1] = __uint_as_float(w.x & 0xffff0000u); o[2] = __uint_as_float(w.y << 16); o[3] = __uint_as_float(w.y & 0xffff0000u);
    o[4] = __uint_as_float(w.z << 16); o[5] = __uint_as_float(w.z & 0xffff0000u); o[6] = __uint_as_float(w.w << 16); o[7] = __uint_as_float(w.w & 0xffff0000u);
}
struct ExpertOrder1 {
    int G, v;
    __device__ void init(int G_, int c) { G = G_; v = (G_ % 8 == 0) ? (c % 8) * (G_ / 8) + c / 8 : c; }
    __device__ bool next(int i, pg8::Unit& u) const { const int L = i * G + v; if (L >= 2048) return false; const int e = L >> 7, r = L & 127; u.pm = e * 8 + (r & 7); u.pn = e * 16 + (r >> 3); return true; }
    __device__ __forceinline__ void a_ready(const pg8::Unit&) const {}
    __device__ __forceinline__ void done(const pg8::Unit&) const {}
};
struct ExpertOrder2 {
    int G, v;
    __device__ void init(int G_, int c) { G = G_; v = (G_ % 8 == 0) ? (c % 8) * (G_ / 8) + c / 8 : c; }
    __device__ bool next(int i, pg8::Unit& u) const { const int L = i * G + v; if (L >= 512) return false; const int e = L >> 5, r = L & 31; u.pm = e * 8 + (r & 7); u.pn = e * 4 + (r >> 3); return true; }
    __device__ __forceinline__ void a_ready(const pg8::Unit&) const {}
    __device__ __forceinline__ void done(const pg8::Unit&) const {}
};
__device__ __forceinline__ float silu_fast(float x) { return x * __builtin_amdgcn_rcpf(1.f + __builtin_amdgcn_exp2f(-1.4426950408889634f * x)); }
struct EpiSwiGLU {
    static constexpr bool PERM = true, AFTER_DRAIN = false; static constexpr int SEG = 0;
    bf16_t* O; int ldc;
    __device__ __forceinline__ void operator()(const pg8::f32x4 (&acc)[2][2][4][2], const pg8::Unit& u, int wr, int wc, int fr, int fq) const {
        int row0 = u.pm * 256 + wr * 64 + fr; asm volatile("" : "+v"(row0)); const int col0 = (u.pn & 15) * 128 + wc * 32 + 8 * fq;
#pragma unroll
        for (int ai = 0; ai < 2; ++ai)
#pragma unroll
            for (int m = 0; m < 4; ++m) {
                const pg8::f32x4 g0 = acc[ai][0][m][0], g1 = acc[ai][0][m][1], u0 = acc[ai][1][m][0], u1 = acc[ai][1][m][1];
                constexpr float IG = 1.f / F8_WGU, HS = F8_HID / F8_WGU;
                const unsigned w0 = pk4_fp8(silu_fast(g0[0] * IG) * u0[0] * HS, silu_fast(g0[1] * IG) * u0[1] * HS, silu_fast(g0[2] * IG) * u0[2] * HS, silu_fast(g0[3] * IG) * u0[3] * HS);
                const unsigned w1 = pk4_fp8(silu_fast(g1[0] * IG) * u1[0] * HS, silu_fast(g1[1] * IG) * u1[1] * HS, silu_fast(g1[2] * IG) * u1[2] * HS, silu_fast(g1[3] * IG) * u1[3] * HS);
                *(uint2*)((unsigned char*)O + (size_t)(row0 + ai * 128 + m * 16) * ldc + col0) = make_uint2(w0, w1);
            }
    }
};
struct EpiProj {
    static constexpr bool PERM = true, AFTER_DRAIN = false; static constexpr int SEG = 0;
    bf16_t* O; const float* bias;
    __device__ __forceinline__ void operator()(const pg8::f32x4 (&acc)[2][2][4][2], const pg8::Unit& u, int wr, int wc, int fr, int fq) const {
        int row0 = u.pm * 256 + wr * 64 + fr; asm volatile("" : "+v"(row0)); const int col0 = u.pn * 256 + wc * 32 + 8 * fq; const bool gate = u.pn < 12; constexpr float L2E = 1.4426950408889634f;
        float bias8[2][8];
        if (gate) { u32x4_t t0[4], t1[4]; const unsigned o0 = (unsigned)col0 * 4u; ldg8_x4<16, 512, 528>(t0, t1, bias, o0, o0);
#pragma unroll
            for (int q = 0; q < 4; ++q) { bias8[0][q] = __uint_as_float(t0[0][q]); bias8[0][4 + q] = __uint_as_float(t0[1][q]); bias8[1][q] = __uint_as_float(t0[2][q]); bias8[1][4 + q] = __uint_as_float(t0[3][q]); } }
#pragma unroll
        for (int bj = 0; bj < 2; ++bj) {
            float b[8];
#pragma unroll
            for (int q = 0; q < 8; ++q) b[q] = gate ? bias8[bj][q] : 0.f;
#pragma unroll
            for (int ai = 0; ai < 2; ++ai)
#pragma unroll
                for (int m = 0; m < 4; ++m) { float v[8];
#pragma unroll
                    for (int q = 0; q < 8; ++q) { const float x = acc[ai][bj][m][q >> 2][q & 3]; v[q] = gate ? __builtin_amdgcn_rcpf(1.f + __builtin_amdgcn_exp2f(-(x + b[q]) * L2E)) : x; }
                    pg8::u32x4 w; w.x = pg8::cvt_pk_bf16(v[0], v[1]); w.y = pg8::cvt_pk_bf16(v[2], v[3]); w.z = pg8::cvt_pk_bf16(v[4], v[5]); w.w = pg8::cvt_pk_bf16(v[6], v[7]);
                    *(pg8::u32x4*)(O + (size_t)(row0 + ai * 128 + m * 16) * DINP + col0 + bj * 128) = w; } }
    }
};
struct EpiQ {
    static constexpr bool PERM = false, AFTER_DRAIN = false; static constexpr int SEG = 0;
    bf16_t* Q; const float* rq; const float* rc; const float* rs;
    __device__ __forceinline__ void operator()(const pg8::f32x4 (&acc)[2][2][4][2], const pg8::Unit& u, int wr, int wc, int fr, int fq) const {
        int row0 = u.pm * 256 + wr * 64 + fr; asm volatile("" : "+v"(row0)); constexpr float SC = 0.10206207261596575f * 1.4426950408889634f;
        float sc8[8]; { unsigned off[8];
#pragma unroll
            for (int i = 0; i < 8; ++i) off[i] = (unsigned)(row0 + (i >> 2) * 128 + (i & 3) * 16) * 4u;
            ldg8_dw(sc8, rq, off); }
#pragma unroll
        for (int bj = 0; bj < 2; ++bj) { const int g32 = u.pn * 8 + bj * 4 + wc, col0 = g32 * 32 + 4 * fq; const bool rope = (g32 % 3) == 2;
#pragma unroll
            for (int ai = 0; ai < 2; ++ai) {
                u32x4_t cs4[4], sn4[4];
                if (rope) { u32x4_t t0[4], t1[4];
                    const unsigned o0 = (unsigned)((row0 + ai * 128) * 16 + 4 * fq) * 4u;
                    ldg8_x4<16 * 16 * 4, 32 * 16 * 4, 48 * 16 * 4>(t0, t1, rc, o0, o0 + (unsigned)(T * 16 * 4));
#pragma unroll
                    for (int m = 0; m < 4; ++m) { cs4[m] = t0[m]; sn4[m] = t1[m]; } }
#pragma unroll
                for (int m = 0; m < 4; ++m) { const int row = row0 + ai * 128 + m * 16; const float s = sc8[ai * 4 + m] * SC;
                    pg8::f32x4 v0 = acc[ai][bj][m][0] * s, v1 = acc[ai][bj][m][1] * s;
                    if (rope) { const pg8::f32x4 c4 = __builtin_bit_cast(pg8::f32x4, cs4[m]), s4 = __builtin_bit_cast(pg8::f32x4, sn4[m]);
                        const pg8::f32x4 x1 = v0, x2 = v1; v0 = x1 * c4 - x2 * s4; v1 = x1 * s4 + x2 * c4; }
                    bf16_t* qp = Q + (size_t)row * 768 + col0;
                    *(uint2*)qp = make_uint2(pg8::cvt_pk_bf16(v0[0], v0[1]), pg8::cvt_pk_bf16(v0[2], v0[3]));
                    *(uint2*)(qp + 16) = make_uint2(pg8::cvt_pk_bf16(v1[0], v1[1]), pg8::cvt_pk_bf16(v1[2], v1[3])); } } }
    }
};
struct EpiKV {
    static constexpr bool PERM = true, AFTER_DRAIN = false; static constexpr int SEG = 0;
    bf16_t* K; bf16_t* V; const float* rkv;
    __device__ __forceinline__ void operator()(const pg8::f32x4 (&acc)[2][2][4][2], const pg8::Unit& u, int wr, int wc, int fr, int fq) const {
        int row0 = u.pm * 256 + wr * 64 + fr; asm volatile("" : "+v"(row0));
        float sc8[8]; { unsigned off[8];
#pragma unroll
            for (int i = 0; i < 8; ++i) off[i] = (unsigned)(row0 + (i >> 2) * 128 + (i & 3) * 16) * 4u;
            ldg8_dw(sc8, rkv, off); }
#pragma unroll
        for (int bj = 0; bj < 2; ++bj) { const int head = u.pn * 2 + bj;
#pragma unroll
            for (int ai = 0; ai < 2; ++ai)
#pragma unroll
                for (int m = 0; m < 4; ++m) { const int row = row0 + ai * 128 + m * 16; const float s = sc8[ai * 4 + m];
                    const pg8::f32x4 v0 = acc[ai][bj][m][0] * s, v1 = acc[ai][bj][m][1] * s; pg8::u32x4 w;
                    w.x = pg8::cvt_pk_bf16(v0[0], v0[1]); w.y = pg8::cvt_pk_bf16(v0[2], v0[3]); w.z = pg8::cvt_pk_bf16(v1[0], v1[1]); w.w = pg8::cvt_pk_bf16(v1[2], v1[3]);
                    bf16_t* dst = (wc < 2) ? K + (size_t)row * 768 + head * 96 + wc * 32 + 8 * fq : V + (size_t)row * 512 + head * 64 + (wc - 2) * 32 + 8 * fq;
                    *(pg8::u32x4*)dst = w; } }
    }
};
struct EpiF32 {
    static constexpr bool PERM = true, AFTER_DRAIN = false; static constexpr int SEG = 0;
    float* O; int ldc; const float* rs;
    __device__ __forceinline__ void operator()(const pg8::f32x4 (&acc)[2][2][4][2], const pg8::Unit& u, int wr, int wc, int fr, int fq) const {
        int row0 = u.pm * 256 + wr * 64 + fr; asm volatile("" : "+v"(row0)); const int col0 = u.pn * 256 + wc * 32 + 8 * fq;
#pragma unroll
        for (int ai = 0; ai < 2; ++ai)
#pragma unroll
            for (int m = 0; m < 4; ++m) { const int row = row0 + ai * 128 + m * 16; const float s = rs ? rs[row] : 1.f;
#pragma unroll
                for (int bj = 0; bj < 2; ++bj) { float* op = O + (size_t)row * ldc + col0 + bj * 128;
                    *(pg8::f32x4*)op = acc[ai][bj][m][0] * s; *(pg8::f32x4*)(op + 4) = acc[ai][bj][m][1] * s; } }
    }
};
struct EpiMerge {
    static constexpr bool PERM = true, AFTER_DRAIN = false; static constexpr int SEG = 8;
    bf16_t* O; const bf16_t* GL;
    static __device__ __forceinline__ void ld8(const bf16_t* p, float* o) { const uint4 w = *(const uint4*)p;
        o[0] = __uint_as_float(w.x << 16); o[1] = __uint_as_float(w.x & 0xffff0000u); o[2] = __uint_as_float(w.y << 16); o[3] = __uint_as_float(w.y & 0xffff0000u);
        o[4] = __uint_as_float(w.z << 16); o[5] = __uint_as_float(w.z & 0xffff0000u); o[6] = __uint_as_float(w.w << 16); o[7] = __uint_as_float(w.w & 0xffff0000u); }
    __device__ __forceinline__ void segment(pg8::f32x4 (&acc)[2][2][4][2], const pg8::Unit& u, int seg, int wr, int wc, int fr, int fq) const {
        int row0 = u.pm * 256 + wr * 64 + fr; asm volatile("" : "+v"(row0));
        const unsigned cb = (unsigned)((seg - 1) * 1024 + u.pn * 256 + wc * 32 + 8 * fq) * 2u;
#pragma unroll
        for (int ai = 0; ai < 2; ++ai)
#pragma unroll
            for (int m = 0; m < 4; ++m) {
                u32x4_t ga[4];
                ldg4_x4<2048, 256, 2304>(ga, GL, (unsigned)(row0 + ai * 128 + m * 16) * (unsigned)(DINP * 2) + cb);
#pragma unroll
                for (int bj = 0; bj < 2; ++bj) { float x0[8], x1[8]; bf8_to_f32(ga[bj * 2], x0); bf8_to_f32(ga[bj * 2 + 1], x1);
#pragma unroll
                    for (int q = 0; q < 8; ++q) acc[ai][bj][m][q >> 2][q & 3] *= x0[q] * __builtin_amdgcn_rcpf(x1[q]); } }
    }
    __device__ __forceinline__ void operator()(const pg8::f32x4 (&acc)[2][2][4][2], const pg8::Unit& u, int wr, int wc, int fr, int fq) const {
        int row0 = u.pm * 256 + wr * 64 + fr; asm volatile("" : "+v"(row0)); const int col0 = u.pn * 256 + wc * 32 + 8 * fq;
        const unsigned cb = (unsigned)(2048 + col0) * 2u;
#pragma unroll
        for (int ai = 0; ai < 2; ++ai) {
            u32x4_t g8[8];
            { unsigned off[8];
#pragma unroll
              for (int i = 0; i < 8; ++i) off[i] = (unsigned)(row0 + ai * 128 + (i & 3) * 16) * (unsigned)(DINP * 2) + cb + (i >> 2) * 256u;
              ldg8_x4v(g8, GL, off); }
#pragma unroll
            for (int m = 0; m < 4; ++m) { const int row = row0 + ai * 128 + m * 16;
#pragma unroll
                for (int bj = 0; bj < 2; ++bj) { float x2[8], v[8]; bf8_to_f32(g8[bj * 4 + m], x2);
#pragma unroll
                    for (int q = 0; q < 8; ++q) v[q] = acc[ai][bj][m][q >> 2][q & 3] * x2[q];
                    pg8::u32x4 w; w.x = pg8::cvt_pk_bf16(v[0], v[1]); w.y = pg8::cvt_pk_bf16(v[2], v[3]); w.z = pg8::cvt_pk_bf16(v[4], v[5]); w.w = pg8::cvt_pk_bf16(v[6], v[7]);
                    *(pg8::u32x4*)(O + (size_t)row * DM + col0 + bj * 128) = w; } } }
    }
};
struct EpiRowScale {
    static constexpr bool PERM = true, AFTER_DRAIN = false; static constexpr int SEG = 0;
    bf16_t* O; int ldc; const float* rs;
    __device__ __forceinline__ void operator()(const pg8::f32x4 (&acc)[2][2][4][2], const pg8::Unit& u, int wr, int wc, int fr, int fq) const {
        int row0 = u.pm * 256 + wr * 64 + fr; asm volatile("" : "+v"(row0)); const int col0 = (u.pn & 3) * 256 + wc * 32 + 8 * fq;
        float sc8[8]; { unsigned off[8];
#pragma unroll
            for (int i = 0; i < 8; ++i) off[i] = (unsigned)(row0 + (i >> 2) * 128 + (i & 3) * 16) * 4u;
            ldg8_dw(sc8, rs, off); }
#pragma unroll
        for (int ai = 0; ai < 2; ++ai)
#pragma unroll
            for (int m = 0; m < 4; ++m) { const int row = row0 + ai * 128 + m * 16; const float s = sc8[ai * 4 + m] * (1.f / (F8_WD * F8_HID));
#pragma unroll
                for (int bj = 0; bj < 2; ++bj) { const pg8::f32x4 v0 = acc[ai][bj][m][0] * s, v1 = acc[ai][bj][m][1] * s; pg8::u32x4 w;
                    w.x = pg8::cvt_pk_bf16(v0[0], v0[1]); w.y = pg8::cvt_pk_bf16(v0[2], v0[3]); w.z = pg8::cvt_pk_bf16(v1[0], v1[1]); w.w = pg8::cvt_pk_bf16(v1[2], v1[3]);
                    *(pg8::u32x4*)(O + (size_t)row * ldc + col0 + bj * 128) = w; } }
    }
};
struct Params {
    const float* in[27];
    const int* pos;
    float* out;
    unsigned char* ws;
};

__device__ __forceinline__ float wave_sum(float v) {
#pragma unroll
    for (int o = 1; o < 64; o <<= 1) v += __shfl_xor(v, o);
    return v;
}
__device__ __forceinline__ float sigmoidf_(float x) { return 1.f / (1.f + expf(-x)); }
__device__ __forceinline__ float siluf_(float x) { return x / (1.f + expf(-x)); }
__device__ __forceinline__ float log_sigmoidf_(float x) { return fminf(x, 0.f) - log1pf(expf(-fabsf(x))); }

__device__ __forceinline__ float bf2f(bf16_t u) { return __uint_as_float((unsigned)u << 16); }
__device__ __forceinline__ unsigned f2bf(float f) { unsigned u = __float_as_uint(f); return (u + 0x7fffu + ((u >> 16) & 1u)) >> 16; }
__device__ __forceinline__ unsigned pk2(float lo, float hi) { return f2bf(lo) | (f2bf(hi) << 16); }
__device__ __forceinline__ void ld4bf(const bf16_t* p, float* o) {
    const uint2 w = *(const uint2*)p; o[0] = __uint_as_float(w.x << 16); o[1] = __uint_as_float(w.x & 0xffff0000u); o[2] = __uint_as_float(w.y << 16); o[3] = __uint_as_float(w.y & 0xffff0000u);
}
__device__ __forceinline__ void transpose_block(const float* Wblk, int ldw, bf16_t* dst, int ldt, const float* ks, const float* ns, float* scr, int lane) {
#pragma unroll 8
    for (int i = 0; i < 32; ++i) { const int kk = 2 * i + (lane >> 5); float v = __builtin_nontemporal_load(&Wblk[(size_t)kk * ldw + (lane & 31)]);     if (ks) v *= ks[kk]; if (ns) v *= ns[lane & 31]; scr[kk * 33 + (lane & 31)] = v; }
    asm volatile("s_waitcnt lgkmcnt(0)" ::: "memory");
    const int c = lane & 7;
#pragma unroll
    for (int j = 0; j < 4; ++j) { const int n = (lane >> 3) + 8 * j; const float* s = scr + (8 * c) * 33 + n;
        uint4 o; o.x = pk2(s[0 * 33], s[1 * 33]); o.y = pk2(s[2 * 33], s[3 * 33]); o.z = pk2(s[4 * 33], s[5 * 33]); o.w = pk2(s[6 * 33], s[7 * 33]);
        *(uint4*)(dst + (size_t)n * ldt + 8 * c) = o; }
    asm volatile("s_waitcnt lgkmcnt(0)" ::: "memory");
}

struct WStream {
    const float* gate; const float* up; const float* down;
    unsigned char* wgu_t; unsigned char* wd_t;
    const char* rowp; unsigned rs8, rs1;
    unsigned vo0;
    const float* src; unsigned char* dst; int ldt; float sc;
    int it, it_stride, step, nsteps;
    float v0, v1, v2, v3;
    char* blk; char* blkw;
    __device__ __forceinline__ void init(int gw, int ngw, char* lds_blk, int lane) {
        constexpr int I_ALL = 2 * 16 * 16 * 64 + 16 * 32 * 32;
        nsteps = (gw < I_ALL) ? 8 * ((I_ALL - gw + ngw - 1) / ngw) : 0;
        if (I_ALL % ngw == 0) { const int per_wg = I_ALL / (ngw >> 3); gw = (gw >> 3) * per_wg + (gw & 7); ngw = 8; nsteps = per_wg; }
        it = gw; it_stride = ngw; step = 0; blk = lds_blk; blkw = lds_blk + (lane & 31) * 80 + 4 * (lane >> 5);
        src = gate; rowp = (const char*)gate; rs8 = 0u; rs1 = 0u; vo0 = 0u; dst = wgu_t; ldt = DM; sc = 1.f; v0 = v1 = v2 = v3 = 0.f;
    }
    __device__ __forceinline__ void rare(int lane) {
        if (step >= 8 && step <= nsteps) {
            const int nr = lane >> 1, hf = lane & 1;
            const uint4 a = *(const uint4*)(blk + nr * 80 + hf * 32), b = *(const uint4*)(blk + nr * 80 + hf * 32 + 16);
            unsigned char* q = dst + (size_t)nr * ldt + hf * 32;
            { typedef unsigned u32x4n __attribute__((ext_vector_type(4))); const u32x4n an = {a.x, a.y, a.z, a.w}, bn = {b.x, b.y, b.z, b.w};
              __builtin_nontemporal_store(an, (u32x4n*)q); __builtin_nontemporal_store(bn, (u32x4n*)(q + 16)); }
        }
        if (step < nsteps) {
            constexpr int I_G = 16 * 16 * 64; int ldw;
            if (it < 2 * I_G) { const int up_ = it >= I_G, r_ = up_ ? it - I_G : it, e_ = r_ >> 10, kb_ = (r_ >> 6) & 15, nb_ = r_ & 63, j0_ = nb_ * 32;
                src = (up_ ? up : gate) + (size_t)e_ * DM * DEXP + (size_t)(64 * kb_) * DEXP + j0_; ldw = DEXP;
                dst = wgu_t + (size_t)(e_ * 4096 + 256 * (j0_ >> 7) + (j0_ & 127) + (up_ ? 128 : 0)) * DM + 64 * kb_; ldt = DM; sc = F8_WGU; }
            else { const int r_ = it - 2 * I_G, e_ = r_ >> 10, kb_ = (r_ >> 5) & 31, nb_ = r_ & 31;
                src = down + (size_t)e_ * DEXP * DM + (size_t)(64 * kb_) * DM + 32 * nb_; ldw = DM; dst = wd_t + (size_t)(e_ * 1024 + 32 * nb_) * DEXP + 64 * kb_; ldt = DEXP; sc = F8_WD; }
            it += it_stride;
            rowp = (const char*)src; rs8 = (unsigned)ldw * 32u; rs1 = (unsigned)ldw * 4u;
            vo0 = (unsigned)((4 * (lane >> 5)) * ldw + (lane & 31)) * 4u;
        } else { rowp = (const char*)src; rs8 = 0u; rs1 = 0u; vo0 = (unsigned)(lane & 31) * 4u; }
    }
    __device__ __forceinline__ void tick(int lane) {
        *(unsigned*)(blkw + ((step - 1) & 7) * 8) = pk4_fp8(v0 * sc, v1 * sc, v2 * sc, v3 * sc);
        if ((step & 7) == 0) rare(lane);
        v0 = __builtin_nontemporal_load((const float*)(rowp + vo0)); v1 = __builtin_nontemporal_load((const float*)(rowp + rs1 + vo0));
        v2 = __builtin_nontemporal_load((const float*)(rowp + 2 * rs1 + vo0)); v3 = __builtin_nontemporal_load((const float*)(rowp + 3 * rs1 + vo0));
        rowp += rs8; ++step;
    }
};

namespace att {
using bf16x8 = __attribute__((ext_vector_type(8))) short;
using s16x4  = __attribute__((ext_vector_type(4))) short;
using f32x16 = __attribute__((ext_vector_type(16))) float;
using u32x4  = __attribute__((ext_vector_type(4))) unsigned;
constexpr int NW = 8, QBLK = 32, KVBLK = 64;
constexpr int LDQ = 768, LDK = 768, LDV = 512, LDO = 1536;
constexpr int KROWB = 208;
constexpr int SHM_K = KVBLK * KROWB, SHM_V = KVBLK * 64 * 2;
constexpr int NBUF = 3;
constexpr int SHM_ATTN = NBUF * SHM_V + NBUF * SHM_K + NW * 64 * 4;
constexpr float THR = 8.f;
#define ASBAR() __builtin_amdgcn_sched_barrier(0)
__device__ __forceinline__ int crow(int r, int hi) { return (r & 3) + 8 * (r >> 2) + 4 * hi; }
__device__ __forceinline__ unsigned cvtpk(float lo, float hi) { unsigned r; asm volatile("v_cvt_pk_bf16_f32 %0, %1, %2" : "=v"(r) : "v"(lo), "v"(hi)); return r; }
#define MX3(a, b, c) __builtin_fmaxf(__builtin_fmaxf((a), (b)), (c))
template <bool FIRST>
__device__ __forceinline__ void partialSM(f32x16& p0, f32x16& p1, float& m_ref, f32x16& negm, float& alpha) {
  constexpr float THRL = THR * 1.4426950408889634f;
  float a = MX3(p0[0], p0[1], p1[0]), b = MX3(p0[2], p0[3], p1[1]); a = MX3(a, p1[2], p1[3]);
#pragma unroll
  for (int r = 4; r < 16; r += 4) { a = MX3(a, p0[r], p0[r + 1]); b = MX3(b, p0[r + 2], p0[r + 3]); a = MX3(a, p1[r], p1[r + 1]); b = MX3(b, p1[r + 2], p1[r + 3]); }
  float pmax = fmaxf(a, b);
  { auto rr = __builtin_amdgcn_permlane32_swap(__float_as_uint(pmax), __float_as_uint(pmax), false, false);
    pmax = fmaxf(__uint_as_float(rr[0]), __uint_as_float(rr[1])); }
  alpha = 1.f;
  if (FIRST || !__builtin_expect(__all(pmax <= THRL), 1)) {
    const float dl = FIRST ? pmax : fmaxf(pmax, 0.f); m_ref += dl;
#pragma unroll
    for (int r = 0; r < 16; ++r) { p0[r] -= dl; p1[r] -= dl; }
#pragma unroll
    for (int r = 0; r < 16; ++r) negm[r] = -m_ref;
    asm volatile("" : "+v"(negm));
    if (!FIRST) alpha = __builtin_amdgcn_exp2f(-dl);
  }
#pragma unroll
  for (int r = 0; r < 16; ++r) p0[r] = __builtin_amdgcn_exp2f(p0[r]);
}
#undef MX3
__device__ __forceinline__ void finishSM(f32x16& p0, f32x16& p1, float alpha, float& l_reg, bf16x8& pa0, bf16x8& pa1, bf16x8& pa2, bf16x8& pa3) {
  for (int r = 0; r < 16; ++r) p1[r] = __builtin_amdgcn_exp2f(p1[r]);
  float ps = 0; for (int r = 0; r < 16; ++r) ps += p0[r]; for (int r = 0; r < 16; ++r) ps += p1[r];
  { auto rr = __builtin_amdgcn_permlane32_swap(__float_as_uint(ps), __float_as_uint(ps), false, false);
    ps = __uint_as_float(rr[0]) + __uint_as_float(rr[1]); }
  l_reg = l_reg * alpha + ps;
#define PK4(P, BASE, OUT) do { u32x4 w = {cvtpk(P[BASE + 0], P[BASE + 1]), cvtpk(P[BASE + 2], P[BASE + 3]), cvtpk(P[BASE + 4], P[BASE + 5]), cvtpk(P[BASE + 6], P[BASE + 7])}; \
    OUT = *reinterpret_cast<bf16x8*>(&w); } while (0)
  PK4(p0, 0, pa0); PK4(p0, 8, pa1); PK4(p1, 0, pa2); PK4(p1, 8, pa3);
#undef PK4
}
__device__ __forceinline__ void qkt(f32x16& p0, f32x16& p1, const char* Ks, const bf16x8* qr, const f32x16& negm, int r32, int hi) {
  p0 = negm; p1 = negm;
#pragma unroll
  for (int d0 = 0; d0 < 6; ++d0) { const int cb = d0 * 32 + hi * 16;
    bf16x8 b0 = *reinterpret_cast<const bf16x8*>(Ks + r32 * KROWB + cb);
    bf16x8 b1 = *reinterpret_cast<const bf16x8*>(Ks + (32 + r32) * KROWB + cb);
    p0 = __builtin_amdgcn_mfma_f32_32x32x16_bf16(b0, qr[d0], p0, 0, 0, 0);
    p1 = __builtin_amdgcn_mfma_f32_32x32x16_bf16(b1, qr[d0], p1, 0, 0, 0); }
}
__device__ __forceinline__ int v_st(int k, int c) { const int kk = k;   return ((kk >> 3) * 2 + (c >> 5)) * 512 + ((kk & 7) * 32 + (c & 31)) * 2; }
__device__ __forceinline__ int v_rd_base(int lane) { return ((lane & 3) << 3) | (((lane >> 2) & 3) << 6) | (((lane >> 4) & 1) << 5) | (((lane >> 5) & 1) << 8); }
constexpr int v_rd_off(int d0, int ks, int half) { return d0 * 512 + ks * 2048 + half * 1024; }
template <int OFF> __device__ __forceinline__ s16x4 tr_read(int vb) {
  s16x4 r; asm volatile("ds_read_b64_tr_b16 %0, %1 offset:%2" : "=&v"(r) : "v"(vb), "i"(OFF) : "memory"); return r;
}
template <int D0> __device__ __forceinline__ void pv_one(f32x16& od, int vb, bf16x8 pa0, bf16x8 pa1, bf16x8 pa2, bf16x8 pa3) {
  const s16x4 l0 = tr_read<v_rd_off(D0, 0, 0)>(vb), h0 = tr_read<v_rd_off(D0, 0, 1)>(vb), l1 = tr_read<v_rd_off(D0, 1, 0)>(vb), h1 = tr_read<v_rd_off(D0, 1, 1)>(vb);
  const s16x4 l2 = tr_read<v_rd_off(D0, 2, 0)>(vb), h2 = tr_read<v_rd_off(D0, 2, 1)>(vb), l3 = tr_read<v_rd_off(D0, 3, 0)>(vb), h3 = tr_read<v_rd_off(D0, 3, 1)>(vb);
  asm volatile("s_waitcnt lgkmcnt(0)" ::: "memory"); ASBAR();
#define PK(L, H) (bf16x8){L[0], L[1], L[2], L[3], H[0], H[1], H[2], H[3]}
  od = __builtin_amdgcn_mfma_f32_32x32x16_bf16(pa0, PK(l0, h0), od, 0, 0, 0);
  od = __builtin_amdgcn_mfma_f32_32x32x16_bf16(pa1, PK(l1, h1), od, 0, 0, 0);
  od = __builtin_amdgcn_mfma_f32_32x32x16_bf16(pa2, PK(l2, h2), od, 0, 0, 0);
  od = __builtin_amdgcn_mfma_f32_32x32x16_bf16(pa3, PK(l3, h3), od, 0, 0, 0);
#undef PK
}
__device__ __forceinline__ void pv_d0(f32x16* o, int vb, bf16x8 pa0, bf16x8 pa1, bf16x8 pa2, bf16x8 pa3) {
  pv_one<0>(o[0], vb, pa0, pa1, pa2, pa3); pv_one<1>(o[1], vb, pa0, pa1, pa2, pa3);
}
__device__ __forceinline__ void attn_unit(const bf16_t* Qb, const bf16_t* Kh, const bf16_t* Vh, bf16_t* Ob, int seq, char* lds, WStream& wst) {
  int tid_ = threadIdx.x; asm volatile("" : "+v"(tid_));
  const int tid = tid_, wid = tid >> 6, lane = tid & 63, r32 = lane & 31, hi = lane >> 5;
  char* V_lds = lds; char* K_lds = lds + NBUF * SHM_V;
  float* ws = (float*)(lds + NBUF * SHM_V + NBUF * SHM_K) + wid * 64; float* li_l = ws; float* al_l = ws + 32;
  float m_ref = 0.f, l_reg = 0; f32x16 o[2] = {}; bf16x8 qr[6]; f32x16 negm = {}; asm volatile("" : "+v"(negm));
  const bf16_t* Qw = Qb + (long)(wid * QBLK + r32) * LDQ + hi * 8;
#pragma unroll
  for (int d0 = 0; d0 < 6; ++d0) qr[d0] = *reinterpret_cast<const bf16x8*>(Qw + d0 * 16);
  const bool kact = tid < 384; const int kr = tid / 12, kc = tid - kr * 12, vr = tid >> 3, vc = (tid & 7) * 8, vst0 = v_st(vr, vc);
  const int kst0 = kr * KROWB + kc * 16, kst1 = (kr + 32) * KROWB + kc * 16;
  const int vb0 = (int)(uintptr_t)V_lds + v_rd_base(lane);
  struct { bf16x8 vs, ks0, ks1; } sr_[2];
#define SLOAD(i, k0) do { sr_[i].vs = *reinterpret_cast<const bf16x8*>(&Vh[(long)((k0) + vr) * LDV + vc]); \
    if (kact) { sr_[i].ks0 = *reinterpret_cast<const bf16x8*>(&Kh[(long)((k0) + kr) * LDK + kc * 8]); sr_[i].ks1 = *reinterpret_cast<const bf16x8*>(&Kh[(long)((k0) + 32 + kr) * LDK + kc * 8]); } } while (0)
#define SWRITE(b, i) do { *(bf16x8*)(V_lds + (b) * SHM_V + vst0) = sr_[i].vs; \
    if (kact) { *(bf16x8*)(K_lds + (b) * SHM_K + kst0) = sr_[i].ks0; *(bf16x8*)(K_lds + (b) * SHM_K + kst1) = sr_[i].ks1; } } while (0)
#define SWAIT() asm volatile("s_waitcnt vmcnt(3)" ::: "memory")
#define RESC(a) do { if (__any((a) < 1.f)) { if (hi == 0) al_l[r32] = (a); asm volatile("s_waitcnt lgkmcnt(0)" ::: "memory"); \
    for (int d = 0; d < 2; ++d) for (int r = 0; r < 16; ++r) o[d][r] *= al_l[crow(r, hi)]; } } while (0)
  f32x16 pA0, pA1, pB0, pB1; float alA, alB; bf16x8 pa0, pa1, pa2, pa3; const int NT = seq / KVBLK;
  constexpr int SE = 0, SO = 1;
  int b_prev = 0, b_cur = 1, b_next = 2;
#define ROT() do { b_prev = b_cur; b_cur = b_next; b_next = (b_next == NBUF - 1) ? 0 : b_next + 1; } while (0)
  SLOAD(SE, 0); asm volatile("s_waitcnt vmcnt(0)" ::: "memory"); SWRITE(0, SE);
  SLOAD(SO, KVBLK); if (2 < NT) SLOAD(SE, 2 * KVBLK);
  __syncthreads();
  qkt(pA0, pA1, K_lds, qr, negm, r32, hi); partialSM<true>(pA0, pA1, m_ref, negm, alA);
  SWAIT(); SWRITE(1, SO); __syncthreads();
  for (int j = 1; j + 1 < NT; j += 2) {
    SLOAD(SO, (j + 2) * KVBLK);
    ASBAR(); qkt(pB0, pB1, K_lds + b_cur * SHM_K, qr, negm, r32, hi);
    finishSM(pA0, pA1, alA, l_reg, pa0, pa1, pa2, pa3); ASBAR();
    pv_d0(o, vb0 + b_prev * SHM_V, pa0, pa1, pa2, pa3); partialSM<false>(pB0, pB1, m_ref, negm, alB);
    SWAIT(); SWRITE(b_next, SE);
    RESC(alB); if (wst.step <= wst.nsteps) wst.tick(lane); __syncthreads(); ROT();
    if (j + 3 < NT) SLOAD(SE, (j + 3) * KVBLK);
    ASBAR(); qkt(pA0, pA1, K_lds + b_cur * SHM_K, qr, negm, r32, hi);
    finishSM(pB0, pB1, alB, l_reg, pa0, pa1, pa2, pa3); ASBAR();
    pv_d0(o, vb0 + b_prev * SHM_V, pa0, pa1, pa2, pa3); partialSM<false>(pA0, pA1, m_ref, negm, alA);
    SWAIT(); SWRITE(b_next, SO);
    RESC(alA); if (wst.step <= wst.nsteps) wst.tick(lane); __syncthreads(); ROT();
  }
  ASBAR(); qkt(pB0, pB1, K_lds + b_cur * SHM_K, qr, negm, r32, hi);
  finishSM(pA0, pA1, alA, l_reg, pa0, pa1, pa2, pa3); ASBAR();
  pv_d0(o, vb0 + b_prev * SHM_V, pa0, pa1, pa2, pa3); partialSM<false>(pB0, pB1, m_ref, negm, alB);
  RESC(alB);
  finishSM(pB0, pB1, alB, l_reg, pa0, pa1, pa2, pa3); ASBAR();
  pv_d0(o, vb0 + b_cur * SHM_V, pa0, pa1, pa2, pa3);
#undef ROT
  if (hi == 0) li_l[r32] = l_reg; asm volatile("s_waitcnt lgkmcnt(0)" ::: "memory");
  float rli[16];
#pragma unroll
  for (int r = 0; r < 16; ++r) rli[r] = __builtin_amdgcn_rcpf(li_l[crow(r, hi)]);
  bf16_t* Ow = Ob + (long)(wid * QBLK) * LDO;
#pragma unroll
  for (int r = 0; r < 16; ++r) { const int orow = crow(r, hi);
#pragma unroll
    for (int d0 = 0; d0 < 2; ++d0) Ow[(long)orow * LDO + d0 * 32 + r32] = (bf16_t)f2bf(o[d0][r] * rli[r]); }
  __syncthreads();
#undef SLOAD
#undef SWRITE
#undef SWAIT
#undef RESC
}
#undef ASBAR
}

namespace gla {
using bf16x8 = __attribute__((ext_vector_type(8))) short;
using s16x4  = __attribute__((ext_vector_type(4))) short;
using f32x16 = __attribute__((ext_vector_type(16))) float;
using u32x4  = __attribute__((ext_vector_type(4))) unsigned;
constexpr int L_DL = 0, L_TOT = 8192, L_RSUM = 10240, L_V = 12288, L_QF = 28672, L_KF = 37888, L_QB = 47104, L_KB = 56320, L_KSTF = 65536, L_KSTB = 74752, L_STF = 65536, L_STB = 83968, L_QR = 102400, L_KR = 110592, L_END = 118784;
constexpr int RB = 144;
__device__ __forceinline__ int crow(int r, int hi) { return (r & 3) + 8 * (r >> 2) + 4 * hi; }
__device__ __forceinline__ unsigned cvtpk(float lo, float hi) { unsigned r; asm volatile("v_cvt_pk_bf16_f32 %0, %1, %2" : "=v"(r) : "v"(lo), "v"(hi)); return r; }
__device__ __forceinline__ int v_st4(int k, int c) { const int kk = (k & ~0xC) | ((k & 4) << 1) | ((k & 8) >> 1); return ((kk >> 3) * 4 + (c >> 5)) * 512 + ((kk & 7) * 32 + (c & 31)) * 2; }
__device__ __forceinline__ int v_rd_base(int lane) { return ((lane & 3) << 3) | (((lane >> 2) & 3) << 6) | (((lane >> 4) & 1) << 5) | (((lane >> 5) & 1) << 8); }
template <int OFF> __device__ __forceinline__ s16x4 tr_read(int vb) { s16x4 r; asm volatile("ds_read_b64_tr_b16 %0, %1 offset:%2" : "=&v"(r) : "v"(vb), "i"(OFF) : "memory"); return r; }
__device__ __forceinline__ void v_frags(int vb, bf16x8 (&f)[4]) {
  const s16x4 l0 = tr_read<0>(vb), h0 = tr_read<2048>(vb), l1 = tr_read<4096>(vb), h1 = tr_read<4096 + 2048>(vb);
  const s16x4 l2 = tr_read<8192>(vb), h2 = tr_read<8192 + 2048>(vb), l3 = tr_read<12288>(vb), h3 = tr_read<12288 + 2048>(vb);
  asm volatile("s_waitcnt lgkmcnt(0)" ::: "memory"); __builtin_amdgcn_sched_barrier(0);
#define PK(L, H) (bf16x8){L[0], L[1], L[2], L[3], H[0], H[1], H[2], H[3]}
  f[0] = PK(l0, h0); f[1] = PK(l1, h1); f[2] = PK(l2, h2); f[3] = PK(l3, h3);
#undef PK
}
__device__ __forceinline__ bf16x8 frag(const char* base, int row, int ks, int hi) { return *reinterpret_cast<const bf16x8*>(base + row * RB + ks * 32 + hi * 16); }

template <bool IS_G1>
__device__ __forceinline__ void prep(char* lds, const bf16_t* projb, const float* wdec, const float* bdec, int t0, int hh, float* dec_out  , long dec_dir_stride) {
  int tid_ = threadIdx.x; asm volatile("" : "+v"(tid_)); const int tid = tid_;
  float* DL = (float*)(lds + L_DL); float* TOT = (float*)(lds + L_TOT);
  { const int i = tid >> 3, r4 = (tid & 7) * 4; float v[4]; ld4bf(projb + (size_t)(t0 + i) * DINP + OFF_GDEC + r4, v); *(float4*)(DL + i * 32 + r4) = make_float4(v[0], v[1], v[2], v[3]);
    const int c8 = (tid & 7) * 8;
    *(uint4*)(lds + L_KR + i * 128 + c8 * 2) = *(const uint4*)(projb + (size_t)(t0 + i) * DINP + OFF_GK + hh * 64 + c8);
    if constexpr (!IS_G1) *(uint4*)(lds + L_QR + i * 128 + c8 * 2) = *(const uint4*)(projb + (size_t)(t0 + i) * DINP + OFF_GQ + hh * 64 + c8); }
#pragma unroll
  for (int e2 = 0; e2 < 2; ++e2) { const int e = tid + e2 * 512, i = e >> 4, cc = (e & 15) * 8;
    *(uint4*)(lds + L_V + v_st4(i, cc)) = *(const uint4*)(projb + (size_t)(t0 + i) * DINP + OFF_GV + hh * 128 + cc); }
  __syncthreads();
  const int cidx = tid & 127, tg = tid >> 7, dir = cidx >> 6, d = cidx & 63;
  float W[16];
#pragma unroll
  for (int r = 0; r < 16; ++r) W[r] = wdec[(size_t)(dir * 16 + r) * 256 + hh * 64 + d];
  const float bias = bdec[dir * 256 + hh * 64 + d];
  constexpr float L2E = 1.4426950408889634f;
  float g[16], cs[16]; float run = 0.f;
#pragma unroll
  for (int ii = 0; ii < 16; ++ii) { const float* dl = DL + (16 * tg + ii) * 32 + dir * 16; float a = bias;
#pragma unroll
    for (int r = 0; r < 16; r += 4) { const float4 x = *(const float4*)(dl + r); a = fmaf(x.x, W[r], a); a = fmaf(x.y, W[r + 1], a); a = fmaf(x.z, W[r + 2], a); a = fmaf(x.w, W[r + 3], a); }
    g[ii] = (fminf(a, 0.f) * L2E - __builtin_amdgcn_logf(1.f + __builtin_amdgcn_exp2f(-fabsf(a) * L2E))) * (1.f / 16.f); run += g[ii]; cs[ii] = run; }
  TOT[tg * 128 + cidx] = run;
  __syncthreads();
  const float t0s = TOT[cidx], t1s = TOT[128 + cidx], t2s = TOT[256 + cidx], t3s = TOT[384 + cidx], tall = (t0s + t1s) + (t2s + t3s);
  const float off_lo = (tg > 0 ? t0s : 0.f) + (tg > 1 ? t1s : 0.f) + (tg > 2 ? t2s : 0.f);
  const float off_hi = (tg < 1 ? t1s : 0.f) + (tg < 2 ? t2s : 0.f) + (tg < 3 ? t3s : 0.f);
  const bf16_t* KR = (const bf16_t*)(lds + L_KR); const bf16_t* QR = (const bf16_t*)(lds + L_QR);
  if constexpr (IS_G1) {
    unsigned pk[8];
#pragma unroll
    for (int ii = 0; ii < 16; ii += 2) {
      float kv2[2];
#pragma unroll
      for (int u = 0; u < 2; ++u) { const int i = 16 * tg + ii + u; const float bi = dir == 0 ? off_lo + cs[ii + u] : off_hi + run - cs[ii + u] + g[ii + u];
        kv2[u] = bf2f(KR[i * 64 + d]) * __builtin_amdgcn_exp2f(tall - bi); }
      pk[ii >> 1] = cvtpk(kv2[0], kv2[1]); }
    char* dst = lds + (dir ? L_KSTB : L_KSTF) + d * RB + 32 * tg;
    *(uint4*)dst = make_uint4(pk[0], pk[1], pk[2], pk[3]); *(uint4*)(dst + 16) = make_uint4(pk[4], pk[5], pk[6], pk[7]);
    if (tg == 0) dec_out[dir * dec_dir_stride + d] = __builtin_amdgcn_exp2f(tall);
  } else {
    bf16_t* Qx = (bf16_t*)(lds + (dir ? L_QB : L_QF)); bf16_t* Kx = (bf16_t*)(lds + (dir ? L_KB : L_KF));
#pragma unroll
    for (int ii = 0; ii < 16; ++ii) { const int i = 16 * tg + ii; const float bi = dir == 0 ? off_lo + cs[ii] : off_hi + run - cs[ii] + g[ii];
      const float qv = bf2f(QR[i * 64 + d]) * 0.125f, kv = bf2f(KR[i * 64 + d]);
      Qx[i * (RB / 2) + d] = (bf16_t)f2bf(qv * __builtin_amdgcn_exp2f(bi)); Kx[i * (RB / 2) + d] = (bf16_t)f2bf(kv * __builtin_amdgcn_exp2f(-bi)); }
  }
  __syncthreads();
}

__device__ __forceinline__ void g1_item(char* lds, const bf16_t* projb, const float* wdec, const float* bdec, int b, int hh, int c, float* kvt, float* dec) {
  int tid_ = threadIdx.x; asm volatile("" : "+v"(tid_)); const int tid = tid_, wid = tid >> 6, lane = tid & 63, r32 = lane & 31, hi = lane >> 5;
  const int bh = b * 4 + hh; const long item = (long)bh * 128 + c, dstride = 8L * 128;
  prep<true>(lds, projb, wdec, bdec, b * SEQ + c * 64, hh, dec + item * 64, dstride * 64);
  const int vblk = wid >> 1, dblk = wid & 1;
  bf16x8 vf[4]; v_frags((int)(uintptr_t)(lds + L_V) + v_rd_base(lane) + vblk * 512, vf);
#pragma unroll
  for (int dir = 0; dir < 2; ++dir) { const char* kst = lds + (dir ? L_KSTB : L_KSTF); f32x16 acc = {};
#pragma unroll
    for (int ks = 0; ks < 4; ++ks) acc = __builtin_amdgcn_mfma_f32_32x32x16_bf16(vf[ks], frag(kst, dblk * 32 + r32, ks, hi), acc, 0, 0, 0);
    float* o = kvt + ((long)dir * dstride + item) * 8192 + (size_t)(vblk * 32) * 64 + dblk * 32 + r32;
#pragma unroll
    for (int r = 0; r < 16; ++r) o[crow(r, hi) * 64] = acc[r]; }
  __syncthreads();
}

__device__ __forceinline__ void g3_item(char* lds, const bf16_t* projb, const float* wdec, const float* bdec, const float* normg, int b, int hh, int c, const bf16_t* st, bf16_t* out, int ldo) {
  int tid_ = threadIdx.x; asm volatile("" : "+v"(tid_)); const int tid = tid_, wid = tid >> 6, lane = tid & 63, r32 = lane & 31, hi = lane >> 5;
  const int bh = b * 4 + hh, t0 = b * SEQ + c * 64; const long item = (long)bh * 128 + c, dstride = 8L * 128;
#pragma unroll
  for (int e4 = 0; e4 < 4; ++e4) { const int e = tid + e4 * 512, dir = e >> 10, v = (e >> 3) & 127, dc = (e & 7) * 8;
    *(uint4*)(lds + (dir ? L_STB : L_STF) + v * RB + dc * 2) = *(const uint4*)(st + ((long)dir * dstride + item) * 8192 + (size_t)v * 64 + dc); }
  prep<false>(lds, projb, wdec, bdec, t0, hh, nullptr, 0);
  const int ib = wid & 1, vblk = wid >> 1, iglob = ib * 32 + r32;
  bf16_t rgr[16];
#pragma unroll
  for (int r = 0; r < 16; ++r) rgr[r] = projb[(size_t)(t0 + ib * 32 + crow(r, hi)) * DINP + OFF_GR + hh * 128 + vblk * 32 + r32];
  f32x16 pF0 = {}, pF1 = {}, pB0 = {}, pB1 = {};
#pragma unroll
  for (int ks = 0; ks < 4; ++ks) {
    const bf16x8 qf = frag(lds + L_QF, iglob, ks, hi), qb = frag(lds + L_QB, iglob, ks, hi);
    pF0 = __builtin_amdgcn_mfma_f32_32x32x16_bf16(frag(lds + L_KF, r32, ks, hi), qf, pF0, 0, 0, 0);
    pF1 = __builtin_amdgcn_mfma_f32_32x32x16_bf16(frag(lds + L_KF, 32 + r32, ks, hi), qf, pF1, 0, 0, 0);
    pB0 = __builtin_amdgcn_mfma_f32_32x32x16_bf16(frag(lds + L_KB, r32, ks, hi), qb, pB0, 0, 0, 0);
    pB1 = __builtin_amdgcn_mfma_f32_32x32x16_bf16(frag(lds + L_KB, 32 + r32, ks, hi), qb, pB1, 0, 0, 0); }
#pragma unroll
  for (int r = 0; r < 16; ++r) { const int j0 = crow(r, hi), j1 = 32 + j0;
    pF0[r] = (j0 <= iglob ? pF0[r] : 0.f) + (j0 >= iglob ? pB0[r] : 0.f);
    pF1[r] = (j1 <= iglob ? pF1[r] : 0.f) + (j1 >= iglob ? pB1[r] : 0.f); }
  bf16x8 pa0, pa1, pa2, pa3;
#define PK4(P, BASE, OUT) do { unsigned a0 = cvtpk(P[BASE + 0], P[BASE + 1]), a1 = cvtpk(P[BASE + 2], P[BASE + 3]);   \
    unsigned b0 = cvtpk(P[BASE + 4], P[BASE + 5]), b1 = cvtpk(P[BASE + 6], P[BASE + 7]);                              \
    auto r0 = __builtin_amdgcn_permlane32_swap(a0, b0, false, false); auto r1 = __builtin_amdgcn_permlane32_swap(a1, b1, false, false); \
    u32x4 w = {r0[0], r1[0], r0[1], r1[1]}; OUT = *reinterpret_cast<bf16x8*>(&w); } while (0)
  PK4(pF0, 0, pa0); PK4(pF0, 8, pa1); PK4(pF1, 0, pa2); PK4(pF1, 8, pa3);
#undef PK4
  bf16x8 vf[4]; v_frags((int)(uintptr_t)(lds + L_V) + v_rd_base(lane) + vblk * 512, vf);
  f32x16 o = {};
  o = __builtin_amdgcn_mfma_f32_32x32x16_bf16(pa0, vf[0], o, 0, 0, 0); o = __builtin_amdgcn_mfma_f32_32x32x16_bf16(pa1, vf[1], o, 0, 0, 0);
  o = __builtin_amdgcn_mfma_f32_32x32x16_bf16(pa2, vf[2], o, 0, 0, 0); o = __builtin_amdgcn_mfma_f32_32x32x16_bf16(pa3, vf[3], o, 0, 0, 0);
#pragma unroll
  for (int ks = 0; ks < 4; ++ks) {
    o = __builtin_amdgcn_mfma_f32_32x32x16_bf16(frag(lds + L_QF, iglob, ks, hi), frag(lds + L_STF, vblk * 32 + r32, ks, hi), o, 0, 0, 0);
    o = __builtin_amdgcn_mfma_f32_32x32x16_bf16(frag(lds + L_QB, iglob, ks, hi), frag(lds + L_STB, vblk * 32 + r32, ks, hi), o, 0, 0, 0); }
  float* RS = (float*)(lds + L_RSUM);
  float ss[16];
#pragma unroll
  for (int r = 0; r < 16; ++r) { float s = o[r] * o[r]; s += __shfl_xor(s, 1); s += __shfl_xor(s, 2); s += __shfl_xor(s, 4); s += __shfl_xor(s, 8); s += __shfl_xor(s, 16); ss[r] = s; }
  if (r32 == 0) {
#pragma unroll
    for (int r = 0; r < 16; ++r) RS[(ib * 4 + vblk) * 32 + crow(r, hi)] = ss[r]; }
  __syncthreads();
  const int v = vblk * 32 + r32; const float ng = normg[v];
#pragma unroll
  for (int r = 0; r < 16; ++r) { const int il = crow(r, hi), i = ib * 32 + il;
    const float tot = (RS[(ib * 4 + 0) * 32 + il] + RS[(ib * 4 + 1) * 32 + il]) + (RS[(ib * 4 + 2) * 32 + il] + RS[(ib * 4 + 3) * 32 + il]);
    const float rstd = 1.f / sqrtf(tot * (1.f / 128.f) + RMS_EPS);
    const float rg = bf2f(rgr[r]);
    out[(size_t)(t0 + i) * ldo + hh * 128 + v] = (bf16_t)f2bf(o[r] * rstd * ng * (rg * __builtin_amdgcn_rcpf(1.f + __builtin_amdgcn_exp2f(-1.4426950408889634f * rg)))); }
  __syncthreads();
}
}

__device__ __forceinline__ void ln_core(float4 (&v)[4], const float* g, const float* b, float* out, bf16_t* outb, int lane) {
    float s = 0.f;
#pragma unroll
    for (int j = 0; j < 4; ++j) s += (v[j].x + v[j].y) + (v[j].z + v[j].w);
    const float mean = wave_sum(s) * (1.f / DM); float s2 = 0.f;
#pragma unroll
    for (int j = 0; j < 4; ++j) { v[j].x -= mean; v[j].y -= mean; v[j].z -= mean; v[j].w -= mean; s2 += (v[j].x * v[j].x + v[j].y * v[j].y) + (v[j].z * v[j].z + v[j].w * v[j].w); }
    const float rstd = 1.f / sqrtf(wave_sum(s2) * (1.f / DM) + LN_EPS);
#pragma unroll
    for (int j = 0; j < 4; ++j) {
        const float4 gg = ((const float4*)g)[lane + 64 * j], bb = ((const float4*)b)[lane + 64 * j];
        float4 o; o.x = v[j].x * rstd * gg.x + bb.x; o.y = v[j].y * rstd * gg.y + bb.y; o.z = v[j].z * rstd * gg.z + bb.z; o.w = v[j].w * rstd * gg.w + bb.w;
        ((float4*)out)[lane + 64 * j] = o; v[j] = o;
        if (outb) ((uint2*)outb)[lane + 64 * j] = make_uint2(pk2(o.x, o.y), pk2(o.z, o.w));
    }
}
__device__ __forceinline__ void wave_sum2(float& a, float& b) {
#pragma unroll
    for (int o = 1; o < 64; o <<= 1) { const float ta = __shfl_xor(a, o), tb = __shfl_xor(b, o); a += ta; b += tb; }
}
template <int MODE>
__device__ __forceinline__ void ln_core2(float4 (&v)[2][4], const float* g, const float* b, float* out0, float* out1, bf16_t* ob0, bf16_t* ob1, int lane, unsigned char* o8_0 = nullptr, unsigned char* o8_1 = nullptr) {
    float s[2] = {0.f, 0.f};
#pragma unroll
    for (int u = 0; u < 2; ++u)
#pragma unroll
        for (int j = 0; j < 4; ++j) s[u] += (v[u][j].x + v[u][j].y) + (v[u][j].z + v[u][j].w);
    wave_sum2(s[0], s[1]);
    float q[2] = {0.f, 0.f};
#pragma unroll
    for (int u = 0; u < 2; ++u) { const float mean = s[u] * (1.f / DM);
#pragma unroll
        for (int j = 0; j < 4; ++j) { v[u][j].x -= mean; v[u][j].y -= mean; v[u][j].z -= mean; v[u][j].w -= mean; q[u] += (v[u][j].x * v[u][j].x + v[u][j].y * v[u][j].y) + (v[u][j].z * v[u][j].z + v[u][j].w * v[u][j].w); } }
    wave_sum2(q[0], q[1]);
#pragma unroll
    for (int j = 0; j < 4; ++j) {
        const float4 gg = ((const float4*)g)[lane + 64 * j], bb = ((const float4*)b)[lane + 64 * j];
#pragma unroll
        for (int u = 0; u < 2; ++u) { const float rstd = 1.f / sqrtf(q[u] * (1.f / DM) + LN_EPS);
            float4 o; o.x = v[u][j].x * rstd * gg.x + bb.x; o.y = v[u][j].y * rstd * gg.y + bb.y; o.z = v[u][j].z * rstd * gg.z + bb.z; o.w = v[u][j].w * rstd * gg.w + bb.w;
            v[u][j] = o;
            if constexpr (MODE == 2) ((float4*)(u ? out1 : out0))[lane + 64 * j] = o;
            else ((uint2*)(u ? ob1 : ob0))[lane + 64 * j] = make_uint2(pk2(o.x, o.y), pk2(o.z, o.w));
            if constexpr (MODE == 1) ((unsigned*)(u ? o8_1 : o8_0))[lane + 64 * j] = pk4_fp8(o.x, o.y, o.z, o.w); }
    }
}
__device__ __forceinline__ int block_excl_scan(int x, int* scr, int tid, int& total) {
    const int lane = tid & 63, wid = tid >> 6; int inc = x;
#pragma unroll
    for (int o = 1; o < 64; o <<= 1) { const int y = __shfl_up(inc, o); if (lane >= o) inc += y; }
    __syncthreads();
    if (lane == 63) scr[wid] = inc;
    __syncthreads();
    int base = 0, tot = 0;
#pragma unroll
    for (int w = 0; w < 8; ++w) { const int c = scr[w]; base += (w < wid) ? c : 0; tot += c; }
    total = tot; return base + inc - x;
}

__device__ __forceinline__ void tb_load(float (&v)[32], const float* Wblk, int ldw, int lane) {
#pragma unroll
    for (int i = 0; i < 32; ++i) v[i] = __builtin_nontemporal_load(&Wblk[(size_t)(2 * i + (lane >> 5)) * ldw + (lane & 31)]);
}
__device__ __forceinline__ void tb_store(const float (&v)[32], bf16_t* dst, int ldt, float* scr, int lane) {
#pragma unroll
    for (int i = 0; i < 32; ++i) scr[(2 * i + (lane >> 5)) * 33 + (lane & 31)] = v[i];
    asm volatile("s_waitcnt lgkmcnt(0)" ::: "memory");
    const int c = lane & 7;
#pragma unroll
    for (int j = 0; j < 4; ++j) { const int n = (lane >> 3) + 8 * j; const float* s = scr + (8 * c) * 33 + n;
        uint4 o; o.x = pk2(s[0 * 33], s[1 * 33]); o.y = pk2(s[2 * 33], s[3 * 33]); o.z = pk2(s[4 * 33], s[5 * 33]); o.w = pk2(s[6 * 33], s[7 * 33]);
        *(uint4*)(dst + (size_t)n * ldt + 8 * c) = o; }
    asm volatile("s_waitcnt lgkmcnt(0)" ::: "memory");
}

__device__ __forceinline__ void tb_store8(const float (&v)[32], unsigned char* dst, int ldt, float sc, float* scr, int lane) {
#pragma unroll
    for (int i = 0; i < 32; ++i) scr[(2 * i + (lane >> 5)) * 33 + (lane & 31)] = v[i];
    asm volatile("s_waitcnt lgkmcnt(0)" ::: "memory");
    const int c = lane & 7;
#pragma unroll
    for (int j = 0; j < 4; ++j) { const int n = (lane >> 3) + 8 * j; const float* s = scr + (8 * c) * 33 + n;
        *(uint2*)(dst + (size_t)n * ldt + 8 * c) = make_uint2(pk4_fp8(s[0 * 33] * sc, s[1 * 33] * sc, s[2 * 33] * sc, s[3 * 33] * sc), pk4_fp8(s[4 * 33] * sc, s[5 * 33] * sc, s[6 * 33] * sc, s[7 * 33] * sc)); }
    asm volatile("s_waitcnt lgkmcnt(0)" ::: "memory");
}

__device__ __forceinline__ void ln_row(const float* a, const float* add, float alpha, const float* g, const float* b, float* out, int lane, float4 (&v)[4], bf16_t* outb = nullptr) {
    float s = 0.f;
#pragma unroll
    for (int j = 0; j < 4; ++j) {
        float4 x = ((const float4*)a)[lane + 64 * j];
        x.x *= alpha; x.y *= alpha; x.z *= alpha; x.w *= alpha;
        if (add) { const float4 y = ((const float4*)add)[lane + 64 * j]; x.x += y.x; x.y += y.y; x.z += y.z; x.w += y.w; }
        v[j] = x; s += (x.x + x.y) + (x.z + x.w);
    }
    const float mean = wave_sum(s) * (1.f / DM); float s2 = 0.f;
#pragma unroll
    for (int j = 0; j < 4; ++j) { v[j].x -= mean; v[j].y -= mean; v[j].z -= mean; v[j].w -= mean; s2 += (v[j].x * v[j].x + v[j].y * v[j].y) + (v[j].z * v[j].z + v[j].w * v[j].w); }
    const float rstd = 1.f / sqrtf(wave_sum(s2) * (1.f / DM) + LN_EPS);
#pragma unroll
    for (int j = 0; j < 4; ++j) {
        const float4 gg = ((const float4*)g)[lane + 64 * j], bb = ((const float4*)b)[lane + 64 * j];
        float4 o; o.x = v[j].x * rstd * gg.x + bb.x; o.y = v[j].y * rstd * gg.y + bb.y; o.z = v[j].z * rstd * gg.z + bb.z; o.w = v[j].w * rstd * gg.w + bb.w;
        if (out) ((float4*)out)[lane + 64 * j] = o; v[j] = o;
        if (outb) ((uint2*)outb)[lane + 64 * j] = make_uint2(pk2(o.x, o.y), pk2(o.z, o.w));
    }
}

struct GemmP {
    const float* A; const int* ridx; const float* Bm; float* C;
    int lda, ldb, ldc, M, N, K, nb, bshift;
    long sA, sB, sC; int sR;
    const float* aux; const bf16_t* auxb; int ldaux; long sAux; const float* aux2; int accum;
};
template <int MODE>
__device__ __forceinline__ void gemm_naive(const GemmP g, float* lds) {
    float (*As)[132] = (float (*)[132])lds;
    float (*Bs)[128] = (float (*)[128])(lds + 16 * 132);
    int tid_ = threadIdx.x; asm volatile("" : "+v"(tid_));
    const int tid = tid_, ty = tid >> 4, tx = tid & 15;
    const int mt = g.M / 128, nt = (g.N + 127) / 128, per = mt * nt, total = per * g.nb;
    int bid_ = blockIdx.x; asm volatile("" : "+s"(bid_));
    for (int tile = bid_; tile < total; tile += gridDim.x) {
        const int z = tile / per, r = tile % per, tm = r / nt, tn = r % nt;
        const int m0 = tm * 128, n0 = tn * 128;
        const float* Bz = g.Bm + (long)(z >> g.bshift) * g.sB;
        float* Cz = g.C + (long)z * g.sC;
        const int arow = m0 + (tid >> 2);
        const long grow = g.ridx ? (long)g.ridx[z * g.sR + arow] : (long)arow;
        const float* Arow = g.A + (long)z * g.sA + grow * g.lda + (tid & 3) * 4;
        const int bk = tid >> 5, bn = n0 + (tid & 31) * 4;
        const bool bok = bn < g.N;
        const float* Bp = Bz + (long)bk * g.ldb + bn;
        float acc[4][8];
#pragma unroll
        for (int i = 0; i < 4; ++i)
#pragma unroll
            for (int j = 0; j < 8; ++j) acc[i][j] = 0.f;
        float4 ra = *(const float4*)(Arow);
        float4 rb = bok ? *(const float4*)(Bp) : make_float4(0.f, 0.f, 0.f, 0.f);
        for (int k0 = 0; k0 < g.K; k0 += 16) {
            __syncthreads();
            { const int rr = tid >> 2, k4 = (tid & 3) * 4; As[k4][rr] = ra.x; As[k4 + 1][rr] = ra.y; As[k4 + 2][rr] = ra.z; As[k4 + 3][rr] = ra.w; }
            *(float4*)&Bs[bk][(tid & 31) * 4] = rb;
            __syncthreads();
            if (k0 + 16 < g.K) {
                ra = *(const float4*)(Arow + k0 + 16);
                rb = bok ? *(const float4*)(Bp + (long)(k0 + 16) * g.ldb) : make_float4(0.f, 0.f, 0.f, 0.f);
            }
#pragma unroll
            for (int k = 0; k < 16; ++k) {
                const float4 a = *(const float4*)&As[k][ty * 4];
                const float4 b0 = *(const float4*)&Bs[k][tx * 8], b1 = *(const float4*)&Bs[k][tx * 8 + 4];
                const float av[4] = {a.x, a.y, a.z, a.w};
                const float bv[8] = {b0.x, b0.y, b0.z, b0.w, b1.x, b1.y, b1.z, b1.w};
#pragma unroll
                for (int i = 0; i < 4; ++i)
#pragma unroll
                    for (int j = 0; j < 8; ++j) acc[i][j] = fmaf(av[i], bv[j], acc[i][j]);
            }
        }
#pragma unroll
        for (int i = 0; i < 4; ++i) {
            const int row = m0 + ty * 4 + i;
#pragma unroll
            for (int jv = 0; jv < 2; ++jv) {
                const int col = n0 + tx * 8 + jv * 4;
                if (col < g.N) {
                    float v[4] = {acc[i][jv * 4], acc[i][jv * 4 + 1], acc[i][jv * 4 + 2], acc[i][jv * 4 + 3]};
                    float* cp = Cz + (long)row * g.ldc + col;
                    if (MODE == 1) {
#pragma unroll
                        for (int q = 0; q < 4; ++q) v[q] *= g.aux[(long)z * g.sAux + col + q];
                    } else if (MODE == 2) {
                        float gl[4]; ld4bf(g.auxb + (long)row * g.ldaux + col, gl); const float4 gb = *(const float4*)(g.aux2 + col);
                        const float gv[4] = {gl[0] + gb.x, gl[1] + gb.y, gl[2] + gb.z, gl[3] + gb.w};
                        float4 old = make_float4(0.f, 0.f, 0.f, 0.f);
                        if (g.accum) old = *(const float4*)cp;
                        const float ov[4] = {old.x, old.y, old.z, old.w};
#pragma unroll
                        for (int q = 0; q < 4; ++q) v[q] = ov[q] + sigmoidf_(gv[q]) * v[q];
                    } else if (MODE == 3) {
                        const float4 old = *(const float4*)cp; const float ov[4] = {old.x, old.y, old.z, old.w};
#pragma unroll
                        for (int q = 0; q < 4; ++q) v[q] = siluf_(ov[q]) * v[q];
                    } else if (MODE == 4) {
                        const float rs = g.aux[(long)z * g.sAux + row];
#pragma unroll
                        for (int q = 0; q < 4; ++q) v[q] *= rs;
                    }
                    *(float4*)cp = make_float4(v[0], v[1], v[2], v[3]);
                }
            }
        }
    }
    __syncthreads();
}

#define W_IN(l)    (p.in[4]  + (size_t)(l) * DM * DIN)
#define B_GATE(l)  (p.in[5]  + (size_t)(l) * 3 * DM)
#define POOL_W(l)  (p.in[6]  + (size_t)(l) * 4 * 128 * 128)
#define POOL_S(l)  (p.in[7]  + (size_t)(l) * 512)
#define W_UP_A(l)  (p.in[8]  + (size_t)(l) * 512 * DM)
#define Q_NORM(l)  (p.in[9]  + (size_t)(l) * 384)
#define W_UQ(l)    (p.in[10] + (size_t)(l) * 384 * 768)
#define KV_NORM(l) (p.in[11] + (size_t)(l) * 256)
#define W_UKV(l)   (p.in[12] + (size_t)(l) * 256 * 1024)
#define W_UP_B(l)  (p.in[13] + (size_t)(l) * 512 * DM)
#define W_DEC(l)   (p.in[14] + (size_t)(l) * 2 * 16 * 256)
#define B_DEC(l)   (p.in[15] + (size_t)(l) * 2 * 256)
#define GLA_NORM(l)(p.in[16] + (size_t)(l) * 128)
#define W_UP_C(l)  (p.in[17] + (size_t)(l) * 512 * DM)
#define W_OUT(l)   (p.in[18] + (size_t)(l) * DM * DM)
#define LN1_G(l)   (p.in[19] + (size_t)(l) * DM)
#define LN1_B(l)   (p.in[20] + (size_t)(l) * DM)
#define ROUTER(l)  (p.in[21] + (size_t)(l) * DM * NE)
#define EW_GATE(l) (p.in[22] + (size_t)(l) * NE * DM * DEXP)
#define EW_UP(l)   (p.in[23] + (size_t)(l) * NE * DM * DEXP)
#define EW_DOWN(l) (p.in[24] + (size_t)(l) * NE * DEXP * DM)
#define LN2_G(l)   (p.in[25] + (size_t)(l) * DM)
#define LN2_B(l)   (p.in[26] + (size_t)(l) * DM)
#define WSF(off) ((float*)(p.ws + (off)))
#define WSI(off) ((int*)(p.ws + (off)))
#define WSB(off) ((bf16_t*)(p.ws + (off)))
#define PJ(t, c) bf2f(projb[(size_t)(t) * DINP + (c)])

enum Stage {
    ST_INIT = 0,
    ST_WCONV,
    ST_PROJ,
    ST_PREP,
    ST_SMALLGEMM,
    ST_ROPE,
    ST_ATTN,
    ST_GLA1, ST_GLA2, ST_GLA3,
    ST_GLAFIN,
    ST_MERGE_A, ST_MERGE_B, ST_MERGE_C,
    ST_OUTP,
    ST_LN1,
    ST_TOPK,
    ST_GATHER,
    ST_EXP_G, ST_EXP_U, ST_EXP_D,
    ST_LN2,
    ST_COUNT
};

#define KAS __attribute__((address_space(4)))
template <int ST>
__device__ __forceinline__ void run_stage(int l, float* lds) {
    const KAS Params* pk_ = (const KAS Params*)__builtin_amdgcn_kernarg_segment_ptr(); asm volatile("" : "+s"(pk_));
    const KAS Params& p = *pk_;
    int tid_ = threadIdx.x; asm volatile("" : "+v"(tid_));
    int bid_ = blockIdx.x; asm volatile("" : "+s"(bid_));
    const int tid = tid_, lane = tid & 63, wid = tid >> 6;
    const int G = gridDim.x, bid = bid_;
    const int gw = bid * 8 + wid, NGW = G * 8;
    const long gt = (long)bid * NTHR + tid, NGT = (long)G * NTHR;
    float* h = p.out;

    if constexpr (ST == ST_INIT) {
        for (int m0 = gw; m0 < T; m0 += 2 * NGW) {
            const int mr[2] = {m0, m0 + NGW}; float4 a[2][4];
#pragma unroll
            for (int u = 0; u < 2; ++u)
#pragma unroll
                for (int j = 0; j < 4; ++j) a[u][j] = ((const float4*)(p.in[0] + (size_t)mr[u] * DM))[lane + 64 * j];
            ln_core2<0>(a, p.in[2], p.in[3], nullptr, nullptr, WSB(WS_HB) + (size_t)mr[0] * DM, WSB(WS_HB) + (size_t)mr[1] * DM, lane);
        }
        {
            float* scr = lds + wid * 4096;
            constexpr int NBLK = DIN / 32, ITEMS_L = (DM / 64) * NBLK;
            {
#define WIN_ITEM(it, W, dst) do { const int ll_ = (it) / ITEMS_L, r_ = (it) % ITEMS_L, kb_ = r_ / NBLK, nb_ = r_ % NBLK; const int n0_ = 32 * nb_, drow_ = n0_ < 2752 ? n0_ + 3072 : n0_ - 2752; \
                    W = p.in[4] + (size_t)ll_ * DM * DIN + (size_t)(64 * kb_) * DIN + n0_; dst = WSB(WS_WIN_T) + (size_t)ll_ * DINP * DM + (size_t)drow_ * DM + 64 * kb_; } while (0)
                float va[32], vb[32]; const float* Wa = nullptr; const float* Wb = nullptr; bf16_t* da = nullptr; bf16_t* db = nullptr;
                int itA = gw, itB = gw + NGW;
                if (itA < 2 * ITEMS_L) { WIN_ITEM(itA, Wa, da); tb_load(va, Wa, DIN, lane); }
                while (itA < 2 * ITEMS_L) {
                    if (itB < 2 * ITEMS_L) { WIN_ITEM(itB, Wb, db); tb_load(vb, Wb, DIN, lane); }
                    tb_store(va, da, DM, scr, lane);
                    itA = itB + NGW;
                    if (itB >= 2 * ITEMS_L) break;
                    if (itA < 2 * ITEMS_L) { WIN_ITEM(itA, Wa, da); tb_load(va, Wa, DIN, lane); }
                    tb_store(vb, db, DM, scr, lane);
                    itB = itA + NGW;
                }
#undef WIN_ITEM
            }
            {
                constexpr int I_UQ = 6 * 24, I_UKV = 4 * 32, I_B = 8 * 32, I_OUT = 16 * 32, I_L = I_UQ + I_UKV + 2 * I_B + I_OUT;
                for (int it = gw; it < 2 * I_L; it += NGW) {
                    const int ll = it / I_L; int r = it % I_L; bf16_t* wsm = WSB(WS_WSMALL + (size_t)ll * WSM_STRIDE);
                    if (r < I_UQ) { const int kb = r / 24, nb = r % 24; transpose_block(p.in[10] + (size_t)ll * 384 * 768 + (size_t)(64 * kb) * 768 + 32 * nb, 768, wsm + WSM_UQ / 2 + (size_t)(32 * nb) * 384 + 64 * kb, 384, p.in[9] + ll * 384 + 64 * kb, nullptr, scr, lane); continue; } r -= I_UQ;
                    if (r < I_UKV) { const int kb = r / 32, nb = r % 32; transpose_block(p.in[12] + (size_t)ll * 256 * 1024 + (size_t)(64 * kb) * 1024 + 32 * nb, 1024, wsm + WSM_UKV / 2 + (size_t)(32 * nb) * 256 + 64 * kb, 256, p.in[11] + ll * 256 + 64 * kb, nullptr, scr, lane); continue; } r -= I_UKV;
                    if (r < 2 * I_B) { const int c = r / I_B, rr = r % I_B, kb = rr / 32, nb = rr % 32; const float* W = (c ? p.in[17] : p.in[13]) + (size_t)ll * 512 * DM;
                        transpose_block(W + (size_t)(64 * kb) * DM + 32 * nb, DM, wsm + WSM_MRG / 2 + (size_t)(32 * nb) * 1536 + 512 * (1 + c) + 64 * kb, 1536, nullptr, nullptr, scr, lane); continue; } r -= 2 * I_B;
                    { const int kb = r / 32, nb = r % 32; transpose_block(p.in[18] + (size_t)ll * DM * DM + (size_t)(64 * kb) * DM + 32 * nb, DM, wsm + WSM_OUT / 2 + (size_t)(32 * nb) * DM + 64 * kb, DM, nullptr, nullptr, scr, lane); }
                }
                {
                    float* At = lds; float* Bs = lds + 128 * 129;
                    for (int it = bid; it < 2 * 4 * 32; it += G) {
                        const int ll = it >> 7, g = (it >> 5) & 3, db = it & 31;
                        const float* pw = p.in[6] + (size_t)ll * 4 * 128 * 128 + (size_t)g * 128 * 128; const float* ps = p.in[7] + ll * 512 + g * 128;
                        const float* wa = p.in[8] + (size_t)ll * 512 * DM + (size_t)(g * 128) * DM + db * 32;
                        __syncthreads();
                        for (int e = tid; e < 128 * 128; e += NTHR) { const int c = e >> 7, cp = e & 127; At[cp * 129 + c] = pw[e] * ps[cp]; }
                        for (int e = tid; e < 128 * 32; e += NTHR) { const int cp = e >> 5, dd = e & 31; Bs[cp * 32 + dd] = wa[(size_t)cp * DM + dd]; }
                        __syncthreads();
                        const int c = tid >> 2, d0 = (tid & 3) * 8;
                        float a0 = 0.f, a1 = 0.f, a2 = 0.f, a3 = 0.f, a4 = 0.f, a5 = 0.f, a6 = 0.f, a7 = 0.f;
#pragma unroll 8
                        for (int cp = 0; cp < 128; ++cp) { const float a = At[cp * 129 + c]; const float4 b0 = *(const float4*)(Bs + cp * 32 + d0), b1 = *(const float4*)(Bs + cp * 32 + d0 + 4);
                            a0 = fmaf(a, b0.x, a0); a1 = fmaf(a, b0.y, a1); a2 = fmaf(a, b0.z, a2); a3 = fmaf(a, b0.w, a3); a4 = fmaf(a, b1.x, a4); a5 = fmaf(a, b1.y, a5); a6 = fmaf(a, b1.z, a6); a7 = fmaf(a, b1.w, a7); }
                        bf16_t* o = WSB(WS_WSMALL + (size_t)ll * WSM_STRIDE + WSM_MRG) + (size_t)(db * 32 + d0) * 1536 + g * 128 + c;
                        o[0] = (bf16_t)f2bf(a0); o[1536] = (bf16_t)f2bf(a1); o[2 * 1536] = (bf16_t)f2bf(a2); o[3 * 1536] = (bf16_t)f2bf(a3);
                        o[4 * 1536] = (bf16_t)f2bf(a4); o[5 * 1536] = (bf16_t)f2bf(a5); o[6 * 1536] = (bf16_t)f2bf(a6); o[7 * 1536] = (bf16_t)f2bf(a7);
                    }
                    __syncthreads();
                }
            }
            for (long i = gt; i < 2L * 64 * DM / 8; i += NGT) { const int ll = (int)(i / (64 * DM / 8)); const long r = i % (64 * DM / 8);
                *(uint4*)(WSB(WS_WIN_T) + (size_t)ll * DINP * DM + (size_t)DIN * DM + r * 8) = make_uint4(0u, 0u, 0u, 0u); }
        }
        float* rc = WSF(WS_ROPE); float* rs = rc + T * 16;
        for (long i = gt; i < (long)T * 16; i += NGT) {
            const int t = (int)(i >> 4), j = (int)(i & 15);
            const float freq = powf(10000.0f, -(float)j / 16.0f);
            const float ang = (float)p.pos[t] * freq;
            rc[i] = cosf(ang); rs[i] = sinf(ang);
        }
    }
    if constexpr (ST == ST_WCONV) {
        float* scr = lds + wid * 4096;
        constexpr int I_G = 16 * 16 * 64, I_D = 16 * 32 * 32;
        constexpr int I_ALL = 2 * I_G + I_D;
#define WCONV_ITEM(it, W, ldw, dst, ldt, sc8) do { if ((it) < 2 * I_G) { const int up_ = (it) >= I_G, r_ = up_ ? (it) - I_G : (it), e_ = r_ >> 10, kb_ = (r_ >> 6) & 15, nb_ = r_ & 63, j0_ = nb_ * 32; \
            W = (up_ ? EW_UP(l) : EW_GATE(l)) + (size_t)e_ * DM * DEXP + (size_t)(64 * kb_) * DEXP + j0_; ldw = DEXP; \
            dst = (unsigned char*)(p.ws + WS_WGU_T) + (size_t)(e_ * 4096 + 256 * (j0_ >> 7) + (j0_ & 127) + (up_ ? 128 : 0)) * DM + 64 * kb_; ldt = DM; sc8 = F8_WGU; } \
          else { const int r_ = (it) - 2 * I_G, e_ = r_ >> 10, kb_ = (r_ >> 5) & 31, nb_ = r_ & 31; \
            W = EW_DOWN(l) + (size_t)e_ * DEXP * DM + (size_t)(64 * kb_) * DM + 32 * nb_; ldw = DM; dst = (unsigned char*)(p.ws + WS_WD_T) + (size_t)(e_ * 1024 + 32 * nb_) * DEXP + 64 * kb_; ldt = DEXP; sc8 = F8_WD; } } while (0)
        float va[32], vb[32]; const float* Wa = nullptr; const float* Wb = nullptr; unsigned char* da = nullptr; unsigned char* db = nullptr; int lwa = 0, lwb = 0, lta = 0, ltb = 0; float sa = 1.f, sb = 1.f;
        int itA = gw, itB = gw + NGW;
        if (itA < I_ALL) { WCONV_ITEM(itA, Wa, lwa, da, lta, sa); tb_load(va, Wa, lwa, lane); }
        while (itA < I_ALL) {
            if (itB < I_ALL) { WCONV_ITEM(itB, Wb, lwb, db, ltb, sb); tb_load(vb, Wb, lwb, lane); }
            tb_store8(va, da, lta, sa, scr, lane);
            itA = itB + NGW;
            if (itB >= I_ALL) break;
            if (itA < I_ALL) { WCONV_ITEM(itA, Wa, lwa, da, lta, sa); tb_load(va, Wa, lwa, lane); }
            tb_store8(vb, db, ltb, sb, scr, lane);
            itB = itA + NGW;
        }
#undef WCONV_ITEM
        __syncthreads();
    }
    if constexpr (ST == ST_PROJ) {
        pg8::Gemm g{WSB(WS_HB), WSB(WS_WIN_T) + (size_t)l * DINP * DM, T, DINP, DM, DM};
        pg8::StaticOrder S; S.init(T, DINP, G, bid);
        EpiProj E{WSB(WS_PROJB), B_GATE(l)};
        pg8::gemm_phase<EpiProj, pg8::StaticOrder, true, true>((PG8_LAS unsigned char*)lds, g, S, E);
    }
    if constexpr (ST == ST_PREP) {
        const bf16_t* projb = WSB(WS_PROJB); bf16_t* br = WSB(WS_BR); bf16_t* U = (bf16_t*)lds;
        float* rq = WSF(WS_RQ); float* rkv = rq + T; const float* rc = WSF(WS_ROPE); const float* rs = rc + T * 16; bf16_t* kb = WSB(WS_KB);
        for (int tile = bid; tile < T / 64; tile += G) {
            const int b = tile / (SEQ / 64), s0 = (tile % (SEQ / 64)) * 64, t0 = b * SEQ + s0;
            __syncthreads();
#pragma unroll
            for (int it = 0; it < 10; ++it) { const int e = tid + it * NTHR, r = e >> 6, ch = e & 63, s = s0 - 8 + r;
                uint4 v = make_uint4(0u, 0u, 0u, 0u);
                if (s >= 0 && s < SEQ) v = *(const uint4*)(projb + (size_t)(b * SEQ + s) * DINP + OFF_POOL + ch * 8);
                *(uint4*)(U + r * 512 + ch * 8) = v; }
            for (int r = wid; r < 64; r += 8) { const bf16_t* row = projb + (size_t)(t0 + r) * DINP;
                float s1 = 0.f, s2 = 0.f;
                if (lane < 48) { const uint4 w = *(const uint4*)(row + OFF_CQ + lane * 8); const unsigned ww[4] = {w.x, w.y, w.z, w.w};
#pragma unroll
                    for (int q = 0; q < 4; ++q) { const float a = __uint_as_float(ww[q] << 16), c = __uint_as_float(ww[q] & 0xffff0000u); s1 += a * a + c * c; } }
                if (lane < 32) { const uint4 w = *(const uint4*)(row + OFF_CKV + lane * 8); const unsigned ww[4] = {w.x, w.y, w.z, w.w};
#pragma unroll
                    for (int q = 0; q < 4; ++q) { const float a = __uint_as_float(ww[q] << 16), c = __uint_as_float(ww[q] & 0xffff0000u); s2 += a * a + c * c; } }
                s1 = wave_sum(s1); s2 = wave_sum(s2);
                if (lane == 0) { rq[t0 + r] = 1.f / sqrtf(s1 * (1.f / 384.f) + RMS_EPS); rkv[t0 + r] = 1.f / sqrtf(s2 * (1.f / 256.f) + RMS_EPS); } }
#pragma unroll
            for (int it = 0; it < 2; ++it) { const int e = tid + it * NTHR, r = e >> 4, j = e & 15, t = t0 + r;
                const float c = rc[(size_t)t * 16 + j], s = rs[(size_t)t * 16 + j], x1 = PJ(t, OFF_KR + j), x2 = PJ(t, OFF_KR + 16 + j);
                const bf16_t k1 = (bf16_t)f2bf(x1 * c - x2 * s), k2 = (bf16_t)f2bf(x1 * s + x2 * c);
#pragma unroll
                for (int hh = 0; hh < 8; ++hh) { kb[(size_t)t * 768 + hh * 96 + 64 + j] = k1; kb[(size_t)t * 768 + hh * 96 + 80 + j] = k2; } }
            __syncthreads();
            { const int cp = tid & 255, half = tid >> 8, c0 = 2 * cp, hw = 1 << (c0 >> 7), sb = s0 + 32 * half;
              const unsigned* U32 = (const unsigned*)U;
              bf16_t* orow = br + (size_t)(b * SEQ + sb) * 1536 + c0;
              float sx = 0.f, sy = 0.f;
              if (s0 >= 8 && s0 + 72 <= SEQ) {
                  for (int u = sb - hw; u < sb + hw; ++u) { const unsigned w = U32[(u - s0 + 8) * 256 + cp]; sx += __uint_as_float(w << 16); sy += __uint_as_float(w & 0xffff0000u); }
                  const float inv = 1.f / (float)(2 * hw);
#pragma unroll 8
                  for (int k = 0; k < 32; ++k) { const int r = sb + k - s0 + 8;
                      const unsigned wc = U32[r * 256 + cp], wa = U32[(r + hw) * 256 + cp], wb = U32[(r - hw) * 256 + cp];
                      *(unsigned*)(orow + (size_t)k * 1536) = pk2(sx * inv - __uint_as_float(wc << 16), sy * inv - __uint_as_float(wc & 0xffff0000u));
                      sx += __uint_as_float(wa << 16); sy += __uint_as_float(wa & 0xffff0000u); sx -= __uint_as_float(wb << 16); sy -= __uint_as_float(wb & 0xffff0000u); }
              } else {
                  for (int u = sb - hw; u < sb + hw; ++u) if (u >= 0 && u < SEQ) { const unsigned w = U32[(u - s0 + 8) * 256 + cp]; sx += __uint_as_float(w << 16); sy += __uint_as_float(w & 0xffff0000u); }
                  for (int k = 0; k < 32; ++k) { const int s = sb + k;
                      int lo = s - hw; if (lo < 0) lo = 0; int hi = s + hw; if (hi > SEQ) hi = SEQ;
                      const float inv = 1.f / (float)(hi - lo); const unsigned wc = U32[(s - s0 + 8) * 256 + cp];
                      *(unsigned*)(orow + (size_t)k * 1536) = pk2(sx * inv - __uint_as_float(wc << 16), sy * inv - __uint_as_float(wc & 0xffff0000u));
                      if (s + hw < SEQ) { const unsigned w = U32[(s + hw - s0 + 8) * 256 + cp]; sx += __uint_as_float(w << 16); sy += __uint_as_float(w & 0xffff0000u); }
                      if (s - hw >= 0) { const unsigned w = U32[(s - hw - s0 + 8) * 256 + cp]; sx -= __uint_as_float(w << 16); sy -= __uint_as_float(w & 0xffff0000u); } }
              } }
        }
        __syncthreads();
    }
    if constexpr (ST == ST_SMALLGEMM) {
        const bf16_t* wsm = WSB(WS_WSMALL + (size_t)l * WSM_STRIDE);
        { pg8::Gemm g{WSB(WS_PROJB) + OFF_CQ, wsm + WSM_UQ / 2, T, 768, 384, DINP}; pg8::StaticOrder S; S.init(T, 768, G, bid);
          EpiQ E{WSB(WS_QB), WSF(WS_RQ), WSF(WS_ROPE), WSF(WS_ROPE) + T * 16}; pg8::gemm_phase<EpiQ, pg8::StaticOrder, true, true>((PG8_LAS unsigned char*)lds, g, S, E); }
        { pg8::Gemm g{WSB(WS_PROJB) + OFF_CKV, wsm + WSM_UKV / 2, T, 1024, 256, DINP}; pg8::StaticOrder S; S.init(T, 1024, G, bid);
          EpiKV E{WSB(WS_KB), WSB(WS_VB), WSF(WS_RQ) + T}; pg8::gemm_phase<EpiKV, pg8::StaticOrder, true, true>((PG8_LAS unsigned char*)lds, g, S, E); }
    }
    if constexpr (ST == ST_ATTN) {
        const int vcu = (G % 8 == 0) ? (bid % 8) * (G / 8) + bid / 8 : bid;
        WStream wst; wst.gate = EW_GATE(l); wst.up = EW_UP(l); wst.down = EW_DOWN(l); wst.wgu_t = p.ws + WS_WGU_T; wst.wd_t = p.ws + WS_WD_T;
        { const int wu = __builtin_amdgcn_readfirstlane(wid); wst.init(bid * 8 + wu, NGW, (char*)lds + att::SHM_ATTN + wu * 2560, lane); }
        for (int L = vcu; L < NB * 8 * 32; L += G) {
            const int bh = L >> 5, qb = L & 31, b = bh >> 3, hh = bh & 7;
            att::attn_unit(WSB(WS_QB) + (size_t)(b * SEQ + qb * 256) * 768 + hh * 96, WSB(WS_KB) + (size_t)(b * SEQ) * 768 + hh * 96, WSB(WS_VB) + (size_t)(b * SEQ) * 512 + hh * 64,
                           WSB(WS_BR) + (size_t)(b * SEQ + qb * 256) * 1536 + 512 + hh * 64, SEQ, (char*)lds, wst);
        }
        while (wst.step <= wst.nsteps) wst.tick(lane);
        __syncthreads();
    }
    if constexpr (ST == ST_GLA1) {
        for (int item = bid; item < NB * 4 * 128; item += G) {
            const int b = item >> 9, hh = (item >> 7) & 3, c = item & 127;
            gla::g1_item((char*)lds, WSB(WS_PROJB), W_DEC(l), B_DEC(l), b, hh, c, WSF(WS_KVT), WSF(WS_DEC));
        }
    }
    if constexpr (ST == ST_GLA2) {
        const float* kvt = WSF(WS_KVT); const float* dec = WSF(WS_DEC); bf16_t* stp = WSB(WS_ST);
        for (long e = gt; e < 2L * 8 * 8192; e += NGT) {
            const int dir = (int)(e >> 16), bh = (int)((e >> 13) & 7), vd = (int)(e & 8191), d = vd & 63;
            const long base = ((long)dir * 8 + bh) * 128;
            float s = 0.f;
#pragma unroll 1
            for (int k0 = 0; k0 < 128; k0 += 32) {
                float kv[32], dc[32];
#pragma unroll
                for (int k = 0; k < 32; ++k) { const int c = dir ? 127 - (k0 + k) : k0 + k; kv[k] = kvt[(base + c) * 8192 + vd]; dc[k] = dec[(base + c) * 64 + d]; }
#pragma unroll
                for (int k = 0; k < 32; ++k) { const int c = dir ? 127 - (k0 + k) : k0 + k; stp[(base + c) * 8192 + vd] = (bf16_t)f2bf(s); s = fmaf(dc[k], s, kv[k]); }
            }
        }
    }
    if constexpr (ST == ST_GLA3) {
        for (int item = bid; item < NB * 4 * 128; item += G) {
            const int b = item >> 9, hh = (item >> 7) & 3, c = item & 127;
            gla::g3_item((char*)lds, WSB(WS_PROJB), W_DEC(l), B_DEC(l), GLA_NORM(l), b, hh, c, WSB(WS_ST), WSB(WS_BR) + 1024, 1536);
        }
    }
    if constexpr (ST == ST_MERGE_A) {
        const bf16_t* wsm = WSB(WS_WSMALL + (size_t)l * WSM_STRIDE);
        pg8::Gemm g{WSB(WS_BR), wsm + WSM_MRG / 2, T, DM, 1536, 1536}; pg8::StaticOrder S; S.init(T, DM, G, bid);
        EpiMerge E{WSB(WS_MERGEDB), WSB(WS_PROJB) + OFF_GATE};
        pg8::gemm_phase<EpiMerge, pg8::StaticOrder, true, true>((PG8_LAS unsigned char*)lds, g, S, E);
    }
    if constexpr (ST == ST_OUTP) {
        const bf16_t* wsm = WSB(WS_WSMALL + (size_t)l * WSM_STRIDE);
        pg8::Gemm g{WSB(WS_MERGEDB), wsm + WSM_OUT / 2, T, DM, DM, DM}; pg8::StaticOrder S; S.init(T, DM, G, bid);
        pg8::EpiBf16<0> E{WSB(WS_TMP), DM, nullptr, 0, 0, 1.f};
        pg8::gemm_phase<pg8::EpiBf16<0>, pg8::StaticOrder, true, true>((PG8_LAS unsigned char*)lds, g, S, E);
    }
    if constexpr (ST == ST_LN1) {
        float* RWT = lds; const float* rw = ROUTER(l);
        for (int i = tid; i < DM * 4; i += NTHR) { const int k = i >> 2, e4 = (i & 3) * 4; const float4 w = *(const float4*)(rw + (size_t)k * 16 + e4);
            RWT[(e4 + 0) * DM + k] = w.x; RWT[(e4 + 1) * DM + k] = w.y; RWT[(e4 + 2) * DM + k] = w.z; RWT[(e4 + 3) * DM + k] = w.w; }
        __syncthreads();
        float* afft = WSF(WS_AFF);
        for (int m0 = gw; m0 < T; m0 += 2 * NGW) {
            const int mr[2] = {m0, m0 + NGW};
            float4 hv[2][4];
#pragma unroll
            for (int u = 0; u < 2; ++u) { const bf16_t* hr = WSB(WS_HB) + (size_t)mr[u] * DM; const bf16_t* tr = WSB(WS_TMP) + (size_t)mr[u] * DM;
#pragma unroll
                for (int j = 0; j < 4; ++j) { float a[4], t4[4]; ld4bf(hr + 4 * (lane + 64 * j), a); ld4bf(tr + 4 * (lane + 64 * j), t4);
                    hv[u][j] = make_float4(fmaf(ALPHA, a[0], t4[0]), fmaf(ALPHA, a[1], t4[1]), fmaf(ALPHA, a[2], t4[2]), fmaf(ALPHA, a[3], t4[3])); } }
            ln_core2<1>(hv, LN1_G(l), LN1_B(l), nullptr, nullptr, WSB(WS_HB) + (size_t)mr[0] * DM, WSB(WS_HB) + (size_t)mr[1] * DM, lane,
                     p.ws + WS_HB8 + (size_t)mr[0] * DM, p.ws + WS_HB8 + (size_t)mr[1] * DM);
            float acc[2][16];
#pragma unroll
            for (int e = 0; e < 16; ++e) { float a0 = 0.f, a1 = 0.f;
#pragma unroll
                for (int j = 0; j < 4; ++j) { const float4 w = *(const float4*)(RWT + e * DM + 4 * (lane + 64 * j));
                    a0 = fmaf(hv[0][j].x, w.x, a0); a0 = fmaf(hv[0][j].y, w.y, a0); a0 = fmaf(hv[0][j].z, w.z, a0); a0 = fmaf(hv[0][j].w, w.w, a0);
                    a1 = fmaf(hv[1][j].x, w.x, a1); a1 = fmaf(hv[1][j].y, w.y, a1); a1 = fmaf(hv[1][j].z, w.z, a1); a1 = fmaf(hv[1][j].w, w.w, a1); }
                acc[0][e] = a0; acc[1][e] = a1; if (e & 1) __builtin_amdgcn_sched_barrier(0); }
#pragma unroll
            for (int i = 0; i < 8; ++i)
#pragma unroll
                for (int u = 0; u < 2; ++u) { const bool up = lane & 32; const float keep = up ? acc[u][i + 8] : acc[u][i], send = up ? acc[u][i] : acc[u][i + 8]; acc[u][i] = keep + __shfl_xor(send, 32); }
#pragma unroll
            for (int i = 0; i < 4; ++i)
#pragma unroll
                for (int u = 0; u < 2; ++u) { const bool up = lane & 16; const float keep = up ? acc[u][i + 4] : acc[u][i], send = up ? acc[u][i] : acc[u][i + 4]; acc[u][i] = keep + __shfl_xor(send, 16); }
#pragma unroll
            for (int i = 0; i < 2; ++i)
#pragma unroll
                for (int u = 0; u < 2; ++u) { const bool up = lane & 8; const float keep = up ? acc[u][i + 2] : acc[u][i], send = up ? acc[u][i] : acc[u][i + 2]; acc[u][i] = keep + __shfl_xor(send, 8); }
#pragma unroll
            for (int u = 0; u < 2; ++u) { const bool up = lane & 4; const float keep = up ? acc[u][1] : acc[u][0], send = up ? acc[u][0] : acc[u][1]; acc[u][0] = keep + __shfl_xor(send, 4); }
            float lg[2] = {acc[0][0], acc[1][0]};
#pragma unroll
            for (int o = 1; o <= 2; o <<= 1) { const float t0 = __shfl_xor(lg[0], o), t1 = __shfl_xor(lg[1], o); lg[0] += t0; lg[1] += t1; }
            float mx[2] = {lg[0], lg[1]};
#pragma unroll
            for (int o = 4; o <= 32; o <<= 1) { const float t0 = __shfl_xor(mx[0], o), t1 = __shfl_xor(mx[1], o); mx[0] = fmaxf(mx[0], t0); mx[1] = fmaxf(mx[1], t1); }
            const float ex[2] = {expf(lg[0] - mx[0]), expf(lg[1] - mx[1])}; float se[2] = {ex[0], ex[1]};
#pragma unroll
            for (int o = 4; o <= 32; o <<= 1) { const float t0 = __shfl_xor(se[0], o), t1 = __shfl_xor(se[1], o); se[0] += t0; se[1] += t1; }
            if ((lane & 3) == 0) { const int e = ((lane >> 5) & 1) * 8 + ((lane >> 4) & 1) * 4 + ((lane >> 3) & 1) * 2 + ((lane >> 2) & 1);
#pragma unroll
                for (int u = 0; u < 2; ++u) afft[(size_t)((mr[u] / SEQ) * 16 + e) * SEQ + (mr[u] % SEQ)] = ex[u] / se[u]; }
        }
        __syncthreads();
    }
    if constexpr (ST == ST_TOPK) {
        const float* afft = WSF(WS_AFF); int* idx = WSI(WS_IDX); float* gv = WSF(WS_GATEV); int* slot = WSI(WS_SLOT);
        int* hist = (int*)lds; int* ctl = hist + 256; int* scr = hist + 272;
        for (int z = bid; z < NZ; z += G) {
            const int e = z >> 1, b = z & 1; const float* list = afft + (size_t)(b * 16 + e) * SEQ;
            unsigned key[16];
#pragma unroll
            for (int j = 0; j < 16; j += 4) { const float4 x = *(const float4*)(list + tid * 16 + j); key[j] = __float_as_uint(x.x); key[j + 1] = __float_as_uint(x.y); key[j + 2] = __float_as_uint(x.z); key[j + 3] = __float_as_uint(x.w); }
            unsigned prefix = 0u; int need = CAP;
#pragma unroll 1
            for (int shift = 24; shift >= 0; shift -= 8) {
                __syncthreads();
                if (tid < 256) hist[tid] = 0;
                __syncthreads();
#pragma unroll
                for (int j = 0; j < 16; ++j) { const bool in = (shift == 24) || ((key[j] >> (shift + 8)) == (prefix >> (shift + 8))); if (in) atomicAdd(&hist[(key[j] >> shift) & 255u], 1); }
                __syncthreads();
                if (tid < 256) {
                    const int hc = hist[tid]; int inc = hc;
#pragma unroll
                    for (int o = 1; o < 64; o <<= 1) { const int y = __shfl_down(inc, o); if (lane + o < 64) inc += y; }
                    if (lane == 0) scr[wid] = inc;
                    __builtin_amdgcn_s_waitcnt(0xc07f); __builtin_amdgcn_wave_barrier();
                }
                __syncthreads();
                if (tid < 256) {
                    const int hc = hist[tid]; int inc = hc;
#pragma unroll
                    for (int o = 1; o < 64; o <<= 1) { const int y = __shfl_down(inc, o); if (lane + o < 64) inc += y; }
                    int ca = inc - hc;
#pragma unroll
                    for (int w = 1; w < 4; ++w) ca += (w > wid) ? scr[w] : 0;
                    if (ca < need && need <= ca + hc) { ctl[0] = tid; ctl[1] = need - ca; } }
                __syncthreads();
                prefix |= (unsigned)ctl[0] << shift; need = ctl[1];
            }
            int ceq = 0;
#pragma unroll
            for (int j = 0; j < 16; ++j) ceq += (key[j] == prefix) ? 1 : 0;
            int tot; const int beq = block_excl_scan(ceq, scr, tid, tot);
            int csel = 0, eqr = beq; unsigned selmask = 0u;
#pragma unroll
            for (int j = 0; j < 16; ++j) { bool sel = key[j] > prefix; if (key[j] == prefix) { sel = eqr < need; ++eqr; } if (sel) { selmask |= 1u << j; ++csel; } }
            int sl = block_excl_scan(csel, scr, tid, tot);
#pragma unroll
            for (int j = 0; j < 16; ++j) { const int trow = b * SEQ + tid * 16 + j;
                if ((selmask >> j) & 1u) { idx[z * CAP + sl] = trow; gv[z * CAP + sl] = __uint_as_float(key[j]); slot[(size_t)trow * 16 + e] = sl; ++sl; }
                else slot[(size_t)trow * 16 + e] = -1; }
        }
        __syncthreads();
    }
    if constexpr (ST == ST_GATHER) {
        const int* idx = WSI(WS_IDX); const bf16_t* hb = WSB(WS_HB); bf16_t* xe = WSB(WS_XE);
        const int nr = (NZ * CAP - gw + NGW - 1) / NGW; const int myi = (lane < nr) ? (idx[gw + lane * NGW] & (T - 1)) : 0;
        for (int k = 0; k < nr; k += 4) {
            const int k1 = (k + 1 < nr) ? k + 1 : k, k2 = (k + 2 < nr) ? k + 2 : k, k3 = (k + 3 < nr) ? k + 3 : k;
            const uint4* s0 = (const uint4*)(hb + (size_t)__shfl(myi, k) * DM); const uint4* s1 = (const uint4*)(hb + (size_t)__shfl(myi, k1) * DM);
            const uint4* s2 = (const uint4*)(hb + (size_t)__shfl(myi, k2) * DM); const uint4* s3 = (const uint4*)(hb + (size_t)__shfl(myi, k3) * DM);
            const uint4 x0 = s0[lane], y0 = s0[lane + 64], x1 = s1[lane], y1 = s1[lane + 64], x2 = s2[lane], y2 = s2[lane + 64], x3 = s3[lane], y3 = s3[lane + 64];
            { uint4* d = (uint4*)(xe + (size_t)(gw + k * NGW) * DM); d[lane] = x0; d[lane + 64] = y0; }
            if (k + 1 < nr) { uint4* d = (uint4*)(xe + (size_t)(gw + (k + 1) * NGW) * DM); d[lane] = x1; d[lane + 64] = y1; }
            if (k + 2 < nr) { uint4* d = (uint4*)(xe + (size_t)(gw + (k + 2) * NGW) * DM); d[lane] = x2; d[lane + 64] = y2; }
            if (k + 3 < nr) { uint4* d = (uint4*)(xe + (size_t)(gw + (k + 3) * NGW) * DM); d[lane] = x3; d[lane + 64] = y3; }
        }
    }
    if constexpr (ST == ST_EXP_G) {
        pg8::Gemm g{WSB(WS_HB8), WSB(WS_WGU_T), NZ * CAP, 16 * 4096, DM / 2, DM / 2, WSI(WS_IDX)};
        ExpertOrder1 S; S.init(G, bid);
        EpiSwiGLU E{WSB(WS_HID), DEXP};
        pg8::gemm_phase<EpiSwiGLU, ExpertOrder1, true, true, true, true>((PG8_LAS unsigned char*)lds, g, S, E);
    }
    if constexpr (ST == ST_EXP_D) {
        pg8::Gemm g{WSB(WS_HID), WSB(WS_WD_T), NZ * CAP, 16 * 1024, DEXP / 2, DEXP / 2};
        ExpertOrder2 S; S.init(G, bid);
        EpiRowScale E{WSB(WS_YE), DM, WSF(WS_GATEV)};
        pg8::gemm_phase<EpiRowScale, ExpertOrder2, true, true, false, true>((PG8_LAS unsigned char*)lds, g, S, E);
    }
    if constexpr (ST == ST_LN2) {
        const int* slot = WSI(WS_SLOT); const bf16_t* ye = WSB(WS_YE);
        for (int m0 = gw; m0 < T; m0 += 2 * NGW) {
            const int mr[2] = {m0, m0 + NGW};
            int sl[2]; unsigned long long mask[2]; float4 a[2][4];
#pragma unroll
            for (int u = 0; u < 2; ++u) { sl[u] = (lane < 16) ? slot[(size_t)mr[u] * 16 + lane] : -1; }
#pragma unroll
            for (int u = 0; u < 2; ++u) { const bf16_t* hr = WSB(WS_HB) + (size_t)mr[u] * DM;
#pragma unroll
                for (int j = 0; j < 4; ++j) { float x[4]; ld4bf(hr + 4 * (lane + 64 * j), x); a[u][j] = make_float4(ALPHA * x[0], ALPHA * x[1], ALPHA * x[2], ALPHA * x[3]); } }
            mask[0] = __ballot(sl[0] >= 0); mask[1] = __ballot(sl[1] >= 0);
            while (mask[0] | mask[1]) {
#pragma unroll
                for (int u = 0; u < 2; ++u) if (mask[u]) {
                    const int e = __builtin_ctzll(mask[u]); mask[u] &= mask[u] - 1;
                    const bf16_t* yr = ye + ((size_t)(e * 2 + mr[u] / SEQ) * CAP + __shfl(sl[u], e)) * DM;
#pragma unroll
                    for (int j = 0; j < 4; ++j) { float y[4]; ld4bf(yr + 4 * (lane + 64 * j), y); a[u][j].x += y[0]; a[u][j].y += y[1]; a[u][j].z += y[2]; a[u][j].w += y[3]; }
                }
            }
            if (l == 0) ln_core2<0>(a, LN2_G(l), LN2_B(l), nullptr, nullptr, WSB(WS_HB) + (size_t)mr[0] * DM, WSB(WS_HB) + (size_t)mr[1] * DM, lane);
            else ln_core2<2>(a, LN2_G(l), LN2_B(l), h + (size_t)mr[0] * DM, h + (size_t)mr[1] * DM, nullptr, nullptr, lane);
        }
    }
}


#define LAS __attribute__((address_space(3)))
#define XB_TMO      128
#define XB_XCNT(j)  (256  + 64 * (j))
#define XB_XSUB(j)  (1280 + 64 * (j))
#define XB_XGEN(j)  (2304 + 64 * (j))
#define XB_TOP      3328
#define XB_TOPGEN   3392
#define XCD_BAR_WORDS 3456
#define XB_SPIN_CAP (1u << 18)
__device__ __forceinline__ unsigned xb_ld(unsigned* p)              { return __hip_atomic_load(p, __ATOMIC_RELAXED, __HIP_MEMORY_SCOPE_AGENT); }
__device__ __forceinline__ unsigned xb_add(unsigned* p, unsigned v) { return __hip_atomic_fetch_add(p, v, __ATOMIC_RELAXED, __HIP_MEMORY_SCOPE_AGENT); }
__device__ __forceinline__ unsigned xb_xcc_id() { return (unsigned)__builtin_amdgcn_s_getreg((3 << 11) | 20) & 0xFu; }
#define XB_SPIN(cond, bar) do { unsigned _sp = 0; while (cond) { __builtin_amdgcn_s_sleep(1); \
    if ((++_sp & 255u) == 0u) { if (xb_ld(&(bar)[XB_TMO])) break; if (_sp > XB_SPIN_CAP) { atomicAdd(&(bar)[XB_TMO], 1u); break; } } } } while (0)
struct XcdBarrier { unsigned* bar; unsigned x; volatile LAS unsigned* st; };
__device__ __forceinline__ XcdBarrier xcd_barrier_post(unsigned* bar, volatile LAS unsigned* st) {
    XcdBarrier b; b.bar = bar; b.x = xb_xcc_id(); b.st = st;
    if (threadIdx.x == 0) (void)xb_add(&bar[XB_XCNT(b.x)], 1u);
    return b;
}
__device__ __forceinline__ void xcd_barrier_complete(unsigned* bar, unsigned x, unsigned& nloc, unsigned& nx) {
    const unsigned G = gridDim.x * gridDim.y * gridDim.z;
    unsigned sum, cnt, mine, sp = 0u;
    for (;;) {
        sum = 0u; cnt = 0u; mine = 0u;
#pragma unroll
        for (unsigned j = 0; j < 16; ++j) { const unsigned c = xb_ld(&bar[XB_XCNT(j)]); sum += c; cnt += (c > 0u) ? 1u : 0u; mine = (j == x) ? c : mine; }
        if (sum == G) break;
        __builtin_amdgcn_s_sleep(1);
        if ((++sp & 255u) == 0u) { if (xb_ld(&bar[XB_TMO])) break; if (sp > XB_SPIN_CAP) { atomicAdd(&bar[XB_TMO], 1u); break; } }
    }
    nloc = mine > 0u ? mine : 1u; nx = cnt > 0u ? cnt : 1u;
}
__device__ __forceinline__ void xcd_barrier(const XcdBarrier& b) {
    asm volatile("s_waitcnt vmcnt(0)" ::: "memory");
    __syncthreads();
    if (threadIdx.x == 0) {
        unsigned* bar = b.bar; asm volatile("" : "+s"(bar));
        unsigned bx = b.x; asm volatile("" : "+s"(bx));
        __builtin_amdgcn_s_waitcnt(0);
        unsigned nloc = b.st[0], nx = b.st[1];
        if (nloc == 0u) { xcd_barrier_complete(bar, bx, nloc, nx); b.st[0] = nloc; b.st[1] = nx; }
        const unsigned old = xb_add(&bar[XB_XSUB(bx)], 1u);
        const unsigned gen = old / nloc;
        if (old + 1u == (gen + 1u) * nloc) {
            __builtin_amdgcn_fence(__ATOMIC_RELEASE, "agent");
            asm volatile("s_waitcnt vmcnt(0)" ::: "memory");
            const unsigned og = xb_add(&bar[XB_TOP], 1u);
            const unsigned tg = og / nx;
            if (og + 1u == (tg + 1u) * nx) xb_add(&bar[XB_TOPGEN], 1u);
            else XB_SPIN(xb_ld(&bar[XB_TOPGEN]) == tg, bar);
            __builtin_amdgcn_fence(__ATOMIC_ACQUIRE, "agent");
            xb_add(&bar[XB_XGEN(bx)], 1u);
            asm volatile("s_waitcnt vmcnt(0)" ::: "memory");
        } else {
            XB_SPIN(xb_ld(&bar[XB_XGEN(bx)]) == gen, bar);
            __builtin_amdgcn_fence(__ATOMIC_ACQUIRE, "agent");
            asm volatile("s_waitcnt vmcnt(0)" ::: "memory");
        }
    }
    __syncthreads();
}
constexpr int MISC_OFF = 131072 + 320;
constexpr int CW_BAR = 4096;

__global__ void __launch_bounds__(NTHR) mega_fwd(Params p) {
    extern __shared__ __attribute__((aligned(16))) unsigned char lds_raw[];
    float* lds = (float*)lds_raw;
    volatile LAS unsigned* MISC = (volatile LAS unsigned*)((LAS unsigned char*)lds_raw + MISC_OFF);
    if (threadIdx.x < 32) MISC[threadIdx.x] = 0u;
    __syncthreads();
    unsigned char* ws_ = ((const KAS Params*)__builtin_amdgcn_kernarg_segment_ptr())->ws;
    XcdBarrier bar = xcd_barrier_post((unsigned*)(ws_ + WS_CTL) + CW_BAR, MISC + 8);
#define GB() xcd_barrier(bar)
    run_stage<ST_INIT>(0, lds); GB();
    for (int step = 0; step < 2 * 11; ++step) {
        const int l = step / 11, s = step % 11;
        switch (s) {
        case 0: run_stage<ST_PROJ>(l, lds); break;
        case 1: run_stage<ST_PREP>(l, lds); run_stage<ST_GLA1>(l, lds); break;
        case 2: run_stage<ST_SMALLGEMM>(l, lds); run_stage<ST_GLA2>(l, lds); break;
        case 3: run_stage<ST_ATTN>(l, lds); run_stage<ST_GLA3>(l, lds); break;
        case 4: run_stage<ST_MERGE_A>(l, lds); break;
        case 5: run_stage<ST_OUTP>(l, lds); break;
        case 6: run_stage<ST_LN1>(l, lds); break;
        case 7: run_stage<ST_TOPK>(l, lds); break;
        case 8: run_stage<ST_EXP_G>(l, lds); break;
        case 9: run_stage<ST_EXP_D>(l, lds); break;
        default: run_stage<ST_LN2>(l, lds); break;
        }
        if (step + 1 < 2 * 11) GB();
    }
#undef GB
}

template <int ST>
__global__ void __launch_bounds__(NTHR) k_stage(Params p, int l) {
    extern __shared__ __attribute__((aligned(16))) unsigned char lds_raw[];
    run_stage<ST>(l, (float*)lds_raw);
}

template <int ST> static void launch_stage(const Params& p, int l, int grid, hipStream_t stream) {
    static bool attr = false;
    if (!attr) { (void)hipFuncSetAttribute((const void*)k_stage<ST>, hipFuncAttributeMaxDynamicSharedMemorySize, LDS_BYTES); attr = true; }
    hipLaunchKernelGGL(k_stage<ST>, dim3(grid), dim3(NTHR), LDS_BYTES, stream, p, l);
}

extern "C" void kernel_launch(void* const* d_in, const int* in_sizes, int n_in, void* d_out, int out_size, void* d_ws, size_t ws_size, hipStream_t stream) {
    if (n_in != 27 || out_size != T * DM || ws_size < WS_END) {
        fprintf(stderr, "kernel_launch: unexpected shapes: n_in %d out %d ws %zu (need >= %zu)\n", n_in, out_size, ws_size, (size_t)WS_END);
        return;
    }
    Params p{};
    for (int i = 0; i < 27; ++i) p.in[i] = (const float*)d_in[i];
    p.pos = (const int*)d_in[1]; p.out = (float*)d_out; p.ws = (unsigned char*)d_ws;
    const int grid = 256;
#if MEGA
    static bool attr = false;
    if (!attr) { (void)hipFuncSetAttribute((const void*)mega_fwd, hipFuncAttributeMaxDynamicSharedMemorySize, LDS_BYTES); attr = true; }
    (void)hipMemsetAsync((char*)d_ws + WS_CTL, 0, 65536, stream);
    hipLaunchKernelGGL(mega_fwd, dim3(grid), dim3(NTHR), LDS_BYTES, stream, p);
#else
    launch_stage<ST_INIT>(p, 0, grid, stream);
    for (int l = 0; l < 2; ++l) {
        launch_stage<ST_PROJ>(p, l, grid, stream);
        launch_stage<ST_PREP>(p, l, grid, stream);
        launch_stage<ST_SMALLGEMM>(p, l, grid, stream);
        launch_stage<ST_ROPE>(p, l, grid, stream);
        launch_stage<ST_ATTN>(p, l, grid, stream);
        launch_stage<ST_GLAREC>(p, l, grid, stream);
        launch_stage<ST_GLAFIN>(p, l, grid, stream);
        launch_stage<ST_MERGE_A>(p, l, grid, stream);
        launch_stage<ST_MERGE_B>(p, l, grid, stream);
        launch_stage<ST_MERGE_C>(p, l, grid, stream);
        launch_stage<ST_OUTP>(p, l, grid, stream);
        launch_stage<ST_LN1>(p, l, grid, stream);
        launch_stage<ST_TOPK>(p, l, grid, stream);
        launch_stage<ST_EXP_G>(p, l, grid, stream);
        launch_stage<ST_EXP_U>(p, l, grid, stream);
        launch_stage<ST_EXP_D>(p, l, grid, stream);
        launch_stage<ST_LN2>(p, l, grid, stream);
    }
#endif
}
```

```cpp
#include <hip/hip_runtime.h>
#include <cstdio>
#include <cstdint>

#ifndef MEGA
#define MEGA 1
#endif

constexpr int NB = 2, SEQ = 8192, T = NB * SEQ, DM = 1024, DIN = 5824, DINP = 5888;
constexpr int OFF_GATE = 0, OFF_POOL = 3072, OFF_CQ = 3072 + 512, OFF_CKV = 3072 + 896, OFF_KR = 3072 + 1152, OFF_GQ = 3072 + 1184, OFF_GK = 3072 + 1440, OFF_GV = 3072 + 1696, OFF_GR = 3072 + 2208, OFF_GDEC = 3072 + 2720;
constexpr int NE = 16, CAP = 1024, DEXP = 2048, NZ = NB * NE;
constexpr float ALPHA = 1.4142135623730951f;
constexpr float LN_EPS = 1e-5f, RMS_EPS = 1e-6f;
constexpr int NTHR = 512, LDS_BYTES = 147456;

constexpr size_t MiB = 1u << 20;
constexpr size_t WS_CTL = 0;
constexpr size_t WS_ROPE = 1 * MiB;
constexpr size_t WS_AFF = 3 * MiB;
constexpr size_t WS_SLOT = 4 * MiB;
constexpr size_t WS_IDX = 5 * MiB;
constexpr size_t WS_GATEV = 5 * MiB + 256 * 1024;
constexpr size_t WS_WIN_T = 8 * MiB;
constexpr size_t WS_WSMALL = 31 * MiB;
constexpr size_t WSM_UQ = 0, WSM_UKV = 1 * MiB, WSM_MRG = 2 * MiB, WSM_OUT = 5 * MiB, WSM_STRIDE = 7 * MiB;
constexpr size_t WS_RQ = 6 * MiB;
constexpr size_t WS_HB = 958 * MiB;
constexpr size_t WS_WGU_T = 76 * MiB;
constexpr size_t WS_WD_T = 204 * MiB;
constexpr size_t WS_PROJB = 268 * MiB;
constexpr size_t WS_XE = 268 * MiB;
constexpr size_t WS_HID = 332 * MiB;
constexpr size_t WS_YE = 460 * MiB;
constexpr size_t WS_BR = 452 * MiB;
constexpr size_t WS_HB8 = 500 * MiB;
constexpr size_t WS_QB = 556 * MiB;
constexpr size_t WS_KB = 580 * MiB;
constexpr size_t WS_VB = 604 * MiB;
constexpr size_t WS_KVT = 702 * MiB;
constexpr size_t WS_ST = 766 * MiB;
constexpr size_t WS_DEC = 798 * MiB;
constexpr size_t WS_MERGEDB = 830 * MiB;
constexpr size_t WS_TMP = 894 * MiB;
constexpr size_t WS_END = 990 * MiB;
static_assert(WS_YE + 64 * MiB <= WS_QB, "overlay map");

namespace pg8 {
#define PG8_LAS __attribute__((address_space(3)))
typedef unsigned short bf16_t;
typedef short bf16x8 __attribute__((ext_vector_type(8)));
typedef float f32x4 __attribute__((ext_vector_type(4)));
typedef unsigned u32x4 __attribute__((ext_vector_type(4)));
constexpr int BM = 256, BK = 64, HALF = 128, HTB = HALF * BK * 2  , STAGE_BYTES = 8 * HTB, NXCD = 8, WGM = 8;

__host__ __device__ __forceinline__ int lds_byte(int r, int c) { const int st = (r >> 4) * 2 + (c >> 5), rr = r & 15, cc = c & 31, ob = rr * 64 + cc * 2; return st * 1024 + (ob ^ (((ob >> 9) & 1) << 5)); }
__host__ __device__ __forceinline__ void stage_rc(int b, int& R, int& C) { const int st = b / 1024, sb = b % 1024, swz = sb ^ (((sb >> 9) & 1) << 5); R = (st >> 1) * 16 + swz / 64; C = (st & 1) * 32 + (swz % 64) / 2; }
__host__ __device__ __forceinline__ int perm32(int rho) { const int n = rho >> 4, i = rho & 15; return 8 * (i >> 2) + 4 * n + (i & 3); }

struct Unit { int pm, pn; };
struct Gemm { const bf16_t* A; const bf16_t* Bt; int M, N, K, lda; const int* ridx; };

struct StaticOrder {
    int nM, nN, nwg, G, c;
    __host__ __device__ void init(int M, int N, int G_, int c_) { nM = M / BM; nN = N / BM; nwg = nM * nN; G = G_; c = c_; }
    __host__ __device__ bool next(int i, Unit& u) const {
        const long L = (long)i * G + c; if (L >= nwg) return false;
        int wgid = (int)L; { const int q = nwg / NXCD, r = nwg % NXCD, xcd = wgid % NXCD, off = wgid / NXCD; wgid = (xcd < r ? xcd * (q + 1) : r * (q + 1) + (xcd - r) * q) + off; }
        const int nig = WGM * nN, gid = wgid / nig, fm = gid * WGM, gsz = (nM - fm) < WGM ? (nM - fm) : WGM;
        u.pm = fm + ((wgid % nig) % gsz); u.pn = (wgid % nig) / gsz; return true;
    }
    __device__ __forceinline__ void a_ready(const Unit&) const {}
    __device__ __forceinline__ void done(const Unit&) const {}
};

__device__ __forceinline__ unsigned cvt_pk_bf16(float lo, float hi) { unsigned r; asm volatile("v_cvt_pk_bf16_f32 %0, %1, %2" : "=v"(r) : "v"(lo), "v"(hi)); return r; }
typedef float f32x2 __attribute__((ext_vector_type(2)));
__device__ __forceinline__ f32x2 gelu_pk(f32x2 v) {
    const f32x2 av = __builtin_elementwise_abs(v), d = av * 0.2316418882f + 1.0f;
    f32x2 t; t.x = __builtin_amdgcn_rcpf(d.x); t.y = __builtin_amdgcn_rcpf(d.y);
    f32x2 q = t * 0.5307027145f + (-0.7265760135f); q = q * t + 0.7107068705f; q = q * t + (-0.142248368f); q = q * t + 0.127414796f; q = q * t;
    const f32x2 s = (v * v) * (-0.72134752044f);
    f32x2 e; e.x = __builtin_amdgcn_exp2f(s.x); e.y = __builtin_amdgcn_exp2f(s.y);
    const f32x2 m = v * (q * e), r = v - m;
    f32x2 o; o.x = v.x < 0.f ? m.x : r.x; o.y = v.y < 0.f ? m.y : r.y; return o;
}

template <int ACT  > struct EpiBf16 {
    static constexpr bool PERM = true, AFTER_DRAIN = false; static constexpr int SEG = 0; static_assert(ACT == 0 || ACT == 1, "EpiBf16: ACT is 0 (none) or 1 (gelu_pk)");
    bf16_t* O; int ldc; const float* bias; int split_cols; size_t split_stride; float scale0;
    __device__ __forceinline__ void operator()(const f32x4 (&acc)[2][2][4][2], const Unit& u, int wr, int wc, int fr, int fq) const {
        const int row0 = u.pm * BM + wr * 64 + fr; int colt = u.pn * BM; bf16_t* base = O;
        float sc = 1.f; if (split_cols) { const int t = colt / split_cols; base += (size_t)t * split_stride; colt -= t * split_cols; if (t == 0) sc = scale0; }
        const int col0 = colt + wc * 32 + 8 * fq, bcol0 = u.pn * BM + wc * 32 + 8 * fq;
        f32x4 bv[2][2];
#pragma unroll
        for (int bj = 0; bj < 2; ++bj)
#pragma unroll
            for (int n = 0; n < 2; ++n) bv[bj][n] = bias ? *(const f32x4*)(bias + bcol0 + bj * HALF + 4 * n) : (f32x4){0.f, 0.f, 0.f, 0.f};
#pragma unroll
        for (int ai = 0; ai < 2; ++ai)
#pragma unroll
            for (int m = 0; m < 4; ++m) { bf16_t* rowp = base + (size_t)(row0 + ai * HALF + m * 16) * ldc + col0;
#pragma unroll
                for (int bj = 0; bj < 2; ++bj) { f32x4 v0 = acc[ai][bj][m][0] + bv[bj][0], v1 = acc[ai][bj][m][1] + bv[bj][1];
                    if (ACT == 1) { f32x2 a = gelu_pk((f32x2){v0[0], v0[1]}), b = gelu_pk((f32x2){v0[2], v0[3]}), c = gelu_pk((f32x2){v1[0], v1[1]}), d = gelu_pk((f32x2){v1[2], v1[3]});
                        v0 = (f32x4){a.x, a.y, b.x, b.y}; v1 = (f32x4){c.x, c.y, d.x, d.y}; }
                    v0 = v0 * sc; v1 = v1 * sc; u32x4 w; w.x = cvt_pk_bf16(v0[0], v0[1]); w.y = cvt_pk_bf16(v0[2], v0[3]); w.z = cvt_pk_bf16(v1[0], v1[1]); w.w = cvt_pk_bf16(v1[2], v1[3]);
                    *(u32x4*)(rowp + bj * HALF) = w; } }
    }
};

struct PanelStats {
    unsigned* xbuf;
    unsigned* cnt;
    unsigned* tmo;
    int ntn; float eps;
    unsigned code;
    __device__ __forceinline__ bool run(const f32x4 (&v)[2][2][4][2], const Unit& u, int wr, int wc, int fr, int fq, PG8_LAS unsigned char* lds, int wid, int lane) const {
        typedef float f32x2v __attribute__((ext_vector_type(2)));
        PG8_LAS f32x2v* P = (PG8_LAS f32x2v*)lds;
        PG8_LAS f32x2v* S = (PG8_LAS f32x2v*)(lds + 8192);
        PG8_LAS unsigned* flag = (PG8_LAS unsigned*)(lds + 8192 + 2048);
#pragma unroll
        for (int ai = 0; ai < 2; ++ai)
#pragma unroll
            for (int m = 0; m < 4; ++m) {
                float s = 0.f;
#pragma unroll
                for (int bj = 0; bj < 2; ++bj)
#pragma unroll
                    for (int n = 0; n < 2; ++n) { const f32x4 x = v[ai][bj][m][n]; s += (x[0] + x[1]) + (x[2] + x[3]); }
                s += __shfl_xor(s, 16); s += __shfl_xor(s, 32);
                const float mw = s * (1.0f / 64.0f); float q = 0.f;
#pragma unroll
                for (int bj = 0; bj < 2; ++bj)
#pragma unroll
                    for (int n = 0; n < 2; ++n) { const f32x4 d = v[ai][bj][m][n] - mw; q += (d[0] * d[0] + d[1] * d[1]) + (d[2] * d[2] + d[3] * d[3]); }
                q += __shfl_xor(q, 16); q += __shfl_xor(q, 32);
                if (fq == 0) P[(ai * HALF + wr * 64 + m * 16 + fr) * 4 + wc] = (f32x2v){mw, q};
            }
        asm volatile("s_waitcnt lgkmcnt(0)" ::: "memory"); __builtin_amdgcn_s_barrier(); asm volatile("" ::: "memory");
#if defined(BROKEN_EXCHANGE_NO_WAIT)
#warning BROKEN CONTROL BUILD: the row-statistics exchange does not wait; results are wrong by design
        if (blockIdx.x >= 64) { const long long t0_ = clock64(); while (clock64() - t0_ < 60000) __builtin_amdgcn_s_sleep(8); }
#endif
        const int row = wid * 32 + (lane & 31);
        if (lane < 32) {
            const f32x2v a = P[row * 4 + 0], b = P[row * 4 + 1], c = P[row * 4 + 2], d = P[row * 4 + 3];
            const float mt = (a.x + b.x + c.x + d.x) * 0.25f;
            const float da = a.x - mt, db = b.x - mt, dc = c.x - mt, dd = d.x - mt;
            const float m2 = (a.y + b.y) + (c.y + d.y) + 64.0f * ((da * da + db * db) + (dc * dc + dd * dd));
            unsigned long long* slot = (unsigned long long*)xbuf + ((size_t)(u.pm * BM + row) * 4 + u.pn);
            __hip_atomic_store(slot, ((unsigned long long)__float_as_uint(m2) << 32) | __float_as_uint(mt), __ATOMIC_RELAXED, __HIP_MEMORY_SCOPE_AGENT);
        }
        asm volatile("s_waitcnt vmcnt(0)" ::: "memory");
        if (lane == 0) __hip_atomic_fetch_add(cnt + 64 * u.pm, 1u, __ATOMIC_RELAXED, __HIP_MEMORY_SCOPE_AGENT);
        if (wid == 0) {
            bool dead = false; const unsigned long long t0 = __builtin_amdgcn_s_memrealtime(); const unsigned want = 8u * (unsigned)ntn;
            for (;;) {
#if defined(BROKEN_EXCHANGE_NO_WAIT)
                break;
#endif
                if ((unsigned)__builtin_amdgcn_readfirstlane(__hip_atomic_load(cnt + 64 * u.pm, __ATOMIC_RELAXED, __HIP_MEMORY_SCOPE_AGENT)) >= want) break;
                if (__builtin_amdgcn_s_memrealtime() - t0 > 2000000ull) {
                    if (lane == 0) { unsigned expect = 0u; __hip_atomic_compare_exchange_strong(tmo + 1, &expect, code | (unsigned)(u.pm & 0xff), __ATOMIC_RELAXED, __ATOMIC_RELAXED, __HIP_MEMORY_SCOPE_AGENT);
                                     __hip_atomic_store(tmo, 1u, __ATOMIC_RELAXED, __HIP_MEMORY_SCOPE_AGENT); }
                    dead = true; break; }
                __builtin_amdgcn_s_sleep(2);
            }
            __builtin_amdgcn_fence(__ATOMIC_ACQUIRE, "agent");
            if (lane == 0) flag[0] = dead ? 1u : 0u;
        }
        asm volatile("s_waitcnt vmcnt(0) lgkmcnt(0)" ::: "memory"); __builtin_amdgcn_s_barrier(); asm volatile("" ::: "memory");
        const bool bad = flag[0] != 0u;
        if (lane < 32) {
            const unsigned long long* slot = (const unsigned long long*)xbuf + (size_t)(u.pm * BM + row) * 4; float mt[4], m2[4]; float ms = 0.f;
#pragma unroll
            for (int t = 0; t < 4; ++t) { if (t < ntn) { const unsigned long long w = __hip_atomic_load(slot + t, __ATOMIC_RELAXED, __HIP_MEMORY_SCOPE_AGENT); mt[t] = __uint_as_float((unsigned)w); m2[t] = __uint_as_float((unsigned)(w >> 32)); } else { mt[t] = 0.f; m2[t] = 0.f; } ms += mt[t]; }
            const float mean = ms / (float)ntn; float q = 0.f;
#pragma unroll
            for (int t = 0; t < 4; ++t) if (t < ntn) { const float dm = mt[t] - mean; q += m2[t] + 256.0f * dm * dm; }
            S[row] = (f32x2v){mean, 1.0f / sqrtf(q / (256.0f * (float)ntn) + eps)};
        }
        asm volatile("s_waitcnt lgkmcnt(0)" ::: "memory"); __builtin_amdgcn_s_barrier(); asm volatile("" ::: "memory");
        return bad;
    }
};
struct EpiLnRes {
    static constexpr bool PERM = false, AFTER_DRAIN = true; static constexpr int SEG = 0;
    const float* base; float* out; int ldc; const float* bias; PanelStats st; unsigned poison;
    __device__ __forceinline__ void fused(f32x4 (&acc)[2][2][4][2], const Unit& u, int wr, int wc, int fr, int fq, PG8_LAS unsigned char* lds, int wid, int lane) const {
        typedef float f32x2v __attribute__((ext_vector_type(2)));
        const PG8_LAS f32x2v* S = (const PG8_LAS f32x2v*)(lds + 8192);
        const int col0 = u.pn * BM + wc * 32 + 4 * fq;
#pragma unroll
        for (int bj = 0; bj < 2; ++bj)
#pragma unroll
            for (int n = 0; n < 2; ++n) { const f32x4 bv = bias ? *(const f32x4*)(bias + col0 + bj * HALF + n * 16) : (f32x4){0.f, 0.f, 0.f, 0.f};
#pragma unroll
                for (int ai = 0; ai < 2; ++ai)
#pragma unroll
                    for (int m = 0; m < 4; ++m) acc[ai][bj][m][n] += bv; }
        f32x4 pre[4][2][2];
#pragma unroll
        for (int m = 0; m < 4; ++m) { const size_t off = (size_t)(u.pm * BM + wr * 64 + m * 16 + fr) * ldc + col0;
#pragma unroll
            for (int bj = 0; bj < 2; ++bj)
#pragma unroll
                for (int n = 0; n < 2; ++n) pre[m][bj][n] = *(const f32x4*)(base + off + bj * HALF + n * 16); }
        const bool bad = st.run(acc, u, wr, wc, fr, fq, lds, wid, lane) || poison != 0u;
        const float qnan = __builtin_nanf("");
#pragma unroll
        for (int ai = 0; ai < 2; ++ai)
#pragma unroll
            for (int m = 0; m < 4; ++m) { const int r = ai * HALF + wr * 64 + m * 16 + fr; const f32x2v sr = S[r]; const size_t off = (size_t)(u.pm * BM + r) * ldc + col0;
#pragma unroll
                for (int bj = 0; bj < 2; ++bj)
#pragma unroll
                    for (int n = 0; n < 2; ++n) { const f32x4 bs = ai == 0 ? pre[m][bj][n] : *(const f32x4*)(base + off + bj * HALF + n * 16); f32x4 o = bs + (acc[ai][bj][m][n] - sr.x) * sr.y;
                        if (bad) o = (f32x4){qnan, qnan, qnan, qnan}; *(f32x4*)(out + off + bj * HALF + n * 16) = o; }
                if (m & 1) asm volatile("" ::: "memory"); }
    }
};
struct EpiLnResLn {
    static constexpr bool PERM = false, AFTER_DRAIN = true; static constexpr int SEG = 0;
    const float* base; float* out; bf16_t* xn; int ldc; const float* bias; PanelStats st1, st2; unsigned poison;
    __device__ __forceinline__ void fused(f32x4 (&acc)[2][2][4][2], const Unit& u, int wr, int wc, int fr, int fq, PG8_LAS unsigned char* lds, int wid, int lane) const {
        typedef float f32x2v __attribute__((ext_vector_type(2))); typedef unsigned u32x2v __attribute__((ext_vector_type(2)));
        const PG8_LAS f32x2v* S = (const PG8_LAS f32x2v*)(lds + 8192);
        const int col0 = u.pn * BM + wc * 32 + 4 * fq;
#pragma unroll
        for (int bj = 0; bj < 2; ++bj)
#pragma unroll
            for (int n = 0; n < 2; ++n) { const f32x4 bv = bias ? *(const f32x4*)(bias + col0 + bj * HALF + n * 16) : (f32x4){0.f, 0.f, 0.f, 0.f};
#pragma unroll
                for (int ai = 0; ai < 2; ++ai)
#pragma unroll
                    for (int m = 0; m < 4; ++m) acc[ai][bj][m][n] += bv; }
        bool bad = st1.run(acc, u, wr, wc, fr, fq, lds, wid, lane) || poison != 0u;
        const float qnan = __builtin_nanf("");
#pragma unroll
        for (int ai = 0; ai < 2; ++ai)
#pragma unroll
            for (int m = 0; m < 4; ++m) { const int r = ai * HALF + wr * 64 + m * 16 + fr; const f32x2v sr = S[r]; const size_t off = (size_t)(u.pm * BM + r) * ldc + col0;
#pragma unroll
                for (int bj = 0; bj < 2; ++bj)
#pragma unroll
                    for (int n = 0; n < 2; ++n) { const f32x4 bs = *(const f32x4*)(base + off + bj * HALF + n * 16); acc[ai][bj][m][n] = bs + (acc[ai][bj][m][n] - sr.x) * sr.y; }
                asm volatile("" : "+v"(acc[ai][0][m][0]), "+v"(acc[ai][0][m][1]), "+v"(acc[ai][1][m][0]), "+v"(acc[ai][1][m][1]));
                if (m & 1) asm volatile("" ::: "memory"); }
        const bool bad1 = bad;
        bad = st2.run(acc, u, wr, wc, fr, fq, lds, wid, lane) || bad;
#pragma unroll
        for (int ai = 0; ai < 2; ++ai)
#pragma unroll
            for (int m = 0; m < 4; ++m) { const int r = ai * HALF + wr * 64 + m * 16 + fr; const f32x2v sr = S[r]; const size_t off = (size_t)(u.pm * BM + r) * ldc + col0;
#pragma unroll
                for (int bj = 0; bj < 2; ++bj)
#pragma unroll
                    for (int n = 0; n < 2; ++n) { const f32x4 x1 = acc[ai][bj][m][n]; *(f32x4*)(out + off + bj * HALF + n * 16) = bad1 ? (f32x4){qnan, qnan, qnan, qnan} : x1;
                        const f32x4 o = (x1 - sr.x) * sr.y; u32x2v w; w.x = cvt_pk_bf16(o[0], o[1]); w.y = cvt_pk_bf16(o[2], o[3]);
                        if (bad) { w.x = 0x7fc07fc0u; w.y = 0x7fc07fc0u; } *(u32x2v*)(xn + off + bj * HALF + n * 16) = w; }
                asm volatile("" ::: "memory"); }
    }
};

template <class Epi, class Sched, bool ALIGN_EPI = false, bool SP2 = false, bool GATHER = false, bool FP8 = false>
__device__ __forceinline__ void gemm_phase(PG8_LAS unsigned char* lds, const Gemm g, const Sched& S, const Epi& E) {
    int tid_ = threadIdx.x; asm volatile("" : "+v"(tid_));
    const int tid = tid_, wid = __builtin_amdgcn_readfirstlane(tid >> 6), lane = tid & 63, wr = wid >> 2, wc = wid & 3, fr = lane & 15, fq = lane >> 4;
    int K_ = g.K; asm volatile("" : "+s"(K_));
    const int K = K_, nt = K / BK;
    unsigned voffA[2], voffB[2];
#pragma unroll
    for (int i = 0; i < 2; ++i) { int R, C; stage_rc(tid * 16 + i * 8192, R, C); const int Rb = Epi::PERM ? ((R & ~31) + perm32(R & 31)) : R;
        voffA[i] = (unsigned)(R * g.lda + C) * 2u; voffB[i] = (unsigned)(Rb * K + C) * 2u; }
    const size_t kstep = (size_t)(BK * 2);
    static_assert(!GATHER || SP2, "GATHER is implemented for the SP2 loop");
    const size_t hstepB = (size_t)HALF * K * 2, hstepA = GATHER ? 0 : (size_t)HALF * g.lda * 2;
    const size_t tstepB = 2 * hstepB, tstepA = GATHER ? 0 : 2 * hstepA;
    const unsigned ldsw = (unsigned)wid * 1024u;
    const int aoffk[2] = {lds_byte(wr * 64 + fr, FP8 ? 16 * fq : 8 * fq), lds_byte(wr * 64 + fr, FP8 ? 16 * fq + 8 : 8 * fq + 32)};
    const int boffk[2] = {lds_byte(wc * 32 + fr, FP8 ? 16 * fq : 8 * fq), lds_byte(wc * 32 + fr, FP8 ? 16 * fq + 8 : 8 * fq + 32)};
#define PG8_SA(b, h) (((b) * 2 + (h)) * HTB)
#define PG8_SB(b, h) ((4 + (b) * 2 + (h)) * HTB)
#define PG8_STAGE(bufoff, gbase, voff) do { _Pragma("unroll") for (int _i = 0; _i < 2; ++_i) \
        __builtin_amdgcn_global_load_lds((const unsigned*)((const char*)(gbase) + (voff)[_i]), (PG8_LAS unsigned*)(lds + (bufoff) + ldsw + _i * 8192), 16, 0, 0); } while (0)
    typedef int i32x4_ __attribute__((ext_vector_type(4))); typedef int i32x8_ __attribute__((ext_vector_type(8)));
#define PG8_LD16(off) (*(const PG8_LAS i32x4_*)(lds + (off)))
#define PG8_LDA(dst, b, h) do { _Pragma("unroll") for (int m = 0; m < 4; ++m) { \
        if constexpr (FP8) dst##8[m] = *(const PG8_LAS i32x8_*)(lds + PG8_SA(b, h) + aoffk[0] + m * 2048);     \
        else { _Pragma("unroll") for (int k = 0; k < 2; ++k) dst[m][k] = *(const PG8_LAS bf16x8*)(lds + PG8_SA(b, h) + aoffk[k] + m * 2048); } } } while (0)
#define PG8_LDB(dst, b, h) do { _Pragma("unroll") for (int n = 0; n < 2; ++n) { \
        if constexpr (FP8) dst##8[n] = *(const PG8_LAS i32x8_*)(lds + PG8_SB(b, h) + boffk[0] + n * 2048); \
        else { _Pragma("unroll") for (int k = 0; k < 2; ++k) dst[n][k] = *(const PG8_LAS bf16x8*)(lds + PG8_SB(b, h) + boffk[k] + n * 2048); } } } while (0)
#define PG8_MMA(ai, bj, At, Bt) do { __builtin_amdgcn_s_setprio(1); _Pragma("unroll") for (int m = 0; m < 4; ++m) _Pragma("unroll") for (int n = 0; n < 2; ++n) { \
        if constexpr (FP8) asm volatile("s_nop 1\n\tv_mfma_scale_f32_16x16x128_f8f6f4 %0, %1, %2, %0, %3, %3 op_sel_hi:[0,0,0]" : "+v"(acc[ai][bj][m][n]) : "v"(Bt##8[n]), "v"(At##8[m]), "v"(sc1_));     \
        else { _Pragma("unroll") for (int k = 0; k < 2; ++k) acc[ai][bj][m][n] = __builtin_amdgcn_mfma_f32_16x16x32_bf16(Bt[n][k], At[m][k], acc[ai][bj][m][n], 0, 0, 0); } } \
        __builtin_amdgcn_s_setprio(0); } while (0)
#define PG8_WAIT_V(n) asm volatile("s_waitcnt vmcnt(" #n ")" ::: "memory")
#define PG8_WAIT_L(n) asm volatile("s_waitcnt lgkmcnt(" #n ")" ::: "memory")
#define PG8_BAR __builtin_amdgcn_s_barrier()
#define PG8_SCHED __builtin_amdgcn_sched_barrier(0)
    Unit cur, nxt; int ui = 0;
    if (!S.next(0, cur)) return;
    unsigned vC0[2] = {voffA[0], voffA[1]}, vC1[2] = {voffA[0], voffA[1]}, vN0[2] = {voffA[0], voffA[1]}, vN1[2] = {voffA[0], voffA[1]};
    int gR[2], gC[2];
#pragma unroll
    for (int i = 0; i < 2; ++i) { stage_rc(tid * 16 + i * 8192, gR[i], gC[i]); }
    if constexpr (GATHER) {
#pragma unroll
        for (int i = 0; i < 2; ++i) { vC0[i] = (unsigned)(g.ridx[cur.pm * 256 + gR[i]] * g.lda + gC[i]) * 2u; vC1[i] = (unsigned)(g.ridx[cur.pm * 256 + 128 + gR[i]] * g.lda + gC[i]) * 2u; }
    }
    f32x4 acc[2][2][4][2];
#pragma unroll
    for (int a = 0; a < 2; ++a)
#pragma unroll
        for (int b = 0; b < 2; ++b)
#pragma unroll
            for (int m = 0; m < 4; ++m)
#pragma unroll
                for (int n = 0; n < 2; ++n) acc[a][b][m][n] = (f32x4){0.f, 0.f, 0.f, 0.f};
    const int sc1_ = 0x7f7f7f7f;
    bf16x8 At[4][2], B0[2][2], B1[2][2]; i32x8_ At8[4], B08[2], B18[2];
    const char* cA = (const char*)g.A + (size_t)cur.pm * tstepA; const char* cB = (const char*)g.Bt + (size_t)cur.pn * tstepB;
    S.a_ready(cur);
    if constexpr (SP2) {
        PG8_STAGE(PG8_SB(0, 0), cB, voffB); PG8_STAGE(PG8_SB(0, 1), cB + hstepB, voffB); PG8_STAGE(PG8_SA(0, 0), cA, vC0); PG8_STAGE(PG8_SA(0, 1), cA + hstepA, vC1);
        if (wr == 1) PG8_BAR;
        PG8_WAIT_V(2); PG8_BAR;
        PG8_STAGE(PG8_SB(1, 0), cB + kstep, voffB); PG8_STAGE(PG8_SA(1, 0), cA + kstep, vC0); PG8_STAGE(PG8_SB(1, 1), cB + hstepB + kstep, voffB);
        PG8_WAIT_V(6); PG8_BAR;
    } else {
        PG8_STAGE(PG8_SB(0, 0), cB, voffB); PG8_STAGE(PG8_SA(0, 0), cA, voffA); PG8_STAGE(PG8_SB(0, 1), cB + hstepB, voffB); PG8_STAGE(PG8_SA(0, 1), cA + hstepA, voffA);
        if (wr == 1) PG8_BAR;
        PG8_WAIT_V(4); PG8_BAR;
        PG8_STAGE(PG8_SB(1, 0), cB + kstep, voffB); PG8_STAGE(PG8_SA(1, 0), cA + kstep, voffA); PG8_STAGE(PG8_SB(1, 1), cB + hstepB + kstep, voffB);
        PG8_WAIT_V(6); PG8_BAR;
    }
    for (;;) {
        const bool has_next = S.next(ui + 1, nxt);
        int gi0[2] = {0, 0}, gi1[2] = {0, 0};
        if constexpr (GATHER) { if (has_next) {
#pragma unroll
            for (int i = 0; i < 2; ++i) { gi0[i] = g.ridx[nxt.pm * 256 + gR[i]]; gi1[i] = g.ridx[nxt.pm * 256 + 128 + gR[i]]; } } }
        const char* nA = has_next ? (const char*)g.A + (size_t)nxt.pm * tstepA : cA; const char* nB = has_next ? (const char*)g.Bt + (size_t)nxt.pn * tstepB : cB;
        for (int t = 0; t < nt; t += 2) {
            const bool last = (t == nt - 2);
            const char* a1 = cA + (size_t)(t + 1) * kstep;
            const char* a2 = last ? nA : cA + (size_t)(t + 2) * kstep; const char* b2 = last ? nB : cB + (size_t)(t + 2) * kstep;
            const char* a3 = a2 + kstep; const char* b3 = b2 + kstep;
            if (last && has_next) S.a_ready(nxt);
            unsigned v20[2] = {vC0[0], vC0[1]}, v21[2] = {vC1[0], vC1[1]};
            if constexpr (GATHER) { if (last && has_next) {
#pragma unroll
                for (int i = 0; i < 2; ++i) { vN0[i] = (unsigned)(gi0[i] * g.lda + gC[i]) * 2u; vN1[i] = (unsigned)(gi1[i] * g.lda + gC[i]) * 2u; v20[i] = vN0[i]; v21[i] = vN1[i]; } } }
            if constexpr (SP2) {
            PG8_LDB(B0, 0, 0); PG8_LDB(B1, 0, 1); PG8_SCHED; PG8_LDA(At, 0, 0); PG8_STAGE(PG8_SA(1, 1), a1 + hstepA, vC1);
            PG8_WAIT_V(8); PG8_WAIT_L(0); PG8_BAR; PG8_MMA(0, 0, At, B0); PG8_MMA(0, 1, At, B1); PG8_BAR; PG8_SCHED;
            PG8_LDA(At, 0, 1); PG8_STAGE(PG8_SB(0, 0), b2, voffB); PG8_STAGE(PG8_SB(0, 1), b2 + hstepB, voffB); PG8_STAGE(PG8_SA(0, 0), a2, v20);
            PG8_WAIT_V(8); PG8_WAIT_L(0); PG8_BAR; PG8_MMA(1, 0, At, B0); PG8_MMA(1, 1, At, B1); PG8_BAR; PG8_SCHED;
            PG8_LDB(B0, 1, 0); PG8_LDB(B1, 1, 1); PG8_SCHED; PG8_LDA(At, 1, 0); PG8_STAGE(PG8_SA(0, 1), a2 + hstepA, v21);
            PG8_WAIT_V(8); PG8_WAIT_L(0); PG8_BAR; PG8_MMA(0, 0, At, B0); PG8_MMA(0, 1, At, B1); PG8_BAR; PG8_SCHED;
            PG8_LDA(At, 1, 1); PG8_STAGE(PG8_SB(1, 0), b3, voffB); PG8_STAGE(PG8_SB(1, 1), b3 + hstepB, voffB); PG8_STAGE(PG8_SA(1, 0), a3, v20);
            PG8_WAIT_V(8); PG8_WAIT_L(0); PG8_BAR; PG8_MMA(1, 0, At, B0); PG8_MMA(1, 1, At, B1); PG8_BAR; PG8_SCHED;
            if constexpr (Epi::SEG > 0) { if ((t + 2) % Epi::SEG == 0 && t + 2 < nt) E.segment(acc, cur, (t + 2) / Epi::SEG, wr, wc, fr, fq); }
            } else {
            PG8_LDB(B0, 0, 0); PG8_SCHED; PG8_LDA(At, 0, 0); PG8_STAGE(PG8_SA(1, 1), a1 + hstepA, voffA);
            PG8_WAIT_L(8); PG8_BAR; PG8_WAIT_L(0); PG8_MMA(0, 0, At, B0); PG8_BAR; PG8_SCHED;
            PG8_LDB(B1, 0, 1); PG8_STAGE(PG8_SB(0, 0), b2, voffB);
            PG8_BAR; PG8_WAIT_L(0); PG8_MMA(0, 1, At, B1); PG8_BAR;
            PG8_LDA(At, 0, 1); PG8_STAGE(PG8_SA(0, 0), a2, voffA);
            PG8_BAR; PG8_WAIT_L(0); PG8_MMA(1, 0, At, B0); PG8_BAR; PG8_SCHED;
            PG8_STAGE(PG8_SB(0, 1), b2 + hstepB, voffB);
            PG8_WAIT_V(6); PG8_BAR; PG8_MMA(1, 1, At, B1); PG8_BAR;
            PG8_LDB(B0, 1, 0); PG8_SCHED; PG8_LDA(At, 1, 0); PG8_STAGE(PG8_SA(0, 1), a2 + hstepA, voffA);
            PG8_WAIT_L(8); PG8_BAR; PG8_WAIT_L(0); PG8_MMA(0, 0, At, B0); PG8_BAR; PG8_SCHED;
            PG8_LDB(B1, 1, 1); PG8_STAGE(PG8_SB(1, 0), b3, voffB);
            PG8_BAR; PG8_WAIT_L(0); PG8_MMA(0, 1, At, B1); PG8_BAR;
            PG8_LDA(At, 1, 1); PG8_STAGE(PG8_SA(1, 0), a3, voffA);
            PG8_BAR; PG8_WAIT_L(0); PG8_MMA(1, 0, At, B0); PG8_BAR; PG8_SCHED;
            PG8_STAGE(PG8_SB(1, 1), b3 + hstepB, voffB);
            PG8_WAIT_V(6); PG8_BAR; PG8_MMA(1, 1, At, B1); PG8_BAR;
            }
        }
        if constexpr (FP8) asm volatile("s_nop 15\n\ts_nop 3" ::: "memory");
        if constexpr (ALIGN_EPI) { if (wr == 0) PG8_BAR; }
        if constexpr (!Epi::AFTER_DRAIN) { E(acc, cur, wr, wc, fr, fq); S.done(cur); }
        if (!has_next) break;
#pragma unroll
        for (int a = 0; a < 2; ++a)
#pragma unroll
            for (int b = 0; b < 2; ++b)
#pragma unroll
                for (int m = 0; m < 4; ++m)
#pragma unroll
                    for (int n = 0; n < 2; ++n) acc[a][b][m][n] = (f32x4){0.f, 0.f, 0.f, 0.f};
        cur = nxt; cA = nA; cB = nB; ++ui;
        if constexpr (GATHER) { vC0[0] = vN0[0]; vC0[1] = vN0[1]; vC1[0] = vN1[0]; vC1[1] = vN1[1]; }
        if constexpr (ALIGN_EPI) { if (wr == 1) PG8_BAR; }
    }
    PG8_WAIT_V(0);
    if constexpr (!ALIGN_EPI) { if (wr == 0) PG8_BAR; }
    PG8_BAR;
    if constexpr (Epi::AFTER_DRAIN) { E.fused(acc, cur, wr, wc, fr, fq, lds, wid, lane); S.done(cur); }
#undef PG8_SA
#undef PG8_SB
#undef PG8_STAGE
#undef PG8_LDA
#undef PG8_LD16
#undef PG8_LDB
#undef PG8_MMA
#undef PG8_WAIT_V
#undef PG8_WAIT_L
#undef PG8_BAR
#undef PG8_SCHED
}
}

typedef unsigned short bf16_t;
__device__ __forceinline__ unsigned pk4_fp8(float a, float b, float c, float d) { unsigned w = 0u; w = __builtin_amdgcn_cvt_pk_fp8_f32(a, b, w, false); w = __builtin_amdgcn_cvt_pk_fp8_f32(c, d, w, true); return w; }
constexpr float F8_WGU = 64.f, F8_WD = 128.f, F8_HID = 4.f;
typedef unsigned u32x4_t __attribute__((ext_vector_type(4)));
__device__ __forceinline__ void ldg8_dw(float (&o)[8], const void* base, const unsigned (&off)[8]) {
    asm volatile("global_load_dword %0, %9, %8\n\tglobal_load_dword %1, %10, %8\n\tglobal_load_dword %2, %11, %8\n\tglobal_load_dword %3, %12, %8\n\t"
                 "global_load_dword %4, %13, %8\n\tglobal_load_dword %5, %14, %8\n\tglobal_load_dword %6, %15, %8\n\tglobal_load_dword %7, %16, %8\n\ts_waitcnt vmcnt(0)"
                 : "=&v"(o[0]), "=&v"(o[1]), "=&v"(o[2]), "=&v"(o[3]), "=&v"(o[4]), "=&v"(o[5]), "=&v"(o[6]), "=&v"(o[7])
                 : "s"(base), "v"(off[0]), "v"(off[1]), "v"(off[2]), "v"(off[3]), "v"(off[4]), "v"(off[5]), "v"(off[6]), "v"(off[7]) : "memory");
}
template <int I1, int I2, int I3>
__device__ __forceinline__ void ldg8_x4(u32x4_t (&a)[4], u32x4_t (&b)[4], const void* base, unsigned offA, unsigned offB) {
    asm volatile("global_load_dwordx4 %0, %9, %8\n\tglobal_load_dwordx4 %1, %9, %8 offset:%11\n\tglobal_load_dwordx4 %2, %9, %8 offset:%12\n\tglobal_load_dwordx4 %3, %9, %8 offset:%13\n\t"
                 "global_load_dwordx4 %4, %10, %8\n\tglobal_load_dwordx4 %5, %10, %8 offset:%11\n\tglobal_load_dwordx4 %6, %10, %8 offset:%12\n\tglobal_load_dwordx4 %7, %10, %8 offset:%13\n\ts_waitcnt vmcnt(0)"
                 : "=&v"(a[0]), "=&v"(a[1]), "=&v"(a[2]), "=&v"(a[3]), "=&v"(b[0]), "=&v"(b[1]), "=&v"(b[2]), "=&v"(b[3])
                 : "s"(base), "v"(offA), "v"(offB), "i"(I1), "i"(I2), "i"(I3) : "memory");
}
__device__ __forceinline__ void ldg8_x4v(u32x4_t (&o)[8], const void* base, const unsigned (&off)[8]) {
    asm volatile("global_load_dwordx4 %0, %9, %8\n\tglobal_load_dwordx4 %1, %10, %8\n\tglobal_load_dwordx4 %2, %11, %8\n\tglobal_load_dwordx4 %3, %12, %8\n\t"
                 "global_load_dwordx4 %4, %13, %8\n\tglobal_load_dwordx4 %5, %14, %8\n\tglobal_load_dwordx4 %6, %15, %8\n\tglobal_load_dwordx4 %7, %16, %8\n\ts_waitcnt vmcnt(0)"
                 : "=&v"(o[0]), "=&v"(o[1]), "=&v"(o[2]), "=&v"(o[3]), "=&v"(o[4]), "=&v"(o[5]), "=&v"(o[6]), "=&v"(o[7])
                 : "s"(base), "v"(off[0]), "v"(off[1]), "v"(off[2]), "v"(off[3]), "v"(off[4]), "v"(off[5]), "v"(off[6]), "v"(off[7]) : "memory");
}
template <int I1, int I2, int I3>
__device__ __forceinline__ void ldg4_x4(u32x4_t (&a)[4], const void* base, unsigned off) {
    asm volatile("global_load_dwordx4 %0, %5, %4\n\tglobal_load_dwordx4 %1, %5, %4 offset:%6\n\tglobal_load_dwordx4 %2, %5, %4 offset:%7\n\tglobal_load_dwordx4 %3, %5, %4 offset:%8\n\ts_waitcnt vmcnt(0)"
                 : "=&v"(a[0]), "=&v"(a[1]), "=&v"(a[2]), "=&v"(a[3]) : "s"(base), "v"(off), "i"(I1), "i"(I2), "i"(I3) : "memory");
}
__device__ __forceinline__ void bf8_to_f32(const u32x4_t w, float* o) {
    o[0] = __uint_as_float(w.x << 16); o[1] = __uint_as_float(w.x & 0xffff0000u); o[2] = __uint_as_float(w.y << 16); o[3] = __uint_as_float(w.y & 0xffff0000u);
    o[4] = __uint_as_float(w.z << 16); o[5] = __uint_as_float(w.z & 0xffff0000u); o[6] = __uint_as_float(w.w << 16); o[7] = __uint_as_float(w.w & 0xffff0000u);
}
struct ExpertOrder1 {
    int G, v;
    __device__ void init(int G_, int c) { G = G_; v = (G_ % 8 == 0) ? (c % 8) * (G_ / 8) + c / 8 : c; }
    __device__ bool next(int i, pg8::Unit& u) const { const int L = i * G + v; if (L >= 2048) return false; const int e = L >> 7, r = L & 127; u.pm = e * 8 + (r & 7); u.pn = e * 16 + (r >> 3); return true; }
    __device__ __forceinline__ void a_ready(const pg8::Unit&) const {}
    __device__ __forceinline__ void done(const pg8::Unit&) const {}
};
struct ExpertOrder2 {
    int G, v;
    __device__ void init(int G_, int c) { G = G_; v = (G_ % 8 == 0) ? (c % 8) * (G_ / 8) + c / 8 : c; }
    __device__ bool next(int i, pg8::Unit& u) const { const int L = i * G + v; if (L >= 512) return false; const int e = L >> 5, r = L & 31; u.pm = e * 8 + (r & 7); u.pn = e * 4 + (r >> 3); return true; }
    __device__ __forceinline__ void a_ready(const pg8::Unit&) const {}
    __device__ __forceinline__ void done(const pg8::Unit&) const {}
};
__device__ __forceinline__ float silu_fast(float x) { return x * __builtin_amdgcn_rcpf(1.f + __builtin_amdgcn_exp2f(-1.4426950408889634f * x)); }
struct EpiSwiGLU {
    static constexpr bool PERM = true, AFTER_DRAIN = false; static constexpr int SEG = 0;
    bf16_t* O; int ldc;
    __device__ __forceinline__ void operator()(const pg8::f32x4 (&acc)[2][2][4][2], const pg8::Unit& u, int wr, int wc, int fr, int fq) const {
        int row0 = u.pm * 256 + wr * 64 + fr; asm volatile("" : "+v"(row0)); const int col0 = (u.pn & 15) * 128 + wc * 32 + 8 * fq;
#pragma unroll
        for (int ai = 0; ai < 2; ++ai)
#pragma unroll
            for (int m = 0; m < 4; ++m) {
                const pg8::f32x4 g0 = acc[ai][0][m][0], g1 = acc[ai][0][m][1], u0 = acc[ai][1][m][0], u1 = acc[ai][1][m][1];
                constexpr float IG = 1.f / F8_WGU, HS = F8_HID / F8_WGU;
                const unsigned w0 = pk4_fp8(silu_fast(g0[0] * IG) * u0[0] * HS, silu_fast(g0[1] * IG) * u0[1] * HS, silu_fast(g0[2] * IG) * u0[2] * HS, silu_fast(g0[3] * IG) * u0[3] * HS);
                const unsigned w1 = pk4_fp8(silu_fast(g1[0] * IG) * u1[0] * HS, silu_fast(g1[1] * IG) * u1[1] * HS, silu_fast(g1[2] * IG) * u1[2] * HS, silu_fast(g1[3] * IG) * u1[3] * HS);
                *(uint2*)((unsigned char*)O + (size_t)(row0 + ai * 128 + m * 16) * ldc + col0) = make_uint2(w0, w1);
            }
    }
};
struct EpiProj {
    static constexpr bool PERM = true, AFTER_DRAIN = false; static constexpr int SEG = 0;
    bf16_t* O; const float* bias;
    __device__ __forceinline__ void operator()(const pg8::f32x4 (&acc)[2][2][4][2], const pg8::Unit& u, int wr, int wc, int fr, int fq) const {
        int row0 = u.pm * 256 + wr * 64 + fr; asm volatile("" : "+v"(row0)); const int col0 = u.pn * 256 + wc * 32 + 8 * fq; const bool gate = u.pn < 12; constexpr float L2E = 1.4426950408889634f;
        float bias8[2][8];
        if (gate) { u32x4_t t0[4], t1[4]; const unsigned o0 = (unsigned)col0 * 4u; ldg8_x4<16, 512, 528>(t0, t1, bias, o0, o0);
#pragma unroll
            for (int q = 0; q < 4; ++q) { bias8[0][q] = __uint_as_float(t0[0][q]); bias8[0][4 + q] = __uint_as_float(t0[1][q]); bias8[1][q] = __uint_as_float(t0[2][q]); bias8[1][4 + q] = __uint_as_float(t0[3][q]); } }
#pragma unroll
        for (int bj = 0; bj < 2; ++bj) {
            float b[8];
#pragma unroll
            for (int q = 0; q < 8; ++q) b[q] = gate ? bias8[bj][q] : 0.f;
#pragma unroll
            for (int ai = 0; ai < 2; ++ai)
#pragma unroll
                for (int m = 0; m < 4; ++m) { float v[8];
#pragma unroll
                    for (int q = 0; q < 8; ++q) { const float x = acc[ai][bj][m][q >> 2][q & 3]; v[q] = gate ? __builtin_amdgcn_rcpf(1.f + __builtin_amdgcn_exp2f(-(x + b[q]) * L2E)) : x; }
                    pg8::u32x4 w; w.x = pg8::cvt_pk_bf16(v[0], v[1]); w.y = pg8::cvt_pk_bf16(v[2], v[3]); w.z = pg8::cvt_pk_bf16(v[4], v[5]); w.w = pg8::cvt_pk_bf16(v[6], v[7]);
                    *(pg8::u32x4*)(O + (size_t)(row0 + ai * 128 + m * 16) * DINP + col0 + bj * 128) = w; } }
    }
};
struct EpiQ {
    static constexpr bool PERM = false, AFTER_DRAIN = false; static constexpr int SEG = 0;
    bf16_t* Q; const float* rq; const float* rc; const float* rs;
    __device__ __forceinline__ void operator()(const pg8::f32x4 (&acc)[2][2][4][2], const pg8::Unit& u, int wr, int wc, int fr, int fq) const {
        int row0 = u.pm * 256 + wr * 64 + fr; asm volatile("" : "+v"(row0)); constexpr float SC = 0.10206207261596575f * 1.4426950408889634f;
        float sc8[8]; { unsigned off[8];
#pragma unroll
            for (int i = 0; i < 8; ++i) off[i] = (unsigned)(row0 + (i >> 2) * 128 + (i & 3) * 16) * 4u;
            ldg8_dw(sc8, rq, off); }
#pragma unroll
        for (int bj = 0; bj < 2; ++bj) { const int g32 = u.pn * 8 + bj * 4 + wc, col0 = g32 * 32 + 4 * fq; const bool rope = (g32 % 3) == 2;
#pragma unroll
            for (int ai = 0; ai < 2; ++ai) {
                u32x4_t cs4[4], sn4[4];
                if (rope) { u32x4_t t0[4], t1[4];
                    const unsigned o0 = (unsigned)((row0 + ai * 128) * 16 + 4 * fq) * 4u;
                    ldg8_x4<16 * 16 * 4, 32 * 16 * 4, 48 * 16 * 4>(t0, t1, rc, o0, o0 + (unsigned)(T * 16 * 4));
#pragma unroll
                    for (int m = 0; m < 4; ++m) { cs4[m] = t0[m]; sn4[m] = t1[m]; } }
#pragma unroll
                for (int m = 0; m < 4; ++m) { const int row = row0 + ai * 128 + m * 16; const float s = sc8[ai * 4 + m] * SC;
                    pg8::f32x4 v0 = acc[ai][bj][m][0] * s, v1 = acc[ai][bj][m][1] * s;
                    if (rope) { const pg8::f32x4 c4 = __builtin_bit_cast(pg8::f32x4, cs4[m]), s4 = __builtin_bit_cast(pg8::f32x4, sn4[m]);
                        const pg8::f32x4 x1 = v0, x2 = v1; v0 = x1 * c4 - x2 * s4; v1 = x1 * s4 + x2 * c4; }
                    bf16_t* qp = Q + (size_t)row * 768 + col0;
                    *(uint2*)qp = make_uint2(pg8::cvt_pk_bf16(v0[0], v0[1]), pg8::cvt_pk_bf16(v0[2], v0[3]));
                    *(uint2*)(qp + 16) = make_uint2(pg8::cvt_pk_bf16(v1[0], v1[1]), pg8::cvt_pk_bf16(v1[2], v1[3])); } } }
    }
};
struct EpiKV {
    static constexpr bool PERM = true, AFTER_DRAIN = false; static constexpr int SEG = 0;
    bf16_t* K; bf16_t* V; const float* rkv;
    __device__ __forceinline__ void operator()(const pg8::f32x4 (&acc)[2][2][4][2], const pg8::Unit& u, int wr, int wc, int fr, int fq) const {
        int row0 = u.pm * 256 + wr * 64 + fr; asm volatile("" : "+v"(row0));
        float sc8[8]; { unsigned off[8];
#pragma unroll
            for (int i = 0; i < 8; ++i) off[i] = (unsigned)(row0 + (i >> 2) * 128 + (i & 3) * 16) * 4u;
            ldg8_dw(sc8, rkv, off); }
#pragma unroll
        for (int bj = 0; bj < 2; ++bj) { const int head = u.pn * 2 + bj;
#pragma unroll
            for (int ai = 0; ai < 2; ++ai)
#pragma unroll
                for (int m = 0; m < 4; ++m) { const int row = row0 + ai * 128 + m * 16; const float s = sc8[ai * 4 + m];
                    const pg8::f32x4 v0 = acc[ai][bj][m][0] * s, v1 = acc[ai][bj][m][1] * s; pg8::u32x4 w;
                    w.x = pg8::cvt_pk_bf16(v0[0], v0[1]); w.y = pg8::cvt_pk_bf16(v0[2], v0[3]); w.z = pg8::cvt_pk_bf16(v1[0], v1[1]); w.w = pg8::cvt_pk_bf16(v1[2], v1[3]);
                    bf16_t* dst = (wc < 2) ? K + (size_t)row * 768 + head * 96 + wc * 32 + 8 * fq : V + (size_t)row * 512 + head * 64 + (wc - 2) * 32 + 8 * fq;
                    *(pg8::u32x4*)dst = w; } }
    }
};
struct EpiF32 {
    static constexpr bool PERM = true, AFTER_DRAIN = false; static constexpr int SEG = 0;
    float* O; int ldc; const float* rs;
    __device__ __forceinline__ void operator()(const pg8::f32x4 (&acc)[2][2][4][2], const pg8::Unit& u, int wr, int wc, int fr, int fq) const {
        int row0 = u.pm * 256 + wr * 64 + fr; asm volatile("" : "+v"(row0)); const int col0 = u.pn * 256 + wc * 32 + 8 * fq;
#pragma unroll
        for (int ai = 0; ai < 2; ++ai)
#pragma unroll
            for (int m = 0; m < 4; ++m) { const int row = row0 + ai * 128 + m * 16; const float s = rs ? rs[row] : 1.f;
#pragma unroll
                for (int bj = 0; bj < 2; ++bj) { float* op = O + (size_t)row * ldc + col0 + bj * 128;
                    *(pg8::f32x4*)op = acc[ai][bj][m][0] * s; *(pg8::f32x4*)(op + 4) = acc[ai][bj][m][1] * s; } }
    }
};
struct EpiMerge {
    static constexpr bool PERM = true, AFTER_DRAIN = false; static constexpr int SEG = 8;
    bf16_t* O; const bf16_t* GL;
    static __device__ __forceinline__ void ld8(const bf16_t* p, float* o) { const uint4 w = *(const uint4*)p;
        o[0] = __uint_as_float(w.x << 16); o[1] = __uint_as_float(w.x & 0xffff0000u); o[2] = __uint_as_float(w.y << 16); o[3] = __uint_as_float(w.y & 0xffff0000u);
        o[4] = __uint_as_float(w.z << 16); o[5] = __uint_as_float(w.z & 0xffff0000u); o[6] = __uint_as_float(w.w << 16); o[7] = __uint_as_float(w.w & 0xffff0000u); }
    __device__ __forceinline__ void segment(pg8::f32x4 (&acc)[2][2][4][2], const pg8::Unit& u, int seg, int wr, int wc, int fr, int fq) const {
        int row0 = u.pm * 256 + wr * 64 + fr; asm volatile("" : "+v"(row0));
        const unsigned cb = (unsigned)((seg - 1) * 1024 + u.pn * 256 + wc * 32 + 8 * fq) * 2u;
#pragma unroll
        for (int ai = 0; ai < 2; ++ai)
#pragma unroll
            for (int m = 0; m < 4; ++m) {
                u32x4_t ga[4];
                ldg4_x4<2048, 256, 2304>(ga, GL, (unsigned)(row0 + ai * 128 + m * 16) * (unsigned)(DINP * 2) + cb);
#pragma unroll
                for (int bj = 0; bj < 2; ++bj) { float x0[8], x1[8]; bf8_to_f32(ga[bj * 2], x0); bf8_to_f32(ga[bj * 2 + 1], x1);
#pragma unroll
                    for (int q = 0; q < 8; ++q) acc[ai][bj][m][q >> 2][q & 3] *= x0[q] * __builtin_amdgcn_rcpf(x1[q]); } }
    }
    __device__ __forceinline__ void operator()(const pg8::f32x4 (&acc)[2][2][4][2], const pg8::Unit& u, int wr, int wc, int fr, int fq) const {
        int row0 = u.pm * 256 + wr * 64 + fr; asm volatile("" : "+v"(row0)); const int col0 = u.pn * 256 + wc * 32 + 8 * fq;
        const unsigned cb = (unsigned)(2048 + col0) * 2u;
#pragma unroll
        for (int ai = 0; ai < 2; ++ai) {
            u32x4_t g8[8];
            { unsigned off[8];
#pragma unroll
              for (int i = 0; i < 8; ++i) off[i] = (unsigned)(row0 + ai * 128 + (i & 3) * 16) * (unsigned)(DINP * 2) + cb + (i >> 2) * 256u;
              ldg8_x4v(g8, GL, off); }
#pragma unroll
            for (int m = 0; m < 4; ++m) { const int row = row0 + ai * 128 + m * 16;
#pragma unroll
                for (int bj = 0; bj < 2; ++bj) { float x2[8], v[8]; bf8_to_f32(g8[bj * 4 + m], x2);
#pragma unroll
                    for (int q = 0; q < 8; ++q) v[q] = acc[ai][bj][m][q >> 2][q & 3] * x2[q];
                    pg8::u32x4 w; w.x = pg8::cvt_pk_bf16(v[0], v[1]); w.y = pg8::cvt_pk_bf16(v[2], v[3]); w.z = pg8::cvt_pk_bf16(v[4], v[5]); w.w = pg8::cvt_pk_bf16(v[6], v[7]);
                    *(pg8::u32x4*)(O + (size_t)row * DM + col0 + bj * 128) = w; } } }
    }
};
struct EpiRowScale {
    static constexpr bool PERM = true, AFTER_DRAIN = false; static constexpr int SEG = 0;
    bf16_t* O; int ldc; const float* rs;
    __device__ __forceinline__ void operator()(const pg8::f32x4 (&acc)[2][2][4][2], const pg8::Unit& u, int wr, int wc, int fr, int fq) const {
        int row0 = u.pm * 256 + wr * 64 + fr; asm volatile("" : "+v"(row0)); const int col0 = (u.pn & 3) * 256 + wc * 32 + 8 * fq;
        float sc8[8]; { unsigned off[8];
#pragma unroll
            for (int i = 0; i < 8; ++i) off[i] = (unsigned)(row0 + (i >> 2) * 128 + (i & 3) * 16) * 4u;
            ldg8_dw(sc8, rs, off); }
#pragma unroll
        for (int ai = 0; ai < 2; ++ai)
#pragma unroll
            for (int m = 0; m < 4; ++m) { const int row = row0 + ai * 128 + m * 16; const float s = sc8[ai * 4 + m] * (1.f / (F8_WD * F8_HID));
#pragma unroll
                for (int bj = 0; bj < 2; ++bj) { const pg8::f32x4 v0 = acc[ai][bj][m][0] * s, v1 = acc[ai][bj][m][1] * s; pg8::u32x4 w;
                    w.x = pg8::cvt_pk_bf16(v0[0], v0[1]); w.y = pg8::cvt_pk_bf16(v0[2], v0[3]); w.z = pg8::cvt_pk_bf16(v1[0], v1[1]); w.w = pg8::cvt_pk_bf16(v1[2], v1[3]);
                    *(pg8::u32x4*)(O + (size_t)row * ldc + col0 + bj * 128) = w; } }
    }
};
struct Params {
    const float* in[27];
    const int* pos;
    float* out;
    unsigned char* ws;
};

__device__ __forceinline__ float wave_sum(float v) {
#pragma unroll
    for (int o = 1; o < 64; o <<= 1) v += __shfl_xor(v, o);
    return v;
}
__device__ __forceinline__ float sigmoidf_(float x) { return 1.f / (1.f + expf(-x)); }
__device__ __forceinline__ float siluf_(float x) { return x / (1.f + expf(-x)); }
__device__ __forceinline__ float log_sigmoidf_(float x) { return fminf(x, 0.f) - log1pf(expf(-fabsf(x))); }

__device__ __forceinline__ float bf2f(bf16_t u) { return __uint_as_float((unsigned)u << 16); }
__device__ __forceinline__ unsigned f2bf(float f) { unsigned u = __float_as_uint(f); return (u + 0x7fffu + ((u >> 16) & 1u)) >> 16; }
__device__ __forceinline__ unsigned pk2(float lo, float hi) { return f2bf(lo) | (f2bf(hi) << 16); }
__device__ __forceinline__ void ld4bf(const bf16_t* p, float* o) {
    const uint2 w = *(const uint2*)p; o[0] = __uint_as_float(w.x << 16); o[1] = __uint_as_float(w.x & 0xffff0000u); o[2] = __uint_as_float(w.y << 16); o[3] = __uint_as_float(w.y & 0xffff0000u);
}
__device__ __forceinline__ void transpose_block(const float* Wblk, int ldw, bf16_t* dst, int ldt, const float* ks, const float* ns, float* scr, int lane) {
#pragma unroll 8
    for (int i = 0; i < 32; ++i) { const int kk = 2 * i + (lane >> 5); float v = __builtin_nontemporal_load(&Wblk[(size_t)kk * ldw + (lane & 31)]);     if (ks) v *= ks[kk]; if (ns) v *= ns[lane & 31]; scr[kk * 33 + (lane & 31)] = v; }
    asm volatile("s_waitcnt lgkmcnt(0)" ::: "memory");
    const int c = lane & 7;
#pragma unroll
    for (int j = 0; j < 4; ++j) { const int n = (lane >> 3) + 8 * j; const float* s = scr + (8 * c) * 33 + n;
        uint4 o; o.x = pk2(s[0 * 33], s[1 * 33]); o.y = pk2(s[2 * 33], s[3 * 33]); o.z = pk2(s[4 * 33], s[5 * 33]); o.w = pk2(s[6 * 33], s[7 * 33]);
        *(uint4*)(dst + (size_t)n * ldt + 8 * c) = o; }
    asm volatile("s_waitcnt lgkmcnt(0)" ::: "memory");
}

struct WStream {
    const float* gate; const float* up; const float* down;
    unsigned char* wgu_t; unsigned char* wd_t;
    const char* rowp; unsigned rs8, rs1;
    unsigned vo0;
    const float* src; unsigned char* dst; int ldt; float sc;
    int it, it_stride, step, nsteps;
    float v0, v1, v2, v3;
    char* blk; char* blkw;
    __device__ __forceinline__ void init(int gw, int ngw, char* lds_blk, int lane) {
        constexpr int I_ALL = 2 * 16 * 16 * 64 + 16 * 32 * 32;
        nsteps = (gw < I_ALL) ? 8 * ((I_ALL - gw + ngw - 1) / ngw) : 0;
        if (I_ALL % ngw == 0) { const int per_wg = I_ALL / (ngw >> 3); gw = (gw >> 3) * per_wg + (gw & 7); ngw = 8; nsteps = per_wg; }
        it = gw; it_stride = ngw; step = 0; blk = lds_blk; blkw = lds_blk + (lane & 31) * 80 + 4 * (lane >> 5);
        src = gate; rowp = (const char*)gate; rs8 = 0u; rs1 = 0u; vo0 = 0u; dst = wgu_t; ldt = DM; sc = 1.f; v0 = v1 = v2 = v3 = 0.f;
    }
    __device__ __forceinline__ void rare(int lane) {
        if (step >= 8 && step <= nsteps) {
            const int nr = lane >> 1, hf = lane & 1;
            const uint4 a = *(const uint4*)(blk + nr * 80 + hf * 32), b = *(const uint4*)(blk + nr * 80 + hf * 32 + 16);
            unsigned char* q = dst + (size_t)nr * ldt + hf * 32;
            { typedef unsigned u32x4n __attribute__((ext_vector_type(4))); const u32x4n an = {a.x, a.y, a.z, a.w}, bn = {b.x, b.y, b.z, b.w};
              __builtin_nontemporal_store(an, (u32x4n*)q); __builtin_nontemporal_store(bn, (u32x4n*)(q + 16)); }
        }
        if (step < nsteps) {
            constexpr int I_G = 16 * 16 * 64; int ldw;
            if (it < 2 * I_G) { const int up_ = it >= I_G, r_ = up_ ? it - I_G : it, e_ = r_ >> 10, kb_ = (r_ >> 6) & 15, nb_ = r_ & 63, j0_ = nb_ * 32;
                src = (up_ ? up : gate) + (size_t)e_ * DM * DEXP + (size_t)(64 * kb_) * DEXP + j0_; ldw = DEXP;
                dst = wgu_t + (size_t)(e_ * 4096 + 256 * (j0_ >> 7) + (j0_ & 127) + (up_ ? 128 : 0)) * DM + 64 * kb_; ldt = DM; sc = F8_WGU; }
            else { const int r_ = it - 2 * I_G, e_ = r_ >> 10, kb_ = (r_ >> 5) & 31, nb_ = r_ & 31;
                src = down + (size_t)e_ * DEXP * DM + (size_t)(64 * kb_) * DM + 32 * nb_; ldw = DM; dst = wd_t + (size_t)(e_ * 1024 + 32 * nb_) * DEXP + 64 * kb_; ldt = DEXP; sc = F8_WD; }
            it += it_stride;
            rowp = (const char*)src; rs8 = (unsigned)ldw * 32u; rs1 = (unsigned)ldw * 4u;
            vo0 = (unsigned)((4 * (lane >> 5)) * ldw + (lane & 31)) * 4u;
        } else { rowp = (const char*)src; rs8 = 0u; rs1 = 0u; vo0 = (unsigned)(lane & 31) * 4u; }
    }
    __device__ __forceinline__ void tick(int lane) {
        *(unsigned*)(blkw + ((step - 1) & 7) * 8) = pk4_fp8(v0 * sc, v1 * sc, v2 * sc, v3 * sc);
        if ((step & 7) == 0) rare(lane);
        v0 = __builtin_nontemporal_load((const float*)(rowp + vo0)); v1 = __builtin_nontemporal_load((const float*)(rowp + rs1 + vo0));
        v2 = __builtin_nontemporal_load((const float*)(rowp + 2 * rs1 + vo0)); v3 = __builtin_nontemporal_load((const float*)(rowp + 3 * rs1 + vo0));
        rowp += rs8; ++step;
    }
};

namespace att {
using bf16x8 = __attribute__((ext_vector_type(8))) short;
using s16x4  = __attribute__((ext_vector_type(4))) short;
using f32x16 = __attribute__((ext_vector_type(16))) float;
using u32x4  = __attribute__((ext_vector_type(4))) unsigned;
constexpr int NW = 8, QBLK = 32, KVBLK = 64;
constexpr int LDQ = 768, LDK = 768, LDV = 512, LDO = 1536;
constexpr int KROWB = 208;
constexpr int SHM_K = KVBLK * KROWB, SHM_V = KVBLK * 64 * 2;
constexpr int NBUF = 3;
constexpr int SHM_ATTN = NBUF * SHM_V + NBUF * SHM_K + NW * 64 * 4;
constexpr float THR = 8.f;
#define ASBAR() __builtin_amdgcn_sched_barrier(0)
__device__ __forceinline__ int crow(int r, int hi) { return (r & 3) + 8 * (r >> 2) + 4 * hi; }
__device__ __forceinline__ unsigned cvtpk(float lo, float hi) { unsigned r; asm volatile("v_cvt_pk_bf16_f32 %0, %1, %2" : "=v"(r) : "v"(lo), "v"(hi)); return r; }
#define MX3(a, b, c) __builtin_fmaxf(__builtin_fmaxf((a), (b)), (c))
template <bool FIRST>
__device__ __forceinline__ void partialSM(f32x16& p0, f32x16& p1, float& m_ref, f32x16& negm, float& alpha) {
  constexpr float THRL = THR * 1.4426950408889634f;
  float a = MX3(p0[0], p0[1], p1[0]), b = MX3(p0[2], p0[3], p1[1]); a = MX3(a, p1[2], p1[3]);
#pragma unroll
  for (int r = 4; r < 16; r += 4) { a = MX3(a, p0[r], p0[r + 1]); b = MX3(b, p0[r + 2], p0[r + 3]); a = MX3(a, p1[r], p1[r + 1]); b = MX3(b, p1[r + 2], p1[r + 3]); }
  float pmax = fmaxf(a, b);
  { auto rr = __builtin_amdgcn_permlane32_swap(__float_as_uint(pmax), __float_as_uint(pmax), false, false);
    pmax = fmaxf(__uint_as_float(rr[0]), __uint_as_float(rr[1])); }
  alpha = 1.f;
  if (FIRST || !__builtin_expect(__all(pmax <= THRL), 1)) {
    const float dl = FIRST ? pmax : fmaxf(pmax, 0.f); m_ref += dl;
#pragma unroll
    for (int r = 0; r < 16; ++r) { p0[r] -= dl; p1[r] -= dl; }
#pragma unroll
    for (int r = 0; r < 16; ++r) negm[r] = -m_ref;
    asm volatile("" : "+v"(negm));
    if (!FIRST) alpha = __builtin_amdgcn_exp2f(-dl);
  }
#pragma unroll
  for (int r = 0; r < 16; ++r) p0[r] = __builtin_amdgcn_exp2f(p0[r]);
}
#undef MX3
__device__ __forceinline__ void finishSM(f32x16& p0, f32x16& p1, float alpha, float& l_reg, bf16x8& pa0, bf16x8& pa1, bf16x8& pa2, bf16x8& pa3) {
  for (int r = 0; r < 16; ++r) p1[r] = __builtin_amdgcn_exp2f(p1[r]);
  float ps = 0; for (int r = 0; r < 16; ++r) ps += p0[r]; for (int r = 0; r < 16; ++r) ps += p1[r];
  { auto rr = __builtin_amdgcn_permlane32_swap(__float_as_uint(ps), __float_as_uint(ps), false, false);
    ps = __uint_as_float(rr[0]) + __uint_as_float(rr[1]); }
  l_reg = l_reg * alpha + ps;
#define PK4(P, BASE, OUT) do { u32x4 w = {cvtpk(P[BASE + 0], P[BASE + 1]), cvtpk(P[BASE + 2], P[BASE + 3]), cvtpk(P[BASE + 4], P[BASE + 5]), cvtpk(P[BASE + 6], P[BASE + 7])}; \
    OUT = *reinterpret_cast<bf16x8*>(&w); } while (0)
  PK4(p0, 0, pa0); PK4(p0, 8, pa1); PK4(p1, 0, pa2); PK4(p1, 8, pa3);
#undef PK4
}
__device__ __forceinline__ void qkt(f32x16& p0, f32x16& p1, const char* Ks, const bf16x8* qr, const f32x16& negm, int r32, int hi) {
  p0 = negm; p1 = negm;
#pragma unroll
  for (int d0 = 0; d0 < 6; ++d0) { const int cb = d0 * 32 + hi * 16;
    bf16x8 b0 = *reinterpret_cast<const bf16x8*>(Ks + r32 * KROWB + cb);
    bf16x8 b1 = *reinterpret_cast<const bf16x8*>(Ks + (32 + r32) * KROWB + cb);
    p0 = __builtin_amdgcn_mfma_f32_32x32x16_bf16(b0, qr[d0], p0, 0, 0, 0);
    p1 = __builtin_amdgcn_mfma_f32_32x32x16_bf16(b1, qr[d0], p1, 0, 0, 0); }
}
__device__ __forceinline__ int v_st(int k, int c) { const int kk = k;   return ((kk >> 3) * 2 + (c >> 5)) * 512 + ((kk & 7) * 32 + (c & 31)) * 2; }
__device__ __forceinline__ int v_rd_base(int lane) { return ((lane & 3) << 3) | (((lane >> 2) & 3) << 6) | (((lane >> 4) & 1) << 5) | (((lane >> 5) & 1) << 8); }
constexpr int v_rd_off(int d0, int ks, int half) { return d0 * 512 + ks * 2048 + half * 1024; }
template <int OFF> __device__ __forceinline__ s16x4 tr_read(int vb) {
  s16x4 r; asm volatile("ds_read_b64_tr_b16 %0, %1 offset:%2" : "=&v"(r) : "v"(vb), "i"(OFF) : "memory"); return r;
}
template <int D0> __device__ __forceinline__ void pv_one(f32x16& od, int vb, bf16x8 pa0, bf16x8 pa1, bf16x8 pa2, bf16x8 pa3) {
  const s16x4 l0 = tr_read<v_rd_off(D0, 0, 0)>(vb), h0 = tr_read<v_rd_off(D0, 0, 1)>(vb), l1 = tr_read<v_rd_off(D0, 1, 0)>(vb), h1 = tr_read<v_rd_off(D0, 1, 1)>(vb);
  const s16x4 l2 = tr_read<v_rd_off(D0, 2, 0)>(vb), h2 = tr_read<v_rd_off(D0, 2, 1)>(vb), l3 = tr_read<v_rd_off(D0, 3, 0)>(vb), h3 = tr_read<v_rd_off(D0, 3, 1)>(vb);
  asm volatile("s_waitcnt lgkmcnt(0)" ::: "memory"); ASBAR();
#define PK(L, H) (bf16x8){L[0], L[1], L[2], L[3], H[0], H[1], H[2], H[3]}
  od = __builtin_amdgcn_mfma_f32_32x32x16_bf16(pa0, PK(l0, h0), od, 0, 0, 0);
  od = __builtin_amdgcn_mfma_f32_32x32x16_bf16(pa1, PK(l1, h1), od, 0, 0, 0);
  od = __builtin_amdgcn_mfma_f32_32x32x16_bf16(pa2, PK(l2, h2), od, 0, 0, 0);
  od = __builtin_amdgcn_mfma_f32_32x32x16_bf16(pa3, PK(l3, h3), od, 0, 0, 0);
#undef PK
}
__device__ __forceinline__ void pv_d0(f32x16* o, int vb, bf16x8 pa0, bf16x8 pa1, bf16x8 pa2, bf16x8 pa3) {
  pv_one<0>(o[0], vb, pa0, pa1, pa2, pa3); pv_one<1>(o[1], vb, pa0, pa1, pa2, pa3);
}
__device__ __forceinline__ void attn_unit(const bf16_t* Qb, const bf16_t* Kh, const bf16_t* Vh, bf16_t* Ob, int seq, char* lds, WStream& wst) {
  int tid_ = threadIdx.x; asm volatile("" : "+v"(tid_));
  const int tid = tid_, wid = tid >> 6, lane = tid & 63, r32 = lane & 31, hi = lane >> 5;
  char* V_lds = lds; char* K_lds = lds + NBUF * SHM_V;
  float* ws = (float*)(lds + NBUF * SHM_V + NBUF * SHM_K) + wid * 64; float* li_l = ws; float* al_l = ws + 32;
  float m_ref = 0.f, l_reg = 0; f32x16 o[2] = {}; bf16x8 qr[6]; f32x16 negm = {}; asm volatile("" : "+v"(negm));
  const bf16_t* Qw = Qb + (long)(wid * QBLK + r32) * LDQ + hi * 8;
#pragma unroll
  for (int d0 = 0; d0 < 6; ++d0) qr[d0] = *reinterpret_cast<const bf16x8*>(Qw + d0 * 16);
  const bool kact = tid < 384; const int kr = tid / 12, kc = tid - kr * 12, vr = tid >> 3, vc = (tid & 7) * 8, vst0 = v_st(vr, vc);
  const int kst0 = kr * KROWB + kc * 16, kst1 = (kr + 32) * KROWB + kc * 16;
  const int vb0 = (int)(uintptr_t)V_lds + v_rd_base(lane);
  struct { bf16x8 vs, ks0, ks1; } sr_[2];
#define SLOAD(i, k0) do { sr_[i].vs = *reinterpret_cast<const bf16x8*>(&Vh[(long)((k0) + vr) * LDV + vc]); \
    if (kact) { sr_[i].ks0 = *reinterpret_cast<const bf16x8*>(&Kh[(long)((k0) + kr) * LDK + kc * 8]); sr_[i].ks1 = *reinterpret_cast<const bf16x8*>(&Kh[(long)((k0) + 32 + kr) * LDK + kc * 8]); } } while (0)
#define SWRITE(b, i) do { *(bf16x8*)(V_lds + (b) * SHM_V + vst0) = sr_[i].vs; \
    if (kact) { *(bf16x8*)(K_lds + (b) * SHM_K + kst0) = sr_[i].ks0; *(bf16x8*)(K_lds + (b) * SHM_K + kst1) = sr_[i].ks1; } } while (0)
#define SWAIT() asm volatile("s_waitcnt vmcnt(3)" ::: "memory")
#define RESC(a) do { if (__any((a) < 1.f)) { if (hi == 0) al_l[r32] = (a); asm volatile("s_waitcnt lgkmcnt(0)" ::: "memory"); \
    for (int d = 0; d < 2; ++d) for (int r = 0; r < 16; ++r) o[d][r] *= al_l[crow(r, hi)]; } } while (0)
  f32x16 pA0, pA1, pB0, pB1; float alA, alB; bf16x8 pa0, pa1, pa2, pa3; const int NT = seq / KVBLK;
  constexpr int SE = 0, SO = 1;
  int b_prev = 0, b_cur = 1, b_next = 2;
#define ROT() do { b_prev = b_cur; b_cur = b_next; b_next = (b_next == NBUF - 1) ? 0 : b_next + 1; } while (0)
  SLOAD(SE, 0); asm volatile("s_waitcnt vmcnt(0)" ::: "memory"); SWRITE(0, SE);
  SLOAD(SO, KVBLK); if (2 < NT) SLOAD(SE, 2 * KVBLK);
  __syncthreads();
  qkt(pA0, pA1, K_lds, qr, negm, r32, hi); partialSM<true>(pA0, pA1, m_ref, negm, alA);
  SWAIT(); SWRITE(1, SO); __syncthreads();
  for (int j = 1; j + 1 < NT; j += 2) {
    SLOAD(SO, (j + 2) * KVBLK);
    ASBAR(); qkt(pB0, pB1, K_lds + b_cur * SHM_K, qr, negm, r32, hi);
    finishSM(pA0, pA1, alA, l_reg, pa0, pa1, pa2, pa3); ASBAR();
    pv_d0(o, vb0 + b_prev * SHM_V, pa0, pa1, pa2, pa3); partialSM<false>(pB0, pB1, m_ref, negm, alB);
    SWAIT(); SWRITE(b_next, SE);
    RESC(alB); if (wst.step <= wst.nsteps) wst.tick(lane); __syncthreads(); ROT();
    if (j + 3 < NT) SLOAD(SE, (j + 3) * KVBLK);
    ASBAR(); qkt(pA0, pA1, K_lds + b_cur * SHM_K, qr, negm, r32, hi);
    finishSM(pB0, pB1, alB, l_reg, pa0, pa1, pa2, pa3); ASBAR();
    pv_d0(o, vb0 + b_prev * SHM_V, pa0, pa1, pa2, pa3); partialSM<false>(pA0, pA1, m_ref, negm, alA);
    SWAIT(); SWRITE(b_next, SO);
    RESC(alA); if (wst.step <= wst.nsteps) wst.tick(lane); __syncthreads(); ROT();
  }
  ASBAR(); qkt(pB0, pB1, K_lds + b_cur * SHM_K, qr, negm, r32, hi);
  finishSM(pA0, pA1, alA, l_reg, pa0, pa1, pa2, pa3); ASBAR();
  pv_d0(o, vb0 + b_prev * SHM_V, pa0, pa1, pa2, pa3); partialSM<false>(pB0, pB1, m_ref, negm, alB);
  RESC(alB);
  finishSM(pB0, pB1, alB, l_reg, pa0, pa1, pa2, pa3); ASBAR();
  pv_d0(o, vb0 + b_cur * SHM_V, pa0, pa1, pa2, pa3);
#undef ROT
  if (hi == 0) li_l[r32] = l_reg; asm volatile("s_waitcnt lgkmcnt(0)" ::: "memory");
  float rli[16];
#pragma unroll
  for (int r = 0; r < 16; ++r) rli[r] = __builtin_amdgcn_rcpf(li_l[crow(r, hi)]);
  bf16_t* Ow = Ob + (long)(wid * QBLK) * LDO;
#pragma unroll
  for (int r = 0; r < 16; ++r) { const int orow = crow(r, hi);
#pragma unroll
    for (int d0 = 0; d0 < 2; ++d0) Ow[(long)orow * LDO + d0 * 32 + r32] = (bf16_t)f2bf(o[d0][r] * rli[r]); }
  __syncthreads();
#undef SLOAD
#undef SWRITE
#undef SWAIT
#undef RESC
}
#undef ASBAR
}

namespace gla {
using bf16x8 = __attribute__((ext_vector_type(8))) short;
using s16x4  = __attribute__((ext_vector_type(4))) short;
using f32x16 = __attribute__((ext_vector_type(16))) float;
using u32x4  = __attribute__((ext_vector_type(4))) unsigned;
constexpr int L_DL = 0, L_TOT = 8192, L_RSUM = 10240, L_V = 12288, L_QF = 28672, L_KF = 37888, L_QB = 47104, L_KB = 56320, L_KSTF = 65536, L_KSTB = 74752, L_STF = 65536, L_STB = 83968, L_QR = 102400, L_KR = 110592, L_END = 118784;
constexpr int RB = 144;
__device__ __forceinline__ int crow(int r, int hi) { return (r & 3) + 8 * (r >> 2) + 4 * hi; }
__device__ __forceinline__ unsigned cvtpk(float lo, float hi) { unsigned r; asm volatile("v_cvt_pk_bf16_f32 %0, %1, %2" : "=v"(r) : "v"(lo), "v"(hi)); return r; }
__device__ __forceinline__ int v_st4(int k, int c) { const int kk = (k & ~0xC) | ((k & 4) << 1) | ((k & 8) >> 1); return ((kk >> 3) * 4 + (c >> 5)) * 512 + ((kk & 7) * 32 + (c & 31)) * 2; }
__device__ __forceinline__ int v_rd_base(int lane) { return ((lane & 3) << 3) | (((lane >> 2) & 3) << 6) | (((lane >> 4) & 1) << 5) | (((lane >> 5) & 1) << 8); }
template <int OFF> __device__ __forceinline__ s16x4 tr_read(int vb) { s16x4 r; asm volatile("ds_read_b64_tr_b16 %0, %1 offset:%2" : "=&v"(r) : "v"(vb), "i"(OFF) : "memory"); return r; }
__device__ __forceinline__ void v_frags(int vb, bf16x8 (&f)[4]) {
  const s16x4 l0 = tr_read<0>(vb), h0 = tr_read<2048>(vb), l1 = tr_read<4096>(vb), h1 = tr_read<4096 + 2048>(vb);
  const s16x4 l2 = tr_read<8192>(vb), h2 = tr_read<8192 + 2048>(vb), l3 = tr_read<12288>(vb), h3 = tr_read<12288 + 2048>(vb);
  asm volatile("s_waitcnt lgkmcnt(0)" ::: "memory"); __builtin_amdgcn_sched_barrier(0);
#define PK(L, H) (bf16x8){L[0], L[1], L[2], L[3], H[0], H[1], H[2], H[3]}
  f[0] = PK(l0, h0); f[1] = PK(l1, h1); f[2] = PK(l2, h2); f[3] = PK(l3, h3);
#undef PK
}
__device__ __forceinline__ bf16x8 frag(const char* base, int row, int ks, int hi) { return *reinterpret_cast<const bf16x8*>(base + row * RB + ks * 32 + hi * 16); }

template <bool IS_G1>
__device__ __forceinline__ void prep(char* lds, const bf16_t* projb, const float* wdec, const float* bdec, int t0, int hh, float* dec_out  , long dec_dir_stride, const bf16_t* st0 = nullptr, long st_dir_stride = 0) {
  int tid_ = threadIdx.x; asm volatile("" : "+v"(tid_)); const int tid = tid_;
  float* DL = (float*)(lds + L_DL); float* TOT = (float*)(lds + L_TOT);
  const int cidx = tid & 127, tg = tid >> 7, dir = cidx >> 6, d = cidx & 63;
  const int i_ = tid >> 3, r4_ = (tid & 7) * 4, c8_ = (tid & 7) * 8;
  const uint2 dlraw = *(const uint2*)(projb + (size_t)(t0 + i_) * DINP + OFF_GDEC + r4_);
  const uint4 kraw = *(const uint4*)(projb + (size_t)(t0 + i_) * DINP + OFF_GK + hh * 64 + c8_);
  uint4 qraw = make_uint4(0u, 0u, 0u, 0u); if constexpr (!IS_G1) qraw = *(const uint4*)(projb + (size_t)(t0 + i_) * DINP + OFF_GQ + hh * 64 + c8_);
  uint4 vraw[2];
#pragma unroll
  for (int e2 = 0; e2 < 2; ++e2) { const int e = tid + e2 * 512, i = e >> 4, cc = (e & 15) * 8; vraw[e2] = *(const uint4*)(projb + (size_t)(t0 + i) * DINP + OFF_GV + hh * 128 + cc); }
  uint4 sraw[4];
  if constexpr (!IS_G1) {
#pragma unroll
    for (int e4 = 0; e4 < 4; ++e4) { const int e = tid + e4 * 512, sdir = e >> 10, v = (e >> 3) & 127, dc = (e & 7) * 8; sraw[e4] = *(const uint4*)(st0 + (long)sdir * st_dir_stride + (size_t)v * 64 + dc); } }
  float W[16];
#pragma unroll
  for (int r = 0; r < 16; ++r) W[r] = wdec[(size_t)(dir * 16 + r) * 256 + hh * 64 + d];
  const float bias = bdec[dir * 256 + hh * 64 + d];
  { *(float4*)(DL + i_ * 32 + r4_) = make_float4(__uint_as_float(dlraw.x << 16), __uint_as_float(dlraw.x & 0xffff0000u), __uint_as_float(dlraw.y << 16), __uint_as_float(dlraw.y & 0xffff0000u));
    *(uint4*)(lds + L_KR + i_ * 128 + c8_ * 2) = kraw;
    if constexpr (!IS_G1) *(uint4*)(lds + L_QR + i_ * 128 + c8_ * 2) = qraw; }
#pragma unroll
  for (int e2 = 0; e2 < 2; ++e2) { const int e = tid + e2 * 512, i = e >> 4, cc = (e & 15) * 8; *(uint4*)(lds + L_V + v_st4(i, cc)) = vraw[e2]; }
  if constexpr (!IS_G1) {
#pragma unroll
    for (int e4 = 0; e4 < 4; ++e4) { const int e = tid + e4 * 512, sdir = e >> 10, v = (e >> 3) & 127, dc = (e & 7) * 8; *(uint4*)(lds + (sdir ? L_STB : L_STF) + v * RB + dc * 2) = sraw[e4]; } }
  __syncthreads();
  constexpr float L2E = 1.4426950408889634f;
  float g[16], cs[16]; float run = 0.f;
#pragma unroll
  for (int ii = 0; ii < 16; ++ii) { const float* dl = DL + (16 * tg + ii) * 32 + dir * 16; float a = bias;
#pragma unroll
    for (int r = 0; r < 16; r += 4) { const float4 x = *(const float4*)(dl + r); a = fmaf(x.x, W[r], a); a = fmaf(x.y, W[r + 1], a); a = fmaf(x.z, W[r + 2], a); a = fmaf(x.w, W[r + 3], a); }
    g[ii] = (fminf(a, 0.f) * L2E - __builtin_amdgcn_logf(1.f + __builtin_amdgcn_exp2f(-fabsf(a) * L2E))) * (1.f / 16.f); run += g[ii]; cs[ii] = run; }
  TOT[tg * 128 + cidx] = run;
  __syncthreads();
  const float t0s = TOT[cidx], t1s = TOT[128 + cidx], t2s = TOT[256 + cidx], t3s = TOT[384 + cidx], tall = (t0s + t1s) + (t2s + t3s);
  const float off_lo = (tg > 0 ? t0s : 0.f) + (tg > 1 ? t1s : 0.f) + (tg > 2 ? t2s : 0.f);
  const float off_hi = (tg < 1 ? t1s : 0.f) + (tg < 2 ? t2s : 0.f) + (tg < 3 ? t3s : 0.f);
  const bf16_t* KR = (const bf16_t*)(lds + L_KR); const bf16_t* QR = (const bf16_t*)(lds + L_QR);
  if constexpr (IS_G1) {
    unsigned pk[8];
#pragma unroll
    for (int ii = 0; ii < 16; ii += 2) {
      float kv2[2];
#pragma unroll
      for (int u = 0; u < 2; ++u) { const int i = 16 * tg + ii + u; const float bi = dir == 0 ? off_lo + cs[ii + u] : off_hi + run - cs[ii + u] + g[ii + u];
        kv2[u] = bf2f(KR[i * 64 + d]) * __builtin_amdgcn_exp2f(tall - bi); }
      pk[ii >> 1] = cvtpk(kv2[0], kv2[1]); }
    char* dst = lds + (dir ? L_KSTB : L_KSTF) + d * RB + 32 * tg;
    *(uint4*)dst = make_uint4(pk[0], pk[1], pk[2], pk[3]); *(uint4*)(dst + 16) = make_uint4(pk[4], pk[5], pk[6], pk[7]);
    if (tg == 0) dec_out[dir * dec_dir_stride + d] = __builtin_amdgcn_exp2f(tall);
  } else {
    bf16_t* Qx = (bf16_t*)(lds + (dir ? L_QB : L_QF)); bf16_t* Kx = (bf16_t*)(lds + (dir ? L_KB : L_KF));
#pragma unroll
    for (int ii = 0; ii < 16; ++ii) { const int i = 16 * tg + ii; const float bi = dir == 0 ? off_lo + cs[ii] : off_hi + run - cs[ii] + g[ii];
      const float qv = bf2f(QR[i * 64 + d]) * 0.125f, kv = bf2f(KR[i * 64 + d]);
      Qx[i * (RB / 2) + d] = (bf16_t)f2bf(qv * __builtin_amdgcn_exp2f(bi)); Kx[i * (RB / 2) + d] = (bf16_t)f2bf(kv * __builtin_amdgcn_exp2f(-bi)); }
  }
  __syncthreads();
}

__device__ __forceinline__ void g1_item(char* lds, const bf16_t* projb, const float* wdec, const float* bdec, int b, int hh, int c, float* kvt, float* dec) {
  int tid_ = threadIdx.x; asm volatile("" : "+v"(tid_)); const int tid = tid_, wid = tid >> 6, lane = tid & 63, r32 = lane & 31, hi = lane >> 5;
  const int bh = b * 4 + hh; const long item = (long)bh * 128 + c, dstride = 8L * 128;
  prep<true>(lds, projb, wdec, bdec, b * SEQ + c * 64, hh, dec + item * 64, dstride * 64);
  const int vblk = wid >> 1, dblk = wid & 1;
  bf16x8 vf[4]; v_frags((int)(uintptr_t)(lds + L_V) + v_rd_base(lane) + vblk * 512, vf);
#pragma unroll
  for (int dir = 0; dir < 2; ++dir) { const char* kst = lds + (dir ? L_KSTB : L_KSTF); f32x16 acc = {};
#pragma unroll
    for (int ks = 0; ks < 4; ++ks) acc = __builtin_amdgcn_mfma_f32_32x32x16_bf16(vf[ks], frag(kst, dblk * 32 + r32, ks, hi), acc, 0, 0, 0);
    float* o = kvt + ((long)dir * dstride + item) * 8192 + (size_t)(vblk * 32) * 64 + dblk * 32 + r32;
#pragma unroll
    for (int r = 0; r < 16; ++r) o[crow(r, hi) * 64] = acc[r]; }
  __syncthreads();
}

__device__ __forceinline__ void g3_item(char* lds, const bf16_t* projb, const float* wdec, const float* bdec, const float* normg, int b, int hh, int c, const bf16_t* st, bf16_t* out, int ldo) {
  int tid_ = threadIdx.x; asm volatile("" : "+v"(tid_)); const int tid = tid_, wid = tid >> 6, lane = tid & 63, r32 = lane & 31, hi = lane >> 5;
  const int bh = b * 4 + hh, t0 = b * SEQ + c * 64; const long item = (long)bh * 128 + c, dstride = 8L * 128;
  const int ib = wid & 1, vblk = wid >> 1, iglob = ib * 32 + r32;
  bf16_t rgr[16];
#pragma unroll
  for (int r = 0; r < 16; ++r) rgr[r] = projb[(size_t)(t0 + ib * 32 + crow(r, hi)) * DINP + OFF_GR + hh * 128 + vblk * 32 + r32];
  const float ng = normg[vblk * 32 + r32];
  prep<false>(lds, projb, wdec, bdec, t0, hh, nullptr, 0, st + item * 8192, dstride * 8192);
  f32x16 pF0 = {}, pF1 = {}, pB0 = {}, pB1 = {};
#pragma unroll
  for (int ks = 0; ks < 4; ++ks) {
    const bf16x8 qf = frag(lds + L_QF, iglob, ks, hi), qb = frag(lds + L_QB, iglob, ks, hi);
    pF0 = __builtin_amdgcn_mfma_f32_32x32x16_bf16(frag(lds + L_KF, r32, ks, hi), qf, pF0, 0, 0, 0);
    pF1 = __builtin_amdgcn_mfma_f32_32x32x16_bf16(frag(lds + L_KF, 32 + r32, ks, hi), qf, pF1, 0, 0, 0);
    pB0 = __builtin_amdgcn_mfma_f32_32x32x16_bf16(frag(lds + L_KB, r32, ks, hi), qb, pB0, 0, 0, 0);
    pB1 = __builtin_amdgcn_mfma_f32_32x32x16_bf16(frag(lds + L_KB, 32 + r32, ks, hi), qb, pB1, 0, 0, 0); }
#pragma unroll
  for (int r = 0; r < 16; ++r) { const int j0 = crow(r, hi), j1 = 32 + j0;
    pF0[r] = (j0 <= iglob ? pF0[r] : 0.f) + (j0 >= iglob ? pB0[r] : 0.f);
    pF1[r] = (j1 <= iglob ? pF1[r] : 0.f) + (j1 >= iglob ? pB1[r] : 0.f); }
  bf16x8 pa0, pa1, pa2, pa3;
#define PK4(P, BASE, OUT) do { unsigned a0 = cvtpk(P[BASE + 0], P[BASE + 1]), a1 = cvtpk(P[BASE + 2], P[BASE + 3]);   \
    unsigned b0 = cvtpk(P[BASE + 4], P[BASE + 5]), b1 = cvtpk(P[BASE + 6], P[BASE + 7]);                              \
    auto r0 = __builtin_amdgcn_permlane32_swap(a0, b0, false, false); auto r1 = __builtin_amdgcn_permlane32_swap(a1, b1, false, false); \
    u32x4 w = {r0[0], r1[0], r0[1], r1[1]}; OUT = *reinterpret_cast<bf16x8*>(&w); } while (0)
  PK4(pF0, 0, pa0); PK4(pF0, 8, pa1); PK4(pF1, 0, pa2); PK4(pF1, 8, pa3);
#undef PK4
  bf16x8 vf[4]; v_frags((int)(uintptr_t)(lds + L_V) + v_rd_base(lane) + vblk * 512, vf);
  f32x16 o = {};
  o = __builtin_amdgcn_mfma_f32_32x32x16_bf16(pa0, vf[0], o, 0, 0, 0); o = __builtin_amdgcn_mfma_f32_32x32x16_bf16(pa1, vf[1], o, 0, 0, 0);
  o = __builtin_amdgcn_mfma_f32_32x32x16_bf16(pa2, vf[2], o, 0, 0, 0); o = __builtin_amdgcn_mfma_f32_32x32x16_bf16(pa3, vf[3], o, 0, 0, 0);
#pragma unroll
  for (int ks = 0; ks < 4; ++ks) {
    o = __builtin_amdgcn_mfma_f32_32x32x16_bf16(frag(lds + L_QF, iglob, ks, hi), frag(lds + L_STF, vblk * 32 + r32, ks, hi), o, 0, 0, 0);
    o = __builtin_amdgcn_mfma_f32_32x32x16_bf16(frag(lds + L_QB, iglob, ks, hi), frag(lds + L_STB, vblk * 32 + r32, ks, hi), o, 0, 0, 0); }
  float* RS = (float*)(lds + L_RSUM);
  float ss[16];
#pragma unroll
  for (int r = 0; r < 16; ++r) { float s = o[r] * o[r]; s += __shfl_xor(s, 1); s += __shfl_xor(s, 2); s += __shfl_xor(s, 4); s += __shfl_xor(s, 8); s += __shfl_xor(s, 16); ss[r] = s; }
  if (r32 == 0) {
#pragma unroll
    for (int r = 0; r < 16; ++r) RS[(ib * 4 + vblk) * 32 + crow(r, hi)] = ss[r]; }
  __syncthreads();
  const int v = vblk * 32 + r32;
#pragma unroll
  for (int r = 0; r < 16; ++r) { const int il = crow(r, hi), i = ib * 32 + il;
    const float tot = (RS[(ib * 4 + 0) * 32 + il] + RS[(ib * 4 + 1) * 32 + il]) + (RS[(ib * 4 + 2) * 32 + il] + RS[(ib * 4 + 3) * 32 + il]);
    const float rstd = 1.f / sqrtf(tot * (1.f / 128.f) + RMS_EPS);
    const float rg = bf2f(rgr[r]);
    out[(size_t)(t0 + i) * ldo + hh * 128 + v] = (bf16_t)f2bf(o[r] * rstd * ng * (rg * __builtin_amdgcn_rcpf(1.f + __builtin_amdgcn_exp2f(-1.4426950408889634f * rg)))); }
  __syncthreads();
}
}

__device__ __forceinline__ void ln_core(float4 (&v)[4], const float* g, const float* b, float* out, bf16_t* outb, int lane) {
    float s = 0.f;
#pragma unroll
    for (int j = 0; j < 4; ++j) s += (v[j].x + v[j].y) + (v[j].z + v[j].w);
    const float mean = wave_sum(s) * (1.f / DM); float s2 = 0.f;
#pragma unroll
    for (int j = 0; j < 4; ++j) { v[j].x -= mean; v[j].y -= mean; v[j].z -= mean; v[j].w -= mean; s2 += (v[j].x * v[j].x + v[j].y * v[j].y) + (v[j].z * v[j].z + v[j].w * v[j].w); }
    const float rstd = 1.f / sqrtf(wave_sum(s2) * (1.f / DM) + LN_EPS);
#pragma unroll
    for (int j = 0; j < 4; ++j) {
        const float4 gg = ((const float4*)g)[lane + 64 * j], bb = ((const float4*)b)[lane + 64 * j];
        float4 o; o.x = v[j].x * rstd * gg.x + bb.x; o.y = v[j].y * rstd * gg.y + bb.y; o.z = v[j].z * rstd * gg.z + bb.z; o.w = v[j].w * rstd * gg.w + bb.w;
        ((float4*)out)[lane + 64 * j] = o; v[j] = o;
        if (outb) ((uint2*)outb)[lane + 64 * j] = make_uint2(pk2(o.x, o.y), pk2(o.z, o.w));
    }
}
__device__ __forceinline__ void wave_sum2(float& a, float& b) {
#pragma unroll
    for (int o = 1; o < 64; o <<= 1) { const float ta = __shfl_xor(a, o), tb = __shfl_xor(b, o); a += ta; b += tb; }
}
template <int MODE>
__device__ __forceinline__ void ln_core2(float4 (&v)[2][4], const float* g, const float* b, float* out0, float* out1, bf16_t* ob0, bf16_t* ob1, int lane, unsigned char* o8_0 = nullptr, unsigned char* o8_1 = nullptr) {
    float s[2] = {0.f, 0.f};
#pragma unroll
    for (int u = 0; u < 2; ++u)
#pragma unroll
        for (int j = 0; j < 4; ++j) s[u] += (v[u][j].x + v[u][j].y) + (v[u][j].z + v[u][j].w);
    wave_sum2(s[0], s[1]);
    float q[2] = {0.f, 0.f};
#pragma unroll
    for (int u = 0; u < 2; ++u) { const float mean = s[u] * (1.f / DM);
#pragma unroll
        for (int j = 0; j < 4; ++j) { v[u][j].x -= mean; v[u][j].y -= mean; v[u][j].z -= mean; v[u][j].w -= mean; q[u] += (v[u][j].x * v[u][j].x + v[u][j].y * v[u][j].y) + (v[u][j].z * v[u][j].z + v[u][j].w * v[u][j].w); } }
    wave_sum2(q[0], q[1]);
#pragma unroll
    for (int j = 0; j < 4; ++j) {
        const float4 gg = ((const float4*)g)[lane + 64 * j], bb = ((const float4*)b)[lane + 64 * j];
#pragma unroll
        for (int u = 0; u < 2; ++u) { const float rstd = 1.f / sqrtf(q[u] * (1.f / DM) + LN_EPS);
            float4 o; o.x = v[u][j].x * rstd * gg.x + bb.x; o.y = v[u][j].y * rstd * gg.y + bb.y; o.z = v[u][j].z * rstd * gg.z + bb.z; o.w = v[u][j].w * rstd * gg.w + bb.w;
            v[u][j] = o;
            if constexpr (MODE == 2) ((float4*)(u ? out1 : out0))[lane + 64 * j] = o;
            else ((uint2*)(u ? ob1 : ob0))[lane + 64 * j] = make_uint2(pk2(o.x, o.y), pk2(o.z, o.w));
            if constexpr (MODE == 1) ((unsigned*)(u ? o8_1 : o8_0))[lane + 64 * j] = pk4_fp8(o.x, o.y, o.z, o.w); }
    }
}
__device__ __forceinline__ int block_excl_scan(int x, int* scr, int tid, int& total) {
    const int lane = tid & 63, wid = tid >> 6; int inc = x;
#pragma unroll
    for (int o = 1; o < 64; o <<= 1) { const int y = __shfl_up(inc, o); if (lane >= o) inc += y; }
    __syncthreads();
    if (lane == 63) scr[wid] = inc;
    __syncthreads();
    int base = 0, tot = 0;
#pragma unroll
    for (int w = 0; w < 8; ++w) { const int c = scr[w]; base += (w < wid) ? c : 0; tot += c; }
    total = tot; return base + inc - x;
}

__device__ __forceinline__ void tb_load(float (&v)[32], const float* Wblk, int ldw, int lane) {
#pragma unroll
    for (int i = 0; i < 32; ++i) v[i] = __builtin_nontemporal_load(&Wblk[(size_t)(2 * i + (lane >> 5)) * ldw + (lane & 31)]);
}
__device__ __forceinline__ void tb_store(const float (&v)[32], bf16_t* dst, int ldt, float* scr, int lane) {
#pragma unroll
    for (int i = 0; i < 32; ++i) scr[(2 * i + (lane >> 5)) * 33 + (lane & 31)] = v[i];
    asm volatile("s_waitcnt lgkmcnt(0)" ::: "memory");
    const int c = lane & 7;
#pragma unroll
    for (int j = 0; j < 4; ++j) { const int n = (lane >> 3) + 8 * j; const float* s = scr + (8 * c) * 33 + n;
        uint4 o; o.x = pk2(s[0 * 33], s[1 * 33]); o.y = pk2(s[2 * 33], s[3 * 33]); o.z = pk2(s[4 * 33], s[5 * 33]); o.w = pk2(s[6 * 33], s[7 * 33]);
        *(uint4*)(dst + (size_t)n * ldt + 8 * c) = o; }
    asm volatile("s_waitcnt lgkmcnt(0)" ::: "memory");
}

__device__ __forceinline__ void tb_store8(const float (&v)[32], unsigned char* dst, int ldt, float sc, float* scr, int lane) {
#pragma unroll
    for (int i = 0; i < 32; ++i) scr[(2 * i + (lane >> 5)) * 33 + (lane & 31)] = v[i];
    asm volatile("s_waitcnt lgkmcnt(0)" ::: "memory");
    const int c = lane & 7;
#pragma unroll
    for (int j = 0; j < 4; ++j) { const int n = (lane >> 3) + 8 * j; const float* s = scr + (8 * c) * 33 + n;
        *(uint2*)(dst + (size_t)n * ldt + 8 * c) = make_uint2(pk4_fp8(s[0 * 33] * sc, s[1 * 33] * sc, s[2 * 33] * sc, s[3 * 33] * sc), pk4_fp8(s[4 * 33] * sc, s[5 * 33] * sc, s[6 * 33] * sc, s[7 * 33] * sc)); }
    asm volatile("s_waitcnt lgkmcnt(0)" ::: "memory");
}

__device__ __forceinline__ void ln_row(const float* a, const float* add, float alpha, const float* g, const float* b, float* out, int lane, float4 (&v)[4], bf16_t* outb = nullptr) {
    float s = 0.f;
#pragma unroll
    for (int j = 0; j < 4; ++j) {
        float4 x = ((const float4*)a)[lane + 64 * j];
        x.x *= alpha; x.y *= alpha; x.z *= alpha; x.w *= alpha;
        if (add) { const float4 y = ((const float4*)add)[lane + 64 * j]; x.x += y.x; x.y += y.y; x.z += y.z; x.w += y.w; }
        v[j] = x; s += (x.x + x.y) + (x.z + x.w);
    }
    const float mean = wave_sum(s) * (1.f / DM); float s2 = 0.f;
#pragma unroll
    for (int j = 0; j < 4; ++j) { v[j].x -= mean; v[j].y -= mean; v[j].z -= mean; v[j].w -= mean; s2 += (v[j].x * v[j].x + v[j].y * v[j].y) + (v[j].z * v[j].z + v[j].w * v[j].w); }
    const float rstd = 1.f / sqrtf(wave_sum(s2) * (1.f / DM) + LN_EPS);
#pragma unroll
    for (int j = 0; j < 4; ++j) {
        const float4 gg = ((const float4*)g)[lane + 64 * j], bb = ((const float4*)b)[lane + 64 * j];
        float4 o; o.x = v[j].x * rstd * gg.x + bb.x; o.y = v[j].y * rstd * gg.y + bb.y; o.z = v[j].z * rstd * gg.z + bb.z; o.w = v[j].w * rstd * gg.w + bb.w;
        if (out) ((float4*)out)[lane + 64 * j] = o; v[j] = o;
        if (outb) ((uint2*)outb)[lane + 64 * j] = make_uint2(pk2(o.x, o.y), pk2(o.z, o.w));
    }
}

struct GemmP {
    const float* A; const int* ridx; const float* Bm; float* C;
    int lda, ldb, ldc, M, N, K, nb, bshift;
    long sA, sB, sC; int sR;
    const float* aux; const bf16_t* auxb; int ldaux; long sAux; const float* aux2; int accum;
};
template <int MODE>
__device__ __forceinline__ void gemm_naive(const GemmP g, float* lds) {
    float (*As)[132] = (float (*)[132])lds;
    float (*Bs)[128] = (float (*)[128])(lds + 16 * 132);
    int tid_ = threadIdx.x; asm volatile("" : "+v"(tid_));
    const int tid = tid_, ty = tid >> 4, tx = tid & 15;
    const int mt = g.M / 128, nt = (g.N + 127) / 128, per = mt * nt, total = per * g.nb;
    int bid_ = blockIdx.x; asm volatile("" : "+s"(bid_));
    for (int tile = bid_; tile < total; tile += gridDim.x) {
        const int z = tile / per, r = tile % per, tm = r / nt, tn = r % nt;
        const int m0 = tm * 128, n0 = tn * 128;
        const float* Bz = g.Bm + (long)(z >> g.bshift) * g.sB;
        float* Cz = g.C + (long)z * g.sC;
        const int arow = m0 + (tid >> 2);
        const long grow = g.ridx ? (long)g.ridx[z * g.sR + arow] : (long)arow;
        const float* Arow = g.A + (long)z * g.sA + grow * g.lda + (tid & 3) * 4;
        const int bk = tid >> 5, bn = n0 + (tid & 31) * 4;
        const bool bok = bn < g.N;
        const float* Bp = Bz + (long)bk * g.ldb + bn;
        float acc[4][8];
#pragma unroll
        for (int i = 0; i < 4; ++i)
#pragma unroll
            for (int j = 0; j < 8; ++j) acc[i][j] = 0.f;
        float4 ra = *(const float4*)(Arow);
        float4 rb = bok ? *(const float4*)(Bp) : make_float4(0.f, 0.f, 0.f, 0.f);
        for (int k0 = 0; k0 < g.K; k0 += 16) {
            __syncthreads();
            { const int rr = tid >> 2, k4 = (tid & 3) * 4; As[k4][rr] = ra.x; As[k4 + 1][rr] = ra.y; As[k4 + 2][rr] = ra.z; As[k4 + 3][rr] = ra.w; }
            *(float4*)&Bs[bk][(tid & 31) * 4] = rb;
            __syncthreads();
            if (k0 + 16 < g.K) {
                ra = *(const float4*)(Arow + k0 + 16);
                rb = bok ? *(const float4*)(Bp + (long)(k0 + 16) * g.ldb) : make_float4(0.f, 0.f, 0.f, 0.f);
            }
#pragma unroll
            for (int k = 0; k < 16; ++k) {
                const float4 a = *(const float4*)&As[k][ty * 4];
                const float4 b0 = *(const float4*)&Bs[k][tx * 8], b1 = *(const float4*)&Bs[k][tx * 8 + 4];
                const float av[4] = {a.x, a.y, a.z, a.w};
                const float bv[8] = {b0.x, b0.y, b0.z, b0.w, b1.x, b1.y, b1.z, b1.w};
#pragma unroll
                for (int i = 0; i < 4; ++i)
#pragma unroll
                    for (int j = 0; j < 8; ++j) acc[i][j] = fmaf(av[i], bv[j], acc[i][j]);
            }
        }
#pragma unroll
        for (int i = 0; i < 4; ++i) {
            const int row = m0 + ty * 4 + i;
#pragma unroll
            for (int jv = 0; jv < 2; ++jv) {
                const int col = n0 + tx * 8 + jv * 4;
                if (col < g.N) {
                    float v[4] = {acc[i][jv * 4], acc[i][jv * 4 + 1], acc[i][jv * 4 + 2], acc[i][jv * 4 + 3]};
                    float* cp = Cz + (long)row * g.ldc + col;
                    if (MODE == 1) {
#pragma unroll
                        for (int q = 0; q < 4; ++q) v[q] *= g.aux[(long)z * g.sAux + col + q];
                    } else if (MODE == 2) {
                        float gl[4]; ld4bf(g.auxb + (long)row * g.ldaux + col, gl); const float4 gb = *(const float4*)(g.aux2 + col);
                        const float gv[4] = {gl[0] + gb.x, gl[1] + gb.y, gl[2] + gb.z, gl[3] + gb.w};
                        float4 old = make_float4(0.f, 0.f, 0.f, 0.f);
                        if (g.accum) old = *(const float4*)cp;
                        const float ov[4] = {old.x, old.y, old.z, old.w};
#pragma unroll
                        for (int q = 0; q < 4; ++q) v[q] = ov[q] + sigmoidf_(gv[q]) * v[q];
                    } else if (MODE == 3) {
                        const float4 old = *(const float4*)cp; const float ov[4] = {old.x, old.y, old.z, old.w};
#pragma unroll
                        for (int q = 0; q < 4; ++q) v[q] = siluf_(ov[q]) * v[q];
                    } else if (MODE == 4) {
                        const float rs = g.aux[(long)z * g.sAux + row];
#pragma unroll
                        for (int q = 0; q < 4; ++q) v[q] *= rs;
                    }
                    *(float4*)cp = make_float4(v[0], v[1], v[2], v[3]);
                }
            }
        }
    }
    __syncthreads();
}

#define W_IN(l)    (p.in[4]  + (size_t)(l) * DM * DIN)
#define B_GATE(l)  (p.in[5]  + (size_t)(l) * 3 * DM)
#define POOL_W(l)  (p.in[6]  + (size_t)(l) * 4 * 128 * 128)
#define POOL_S(l)  (p.in[7]  + (size_t)(l) * 512)
#define W_UP_A(l)  (p.in[8]  + (size_t)(l) * 512 * DM)
#define Q_NORM(l)  (p.in[9]  + (size_t)(l) * 384)
#define W_UQ(l)    (p.in[10] + (size_t)(l) * 384 * 768)
#define KV_NORM(l) (p.in[11] + (size_t)(l) * 256)
#define W_UKV(l)   (p.in[12] + (size_t)(l) * 256 * 1024)
#define W_UP_B(l)  (p.in[13] + (size_t)(l) * 512 * DM)
#define W_DEC(l)   (p.in[14] + (size_t)(l) * 2 * 16 * 256)
#define B_DEC(l)   (p.in[15] + (size_t)(l) * 2 * 256)
#define GLA_NORM(l)(p.in[16] + (size_t)(l) * 128)
#define W_UP_C(l)  (p.in[17] + (size_t)(l) * 512 * DM)
#define W_OUT(l)   (p.in[18] + (size_t)(l) * DM * DM)
#define LN1_G(l)   (p.in[19] + (size_t)(l) * DM)
#define LN1_B(l)   (p.in[20] + (size_t)(l) * DM)
#define ROUTER(l)  (p.in[21] + (size_t)(l) * DM * NE)
#define EW_GATE(l) (p.in[22] + (size_t)(l) * NE * DM * DEXP)
#define EW_UP(l)   (p.in[23] + (size_t)(l) * NE * DM * DEXP)
#define EW_DOWN(l) (p.in[24] + (size_t)(l) * NE * DEXP * DM)
#define LN2_G(l)   (p.in[25] + (size_t)(l) * DM)
#define LN2_B(l)   (p.in[26] + (size_t)(l) * DM)
#define WSF(off) ((float*)(p.ws + (off)))
#define WSI(off) ((int*)(p.ws + (off)))
#define WSB(off) ((bf16_t*)(p.ws + (off)))
#define PJ(t, c) bf2f(projb[(size_t)(t) * DINP + (c)])

enum Stage {
    ST_INIT = 0,
    ST_WCONV,
    ST_PROJ,
    ST_PREP,
    ST_SMALLGEMM,
    ST_ROPE,
    ST_ATTN,
    ST_GLA1, ST_GLA2, ST_GLA3,
    ST_GLAFIN,
    ST_MERGE_A, ST_MERGE_B, ST_MERGE_C,
    ST_OUTP,
    ST_LN1,
    ST_TOPK,
    ST_GATHER,
    ST_EXP_G, ST_EXP_U, ST_EXP_D,
    ST_LN2,
    ST_COUNT
};

#define KAS __attribute__((address_space(4)))
template <int ST>
__device__ __forceinline__ void run_stage(int l, float* lds) {
    const KAS Params* pk_ = (const KAS Params*)__builtin_amdgcn_kernarg_segment_ptr(); asm volatile("" : "+s"(pk_));
    const KAS Params& p = *pk_;
    int tid_ = threadIdx.x; asm volatile("" : "+v"(tid_));
    int bid_ = blockIdx.x; asm volatile("" : "+s"(bid_));
    const int tid = tid_, lane = tid & 63, wid = tid >> 6;
    const int G = gridDim.x, bid = bid_;
    const int gw = bid * 8 + wid, NGW = G * 8;
    const long gt = (long)bid * NTHR + tid, NGT = (long)G * NTHR;
    float* h = p.out;

    if constexpr (ST == ST_INIT) {
        for (int m0 = gw; m0 < T; m0 += 2 * NGW) {
            const int mr[2] = {m0, m0 + NGW}; float4 a[2][4];
#pragma unroll
            for (int u = 0; u < 2; ++u)
#pragma unroll
                for (int j = 0; j < 4; ++j) a[u][j] = ((const float4*)(p.in[0] + (size_t)mr[u] * DM))[lane + 64 * j];
            ln_core2<0>(a, p.in[2], p.in[3], nullptr, nullptr, WSB(WS_HB) + (size_t)mr[0] * DM, WSB(WS_HB) + (size_t)mr[1] * DM, lane);
        }
        {
            float* scr = lds + wid * 4096;
            constexpr int NBLK = DIN / 32, ITEMS_L = (DM / 64) * NBLK;
            {
#define WIN_ITEM(it, W, dst) do { const int ll_ = (it) / ITEMS_L, r_ = (it) % ITEMS_L, kb_ = r_ / NBLK, nb_ = r_ % NBLK; const int n0_ = 32 * nb_, drow_ = n0_ < 2752 ? n0_ + 3072 : n0_ - 2752; \
                    W = p.in[4] + (size_t)ll_ * DM * DIN + (size_t)(64 * kb_) * DIN + n0_; dst = WSB(WS_WIN_T) + (size_t)ll_ * DINP * DM + (size_t)drow_ * DM + 64 * kb_; } while (0)
                float va[32], vb[32]; const float* Wa = nullptr; const float* Wb = nullptr; bf16_t* da = nullptr; bf16_t* db = nullptr;
                int itA = gw, itB = gw + NGW;
                if (itA < 2 * ITEMS_L) { WIN_ITEM(itA, Wa, da); tb_load(va, Wa, DIN, lane); }
                while (itA < 2 * ITEMS_L) {
                    if (itB < 2 * ITEMS_L) { WIN_ITEM(itB, Wb, db); tb_load(vb, Wb, DIN, lane); }
                    tb_store(va, da, DM, scr, lane);
                    itA = itB + NGW;
                    if (itB >= 2 * ITEMS_L) break;
                    if (itA < 2 * ITEMS_L) { WIN_ITEM(itA, Wa, da); tb_load(va, Wa, DIN, lane); }
                    tb_store(vb, db, DM, scr, lane);
                    itB = itA + NGW;
                }
#undef WIN_ITEM
            }
            {
                constexpr int I_UQ = 6 * 24, I_UKV = 4 * 32, I_B = 8 * 32, I_OUT = 16 * 32, I_L = I_UQ + I_UKV + 2 * I_B + I_OUT;
                for (int it = gw; it < 2 * I_L; it += NGW) {
                    const int ll = it / I_L; int r = it % I_L; bf16_t* wsm = WSB(WS_WSMALL + (size_t)ll * WSM_STRIDE);
                    if (r < I_UQ) { const int kb = r / 24, nb = r % 24; transpose_block(p.in[10] + (size_t)ll * 384 * 768 + (size_t)(64 * kb) * 768 + 32 * nb, 768, wsm + WSM_UQ / 2 + (size_t)(32 * nb) * 384 + 64 * kb, 384, p.in[9] + ll * 384 + 64 * kb, nullptr, scr, lane); continue; } r -= I_UQ;
                    if (r < I_UKV) { const int kb = r / 32, nb = r % 32; transpose_block(p.in[12] + (size_t)ll * 256 * 1024 + (size_t)(64 * kb) * 1024 + 32 * nb, 1024, wsm + WSM_UKV / 2 + (size_t)(32 * nb) * 256 + 64 * kb, 256, p.in[11] + ll * 256 + 64 * kb, nullptr, scr, lane); continue; } r -= I_UKV;
                    if (r < 2 * I_B) { const int c = r / I_B, rr = r % I_B, kb = rr / 32, nb = rr % 32; const float* W = (c ? p.in[17] : p.in[13]) + (size_t)ll * 512 * DM;
                        transpose_block(W + (size_t)(64 * kb) * DM + 32 * nb, DM, wsm + WSM_MRG / 2 + (size_t)(32 * nb) * 1536 + 512 * (1 + c) + 64 * kb, 1536, nullptr, nullptr, scr, lane); continue; } r -= 2 * I_B;
                    { const int kb = r / 32, nb = r % 32; transpose_block(p.in[18] + (size_t)ll * DM * DM + (size_t)(64 * kb) * DM + 32 * nb, DM, wsm + WSM_OUT / 2 + (size_t)(32 * nb) * DM + 64 * kb, DM, nullptr, nullptr, scr, lane); }
                }
                {
                    float* At = lds; float* Bs = lds + 128 * 129;
                    for (int it = bid; it < 2 * 4 * 32; it += G) {
                        const int ll = it >> 7, g = (it >> 5) & 3, db = it & 31;
                        const float* pw = p.in[6] + (size_t)ll * 4 * 128 * 128 + (size_t)g * 128 * 128; const float* ps = p.in[7] + ll * 512 + g * 128;
                        const float* wa = p.in[8] + (size_t)ll * 512 * DM + (size_t)(g * 128) * DM + db * 32;
                        __syncthreads();
                        for (int e = tid; e < 128 * 128; e += NTHR) { const int c = e >> 7, cp = e & 127; At[cp * 129 + c] = pw[e] * ps[cp]; }
                        for (int e = tid; e < 128 * 32; e += NTHR) { const int cp = e >> 5, dd = e & 31; Bs[cp * 32 + dd] = wa[(size_t)cp * DM + dd]; }
                        __syncthreads();
                        const int c = tid >> 2, d0 = (tid & 3) * 8;
                        float a0 = 0.f, a1 = 0.f, a2 = 0.f, a3 = 0.f, a4 = 0.f, a5 = 0.f, a6 = 0.f, a7 = 0.f;
#pragma unroll 8
                        for (int cp = 0; cp < 128; ++cp) { const float a = At[cp * 129 + c]; const float4 b0 = *(const float4*)(Bs + cp * 32 + d0), b1 = *(const float4*)(Bs + cp * 32 + d0 + 4);
                            a0 = fmaf(a, b0.x, a0); a1 = fmaf(a, b0.y, a1); a2 = fmaf(a, b0.z, a2); a3 = fmaf(a, b0.w, a3); a4 = fmaf(a, b1.x, a4); a5 = fmaf(a, b1.y, a5); a6 = fmaf(a, b1.z, a6); a7 = fmaf(a, b1.w, a7); }
                        bf16_t* o = WSB(WS_WSMALL + (size_t)ll * WSM_STRIDE + WSM_MRG) + (size_t)(db * 32 + d0) * 1536 + g * 128 + c;
                        o[0] = (bf16_t)f2bf(a0); o[1536] = (bf16_t)f2bf(a1); o[2 * 1536] = (bf16_t)f2bf(a2); o[3 * 1536] = (bf16_t)f2bf(a3);
                        o[4 * 1536] = (bf16_t)f2bf(a4); o[5 * 1536] = (bf16_t)f2bf(a5); o[6 * 1536] = (bf16_t)f2bf(a6); o[7 * 1536] = (bf16_t)f2bf(a7);
                    }
                    __syncthreads();
                }
            }
            for (long i = gt; i < 2L * 64 * DM / 8; i += NGT) { const int ll = (int)(i / (64 * DM / 8)); const long r = i % (64 * DM / 8);
                *(uint4*)(WSB(WS_WIN_T) + (size_t)ll * DINP * DM + (size_t)DIN * DM + r * 8) = make_uint4(0u, 0u, 0u, 0u); }
        }
        float* rc = WSF(WS_ROPE); float* rs = rc + T * 16;
        for (long i = gt; i < (long)T * 16; i += NGT) {
            const int t = (int)(i >> 4), j = (int)(i & 15);
            const float freq = powf(10000.0f, -(float)j / 16.0f);
            const float ang = (float)p.pos[t] * freq;
            rc[i] = cosf(ang); rs[i] = sinf(ang);
        }
    }
    if constexpr (ST == ST_WCONV) {
        float* scr = lds + wid * 4096;
        constexpr int I_G = 16 * 16 * 64, I_D = 16 * 32 * 32;
        constexpr int I_ALL = 2 * I_G + I_D;
#define WCONV_ITEM(it, W, ldw, dst, ldt, sc8) do { if ((it) < 2 * I_G) { const int up_ = (it) >= I_G, r_ = up_ ? (it) - I_G : (it), e_ = r_ >> 10, kb_ = (r_ >> 6) & 15, nb_ = r_ & 63, j0_ = nb_ * 32; \
            W = (up_ ? EW_UP(l) : EW_GATE(l)) + (size_t)e_ * DM * DEXP + (size_t)(64 * kb_) * DEXP + j0_; ldw = DEXP; \
            dst = (unsigned char*)(p.ws + WS_WGU_T) + (size_t)(e_ * 4096 + 256 * (j0_ >> 7) + (j0_ & 127) + (up_ ? 128 : 0)) * DM + 64 * kb_; ldt = DM; sc8 = F8_WGU; } \
          else { const int r_ = (it) - 2 * I_G, e_ = r_ >> 10, kb_ = (r_ >> 5) & 31, nb_ = r_ & 31; \
            W = EW_DOWN(l) + (size_t)e_ * DEXP * DM + (size_t)(64 * kb_) * DM + 32 * nb_; ldw = DM; dst = (unsigned char*)(p.ws + WS_WD_T) + (size_t)(e_ * 1024 + 32 * nb_) * DEXP + 64 * kb_; ldt = DEXP; sc8 = F8_WD; } } while (0)
        float va[32], vb[32]; const float* Wa = nullptr; const float* Wb = nullptr; unsigned char* da = nullptr; unsigned char* db = nullptr; int lwa = 0, lwb = 0, lta = 0, ltb = 0; float sa = 1.f, sb = 1.f;
        int itA = gw, itB = gw + NGW;
        if (itA < I_ALL) { WCONV_ITEM(itA, Wa, lwa, da, lta, sa); tb_load(va, Wa, lwa, lane); }
        while (itA < I_ALL) {
            if (itB < I_ALL) { WCONV_ITEM(itB, Wb, lwb, db, ltb, sb); tb_load(vb, Wb, lwb, lane); }
            tb_store8(va, da, lta, sa, scr, lane);
            itA = itB + NGW;
            if (itB >= I_ALL) break;
            if (itA < I_ALL) { WCONV_ITEM(itA, Wa, lwa, da, lta, sa); tb_load(va, Wa, lwa, lane); }
            tb_store8(vb, db, ltb, sb, scr, lane);
            itB = itA + NGW;
        }
#undef WCONV_ITEM
        __syncthreads();
    }
    if constexpr (ST == ST_PROJ) {
        pg8::Gemm g{WSB(WS_HB), WSB(WS_WIN_T) + (size_t)l * DINP * DM, T, DINP, DM, DM};
        pg8::StaticOrder S; S.init(T, DINP, G, bid);
        EpiProj E{WSB(WS_PROJB), B_GATE(l)};
        pg8::gemm_phase<EpiProj, pg8::StaticOrder, true, true>((PG8_LAS unsigned char*)lds, g, S, E);
    }
    if constexpr (ST == ST_PREP) {
        const bf16_t* projb = WSB(WS_PROJB); bf16_t* br = WSB(WS_BR); bf16_t* U = (bf16_t*)lds;
        float* rq = WSF(WS_RQ); float* rkv = rq + T; const float* rc = WSF(WS_ROPE); const float* rs = rc + T * 16; bf16_t* kb = WSB(WS_KB);
        for (int tile = bid; tile < T / 64; tile += G) {
            const int b = tile / (SEQ / 64), s0 = (tile % (SEQ / 64)) * 64, t0 = b * SEQ + s0;
            __syncthreads();
#pragma unroll
            for (int it = 0; it < 10; ++it) { const int e = tid + it * NTHR, r = e >> 6, ch = e & 63, s = s0 - 8 + r;
                uint4 v = make_uint4(0u, 0u, 0u, 0u);
                if (s >= 0 && s < SEQ) v = *(const uint4*)(projb + (size_t)(b * SEQ + s) * DINP + OFF_POOL + ch * 8);
                *(uint4*)(U + r * 512 + ch * 8) = v; }
            for (int r = wid; r < 64; r += 8) { const bf16_t* row = projb + (size_t)(t0 + r) * DINP;
                float s1 = 0.f, s2 = 0.f;
                if (lane < 48) { const uint4 w = *(const uint4*)(row + OFF_CQ + lane * 8); const unsigned ww[4] = {w.x, w.y, w.z, w.w};
#pragma unroll
                    for (int q = 0; q < 4; ++q) { const float a = __uint_as_float(ww[q] << 16), c = __uint_as_float(ww[q] & 0xffff0000u); s1 += a * a + c * c; } }
                if (lane < 32) { const uint4 w = *(const uint4*)(row + OFF_CKV + lane * 8); const unsigned ww[4] = {w.x, w.y, w.z, w.w};
#pragma unroll
                    for (int q = 0; q < 4; ++q) { const float a = __uint_as_float(ww[q] << 16), c = __uint_as_float(ww[q] & 0xffff0000u); s2 += a * a + c * c; } }
                s1 = wave_sum(s1); s2 = wave_sum(s2);
                if (lane == 0) { rq[t0 + r] = 1.f / sqrtf(s1 * (1.f / 384.f) + RMS_EPS); rkv[t0 + r] = 1.f / sqrtf(s2 * (1.f / 256.f) + RMS_EPS); } }
#pragma unroll
            for (int it = 0; it < 2; ++it) { const int e = tid + it * NTHR, r = e >> 4, j = e & 15, t = t0 + r;
                const float c = rc[(size_t)t * 16 + j], s = rs[(size_t)t * 16 + j], x1 = PJ(t, OFF_KR + j), x2 = PJ(t, OFF_KR + 16 + j);
                const bf16_t k1 = (bf16_t)f2bf(x1 * c - x2 * s), k2 = (bf16_t)f2bf(x1 * s + x2 * c);
#pragma unroll
                for (int hh = 0; hh < 8; ++hh) { kb[(size_t)t * 768 + hh * 96 + 64 + j] = k1; kb[(size_t)t * 768 + hh * 96 + 80 + j] = k2; } }
            __syncthreads();
            { const int cp = tid & 255, half = tid >> 8, c0 = 2 * cp, hw = 1 << (c0 >> 7), sb = s0 + 32 * half;
              const unsigned* U32 = (const unsigned*)U;
              bf16_t* orow = br + (size_t)(b * SEQ + sb) * 1536 + c0;
              float sx = 0.f, sy = 0.f;
              if (s0 >= 8 && s0 + 72 <= SEQ) {
                  for (int u = sb - hw; u < sb + hw; ++u) { const unsigned w = U32[(u - s0 + 8) * 256 + cp]; sx += __uint_as_float(w << 16); sy += __uint_as_float(w & 0xffff0000u); }
                  const float inv = 1.f / (float)(2 * hw);
#pragma unroll 8
                  for (int k = 0; k < 32; ++k) { const int r = sb + k - s0 + 8;
                      const unsigned wc = U32[r * 256 + cp], wa = U32[(r + hw) * 256 + cp], wb = U32[(r - hw) * 256 + cp];
                      *(unsigned*)(orow + (size_t)k * 1536) = pk2(sx * inv - __uint_as_float(wc << 16), sy * inv - __uint_as_float(wc & 0xffff0000u));
                      sx += __uint_as_float(wa << 16); sy += __uint_as_float(wa & 0xffff0000u); sx -= __uint_as_float(wb << 16); sy -= __uint_as_float(wb & 0xffff0000u); }
              } else {
                  for (int u = sb - hw; u < sb + hw; ++u) if (u >= 0 && u < SEQ) { const unsigned w = U32[(u - s0 + 8) * 256 + cp]; sx += __uint_as_float(w << 16); sy += __uint_as_float(w & 0xffff0000u); }
                  for (int k = 0; k < 32; ++k) { const int s = sb + k;
                      int lo = s - hw; if (lo < 0) lo = 0; int hi = s + hw; if (hi > SEQ) hi = SEQ;
                      const float inv = 1.f / (float)(hi - lo); const unsigned wc = U32[(s - s0 + 8) * 256 + cp];
                      *(unsigned*)(orow + (size_t)k * 1536) = pk2(sx * inv - __uint_as_float(wc << 16), sy * inv - __uint_as_float(wc & 0xffff0000u));
                      if (s + hw < SEQ) { const unsigned w = U32[(s + hw - s0 + 8) * 256 + cp]; sx += __uint_as_float(w << 16); sy += __uint_as_float(w & 0xffff0000u); }
                      if (s - hw >= 0) { const unsigned w = U32[(s - hw - s0 + 8) * 256 + cp]; sx -= __uint_as_float(w << 16); sy -= __uint_as_float(w & 0xffff0000u); } }
              } }
        }
        __syncthreads();
    }
    if constexpr (ST == ST_SMALLGEMM) {
        const bf16_t* wsm = WSB(WS_WSMALL + (size_t)l * WSM_STRIDE);
        { pg8::Gemm g{WSB(WS_PROJB) + OFF_CQ, wsm + WSM_UQ / 2, T, 768, 384, DINP}; pg8::StaticOrder S; S.init(T, 768, G, bid);
          EpiQ E{WSB(WS_QB), WSF(WS_RQ), WSF(WS_ROPE), WSF(WS_ROPE) + T * 16}; pg8::gemm_phase<EpiQ, pg8::StaticOrder, true, true>((PG8_LAS unsigned char*)lds, g, S, E); }
        { pg8::Gemm g{WSB(WS_PROJB) + OFF_CKV, wsm + WSM_UKV / 2, T, 1024, 256, DINP}; pg8::StaticOrder S; S.init(T, 1024, G, bid);
          EpiKV E{WSB(WS_KB), WSB(WS_VB), WSF(WS_RQ) + T}; pg8::gemm_phase<EpiKV, pg8::StaticOrder, true, true>((PG8_LAS unsigned char*)lds, g, S, E); }
    }
    if constexpr (ST == ST_ATTN) {
        const int vcu = (G % 8 == 0) ? (bid % 8) * (G / 8) + bid / 8 : bid;
        WStream wst; wst.gate = EW_GATE(l); wst.up = EW_UP(l); wst.down = EW_DOWN(l); wst.wgu_t = p.ws + WS_WGU_T; wst.wd_t = p.ws + WS_WD_T;
        { const int wu = __builtin_amdgcn_readfirstlane(wid); wst.init(bid * 8 + wu, NGW, (char*)lds + att::SHM_ATTN + wu * 2560, lane); }
        for (int L = vcu; L < NB * 8 * 32; L += G) {
            const int bh = L >> 5, qb = L & 31, b = bh >> 3, hh = bh & 7;
            att::attn_unit(WSB(WS_QB) + (size_t)(b * SEQ + qb * 256) * 768 + hh * 96, WSB(WS_KB) + (size_t)(b * SEQ) * 768 + hh * 96, WSB(WS_VB) + (size_t)(b * SEQ) * 512 + hh * 64,
                           WSB(WS_BR) + (size_t)(b * SEQ + qb * 256) * 1536 + 512 + hh * 64, SEQ, (char*)lds, wst);
        }
        while (wst.step <= wst.nsteps) wst.tick(lane);
        __syncthreads();
    }
    if constexpr (ST == ST_GLA1) {
        for (int item = bid; item < NB * 4 * 128; item += G) {
            const int b = item >> 9, hh = (item >> 7) & 3, c = item & 127;
            gla::g1_item((char*)lds, WSB(WS_PROJB), W_DEC(l), B_DEC(l), b, hh, c, WSF(WS_KVT), WSF(WS_DEC));
        }
    }
    if constexpr (ST == ST_GLA2) {
        const float* kvt = WSF(WS_KVT); const float* dec = WSF(WS_DEC); bf16_t* stp = WSB(WS_ST);
        for (long e = gt; e < 2L * 8 * 8192; e += NGT) {
            const int dir = (int)(e >> 16), bh = (int)((e >> 13) & 7), vd = (int)(e & 8191), d = vd & 63;
            const long base = ((long)dir * 8 + bh) * 128;
            float s = 0.f;
#pragma unroll 1
            for (int k0 = 0; k0 < 128; k0 += 32) {
                float kv[32], dc[32];
#pragma unroll
                for (int k = 0; k < 32; ++k) { const int c = dir ? 127 - (k0 + k) : k0 + k; kv[k] = kvt[(base + c) * 8192 + vd]; dc[k] = dec[(base + c) * 64 + d]; }
#pragma unroll
                for (int k = 0; k < 32; ++k) { const int c = dir ? 127 - (k0 + k) : k0 + k; stp[(base + c) * 8192 + vd] = (bf16_t)f2bf(s); s = fmaf(dc[k], s, kv[k]); }
            }
        }
    }
    if constexpr (ST == ST_GLA3) {
        for (int item = bid; item < NB * 4 * 128; item += G) {
            const int b = item >> 9, hh = (item >> 7) & 3, c = item & 127;
            gla::g3_item((char*)lds, WSB(WS_PROJB), W_DEC(l), B_DEC(l), GLA_NORM(l), b, hh, c, WSB(WS_ST), WSB(WS_BR) + 1024, 1536);
        }
    }
    if constexpr (ST == ST_MERGE_A) {
        const bf16_t* wsm = WSB(WS_WSMALL + (size_t)l * WSM_STRIDE);
        pg8::Gemm g{WSB(WS_BR), wsm + WSM_MRG / 2, T, DM, 1536, 1536}; pg8::StaticOrder S; S.init(T, DM, G, bid);
        EpiMerge E{WSB(WS_MERGEDB), WSB(WS_PROJB) + OFF_GATE};
        pg8::gemm_phase<EpiMerge, pg8::StaticOrder, true, true>((PG8_LAS unsigned char*)lds, g, S, E);
    }
    if constexpr (ST == ST_OUTP) {
        const bf16_t* wsm = WSB(WS_WSMALL + (size_t)l * WSM_STRIDE);
        pg8::Gemm g{WSB(WS_MERGEDB), wsm + WSM_OUT / 2, T, DM, DM, DM}; pg8::StaticOrder S; S.init(T, DM, G, bid);
        pg8::EpiBf16<0> E{WSB(WS_TMP), DM, nullptr, 0, 0, 1.f};
        pg8::gemm_phase<pg8::EpiBf16<0>, pg8::StaticOrder, true, true>((PG8_LAS unsigned char*)lds, g, S, E);
    }
    if constexpr (ST == ST_LN1) {
        float* RWT = lds; const float* rw = ROUTER(l);
        for (int i = tid; i < DM * 4; i += NTHR) { const int k = i >> 2, e4 = (i & 3) * 4; const float4 w = *(const float4*)(rw + (size_t)k * 16 + e4);
            RWT[(e4 + 0) * DM + k] = w.x; RWT[(e4 + 1) * DM + k] = w.y; RWT[(e4 + 2) * DM + k] = w.z; RWT[(e4 + 3) * DM + k] = w.w; }
        __syncthreads();
        float* afft = WSF(WS_AFF);
        for (int m0 = gw; m0 < T; m0 += 2 * NGW) {
            const int mr[2] = {m0, m0 + NGW};
            float4 hv[2][4];
#pragma unroll
            for (int u = 0; u < 2; ++u) { const bf16_t* hr = WSB(WS_HB) + (size_t)mr[u] * DM; const bf16_t* tr = WSB(WS_TMP) + (size_t)mr[u] * DM;
#pragma unroll
                for (int j = 0; j < 4; ++j) { float a[4], t4[4]; ld4bf(hr + 4 * (lane + 64 * j), a); ld4bf(tr + 4 * (lane + 64 * j), t4);
                    hv[u][j] = make_float4(fmaf(ALPHA, a[0], t4[0]), fmaf(ALPHA, a[1], t4[1]), fmaf(ALPHA, a[2], t4[2]), fmaf(ALPHA, a[3], t4[3])); } }
            ln_core2<1>(hv, LN1_G(l), LN1_B(l), nullptr, nullptr, WSB(WS_HB) + (size_t)mr[0] * DM, WSB(WS_HB) + (size_t)mr[1] * DM, lane,
                     p.ws + WS_HB8 + (size_t)mr[0] * DM, p.ws + WS_HB8 + (size_t)mr[1] * DM);
            float acc[2][16];
#pragma unroll
            for (int e = 0; e < 16; ++e) { float a0 = 0.f, a1 = 0.f;
#pragma unroll
                for (int j = 0; j < 4; ++j) { const float4 w = *(const float4*)(RWT + e * DM + 4 * (lane + 64 * j));
                    a0 = fmaf(hv[0][j].x, w.x, a0); a0 = fmaf(hv[0][j].y, w.y, a0); a0 = fmaf(hv[0][j].z, w.z, a0); a0 = fmaf(hv[0][j].w, w.w, a0);
                    a1 = fmaf(hv[1][j].x, w.x, a1); a1 = fmaf(hv[1][j].y, w.y, a1); a1 = fmaf(hv[1][j].z, w.z, a1); a1 = fmaf(hv[1][j].w, w.w, a1); }
                acc[0][e] = a0; acc[1][e] = a1; if (e & 1) __builtin_amdgcn_sched_barrier(0); }
#pragma unroll
            for (int i = 0; i < 8; ++i)
#pragma unroll
                for (int u = 0; u < 2; ++u) { const bool up = lane & 32; const float keep = up ? acc[u][i + 8] : acc[u][i], send = up ? acc[u][i] : acc[u][i + 8]; acc[u][i] = keep + __shfl_xor(send, 32); }
#pragma unroll
            for (int i = 0; i < 4; ++i)
#pragma unroll
                for (int u = 0; u < 2; ++u) { const bool up = lane & 16; const float keep = up ? acc[u][i + 4] : acc[u][i], send = up ? acc[u][i] : acc[u][i + 4]; acc[u][i] = keep + __shfl_xor(send, 16); }
#pragma unroll
            for (int i = 0; i < 2; ++i)
#pragma unroll
                for (int u = 0; u < 2; ++u) { const bool up = lane & 8; const float keep = up ? acc[u][i + 2] : acc[u][i], send = up ? acc[u][i] : acc[u][i + 2]; acc[u][i] = keep + __shfl_xor(send, 8); }
#pragma unroll
            for (int u = 0; u < 2; ++u) { const bool up = lane & 4; const float keep = up ? acc[u][1] : acc[u][0], send = up ? acc[u][0] : acc[u][1]; acc[u][0] = keep + __shfl_xor(send, 4); }
            float lg[2] = {acc[0][0], acc[1][0]};
#pragma unroll
            for (int o = 1; o <= 2; o <<= 1) { const float t0 = __shfl_xor(lg[0], o), t1 = __shfl_xor(lg[1], o); lg[0] += t0; lg[1] += t1; }
            float mx[2] = {lg[0], lg[1]};
#pragma unroll
            for (int o = 4; o <= 32; o <<= 1) { const float t0 = __shfl_xor(mx[0], o), t1 = __shfl_xor(mx[1], o); mx[0] = fmaxf(mx[0], t0); mx[1] = fmaxf(mx[1], t1); }
            const float ex[2] = {expf(lg[0] - mx[0]), expf(lg[1] - mx[1])}; float se[2] = {ex[0], ex[1]};
#pragma unroll
            for (int o = 4; o <= 32; o <<= 1) { const float t0 = __shfl_xor(se[0], o), t1 = __shfl_xor(se[1], o); se[0] += t0; se[1] += t1; }
            if ((lane & 3) == 0) { const int e = ((lane >> 5) & 1) * 8 + ((lane >> 4) & 1) * 4 + ((lane >> 3) & 1) * 2 + ((lane >> 2) & 1);
#pragma unroll
                for (int u = 0; u < 2; ++u) afft[(size_t)((mr[u] / SEQ) * 16 + e) * SEQ + (mr[u] % SEQ)] = ex[u] / se[u]; }
        }
        __syncthreads();
    }
    if constexpr (ST == ST_TOPK) {
        const float* afft = WSF(WS_AFF); int* idx = WSI(WS_IDX); float* gv = WSF(WS_GATEV); int* slot = WSI(WS_SLOT);
        int* hist = (int*)lds; int* ctl = hist + 256; int* scr = hist + 272;
        for (int z = bid; z < NZ; z += G) {
            const int e = z >> 1, b = z & 1; const float* list = afft + (size_t)(b * 16 + e) * SEQ;
            unsigned key[16];
#pragma unroll
            for (int j = 0; j < 16; j += 4) { const float4 x = *(const float4*)(list + tid * 16 + j); key[j] = __float_as_uint(x.x); key[j + 1] = __float_as_uint(x.y); key[j + 2] = __float_as_uint(x.z); key[j + 3] = __float_as_uint(x.w); }
            unsigned prefix = 0u; int need = CAP;
#pragma unroll 1
            for (int shift = 24; shift >= 0; shift -= 8) {
                __syncthreads();
                if (tid < 256) hist[tid] = 0;
                __syncthreads();
#pragma unroll
                for (int j = 0; j < 16; ++j) { const bool in = (shift == 24) || ((key[j] >> (shift + 8)) == (prefix >> (shift + 8))); if (in) atomicAdd(&hist[(key[j] >> shift) & 255u], 1); }
                __syncthreads();
                if (tid < 256) {
                    const int hc = hist[tid]; int inc = hc;
#pragma unroll
                    for (int o = 1; o < 64; o <<= 1) { const int y = __shfl_down(inc, o); if (lane + o < 64) inc += y; }
                    if (lane == 0) scr[wid] = inc;
                    __builtin_amdgcn_s_waitcnt(0xc07f); __builtin_amdgcn_wave_barrier();
                }
                __syncthreads();
                if (tid < 256) {
                    const int hc = hist[tid]; int inc = hc;
#pragma unroll
                    for (int o = 1; o < 64; o <<= 1) { const int y = __shfl_down(inc, o); if (lane + o < 64) inc += y; }
                    int ca = inc - hc;
#pragma unroll
                    for (int w = 1; w < 4; ++w) ca += (w > wid) ? scr[w] : 0;
                    if (ca < need && need <= ca + hc) { ctl[0] = tid; ctl[1] = need - ca; } }
                __syncthreads();
                prefix |= (unsigned)ctl[0] << shift; need = ctl[1];
            }
            int ceq = 0;
#pragma unroll
            for (int j = 0; j < 16; ++j) ceq += (key[j] == prefix) ? 1 : 0;
            int tot; const int beq = block_excl_scan(ceq, scr, tid, tot);
            int csel = 0, eqr = beq; unsigned selmask = 0u;
#pragma unroll
            for (int j = 0; j < 16; ++j) { bool sel = key[j] > prefix; if (key[j] == prefix) { sel = eqr < need; ++eqr; } if (sel) { selmask |= 1u << j; ++csel; } }
            int sl = block_excl_scan(csel, scr, tid, tot);
#pragma unroll
            for (int j = 0; j < 16; ++j) { const int trow = b * SEQ + tid * 16 + j;
                if ((selmask >> j) & 1u) { idx[z * CAP + sl] = trow; gv[z * CAP + sl] = __uint_as_float(key[j]); slot[(size_t)trow * 16 + e] = sl; ++sl; }
                else slot[(size_t)trow * 16 + e] = -1; }
        }
        __syncthreads();
    }
    if constexpr (ST == ST_GATHER) {
        const int* idx = WSI(WS_IDX); const bf16_t* hb = WSB(WS_HB); bf16_t* xe = WSB(WS_XE);
        const int nr = (NZ * CAP - gw + NGW - 1) / NGW; const int myi = (lane < nr) ? (idx[gw + lane * NGW] & (T - 1)) : 0;
        for (int k = 0; k < nr; k += 4) {
            const int k1 = (k + 1 < nr) ? k + 1 : k, k2 = (k + 2 < nr) ? k + 2 : k, k3 = (k + 3 < nr) ? k + 3 : k;
            const uint4* s0 = (const uint4*)(hb + (size_t)__shfl(myi, k) * DM); const uint4* s1 = (const uint4*)(hb + (size_t)__shfl(myi, k1) * DM);
            const uint4* s2 = (const uint4*)(hb + (size_t)__shfl(myi, k2) * DM); const uint4* s3 = (const uint4*)(hb + (size_t)__shfl(myi, k3) * DM);
            const uint4 x0 = s0[lane], y0 = s0[lane + 64], x1 = s1[lane], y1 = s1[lane + 64], x2 = s2[lane], y2 = s2[lane + 64], x3 = s3[lane], y3 = s3[lane + 64];
            { uint4* d = (uint4*)(xe + (size_t)(gw + k * NGW) * DM); d[lane] = x0; d[lane + 64] = y0; }
            if (k + 1 < nr) { uint4* d = (uint4*)(xe + (size_t)(gw + (k + 1) * NGW) * DM); d[lane] = x1; d[lane + 64] = y1; }
            if (k + 2 < nr) { uint4* d = (uint4*)(xe + (size_t)(gw + (k + 2) * NGW) * DM); d[lane] = x2; d[lane + 64] = y2; }
            if (k + 3 < nr) { uint4* d = (uint4*)(xe + (size_t)(gw + (k + 3) * NGW) * DM); d[lane] = x3; d[lane + 64] = y3; }
        }
    }
    if constexpr (ST == ST_EXP_G) {
        pg8::Gemm g{WSB(WS_HB8), WSB(WS_WGU_T), NZ * CAP, 16 * 4096, DM / 2, DM / 2, WSI(WS_IDX)};
        ExpertOrder1 S; S.init(G, bid);
        EpiSwiGLU E{WSB(WS_HID), DEXP};
        pg8::gemm_phase<EpiSwiGLU, ExpertOrder1, true, true, true, true>((PG8_LAS unsigned char*)lds, g, S, E);
    }
    if constexpr (ST == ST_EXP_D) {
        pg8::Gemm g{WSB(WS_HID), WSB(WS_WD_T), NZ * CAP, 16 * 1024, DEXP / 2, DEXP / 2};
        ExpertOrder2 S; S.init(G, bid);
        EpiRowScale E{WSB(WS_YE), DM, WSF(WS_GATEV)};
        pg8::gemm_phase<EpiRowScale, ExpertOrder2, true, true, false, true>((PG8_LAS unsigned char*)lds, g, S, E);
    }
    if constexpr (ST == ST_LN2) {
        const int* slot = WSI(WS_SLOT); const bf16_t* ye = WSB(WS_YE);
        for (int m0 = gw; m0 < T; m0 += 2 * NGW) {
            const int mr[2] = {m0, m0 + NGW};
            int sl[2]; unsigned long long mask[2]; float4 a[2][4];
#pragma unroll
            for (int u = 0; u < 2; ++u) { sl[u] = (lane < 16) ? slot[(size_t)mr[u] * 16 + lane] : -1; }
#pragma unroll
            for (int u = 0; u < 2; ++u) { const bf16_t* hr = WSB(WS_HB) + (size_t)mr[u] * DM;
#pragma unroll
                for (int j = 0; j < 4; ++j) { float x[4]; ld4bf(hr + 4 * (lane + 64 * j), x); a[u][j] = make_float4(ALPHA * x[0], ALPHA * x[1], ALPHA * x[2], ALPHA * x[3]); } }
            mask[0] = __ballot(sl[0] >= 0); mask[1] = __ballot(sl[1] >= 0);
            while (mask[0] | mask[1]) {
#pragma unroll
                for (int u = 0; u < 2; ++u) if (mask[u]) {
                    const int e = __builtin_ctzll(mask[u]); mask[u] &= mask[u] - 1;
                    const bf16_t* yr = ye + ((size_t)(e * 2 + mr[u] / SEQ) * CAP + __shfl(sl[u], e)) * DM;
#pragma unroll
                    for (int j = 0; j < 4; ++j) { float y[4]; ld4bf(yr + 4 * (lane + 64 * j), y); a[u][j].x += y[0]; a[u][j].y += y[1]; a[u][j].z += y[2]; a[u][j].w += y[3]; }
                }
            }
            if (l == 0) ln_core2<0>(a, LN2_G(l), LN2_B(l), nullptr, nullptr, WSB(WS_HB) + (size_t)mr[0] * DM, WSB(WS_HB) + (size_t)mr[1] * DM, lane);
            else ln_core2<2>(a, LN2_G(l), LN2_B(l), h + (size_t)mr[0] * DM, h + (size_t)mr[1] * DM, nullptr, nullptr, lane);
        }
    }
}


#define LAS __attribute__((address_space(3)))
#define XB_TMO      128
#define XB_XCNT(j)  (256  + 64 * (j))
#define XB_XSUB(j)  (1280 + 64 * (j))
#define XB_XGEN(j)  (2304 + 64 * (j))
#define XB_TOP      3328
#define XB_TOPGEN   3392
#define XCD_BAR_WORDS 3456
#define XB_SPIN_CAP (1u << 18)
__device__ __forceinline__ unsigned xb_ld(unsigned* p)              { return __hip_atomic_load(p, __ATOMIC_RELAXED, __HIP_MEMORY_SCOPE_AGENT); }
__device__ __forceinline__ unsigned xb_add(unsigned* p, unsigned v) { return __hip_atomic_fetch_add(p, v, __ATOMIC_RELAXED, __HIP_MEMORY_SCOPE_AGENT); }
__device__ __forceinline__ unsigned xb_xcc_id() { return (unsigned)__builtin_amdgcn_s_getreg((3 << 11) | 20) & 0xFu; }
#define XB_SPIN(cond, bar) do { unsigned _sp = 0; while (cond) { __builtin_amdgcn_s_sleep(1); \
    if ((++_sp & 255u) == 0u) { if (xb_ld(&(bar)[XB_TMO])) break; if (_sp > XB_SPIN_CAP) { atomicAdd(&(bar)[XB_TMO], 1u); break; } } } } while (0)
struct XcdBarrier { unsigned* bar; unsigned x; volatile LAS unsigned* st; };
__device__ __forceinline__ XcdBarrier xcd_barrier_post(unsigned* bar, volatile LAS unsigned* st) {
    XcdBarrier b; b.bar = bar; b.x = xb_xcc_id(); b.st = st;
    if (threadIdx.x == 0) (void)xb_add(&bar[XB_XCNT(b.x)], 1u);
    return b;
}
__device__ __forceinline__ void xcd_barrier_complete(unsigned* bar, unsigned x, unsigned& nloc, unsigned& nx) {
    const unsigned G = gridDim.x * gridDim.y * gridDim.z;
    unsigned sum, cnt, mine, sp = 0u;
    for (;;) {
        sum = 0u; cnt = 0u; mine = 0u;
#pragma unroll
        for (unsigned j = 0; j < 16; ++j) { const unsigned c = xb_ld(&bar[XB_XCNT(j)]); sum += c; cnt += (c > 0u) ? 1u : 0u; mine = (j == x) ? c : mine; }
        if (sum == G) break;
        __builtin_amdgcn_s_sleep(1);
        if ((++sp & 255u) == 0u) { if (xb_ld(&bar[XB_TMO])) break; if (sp > XB_SPIN_CAP) { atomicAdd(&bar[XB_TMO], 1u); break; } }
    }
    nloc = mine > 0u ? mine : 1u; nx = cnt > 0u ? cnt : 1u;
}
__device__ __forceinline__ void xcd_barrier(const XcdBarrier& b) {
    asm volatile("s_waitcnt vmcnt(0)" ::: "memory");
    __syncthreads();
    if (threadIdx.x == 0) {
        unsigned* bar = b.bar; asm volatile("" : "+s"(bar));
        unsigned bx = b.x; asm volatile("" : "+s"(bx));
        __builtin_amdgcn_s_waitcnt(0);
        unsigned nloc = b.st[0], nx = b.st[1];
        if (nloc == 0u) { xcd_barrier_complete(bar, bx, nloc, nx); b.st[0] = nloc; b.st[1] = nx; }
        const unsigned old = xb_add(&bar[XB_XSUB(bx)], 1u);
        const unsigned gen = old / nloc;
        if (old + 1u == (gen + 1u) * nloc) {
            __builtin_amdgcn_fence(__ATOMIC_RELEASE, "agent");
            asm volatile("s_waitcnt vmcnt(0)" ::: "memory");
            const unsigned og = xb_add(&bar[XB_TOP], 1u);
            const unsigned tg = og / nx;
            if (og + 1u == (tg + 1u) * nx) xb_add(&bar[XB_TOPGEN], 1u);
            else XB_SPIN(xb_ld(&bar[XB_TOPGEN]) == tg, bar);
            __builtin_amdgcn_fence(__ATOMIC_ACQUIRE, "agent");
            xb_add(&bar[XB_XGEN(bx)], 1u);
            asm volatile("s_waitcnt vmcnt(0)" ::: "memory");
        } else {
            XB_SPIN(xb_ld(&bar[XB_XGEN(bx)]) == gen, bar);
            __builtin_amdgcn_fence(__ATOMIC_ACQUIRE, "agent");
            asm volatile("s_waitcnt vmcnt(0)" ::: "memory");
        }
    }
    __syncthreads();
}
constexpr int MISC_OFF = 131072 + 320;
constexpr int CW_BAR = 4096;

__global__ void __launch_bounds__(NTHR) mega_fwd(Params p) {
    extern __shared__ __attribute__((aligned(16))) unsigned char lds_raw[];
    float* lds = (float*)lds_raw;
    volatile LAS unsigned* MISC = (volatile LAS unsigned*)((LAS unsigned char*)lds_raw + MISC_OFF);
    if (threadIdx.x < 32) MISC[threadIdx.x] = 0u;
    __syncthreads();
    unsigned char* ws_ = ((const KAS Params*)__builtin_amdgcn_kernarg_segment_ptr())->ws;
    XcdBarrier bar = xcd_barrier_post((unsigned*)(ws_ + WS_CTL) + CW_BAR, MISC + 8);
#define GB() xcd_barrier(bar)
    run_stage<ST_INIT>(0, lds); GB();
    for (int step = 0; step < 2 * 11; ++step) {
        const int l = step / 11, s = step % 11;
        switch (s) {
        case 0: run_stage<ST_PROJ>(l, lds); break;
        case 1: run_stage<ST_PREP>(l, lds); run_stage<ST_GLA1>(l, lds); break;
        case 2: run_stage<ST_SMALLGEMM>(l, lds); run_stage<ST_GLA2>(l, lds); break;
        case 3: run_stage<ST_ATTN>(l, lds); run_stage<ST_GLA3>(l, lds); break;
        case 4: run_stage<ST_MERGE_A>(l, lds); break;
        case 5: run_stage<ST_OUTP>(l, lds); break;
        case 6: run_stage<ST_LN1>(l, lds); break;
        case 7: run_stage<ST_TOPK>(l, lds); break;
        case 8: run_stage<ST_EXP_G>(l, lds); break;
        case 9: run_stage<ST_EXP_D>(l, lds); break;
        default: run_stage<ST_LN2>(l, lds); break;
        }
        if (step + 1 < 2 * 11) GB();
    }
#undef GB
}

template <int ST>
__global__ void __launch_bounds__(NTHR) k_stage(Params p, int l) {
    extern __shared__ __attribute__((aligned(16))) unsigned char lds_raw[];
    run_stage<ST>(l, (float*)lds_raw);
}

template <int ST> static void launch_stage(const Params& p, int l, int grid, hipStream_t stream) {
    static bool attr = false;
    if (!attr) { (void)hipFuncSetAttribute((const void*)k_stage<ST>, hipFuncAttributeMaxDynamicSharedMemorySize, LDS_BYTES); attr = true; }
    hipLaunchKernelGGL(k_stage<ST>, dim3(grid), dim3(NTHR), LDS_BYTES, stream, p, l);
}

extern "C" void kernel_launch(void* const* d_in, const int* in_sizes, int n_in, void* d_out, int out_size, void* d_ws, size_t ws_size, hipStream_t stream) {
    if (n_in != 27 || out_size != T * DM || ws_size < WS_END) {
        fprintf(stderr, "kernel_launch: unexpected shapes: n_in %d out %d ws %zu (need >= %zu)\n", n_in, out_size, ws_size, (size_t)WS_END);
        return;
    }
    Params p{};
    for (int i = 0; i < 27; ++i) p.in[i] = (const float*)d_in[i];
    p.pos = (const int*)d_in[1]; p.out = (float*)d_out; p.ws = (unsigned char*)d_ws;
    const int grid = 256;
#if MEGA
    static bool attr = false;
    if (!attr) { (void)hipFuncSetAttribute((const void*)mega_fwd, hipFuncAttributeMaxDynamicSharedMemorySize, LDS_BYTES); attr = true; }
    (void)hipMemsetAsync((char*)d_ws + WS_CTL, 0, 65536, stream);
    hipLaunchKernelGGL(mega_fwd, dim3(grid), dim3(NTHR), LDS_BYTES, stream, p);
#else
    launch_stage<ST_INIT>(p, 0, grid, stream);
    for (int l = 0; l < 2; ++l) {
        launch_stage<ST_PROJ>(p, l, grid, stream);
        launch_stage<ST_PREP>(p, l, grid, stream);
        launch_stage<ST_SMALLGEMM>(p, l, grid, stream);
        launch_stage<ST_ROPE>(p, l, grid, stream);
        launch_stage<ST_ATTN>(p, l, grid, stream);
        launch_stage<ST_GLAREC>(p, l, grid, stream);
        launch_stage<ST_GLAFIN>(p, l, grid, stream);
        launch_stage<ST_MERGE_A>(p, l, grid, stream);
        launch_stage<ST_MERGE_B>(p, l, grid, stream);
        launch_stage<ST_MERGE_C>(p, l, grid, stream);
        launch_stage<ST_OUTP>(p, l, grid, stream);
        launch_stage<ST_LN1>(p, l, grid, stream);
        launch_stage<ST_TOPK>(p, l, grid, stream);
        launch_stage<ST_EXP_G>(p, l, grid, stream);
        launch_stage<ST_EXP_U>(p, l, grid, stream);
        launch_stage<ST_EXP_D>(p, l, grid, stream);
        launch_stage<ST_LN2>(p, l, grid, stream);
    }
#endif
}
```

```cpp
#include <hip/hip_runtime.h>
#include <cstdio>
#include <cstdint>

#ifndef MEGA
#define MEGA 1
#endif

constexpr int NB = 2, SEQ = 8192, T = NB * SEQ, DM = 1024, DIN = 5824, DINP = 5888;
constexpr int OFF_GATE = 0, OFF_POOL = 3072, OFF_CQ = 3072 + 512, OFF_CKV = 3072 + 896, OFF_KR = 3072 + 1152, OFF_GQ = 3072 + 1184, OFF_GK = 3072 + 1440, OFF_GV = 3072 + 1696, OFF_GR = 3072 + 2208, OFF_GDEC = 3072 + 2720;
constexpr int NE = 16, CAP = 1024, DEXP = 2048, NZ = NB * NE;
constexpr float ALPHA = 1.4142135623730951f;
constexpr float LN_EPS = 1e-5f, RMS_EPS = 1e-6f;
constexpr int NTHR = 512, LDS_BYTES = 147456;

constexpr size_t MiB = 1u << 20;
constexpr size_t WS_CTL = 0;
constexpr size_t WS_ROPE = 1 * MiB;
constexpr size_t WS_AFF = 3 * MiB;
constexpr size_t WS_SLOT = 4 * MiB;
constexpr size_t WS_IDX = 5 * MiB;
constexpr size_t WS_GATEV = 5 * MiB + 256 * 1024;
constexpr size_t WS_WIN_T = 8 * MiB;
constexpr size_t WS_WSMALL = 31 * MiB;
constexpr size_t WSM_UQ = 0, WSM_UKV = 1 * MiB, WSM_MRG = 2 * MiB, WSM_OUT = 5 * MiB, WSM_STRIDE = 7 * MiB;
constexpr size_t WS_RQ = 6 * MiB;
constexpr size_t WS_HB = 958 * MiB;
constexpr size_t WS_WGU_T = 76 * MiB;
constexpr size_t WS_WD_T = 204 * MiB;
constexpr size_t WS_PROJB = 268 * MiB;
constexpr size_t WS_XE = 268 * MiB;
constexpr size_t WS_HID = 332 * MiB;
constexpr size_t WS_YE = 460 * MiB;
constexpr size_t WS_BR = 452 * MiB;
constexpr size_t WS_HB8 = 500 * MiB;
constexpr size_t WS_QB = 556 * MiB;
constexpr size_t WS_KB = 580 * MiB;
constexpr size_t WS_VB = 604 * MiB;
constexpr size_t WS_KVT = 702 * MiB;
constexpr size_t WS_ST = 766 * MiB;
constexpr size_t WS_DEC = 798 * MiB;
constexpr size_t WS_MERGEDB = 830 * MiB;
constexpr size_t WS_TMP = 894 * MiB;
constexpr size_t WS_END = 990 * MiB;
static_assert(WS_YE + 64 * MiB <= WS_QB, "overlay map");

namespace pg8 {
#define PG8_LAS __attribute__((address_space(3)))
typedef unsigned short bf16_t;
typedef short bf16x8 __attribute__((ext_vector_type(8)));
typedef float f32x4 __attribute__((ext_vector_type(4)));
typedef unsigned u32x4 __attribute__((ext_vector_type(4)));
constexpr int BM = 256, BK = 64, HALF = 128, HTB = HALF * BK * 2  , STAGE_BYTES = 8 * HTB, NXCD = 8, WGM = 8;

__host__ __device__ __forceinline__ int lds_byte(int r, int c) { const int st = (r >> 4) * 2 + (c >> 5), rr = r & 15, cc = c & 31, ob = rr * 64 + cc * 2; return st * 1024 + (ob ^ (((ob >> 9) & 1) << 5)); }
__host__ __device__ __forceinline__ void stage_rc(int b, int& R, int& C) { const int st = b / 1024, sb = b % 1024, swz = sb ^ (((sb >> 9) & 1) << 5); R = (st >> 1) * 16 + swz / 64; C = (st & 1) * 32 + (swz % 64) / 2; }
__host__ __device__ __forceinline__ int perm32(int rho) { const int n = rho >> 4, i = rho & 15; return 8 * (i >> 2) + 4 * n + (i & 3); }

struct Unit { int pm, pn; };
struct Gemm { const bf16_t* A; const bf16_t* Bt; int M, N, K, lda; const int* ridx; };

struct StaticOrder {
    int nM, nN, nwg, G, c;
    __host__ __device__ void init(int M, int N, int G_, int c_) { nM = M / BM; nN = N / BM; nwg = nM * nN; G = G_; c = c_; }
    __host__ __device__ bool next(int i, Unit& u) const {
        const long L = (long)i * G + c; if (L >= nwg) return false;
        int wgid = (int)L; { const int q = nwg / NXCD, r = nwg % NXCD, xcd = wgid % NXCD, off = wgid / NXCD; wgid = (xcd < r ? xcd * (q + 1) : r * (q + 1) + (xcd - r) * q) + off; }
        const int nig = WGM * nN, gid = wgid / nig, fm = gid * WGM, gsz = (nM - fm) < WGM ? (nM - fm) : WGM;
        u.pm = fm + ((wgid % nig) % gsz); u.pn = (wgid % nig) / gsz; return true;
    }
    __device__ __forceinline__ void a_ready(const Unit&) const {}
    __device__ __forceinline__ void done(const Unit&) const {}
};

__device__ __forceinline__ unsigned cvt_pk_bf16(float lo, float hi) { unsigned r; asm volatile("v_cvt_pk_bf16_f32 %0, %1, %2" : "=v"(r) : "v"(lo), "v"(hi)); return r; }
typedef float f32x2 __attribute__((ext_vector_type(2)));
__device__ __forceinline__ f32x2 gelu_pk(f32x2 v) {
    const f32x2 av = __builtin_elementwise_abs(v), d = av * 0.2316418882f + 1.0f;
    f32x2 t; t.x = __builtin_amdgcn_rcpf(d.x); t.y = __builtin_amdgcn_rcpf(d.y);
    f32x2 q = t * 0.5307027145f + (-0.7265760135f); q = q * t + 0.7107068705f; q = q * t + (-0.142248368f); q = q * t + 0.127414796f; q = q * t;
    const f32x2 s = (v * v) * (-0.72134752044f);
    f32x2 e; e.x = __builtin_amdgcn_exp2f(s.x); e.y = __builtin_amdgcn_exp2f(s.y);
    const f32x2 m = v * (q * e), r = v - m;
    f32x2 o; o.x = v.x < 0.f ? m.x : r.x; o.y = v.y < 0.f ? m.y : r.y; return o;
}

template <int ACT  > struct EpiBf16 {
    static constexpr bool PERM = true, AFTER_DRAIN = false; static constexpr int SEG = 0; static_assert(ACT == 0 || ACT == 1, "EpiBf16: ACT is 0 (none) or 1 (gelu_pk)");
    bf16_t* O; int ldc; const float* bias; int split_cols; size_t split_stride; float scale0;
    __device__ __forceinline__ void operator()(const f32x4 (&acc)[2][2][4][2], const Unit& u, int wr, int wc, int fr, int fq) const {
        const int row0 = u.pm * BM + wr * 64 + fr; int colt = u.pn * BM; bf16_t* base = O;
        float sc = 1.f; if (split_cols) { const int t = colt / split_cols; base += (size_t)t * split_stride; colt -= t * split_cols; if (t == 0) sc = scale0; }
        const int col0 = colt + wc * 32 + 8 * fq, bcol0 = u.pn * BM + wc * 32 + 8 * fq;
        f32x4 bv[2][2];
#pragma unroll
        for (int bj = 0; bj < 2; ++bj)
#pragma unroll
            for (int n = 0; n < 2; ++n) bv[bj][n] = bias ? *(const f32x4*)(bias + bcol0 + bj * HALF + 4 * n) : (f32x4){0.f, 0.f, 0.f, 0.f};
#pragma unroll
        for (int ai = 0; ai < 2; ++ai)
#pragma unroll
            for (int m = 0; m < 4; ++m) { bf16_t* rowp = base + (size_t)(row0 + ai * HALF + m * 16) * ldc + col0;
#pragma unroll
                for (int bj = 0; bj < 2; ++bj) { f32x4 v0 = acc[ai][bj][m][0] + bv[bj][0], v1 = acc[ai][bj][m][1] + bv[bj][1];
                    if (ACT == 1) { f32x2 a = gelu_pk((f32x2){v0[0], v0[1]}), b = gelu_pk((f32x2){v0[2], v0[3]}), c = gelu_pk((f32x2){v1[0], v1[1]}), d = gelu_pk((f32x2){v1[2], v1[3]});
                        v0 = (f32x4){a.x, a.y, b.x, b.y}; v1 = (f32x4){c.x, c.y, d.x, d.y}; }
                    v0 = v0 * sc; v1 = v1 * sc; u32x4 w; w.x = cvt_pk_bf16(v0[0], v0[1]); w.y = cvt_pk_bf16(v0[2], v0[3]); w.z = cvt_pk_bf16(v1[0], v1[1]); w.w = cvt_pk_bf16(v1[2], v1[3]);
                    *(u32x4*)(rowp + bj * HALF) = w; } }
    }
};

struct PanelStats {
    unsigned* xbuf;
    unsigned* cnt;
    unsigned* tmo;
    int ntn; float eps;
    unsigned code;
    __device__ __forceinline__ bool run(const f32x4 (&v)[2][2][4][2], const Unit& u, int wr, int wc, int fr, int fq, PG8_LAS unsigned char* lds, int wid, int lane) const {
        typedef float f32x2v __attribute__((ext_vector_type(2)));
        PG8_LAS f32x2v* P = (PG8_LAS f32x2v*)lds;
        PG8_LAS f32x2v* S = (PG8_LAS f32x2v*)(lds + 8192);
        PG8_LAS unsigned* flag = (PG8_LAS unsigned*)(lds + 8192 + 2048);
#pragma unroll
        for (int ai = 0; ai < 2; ++ai)
#pragma unroll
            for (int m = 0; m < 4; ++m) {
                float s = 0.f;
#pragma unroll
                for (int bj = 0; bj < 2; ++bj)
#pragma unroll
                    for (int n = 0; n < 2; ++n) { const f32x4 x = v[ai][bj][m][n]; s += (x[0] + x[1]) + (x[2] + x[3]); }
                s += __shfl_xor(s, 16); s += __shfl_xor(s, 32);
                const float mw = s * (1.0f / 64.0f); float q = 0.f;
#pragma unroll
                for (int bj = 0; bj < 2; ++bj)
#pragma unroll
                    for (int n = 0; n < 2; ++n) { const f32x4 d = v[ai][bj][m][n] - mw; q += (d[0] * d[0] + d[1] * d[1]) + (d[2] * d[2] + d[3] * d[3]); }
                q += __shfl_xor(q, 16); q += __shfl_xor(q, 32);
                if (fq == 0) P[(ai * HALF + wr * 64 + m * 16 + fr) * 4 + wc] = (f32x2v){mw, q};
            }
        asm volatile("s_waitcnt lgkmcnt(0)" ::: "memory"); __builtin_amdgcn_s_barrier(); asm volatile("" ::: "memory");
#if defined(BROKEN_EXCHANGE_NO_WAIT)
#warning BROKEN CONTROL BUILD: the row-statistics exchange does not wait; results are wrong by design
        if (blockIdx.x >= 64) { const long long t0_ = clock64(); while (clock64() - t0_ < 60000) __builtin_amdgcn_s_sleep(8); }
#endif
        const int row = wid * 32 + (lane & 31);
        if (lane < 32) {
            const f32x2v a = P[row * 4 + 0], b = P[row * 4 + 1], c = P[row * 4 + 2], d = P[row * 4 + 3];
            const float mt = (a.x + b.x + c.x + d.x) * 0.25f;
            const float da = a.x - mt, db = b.x - mt, dc = c.x - mt, dd = d.x - mt;
            const float m2 = (a.y + b.y) + (c.y + d.y) + 64.0f * ((da * da + db * db) + (dc * dc + dd * dd));
            unsigned long long* slot = (unsigned long long*)xbuf + ((size_t)(u.pm * BM + row) * 4 + u.pn);
            __hip_atomic_store(slot, ((unsigned long long)__float_as_uint(m2) << 32) | __float_as_uint(mt), __ATOMIC_RELAXED, __HIP_MEMORY_SCOPE_AGENT);
        }
        asm volatile("s_waitcnt vmcnt(0)" ::: "memory");
        if (lane == 0) __hip_atomic_fetch_add(cnt + 64 * u.pm, 1u, __ATOMIC_RELAXED, __HIP_MEMORY_SCOPE_AGENT);
        if (wid == 0) {
            bool dead = false; const unsigned long long t0 = __builtin_amdgcn_s_memrealtime(); const unsigned want = 8u * (unsigned)ntn;
            for (;;) {
#if defined(BROKEN_EXCHANGE_NO_WAIT)
                break;
#endif
                if ((unsigned)__builtin_amdgcn_readfirstlane(__hip_atomic_load(cnt + 64 * u.pm, __ATOMIC_RELAXED, __HIP_MEMORY_SCOPE_AGENT)) >= want) break;
                if (__builtin_amdgcn_s_memrealtime() - t0 > 2000000ull) {
                    if (lane == 0) { unsigned expect = 0u; __hip_atomic_compare_exchange_strong(tmo + 1, &expect, code | (unsigned)(u.pm & 0xff), __ATOMIC_RELAXED, __ATOMIC_RELAXED, __HIP_MEMORY_SCOPE_AGENT);
                                     __hip_atomic_store(tmo, 1u, __ATOMIC_RELAXED, __HIP_MEMORY_SCOPE_AGENT); }
                    dead = true; break; }
                __builtin_amdgcn_s_sleep(2);
            }
            __builtin_amdgcn_fence(__ATOMIC_ACQUIRE, "agent");
            if (lane == 0) flag[0] = dead ? 1u : 0u;
        }
        asm volatile("s_waitcnt vmcnt(0) lgkmcnt(0)" ::: "memory"); __builtin_amdgcn_s_barrier(); asm volatile("" ::: "memory");
        const bool bad = flag[0] != 0u;
        if (lane < 32) {
            const unsigned long long* slot = (const unsigned long long*)xbuf + (size_t)(u.pm * BM + row) * 4; float mt[4], m2[4]; float ms = 0.f;
#pragma unroll
            for (int t = 0; t < 4; ++t) { if (t < ntn) { const unsigned long long w = __hip_atomic_load(slot + t, __ATOMIC_RELAXED, __HIP_MEMORY_SCOPE_AGENT); mt[t] = __uint_as_float((unsigned)w); m2[t] = __uint_as_float((unsigned)(w >> 32)); } else { mt[t] = 0.f; m2[t] = 0.f; } ms += mt[t]; }
            const float mean = ms / (float)ntn; float q = 0.f;
#pragma unroll
            for (int t = 0; t < 4; ++t) if (t < ntn) { const float dm = mt[t] - mean; q += m2[t] + 256.0f * dm * dm; }
            S[row] = (f32x2v){mean, 1.0f / sqrtf(q / (256.0f * (float)ntn) + eps)};
        }
        asm volatile("s_waitcnt lgkmcnt(0)" ::: "memory"); __builtin_amdgcn_s_barrier(); asm volatile("" ::: "memory");
        return bad;
    }
};
struct EpiLnRes {
    static constexpr bool PERM = false, AFTER_DRAIN = true; static constexpr int SEG = 0;
    const float* base; float* out; int ldc; const float* bias; PanelStats st; unsigned poison;
    __device__ __forceinline__ void fused(f32x4 (&acc)[2][2][4][2], const Unit& u, int wr, int wc, int fr, int fq, PG8_LAS unsigned char* lds, int wid, int lane) const {
        typedef float f32x2v __attribute__((ext_vector_type(2)));
        const PG8_LAS f32x2v* S = (const PG8_LAS f32x2v*)(lds + 8192);
        const int col0 = u.pn * BM + wc * 32 + 4 * fq;
#pragma unroll
        for (int bj = 0; bj < 2; ++bj)
#pragma unroll
            for (int n = 0; n < 2; ++n) { const f32x4 bv = bias ? *(const f32x4*)(bias + col0 + bj * HALF + n * 16) : (f32x4){0.f, 0.f, 0.f, 0.f};
#pragma unroll
                for (int ai = 0; ai < 2; ++ai)
#pragma unroll
                    for (int m = 0; m < 4; ++m) acc[ai][bj][m][n] += bv; }
        f32x4 pre[4][2][2];
#pragma unroll
        for (int m = 0; m < 4; ++m) { const size_t off = (size_t)(u.pm * BM + wr * 64 + m * 16 + fr) * ldc + col0;
#pragma unroll
            for (int bj = 0; bj < 2; ++bj)
#pragma unroll
                for (int n = 0; n < 2; ++n) pre[m][bj][n] = *(const f32x4*)(base + off + bj * HALF + n * 16); }
        const bool bad = st.run(acc, u, wr, wc, fr, fq, lds, wid, lane) || poison != 0u;
        const float qnan = __builtin_nanf("");
#pragma unroll
        for (int ai = 0; ai < 2; ++ai)
#pragma unroll
            for (int m = 0; m < 4; ++m) { const int r = ai * HALF + wr * 64 + m * 16 + fr; const f32x2v sr = S[r]; const size_t off = (size_t)(u.pm * BM + r) * ldc + col0;
#pragma unroll
                for (int bj = 0; bj < 2; ++bj)
#pragma unroll
                    for (int n = 0; n < 2; ++n) { const f32x4 bs = ai == 0 ? pre[m][bj][n] : *(const f32x4*)(base + off + bj * HALF + n * 16); f32x4 o = bs + (acc[ai][bj][m][n] - sr.x) * sr.y;
                        if (bad) o = (f32x4){qnan, qnan, qnan, qnan}; *(f32x4*)(out + off + bj * HALF + n * 16) = o; }
                if (m & 1) asm volatile("" ::: "memory"); }
    }
};
struct EpiLnResLn {
    static constexpr bool PERM = false, AFTER_DRAIN = true; static constexpr int SEG = 0;
    const float* base; float* out; bf16_t* xn; int ldc; const float* bias; PanelStats st1, st2; unsigned poison;
    __device__ __forceinline__ void fused(f32x4 (&acc)[2][2][4][2], const Unit& u, int wr, int wc, int fr, int fq, PG8_LAS unsigned char* lds, int wid, int lane) const {
        typedef float f32x2v __attribute__((ext_vector_type(2))); typedef unsigned u32x2v __attribute__((ext_vector_type(2)));
        const PG8_LAS f32x2v* S = (const PG8_LAS f32x2v*)(lds + 8192);
        const int col0 = u.pn * BM + wc * 32 + 4 * fq;
#pragma unroll
        for (int bj = 0; bj < 2; ++bj)
#pragma unroll
            for (int n = 0; n < 2; ++n) { const f32x4 bv = bias ? *(const f32x4*)(bias + col0 + bj * HALF + n * 16) : (f32x4){0.f, 0.f, 0.f, 0.f};
#pragma unroll
                for (int ai = 0; ai < 2; ++ai)
#pragma unroll
                    for (int m = 0; m < 4; ++m) acc[ai][bj][m][n] += bv; }
        bool bad = st1.run(acc, u, wr, wc, fr, fq, lds, wid, lane) || poison != 0u;
        const float qnan = __builtin_nanf("");
#pragma unroll
        for (int ai = 0; ai < 2; ++ai)
#pragma unroll
            for (int m = 0; m < 4; ++m) { const int r = ai * HALF + wr * 64 + m * 16 + fr; const f32x2v sr = S[r]; const size_t off = (size_t)(u.pm * BM + r) * ldc + col0;
#pragma unroll
                for (int bj = 0; bj < 2; ++bj)
#pragma unroll
                    for (int n = 0; n < 2; ++n) { const f32x4 bs = *(const f32x4*)(base + off + bj * HALF + n * 16); acc[ai][bj][m][n] = bs + (acc[ai][bj][m][n] - sr.x) * sr.y; }
                asm volatile("" : "+v"(acc[ai][0][m][0]), "+v"(acc[ai][0][m][1]), "+v"(acc[ai][1][m][0]), "+v"(acc[ai][1][m][1]));
                if (m & 1) asm volatile("" ::: "memory"); }
        const bool bad1 = bad;
        bad = st2.run(acc, u, wr, wc, fr, fq, lds, wid, lane) || bad;
#pragma unroll
        for (int ai = 0; ai < 2; ++ai)
#pragma unroll
            for (int m = 0; m < 4; ++m) { const int r = ai * HALF + wr * 64 + m * 16 + fr; const f32x2v sr = S[r]; const size_t off = (size_t)(u.pm * BM + r) * ldc + col0;
#pragma unroll
                for (int bj = 0; bj < 2; ++bj)
#pragma unroll
                    for (int n = 0; n < 2; ++n) { const f32x4 x1 = acc[ai][bj][m][n]; *(f32x4*)(out + off + bj * HALF + n * 16) = bad1 ? (f32x4){qnan, qnan, qnan, qnan} : x1;
                        const f32x4 o = (x1 - sr.x) * sr.y; u32x2v w; w.x = cvt_pk_bf16(o[0], o[1]); w.y = cvt_pk_bf16(o[2], o[3]);
                        if (bad) { w.x = 0x7fc07fc0u; w.y = 0x7fc07fc0u; } *(u32x2v*)(xn + off + bj * HALF + n * 16) = w; }
                asm volatile("" ::: "memory"); }
    }
};

template <class Epi, class Sched, bool ALIGN_EPI = false, bool SP2 = false, bool GATHER = false, bool FP8 = false>
__device__ __forceinline__ void gemm_phase(PG8_LAS unsigned char* lds, const Gemm g, const Sched& S, const Epi& E) {
    int tid_ = threadIdx.x; asm volatile("" : "+v"(tid_));
    const int tid = tid_, wid = __builtin_amdgcn_readfirstlane(tid >> 6), lane = tid & 63, wr = wid >> 2, wc = wid & 3, fr = lane & 15, fq = lane >> 4;
    int K_ = g.K; asm volatile("" : "+s"(K_));
    const int K = K_, nt = K / BK;
    unsigned voffA[2], voffB[2];
#pragma unroll
    for (int i = 0; i < 2; ++i) { int R, C; stage_rc(tid * 16 + i * 8192, R, C); const int Rb = Epi::PERM ? ((R & ~31) + perm32(R & 31)) : R;
        voffA[i] = (unsigned)(R * g.lda + C) * 2u; voffB[i] = (unsigned)(Rb * K + C) * 2u; }
    const size_t kstep = (size_t)(BK * 2);
    static_assert(!GATHER || SP2, "GATHER is implemented for the SP2 loop");
    const size_t hstepB = (size_t)HALF * K * 2, hstepA = GATHER ? 0 : (size_t)HALF * g.lda * 2;
    const size_t tstepB = 2 * hstepB, tstepA = GATHER ? 0 : 2 * hstepA;
    const unsigned ldsw = (unsigned)wid * 1024u;
    const int aoffk[2] = {lds_byte(wr * 64 + fr, FP8 ? 16 * fq : 8 * fq), lds_byte(wr * 64 + fr, FP8 ? 16 * fq + 8 : 8 * fq + 32)};
    const int boffk[2] = {lds_byte(wc * 32 + fr, FP8 ? 16 * fq : 8 * fq), lds_byte(wc * 32 + fr, FP8 ? 16 * fq + 8 : 8 * fq + 32)};
#define PG8_SA(b, h) (((b) * 2 + (h)) * HTB)
#define PG8_SB(b, h) ((4 + (b) * 2 + (h)) * HTB)
#define PG8_STAGE(bufoff, gbase, voff) do { _Pragma("unroll") for (int _i = 0; _i < 2; ++_i) \
        __builtin_amdgcn_global_load_lds((const unsigned*)((const char*)(gbase) + (voff)[_i]), (PG8_LAS unsigned*)(lds + (bufoff) + ldsw + _i * 8192), 16, 0, 0); } while (0)
    typedef int i32x4_ __attribute__((ext_vector_type(4))); typedef int i32x8_ __attribute__((ext_vector_type(8)));
#define PG8_LD16(off) (*(const PG8_LAS i32x4_*)(lds + (off)))
#define PG8_LDA(dst, b, h) do { _Pragma("unroll") for (int m = 0; m < 4; ++m) { \
        if constexpr (FP8) dst##8[m] = *(const PG8_LAS i32x8_*)(lds + PG8_SA(b, h) + aoffk[0] + m * 2048);     \
        else { _Pragma("unroll") for (int k = 0; k < 2; ++k) dst[m][k] = *(const PG8_LAS bf16x8*)(lds + PG8_SA(b, h) + aoffk[k] + m * 2048); } } } while (0)
#define PG8_LDB(dst, b, h) do { _Pragma("unroll") for (int n = 0; n < 2; ++n) { \
        if constexpr (FP8) dst##8[n] = *(const PG8_LAS i32x8_*)(lds + PG8_SB(b, h) + boffk[0] + n * 2048); \
        else { _Pragma("unroll") for (int k = 0; k < 2; ++k) dst[n][k] = *(const PG8_LAS bf16x8*)(lds + PG8_SB(b, h) + boffk[k] + n * 2048); } } } while (0)
#define PG8_MMA(ai, bj, At, Bt) do { __builtin_amdgcn_s_setprio(1); _Pragma("unroll") for (int m = 0; m < 4; ++m) _Pragma("unroll") for (int n = 0; n < 2; ++n) { \
        if constexpr (FP8) asm volatile("s_nop 1\n\tv_mfma_scale_f32_16x16x128_f8f6f4 %0, %1, %2, %0, %3, %3 op_sel_hi:[0,0,0]" : "+v"(acc[ai][bj][m][n]) : "v"(Bt##8[n]), "v"(At##8[m]), "v"(sc1_));     \
        else { _Pragma("unroll") for (int k = 0; k < 2; ++k) acc[ai][bj][m][n] = __builtin_amdgcn_mfma_f32_16x16x32_bf16(Bt[n][k], At[m][k], acc[ai][bj][m][n], 0, 0, 0); } } \
        __builtin_amdgcn_s_setprio(0); } while (0)
#define PG8_WAIT_V(n) asm volatile("s_waitcnt vmcnt(" #n ")" ::: "memory")
#define PG8_WAIT_L(n) asm volatile("s_waitcnt lgkmcnt(" #n ")" ::: "memory")
#define PG8_BAR __builtin_amdgcn_s_barrier()
#define PG8_SCHED __builtin_amdgcn_sched_barrier(0)
    Unit cur, nxt; int ui = 0;
    if (!S.next(0, cur)) return;
    unsigned vC0[2] = {voffA[0], voffA[1]}, vC1[2] = {voffA[0], voffA[1]}, vN0[2] = {voffA[0], voffA[1]}, vN1[2] = {voffA[0], voffA[1]};
    int gR[2], gC[2];
#pragma unroll
    for (int i = 0; i < 2; ++i) { stage_rc(tid * 16 + i * 8192, gR[i], gC[i]); }
    if constexpr (GATHER) {
#pragma unroll
        for (int i = 0; i < 2; ++i) { vC0[i] = (unsigned)(g.ridx[cur.pm * 256 + gR[i]] * g.lda + gC[i]) * 2u; vC1[i] = (unsigned)(g.ridx[cur.pm * 256 + 128 + gR[i]] * g.lda + gC[i]) * 2u; }
    }
    f32x4 acc[2][2][4][2];
#pragma unroll
    for (int a = 0; a < 2; ++a)
#pragma unroll
        for (int b = 0; b < 2; ++b)
#pragma unroll
            for (int m = 0; m < 4; ++m)
#pragma unroll
                for (int n = 0; n < 2; ++n) acc[a][b][m][n] = (f32x4){0.f, 0.f, 0.f, 0.f};
    const int sc1_ = 0x7f7f7f7f;
    bf16x8 At[4][2], B0[2][2], B1[2][2]; i32x8_ At8[4], B08[2], B18[2];
    const char* cA = (const char*)g.A + (size_t)cur.pm * tstepA; const char* cB = (const char*)g.Bt + (size_t)cur.pn * tstepB;
    S.a_ready(cur);
    if constexpr (SP2) {
        PG8_STAGE(PG8_SB(0, 0), cB, voffB); PG8_STAGE(PG8_SB(0, 1), cB + hstepB, voffB); PG8_STAGE(PG8_SA(0, 0), cA, vC0); PG8_STAGE(PG8_SA(0, 1), cA + hstepA, vC1);
        if (wr == 1) PG8_BAR;
        PG8_WAIT_V(2); PG8_BAR;
        PG8_STAGE(PG8_SB(1, 0), cB + kstep, voffB); PG8_STAGE(PG8_SA(1, 0), cA + kstep, vC0); PG8_STAGE(PG8_SB(1, 1), cB + hstepB + kstep, voffB);
        PG8_WAIT_V(6); PG8_BAR;
    } else {
        PG8_STAGE(PG8_SB(0, 0), cB, voffB); PG8_STAGE(PG8_SA(0, 0), cA, voffA); PG8_STAGE(PG8_SB(0, 1), cB + hstepB, voffB); PG8_STAGE(PG8_SA(0, 1), cA + hstepA, voffA);
        if (wr == 1) PG8_BAR;
        PG8_WAIT_V(4); PG8_BAR;
        PG8_STAGE(PG8_SB(1, 0), cB + kstep, voffB); PG8_STAGE(PG8_SA(1, 0), cA + kstep, voffA); PG8_STAGE(PG8_SB(1, 1), cB + hstepB + kstep, voffB);
        PG8_WAIT_V(6); PG8_BAR;
    }
    for (;;) {
        const bool has_next = S.next(ui + 1, nxt);
        int gi0[2] = {0, 0}, gi1[2] = {0, 0};
        if constexpr (GATHER) { if (has_next) {
#pragma unroll
            for (int i = 0; i < 2; ++i) { gi0[i] = g.ridx[nxt.pm * 256 + gR[i]]; gi1[i] = g.ridx[nxt.pm * 256 + 128 + gR[i]]; } } }
        const char* nA = has_next ? (const char*)g.A + (size_t)nxt.pm * tstepA : cA; const char* nB = has_next ? (const char*)g.Bt + (size_t)nxt.pn * tstepB : cB;
        for (int t = 0; t < nt; t += 2) {
            const bool last = (t == nt - 2);
            const char* a1 = cA + (size_t)(t + 1) * kstep;
            const char* a2 = last ? nA : cA + (size_t)(t + 2) * kstep; const char* b2 = last ? nB : cB + (size_t)(t + 2) * kstep;
            const char* a3 = a2 + kstep; const char* b3 = b2 + kstep;
            if (last && has_next) S.a_ready(nxt);
            unsigned v20[2] = {vC0[0], vC0[1]}, v21[2] = {vC1[0], vC1[1]};
            if constexpr (GATHER) { if (last && has_next) {
#pragma unroll
                for (int i = 0; i < 2; ++i) { vN0[i] = (unsigned)(gi0[i] * g.lda + gC[i]) * 2u; vN1[i] = (unsigned)(gi1[i] * g.lda + gC[i]) * 2u; v20[i] = vN0[i]; v21[i] = vN1[i]; } } }
            if constexpr (SP2) {
            PG8_LDB(B0, 0, 0); PG8_LDB(B1, 0, 1); PG8_SCHED; PG8_LDA(At, 0, 0); PG8_STAGE(PG8_SA(1, 1), a1 + hstepA, vC1);
            PG8_WAIT_V(8); PG8_WAIT_L(0); PG8_BAR; PG8_MMA(0, 0, At, B0); PG8_MMA(0, 1, At, B1); PG8_BAR; PG8_SCHED;
            PG8_LDA(At, 0, 1); PG8_STAGE(PG8_SB(0, 0), b2, voffB); PG8_STAGE(PG8_SB(0, 1), b2 + hstepB, voffB); PG8_STAGE(PG8_SA(0, 0), a2, v20);
            PG8_WAIT_V(8); PG8_WAIT_L(0); PG8_BAR; PG8_MMA(1, 0, At, B0); PG8_MMA(1, 1, At, B1); PG8_BAR; PG8_SCHED;
            PG8_LDB(B0, 1, 0); PG8_LDB(B1, 1, 1); PG8_SCHED; PG8_LDA(At, 1, 0); PG8_STAGE(PG8_SA(0, 1), a2 + hstepA, v21);
            PG8_WAIT_V(8); PG8_WAIT_L(0); PG8_BAR; PG8_MMA(0, 0, At, B0); PG8_MMA(0, 1, At, B1); PG8_BAR; PG8_SCHED;
            PG8_LDA(At, 1, 1); PG8_STAGE(PG8_SB(1, 0), b3, voffB); PG8_STAGE(PG8_SB(1, 1), b3 + hstepB, voffB); PG8_STAGE(PG8_SA(1, 0), a3, v20);
            PG8_WAIT_V(8); PG8_WAIT_L(0); PG8_BAR; PG8_MMA(1, 0, At, B0); PG8_MMA(1, 1, At, B1); PG8_BAR; PG8_SCHED;
            if constexpr (Epi::SEG > 0) { if ((t + 2) % Epi::SEG == 0 && t + 2 < nt) E.segment(acc, cur, (t + 2) / Epi::SEG, wr, wc, fr, fq); }
            } else {
            PG8_LDB(B0, 0, 0); PG8_SCHED; PG8_LDA(At, 0, 0); PG8_STAGE(PG8_SA(1, 1), a1 + hstepA, voffA);
            PG8_WAIT_L(8); PG8_BAR; PG8_WAIT_L(0); PG8_MMA(0, 0, At, B0); PG8_BAR; PG8_SCHED;
            PG8_LDB(B1, 0, 1); PG8_STAGE(PG8_SB(0, 0), b2, voffB);
            PG8_BAR; PG8_WAIT_L(0); PG8_MMA(0, 1, At, B1); PG8_BAR;
            PG8_LDA(At, 0, 1); PG8_STAGE(PG8_SA(0, 0), a2, voffA);
            PG8_BAR; PG8_WAIT_L(0); PG8_MMA(1, 0, At, B0); PG8_BAR; PG8_SCHED;
            PG8_STAGE(PG8_SB(0, 1), b2 + hstepB, voffB);
            PG8_WAIT_V(6); PG8_BAR; PG8_MMA(1, 1, At, B1); PG8_BAR;
            PG8_LDB(B0, 1, 0); PG8_SCHED; PG8_LDA(At, 1, 0); PG8_STAGE(PG8_SA(0, 1), a2 + hstepA, voffA);
            PG8_WAIT_L(8); PG8_BAR; PG8_WAIT_L(0); PG8_MMA(0, 0, At, B0); PG8_BAR; PG8_SCHED;
            PG8_LDB(B1, 1, 1); PG8_STAGE(PG8_SB(1, 0), b3, voffB);
            PG8_BAR; PG8_WAIT_L(0); PG8_MMA(0, 1, At, B1); PG8_BAR;
            PG8_LDA(At, 1, 1); PG8_STAGE(PG8_SA(1, 0), a3, voffA);
            PG8_BAR; PG8_WAIT_L(0); PG8_MMA(1, 0, At, B0); PG8_BAR; PG8_SCHED;
            PG8_STAGE(PG8_SB(1, 1), b3 + hstepB, voffB);
            PG8_WAIT_V(6); PG8_BAR; PG8_MMA(1, 1, At, B1); PG8_BAR;
            }
        }
        if constexpr (FP8) asm volatile("s_nop 15\n\ts_nop 3" ::: "memory");
        if constexpr (ALIGN_EPI) { if (wr == 0) PG8_BAR; }
        if constexpr (!Epi::AFTER_DRAIN) { E(acc, cur, wr, wc, fr, fq); S.done(cur); }
        if (!has_next) break;
#pragma unroll
        for (int a = 0; a < 2; ++a)
#pragma unroll
            for (int b = 0; b < 2; ++b)
#pragma unroll
                for (int m = 0; m < 4; ++m)
#pragma unroll
                    for (int n = 0; n < 2; ++n) acc[a][b][m][n] = (f32x4){0.f, 0.f, 0.f, 0.f};
        cur = nxt; cA = nA; cB = nB; ++ui;
        if constexpr (GATHER) { vC0[0] = vN0[0]; vC0[1] = vN0[1]; vC1[0] = vN1[0]; vC1[1] = vN1[1]; }
        if constexpr (ALIGN_EPI) { if (wr == 1) PG8_BAR; }
    }
    PG8_WAIT_V(0);
    if constexpr (!ALIGN_EPI) { if (wr == 0) PG8_BAR; }
    PG8_BAR;
    if constexpr (Epi::AFTER_DRAIN) { E.fused(acc, cur, wr, wc, fr, fq, lds, wid, lane); S.done(cur); }
#undef PG8_SA
#undef PG8_SB
#undef PG8_STAGE
#undef PG8_LDA
#undef PG8_LD16
#undef PG8_LDB
#undef PG8_MMA
#undef PG8_WAIT_V
#undef PG8_WAIT_L
#undef PG8_BAR
#undef PG8_SCHED
}
}

typedef unsigned short bf16_t;
__device__ __forceinline__ unsigned pk4_fp8(float a, float b, float c, float d) { unsigned w = 0u; w = __builtin_amdgcn_cvt_pk_fp8_f32(a, b, w, false); w = __builtin_amdgcn_cvt_pk_fp8_f32(c, d, w, true); return w; }
constexpr float F8_WGU = 64.f, F8_WD = 128.f, F8_HID = 4.f;
typedef unsigned u32x4_t __attribute__((ext_vector_type(4)));
__device__ __forceinline__ void ldg8_dw(float (&o)[8], const void* base, const unsigned (&off)[8]) {
    asm volatile("global_load_dword %0, %9, %8\n\tglobal_load_dword %1, %10, %8\n\tglobal_load_dword %2, %11, %8\n\tglobal_load_dword %3, %12, %8\n\t"
                 "global_load_dword %4, %13, %8\n\tglobal_load_dword %5, %14, %8\n\tglobal_load_dword %6, %15, %8\n\tglobal_load_dword %7, %16, %8\n\ts_waitcnt vmcnt(0)"
                 : "=&v"(o[0]), "=&v"(o[1]), "=&v"(o[2]), "=&v"(o[3]), "=&v"(o[4]), "=&v"(o[5]), "=&v"(o[6]), "=&v"(o[7])
                 : "s"(base), "v"(off[0]), "v"(off[1]), "v"(off[2]), "v"(off[3]), "v"(off[4]), "v"(off[5]), "v"(off[6]), "v"(off[7]) : "memory");
}
template <int I1, int I2, int I3>
__device__ __forceinline__ void ldg8_x4(u32x4_t (&a)[4], u32x4_t (&b)[4], const void* base, unsigned offA, unsigned offB) {
    asm volatile("global_load_dwordx4 %0, %9, %8\n\tglobal_load_dwordx4 %1, %9, %8 offset:%11\n\tglobal_load_dwordx4 %2, %9, %8 offset:%12\n\tglobal_load_dwordx4 %3, %9, %8 offset:%13\n\t"
                 "global_load_dwordx4 %4, %10, %8\n\tglobal_load_dwordx4 %5, %10, %8 offset:%11\n\tglobal_load_dwordx4 %6, %10, %8 offset:%12\n\tglobal_load_dwordx4 %7, %10, %8 offset:%13\n\ts_waitcnt vmcnt(0)"
                 : "=&v"(a[0]), "=&v"(a[1]), "=&v"(a[2]), "=&v"(a[3]), "=&v"(b[0]), "=&v"(b[1]), "=&v"(b[2]), "=&v"(b[3])
                 : "s"(base), "v"(offA), "v"(offB), "i"(I1), "i"(I2), "i"(I3) : "memory");
}
__device__ __forceinline__ void ldg8_x4v(u32x4_t (&o)[8], const void* base, const unsigned (&off)[8]) {
    asm volatile("global_load_dwordx4 %0, %9, %8\n\tglobal_load_dwordx4 %1, %10, %8\n\tglobal_load_dwordx4 %2, %11, %8\n\tglobal_load_dwordx4 %3, %12, %8\n\t"
                 "global_load_dwordx4 %4, %13, %8\n\tglobal_load_dwordx4 %5, %14, %8\n\tglobal_load_dwordx4 %6, %15, %8\n\tglobal_load_dwordx4 %7, %16, %8\n\ts_waitcnt vmcnt(0)"
                 : "=&v"(o[0]), "=&v"(o[1]), "=&v"(o[2]), "=&v"(o[3]), "=&v"(o[4]), "=&v"(o[5]), "=&v"(o[6]), "=&v"(o[7])
                 : "s"(base), "v"(off[0]), "v"(off[1]), "v"(off[2]), "v"(off[3]), "v"(off[4]), "v"(off[5]), "v"(off[6]), "v"(off[7]) : "memory");
}
template <int I1, int I2, int I3>
__device__ __forceinline__ void ldg4_x4(u32x4_t (&a)[4], const void* base, unsigned off) {
    asm volatile("global_load_dwordx4 %0, %5, %4\n\tglobal_load_dwordx4 %1, %5, %4 offset:%6\n\tglobal_load_dwordx4 %2, %5, %4 offset:%7\n\tglobal_load_dwordx4 %3, %5, %4 offset:%8\n\ts_waitcnt vmcnt(0)"
                 : "=&v"(a[0]), "=&v"(a[1]), "=&v"(a[2]), "=&v"(a[3]) : "s"(base), "v"(off), "i"(I1), "i"(I2), "i"(I3) : "memory");
}
__device__ __forceinline__ void bf8_to_f32(const u32x4_t w, float* o) {
    o[0] = __uint_as_float(w.x << 16); o[1] = __uint_as_float(w.x & 0xffff0000u); o[2] = __uint_as_float(w.y << 16); o[3] = __uint_as_float(w.y & 0xffff0000u);
    o[4] = __uint_as_float(w.z << 16); o[5] = __uint_as_float(w.z & 0xffff0000u); o[6] = __uint_as_float(w.w << 16); o[7] = __uint_as_float(w.w & 0xffff0000u);
}
struct ExpertOrder1 {
    int G, v;
    __device__ void init(int G_, int c) { G = G_; v = (G_ % 8 == 0) ? (c % 8) * (G_ / 8) + c / 8 : c; }
    __device__ bool next(int i, pg8::Unit& u) const { const int L = i * G + v; if (L >= 2048) return false; const int e = L >> 7, r = L & 127; u.pm = e * 8 + (r & 7); u.pn = e * 16 + (r >> 3); return true; }
    __device__ __forceinline__ void a_ready(const pg8::Unit&) const {}
    __device__ __forceinline__ void done(const pg8::Unit&) const {}
};
struct ExpertOrder2 {
    int G, v;
    __device__ void init(int G_, int c) { G = G_; v = (G_ % 8 == 0) ? (c % 8) * (G_ / 8) + c / 8 : c; }
    __device__ bool next(int i, pg8::Unit& u) const { const int L = i * G + v; if (L >= 512) return false; const int e = L >> 5, r = L & 31; u.pm = e * 8 + (r & 7); u.pn = e * 4 + (r >> 3); return true; }
    __device__ __forceinline__ void a_ready(const pg8::Unit&) const {}
    __device__ __forceinline__ void done(const pg8::Unit&) const {}
};
__device__ __forceinline__ float silu_fast(float x) { return x * __builtin_amdgcn_rcpf(1.f + __builtin_amdgcn_exp2f(-1.4426950408889634f * x)); }
struct EpiSwiGLU {
    static constexpr bool PERM = true, AFTER_DRAIN = false; static constexpr int SEG = 0;
    bf16_t* O; int ldc;
    __device__ __forceinline__ void operator()(const pg8::f32x4 (&acc)[2][2][4][2], const pg8::Unit& u, int wr, int wc, int fr, int fq) const {
        int row0 = u.pm * 256 + wr * 64 + fr; asm volatile("" : "+v"(row0)); const int col0 = (u.pn & 15) * 128 + wc * 32 + 8 * fq;
#pragma unroll
        for (int ai = 0; ai < 2; ++ai)
#pragma unroll
            for (int m = 0; m < 4; ++m) {
                const pg8::f32x4 g0 = acc[ai][0][m][0], g1 = acc[ai][0][m][1], u0 = acc[ai][1][m][0], u1 = acc[ai][1][m][1];
                constexpr float C1 = -1.4426950408889634f / F8_WGU, K2 = F8_WGU * F8_WGU / F8_HID;
                const pg8::f32x4 t0 = g0 * C1, t1 = g1 * C1;
                pg8::f32x4 e0, e1;
#pragma unroll
                for (int q = 0; q < 4; ++q) { e0[q] = __builtin_amdgcn_exp2f(t0[q]); e1[q] = __builtin_amdgcn_exp2f(t1[q]); }
                const pg8::f32x4 s0 = e0 * K2 + K2, s1 = e1 * K2 + K2, p0 = g0 * u0, p1 = g1 * u1;
                pg8::f32x4 r0, r1;
#pragma unroll
                for (int q = 0; q < 4; ++q) { r0[q] = __builtin_amdgcn_rcpf(s0[q]); r1[q] = __builtin_amdgcn_rcpf(s1[q]); }
                const pg8::f32x4 o0 = p0 * r0, o1 = p1 * r1;
                const unsigned w0 = pk4_fp8(o0[0], o0[1], o0[2], o0[3]), w1 = pk4_fp8(o1[0], o1[1], o1[2], o1[3]);
                *(uint2*)((unsigned char*)O + (size_t)(row0 + ai * 128 + m * 16) * ldc + col0) = make_uint2(w0, w1);
            }
    }
};
struct EpiProj {
    static constexpr bool PERM = true, AFTER_DRAIN = false; static constexpr int SEG = 0;
    bf16_t* O; const float* bias;
    __device__ __forceinline__ void operator()(const pg8::f32x4 (&acc)[2][2][4][2], const pg8::Unit& u, int wr, int wc, int fr, int fq) const {
        int row0 = u.pm * 256 + wr * 64 + fr; asm volatile("" : "+v"(row0)); const int col0 = u.pn * 256 + wc * 32 + 8 * fq; const bool gate = u.pn < 12; constexpr float L2E = 1.4426950408889634f;
        float bias8[2][8];
        if (gate) { u32x4_t t0[4], t1[4]; const unsigned o0 = (unsigned)col0 * 4u; ldg8_x4<16, 512, 528>(t0, t1, bias, o0, o0);
#pragma unroll
            for (int q = 0; q < 4; ++q) { bias8[0][q] = __uint_as_float(t0[0][q]); bias8[0][4 + q] = __uint_as_float(t0[1][q]); bias8[1][q] = __uint_as_float(t0[2][q]); bias8[1][4 + q] = __uint_as_float(t0[3][q]); } }
#pragma unroll
        for (int bj = 0; bj < 2; ++bj) {
            float b[8];
#pragma unroll
            for (int q = 0; q < 8; ++q) b[q] = gate ? bias8[bj][q] : 0.f;
#pragma unroll
            for (int ai = 0; ai < 2; ++ai)
#pragma unroll
                for (int m = 0; m < 4; ++m) { float v[8];
                    if (gate) {
                        const pg8::f32x4 nb0 = {-b[0] * L2E, -b[1] * L2E, -b[2] * L2E, -b[3] * L2E}, nb1 = {-b[4] * L2E, -b[5] * L2E, -b[6] * L2E, -b[7] * L2E};
                        const pg8::f32x4 t0 = acc[ai][bj][m][0] * -L2E + nb0, t1 = acc[ai][bj][m][1] * -L2E + nb1;
                        pg8::f32x4 e0, e1, r0, r1;
                        _Pragma("unroll") for (int q = 0; q < 4; ++q) { e0[q] = __builtin_amdgcn_exp2f(t0[q]); e1[q] = __builtin_amdgcn_exp2f(t1[q]); }
                        const pg8::f32x4 s0 = e0 + 1.f, s1 = e1 + 1.f;
                        _Pragma("unroll") for (int q = 0; q < 4; ++q) { r0[q] = __builtin_amdgcn_rcpf(s0[q]); r1[q] = __builtin_amdgcn_rcpf(s1[q]); }
                        asm volatile("s_nop 0" : "+v"(r0), "+v"(r1));
                        _Pragma("unroll") for (int q = 0; q < 4; ++q) { v[q] = r0[q]; v[4 + q] = r1[q]; } }
                    else { _Pragma("unroll") for (int q = 0; q < 8; ++q) v[q] = acc[ai][bj][m][q >> 2][q & 3]; }
                    pg8::u32x4 w; w.x = pg8::cvt_pk_bf16(v[0], v[1]); w.y = pg8::cvt_pk_bf16(v[2], v[3]); w.z = pg8::cvt_pk_bf16(v[4], v[5]); w.w = pg8::cvt_pk_bf16(v[6], v[7]);
                    *(pg8::u32x4*)(O + (size_t)(row0 + ai * 128 + m * 16) * DINP + col0 + bj * 128) = w; } }
    }
};
struct EpiQ {
    static constexpr bool PERM = false, AFTER_DRAIN = false; static constexpr int SEG = 0;
    bf16_t* Q; const float* rq; const float* rc; const float* rs;
    __device__ __forceinline__ void operator()(const pg8::f32x4 (&acc)[2][2][4][2], const pg8::Unit& u, int wr, int wc, int fr, int fq) const {
        int row0 = u.pm * 256 + wr * 64 + fr; asm volatile("" : "+v"(row0)); constexpr float SC = 0.10206207261596575f * 1.4426950408889634f;
        float sc8[8]; { unsigned off[8];
#pragma unroll
            for (int i = 0; i < 8; ++i) off[i] = (unsigned)(row0 + (i >> 2) * 128 + (i & 3) * 16) * 4u;
            ldg8_dw(sc8, rq, off); }
#pragma unroll
        for (int bj = 0; bj < 2; ++bj) { const int g32 = u.pn * 8 + bj * 4 + wc, col0 = g32 * 32 + 4 * fq; const bool rope = (g32 % 3) == 2;
#pragma unroll
            for (int ai = 0; ai < 2; ++ai) {
                u32x4_t cs4[4], sn4[4];
                if (rope) { u32x4_t t0[4], t1[4];
                    const unsigned o0 = (unsigned)((row0 + ai * 128) * 16 + 4 * fq) * 4u;
                    ldg8_x4<16 * 16 * 4, 32 * 16 * 4, 48 * 16 * 4>(t0, t1, rc, o0, o0 + (unsigned)(T * 16 * 4));
#pragma unroll
                    for (int m = 0; m < 4; ++m) { cs4[m] = t0[m]; sn4[m] = t1[m]; } }
#pragma unroll
                for (int m = 0; m < 4; ++m) { const int row = row0 + ai * 128 + m * 16; const float s = sc8[ai * 4 + m] * SC;
                    pg8::f32x4 v0 = acc[ai][bj][m][0] * s, v1 = acc[ai][bj][m][1] * s;
                    if (rope) { const pg8::f32x4 c4 = __builtin_bit_cast(pg8::f32x4, cs4[m]), s4 = __builtin_bit_cast(pg8::f32x4, sn4[m]);
                        const pg8::f32x4 x1 = v0, x2 = v1; v0 = x1 * c4 - x2 * s4; v1 = x1 * s4 + x2 * c4; }
                    bf16_t* qp = Q + (size_t)row * 768 + col0;
                    *(uint2*)qp = make_uint2(pg8::cvt_pk_bf16(v0[0], v0[1]), pg8::cvt_pk_bf16(v0[2], v0[3]));
                    *(uint2*)(qp + 16) = make_uint2(pg8::cvt_pk_bf16(v1[0], v1[1]), pg8::cvt_pk_bf16(v1[2], v1[3])); } } }
    }
};
struct EpiKV {
    static constexpr bool PERM = true, AFTER_DRAIN = false; static constexpr int SEG = 0;
    bf16_t* K; bf16_t* V; const float* rkv;
    __device__ __forceinline__ void operator()(const pg8::f32x4 (&acc)[2][2][4][2], const pg8::Unit& u, int wr, int wc, int fr, int fq) const {
        int row0 = u.pm * 256 + wr * 64 + fr; asm volatile("" : "+v"(row0));
        float sc8[8]; { unsigned off[8];
#pragma unroll
            for (int i = 0; i < 8; ++i) off[i] = (unsigned)(row0 + (i >> 2) * 128 + (i & 3) * 16) * 4u;
            ldg8_dw(sc8, rkv, off); }
#pragma unroll
        for (int bj = 0; bj < 2; ++bj) { const int head = u.pn * 2 + bj;
#pragma unroll
            for (int ai = 0; ai < 2; ++ai)
#pragma unroll
                for (int m = 0; m < 4; ++m) { const int row = row0 + ai * 128 + m * 16; const float s = sc8[ai * 4 + m];
                    const pg8::f32x4 v0 = acc[ai][bj][m][0] * s, v1 = acc[ai][bj][m][1] * s; pg8::u32x4 w;
                    w.x = pg8::cvt_pk_bf16(v0[0], v0[1]); w.y = pg8::cvt_pk_bf16(v0[2], v0[3]); w.z = pg8::cvt_pk_bf16(v1[0], v1[1]); w.w = pg8::cvt_pk_bf16(v1[2], v1[3]);
                    bf16_t* dst = (wc < 2) ? K + (size_t)row * 768 + head * 96 + wc * 32 + 8 * fq : V + (size_t)row * 512 + head * 64 + (wc - 2) * 32 + 8 * fq;
                    *(pg8::u32x4*)dst = w; } }
    }
};
struct EpiF32 {
    static constexpr bool PERM = true, AFTER_DRAIN = false; static constexpr int SEG = 0;
    float* O; int ldc; const float* rs;
    __device__ __forceinline__ void operator()(const pg8::f32x4 (&acc)[2][2][4][2], const pg8::Unit& u, int wr, int wc, int fr, int fq) const {
        int row0 = u.pm * 256 + wr * 64 + fr; asm volatile("" : "+v"(row0)); const int col0 = u.pn * 256 + wc * 32 + 8 * fq;
#pragma unroll
        for (int ai = 0; ai < 2; ++ai)
#pragma unroll
            for (int m = 0; m < 4; ++m) { const int row = row0 + ai * 128 + m * 16; const float s = rs ? rs[row] : 1.f;
#pragma unroll
                for (int bj = 0; bj < 2; ++bj) { float* op = O + (size_t)row * ldc + col0 + bj * 128;
                    *(pg8::f32x4*)op = acc[ai][bj][m][0] * s; *(pg8::f32x4*)(op + 4) = acc[ai][bj][m][1] * s; } }
    }
};
struct EpiMerge {
    static constexpr bool PERM = true, AFTER_DRAIN = false; static constexpr int SEG = 8;
    bf16_t* O; const bf16_t* GL;
    static __device__ __forceinline__ void ld8(const bf16_t* p, float* o) { const uint4 w = *(const uint4*)p;
        o[0] = __uint_as_float(w.x << 16); o[1] = __uint_as_float(w.x & 0xffff0000u); o[2] = __uint_as_float(w.y << 16); o[3] = __uint_as_float(w.y & 0xffff0000u);
        o[4] = __uint_as_float(w.z << 16); o[5] = __uint_as_float(w.z & 0xffff0000u); o[6] = __uint_as_float(w.w << 16); o[7] = __uint_as_float(w.w & 0xffff0000u); }
    __device__ __forceinline__ void segment(pg8::f32x4 (&acc)[2][2][4][2], const pg8::Unit& u, int seg, int wr, int wc, int fr, int fq) const {
        int row0 = u.pm * 256 + wr * 64 + fr; asm volatile("" : "+v"(row0));
        const unsigned cb = (unsigned)((seg - 1) * 1024 + u.pn * 256 + wc * 32 + 8 * fq) * 2u;
#pragma unroll
        for (int ai = 0; ai < 2; ++ai)
#pragma unroll
            for (int m = 0; m < 4; ++m) {
                u32x4_t ga[4];
                ldg4_x4<2048, 256, 2304>(ga, GL, (unsigned)(row0 + ai * 128 + m * 16) * (unsigned)(DINP * 2) + cb);
#pragma unroll
                for (int bj = 0; bj < 2; ++bj) { float x0[8], x1[8]; bf8_to_f32(ga[bj * 2], x0); bf8_to_f32(ga[bj * 2 + 1], x1);
#pragma unroll
                    for (int q = 0; q < 8; ++q) acc[ai][bj][m][q >> 2][q & 3] *= x0[q] * __builtin_amdgcn_rcpf(x1[q]); } }
    }
    __device__ __forceinline__ void operator()(const pg8::f32x4 (&acc)[2][2][4][2], const pg8::Unit& u, int wr, int wc, int fr, int fq) const {
        int row0 = u.pm * 256 + wr * 64 + fr; asm volatile("" : "+v"(row0)); const int col0 = u.pn * 256 + wc * 32 + 8 * fq;
        const unsigned cb = (unsigned)(2048 + col0) * 2u;
#pragma unroll
        for (int ai = 0; ai < 2; ++ai) {
            u32x4_t g8[8];
            { unsigned off[8];
#pragma unroll
              for (int i = 0; i < 8; ++i) off[i] = (unsigned)(row0 + ai * 128 + (i & 3) * 16) * (unsigned)(DINP * 2) + cb + (i >> 2) * 256u;
              ldg8_x4v(g8, GL, off); }
#pragma unroll
            for (int m = 0; m < 4; ++m) { const int row = row0 + ai * 128 + m * 16;
#pragma unroll
                for (int bj = 0; bj < 2; ++bj) { float x2[8], v[8]; bf8_to_f32(g8[bj * 4 + m], x2);
#pragma unroll
                    for (int q = 0; q < 8; ++q) v[q] = acc[ai][bj][m][q >> 2][q & 3] * x2[q];
                    pg8::u32x4 w; w.x = pg8::cvt_pk_bf16(v[0], v[1]); w.y = pg8::cvt_pk_bf16(v[2], v[3]); w.z = pg8::cvt_pk_bf16(v[4], v[5]); w.w = pg8::cvt_pk_bf16(v[6], v[7]);
                    *(pg8::u32x4*)(O + (size_t)row * DM + col0 + bj * 128) = w; } } }
    }
};
struct EpiRowScale {
    static constexpr bool PERM = true, AFTER_DRAIN = false; static constexpr int SEG = 0;
    bf16_t* O; int ldc; const float* rs;
    __device__ __forceinline__ void operator()(const pg8::f32x4 (&acc)[2][2][4][2], const pg8::Unit& u, int wr, int wc, int fr, int fq) const {
        int row0 = u.pm * 256 + wr * 64 + fr; asm volatile("" : "+v"(row0)); const int col0 = (u.pn & 3) * 256 + wc * 32 + 8 * fq;
        float sc8[8]; { unsigned off[8];
#pragma unroll
            for (int i = 0; i < 8; ++i) off[i] = (unsigned)(row0 + (i >> 2) * 128 + (i & 3) * 16) * 4u;
            ldg8_dw(sc8, rs, off); }
#pragma unroll
        for (int ai = 0; ai < 2; ++ai)
#pragma unroll
            for (int m = 0; m < 4; ++m) { const int row = row0 + ai * 128 + m * 16; const float s = sc8[ai * 4 + m] * (1.f / (F8_WD * F8_HID));
#pragma unroll
                for (int bj = 0; bj < 2; ++bj) { const pg8::f32x4 v0 = acc[ai][bj][m][0] * s, v1 = acc[ai][bj][m][1] * s; pg8::u32x4 w;
                    w.x = pg8::cvt_pk_bf16(v0[0], v0[1]); w.y = pg8::cvt_pk_bf16(v0[2], v0[3]); w.z = pg8::cvt_pk_bf16(v1[0], v1[1]); w.w = pg8::cvt_pk_bf16(v1[2], v1[3]);
                    *(pg8::u32x4*)(O + (size_t)row * ldc + col0 + bj * 128) = w; } }
    }
};
struct Params {
    const float* in[27];
    const int* pos;
    float* out;
    unsigned char* ws;
};

__device__ __forceinline__ float wave_sum(float v) {
#pragma unroll
    for (int o = 1; o < 64; o <<= 1) v += __shfl_xor(v, o);
    return v;
}
__device__ __forceinline__ float sigmoidf_(float x) { return 1.f / (1.f + expf(-x)); }
__device__ __forceinline__ float siluf_(float x) { return x / (1.f + expf(-x)); }
__device__ __forceinline__ float log_sigmoidf_(float x) { return fminf(x, 0.f) - log1pf(expf(-fabsf(x))); }

__device__ __forceinline__ float bf2f(bf16_t u) { return __uint_as_float((unsigned)u << 16); }
__device__ __forceinline__ unsigned f2bf(float f) { unsigned u = __float_as_uint(f); return (u + 0x7fffu + ((u >> 16) & 1u)) >> 16; }
__device__ __forceinline__ unsigned pk2(float lo, float hi) { return f2bf(lo) | (f2bf(hi) << 16); }
__device__ __forceinline__ void ld4bf(const bf16_t* p, float* o) {
    const uint2 w = *(const uint2*)p; o[0] = __uint_as_float(w.x << 16); o[1] = __uint_as_float(w.x & 0xffff0000u); o[2] = __uint_as_float(w.y << 16); o[3] = __uint_as_float(w.y & 0xffff0000u);
}
__device__ __forceinline__ void transpose_block(const float* Wblk, int ldw, bf16_t* dst, int ldt, const float* ks, const float* ns, float* scr, int lane) {
#pragma unroll 8
    for (int i = 0; i < 32; ++i) { const int kk = 2 * i + (lane >> 5); float v = __builtin_nontemporal_load(&Wblk[(size_t)kk * ldw + (lane & 31)]);     if (ks) v *= ks[kk]; if (ns) v *= ns[lane & 31]; scr[kk * 33 + (lane & 31)] = v; }
    asm volatile("s_waitcnt lgkmcnt(0)" ::: "memory");
    const int c = lane & 7;
#pragma unroll
    for (int j = 0; j < 4; ++j) { const int n = (lane >> 3) + 8 * j; const float* s = scr + (8 * c) * 33 + n;
        uint4 o; o.x = pk2(s[0 * 33], s[1 * 33]); o.y = pk2(s[2 * 33], s[3 * 33]); o.z = pk2(s[4 * 33], s[5 * 33]); o.w = pk2(s[6 * 33], s[7 * 33]);
        *(uint4*)(dst + (size_t)n * ldt + 8 * c) = o; }
    asm volatile("s_waitcnt lgkmcnt(0)" ::: "memory");
}

struct WStream {
    const float* gate; const float* up; const float* down;
    unsigned char* wgu_t; unsigned char* wd_t;
    const char* rowp; unsigned rs8, rs1;
    unsigned vo0;
    const float* src; unsigned char* dst; int ldt; float sc;
    int it, it_stride, step, nsteps;
    float v0, v1, v2, v3;
    char* blk; char* blkw;
    __device__ __forceinline__ void init(int gw, int ngw, char* lds_blk, int lane) {
        constexpr int I_ALL = 2 * 16 * 16 * 64 + 16 * 32 * 32;
        nsteps = (gw < I_ALL) ? 8 * ((I_ALL - gw + ngw - 1) / ngw) : 0;
        if (I_ALL % ngw == 0) { const int per_wg = I_ALL / (ngw >> 3); gw = (gw >> 3) * per_wg + (gw & 7); ngw = 8; nsteps = per_wg; }
        it = gw; it_stride = ngw; step = 0; blk = lds_blk; blkw = lds_blk + (lane & 31) * 80 + 4 * (lane >> 5);
        src = gate; rowp = (const char*)gate; rs8 = 0u; rs1 = 0u; vo0 = 0u; dst = wgu_t; ldt = DM; sc = 1.f; v0 = v1 = v2 = v3 = 0.f;
    }
    __device__ __forceinline__ void rare(int lane) {
        if (step >= 8 && step <= nsteps) {
            const int nr = lane >> 1, hf = lane & 1;
            const uint4 a = *(const uint4*)(blk + nr * 80 + hf * 32), b = *(const uint4*)(blk + nr * 80 + hf * 32 + 16);
            unsigned char* q = dst + (size_t)nr * ldt + hf * 32;
            { typedef unsigned u32x4n __attribute__((ext_vector_type(4))); const u32x4n an = {a.x, a.y, a.z, a.w}, bn = {b.x, b.y, b.z, b.w};
              __builtin_nontemporal_store(an, (u32x4n*)q); __builtin_nontemporal_store(bn, (u32x4n*)(q + 16)); }
        }
        if (step < nsteps) {
            constexpr int I_G = 16 * 16 * 64; int ldw;
            if (it < 2 * I_G) { const int up_ = it >= I_G, r_ = up_ ? it - I_G : it, e_ = r_ >> 10, kb_ = (r_ >> 6) & 15, nb_ = r_ & 63, j0_ = nb_ * 32;
                src = (up_ ? up : gate) + (size_t)e_ * DM * DEXP + (size_t)(64 * kb_) * DEXP + j0_; ldw = DEXP;
                dst = wgu_t + (size_t)(e_ * 4096 + 256 * (j0_ >> 7) + (j0_ & 127) + (up_ ? 128 : 0)) * DM + 64 * kb_; ldt = DM; sc = F8_WGU; }
            else { const int r_ = it - 2 * I_G, e_ = r_ >> 10, kb_ = (r_ >> 5) & 31, nb_ = r_ & 31;
                src = down + (size_t)e_ * DEXP * DM + (size_t)(64 * kb_) * DM + 32 * nb_; ldw = DM; dst = wd_t + (size_t)(e_ * 1024 + 32 * nb_) * DEXP + 64 * kb_; ldt = DEXP; sc = F8_WD; }
            it += it_stride;
            rowp = (const char*)src; rs8 = (unsigned)ldw * 32u; rs1 = (unsigned)ldw * 4u;
            vo0 = (unsigned)((4 * (lane >> 5)) * ldw + (lane & 31)) * 4u;
        } else { rowp = (const char*)src; rs8 = 0u; rs1 = 0u; vo0 = (unsigned)(lane & 31) * 4u; }
    }
    __device__ __forceinline__ void tick(int lane) {
        *(unsigned*)(blkw + ((step - 1) & 7) * 8) = pk4_fp8(v0 * sc, v1 * sc, v2 * sc, v3 * sc);
        if ((step & 7) == 0) rare(lane);
        v0 = __builtin_nontemporal_load((const float*)(rowp + vo0)); v1 = __builtin_nontemporal_load((const float*)(rowp + rs1 + vo0));
        v2 = __builtin_nontemporal_load((const float*)(rowp + 2 * rs1 + vo0)); v3 = __builtin_nontemporal_load((const float*)(rowp + 3 * rs1 + vo0));
        rowp += rs8; ++step;
    }
};

namespace att {
using bf16x8 = __attribute__((ext_vector_type(8))) short;
using s16x4  = __attribute__((ext_vector_type(4))) short;
using f32x16 = __attribute__((ext_vector_type(16))) float;
using u32x4  = __attribute__((ext_vector_type(4))) unsigned;
constexpr int NW = 8, QBLK = 32, KVBLK = 64;
constexpr int LDQ = 768, LDK = 768, LDV = 512, LDO = 1536;
constexpr int KROWB = 208;
constexpr int SHM_K = KVBLK * KROWB, SHM_V = KVBLK * 64 * 2;
constexpr int NBUF = 3;
constexpr int SHM_ATTN = NBUF * SHM_V + NBUF * SHM_K + NW * 64 * 4;
constexpr float THR = 8.f;
#define ASBAR() __builtin_amdgcn_sched_barrier(0)
__device__ __forceinline__ int crow(int r, int hi) { return (r & 3) + 8 * (r >> 2) + 4 * hi; }
__device__ __forceinline__ unsigned cvtpk(float lo, float hi) { unsigned r; asm volatile("v_cvt_pk_bf16_f32 %0, %1, %2" : "=v"(r) : "v"(lo), "v"(hi)); return r; }
#define MX3(a, b, c) __builtin_fmaxf(__builtin_fmaxf((a), (b)), (c))
template <bool FIRST>
__device__ __forceinline__ void partialSM(f32x16& p0, f32x16& p1, float& m_ref, f32x16& negm, float& alpha) {
  constexpr float THRL = THR * 1.4426950408889634f;
  float a = MX3(p0[0], p0[1], p1[0]), b = MX3(p0[2], p0[3], p1[1]); a = MX3(a, p1[2], p1[3]);
#pragma unroll
  for (int r = 4; r < 16; r += 4) { a = MX3(a, p0[r], p0[r + 1]); b = MX3(b, p0[r + 2], p0[r + 3]); a = MX3(a, p1[r], p1[r + 1]); b = MX3(b, p1[r + 2], p1[r + 3]); }
  float pmax = fmaxf(a, b);
  { auto rr = __builtin_amdgcn_permlane32_swap(__float_as_uint(pmax), __float_as_uint(pmax), false, false);
    pmax = fmaxf(__uint_as_float(rr[0]), __uint_as_float(rr[1])); }
  alpha = 1.f;
  if (FIRST || !__builtin_expect(__all(pmax <= THRL), 1)) {
    const float dl = FIRST ? pmax : fmaxf(pmax, 0.f); m_ref += dl;
#pragma unroll
    for (int r = 0; r < 16; ++r) { p0[r] -= dl; p1[r] -= dl; }
#pragma unroll
    for (int r = 0; r < 16; ++r) negm[r] = -m_ref;
    asm volatile("" : "+v"(negm));
    if (!FIRST) alpha = __builtin_amdgcn_exp2f(-dl);
  }
#pragma unroll
  for (int r = 0; r < 16; ++r) p0[r] = __builtin_amdgcn_exp2f(p0[r]);
}
#undef MX3
__device__ __forceinline__ void finishSM(f32x16& p0, f32x16& p1, float alpha, float& l_reg, bf16x8& pa0, bf16x8& pa1, bf16x8& pa2, bf16x8& pa3) {
  for (int r = 0; r < 16; ++r) p1[r] = __builtin_amdgcn_exp2f(p1[r]);
  float ps = 0; for (int r = 0; r < 16; ++r) ps += p0[r]; for (int r = 0; r < 16; ++r) ps += p1[r];
  { auto rr = __builtin_amdgcn_permlane32_swap(__float_as_uint(ps), __float_as_uint(ps), false, false);
    ps = __uint_as_float(rr[0]) + __uint_as_float(rr[1]); }
  l_reg = l_reg * alpha + ps;
#define PK4(P, BASE, OUT) do { u32x4 w = {cvtpk(P[BASE + 0], P[BASE + 1]), cvtpk(P[BASE + 2], P[BASE + 3]), cvtpk(P[BASE + 4], P[BASE + 5]), cvtpk(P[BASE + 6], P[BASE + 7])}; \
    OUT = *reinterpret_cast<bf16x8*>(&w); } while (0)
  PK4(p0, 0, pa0); PK4(p0, 8, pa1); PK4(p1, 0, pa2); PK4(p1, 8, pa3);
#undef PK4
}
__device__ __forceinline__ void qkt(f32x16& p0, f32x16& p1, const char* Ks, const bf16x8* qr, const f32x16& negm, int r32, int hi) {
  p0 = negm; p1 = negm;
#pragma unroll
  for (int d0 = 0; d0 < 6; ++d0) { const int cb = d0 * 32 + hi * 16;
    bf16x8 b0 = *reinterpret_cast<const bf16x8*>(Ks + r32 * KROWB + cb);
    bf16x8 b1 = *reinterpret_cast<const bf16x8*>(Ks + (32 + r32) * KROWB + cb);
    p0 = __builtin_amdgcn_mfma_f32_32x32x16_bf16(b0, qr[d0], p0, 0, 0, 0);
    p1 = __builtin_amdgcn_mfma_f32_32x32x16_bf16(b1, qr[d0], p1, 0, 0, 0); }
}
__device__ __forceinline__ int v_st(int k, int c) { const int kk = k;   return ((kk >> 3) * 2 + (c >> 5)) * 512 + ((kk & 7) * 32 + (c & 31)) * 2; }
__device__ __forceinline__ int v_rd_base(int lane) { return ((lane & 3) << 3) | (((lane >> 2) & 3) << 6) | (((lane >> 4) & 1) << 5) | (((lane >> 5) & 1) << 8); }
constexpr int v_rd_off(int d0, int ks, int half) { return d0 * 512 + ks * 2048 + half * 1024; }
template <int OFF> __device__ __forceinline__ s16x4 tr_read(int vb) {
  s16x4 r; asm volatile("ds_read_b64_tr_b16 %0, %1 offset:%2" : "=&v"(r) : "v"(vb), "i"(OFF) : "memory"); return r;
}
template <int D0> __device__ __forceinline__ void pv_one(f32x16& od, int vb, bf16x8 pa0, bf16x8 pa1, bf16x8 pa2, bf16x8 pa3) {
  const s16x4 l0 = tr_read<v_rd_off(D0, 0, 0)>(vb), h0 = tr_read<v_rd_off(D0, 0, 1)>(vb), l1 = tr_read<v_rd_off(D0, 1, 0)>(vb), h1 = tr_read<v_rd_off(D0, 1, 1)>(vb);
  const s16x4 l2 = tr_read<v_rd_off(D0, 2, 0)>(vb), h2 = tr_read<v_rd_off(D0, 2, 1)>(vb), l3 = tr_read<v_rd_off(D0, 3, 0)>(vb), h3 = tr_read<v_rd_off(D0, 3, 1)>(vb);
  asm volatile("s_waitcnt lgkmcnt(0)" ::: "memory"); ASBAR();
#define PK(L, H) (bf16x8){L[0], L[1], L[2], L[3], H[0], H[1], H[2], H[3]}
  od = __builtin_amdgcn_mfma_f32_32x32x16_bf16(pa0, PK(l0, h0), od, 0, 0, 0);
  od = __builtin_amdgcn_mfma_f32_32x32x16_bf16(pa1, PK(l1, h1), od, 0, 0, 0);
  od = __builtin_amdgcn_mfma_f32_32x32x16_bf16(pa2, PK(l2, h2), od, 0, 0, 0);
  od = __builtin_amdgcn_mfma_f32_32x32x16_bf16(pa3, PK(l3, h3), od, 0, 0, 0);
#undef PK
}
__device__ __forceinline__ void pv_d0(f32x16* o, int vb, bf16x8 pa0, bf16x8 pa1, bf16x8 pa2, bf16x8 pa3) {
  pv_one<0>(o[0], vb, pa0, pa1, pa2, pa3); pv_one<1>(o[1], vb, pa0, pa1, pa2, pa3);
}
__device__ __forceinline__ void attn_unit(const bf16_t* Qb, const bf16_t* Kh, const bf16_t* Vh, bf16_t* Ob, int seq, char* lds, WStream& wst) {
  int tid_ = threadIdx.x; asm volatile("" : "+v"(tid_));
  const int tid = tid_, wid = tid >> 6, lane = tid & 63, r32 = lane & 31, hi = lane >> 5;
  char* V_lds = lds; char* K_lds = lds + NBUF * SHM_V;
  float* ws = (float*)(lds + NBUF * SHM_V + NBUF * SHM_K) + wid * 64; float* li_l = ws; float* al_l = ws + 32;
  float m_ref = 0.f, l_reg = 0; f32x16 o[2] = {}; bf16x8 qr[6]; f32x16 negm = {}; asm volatile("" : "+v"(negm));
  const bf16_t* Qw = Qb + (long)(wid * QBLK + r32) * LDQ + hi * 8;
#pragma unroll
  for (int d0 = 0; d0 < 6; ++d0) qr[d0] = *reinterpret_cast<const bf16x8*>(Qw + d0 * 16);
  const bool kact = tid < 384; const int kr = tid / 12, kc = tid - kr * 12, vr = tid >> 3, vc = (tid & 7) * 8, vst0 = v_st(vr, vc);
  const int kst0 = kr * KROWB + kc * 16, kst1 = (kr + 32) * KROWB + kc * 16;
  const int vb0 = (int)(uintptr_t)V_lds + v_rd_base(lane);
  struct { bf16x8 vs, ks0, ks1; } sr_[2];
#define SLOAD(i, k0) do { sr_[i].vs = *reinterpret_cast<const bf16x8*>(&Vh[(long)((k0) + vr) * LDV + vc]); \
    if (kact) { sr_[i].ks0 = *reinterpret_cast<const bf16x8*>(&Kh[(long)((k0) + kr) * LDK + kc * 8]); sr_[i].ks1 = *reinterpret_cast<const bf16x8*>(&Kh[(long)((k0) + 32 + kr) * LDK + kc * 8]); } } while (0)
#define SWRITE(b, i) do { *(bf16x8*)(V_lds + (b) * SHM_V + vst0) = sr_[i].vs; \
    if (kact) { *(bf16x8*)(K_lds + (b) * SHM_K + kst0) = sr_[i].ks0; *(bf16x8*)(K_lds + (b) * SHM_K + kst1) = sr_[i].ks1; } } while (0)
#define SWAIT() asm volatile("s_waitcnt vmcnt(3)" ::: "memory")
#define RESC(a) do { if (__any((a) < 1.f)) { if (hi == 0) al_l[r32] = (a); asm volatile("s_waitcnt lgkmcnt(0)" ::: "memory"); \
    for (int d = 0; d < 2; ++d) for (int r = 0; r < 16; ++r) o[d][r] *= al_l[crow(r, hi)]; } } while (0)
  f32x16 pA0, pA1, pB0, pB1; float alA, alB; bf16x8 pa0, pa1, pa2, pa3; const int NT = seq / KVBLK;
  constexpr int SE = 0, SO = 1;
  int b_prev = 0, b_cur = 1, b_next = 2;
#define ROT() do { b_prev = b_cur; b_cur = b_next; b_next = (b_next == NBUF - 1) ? 0 : b_next + 1; } while (0)
  SLOAD(SE, 0); asm volatile("s_waitcnt vmcnt(0)" ::: "memory"); SWRITE(0, SE);
  SLOAD(SO, KVBLK); if (2 < NT) SLOAD(SE, 2 * KVBLK);
  if (__builtin_amdgcn_readfirstlane(tid) >= 256) __builtin_amdgcn_s_setprio(1);
  __syncthreads();
  qkt(pA0, pA1, K_lds, qr, negm, r32, hi); partialSM<true>(pA0, pA1, m_ref, negm, alA);
  SWAIT(); SWRITE(1, SO); __syncthreads();
  for (int j = 1; j + 1 < NT; j += 2) {
    SLOAD(SO, (j + 2) * KVBLK);
    ASBAR(); qkt(pB0, pB1, K_lds + b_cur * SHM_K, qr, negm, r32, hi);
    finishSM(pA0, pA1, alA, l_reg, pa0, pa1, pa2, pa3); ASBAR();
    pv_d0(o, vb0 + b_prev * SHM_V, pa0, pa1, pa2, pa3); partialSM<false>(pB0, pB1, m_ref, negm, alB);
    SWAIT(); SWRITE(b_next, SE);
    RESC(alB); if (wst.step <= wst.nsteps) wst.tick(lane); __syncthreads(); ROT();
    if (j + 3 < NT) SLOAD(SE, (j + 3) * KVBLK);
    ASBAR(); qkt(pA0, pA1, K_lds + b_cur * SHM_K, qr, negm, r32, hi);
    finishSM(pB0, pB1, alB, l_reg, pa0, pa1, pa2, pa3); ASBAR();
    pv_d0(o, vb0 + b_prev * SHM_V, pa0, pa1, pa2, pa3); partialSM<false>(pA0, pA1, m_ref, negm, alA);
    SWAIT(); SWRITE(b_next, SO);
    RESC(alA); if (wst.step <= wst.nsteps) wst.tick(lane); __syncthreads(); ROT();
  }
  ASBAR(); qkt(pB0, pB1, K_lds + b_cur * SHM_K, qr, negm, r32, hi);
  finishSM(pA0, pA1, alA, l_reg, pa0, pa1, pa2, pa3); ASBAR();
  pv_d0(o, vb0 + b_prev * SHM_V, pa0, pa1, pa2, pa3); partialSM<false>(pB0, pB1, m_ref, negm, alB);
  RESC(alB);
  finishSM(pB0, pB1, alB, l_reg, pa0, pa1, pa2, pa3); ASBAR();
  pv_d0(o, vb0 + b_cur * SHM_V, pa0, pa1, pa2, pa3);
#undef ROT
  __builtin_amdgcn_s_setprio(0);
  if (hi == 0) li_l[r32] = l_reg; asm volatile("s_waitcnt lgkmcnt(0)" ::: "memory");
  float rli[16];
#pragma unroll
  for (int r = 0; r < 16; ++r) rli[r] = __builtin_amdgcn_rcpf(li_l[crow(r, hi)]);
  bf16_t* Ow = Ob + (long)(wid * QBLK) * LDO;
#pragma unroll
  for (int r = 0; r < 16; ++r) { const int orow = crow(r, hi);
#pragma unroll
    for (int d0 = 0; d0 < 2; ++d0) Ow[(long)orow * LDO + d0 * 32 + r32] = (bf16_t)f2bf(o[d0][r] * rli[r]); }
  __syncthreads();
#undef SLOAD
#undef SWRITE
#undef SWAIT
#undef RESC
}
#undef ASBAR
}

namespace gla {
using bf16x8 = __attribute__((ext_vector_type(8))) short;
using s16x4  = __attribute__((ext_vector_type(4))) short;
using f32x16 = __attribute__((ext_vector_type(16))) float;
using u32x4  = __attribute__((ext_vector_type(4))) unsigned;
constexpr int L_DL = 0, L_TOT = 8192, L_RSUM = 10240, L_V = 12288, L_QF = 28672, L_KF = 37888, L_QB = 47104, L_KB = 56320, L_KSTF = 65536, L_KSTB = 74752, L_STF = 65536, L_STB = 83968, L_QR = 102400, L_KR = 110592, L_END = 118784;
constexpr int RB = 144;
__device__ __forceinline__ int crow(int r, int hi) { return (r & 3) + 8 * (r >> 2) + 4 * hi; }
__device__ __forceinline__ unsigned cvtpk(float lo, float hi) { unsigned r; asm volatile("v_cvt_pk_bf16_f32 %0, %1, %2" : "=v"(r) : "v"(lo), "v"(hi)); return r; }
__device__ __forceinline__ int v_st4(int k, int c) { const int kk = (k & ~0xC) | ((k & 4) << 1) | ((k & 8) >> 1); return ((kk >> 3) * 4 + (c >> 5)) * 512 + ((kk & 7) * 32 + (c & 31)) * 2; }
__device__ __forceinline__ int v_rd_base(int lane) { return ((lane & 3) << 3) | (((lane >> 2) & 3) << 6) | (((lane >> 4) & 1) << 5) | (((lane >> 5) & 1) << 8); }
template <int OFF> __device__ __forceinline__ s16x4 tr_read(int vb) { s16x4 r; asm volatile("ds_read_b64_tr_b16 %0, %1 offset:%2" : "=&v"(r) : "v"(vb), "i"(OFF) : "memory"); return r; }
__device__ __forceinline__ void v_frags(int vb, bf16x8 (&f)[4]) {
  const s16x4 l0 = tr_read<0>(vb), h0 = tr_read<2048>(vb), l1 = tr_read<4096>(vb), h1 = tr_read<4096 + 2048>(vb);
  const s16x4 l2 = tr_read<8192>(vb), h2 = tr_read<8192 + 2048>(vb), l3 = tr_read<12288>(vb), h3 = tr_read<12288 + 2048>(vb);
  asm volatile("s_waitcnt lgkmcnt(0)" ::: "memory"); __builtin_amdgcn_sched_barrier(0);
#define PK(L, H) (bf16x8){L[0], L[1], L[2], L[3], H[0], H[1], H[2], H[3]}
  f[0] = PK(l0, h0); f[1] = PK(l1, h1); f[2] = PK(l2, h2); f[3] = PK(l3, h3);
#undef PK
}
__device__ __forceinline__ bf16x8 frag(const char* base, int row, int ks, int hi) { return *reinterpret_cast<const bf16x8*>(base + row * RB + ks * 32 + hi * 16); }

template <bool IS_G1>
__device__ __forceinline__ void prep(char* lds, const bf16_t* projb, const float* wdec, const float* bdec, int t0, int hh, float* dec_out  , long dec_dir_stride, const bf16_t* st0 = nullptr, long st_dir_stride = 0) {
  int tid_ = threadIdx.x; asm volatile("" : "+v"(tid_)); const int tid = tid_;
  float* DL = (float*)(lds + L_DL); float* TOT = (float*)(lds + L_TOT);
  const int cidx = tid & 127, tg = tid >> 7, dir = cidx >> 6, d = cidx & 63;
  const int i_ = tid >> 3, r4_ = (tid & 7) * 4, c8_ = (tid & 7) * 8;
  const uint2 dlraw = *(const uint2*)(projb + (size_t)(t0 + i_) * DINP + OFF_GDEC + r4_);
  const uint4 kraw = *(const uint4*)(projb + (size_t)(t0 + i_) * DINP + OFF_GK + hh * 64 + c8_);
  uint4 qraw = make_uint4(0u, 0u, 0u, 0u); if constexpr (!IS_G1) qraw = *(const uint4*)(projb + (size_t)(t0 + i_) * DINP + OFF_GQ + hh * 64 + c8_);
  uint4 vraw[2];
#pragma unroll
  for (int e2 = 0; e2 < 2; ++e2) { const int e = tid + e2 * 512, i = e >> 4, cc = (e & 15) * 8; vraw[e2] = *(const uint4*)(projb + (size_t)(t0 + i) * DINP + OFF_GV + hh * 128 + cc); }
  uint4 sraw[4];
  if constexpr (!IS_G1) {
#pragma unroll
    for (int e4 = 0; e4 < 4; ++e4) { const int e = tid + e4 * 512, sdir = e >> 10, v = (e >> 3) & 127, dc = (e & 7) * 8; sraw[e4] = *(const uint4*)(st0 + (long)sdir * st_dir_stride + (size_t)v * 64 + dc); } }
  float W[16];
#pragma unroll
  for (int r = 0; r < 16; ++r) W[r] = wdec[(size_t)(dir * 16 + r) * 256 + hh * 64 + d];
  const float bias = bdec[dir * 256 + hh * 64 + d];
  { *(float4*)(DL + i_ * 32 + r4_) = make_float4(__uint_as_float(dlraw.x << 16), __uint_as_float(dlraw.x & 0xffff0000u), __uint_as_float(dlraw.y << 16), __uint_as_float(dlraw.y & 0xffff0000u));
    *(uint4*)(lds + L_KR + i_ * 128 + c8_ * 2) = kraw;
    if constexpr (!IS_G1) *(uint4*)(lds + L_QR + i_ * 128 + c8_ * 2) = qraw; }
#pragma unroll
  for (int e2 = 0; e2 < 2; ++e2) { const int e = tid + e2 * 512, i = e >> 4, cc = (e & 15) * 8; *(uint4*)(lds + L_V + v_st4(i, cc)) = vraw[e2]; }
  if constexpr (!IS_G1) {
#pragma unroll
    for (int e4 = 0; e4 < 4; ++e4) { const int e = tid + e4 * 512, sdir = e >> 10, v = (e >> 3) & 127, dc = (e & 7) * 8; *(uint4*)(lds + (sdir ? L_STB : L_STF) + v * RB + dc * 2) = sraw[e4]; } }
  __syncthreads();
  constexpr float L2E = 1.4426950408889634f;
  float g[16], cs[16]; float run = 0.f;
#pragma unroll
  for (int ii = 0; ii < 16; ++ii) { const float* dl = DL + (16 * tg + ii) * 32 + dir * 16; float a = bias;
    typedef float f32x2p __attribute__((ext_vector_type(2))); f32x2p acc2 = {a, 0.f};
#pragma unroll
    for (int r = 0; r < 16; r += 4) { const float4 x = *(const float4*)(dl + r); acc2 = __builtin_elementwise_fma((f32x2p){x.x, x.y}, (f32x2p){W[r], W[r + 1]}, acc2); acc2 = __builtin_elementwise_fma((f32x2p){x.z, x.w}, (f32x2p){W[r + 2], W[r + 3]}, acc2); }
    a = acc2.x + acc2.y;
    g[ii] = (fminf(a, 0.f) * L2E - __builtin_amdgcn_logf(1.f + __builtin_amdgcn_exp2f(-fabsf(a) * L2E))) * (1.f / 16.f); run += g[ii]; cs[ii] = run; }
  TOT[tg * 128 + cidx] = run;
  __syncthreads();
  const float t0s = TOT[cidx], t1s = TOT[128 + cidx], t2s = TOT[256 + cidx], t3s = TOT[384 + cidx], tall = (t0s + t1s) + (t2s + t3s);
  const float off_lo = (tg > 0 ? t0s : 0.f) + (tg > 1 ? t1s : 0.f) + (tg > 2 ? t2s : 0.f);
  const float off_hi = (tg < 1 ? t1s : 0.f) + (tg < 2 ? t2s : 0.f) + (tg < 3 ? t3s : 0.f);
  const bf16_t* KR = (const bf16_t*)(lds + L_KR); const bf16_t* QR = (const bf16_t*)(lds + L_QR);
  if constexpr (IS_G1) {
    unsigned pk[8];
#pragma unroll
    for (int ii = 0; ii < 16; ii += 2) {
      float kv2[2];
#pragma unroll
      for (int u = 0; u < 2; ++u) { const int i = 16 * tg + ii + u; const float bi = dir == 0 ? off_lo + cs[ii + u] : off_hi + run - cs[ii + u] + g[ii + u];
        kv2[u] = bf2f(KR[i * 64 + d]) * __builtin_amdgcn_exp2f(tall - bi); }
      pk[ii >> 1] = cvtpk(kv2[0], kv2[1]); }
    char* dst = lds + (dir ? L_KSTB : L_KSTF) + d * RB + 32 * tg;
    *(uint4*)dst = make_uint4(pk[0], pk[1], pk[2], pk[3]); *(uint4*)(dst + 16) = make_uint4(pk[4], pk[5], pk[6], pk[7]);
    if (tg == 0) dec_out[dir * dec_dir_stride + d] = __builtin_amdgcn_exp2f(tall);
  } else {
    bf16_t* Qx = (bf16_t*)(lds + (dir ? L_QB : L_QF)); bf16_t* Kx = (bf16_t*)(lds + (dir ? L_KB : L_KF));
#pragma unroll
    for (int ii = 0; ii < 16; ++ii) { const int i = 16 * tg + ii; const float bi = dir == 0 ? off_lo + cs[ii] : off_hi + run - cs[ii] + g[ii];
      const float qv = bf2f(QR[i * 64 + d]) * 0.125f, kv = bf2f(KR[i * 64 + d]);
      Qx[i * (RB / 2) + d] = (bf16_t)f2bf(qv * __builtin_amdgcn_exp2f(bi)); Kx[i * (RB / 2) + d] = (bf16_t)f2bf(kv * __builtin_amdgcn_exp2f(-bi)); }
  }
  __syncthreads();
}

__device__ __forceinline__ void g1_item(char* lds, const bf16_t* projb, const float* wdec, const float* bdec, int b, int hh, int c, float* kvt, float* dec) {
  int tid_ = threadIdx.x; asm volatile("" : "+v"(tid_)); const int tid = tid_, wid = tid >> 6, lane = tid & 63, r32 = lane & 31, hi = lane >> 5;
  const int bh = b * 4 + hh; const long item = (long)bh * 128 + c, dstride = 8L * 128;
  prep<true>(lds, projb, wdec, bdec, b * SEQ + c * 64, hh, dec + item * 64, dstride * 64);
  const int vblk = wid >> 1, dblk = wid & 1;
  bf16x8 vf[4]; v_frags((int)(uintptr_t)(lds + L_V) + v_rd_base(lane) + vblk * 512, vf);
#pragma unroll
  for (int dir = 0; dir < 2; ++dir) { const char* kst = lds + (dir ? L_KSTB : L_KSTF); f32x16 acc = {};
#pragma unroll
    for (int ks = 0; ks < 4; ++ks) acc = __builtin_amdgcn_mfma_f32_32x32x16_bf16(vf[ks], frag(kst, dblk * 32 + r32, ks, hi), acc, 0, 0, 0);
    float* o = kvt + ((long)dir * dstride + item) * 8192 + (size_t)(vblk * 32) * 64 + dblk * 32 + r32;
#pragma unroll
    for (int r = 0; r < 16; ++r) o[crow(r, hi) * 64] = acc[r]; }
  __syncthreads();
}

__device__ __forceinline__ void g3_item(char* lds, const bf16_t* projb, const float* wdec, const float* bdec, const float* normg, int b, int hh, int c, const bf16_t* st, bf16_t* out, int ldo) {
  int tid_ = threadIdx.x; asm volatile("" : "+v"(tid_)); const int tid = tid_, wid = tid >> 6, lane = tid & 63, r32 = lane & 31, hi = lane >> 5;
  const int bh = b * 4 + hh, t0 = b * SEQ + c * 64; const long item = (long)bh * 128 + c, dstride = 8L * 128;
  const int ib = wid & 1, vblk = wid >> 1, iglob = ib * 32 + r32;
  bf16_t rgr[16];
#pragma unroll
  for (int r = 0; r < 16; ++r) rgr[r] = projb[(size_t)(t0 + ib * 32 + crow(r, hi)) * DINP + OFF_GR + hh * 128 + vblk * 32 + r32];
  const float ng = normg[vblk * 32 + r32];
  prep<false>(lds, projb, wdec, bdec, t0, hh, nullptr, 0, st + item * 8192, dstride * 8192);
  f32x16 pF0 = {}, pF1 = {}, pB0 = {}, pB1 = {};
#pragma unroll
  for (int ks = 0; ks < 4; ++ks) {
    const bf16x8 qf = frag(lds + L_QF, iglob, ks, hi), qb = frag(lds + L_QB, iglob, ks, hi);
    pF0 = __builtin_amdgcn_mfma_f32_32x32x16_bf16(frag(lds + L_KF, r32, ks, hi), qf, pF0, 0, 0, 0);
    pF1 = __builtin_amdgcn_mfma_f32_32x32x16_bf16(frag(lds + L_KF, 32 + r32, ks, hi), qf, pF1, 0, 0, 0);
    pB0 = __builtin_amdgcn_mfma_f32_32x32x16_bf16(frag(lds + L_KB, r32, ks, hi), qb, pB0, 0, 0, 0);
    pB1 = __builtin_amdgcn_mfma_f32_32x32x16_bf16(frag(lds + L_KB, 32 + r32, ks, hi), qb, pB1, 0, 0, 0); }
#pragma unroll
  for (int r = 0; r < 16; ++r) { const int j0 = crow(r, hi), j1 = 32 + j0;
    pF0[r] = (j0 <= iglob ? pF0[r] : 0.f) + (j0 >= iglob ? pB0[r] : 0.f);
    pF1[r] = (j1 <= iglob ? pF1[r] : 0.f) + (j1 >= iglob ? pB1[r] : 0.f); }
  bf16x8 pa0, pa1, pa2, pa3;
#define PK4(P, BASE, OUT) do { unsigned a0 = cvtpk(P[BASE + 0], P[BASE + 1]), a1 = cvtpk(P[BASE + 2], P[BASE + 3]);   \
    unsigned b0 = cvtpk(P[BASE + 4], P[BASE + 5]), b1 = cvtpk(P[BASE + 6], P[BASE + 7]);                              \
    auto r0 = __builtin_amdgcn_permlane32_swap(a0, b0, false, false); auto r1 = __builtin_amdgcn_permlane32_swap(a1, b1, false, false); \
    u32x4 w = {r0[0], r1[0], r0[1], r1[1]}; OUT = *reinterpret_cast<bf16x8*>(&w); } while (0)
  PK4(pF0, 0, pa0); PK4(pF0, 8, pa1); PK4(pF1, 0, pa2); PK4(pF1, 8, pa3);
#undef PK4
  bf16x8 vf[4]; v_frags((int)(uintptr_t)(lds + L_V) + v_rd_base(lane) + vblk * 512, vf);
  f32x16 o = {};
  o = __builtin_amdgcn_mfma_f32_32x32x16_bf16(pa0, vf[0], o, 0, 0, 0); o = __builtin_amdgcn_mfma_f32_32x32x16_bf16(pa1, vf[1], o, 0, 0, 0);
  o = __builtin_amdgcn_mfma_f32_32x32x16_bf16(pa2, vf[2], o, 0, 0, 0); o = __builtin_amdgcn_mfma_f32_32x32x16_bf16(pa3, vf[3], o, 0, 0, 0);
#pragma unroll
  for (int ks = 0; ks < 4; ++ks) {
    o = __builtin_amdgcn_mfma_f32_32x32x16_bf16(frag(lds + L_QF, iglob, ks, hi), frag(lds + L_STF, vblk * 32 + r32, ks, hi), o, 0, 0, 0);
    o = __builtin_amdgcn_mfma_f32_32x32x16_bf16(frag(lds + L_QB, iglob, ks, hi), frag(lds + L_STB, vblk * 32 + r32, ks, hi), o, 0, 0, 0); }
  float* RS = (float*)(lds + L_RSUM);
  { float v2[16];
#pragma unroll
    for (int r = 0; r < 16; ++r) v2[r] = o[r] * o[r];
    const bool b4 = lane & 16, b3 = lane & 8, b2 = lane & 4, b1 = lane & 2;
#pragma unroll
    for (int i = 0; i < 8; ++i) { const float keep = b4 ? v2[i + 8] : v2[i], send = b4 ? v2[i] : v2[i + 8]; v2[i] = keep + __shfl_xor(send, 16); }
#pragma unroll
    for (int i = 0; i < 4; ++i) { const float keep = b3 ? v2[i + 4] : v2[i], send = b3 ? v2[i] : v2[i + 4]; v2[i] = keep + __shfl_xor(send, 8); }
#pragma unroll
    for (int i = 0; i < 2; ++i) { const float keep = b2 ? v2[i + 2] : v2[i], send = b2 ? v2[i] : v2[i + 2]; v2[i] = keep + __shfl_xor(send, 4); }
    { const float keep = b1 ? v2[1] : v2[0], send = b1 ? v2[0] : v2[1]; v2[0] = keep + __shfl_xor(send, 2); }
    v2[0] += __shfl_xor(v2[0], 1);
    const int rr = (b4 ? 8 : 0) + (b3 ? 4 : 0) + (b2 ? 2 : 0) + (b1 ? 1 : 0);
    if ((lane & 1) == 0) RS[(ib * 4 + vblk) * 32 + crow(rr, hi)] = v2[0]; }
  __syncthreads();
  const int v = vblk * 32 + r32;
#pragma unroll
  for (int r = 0; r < 16; ++r) { const int il = crow(r, hi), i = ib * 32 + il;
    const float tot = (RS[(ib * 4 + 0) * 32 + il] + RS[(ib * 4 + 1) * 32 + il]) + (RS[(ib * 4 + 2) * 32 + il] + RS[(ib * 4 + 3) * 32 + il]);
    const float rstd = __builtin_amdgcn_rsqf(tot * (1.f / 128.f) + RMS_EPS);
    const float rg = bf2f(rgr[r]);
    out[(size_t)(t0 + i) * ldo + hh * 128 + v] = (bf16_t)f2bf(o[r] * rstd * ng * (rg * __builtin_amdgcn_rcpf(1.f + __builtin_amdgcn_exp2f(-1.4426950408889634f * rg)))); }
  __syncthreads();
}
}

__device__ __forceinline__ void ln_core(float4 (&v)[4], const float* g, const float* b, float* out, bf16_t* outb, int lane) {
    float s = 0.f;
#pragma unroll
    for (int j = 0; j < 4; ++j) s += (v[j].x + v[j].y) + (v[j].z + v[j].w);
    const float mean = wave_sum(s) * (1.f / DM); float s2 = 0.f;
#pragma unroll
    for (int j = 0; j < 4; ++j) { v[j].x -= mean; v[j].y -= mean; v[j].z -= mean; v[j].w -= mean; s2 += (v[j].x * v[j].x + v[j].y * v[j].y) + (v[j].z * v[j].z + v[j].w * v[j].w); }
    const float rstd = 1.f / sqrtf(wave_sum(s2) * (1.f / DM) + LN_EPS);
#pragma unroll
    for (int j = 0; j < 4; ++j) {
        const float4 gg = ((const float4*)g)[lane + 64 * j], bb = ((const float4*)b)[lane + 64 * j];
        float4 o; o.x = v[j].x * rstd * gg.x + bb.x; o.y = v[j].y * rstd * gg.y + bb.y; o.z = v[j].z * rstd * gg.z + bb.z; o.w = v[j].w * rstd * gg.w + bb.w;
        ((float4*)out)[lane + 64 * j] = o; v[j] = o;
        if (outb) ((uint2*)outb)[lane + 64 * j] = make_uint2(pk2(o.x, o.y), pk2(o.z, o.w));
    }
}
__device__ __forceinline__ void wave_sum2(float& a, float& b) {
#pragma unroll
    for (int o = 1; o < 64; o <<= 1) { const float ta = __shfl_xor(a, o), tb = __shfl_xor(b, o); a += ta; b += tb; }
}
template <int MODE>
__device__ __forceinline__ void ln_core2(float4 (&v)[2][4], const float* g, const float* b, float* out0, float* out1, bf16_t* ob0, bf16_t* ob1, int lane, unsigned char* o8_0 = nullptr, unsigned char* o8_1 = nullptr) {
    float s[2] = {0.f, 0.f};
#pragma unroll
    for (int u = 0; u < 2; ++u)
#pragma unroll
        for (int j = 0; j < 4; ++j) s[u] += (v[u][j].x + v[u][j].y) + (v[u][j].z + v[u][j].w);
    wave_sum2(s[0], s[1]);
    float q[2] = {0.f, 0.f};
#pragma unroll
    for (int u = 0; u < 2; ++u) { const float mean = s[u] * (1.f / DM);
#pragma unroll
        for (int j = 0; j < 4; ++j) { v[u][j].x -= mean; v[u][j].y -= mean; v[u][j].z -= mean; v[u][j].w -= mean; q[u] += (v[u][j].x * v[u][j].x + v[u][j].y * v[u][j].y) + (v[u][j].z * v[u][j].z + v[u][j].w * v[u][j].w); } }
    wave_sum2(q[0], q[1]);
#pragma unroll
    for (int j = 0; j < 4; ++j) {
        const float4 gg = ((const float4*)g)[lane + 64 * j], bb = ((const float4*)b)[lane + 64 * j];
#pragma unroll
        for (int u = 0; u < 2; ++u) { const float rstd = 1.f / sqrtf(q[u] * (1.f / DM) + LN_EPS);
            float4 o; o.x = v[u][j].x * rstd * gg.x + bb.x; o.y = v[u][j].y * rstd * gg.y + bb.y; o.z = v[u][j].z * rstd * gg.z + bb.z; o.w = v[u][j].w * rstd * gg.w + bb.w;
            v[u][j] = o;
            if constexpr (MODE == 2) ((float4*)(u ? out1 : out0))[lane + 64 * j] = o;
            else ((uint2*)(u ? ob1 : ob0))[lane + 64 * j] = make_uint2(pk2(o.x, o.y), pk2(o.z, o.w));
            if constexpr (MODE == 1) ((unsigned*)(u ? o8_1 : o8_0))[lane + 64 * j] = pk4_fp8(o.x, o.y, o.z, o.w); }
    }
}
__device__ __forceinline__ int block_excl_scan(int x, int* scr, int tid, int& total) {
    const int lane = tid & 63, wid = tid >> 6; int inc = x;
#pragma unroll
    for (int o = 1; o < 64; o <<= 1) { const int y = __shfl_up(inc, o); if (lane >= o) inc += y; }
    __syncthreads();
    if (lane == 63) scr[wid] = inc;
    __syncthreads();
    int base = 0, tot = 0;
#pragma unroll
    for (int w = 0; w < 8; ++w) { const int c = scr[w]; base += (w < wid) ? c : 0; tot += c; }
    total = tot; return base + inc - x;
}

__device__ __forceinline__ void tb_load(float (&v)[32], const float* Wblk, int ldw, int lane) {
#pragma unroll
    for (int i = 0; i < 32; ++i) v[i] = __builtin_nontemporal_load(&Wblk[(size_t)(2 * i + (lane >> 5)) * ldw + (lane & 31)]);
}
__device__ __forceinline__ void tb_store(const float (&v)[32], bf16_t* dst, int ldt, float* scr, int lane) {
#pragma unroll
    for (int i = 0; i < 32; ++i) scr[(2 * i + (lane >> 5)) * 33 + (lane & 31)] = v[i];
    asm volatile("s_waitcnt lgkmcnt(0)" ::: "memory");
    const int c = lane & 7;
#pragma unroll
    for (int j = 0; j < 4; ++j) { const int n = (lane >> 3) + 8 * j; const float* s = scr + (8 * c) * 33 + n;
        uint4 o; o.x = pk2(s[0 * 33], s[1 * 33]); o.y = pk2(s[2 * 33], s[3 * 33]); o.z = pk2(s[4 * 33], s[5 * 33]); o.w = pk2(s[6 * 33], s[7 * 33]);
        *(uint4*)(dst + (size_t)n * ldt + 8 * c) = o; }
    asm volatile("s_waitcnt lgkmcnt(0)" ::: "memory");
}

__device__ __forceinline__ void tb_store8(const float (&v)[32], unsigned char* dst, int ldt, float sc, float* scr, int lane) {
#pragma unroll
    for (int i = 0; i < 32; ++i) scr[(2 * i + (lane >> 5)) * 33 + (lane & 31)] = v[i];
    asm volatile("s_waitcnt lgkmcnt(0)" ::: "memory");
    const int c = lane & 7;
#pragma unroll
    for (int j = 0; j < 4; ++j) { const int n = (lane >> 3) + 8 * j; const float* s = scr + (8 * c) * 33 + n;
        *(uint2*)(dst + (size_t)n * ldt + 8 * c) = make_uint2(pk4_fp8(s[0 * 33] * sc, s[1 * 33] * sc, s[2 * 33] * sc, s[3 * 33] * sc), pk4_fp8(s[4 * 33] * sc, s[5 * 33] * sc, s[6 * 33] * sc, s[7 * 33] * sc)); }
    asm volatile("s_waitcnt lgkmcnt(0)" ::: "memory");
}

__device__ __forceinline__ void ln_row(const float* a, const float* add, float alpha, const float* g, const float* b, float* out, int lane, float4 (&v)[4], bf16_t* outb = nullptr) {
    float s = 0.f;
#pragma unroll
    for (int j = 0; j < 4; ++j) {
        float4 x = ((const float4*)a)[lane + 64 * j];
        x.x *= alpha; x.y *= alpha; x.z *= alpha; x.w *= alpha;
        if (add) { const float4 y = ((const float4*)add)[lane + 64 * j]; x.x += y.x; x.y += y.y; x.z += y.z; x.w += y.w; }
        v[j] = x; s += (x.x + x.y) + (x.z + x.w);
    }
    const float mean = wave_sum(s) * (1.f / DM); float s2 = 0.f;
#pragma unroll
    for (int j = 0; j < 4; ++j) { v[j].x -= mean; v[j].y -= mean; v[j].z -= mean; v[j].w -= mean; s2 += (v[j].x * v[j].x + v[j].y * v[j].y) + (v[j].z * v[j].z + v[j].w * v[j].w); }
    const float rstd = 1.f / sqrtf(wave_sum(s2) * (1.f / DM) + LN_EPS);
#pragma unroll
    for (int j = 0; j < 4; ++j) {
        const float4 gg = ((const float4*)g)[lane + 64 * j], bb = ((const float4*)b)[lane + 64 * j];
        float4 o; o.x = v[j].x * rstd * gg.x + bb.x; o.y = v[j].y * rstd * gg.y + bb.y; o.z = v[j].z * rstd * gg.z + bb.z; o.w = v[j].w * rstd * gg.w + bb.w;
        if (out) ((float4*)out)[lane + 64 * j] = o; v[j] = o;
        if (outb) ((uint2*)outb)[lane + 64 * j] = make_uint2(pk2(o.x, o.y), pk2(o.z, o.w));
    }
}

struct GemmP {
    const float* A; const int* ridx; const float* Bm; float* C;
    int lda, ldb, ldc, M, N, K, nb, bshift;
    long sA, sB, sC; int sR;
    const float* aux; const bf16_t* auxb; int ldaux; long sAux; const float* aux2; int accum;
};
template <int MODE>
__device__ __forceinline__ void gemm_naive(const GemmP g, float* lds) {
    float (*As)[132] = (float (*)[132])lds;
    float (*Bs)[128] = (float (*)[128])(lds + 16 * 132);
    int tid_ = threadIdx.x; asm volatile("" : "+v"(tid_));
    const int tid = tid_, ty = tid >> 4, tx = tid & 15;
    const int mt = g.M / 128, nt = (g.N + 127) / 128, per = mt * nt, total = per * g.nb;
    int bid_ = blockIdx.x; asm volatile("" : "+s"(bid_));
    for (int tile = bid_; tile < total; tile += gridDim.x) {
        const int z = tile / per, r = tile % per, tm = r / nt, tn = r % nt;
        const int m0 = tm * 128, n0 = tn * 128;
        const float* Bz = g.Bm + (long)(z >> g.bshift) * g.sB;
        float* Cz = g.C + (long)z * g.sC;
        const int arow = m0 + (tid >> 2);
        const long grow = g.ridx ? (long)g.ridx[z * g.sR + arow] : (long)arow;
        const float* Arow = g.A + (long)z * g.sA + grow * g.lda + (tid & 3) * 4;
        const int bk = tid >> 5, bn = n0 + (tid & 31) * 4;
        const bool bok = bn < g.N;
        const float* Bp = Bz + (long)bk * g.ldb + bn;
        float acc[4][8];
#pragma unroll
        for (int i = 0; i < 4; ++i)
#pragma unroll
            for (int j = 0; j < 8; ++j) acc[i][j] = 0.f;
        float4 ra = *(const float4*)(Arow);
        float4 rb = bok ? *(const float4*)(Bp) : make_float4(0.f, 0.f, 0.f, 0.f);
        for (int k0 = 0; k0 < g.K; k0 += 16) {
            __syncthreads();
            { const int rr = tid >> 2, k4 = (tid & 3) * 4; As[k4][rr] = ra.x; As[k4 + 1][rr] = ra.y; As[k4 + 2][rr] = ra.z; As[k4 + 3][rr] = ra.w; }
            *(float4*)&Bs[bk][(tid & 31) * 4] = rb;
            __syncthreads();
            if (k0 + 16 < g.K) {
                ra = *(const float4*)(Arow + k0 + 16);
                rb = bok ? *(const float4*)(Bp + (long)(k0 + 16) * g.ldb) : make_float4(0.f, 0.f, 0.f, 0.f);
            }
#pragma unroll
            for (int k = 0; k < 16; ++k) {
                const float4 a = *(const float4*)&As[k][ty * 4];
                const float4 b0 = *(const float4*)&Bs[k][tx * 8], b1 = *(const float4*)&Bs[k][tx * 8 + 4];
                const float av[4] = {a.x, a.y, a.z, a.w};
                const float bv[8] = {b0.x, b0.y, b0.z, b0.w, b1.x, b1.y, b1.z, b1.w};
#pragma unroll
                for (int i = 0; i < 4; ++i)
#pragma unroll
                    for (int j = 0; j < 8; ++j) acc[i][j] = fmaf(av[i], bv[j], acc[i][j]);
            }
        }
#pragma unroll
        for (int i = 0; i < 4; ++i) {
            const int row = m0 + ty * 4 + i;
#pragma unroll
            for (int jv = 0; jv < 2; ++jv) {
                const int col = n0 + tx * 8 + jv * 4;
                if (col < g.N) {
                    float v[4] = {acc[i][jv * 4], acc[i][jv * 4 + 1], acc[i][jv * 4 + 2], acc[i][jv * 4 + 3]};
                    float* cp = Cz + (long)row * g.ldc + col;
                    if (MODE == 1) {
#pragma unroll
                        for (int q = 0; q < 4; ++q) v[q] *= g.aux[(long)z * g.sAux + col + q];
                    } else if (MODE == 2) {
                        float gl[4]; ld4bf(g.auxb + (long)row * g.ldaux + col, gl); const float4 gb = *(const float4*)(g.aux2 + col);
                        const float gv[4] = {gl[0] + gb.x, gl[1] + gb.y, gl[2] + gb.z, gl[3] + gb.w};
                        float4 old = make_float4(0.f, 0.f, 0.f, 0.f);
                        if (g.accum) old = *(const float4*)cp;
                        const float ov[4] = {old.x, old.y, old.z, old.w};
#pragma unroll
                        for (int q = 0; q < 4; ++q) v[q] = ov[q] + sigmoidf_(gv[q]) * v[q];
                    } else if (MODE == 3) {
                        const float4 old = *(const float4*)cp; const float ov[4] = {old.x, old.y, old.z, old.w};
#pragma unroll
                        for (int q = 0; q < 4; ++q) v[q] = siluf_(ov[q]) * v[q];
                    } else if (MODE == 4) {
                        const float rs = g.aux[(long)z * g.sAux + row];
#pragma unroll
                        for (int q = 0; q < 4; ++q) v[q] *= rs;
                    }
                    *(float4*)cp = make_float4(v[0], v[1], v[2], v[3]);
                }
            }
        }
    }
    __syncthreads();
}

#define W_IN(l)    (p.in[4]  + (size_t)(l) * DM * DIN)
#define B_GATE(l)  (p.in[5]  + (size_t)(l) * 3 * DM)
#define POOL_W(l)  (p.in[6]  + (size_t)(l) * 4 * 128 * 128)
#define POOL_S(l)  (p.in[7]  + (size_t)(l) * 512)
#define W_UP_A(l)  (p.in[8]  + (size_t)(l) * 512 * DM)
#define Q_NORM(l)  (p.in[9]  + (size_t)(l) * 384)
#define W_UQ(l)    (p.in[10] + (size_t)(l) * 384 * 768)
#define KV_NORM(l) (p.in[11] + (size_t)(l) * 256)
#define W_UKV(l)   (p.in[12] + (size_t)(l) * 256 * 1024)
#define W_UP_B(l)  (p.in[13] + (size_t)(l) * 512 * DM)
#define W_DEC(l)   (p.in[14] + (size_t)(l) * 2 * 16 * 256)
#define B_DEC(l)   (p.in[15] + (size_t)(l) * 2 * 256)
#define GLA_NORM(l)(p.in[16] + (size_t)(l) * 128)
#define W_UP_C(l)  (p.in[17] + (size_t)(l) * 512 * DM)
#define W_OUT(l)   (p.in[18] + (size_t)(l) * DM * DM)
#define LN1_G(l)   (p.in[19] + (size_t)(l) * DM)
#define LN1_B(l)   (p.in[20] + (size_t)(l) * DM)
#define ROUTER(l)  (p.in[21] + (size_t)(l) * DM * NE)
#define EW_GATE(l) (p.in[22] + (size_t)(l) * NE * DM * DEXP)
#define EW_UP(l)   (p.in[23] + (size_t)(l) * NE * DM * DEXP)
#define EW_DOWN(l) (p.in[24] + (size_t)(l) * NE * DEXP * DM)
#define LN2_G(l)   (p.in[25] + (size_t)(l) * DM)
#define LN2_B(l)   (p.in[26] + (size_t)(l) * DM)
#define WSF(off) ((float*)(p.ws + (off)))
#define WSI(off) ((int*)(p.ws + (off)))
#define WSB(off) ((bf16_t*)(p.ws + (off)))
#define PJ(t, c) bf2f(projb[(size_t)(t) * DINP + (c)])

enum Stage {
    ST_INIT = 0,
    ST_WCONV,
    ST_PROJ,
    ST_PREP,
    ST_SMALLGEMM,
    ST_ROPE,
    ST_ATTN,
    ST_GLA1, ST_GLA2, ST_GLA3,
    ST_GLAFIN,
    ST_MERGE_A, ST_MERGE_B, ST_MERGE_C,
    ST_OUTP,
    ST_LN1,
    ST_TOPK,
    ST_GATHER,
    ST_EXP_G, ST_EXP_U, ST_EXP_D,
    ST_LN2,
    ST_COUNT
};

#define KAS __attribute__((address_space(4)))
template <int ST>
__device__ __forceinline__ void run_stage(int l, float* lds) {
    const KAS Params* pk_ = (const KAS Params*)__builtin_amdgcn_kernarg_segment_ptr(); asm volatile("" : "+s"(pk_));
    const KAS Params& p = *pk_;
    int tid_ = threadIdx.x; asm volatile("" : "+v"(tid_));
    int bid_ = blockIdx.x; asm volatile("" : "+s"(bid_));
    const int tid = tid_, lane = tid & 63, wid = tid >> 6;
    const int G = gridDim.x, bid = bid_;
    const int gw = bid * 8 + wid, NGW = G * 8;
    const long gt = (long)bid * NTHR + tid, NGT = (long)G * NTHR;
    float* h = p.out;

    if constexpr (ST == ST_INIT) {
        for (int m0 = gw; m0 < T; m0 += 2 * NGW) {
            const int mr[2] = {m0, m0 + NGW}; float4 a[2][4];
#pragma unroll
            for (int u = 0; u < 2; ++u)
#pragma unroll
                for (int j = 0; j < 4; ++j) a[u][j] = ((const float4*)(p.in[0] + (size_t)mr[u] * DM))[lane + 64 * j];
            ln_core2<0>(a, p.in[2], p.in[3], nullptr, nullptr, WSB(WS_HB) + (size_t)mr[0] * DM, WSB(WS_HB) + (size_t)mr[1] * DM, lane);
        }
        {
            float* scr = lds + wid * 4096;
            constexpr int NBLK = DIN / 32, ITEMS_L = (DM / 64) * NBLK;
            {
#define WIN_ITEM(it, W, dst) do { const int ll_ = (it) / ITEMS_L, r_ = (it) % ITEMS_L, kb_ = r_ / NBLK, nb_ = r_ % NBLK; const int n0_ = 32 * nb_, drow_ = n0_ < 2752 ? n0_ + 3072 : n0_ - 2752; \
                    W = p.in[4] + (size_t)ll_ * DM * DIN + (size_t)(64 * kb_) * DIN + n0_; dst = WSB(WS_WIN_T) + (size_t)ll_ * DINP * DM + (size_t)drow_ * DM + 64 * kb_; } while (0)
                float va[32], vb[32]; const float* Wa = nullptr; const float* Wb = nullptr; bf16_t* da = nullptr; bf16_t* db = nullptr;
                int itA = gw, itB = gw + NGW;
                if (itA < 2 * ITEMS_L) { WIN_ITEM(itA, Wa, da); tb_load(va, Wa, DIN, lane); }
                while (itA < 2 * ITEMS_L) {
                    if (itB < 2 * ITEMS_L) { WIN_ITEM(itB, Wb, db); tb_load(vb, Wb, DIN, lane); }
                    tb_store(va, da, DM, scr, lane);
                    itA = itB + NGW;
                    if (itB >= 2 * ITEMS_L) break;
                    if (itA < 2 * ITEMS_L) { WIN_ITEM(itA, Wa, da); tb_load(va, Wa, DIN, lane); }
                    tb_store(vb, db, DM, scr, lane);
                    itB = itA + NGW;
                }
#undef WIN_ITEM
            }
            {
                constexpr int I_UQ = 6 * 24, I_UKV = 4 * 32, I_B = 8 * 32, I_OUT = 16 * 32, I_L = I_UQ + I_UKV + 2 * I_B + I_OUT;
                for (int it = gw; it < 2 * I_L; it += NGW) {
                    const int ll = it / I_L; int r = it % I_L; bf16_t* wsm = WSB(WS_WSMALL + (size_t)ll * WSM_STRIDE);
                    if (r < I_UQ) { const int kb = r / 24, nb = r % 24; transpose_block(p.in[10] + (size_t)ll * 384 * 768 + (size_t)(64 * kb) * 768 + 32 * nb, 768, wsm + WSM_UQ / 2 + (size_t)(32 * nb) * 384 + 64 * kb, 384, p.in[9] + ll * 384 + 64 * kb, nullptr, scr, lane); continue; } r -= I_UQ;
                    if (r < I_UKV) { const int kb = r / 32, nb = r % 32; transpose_block(p.in[12] + (size_t)ll * 256 * 1024 + (size_t)(64 * kb) * 1024 + 32 * nb, 1024, wsm + WSM_UKV / 2 + (size_t)(32 * nb) * 256 + 64 * kb, 256, p.in[11] + ll * 256 + 64 * kb, nullptr, scr, lane); continue; } r -= I_UKV;
                    if (r < 2 * I_B) { const int c = r / I_B, rr = r % I_B, kb = rr / 32, nb = rr % 32; const float* W = (c ? p.in[17] : p.in[13]) + (size_t)ll * 512 * DM;
                        transpose_block(W + (size_t)(64 * kb) * DM + 32 * nb, DM, wsm + WSM_MRG / 2 + (size_t)(32 * nb) * 1536 + 512 * (1 + c) + 64 * kb, 1536, nullptr, nullptr, scr, lane); continue; } r -= 2 * I_B;
                    { const int kb = r / 32, nb = r % 32; transpose_block(p.in[18] + (size_t)ll * DM * DM + (size_t)(64 * kb) * DM + 32 * nb, DM, wsm + WSM_OUT / 2 + (size_t)(32 * nb) * DM + 64 * kb, DM, nullptr, nullptr, scr, lane); }
                }
                {
                    float* At = lds; float* Bs = lds + 128 * 129;
                    for (int it = bid; it < 2 * 4 * 32; it += G) {
                        const int ll = it >> 7, g = (it >> 5) & 3, db = it & 31;
                        const float* pw = p.in[6] + (size_t)ll * 4 * 128 * 128 + (size_t)g * 128 * 128; const float* ps = p.in[7] + ll * 512 + g * 128;
                        const float* wa = p.in[8] + (size_t)ll * 512 * DM + (size_t)(g * 128) * DM + db * 32;
                        __syncthreads();
                        {
                            const float psv = ps[tid & 127];
                            float bq[8];
#pragma unroll
                            for (int k = 0; k < 8; ++k) { const int e = tid + k * NTHR; bq[k] = wa[(size_t)(e >> 5) * DM + (e & 31)]; }
#pragma unroll
                            for (int h2 = 0; h2 < 2; ++h2) { float aq[16];
#pragma unroll
                                for (int k = 0; k < 16; ++k) aq[k] = pw[tid + (h2 * 16 + k) * NTHR];
#pragma unroll
                                for (int k = 0; k < 16; ++k) { const int e = tid + (h2 * 16 + k) * NTHR; At[(e & 127) * 129 + (e >> 7)] = aq[k] * psv; } }
#pragma unroll
                            for (int k = 0; k < 8; ++k) { const int e = tid + k * NTHR; Bs[(e >> 5) * 32 + (e & 31)] = bq[k]; }
                        }
                        __syncthreads();
                        const int c = tid >> 2, d0 = (tid & 3) * 8;
                        float a0 = 0.f, a1 = 0.f, a2 = 0.f, a3 = 0.f, a4 = 0.f, a5 = 0.f, a6 = 0.f, a7 = 0.f;
#pragma unroll 8
                        for (int cp = 0; cp < 128; ++cp) { const float a = At[cp * 129 + c]; const float4 b0 = *(const float4*)(Bs + cp * 32 + d0), b1 = *(const float4*)(Bs + cp * 32 + d0 + 4);
                            a0 = fmaf(a, b0.x, a0); a1 = fmaf(a, b0.y, a1); a2 = fmaf(a, b0.z, a2); a3 = fmaf(a, b0.w, a3); a4 = fmaf(a, b1.x, a4); a5 = fmaf(a, b1.y, a5); a6 = fmaf(a, b1.z, a6); a7 = fmaf(a, b1.w, a7); }
                        bf16_t* o = WSB(WS_WSMALL + (size_t)ll * WSM_STRIDE + WSM_MRG) + (size_t)(db * 32 + d0) * 1536 + g * 128 + c;
                        o[0] = (bf16_t)f2bf(a0); o[1536] = (bf16_t)f2bf(a1); o[2 * 1536] = (bf16_t)f2bf(a2); o[3 * 1536] = (bf16_t)f2bf(a3);
                        o[4 * 1536] = (bf16_t)f2bf(a4); o[5 * 1536] = (bf16_t)f2bf(a5); o[6 * 1536] = (bf16_t)f2bf(a6); o[7 * 1536] = (bf16_t)f2bf(a7);
                    }
                    __syncthreads();
                }
            }
            for (long i = gt; i < 2L * 64 * DM / 8; i += NGT) { const int ll = (int)(i / (64 * DM / 8)); const long r = i % (64 * DM / 8);
                *(uint4*)(WSB(WS_WIN_T) + (size_t)ll * DINP * DM + (size_t)DIN * DM + r * 8) = make_uint4(0u, 0u, 0u, 0u); }
        }
        float* rc = WSF(WS_ROPE); float* rs = rc + T * 16;
        for (long i = gt; i < (long)T * 16; i += NGT) {
            const int t = (int)(i >> 4), j = (int)(i & 15);
            const float freq = powf(10000.0f, -(float)j / 16.0f);
            const float ang = (float)p.pos[t] * freq;
            rc[i] = cosf(ang); rs[i] = sinf(ang);
        }
    }
    if constexpr (ST == ST_WCONV) {
        float* scr = lds + wid * 4096;
        constexpr int I_G = 16 * 16 * 64, I_D = 16 * 32 * 32;
        constexpr int I_ALL = 2 * I_G + I_D;
#define WCONV_ITEM(it, W, ldw, dst, ldt, sc8) do { if ((it) < 2 * I_G) { const int up_ = (it) >= I_G, r_ = up_ ? (it) - I_G : (it), e_ = r_ >> 10, kb_ = (r_ >> 6) & 15, nb_ = r_ & 63, j0_ = nb_ * 32; \
            W = (up_ ? EW_UP(l) : EW_GATE(l)) + (size_t)e_ * DM * DEXP + (size_t)(64 * kb_) * DEXP + j0_; ldw = DEXP; \
            dst = (unsigned char*)(p.ws + WS_WGU_T) + (size_t)(e_ * 4096 + 256 * (j0_ >> 7) + (j0_ & 127) + (up_ ? 128 : 0)) * DM + 64 * kb_; ldt = DM; sc8 = F8_WGU; } \
          else { const int r_ = (it) - 2 * I_G, e_ = r_ >> 10, kb_ = (r_ >> 5) & 31, nb_ = r_ & 31; \
            W = EW_DOWN(l) + (size_t)e_ * DEXP * DM + (size_t)(64 * kb_) * DM + 32 * nb_; ldw = DM; dst = (unsigned char*)(p.ws + WS_WD_T) + (size_t)(e_ * 1024 + 32 * nb_) * DEXP + 64 * kb_; ldt = DEXP; sc8 = F8_WD; } } while (0)
        float va[32], vb[32]; const float* Wa = nullptr; const float* Wb = nullptr; unsigned char* da = nullptr; unsigned char* db = nullptr; int lwa = 0, lwb = 0, lta = 0, ltb = 0; float sa = 1.f, sb = 1.f;
        int itA = gw, itB = gw + NGW;
        if (itA < I_ALL) { WCONV_ITEM(itA, Wa, lwa, da, lta, sa); tb_load(va, Wa, lwa, lane); }
        while (itA < I_ALL) {
            if (itB < I_ALL) { WCONV_ITEM(itB, Wb, lwb, db, ltb, sb); tb_load(vb, Wb, lwb, lane); }
            tb_store8(va, da, lta, sa, scr, lane);
            itA = itB + NGW;
            if (itB >= I_ALL) break;
            if (itA < I_ALL) { WCONV_ITEM(itA, Wa, lwa, da, lta, sa); tb_load(va, Wa, lwa, lane); }
            tb_store8(vb, db, ltb, sb, scr, lane);
            itB = itA + NGW;
        }
#undef WCONV_ITEM
        __syncthreads();
    }
    if constexpr (ST == ST_PROJ) {
        pg8::Gemm g{WSB(WS_HB), WSB(WS_WIN_T) + (size_t)l * DINP * DM, T, DINP, DM, DM};
        pg8::StaticOrder S; S.init(T, DINP, G, bid);
        EpiProj E{WSB(WS_PROJB), B_GATE(l)};
        pg8::gemm_phase<EpiProj, pg8::StaticOrder, true, true>((PG8_LAS unsigned char*)lds, g, S, E);
    }
    if constexpr (ST == ST_PREP) {
        const bf16_t* projb = WSB(WS_PROJB); bf16_t* br = WSB(WS_BR); bf16_t* U = (bf16_t*)lds;
        float* rq = WSF(WS_RQ); float* rkv = rq + T; const float* rc = WSF(WS_ROPE); const float* rs = rc + T * 16; bf16_t* kb = WSB(WS_KB);
        for (int tile = bid; tile < T / 64; tile += G) {
            const int b = tile / (SEQ / 64), s0 = (tile % (SEQ / 64)) * 64, t0 = b * SEQ + s0;
            __syncthreads();
#pragma unroll
            for (int it = 0; it < 10; ++it) { const int e = tid + it * NTHR, r = e >> 6, ch = e & 63, s = s0 - 8 + r;
                uint4 v = make_uint4(0u, 0u, 0u, 0u);
                if (s >= 0 && s < SEQ) v = *(const uint4*)(projb + (size_t)(b * SEQ + s) * DINP + OFF_POOL + ch * 8);
                *(uint4*)(U + r * 512 + ch * 8) = v; }
            { const int r = tid >> 3, part = tid & 7; const bf16_t* row = projb + (size_t)(t0 + r) * DINP;
              uint4 wq[6], wk[4];
#pragma unroll
              for (int k = 0; k < 6; ++k) wq[k] = *(const uint4*)(row + OFF_CQ + (part + 8 * k) * 8);
#pragma unroll
              for (int k = 0; k < 4; ++k) wk[k] = *(const uint4*)(row + OFF_CKV + (part + 8 * k) * 8);
              float s1 = 0.f, s2 = 0.f;
#pragma unroll
              for (int k = 0; k < 6; ++k) { const unsigned ww[4] = {wq[k].x, wq[k].y, wq[k].z, wq[k].w};
#pragma unroll
                  for (int q = 0; q < 4; ++q) { const float a = __uint_as_float(ww[q] << 16), c = __uint_as_float(ww[q] & 0xffff0000u); s1 += a * a + c * c; } }
#pragma unroll
              for (int k = 0; k < 4; ++k) { const unsigned ww[4] = {wk[k].x, wk[k].y, wk[k].z, wk[k].w};
#pragma unroll
                  for (int q = 0; q < 4; ++q) { const float a = __uint_as_float(ww[q] << 16), c = __uint_as_float(ww[q] & 0xffff0000u); s2 += a * a + c * c; } }
#pragma unroll
              for (int o = 1; o < 8; o <<= 1) { s1 += __shfl_xor(s1, o); s2 += __shfl_xor(s2, o); }
              if (part == 0) { rq[t0 + r] = 1.f / sqrtf(s1 * (1.f / 384.f) + RMS_EPS); rkv[t0 + r] = 1.f / sqrtf(s2 * (1.f / 256.f) + RMS_EPS); } }
            { const int r = tid >> 3, j = (tid & 7) * 2, t = t0 + r;
              const float2 c2 = *(const float2*)(rc + (size_t)t * 16 + j), s2v = *(const float2*)(rs + (size_t)t * 16 + j);
              const unsigned x1p = *(const unsigned*)(projb + (size_t)t * DINP + OFF_KR + j), x2p = *(const unsigned*)(projb + (size_t)t * DINP + OFF_KR + 16 + j);
              const float x1a = __uint_as_float(x1p << 16), x1b = __uint_as_float(x1p & 0xffff0000u), x2a = __uint_as_float(x2p << 16), x2b = __uint_as_float(x2p & 0xffff0000u);
              const unsigned k1 = pk2(x1a * c2.x - x2a * s2v.x, x1b * c2.y - x2b * s2v.y), k2 = pk2(x1a * s2v.x + x2a * c2.x, x1b * s2v.y + x2b * c2.y);
#pragma unroll
              for (int hh = 0; hh < 8; ++hh) { *(unsigned*)(kb + (size_t)t * 768 + hh * 96 + 64 + j) = k1; *(unsigned*)(kb + (size_t)t * 768 + hh * 96 + 80 + j) = k2; } }
            __syncthreads();
            { const int cg = tid & 63, c0 = 8 * cg, hw = 1 << (c0 >> 7), sb = s0 + 8 * (tid >> 6);
              bf16_t* orow = br + (size_t)(b * SEQ + sb) * 1536 + c0;
              float sm[8];
#pragma unroll
              for (int q = 0; q < 8; ++q) sm[q] = 0.f;
#define U8ACC(ROW, SGN) do { const uint4 w_ = *(const uint4*)(U + (ROW) * 512 + c0); const unsigned ww_[4] = {w_.x, w_.y, w_.z, w_.w}; \
                  _Pragma("unroll") for (int q_ = 0; q_ < 4; ++q_) { sm[2 * q_] += (SGN) * __uint_as_float(ww_[q_] << 16); sm[2 * q_ + 1] += (SGN) * __uint_as_float(ww_[q_] & 0xffff0000u); } } while (0)
              for (int u = sb - hw; u < sb + hw; ++u) U8ACC(u - s0 + 8, 1.f);
#pragma unroll
              for (int k = 0; k < 8; ++k) { const int s = sb + k, r = s - s0 + 8;
                  int lo = s - hw; if (lo < 0) lo = 0; int hi = s + hw; if (hi > SEQ) hi = SEQ;
                  const float inv = 1.f / (float)(hi - lo);
                  const uint4 wc = *(const uint4*)(U + r * 512 + c0); const unsigned wcc[4] = {wc.x, wc.y, wc.z, wc.w}; uint4 o;
                  o.x = pk2(sm[0] * inv - __uint_as_float(wcc[0] << 16), sm[1] * inv - __uint_as_float(wcc[0] & 0xffff0000u));
                  o.y = pk2(sm[2] * inv - __uint_as_float(wcc[1] << 16), sm[3] * inv - __uint_as_float(wcc[1] & 0xffff0000u));
                  o.z = pk2(sm[4] * inv - __uint_as_float(wcc[2] << 16), sm[5] * inv - __uint_as_float(wcc[2] & 0xffff0000u));
                  o.w = pk2(sm[6] * inv - __uint_as_float(wcc[3] << 16), sm[7] * inv - __uint_as_float(wcc[3] & 0xffff0000u));
                  *(uint4*)(orow + (size_t)k * 1536) = o;
                  U8ACC(r + hw, 1.f); U8ACC(r - hw, -1.f); }
#undef U8ACC
            }
        }
        __syncthreads();
    }
    if constexpr (ST == ST_SMALLGEMM) {
        const bf16_t* wsm = WSB(WS_WSMALL + (size_t)l * WSM_STRIDE);
        { pg8::Gemm g{WSB(WS_PROJB) + OFF_CQ, wsm + WSM_UQ / 2, T, 768, 384, DINP}; pg8::StaticOrder S; S.init(T, 768, G, bid);
          EpiQ E{WSB(WS_QB), WSF(WS_RQ), WSF(WS_ROPE), WSF(WS_ROPE) + T * 16}; pg8::gemm_phase<EpiQ, pg8::StaticOrder, true, true>((PG8_LAS unsigned char*)lds, g, S, E); }
        { pg8::Gemm g{WSB(WS_PROJB) + OFF_CKV, wsm + WSM_UKV / 2, T, 1024, 256, DINP}; pg8::StaticOrder S; S.init(T, 1024, G, bid);
          EpiKV E{WSB(WS_KB), WSB(WS_VB), WSF(WS_RQ) + T}; pg8::gemm_phase<EpiKV, pg8::StaticOrder, true, true>((PG8_LAS unsigned char*)lds, g, S, E); }
    }
    if constexpr (ST == ST_ATTN) {
        const int vcu = (G % 8 == 0) ? (bid % 8) * (G / 8) + bid / 8 : bid;
        WStream wst; wst.gate = EW_GATE(l); wst.up = EW_UP(l); wst.down = EW_DOWN(l); wst.wgu_t = p.ws + WS_WGU_T; wst.wd_t = p.ws + WS_WD_T;
        { const int wu = __builtin_amdgcn_readfirstlane(wid); wst.init(bid * 8 + wu, NGW, (char*)lds + att::SHM_ATTN + wu * 2560, lane); }
        for (int L = vcu; L < NB * 8 * 32; L += G) {
            const int bh = L >> 5, qb = L & 31, b = bh >> 3, hh = bh & 7;
            att::attn_unit(WSB(WS_QB) + (size_t)(b * SEQ + qb * 256) * 768 + hh * 96, WSB(WS_KB) + (size_t)(b * SEQ) * 768 + hh * 96, WSB(WS_VB) + (size_t)(b * SEQ) * 512 + hh * 64,
                           WSB(WS_BR) + (size_t)(b * SEQ + qb * 256) * 1536 + 512 + hh * 64, SEQ, (char*)lds, wst);
        }
        while (wst.step <= wst.nsteps) wst.tick(lane);
        __syncthreads();
    }
    if constexpr (ST == ST_GLA1) {
        for (int item = bid; item < NB * 4 * 128; item += G) {
            const int b = item >> 9, hh = (item >> 7) & 3, c = item & 127;
            gla::g1_item((char*)lds, WSB(WS_PROJB), W_DEC(l), B_DEC(l), b, hh, c, WSF(WS_KVT), WSF(WS_DEC));
        }
    }
    if constexpr (ST == ST_GLA2) {
        const float* kvt = WSF(WS_KVT); const float* dec = WSF(WS_DEC); bf16_t* stp = WSB(WS_ST);
        for (long e = gt; e < 2L * 8 * 8192; e += NGT) {
            const int dir = (int)(e >> 16), bh = (int)((e >> 13) & 7), vd = (int)(e & 8191), d = vd & 63;
            const long base = ((long)dir * 8 + bh) * 128;
            float s = 0.f;
#pragma unroll 1
            for (int k0 = 0; k0 < 128; k0 += 32) {
                float kv[32], dc[32];
#pragma unroll
                for (int k = 0; k < 32; ++k) { const int c = dir ? 127 - (k0 + k) : k0 + k; kv[k] = kvt[(base + c) * 8192 + vd]; dc[k] = dec[(base + c) * 64 + d]; }
#pragma unroll
                for (int k = 0; k < 32; ++k) { const int c = dir ? 127 - (k0 + k) : k0 + k; stp[(base + c) * 8192 + vd] = (bf16_t)f2bf(s); s = fmaf(dc[k], s, kv[k]); }
            }
        }
    }
    if constexpr (ST == ST_GLA3) {
        for (int item = bid; item < NB * 4 * 128; item += G) {
            const int b = item >> 9, hh = (item >> 7) & 3, c = item & 127;
            gla::g3_item((char*)lds, WSB(WS_PROJB), W_DEC(l), B_DEC(l), GLA_NORM(l), b, hh, c, WSB(WS_ST), WSB(WS_BR) + 1024, 1536);
        }
    }
    if constexpr (ST == ST_MERGE_A) {
        const bf16_t* wsm = WSB(WS_WSMALL + (size_t)l * WSM_STRIDE);
        pg8::Gemm g{WSB(WS_BR), wsm + WSM_MRG / 2, T, DM, 1536, 1536}; pg8::StaticOrder S; S.init(T, DM, G, bid);
        EpiMerge E{WSB(WS_MERGEDB), WSB(WS_PROJB) + OFF_GATE};
        pg8::gemm_phase<EpiMerge, pg8::StaticOrder, true, true>((PG8_LAS unsigned char*)lds, g, S, E);
    }
    if constexpr (ST == ST_OUTP) {
        const bf16_t* wsm = WSB(WS_WSMALL + (size_t)l * WSM_STRIDE);
        pg8::Gemm g{WSB(WS_MERGEDB), wsm + WSM_OUT / 2, T, DM, DM, DM}; pg8::StaticOrder S; S.init(T, DM, G, bid);
        pg8::EpiBf16<0> E{WSB(WS_TMP), DM, nullptr, 0, 0, 1.f};
        pg8::gemm_phase<pg8::EpiBf16<0>, pg8::StaticOrder, true, true>((PG8_LAS unsigned char*)lds, g, S, E);
    }
    if constexpr (ST == ST_LN1) {
        float* RWT = lds; const float* rw = ROUTER(l);
        for (int i = tid; i < DM * 4; i += NTHR) { const int k = i >> 2, e4 = (i & 3) * 4; const float4 w = *(const float4*)(rw + (size_t)k * 16 + e4);
            RWT[(e4 + 0) * DM + k] = w.x; RWT[(e4 + 1) * DM + k] = w.y; RWT[(e4 + 2) * DM + k] = w.z; RWT[(e4 + 3) * DM + k] = w.w; }
        __syncthreads();
        float* afft = WSF(WS_AFF);
        for (int m0 = gw; m0 < T; m0 += 2 * NGW) {
            const int mr[2] = {m0, m0 + NGW};
            float4 hv[2][4];
#pragma unroll
            for (int u = 0; u < 2; ++u) { const bf16_t* hr = WSB(WS_HB) + (size_t)mr[u] * DM; const bf16_t* tr = WSB(WS_TMP) + (size_t)mr[u] * DM;
#pragma unroll
                for (int j = 0; j < 4; ++j) { float a[4], t4[4]; ld4bf(hr + 4 * (lane + 64 * j), a); ld4bf(tr + 4 * (lane + 64 * j), t4);
                    hv[u][j] = make_float4(fmaf(ALPHA, a[0], t4[0]), fmaf(ALPHA, a[1], t4[1]), fmaf(ALPHA, a[2], t4[2]), fmaf(ALPHA, a[3], t4[3])); } }
            ln_core2<1>(hv, LN1_G(l), LN1_B(l), nullptr, nullptr, WSB(WS_HB) + (size_t)mr[0] * DM, WSB(WS_HB) + (size_t)mr[1] * DM, lane,
                     p.ws + WS_HB8 + (size_t)mr[0] * DM, p.ws + WS_HB8 + (size_t)mr[1] * DM);
            float acc[2][16];
            {
                typedef float f32x2r __attribute__((ext_vector_type(2)));
                f32x2r hp[4][4];
#pragma unroll
                for (int j = 0; j < 4; ++j) { hp[j][0] = (f32x2r){hv[0][j].x, hv[1][j].x}; hp[j][1] = (f32x2r){hv[0][j].y, hv[1][j].y}; hp[j][2] = (f32x2r){hv[0][j].z, hv[1][j].z}; hp[j][3] = (f32x2r){hv[0][j].w, hv[1][j].w}; }
#pragma unroll
                for (int e = 0; e < 16; ++e) { f32x2r a2 = {0.f, 0.f};
#pragma unroll
                    for (int j = 0; j < 4; ++j) { const float4 w = *(const float4*)(RWT + e * DM + 4 * (lane + 64 * j));
                        const f32x2r wxy = {w.x, w.y}, wzw = {w.z, w.w};
                        asm("v_pk_fma_f32 %0, %1, %2, %0 op_sel_hi:[1,0,1]" : "+v"(a2) : "v"(hp[j][0]), "v"(wxy));
                        asm("v_pk_fma_f32 %0, %1, %2, %0 op_sel:[0,1,0] op_sel_hi:[1,1,1]" : "+v"(a2) : "v"(hp[j][1]), "v"(wxy));
                        asm("v_pk_fma_f32 %0, %1, %2, %0 op_sel_hi:[1,0,1]" : "+v"(a2) : "v"(hp[j][2]), "v"(wzw));
                        asm("v_pk_fma_f32 %0, %1, %2, %0 op_sel:[0,1,0] op_sel_hi:[1,1,1]" : "+v"(a2) : "v"(hp[j][3]), "v"(wzw)); }
                    acc[0][e] = a2.x; acc[1][e] = a2.y; if (e & 1) __builtin_amdgcn_sched_barrier(0); }
            }
#pragma unroll
            for (int i = 0; i < 8; ++i)
#pragma unroll
                for (int u = 0; u < 2; ++u) { const bool up = lane & 32; const float keep = up ? acc[u][i + 8] : acc[u][i], send = up ? acc[u][i] : acc[u][i + 8]; acc[u][i] = keep + __shfl_xor(send, 32); }
#pragma unroll
            for (int i = 0; i < 4; ++i)
#pragma unroll
                for (int u = 0; u < 2; ++u) { const bool up = lane & 16; const float keep = up ? acc[u][i + 4] : acc[u][i], send = up ? acc[u][i] : acc[u][i + 4]; acc[u][i] = keep + __shfl_xor(send, 16); }
#pragma unroll
            for (int i = 0; i < 2; ++i)
#pragma unroll
                for (int u = 0; u < 2; ++u) { const bool up = lane & 8; const float keep = up ? acc[u][i + 2] : acc[u][i], send = up ? acc[u][i] : acc[u][i + 2]; acc[u][i] = keep + __shfl_xor(send, 8); }
#pragma unroll
            for (int u = 0; u < 2; ++u) { const bool up = lane & 4; const float keep = up ? acc[u][1] : acc[u][0], send = up ? acc[u][0] : acc[u][1]; acc[u][0] = keep + __shfl_xor(send, 4); }
            float lg[2] = {acc[0][0], acc[1][0]};
#pragma unroll
            for (int o = 1; o <= 2; o <<= 1) { const float t0 = __shfl_xor(lg[0], o), t1 = __shfl_xor(lg[1], o); lg[0] += t0; lg[1] += t1; }
            float mx[2] = {lg[0], lg[1]};
#pragma unroll
            for (int o = 4; o <= 32; o <<= 1) { const float t0 = __shfl_xor(mx[0], o), t1 = __shfl_xor(mx[1], o); mx[0] = fmaxf(mx[0], t0); mx[1] = fmaxf(mx[1], t1); }
            const float ex[2] = {expf(lg[0] - mx[0]), expf(lg[1] - mx[1])}; float se[2] = {ex[0], ex[1]};
#pragma unroll
            for (int o = 4; o <= 32; o <<= 1) { const float t0 = __shfl_xor(se[0], o), t1 = __shfl_xor(se[1], o); se[0] += t0; se[1] += t1; }
            if ((lane & 3) == 0) { const int e = ((lane >> 5) & 1) * 8 + ((lane >> 4) & 1) * 4 + ((lane >> 3) & 1) * 2 + ((lane >> 2) & 1);
#pragma unroll
                for (int u = 0; u < 2; ++u) afft[(size_t)((mr[u] / SEQ) * 16 + e) * SEQ + (mr[u] % SEQ)] = ex[u] / se[u]; }
        }
        __syncthreads();
    }
    if constexpr (ST == ST_TOPK) {
        const float* afft = WSF(WS_AFF); int* idx = WSI(WS_IDX); float* gv = WSF(WS_GATEV); int* slot = WSI(WS_SLOT);
        int* hist = (int*)lds; int* ctl = hist + 256; int* scr = hist + 272;
        for (int z = bid; z < NZ; z += G) {
            const int e = z >> 1, b = z & 1; const float* list = afft + (size_t)(b * 16 + e) * SEQ;
            unsigned key[16];
#pragma unroll
            for (int j = 0; j < 16; j += 4) { const float4 x = *(const float4*)(list + tid * 16 + j); key[j] = __float_as_uint(x.x); key[j + 1] = __float_as_uint(x.y); key[j + 2] = __float_as_uint(x.z); key[j + 3] = __float_as_uint(x.w); }
            unsigned prefix = 0u; int need = CAP;
#pragma unroll 1
            for (int shift = 24; shift >= 0; shift -= 8) {
                __syncthreads();
                if (tid < 256) hist[tid] = 0;
                __syncthreads();
#pragma unroll
                for (int j = 0; j < 16; ++j) { const bool in = (shift == 24) || ((key[j] >> (shift + 8)) == (prefix >> (shift + 8))); if (in) atomicAdd(&hist[(key[j] >> shift) & 255u], 1); }
                __syncthreads();
                if (tid < 256) {
                    const int hc = hist[tid]; int inc = hc;
#pragma unroll
                    for (int o = 1; o < 64; o <<= 1) { const int y = __shfl_down(inc, o); if (lane + o < 64) inc += y; }
                    if (lane == 0) scr[wid] = inc;
                    __builtin_amdgcn_s_waitcnt(0xc07f); __builtin_amdgcn_wave_barrier();
                }
                __syncthreads();
                if (tid < 256) {
                    const int hc = hist[tid]; int inc = hc;
#pragma unroll
                    for (int o = 1; o < 64; o <<= 1) { const int y = __shfl_down(inc, o); if (lane + o < 64) inc += y; }
                    int ca = inc - hc;
#pragma unroll
                    for (int w = 1; w < 4; ++w) ca += (w > wid) ? scr[w] : 0;
                    if (ca < need && need <= ca + hc) { ctl[0] = tid; ctl[1] = need - ca; } }
                __syncthreads();
                prefix |= (unsigned)ctl[0] << shift; need = ctl[1];
            }
            int ceq = 0;
#pragma unroll
            for (int j = 0; j < 16; ++j) ceq += (key[j] == prefix) ? 1 : 0;
            int tot; const int beq = block_excl_scan(ceq, scr, tid, tot);
            int csel = 0, eqr = beq; unsigned selmask = 0u;
#pragma unroll
            for (int j = 0; j < 16; ++j) { bool sel = key[j] > prefix; if (key[j] == prefix) { sel = eqr < need; ++eqr; } if (sel) { selmask |= 1u << j; ++csel; } }
            int sl = block_excl_scan(csel, scr, tid, tot);
#pragma unroll
            for (int j = 0; j < 16; ++j) { const int trow = b * SEQ + tid * 16 + j;
                if ((selmask >> j) & 1u) { idx[z * CAP + sl] = trow; gv[z * CAP + sl] = __uint_as_float(key[j]); slot[(size_t)trow * 16 + e] = sl; ++sl; }
                else slot[(size_t)trow * 16 + e] = -1; }
        }
        __syncthreads();
    }
    if constexpr (ST == ST_GATHER) {
        const int* idx = WSI(WS_IDX); const bf16_t* hb = WSB(WS_HB); bf16_t* xe = WSB(WS_XE);
        const int nr = (NZ * CAP - gw + NGW - 1) / NGW; const int myi = (lane < nr) ? (idx[gw + lane * NGW] & (T - 1)) : 0;
        for (int k = 0; k < nr; k += 4) {
            const int k1 = (k + 1 < nr) ? k + 1 : k, k2 = (k + 2 < nr) ? k + 2 : k, k3 = (k + 3 < nr) ? k + 3 : k;
            const uint4* s0 = (const uint4*)(hb + (size_t)__shfl(myi, k) * DM); const uint4* s1 = (const uint4*)(hb + (size_t)__shfl(myi, k1) * DM);
            const uint4* s2 = (const uint4*)(hb + (size_t)__shfl(myi, k2) * DM); const uint4* s3 = (const uint4*)(hb + (size_t)__shfl(myi, k3) * DM);
            const uint4 x0 = s0[lane], y0 = s0[lane + 64], x1 = s1[lane], y1 = s1[lane + 64], x2 = s2[lane], y2 = s2[lane + 64], x3 = s3[lane], y3 = s3[lane + 64];
            { uint4* d = (uint4*)(xe + (size_t)(gw + k * NGW) * DM); d[lane] = x0; d[lane + 64] = y0; }
            if (k + 1 < nr) { uint4* d = (uint4*)(xe + (size_t)(gw + (k + 1) * NGW) * DM); d[lane] = x1; d[lane + 64] = y1; }
            if (k + 2 < nr) { uint4* d = (uint4*)(xe + (size_t)(gw + (k + 2) * NGW) * DM); d[lane] = x2; d[lane + 64] = y2; }
            if (k + 3 < nr) { uint4* d = (uint4*)(xe + (size_t)(gw + (k + 3) * NGW) * DM); d[lane] = x3; d[lane + 64] = y3; }
        }
    }
    if constexpr (ST == ST_EXP_G) {
        pg8::Gemm g{WSB(WS_HB8), WSB(WS_WGU_T), NZ * CAP, 16 * 4096, DM / 2, DM / 2, WSI(WS_IDX)};
        ExpertOrder1 S; S.init(G, bid);
        EpiSwiGLU E{WSB(WS_HID), DEXP};
        pg8::gemm_phase<EpiSwiGLU, ExpertOrder1, true, true, true, true>((PG8_LAS unsigned char*)lds, g, S, E);
    }
    if constexpr (ST == ST_EXP_D) {
        pg8::Gemm g{WSB(WS_HID), WSB(WS_WD_T), NZ * CAP, 16 * 1024, DEXP / 2, DEXP / 2};
        ExpertOrder2 S; S.init(G, bid);
        EpiRowScale E{WSB(WS_YE), DM, WSF(WS_GATEV)};
        pg8::gemm_phase<EpiRowScale, ExpertOrder2, true, true, false, true>((PG8_LAS unsigned char*)lds, g, S, E);
    }
    if constexpr (ST == ST_LN2) {
        const int* slot = WSI(WS_SLOT); const bf16_t* ye = WSB(WS_YE);
        for (int m0 = gw; m0 < T; m0 += 2 * NGW) {
            const int mr[2] = {m0, m0 + NGW};
            int sl[2]; unsigned long long mask[2]; float4 a[2][4];
#pragma unroll
            for (int u = 0; u < 2; ++u) { sl[u] = (lane < 16) ? slot[(size_t)mr[u] * 16 + lane] : -1; }
#pragma unroll
            for (int u = 0; u < 2; ++u) { const bf16_t* hr = WSB(WS_HB) + (size_t)mr[u] * DM;
#pragma unroll
                for (int j = 0; j < 4; ++j) { float x[4]; ld4bf(hr + 4 * (lane + 64 * j), x); a[u][j] = make_float4(ALPHA * x[0], ALPHA * x[1], ALPHA * x[2], ALPHA * x[3]); } }
            mask[0] = __ballot(sl[0] >= 0); mask[1] = __ballot(sl[1] >= 0);
            {
                const int cnt[2] = {__builtin_popcountll(mask[0]), __builtin_popcountll(mask[1])};
                uint2 yb[2][4][4];
#pragma unroll
                for (int u = 0; u < 2; ++u)
#pragma unroll
                    for (int k = 0; k < 4; ++k) if (k < cnt[u]) {
                        const int e = __builtin_ctzll(mask[u]); mask[u] &= mask[u] - 1;
                        const bf16_t* yr = ye + ((size_t)(e * 2 + mr[u] / SEQ) * CAP + __shfl(sl[u], e)) * DM;
#pragma unroll
                        for (int j = 0; j < 4; ++j) yb[u][k][j] = *(const uint2*)(yr + 4 * (lane + 64 * j)); }
#pragma unroll
                for (int u = 0; u < 2; ++u)
#pragma unroll
                    for (int k = 0; k < 4; ++k) if (k < cnt[u]) {
#pragma unroll
                        for (int j = 0; j < 4; ++j) { const uint2 w = yb[u][k][j];
                            a[u][j].x += __uint_as_float(w.x << 16); a[u][j].y += __uint_as_float(w.x & 0xffff0000u); a[u][j].z += __uint_as_float(w.y << 16); a[u][j].w += __uint_as_float(w.y & 0xffff0000u); } }
            }
            while (mask[0] | mask[1]) {
#pragma unroll
                for (int u = 0; u < 2; ++u) if (mask[u]) {
                    const int e = __builtin_ctzll(mask[u]); mask[u] &= mask[u] - 1;
                    const bf16_t* yr = ye + ((size_t)(e * 2 + mr[u] / SEQ) * CAP + __shfl(sl[u], e)) * DM;
#pragma unroll
                    for (int j = 0; j < 4; ++j) { float y[4]; ld4bf(yr + 4 * (lane + 64 * j), y); a[u][j].x += y[0]; a[u][j].y += y[1]; a[u][j].z += y[2]; a[u][j].w += y[3]; }
                }
            }
            if (l == 0) ln_core2<0>(a, LN2_G(l), LN2_B(l), nullptr, nullptr, WSB(WS_HB) + (size_t)mr[0] * DM, WSB(WS_HB) + (size_t)mr[1] * DM, lane);
            else ln_core2<2>(a, LN2_G(l), LN2_B(l), h + (size_t)mr[0] * DM, h + (size_t)mr[1] * DM, nullptr, nullptr, lane);
        }
    }
}


#define LAS __attribute__((address_space(3)))
#define XB_TMO      128
#define XB_XCNT(j)  (256  + 64 * (j))
#define XB_XSUB(j)  (1280 + 64 * (j))
#define XB_XGEN(j)  (2304 + 64 * (j))
#define XB_TOP      3328
#define XB_TOPGEN   3392
#define XCD_BAR_WORDS 3456
#define XB_SPIN_CAP (1u << 18)
__device__ __forceinline__ unsigned xb_ld(unsigned* p)              { return __hip_atomic_load(p, __ATOMIC_RELAXED, __HIP_MEMORY_SCOPE_AGENT); }
__device__ __forceinline__ unsigned xb_add(unsigned* p, unsigned v) { return __hip_atomic_fetch_add(p, v, __ATOMIC_RELAXED, __HIP_MEMORY_SCOPE_AGENT); }
__device__ __forceinline__ unsigned xb_xcc_id() { return (unsigned)__builtin_amdgcn_s_getreg((3 << 11) | 20) & 0xFu; }
#define XB_SPIN(cond, bar) do { unsigned _sp = 0; while (cond) { __builtin_amdgcn_s_sleep(1); \
    if ((++_sp & 255u) == 0u) { if (xb_ld(&(bar)[XB_TMO])) break; if (_sp > XB_SPIN_CAP) { atomicAdd(&(bar)[XB_TMO], 1u); break; } } } } while (0)
struct XcdBarrier { unsigned* bar; unsigned x; volatile LAS unsigned* st; };
__device__ __forceinline__ XcdBarrier xcd_barrier_post(unsigned* bar, volatile LAS unsigned* st) {
    XcdBarrier b; b.bar = bar; b.x = xb_xcc_id(); b.st = st;
    if (threadIdx.x == 0) (void)xb_add(&bar[XB_XCNT(b.x)], 1u);
    return b;
}
__device__ __forceinline__ void xcd_barrier_complete(unsigned* bar, unsigned x, unsigned& nloc, unsigned& nx) {
    const unsigned G = gridDim.x * gridDim.y * gridDim.z;
    unsigned sum, cnt, mine, sp = 0u;
    for (;;) {
        sum = 0u; cnt = 0u; mine = 0u;
#pragma unroll
        for (unsigned j = 0; j < 16; ++j) { const unsigned c = xb_ld(&bar[XB_XCNT(j)]); sum += c; cnt += (c > 0u) ? 1u : 0u; mine = (j == x) ? c : mine; }
        if (sum == G) break;
        __builtin_amdgcn_s_sleep(1);
        if ((++sp & 255u) == 0u) { if (xb_ld(&bar[XB_TMO])) break; if (sp > XB_SPIN_CAP) { atomicAdd(&bar[XB_TMO], 1u); break; } }
    }
    nloc = mine > 0u ? mine : 1u; nx = cnt > 0u ? cnt : 1u;
}
__device__ __forceinline__ void xcd_barrier(const XcdBarrier& b) {
    asm volatile("s_waitcnt vmcnt(0)" ::: "memory");
    __syncthreads();
    if (threadIdx.x == 0) {
        unsigned* bar = b.bar; asm volatile("" : "+s"(bar));
        unsigned bx = b.x; asm volatile("" : "+s"(bx));
        __builtin_amdgcn_s_waitcnt(0);
        unsigned nloc = b.st[0], nx = b.st[1];
        if (nloc == 0u) { xcd_barrier_complete(bar, bx, nloc, nx); b.st[0] = nloc; b.st[1] = nx; }
        const unsigned old = xb_add(&bar[XB_XSUB(bx)], 1u);
        const unsigned gen = old / nloc;
        if (old + 1u == (gen + 1u) * nloc) {
            __builtin_amdgcn_fence(__ATOMIC_RELEASE, "agent");
            asm volatile("s_waitcnt vmcnt(0)" ::: "memory");
            const unsigned og = xb_add(&bar[XB_TOP], 1u);
            const unsigned tg = og / nx;
            if (og + 1u == (tg + 1u) * nx) xb_add(&bar[XB_TOPGEN], 1u);
            else XB_SPIN(xb_ld(&bar[XB_TOPGEN]) == tg, bar);
            __builtin_amdgcn_fence(__ATOMIC_ACQUIRE, "agent");
            xb_add(&bar[XB_XGEN(bx)], 1u);
            asm volatile("s_waitcnt vmcnt(0)" ::: "memory");
        } else {
            XB_SPIN(xb_ld(&bar[XB_XGEN(bx)]) == gen, bar);
            __builtin_amdgcn_fence(__ATOMIC_ACQUIRE, "agent");
            asm volatile("s_waitcnt vmcnt(0)" ::: "memory");
        }
    }
    __syncthreads();
}
constexpr int MISC_OFF = 131072 + 320;
constexpr int CW_BAR = 4096;

__global__ void __launch_bounds__(NTHR) mega_fwd(Params p) {
    extern __shared__ __attribute__((aligned(16))) unsigned char lds_raw[];
    float* lds = (float*)lds_raw;
    volatile LAS unsigned* MISC = (volatile LAS unsigned*)((LAS unsigned char*)lds_raw + MISC_OFF);
    if (threadIdx.x < 32) MISC[threadIdx.x] = 0u;
    __syncthreads();
    unsigned char* ws_ = ((const KAS Params*)__builtin_amdgcn_kernarg_segment_ptr())->ws;
    XcdBarrier bar = xcd_barrier_post((unsigned*)(ws_ + WS_CTL) + CW_BAR, MISC + 8);
#define GB() xcd_barrier(bar)
#define YPRIO_ON()  do { if (__builtin_amdgcn_readfirstlane(threadIdx.x) >= 256) __builtin_amdgcn_s_setprio(1); } while (0)
#define YPRIO_OFF() __builtin_amdgcn_s_setprio(0)
    run_stage<ST_INIT>(0, lds); GB();
    for (int step = 0; step < 2 * 11; ++step) {
        const int l = step / 11, s = step % 11;
        switch (s) {
        case 0: run_stage<ST_PROJ>(l, lds); break;
        case 1: run_stage<ST_PREP>(l, lds); YPRIO_ON(); run_stage<ST_GLA1>(l, lds); YPRIO_OFF(); break;
        case 2: run_stage<ST_SMALLGEMM>(l, lds); run_stage<ST_GLA2>(l, lds); break;
        case 3: run_stage<ST_ATTN>(l, lds); YPRIO_ON(); run_stage<ST_GLA3>(l, lds); YPRIO_OFF(); break;
        case 4: run_stage<ST_MERGE_A>(l, lds); break;
        case 5: run_stage<ST_OUTP>(l, lds); break;
        case 6: run_stage<ST_LN1>(l, lds); break;
        case 7: run_stage<ST_TOPK>(l, lds); break;
        case 8: run_stage<ST_EXP_G>(l, lds); break;
        case 9: run_stage<ST_EXP_D>(l, lds); break;
        default: run_stage<ST_LN2>(l, lds); break;
        }
        if (step + 1 < 2 * 11) GB();
    }
#undef GB
}

template <int ST>
__global__ void __launch_bounds__(NTHR) k_stage(Params p, int l) {
    extern __shared__ __attribute__((aligned(16))) unsigned char lds_raw[];
    run_stage<ST>(l, (float*)lds_raw);
}

template <int ST> static void launch_stage(const Params& p, int l, int grid, hipStream_t stream) {
    static bool attr = false;
    if (!attr) { (void)hipFuncSetAttribute((const void*)k_stage<ST>, hipFuncAttributeMaxDynamicSharedMemorySize, LDS_BYTES); attr = true; }
    hipLaunchKernelGGL(k_stage<ST>, dim3(grid), dim3(NTHR), LDS_BYTES, stream, p, l);
}

extern "C" void kernel_launch(void* const* d_in, const int* in_sizes, int n_in, void* d_out, int out_size, void* d_ws, size_t ws_size, hipStream_t stream) {
    if (n_in != 27 || out_size != T * DM || ws_size < WS_END) {
        fprintf(stderr, "kernel_launch: unexpected shapes: n_in %d out %d ws %zu (need >= %zu)\n", n_in, out_size, ws_size, (size_t)WS_END);
        return;
    }
    Params p{};
    for (int i = 0; i < 27; ++i) p.in[i] = (const float*)d_in[i];
    p.pos = (const int*)d_in[1]; p.out = (float*)d_out; p.ws = (unsigned char*)d_ws;
    const int grid = 256;
#if MEGA
    static bool attr = false;
    if (!attr) { (void)hipFuncSetAttribute((const void*)mega_fwd, hipFuncAttributeMaxDynamicSharedMemorySize, LDS_BYTES); attr = true; }
    (void)hipMemsetAsync((char*)d_ws + WS_CTL, 0, 65536, stream);
    hipLaunchKernelGGL(mega_fwd, dim3(grid), dim3(NTHR), LDS_BYTES, stream, p);
#else
    launch_stage<ST_INIT>(p, 0, grid, stream);
    for (int l = 0; l < 2; ++l) {
        launch_stage<ST_PROJ>(p, l, grid, stream);
        launch_stage<ST_PREP>(p, l, grid, stream);
        launch_stage<ST_SMALLGEMM>(p, l, grid, stream);
        launch_stage<ST_ROPE>(p, l, grid, stream);
        launch_stage<ST_ATTN>(p, l, grid, stream);
        launch_stage<ST_GLAREC>(p, l, grid, stream);
        launch_stage<ST_GLAFIN>(p, l, grid, stream);
        launch_stage<ST_MERGE_A>(p, l, grid, stream);
        launch_stage<ST_MERGE_B>(p, l, grid, stream);
        launch_stage<ST_MERGE_C>(p, l, grid, stream);
        launch_stage<ST_OUTP>(p, l, grid, stream);
        launch_stage<ST_LN1>(p, l, grid, stream);
        launch_stage<ST_TOPK>(p, l, grid, stream);
        launch_stage<ST_EXP_G>(p, l, grid, stream);
        launch_stage<ST_EXP_U>(p, l, grid, stream);
        launch_stage<ST_EXP_D>(p, l, grid, stream);
        launch_stage<ST_LN2>(p, l, grid, stream);
    }
#endif
}
```
